# Optimizing an MI355X kernel written in HIP

```python
import math
import jax, jax.numpy as jnp
from jax import lax
import numpy as np

D_MODEL = 1024
BATCH = 8
SEQ = 4096
DEPTH = 4

GRID_W = 64
HEAD_DIM = 64
ATT_HEADS = 8
ATT_KV_HEADS = 2
GQA_GROUP = ATT_HEADS // ATT_KV_HEADS
ATT_WIDTH = ATT_HEADS * HEAD_DIM
ATT_KV_WIDTH = ATT_KV_HEADS * HEAD_DIM
Q_BLOCK = 128
ROPE_THETA = 10000.0
ROPE_FREQS = HEAD_DIM // 4
GLA_HEADS = 4
GLA_DK = 32
GLA_DV = 64
GLA_QK_WIDTH = GLA_HEADS * GLA_DK
GLA_WIDTH = GLA_HEADS * GLA_DV
GLA_GATE_RANK = 16
GLA_TAU = 16.0
GLA_CHUNK = 64
FNET_GROUPS = 4
FNET_GROUP_DIM = 64
FNET_WIDTH = FNET_GROUPS * FNET_GROUP_DIM
MIX_WIDTH = ATT_WIDTH + GLA_WIDTH + FNET_WIDTH
IN_SPLITS = (ATT_WIDTH, ATT_KV_WIDTH, ATT_KV_WIDTH, GLA_QK_WIDTH, GLA_QK_WIDTH,
             GLA_WIDTH, GLA_WIDTH, 2 * GLA_GATE_RANK, FNET_WIDTH)
IN_WIDTH = 1824
N_EXPERTS = 32
TOP_K = 4
D_EXPERT = 1024
SWIGLU_LIMIT = 7.0
SWIGLU_ALPHA = 1.702
LN_EPS = 1e-5
RMS_EPS = 1e-6
DN_ALPHA = (2.0 * DEPTH) ** 0.25
DN_BETA = (8.0 * DEPTH) ** -0.25

kernel_name = "hymba_style_gla_gqa_fnet_moe_deepnorm_encoder"


def layer_norm(x, g, b):
    xf = x.astype(jnp.float32)
    mu = jnp.mean(xf, axis=-1, keepdims=True)
    var = jnp.mean(jnp.square(xf - mu), axis=-1, keepdims=True)
    return ((xf - mu) * lax.rsqrt(var + LN_EPS) * g + b).astype(x.dtype)


def rms_norm_f32(x, g):
    xf = x.astype(jnp.float32)
    return xf * lax.rsqrt(jnp.mean(jnp.square(xf), axis=-1, keepdims=True) + RMS_EPS) * g.astype(jnp.float32)


def split_columns(proj):
    points, acc = [], 0
    for w in IN_SPLITS[:-1]:
        acc += w
        points.append(acc)
    return jnp.split(proj, points, axis=-1)


def axial_rope_tables(seq_len):
    rows = seq_len // GRID_W
    row_id = jnp.repeat(jnp.arange(rows, dtype=jnp.float32), GRID_W, total_repeat_length=seq_len)
    col_id = (jnp.arange(seq_len) % GRID_W).astype(jnp.float32)
    inv_freq = 1.0 / (ROPE_THETA ** (jnp.arange(ROPE_FREQS, dtype=jnp.float32) / ROPE_FREQS))
    ang = jnp.stack([row_id[:, None] * inv_freq, col_id[:, None] * inv_freq], axis=1)
    return jnp.cos(ang), jnp.sin(ang)


def apply_axial_rope(x, cos, sin):
    xr = x.reshape(*x.shape[:-1], 2, 2, ROPE_FREQS)
    x1, x2 = xr[..., 0, :], xr[..., 1, :]
    out = jnp.stack([x1 * cos - x2 * sin, x1 * sin + x2 * cos], axis=-2)
    return out.reshape(x.shape)


def gqa_axial_attention(q, k, v, q_gain, k_gain, cos, sin):
    b, s, _ = q.shape
    qh = q.reshape(b, s, ATT_KV_HEADS, GQA_GROUP, HEAD_DIM).transpose(0, 2, 3, 1, 4)
    kh = k.reshape(b, s, ATT_KV_HEADS, HEAD_DIM).transpose(0, 2, 1, 3)
    vh = v.reshape(b, s, ATT_KV_HEADS, HEAD_DIM).transpose(0, 2, 1, 3).astype(jnp.float32)
    qh = apply_axial_rope(rms_norm_f32(qh, q_gain), cos, sin) * (HEAD_DIM ** -0.5)
    kh = apply_axial_rope(rms_norm_f32(kh, k_gain), cos, sin)
    nb = s // Q_BLOCK
    qb = qh.reshape(b, ATT_KV_HEADS, GQA_GROUP, nb, Q_BLOCK, HEAD_DIM).transpose(3, 0, 1, 2, 4, 5)

    def one_block(q_blk):
        scores = jnp.einsum('bkgqd,bksd->bkgqs', q_blk, kh)
        p = jax.nn.softmax(scores, axis=-1)
        return jnp.einsum('bkgqs,bksd->bkgqd', p, vh)

    o = lax.map(one_block, qb)
    return o.transpose(1, 0, 4, 2, 3, 5).reshape(b, s, ATT_WIDTH)


def gla_chunked(q, k, v, log_a, strict):
    b, h, s, dk = q.shape
    dv = v.shape[-1]
    nc = s // GLA_CHUNK

    def to_chunks(t):
        return t.reshape(b, h, nc, GLA_CHUNK, t.shape[-1]).transpose(2, 0, 1, 3, 4)

    idx = jnp.arange(GLA_CHUNK)
    mask = (idx[:, None] > idx[None, :]) if strict else (idx[:, None] >= idx[None, :])

    def step(state, inp):
        qc, kc, vc, ac = inp
        bc = jnp.cumsum(ac, axis=-2)
        diff = bc[..., :, None, :] - bc[..., None, :, :]
        decay = jnp.exp(jnp.where(mask[:, :, None], diff, -jnp.inf))
        scores = jnp.einsum('bhid,bhjd,bhijd->bhij', qc, kc, decay)
        o = (jnp.einsum('bhij,bhjv->bhiv', scores, vc)
             + jnp.einsum('bhid,bhdv->bhiv', qc * jnp.exp(bc), state))
        b_last = bc[..., -1, :]
        k_dec = kc * jnp.exp(b_last[..., None, :] - bc)
        state = state * jnp.exp(b_last)[..., None] + jnp.einsum('bhjd,bhjv->bhdv', k_dec, vc)
        return state, o

    state0 = jnp.zeros((b, h, dk, dv), jnp.float32)
    _, o = lax.scan(step, state0, (to_chunks(q), to_chunks(k), to_chunks(v), to_chunks(log_a)))
    return o.transpose(1, 2, 0, 3, 4).reshape(b, h, s, dv)


def gla_mixer(q, k, v, r, lowrank, gate_w, gate_b, norm_g):
    b, s, _ = q.shape

    def heads(t, d):
        return t.reshape(b, s, GLA_HEADS, d).transpose(0, 2, 1, 3).astype(jnp.float32)

    qh = heads(q, GLA_DK) * (GLA_DK ** -0.5)
    kh = heads(k, GLA_DK)
    vh = heads(v, GLA_DV)
    z = jnp.einsum('bsnr,nrk->bsnk', lowrank.reshape(b, s, 2, GLA_GATE_RANK), gate_w) + gate_b
    log_a = jax.nn.log_sigmoid(z.astype(jnp.float32)) / GLA_TAU
    la_fwd = heads(log_a[:, :, 0], GLA_DK)
    la_bwd = heads(log_a[:, :, 1], GLA_DK)
    o_fwd = gla_chunked(qh, kh, vh, la_fwd, strict=False)
    flip = lambda t: jnp.flip(t, axis=2)
    o_bwd = flip(gla_chunked(flip(qh), flip(kh), flip(vh), flip(la_bwd), strict=True))
    o = rms_norm_f32(o_fwd + o_bwd, norm_g)
    o = o.transpose(0, 2, 1, 3).reshape(b, s, GLA_WIDTH)
    return o * jax.nn.silu(r.astype(jnp.float32))


def fourier_mixer(f):
    b, s, _ = f.shape
    fg = f.reshape(b, s, FNET_GROUPS, FNET_GROUP_DIM).astype(jnp.float32)
    return jnp.fft.fftn(fg, axes=(1, 3), norm='ortho').real.reshape(b, s, FNET_WIDTH)


def moe_ffn(x, router_w, router_b, w_gu, b_gu, w_down, b_down):
    b, s, d = x.shape
    xt = x.reshape(b * s, d)
    logits = (xt @ router_w + router_b).astype(jnp.float32)
    top_val, top_idx = lax.top_k(logits, TOP_K)
    top_w = jax.nn.softmax(top_val, axis=-1)
    combine = jnp.sum(jax.nn.one_hot(top_idx, N_EXPERTS, dtype=jnp.float32) * top_w[..., None], axis=1)
    y = jnp.zeros((b * s, d), jnp.float32)
    for e in range(N_EXPERTS):
        gu = xt @ w_gu[e] + b_gu[e]
        gate, up = jnp.split(gu, 2, axis=-1)
        gate = jnp.minimum(gate, SWIGLU_LIMIT)
        up = jnp.clip(up, -SWIGLU_LIMIT, SWIGLU_LIMIT)
        hid = (up + 1.0) * (gate * jax.nn.sigmoid(SWIGLU_ALPHA * gate))
        y = y + combine[:, e:e + 1] * (hid @ w_down[e] + b_down[e]).astype(jnp.float32)
    return y.reshape(b, s, d).astype(x.dtype)


def setup_inputs(seed: int = 0) -> dict:
    key = jax.random.key(seed)
    ks = jax.random.split(key, 20)
    f32 = jnp.float32
    nrm = lambda k, shape, scale: jax.random.normal(k, shape, f32) * scale
    L = DEPTH
    return {
        "x": nrm(ks[0], (BATCH, SEQ, D_MODEL), 1.0),
        "ln_in_g": 1.0 + nrm(ks[1], (D_MODEL,), 0.02),
        "ln_in_b": nrm(ks[2], (D_MODEL,), 0.02),
        "w_in": nrm(ks[3], (L, D_MODEL, IN_WIDTH), D_MODEL ** -0.5),
        "att_q_gain": 1.0 + nrm(ks[4], (L, HEAD_DIM), 0.02),
        "att_k_gain": 1.0 + nrm(ks[5], (L, HEAD_DIM), 0.02),
        "gla_gate_w": nrm(ks[6], (L, 2, GLA_GATE_RANK, GLA_QK_WIDTH), GLA_GATE_RANK ** -0.5),
        "gla_gate_b": nrm(ks[7], (L, 2, GLA_QK_WIDTH), 0.1),
        "gla_norm_g": 1.0 + nrm(ks[8], (L, GLA_DV), 0.02),
        "w_out": nrm(ks[9], (L, MIX_WIDTH, D_MODEL), MIX_WIDTH ** -0.5 * DN_BETA),
        "ln1_g": 1.0 + nrm(ks[10], (L, D_MODEL), 0.02),
        "ln1_b": nrm(ks[11], (L, D_MODEL), 0.02),
        "router_w": nrm(ks[12], (L, D_MODEL, N_EXPERTS), D_MODEL ** -0.5),
        "router_b": nrm(ks[13], (L, N_EXPERTS), 0.01),
        "exp_w_gu": nrm(ks[14], (L, N_EXPERTS, D_MODEL, 2 * D_EXPERT), D_MODEL ** -0.5),
        "exp_b_gu": nrm(ks[15], (L, N_EXPERTS, 2 * D_EXPERT), 0.02),
        "exp_w_down": nrm(ks[16], (L, N_EXPERTS, D_EXPERT, D_MODEL), D_EXPERT ** -0.5 * DN_BETA),
        "exp_b_down": nrm(ks[17], (L, N_EXPERTS, D_MODEL), 0.02),
        "ln2_g": 1.0 + nrm(ks[18], (L, D_MODEL), 0.02),
        "ln2_b": nrm(ks[19], (L, D_MODEL), 0.02),
    }


def reference(x, ln_in_g, ln_in_b, w_in, att_q_gain, att_k_gain, gla_gate_w, gla_gate_b,
              gla_norm_g, w_out, ln1_g, ln1_b, router_w, router_b, exp_w_gu, exp_b_gu,
              exp_w_down, exp_b_down, ln2_g, ln2_b):
    b, s, d = x.shape
    cos, sin = axial_rope_tables(s)
    h = layer_norm(x, ln_in_g, ln_in_b)
    for l in range(DEPTH):
        proj = jnp.einsum('bsd,dp->bsp', h, w_in[l])
        aq, ak, av, gq, gk, gv, gr, glr, fx = split_columns(proj)
        o_att = gqa_axial_attention(aq, ak, av, att_q_gain[l], att_k_gain[l], cos, sin)
        o_gla = gla_mixer(gq, gk, gv, gr, glr, gla_gate_w[l], gla_gate_b[l], gla_norm_g[l])
        o_fft = fourier_mixer(fx)
        mix = jnp.concatenate([o_att, o_gla, o_fft], axis=-1).astype(h.dtype)
        h = layer_norm(DN_ALPHA * h + mix @ w_out[l], ln1_g[l], ln1_b[l])
        y = moe_ffn(h, router_w[l], router_b[l], exp_w_gu[l], exp_b_gu[l], exp_w_down[l], exp_b_down[l])
        h = layer_norm(DN_ALPHA * h + y, ln2_g[l], ln2_b[l])
    return h
```

```cpp
#include <hip/hip_runtime.h>
#include <hip/hip_bf16.h>
#include <cstdio>
#include <cstdint>
#include <cmath>
namespace pg8 {
#define PG8_LAS __attribute__((address_space(3)))
typedef unsigned short bf16_t;
typedef short bf16x8 __attribute__((ext_vector_type(8)));
typedef float f32x4 __attribute__((ext_vector_type(4)));
typedef unsigned u32x4 __attribute__((ext_vector_type(4)));
constexpr int BM = 256, BK = 64, HALF = 128, HTB = HALF * BK * 2  , STAGE_BYTES = 8 * HTB, NXCD = 8, WGM = 8;

__host__ __device__ __forceinline__ int lds_byte(int r, int c) { const int st = (r >> 4) * 2 + (c >> 5), rr = r & 15, cc = c & 31, ob = rr * 64 + cc * 2; return st * 1024 + (ob ^ (((ob >> 9) & 1) << 5)); }
__host__ __device__ __forceinline__ void stage_rc(int b, int& R, int& C) { const int st = b / 1024, sb = b % 1024, swz = sb ^ (((sb >> 9) & 1) << 5); R = (st >> 1) * 16 + swz / 64; C = (st & 1) * 32 + (swz % 64) / 2; }
__host__ __device__ __forceinline__ int perm32(int rho) { const int n = rho >> 4, i = rho & 15; return 8 * (i >> 2) + 4 * n + (i & 3); }

struct Unit { int pm, pn; };
struct Gemm { const bf16_t* A; const bf16_t* Bt; int M, N, K; };

struct StaticOrder {
    int nM, nN, nwg, G, c;
    __host__ __device__ void init(int M, int N, int G_, int c_) { nM = M / BM; nN = N / BM; nwg = nM * nN; G = G_; c = c_; }
    __host__ __device__ bool next(int i, Unit& u) const {
        const long L = (long)i * G + c; if (L >= nwg) return false;
        int wgid = (int)L; { const int q = nwg / NXCD, r = nwg % NXCD, xcd = wgid % NXCD, off = wgid / NXCD; wgid = (xcd < r ? xcd * (q + 1) : r * (q + 1) + (xcd - r) * q) + off; }
        const int nig = WGM * nN, gid = wgid / nig, fm = gid * WGM, gsz = (nM - fm) < WGM ? (nM - fm) : WGM;
        u.pm = fm + ((wgid % nig) % gsz); u.pn = (wgid % nig) / gsz; return true;
    }
    __device__ __forceinline__ void a_ready(const Unit&) const {}
    __device__ __forceinline__ void done(const Unit&) const {}
};

__device__ __forceinline__ unsigned cvt_pk_bf16(float lo, float hi) { unsigned r; asm volatile("v_cvt_pk_bf16_f32 %0, %1, %2" : "=v"(r) : "v"(lo), "v"(hi)); return r; }
typedef float f32x2 __attribute__((ext_vector_type(2)));
__device__ __forceinline__ u32x4 pack8(const f32x4 v0, const f32x4 v1) { u32x4 w; w.x = cvt_pk_bf16(v0[0], v0[1]); w.y = cvt_pk_bf16(v0[2], v0[3]); w.z = cvt_pk_bf16(v1[0], v1[1]); w.w = cvt_pk_bf16(v1[2], v1[3]); return w; }

struct EpiPlainBf16 {
    static constexpr bool PERM = true, AFTER_DRAIN = false;
    bf16_t* O; int ldc;
    __device__ __forceinline__ void operator()(const f32x4 (&acc)[2][2][4][2], const Unit& u, int wr, int wc, int fr, int fq) const {
        const int row0 = u.pm * BM + wr * 64 + fr, col0 = u.pn * BM + wc * 32 + 8 * fq;
#pragma unroll
        for (int ai = 0; ai < 2; ++ai)
#pragma unroll
            for (int m = 0; m < 4; ++m) { bf16_t* rowp = O + (size_t)(row0 + ai * HALF + m * 16) * ldc + col0;
#pragma unroll
                for (int bj = 0; bj < 2; ++bj) *(u32x4*)(rowp + bj * HALF) = pack8(acc[ai][bj][m][0], acc[ai][bj][m][1]); }
    }
};
struct EpiFnet {
    static constexpr bool PERM = true, AFTER_DRAIN = false;
    bf16_t* MIX;
    __device__ __forceinline__ void operator()(const f32x4 (&acc)[2][2][4][2], const Unit& u, int wr, int wc, int fr, int fq) const {
        const int row0 = u.pn * 4096 + u.pm * BM + wr * 64 + fr, col0 = 768 + wc * 32 + 8 * fq;
#pragma unroll
        for (int ai = 0; ai < 2; ++ai)
#pragma unroll
            for (int m = 0; m < 4; ++m) { bf16_t* rowp = MIX + (size_t)(row0 + ai * HALF + m * 16) * 1024 + col0;
#pragma unroll
                for (int bj = 0; bj < 2; ++bj) *(u32x4*)(rowp + bj * HALF) = pack8(acc[ai][bj][m][0], acc[ai][bj][m][1]); }
    }
};
struct EpiResF32 {
    static constexpr bool PERM = false, AFTER_DRAIN = false;
    const float* base; float* out; int ldc; float alpha;
    __device__ __forceinline__ void operator()(const f32x4 (&acc)[2][2][4][2], const Unit& u, int wr, int wc, int fr, int fq) const {
        const int row0 = u.pm * BM + wr * 64 + fr, col0 = u.pn * BM + wc * 32 + 4 * fq;
#pragma unroll
        for (int ai = 0; ai < 2; ++ai)
#pragma unroll
            for (int m = 0; m < 4; ++m) { const size_t off = (size_t)(row0 + ai * HALF + m * 16) * ldc + col0;
#pragma unroll
                for (int bj = 0; bj < 2; ++bj)
#pragma unroll
                    for (int n = 0; n < 2; ++n) { const f32x4 b = *(const f32x4*)(base + off + bj * HALF + n * 16); *(f32x4*)(out + off + bj * HALF + n * 16) = b * alpha + acc[ai][bj][m][n]; } }
    }
};
__device__ __forceinline__ float swiglu1(float g, float u) { g = fminf(g, 7.0f); u = fminf(fmaxf(u, -7.0f), 7.0f); return (u + 1.0f) * g * __builtin_amdgcn_rcpf(1.0f + __expf(-1.702f * g)); }
struct EpiSwiglu {
    static constexpr bool PERM = true, AFTER_DRAIN = false;
    bf16_t* HID; const float* bgu;
    __device__ __forceinline__ void operator()(const f32x4 (&acc)[2][2][4][2], const Unit& u, int wr, int wc, int fr, int fq) const {
        const int e = u.pn >> 3, pnl = u.pn & 7; const int row0 = u.pm * BM + wr * 64 + fr, jj0 = pnl * 128 + wc * 32 + 8 * fq;
        const float* bg = bgu + (size_t)e * 2048 + jj0;
        const f32x4 bg0 = *(const f32x4*)bg, bg1 = *(const f32x4*)(bg + 4), bu0 = *(const f32x4*)(bg + 1024), bu1 = *(const f32x4*)(bg + 1028);
#pragma unroll
        for (int ai = 0; ai < 2; ++ai)
#pragma unroll
            for (int m = 0; m < 4; ++m) { bf16_t* rowp = HID + (size_t)(row0 + ai * HALF + m * 16) * 1024 + jj0;
                const f32x4 g0 = acc[ai][0][m][0] + bg0, g1 = acc[ai][0][m][1] + bg1, u0 = acc[ai][1][m][0] + bu0, u1 = acc[ai][1][m][1] + bu1;
                f32x4 h0, h1;
#pragma unroll
                for (int i = 0; i < 4; ++i) { h0[i] = swiglu1(g0[i], u0[i]); h1[i] = swiglu1(g1[i], u1[i]); }
                *(u32x4*)rowp = pack8(h0, h1); }
    }
};
struct EpiDown {
    static constexpr bool PERM = true, AFTER_DRAIN = false;
    bf16_t* Y; const float* bd;
    __device__ __forceinline__ void operator()(const f32x4 (&acc)[2][2][4][2], const Unit& u, int wr, int wc, int fr, int fq) const {
        const int e = u.pn >> 2, pnl = u.pn & 3; const int row0 = u.pm * BM + wr * 64 + fr, col0 = pnl * BM + wc * 32 + 8 * fq;
        const float* bp = bd + (size_t)e * 1024 + col0;
        f32x4 bv[2][2];
#pragma unroll
        for (int bj = 0; bj < 2; ++bj)
#pragma unroll
            for (int n = 0; n < 2; ++n) bv[bj][n] = *(const f32x4*)(bp + bj * HALF + 4 * n);
#pragma unroll
        for (int ai = 0; ai < 2; ++ai)
#pragma unroll
            for (int m = 0; m < 4; ++m) { bf16_t* rowp = Y + (size_t)(row0 + ai * HALF + m * 16) * 1024 + col0;
#pragma unroll
                for (int bj = 0; bj < 2; ++bj) *(u32x4*)(rowp + bj * HALF) = pack8(acc[ai][bj][m][0] + bv[bj][0], acc[ai][bj][m][1] + bv[bj][1]); }
    }
};
struct ListOrder {
    const PG8_LAS int* list; int n;
    __device__ __forceinline__ bool next(int i, Unit& u) const { if (i >= n) return false; const int v = __builtin_amdgcn_readfirstlane(list[i]); u.pm = v >> 16; u.pn = v & 0xffff; return true; }
    __device__ __forceinline__ void a_ready(const Unit&) const {}
    __device__ __forceinline__ void done(const Unit&) const {}
};
template <class Epi, class Sched, bool ALIGN_EPI = false, bool SP2 = false>
__device__ __forceinline__ void gemm_phase(PG8_LAS unsigned char* lds, const Gemm g, const Sched& S, const Epi& E) {
    int tid_ = threadIdx.x; asm volatile("" : "+v"(tid_));
    const int tid = tid_, wid = __builtin_amdgcn_readfirstlane(tid >> 6), lane = tid & 63, wr = wid >> 2, wc = wid & 3, fr = lane & 15, fq = lane >> 4;
    const int K = g.K, nt = K / BK;
    unsigned voffA[2], voffB[2];
#pragma unroll
    for (int i = 0; i < 2; ++i) { int R, C; stage_rc(tid * 16 + i * 8192, R, C); const int Rb = Epi::PERM ? ((R & ~31) + perm32(R & 31)) : R;
        voffA[i] = (unsigned)(R * K + C) * 2u; voffB[i] = (unsigned)(Rb * K + C) * 2u; }
    const size_t kstep = (size_t)(BK * 2);
    const size_t hstep = (size_t)HALF * K * 2;
    const size_t tstep = 2 * hstep;
    const unsigned ldsw = (unsigned)wid * 1024u;
    const int aoff = lds_byte(wr * 64 + fr, fq * 8), boff = lds_byte(wc * 32 + fr, fq * 8);
#define PG8_SA(b, h) (((b) * 2 + (h)) * HTB)
#define PG8_SB(b, h) ((4 + (b) * 2 + (h)) * HTB)
#define PG8_STAGE(bufoff, gbase, voff) do { _Pragma("unroll") for (int _i = 0; _i < 2; ++_i) \
        __builtin_amdgcn_global_load_lds((const unsigned*)((const char*)(gbase) + (voff)[_i]), (PG8_LAS unsigned*)(lds + (bufoff) + ldsw + _i * 8192), 16, 0, 0); } while (0)
#define PG8_LDA(dst, b, h) do { _Pragma("unroll") for (int m = 0; m < 4; ++m) _Pragma("unroll") for (int k = 0; k < 2; ++k) dst[m][k] = *(const PG8_LAS bf16x8*)(lds + PG8_SA(b, h) + aoff + m * 2048 + k * 1024); } while (0)
#define PG8_LDB(dst, b, h) do { _Pragma("unroll") for (int n = 0; n < 2; ++n) _Pragma("unroll") for (int k = 0; k < 2; ++k) dst[n][k] = *(const PG8_LAS bf16x8*)(lds + PG8_SB(b, h) + boff + n * 2048 + k * 1024); } while (0)
#define PG8_MMA(ai, bj, At, Bt) do { __builtin_amdgcn_s_setprio(1); _Pragma("unroll") for (int m = 0; m < 4; ++m) _Pragma("unroll") for (int n = 0; n < 2; ++n) _Pragma("unroll") for (int k = 0; k < 2; ++k) \
        acc[ai][bj][m][n] = __builtin_amdgcn_mfma_f32_16x16x32_bf16(Bt[n][k], At[m][k], acc[ai][bj][m][n], 0, 0, 0); __builtin_amdgcn_s_setprio(0); } while (0)
#define PG8_WAIT_V(n) asm volatile("s_waitcnt vmcnt(" #n ")" ::: "memory")
#define PG8_WAIT_L(n) asm volatile("s_waitcnt lgkmcnt(" #n ")" ::: "memory")
#define PG8_BAR __builtin_amdgcn_s_barrier()
#define PG8_SCHED __builtin_amdgcn_sched_barrier(0)
    Unit cur, nxt; int ui = 0;
    if (!S.next(0, cur)) return;
    f32x4 acc[2][2][4][2];
#pragma unroll
    for (int a = 0; a < 2; ++a)
#pragma unroll
        for (int b = 0; b < 2; ++b)
#pragma unroll
            for (int m = 0; m < 4; ++m)
#pragma unroll
                for (int n = 0; n < 2; ++n) acc[a][b][m][n] = (f32x4){0.f, 0.f, 0.f, 0.f};
    bf16x8 At[4][2], B0[2][2], B1[2][2];
    const char* cA = (const char*)g.A + (size_t)cur.pm * tstep; const char* cB = (const char*)g.Bt + (size_t)cur.pn * tstep;
    S.a_ready(cur);
    if constexpr (SP2) {
        PG8_STAGE(PG8_SB(0, 0), cB, voffB); PG8_STAGE(PG8_SB(0, 1), cB + hstep, voffB); PG8_STAGE(PG8_SA(0, 0), cA, voffA); PG8_STAGE(PG8_SA(0, 1), cA + hstep, voffA);
        if (wr == 1) PG8_BAR;
        PG8_WAIT_V(2); PG8_BAR;
        PG8_STAGE(PG8_SB(1, 0), cB + kstep, voffB); PG8_STAGE(PG8_SA(1, 0), cA + kstep, voffA); PG8_STAGE(PG8_SB(1, 1), cB + hstep + kstep, voffB);
        PG8_WAIT_V(6); PG8_BAR;
    } else {
        PG8_STAGE(PG8_SB(0, 0), cB, voffB); PG8_STAGE(PG8_SA(0, 0), cA, voffA); PG8_STAGE(PG8_SB(0, 1), cB + hstep, voffB); PG8_STAGE(PG8_SA(0, 1), cA + hstep, voffA);
        if (wr == 1) PG8_BAR;
        PG8_WAIT_V(4); PG8_BAR;
        PG8_STAGE(PG8_SB(1, 0), cB + kstep, voffB); PG8_STAGE(PG8_SA(1, 0), cA + kstep, voffA); PG8_STAGE(PG8_SB(1, 1), cB + hstep + kstep, voffB);
        PG8_WAIT_V(6); PG8_BAR;
    }
    for (;;) {
        const bool has_next = S.next(ui + 1, nxt);
        const char* nA = has_next ? (const char*)g.A + (size_t)nxt.pm * tstep : cA; const char* nB = has_next ? (const char*)g.Bt + (size_t)nxt.pn * tstep : cB;
        for (int t = 0; t < nt; t += 2) {
            const bool last = (t == nt - 2);
            const char* a1 = cA + (size_t)(t + 1) * kstep;
            const char* a2 = last ? nA : cA + (size_t)(t + 2) * kstep; const char* b2 = last ? nB : cB + (size_t)(t + 2) * kstep;
            const char* a3 = a2 + kstep; const char* b3 = b2 + kstep;
            if (last && has_next) S.a_ready(nxt);
            if constexpr (SP2) {
            PG8_LDB(B0, 0, 0); PG8_LDB(B1, 0, 1); PG8_SCHED; PG8_LDA(At, 0, 0); PG8_STAGE(PG8_SA(1, 1), a1 + hstep, voffA);
            PG8_WAIT_V(8); PG8_WAIT_L(0); PG8_BAR; PG8_MMA(0, 0, At, B0); PG8_MMA(0, 1, At, B1); PG8_BAR; PG8_SCHED;
            PG8_LDA(At, 0, 1); PG8_STAGE(PG8_SB(0, 0), b2, voffB); PG8_STAGE(PG8_SB(0, 1), b2 + hstep, voffB); PG8_STAGE(PG8_SA(0, 0), a2, voffA);
            PG8_WAIT_V(8); PG8_WAIT_L(0); PG8_BAR; PG8_MMA(1, 0, At, B0); PG8_MMA(1, 1, At, B1); PG8_BAR; PG8_SCHED;
            PG8_LDB(B0, 1, 0); PG8_LDB(B1, 1, 1); PG8_SCHED; PG8_LDA(At, 1, 0); PG8_STAGE(PG8_SA(0, 1), a2 + hstep, voffA);
            PG8_WAIT_V(8); PG8_WAIT_L(0); PG8_BAR; PG8_MMA(0, 0, At, B0); PG8_MMA(0, 1, At, B1); PG8_BAR; PG8_SCHED;
            PG8_LDA(At, 1, 1); PG8_STAGE(PG8_SB(1, 0), b3, voffB); PG8_STAGE(PG8_SB(1, 1), b3 + hstep, voffB); PG8_STAGE(PG8_SA(1, 0), a3, voffA);
            PG8_WAIT_V(8); PG8_WAIT_L(0); PG8_BAR; PG8_MMA(1, 0, At, B0); PG8_MMA(1, 1, At, B1); PG8_BAR; PG8_SCHED;
            } else {
            PG8_LDB(B0, 0, 0); PG8_SCHED; PG8_LDA(At, 0, 0); PG8_STAGE(PG8_SA(1, 1), a1 + hstep, voffA);
            PG8_WAIT_L(8); PG8_BAR; PG8_WAIT_L(0); PG8_MMA(0, 0, At, B0); PG8_BAR; PG8_SCHED;
            PG8_LDB(B1, 0, 1); PG8_STAGE(PG8_SB(0, 0), b2, voffB);
            PG8_BAR; PG8_WAIT_L(0); PG8_MMA(0, 1, At, B1); PG8_BAR;
            PG8_LDA(At, 0, 1); PG8_STAGE(PG8_SA(0, 0), a2, voffA);
            PG8_BAR; PG8_WAIT_L(0); PG8_MMA(1, 0, At, B0); PG8_BAR; PG8_SCHED;
            PG8_STAGE(PG8_SB(0, 1), b2 + hstep, voffB);
            PG8_WAIT_V(6); PG8_BAR; PG8_MMA(1, 1, At, B1); PG8_BAR;
            PG8_LDB(B0, 1, 0); PG8_SCHED; PG8_LDA(At, 1, 0); PG8_STAGE(PG8_SA(0, 1), a2 + hstep, voffA);
            PG8_WAIT_L(8); PG8_BAR; PG8_WAIT_L(0); PG8_MMA(0, 0, At, B0); PG8_BAR; PG8_SCHED;
            PG8_LDB(B1, 1, 1); PG8_STAGE(PG8_SB(1, 0), b3, voffB);
            PG8_BAR; PG8_WAIT_L(0); PG8_MMA(0, 1, At, B1); PG8_BAR;
            PG8_LDA(At, 1, 1); PG8_STAGE(PG8_SA(1, 0), a3, voffA);
            PG8_BAR; PG8_WAIT_L(0); PG8_MMA(1, 0, At, B0); PG8_BAR; PG8_SCHED;
            PG8_STAGE(PG8_SB(1, 1), b3 + hstep, voffB);
            PG8_WAIT_V(6); PG8_BAR; PG8_MMA(1, 1, At, B1); PG8_BAR;
            }
        }
        if constexpr (ALIGN_EPI) { if (wr == 0) PG8_BAR; }
        if constexpr (!Epi::AFTER_DRAIN) { E(acc, cur, wr, wc, fr, fq); S.done(cur); }
        if (!has_next) break;
#pragma unroll
        for (int a = 0; a < 2; ++a)
#pragma unroll
            for (int b = 0; b < 2; ++b)
#pragma unroll
                for (int m = 0; m < 4; ++m)
#pragma unroll
                    for (int n = 0; n < 2; ++n) acc[a][b][m][n] = (f32x4){0.f, 0.f, 0.f, 0.f};
        cur = nxt; cA = nA; cB = nB; ++ui;
        if constexpr (ALIGN_EPI) { if (wr == 1) PG8_BAR; }
    }
    PG8_WAIT_V(0);
    if constexpr (!ALIGN_EPI) { if (wr == 0) PG8_BAR; }
    PG8_BAR;
    if constexpr (Epi::AFTER_DRAIN) { E.fused(acc, cur, wr, wc, fr, fq, lds, wid, lane); S.done(cur); }
#undef PG8_SA
#undef PG8_SB
#undef PG8_STAGE
#undef PG8_LDA
#undef PG8_LDB
#undef PG8_MMA
#undef PG8_WAIT_V
#undef PG8_WAIT_L
#undef PG8_BAR
#undef PG8_SCHED
}
}
#define GAS __attribute__((address_space(1)))
#define LAS __attribute__((address_space(3)))
typedef unsigned short bf16;
typedef unsigned v4u __attribute__((ext_vector_type(4)));
typedef float f32x4 __attribute__((ext_vector_type(4)));
typedef short bf16x8 __attribute__((ext_vector_type(8)));
typedef GAS unsigned gu32;
typedef GAS unsigned long long gu64;
#define RLX_AGENT __ATOMIC_RELAXED, __HIP_MEMORY_SCOPE_AGENT
#define LDS_WAIT() asm volatile("s_waitcnt lgkmcnt(0)" ::: "memory")
#define VM_WAIT() asm volatile("s_waitcnt vmcnt(0)" ::: "memory")
__device__ __forceinline__ unsigned long long rt() { return __builtin_amdgcn_s_memrealtime(); }
__device__ __forceinline__ unsigned f2bf(float f) { unsigned u = __builtin_bit_cast(unsigned, f); return (u + 0x7fffu + ((u >> 16) & 1u)) >> 16; }
__device__ __forceinline__ unsigned pk2(float lo, float hi) { return f2bf(lo) | (f2bf(hi) << 16); }
#define XB_TMO      128
#define XB_XCNT(j)  (256  + 64 * (j))
#define XB_XSUB(j)  (1280 + 64 * (j))
#define XB_XGEN(j)  (2304 + 64 * (j))
#define XB_TOP      3328
#define XB_TOPGEN   3392
#define XCD_BAR_WORDS 3456
#define XB_SPIN_CAP (1u << 18)

__device__ __forceinline__ unsigned xb_ld(unsigned* p)              { return __hip_atomic_load(p, __ATOMIC_RELAXED, __HIP_MEMORY_SCOPE_AGENT); }
__device__ __forceinline__ unsigned xb_add(unsigned* p, unsigned v) { return __hip_atomic_fetch_add(p, v, __ATOMIC_RELAXED, __HIP_MEMORY_SCOPE_AGENT); }
__device__ __forceinline__ unsigned xb_xcc_id() { return (unsigned)__builtin_amdgcn_s_getreg((3 << 11) | 20) & 0xFu; }
#define XB_SPIN(cond, bar) do { unsigned _sp = 0; while (cond) { __builtin_amdgcn_s_sleep(1); \
    if ((++_sp & 255u) == 0u) { if (xb_ld(&(bar)[XB_TMO])) break; if (_sp > XB_SPIN_CAP) { atomicAdd(&(bar)[XB_TMO], 1u); break; } } } } while (0)

struct XcdBarrier {
    unsigned* bar; unsigned x;
    volatile LAS unsigned* st;
};

__device__ __forceinline__ XcdBarrier xcd_barrier_post(unsigned* bar, volatile LAS unsigned* st) {
    XcdBarrier b; b.bar = bar; b.x = xb_xcc_id(); b.st = st;
    if (threadIdx.x == 0) (void)xb_add(&bar[XB_XCNT(b.x)], 1u);
    return b;
}
__device__ __forceinline__ void xcd_barrier_complete(unsigned* bar, unsigned x, unsigned& nloc, unsigned& nx) {
    const unsigned G = gridDim.x * gridDim.y * gridDim.z;
    unsigned sum, cnt, mine, sp = 0u;
    for (;;) {
        sum = 0u; cnt = 0u; mine = 0u;
#pragma unroll
        for (unsigned j = 0; j < 16; ++j) { const unsigned c = xb_ld(&bar[XB_XCNT(j)]); sum += c; cnt += (c > 0u) ? 1u : 0u; mine = (j == x) ? c : mine; }
        if (sum == G) break;
        __builtin_amdgcn_s_sleep(1);
        if ((++sp & 255u) == 0u) { if (xb_ld(&bar[XB_TMO])) break; if (sp > XB_SPIN_CAP) { atomicAdd(&bar[XB_TMO], 1u); break; } }
    }
    nloc = mine > 0u ? mine : 1u; nx = cnt > 0u ? cnt : 1u;
}

__device__ __forceinline__ void xcd_barrier(const XcdBarrier& b) {
    asm volatile("s_waitcnt vmcnt(0)" ::: "memory");
    __syncthreads();
    if (threadIdx.x == 0) {
        unsigned* bar = b.bar;
        __builtin_amdgcn_s_waitcnt(0);
        unsigned nloc = b.st[0], nx = b.st[1];
        if (nloc == 0u) { xcd_barrier_complete(bar, b.x, nloc, nx); b.st[0] = nloc; b.st[1] = nx; }
        const unsigned old = xb_add(&bar[XB_XSUB(b.x)], 1u);
        const unsigned gen = old / nloc;
        if (old + 1u == (gen + 1u) * nloc) {
            __builtin_amdgcn_fence(__ATOMIC_RELEASE, "agent");
            asm volatile("s_waitcnt vmcnt(0)" ::: "memory");
            const unsigned og = xb_add(&bar[XB_TOP], 1u);
            const unsigned tg = og / nx;
            if (og + 1u == (tg + 1u) * nx) xb_add(&bar[XB_TOPGEN], 1u);
            else XB_SPIN(xb_ld(&bar[XB_TOPGEN]) == tg, bar);
            __builtin_amdgcn_fence(__ATOMIC_ACQUIRE, "agent");
            xb_add(&bar[XB_XGEN(b.x)], 1u);
            asm volatile("s_waitcnt vmcnt(0)" ::: "memory");
        } else {
            XB_SPIN(xb_ld(&bar[XB_XGEN(b.x)]) == gen, bar);
            __builtin_amdgcn_fence(__ATOMIC_ACQUIRE, "agent");
            asm volatile("s_waitcnt vmcnt(0)" ::: "memory");
        }
    }
    __syncthreads();
}
constexpr int NB = 8, SEQ = 4096, DM = 1024, NL = 4, NTOK = NB * SEQ;
constexpr int INW = 1824, INP = 2048;
constexpr int C_AQ = 0, C_AK = 512, C_AV = 640, C_GQ = 768, C_GK = 896, C_GV = 1024, C_GR = 1280, C_FX = 1536, C_GLR = 1792;
constexpr int NE = 32, TOPK = 4, DE = 1024;
constexpr int MPAD = NTOK * TOPK + NE * 256;
constexpr float LN_EPS = 1e-5f, RMS_EPS = 1e-6f;
constexpr float DN_ALPHA = 1.681792830507429f;
constexpr float QSCALE = 0.125f * 1.4426950408889634f;
constexpr float GLA_QSCALE = 0.17677669529663687f;

constexpr size_t MiB = 1u << 20;
constexpr size_t WS_CTL = 0, CTL_ZERO_BYTES = 1 * MiB;
constexpr size_t WS_ROPE = 1 * MiB;
constexpr size_t WS_WIN_T = 2 * MiB;
constexpr size_t WS_WOUT_T = 18 * MiB;
constexpr size_t WS_ADFT = 26 * MiB;
constexpr size_t WS_WGU_T = 90 * MiB;
constexpr size_t WS_WDN_T = 602 * MiB;
constexpr size_t WS_HF = 858 * MiB;
constexpr size_t WS_HB = 986 * MiB;
constexpr size_t WS_PROJ = 1050 * MiB;
constexpr size_t WS_QB = 1178 * MiB;
constexpr size_t WS_KB = 1210 * MiB;
constexpr size_t WS_MIX = 1218 * MiB;
constexpr size_t WS_T1 = 1282 * MiB;
constexpr size_t WS_UVT = 1410 * MiB;
constexpr size_t WS_LA = 1442 * MiB;
constexpr size_t WS_OF = 1474 * MiB;
constexpr size_t WS_OB = 1506 * MiB;
constexpr size_t WS_TOK = 1538 * MiB;
constexpr size_t WS_XS = 1542 * MiB;
constexpr size_t WS_HID = 1814 * MiB;
constexpr size_t WS_YS = 2086 * MiB;
constexpr size_t WS_END = 2358 * MiB;
static_assert((size_t)MPAD * 2048 == 272 * MiB, "sorted buffers");
constexpr int CW_TMO = 0, CW_CODE = 1, CW_BAR = 4096, CW_CNT = 8192;

constexpr int RING_OFF = 0, RING_BYTES = 131072;
constexpr int LDSCTL_OFF = RING_BYTES;
constexpr int LDS_BYTES = 147456;
constexpr int LC_MISC = 0;
constexpr int LC_PSTART = 128;
constexpr int LC_ULIST = 384;
constexpr int LC_CNT = 640;
constexpr int LC_BASE = 768;
constexpr int LC_SELE = 1024;
constexpr int LC_SELS = 1024 + 2048;
constexpr int LC_COS64 = 5120;

constexpr int NWAVES = 8;
constexpr int N_PHASES = 1 + 10 * NL;

__device__ __forceinline__ float bf2f(unsigned short b) { return __uint_as_float((unsigned)b << 16); }
__device__ __forceinline__ float wave_sum(float v) {
#pragma unroll
    for (int o = 1; o < 64; o <<= 1) v += __shfl_xor(v, o);
    return v;
}
typedef unsigned short u16x8 __attribute__((ext_vector_type(8)));
typedef unsigned short u16x4 __attribute__((ext_vector_type(4)));

__device__ __forceinline__ void tr_item(const float* W, int K, int Nsrc, int src_n0, bf16* WT, int dst_n0, int k0, LAS float* scr, int lane) {
    if (src_n0 >= 0) {
#pragma unroll 8
        for (int i = 0; i < 32; ++i) { const int kk = 2 * i + (lane >> 5); scr[kk * 33 + (lane & 31)] = W[(size_t)(k0 + kk) * Nsrc + src_n0 + (lane & 31)]; }
    } else {
#pragma unroll 8
        for (int i = 0; i < 32; ++i) { const int kk = 2 * i + (lane >> 5); scr[kk * 33 + (lane & 31)] = 0.f; }
    }
    LDS_WAIT(); asm volatile("" ::: "memory");
    const int c = lane & 7;
#pragma unroll
    for (int j = 0; j < 4; ++j) { const int n = (lane >> 3) + 8 * j; const LAS float* s = scr + (8 * c) * 33 + n;
        v4u o; o.x = pk2(s[0 * 33], s[1 * 33]); o.y = pk2(s[2 * 33], s[3 * 33]); o.z = pk2(s[4 * 33], s[5 * 33]); o.w = pk2(s[6 * 33], s[7 * 33]);
        *(v4u*)(WT + (size_t)(dst_n0 + n) * K + k0 + 8 * c) = o; }
    LDS_WAIT(); asm volatile("" ::: "memory");
}

__device__ __forceinline__ void ln_row(f32x4 (&v)[4], const float* g, const float* bt, float* of32, bf16* obf, int lane) {
    float s = 0.f;
#pragma unroll
    for (int j = 0; j < 4; ++j) s += (v[j].x + v[j].y) + (v[j].z + v[j].w);
    const float mean = wave_sum(s) * (1.f / DM); float s2 = 0.f;
#pragma unroll
    for (int j = 0; j < 4; ++j) { v[j] = v[j] - mean; s2 += (v[j].x * v[j].x + v[j].y * v[j].y) + (v[j].z * v[j].z + v[j].w * v[j].w); }
    const float rstd = 1.f / sqrtf(wave_sum(s2) * (1.f / DM) + LN_EPS);
#pragma unroll
    for (int j = 0; j < 4; ++j) { const f32x4 gg = *(const f32x4*)(g + lane * 4 + 256 * j), bb = *(const f32x4*)(bt + lane * 4 + 256 * j);
        v[j] = v[j] * rstd * gg + bb;
        if (of32) *(f32x4*)(of32 + lane * 4 + 256 * j) = v[j];
        if (obf) *(unsigned long long*)(obf + lane * 4 + 256 * j) = (unsigned long long)pk2(v[j].x, v[j].y) | ((unsigned long long)pk2(v[j].z, v[j].w) << 32); }
}

struct Args { const float* in[20]; float* out; unsigned char* ws; int ph_lo, ph_hi; };
static_assert(sizeof(Args) == 20 * 8 + 8 + 8 + 8, "no padding bytes in Args");


typedef __attribute__((address_space(4))) const unsigned char* kptr_t;
__device__ __forceinline__ kptr_t karg() { kptr_t p = (kptr_t)__builtin_amdgcn_kernarg_segment_ptr(); asm volatile("" : "+s"(p)); return p; }
#define KIN(i) (*(const float* const __attribute__((address_space(4)))*)(karg() + 8 * (i)))
#define KOUT() (*(float* const __attribute__((address_space(4)))*)(karg() + 160))
#define KWS() (*(unsigned char* const __attribute__((address_space(4)))*)(karg() + 168))
#define WSP(T, off) ((T*)(ws + (off)))

#ifndef NAIVE_ATTN
#define NAIVE_ATTN 1
#endif

__global__ void __launch_bounds__(NWAVES * 64, 2) fwd(Args args) {
    extern __shared__ __attribute__((aligned(16))) unsigned char lds_raw[];
    LAS unsigned char* lds = (LAS unsigned char*)lds_raw;
    LAS unsigned char* lctl = lds + LDSCTL_OFF;
    const int G = gridDim.x, bx = blockIdx.x;
    const int NGW = G * NWAVES, NGT = G * NWAVES * 64;
#define TID_SETUP() int tid_ = threadIdx.x; asm volatile("" : "+v"(tid_)); const int tid = tid_, lane = tid & 63, wave = __builtin_amdgcn_readfirstlane(tid >> 6); \
    const int gw = bx * NWAVES + wave, gt = bx * (NWAVES * 64) + tid; (void)lane; (void)gw; (void)gt
    for (int u = threadIdx.x; u < (LDS_BYTES - LDSCTL_OFF) / 4; u += NWAVES * 64) ((LAS unsigned*)lctl)[u] = 0u;
    __syncthreads();
    volatile LAS unsigned* MISC = (volatile LAS unsigned*)(lctl + LC_MISC);
    XcdBarrier bar = xcd_barrier_post((unsigned*)(KWS() + WS_CTL) + CW_BAR, MISC + 8);
    const int lo = args.ph_lo, hi = args.ph_hi;
#ifndef PH_OFF
#define PH_OFF 0
#endif
#define PON(j) (!((PH_OFF >> (j)) & 1))
#define IN(k) (lo <= (k) && (k) < hi)
#define SEAM(k) do { if (IN(k) && IN((k) + 1)) xcd_barrier(bar); } while (0)

    if (IN(0) && PON(0)) {
        TID_SETUP(); unsigned char* ws = KWS(); const float* x_in = KIN(0); const float* ln_in_g = KIN(1); const float* ln_in_b = KIN(2); const float* w_in = KIN(3); const float* w_out = KIN(9);
        const float* exp_w_gu = KIN(14); const float* exp_w_down = KIN(16);
        float* ROPE = WSP(float, WS_ROPE); bf16* WIN_T = WSP(bf16, WS_WIN_T); bf16* WOUT_T = WSP(bf16, WS_WOUT_T); bf16* ADFT = WSP(bf16, WS_ADFT); bf16* WGU_T = WSP(bf16, WS_WGU_T); bf16* WDN_T = WSP(bf16, WS_WDN_T);
        float* HF = WSP(float, WS_HF); bf16* HB = WSP(bf16, WS_HB);
        LAS float* scr = (LAS float*)(lds + RING_OFF + wave * 16384);
        constexpr int I_WIN = NL * 64 * 16, I_WOUT = NL * 32 * 16, I_WGU = NL * NE * 64 * 16, I_WDN = NL * NE * 32 * 16;
        constexpr int NITEMS = I_WIN + I_WOUT + I_WGU + I_WDN;
        for (int it = gw; it < NITEMS; it += NGW) {
            int r = it;
            if (r < I_WIN) { const int l = r / 1024, q = r % 1024, kb = q / 64, nb = q % 64, n0 = nb * 32;
                const int src = n0 < 1536 ? n0 : (n0 < 1792 ? n0 + 32 : (n0 < 1824 ? n0 - 256 : -1));
                tr_item(w_in + (size_t)l * DM * INW, DM, INW, src, WIN_T + (size_t)l * INP * DM, n0, kb * 64, scr, lane); continue; }
            r -= I_WIN;
            if (r < I_WOUT) { const int l = r / 512, q = r % 512, kb = q / 32, nb = q % 32;
                tr_item(w_out + (size_t)l * DM * DM, DM, DM, nb * 32, WOUT_T + (size_t)l * DM * DM, nb * 32, kb * 64, scr, lane); continue; }
            r -= I_WOUT;
            if (r < I_WGU) { const int le = r / 1024, q = r % 1024, kb = q / 64, nb = q % 64, n0 = nb * 32;
                const int pn = n0 >> 8, bj = (n0 >> 7) & 1, j = n0 & 127, src = bj * 1024 + pn * 128 + j;
                tr_item(exp_w_gu + (size_t)le * DM * 2048, DM, 2048, src, WGU_T + (size_t)le * 2048 * DM, n0, kb * 64, scr, lane); continue; }
            r -= I_WGU;
            { const int le = r / 512, q = r % 512, kb = q / 32, nb = q % 32;
                tr_item(exp_w_down + (size_t)le * DE * DM, DE, DM, nb * 32, WDN_T + (size_t)le * DM * DE, nb * 32, kb * 64, scr, lane); }
        }
        for (int it = gt; it < 4096 * 1024; it += NGT) { const int sp = it >> 10, c8 = (it & 1023) * 8; const int half = c8 >> 12, s0 = c8 & 4095;
            float vals[8];
#pragma unroll
            for (int i = 0; i < 8; ++i) { const int m = ((s0 + i) * sp) & 4095; float sn, cs; sincospif((float)m * (1.0f / 2048.0f), &sn, &cs); vals[i] = (half ? -sn : cs) * (1.0f / 512.0f); }
            v4u o; o.x = pk2(vals[0], vals[1]); o.y = pk2(vals[2], vals[3]); o.z = pk2(vals[4], vals[5]); o.w = pk2(vals[6], vals[7]);
            *(v4u*)(ADFT + (size_t)sp * 8192 + c8) = o; }
        for (int it = gt; it < SEQ * 32; it += NGT) { const int t = it >> 5, i = it & 31, a = i >> 4, f = i & 15; const int pos = a ? (t & 63) : (t >> 6);
            const double inv = exp(-9.210340371976184 * (double)f / 16.0); const double ang = (double)pos * inv;
            ROPE[it] = (float)cos(ang); ROPE[SEQ * 32 + it] = (float)sin(ang); }
        for (int m = gw; m < NTOK; m += NGW) { f32x4 v[4];
#pragma unroll
            for (int j = 0; j < 4; ++j) v[j] = *(const f32x4*)(x_in + (size_t)m * DM + lane * 4 + 256 * j);
            ln_row(v, ln_in_g, ln_in_b, HF + (size_t)m * DM, HB + (size_t)m * DM, lane); }
    }
    SEAM(0);

    for (int l = 0; l < NL; ++l) {
        const int pb = 1 + 10 * l;
        if (IN(pb + 0) && PON(1)) {
            TID_SETUP(); unsigned char* ws = KWS(); bf16* HB = WSP(bf16, WS_HB); bf16* WIN_T = WSP(bf16, WS_WIN_T); bf16* PROJ = WSP(bf16, WS_PROJ);
            pg8::Gemm g{HB, WIN_T + (size_t)l * INP * DM, NTOK, INP, DM}; pg8::StaticOrder S; S.init(NTOK, INP, G, bx);
            pg8::EpiPlainBf16 E{PROJ, INP};
            pg8::gemm_phase<pg8::EpiPlainBf16, pg8::StaticOrder, true, true>(lds + RING_OFF, g, S, E);
        }
        SEAM(pb + 0);
        if (IN(pb + 1) && PON(2)) {
            TID_SETUP(); unsigned char* ws = KWS(); const float* att_q_gain = KIN(4); const float* att_k_gain = KIN(5); const float* gla_gate_w = KIN(6); const float* gla_gate_b = KIN(7);
            const float* ROPE = WSP(float, WS_ROPE); const bf16* PROJ = WSP(bf16, WS_PROJ); bf16* QB = WSP(bf16, WS_QB); bf16* KB = WSP(bf16, WS_KB); bf16* UVT = WSP(bf16, WS_UVT); float* LA = WSP(float, WS_LA);
            const float* qg = att_q_gain + l * 64; const float* kg = att_k_gain + l * 64;
            for (int m = gw; m < NTOK; m += NGW) { const int t = m & (SEQ - 1); const int ri = (lane >> 5) * 16 + (lane & 15);
                const float cs = ROPE[t * 32 + ri], sn = ROPE[SEQ * 32 + t * 32 + ri]; const float sg = ((lane >> 4) & 1) ? 1.f : -1.f;
#pragma unroll
                for (int h = 0; h < 10; ++h) { const float xv = bf2f(PROJ[(size_t)m * INP + h * 64 + lane]);
                    const float ms = wave_sum(xv * xv) * (1.f / 64.f); const float xn = xv * (1.f / sqrtf(ms + RMS_EPS)) * (h < 8 ? qg[lane] : kg[lane]);
                    const float pr = __shfl_xor(xn, 16); float o = xn * cs + sg * pr * sn;
                    if (h < 8) { o *= QSCALE; QB[(size_t)m * 512 + h * 64 + lane] = (bf16)f2bf(o); } else KB[(size_t)m * 128 + (h - 8) * 64 + lane] = (bf16)f2bf(o); } }
            { const float* gw_l = gla_gate_w + (size_t)l * 2 * 16 * 128; const float* gb_l = gla_gate_b + (size_t)l * 2 * 128;
              for (int m = gw; m < NTOK; m += NGW) { const float lr = (lane < 32) ? bf2f(PROJ[(size_t)m * INP + C_GLR + lane]) : 0.f;
                const int dir = lane >> 5, kc = (lane & 31) * 4; f32x4 z = *(const f32x4*)(gb_l + dir * 128 + kc);
#pragma unroll
                for (int r = 0; r < 16; ++r) { const float a = __shfl(lr, dir * 16 + r); const f32x4 w = *(const f32x4*)(gw_l + (size_t)(dir * 16 + r) * 128 + kc); z = z + w * a; }
                f32x4 o;
#pragma unroll
                for (int i = 0; i < 4; ++i) o[i] = (fminf(z[i], 0.f) - log1pf(expf(-fabsf(z[i])))) * (1.f / 16.f);
                *(f32x4*)(LA + (size_t)m * 256 + dir * 128 + kc) = o; } }
            { LAS float* c64 = (LAS float*)(lctl + LC_COS64);
              if (tid < 64) { float sn, cs; sincospif((float)tid * (1.0f / 32.0f), &sn, &cs); c64[tid] = cs; c64[64 + tid] = sn; }
              __syncthreads();
              for (int it = gt; it < NB * 256 * SEQ; it += NGT) { const int s = it & (SEQ - 1), bc = it >> 12, b = bc >> 8, ch = bc & 255, g4 = ch >> 6, cc = ch & 63;
                const bf16* src = PROJ + (size_t)(b * SEQ + s) * INP + C_FX + g4 * 64; float U = 0.f, V = 0.f;
#pragma unroll
                for (int c8 = 0; c8 < 8; ++c8) { const u16x8 f = *(const u16x8*)(src + c8 * 8);
#pragma unroll
                    for (int i = 0; i < 8; ++i) { const int k = ((c8 * 8 + i) * cc) & 63; const float fv = bf2f(f[i]); U += fv * c64[k]; V += fv * c64[64 + k]; } }
                UVT[(size_t)bc * 8192 + s] = (bf16)f2bf(U); UVT[(size_t)bc * 8192 + 4096 + s] = (bf16)f2bf(V); } }
        }
        SEAM(pb + 1);
        if (IN(pb + 2) && PON(3)) {
            TID_SETUP(); unsigned char* ws = KWS(); const bf16* PROJ = WSP(bf16, WS_PROJ); const float* LA = WSP(float, WS_LA); float* OF = WSP(float, WS_OF); float* OB = WSP(float, WS_OB);
            for (int job = bx; job < NB * 4 * 2; job += G) { const int dir = job & 1, hd = (job >> 1) & 3, b = job >> 3;
                const int vl = lane & 7, dg = lane >> 3; const int vcol = hd * 64 + wave * 8 + vl;
                float s0 = 0.f, s1 = 0.f, s2 = 0.f, s3 = 0.f; float* OUT = dir ? OB : OF;
                for (int t8 = 0; t8 < SEQ; t8 += 8) {
                    u16x4 q4[8], k4[8]; f32x4 a4[8]; float vv[8];
#pragma unroll
                    for (int i = 0; i < 8; ++i) { const int t = dir ? (SEQ - 1 - (t8 + i)) : (t8 + i); const size_t m = (size_t)b * SEQ + t;
                        q4[i] = *(const u16x4*)(PROJ + m * INP + C_GQ + hd * 32 + dg * 4); k4[i] = *(const u16x4*)(PROJ + m * INP + C_GK + hd * 32 + dg * 4);
                        a4[i] = *(const f32x4*)(LA + m * 256 + dir * 128 + hd * 32 + dg * 4); vv[i] = bf2f(PROJ[m * INP + C_GV + vcol]); }
#pragma unroll
                    for (int i = 0; i < 8; ++i) { const int t = dir ? (SEQ - 1 - (t8 + i)) : (t8 + i); const size_t m = (size_t)b * SEQ + t;
                        const float e0 = expf(a4[i][0]), e1 = expf(a4[i][1]), e2 = expf(a4[i][2]), e3 = expf(a4[i][3]);
                        const float q0 = bf2f(q4[i][0]), q1 = bf2f(q4[i][1]), q2 = bf2f(q4[i][2]), q3 = bf2f(q4[i][3]);
                        const float k0 = bf2f(k4[i][0]), k1 = bf2f(k4[i][1]), k2 = bf2f(k4[i][2]), k3 = bf2f(k4[i][3]);
                        float part;
                        if (dir == 0) { s0 = s0 * e0 + k0 * vv[i]; s1 = s1 * e1 + k1 * vv[i]; s2 = s2 * e2 + k2 * vv[i]; s3 = s3 * e3 + k3 * vv[i]; part = (q0 * s0 + q1 * s1) + (q2 * s2 + q3 * s3); }
                        else { s0 *= e0; s1 *= e1; s2 *= e2; s3 *= e3; part = (q0 * s0 + q1 * s1) + (q2 * s2 + q3 * s3); s0 += k0 * vv[i]; s1 += k1 * vv[i]; s2 += k2 * vv[i]; s3 += k3 * vv[i]; }
                        part += __shfl_xor(part, 8); part += __shfl_xor(part, 16); part += __shfl_xor(part, 32);
                        if (dg == 0) OUT[m * 256 + vcol] = part * GLA_QSCALE; }
                }
            }
        }
        SEAM(pb + 2);
        if (IN(pb + 3) && PON(4)) {
            TID_SETUP(); unsigned char* ws = KWS(); const float* gla_norm_g = KIN(8); const bf16* PROJ = WSP(bf16, WS_PROJ); const float* OF = WSP(float, WS_OF); const float* OB = WSP(float, WS_OB);
            bf16* MIX = WSP(bf16, WS_MIX); const bf16* ADFT = WSP(bf16, WS_ADFT); const bf16* UVT = WSP(bf16, WS_UVT); const bf16* QB = WSP(bf16, WS_QB); const bf16* KB = WSP(bf16, WS_KB);
            { pg8::Gemm g{ADFT, UVT, SEQ, NB * 256, 8192}; pg8::StaticOrder S; S.init(SEQ, NB * 256, G, bx);
              pg8::EpiFnet E{MIX};
              pg8::gemm_phase<pg8::EpiFnet, pg8::StaticOrder, true, true>(lds + RING_OFF, g, S, E); }
            __syncthreads();
            for (int it = gw; it < NTOK * 4; it += NGW) { const int m = it >> 2, hd = it & 3; const size_t o = (size_t)m * 256 + hd * 64 + lane;
                const float v = OF[o] + OB[o]; const float ms = wave_sum(v * v) * (1.f / 64.f);
                const float r = bf2f(PROJ[(size_t)m * INP + C_GR + hd * 64 + lane]); const float sil = r / (1.f + expf(-r));
                MIX[(size_t)m * DM + 512 + hd * 64 + lane] = (bf16)f2bf(v * (1.f / sqrtf(ms + RMS_EPS)) * gla_norm_g[l * 64 + lane] * sil); }
#if NAIVE_ATTN
            { LAS float* Kt = (LAS float*)(lds + RING_OFF); LAS float* Vt = Kt + 64 * 64;
              for (int unit = bx; unit < NB * 8 * 8; unit += G) { const int rb = unit & 7, h = (unit >> 3) & 7, b = unit >> 6, kvh = h >> 2;
                const size_t qrow = (size_t)b * SEQ + rb * 512 + tid;
                float q[64], o[64]; float mrun = -INFINITY, lrun = 0.f;
#pragma unroll
                for (int c8 = 0; c8 < 8; ++c8) { const u16x8 f = *(const u16x8*)(QB + qrow * 512 + h * 64 + c8 * 8);
#pragma unroll
                    for (int i = 0; i < 8; ++i) { q[c8 * 8 + i] = bf2f(f[i]); o[c8 * 8 + i] = 0.f; } }
                for (int kt = 0; kt < SEQ; kt += 64) {
                    __syncthreads();
                    { const int kr = tid >> 3, c8 = (tid & 7) * 8; const size_t krow = (size_t)b * SEQ + kt + kr;
                      const u16x8 kf = *(const u16x8*)(KB + krow * 128 + kvh * 64 + c8); const u16x8 vf = *(const u16x8*)(PROJ + krow * INP + C_AV + kvh * 64 + c8);
#pragma unroll
                      for (int i = 0; i < 8; ++i) { Kt[kr * 64 + c8 + i] = bf2f(kf[i]); Vt[kr * 64 + c8 + i] = bf2f(vf[i]); } }
                    __syncthreads();
#pragma unroll 1
                    for (int j = 0; j < 64; ++j) { float a = 0.f;
#pragma unroll
                        for (int d4 = 0; d4 < 16; ++d4) { const f32x4 kv = *(const LAS f32x4*)(Kt + j * 64 + d4 * 4); a += (q[d4 * 4] * kv.x + q[d4 * 4 + 1] * kv.y) + (q[d4 * 4 + 2] * kv.z + q[d4 * 4 + 3] * kv.w); }
                        if (a > mrun) { const float al = exp2f(mrun - a); mrun = a; lrun *= al;
#pragma unroll
                            for (int d = 0; d < 64; ++d) o[d] *= al; }
                        const float p = exp2f(a - mrun); lrun += p;
#pragma unroll
                        for (int d4 = 0; d4 < 16; ++d4) { const f32x4 vv = *(const LAS f32x4*)(Vt + j * 64 + d4 * 4); o[d4 * 4] += p * vv.x; o[d4 * 4 + 1] += p * vv.y; o[d4 * 4 + 2] += p * vv.z; o[d4 * 4 + 3] += p * vv.w; } }
                }
                const float rl = 1.f / lrun;
#pragma unroll
                for (int c8 = 0; c8 < 8; ++c8) { v4u w; w.x = pk2(o[c8 * 8] * rl, o[c8 * 8 + 1] * rl); w.y = pk2(o[c8 * 8 + 2] * rl, o[c8 * 8 + 3] * rl); w.z = pk2(o[c8 * 8 + 4] * rl, o[c8 * 8 + 5] * rl); w.w = pk2(o[c8 * 8 + 6] * rl, o[c8 * 8 + 7] * rl);
                    *(v4u*)(MIX + qrow * DM + h * 64 + c8 * 8) = w; }
              }
              __syncthreads(); }
#endif
        }
        SEAM(pb + 3);
        if (IN(pb + 4) && PON(5)) {
            TID_SETUP(); unsigned char* ws = KWS(); const bf16* MIX = WSP(bf16, WS_MIX); const bf16* WOUT_T = WSP(bf16, WS_WOUT_T); const float* HF = WSP(float, WS_HF); float* T1 = WSP(float, WS_T1);
            pg8::Gemm g{MIX, WOUT_T + (size_t)l * DM * DM, NTOK, DM, DM}; pg8::StaticOrder S; S.init(NTOK, DM, G, bx);
            pg8::EpiResF32 E{HF, T1, DM, DN_ALPHA};
            pg8::gemm_phase<pg8::EpiResF32, pg8::StaticOrder, true, true>(lds + RING_OFF, g, S, E);
        }
        SEAM(pb + 4);
        if (IN(pb + 5) && PON(6)) {
            TID_SETUP(); unsigned char* ws = KWS(); gu32* ctl = (gu32*)(ws + WS_CTL); const float* ln1_g = KIN(10); const float* ln1_b = KIN(11); const float* router_w = KIN(12); const float* router_b = KIN(13);
            const float* T1 = WSP(float, WS_T1); float* HF = WSP(float, WS_HF); bf16* HB = WSP(bf16, WS_HB); int* TOKE = WSP(int, WS_TOK); int* TOKS = TOKE + NTOK * 4; float* TOKW = (float*)(TOKS + NTOK * 4);
            LAS float* RW = (LAS float*)(lds + RING_OFF);
            { const float* rw = router_w + (size_t)l * DM * NE; for (int i = tid; i < DM * NE; i += NWAVES * 64) { const int c = i >> 5, e = i & 31; RW[e * DM + c] = rw[i]; } }
            LAS int* lcnt = (LAS int*)(lctl + LC_CNT); LAS int* lbase = (LAS int*)(lctl + LC_BASE); LAS int* sele = (LAS int*)(lctl + LC_SELE); LAS int* sels = (LAS int*)(lctl + LC_SELS);
            const float* rb = router_b + l * NE;
            for (int r0 = bx * 128; r0 < NTOK; r0 += G * 128) {
                if (tid < 32) lcnt[tid] = 0;
                __syncthreads();
                for (int rr = 0; rr < 16; ++rr) { const int lr = wave * 16 + rr; const size_t m = (size_t)r0 + lr; f32x4 v[4];
#pragma unroll
                    for (int j = 0; j < 4; ++j) v[j] = *(const f32x4*)(T1 + m * DM + lane * 4 + 256 * j);
                    ln_row(v, ln1_g + l * DM, ln1_b + l * DM, HF + m * DM, HB + m * DM, lane);
                    float lg[32];
#pragma unroll
                    for (int e = 0; e < 32; ++e) { float a = 0.f;
#pragma unroll
                        for (int j = 0; j < 4; ++j) { const f32x4 w = *(const LAS f32x4*)(RW + e * DM + lane * 4 + 256 * j); a += (v[j].x * w.x + v[j].y * w.y) + (v[j].z * w.z + v[j].w * w.w); }
                        lg[e] = wave_sum(a) + rb[e]; }
                    int se[4]; float sv[4];
#pragma unroll
                    for (int k = 0; k < 4; ++k) { float best = -INFINITY; int bi = 0;
#pragma unroll
                        for (int e = 0; e < 32; ++e) { if (lg[e] > best) { best = lg[e]; bi = e; } }
                        se[k] = bi; sv[k] = best;
#pragma unroll
                        for (int e = 0; e < 32; ++e) if (e == bi) lg[e] = -INFINITY; }
                    const float e1 = expf(sv[1] - sv[0]), e2 = expf(sv[2] - sv[0]), e3 = expf(sv[3] - sv[0]); const float inv = 1.f / (1.f + e1 + e2 + e3);
                    if (lane == 0) { const float wts[4] = {inv, e1 * inv, e2 * inv, e3 * inv};
#pragma unroll
                        for (int k = 0; k < 4; ++k) { const int ls = __hip_atomic_fetch_add(lcnt + se[k], 1, __ATOMIC_RELAXED, __HIP_MEMORY_SCOPE_WORKGROUP); sele[lr * 4 + k] = se[k]; sels[lr * 4 + k] = ls; TOKW[m * 4 + k] = wts[k]; } }
                }
                __syncthreads();
                if (tid < 32) lbase[tid] = (int)__hip_atomic_fetch_add(ctl + CW_CNT + l * 32 + tid, (unsigned)lcnt[tid], RLX_AGENT);
                __syncthreads();
                { const int e = sele[tid]; TOKE[(size_t)r0 * 4 + tid] = e; TOKS[(size_t)r0 * 4 + tid] = lbase[e] + sels[tid]; }
                __syncthreads();
            }
        }
        SEAM(pb + 5);
        if (IN(pb + 6) || IN(pb + 7) || IN(pb + 8)) {
            LAS int* pst = (LAS int*)(lctl + LC_PSTART); gu32* ctl = (gu32*)(KWS() + WS_CTL);
            __syncthreads();
            if (threadIdx.x == 0) { int acc = 0; for (int e = 0; e < NE; ++e) { pst[e] = acc; const int c = (int)__hip_atomic_load(ctl + CW_CNT + l * 32 + e, RLX_AGENT); acc += (c + 255) >> 8; } pst[NE] = acc; }
            __syncthreads();
        }
        if (IN(pb + 6) && PON(7)) {
            TID_SETUP(); unsigned char* ws = KWS(); const int* TOKE = WSP(int, WS_TOK); const int* TOKS = TOKE + NTOK * 4; int* TOKP = (int*)(TOKE + 3 * NTOK * 4); const bf16* HB = WSP(bf16, WS_HB); bf16* XS = WSP(bf16, WS_XS);
            const LAS int* pst = (const LAS int*)(lctl + LC_PSTART);
            for (int it = gw; it < NTOK * 4; it += NGW) { const int m = it >> 2; const int e = TOKE[it], sl = TOKS[it]; const int dst = pst[e] * 256 + sl;
                if (lane == 0) TOKP[it] = dst;
                const v4u* src = (const v4u*)(HB + (size_t)m * DM); v4u* d = (v4u*)(XS + (size_t)dst * DM);
                d[lane] = src[lane]; d[lane + 64] = src[lane + 64]; }
        }
        SEAM(pb + 6);
        if (IN(pb + 7) && PON(8)) {
            TID_SETUP(); unsigned char* ws = KWS(); const float* exp_b_gu = KIN(15); const bf16* XS = WSP(bf16, WS_XS); const bf16* WGU_T = WSP(bf16, WS_WGU_T); bf16* HID = WSP(bf16, WS_HID);
            const LAS int* pst = (const LAS int*)(lctl + LC_PSTART); LAS int* ul = (LAS int*)(lctl + LC_ULIST);
            const int nM = pst[NE], nN = 8, nwg = nM * nN;
            if (tid < 64) { const long L = (long)tid * G + bx; int v = -1;
                if (L < nwg) { int wgid = (int)L; { const int q = nwg / 8, r = nwg % 8, xcd = wgid % 8, off = wgid / 8; wgid = (xcd < r ? xcd * (q + 1) : r * (q + 1) + (xcd - r) * q) + off; }
                    const int nig = 8 * nN, gid = wgid / nig, fm = gid * 8, gsz = (nM - fm) < 8 ? (nM - fm) : 8; const int pm = fm + ((wgid % nig) % gsz), pn = (wgid % nig) / gsz;
                    int e = 0; for (int k = 1; k < NE; ++k) if (pst[k] <= pm) e = k;
                    v = (pm << 16) | (e * nN + pn); }
                ul[tid] = v; }
            __syncthreads();
            const int nunits = bx < nwg ? (nwg - bx + G - 1) / G : 0;
            pg8::Gemm g{XS, WGU_T + (size_t)l * NE * 2048 * DM, MPAD, NE * 2048, DM}; pg8::ListOrder S{ul, nunits};
            pg8::EpiSwiglu E{HID, exp_b_gu + (size_t)l * NE * 2048};
            pg8::gemm_phase<pg8::EpiSwiglu, pg8::ListOrder, true, true>(lds + RING_OFF, g, S, E);
        }
        SEAM(pb + 7);
        if (IN(pb + 8) && PON(9)) {
            TID_SETUP(); unsigned char* ws = KWS(); const float* exp_b_down = KIN(17); const bf16* HID = WSP(bf16, WS_HID); const bf16* WDN_T = WSP(bf16, WS_WDN_T); bf16* YS = WSP(bf16, WS_YS);
            const LAS int* pst = (const LAS int*)(lctl + LC_PSTART); LAS int* ul = (LAS int*)(lctl + LC_ULIST);
            const int nM = pst[NE], nN = 4, nwg = nM * nN;
            __syncthreads();
            if (tid < 64) { const long L = (long)tid * G + bx; int v = -1;
                if (L < nwg) { int wgid = (int)L; { const int q = nwg / 8, r = nwg % 8, xcd = wgid % 8, off = wgid / 8; wgid = (xcd < r ? xcd * (q + 1) : r * (q + 1) + (xcd - r) * q) + off; }
                    const int nig = 8 * nN, gid = wgid / nig, fm = gid * 8, gsz = (nM - fm) < 8 ? (nM - fm) : 8; const int pm = fm + ((wgid % nig) % gsz), pn = (wgid % nig) / gsz;
                    int e = 0; for (int k = 1; k < NE; ++k) if (pst[k] <= pm) e = k;
                    v = (pm << 16) | (e * nN + pn); }
                ul[tid] = v; }
            __syncthreads();
            const int nunits = bx < nwg ? (nwg - bx + G - 1) / G : 0;
            pg8::Gemm g{HID, WDN_T + (size_t)l * NE * DM * DE, MPAD, NE * DM, DE}; pg8::ListOrder S{ul, nunits};
            pg8::EpiDown E{YS, exp_b_down + (size_t)l * NE * DM};
            pg8::gemm_phase<pg8::EpiDown, pg8::ListOrder, true, true>(lds + RING_OFF, g, S, E);
        }
        SEAM(pb + 8);
        if (IN(pb + 9) && PON(10)) {
            TID_SETUP(); unsigned char* ws = KWS(); const float* ln2_g = KIN(18); const float* ln2_b = KIN(19); float* out = KOUT(); float* HF = WSP(float, WS_HF); bf16* HB = WSP(bf16, WS_HB);
            const bf16* YS = WSP(bf16, WS_YS); const float* TOKW = (const float*)(WSP(int, WS_TOK) + 2 * NTOK * 4); const int* TOKP = WSP(int, WS_TOK) + 3 * NTOK * 4;
            const bool lastl = (l == NL - 1);
            for (int m = gw; m < NTOK; m += NGW) { f32x4 v[4];
#pragma unroll
                for (int j = 0; j < 4; ++j) v[j] = *(const f32x4*)(HF + (size_t)m * DM + lane * 4 + 256 * j) * DN_ALPHA;
#pragma unroll
                for (int k = 0; k < 4; ++k) { const float w = TOKW[m * 4 + k]; const bf16* yr = YS + (size_t)TOKP[m * 4 + k] * DM;
#pragma unroll
                    for (int j = 0; j < 4; ++j) { const u16x4 y = *(const u16x4*)(yr + lane * 4 + 256 * j); v[j].x += w * bf2f(y[0]); v[j].y += w * bf2f(y[1]); v[j].z += w * bf2f(y[2]); v[j].w += w * bf2f(y[3]); } }
                ln_row(v, ln2_g + l * DM, ln2_b + l * DM, lastl ? out + (size_t)m * DM : HF + (size_t)m * DM, lastl ? nullptr : HB + (size_t)m * DM, lane); }
        }
        SEAM(pb + 9);
    }
#undef IN
#undef SEAM
}

#ifndef MK_PER_PHASE
#define MK_PER_PHASE 0
#endif
extern "C" void kernel_launch(void* const* d_in, const int* in_sizes, int n_in, void* d_out, int out_size, void* d_ws, size_t ws_size, hipStream_t stream) {
    static int grid = 0;
    if (grid == 0) {
        if (n_in != 20 || in_sizes[0] != NTOK * DM || out_size != NTOK * DM || ws_size < WS_END) { fprintf(stderr, "kernel_launch: unexpected shapes (n_in %d, in0 %d, out %d, ws %zu); nothing launched\n", n_in, n_in > 0 ? in_sizes[0] : -1, out_size, ws_size); grid = -1; return; }
        int dev = 0, cus = 0, per_cu = 0;
        if (hipGetDevice(&dev) != hipSuccess || hipDeviceGetAttribute(&cus, hipDeviceAttributeMultiprocessorCount, dev) != hipSuccess) { grid = -1; return; }
        if (hipFuncSetAttribute((const void*)fwd, hipFuncAttributeMaxDynamicSharedMemorySize, LDS_BYTES) != hipSuccess) { fprintf(stderr, "kernel_launch: hipFuncSetAttribute failed\n"); grid = -1; return; }
        if (hipOccupancyMaxActiveBlocksPerMultiprocessor(&per_cu, (const void*)fwd, NWAVES * 64, LDS_BYTES) != hipSuccess || per_cu < 1) fprintf(stderr, "kernel_launch: occupancy query reports %d\n", per_cu);
        (void)hipGetLastError();
        grid = cus;
    }
    if (grid < 0) return;
    if (hipMemsetAsync((char*)d_ws + WS_CTL, 0, CTL_ZERO_BYTES, stream) != hipSuccess) return;
    Args a{};
    for (int i = 0; i < 20; ++i) a.in[i] = (const float*)d_in[i];
    a.out = (float*)d_out; a.ws = (unsigned char*)d_ws;
#if MK_PER_PHASE
    for (int p = 0; p < N_PHASES; ++p) { a.ph_lo = p; a.ph_hi = p + 1; hipLaunchKernelGGL(fwd, dim3(grid), dim3(NWAVES * 64), LDS_BYTES, stream, a); }
#else
    a.ph_lo = 0; a.ph_hi = N_PHASES;
    hipLaunchKernelGGL(fwd, dim3(grid), dim3(NWAVES * 64), LDS_BYTES, stream, a);
#endif
    const hipError_t le = hipPeekAtLastError();
    if (le != hipSuccess) fprintf(stderr, "kernel_launch: launch failed: %s\n", hipGetErrorName(le));
}
```

```cpp
#include <hip/hip_runtime.h>
#include <hip/hip_bf16.h>
#include <cstdio>
#include <cstdint>
#include <cmath>
namespace pg8 {
#define PG8_LAS __attribute__((address_space(3)))
typedef unsigned short bf16_t;
typedef short bf16x8 __attribute__((ext_vector_type(8)));
typedef float f32x4 __attribute__((ext_vector_type(4)));
typedef unsigned u32x4 __attribute__((ext_vector_type(4)));
constexpr int BM = 256, BK = 64, HALF = 128, HTB = HALF * BK * 2  , STAGE_BYTES = 8 * HTB, NXCD = 8, WGM = 8;

__host__ __device__ __forceinline__ int lds_byte(int r, int c) { const int st = (r >> 4) * 2 + (c >> 5), rr = r & 15, cc = c & 31, ob = rr * 64 + cc * 2; return st * 1024 + (ob ^ (((ob >> 9) & 1) << 5)); }
__host__ __device__ __forceinline__ void stage_rc(int b, int& R, int& C) { const int st = b / 1024, sb = b % 1024, swz = sb ^ (((sb >> 9) & 1) << 5); R = (st >> 1) * 16 + swz / 64; C = (st & 1) * 32 + (swz % 64) / 2; }
__host__ __device__ __forceinline__ int perm32(int rho) { const int n = rho >> 4, i = rho & 15; return 8 * (i >> 2) + 4 * n + (i & 3); }

struct Unit { int pm, pn; };
struct Gemm { const bf16_t* A; const bf16_t* Bt; int M, N, K; };

struct StaticOrder {
    int nM, nN, nwg, G, c;
    __host__ __device__ void init(int M, int N, int G_, int c_) { nM = M / BM; nN = N / BM; nwg = nM * nN; G = G_; c = c_; }
    __host__ __device__ bool next(int i, Unit& u) const {
        const long L = (long)i * G + c; if (L >= nwg) return false;
        int wgid = (int)L; { const int q = nwg / NXCD, r = nwg % NXCD, xcd = wgid % NXCD, off = wgid / NXCD; wgid = (xcd < r ? xcd * (q + 1) : r * (q + 1) + (xcd - r) * q) + off; }
        const int nig = WGM * nN, gid = wgid / nig, fm = gid * WGM, gsz = (nM - fm) < WGM ? (nM - fm) : WGM;
        u.pm = fm + ((wgid % nig) % gsz); u.pn = (wgid % nig) / gsz; return true;
    }
    __device__ __forceinline__ void a_ready(const Unit&) const {}
    __device__ __forceinline__ void done(const Unit&) const {}
};

__device__ __forceinline__ unsigned cvt_pk_bf16(float lo, float hi) { unsigned r; asm volatile("v_cvt_pk_bf16_f32 %0, %1, %2" : "=v"(r) : "v"(lo), "v"(hi)); return r; }
typedef float f32x2 __attribute__((ext_vector_type(2)));
__device__ __forceinline__ u32x4 pack8(const f32x4 v0, const f32x4 v1) { u32x4 w; w.x = cvt_pk_bf16(v0[0], v0[1]); w.y = cvt_pk_bf16(v0[2], v0[3]); w.z = cvt_pk_bf16(v1[0], v1[1]); w.w = cvt_pk_bf16(v1[2], v1[3]); return w; }

struct EpiPlainBf16 {
    static constexpr bool PERM = true, AFTER_DRAIN = false;
    bf16_t* O; int ldc;
    __device__ __forceinline__ void operator()(const f32x4 (&acc)[2][2][4][2], const Unit& u, int wr, int wc, int fr, int fq) const {
        const int row0 = u.pm * BM + wr * 64 + fr, col0 = u.pn * BM + wc * 32 + 8 * fq;
#pragma unroll
        for (int ai = 0; ai < 2; ++ai)
#pragma unroll
            for (int m = 0; m < 4; ++m) { bf16_t* rowp = O + (size_t)(row0 + ai * HALF + m * 16) * ldc + col0;
#pragma unroll
                for (int bj = 0; bj < 2; ++bj) *(u32x4*)(rowp + bj * HALF) = pack8(acc[ai][bj][m][0], acc[ai][bj][m][1]); }
    }
};
struct EpiFnet {
    static constexpr bool PERM = true, AFTER_DRAIN = false;
    bf16_t* MIX;
    __device__ __forceinline__ void operator()(const f32x4 (&acc)[2][2][4][2], const Unit& u, int wr, int wc, int fr, int fq) const {
        const int row0 = u.pn * 4096 + u.pm * BM + wr * 64 + fr, col0 = 768 + wc * 32 + 8 * fq;
#pragma unroll
        for (int ai = 0; ai < 2; ++ai)
#pragma unroll
            for (int m = 0; m < 4; ++m) { bf16_t* rowp = MIX + (size_t)(row0 + ai * HALF + m * 16) * 1024 + col0;
#pragma unroll
                for (int bj = 0; bj < 2; ++bj) *(u32x4*)(rowp + bj * HALF) = pack8(acc[ai][bj][m][0], acc[ai][bj][m][1]); }
    }
};
struct EpiResF32 {
    static constexpr bool PERM = false, AFTER_DRAIN = false;
    const float* base; float* out; int ldc; float alpha;
    __device__ __forceinline__ void operator()(const f32x4 (&acc)[2][2][4][2], const Unit& u, int wr, int wc, int fr, int fq) const {
        const int row0 = u.pm * BM + wr * 64 + fr, col0 = u.pn * BM + wc * 32 + 4 * fq;
#pragma unroll
        for (int ai = 0; ai < 2; ++ai)
#pragma unroll
            for (int m = 0; m < 4; ++m) { const size_t off = (size_t)(row0 + ai * HALF + m * 16) * ldc + col0;
#pragma unroll
                for (int bj = 0; bj < 2; ++bj)
#pragma unroll
                    for (int n = 0; n < 2; ++n) { const f32x4 b = *(const f32x4*)(base + off + bj * HALF + n * 16); *(f32x4*)(out + off + bj * HALF + n * 16) = b * alpha + acc[ai][bj][m][n]; } }
    }
};
__device__ __forceinline__ float swiglu1(float g, float u) { g = fminf(g, 7.0f); u = fminf(fmaxf(u, -7.0f), 7.0f); return (u + 1.0f) * g * __builtin_amdgcn_rcpf(1.0f + __expf(-1.702f * g)); }
struct EpiSwiglu {
    static constexpr bool PERM = true, AFTER_DRAIN = false;
    bf16_t* HID; const float* bgu;
    __device__ __forceinline__ void operator()(const f32x4 (&acc)[2][2][4][2], const Unit& u, int wr, int wc, int fr, int fq) const {
        const int e = u.pn >> 3, pnl = u.pn & 7; const int row0 = u.pm * BM + wr * 64 + fr, jj0 = pnl * 128 + wc * 32 + 8 * fq;
        const float* bg = bgu + (size_t)e * 2048 + jj0;
        const f32x4 bg0 = *(const f32x4*)bg, bg1 = *(const f32x4*)(bg + 4), bu0 = *(const f32x4*)(bg + 1024), bu1 = *(const f32x4*)(bg + 1028);
#pragma unroll
        for (int ai = 0; ai < 2; ++ai)
#pragma unroll
            for (int m = 0; m < 4; ++m) { bf16_t* rowp = HID + (size_t)(row0 + ai * HALF + m * 16) * 1024 + jj0;
                const f32x4 g0 = acc[ai][0][m][0] + bg0, g1 = acc[ai][0][m][1] + bg1, u0 = acc[ai][1][m][0] + bu0, u1 = acc[ai][1][m][1] + bu1;
                f32x4 h0, h1;
#pragma unroll
                for (int i = 0; i < 4; ++i) { h0[i] = swiglu1(g0[i], u0[i]); h1[i] = swiglu1(g1[i], u1[i]); }
                *(u32x4*)rowp = pack8(h0, h1); }
    }
};
struct EpiDown {
    static constexpr bool PERM = true, AFTER_DRAIN = false;
    bf16_t* Y; const float* bd;
    __device__ __forceinline__ void operator()(const f32x4 (&acc)[2][2][4][2], const Unit& u, int wr, int wc, int fr, int fq) const {
        const int e = u.pn >> 2, pnl = u.pn & 3; const int row0 = u.pm * BM + wr * 64 + fr, col0 = pnl * BM + wc * 32 + 8 * fq;
        const float* bp = bd + (size_t)e * 1024 + col0;
        f32x4 bv[2][2];
#pragma unroll
        for (int bj = 0; bj < 2; ++bj)
#pragma unroll
            for (int n = 0; n < 2; ++n) bv[bj][n] = *(const f32x4*)(bp + bj * HALF + 4 * n);
#pragma unroll
        for (int ai = 0; ai < 2; ++ai)
#pragma unroll
            for (int m = 0; m < 4; ++m) { bf16_t* rowp = Y + (size_t)(row0 + ai * HALF + m * 16) * 1024 + col0;
#pragma unroll
                for (int bj = 0; bj < 2; ++bj) *(u32x4*)(rowp + bj * HALF) = pack8(acc[ai][bj][m][0] + bv[bj][0], acc[ai][bj][m][1] + bv[bj][1]); }
    }
};
struct ListOrder {
    const PG8_LAS int* list; int n;
    __device__ __forceinline__ bool next(int i, Unit& u) const { if (i >= n) return false; const int v = __builtin_amdgcn_readfirstlane(list[i]); u.pm = v >> 16; u.pn = v & 0xffff; return true; }
    __device__ __forceinline__ void a_ready(const Unit&) const {}
    __device__ __forceinline__ void done(const Unit&) const {}
};
template <class Epi, class Sched, bool ALIGN_EPI = false, bool SP2 = false>
__device__ __forceinline__ void gemm_phase(PG8_LAS unsigned char* lds, const Gemm g, const Sched& S, const Epi& E) {
    int tid_ = threadIdx.x; asm volatile("" : "+v"(tid_));
    const int tid = tid_, wid = __builtin_amdgcn_readfirstlane(tid >> 6), lane = tid & 63, wr = wid >> 2, wc = wid & 3, fr = lane & 15, fq = lane >> 4;
    const int K = g.K, nt = K / BK;
    unsigned voffA[2], voffB[2];
#pragma unroll
    for (int i = 0; i < 2; ++i) { int R, C; stage_rc(tid * 16 + i * 8192, R, C); const int Rb = Epi::PERM ? ((R & ~31) + perm32(R & 31)) : R;
        voffA[i] = (unsigned)(R * K + C) * 2u; voffB[i] = (unsigned)(Rb * K + C) * 2u; }
    const size_t kstep = (size_t)(BK * 2);
    const size_t hstep = (size_t)HALF * K * 2;
    const size_t tstep = 2 * hstep;
    const unsigned ldsw = (unsigned)wid * 1024u;
    const int aoff = lds_byte(wr * 64 + fr, fq * 8), boff = lds_byte(wc * 32 + fr, fq * 8);
#define PG8_SA(b, h) (((b) * 2 + (h)) * HTB)
#define PG8_SB(b, h) ((4 + (b) * 2 + (h)) * HTB)
#define PG8_STAGE(bufoff, gbase, voff) do { _Pragma("unroll") for (int _i = 0; _i < 2; ++_i) \
        __builtin_amdgcn_global_load_lds((const unsigned*)((const char*)(gbase) + (voff)[_i]), (PG8_LAS unsigned*)(lds + (bufoff) + ldsw + _i * 8192), 16, 0, 0); } while (0)
#define PG8_LDA(dst, b, h) do { _Pragma("unroll") for (int m = 0; m < 4; ++m) _Pragma("unroll") for (int k = 0; k < 2; ++k) dst[m][k] = *(const PG8_LAS bf16x8*)(lds + PG8_SA(b, h) + aoff + m * 2048 + k * 1024); } while (0)
#define PG8_LDB(dst, b, h) do { _Pragma("unroll") for (int n = 0; n < 2; ++n) _Pragma("unroll") for (int k = 0; k < 2; ++k) dst[n][k] = *(const PG8_LAS bf16x8*)(lds + PG8_SB(b, h) + boff + n * 2048 + k * 1024); } while (0)
#define PG8_MMA(ai, bj, At, Bt) do { __builtin_amdgcn_s_setprio(1); _Pragma("unroll") for (int m = 0; m < 4; ++m) _Pragma("unroll") for (int n = 0; n < 2; ++n) _Pragma("unroll") for (int k = 0; k < 2; ++k) \
        acc[ai][bj][m][n] = __builtin_amdgcn_mfma_f32_16x16x32_bf16(Bt[n][k], At[m][k], acc[ai][bj][m][n], 0, 0, 0); __builtin_amdgcn_s_setprio(0); } while (0)
#define PG8_WAIT_V(n) asm volatile("s_waitcnt vmcnt(" #n ")" ::: "memory")
#define PG8_WAIT_L(n) asm volatile("s_waitcnt lgkmcnt(" #n ")" ::: "memory")
#define PG8_BAR __builtin_amdgcn_s_barrier()
#define PG8_SCHED __builtin_amdgcn_sched_barrier(0)
    Unit cur, nxt; int ui = 0;
    if (!S.next(0, cur)) return;
    f32x4 acc[2][2][4][2];
#pragma unroll
    for (int a = 0; a < 2; ++a)
#pragma unroll
        for (int b = 0; b < 2; ++b)
#pragma unroll
            for (int m = 0; m < 4; ++m)
#pragma unroll
                for (int n = 0; n < 2; ++n) acc[a][b][m][n] = (f32x4){0.f, 0.f, 0.f, 0.f};
    bf16x8 At[4][2], B0[2][2], B1[2][2];
    const char* cA = (const char*)g.A + (size_t)cur.pm * tstep; const char* cB = (const char*)g.Bt + (size_t)cur.pn * tstep;
    S.a_ready(cur);
    if constexpr (SP2) {
        PG8_STAGE(PG8_SB(0, 0), cB, voffB); PG8_STAGE(PG8_SB(0, 1), cB + hstep, voffB); PG8_STAGE(PG8_SA(0, 0), cA, voffA); PG8_STAGE(PG8_SA(0, 1), cA + hstep, voffA);
        if (wr == 1) PG8_BAR;
        PG8_WAIT_V(2); PG8_BAR;
        PG8_STAGE(PG8_SB(1, 0), cB + kstep, voffB); PG8_STAGE(PG8_SA(1, 0), cA + kstep, voffA); PG8_STAGE(PG8_SB(1, 1), cB + hstep + kstep, voffB);
        PG8_WAIT_V(6); PG8_BAR;
    } else {
        PG8_STAGE(PG8_SB(0, 0), cB, voffB); PG8_STAGE(PG8_SA(0, 0), cA, voffA); PG8_STAGE(PG8_SB(0, 1), cB + hstep, voffB); PG8_STAGE(PG8_SA(0, 1), cA + hstep, voffA);
        if (wr == 1) PG8_BAR;
        PG8_WAIT_V(4); PG8_BAR;
        PG8_STAGE(PG8_SB(1, 0), cB + kstep, voffB); PG8_STAGE(PG8_SA(1, 0), cA + kstep, voffA); PG8_STAGE(PG8_SB(1, 1), cB + hstep + kstep, voffB);
        PG8_WAIT_V(6); PG8_BAR;
    }
    for (;;) {
        const bool has_next = S.next(ui + 1, nxt);
        const char* nA = has_next ? (const char*)g.A + (size_t)nxt.pm * tstep : cA; const char* nB = has_next ? (const char*)g.Bt + (size_t)nxt.pn * tstep : cB;
        for (int t = 0; t < nt; t += 2) {
            const bool last = (t == nt - 2);
            const char* a1 = cA + (size_t)(t + 1) * kstep;
            const char* a2 = last ? nA : cA + (size_t)(t + 2) * kstep; const char* b2 = last ? nB : cB + (size_t)(t + 2) * kstep;
            const char* a3 = a2 + kstep; const char* b3 = b2 + kstep;
            if (last && has_next) S.a_ready(nxt);
            if constexpr (SP2) {
            PG8_LDB(B0, 0, 0); PG8_LDB(B1, 0, 1); PG8_SCHED; PG8_LDA(At, 0, 0); PG8_STAGE(PG8_SA(1, 1), a1 + hstep, voffA);
            PG8_WAIT_V(8); PG8_WAIT_L(0); PG8_BAR; PG8_MMA(0, 0, At, B0); PG8_MMA(0, 1, At, B1); PG8_BAR; PG8_SCHED;
            PG8_LDA(At, 0, 1); PG8_STAGE(PG8_SB(0, 0), b2, voffB); PG8_STAGE(PG8_SB(0, 1), b2 + hstep, voffB); PG8_STAGE(PG8_SA(0, 0), a2, voffA);
            PG8_WAIT_V(8); PG8_WAIT_L(0); PG8_BAR; PG8_MMA(1, 0, At, B0); PG8_MMA(1, 1, At, B1); PG8_BAR; PG8_SCHED;
            PG8_LDB(B0, 1, 0); PG8_LDB(B1, 1, 1); PG8_SCHED; PG8_LDA(At, 1, 0); PG8_STAGE(PG8_SA(0, 1), a2 + hstep, voffA);
            PG8_WAIT_V(8); PG8_WAIT_L(0); PG8_BAR; PG8_MMA(0, 0, At, B0); PG8_MMA(0, 1, At, B1); PG8_BAR; PG8_SCHED;
            PG8_LDA(At, 1, 1); PG8_STAGE(PG8_SB(1, 0), b3, voffB); PG8_STAGE(PG8_SB(1, 1), b3 + hstep, voffB); PG8_STAGE(PG8_SA(1, 0), a3, voffA);
            PG8_WAIT_V(8); PG8_WAIT_L(0); PG8_BAR; PG8_MMA(1, 0, At, B0); PG8_MMA(1, 1, At, B1); PG8_BAR; PG8_SCHED;
            } else {
            PG8_LDB(B0, 0, 0); PG8_SCHED; PG8_LDA(At, 0, 0); PG8_STAGE(PG8_SA(1, 1), a1 + hstep, voffA);
            PG8_WAIT_L(8); PG8_BAR; PG8_WAIT_L(0); PG8_MMA(0, 0, At, B0); PG8_BAR; PG8_SCHED;
            PG8_LDB(B1, 0, 1); PG8_STAGE(PG8_SB(0, 0), b2, voffB);
            PG8_BAR; PG8_WAIT_L(0); PG8_MMA(0, 1, At, B1); PG8_BAR;
            PG8_LDA(At, 0, 1); PG8_STAGE(PG8_SA(0, 0), a2, voffA);
            PG8_BAR; PG8_WAIT_L(0); PG8_MMA(1, 0, At, B0); PG8_BAR; PG8_SCHED;
            PG8_STAGE(PG8_SB(0, 1), b2 + hstep, voffB);
            PG8_WAIT_V(6); PG8_BAR; PG8_MMA(1, 1, At, B1); PG8_BAR;
            PG8_LDB(B0, 1, 0); PG8_SCHED; PG8_LDA(At, 1, 0); PG8_STAGE(PG8_SA(0, 1), a2 + hstep, voffA);
            PG8_WAIT_L(8); PG8_BAR; PG8_WAIT_L(0); PG8_MMA(0, 0, At, B0); PG8_BAR; PG8_SCHED;
            PG8_LDB(B1, 1, 1); PG8_STAGE(PG8_SB(1, 0), b3, voffB);
            PG8_BAR; PG8_WAIT_L(0); PG8_MMA(0, 1, At, B1); PG8_BAR;
            PG8_LDA(At, 1, 1); PG8_STAGE(PG8_SA(1, 0), a3, voffA);
            PG8_BAR; PG8_WAIT_L(0); PG8_MMA(1, 0, At, B0); PG8_BAR; PG8_SCHED;
            PG8_STAGE(PG8_SB(1, 1), b3 + hstep, voffB);
            PG8_WAIT_V(6); PG8_BAR; PG8_MMA(1, 1, At, B1); PG8_BAR;
            }
        }
        if constexpr (ALIGN_EPI) { if (wr == 0) PG8_BAR; }
        if constexpr (!Epi::AFTER_DRAIN) { E(acc, cur, wr, wc, fr, fq); S.done(cur); }
        if (!has_next) break;
#pragma unroll
        for (int a = 0; a < 2; ++a)
#pragma unroll
            for (int b = 0; b < 2; ++b)
#pragma unroll
                for (int m = 0; m < 4; ++m)
#pragma unroll
                    for (int n = 0; n < 2; ++n) acc[a][b][m][n] = (f32x4){0.f, 0.f, 0.f, 0.f};
        cur = nxt; cA = nA; cB = nB; ++ui;
        if constexpr (ALIGN_EPI) { if (wr == 1) PG8_BAR; }
    }
    PG8_WAIT_V(0);
    if constexpr (!ALIGN_EPI) { if (wr == 0) PG8_BAR; }
    PG8_BAR;
    if constexpr (Epi::AFTER_DRAIN) { E.fused(acc, cur, wr, wc, fr, fq, lds, wid, lane); S.done(cur); }
#undef PG8_SA
#undef PG8_SB
#undef PG8_STAGE
#undef PG8_LDA
#undef PG8_LDB
#undef PG8_MMA
#undef PG8_WAIT_V
#undef PG8_WAIT_L
#undef PG8_BAR
#undef PG8_SCHED
}
}
#define GAS __attribute__((address_space(1)))
#define LAS __attribute__((address_space(3)))
typedef unsigned short bf16;
typedef unsigned v4u __attribute__((ext_vector_type(4)));
typedef float f32x4 __attribute__((ext_vector_type(4)));
typedef short bf16x8 __attribute__((ext_vector_type(8)));
typedef GAS unsigned gu32;
typedef GAS unsigned long long gu64;
#define RLX_AGENT __ATOMIC_RELAXED, __HIP_MEMORY_SCOPE_AGENT
#define LDS_WAIT() asm volatile("s_waitcnt lgkmcnt(0)" ::: "memory")
#define VM_WAIT() asm volatile("s_waitcnt vmcnt(0)" ::: "memory")
__device__ __forceinline__ unsigned long long rt() { return __builtin_amdgcn_s_memrealtime(); }
__device__ __forceinline__ unsigned f2bf(float f) { unsigned u = __builtin_bit_cast(unsigned, f); return (u + 0x7fffu + ((u >> 16) & 1u)) >> 16; }
__device__ __forceinline__ unsigned pk2(float lo, float hi) { return f2bf(lo) | (f2bf(hi) << 16); }
#define XB_TMO      128
#define XB_XCNT(j)  (256  + 64 * (j))
#define XB_XSUB(j)  (1280 + 64 * (j))
#define XB_XGEN(j)  (2304 + 64 * (j))
#define XB_TOP      3328
#define XB_TOPGEN   3392
#define XCD_BAR_WORDS 3456
#define XB_SPIN_CAP (1u << 18)

__device__ __forceinline__ unsigned xb_ld(unsigned* p)              { return __hip_atomic_load(p, __ATOMIC_RELAXED, __HIP_MEMORY_SCOPE_AGENT); }
__device__ __forceinline__ unsigned xb_add(unsigned* p, unsigned v) { return __hip_atomic_fetch_add(p, v, __ATOMIC_RELAXED, __HIP_MEMORY_SCOPE_AGENT); }
__device__ __forceinline__ unsigned xb_xcc_id() { return (unsigned)__builtin_amdgcn_s_getreg((3 << 11) | 20) & 0xFu; }
#define XB_SPIN(cond, bar) do { unsigned _sp = 0; while (cond) { __builtin_amdgcn_s_sleep(1); \
    if ((++_sp & 255u) == 0u) { if (xb_ld(&(bar)[XB_TMO])) break; if (_sp > XB_SPIN_CAP) { atomicAdd(&(bar)[XB_TMO], 1u); break; } } } } while (0)

struct XcdBarrier {
    unsigned* bar; unsigned x;
    volatile LAS unsigned* st;
};

__device__ __forceinline__ XcdBarrier xcd_barrier_post(unsigned* bar, volatile LAS unsigned* st) {
    XcdBarrier b; b.bar = bar; b.x = xb_xcc_id(); b.st = st;
    if (threadIdx.x == 0) (void)xb_add(&bar[XB_XCNT(b.x)], 1u);
    return b;
}
__device__ __forceinline__ void xcd_barrier_complete(unsigned* bar, unsigned x, unsigned& nloc, unsigned& nx) {
    const unsigned G = gridDim.x * gridDim.y * gridDim.z;
    unsigned sum, cnt, mine, sp = 0u;
    for (;;) {
        sum = 0u; cnt = 0u; mine = 0u;
#pragma unroll
        for (unsigned j = 0; j < 16; ++j) { const unsigned c = xb_ld(&bar[XB_XCNT(j)]); sum += c; cnt += (c > 0u) ? 1u : 0u; mine = (j == x) ? c : mine; }
        if (sum == G) break;
        __builtin_amdgcn_s_sleep(1);
        if ((++sp & 255u) == 0u) { if (xb_ld(&bar[XB_TMO])) break; if (sp > XB_SPIN_CAP) { atomicAdd(&bar[XB_TMO], 1u); break; } }
    }
    nloc = mine > 0u ? mine : 1u; nx = cnt > 0u ? cnt : 1u;
}

__device__ __forceinline__ void xcd_barrier(const XcdBarrier& b) {
    asm volatile("s_waitcnt vmcnt(0)" ::: "memory");
    __syncthreads();
    if (threadIdx.x == 0) {
        unsigned* bar = b.bar;
        __builtin_amdgcn_s_waitcnt(0);
        unsigned nloc = b.st[0], nx = b.st[1];
        if (nloc == 0u) { xcd_barrier_complete(bar, b.x, nloc, nx); b.st[0] = nloc; b.st[1] = nx; }
        const unsigned old = xb_add(&bar[XB_XSUB(b.x)], 1u);
        const unsigned gen = old / nloc;
        if (old + 1u == (gen + 1u) * nloc) {
            __builtin_amdgcn_fence(__ATOMIC_RELEASE, "agent");
            asm volatile("s_waitcnt vmcnt(0)" ::: "memory");
            const unsigned og = xb_add(&bar[XB_TOP], 1u);
            const unsigned tg = og / nx;
            if (og + 1u == (tg + 1u) * nx) xb_add(&bar[XB_TOPGEN], 1u);
            else XB_SPIN(xb_ld(&bar[XB_TOPGEN]) == tg, bar);
            __builtin_amdgcn_fence(__ATOMIC_ACQUIRE, "agent");
            xb_add(&bar[XB_XGEN(b.x)], 1u);
            asm volatile("s_waitcnt vmcnt(0)" ::: "memory");
        } else {
            XB_SPIN(xb_ld(&bar[XB_XGEN(b.x)]) == gen, bar);
            __builtin_amdgcn_fence(__ATOMIC_ACQUIRE, "agent");
            asm volatile("s_waitcnt vmcnt(0)" ::: "memory");
        }
    }
    __syncthreads();
}
namespace attn_body {
using bf16=__hip_bfloat16;
using bf16x8=__attribute__((ext_vector_type(8)))short;
using s16x4=__attribute__((ext_vector_type(4)))short;
using f32x16=__attribute__((ext_vector_type(16)))float;
using u32x4=__attribute__((ext_vector_type(4)))unsigned;
constexpr int BATCH=8,NHEAD=8,NKVH=2,SEQ=4096,D=64;
constexpr int DMQ=512,DMK=128,DMV=2048,DMO=1024;
constexpr int NW=8,QBLK=32,QB=QBLK*NW,KVBLK=64,NQB=SEQ/QB;
constexpr int ATTN_UNIT_ROWS=QB;
__device__ __forceinline__ int crow(int r,int hi){return (r&3)+8*(r>>2)+4*hi;}
#define SBAR() __builtin_amdgcn_sched_barrier(0)
__device__ __forceinline__ void cmask(f32x16&p0,f32x16&p1,int jb,int qrel,int hi){
  const float NEG=-INFINITY; int kb=64*jb+4*hi;
  #pragma unroll
  for(int r=0;r<16;++r){int kv=kb+(r&3)+8*(r>>2); if(kv>qrel)p0[r]=NEG; if(kv+32>qrel)p1[r]=NEG;}
}

constexpr int NSLOT=3, SLOTB=8192;
constexpr int LDS_K=0, LDS_V=NSLOT*SLOTB, LDS_WS=2*NSLOT*SLOTB, LDS_OST=LDS_WS+NW*64*4, LDS_BYTES=LDS_OST+NW*4096;
constexpr float C2=0.125f*1.4426950408889634f;
__device__ __forceinline__ void glds16(const void*gsrc,unsigned lds_dst){unsigned keep;
  asm volatile("s_mov_b32 %0, m0\n\ts_mov_b32 m0, %2\n\ts_nop 0\n\tglobal_load_lds_dwordx4 %1, off\n\ts_mov_b32 m0, %0":"=&s"(keep):"v"(gsrc),"s"(lds_dst):"memory");}
__device__ __forceinline__ float max3f(float a,float b,float c){float r;asm("v_max3_f32 %0, %1, %2, %3":"=v"(r):"v"(a),"v"(b),"v"(c));return r;}
__device__ __forceinline__ float max2f(float a,float b){float r;asm("v_max_f32_e32 %0, %1, %2":"=v"(r):"v"(a),"v"(b));return r;}
__device__ __forceinline__ float fadd_s(float a,float b){float r;asm("v_add_f32_e32 %0, %1, %2":"=v"(r):"v"(a),"v"(b));return r;}
__device__ __forceinline__ float fsub_s(float a,float b){float r;asm("v_sub_f32_e32 %0, %1, %2":"=v"(r):"v"(a),"v"(b));return r;}
typedef float f32x2_t __attribute__((ext_vector_type(2))); typedef __bf16 bf16x2_t __attribute__((ext_vector_type(2)));
__device__ __forceinline__ unsigned cvtpk_s(float lo,float hi){f32x2_t v={lo,hi};bf16x2_t b=__builtin_convertvector(v,bf16x2_t);return __builtin_bit_cast(unsigned,b);}
#define WAIT_BAR(N) asm volatile("s_waitcnt vmcnt(" #N ") lgkmcnt(0)\n\ts_barrier":::"memory")

__device__ __forceinline__ void qkt(f32x16&p0,f32x16&p1,const char*Kslot,const bf16x8*qr,const f32x16&negm,int r32,int hi){
  const char*kb=Kslot+hi*1024+r32*16;
  #pragma unroll
  for(int d0=0;d0<4;++d0){
    const bf16x8 b0=*reinterpret_cast<const bf16x8*>(kb+d0*2048);
    const bf16x8 b1=*reinterpret_cast<const bf16x8*>(kb+d0*2048+512);
    if(d0==0){p0=__builtin_amdgcn_mfma_f32_32x32x16_bf16(b0,qr[0],negm,0,0,0);p1=__builtin_amdgcn_mfma_f32_32x32x16_bf16(b1,qr[0],negm,0,0,0);}
    else{p0=__builtin_amdgcn_mfma_f32_32x32x16_bf16(b0,qr[d0],p0,0,0,0);p1=__builtin_amdgcn_mfma_f32_32x32x16_bf16(b1,qr[d0],p1,0,0,0);}}
}
typedef __attribute__((address_space(3))) const char* lds_cptr;
typedef short v4i16_t __attribute__((ext_vector_type(4)));
__device__ __forceinline__ void kload8(bf16x8*kf,lds_cptr kp){
  kf[0]=*(const __attribute__((address_space(3))) bf16x8*)(kp);      kf[1]=*(const __attribute__((address_space(3))) bf16x8*)(kp+512);
  kf[2]=*(const __attribute__((address_space(3))) bf16x8*)(kp+2048); kf[3]=*(const __attribute__((address_space(3))) bf16x8*)(kp+2560);
  kf[4]=*(const __attribute__((address_space(3))) bf16x8*)(kp+4096); kf[5]=*(const __attribute__((address_space(3))) bf16x8*)(kp+4608);
  kf[6]=*(const __attribute__((address_space(3))) bf16x8*)(kp+6144); kf[7]=*(const __attribute__((address_space(3))) bf16x8*)(kp+6656);
}
__device__ __forceinline__ void kload2(bf16x8*kf,lds_cptr kp,int j){ kf[2*j]=*(const __attribute__((address_space(3))) bf16x8*)(kp+j*2048); kf[2*j+1]=*(const __attribute__((address_space(3))) bf16x8*)(kp+j*2048+512); }
__device__ __forceinline__ s16x4 vtr(lds_cptr p){ return __builtin_bit_cast(s16x4,__builtin_amdgcn_ds_read_tr16_b64_v4i16((__attribute__((address_space(3))) v4i16_t*)p)); }
__device__ __forceinline__ float rowmax(const f32x16&p0,const f32x16&p1){
  float a=max3f(p0[0],p0[1],p1[0]),b=max3f(p0[2],p0[3],p1[1]);a=max3f(a,p1[2],p1[3]);
  #pragma unroll
  for(int r=4;r<16;r+=4){a=max3f(a,p0[r],p0[r+1]);b=max3f(b,p0[r+2],p0[r+3]);a=max3f(a,p1[r],p1[r+1]);b=max3f(b,p1[r+2],p1[r+3]);}
  const float m=max2f(a,b);
  auto rr=__builtin_amdgcn_permlane32_swap(__float_as_uint(m),__float_as_uint(m),false,false);
  return max2f(__uint_as_float(rr[0]),__uint_as_float(rr[1]));
}
__device__ __forceinline__ void pv(f32x16*o,int vb,bf16x8 pa0,bf16x8 pa1,bf16x8 pa2,bf16x8 pa3){
  #pragma unroll
  for(int d0=0;d0<2;++d0){s16x4 lo[4],hi[4];
    #pragma unroll
    for(int ks=0;ks<4;++ks){
      asm volatile("ds_read_b64_tr_b16 %0,%1 offset:%c2":"=&v"(lo[ks]):"v"(vb),"i"(d0*4096+ks*1024):"memory");
      asm volatile("ds_read_b64_tr_b16 %0,%1 offset:%c2":"=&v"(hi[ks]):"v"(vb),"i"(d0*4096+ks*1024+512):"memory");}
    asm volatile("s_waitcnt lgkmcnt(0)":::"memory");SBAR();
    #define PK(k) (bf16x8){lo[k][0],lo[k][1],lo[k][2],lo[k][3],hi[k][0],hi[k][1],hi[k][2],hi[k][3]}
    o[d0]=__builtin_amdgcn_mfma_f32_32x32x16_bf16(pa0,PK(0),o[d0],0,0,0);
    o[d0]=__builtin_amdgcn_mfma_f32_32x32x16_bf16(pa1,PK(1),o[d0],0,0,0);
    o[d0]=__builtin_amdgcn_mfma_f32_32x32x16_bf16(pa2,PK(2),o[d0],0,0,0);
    o[d0]=__builtin_amdgcn_mfma_f32_32x32x16_bf16(pa3,PK(3),o[d0],0,0,0);
    #undef PK
  }
}

#ifndef ATTN_STORE16
#define ATTN_STORE16(p,v) (*(u32x4*)(p)=(v))
#endif
template<int THRL> __device__ __forceinline__ void attn_unit(int b,int h,int qb,const bf16*Q,const bf16*__restrict__ K,const bf16*__restrict__ V,bf16*O,char*shm){
  int tid_=threadIdx.x; asm volatile("":"+v"(tid_)); const int tid=tid_,lane=tid&63,r32=lane&31,hi=lane>>5; const int wid=__builtin_amdgcn_readfirstlane(tid>>6);
  const long rowbase=(long)b*SEQ; const int q0=qb*QB;
  const bf16*Qw=Q+(rowbase+q0+wid*QBLK)*DMQ+h*D; const int kvh=h>>2;
  const bf16*Kh=K+rowbase*DMK+kvh*D,*Vh=V+rowbase*DMV+kvh*D;
  const unsigned lds0=(unsigned)(uintptr_t)shm;
  float*wsf=(float*)(shm+LDS_WS)+wid*64;
  const bf16*ksrc=Kh+(long)lane*DMK+wid*8;
  const bf16*vsrc=Vh+(long)(16*(wid&3)+(lane>>2))*DMV+(wid>>2)*32+(lane&3)*8;
  const unsigned kdst=lds0+LDS_K+wid*1024, vdst=lds0+LDS_V+wid*1024;
  #define DMA_K(t,slot) glds16(ksrc+(long)(t)*KVBLK*DMK,(unsigned)__builtin_amdgcn_readfirstlane(kdst+(slot)))
  #define DMA_V(t,slot) glds16(vsrc+(long)(t)*KVBLK*DMV,(unsigned)__builtin_amdgcn_readfirstlane(vdst+(slot)))
  const int vb0=(int)(lds0+LDS_V)+((lane>>4)&1)*32+(lane&3)*8+(4*hi+((lane&15)>>2))*64;
  const char*Kbase=shm+LDS_K; bf16x8 kf[8];
  const lds_cptr shm3=(lds_cptr)shm; const lds_cptr kp0=shm3+LDS_K+hi*1024+r32*16; const lds_cptr vp0=shm3+LDS_V+((lane>>4)&1)*32+(lane&3)*8+(4*hi+((lane&15)>>2))*64;
  constexpr int NT=SEQ/KVBLK;
  DMA_K(0,0);DMA_V(0,0);DMA_K(1,SLOTB);
  bf16x8 qr[4];
  #pragma unroll
  for(int d0=0;d0<4;++d0)qr[d0]=*reinterpret_cast<const bf16x8*>(&Qw[(long)r32*DMQ+d0*16+hi*8]);
  float mhat=0.f,l_reg=0.f;f32x16 o[2];o[0]=f32x16{};o[1]=f32x16{};f32x16 negm=f32x16{};asm volatile("":"+v"(negm));
  #define CMASK(P0,P1,t) do{}while(0)
  bool resc=false;
  #define START(P0,P1) do{ const float rm=rowmax(P0,P1); resc=false; \
    { const float dl=rm; mhat=fadd_s(mhat,dl); \
      _Pragma("unroll") for(int r=0;r<16;++r){P0[r]=fsub_s(P0[r],dl);P1[r]=fsub_s(P1[r],dl);} \
      _Pragma("unroll") for(int r=0;r<16;++r)negm[r]=-mhat; asm volatile("":"+v"(negm)); } \
    _Pragma("unroll") for(int r=0;r<16;++r)P0[r]=__builtin_amdgcn_exp2f(P0[r]); }while(0)
  #define RESC() do{ if(resc){ asm volatile("s_waitcnt lgkmcnt(0)":::"memory"); \
      _Pragma("unroll") for(int d_=0;d_<2;++d_) _Pragma("unroll") for(int r=0;r<16;++r)o[d_][r]*=wsf[crow(r,hi)]; } }while(0)
  f32x16 pA0,pA1,pB0,pB1;
  int sl_prev=0,sl_cur=0,sl_next=SLOTB;
  #define ROT() do{sl_prev=sl_cur;sl_cur=sl_next;sl_next=(sl_next==(NSLOT-1)*SLOTB)?0:sl_next+SLOTB;}while(0)
  DMA_K(2,2*SLOTB);
  WAIT_BAR(3);
  qkt(pA0,pA1,Kbase,qr,negm,r32,hi);asm volatile("s_nop 15\n\ts_nop 7":"+v"(pA0),"+v"(pA1));CMASK(pA0,pA1,0);
  START(pA0,pA1);
  _Pragma("unroll") for(int r=0;r<16;++r)pA1[r]=__builtin_amdgcn_exp2f(pA1[r]);
  WAIT_BAR(0);
  DMA_K(3,0);DMA_V(1,SLOTB);
  ROT();
  kload8(kf,kp0+sl_cur);
  WAIT_BAR(2);
  s16x4 vlo[8],vhi[8]; u32x4 pw0,pw1,pw2,pw3;
  #define PKW(P,B) cvtpk_s(P[B],P[B+1])
  #define PAF(k) __builtin_bit_cast(bf16x8,pw##k)
  #define VFR(i) (bf16x8){vlo[i][0],vlo[i][1],vlo[i][2],vlo[i][3],vhi[i][0],vhi[i][1],vhi[i][2],vhi[i][3]}
  #define PIN(x) asm volatile("":"+v"(x))
  #define MX3(a,b,c) __builtin_fmaxf(__builtin_fmaxf((a),(b)),(c))
  #define GAPA(MF,A0,A1,A2,A3,W0,W1,PW) do{ MF; sacc+=A0; sacc+=A1; sacc+=A2; sacc+=A3; PIN(sacc); W0; W1; PIN(PW); SBAR(); }while(0)
  #define EX(v) __builtin_amdgcn_exp2f(v)
  #define GAPB(MF,X,B) do{ MF; X[B]=EX(X[B]); X[B+1]=EX(X[B+1]); X[B+2]=EX(X[B+2]); X[B+3]=EX(X[B+3]); PIN(X); SBAR(); }while(0)
  #define VRD(i) do{ vlo[i]=vtr(vp_+(((i)>>2)*4096+((i)&3)*1024)); vhi[i]=vtr(vp_+(((i)>>2)*4096+((i)&3)*1024+512)); }while(0)
  #define KRD(G,j) do{ if(G){ kload2(kf,kp0+sl_next,j); SBAR(); } }while(0)
  #define STEP(C0,C1,P0,P1,t,GK,GV,GL) do{ SBAR(); \
    const lds_cptr vp_=vp0+sl_prev; \
    VRD(0); SBAR(); float sacc=(P0[0]+P0[1]); \
    GAPA(C0=__builtin_amdgcn_mfma_f32_32x32x16_bf16(kf[0],qr[0],negm,0,0,0), P0[2],P0[3],P0[4],P0[5],     pw0[0]=PKW(P0,0), pw0[1]=PKW(P0,2), pw0); \
    VRD(4); SBAR(); GAPA(C1=__builtin_amdgcn_mfma_f32_32x32x16_bf16(kf[1],qr[0],negm,0,0,0), P0[6],P0[7],P0[8],P0[9],     pw0[2]=PKW(P0,4), pw0[3]=PKW(P0,6), pw0); \
    VRD(1); SBAR(); GAPA(C0=__builtin_amdgcn_mfma_f32_32x32x16_bf16(kf[2],qr[1],C0,0,0,0),   P0[10],P0[11],P0[12],P0[13], pw1[0]=PKW(P0,8), pw1[1]=PKW(P0,10), pw1); \
    VRD(5); SBAR(); GAPA(C1=__builtin_amdgcn_mfma_f32_32x32x16_bf16(kf[3],qr[1],C1,0,0,0),   P0[14],P0[15],P1[0],P1[1],   pw1[2]=PKW(P0,12),pw1[3]=PKW(P0,14), pw1); \
    VRD(2); SBAR(); GAPA(C0=__builtin_amdgcn_mfma_f32_32x32x16_bf16(kf[4],qr[2],C0,0,0,0),   P1[2],P1[3],P1[4],P1[5],     pw2[0]=PKW(P1,0), pw2[1]=PKW(P1,2), pw2); \
    VRD(6); SBAR(); GAPA(C1=__builtin_amdgcn_mfma_f32_32x32x16_bf16(kf[5],qr[2],C1,0,0,0),   P1[6],P1[7],P1[8],P1[9],     pw2[2]=PKW(P1,4), pw2[3]=PKW(P1,6), pw2); \
    VRD(3); SBAR(); GAPA(C0=__builtin_amdgcn_mfma_f32_32x32x16_bf16(kf[6],qr[3],C0,0,0,0),   P1[10],P1[11],P1[12],P1[13], pw3[0]=PKW(P1,8), pw3[1]=PKW(P1,10), pw3); \
    VRD(7); SBAR(); GAPA(C1=__builtin_amdgcn_mfma_f32_32x32x16_bf16(kf[7],qr[3],C1,0,0,0),   P1[14],P1[15],0.f,0.f,       pw3[2]=PKW(P1,12),pw3[3]=PKW(P1,14), pw3); \
    l_reg+=sacc; \
    if(GK){DMA_K((t)+3,sl_cur);} if(GV){DMA_V((t)+1,sl_next);} \
    CMASK(C0,C1,t); \
    { float a=MX3(C0[0],C0[1],C1[0]),b=MX3(C0[2],C0[3],C1[1]); a=MX3(a,C1[2],C1[3]); \
      _Pragma("unroll") for(int r=4;r<16;r+=4){a=MX3(a,C0[r],C0[r+1]);b=MX3(b,C0[r+2],C0[r+3]);a=MX3(a,C1[r],C1[r+1]);b=MX3(b,C1[r+2],C1[r+3]);} \
      float rm=__builtin_fmaxf(a,b); { auto rr=__builtin_amdgcn_permlane32_swap(__float_as_uint(rm),__float_as_uint(rm),false,false); rm=__builtin_fmaxf(__uint_as_float(rr[0]),__uint_as_float(rr[1])); } \
      resc=false; \
      if(__builtin_expect(__any(rm>(float)THRL),0)){ const float dl=__builtin_fmaxf(rm,0.f); mhat+=dl; \
        _Pragma("unroll") for(int r=0;r<16;++r){C0[r]-=dl;C1[r]-=dl;} \
        _Pragma("unroll") for(int r=0;r<16;++r)negm[r]=-mhat; asm volatile("":"+v"(negm)); \
        const float f=__builtin_amdgcn_exp2f(-dl); l_reg*=f; if(hi==0)wsf[r32]=f; resc=true; } } \
    SBAR(); \
    GAPB(o[0]=__builtin_amdgcn_mfma_f32_32x32x16_bf16(PAF(0),VFR(0),o[0],0,0,0), C0,0); \
    GAPB(o[1]=__builtin_amdgcn_mfma_f32_32x32x16_bf16(PAF(0),VFR(4),o[1],0,0,0), C0,4); \
    KRD(GL,0); GAPB(o[0]=__builtin_amdgcn_mfma_f32_32x32x16_bf16(PAF(1),VFR(1),o[0],0,0,0), C0,8); \
    KRD(GL,1); GAPB(o[1]=__builtin_amdgcn_mfma_f32_32x32x16_bf16(PAF(1),VFR(5),o[1],0,0,0), C0,12); \
    KRD(GL,2); GAPB(o[0]=__builtin_amdgcn_mfma_f32_32x32x16_bf16(PAF(2),VFR(2),o[0],0,0,0), C1,0); \
    KRD(GL,3); GAPB(o[1]=__builtin_amdgcn_mfma_f32_32x32x16_bf16(PAF(2),VFR(6),o[1],0,0,0), C1,4); \
    GAPB(o[0]=__builtin_amdgcn_mfma_f32_32x32x16_bf16(PAF(3),VFR(3),o[0],0,0,0), C1,8); \
    GAPB(o[1]=__builtin_amdgcn_mfma_f32_32x32x16_bf16(PAF(3),VFR(7),o[1],0,0,0), C1,12); \
    }while(0)
  int t=1;
  #undef CMASK
  #define CMASK(P0,P1,t) do{}while(0)
  for(;t+5<NT;t+=2){
    STEP(pB0,pB1,pA0,pA1,t,true,true,true);     WAIT_BAR(2); RESC(); ROT();
    STEP(pA0,pA1,pB0,pB1,t+1,true,true,true);   WAIT_BAR(2); RESC(); ROT();
  }
  #undef CMASK
  #define CMASK(P0,P1,t) do{}while(0)
  #define ENDW(tt) do{ if((tt)+3<NT){WAIT_BAR(2);} else if((tt)+2<NT){WAIT_BAR(1);} else {WAIT_BAR(0);} }while(0)
  for(;t+1<NT;t+=2){
    STEP(pB0,pB1,pA0,pA1,t,(t+3<NT),(t+1<NT),(t+1<NT));       ENDW(t);   RESC(); ROT();
    STEP(pA0,pA1,pB0,pB1,t+1,(t+4<NT),(t+2<NT),(t+2<NT));     ENDW(t+1); RESC(); ROT();
  }
  STEP(pB0,pB1,pA0,pA1,NT-1,false,false,false); RESC();
  { float sacc=pB0[0]+pB0[1]; _Pragma("unroll") for(int r=2;r<16;++r)sacc+=pB0[r]; _Pragma("unroll") for(int r=0;r<16;++r)sacc+=pB1[r]; l_reg+=sacc;
    pw0=(u32x4){PKW(pB0,0),PKW(pB0,2),PKW(pB0,4),PKW(pB0,6)};pw1=(u32x4){PKW(pB0,8),PKW(pB0,10),PKW(pB0,12),PKW(pB0,14)};pw2=(u32x4){PKW(pB1,0),PKW(pB1,2),PKW(pB1,4),PKW(pB1,6)};pw3=(u32x4){PKW(pB1,8),PKW(pB1,10),PKW(pB1,12),PKW(pB1,14)};
    SBAR(); pv(o,vb0+sl_cur,PAF(0),PAF(1),PAF(2),PAF(3)); }
  #undef PKW
  #undef PAF
  #undef VFR
  #undef PIN
  #undef MX3
  #undef GAPA
  #undef GAPB
  #undef EX
  #undef VRD
  #undef KRD
  #undef STEP
  #undef ENDW
  {auto rr=__builtin_amdgcn_permlane32_swap(__float_as_uint(l_reg),__float_as_uint(l_reg),false,false);l_reg=__uint_as_float(rr[0])+__uint_as_float(rr[1]);}
  if(hi==0)wsf[32+r32]=l_reg;asm volatile("s_waitcnt lgkmcnt(0)":::"memory");
  float rli[16];
  #pragma unroll
  for(int r=0;r<16;++r)rli[r]=__builtin_amdgcn_rcpf(wsf[32+crow(r,hi)]);
  bf16*Ow=O+(rowbase+q0+wid*QBLK)*DMO+h*D;
  { bf16*stg=(bf16*)(shm+LDS_OST)+wid*2048;
    #pragma unroll
    for(int r=0;r<16;++r){const int orow=crow(r,hi);
      #pragma unroll
      for(int d0=0;d0<2;++d0)stg[orow*64+d0*32+r32]=__float2bfloat16(o[d0][r]*rli[r]);}
    asm volatile("s_waitcnt lgkmcnt(0)":::"memory");
    #pragma unroll
    for(int i=0;i<4;++i){const int row=i*8+(lane>>3),ch=lane&7; const u32x4 v=*(const u32x4*)(stg+row*64+ch*8); ATTN_STORE16(Ow+(long)row*DMO+ch*8,v);} }
  asm volatile("s_waitcnt lgkmcnt(0)\n\ts_barrier":::"memory");
  #undef DMA_K
  #undef DMA_V
  #undef CMASK
  #undef START
  #undef RESC
  #undef ROT
}
constexpr int ATTN_LDS_BYTES=LDS_BYTES;
struct AttnTensors { const bf16* Q; const bf16* K; const bf16* V; bf16* O; };
struct AttnUnit { int bh; int qb; };
struct StaticOrder {
  int vcu, G;
  __device__ __forceinline__ explicit StaticOrder(int grid,int block):vcu((grid%8==0)?(block%8)*(grid/8)+block/8:block),G(grid){}
  __device__ __forceinline__ bool next(int i,AttnUnit&u)const{ const int per=(BATCH*NHEAD*NQB+G-1)/G; if(i>=per)return false; const int idx=vcu*per+i; if(idx>=BATCH*NHEAD*NQB)return false;
    const int qb=idx%NQB, hq=(idx/NQB)&3, bk=idx/(NQB*4), kvh=bk&1, b=bk>>1; u.bh=b*NHEAD+kvh*4+hq; u.qb=qb; return true; }
  __device__ __forceinline__ void a_ready(const AttnUnit&)const{}
  __device__ __forceinline__ void done(const AttnUnit&)const{}
};
template<class Sched,int THRL=8> __device__ __forceinline__ void attn_phase(char*lds,const AttnTensors&T,const Sched&S){
  AttnUnit u;
  for(int i=0;S.next(i,u);++i){ S.a_ready(u); attn_unit<THRL>(u.bh/NHEAD,u.bh%NHEAD,u.qb,T.Q,T.K,T.V,T.O,lds); S.done(u); }
}
#undef SBAR
#undef WAIT_BAR
}
constexpr int NB = 8, SEQ = 4096, DM = 1024, NL = 4, NTOK = NB * SEQ;
constexpr int INW = 1824, INP = 2048;
constexpr int C_AQ = 0, C_AK = 512, C_AV = 640, C_GQ = 768, C_GK = 896, C_GV = 1024, C_GR = 1280, C_FX = 1536, C_GLR = 1792;
constexpr int NE = 32, TOPK = 4, DE = 1024;
constexpr int MPAD = NTOK * TOPK + NE * 256;
constexpr float LN_EPS = 1e-5f, RMS_EPS = 1e-6f;
constexpr float DN_ALPHA = 1.681792830507429f;
constexpr float QSCALE = 0.125f * 1.4426950408889634f;
constexpr float GLA_QSCALE = 0.17677669529663687f;

constexpr size_t MiB = 1u << 20;
constexpr size_t WS_CTL = 0, CTL_ZERO_BYTES = 1 * MiB;
constexpr size_t WS_ROPE = 1 * MiB;
constexpr size_t WS_WIN_T = 2 * MiB;
constexpr size_t WS_WOUT_T = 18 * MiB;
constexpr size_t WS_ADFT = 26 * MiB;
constexpr size_t WS_WGU_T = 90 * MiB;
constexpr size_t WS_WDN_T = 602 * MiB;
constexpr size_t WS_HF = 858 * MiB;
constexpr size_t WS_HB = 986 * MiB;
constexpr size_t WS_PROJ = 1050 * MiB;
constexpr size_t WS_QB = 1178 * MiB;
constexpr size_t WS_KB = 1210 * MiB;
constexpr size_t WS_MIX = 1218 * MiB;
constexpr size_t WS_T1 = 1282 * MiB;
constexpr size_t WS_UVT = 1410 * MiB;
constexpr size_t WS_LA = 1442 * MiB;
constexpr size_t WS_OF = 1474 * MiB;
constexpr size_t WS_OB = 1506 * MiB;
constexpr size_t WS_TOK = 1538 * MiB;
constexpr size_t WS_XS = 1542 * MiB;
constexpr size_t WS_HID = 1814 * MiB;
constexpr size_t WS_YS = 2086 * MiB;
constexpr size_t WS_END = 2358 * MiB;
static_assert((size_t)MPAD * 2048 == 272 * MiB, "sorted buffers");
constexpr int CW_TMO = 0, CW_CODE = 1, CW_BAR = 4096, CW_CNT = 8192;

constexpr int RING_OFF = 0, RING_BYTES = 131072;
constexpr int LDSCTL_OFF = RING_BYTES;
constexpr int LDS_BYTES = 147456;
constexpr int LC_MISC = 0;
constexpr int LC_PSTART = 128;
constexpr int LC_ULIST = 384;
constexpr int LC_CNT = 640;
constexpr int LC_BASE = 768;
constexpr int LC_SELE = 1024;
constexpr int LC_SELS = 1024 + 2048;
constexpr int LC_COS64 = 5120;

constexpr int NWAVES = 8;
constexpr int N_PHASES = 1 + 10 * NL;

__device__ __forceinline__ float bf2f(unsigned short b) { return __uint_as_float((unsigned)b << 16); }
__device__ __forceinline__ float wave_sum(float v) {
#pragma unroll
    for (int o = 1; o < 64; o <<= 1) v += __shfl_xor(v, o);
    return v;
}
typedef unsigned short u16x8 __attribute__((ext_vector_type(8)));
typedef unsigned short u16x4 __attribute__((ext_vector_type(4)));

__device__ __forceinline__ void tr_item(const float* W, int K, int Nsrc, int src_n0, bf16* WT, int dst_n0, int k0, LAS float* scr, int lane) {
    if (src_n0 >= 0) {
#pragma unroll 8
        for (int i = 0; i < 32; ++i) { const int kk = 2 * i + (lane >> 5); scr[kk * 33 + (lane & 31)] = W[(size_t)(k0 + kk) * Nsrc + src_n0 + (lane & 31)]; }
    } else {
#pragma unroll 8
        for (int i = 0; i < 32; ++i) { const int kk = 2 * i + (lane >> 5); scr[kk * 33 + (lane & 31)] = 0.f; }
    }
    LDS_WAIT(); asm volatile("" ::: "memory");
    const int c = lane & 7;
#pragma unroll
    for (int j = 0; j < 4; ++j) { const int n = (lane >> 3) + 8 * j; const LAS float* s = scr + (8 * c) * 33 + n;
        v4u o; o.x = pk2(s[0 * 33], s[1 * 33]); o.y = pk2(s[2 * 33], s[3 * 33]); o.z = pk2(s[4 * 33], s[5 * 33]); o.w = pk2(s[6 * 33], s[7 * 33]);
        *(v4u*)(WT + (size_t)(dst_n0 + n) * K + k0 + 8 * c) = o; }
    LDS_WAIT(); asm volatile("" ::: "memory");
}

__device__ __forceinline__ void ln_row(f32x4 (&v)[4], const float* g, const float* bt, float* of32, bf16* obf, int lane) {
    float s = 0.f;
#pragma unroll
    for (int j = 0; j < 4; ++j) s += (v[j].x + v[j].y) + (v[j].z + v[j].w);
    const float mean = wave_sum(s) * (1.f / DM); float s2 = 0.f;
#pragma unroll
    for (int j = 0; j < 4; ++j) { v[j] = v[j] - mean; s2 += (v[j].x * v[j].x + v[j].y * v[j].y) + (v[j].z * v[j].z + v[j].w * v[j].w); }
    const float rstd = 1.f / sqrtf(wave_sum(s2) * (1.f / DM) + LN_EPS);
#pragma unroll
    for (int j = 0; j < 4; ++j) { const f32x4 gg = *(const f32x4*)(g + lane * 4 + 256 * j), bb = *(const f32x4*)(bt + lane * 4 + 256 * j);
        v[j] = v[j] * rstd * gg + bb;
        if (of32) *(f32x4*)(of32 + lane * 4 + 256 * j) = v[j];
        if (obf) *(unsigned long long*)(obf + lane * 4 + 256 * j) = (unsigned long long)pk2(v[j].x, v[j].y) | ((unsigned long long)pk2(v[j].z, v[j].w) << 32); }
}

struct Args { const float* in[20]; float* out; unsigned char* ws; int ph_lo, ph_hi; };
static_assert(sizeof(Args) == 20 * 8 + 8 + 8 + 8, "no padding bytes in Args");


typedef __attribute__((address_space(4))) const unsigned char* kptr_t;
__device__ __forceinline__ kptr_t karg() { kptr_t p = (kptr_t)__builtin_amdgcn_kernarg_segment_ptr(); asm volatile("" : "+s"(p)); return p; }
#define KIN(i) (*(const float* const __attribute__((address_space(4)))*)(karg() + 8 * (i)))
#define KOUT() (*(float* const __attribute__((address_space(4)))*)(karg() + 160))
#define KWS() (*(unsigned char* const __attribute__((address_space(4)))*)(karg() + 168))
#define WSP(T, off) ((T*)(ws + (off)))

#ifndef NAIVE_ATTN
#define NAIVE_ATTN 0
#endif

__global__ void __launch_bounds__(NWAVES * 64, 2) fwd(Args args) {
    extern __shared__ __attribute__((aligned(16))) unsigned char lds_raw[];
    LAS unsigned char* lds = (LAS unsigned char*)lds_raw;
    LAS unsigned char* lctl = lds + LDSCTL_OFF;
    const int G = gridDim.x, bx = blockIdx.x;
    const int NGW = G * NWAVES, NGT = G * NWAVES * 64;
#define TID_SETUP() int tid_ = threadIdx.x; asm volatile("" : "+v"(tid_)); const int tid = tid_, lane = tid & 63, wave = __builtin_amdgcn_readfirstlane(tid >> 6); \
    const int gw = bx * NWAVES + wave, gt = bx * (NWAVES * 64) + tid; (void)lane; (void)gw; (void)gt
    for (int u = threadIdx.x; u < (LDS_BYTES - LDSCTL_OFF) / 4; u += NWAVES * 64) ((LAS unsigned*)lctl)[u] = 0u;
    __syncthreads();
    volatile LAS unsigned* MISC = (volatile LAS unsigned*)(lctl + LC_MISC);
    XcdBarrier bar = xcd_barrier_post((unsigned*)(KWS() + WS_CTL) + CW_BAR, MISC + 8);
    const int lo = args.ph_lo, hi = args.ph_hi;
#ifndef PH_OFF
#define PH_OFF 0
#endif
#define PON(j) (!((PH_OFF >> (j)) & 1))
#define IN(k) (lo <= (k) && (k) < hi)
#define SEAM(k) do { if (IN(k) && IN((k) + 1)) xcd_barrier(bar); } while (0)

    if (IN(0) && PON(0)) {
        TID_SETUP(); unsigned char* ws = KWS(); const float* x_in = KIN(0); const float* ln_in_g = KIN(1); const float* ln_in_b = KIN(2); const float* w_in = KIN(3); const float* w_out = KIN(9);
        const float* exp_w_gu = KIN(14); const float* exp_w_down = KIN(16);
        float* ROPE = WSP(float, WS_ROPE); bf16* WIN_T = WSP(bf16, WS_WIN_T); bf16* WOUT_T = WSP(bf16, WS_WOUT_T); bf16* ADFT = WSP(bf16, WS_ADFT); bf16* WGU_T = WSP(bf16, WS_WGU_T); bf16* WDN_T = WSP(bf16, WS_WDN_T);
        float* HF = WSP(float, WS_HF); bf16* HB = WSP(bf16, WS_HB);
        LAS float* scr = (LAS float*)(lds + RING_OFF + wave * 16384);
        constexpr int I_WIN = NL * 64 * 16, I_WOUT = NL * 32 * 16, I_WGU = NL * NE * 64 * 16, I_WDN = NL * NE * 32 * 16;
        constexpr int NITEMS = I_WIN + I_WOUT + I_WGU + I_WDN;
        for (int it = gw; it < NITEMS; it += NGW) {
            int r = it;
            if (r < I_WIN) { const int l = r / 1024, q = r % 1024, kb = q / 64, nb = q % 64, n0 = nb * 32;
                const int src = n0 < 1536 ? n0 : (n0 < 1792 ? n0 + 32 : (n0 < 1824 ? n0 - 256 : -1));
                tr_item(w_in + (size_t)l * DM * INW, DM, INW, src, WIN_T + (size_t)l * INP * DM, n0, kb * 64, scr, lane); continue; }
            r -= I_WIN;
            if (r < I_WOUT) { const int l = r / 512, q = r % 512, kb = q / 32, nb = q % 32;
                tr_item(w_out + (size_t)l * DM * DM, DM, DM, nb * 32, WOUT_T + (size_t)l * DM * DM, nb * 32, kb * 64, scr, lane); continue; }
            r -= I_WOUT;
            if (r < I_WGU) { const int le = r / 1024, q = r % 1024, kb = q / 64, nb = q % 64, n0 = nb * 32;
                const int pn = n0 >> 8, bj = (n0 >> 7) & 1, j = n0 & 127, src = bj * 1024 + pn * 128 + j;
                tr_item(exp_w_gu + (size_t)le * DM * 2048, DM, 2048, src, WGU_T + (size_t)le * 2048 * DM, n0, kb * 64, scr, lane); continue; }
            r -= I_WGU;
            { const int le = r / 512, q = r % 512, kb = q / 32, nb = q % 32;
                tr_item(exp_w_down + (size_t)le * DE * DM, DE, DM, nb * 32, WDN_T + (size_t)le * DM * DE, nb * 32, kb * 64, scr, lane); }
        }
        for (int it = gt; it < 4096 * 1024; it += NGT) { const int sp = it >> 10, c8 = (it & 1023) * 8; const int half = c8 >> 12, s0 = c8 & 4095;
            float vals[8];
#pragma unroll
            for (int i = 0; i < 8; ++i) { const int m = ((s0 + i) * sp) & 4095; float sn, cs; sincospif((float)m * (1.0f / 2048.0f), &sn, &cs); vals[i] = (half ? -sn : cs) * (1.0f / 512.0f); }
            v4u o; o.x = pk2(vals[0], vals[1]); o.y = pk2(vals[2], vals[3]); o.z = pk2(vals[4], vals[5]); o.w = pk2(vals[6], vals[7]);
            *(v4u*)(ADFT + (size_t)sp * 8192 + c8) = o; }
        for (int it = gt; it < SEQ * 32; it += NGT) { const int t = it >> 5, i = it & 31, a = i >> 4, f = i & 15; const int pos = a ? (t & 63) : (t >> 6);
            const double inv = exp(-9.210340371976184 * (double)f / 16.0); const double ang = (double)pos * inv;
            ROPE[it] = (float)cos(ang); ROPE[SEQ * 32 + it] = (float)sin(ang); }
        for (int m = gw; m < NTOK; m += NGW) { f32x4 v[4];
#pragma unroll
            for (int j = 0; j < 4; ++j) v[j] = *(const f32x4*)(x_in + (size_t)m * DM + lane * 4 + 256 * j);
            ln_row(v, ln_in_g, ln_in_b, HF + (size_t)m * DM, HB + (size_t)m * DM, lane); }
    }
    SEAM(0);

    for (int l = 0; l < NL; ++l) {
        const int pb = 1 + 10 * l;
        if (IN(pb + 0) && PON(1)) {
            TID_SETUP(); unsigned char* ws = KWS(); bf16* HB = WSP(bf16, WS_HB); bf16* WIN_T = WSP(bf16, WS_WIN_T); bf16* PROJ = WSP(bf16, WS_PROJ);
            pg8::Gemm g{HB, WIN_T + (size_t)l * INP * DM, NTOK, INP, DM}; pg8::StaticOrder S; S.init(NTOK, INP, G, bx);
            pg8::EpiPlainBf16 E{PROJ, INP};
            pg8::gemm_phase<pg8::EpiPlainBf16, pg8::StaticOrder, true, true>(lds + RING_OFF, g, S, E);
        }
        SEAM(pb + 0);
        if (IN(pb + 1) && PON(2)) {
            TID_SETUP(); unsigned char* ws = KWS(); const float* att_q_gain = KIN(4); const float* att_k_gain = KIN(5); const float* gla_gate_w = KIN(6); const float* gla_gate_b = KIN(7);
            const float* ROPE = WSP(float, WS_ROPE); const bf16* PROJ = WSP(bf16, WS_PROJ); bf16* QB = WSP(bf16, WS_QB); bf16* KB = WSP(bf16, WS_KB); bf16* UVT = WSP(bf16, WS_UVT); float* LA = WSP(float, WS_LA);
            const float* qg = att_q_gain + l * 64; const float* kg = att_k_gain + l * 64;
            for (int m = gw; m < NTOK; m += NGW) { const int t = m & (SEQ - 1); const int ri = (lane >> 5) * 16 + (lane & 15);
                const float cs = ROPE[t * 32 + ri], sn = ROPE[SEQ * 32 + t * 32 + ri]; const float sg = ((lane >> 4) & 1) ? 1.f : -1.f;
#pragma unroll
                for (int h = 0; h < 10; ++h) { const float xv = bf2f(PROJ[(size_t)m * INP + h * 64 + lane]);
                    const float ms = wave_sum(xv * xv) * (1.f / 64.f); const float xn = xv * (1.f / sqrtf(ms + RMS_EPS)) * (h < 8 ? qg[lane] : kg[lane]);
                    const float pr = __shfl_xor(xn, 16); float o = xn * cs + sg * pr * sn;
                    if (h < 8) { o *= QSCALE; QB[(size_t)m * 512 + h * 64 + lane] = (bf16)f2bf(o); } else KB[(size_t)m * 128 + (h - 8) * 64 + lane] = (bf16)f2bf(o); } }
            { const float* gw_l = gla_gate_w + (size_t)l * 2 * 16 * 128; const float* gb_l = gla_gate_b + (size_t)l * 2 * 128;
              for (int m = gw; m < NTOK; m += NGW) { const float lr = (lane < 32) ? bf2f(PROJ[(size_t)m * INP + C_GLR + lane]) : 0.f;
                const int dir = lane >> 5, kc = (lane & 31) * 4; f32x4 z = *(const f32x4*)(gb_l + dir * 128 + kc);
#pragma unroll
                for (int r = 0; r < 16; ++r) { const float a = __shfl(lr, dir * 16 + r); const f32x4 w = *(const f32x4*)(gw_l + (size_t)(dir * 16 + r) * 128 + kc); z = z + w * a; }
                f32x4 o;
#pragma unroll
                for (int i = 0; i < 4; ++i) o[i] = (fminf(z[i], 0.f) - log1pf(expf(-fabsf(z[i])))) * (1.f / 16.f);
                *(f32x4*)(LA + (size_t)m * 256 + dir * 128 + kc) = o; } }
            { LAS float* c64 = (LAS float*)(lctl + LC_COS64);
              if (tid < 64) { float sn, cs; sincospif((float)tid * (1.0f / 32.0f), &sn, &cs); c64[tid] = cs; c64[64 + tid] = sn; }
              __syncthreads();
              for (int it = gt; it < NB * 256 * SEQ; it += NGT) { const int s = it & (SEQ - 1), bc = it >> 12, b = bc >> 8, ch = bc & 255, g4 = ch >> 6, cc = ch & 63;
                const bf16* src = PROJ + (size_t)(b * SEQ + s) * INP + C_FX + g4 * 64; float U = 0.f, V = 0.f;
#pragma unroll
                for (int c8 = 0; c8 < 8; ++c8) { const u16x8 f = *(const u16x8*)(src + c8 * 8);
#pragma unroll
                    for (int i = 0; i < 8; ++i) { const int k = ((c8 * 8 + i) * cc) & 63; const float fv = bf2f(f[i]); U += fv * c64[k]; V += fv * c64[64 + k]; } }
                UVT[(size_t)bc * 8192 + s] = (bf16)f2bf(U); UVT[(size_t)bc * 8192 + 4096 + s] = (bf16)f2bf(V); } }
        }
        SEAM(pb + 1);
        if (IN(pb + 2) && PON(3)) {
            TID_SETUP(); unsigned char* ws = KWS(); const bf16* PROJ = WSP(bf16, WS_PROJ); const float* LA = WSP(float, WS_LA); float* OF = WSP(float, WS_OF); float* OB = WSP(float, WS_OB);
            for (int job = bx; job < NB * 4 * 2; job += G) { const int dir = job & 1, hd = (job >> 1) & 3, b = job >> 3;
                const int vl = lane & 7, dg = lane >> 3; const int vcol = hd * 64 + wave * 8 + vl;
                float s0 = 0.f, s1 = 0.f, s2 = 0.f, s3 = 0.f; float* OUT = dir ? OB : OF;
                for (int t8 = 0; t8 < SEQ; t8 += 8) {
                    u16x4 q4[8], k4[8]; f32x4 a4[8]; float vv[8];
#pragma unroll
                    for (int i = 0; i < 8; ++i) { const int t = dir ? (SEQ - 1 - (t8 + i)) : (t8 + i); const size_t m = (size_t)b * SEQ + t;
                        q4[i] = *(const u16x4*)(PROJ + m * INP + C_GQ + hd * 32 + dg * 4); k4[i] = *(const u16x4*)(PROJ + m * INP + C_GK + hd * 32 + dg * 4);
                        a4[i] = *(const f32x4*)(LA + m * 256 + dir * 128 + hd * 32 + dg * 4); vv[i] = bf2f(PROJ[m * INP + C_GV + vcol]); }
#pragma unroll
                    for (int i = 0; i < 8; ++i) { const int t = dir ? (SEQ - 1 - (t8 + i)) : (t8 + i); const size_t m = (size_t)b * SEQ + t;
                        const float e0 = expf(a4[i][0]), e1 = expf(a4[i][1]), e2 = expf(a4[i][2]), e3 = expf(a4[i][3]);
                        const float q0 = bf2f(q4[i][0]), q1 = bf2f(q4[i][1]), q2 = bf2f(q4[i][2]), q3 = bf2f(q4[i][3]);
                        const float k0 = bf2f(k4[i][0]), k1 = bf2f(k4[i][1]), k2 = bf2f(k4[i][2]), k3 = bf2f(k4[i][3]);
                        float part;
                        if (dir == 0) { s0 = s0 * e0 + k0 * vv[i]; s1 = s1 * e1 + k1 * vv[i]; s2 = s2 * e2 + k2 * vv[i]; s3 = s3 * e3 + k3 * vv[i]; part = (q0 * s0 + q1 * s1) + (q2 * s2 + q3 * s3); }
                        else { s0 *= e0; s1 *= e1; s2 *= e2; s3 *= e3; part = (q0 * s0 + q1 * s1) + (q2 * s2 + q3 * s3); s0 += k0 * vv[i]; s1 += k1 * vv[i]; s2 += k2 * vv[i]; s3 += k3 * vv[i]; }
                        part += __shfl_xor(part, 8); part += __shfl_xor(part, 16); part += __shfl_xor(part, 32);
                        if (dg == 0) OUT[m * 256 + vcol] = part * GLA_QSCALE; }
                }
            }
        }
        SEAM(pb + 2);
        if (IN(pb + 3) && PON(4)) {
            TID_SETUP(); unsigned char* ws = KWS(); const float* gla_norm_g = KIN(8); const bf16* PROJ = WSP(bf16, WS_PROJ); const float* OF = WSP(float, WS_OF); const float* OB = WSP(float, WS_OB);
            bf16* MIX = WSP(bf16, WS_MIX); const bf16* ADFT = WSP(bf16, WS_ADFT); const bf16* UVT = WSP(bf16, WS_UVT); const bf16* QB = WSP(bf16, WS_QB); const bf16* KB = WSP(bf16, WS_KB);
            { pg8::Gemm g{ADFT, UVT, SEQ, NB * 256, 8192}; pg8::StaticOrder S; S.init(SEQ, NB * 256, G, bx);
              pg8::EpiFnet E{MIX};
              pg8::gemm_phase<pg8::EpiFnet, pg8::StaticOrder, true, true>(lds + RING_OFF, g, S, E); }
            __syncthreads();
            for (int it = gw; it < NTOK * 4; it += NGW) { const int m = it >> 2, hd = it & 3; const size_t o = (size_t)m * 256 + hd * 64 + lane;
                const float v = OF[o] + OB[o]; const float ms = wave_sum(v * v) * (1.f / 64.f);
                const float r = bf2f(PROJ[(size_t)m * INP + C_GR + hd * 64 + lane]); const float sil = r / (1.f + expf(-r));
                MIX[(size_t)m * DM + 512 + hd * 64 + lane] = (bf16)f2bf(v * (1.f / sqrtf(ms + RMS_EPS)) * gla_norm_g[l * 64 + lane] * sil); }
#if NAIVE_ATTN
            { LAS float* Kt = (LAS float*)(lds + RING_OFF); LAS float* Vt = Kt + 64 * 64;
              for (int unit = bx; unit < NB * 8 * 8; unit += G) { const int rb = unit & 7, h = (unit >> 3) & 7, b = unit >> 6, kvh = h >> 2;
                const size_t qrow = (size_t)b * SEQ + rb * 512 + tid;
                float q[64], o[64]; float mrun = -INFINITY, lrun = 0.f;
#pragma unroll
                for (int c8 = 0; c8 < 8; ++c8) { const u16x8 f = *(const u16x8*)(QB + qrow * 512 + h * 64 + c8 * 8);
#pragma unroll
                    for (int i = 0; i < 8; ++i) { q[c8 * 8 + i] = bf2f(f[i]); o[c8 * 8 + i] = 0.f; } }
                for (int kt = 0; kt < SEQ; kt += 64) {
                    __syncthreads();
                    { const int kr = tid >> 3, c8 = (tid & 7) * 8; const size_t krow = (size_t)b * SEQ + kt + kr;
                      const u16x8 kf = *(const u16x8*)(KB + krow * 128 + kvh * 64 + c8); const u16x8 vf = *(const u16x8*)(PROJ + krow * INP + C_AV + kvh * 64 + c8);
#pragma unroll
                      for (int i = 0; i < 8; ++i) { Kt[kr * 64 + c8 + i] = bf2f(kf[i]); Vt[kr * 64 + c8 + i] = bf2f(vf[i]); } }
                    __syncthreads();
#pragma unroll 1
                    for (int j = 0; j < 64; ++j) { float a = 0.f;
#pragma unroll
                        for (int d4 = 0; d4 < 16; ++d4) { const f32x4 kv = *(const LAS f32x4*)(Kt + j * 64 + d4 * 4); a += (q[d4 * 4] * kv.x + q[d4 * 4 + 1] * kv.y) + (q[d4 * 4 + 2] * kv.z + q[d4 * 4 + 3] * kv.w); }
                        if (a > mrun) { const float al = exp2f(mrun - a); mrun = a; lrun *= al;
#pragma unroll
                            for (int d = 0; d < 64; ++d) o[d] *= al; }
                        const float p = exp2f(a - mrun); lrun += p;
#pragma unroll
                        for (int d4 = 0; d4 < 16; ++d4) { const f32x4 vv = *(const LAS f32x4*)(Vt + j * 64 + d4 * 4); o[d4 * 4] += p * vv.x; o[d4 * 4 + 1] += p * vv.y; o[d4 * 4 + 2] += p * vv.z; o[d4 * 4 + 3] += p * vv.w; } }
                }
                const float rl = 1.f / lrun;
#pragma unroll
                for (int c8 = 0; c8 < 8; ++c8) { v4u w; w.x = pk2(o[c8 * 8] * rl, o[c8 * 8 + 1] * rl); w.y = pk2(o[c8 * 8 + 2] * rl, o[c8 * 8 + 3] * rl); w.z = pk2(o[c8 * 8 + 4] * rl, o[c8 * 8 + 5] * rl); w.w = pk2(o[c8 * 8 + 6] * rl, o[c8 * 8 + 7] * rl);
                    *(v4u*)(MIX + qrow * DM + h * 64 + c8 * 8) = w; }
              }
              __syncthreads(); }
#else
            { const attn_body::AttnTensors AT{(const attn_body::bf16*)QB, (const attn_body::bf16*)KB, (const attn_body::bf16*)(PROJ + C_AV), (attn_body::bf16*)MIX};
              const attn_body::StaticOrder S(G, bx);
              attn_body::attn_phase<attn_body::StaticOrder>((char*)lds_raw + RING_OFF, AT, S); }
#endif
        }
        SEAM(pb + 3);
        if (IN(pb + 4) && PON(5)) {
            TID_SETUP(); unsigned char* ws = KWS(); const bf16* MIX = WSP(bf16, WS_MIX); const bf16* WOUT_T = WSP(bf16, WS_WOUT_T); const float* HF = WSP(float, WS_HF); float* T1 = WSP(float, WS_T1);
            pg8::Gemm g{MIX, WOUT_T + (size_t)l * DM * DM, NTOK, DM, DM}; pg8::StaticOrder S; S.init(NTOK, DM, G, bx);
            pg8::EpiResF32 E{HF, T1, DM, DN_ALPHA};
            pg8::gemm_phase<pg8::EpiResF32, pg8::StaticOrder, true, true>(lds + RING_OFF, g, S, E);
        }
        SEAM(pb + 4);
        if (IN(pb + 5) && PON(6)) {
            TID_SETUP(); unsigned char* ws = KWS(); gu32* ctl = (gu32*)(ws + WS_CTL); const float* ln1_g = KIN(10); const float* ln1_b = KIN(11); const float* router_w = KIN(12); const float* router_b = KIN(13);
            const float* T1 = WSP(float, WS_T1); float* HF = WSP(float, WS_HF); bf16* HB = WSP(bf16, WS_HB); int* TOKE = WSP(int, WS_TOK); int* TOKS = TOKE + NTOK * 4; float* TOKW = (float*)(TOKS + NTOK * 4);
            LAS float* RW = (LAS float*)(lds + RING_OFF);
            { const float* rw = router_w + (size_t)l * DM * NE; for (int i = tid; i < DM * NE; i += NWAVES * 64) { const int c = i >> 5, e = i & 31; RW[e * DM + c] = rw[i]; } }
            LAS int* lcnt = (LAS int*)(lctl + LC_CNT); LAS int* lbase = (LAS int*)(lctl + LC_BASE); LAS int* sele = (LAS int*)(lctl + LC_SELE); LAS int* sels = (LAS int*)(lctl + LC_SELS);
            const float* rb = router_b + l * NE;
            for (int r0 = bx * 128; r0 < NTOK; r0 += G * 128) {
                if (tid < 32) lcnt[tid] = 0;
                __syncthreads();
                for (int rr = 0; rr < 16; ++rr) { const int lr = wave * 16 + rr; const size_t m = (size_t)r0 + lr; f32x4 v[4];
#pragma unroll
                    for (int j = 0; j < 4; ++j) v[j] = *(const f32x4*)(T1 + m * DM + lane * 4 + 256 * j);
                    ln_row(v, ln1_g + l * DM, ln1_b + l * DM, HF + m * DM, HB + m * DM, lane);
                    float lg[32];
#pragma unroll
                    for (int e = 0; e < 32; ++e) { float a = 0.f;
#pragma unroll
                        for (int j = 0; j < 4; ++j) { const f32x4 w = *(const LAS f32x4*)(RW + e * DM + lane * 4 + 256 * j); a += (v[j].x * w.x + v[j].y * w.y) + (v[j].z * w.z + v[j].w * w.w); }
                        lg[e] = wave_sum(a) + rb[e]; }
                    int se[4]; float sv[4];
#pragma unroll
                    for (int k = 0; k < 4; ++k) { float best = -INFINITY; int bi = 0;
#pragma unroll
                        for (int e = 0; e < 32; ++e) { if (lg[e] > best) { best = lg[e]; bi = e; } }
                        se[k] = bi; sv[k] = best;
#pragma unroll
                        for (int e = 0; e < 32; ++e) if (e == bi) lg[e] = -INFINITY; }
                    const float e1 = expf(sv[1] - sv[0]), e2 = expf(sv[2] - sv[0]), e3 = expf(sv[3] - sv[0]); const float inv = 1.f / (1.f + e1 + e2 + e3);
                    if (lane == 0) { const float wts[4] = {inv, e1 * inv, e2 * inv, e3 * inv};
#pragma unroll
                        for (int k = 0; k < 4; ++k) { const int ls = __hip_atomic_fetch_add(lcnt + se[k], 1, __ATOMIC_RELAXED, __HIP_MEMORY_SCOPE_WORKGROUP); sele[lr * 4 + k] = se[k]; sels[lr * 4 + k] = ls; TOKW[m * 4 + k] = wts[k]; } }
                }
                __syncthreads();
                if (tid < 32) lbase[tid] = (int)__hip_atomic_fetch_add(ctl + CW_CNT + l * 32 + tid, (unsigned)lcnt[tid], RLX_AGENT);
                __syncthreads();
                { const int e = sele[tid]; TOKE[(size_t)r0 * 4 + tid] = e; TOKS[(size_t)r0 * 4 + tid] = lbase[e] + sels[tid]; }
                __syncthreads();
            }
        }
        SEAM(pb + 5);
        if (IN(pb + 6) || IN(pb + 7) || IN(pb + 8)) {
            LAS int* pst = (LAS int*)(lctl + LC_PSTART); gu32* ctl = (gu32*)(KWS() + WS_CTL);
            __syncthreads();
            if (threadIdx.x == 0) { int acc = 0; for (int e = 0; e < NE; ++e) { pst[e] = acc; const int c = (int)__hip_atomic_load(ctl + CW_CNT + l * 32 + e, RLX_AGENT); acc += (c + 255) >> 8; } pst[NE] = acc; }
            __syncthreads();
        }
        if (IN(pb + 6) && PON(7)) {
            TID_SETUP(); unsigned char* ws = KWS(); const int* TOKE = WSP(int, WS_TOK); const int* TOKS = TOKE + NTOK * 4; int* TOKP = (int*)(TOKE + 3 * NTOK * 4); const bf16* HB = WSP(bf16, WS_HB); bf16* XS = WSP(bf16, WS_XS);
            const LAS int* pst = (const LAS int*)(lctl + LC_PSTART);
            for (int it = gw; it < NTOK * 4; it += NGW) { const int m = it >> 2; const int e = TOKE[it], sl = TOKS[it]; const int dst = pst[e] * 256 + sl;
                if (lane == 0) TOKP[it] = dst;
                const v4u* src = (const v4u*)(HB + (size_t)m * DM); v4u* d = (v4u*)(XS + (size_t)dst * DM);
                d[lane] = src[lane]; d[lane + 64] = src[lane + 64]; }
        }
        SEAM(pb + 6);
        if (IN(pb + 7) && PON(8)) {
            TID_SETUP(); unsigned char* ws = KWS(); const float* exp_b_gu = KIN(15); const bf16* XS = WSP(bf16, WS_XS); const bf16* WGU_T = WSP(bf16, WS_WGU_T); bf16* HID = WSP(bf16, WS_HID);
            const LAS int* pst = (const LAS int*)(lctl + LC_PSTART); LAS int* ul = (LAS int*)(lctl + LC_ULIST);
            const int nM = pst[NE], nN = 8, nwg = nM * nN;
            if (tid < 64) { const long L = (long)tid * G + bx; int v = -1;
                if (L < nwg) { int wgid = (int)L; { const int q = nwg / 8, r = nwg % 8, xcd = wgid % 8, off = wgid / 8; wgid = (xcd < r ? xcd * (q + 1) : r * (q + 1) + (xcd - r) * q) + off; }
                    const int nig = 8 * nN, gid = wgid / nig, fm = gid * 8, gsz = (nM - fm) < 8 ? (nM - fm) : 8; const int pm = fm + ((wgid % nig) % gsz), pn = (wgid % nig) / gsz;
                    int e = 0; for (int k = 1; k < NE; ++k) if (pst[k] <= pm) e = k;
                    v = (pm << 16) | (e * nN + pn); }
                ul[tid] = v; }
            __syncthreads();
            const int nunits = bx < nwg ? (nwg - bx + G - 1) / G : 0;
            pg8::Gemm g{XS, WGU_T + (size_t)l * NE * 2048 * DM, MPAD, NE * 2048, DM}; pg8::ListOrder S{ul, nunits};
            pg8::EpiSwiglu E{HID, exp_b_gu + (size_t)l * NE * 2048};
            pg8::gemm_phase<pg8::EpiSwiglu, pg8::ListOrder, true, true>(lds + RING_OFF, g, S, E);
        }
        SEAM(pb + 7);
        if (IN(pb + 8) && PON(9)) {
            TID_SETUP(); unsigned char* ws = KWS(); const float* exp_b_down = KIN(17); const bf16* HID = WSP(bf16, WS_HID); const bf16* WDN_T = WSP(bf16, WS_WDN_T); bf16* YS = WSP(bf16, WS_YS);
            const LAS int* pst = (const LAS int*)(lctl + LC_PSTART); LAS int* ul = (LAS int*)(lctl + LC_ULIST);
            const int nM = pst[NE], nN = 4, nwg = nM * nN;
            __syncthreads();
            if (tid < 64) { const long L = (long)tid * G + bx; int v = -1;
                if (L < nwg) { int wgid = (int)L; { const int q = nwg / 8, r = nwg % 8, xcd = wgid % 8, off = wgid / 8; wgid = (xcd < r ? xcd * (q + 1) : r * (q + 1) + (xcd - r) * q) + off; }
                    const int nig = 8 * nN, gid = wgid / nig, fm = gid * 8, gsz = (nM - fm) < 8 ? (nM - fm) : 8; const int pm = fm + ((wgid % nig) % gsz), pn = (wgid % nig) / gsz;
                    int e = 0; for (int k = 1; k < NE; ++k) if (pst[k] <= pm) e = k;
                    v = (pm << 16) | (e * nN + pn); }
                ul[tid] = v; }
            __syncthreads();
            const int nunits = bx < nwg ? (nwg - bx + G - 1) / G : 0;
            pg8::Gemm g{HID, WDN_T + (size_t)l * NE * DM * DE, MPAD, NE * DM, DE}; pg8::ListOrder S{ul, nunits};
            pg8::EpiDown E{YS, exp_b_down + (size_t)l * NE * DM};
            pg8::gemm_phase<pg8::EpiDown, pg8::ListOrder, true, true>(lds + RING_OFF, g, S, E);
        }
        SEAM(pb + 8);
        if (IN(pb + 9) && PON(10)) {
            TID_SETUP(); unsigned char* ws = KWS(); const float* ln2_g = KIN(18); const float* ln2_b = KIN(19); float* out = KOUT(); float* HF = WSP(float, WS_HF); bf16* HB = WSP(bf16, WS_HB);
            const bf16* YS = WSP(bf16, WS_YS); const float* TOKW = (const float*)(WSP(int, WS_TOK) + 2 * NTOK * 4); const int* TOKP = WSP(int, WS_TOK) + 3 * NTOK * 4;
            const bool lastl = (l == NL - 1);
            for (int m = gw; m < NTOK; m += NGW) { f32x4 v[4];
#pragma unroll
                for (int j = 0; j < 4; ++j) v[j] = *(const f32x4*)(HF + (size_t)m * DM + lane * 4 + 256 * j) * DN_ALPHA;
#pragma unroll
                for (int k = 0; k < 4; ++k) { const float w = TOKW[m * 4 + k]; const bf16* yr = YS + (size_t)TOKP[m * 4 + k] * DM;
#pragma unroll
                    for (int j = 0; j < 4; ++j) { const u16x4 y = *(const u16x4*)(yr + lane * 4 + 256 * j); v[j].x += w * bf2f(y[0]); v[j].y += w * bf2f(y[1]); v[j].z += w * bf2f(y[2]); v[j].w += w * bf2f(y[3]); } }
                ln_row(v, ln2_g + l * DM, ln2_b + l * DM, lastl ? out + (size_t)m * DM : HF + (size_t)m * DM, lastl ? nullptr : HB + (size_t)m * DM, lane); }
        }
        SEAM(pb + 9);
    }
#undef IN
#undef SEAM
}

#ifndef MK_PER_PHASE
#define MK_PER_PHASE 0
#endif
extern "C" void kernel_launch(void* const* d_in, const int* in_sizes, int n_in, void* d_out, int out_size, void* d_ws, size_t ws_size, hipStream_t stream) {
    static int grid = 0;
    if (grid == 0) {
        if (n_in != 20 || in_sizes[0] != NTOK * DM || out_size != NTOK * DM || ws_size < WS_END) { fprintf(stderr, "kernel_launch: unexpected shapes (n_in %d, in0 %d, out %d, ws %zu); nothing launched\n", n_in, n_in > 0 ? in_sizes[0] : -1, out_size, ws_size); grid = -1; return; }
        int dev = 0, cus = 0, per_cu = 0;
        if (hipGetDevice(&dev) != hipSuccess || hipDeviceGetAttribute(&cus, hipDeviceAttributeMultiprocessorCount, dev) != hipSuccess) { grid = -1; return; }
        if (hipFuncSetAttribute((const void*)fwd, hipFuncAttributeMaxDynamicSharedMemorySize, LDS_BYTES) != hipSuccess) { fprintf(stderr, "kernel_launch: hipFuncSetAttribute failed\n"); grid = -1; return; }
        if (hipOccupancyMaxActiveBlocksPerMultiprocessor(&per_cu, (const void*)fwd, NWAVES * 64, LDS_BYTES) != hipSuccess || per_cu < 1) fprintf(stderr, "kernel_launch: occupancy query reports %d\n", per_cu);
        (void)hipGetLastError();
        grid = cus;
    }
    if (grid < 0) return;
    if (hipMemsetAsync((char*)d_ws + WS_CTL, 0, CTL_ZERO_BYTES, stream) != hipSuccess) return;
    Args a{};
    for (int i = 0; i < 20; ++i) a.in[i] = (const float*)d_in[i];
    a.out = (float*)d_out; a.ws = (unsigned char*)d_ws;
#if MK_PER_PHASE
    for (int p = 0; p < N_PHASES; ++p) { a.ph_lo = p; a.ph_hi = p + 1; hipLaunchKernelGGL(fwd, dim3(grid), dim3(NWAVES * 64), LDS_BYTES, stream, a); }
#else
    a.ph_lo = 0; a.ph_hi = N_PHASES;
    hipLaunchKernelGGL(fwd, dim3(grid), dim3(NWAVES * 64), LDS_BYTES, stream, a);
#endif
    const hipError_t le = hipPeekAtLastError();
    if (le != hipSuccess) fprintf(stderr, "kernel_launch: launch failed: %s\n", hipGetErrorName(le));
}
```

```cpp
#include <hip/hip_runtime.h>
#include <hip/hip_bf16.h>
#include <cstdio>
#include <cstdint>
#include <cmath>
namespace pg8 {
#define PG8_LAS __attribute__((address_space(3)))
typedef unsigned short bf16_t;
typedef short bf16x8 __attribute__((ext_vector_type(8)));
typedef float f32x4 __attribute__((ext_vector_type(4)));
typedef unsigned u32x4 __attribute__((ext_vector_type(4)));
constexpr int BM = 256, BK = 64, HALF = 128, HTB = HALF * BK * 2  , STAGE_BYTES = 8 * HTB, NXCD = 8, WGM = 8;

__host__ __device__ __forceinline__ int lds_byte(int r, int c) { const int st = (r >> 4) * 2 + (c >> 5), rr = r & 15, cc = c & 31, ob = rr * 64 + cc * 2; return st * 1024 + (ob ^ (((ob >> 9) & 1) << 5)); }
__host__ __device__ __forceinline__ void stage_rc(int b, int& R, int& C) { const int st = b / 1024, sb = b % 1024, swz = sb ^ (((sb >> 9) & 1) << 5); R = (st >> 1) * 16 + swz / 64; C = (st & 1) * 32 + (swz % 64) / 2; }
__host__ __device__ __forceinline__ int perm32(int rho) { const int n = rho >> 4, i = rho & 15; return 8 * (i >> 2) + 4 * n + (i & 3); }

struct Unit { int pm, pn; };
struct Gemm { const bf16_t* A; const bf16_t* Bt; int M, N, K; };

struct StaticOrder {
    int nM, nN, nwg, G, c;
    __host__ __device__ void init(int M, int N, int G_, int c_) { nM = M / BM; nN = N / BM; nwg = nM * nN; G = G_; c = c_; }
    __host__ __device__ bool next(int i, Unit& u) const {
        const long L = (long)i * G + c; if (L >= nwg) return false;
        int wgid = (int)L; { const int q = nwg / NXCD, r = nwg % NXCD, xcd = wgid % NXCD, off = wgid / NXCD; wgid = (xcd < r ? xcd * (q + 1) : r * (q + 1) + (xcd - r) * q) + off; }
        const int nig = WGM * nN, gid = wgid / nig, fm = gid * WGM, gsz = (nM - fm) < WGM ? (nM - fm) : WGM;
        u.pm = fm + ((wgid % nig) % gsz); u.pn = (wgid % nig) / gsz; return true;
    }
    __device__ __forceinline__ void a_ready(const Unit&) const {}
    __device__ __forceinline__ void done(const Unit&) const {}
};

__device__ __forceinline__ unsigned cvt_pk_bf16(float lo, float hi) { unsigned r; asm volatile("v_cvt_pk_bf16_f32 %0, %1, %2" : "=v"(r) : "v"(lo), "v"(hi)); return r; }
typedef float f32x2 __attribute__((ext_vector_type(2)));
__device__ __forceinline__ u32x4 pack8(const f32x4 v0, const f32x4 v1) { u32x4 w; w.x = cvt_pk_bf16(v0[0], v0[1]); w.y = cvt_pk_bf16(v0[2], v0[3]); w.z = cvt_pk_bf16(v1[0], v1[1]); w.w = cvt_pk_bf16(v1[2], v1[3]); return w; }

struct EpiPlainBf16 {
    static constexpr bool PERM = true, AFTER_DRAIN = false;
    bf16_t* O; int ldc;
    __device__ __forceinline__ void operator()(const f32x4 (&acc)[2][2][4][2], const Unit& u, int wr, int wc, int fr, int fq) const {
        const int row0 = u.pm * BM + wr * 64 + fr, col0 = u.pn * BM + wc * 32 + 8 * fq;
#pragma unroll
        for (int ai = 0; ai < 2; ++ai)
#pragma unroll
            for (int m = 0; m < 4; ++m) { bf16_t* rowp = O + (size_t)(row0 + ai * HALF + m * 16) * ldc + col0;
#pragma unroll
                for (int bj = 0; bj < 2; ++bj) *(u32x4*)(rowp + bj * HALF) = pack8(acc[ai][bj][m][0], acc[ai][bj][m][1]); }
    }
};
struct EpiFnet {
    static constexpr bool PERM = true, AFTER_DRAIN = false;
    bf16_t* MIX;
    __device__ __forceinline__ void operator()(const f32x4 (&acc)[2][2][4][2], const Unit& u, int wr, int wc, int fr, int fq) const {
        const int row0 = u.pn * 4096 + u.pm * BM + wr * 64 + fr, col0 = 768 + wc * 32 + 8 * fq;
#pragma unroll
        for (int ai = 0; ai < 2; ++ai)
#pragma unroll
            for (int m = 0; m < 4; ++m) { bf16_t* rowp = MIX + (size_t)(row0 + ai * HALF + m * 16) * 1024 + col0;
#pragma unroll
                for (int bj = 0; bj < 2; ++bj) *(u32x4*)(rowp + bj * HALF) = pack8(acc[ai][bj][m][0], acc[ai][bj][m][1]); }
    }
};
struct EpiResF32 {
    static constexpr bool PERM = false, AFTER_DRAIN = false;
    const float* base; float* out; int ldc; float alpha;
    __device__ __forceinline__ void operator()(const f32x4 (&acc)[2][2][4][2], const Unit& u, int wr, int wc, int fr, int fq) const {
        const int row0 = u.pm * BM + wr * 64 + fr, col0 = u.pn * BM + wc * 32 + 4 * fq;
#pragma unroll
        for (int ai = 0; ai < 2; ++ai)
#pragma unroll
            for (int m = 0; m < 4; ++m) { const size_t off = (size_t)(row0 + ai * HALF + m * 16) * ldc + col0;
#pragma unroll
                for (int bj = 0; bj < 2; ++bj)
#pragma unroll
                    for (int n = 0; n < 2; ++n) { const f32x4 b = *(const f32x4*)(base + off + bj * HALF + n * 16); *(f32x4*)(out + off + bj * HALF + n * 16) = b * alpha + acc[ai][bj][m][n]; } }
    }
};
__device__ __forceinline__ float swiglu1(float g, float u) { g = fminf(g, 7.0f); u = fminf(fmaxf(u, -7.0f), 7.0f); return (u + 1.0f) * g * __builtin_amdgcn_rcpf(1.0f + __expf(-1.702f * g)); }
struct EpiSwiglu {
    static constexpr bool PERM = true, AFTER_DRAIN = false;
    bf16_t* HID; const float* bgu;
    __device__ __forceinline__ void operator()(const f32x4 (&acc)[2][2][4][2], const Unit& u, int wr, int wc, int fr, int fq) const {
        const int e = u.pn >> 3, pnl = u.pn & 7; const int row0 = u.pm * BM + wr * 64 + fr, jj0 = pnl * 128 + wc * 32 + 8 * fq;
        const float* bg = bgu + (size_t)e * 2048 + jj0;
        const f32x4 bg0 = *(const f32x4*)bg, bg1 = *(const f32x4*)(bg + 4), bu0 = *(const f32x4*)(bg + 1024), bu1 = *(const f32x4*)(bg + 1028);
#pragma unroll
        for (int ai = 0; ai < 2; ++ai)
#pragma unroll
            for (int m = 0; m < 4; ++m) { bf16_t* rowp = HID + (size_t)(row0 + ai * HALF + m * 16) * 1024 + jj0;
                const f32x4 g0 = acc[ai][0][m][0] + bg0, g1 = acc[ai][0][m][1] + bg1, u0 = acc[ai][1][m][0] + bu0, u1 = acc[ai][1][m][1] + bu1;
                f32x4 h0, h1;
#pragma unroll
                for (int i = 0; i < 4; ++i) { h0[i] = swiglu1(g0[i], u0[i]); h1[i] = swiglu1(g1[i], u1[i]); }
                *(u32x4*)rowp = pack8(h0, h1); }
    }
};
struct EpiDown {
    static constexpr bool PERM = true, AFTER_DRAIN = false;
    bf16_t* Y; const float* bd;
    __device__ __forceinline__ void operator()(const f32x4 (&acc)[2][2][4][2], const Unit& u, int wr, int wc, int fr, int fq) const {
        const int e = u.pn >> 2, pnl = u.pn & 3; const int row0 = u.pm * BM + wr * 64 + fr, col0 = pnl * BM + wc * 32 + 8 * fq;
        const float* bp = bd + (size_t)e * 1024 + col0;
        f32x4 bv[2][2];
#pragma unroll
        for (int bj = 0; bj < 2; ++bj)
#pragma unroll
            for (int n = 0; n < 2; ++n) bv[bj][n] = *(const f32x4*)(bp + bj * HALF + 4 * n);
#pragma unroll
        for (int ai = 0; ai < 2; ++ai)
#pragma unroll
            for (int m = 0; m < 4; ++m) { bf16_t* rowp = Y + (size_t)(row0 + ai * HALF + m * 16) * 1024 + col0;
#pragma unroll
                for (int bj = 0; bj < 2; ++bj) *(u32x4*)(rowp + bj * HALF) = pack8(acc[ai][bj][m][0] + bv[bj][0], acc[ai][bj][m][1] + bv[bj][1]); }
    }
};
struct ListOrder {
    const PG8_LAS int* list; int n;
    __device__ __forceinline__ bool next(int i, Unit& u) const { if (i >= n) return false; const int v = __builtin_amdgcn_readfirstlane(list[i]); u.pm = v >> 16; u.pn = v & 0xffff; return true; }
    __device__ __forceinline__ void a_ready(const Unit&) const {}
    __device__ __forceinline__ void done(const Unit&) const {}
};
template <class Epi, class Sched, bool ALIGN_EPI = false, bool SP2 = false>
__device__ __forceinline__ void gemm_phase(PG8_LAS unsigned char* lds, const Gemm g, const Sched& S, const Epi& E) {
    int tid_ = threadIdx.x; asm volatile("" : "+v"(tid_));
    const int tid = tid_, wid = __builtin_amdgcn_readfirstlane(tid >> 6), lane = tid & 63, wr = wid >> 2, wc = wid & 3, fr = lane & 15, fq = lane >> 4;
    const int K = g.K, nt = K / BK;
    unsigned voffA[2], voffB[2];
#pragma unroll
    for (int i = 0; i < 2; ++i) { int R, C; stage_rc(tid * 16 + i * 8192, R, C); const int Rb = Epi::PERM ? ((R & ~31) + perm32(R & 31)) : R;
        voffA[i] = (unsigned)(R * K + C) * 2u; voffB[i] = (unsigned)(Rb * K + C) * 2u; }
    const size_t kstep = (size_t)(BK * 2);
    const size_t hstep = (size_t)HALF * K * 2;
    const size_t tstep = 2 * hstep;
    const unsigned ldsw = (unsigned)wid * 1024u;
    const int aoff = lds_byte(wr * 64 + fr, fq * 8), boff = lds_byte(wc * 32 + fr, fq * 8);
#define PG8_SA(b, h) (((b) * 2 + (h)) * HTB)
#define PG8_SB(b, h) ((4 + (b) * 2 + (h)) * HTB)
#define PG8_STAGE(bufoff, gbase, voff) do { _Pragma("unroll") for (int _i = 0; _i < 2; ++_i) \
        __builtin_amdgcn_global_load_lds((const unsigned*)((const char*)(gbase) + (voff)[_i]), (PG8_LAS unsigned*)(lds + (bufoff) + ldsw + _i * 8192), 16, 0, 0); } while (0)
#define PG8_LDA(dst, b, h) do { _Pragma("unroll") for (int m = 0; m < 4; ++m) _Pragma("unroll") for (int k = 0; k < 2; ++k) dst[m][k] = *(const PG8_LAS bf16x8*)(lds + PG8_SA(b, h) + aoff + m * 2048 + k * 1024); } while (0)
#define PG8_LDB(dst, b, h) do { _Pragma("unroll") for (int n = 0; n < 2; ++n) _Pragma("unroll") for (int k = 0; k < 2; ++k) dst[n][k] = *(const PG8_LAS bf16x8*)(lds + PG8_SB(b, h) + boff + n * 2048 + k * 1024); } while (0)
#define PG8_MMA(ai, bj, At, Bt) do { __builtin_amdgcn_s_setprio(1); _Pragma("unroll") for (int m = 0; m < 4; ++m) _Pragma("unroll") for (int n = 0; n < 2; ++n) _Pragma("unroll") for (int k = 0; k < 2; ++k) \
        acc[ai][bj][m][n] = __builtin_amdgcn_mfma_f32_16x16x32_bf16(Bt[n][k], At[m][k], acc[ai][bj][m][n], 0, 0, 0); __builtin_amdgcn_s_setprio(0); } while (0)
#define PG8_WAIT_V(n) asm volatile("s_waitcnt vmcnt(" #n ")" ::: "memory")
#define PG8_WAIT_L(n) asm volatile("s_waitcnt lgkmcnt(" #n ")" ::: "memory")
#define PG8_BAR __builtin_amdgcn_s_barrier()
#define PG8_SCHED __builtin_amdgcn_sched_barrier(0)
    Unit cur, nxt; int ui = 0;
    if (!S.next(0, cur)) return;
    f32x4 acc[2][2][4][2];
#pragma unroll
    for (int a = 0; a < 2; ++a)
#pragma unroll
        for (int b = 0; b < 2; ++b)
#pragma unroll
            for (int m = 0; m < 4; ++m)
#pragma unroll
                for (int n = 0; n < 2; ++n) acc[a][b][m][n] = (f32x4){0.f, 0.f, 0.f, 0.f};
    bf16x8 At[4][2], B0[2][2], B1[2][2];
    const char* cA = (const char*)g.A + (size_t)cur.pm * tstep; const char* cB = (const char*)g.Bt + (size_t)cur.pn * tstep;
    S.a_ready(cur);
    if constexpr (SP2) {
        PG8_STAGE(PG8_SB(0, 0), cB, voffB); PG8_STAGE(PG8_SB(0, 1), cB + hstep, voffB); PG8_STAGE(PG8_SA(0, 0), cA, voffA); PG8_STAGE(PG8_SA(0, 1), cA + hstep, voffA);
        if (wr == 1) PG8_BAR;
        PG8_WAIT_V(2); PG8_BAR;
        PG8_STAGE(PG8_SB(1, 0), cB + kstep, voffB); PG8_STAGE(PG8_SA(1, 0), cA + kstep, voffA); PG8_STAGE(PG8_SB(1, 1), cB + hstep + kstep, voffB);
        PG8_WAIT_V(6); PG8_BAR;
    } else {
        PG8_STAGE(PG8_SB(0, 0), cB, voffB); PG8_STAGE(PG8_SA(0, 0), cA, voffA); PG8_STAGE(PG8_SB(0, 1), cB + hstep, voffB); PG8_STAGE(PG8_SA(0, 1), cA + hstep, voffA);
        if (wr == 1) PG8_BAR;
        PG8_WAIT_V(4); PG8_BAR;
        PG8_STAGE(PG8_SB(1, 0), cB + kstep, voffB); PG8_STAGE(PG8_SA(1, 0), cA + kstep, voffA); PG8_STAGE(PG8_SB(1, 1), cB + hstep + kstep, voffB);
        PG8_WAIT_V(6); PG8_BAR;
    }
    for (;;) {
        const bool has_next = S.next(ui + 1, nxt);
        const char* nA = has_next ? (const char*)g.A + (size_t)nxt.pm * tstep : cA; const char* nB = has_next ? (const char*)g.Bt + (size_t)nxt.pn * tstep : cB;
        for (int t = 0; t < nt; t += 2) {
            const bool last = (t == nt - 2);
            const char* a1 = cA + (size_t)(t + 1) * kstep;
            const char* a2 = last ? nA : cA + (size_t)(t + 2) * kstep; const char* b2 = last ? nB : cB + (size_t)(t + 2) * kstep;
            const char* a3 = a2 + kstep; const char* b3 = b2 + kstep;
            if (last && has_next) S.a_ready(nxt);
            if constexpr (SP2) {
            PG8_LDB(B0, 0, 0); PG8_LDB(B1, 0, 1); PG8_SCHED; PG8_LDA(At, 0, 0); PG8_STAGE(PG8_SA(1, 1), a1 + hstep, voffA);
            PG8_WAIT_V(8); PG8_WAIT_L(0); PG8_BAR; PG8_MMA(0, 0, At, B0); PG8_MMA(0, 1, At, B1); PG8_BAR; PG8_SCHED;
            PG8_LDA(At, 0, 1); PG8_STAGE(PG8_SB(0, 0), b2, voffB); PG8_STAGE(PG8_SB(0, 1), b2 + hstep, voffB); PG8_STAGE(PG8_SA(0, 0), a2, voffA);
            PG8_WAIT_V(8); PG8_WAIT_L(0); PG8_BAR; PG8_MMA(1, 0, At, B0); PG8_MMA(1, 1, At, B1); PG8_BAR; PG8_SCHED;
            PG8_LDB(B0, 1, 0); PG8_LDB(B1, 1, 1); PG8_SCHED; PG8_LDA(At, 1, 0); PG8_STAGE(PG8_SA(0, 1), a2 + hstep, voffA);
            PG8_WAIT_V(8); PG8_WAIT_L(0); PG8_BAR; PG8_MMA(0, 0, At, B0); PG8_MMA(0, 1, At, B1); PG8_BAR; PG8_SCHED;
            PG8_LDA(At, 1, 1); PG8_STAGE(PG8_SB(1, 0), b3, voffB); PG8_STAGE(PG8_SB(1, 1), b3 + hstep, voffB); PG8_STAGE(PG8_SA(1, 0), a3, voffA);
            PG8_WAIT_V(8); PG8_WAIT_L(0); PG8_BAR; PG8_MMA(1, 0, At, B0); PG8_MMA(1, 1, At, B1); PG8_BAR; PG8_SCHED;
            } else {
            PG8_LDB(B0, 0, 0); PG8_SCHED; PG8_LDA(At, 0, 0); PG8_STAGE(PG8_SA(1, 1), a1 + hstep, voffA);
            PG8_WAIT_L(8); PG8_BAR; PG8_WAIT_L(0); PG8_MMA(0, 0, At, B0); PG8_BAR; PG8_SCHED;
            PG8_LDB(B1, 0, 1); PG8_STAGE(PG8_SB(0, 0), b2, voffB);
            PG8_BAR; PG8_WAIT_L(0); PG8_MMA(0, 1, At, B1); PG8_BAR;
            PG8_LDA(At, 0, 1); PG8_STAGE(PG8_SA(0, 0), a2, voffA);
            PG8_BAR; PG8_WAIT_L(0); PG8_MMA(1, 0, At, B0); PG8_BAR; PG8_SCHED;
            PG8_STAGE(PG8_SB(0, 1), b2 + hstep, voffB);
            PG8_WAIT_V(6); PG8_BAR; PG8_MMA(1, 1, At, B1); PG8_BAR;
            PG8_LDB(B0, 1, 0); PG8_SCHED; PG8_LDA(At, 1, 0); PG8_STAGE(PG8_SA(0, 1), a2 + hstep, voffA);
            PG8_WAIT_L(8); PG8_BAR; PG8_WAIT_L(0); PG8_MMA(0, 0, At, B0); PG8_BAR; PG8_SCHED;
            PG8_LDB(B1, 1, 1); PG8_STAGE(PG8_SB(1, 0), b3, voffB);
            PG8_BAR; PG8_WAIT_L(0); PG8_MMA(0, 1, At, B1); PG8_BAR;
            PG8_LDA(At, 1, 1); PG8_STAGE(PG8_SA(1, 0), a3, voffA);
            PG8_BAR; PG8_WAIT_L(0); PG8_MMA(1, 0, At, B0); PG8_BAR; PG8_SCHED;
            PG8_STAGE(PG8_SB(1, 1), b3 + hstep, voffB);
            PG8_WAIT_V(6); PG8_BAR; PG8_MMA(1, 1, At, B1); PG8_BAR;
            }
        }
        if constexpr (ALIGN_EPI) { if (wr == 0) PG8_BAR; }
        if constexpr (!Epi::AFTER_DRAIN) { E(acc, cur, wr, wc, fr, fq); S.done(cur); }
        if (!has_next) break;
#pragma unroll
        for (int a = 0; a < 2; ++a)
#pragma unroll
            for (int b = 0; b < 2; ++b)
#pragma unroll
                for (int m = 0; m < 4; ++m)
#pragma unroll
                    for (int n = 0; n < 2; ++n) acc[a][b][m][n] = (f32x4){0.f, 0.f, 0.f, 0.f};
        cur = nxt; cA = nA; cB = nB; ++ui;
        if constexpr (ALIGN_EPI) { if (wr == 1) PG8_BAR; }
    }
    PG8_WAIT_V(0);
    if constexpr (!ALIGN_EPI) { if (wr == 0) PG8_BAR; }
    PG8_BAR;
    if constexpr (Epi::AFTER_DRAIN) { E.fused(acc, cur, wr, wc, fr, fq, lds, wid, lane); S.done(cur); }
#undef PG8_SA
#undef PG8_SB
#undef PG8_STAGE
#undef PG8_LDA
#undef PG8_LDB
#undef PG8_MMA
#undef PG8_WAIT_V
#undef PG8_WAIT_L
#undef PG8_BAR
#undef PG8_SCHED
}
}
#define GAS __attribute__((address_space(1)))
#define LAS __attribute__((address_space(3)))
typedef unsigned short bf16;
typedef unsigned v4u __attribute__((ext_vector_type(4)));
typedef float f32x4 __attribute__((ext_vector_type(4)));
typedef short bf16x8 __attribute__((ext_vector_type(8)));
typedef GAS unsigned gu32;
typedef GAS unsigned long long gu64;
#define RLX_AGENT __ATOMIC_RELAXED, __HIP_MEMORY_SCOPE_AGENT
#define LDS_WAIT() asm volatile("s_waitcnt lgkmcnt(0)" ::: "memory")
#define VM_WAIT() asm volatile("s_waitcnt vmcnt(0)" ::: "memory")
__device__ __forceinline__ unsigned long long rt() { return __builtin_amdgcn_s_memrealtime(); }
__device__ __forceinline__ unsigned f2bf(float f) { unsigned u = __builtin_bit_cast(unsigned, f); return (u + 0x7fffu + ((u >> 16) & 1u)) >> 16; }
__device__ __forceinline__ unsigned pk2(float lo, float hi) { return f2bf(lo) | (f2bf(hi) << 16); }
#define XB_TMO      128
#define XB_XCNT(j)  (256  + 64 * (j))
#define XB_XSUB(j)  (1280 + 64 * (j))
#define XB_XGEN(j)  (2304 + 64 * (j))
#define XB_TOP      3328
#define XB_TOPGEN   3392
#define XCD_BAR_WORDS 3456
#define XB_SPIN_CAP (1u << 18)

__device__ __forceinline__ unsigned xb_ld(unsigned* p)              { return __hip_atomic_load(p, __ATOMIC_RELAXED, __HIP_MEMORY_SCOPE_AGENT); }
__device__ __forceinline__ unsigned xb_add(unsigned* p, unsigned v) { return __hip_atomic_fetch_add(p, v, __ATOMIC_RELAXED, __HIP_MEMORY_SCOPE_AGENT); }
__device__ __forceinline__ unsigned xb_xcc_id() { return (unsigned)__builtin_amdgcn_s_getreg((3 << 11) | 20) & 0xFu; }
#define XB_SPIN(cond, bar) do { unsigned _sp = 0; while (cond) { __builtin_amdgcn_s_sleep(1); \
    if ((++_sp & 255u) == 0u) { if (xb_ld(&(bar)[XB_TMO])) break; if (_sp > XB_SPIN_CAP) { atomicAdd(&(bar)[XB_TMO], 1u); break; } } } } while (0)

struct XcdBarrier {
    unsigned* bar; unsigned x;
    volatile LAS unsigned* st;
};

__device__ __forceinline__ XcdBarrier xcd_barrier_post(unsigned* bar, volatile LAS unsigned* st) {
    XcdBarrier b; b.bar = bar; b.x = xb_xcc_id(); b.st = st;
    if (threadIdx.x == 0) (void)xb_add(&bar[XB_XCNT(b.x)], 1u);
    return b;
}
__device__ __forceinline__ void xcd_barrier_complete(unsigned* bar, unsigned x, unsigned& nloc, unsigned& nx) {
    const unsigned G = gridDim.x * gridDim.y * gridDim.z;
    unsigned sum, cnt, mine, sp = 0u;
    for (;;) {
        sum = 0u; cnt = 0u; mine = 0u;
#pragma unroll
        for (unsigned j = 0; j < 16; ++j) { const unsigned c = xb_ld(&bar[XB_XCNT(j)]); sum += c; cnt += (c > 0u) ? 1u : 0u; mine = (j == x) ? c : mine; }
        if (sum == G) break;
        __builtin_amdgcn_s_sleep(1);
        if ((++sp & 255u) == 0u) { if (xb_ld(&bar[XB_TMO])) break; if (sp > XB_SPIN_CAP) { atomicAdd(&bar[XB_TMO], 1u); break; } }
    }
    nloc = mine > 0u ? mine : 1u; nx = cnt > 0u ? cnt : 1u;
}

__device__ __forceinline__ void xcd_barrier(const XcdBarrier& b) {
    asm volatile("s_waitcnt vmcnt(0)" ::: "memory");
    __syncthreads();
    if (threadIdx.x == 0) {
        unsigned* bar = b.bar;
        __builtin_amdgcn_s_waitcnt(0);
        unsigned nloc = b.st[0], nx = b.st[1];
        if (nloc == 0u) { xcd_barrier_complete(bar, b.x, nloc, nx); b.st[0] = nloc; b.st[1] = nx; }
        const unsigned old = xb_add(&bar[XB_XSUB(b.x)], 1u);
        const unsigned gen = old / nloc;
        if (old + 1u == (gen + 1u) * nloc) {
            __builtin_amdgcn_fence(__ATOMIC_RELEASE, "agent");
            asm volatile("s_waitcnt vmcnt(0)" ::: "memory");
            const unsigned og = xb_add(&bar[XB_TOP], 1u);
            const unsigned tg = og / nx;
            if (og + 1u == (tg + 1u) * nx) xb_add(&bar[XB_TOPGEN], 1u);
            else XB_SPIN(xb_ld(&bar[XB_TOPGEN]) == tg, bar);
            __builtin_amdgcn_fence(__ATOMIC_ACQUIRE, "agent");
            xb_add(&bar[XB_XGEN(b.x)], 1u);
            asm volatile("s_waitcnt vmcnt(0)" ::: "memory");
        } else {
            XB_SPIN(xb_ld(&bar[XB_XGEN(b.x)]) == gen, bar);
            __builtin_amdgcn_fence(__ATOMIC_ACQUIRE, "agent");
            asm volatile("s_waitcnt vmcnt(0)" ::: "memory");
        }
    }
    __syncthreads();
}
namespace attn_body {
using bf16=__hip_bfloat16;
using bf16x8=__attribute__((ext_vector_type(8)))short;
using s16x4=__attribute__((ext_vector_type(4)))short;
using f32x16=__attribute__((ext_vector_type(16)))float;
using u32x4=__attribute__((ext_vector_type(4)))unsigned;
constexpr int BATCH=8,NHEAD=8,NKVH=2,SEQ=4096,D=64;
constexpr int DMQ=512,DMK=128,DMV=2048,DMO=1024;
constexpr int NW=8,QBLK=32,QB=QBLK*NW,KVBLK=64,NQB=SEQ/QB;
constexpr int ATTN_UNIT_ROWS=QB;
__device__ __forceinline__ int crow(int r,int hi){return (r&3)+8*(r>>2)+4*hi;}
#define SBAR() __builtin_amdgcn_sched_barrier(0)
__device__ __forceinline__ void cmask(f32x16&p0,f32x16&p1,int jb,int qrel,int hi){
  const float NEG=-INFINITY; int kb=64*jb+4*hi;
  #pragma unroll
  for(int r=0;r<16;++r){int kv=kb+(r&3)+8*(r>>2); if(kv>qrel)p0[r]=NEG; if(kv+32>qrel)p1[r]=NEG;}
}

constexpr int NSLOT=3, SLOTB=8192;
constexpr int LDS_K=0, LDS_V=NSLOT*SLOTB, LDS_WS=2*NSLOT*SLOTB, LDS_OST=LDS_WS+NW*64*4, LDS_BYTES=LDS_OST+NW*4096;
constexpr float C2=0.125f*1.4426950408889634f;
__device__ __forceinline__ void glds16(const void*gsrc,unsigned lds_dst){unsigned keep;
  asm volatile("s_mov_b32 %0, m0\n\ts_mov_b32 m0, %2\n\ts_nop 0\n\tglobal_load_lds_dwordx4 %1, off\n\ts_mov_b32 m0, %0":"=&s"(keep):"v"(gsrc),"s"(lds_dst):"memory");}
__device__ __forceinline__ float max3f(float a,float b,float c){float r;asm("v_max3_f32 %0, %1, %2, %3":"=v"(r):"v"(a),"v"(b),"v"(c));return r;}
__device__ __forceinline__ float max2f(float a,float b){float r;asm("v_max_f32_e32 %0, %1, %2":"=v"(r):"v"(a),"v"(b));return r;}
__device__ __forceinline__ float fadd_s(float a,float b){float r;asm("v_add_f32_e32 %0, %1, %2":"=v"(r):"v"(a),"v"(b));return r;}
__device__ __forceinline__ float fsub_s(float a,float b){float r;asm("v_sub_f32_e32 %0, %1, %2":"=v"(r):"v"(a),"v"(b));return r;}
typedef float f32x2_t __attribute__((ext_vector_type(2))); typedef __bf16 bf16x2_t __attribute__((ext_vector_type(2)));
__device__ __forceinline__ unsigned cvtpk_s(float lo,float hi){f32x2_t v={lo,hi};bf16x2_t b=__builtin_convertvector(v,bf16x2_t);return __builtin_bit_cast(unsigned,b);}
#define WAIT_BAR(N) asm volatile("s_waitcnt vmcnt(" #N ") lgkmcnt(0)\n\ts_barrier":::"memory")

__device__ __forceinline__ void qkt(f32x16&p0,f32x16&p1,const char*Kslot,const bf16x8*qr,const f32x16&negm,int r32,int hi){
  const char*kb=Kslot+hi*1024+r32*16;
  #pragma unroll
  for(int d0=0;d0<4;++d0){
    const bf16x8 b0=*reinterpret_cast<const bf16x8*>(kb+d0*2048);
    const bf16x8 b1=*reinterpret_cast<const bf16x8*>(kb+d0*2048+512);
    if(d0==0){p0=__builtin_amdgcn_mfma_f32_32x32x16_bf16(b0,qr[0],negm,0,0,0);p1=__builtin_amdgcn_mfma_f32_32x32x16_bf16(b1,qr[0],negm,0,0,0);}
    else{p0=__builtin_amdgcn_mfma_f32_32x32x16_bf16(b0,qr[d0],p0,0,0,0);p1=__builtin_amdgcn_mfma_f32_32x32x16_bf16(b1,qr[d0],p1,0,0,0);}}
}
typedef __attribute__((address_space(3))) const char* lds_cptr;
typedef short v4i16_t __attribute__((ext_vector_type(4)));
__device__ __forceinline__ void kload8(bf16x8*kf,lds_cptr kp){
  kf[0]=*(const __attribute__((address_space(3))) bf16x8*)(kp);      kf[1]=*(const __attribute__((address_space(3))) bf16x8*)(kp+512);
  kf[2]=*(const __attribute__((address_space(3))) bf16x8*)(kp+2048); kf[3]=*(const __attribute__((address_space(3))) bf16x8*)(kp+2560);
  kf[4]=*(const __attribute__((address_space(3))) bf16x8*)(kp+4096); kf[5]=*(const __attribute__((address_space(3))) bf16x8*)(kp+4608);
  kf[6]=*(const __attribute__((address_space(3))) bf16x8*)(kp+6144); kf[7]=*(const __attribute__((address_space(3))) bf16x8*)(kp+6656);
}
__device__ __forceinline__ void kload2(bf16x8*kf,lds_cptr kp,int j){ kf[2*j]=*(const __attribute__((address_space(3))) bf16x8*)(kp+j*2048); kf[2*j+1]=*(const __attribute__((address_space(3))) bf16x8*)(kp+j*2048+512); }
__device__ __forceinline__ s16x4 vtr(lds_cptr p){ return __builtin_bit_cast(s16x4,__builtin_amdgcn_ds_read_tr16_b64_v4i16((__attribute__((address_space(3))) v4i16_t*)p)); }
__device__ __forceinline__ float rowmax(const f32x16&p0,const f32x16&p1){
  float a=max3f(p0[0],p0[1],p1[0]),b=max3f(p0[2],p0[3],p1[1]);a=max3f(a,p1[2],p1[3]);
  #pragma unroll
  for(int r=4;r<16;r+=4){a=max3f(a,p0[r],p0[r+1]);b=max3f(b,p0[r+2],p0[r+3]);a=max3f(a,p1[r],p1[r+1]);b=max3f(b,p1[r+2],p1[r+3]);}
  const float m=max2f(a,b);
  auto rr=__builtin_amdgcn_permlane32_swap(__float_as_uint(m),__float_as_uint(m),false,false);
  return max2f(__uint_as_float(rr[0]),__uint_as_float(rr[1]));
}
__device__ __forceinline__ void pv(f32x16*o,int vb,bf16x8 pa0,bf16x8 pa1,bf16x8 pa2,bf16x8 pa3){
  #pragma unroll
  for(int d0=0;d0<2;++d0){s16x4 lo[4],hi[4];
    #pragma unroll
    for(int ks=0;ks<4;++ks){
      asm volatile("ds_read_b64_tr_b16 %0,%1 offset:%c2":"=&v"(lo[ks]):"v"(vb),"i"(d0*4096+ks*1024):"memory");
      asm volatile("ds_read_b64_tr_b16 %0,%1 offset:%c2":"=&v"(hi[ks]):"v"(vb),"i"(d0*4096+ks*1024+512):"memory");}
    asm volatile("s_waitcnt lgkmcnt(0)":::"memory");SBAR();
    #define PK(k) (bf16x8){lo[k][0],lo[k][1],lo[k][2],lo[k][3],hi[k][0],hi[k][1],hi[k][2],hi[k][3]}
    o[d0]=__builtin_amdgcn_mfma_f32_32x32x16_bf16(pa0,PK(0),o[d0],0,0,0);
    o[d0]=__builtin_amdgcn_mfma_f32_32x32x16_bf16(pa1,PK(1),o[d0],0,0,0);
    o[d0]=__builtin_amdgcn_mfma_f32_32x32x16_bf16(pa2,PK(2),o[d0],0,0,0);
    o[d0]=__builtin_amdgcn_mfma_f32_32x32x16_bf16(pa3,PK(3),o[d0],0,0,0);
    #undef PK
  }
}

#ifndef ATTN_STORE16
#define ATTN_STORE16(p,v) (*(u32x4*)(p)=(v))
#endif
template<int THRL> __device__ __forceinline__ void attn_unit(int b,int h,int qb,const bf16*Q,const bf16*__restrict__ K,const bf16*__restrict__ V,bf16*O,char*shm){
  int tid_=threadIdx.x; asm volatile("":"+v"(tid_)); const int tid=tid_,lane=tid&63,r32=lane&31,hi=lane>>5; const int wid=__builtin_amdgcn_readfirstlane(tid>>6);
  const long rowbase=(long)b*SEQ; const int q0=qb*QB;
  const bf16*Qw=Q+(rowbase+q0+wid*QBLK)*DMQ+h*D; const int kvh=h>>2;
  const bf16*Kh=K+rowbase*DMK+kvh*D,*Vh=V+rowbase*DMV+kvh*D;
  const unsigned lds0=(unsigned)(uintptr_t)shm;
  float*wsf=(float*)(shm+LDS_WS)+wid*64;
  const bf16*ksrc=Kh+(long)lane*DMK+wid*8;
  const bf16*vsrc=Vh+(long)(16*(wid&3)+(lane>>2))*DMV+(wid>>2)*32+(lane&3)*8;
  const unsigned kdst=lds0+LDS_K+wid*1024, vdst=lds0+LDS_V+wid*1024;
  #define DMA_K(t,slot) glds16(ksrc+(long)(t)*KVBLK*DMK,(unsigned)__builtin_amdgcn_readfirstlane(kdst+(slot)))
  #define DMA_V(t,slot) glds16(vsrc+(long)(t)*KVBLK*DMV,(unsigned)__builtin_amdgcn_readfirstlane(vdst+(slot)))
  const int vb0=(int)(lds0+LDS_V)+((lane>>4)&1)*32+(lane&3)*8+(4*hi+((lane&15)>>2))*64;
  const char*Kbase=shm+LDS_K; bf16x8 kf[8];
  const lds_cptr shm3=(lds_cptr)shm; const lds_cptr kp0=shm3+LDS_K+hi*1024+r32*16; const lds_cptr vp0=shm3+LDS_V+((lane>>4)&1)*32+(lane&3)*8+(4*hi+((lane&15)>>2))*64;
  constexpr int NT=SEQ/KVBLK;
  DMA_K(0,0);DMA_V(0,0);DMA_K(1,SLOTB);
  bf16x8 qr[4];
  #pragma unroll
  for(int d0=0;d0<4;++d0)qr[d0]=*reinterpret_cast<const bf16x8*>(&Qw[(long)r32*DMQ+d0*16+hi*8]);
  float mhat=0.f,l_reg=0.f;f32x16 o[2];o[0]=f32x16{};o[1]=f32x16{};f32x16 negm=f32x16{};asm volatile("":"+v"(negm));
  #define CMASK(P0,P1,t) do{}while(0)
  bool resc=false;
  #define START(P0,P1) do{ const float rm=rowmax(P0,P1); resc=false; \
    { const float dl=rm; mhat=fadd_s(mhat,dl); \
      _Pragma("unroll") for(int r=0;r<16;++r){P0[r]=fsub_s(P0[r],dl);P1[r]=fsub_s(P1[r],dl);} \
      _Pragma("unroll") for(int r=0;r<16;++r)negm[r]=-mhat; asm volatile("":"+v"(negm)); } \
    _Pragma("unroll") for(int r=0;r<16;++r)P0[r]=__builtin_amdgcn_exp2f(P0[r]); }while(0)
  #define RESC() do{ if(resc){ asm volatile("s_waitcnt lgkmcnt(0)":::"memory"); \
      _Pragma("unroll") for(int d_=0;d_<2;++d_) _Pragma("unroll") for(int r=0;r<16;++r)o[d_][r]*=wsf[crow(r,hi)]; } }while(0)
  f32x16 pA0,pA1,pB0,pB1;
  int sl_prev=0,sl_cur=0,sl_next=SLOTB;
  #define ROT() do{sl_prev=sl_cur;sl_cur=sl_next;sl_next=(sl_next==(NSLOT-1)*SLOTB)?0:sl_next+SLOTB;}while(0)
  DMA_K(2,2*SLOTB);
  WAIT_BAR(3);
  qkt(pA0,pA1,Kbase,qr,negm,r32,hi);asm volatile("s_nop 15\n\ts_nop 7":"+v"(pA0),"+v"(pA1));CMASK(pA0,pA1,0);
  START(pA0,pA1);
  _Pragma("unroll") for(int r=0;r<16;++r)pA1[r]=__builtin_amdgcn_exp2f(pA1[r]);
  WAIT_BAR(0);
  DMA_K(3,0);DMA_V(1,SLOTB);
  ROT();
  kload8(kf,kp0+sl_cur);
  WAIT_BAR(2);
  s16x4 vlo[8],vhi[8]; u32x4 pw0,pw1,pw2,pw3;
  #define PKW(P,B) cvtpk_s(P[B],P[B+1])
  #define PAF(k) __builtin_bit_cast(bf16x8,pw##k)
  #define VFR(i) (bf16x8){vlo[i][0],vlo[i][1],vlo[i][2],vlo[i][3],vhi[i][0],vhi[i][1],vhi[i][2],vhi[i][3]}
  #define PIN(x) asm volatile("":"+v"(x))
  #define MX3(a,b,c) __builtin_fmaxf(__builtin_fmaxf((a),(b)),(c))
  #define GAPA(MF,A0,A1,A2,A3,W0,W1,PW) do{ MF; sacc+=A0; sacc+=A1; sacc+=A2; sacc+=A3; PIN(sacc); W0; W1; PIN(PW); SBAR(); }while(0)
  #define EX(v) __builtin_amdgcn_exp2f(v)
  #define GAPB(MF,X,B) do{ MF; X[B]=EX(X[B]); X[B+1]=EX(X[B+1]); X[B+2]=EX(X[B+2]); X[B+3]=EX(X[B+3]); PIN(X); SBAR(); }while(0)
  #define VRD(i) do{ vlo[i]=vtr(vp_+(((i)>>2)*4096+((i)&3)*1024)); vhi[i]=vtr(vp_+(((i)>>2)*4096+((i)&3)*1024+512)); }while(0)
  #define KRD(G,j) do{ if(G){ kload2(kf,kp0+sl_next,j); SBAR(); } }while(0)
  #define STEP(C0,C1,P0,P1,t,GK,GV,GL) do{ SBAR(); \
    const lds_cptr vp_=vp0+sl_prev; \
    VRD(0); SBAR(); float sacc=(P0[0]+P0[1]); \
    GAPA(C0=__builtin_amdgcn_mfma_f32_32x32x16_bf16(kf[0],qr[0],negm,0,0,0), P0[2],P0[3],P0[4],P0[5],     pw0[0]=PKW(P0,0), pw0[1]=PKW(P0,2), pw0); \
    VRD(4); SBAR(); GAPA(C1=__builtin_amdgcn_mfma_f32_32x32x16_bf16(kf[1],qr[0],negm,0,0,0), P0[6],P0[7],P0[8],P0[9],     pw0[2]=PKW(P0,4), pw0[3]=PKW(P0,6), pw0); \
    VRD(1); SBAR(); GAPA(C0=__builtin_amdgcn_mfma_f32_32x32x16_bf16(kf[2],qr[1],C0,0,0,0),   P0[10],P0[11],P0[12],P0[13], pw1[0]=PKW(P0,8), pw1[1]=PKW(P0,10), pw1); \
    VRD(5); SBAR(); GAPA(C1=__builtin_amdgcn_mfma_f32_32x32x16_bf16(kf[3],qr[1],C1,0,0,0),   P0[14],P0[15],P1[0],P1[1],   pw1[2]=PKW(P0,12),pw1[3]=PKW(P0,14), pw1); \
    VRD(2); SBAR(); GAPA(C0=__builtin_amdgcn_mfma_f32_32x32x16_bf16(kf[4],qr[2],C0,0,0,0),   P1[2],P1[3],P1[4],P1[5],     pw2[0]=PKW(P1,0), pw2[1]=PKW(P1,2), pw2); \
    VRD(6); SBAR(); GAPA(C1=__builtin_amdgcn_mfma_f32_32x32x16_bf16(kf[5],qr[2],C1,0,0,0),   P1[6],P1[7],P1[8],P1[9],     pw2[2]=PKW(P1,4), pw2[3]=PKW(P1,6), pw2); \
    VRD(3); SBAR(); GAPA(C0=__builtin_amdgcn_mfma_f32_32x32x16_bf16(kf[6],qr[3],C0,0,0,0),   P1[10],P1[11],P1[12],P1[13], pw3[0]=PKW(P1,8), pw3[1]=PKW(P1,10), pw3); \
    VRD(7); SBAR(); GAPA(C1=__builtin_amdgcn_mfma_f32_32x32x16_bf16(kf[7],qr[3],C1,0,0,0),   P1[14],P1[15],0.f,0.f,       pw3[2]=PKW(P1,12),pw3[3]=PKW(P1,14), pw3); \
    l_reg+=sacc; \
    if(GK){DMA_K((t)+3,sl_cur);} if(GV){DMA_V((t)+1,sl_next);} \
    CMASK(C0,C1,t); \
    { float a=MX3(C0[0],C0[1],C1[0]),b=MX3(C0[2],C0[3],C1[1]); a=MX3(a,C1[2],C1[3]); \
      _Pragma("unroll") for(int r=4;r<16;r+=4){a=MX3(a,C0[r],C0[r+1]);b=MX3(b,C0[r+2],C0[r+3]);a=MX3(a,C1[r],C1[r+1]);b=MX3(b,C1[r+2],C1[r+3]);} \
      float rm=__builtin_fmaxf(a,b); { auto rr=__builtin_amdgcn_permlane32_swap(__float_as_uint(rm),__float_as_uint(rm),false,false); rm=__builtin_fmaxf(__uint_as_float(rr[0]),__uint_as_float(rr[1])); } \
      resc=false; \
      if(__builtin_expect(__any(rm>(float)THRL),0)){ const float dl=__builtin_fmaxf(rm,0.f); mhat+=dl; \
        _Pragma("unroll") for(int r=0;r<16;++r){C0[r]-=dl;C1[r]-=dl;} \
        _Pragma("unroll") for(int r=0;r<16;++r)negm[r]=-mhat; asm volatile("":"+v"(negm)); \
        const float f=__builtin_amdgcn_exp2f(-dl); l_reg*=f; if(hi==0)wsf[r32]=f; resc=true; } } \
    SBAR(); \
    GAPB(o[0]=__builtin_amdgcn_mfma_f32_32x32x16_bf16(PAF(0),VFR(0),o[0],0,0,0), C0,0); \
    GAPB(o[1]=__builtin_amdgcn_mfma_f32_32x32x16_bf16(PAF(0),VFR(4),o[1],0,0,0), C0,4); \
    KRD(GL,0); GAPB(o[0]=__builtin_amdgcn_mfma_f32_32x32x16_bf16(PAF(1),VFR(1),o[0],0,0,0), C0,8); \
    KRD(GL,1); GAPB(o[1]=__builtin_amdgcn_mfma_f32_32x32x16_bf16(PAF(1),VFR(5),o[1],0,0,0), C0,12); \
    KRD(GL,2); GAPB(o[0]=__builtin_amdgcn_mfma_f32_32x32x16_bf16(PAF(2),VFR(2),o[0],0,0,0), C1,0); \
    KRD(GL,3); GAPB(o[1]=__builtin_amdgcn_mfma_f32_32x32x16_bf16(PAF(2),VFR(6),o[1],0,0,0), C1,4); \
    GAPB(o[0]=__builtin_amdgcn_mfma_f32_32x32x16_bf16(PAF(3),VFR(3),o[0],0,0,0), C1,8); \
    GAPB(o[1]=__builtin_amdgcn_mfma_f32_32x32x16_bf16(PAF(3),VFR(7),o[1],0,0,0), C1,12); \
    }while(0)
  int t=1;
  #undef CMASK
  #define CMASK(P0,P1,t) do{}while(0)
  for(;t+5<NT;t+=2){
    STEP(pB0,pB1,pA0,pA1,t,true,true,true);     WAIT_BAR(2); RESC(); ROT();
    STEP(pA0,pA1,pB0,pB1,t+1,true,true,true);   WAIT_BAR(2); RESC(); ROT();
  }
  #undef CMASK
  #define CMASK(P0,P1,t) do{}while(0)
  #define ENDW(tt) do{ if((tt)+3<NT){WAIT_BAR(2);} else if((tt)+2<NT){WAIT_BAR(1);} else {WAIT_BAR(0);} }while(0)
  for(;t+1<NT;t+=2){
    STEP(pB0,pB1,pA0,pA1,t,(t+3<NT),(t+1<NT),(t+1<NT));       ENDW(t);   RESC(); ROT();
    STEP(pA0,pA1,pB0,pB1,t+1,(t+4<NT),(t+2<NT),(t+2<NT));     ENDW(t+1); RESC(); ROT();
  }
  STEP(pB0,pB1,pA0,pA1,NT-1,false,false,false); RESC();
  { float sacc=pB0[0]+pB0[1]; _Pragma("unroll") for(int r=2;r<16;++r)sacc+=pB0[r]; _Pragma("unroll") for(int r=0;r<16;++r)sacc+=pB1[r]; l_reg+=sacc;
    pw0=(u32x4){PKW(pB0,0),PKW(pB0,2),PKW(pB0,4),PKW(pB0,6)};pw1=(u32x4){PKW(pB0,8),PKW(pB0,10),PKW(pB0,12),PKW(pB0,14)};pw2=(u32x4){PKW(pB1,0),PKW(pB1,2),PKW(pB1,4),PKW(pB1,6)};pw3=(u32x4){PKW(pB1,8),PKW(pB1,10),PKW(pB1,12),PKW(pB1,14)};
    SBAR(); pv(o,vb0+sl_cur,PAF(0),PAF(1),PAF(2),PAF(3)); }
  #undef PKW
  #undef PAF
  #undef VFR
  #undef PIN
  #undef MX3
  #undef GAPA
  #undef GAPB
  #undef EX
  #undef VRD
  #undef KRD
  #undef STEP
  #undef ENDW
  {auto rr=__builtin_amdgcn_permlane32_swap(__float_as_uint(l_reg),__float_as_uint(l_reg),false,false);l_reg=__uint_as_float(rr[0])+__uint_as_float(rr[1]);}
  if(hi==0)wsf[32+r32]=l_reg;asm volatile("s_waitcnt lgkmcnt(0)":::"memory");
  float rli[16];
  #pragma unroll
  for(int r=0;r<16;++r)rli[r]=__builtin_amdgcn_rcpf(wsf[32+crow(r,hi)]);
  bf16*Ow=O+(rowbase+q0+wid*QBLK)*DMO+h*D;
  { bf16*stg=(bf16*)(shm+LDS_OST)+wid*2048;
    #pragma unroll
    for(int r=0;r<16;++r){const int orow=crow(r,hi);
      #pragma unroll
      for(int d0=0;d0<2;++d0)stg[orow*64+d0*32+r32]=__float2bfloat16(o[d0][r]*rli[r]);}
    asm volatile("s_waitcnt lgkmcnt(0)":::"memory");
    #pragma unroll
    for(int i=0;i<4;++i){const int row=i*8+(lane>>3),ch=lane&7; const u32x4 v=*(const u32x4*)(stg+row*64+ch*8); ATTN_STORE16(Ow+(long)row*DMO+ch*8,v);} }
  asm volatile("s_waitcnt lgkmcnt(0)\n\ts_barrier":::"memory");
  #undef DMA_K
  #undef DMA_V
  #undef CMASK
  #undef START
  #undef RESC
  #undef ROT
}
constexpr int ATTN_LDS_BYTES=LDS_BYTES;
struct AttnTensors { const bf16* Q; const bf16* K; const bf16* V; bf16* O; };
struct AttnUnit { int bh; int qb; };
struct StaticOrder {
  int vcu, G;
  __device__ __forceinline__ explicit StaticOrder(int grid,int block):vcu((grid%8==0)?(block%8)*(grid/8)+block/8:block),G(grid){}
  __device__ __forceinline__ bool next(int i,AttnUnit&u)const{ const int per=(BATCH*NHEAD*NQB+G-1)/G; if(i>=per)return false; const int idx=vcu*per+i; if(idx>=BATCH*NHEAD*NQB)return false;
    const int qb=idx%NQB, hq=(idx/NQB)&3, bk=idx/(NQB*4), kvh=bk&1, b=bk>>1; u.bh=b*NHEAD+kvh*4+hq; u.qb=qb; return true; }
  __device__ __forceinline__ void a_ready(const AttnUnit&)const{}
  __device__ __forceinline__ void done(const AttnUnit&)const{}
};
template<class Sched,int THRL=8> __device__ __forceinline__ void attn_phase(char*lds,const AttnTensors&T,const Sched&S){
  AttnUnit u;
  for(int i=0;S.next(i,u);++i){ S.a_ready(u); attn_unit<THRL>(u.bh/NHEAD,u.bh%NHEAD,u.qb,T.Q,T.K,T.V,T.O,lds); S.done(u); }
}
#undef SBAR
#undef WAIT_BAR
}
constexpr int NB = 8, SEQ = 4096, DM = 1024, NL = 4, NTOK = NB * SEQ;
constexpr int INW = 1824, INP = 2048;
constexpr int C_AQ = 0, C_AK = 512, C_AV = 640, C_GQ = 768, C_GK = 896, C_GV = 1024, C_GR = 1280, C_FX = 1536, C_GLR = 1792;
constexpr int NE = 32, TOPK = 4, DE = 1024;
constexpr int MPAD = NTOK * TOPK + NE * 256;
constexpr float LN_EPS = 1e-5f, RMS_EPS = 1e-6f;
constexpr float DN_ALPHA = 1.681792830507429f;
constexpr float QSCALE = 0.125f * 1.4426950408889634f;
constexpr float GLA_QSCALE = 0.17677669529663687f;

constexpr size_t MiB = 1u << 20;
constexpr size_t WS_CTL = 0, CTL_ZERO_BYTES = 1 * MiB;
constexpr size_t WS_ROPE = 1 * MiB;
constexpr size_t WS_WIN_T = 2 * MiB;
constexpr size_t WS_WOUT_T = 18 * MiB;
constexpr size_t WS_ADFT = 26 * MiB;
constexpr size_t WS_WGU_T = 90 * MiB;
constexpr size_t WS_WDN_T = 602 * MiB;
constexpr size_t WS_HF = 858 * MiB;
constexpr size_t WS_HB = 986 * MiB;
constexpr size_t WS_PROJ = 1050 * MiB;
constexpr size_t WS_QB = 1178 * MiB;
constexpr size_t WS_KB = 1210 * MiB;
constexpr size_t WS_MIX = 1218 * MiB;
constexpr size_t WS_T1 = 1282 * MiB;
constexpr size_t WS_UVT = 1410 * MiB;
constexpr size_t WS_LA = 1442 * MiB;
constexpr size_t WS_OF = 1474 * MiB;
constexpr size_t WS_OB = 1506 * MiB;
constexpr size_t WS_TOK = 1538 * MiB;
constexpr size_t WS_XS = 1542 * MiB;
constexpr size_t WS_HID = 1814 * MiB;
constexpr size_t WS_YS = 2086 * MiB;
constexpr size_t WS_END = 2358 * MiB;
static_assert((size_t)MPAD * 2048 == 272 * MiB, "sorted buffers");
constexpr int CW_TMO = 0, CW_CODE = 1, CW_BAR = 4096, CW_CNT = 8192;

constexpr int RING_OFF = 0, RING_BYTES = 131072;
constexpr int LDSCTL_OFF = RING_BYTES;
constexpr int LDS_BYTES = 147456;
constexpr int LC_MISC = 0;
constexpr int LC_PSTART = 128;
constexpr int LC_ULIST = 384;
constexpr int LC_CNT = 640;
constexpr int LC_BASE = 768;
constexpr int LC_SELE = 1024;
constexpr int LC_SELS = 1024 + 2048;
constexpr int LC_COS64 = 5120;

constexpr int NWAVES = 8;
constexpr int N_PHASES = 1 + 10 * NL;

__device__ __forceinline__ float bf2f(unsigned short b) { return __uint_as_float((unsigned)b << 16); }
__device__ __forceinline__ float wave_sum(float v) {
#pragma unroll
    for (int o = 1; o < 64; o <<= 1) v += __shfl_xor(v, o);
    return v;
}
typedef unsigned short u16x8 __attribute__((ext_vector_type(8)));
typedef unsigned short u16x4 __attribute__((ext_vector_type(4)));

__device__ __forceinline__ void tr_item(const float* W, int K, int Nsrc, int src_n0, bf16* WT, int dst_n0, int k0, LAS float* scr, int lane) {
    if (src_n0 >= 0) {
#pragma unroll 8
        for (int i = 0; i < 32; ++i) { const int kk = 2 * i + (lane >> 5); scr[kk * 33 + (lane & 31)] = W[(size_t)(k0 + kk) * Nsrc + src_n0 + (lane & 31)]; }
    } else {
#pragma unroll 8
        for (int i = 0; i < 32; ++i) { const int kk = 2 * i + (lane >> 5); scr[kk * 33 + (lane & 31)] = 0.f; }
    }
    LDS_WAIT(); asm volatile("" ::: "memory");
    const int c = lane & 7;
#pragma unroll
    for (int j = 0; j < 4; ++j) { const int n = (lane >> 3) + 8 * j; const LAS float* s = scr + (8 * c) * 33 + n;
        v4u o; o.x = pk2(s[0 * 33], s[1 * 33]); o.y = pk2(s[2 * 33], s[3 * 33]); o.z = pk2(s[4 * 33], s[5 * 33]); o.w = pk2(s[6 * 33], s[7 * 33]);
        *(v4u*)(WT + (size_t)(dst_n0 + n) * K + k0 + 8 * c) = o; }
    LDS_WAIT(); asm volatile("" ::: "memory");
}

__device__ __forceinline__ void ln_row(f32x4 (&v)[4], const float* g, const float* bt, float* of32, bf16* obf, int lane) {
    float s = 0.f;
#pragma unroll
    for (int j = 0; j < 4; ++j) s += (v[j].x + v[j].y) + (v[j].z + v[j].w);
    const float mean = wave_sum(s) * (1.f / DM); float s2 = 0.f;
#pragma unroll
    for (int j = 0; j < 4; ++j) { v[j] = v[j] - mean; s2 += (v[j].x * v[j].x + v[j].y * v[j].y) + (v[j].z * v[j].z + v[j].w * v[j].w); }
    const float rstd = 1.f / sqrtf(wave_sum(s2) * (1.f / DM) + LN_EPS);
#pragma unroll
    for (int j = 0; j < 4; ++j) { const f32x4 gg = *(const f32x4*)(g + lane * 4 + 256 * j), bb = *(const f32x4*)(bt + lane * 4 + 256 * j);
        v[j] = v[j] * rstd * gg + bb;
        if (of32) *(f32x4*)(of32 + lane * 4 + 256 * j) = v[j];
        if (obf) *(unsigned long long*)(obf + lane * 4 + 256 * j) = (unsigned long long)pk2(v[j].x, v[j].y) | ((unsigned long long)pk2(v[j].z, v[j].w) << 32); }
}


constexpr int GL_QF = 0, GL_KF = 2112, GL_QB = 4224, GL_KB = 6336, GL_BC = 8448, GL_V = 12672, GL_P = 16768, GL_HF = 20928, GL_HB = 22976, GL_END = 25024;
static_assert(GL_END * 4 <= RING_BYTES, "GLA chunk image fits the ring region");
__device__ __forceinline__ void gla_stage(LAS float* L, const bf16* PROJ, const float* LA, size_t tok0, int hd, int tid) {
    __syncthreads();
#pragma unroll
    for (int r = 0; r < 8; ++r) { const int idx = tid + 512 * r, dir = idx >> 11, j = (idx >> 5) & 63, d = idx & 31; L[GL_BC + dir * 2112 + j * 33 + d] = LA[(tok0 + j) * 256 + dir * 128 + hd * 32 + d]; }
    { const int j = tid >> 3, v0 = (tid & 7) * 8; const u16x8 f = *(const u16x8*)(PROJ + (tok0 + j) * INP + C_GV + hd * 64 + v0);
#pragma unroll
      for (int i = 0; i < 8; ++i) L[GL_V + j * 64 + v0 + i] = bf2f(f[i]); }
    const int qj = tid >> 3, qd = (tid & 7) * 4;
    const u16x4 q4 = *(const u16x4*)(PROJ + (tok0 + qj) * INP + C_GQ + hd * 32 + qd), k4 = *(const u16x4*)(PROJ + (tok0 + qj) * INP + C_GK + hd * 32 + qd);
    __syncthreads();
    if (tid < 64) { const int dir = tid >> 5, d = tid & 31; LAS float* p = L + GL_BC + dir * 2112 + d; float acc = 0.f;
        if (dir == 0) { for (int j = 0; j < 64; ++j) { acc += p[j * 33]; p[j * 33] = acc; } }
        else { for (int j = 63; j >= 0; --j) { acc += p[j * 33]; p[j * 33] = acc; } } }
    __syncthreads();
#pragma unroll
    for (int i = 0; i < 4; ++i) { const float bf_ = L[GL_BC + qj * 33 + qd + i], bb_ = L[GL_BC + 2112 + qj * 33 + qd + i]; const float qv = bf2f(q4[i]) * GLA_QSCALE, kv = bf2f(k4[i]);
        L[GL_QF + qj * 33 + qd + i] = qv * expf(bf_); L[GL_KF + qj * 33 + qd + i] = kv * expf(-bf_); L[GL_QB + qj * 33 + qd + i] = qv * expf(bb_); L[GL_KB + qj * 33 + qd + i] = kv * expf(-bb_); }
    __syncthreads();
}

struct Args { const float* in[20]; float* out; unsigned char* ws; int ph_lo, ph_hi; };
static_assert(sizeof(Args) == 20 * 8 + 8 + 8 + 8, "no padding bytes in Args");


typedef __attribute__((address_space(4))) const unsigned char* kptr_t;
__device__ __forceinline__ kptr_t karg() { kptr_t p = (kptr_t)__builtin_amdgcn_kernarg_segment_ptr(); asm volatile("" : "+s"(p)); return p; }
#define KIN(i) (*(const float* const __attribute__((address_space(4)))*)(karg() + 8 * (i)))
#define KOUT() (*(float* const __attribute__((address_space(4)))*)(karg() + 160))
#define KWS() (*(unsigned char* const __attribute__((address_space(4)))*)(karg() + 168))
#define WSP(T, off) ((T*)(ws + (off)))

#ifndef NAIVE_ATTN
#define NAIVE_ATTN 0
#endif

__global__ void __launch_bounds__(NWAVES * 64, 2) fwd(Args args) {
    extern __shared__ __attribute__((aligned(16))) unsigned char lds_raw[];
    LAS unsigned char* lds = (LAS unsigned char*)lds_raw;
    LAS unsigned char* lctl = lds + LDSCTL_OFF;
    const int G = gridDim.x, bx = blockIdx.x;
    const int NGW = G * NWAVES, NGT = G * NWAVES * 64;
#define TID_SETUP() int tid_ = threadIdx.x; asm volatile("" : "+v"(tid_)); const int tid = tid_, lane = tid & 63, wave = __builtin_amdgcn_readfirstlane(tid >> 6); \
    const int gw = bx * NWAVES + wave, gt = bx * (NWAVES * 64) + tid; (void)lane; (void)gw; (void)gt
    for (int u = threadIdx.x; u < (LDS_BYTES - LDSCTL_OFF) / 4; u += NWAVES * 64) ((LAS unsigned*)lctl)[u] = 0u;
    __syncthreads();
    volatile LAS unsigned* MISC = (volatile LAS unsigned*)(lctl + LC_MISC);
    XcdBarrier bar = xcd_barrier_post((unsigned*)(KWS() + WS_CTL) + CW_BAR, MISC + 8);
    const int lo = args.ph_lo, hi = args.ph_hi;
#ifndef PH_OFF
#define PH_OFF 0
#endif
#define PON(j) (!((PH_OFF >> (j)) & 1))
#define IN(k) (lo <= (k) && (k) < hi)
#define SEAM(k) do { if (IN(k) && IN((k) + 1)) xcd_barrier(bar); } while (0)

    if (IN(0) && PON(0)) {
        TID_SETUP(); unsigned char* ws = KWS(); const float* x_in = KIN(0); const float* ln_in_g = KIN(1); const float* ln_in_b = KIN(2); const float* w_in = KIN(3); const float* w_out = KIN(9);
        const float* exp_w_gu = KIN(14); const float* exp_w_down = KIN(16);
        float* ROPE = WSP(float, WS_ROPE); bf16* WIN_T = WSP(bf16, WS_WIN_T); bf16* WOUT_T = WSP(bf16, WS_WOUT_T); bf16* ADFT = WSP(bf16, WS_ADFT); bf16* WGU_T = WSP(bf16, WS_WGU_T); bf16* WDN_T = WSP(bf16, WS_WDN_T);
        float* HF = WSP(float, WS_HF); bf16* HB = WSP(bf16, WS_HB);
        LAS float* scr = (LAS float*)(lds + RING_OFF + wave * 16384);
        constexpr int I_WIN = NL * 64 * 16, I_WOUT = NL * 32 * 16, I_WGU = NL * NE * 64 * 16, I_WDN = NL * NE * 32 * 16;
        constexpr int NITEMS = I_WIN + I_WOUT + I_WGU + I_WDN;
        for (int it = gw; it < NITEMS; it += NGW) {
            int r = it;
            if (r < I_WIN) { const int l = r / 1024, q = r % 1024, kb = q / 64, nb = q % 64, n0 = nb * 32;
                const int src = n0 < 1536 ? n0 : (n0 < 1792 ? n0 + 32 : (n0 < 1824 ? n0 - 256 : -1));
                tr_item(w_in + (size_t)l * DM * INW, DM, INW, src, WIN_T + (size_t)l * INP * DM, n0, kb * 64, scr, lane); continue; }
            r -= I_WIN;
            if (r < I_WOUT) { const int l = r / 512, q = r % 512, kb = q / 32, nb = q % 32;
                tr_item(w_out + (size_t)l * DM * DM, DM, DM, nb * 32, WOUT_T + (size_t)l * DM * DM, nb * 32, kb * 64, scr, lane); continue; }
            r -= I_WOUT;
            if (r < I_WGU) { const int le = r / 1024, q = r % 1024, kb = q / 64, nb = q % 64, n0 = nb * 32;
                const int pn = n0 >> 8, bj = (n0 >> 7) & 1, j = n0 & 127, src = bj * 1024 + pn * 128 + j;
                tr_item(exp_w_gu + (size_t)le * DM * 2048, DM, 2048, src, WGU_T + (size_t)le * 2048 * DM, n0, kb * 64, scr, lane); continue; }
            r -= I_WGU;
            { const int le = r / 512, q = r % 512, kb = q / 32, nb = q % 32;
                tr_item(exp_w_down + (size_t)le * DE * DM, DE, DM, nb * 32, WDN_T + (size_t)le * DM * DE, nb * 32, kb * 64, scr, lane); }
        }
        for (int it = gt; it < 4096 * 1024; it += NGT) { const int sp = it >> 10, c8 = (it & 1023) * 8; const int half = c8 >> 12, s0 = c8 & 4095;
            float vals[8];
#pragma unroll
            for (int i = 0; i < 8; ++i) { const int m = ((s0 + i) * sp) & 4095; float sn, cs; sincospif((float)m * (1.0f / 2048.0f), &sn, &cs); vals[i] = (half ? -sn : cs) * (1.0f / 512.0f); }
            v4u o; o.x = pk2(vals[0], vals[1]); o.y = pk2(vals[2], vals[3]); o.z = pk2(vals[4], vals[5]); o.w = pk2(vals[6], vals[7]);
            *(v4u*)(ADFT + (size_t)sp * 8192 + c8) = o; }
        for (int it = gt; it < SEQ * 32; it += NGT) { const int t = it >> 5, i = it & 31, a = i >> 4, f = i & 15; const int pos = a ? (t & 63) : (t >> 6);
            const double inv = exp(-9.210340371976184 * (double)f / 16.0); const double ang = (double)pos * inv;
            ROPE[it] = (float)cos(ang); ROPE[SEQ * 32 + it] = (float)sin(ang); }
        for (int m = gw; m < NTOK; m += NGW) { f32x4 v[4];
#pragma unroll
            for (int j = 0; j < 4; ++j) v[j] = *(const f32x4*)(x_in + (size_t)m * DM + lane * 4 + 256 * j);
            ln_row(v, ln_in_g, ln_in_b, HF + (size_t)m * DM, HB + (size_t)m * DM, lane); }
    }
    SEAM(0);

    for (int l = 0; l < NL; ++l) {
        const int pb = 1 + 10 * l;
        if (IN(pb + 0) && PON(1)) {
            TID_SETUP(); unsigned char* ws = KWS(); bf16* HB = WSP(bf16, WS_HB); bf16* WIN_T = WSP(bf16, WS_WIN_T); bf16* PROJ = WSP(bf16, WS_PROJ);
            pg8::Gemm g{HB, WIN_T + (size_t)l * INP * DM, NTOK, INP, DM}; pg8::StaticOrder S; S.init(NTOK, INP, G, bx);
            pg8::EpiPlainBf16 E{PROJ, INP};
            pg8::gemm_phase<pg8::EpiPlainBf16, pg8::StaticOrder, true, true>(lds + RING_OFF, g, S, E);
        }
        SEAM(pb + 0);
        if (IN(pb + 1) && PON(2)) {
            TID_SETUP(); unsigned char* ws = KWS(); const float* att_q_gain = KIN(4); const float* att_k_gain = KIN(5); const float* gla_gate_w = KIN(6); const float* gla_gate_b = KIN(7);
            const float* ROPE = WSP(float, WS_ROPE); const bf16* PROJ = WSP(bf16, WS_PROJ); bf16* QB = WSP(bf16, WS_QB); bf16* KB = WSP(bf16, WS_KB); bf16* UVT = WSP(bf16, WS_UVT); float* LA = WSP(float, WS_LA);
            const float* qg = att_q_gain + l * 64; const float* kg = att_k_gain + l * 64;
            for (int m = gw; m < NTOK; m += NGW) { const int t = m & (SEQ - 1); const int ri = (lane >> 5) * 16 + (lane & 15);
                const float cs = ROPE[t * 32 + ri], sn = ROPE[SEQ * 32 + t * 32 + ri]; const float sg = ((lane >> 4) & 1) ? 1.f : -1.f;
#pragma unroll
                for (int h = 0; h < 10; ++h) { const float xv = bf2f(PROJ[(size_t)m * INP + h * 64 + lane]);
                    const float ms = wave_sum(xv * xv) * (1.f / 64.f); const float xn = xv * (1.f / sqrtf(ms + RMS_EPS)) * (h < 8 ? qg[lane] : kg[lane]);
                    const float pr = __shfl_xor(xn, 16); float o = xn * cs + sg * pr * sn;
                    if (h < 8) { o *= QSCALE; QB[(size_t)m * 512 + h * 64 + lane] = (bf16)f2bf(o); } else KB[(size_t)m * 128 + (h - 8) * 64 + lane] = (bf16)f2bf(o); } }
            { const float* gw_l = gla_gate_w + (size_t)l * 2 * 16 * 128; const float* gb_l = gla_gate_b + (size_t)l * 2 * 128;
              for (int m = gw; m < NTOK; m += NGW) { const float lr = (lane < 32) ? bf2f(PROJ[(size_t)m * INP + C_GLR + lane]) : 0.f;
                const int dir = lane >> 5, kc = (lane & 31) * 4; f32x4 z = *(const f32x4*)(gb_l + dir * 128 + kc);
#pragma unroll
                for (int r = 0; r < 16; ++r) { const float a = __shfl(lr, dir * 16 + r); const f32x4 w = *(const f32x4*)(gw_l + (size_t)(dir * 16 + r) * 128 + kc); z = z + w * a; }
                f32x4 o;
#pragma unroll
                for (int i = 0; i < 4; ++i) o[i] = (fminf(z[i], 0.f) - log1pf(expf(-fabsf(z[i])))) * (1.f / 16.f);
                *(f32x4*)(LA + (size_t)m * 256 + dir * 128 + kc) = o; } }
            { LAS float* c64 = (LAS float*)(lctl + LC_COS64);
              if (tid < 64) { float sn, cs; sincospif((float)tid * (1.0f / 32.0f), &sn, &cs); c64[tid] = cs; c64[64 + tid] = sn; }
              __syncthreads();
              for (int it = gt; it < NB * 256 * SEQ; it += NGT) { const int s = it & (SEQ - 1), bc = it >> 12, b = bc >> 8, ch = bc & 255, g4 = ch >> 6, cc = ch & 63;
                const bf16* src = PROJ + (size_t)(b * SEQ + s) * INP + C_FX + g4 * 64; float U = 0.f, V = 0.f;
#pragma unroll
                for (int c8 = 0; c8 < 8; ++c8) { const u16x8 f = *(const u16x8*)(src + c8 * 8);
#pragma unroll
                    for (int i = 0; i < 8; ++i) { const int k = ((c8 * 8 + i) * cc) & 63; const float fv = bf2f(f[i]); U += fv * c64[k]; V += fv * c64[64 + k]; } }
                UVT[(size_t)bc * 8192 + s] = (bf16)f2bf(U); UVT[(size_t)bc * 8192 + 4096 + s] = (bf16)f2bf(V); } }
            { LAS float* L = (LAS float*)(lds + RING_OFF); float* GS = WSP(float, WS_OF); float* GD = WSP(float, WS_OB);
              for (int u = bx; u < NB * 4 * 64; u += G) { const int c = u & 63, bh = u >> 6, hd = bh & 3, b = bh >> 2; const size_t tok0 = (size_t)b * SEQ + c * 64;
                gla_stage(L, PROJ, LA, tok0, hd, tid);
                const int dir = tid >> 8, d0 = ((tid >> 4) & 15) * 2, v0 = (tid & 15) * 4; const LAS float* Kd = L + (dir ? GL_KB : GL_KF);
                f32x4 a0 = {0.f, 0.f, 0.f, 0.f}, a1 = {0.f, 0.f, 0.f, 0.f};
#pragma unroll 8
                for (int j = 0; j < 64; ++j) { const float k0 = Kd[j * 33 + d0], k1 = Kd[j * 33 + d0 + 1]; const f32x4 vv = *(const LAS f32x4*)(L + GL_V + j * 64 + v0); a0 = a0 + vv * k0; a1 = a1 + vv * k1; }
                const int jl = dir ? 0 : 63; const float D0 = expf(L[GL_BC + dir * 2112 + jl * 33 + d0]), D1 = expf(L[GL_BC + dir * 2112 + jl * 33 + d0 + 1]);
                const size_t sidx = ((size_t)u * 2 + dir);
                *(f32x4*)(GS + sidx * 2048 + d0 * 64 + v0) = a0 * D0; *(f32x4*)(GS + sidx * 2048 + (d0 + 1) * 64 + v0) = a1 * D1;
                if ((tid & 15) == 0) { GD[sidx * 32 + d0] = D0; GD[sidx * 32 + d0 + 1] = D1; } }
              __syncthreads(); }
        }
        SEAM(pb + 1);
        if (IN(pb + 2) && PON(3)) {
            TID_SETUP(); unsigned char* ws = KWS(); float* GS = WSP(float, WS_OF); const float* GD = WSP(float, WS_OB);
            for (int e = gt; e < NB * 4 * 2 * 2048; e += NGT) { const int dv = e & 2047, dir = (e >> 11) & 1, bh = e >> 12, d = dv >> 6; float H = 0.f;
                for (int c8 = 0; c8 < 64; c8 += 8) { float sv[8], dd[8];
#pragma unroll
                    for (int i = 0; i < 8; ++i) { const int c = dir ? 63 - (c8 + i) : (c8 + i); const size_t sidx = ((size_t)(bh * 64 + c) * 2 + dir); sv[i] = GS[sidx * 2048 + dv]; dd[i] = GD[sidx * 32 + d]; }
#pragma unroll
                    for (int i = 0; i < 8; ++i) { const int c = dir ? 63 - (c8 + i) : (c8 + i); const size_t sidx = ((size_t)(bh * 64 + c) * 2 + dir); GS[sidx * 2048 + dv] = H; H = H * dd[i] + sv[i]; } } }
        }
        SEAM(pb + 2);
        if (IN(pb + 3) && PON(4)) {
            TID_SETUP(); unsigned char* ws = KWS(); const float* gla_norm_g = KIN(8); const bf16* PROJ = WSP(bf16, WS_PROJ);
            bf16* MIX = WSP(bf16, WS_MIX); const bf16* ADFT = WSP(bf16, WS_ADFT); const bf16* UVT = WSP(bf16, WS_UVT); const bf16* QB = WSP(bf16, WS_QB); const bf16* KB = WSP(bf16, WS_KB);
            { pg8::Gemm g{ADFT, UVT, SEQ, NB * 256, 8192}; pg8::StaticOrder S; S.init(SEQ, NB * 256, G, bx);
              pg8::EpiFnet E{MIX};
              pg8::gemm_phase<pg8::EpiFnet, pg8::StaticOrder, true, true>(lds + RING_OFF, g, S, E); }
            __syncthreads();
            { LAS float* L = (LAS float*)(lds + RING_OFF); const float* GS = WSP(float, WS_OF); const float* LA = WSP(float, WS_LA);
              for (int u = bx; u < NB * 4 * 64; u += G) { const int c = u & 63, bh = u >> 6, hd = bh & 3, b = bh >> 2; const size_t tok0 = (size_t)b * SEQ + c * 64;
                gla_stage(L, PROJ, LA, tok0, hd, tid);
                { const f32x4* src = (const f32x4*)(GS + (size_t)u * 2 * 2048) + tid * 2; LAS f32x4* dst = (LAS f32x4*)(L + GL_HF) + tid * 2; dst[0] = src[0]; dst[1] = src[1]; }
                const int i0 = (tid >> 4) * 2, j0 = (tid & 15) * 4;
                { float pf[2][4], pb[2][4];
#pragma unroll
                  for (int a_ = 0; a_ < 2; ++a_)
#pragma unroll
                      for (int c_ = 0; c_ < 4; ++c_) { pf[a_][c_] = 0.f; pb[a_][c_] = 0.f; }
#pragma unroll 4
                  for (int d = 0; d < 32; ++d) { const float qf0 = L[GL_QF + i0 * 33 + d], qf1 = L[GL_QF + (i0 + 1) * 33 + d], qb0 = L[GL_QB + i0 * 33 + d], qb1 = L[GL_QB + (i0 + 1) * 33 + d];
#pragma unroll
                      for (int c_ = 0; c_ < 4; ++c_) { const float kf = L[GL_KF + (j0 + c_) * 33 + d], kb = L[GL_KB + (j0 + c_) * 33 + d]; pf[0][c_] += qf0 * kf; pf[1][c_] += qf1 * kf; pb[0][c_] += qb0 * kb; pb[1][c_] += qb1 * kb; } }
#pragma unroll
                  for (int a_ = 0; a_ < 2; ++a_)
#pragma unroll
                      for (int c_ = 0; c_ < 4; ++c_) L[GL_P + (i0 + a_) * 65 + j0 + c_] = (j0 + c_ <= i0 + a_) ? pf[a_][c_] : pb[a_][c_]; }
                __syncthreads();
                f32x4 o0 = {0.f, 0.f, 0.f, 0.f}, o1 = {0.f, 0.f, 0.f, 0.f}; const int v0 = j0;
#pragma unroll 8
                for (int j = 0; j < 64; ++j) { const float p0 = L[GL_P + i0 * 65 + j], p1 = L[GL_P + (i0 + 1) * 65 + j]; const f32x4 vv = *(const LAS f32x4*)(L + GL_V + j * 64 + v0); o0 = o0 + vv * p0; o1 = o1 + vv * p1; }
#pragma unroll 8
                for (int d = 0; d < 32; ++d) { const f32x4 hf = *(const LAS f32x4*)(L + GL_HF + d * 64 + v0), hb = *(const LAS f32x4*)(L + GL_HB + d * 64 + v0);
                    o0 = o0 + hf * L[GL_QF + i0 * 33 + d] + hb * L[GL_QB + i0 * 33 + d]; o1 = o1 + hf * L[GL_QF + (i0 + 1) * 33 + d] + hb * L[GL_QB + (i0 + 1) * 33 + d]; }
                float s0 = (o0.x * o0.x + o0.y * o0.y) + (o0.z * o0.z + o0.w * o0.w), s1 = (o1.x * o1.x + o1.y * o1.y) + (o1.z * o1.z + o1.w * o1.w);
#pragma unroll
                for (int m_ = 1; m_ < 16; m_ <<= 1) { s0 += __shfl_xor(s0, m_); s1 += __shfl_xor(s1, m_); }
                const f32x4 gn = *(const f32x4*)(gla_norm_g + l * 64 + v0);
#pragma unroll
                for (int a_ = 0; a_ < 2; ++a_) { const f32x4 ov = a_ ? o1 : o0; const float rs = 1.f / sqrtf((a_ ? s1 : s0) * (1.f / 64.f) + RMS_EPS); const size_t m = tok0 + i0 + a_;
                    const u16x4 r4 = *(const u16x4*)(PROJ + m * INP + C_GR + hd * 64 + v0); float y[4];
#pragma unroll
                    for (int i = 0; i < 4; ++i) { const float r = bf2f(r4[i]); y[i] = ov[i] * rs * gn[i] * (r / (1.f + expf(-r))); }
                    *(unsigned long long*)(MIX + m * DM + 512 + hd * 64 + v0) = (unsigned long long)pk2(y[0], y[1]) | ((unsigned long long)pk2(y[2], y[3]) << 32); } }
              __syncthreads(); }
#if NAIVE_ATTN
            { LAS float* Kt = (LAS float*)(lds + RING_OFF); LAS float* Vt = Kt + 64 * 64;
              for (int unit = bx; unit < NB * 8 * 8; unit += G) { const int rb = unit & 7, h = (unit >> 3) & 7, b = unit >> 6, kvh = h >> 2;
                const size_t qrow = (size_t)b * SEQ + rb * 512 + tid;
                float q[64], o[64]; float mrun = -INFINITY, lrun = 0.f;
#pragma unroll
                for (int c8 = 0; c8 < 8; ++c8) { const u16x8 f = *(const u16x8*)(QB + qrow * 512 + h * 64 + c8 * 8);
#pragma unroll
                    for (int i = 0; i < 8; ++i) { q[c8 * 8 + i] = bf2f(f[i]); o[c8 * 8 + i] = 0.f; } }
                for (int kt = 0; kt < SEQ; kt += 64) {
                    __syncthreads();
                    { const int kr = tid >> 3, c8 = (tid & 7) * 8; const size_t krow = (size_t)b * SEQ + kt + kr;
                      const u16x8 kf = *(const u16x8*)(KB + krow * 128 + kvh * 64 + c8); const u16x8 vf = *(const u16x8*)(PROJ + krow * INP + C_AV + kvh * 64 + c8);
#pragma unroll
                      for (int i = 0; i < 8; ++i) { Kt[kr * 64 + c8 + i] = bf2f(kf[i]); Vt[kr * 64 + c8 + i] = bf2f(vf[i]); } }
                    __syncthreads();
#pragma unroll 1
                    for (int j = 0; j < 64; ++j) { float a = 0.f;
#pragma unroll
                        for (int d4 = 0; d4 < 16; ++d4) { const f32x4 kv = *(const LAS f32x4*)(Kt + j * 64 + d4 * 4); a += (q[d4 * 4] * kv.x + q[d4 * 4 + 1] * kv.y) + (q[d4 * 4 + 2] * kv.z + q[d4 * 4 + 3] * kv.w); }
                        if (a > mrun) { const float al = exp2f(mrun - a); mrun = a; lrun *= al;
#pragma unroll
                            for (int d = 0; d < 64; ++d) o[d] *= al; }
                        const float p = exp2f(a - mrun); lrun += p;
#pragma unroll
                        for (int d4 = 0; d4 < 16; ++d4) { const f32x4 vv = *(const LAS f32x4*)(Vt + j * 64 + d4 * 4); o[d4 * 4] += p * vv.x; o[d4 * 4 + 1] += p * vv.y; o[d4 * 4 + 2] += p * vv.z; o[d4 * 4 + 3] += p * vv.w; } }
                }
                const float rl = 1.f / lrun;
#pragma unroll
                for (int c8 = 0; c8 < 8; ++c8) { v4u w; w.x = pk2(o[c8 * 8] * rl, o[c8 * 8 + 1] * rl); w.y = pk2(o[c8 * 8 + 2] * rl, o[c8 * 8 + 3] * rl); w.z = pk2(o[c8 * 8 + 4] * rl, o[c8 * 8 + 5] * rl); w.w = pk2(o[c8 * 8 + 6] * rl, o[c8 * 8 + 7] * rl);
                    *(v4u*)(MIX + qrow * DM + h * 64 + c8 * 8) = w; }
              }
              __syncthreads(); }
#else
            { const attn_body::AttnTensors AT{(const attn_body::bf16*)QB, (const attn_body::bf16*)KB, (const attn_body::bf16*)(PROJ + C_AV), (attn_body::bf16*)MIX};
              const attn_body::StaticOrder S(G, bx);
              attn_body::attn_phase<attn_body::StaticOrder>((char*)lds_raw + RING_OFF, AT, S); }
#endif
        }
        SEAM(pb + 3);
        if (IN(pb + 4) && PON(5)) {
            TID_SETUP(); unsigned char* ws = KWS(); const bf16* MIX = WSP(bf16, WS_MIX); const bf16* WOUT_T = WSP(bf16, WS_WOUT_T); const float* HF = WSP(float, WS_HF); float* T1 = WSP(float, WS_T1);
            pg8::Gemm g{MIX, WOUT_T + (size_t)l * DM * DM, NTOK, DM, DM}; pg8::StaticOrder S; S.init(NTOK, DM, G, bx);
            pg8::EpiResF32 E{HF, T1, DM, DN_ALPHA};
            pg8::gemm_phase<pg8::EpiResF32, pg8::StaticOrder, true, true>(lds + RING_OFF, g, S, E);
        }
        SEAM(pb + 4);
        if (IN(pb + 5) && PON(6)) {
            TID_SETUP(); unsigned char* ws = KWS(); gu32* ctl = (gu32*)(ws + WS_CTL); const float* ln1_g = KIN(10); const float* ln1_b = KIN(11); const float* router_w = KIN(12); const float* router_b = KIN(13);
            const float* T1 = WSP(float, WS_T1); float* HF = WSP(float, WS_HF); bf16* HB = WSP(bf16, WS_HB); int* TOKE = WSP(int, WS_TOK); int* TOKS = TOKE + NTOK * 4; float* TOKW = (float*)(TOKS + NTOK * 4);
            LAS float* RW = (LAS float*)(lds + RING_OFF);
            { const float* rw = router_w + (size_t)l * DM * NE; for (int i = tid; i < DM * NE; i += NWAVES * 64) { const int c = i >> 5, e = i & 31; RW[e * DM + c] = rw[i]; } }
            LAS int* lcnt = (LAS int*)(lctl + LC_CNT); LAS int* lbase = (LAS int*)(lctl + LC_BASE); LAS int* sele = (LAS int*)(lctl + LC_SELE); LAS int* sels = (LAS int*)(lctl + LC_SELS);
            const float* rb = router_b + l * NE;
            for (int r0 = bx * 128; r0 < NTOK; r0 += G * 128) {
                if (tid < 32) lcnt[tid] = 0;
                __syncthreads();
                for (int rr = 0; rr < 16; ++rr) { const int lr = wave * 16 + rr; const size_t m = (size_t)r0 + lr; f32x4 v[4];
#pragma unroll
                    for (int j = 0; j < 4; ++j) v[j] = *(const f32x4*)(T1 + m * DM + lane * 4 + 256 * j);
                    ln_row(v, ln1_g + l * DM, ln1_b + l * DM, HF + m * DM, HB + m * DM, lane);
                    float lg[32];
#pragma unroll
                    for (int e = 0; e < 32; ++e) { float a = 0.f;
#pragma unroll
                        for (int j = 0; j < 4; ++j) { const f32x4 w = *(const LAS f32x4*)(RW + e * DM + lane * 4 + 256 * j); a += (v[j].x * w.x + v[j].y * w.y) + (v[j].z * w.z + v[j].w * w.w); }
                        lg[e] = wave_sum(a) + rb[e]; }
                    int se[4]; float sv[4];
#pragma unroll
                    for (int k = 0; k < 4; ++k) { float best = -INFINITY; int bi = 0;
#pragma unroll
                        for (int e = 0; e < 32; ++e) { if (lg[e] > best) { best = lg[e]; bi = e; } }
                        se[k] = bi; sv[k] = best;
#pragma unroll
                        for (int e = 0; e < 32; ++e) if (e == bi) lg[e] = -INFINITY; }
                    const float e1 = expf(sv[1] - sv[0]), e2 = expf(sv[2] - sv[0]), e3 = expf(sv[3] - sv[0]); const float inv = 1.f / (1.f + e1 + e2 + e3);
                    if (lane == 0) { const float wts[4] = {inv, e1 * inv, e2 * inv, e3 * inv};
#pragma unroll
                        for (int k = 0; k < 4; ++k) { const int ls = __hip_atomic_fetch_add(lcnt + se[k], 1, __ATOMIC_RELAXED, __HIP_MEMORY_SCOPE_WORKGROUP); sele[lr * 4 + k] = se[k]; sels[lr * 4 + k] = ls; TOKW[m * 4 + k] = wts[k]; } }
                }
                __syncthreads();
                if (tid < 32) lbase[tid] = (int)__hip_atomic_fetch_add(ctl + CW_CNT + l * 32 + tid, (unsigned)lcnt[tid], RLX_AGENT);
                __syncthreads();
                { const int e = sele[tid]; TOKE[(size_t)r0 * 4 + tid] = e; TOKS[(size_t)r0 * 4 + tid] = lbase[e] + sels[tid]; }
                __syncthreads();
            }
        }
        SEAM(pb + 5);
        if (IN(pb + 6) || IN(pb + 7) || IN(pb + 8)) {
            LAS int* pst = (LAS int*)(lctl + LC_PSTART); gu32* ctl = (gu32*)(KWS() + WS_CTL);
            __syncthreads();
            if (threadIdx.x == 0) { int acc = 0; for (int e = 0; e < NE; ++e) { pst[e] = acc; const int c = (int)__hip_atomic_load(ctl + CW_CNT + l * 32 + e, RLX_AGENT); acc += (c + 255) >> 8; } pst[NE] = acc; }
            __syncthreads();
        }
        if (IN(pb + 6) && PON(7)) {
            TID_SETUP(); unsigned char* ws = KWS(); const int* TOKE = WSP(int, WS_TOK); const int* TOKS = TOKE + NTOK * 4; int* TOKP = (int*)(TOKE + 3 * NTOK * 4); const bf16* HB = WSP(bf16, WS_HB); bf16* XS = WSP(bf16, WS_XS);
            const LAS int* pst = (const LAS int*)(lctl + LC_PSTART);
            for (int it = gw; it < NTOK * 4; it += NGW) { const int m = it >> 2; const int e = TOKE[it], sl = TOKS[it]; const int dst = pst[e] * 256 + sl;
                if (lane == 0) TOKP[it] = dst;
                const v4u* src = (const v4u*)(HB + (size_t)m * DM); v4u* d = (v4u*)(XS + (size_t)dst * DM);
                d[lane] = src[lane]; d[lane + 64] = src[lane + 64]; }
        }
        SEAM(pb + 6);
        if (IN(pb + 7) && PON(8)) {
            TID_SETUP(); unsigned char* ws = KWS(); const float* exp_b_gu = KIN(15); const bf16* XS = WSP(bf16, WS_XS); const bf16* WGU_T = WSP(bf16, WS_WGU_T); bf16* HID = WSP(bf16, WS_HID);
            const LAS int* pst = (const LAS int*)(lctl + LC_PSTART); LAS int* ul = (LAS int*)(lctl + LC_ULIST);
            const int nM = pst[NE], nN = 8, nwg = nM * nN;
            if (tid < 64) { const long L = (long)tid * G + bx; int v = -1;
                if (L < nwg) { int wgid = (int)L; { const int q = nwg / 8, r = nwg % 8, xcd = wgid % 8, off = wgid / 8; wgid = (xcd < r ? xcd * (q + 1) : r * (q + 1) + (xcd - r) * q) + off; }
                    const int nig = 8 * nN, gid = wgid / nig, fm = gid * 8, gsz = (nM - fm) < 8 ? (nM - fm) : 8; const int pm = fm + ((wgid % nig) % gsz), pn = (wgid % nig) / gsz;
                    int e = 0; for (int k = 1; k < NE; ++k) if (pst[k] <= pm) e = k;
                    v = (pm << 16) | (e * nN + pn); }
                ul[tid] = v; }
            __syncthreads();
            const int nunits = bx < nwg ? (nwg - bx + G - 1) / G : 0;
            pg8::Gemm g{XS, WGU_T + (size_t)l * NE * 2048 * DM, MPAD, NE * 2048, DM}; pg8::ListOrder S{ul, nunits};
            pg8::EpiSwiglu E{HID, exp_b_gu + (size_t)l * NE * 2048};
            pg8::gemm_phase<pg8::EpiSwiglu, pg8::ListOrder, true, true>(lds + RING_OFF, g, S, E);
        }
        SEAM(pb + 7);
        if (IN(pb + 8) && PON(9)) {
            TID_SETUP(); unsigned char* ws = KWS(); const float* exp_b_down = KIN(17); const bf16* HID = WSP(bf16, WS_HID); const bf16* WDN_T = WSP(bf16, WS_WDN_T); bf16* YS = WSP(bf16, WS_YS);
            const LAS int* pst = (const LAS int*)(lctl + LC_PSTART); LAS int* ul = (LAS int*)(lctl + LC_ULIST);
            const int nM = pst[NE], nN = 4, nwg = nM * nN;
            __syncthreads();
            if (tid < 64) { const long L = (long)tid * G + bx; int v = -1;
                if (L < nwg) { int wgid = (int)L; { const int q = nwg / 8, r = nwg % 8, xcd = wgid % 8, off = wgid / 8; wgid = (xcd < r ? xcd * (q + 1) : r * (q + 1) + (xcd - r) * q) + off; }
                    const int nig = 8 * nN, gid = wgid / nig, fm = gid * 8, gsz = (nM - fm) < 8 ? (nM - fm) : 8; const int pm = fm + ((wgid % nig) % gsz), pn = (wgid % nig) / gsz;
                    int e = 0; for (int k = 1; k < NE; ++k) if (pst[k] <= pm) e = k;
                    v = (pm << 16) | (e * nN + pn); }
                ul[tid] = v; }
            __syncthreads();
            const int nunits = bx < nwg ? (nwg - bx + G - 1) / G : 0;
            pg8::Gemm g{HID, WDN_T + (size_t)l * NE * DM * DE, MPAD, NE * DM, DE}; pg8::ListOrder S{ul, nunits};
            pg8::EpiDown E{YS, exp_b_down + (size_t)l * NE * DM};
            pg8::gemm_phase<pg8::EpiDown, pg8::ListOrder, true, true>(lds + RING_OFF, g, S, E);
        }
        SEAM(pb + 8);
        if (IN(pb + 9) && PON(10)) {
            TID_SETUP(); unsigned char* ws = KWS(); const float* ln2_g = KIN(18); const float* ln2_b = KIN(19); float* out = KOUT(); float* HF = WSP(float, WS_HF); bf16* HB = WSP(bf16, WS_HB);
            const bf16* YS = WSP(bf16, WS_YS); const float* TOKW = (const float*)(WSP(int, WS_TOK) + 2 * NTOK * 4); const int* TOKP = WSP(int, WS_TOK) + 3 * NTOK * 4;
            const bool lastl = (l == NL - 1);
            for (int m = gw; m < NTOK; m += NGW) { f32x4 v[4];
#pragma unroll
                for (int j = 0; j < 4; ++j) v[j] = *(const f32x4*)(HF + (size_t)m * DM + lane * 4 + 256 * j) * DN_ALPHA;
#pragma unroll
                for (int k = 0; k < 4; ++k) { const float w = TOKW[m * 4 + k]; const bf16* yr = YS + (size_t)TOKP[m * 4 + k] * DM;
#pragma unroll
                    for (int j = 0; j < 4; ++j) { const u16x4 y = *(const u16x4*)(yr + lane * 4 + 256 * j); v[j].x += w * bf2f(y[0]); v[j].y += w * bf2f(y[1]); v[j].z += w * bf2f(y[2]); v[j].w += w * bf2f(y[3]); } }
                ln_row(v, ln2_g + l * DM, ln2_b + l * DM, lastl ? out + (size_t)m * DM : HF + (size_t)m * DM, lastl ? nullptr : HB + (size_t)m * DM, lane); }
        }
        SEAM(pb + 9);
    }
#undef IN
#undef SEAM
}

#ifndef MK_PER_PHASE
#define MK_PER_PHASE 0
#endif
extern "C" void kernel_launch(void* const* d_in, const int* in_sizes, int n_in, void* d_out, int out_size, void* d_ws, size_t ws_size, hipStream_t stream) {
    static int grid = 0;
    if (grid == 0) {
        if (n_in != 20 || in_sizes[0] != NTOK * DM || out_size != NTOK * DM || ws_size < WS_END) { fprintf(stderr, "kernel_launch: unexpected shapes (n_in %d, in0 %d, out %d, ws %zu); nothing launched\n", n_in, n_in > 0 ? in_sizes[0] : -1, out_size, ws_size); grid = -1; return; }
        int dev = 0, cus = 0, per_cu = 0;
        if (hipGetDevice(&dev) != hipSuccess || hipDeviceGetAttribute(&cus, hipDeviceAttributeMultiprocessorCount, dev) != hipSuccess) { grid = -1; return; }
        if (hipFuncSetAttribute((const void*)fwd, hipFuncAttributeMaxDynamicSharedMemorySize, LDS_BYTES) != hipSuccess) { fprintf(stderr, "kernel_launch: hipFuncSetAttribute failed\n"); grid = -1; return; }
        if (hipOccupancyMaxActiveBlocksPerMultiprocessor(&per_cu, (const void*)fwd, NWAVES * 64, LDS_BYTES) != hipSuccess || per_cu < 1) fprintf(stderr, "kernel_launch: occupancy query reports %d\n", per_cu);
        (void)hipGetLastError();
        grid = cus;
    }
    if (grid < 0) return;
    if (hipMemsetAsync((char*)d_ws + WS_CTL, 0, CTL_ZERO_BYTES, stream) != hipSuccess) return;
    Args a{};
    for (int i = 0; i < 20; ++i) a.in[i] = (const float*)d_in[i];
    a.out = (float*)d_out; a.ws = (unsigned char*)d_ws;
#if MK_PER_PHASE
    for (int p = 0; p < N_PHASES; ++p) { a.ph_lo = p; a.ph_hi = p + 1; hipLaunchKernelGGL(fwd, dim3(grid), dim3(NWAVES * 64), LDS_BYTES, stream, a); }
#else
    a.ph_lo = 0; a.ph_hi = N_PHASES;
    hipLaunchKernelGGL(fwd, dim3(grid), dim3(NWAVES * 64), LDS_BYTES, stream, a);
#endif
    const hipError_t le = hipPeekAtLastError();
    if (le != hipSuccess) fprintf(stderr, "kernel_launch: launch failed: %s\n", hipGetErrorName(le));
}
```

```cpp
#include <hip/hip_runtime.h>
#include <hip/hip_bf16.h>
#include <cstdio>
#include <cstdint>
#include <cmath>
namespace pg8 {
#define PG8_LAS __attribute__((address_space(3)))
typedef unsigned short bf16_t;
typedef short bf16x8 __attribute__((ext_vector_type(8)));
typedef float f32x4 __attribute__((ext_vector_type(4)));
typedef unsigned u32x4 __attribute__((ext_vector_type(4)));
constexpr int BM = 256, BK = 64, HALF = 128, HTB = HALF * BK * 2  , STAGE_BYTES = 8 * HTB, NXCD = 8, WGM = 8;

__host__ __device__ __forceinline__ int lds_byte(int r, int c) { const int st = (r >> 4) * 2 + (c >> 5), rr = r & 15, cc = c & 31, ob = rr * 64 + cc * 2; return st * 1024 + (ob ^ (((ob >> 9) & 1) << 5)); }
__host__ __device__ __forceinline__ void stage_rc(int b, int& R, int& C) { const int st = b / 1024, sb = b % 1024, swz = sb ^ (((sb >> 9) & 1) << 5); R = (st >> 1) * 16 + swz / 64; C = (st & 1) * 32 + (swz % 64) / 2; }
__host__ __device__ __forceinline__ int perm32(int rho) { const int n = rho >> 4, i = rho & 15; return 8 * (i >> 2) + 4 * n + (i & 3); }

struct Unit { int pm, pn; };
struct Gemm { const bf16_t* A; const bf16_t* Bt; int M, N, K; };

struct StaticOrder {
    int nM, nN, nwg, G, c;
    __host__ __device__ void init(int M, int N, int G_, int c_) { nM = M / BM; nN = N / BM; nwg = nM * nN; G = G_; c = c_; }
    __host__ __device__ bool next(int i, Unit& u) const {
        const long L = (long)i * G + c; if (L >= nwg) return false;
        int wgid = (int)L; { const int q = nwg / NXCD, r = nwg % NXCD, xcd = wgid % NXCD, off = wgid / NXCD; wgid = (xcd < r ? xcd * (q + 1) : r * (q + 1) + (xcd - r) * q) + off; }
        const int nig = WGM * nN, gid = wgid / nig, fm = gid * WGM, gsz = (nM - fm) < WGM ? (nM - fm) : WGM;
        u.pm = fm + ((wgid % nig) % gsz); u.pn = (wgid % nig) / gsz; return true;
    }
    __device__ __forceinline__ void a_ready(const Unit&) const {}
    __device__ __forceinline__ void done(const Unit&) const {}
};

__device__ __forceinline__ unsigned cvt_pk_bf16(float lo, float hi) { unsigned r; asm volatile("v_cvt_pk_bf16_f32 %0, %1, %2" : "=v"(r) : "v"(lo), "v"(hi)); return r; }
typedef float f32x2 __attribute__((ext_vector_type(2)));
__device__ __forceinline__ u32x4 pack8(const f32x4 v0, const f32x4 v1) { u32x4 w; w.x = cvt_pk_bf16(v0[0], v0[1]); w.y = cvt_pk_bf16(v0[2], v0[3]); w.z = cvt_pk_bf16(v1[0], v1[1]); w.w = cvt_pk_bf16(v1[2], v1[3]); return w; }

struct EpiPlainBf16 {
    static constexpr bool PERM = true, AFTER_DRAIN = false;
    bf16_t* O; int ldc;
    __device__ __forceinline__ void operator()(const f32x4 (&acc)[2][2][4][2], const Unit& u, int wr, int wc, int fr, int fq) const {
        const int row0 = u.pm * BM + wr * 64 + fr, col0 = u.pn * BM + wc * 32 + 8 * fq;
#pragma unroll
        for (int ai = 0; ai < 2; ++ai)
#pragma unroll
            for (int m = 0; m < 4; ++m) { bf16_t* rowp = O + (size_t)(row0 + ai * HALF + m * 16) * ldc + col0;
#pragma unroll
                for (int bj = 0; bj < 2; ++bj) *(u32x4*)(rowp + bj * HALF) = pack8(acc[ai][bj][m][0], acc[ai][bj][m][1]); }
    }
};
struct EpiFnet {
    static constexpr bool PERM = true, AFTER_DRAIN = false;
    bf16_t* MIX;
    __device__ __forceinline__ void operator()(const f32x4 (&acc)[2][2][4][2], const Unit& u, int wr, int wc, int fr, int fq) const {
        const int row0 = u.pn * 4096 + u.pm * BM + wr * 64 + fr, col0 = 768 + wc * 32 + 8 * fq;
#pragma unroll
        for (int ai = 0; ai < 2; ++ai)
#pragma unroll
            for (int m = 0; m < 4; ++m) { bf16_t* rowp = MIX + (size_t)(row0 + ai * HALF + m * 16) * 1024 + col0;
#pragma unroll
                for (int bj = 0; bj < 2; ++bj) *(u32x4*)(rowp + bj * HALF) = pack8(acc[ai][bj][m][0], acc[ai][bj][m][1]); }
    }
};
struct EpiResF32 {
    static constexpr bool PERM = false, AFTER_DRAIN = false;
    const float* base; float* out; int ldc; float alpha;
    __device__ __forceinline__ void operator()(const f32x4 (&acc)[2][2][4][2], const Unit& u, int wr, int wc, int fr, int fq) const {
        const int row0 = u.pm * BM + wr * 64 + fr, col0 = u.pn * BM + wc * 32 + 4 * fq;
#pragma unroll
        for (int ai = 0; ai < 2; ++ai)
#pragma unroll
            for (int m = 0; m < 4; ++m) { const size_t off = (size_t)(row0 + ai * HALF + m * 16) * ldc + col0;
#pragma unroll
                for (int bj = 0; bj < 2; ++bj)
#pragma unroll
                    for (int n = 0; n < 2; ++n) { const f32x4 b = *(const f32x4*)(base + off + bj * HALF + n * 16); *(f32x4*)(out + off + bj * HALF + n * 16) = b * alpha + acc[ai][bj][m][n]; } }
    }
};
__device__ __forceinline__ float swiglu1(float g, float u) { g = fminf(g, 7.0f); u = fminf(fmaxf(u, -7.0f), 7.0f); return (u + 1.0f) * g * __builtin_amdgcn_rcpf(1.0f + __expf(-1.702f * g)); }
struct EpiSwiglu {
    static constexpr bool PERM = true, AFTER_DRAIN = false;
    bf16_t* HID; const float* bgu;
    __device__ __forceinline__ void operator()(const f32x4 (&acc)[2][2][4][2], const Unit& u, int wr, int wc, int fr, int fq) const {
        const int e = u.pn >> 3, pnl = u.pn & 7; const int row0 = u.pm * BM + wr * 64 + fr, jj0 = pnl * 128 + wc * 32 + 8 * fq;
        const float* bg = bgu + (size_t)e * 2048 + jj0;
        const f32x4 bg0 = *(const f32x4*)bg, bg1 = *(const f32x4*)(bg + 4), bu0 = *(const f32x4*)(bg + 1024), bu1 = *(const f32x4*)(bg + 1028);
#pragma unroll
        for (int ai = 0; ai < 2; ++ai)
#pragma unroll
            for (int m = 0; m < 4; ++m) { bf16_t* rowp = HID + (size_t)(row0 + ai * HALF + m * 16) * 1024 + jj0;
                const f32x4 g0 = acc[ai][0][m][0] + bg0, g1 = acc[ai][0][m][1] + bg1, u0 = acc[ai][1][m][0] + bu0, u1 = acc[ai][1][m][1] + bu1;
                f32x4 h0, h1;
#pragma unroll
                for (int i = 0; i < 4; ++i) { h0[i] = swiglu1(g0[i], u0[i]); h1[i] = swiglu1(g1[i], u1[i]); }
                *(u32x4*)rowp = pack8(h0, h1); }
    }
};
struct EpiDown {
    static constexpr bool PERM = true, AFTER_DRAIN = false;
    bf16_t* Y; const float* bd;
    __device__ __forceinline__ void operator()(const f32x4 (&acc)[2][2][4][2], const Unit& u, int wr, int wc, int fr, int fq) const {
        const int e = u.pn >> 2, pnl = u.pn & 3; const int row0 = u.pm * BM + wr * 64 + fr, col0 = pnl * BM + wc * 32 + 8 * fq;
        const float* bp = bd + (size_t)e * 1024 + col0;
        f32x4 bv[2][2];
#pragma unroll
        for (int bj = 0; bj < 2; ++bj)
#pragma unroll
            for (int n = 0; n < 2; ++n) bv[bj][n] = *(const f32x4*)(bp + bj * HALF + 4 * n);
#pragma unroll
        for (int ai = 0; ai < 2; ++ai)
#pragma unroll
            for (int m = 0; m < 4; ++m) { bf16_t* rowp = Y + (size_t)(row0 + ai * HALF + m * 16) * 1024 + col0;
#pragma unroll
                for (int bj = 0; bj < 2; ++bj) *(u32x4*)(rowp + bj * HALF) = pack8(acc[ai][bj][m][0] + bv[bj][0], acc[ai][bj][m][1] + bv[bj][1]); }
    }
};
struct ListOrder {
    const PG8_LAS int* list; int n;
    __device__ __forceinline__ bool next(int i, Unit& u) const { if (i >= n) return false; const int v = __builtin_amdgcn_readfirstlane(list[i]); u.pm = v >> 16; u.pn = v & 0xffff; return true; }
    __device__ __forceinline__ void a_ready(const Unit&) const {}
    __device__ __forceinline__ void done(const Unit&) const {}
};
template <class Epi, class Sched, bool ALIGN_EPI = false, bool SP2 = false>
__device__ __forceinline__ void gemm_phase(PG8_LAS unsigned char* lds, const Gemm g, const Sched& S, const Epi& E) {
    int tid_ = threadIdx.x; asm volatile("" : "+v"(tid_));
    const int tid = tid_, wid = __builtin_amdgcn_readfirstlane(tid >> 6), lane = tid & 63, wr = wid >> 2, wc = wid & 3, fr = lane & 15, fq = lane >> 4;
    const int K = g.K, nt = K / BK;
    unsigned voffA[2], voffB[2];
#pragma unroll
    for (int i = 0; i < 2; ++i) { int R, C; stage_rc(tid * 16 + i * 8192, R, C); const int Rb = Epi::PERM ? ((R & ~31) + perm32(R & 31)) : R;
        voffA[i] = (unsigned)(R * K + C) * 2u; voffB[i] = (unsigned)(Rb * K + C) * 2u; }
    const size_t kstep = (size_t)(BK * 2);
    const size_t hstep = (size_t)HALF * K * 2;
    const size_t tstep = 2 * hstep;
    const unsigned ldsw = (unsigned)wid * 1024u;
    const int aoff = lds_byte(wr * 64 + fr, fq * 8), boff = lds_byte(wc * 32 + fr, fq * 8);
#define PG8_SA(b, h) (((b) * 2 + (h)) * HTB)
#define PG8_SB(b, h) ((4 + (b) * 2 + (h)) * HTB)
#define PG8_STAGE(bufoff, gbase, voff) do { _Pragma("unroll") for (int _i = 0; _i < 2; ++_i) \
        __builtin_amdgcn_global_load_lds((const unsigned*)((const char*)(gbase) + (voff)[_i]), (PG8_LAS unsigned*)(lds + (bufoff) + ldsw + _i * 8192), 16, 0, 0); } while (0)
#define PG8_LDA(dst, b, h) do { _Pragma("unroll") for (int m = 0; m < 4; ++m) _Pragma("unroll") for (int k = 0; k < 2; ++k) dst[m][k] = *(const PG8_LAS bf16x8*)(lds + PG8_SA(b, h) + aoff + m * 2048 + k * 1024); } while (0)
#define PG8_LDB(dst, b, h) do { _Pragma("unroll") for (int n = 0; n < 2; ++n) _Pragma("unroll") for (int k = 0; k < 2; ++k) dst[n][k] = *(const PG8_LAS bf16x8*)(lds + PG8_SB(b, h) + boff + n * 2048 + k * 1024); } while (0)
#define PG8_MMA(ai, bj, At, Bt) do { __builtin_amdgcn_s_setprio(1); _Pragma("unroll") for (int m = 0; m < 4; ++m) _Pragma("unroll") for (int n = 0; n < 2; ++n) _Pragma("unroll") for (int k = 0; k < 2; ++k) \
        acc[ai][bj][m][n] = __builtin_amdgcn_mfma_f32_16x16x32_bf16(Bt[n][k], At[m][k], acc[ai][bj][m][n], 0, 0, 0); __builtin_amdgcn_s_setprio(0); } while (0)
#define PG8_WAIT_V(n) asm volatile("s_waitcnt vmcnt(" #n ")" ::: "memory")
#define PG8_WAIT_L(n) asm volatile("s_waitcnt lgkmcnt(" #n ")" ::: "memory")
#define PG8_BAR __builtin_amdgcn_s_barrier()
#define PG8_SCHED __builtin_amdgcn_sched_barrier(0)
    Unit cur, nxt; int ui = 0;
    if (!S.next(0, cur)) return;
    f32x4 acc[2][2][4][2];
#pragma unroll
    for (int a = 0; a < 2; ++a)
#pragma unroll
        for (int b = 0; b < 2; ++b)
#pragma unroll
            for (int m = 0; m < 4; ++m)
#pragma unroll
                for (int n = 0; n < 2; ++n) acc[a][b][m][n] = (f32x4){0.f, 0.f, 0.f, 0.f};
    bf16x8 At[4][2], B0[2][2], B1[2][2];
    const char* cA = (const char*)g.A + (size_t)cur.pm * tstep; const char* cB = (const char*)g.Bt + (size_t)cur.pn * tstep;
    S.a_ready(cur);
    if constexpr (SP2) {
        PG8_STAGE(PG8_SB(0, 0), cB, voffB); PG8_STAGE(PG8_SB(0, 1), cB + hstep, voffB); PG8_STAGE(PG8_SA(0, 0), cA, voffA); PG8_STAGE(PG8_SA(0, 1), cA + hstep, voffA);
        if (wr == 1) PG8_BAR;
        PG8_WAIT_V(2); PG8_BAR;
        PG8_STAGE(PG8_SB(1, 0), cB + kstep, voffB); PG8_STAGE(PG8_SA(1, 0), cA + kstep, voffA); PG8_STAGE(PG8_SB(1, 1), cB + hstep + kstep, voffB);
        PG8_WAIT_V(6); PG8_BAR;
    } else {
        PG8_STAGE(PG8_SB(0, 0), cB, voffB); PG8_STAGE(PG8_SA(0, 0), cA, voffA); PG8_STAGE(PG8_SB(0, 1), cB + hstep, voffB); PG8_STAGE(PG8_SA(0, 1), cA + hstep, voffA);
        if (wr == 1) PG8_BAR;
        PG8_WAIT_V(4); PG8_BAR;
        PG8_STAGE(PG8_SB(1, 0), cB + kstep, voffB); PG8_STAGE(PG8_SA(1, 0), cA + kstep, voffA); PG8_STAGE(PG8_SB(1, 1), cB + hstep + kstep, voffB);
        PG8_WAIT_V(6); PG8_BAR;
    }
    for (;;) {
        const bool has_next = S.next(ui + 1, nxt);
        const char* nA = has_next ? (const char*)g.A + (size_t)nxt.pm * tstep : cA; const char* nB = has_next ? (const char*)g.Bt + (size_t)nxt.pn * tstep : cB;
        for (int t = 0; t < nt; t += 2) {
            const bool last = (t == nt - 2);
            const char* a1 = cA + (size_t)(t + 1) * kstep;
            const char* a2 = last ? nA : cA + (size_t)(t + 2) * kstep; const char* b2 = last ? nB : cB + (size_t)(t + 2) * kstep;
            const char* a3 = a2 + kstep; const char* b3 = b2 + kstep;
            if (last && has_next) S.a_ready(nxt);
            if constexpr (SP2) {
            PG8_LDB(B0, 0, 0); PG8_LDB(B1, 0, 1); PG8_SCHED; PG8_LDA(At, 0, 0); PG8_STAGE(PG8_SA(1, 1), a1 + hstep, voffA);
            PG8_WAIT_V(8); PG8_WAIT_L(0); PG8_BAR; PG8_MMA(0, 0, At, B0); PG8_MMA(0, 1, At, B1); PG8_BAR; PG8_SCHED;
            PG8_LDA(At, 0, 1); PG8_STAGE(PG8_SB(0, 0), b2, voffB); PG8_STAGE(PG8_SB(0, 1), b2 + hstep, voffB); PG8_STAGE(PG8_SA(0, 0), a2, voffA);
            PG8_WAIT_V(8); PG8_WAIT_L(0); PG8_BAR; PG8_MMA(1, 0, At, B0); PG8_MMA(1, 1, At, B1); PG8_BAR; PG8_SCHED;
            PG8_LDB(B0, 1, 0); PG8_LDB(B1, 1, 1); PG8_SCHED; PG8_LDA(At, 1, 0); PG8_STAGE(PG8_SA(0, 1), a2 + hstep, voffA);
            PG8_WAIT_V(8); PG8_WAIT_L(0); PG8_BAR; PG8_MMA(0, 0, At, B0); PG8_MMA(0, 1, At, B1); PG8_BAR; PG8_SCHED;
            PG8_LDA(At, 1, 1); PG8_STAGE(PG8_SB(1, 0), b3, voffB); PG8_STAGE(PG8_SB(1, 1), b3 + hstep, voffB); PG8_STAGE(PG8_SA(1, 0), a3, voffA);
            PG8_WAIT_V(8); PG8_WAIT_L(0); PG8_BAR; PG8_MMA(1, 0, At, B0); PG8_MMA(1, 1, At, B1); PG8_BAR; PG8_SCHED;
            } else {
            PG8_LDB(B0, 0, 0); PG8_SCHED; PG8_LDA(At, 0, 0); PG8_STAGE(PG8_SA(1, 1), a1 + hstep, voffA);
            PG8_WAIT_L(8); PG8_BAR; PG8_WAIT_L(0); PG8_MMA(0, 0, At, B0); PG8_BAR; PG8_SCHED;
            PG8_LDB(B1, 0, 1); PG8_STAGE(PG8_SB(0, 0), b2, voffB);
            PG8_BAR; PG8_WAIT_L(0); PG8_MMA(0, 1, At, B1); PG8_BAR;
            PG8_LDA(At, 0, 1); PG8_STAGE(PG8_SA(0, 0), a2, voffA);
            PG8_BAR; PG8_WAIT_L(0); PG8_MMA(1, 0, At, B0); PG8_BAR; PG8_SCHED;
            PG8_STAGE(PG8_SB(0, 1), b2 + hstep, voffB);
            PG8_WAIT_V(6); PG8_BAR; PG8_MMA(1, 1, At, B1); PG8_BAR;
            PG8_LDB(B0, 1, 0); PG8_SCHED; PG8_LDA(At, 1, 0); PG8_STAGE(PG8_SA(0, 1), a2 + hstep, voffA);
            PG8_WAIT_L(8); PG8_BAR; PG8_WAIT_L(0); PG8_MMA(0, 0, At, B0); PG8_BAR; PG8_SCHED;
            PG8_LDB(B1, 1, 1); PG8_STAGE(PG8_SB(1, 0), b3, voffB);
            PG8_BAR; PG8_WAIT_L(0); PG8_MMA(0, 1, At, B1); PG8_BAR;
            PG8_LDA(At, 1, 1); PG8_STAGE(PG8_SA(1, 0), a3, voffA);
            PG8_BAR; PG8_WAIT_L(0); PG8_MMA(1, 0, At, B0); PG8_BAR; PG8_SCHED;
            PG8_STAGE(PG8_SB(1, 1), b3 + hstep, voffB);
            PG8_WAIT_V(6); PG8_BAR; PG8_MMA(1, 1, At, B1); PG8_BAR;
            }
        }
        if constexpr (ALIGN_EPI) { if (wr == 0) PG8_BAR; }
        if constexpr (!Epi::AFTER_DRAIN) { E(acc, cur, wr, wc, fr, fq); S.done(cur); }
        if (!has_next) break;
#pragma unroll
        for (int a = 0; a < 2; ++a)
#pragma unroll
            for (int b = 0; b < 2; ++b)
#pragma unroll
                for (int m = 0; m < 4; ++m)
#pragma unroll
                    for (int n = 0; n < 2; ++n) acc[a][b][m][n] = (f32x4){0.f, 0.f, 0.f, 0.f};
        cur = nxt; cA = nA; cB = nB; ++ui;
        if constexpr (ALIGN_EPI) { if (wr == 1) PG8_BAR; }
    }
    PG8_WAIT_V(0);
    if constexpr (!ALIGN_EPI) { if (wr == 0) PG8_BAR; }
    PG8_BAR;
    if constexpr (Epi::AFTER_DRAIN) { E.fused(acc, cur, wr, wc, fr, fq, lds, wid, lane); S.done(cur); }
#undef PG8_SA
#undef PG8_SB
#undef PG8_STAGE
#undef PG8_LDA
#undef PG8_LDB
#undef PG8_MMA
#undef PG8_WAIT_V
#undef PG8_WAIT_L
#undef PG8_BAR
#undef PG8_SCHED
}
}
namespace pg8 {
template <class Epi, class Sched, bool ALIGN_EPI>
__device__ __forceinline__ void gemm_phase_gather(PG8_LAS unsigned char* lds, const Gemm g, const Sched& S, const Epi& E, const PG8_LAS unsigned short* rows16) {
    int tid_ = threadIdx.x; asm volatile("" : "+v"(tid_));
    const int tid = tid_, wid = __builtin_amdgcn_readfirstlane(tid >> 6), lane = tid & 63, wr = wid >> 2, wc = wid & 3, fr = lane & 15, fq = lane >> 4;
    const int K = g.K, nt = K / BK;
    unsigned voffB[2]; int RA[2]; unsigned CA2[2];
#pragma unroll
    for (int i = 0; i < 2; ++i) { int R, C; stage_rc(tid * 16 + i * 8192, R, C); const int Rb = Epi::PERM ? ((R & ~31) + perm32(R & 31)) : R;
        RA[i] = R; CA2[i] = (unsigned)C * 2u; voffB[i] = (unsigned)(Rb * K + C) * 2u; }
    const size_t kstep = (size_t)(BK * 2);
    const size_t hstep = (size_t)HALF * K * 2;
    const size_t tstep = 2 * hstep;
    const unsigned ldsw = (unsigned)wid * 1024u;
    const unsigned rowb = (unsigned)K * 2u;
    const int aoff = lds_byte(wr * 64 + fr, fq * 8), boff = lds_byte(wc * 32 + fr, fq * 8);
#define PG8_SA(b, h) (((b) * 2 + (h)) * HTB)
#define PG8_SB(b, h) ((4 + (b) * 2 + (h)) * HTB)
#define PG8_STAGE(bufoff, gbase, voff) do { _Pragma("unroll") for (int _i = 0; _i < 2; ++_i) \
        __builtin_amdgcn_global_load_lds((const unsigned*)((const char*)(gbase) + (voff)[_i]), (PG8_LAS unsigned*)(lds + (bufoff) + ldsw + _i * 8192), 16, 0, 0); } while (0)
#define PG8_LDA(dst, b, h) do { _Pragma("unroll") for (int m = 0; m < 4; ++m) _Pragma("unroll") for (int k = 0; k < 2; ++k) dst[m][k] = *(const PG8_LAS bf16x8*)(lds + PG8_SA(b, h) + aoff + m * 2048 + k * 1024); } while (0)
#define PG8_LDB(dst, b, h) do { _Pragma("unroll") for (int n = 0; n < 2; ++n) _Pragma("unroll") for (int k = 0; k < 2; ++k) dst[n][k] = *(const PG8_LAS bf16x8*)(lds + PG8_SB(b, h) + boff + n * 2048 + k * 1024); } while (0)
#define PG8_MMA(ai, bj, At, Bt) do { __builtin_amdgcn_s_setprio(1); _Pragma("unroll") for (int m = 0; m < 4; ++m) _Pragma("unroll") for (int n = 0; n < 2; ++n) _Pragma("unroll") for (int k = 0; k < 2; ++k) \
        acc[ai][bj][m][n] = __builtin_amdgcn_mfma_f32_16x16x32_bf16(Bt[n][k], At[m][k], acc[ai][bj][m][n], 0, 0, 0); __builtin_amdgcn_s_setprio(0); } while (0)
#define PG8_WAIT_V(n) asm volatile("s_waitcnt vmcnt(" #n ")" ::: "memory")
#define PG8_WAIT_L(n) asm volatile("s_waitcnt lgkmcnt(" #n ")" ::: "memory")
#define PG8_BAR __builtin_amdgcn_s_barrier()
#define PG8_SCHED __builtin_amdgcn_sched_barrier(0)
#define PG8_GOFF(dst, U) do { _Pragma("unroll") for (int h_ = 0; h_ < 2; ++h_) _Pragma("unroll") for (int i_ = 0; i_ < 2; ++i_) dst[h_][i_] = (unsigned)rows16[(U) * 256 + h_ * HALF + RA[i_]] * rowb + CA2[i_]; } while (0)
    Unit cur, nxt; int ui = 0;
    if (!S.next(0, cur)) return;
    f32x4 acc[2][2][4][2];
#pragma unroll
    for (int a = 0; a < 2; ++a)
#pragma unroll
        for (int b = 0; b < 2; ++b)
#pragma unroll
            for (int m = 0; m < 4; ++m)
#pragma unroll
                for (int n = 0; n < 2; ++n) acc[a][b][m][n] = (f32x4){0.f, 0.f, 0.f, 0.f};
    bf16x8 At[4][2], B0[2][2], B1[2][2];
    const char* const Ab = (const char*)g.A;
    const char* cB = (const char*)g.Bt + (size_t)cur.pn * tstep;
    unsigned gc[2][2], gn[2][2];
    PG8_GOFF(gc, 0);
    S.a_ready(cur);
    PG8_STAGE(PG8_SB(0, 0), cB, voffB); PG8_STAGE(PG8_SB(0, 1), cB + hstep, voffB); PG8_STAGE(PG8_SA(0, 0), Ab, gc[0]); PG8_STAGE(PG8_SA(0, 1), Ab, gc[1]);
    if (wr == 1) PG8_BAR;
    PG8_WAIT_V(2); PG8_BAR;
    PG8_STAGE(PG8_SB(1, 0), cB + kstep, voffB); PG8_STAGE(PG8_SA(1, 0), Ab + kstep, gc[0]); PG8_STAGE(PG8_SB(1, 1), cB + hstep + kstep, voffB);
    PG8_WAIT_V(6); PG8_BAR;
    for (;;) {
        const bool has_next = S.next(ui + 1, nxt);
        const char* nB = has_next ? (const char*)g.Bt + (size_t)nxt.pn * tstep : cB;
        if (has_next) { PG8_GOFF(gn, ui + 1); } else {
#pragma unroll
            for (int h_ = 0; h_ < 2; ++h_)
#pragma unroll
                for (int i_ = 0; i_ < 2; ++i_) gn[h_][i_] = gc[h_][i_]; }
        for (int t = 0; t < nt; t += 2) {
            const bool last = (t == nt - 2);
            const char* a1 = Ab + (size_t)(t + 1) * kstep;
            const char* a2 = last ? Ab : Ab + (size_t)(t + 2) * kstep; const char* b2 = last ? nB : cB + (size_t)(t + 2) * kstep;
            const char* a3 = a2 + kstep; const char* b3 = b2 + kstep;
            unsigned g2[2][2];
#pragma unroll
            for (int h_ = 0; h_ < 2; ++h_)
#pragma unroll
                for (int i_ = 0; i_ < 2; ++i_) g2[h_][i_] = last ? gn[h_][i_] : gc[h_][i_];
            if (last && has_next) S.a_ready(nxt);
            PG8_LDB(B0, 0, 0); PG8_LDB(B1, 0, 1); PG8_SCHED; PG8_LDA(At, 0, 0); PG8_STAGE(PG8_SA(1, 1), a1, gc[1]);
            PG8_WAIT_V(8); PG8_WAIT_L(0); PG8_BAR; PG8_MMA(0, 0, At, B0); PG8_MMA(0, 1, At, B1); PG8_BAR; PG8_SCHED;
            PG8_LDA(At, 0, 1); PG8_STAGE(PG8_SB(0, 0), b2, voffB); PG8_STAGE(PG8_SB(0, 1), b2 + hstep, voffB); PG8_STAGE(PG8_SA(0, 0), a2, g2[0]);
            PG8_WAIT_V(8); PG8_WAIT_L(0); PG8_BAR; PG8_MMA(1, 0, At, B0); PG8_MMA(1, 1, At, B1); PG8_BAR; PG8_SCHED;
            PG8_LDB(B0, 1, 0); PG8_LDB(B1, 1, 1); PG8_SCHED; PG8_LDA(At, 1, 0); PG8_STAGE(PG8_SA(0, 1), a2, g2[1]);
            PG8_WAIT_V(8); PG8_WAIT_L(0); PG8_BAR; PG8_MMA(0, 0, At, B0); PG8_MMA(0, 1, At, B1); PG8_BAR; PG8_SCHED;
            PG8_LDA(At, 1, 1); PG8_STAGE(PG8_SB(1, 0), b3, voffB); PG8_STAGE(PG8_SB(1, 1), b3 + hstep, voffB); PG8_STAGE(PG8_SA(1, 0), a3, g2[0]);
            PG8_WAIT_V(8); PG8_WAIT_L(0); PG8_BAR; PG8_MMA(1, 0, At, B0); PG8_MMA(1, 1, At, B1); PG8_BAR; PG8_SCHED;
        }
        if constexpr (ALIGN_EPI) { if (wr == 0) PG8_BAR; }
        E(acc, cur, wr, wc, fr, fq); S.done(cur);
        if (!has_next) break;
#pragma unroll
        for (int a = 0; a < 2; ++a)
#pragma unroll
            for (int b = 0; b < 2; ++b)
#pragma unroll
                for (int m = 0; m < 4; ++m)
#pragma unroll
                    for (int n = 0; n < 2; ++n) acc[a][b][m][n] = (f32x4){0.f, 0.f, 0.f, 0.f};
        cur = nxt; cB = nB; ++ui;
#pragma unroll
        for (int h_ = 0; h_ < 2; ++h_)
#pragma unroll
            for (int i_ = 0; i_ < 2; ++i_) gc[h_][i_] = gn[h_][i_];
        if constexpr (ALIGN_EPI) { if (wr == 1) PG8_BAR; }
    }
    PG8_WAIT_V(0);
    if constexpr (!ALIGN_EPI) { if (wr == 0) PG8_BAR; }
    PG8_BAR;
#undef PG8_SA
#undef PG8_SB
#undef PG8_STAGE
#undef PG8_LDA
#undef PG8_LDB
#undef PG8_MMA
#undef PG8_WAIT_V
#undef PG8_WAIT_L
#undef PG8_BAR
#undef PG8_SCHED
#undef PG8_GOFF
}
}
#define GAS __attribute__((address_space(1)))
#define LAS __attribute__((address_space(3)))
typedef unsigned short bf16;
typedef unsigned v4u __attribute__((ext_vector_type(4)));
typedef float f32x4 __attribute__((ext_vector_type(4)));
typedef short bf16x8 __attribute__((ext_vector_type(8)));
typedef GAS unsigned gu32;
typedef GAS unsigned long long gu64;
#define RLX_AGENT __ATOMIC_RELAXED, __HIP_MEMORY_SCOPE_AGENT
#define LDS_WAIT() asm volatile("s_waitcnt lgkmcnt(0)" ::: "memory")
#define VM_WAIT() asm volatile("s_waitcnt vmcnt(0)" ::: "memory")
__device__ __forceinline__ unsigned long long rt() { return __builtin_amdgcn_s_memrealtime(); }
__device__ __forceinline__ unsigned f2bf(float f) { unsigned u = __builtin_bit_cast(unsigned, f); return (u + 0x7fffu + ((u >> 16) & 1u)) >> 16; }
__device__ __forceinline__ unsigned pk2(float lo, float hi) { return f2bf(lo) | (f2bf(hi) << 16); }
#define XB_TMO      128
#define XB_XCNT(j)  (256  + 64 * (j))
#define XB_XSUB(j)  (1280 + 64 * (j))
#define XB_XGEN(j)  (2304 + 64 * (j))
#define XB_TOP      3328
#define XB_TOPGEN   3392
#define XCD_BAR_WORDS 3456
#define XB_SPIN_CAP (1u << 18)

__device__ __forceinline__ unsigned xb_ld(unsigned* p)              { return __hip_atomic_load(p, __ATOMIC_RELAXED, __HIP_MEMORY_SCOPE_AGENT); }
__device__ __forceinline__ unsigned xb_add(unsigned* p, unsigned v) { return __hip_atomic_fetch_add(p, v, __ATOMIC_RELAXED, __HIP_MEMORY_SCOPE_AGENT); }
__device__ __forceinline__ unsigned xb_xcc_id() { return (unsigned)__builtin_amdgcn_s_getreg((3 << 11) | 20) & 0xFu; }
#define XB_SPIN(cond, bar) do { unsigned _sp = 0; while (cond) { __builtin_amdgcn_s_sleep(1); \
    if ((++_sp & 255u) == 0u) { if (xb_ld(&(bar)[XB_TMO])) break; if (_sp > XB_SPIN_CAP) { atomicAdd(&(bar)[XB_TMO], 1u); break; } } } } while (0)

struct XcdBarrier {
    unsigned* bar; unsigned x;
    volatile LAS unsigned* st;
};

__device__ __forceinline__ XcdBarrier xcd_barrier_post(unsigned* bar, volatile LAS unsigned* st) {
    XcdBarrier b; b.bar = bar; b.x = xb_xcc_id(); b.st = st;
    if (threadIdx.x == 0) (void)xb_add(&bar[XB_XCNT(b.x)], 1u);
    return b;
}
__device__ __forceinline__ void xcd_barrier_complete(unsigned* bar, unsigned x, unsigned& nloc, unsigned& nx) {
    const unsigned G = gridDim.x * gridDim.y * gridDim.z;
    unsigned sum, cnt, mine, sp = 0u;
    for (;;) {
        sum = 0u; cnt = 0u; mine = 0u;
#pragma unroll
        for (unsigned j = 0; j < 16; ++j) { const unsigned c = xb_ld(&bar[XB_XCNT(j)]); sum += c; cnt += (c > 0u) ? 1u : 0u; mine = (j == x) ? c : mine; }
        if (sum == G) break;
        __builtin_amdgcn_s_sleep(1);
        if ((++sp & 255u) == 0u) { if (xb_ld(&bar[XB_TMO])) break; if (sp > XB_SPIN_CAP) { atomicAdd(&bar[XB_TMO], 1u); break; } }
    }
    nloc = mine > 0u ? mine : 1u; nx = cnt > 0u ? cnt : 1u;
}

__device__ __forceinline__ void xcd_barrier(const XcdBarrier& b) {
    asm volatile("s_waitcnt vmcnt(0)" ::: "memory");
    __syncthreads();
    if (threadIdx.x == 0) {
        unsigned* bar = b.bar;
        __builtin_amdgcn_s_waitcnt(0);
        unsigned nloc = b.st[0], nx = b.st[1];
        if (nloc == 0u) { xcd_barrier_complete(bar, b.x, nloc, nx); b.st[0] = nloc; b.st[1] = nx; }
        const unsigned old = xb_add(&bar[XB_XSUB(b.x)], 1u);
        const unsigned gen = old / nloc;
        if (old + 1u == (gen + 1u) * nloc) {
            __builtin_amdgcn_fence(__ATOMIC_RELEASE, "agent");
            asm volatile("s_waitcnt vmcnt(0)" ::: "memory");
            const unsigned og = xb_add(&bar[XB_TOP], 1u);
            const unsigned tg = og / nx;
            if (og + 1u == (tg + 1u) * nx) xb_add(&bar[XB_TOPGEN], 1u);
            else XB_SPIN(xb_ld(&bar[XB_TOPGEN]) == tg, bar);
            __builtin_amdgcn_fence(__ATOMIC_ACQUIRE, "agent");
            xb_add(&bar[XB_XGEN(b.x)], 1u);
            asm volatile("s_waitcnt vmcnt(0)" ::: "memory");
        } else {
            XB_SPIN(xb_ld(&bar[XB_XGEN(b.x)]) == gen, bar);
            __builtin_amdgcn_fence(__ATOMIC_ACQUIRE, "agent");
            asm volatile("s_waitcnt vmcnt(0)" ::: "memory");
        }
    }
    __syncthreads();
}
namespace attn_body {
using bf16=__hip_bfloat16;
using bf16x8=__attribute__((ext_vector_type(8)))short;
using s16x4=__attribute__((ext_vector_type(4)))short;
using f32x16=__attribute__((ext_vector_type(16)))float;
using u32x4=__attribute__((ext_vector_type(4)))unsigned;
constexpr int BATCH=8,NHEAD=8,NKVH=2,SEQ=4096,D=64;
constexpr int DMQ=512,DMK=128,DMV=2048,DMO=1024;
constexpr int NW=8,QBLK=32,QB=QBLK*NW,KVBLK=64,NQB=SEQ/QB;
constexpr int ATTN_UNIT_ROWS=QB;
__device__ __forceinline__ int crow(int r,int hi){return (r&3)+8*(r>>2)+4*hi;}
#define SBAR() __builtin_amdgcn_sched_barrier(0)
__device__ __forceinline__ void cmask(f32x16&p0,f32x16&p1,int jb,int qrel,int hi){
  const float NEG=-INFINITY; int kb=64*jb+4*hi;
  #pragma unroll
  for(int r=0;r<16;++r){int kv=kb+(r&3)+8*(r>>2); if(kv>qrel)p0[r]=NEG; if(kv+32>qrel)p1[r]=NEG;}
}

constexpr int NSLOT=3, SLOTB=8192;
constexpr int LDS_K=0, LDS_V=NSLOT*SLOTB, LDS_WS=2*NSLOT*SLOTB, LDS_OST=LDS_WS+NW*64*4, LDS_BYTES=LDS_OST+NW*4096;
constexpr float C2=0.125f*1.4426950408889634f;
__device__ __forceinline__ void glds16(const void*gsrc,unsigned lds_dst){unsigned keep;
  asm volatile("s_mov_b32 %0, m0\n\ts_mov_b32 m0, %2\n\ts_nop 0\n\tglobal_load_lds_dwordx4 %1, off\n\ts_mov_b32 m0, %0":"=&s"(keep):"v"(gsrc),"s"(lds_dst):"memory");}
__device__ __forceinline__ float max3f(float a,float b,float c){float r;asm("v_max3_f32 %0, %1, %2, %3":"=v"(r):"v"(a),"v"(b),"v"(c));return r;}
__device__ __forceinline__ float max2f(float a,float b){float r;asm("v_max_f32_e32 %0, %1, %2":"=v"(r):"v"(a),"v"(b));return r;}
__device__ __forceinline__ float fadd_s(float a,float b){float r;asm("v_add_f32_e32 %0, %1, %2":"=v"(r):"v"(a),"v"(b));return r;}
__device__ __forceinline__ float fsub_s(float a,float b){float r;asm("v_sub_f32_e32 %0, %1, %2":"=v"(r):"v"(a),"v"(b));return r;}
typedef float f32x2_t __attribute__((ext_vector_type(2))); typedef __bf16 bf16x2_t __attribute__((ext_vector_type(2)));
__device__ __forceinline__ unsigned cvtpk_s(float lo,float hi){f32x2_t v={lo,hi};bf16x2_t b=__builtin_convertvector(v,bf16x2_t);return __builtin_bit_cast(unsigned,b);}
#define WAIT_BAR(N) asm volatile("s_waitcnt vmcnt(" #N ") lgkmcnt(0)\n\ts_barrier":::"memory")

__device__ __forceinline__ void qkt(f32x16&p0,f32x16&p1,const char*Kslot,const bf16x8*qr,const f32x16&negm,int r32,int hi){
  const char*kb=Kslot+hi*1024+r32*16;
  #pragma unroll
  for(int d0=0;d0<4;++d0){
    const bf16x8 b0=*reinterpret_cast<const bf16x8*>(kb+d0*2048);
    const bf16x8 b1=*reinterpret_cast<const bf16x8*>(kb+d0*2048+512);
    if(d0==0){p0=__builtin_amdgcn_mfma_f32_32x32x16_bf16(b0,qr[0],negm,0,0,0);p1=__builtin_amdgcn_mfma_f32_32x32x16_bf16(b1,qr[0],negm,0,0,0);}
    else{p0=__builtin_amdgcn_mfma_f32_32x32x16_bf16(b0,qr[d0],p0,0,0,0);p1=__builtin_amdgcn_mfma_f32_32x32x16_bf16(b1,qr[d0],p1,0,0,0);}}
}
typedef __attribute__((address_space(3))) const char* lds_cptr;
typedef short v4i16_t __attribute__((ext_vector_type(4)));
__device__ __forceinline__ void kload8(bf16x8*kf,lds_cptr kp){
  kf[0]=*(const __attribute__((address_space(3))) bf16x8*)(kp);      kf[1]=*(const __attribute__((address_space(3))) bf16x8*)(kp+512);
  kf[2]=*(const __attribute__((address_space(3))) bf16x8*)(kp+2048); kf[3]=*(const __attribute__((address_space(3))) bf16x8*)(kp+2560);
  kf[4]=*(const __attribute__((address_space(3))) bf16x8*)(kp+4096); kf[5]=*(const __attribute__((address_space(3))) bf16x8*)(kp+4608);
  kf[6]=*(const __attribute__((address_space(3))) bf16x8*)(kp+6144); kf[7]=*(const __attribute__((address_space(3))) bf16x8*)(kp+6656);
}
__device__ __forceinline__ void kload2(bf16x8*kf,lds_cptr kp,int j){ kf[2*j]=*(const __attribute__((address_space(3))) bf16x8*)(kp+j*2048); kf[2*j+1]=*(const __attribute__((address_space(3))) bf16x8*)(kp+j*2048+512); }
__device__ __forceinline__ s16x4 vtr(lds_cptr p){ return __builtin_bit_cast(s16x4,__builtin_amdgcn_ds_read_tr16_b64_v4i16((__attribute__((address_space(3))) v4i16_t*)p)); }
__device__ __forceinline__ float rowmax(const f32x16&p0,const f32x16&p1){
  float a=max3f(p0[0],p0[1],p1[0]),b=max3f(p0[2],p0[3],p1[1]);a=max3f(a,p1[2],p1[3]);
  #pragma unroll
  for(int r=4;r<16;r+=4){a=max3f(a,p0[r],p0[r+1]);b=max3f(b,p0[r+2],p0[r+3]);a=max3f(a,p1[r],p1[r+1]);b=max3f(b,p1[r+2],p1[r+3]);}
  const float m=max2f(a,b);
  auto rr=__builtin_amdgcn_permlane32_swap(__float_as_uint(m),__float_as_uint(m),false,false);
  return max2f(__uint_as_float(rr[0]),__uint_as_float(rr[1]));
}
__device__ __forceinline__ void pv(f32x16*o,int vb,bf16x8 pa0,bf16x8 pa1,bf16x8 pa2,bf16x8 pa3){
  #pragma unroll
  for(int d0=0;d0<2;++d0){s16x4 lo[4],hi[4];
    #pragma unroll
    for(int ks=0;ks<4;++ks){
      asm volatile("ds_read_b64_tr_b16 %0,%1 offset:%c2":"=&v"(lo[ks]):"v"(vb),"i"(d0*4096+ks*1024):"memory");
      asm volatile("ds_read_b64_tr_b16 %0,%1 offset:%c2":"=&v"(hi[ks]):"v"(vb),"i"(d0*4096+ks*1024+512):"memory");}
    asm volatile("s_waitcnt lgkmcnt(0)":::"memory");SBAR();
    #define PK(k) (bf16x8){lo[k][0],lo[k][1],lo[k][2],lo[k][3],hi[k][0],hi[k][1],hi[k][2],hi[k][3]}
    o[d0]=__builtin_amdgcn_mfma_f32_32x32x16_bf16(pa0,PK(0),o[d0],0,0,0);
    o[d0]=__builtin_amdgcn_mfma_f32_32x32x16_bf16(pa1,PK(1),o[d0],0,0,0);
    o[d0]=__builtin_amdgcn_mfma_f32_32x32x16_bf16(pa2,PK(2),o[d0],0,0,0);
    o[d0]=__builtin_amdgcn_mfma_f32_32x32x16_bf16(pa3,PK(3),o[d0],0,0,0);
    #undef PK
  }
}

#ifndef ATTN_STORE16
#define ATTN_STORE16(p,v) (*(u32x4*)(p)=(v))
#endif
template<int THRL> __device__ __forceinline__ void attn_unit(int b,int h,int qb,const bf16*Q,const bf16*__restrict__ K,const bf16*__restrict__ V,bf16*O,char*shm){
  int tid_=threadIdx.x; asm volatile("":"+v"(tid_)); const int tid=tid_,lane=tid&63,r32=lane&31,hi=lane>>5; const int wid=__builtin_amdgcn_readfirstlane(tid>>6);
  const long rowbase=(long)b*SEQ; const int q0=qb*QB;
  const bf16*Qw=Q+(rowbase+q0+wid*QBLK)*DMQ+h*D; const int kvh=h>>2;
  const bf16*Kh=K+rowbase*DMK+kvh*D,*Vh=V+rowbase*DMV+kvh*D;
  const unsigned lds0=(unsigned)(uintptr_t)shm;
  float*wsf=(float*)(shm+LDS_WS)+wid*64;
  const bf16*ksrc=Kh+(long)lane*DMK+wid*8;
  const bf16*vsrc=Vh+(long)(16*(wid&3)+(lane>>2))*DMV+(wid>>2)*32+(lane&3)*8;
  const unsigned kdst=lds0+LDS_K+wid*1024, vdst=lds0+LDS_V+wid*1024;
  #define DMA_K(t,slot) glds16(ksrc+(long)(t)*KVBLK*DMK,(unsigned)__builtin_amdgcn_readfirstlane(kdst+(slot)))
  #define DMA_V(t,slot) glds16(vsrc+(long)(t)*KVBLK*DMV,(unsigned)__builtin_amdgcn_readfirstlane(vdst+(slot)))
  const int vb0=(int)(lds0+LDS_V)+((lane>>4)&1)*32+(lane&3)*8+(4*hi+((lane&15)>>2))*64;
  const char*Kbase=shm+LDS_K; bf16x8 kf[8];
  const lds_cptr shm3=(lds_cptr)shm; const lds_cptr kp0=shm3+LDS_K+hi*1024+r32*16; const lds_cptr vp0=shm3+LDS_V+((lane>>4)&1)*32+(lane&3)*8+(4*hi+((lane&15)>>2))*64;
  constexpr int NT=SEQ/KVBLK;
  DMA_K(0,0);DMA_V(0,0);DMA_K(1,SLOTB);
  bf16x8 qr[4];
  #pragma unroll
  for(int d0=0;d0<4;++d0)qr[d0]=*reinterpret_cast<const bf16x8*>(&Qw[(long)r32*DMQ+d0*16+hi*8]);
  float mhat=0.f,l_reg=0.f;f32x16 o[2];o[0]=f32x16{};o[1]=f32x16{};f32x16 negm=f32x16{};asm volatile("":"+v"(negm));
  #define CMASK(P0,P1,t) do{}while(0)
  bool resc=false;
  #define START(P0,P1) do{ const float rm=rowmax(P0,P1); resc=false; \
    { const float dl=rm; mhat=fadd_s(mhat,dl); \
      _Pragma("unroll") for(int r=0;r<16;++r){P0[r]=fsub_s(P0[r],dl);P1[r]=fsub_s(P1[r],dl);} \
      _Pragma("unroll") for(int r=0;r<16;++r)negm[r]=-mhat; asm volatile("":"+v"(negm)); } \
    _Pragma("unroll") for(int r=0;r<16;++r)P0[r]=__builtin_amdgcn_exp2f(P0[r]); }while(0)
  #define RESC() do{ if(resc){ asm volatile("s_waitcnt lgkmcnt(0)":::"memory"); \
      _Pragma("unroll") for(int d_=0;d_<2;++d_) _Pragma("unroll") for(int r=0;r<16;++r)o[d_][r]*=wsf[crow(r,hi)]; } }while(0)
  f32x16 pA0,pA1,pB0,pB1;
  int sl_prev=0,sl_cur=0,sl_next=SLOTB;
  #define ROT() do{sl_prev=sl_cur;sl_cur=sl_next;sl_next=(sl_next==(NSLOT-1)*SLOTB)?0:sl_next+SLOTB;}while(0)
  DMA_K(2,2*SLOTB);
  WAIT_BAR(3);
  qkt(pA0,pA1,Kbase,qr,negm,r32,hi);asm volatile("s_nop 15\n\ts_nop 7":"+v"(pA0),"+v"(pA1));CMASK(pA0,pA1,0);
  START(pA0,pA1);
  _Pragma("unroll") for(int r=0;r<16;++r)pA1[r]=__builtin_amdgcn_exp2f(pA1[r]);
  WAIT_BAR(0);
  DMA_K(3,0);DMA_V(1,SLOTB);
  ROT();
  kload8(kf,kp0+sl_cur);
  WAIT_BAR(2);
  s16x4 vlo[8],vhi[8]; u32x4 pw0,pw1,pw2,pw3;
  #define PKW(P,B) cvtpk_s(P[B],P[B+1])
  #define PAF(k) __builtin_bit_cast(bf16x8,pw##k)
  #define VFR(i) (bf16x8){vlo[i][0],vlo[i][1],vlo[i][2],vlo[i][3],vhi[i][0],vhi[i][1],vhi[i][2],vhi[i][3]}
  #define PIN(x) asm volatile("":"+v"(x))
  #define MX3(a,b,c) __builtin_fmaxf(__builtin_fmaxf((a),(b)),(c))
  #define GAPA(MF,A0,A1,A2,A3,W0,W1,PW) do{ MF; sacc+=A0; sacc+=A1; sacc+=A2; sacc+=A3; PIN(sacc); W0; W1; PIN(PW); SBAR(); }while(0)
  #define EX(v) __builtin_amdgcn_exp2f(v)
  #define GAPB(MF,X,B) do{ MF; X[B]=EX(X[B]); X[B+1]=EX(X[B+1]); X[B+2]=EX(X[B+2]); X[B+3]=EX(X[B+3]); PIN(X); SBAR(); }while(0)
  #define VRD(i) do{ vlo[i]=vtr(vp_+(((i)>>2)*4096+((i)&3)*1024)); vhi[i]=vtr(vp_+(((i)>>2)*4096+((i)&3)*1024+512)); }while(0)
  #define KRD(G,j) do{ if(G){ kload2(kf,kp0+sl_next,j); SBAR(); } }while(0)
  #define STEP(C0,C1,P0,P1,t,GK,GV,GL) do{ SBAR(); \
    const lds_cptr vp_=vp0+sl_prev; \
    VRD(0); SBAR(); float sacc=(P0[0]+P0[1]); \
    GAPA(C0=__builtin_amdgcn_mfma_f32_32x32x16_bf16(kf[0],qr[0],negm,0,0,0), P0[2],P0[3],P0[4],P0[5],     pw0[0]=PKW(P0,0), pw0[1]=PKW(P0,2), pw0); \
    VRD(4); SBAR(); GAPA(C1=__builtin_amdgcn_mfma_f32_32x32x16_bf16(kf[1],qr[0],negm,0,0,0), P0[6],P0[7],P0[8],P0[9],     pw0[2]=PKW(P0,4), pw0[3]=PKW(P0,6), pw0); \
    VRD(1); SBAR(); GAPA(C0=__builtin_amdgcn_mfma_f32_32x32x16_bf16(kf[2],qr[1],C0,0,0,0),   P0[10],P0[11],P0[12],P0[13], pw1[0]=PKW(P0,8), pw1[1]=PKW(P0,10), pw1); \
    VRD(5); SBAR(); GAPA(C1=__builtin_amdgcn_mfma_f32_32x32x16_bf16(kf[3],qr[1],C1,0,0,0),   P0[14],P0[15],P1[0],P1[1],   pw1[2]=PKW(P0,12),pw1[3]=PKW(P0,14), pw1); \
    VRD(2); SBAR(); GAPA(C0=__builtin_amdgcn_mfma_f32_32x32x16_bf16(kf[4],qr[2],C0,0,0,0),   P1[2],P1[3],P1[4],P1[5],     pw2[0]=PKW(P1,0), pw2[1]=PKW(P1,2), pw2); \
    VRD(6); SBAR(); GAPA(C1=__builtin_amdgcn_mfma_f32_32x32x16_bf16(kf[5],qr[2],C1,0,0,0),   P1[6],P1[7],P1[8],P1[9],     pw2[2]=PKW(P1,4), pw2[3]=PKW(P1,6), pw2); \
    VRD(3); SBAR(); GAPA(C0=__builtin_amdgcn_mfma_f32_32x32x16_bf16(kf[6],qr[3],C0,0,0,0),   P1[10],P1[11],P1[12],P1[13], pw3[0]=PKW(P1,8), pw3[1]=PKW(P1,10), pw3); \
    VRD(7); SBAR(); GAPA(C1=__builtin_amdgcn_mfma_f32_32x32x16_bf16(kf[7],qr[3],C1,0,0,0),   P1[14],P1[15],0.f,0.f,       pw3[2]=PKW(P1,12),pw3[3]=PKW(P1,14), pw3); \
    l_reg+=sacc; \
    if(GK){DMA_K((t)+3,sl_cur);} if(GV){DMA_V((t)+1,sl_next);} \
    CMASK(C0,C1,t); \
    { float a=MX3(C0[0],C0[1],C1[0]),b=MX3(C0[2],C0[3],C1[1]); a=MX3(a,C1[2],C1[3]); \
      _Pragma("unroll") for(int r=4;r<16;r+=4){a=MX3(a,C0[r],C0[r+1]);b=MX3(b,C0[r+2],C0[r+3]);a=MX3(a,C1[r],C1[r+1]);b=MX3(b,C1[r+2],C1[r+3]);} \
      float rm=__builtin_fmaxf(a,b); { auto rr=__builtin_amdgcn_permlane32_swap(__float_as_uint(rm),__float_as_uint(rm),false,false); rm=__builtin_fmaxf(__uint_as_float(rr[0]),__uint_as_float(rr[1])); } \
      resc=false; \
      if(__builtin_expect(__any(rm>(float)THRL),0)){ const float dl=__builtin_fmaxf(rm,0.f); mhat+=dl; \
        _Pragma("unroll") for(int r=0;r<16;++r){C0[r]-=dl;C1[r]-=dl;} \
        _Pragma("unroll") for(int r=0;r<16;++r)negm[r]=-mhat; asm volatile("":"+v"(negm)); \
        const float f=__builtin_amdgcn_exp2f(-dl); l_reg*=f; if(hi==0)wsf[r32]=f; resc=true; } } \
    SBAR(); \
    GAPB(o[0]=__builtin_amdgcn_mfma_f32_32x32x16_bf16(PAF(0),VFR(0),o[0],0,0,0), C0,0); \
    GAPB(o[1]=__builtin_amdgcn_mfma_f32_32x32x16_bf16(PAF(0),VFR(4),o[1],0,0,0), C0,4); \
    KRD(GL,0); GAPB(o[0]=__builtin_amdgcn_mfma_f32_32x32x16_bf16(PAF(1),VFR(1),o[0],0,0,0), C0,8); \
    KRD(GL,1); GAPB(o[1]=__builtin_amdgcn_mfma_f32_32x32x16_bf16(PAF(1),VFR(5),o[1],0,0,0), C0,12); \
    KRD(GL,2); GAPB(o[0]=__builtin_amdgcn_mfma_f32_32x32x16_bf16(PAF(2),VFR(2),o[0],0,0,0), C1,0); \
    KRD(GL,3); GAPB(o[1]=__builtin_amdgcn_mfma_f32_32x32x16_bf16(PAF(2),VFR(6),o[1],0,0,0), C1,4); \
    GAPB(o[0]=__builtin_amdgcn_mfma_f32_32x32x16_bf16(PAF(3),VFR(3),o[0],0,0,0), C1,8); \
    GAPB(o[1]=__builtin_amdgcn_mfma_f32_32x32x16_bf16(PAF(3),VFR(7),o[1],0,0,0), C1,12); \
    }while(0)
  int t=1;
  #undef CMASK
  #define CMASK(P0,P1,t) do{}while(0)
  for(;t+5<NT;t+=2){
    STEP(pB0,pB1,pA0,pA1,t,true,true,true);     WAIT_BAR(2); RESC(); ROT();
    STEP(pA0,pA1,pB0,pB1,t+1,true,true,true);   WAIT_BAR(2); RESC(); ROT();
  }
  #undef CMASK
  #define CMASK(P0,P1,t) do{}while(0)
  #define ENDW(tt) do{ if((tt)+3<NT){WAIT_BAR(2);} else if((tt)+2<NT){WAIT_BAR(1);} else {WAIT_BAR(0);} }while(0)
  for(;t+1<NT;t+=2){
    STEP(pB0,pB1,pA0,pA1,t,(t+3<NT),(t+1<NT),(t+1<NT));       ENDW(t);   RESC(); ROT();
    STEP(pA0,pA1,pB0,pB1,t+1,(t+4<NT),(t+2<NT),(t+2<NT));     ENDW(t+1); RESC(); ROT();
  }
  STEP(pB0,pB1,pA0,pA1,NT-1,false,false,false); RESC();
  { float sacc=pB0[0]+pB0[1]; _Pragma("unroll") for(int r=2;r<16;++r)sacc+=pB0[r]; _Pragma("unroll") for(int r=0;r<16;++r)sacc+=pB1[r]; l_reg+=sacc;
    pw0=(u32x4){PKW(pB0,0),PKW(pB0,2),PKW(pB0,4),PKW(pB0,6)};pw1=(u32x4){PKW(pB0,8),PKW(pB0,10),PKW(pB0,12),PKW(pB0,14)};pw2=(u32x4){PKW(pB1,0),PKW(pB1,2),PKW(pB1,4),PKW(pB1,6)};pw3=(u32x4){PKW(pB1,8),PKW(pB1,10),PKW(pB1,12),PKW(pB1,14)};
    SBAR(); pv(o,vb0+sl_cur,PAF(0),PAF(1),PAF(2),PAF(3)); }
  #undef PKW
  #undef PAF
  #undef VFR
  #undef PIN
  #undef MX3
  #undef GAPA
  #undef GAPB
  #undef EX
  #undef VRD
  #undef KRD
  #undef STEP
  #undef ENDW
  {auto rr=__builtin_amdgcn_permlane32_swap(__float_as_uint(l_reg),__float_as_uint(l_reg),false,false);l_reg=__uint_as_float(rr[0])+__uint_as_float(rr[1]);}
  if(hi==0)wsf[32+r32]=l_reg;asm volatile("s_waitcnt lgkmcnt(0)":::"memory");
  float rli[16];
  #pragma unroll
  for(int r=0;r<16;++r)rli[r]=__builtin_amdgcn_rcpf(wsf[32+crow(r,hi)]);
  bf16*Ow=O+(rowbase+q0+wid*QBLK)*DMO+h*D;
  { bf16*stg=(bf16*)(shm+LDS_OST)+wid*2048;
    #pragma unroll
    for(int r=0;r<16;++r){const int orow=crow(r,hi);
      #pragma unroll
      for(int d0=0;d0<2;++d0)stg[orow*64+d0*32+r32]=__float2bfloat16(o[d0][r]*rli[r]);}
    asm volatile("s_waitcnt lgkmcnt(0)":::"memory");
    #pragma unroll
    for(int i=0;i<4;++i){const int row=i*8+(lane>>3),ch=lane&7; const u32x4 v=*(const u32x4*)(stg+row*64+ch*8); ATTN_STORE16(Ow+(long)row*DMO+ch*8,v);} }
  asm volatile("s_waitcnt lgkmcnt(0)\n\ts_barrier":::"memory");
  #undef DMA_K
  #undef DMA_V
  #undef CMASK
  #undef START
  #undef RESC
  #undef ROT
}
constexpr int ATTN_LDS_BYTES=LDS_BYTES;
struct AttnTensors { const bf16* Q; const bf16* K; const bf16* V; bf16* O; };
struct AttnUnit { int bh; int qb; };
struct StaticOrder {
  int vcu, G;
  __device__ __forceinline__ explicit StaticOrder(int grid,int block):vcu((grid%8==0)?(block%8)*(grid/8)+block/8:block),G(grid){}
  __device__ __forceinline__ bool next(int i,AttnUnit&u)const{ const int per=(BATCH*NHEAD*NQB+G-1)/G; if(i>=per)return false; const int idx=vcu*per+i; if(idx>=BATCH*NHEAD*NQB)return false;
    const int qb=idx%NQB, hq=(idx/NQB)&3, bk=idx/(NQB*4), kvh=bk&1, b=bk>>1; u.bh=b*NHEAD+kvh*4+hq; u.qb=qb; return true; }
  __device__ __forceinline__ void a_ready(const AttnUnit&)const{}
  __device__ __forceinline__ void done(const AttnUnit&)const{}
};
template<class Sched,int THRL=8> __device__ __forceinline__ void attn_phase(char*lds,const AttnTensors&T,const Sched&S){
  AttnUnit u;
  for(int i=0;S.next(i,u);++i){ S.a_ready(u); attn_unit<THRL>(u.bh/NHEAD,u.bh%NHEAD,u.qb,T.Q,T.K,T.V,T.O,lds); S.done(u); }
}
#undef SBAR
#undef WAIT_BAR
}
constexpr int NB = 8, SEQ = 4096, DM = 1024, NL = 4, NTOK = NB * SEQ;
constexpr int INW = 1824, INP = 2048;
constexpr int C_AQ = 0, C_AK = 512, C_AV = 640, C_GQ = 768, C_GK = 896, C_GV = 1024, C_GR = 1280, C_FX = 1536, C_GLR = 1792;
constexpr int NE = 32, TOPK = 4, DE = 1024;
constexpr int MPAD = NTOK * TOPK + NE * 256;
constexpr float LN_EPS = 1e-5f, RMS_EPS = 1e-6f;
constexpr float DN_ALPHA = 1.681792830507429f;
constexpr float QSCALE = 0.125f * 1.4426950408889634f;
constexpr float GLA_QSCALE = 0.17677669529663687f;

constexpr size_t MiB = 1u << 20;
constexpr size_t WS_CTL = 0, CTL_ZERO_BYTES = 1 * MiB;
constexpr size_t WS_ROPE = 1 * MiB;
constexpr size_t WS_WIN_T = 2 * MiB;
constexpr size_t WS_WOUT_T = 18 * MiB;
constexpr size_t WS_FTAB = 26 * MiB;
constexpr size_t WS_TW = WS_FTAB + 65536;
constexpr size_t WS_FTMP = 27 * MiB;
constexpr size_t WS_WGU_T = 90 * MiB;
constexpr size_t WS_WDN_T = 602 * MiB;
constexpr size_t WS_HF = 858 * MiB;
constexpr size_t WS_HB = 986 * MiB;
constexpr size_t WS_PROJ = 1050 * MiB;
constexpr size_t WS_QB = 1178 * MiB;
constexpr size_t WS_KB = 1210 * MiB;
constexpr size_t WS_MIX = 1218 * MiB;
constexpr size_t WS_T1 = 1282 * MiB;
constexpr size_t WS_UVT = 1410 * MiB;
constexpr size_t WS_LA = 1442 * MiB;
constexpr size_t WS_OF = 1474 * MiB;
constexpr size_t WS_OB = 1506 * MiB;
constexpr size_t WS_TOK = 1538 * MiB;
constexpr size_t WS_XS = 1542 * MiB;
constexpr size_t WS_HID = 1814 * MiB;
constexpr size_t WS_YS = 2086 * MiB;
constexpr size_t WS_END = 2358 * MiB;
static_assert((size_t)MPAD * 2048 == 272 * MiB, "sorted buffers");
constexpr int CW_TMO = 0, CW_CODE = 1, CW_BAR = 4096, CW_CNT = 8192;

constexpr int RING_OFF = 0, RING_BYTES = 131072;
constexpr int LDSCTL_OFF = RING_BYTES;
constexpr int LDS_BYTES = 147456;
constexpr int LC_MISC = 0;
constexpr int LC_PSTART = 128;
constexpr int LC_ULIST = 384;
constexpr int LC_CNT = 640;
constexpr int LC_BASE = 768;
constexpr int LC_SELE = 1024;
constexpr int LC_SELS = 1024 + 2048;
constexpr int LC_COS64 = 5120;
constexpr int LC_ROWS = 6144;

constexpr int NWAVES = 8;
constexpr int N_PHASES = 1 + 10 * NL;

__device__ __forceinline__ float bf2f(unsigned short b) { return __uint_as_float((unsigned)b << 16); }
__device__ __forceinline__ float wave_sum(float v) {
#pragma unroll
    for (int o = 1; o < 64; o <<= 1) v += __shfl_xor(v, o);
    return v;
}
typedef unsigned short u16x8 __attribute__((ext_vector_type(8)));
typedef unsigned short u16x4 __attribute__((ext_vector_type(4)));

__device__ __forceinline__ void tr_tile64(const float* W, int K, int Nsrc, int srcn, bf16* WT, int dst_n, int k0) {
    float v[64];
    if (srcn >= 0) { const float* p = W + (size_t)k0 * Nsrc + srcn;
#pragma unroll
        for (int i = 0; i < 64; ++i) v[i] = __builtin_nontemporal_load(p + (size_t)i * Nsrc); }
    else {
#pragma unroll
        for (int i = 0; i < 64; ++i) v[i] = 0.f; }
    bf16* o = WT + (size_t)dst_n * K + k0;
#pragma unroll
    for (int j = 0; j < 8; ++j) { v4u w; w.x = pk2(v[8 * j], v[8 * j + 1]); w.y = pk2(v[8 * j + 2], v[8 * j + 3]); w.z = pk2(v[8 * j + 4], v[8 * j + 5]); w.w = pk2(v[8 * j + 6], v[8 * j + 7]); *(v4u*)(o + 8 * j) = w; }
}

__device__ __forceinline__ void ln_row(f32x4 (&v)[4], const float* g, const float* bt, float* of32, bf16* obf, int lane) {
    float s = 0.f;
#pragma unroll
    for (int j = 0; j < 4; ++j) s += (v[j].x + v[j].y) + (v[j].z + v[j].w);
    const float mean = wave_sum(s) * (1.f / DM); float s2 = 0.f;
#pragma unroll
    for (int j = 0; j < 4; ++j) { v[j] = v[j] - mean; s2 += (v[j].x * v[j].x + v[j].y * v[j].y) + (v[j].z * v[j].z + v[j].w * v[j].w); }
    const float rstd = 1.f / sqrtf(wave_sum(s2) * (1.f / DM) + LN_EPS);
#pragma unroll
    for (int j = 0; j < 4; ++j) { const f32x4 gg = *(const f32x4*)(g + lane * 4 + 256 * j), bb = *(const f32x4*)(bt + lane * 4 + 256 * j);
        v[j] = v[j] * rstd * gg + bb;
        if (of32) *(f32x4*)(of32 + lane * 4 + 256 * j) = v[j];
        if (obf) *(unsigned long long*)(obf + lane * 4 + 256 * j) = (unsigned long long)pk2(v[j].x, v[j].y) | ((unsigned long long)pk2(v[j].z, v[j].w) << 32); }
}


constexpr int GL_QF = 0, GL_KF = 2112, GL_QB = 4224, GL_KB = 6336, GL_BC = 8448, GL_V = 12672, GL_P = 16768, GL_HF = 20928, GL_HB = 22976, GL_END = 25024;
static_assert(GL_END * 4 <= RING_BYTES, "GLA chunk image fits the ring region");
__device__ __forceinline__ void gla_stage(LAS float* L, const bf16* PROJ, const float* LA, size_t tok0, int hd, int tid) {
    __syncthreads();
#pragma unroll
    for (int r = 0; r < 8; ++r) { const int idx = tid + 512 * r, dir = idx >> 11, j = (idx >> 5) & 63, d = idx & 31; L[GL_BC + dir * 2112 + j * 33 + d] = LA[(tok0 + j) * 256 + dir * 128 + hd * 32 + d]; }
    { const int j = tid >> 3, v0 = (tid & 7) * 8; const u16x8 f = *(const u16x8*)(PROJ + (tok0 + j) * INP + C_GV + hd * 64 + v0);
#pragma unroll
      for (int i = 0; i < 8; ++i) L[GL_V + j * 64 + v0 + i] = bf2f(f[i]); }
    const int qj = tid >> 3, qd = (tid & 7) * 4;
    const u16x4 q4 = *(const u16x4*)(PROJ + (tok0 + qj) * INP + C_GQ + hd * 32 + qd), k4 = *(const u16x4*)(PROJ + (tok0 + qj) * INP + C_GK + hd * 32 + qd);
    __syncthreads();
    if (tid < 64) { const int dir = tid >> 5, d = tid & 31; LAS float* p = L + GL_BC + dir * 2112 + d; float acc = 0.f;
        if (dir == 0) { for (int j = 0; j < 64; ++j) { acc += p[j * 33]; p[j * 33] = acc; } }
        else { for (int j = 63; j >= 0; --j) { acc += p[j * 33]; p[j * 33] = acc; } } }
    __syncthreads();
#pragma unroll
    for (int i = 0; i < 4; ++i) { const float bf_ = L[GL_BC + qj * 33 + qd + i], bb_ = L[GL_BC + 2112 + qj * 33 + qd + i]; const float qv = bf2f(q4[i]) * GLA_QSCALE, kv = bf2f(k4[i]);
        L[GL_QF + qj * 33 + qd + i] = qv * expf(bf_); L[GL_KF + qj * 33 + qd + i] = kv * expf(-bf_); L[GL_QB + qj * 33 + qd + i] = qv * expf(bb_); L[GL_KB + qj * 33 + qd + i] = kv * expf(-bb_); }
    __syncthreads();
}


typedef float f32x16 __attribute__((ext_vector_type(16)));
typedef short s16x4 __attribute__((ext_vector_type(4)));
typedef float f32x2_t __attribute__((ext_vector_type(2))); typedef __bf16 bf16x2_t __attribute__((ext_vector_type(2)));
__device__ __forceinline__ unsigned cvtpk2(float lo, float hi) { f32x2_t v = {lo, hi}; bf16x2_t b = __builtin_convertvector(v, bf16x2_t); return __builtin_bit_cast(unsigned, b); }
__device__ __forceinline__ bf16x8 pack_step(const f32x16& x, int s) { v4u p; p.x = cvtpk2(x[8 * s], x[8 * s + 1]); p.y = cvtpk2(x[8 * s + 2], x[8 * s + 3]); p.z = cvtpk2(x[8 * s + 4], x[8 * s + 5]); p.w = cvtpk2(x[8 * s + 6], x[8 * s + 7]); return __builtin_bit_cast(bf16x8, p); }
__device__ __forceinline__ int crow16(int i, int h) { return (i & 3) + 8 * (i >> 2) + 4 * h; }
#define MFMA32(a, b, c) __builtin_amdgcn_mfma_f32_32x32x16_bf16((a), (b), (c), 0, 0, 0)
constexpr int FT_PITCH = 72, FT_TAB = 64 * FT_PITCH;
constexpr int FFT_LDS_TAB = 0, FFT_LDS_TW = 28672, FFT_LDS_HT = 28672, FFT_HT_PAIR = 2 * 64 * FT_PITCH * 2;

struct Args { const float* in[20]; float* out; unsigned char* ws; int ph_lo, ph_hi; };
static_assert(sizeof(Args) == 20 * 8 + 8 + 8 + 8, "no padding bytes in Args");


typedef __attribute__((address_space(4))) const unsigned char* kptr_t;
__device__ __forceinline__ kptr_t karg() { kptr_t p = (kptr_t)__builtin_amdgcn_kernarg_segment_ptr(); asm volatile("" : "+s"(p)); return p; }
#define KIN(i) (*(const float* const __attribute__((address_space(4)))*)(karg() + 8 * (i)))
#define KOUT() (*(float* const __attribute__((address_space(4)))*)(karg() + 160))
#define KWS() (*(unsigned char* const __attribute__((address_space(4)))*)(karg() + 168))
#define WSP(T, off) ((T*)(ws + (off)))

#ifndef NAIVE_ATTN
#define NAIVE_ATTN 0
#endif

__global__ void __launch_bounds__(NWAVES * 64, 2) fwd(Args args) {
    extern __shared__ __attribute__((aligned(16))) unsigned char lds_raw[];
    LAS unsigned char* lds = (LAS unsigned char*)lds_raw;
    LAS unsigned char* lctl = lds + LDSCTL_OFF;
    const int G = gridDim.x, bx = blockIdx.x;
    const int NGW = G * NWAVES, NGT = G * NWAVES * 64;
#define TID_SETUP() int tid_ = threadIdx.x; asm volatile("" : "+v"(tid_)); const int tid = tid_, lane = tid & 63, wave = __builtin_amdgcn_readfirstlane(tid >> 6); \
    const int gw = bx * NWAVES + wave, gt = bx * (NWAVES * 64) + tid; (void)lane; (void)gw; (void)gt
    for (int u = threadIdx.x; u < (LDS_BYTES - LDSCTL_OFF) / 4; u += NWAVES * 64) ((LAS unsigned*)lctl)[u] = 0u;
    __syncthreads();
    volatile LAS unsigned* MISC = (volatile LAS unsigned*)(lctl + LC_MISC);
    XcdBarrier bar = xcd_barrier_post((unsigned*)(KWS() + WS_CTL) + CW_BAR, MISC + 8);
    const int lo = args.ph_lo, hi = args.ph_hi;
#ifndef PH_OFF
#define PH_OFF 0
#endif
#define PON(j) (!((PH_OFF >> (j)) & 1))
#define IN(k) (lo <= (k) && (k) < hi)
#ifndef PROBE_A
#define PROBE_A -1
#endif
#ifndef PROBE_B
#define PROBE_B -1
#endif
#if PROBE_A >= 0
#define STAMP(k) do { if (blockIdx.x == 0 && threadIdx.x == 0) { ((unsigned long long*)(KWS() + WS_CTL + 65536))[(k)] = __builtin_amdgcn_s_memrealtime(); } } while (0)
#else
#define STAMP(k) do {} while (0)
#endif
#define SEAM(k) do { if (IN(k) && IN((k) + 1)) xcd_barrier(bar); STAMP((k) + 1); } while (0)
    STAMP(0);

    if (IN(0) && PON(0)) {
        TID_SETUP(); unsigned char* ws = KWS(); const float* x_in = KIN(0); const float* ln_in_g = KIN(1); const float* ln_in_b = KIN(2); const float* w_in = KIN(3); const float* w_out = KIN(9);
        const float* exp_w_gu = KIN(14); const float* exp_w_down = KIN(16);
        float* ROPE = WSP(float, WS_ROPE); bf16* WIN_T = WSP(bf16, WS_WIN_T); bf16* WOUT_T = WSP(bf16, WS_WOUT_T); bf16* WGU_T = WSP(bf16, WS_WGU_T); bf16* WDN_T = WSP(bf16, WS_WDN_T);
        float* HF = WSP(float, WS_HF); bf16* HB = WSP(bf16, WS_HB);
        constexpr int I_WIN = NL * 32 * 16, I_WOUT = NL * 16 * 16, I_WGU = NL * NE * 32 * 16, I_WDN = NL * NE * 16 * 16;
        constexpr int NITEMS = I_WIN + I_WOUT + I_WGU + I_WDN;
        for (int it = gw; it < NITEMS; it += NGW) {
            int r = it;
            if (r < I_WIN) { const int l = r / 512, q = r % 512, kb = q / 32, nb = q % 32, n = nb * 64 + lane;
                const int src = n < 1536 ? n : (n < 1792 ? n + 32 : (n < 1824 ? n - 256 : -1));
                tr_tile64(w_in + (size_t)l * DM * INW, DM, INW, src, WIN_T + (size_t)l * INP * DM, n, kb * 64); continue; }
            r -= I_WIN;
            if (r < I_WOUT) { const int l = r / 256, q = r % 256, kb = q / 16, nb = q % 16, n = nb * 64 + lane;
                tr_tile64(w_out + (size_t)l * DM * DM, DM, DM, n, WOUT_T + (size_t)l * DM * DM, n, kb * 64); continue; }
            r -= I_WOUT;
            if (r < I_WGU) { const int le = r / 512, q = r % 512, kb = q / 32, nb = q % 32, n = nb * 64 + lane;
                const int pn = n >> 8, bj = (n >> 7) & 1, j = n & 127, src = bj * 1024 + pn * 128 + j;
                tr_tile64(exp_w_gu + (size_t)le * DM * 2048, DM, 2048, src, WGU_T + (size_t)le * 2048 * DM, n, kb * 64); continue; }
            r -= I_WGU;
            { const int le = r / 256, q = r % 256, kb = q / 16, nb = q % 16, n = nb * 64 + lane;
                tr_tile64(exp_w_down + (size_t)le * DE * DM, DE, DM, n, WDN_T + (size_t)le * DM * DE, n, kb * 64); }
        }
        { bf16* FTAB = WSP(bf16, WS_FTAB); float* TW = WSP(float, WS_TW);
          for (int it = gt; it < 3 * FT_TAB; it += NGT) { const int t = it / FT_TAB, q = it % FT_TAB, row = q / FT_PITCH, col = q % FT_PITCH; float sn, cs; sincospif((float)((row * col) & 63) * (1.0f / 32.0f), &sn, &cs);
              const float v = col >= 64 ? 0.f : (t == 0 ? cs : (t == 1 ? sn : -sn)); FTAB[it] = (bf16)f2bf(v); }
          for (int it = gt; it < 4096; it += NGT) { float sn, cs; sincospif((float)it * (1.0f / 2048.0f), &sn, &cs); TW[2 * it] = cs; TW[2 * it + 1] = -sn; } }
        for (int it = gt; it < SEQ * 32; it += NGT) { const int t = it >> 5, i = it & 31, a = i >> 4, f = i & 15; const int pos = a ? (t & 63) : (t >> 6);
            const double inv = exp(-9.210340371976184 * (double)f / 16.0); const double ang = (double)pos * inv;
            ROPE[it] = (float)cos(ang); ROPE[SEQ * 32 + it] = (float)sin(ang); }
        for (int m = gw; m < NTOK; m += NGW) { f32x4 v[4];
#pragma unroll
            for (int j = 0; j < 4; ++j) v[j] = *(const f32x4*)(x_in + (size_t)m * DM + lane * 4 + 256 * j);
            ln_row(v, ln_in_g, ln_in_b, HF + (size_t)m * DM, HB + (size_t)m * DM, lane); }
    }
    SEAM(0);

    for (int l = 0; l < NL; ++l) {
        const int pb = 1 + 10 * l;
        if (IN(pb + 0) && PON(1)) {
            TID_SETUP(); unsigned char* ws = KWS(); bf16* HB = WSP(bf16, WS_HB); bf16* WIN_T = WSP(bf16, WS_WIN_T); bf16* PROJ = WSP(bf16, WS_PROJ);
            pg8::Gemm g{HB, WIN_T + (size_t)l * INP * DM, NTOK, INP, DM}; pg8::StaticOrder S; S.init(NTOK, INP, G, bx);
            pg8::EpiPlainBf16 E{PROJ, INP};
            pg8::gemm_phase<pg8::EpiPlainBf16, pg8::StaticOrder, true, true>(lds + RING_OFF, g, S, E);
        }
        SEAM(pb + 0);
        if (IN(pb + 1) && PON(2)) {
            TID_SETUP(); unsigned char* ws = KWS(); const float* att_q_gain = KIN(4); const float* att_k_gain = KIN(5); const float* gla_gate_w = KIN(6); const float* gla_gate_b = KIN(7);
            const float* ROPE = WSP(float, WS_ROPE); const bf16* PROJ = WSP(bf16, WS_PROJ); bf16* QB = WSP(bf16, WS_QB); bf16* KB = WSP(bf16, WS_KB); float* LA = WSP(float, WS_LA);
            const float* qg = att_q_gain + l * 64; const float* kg = att_k_gain + l * 64;
            for (int m = gw; m < NTOK; m += NGW) { const int t = m & (SEQ - 1); const int ri = (lane >> 5) * 16 + (lane & 15);
                const float cs = ROPE[t * 32 + ri], sn = ROPE[SEQ * 32 + t * 32 + ri]; const float sg = ((lane >> 4) & 1) ? 1.f : -1.f;
#pragma unroll
                for (int h = 0; h < 10; ++h) { const float xv = bf2f(PROJ[(size_t)m * INP + h * 64 + lane]);
                    const float ms = wave_sum(xv * xv) * (1.f / 64.f); const float xn = xv * (1.f / sqrtf(ms + RMS_EPS)) * (h < 8 ? qg[lane] : kg[lane]);
                    const float pr = __shfl_xor(xn, 16); float o = xn * cs + sg * pr * sn;
                    if (h < 8) { o *= QSCALE; QB[(size_t)m * 512 + h * 64 + lane] = (bf16)f2bf(o); } else KB[(size_t)m * 128 + (h - 8) * 64 + lane] = (bf16)f2bf(o); } }
            { const float* gw_l = gla_gate_w + (size_t)l * 2 * 16 * 128; const float* gb_l = gla_gate_b + (size_t)l * 2 * 128;
              for (int m = gw; m < NTOK; m += NGW) { const float lr = (lane < 32) ? bf2f(PROJ[(size_t)m * INP + C_GLR + lane]) : 0.f;
                const int dir = lane >> 5, kc = (lane & 31) * 4; f32x4 z = *(const f32x4*)(gb_l + dir * 128 + kc);
#pragma unroll
                for (int r = 0; r < 16; ++r) { const float a = __shfl(lr, dir * 16 + r); const f32x4 w = *(const f32x4*)(gw_l + (size_t)(dir * 16 + r) * 128 + kc); z = z + w * a; }
                f32x4 o;
#pragma unroll
                for (int i = 0; i < 4; ++i) o[i] = (fminf(z[i], 0.f) - log1pf(expf(-fabsf(z[i])))) * (1.f / 16.f);
                *(f32x4*)(LA + (size_t)m * 256 + dir * 128 + kc) = o; } }
            { __syncthreads();
              { const v4u* src = (const v4u*)WSP(bf16, WS_FTAB); LAS v4u* dst = (LAS v4u*)(lds + RING_OFF + FFT_LDS_TAB); for (int i = tid; i < 3 * FT_TAB * 2 / 16; i += NWAVES * 64) dst[i] = src[i];
                const v4u* s2_ = (const v4u*)WSP(float, WS_TW); LAS v4u* d2_ = (LAS v4u*)(lds + RING_OFF + FFT_LDS_TW); for (int i = tid; i < 4096 * 8 / 16; i += NWAVES * 64) d2_[i] = s2_[i]; }
              __syncthreads();
              const LAS bf16* FT = (const LAS bf16*)(lds + RING_OFF + FFT_LDS_TAB); const LAS float* TWL = (const LAS float*)(lds + RING_OFF + FFT_LDS_TW); bf16* FTMP = WSP(bf16, WS_FTMP);
              const int pair = wave >> 1, cb = wave & 1, r = lane & 31, h = lane >> 5;
              for (int ub = bx; ub < NB * 4 * 64 / 4; ub += G) { const int u = ub * 4 + pair, s2 = u & 63, g4 = (u >> 6) & 3, b = u >> 8;
                bf16x8 xa[2][4];
#pragma unroll
                for (int R = 0; R < 2; ++R)
#pragma unroll
                    for (int ks = 0; ks < 4; ++ks) xa[R][ks] = *(const bf16x8*)(PROJ + ((size_t)b * SEQ + 64 * (32 * R + r) + s2) * INP + C_FX + g4 * 64 + 16 * ks + 8 * h);
                f32x16 Tr[2], Ti[2];
#pragma unroll
                for (int R = 0; R < 2; ++R)
#pragma unroll
                    for (int i = 0; i < 16; ++i) { Tr[R][i] = 0.f; Ti[R][i] = 0.f; }
#pragma unroll
                for (int ks = 0; ks < 4; ++ks) { const bf16x8 bc = *(const LAS bf16x8*)(FT + (32 * cb + r) * FT_PITCH + 16 * ks + 8 * h), bs = *(const LAS bf16x8*)(FT + 2 * FT_TAB + (32 * cb + r) * FT_PITCH + 16 * ks + 8 * h);
#pragma unroll
                    for (int R = 0; R < 2; ++R) { Tr[R] = MFMA32(xa[R][ks], bc, Tr[R]); Ti[R] = MFMA32(xa[R][ks], bs, Ti[R]); } }
#pragma unroll
                for (int Rp = 0; Rp < 2; ++Rp) { f32x16 Gr, Gi;
#pragma unroll
                    for (int i = 0; i < 16; ++i) { Gr[i] = 0.f; Gi[i] = 0.f; }
#pragma unroll
                    for (int R = 0; R < 2; ++R)
#pragma unroll
                        for (int s_ = 0; s_ < 2; ++s_) { const bf16x8 xr = pack_step(Tr[R], s_), xi = pack_step(Ti[R], s_);
                            const int kb = 32 * R + 16 * s_ + 4 * h, ro = (32 * Rp + r) * FT_PITCH + kb;
                            const s16x4 c0 = *(const LAS s16x4*)(FT + ro), c1 = *(const LAS s16x4*)(FT + ro + 8), s0 = *(const LAS s16x4*)(FT + FT_TAB + ro), s1 = *(const LAS s16x4*)(FT + FT_TAB + ro + 8),
                                        n0 = *(const LAS s16x4*)(FT + 2 * FT_TAB + ro), n1 = *(const LAS s16x4*)(FT + 2 * FT_TAB + ro + 8);
                            const bf16x8 ca = __builtin_shufflevector(c0, c1, 0, 1, 2, 3, 4, 5, 6, 7), sa = __builtin_shufflevector(s0, s1, 0, 1, 2, 3, 4, 5, 6, 7), na = __builtin_shufflevector(n0, n1, 0, 1, 2, 3, 4, 5, 6, 7);
                            Gr = MFMA32(ca, xr, Gr); Gr = MFMA32(sa, xi, Gr); Gi = MFMA32(ca, xi, Gi); Gi = MFMA32(na, xr, Gi); }
#pragma unroll
                    for (int i = 0; i < 16; ++i) { const int s1p = 32 * Rp + crow16(i, h); const int m = (s2 * s1p) & 4095; const float wr = TWL[2 * m], wi = TWL[2 * m + 1];
                        const size_t o = ((((size_t)(b * 4 + g4) * 64 + s1p) * 2) * 64 + s2) * 64 + 32 * cb + r;
                        FTMP[o] = (bf16)f2bf(Gr[i] * wr - Gi[i] * wi); FTMP[o + 4096] = (bf16)f2bf(Gr[i] * wi + Gi[i] * wr); } }
              }
              __syncthreads(); }
            { LAS float* L = (LAS float*)(lds + RING_OFF); float* GS = WSP(float, WS_OF); float* GD = WSP(float, WS_OB);
              for (int u = bx; u < NB * 4 * 64; u += G) { const int c = u & 63, bh = u >> 6, hd = bh & 3, b = bh >> 2; const size_t tok0 = (size_t)b * SEQ + c * 64;
                gla_stage(L, PROJ, LA, tok0, hd, tid);
                const int dir = tid >> 8, d0 = ((tid >> 4) & 15) * 2, v0 = (tid & 15) * 4; const LAS float* Kd = L + (dir ? GL_KB : GL_KF);
                f32x4 a0 = {0.f, 0.f, 0.f, 0.f}, a1 = {0.f, 0.f, 0.f, 0.f};
#pragma unroll 8
                for (int j = 0; j < 64; ++j) { const float k0 = Kd[j * 33 + d0], k1 = Kd[j * 33 + d0 + 1]; const f32x4 vv = *(const LAS f32x4*)(L + GL_V + j * 64 + v0); a0 = a0 + vv * k0; a1 = a1 + vv * k1; }
                const int jl = dir ? 0 : 63; const float D0 = expf(L[GL_BC + dir * 2112 + jl * 33 + d0]), D1 = expf(L[GL_BC + dir * 2112 + jl * 33 + d0 + 1]);
                const size_t sidx = ((size_t)u * 2 + dir);
                *(f32x4*)(GS + sidx * 2048 + d0 * 64 + v0) = a0 * D0; *(f32x4*)(GS + sidx * 2048 + (d0 + 1) * 64 + v0) = a1 * D1;
                if ((tid & 15) == 0) { GD[sidx * 32 + d0] = D0; GD[sidx * 32 + d0 + 1] = D1; } }
              __syncthreads(); }
        }
        SEAM(pb + 1);
        if (IN(pb + 2) && PON(3)) {
            TID_SETUP(); unsigned char* ws = KWS(); float* GS = WSP(float, WS_OF); const float* GD = WSP(float, WS_OB);
            for (int e = gt; e < NB * 4 * 2 * 2048; e += NGT) { const int dv = e & 2047, dir = (e >> 11) & 1, bh = e >> 12, d = dv >> 6; float H = 0.f;
                for (int c8 = 0; c8 < 64; c8 += 8) { float sv[8], dd[8];
#pragma unroll
                    for (int i = 0; i < 8; ++i) { const int c = dir ? 63 - (c8 + i) : (c8 + i); const size_t sidx = ((size_t)(bh * 64 + c) * 2 + dir); sv[i] = GS[sidx * 2048 + dv]; dd[i] = GD[sidx * 32 + d]; }
#pragma unroll
                    for (int i = 0; i < 8; ++i) { const int c = dir ? 63 - (c8 + i) : (c8 + i); const size_t sidx = ((size_t)(bh * 64 + c) * 2 + dir); GS[sidx * 2048 + dv] = H; H = H * dd[i] + sv[i]; } } }
        }
        SEAM(pb + 2);
        if (IN(pb + 3) && PON(4)) {
            TID_SETUP(); unsigned char* ws = KWS(); const float* gla_norm_g = KIN(8); const bf16* PROJ = WSP(bf16, WS_PROJ);
            bf16* MIX = WSP(bf16, WS_MIX); const bf16* QB = WSP(bf16, WS_QB); const bf16* KB = WSP(bf16, WS_KB);
            { __syncthreads();
              { const v4u* src = (const v4u*)WSP(bf16, WS_FTAB); LAS v4u* dst = (LAS v4u*)(lds + RING_OFF + FFT_LDS_TAB); for (int i = tid; i < 3 * FT_TAB * 2 / 16; i += NWAVES * 64) dst[i] = src[i]; }
              const LAS bf16* FT = (const LAS bf16*)(lds + RING_OFF + FFT_LDS_TAB); const bf16* FTMP = WSP(bf16, WS_FTMP);
              const int pair = wave >> 1, cb = wave & 1, r = lane & 31, h = lane >> 5;
              LAS bf16* HT = (LAS bf16*)(lds + RING_OFF + FFT_LDS_HT + pair * FFT_HT_PAIR);
              for (int ub = bx; ub < NB * 4 * 64 / 4; ub += G) { const int u = ub * 4 + pair, s1p = u & 63, g4 = (u >> 6) & 3, b = u >> 8;
                const bf16* src = FTMP + (size_t)u * 2 * 4096;
                __syncthreads();
#pragma unroll
                for (int q = 0; q < 8; ++q) { const int p = cb * 64 + lane + 128 * q, ri = p >> 9, s2 = (p >> 3) & 63, c0 = (p & 7) * 8; const u16x8 v = *(const u16x8*)(src + p * 8);
#pragma unroll
                    for (int i = 0; i < 8; ++i) HT[(ri * 64 + c0 + i) * FT_PITCH + s2] = v[i]; }
                __syncthreads();
#pragma unroll
                for (int Rp = 0; Rp < 2; ++Rp) { f32x16 acc;
#pragma unroll
                    for (int i = 0; i < 16; ++i) acc[i] = 0.f;
#pragma unroll
                    for (int ks = 0; ks < 4; ++ks) { const int ko = 16 * ks + 8 * h;
                        const bf16x8 ca = *(const LAS bf16x8*)(FT + (32 * Rp + r) * FT_PITCH + ko), sa = *(const LAS bf16x8*)(FT + FT_TAB + (32 * Rp + r) * FT_PITCH + ko);
                        const bf16x8 hr = *(const LAS bf16x8*)(HT + (32 * cb + r) * FT_PITCH + ko), hi_ = *(const LAS bf16x8*)(HT + (64 + 32 * cb + r) * FT_PITCH + ko);
                        acc = MFMA32(ca, hr, acc); acc = MFMA32(sa, hi_, acc); }
#pragma unroll
                    for (int i = 0; i < 16; ++i) { const int s2p = 32 * Rp + crow16(i, h); MIX[((size_t)b * SEQ + s1p + 64 * s2p) * DM + 768 + g4 * 64 + 32 * cb + r] = (bf16)f2bf(acc[i] * (1.0f / 512.0f)); } }
              }
              __syncthreads(); }
            { LAS float* L = (LAS float*)(lds + RING_OFF); const float* GS = WSP(float, WS_OF); const float* LA = WSP(float, WS_LA);
              for (int u = bx; u < NB * 4 * 64; u += G) { const int c = u & 63, bh = u >> 6, hd = bh & 3, b = bh >> 2; const size_t tok0 = (size_t)b * SEQ + c * 64;
                gla_stage(L, PROJ, LA, tok0, hd, tid);
                { const f32x4* src = (const f32x4*)(GS + (size_t)u * 2 * 2048) + tid * 2; LAS f32x4* dst = (LAS f32x4*)(L + GL_HF) + tid * 2; dst[0] = src[0]; dst[1] = src[1]; }
                const int i0 = (tid >> 4) * 2, j0 = (tid & 15) * 4;
                { float pf[2][4], pb[2][4];
#pragma unroll
                  for (int a_ = 0; a_ < 2; ++a_)
#pragma unroll
                      for (int c_ = 0; c_ < 4; ++c_) { pf[a_][c_] = 0.f; pb[a_][c_] = 0.f; }
#pragma unroll 4
                  for (int d = 0; d < 32; ++d) { const float qf0 = L[GL_QF + i0 * 33 + d], qf1 = L[GL_QF + (i0 + 1) * 33 + d], qb0 = L[GL_QB + i0 * 33 + d], qb1 = L[GL_QB + (i0 + 1) * 33 + d];
#pragma unroll
                      for (int c_ = 0; c_ < 4; ++c_) { const float kf = L[GL_KF + (j0 + c_) * 33 + d], kb = L[GL_KB + (j0 + c_) * 33 + d]; pf[0][c_] += qf0 * kf; pf[1][c_] += qf1 * kf; pb[0][c_] += qb0 * kb; pb[1][c_] += qb1 * kb; } }
#pragma unroll
                  for (int a_ = 0; a_ < 2; ++a_)
#pragma unroll
                      for (int c_ = 0; c_ < 4; ++c_) L[GL_P + (i0 + a_) * 65 + j0 + c_] = (j0 + c_ <= i0 + a_) ? pf[a_][c_] : pb[a_][c_]; }
                __syncthreads();
                f32x4 o0 = {0.f, 0.f, 0.f, 0.f}, o1 = {0.f, 0.f, 0.f, 0.f}; const int v0 = j0;
#pragma unroll 8
                for (int j = 0; j < 64; ++j) { const float p0 = L[GL_P + i0 * 65 + j], p1 = L[GL_P + (i0 + 1) * 65 + j]; const f32x4 vv = *(const LAS f32x4*)(L + GL_V + j * 64 + v0); o0 = o0 + vv * p0; o1 = o1 + vv * p1; }
#pragma unroll 8
                for (int d = 0; d < 32; ++d) { const f32x4 hf = *(const LAS f32x4*)(L + GL_HF + d * 64 + v0), hb = *(const LAS f32x4*)(L + GL_HB + d * 64 + v0);
                    o0 = o0 + hf * L[GL_QF + i0 * 33 + d] + hb * L[GL_QB + i0 * 33 + d]; o1 = o1 + hf * L[GL_QF + (i0 + 1) * 33 + d] + hb * L[GL_QB + (i0 + 1) * 33 + d]; }
                float s0 = (o0.x * o0.x + o0.y * o0.y) + (o0.z * o0.z + o0.w * o0.w), s1 = (o1.x * o1.x + o1.y * o1.y) + (o1.z * o1.z + o1.w * o1.w);
#pragma unroll
                for (int m_ = 1; m_ < 16; m_ <<= 1) { s0 += __shfl_xor(s0, m_); s1 += __shfl_xor(s1, m_); }
                const f32x4 gn = *(const f32x4*)(gla_norm_g + l * 64 + v0);
#pragma unroll
                for (int a_ = 0; a_ < 2; ++a_) { const f32x4 ov = a_ ? o1 : o0; const float rs = 1.f / sqrtf((a_ ? s1 : s0) * (1.f / 64.f) + RMS_EPS); const size_t m = tok0 + i0 + a_;
                    const u16x4 r4 = *(const u16x4*)(PROJ + m * INP + C_GR + hd * 64 + v0); float y[4];
#pragma unroll
                    for (int i = 0; i < 4; ++i) { const float r = bf2f(r4[i]); y[i] = ov[i] * rs * gn[i] * (r / (1.f + expf(-r))); }
                    *(unsigned long long*)(MIX + m * DM + 512 + hd * 64 + v0) = (unsigned long long)pk2(y[0], y[1]) | ((unsigned long long)pk2(y[2], y[3]) << 32); } }
              __syncthreads(); }
#if NAIVE_ATTN
            { LAS float* Kt = (LAS float*)(lds + RING_OFF); LAS float* Vt = Kt + 64 * 64;
              for (int unit = bx; unit < NB * 8 * 8; unit += G) { const int rb = unit & 7, h = (unit >> 3) & 7, b = unit >> 6, kvh = h >> 2;
                const size_t qrow = (size_t)b * SEQ + rb * 512 + tid;
                float q[64], o[64]; float mrun = -INFINITY, lrun = 0.f;
#pragma unroll
                for (int c8 = 0; c8 < 8; ++c8) { const u16x8 f = *(const u16x8*)(QB + qrow * 512 + h * 64 + c8 * 8);
#pragma unroll
                    for (int i = 0; i < 8; ++i) { q[c8 * 8 + i] = bf2f(f[i]); o[c8 * 8 + i] = 0.f; } }
                for (int kt = 0; kt < SEQ; kt += 64) {
                    __syncthreads();
                    { const int kr = tid >> 3, c8 = (tid & 7) * 8; const size_t krow = (size_t)b * SEQ + kt + kr;
                      const u16x8 kf = *(const u16x8*)(KB + krow * 128 + kvh * 64 + c8); const u16x8 vf = *(const u16x8*)(PROJ + krow * INP + C_AV + kvh * 64 + c8);
#pragma unroll
                      for (int i = 0; i < 8; ++i) { Kt[kr * 64 + c8 + i] = bf2f(kf[i]); Vt[kr * 64 + c8 + i] = bf2f(vf[i]); } }
                    __syncthreads();
#pragma unroll 1
                    for (int j = 0; j < 64; ++j) { float a = 0.f;
#pragma unroll
                        for (int d4 = 0; d4 < 16; ++d4) { const f32x4 kv = *(const LAS f32x4*)(Kt + j * 64 + d4 * 4); a += (q[d4 * 4] * kv.x + q[d4 * 4 + 1] * kv.y) + (q[d4 * 4 + 2] * kv.z + q[d4 * 4 + 3] * kv.w); }
                        if (a > mrun) { const float al = exp2f(mrun - a); mrun = a; lrun *= al;
#pragma unroll
                            for (int d = 0; d < 64; ++d) o[d] *= al; }
                        const float p = exp2f(a - mrun); lrun += p;
#pragma unroll
                        for (int d4 = 0; d4 < 16; ++d4) { const f32x4 vv = *(const LAS f32x4*)(Vt + j * 64 + d4 * 4); o[d4 * 4] += p * vv.x; o[d4 * 4 + 1] += p * vv.y; o[d4 * 4 + 2] += p * vv.z; o[d4 * 4 + 3] += p * vv.w; } }
                }
                const float rl = 1.f / lrun;
#pragma unroll
                for (int c8 = 0; c8 < 8; ++c8) { v4u w; w.x = pk2(o[c8 * 8] * rl, o[c8 * 8 + 1] * rl); w.y = pk2(o[c8 * 8 + 2] * rl, o[c8 * 8 + 3] * rl); w.z = pk2(o[c8 * 8 + 4] * rl, o[c8 * 8 + 5] * rl); w.w = pk2(o[c8 * 8 + 6] * rl, o[c8 * 8 + 7] * rl);
                    *(v4u*)(MIX + qrow * DM + h * 64 + c8 * 8) = w; }
              }
              __syncthreads(); }
#else
            { const attn_body::AttnTensors AT{(const attn_body::bf16*)QB, (const attn_body::bf16*)KB, (const attn_body::bf16*)(PROJ + C_AV), (attn_body::bf16*)MIX};
              const attn_body::StaticOrder S(G, bx);
              attn_body::attn_phase<attn_body::StaticOrder>((char*)lds_raw + RING_OFF, AT, S); }
#endif
        }
        SEAM(pb + 3);
        if (IN(pb + 4) && PON(5)) {
            TID_SETUP(); unsigned char* ws = KWS(); const bf16* MIX = WSP(bf16, WS_MIX); const bf16* WOUT_T = WSP(bf16, WS_WOUT_T); const float* HF = WSP(float, WS_HF); float* T1 = WSP(float, WS_T1);
            pg8::Gemm g{MIX, WOUT_T + (size_t)l * DM * DM, NTOK, DM, DM}; pg8::StaticOrder S; S.init(NTOK, DM, G, bx);
            pg8::EpiResF32 E{HF, T1, DM, DN_ALPHA};
            pg8::gemm_phase<pg8::EpiResF32, pg8::StaticOrder, true, true>(lds + RING_OFF, g, S, E);
        }
        SEAM(pb + 4);
        if (IN(pb + 5) && PON(6)) {
            TID_SETUP(); unsigned char* ws = KWS(); gu32* ctl = (gu32*)(ws + WS_CTL); const float* ln1_g = KIN(10); const float* ln1_b = KIN(11); const float* router_w = KIN(12); const float* router_b = KIN(13);
            const float* T1 = WSP(float, WS_T1); float* HF = WSP(float, WS_HF); bf16* HB = WSP(bf16, WS_HB); int* TOKE = WSP(int, WS_TOK); int* TOKS = TOKE + NTOK * 4; float* TOKW = (float*)(TOKS + NTOK * 4); int* LIST = WSP(int, WS_XS);
            LAS float* RW = (LAS float*)(lds + RING_OFF);
            { const float* rw = router_w + (size_t)l * DM * NE; for (int i = tid; i < DM * NE; i += NWAVES * 64) { const int c = i >> 5, e = i & 31; RW[e * DM + c] = rw[i]; } }
            LAS int* lcnt = (LAS int*)(lctl + LC_CNT); LAS int* lbase = (LAS int*)(lctl + LC_BASE); LAS int* sele = (LAS int*)(lctl + LC_SELE); LAS int* sels = (LAS int*)(lctl + LC_SELS);
            const float* rb = router_b + l * NE;
            for (int r0 = bx * 128; r0 < NTOK; r0 += G * 128) {
                if (tid < 32) lcnt[tid] = 0;
                __syncthreads();
                for (int rr = 0; rr < 16; ++rr) { const int lr = wave * 16 + rr; const size_t m = (size_t)r0 + lr; f32x4 v[4];
#pragma unroll
                    for (int j = 0; j < 4; ++j) v[j] = *(const f32x4*)(T1 + m * DM + lane * 4 + 256 * j);
                    ln_row(v, ln1_g + l * DM, ln1_b + l * DM, HF + m * DM, HB + m * DM, lane);
                    float lg[32];
#pragma unroll
                    for (int e = 0; e < 32; ++e) { float a = 0.f;
#pragma unroll
                        for (int j = 0; j < 4; ++j) { const f32x4 w = *(const LAS f32x4*)(RW + e * DM + lane * 4 + 256 * j); a += (v[j].x * w.x + v[j].y * w.y) + (v[j].z * w.z + v[j].w * w.w); }
                        lg[e] = wave_sum(a) + rb[e]; }
                    int se[4]; float sv[4];
#pragma unroll
                    for (int k = 0; k < 4; ++k) { float best = -INFINITY; int bi = 0;
#pragma unroll
                        for (int e = 0; e < 32; ++e) { if (lg[e] > best) { best = lg[e]; bi = e; } }
                        se[k] = bi; sv[k] = best;
#pragma unroll
                        for (int e = 0; e < 32; ++e) if (e == bi) lg[e] = -INFINITY; }
                    const float e1 = expf(sv[1] - sv[0]), e2 = expf(sv[2] - sv[0]), e3 = expf(sv[3] - sv[0]); const float inv = 1.f / (1.f + e1 + e2 + e3);
                    if (lane == 0) { const float wts[4] = {inv, e1 * inv, e2 * inv, e3 * inv};
#pragma unroll
                        for (int k = 0; k < 4; ++k) { const int ls = __hip_atomic_fetch_add(lcnt + se[k], 1, __ATOMIC_RELAXED, __HIP_MEMORY_SCOPE_WORKGROUP); sele[lr * 4 + k] = se[k]; sels[lr * 4 + k] = ls; TOKW[m * 4 + k] = wts[k]; } }
                }
                __syncthreads();
                if (tid < 32) lbase[tid] = (int)__hip_atomic_fetch_add(ctl + CW_CNT + l * 32 + tid, (unsigned)lcnt[tid], RLX_AGENT);
                __syncthreads();
                { const int e = sele[tid], sl = lbase[e] + sels[tid]; TOKE[(size_t)r0 * 4 + tid] = e; TOKS[(size_t)r0 * 4 + tid] = sl; LIST[(size_t)e * NTOK + sl] = r0 + (tid >> 2); }
                __syncthreads();
            }
        }
        SEAM(pb + 5);
        STAMP(pb + 7);
        if (IN(pb + 7) || IN(pb + 8) || IN(pb + 9)) {
            LAS int* pst = (LAS int*)(lctl + LC_PSTART); LAS int* ecnt = (LAS int*)(lctl + LC_BASE); gu32* ctl = (gu32*)(KWS() + WS_CTL);
            __syncthreads();
            if (threadIdx.x == 0) { int acc = 0; for (int e = 0; e < NE; ++e) { pst[e] = acc; const int c = (int)__hip_atomic_load(ctl + CW_CNT + l * 32 + e, RLX_AGENT); ecnt[e] = c; acc += (c + 255) >> 8; } pst[NE] = acc; }
            __syncthreads();
        }
        if (IN(pb + 7) && PON(8)) {
            TID_SETUP(); unsigned char* ws = KWS(); const float* exp_b_gu = KIN(15); const bf16* HB = WSP(bf16, WS_HB); const int* LIST = WSP(int, WS_XS); const bf16* WGU_T = WSP(bf16, WS_WGU_T); bf16* HID = WSP(bf16, WS_HID);
            const LAS int* pst = (const LAS int*)(lctl + LC_PSTART); LAS int* ul = (LAS int*)(lctl + LC_ULIST);
            const int nM = pst[NE], nN = 8, nwg = nM * nN;
            if (tid < 64) { const long L = (long)tid * G + bx; int v = -1;
                if (L < nwg) { int wgid = (int)L; { const int q = nwg / 8, r = nwg % 8, xcd = wgid % 8, off = wgid / 8; wgid = (xcd < r ? xcd * (q + 1) : r * (q + 1) + (xcd - r) * q) + off; }
                    const int nig = 8 * nN, gid = wgid / nig, fm = gid * 8, gsz = (nM - fm) < 8 ? (nM - fm) : 8; const int pm = fm + ((wgid % nig) % gsz), pn = (wgid % nig) / gsz;
                    int e = 0; for (int k = 1; k < NE; ++k) if (pst[k] <= pm) e = k;
                    v = (pm << 16) | (e * nN + pn); }
                ul[tid] = v; }
            __syncthreads();
            const int nunits = bx < nwg ? (nwg - bx + G - 1) / G : 0;
            LAS unsigned short* rows16 = (LAS unsigned short*)(lctl + LC_ROWS); const LAS int* ecnt = (const LAS int*)(lctl + LC_BASE);
            for (int sl = 0; sl < nunits; ++sl) { const int v = ul[sl]; const int pm = v >> 16, e = (v & 0xffff) >> 3, pl = pm - pst[e];
                if (tid < 256) { const int idx = pl * 256 + tid; rows16[sl * 256 + tid] = (idx < ecnt[e]) ? (unsigned short)LIST[(size_t)e * NTOK + idx] : (unsigned short)0; } }
            __syncthreads();
            pg8::Gemm g{HB, WGU_T + (size_t)l * NE * 2048 * DM, NTOK, NE * 2048, DM}; pg8::ListOrder S{ul, nunits};
            pg8::EpiSwiglu E{HID, exp_b_gu + (size_t)l * NE * 2048};
            pg8::gemm_phase_gather<pg8::EpiSwiglu, pg8::ListOrder, true>(lds + RING_OFF, g, S, E, rows16);
        }
        SEAM(pb + 7);
        if (IN(pb + 8) && PON(9)) {
            TID_SETUP(); unsigned char* ws = KWS(); const float* exp_b_down = KIN(17); const bf16* HID = WSP(bf16, WS_HID); const bf16* WDN_T = WSP(bf16, WS_WDN_T); bf16* YS = WSP(bf16, WS_YS);
            const LAS int* pst = (const LAS int*)(lctl + LC_PSTART); LAS int* ul = (LAS int*)(lctl + LC_ULIST);
            const int nM = pst[NE], nN = 4, nwg = nM * nN;
            __syncthreads();
            if (tid < 64) { const long L = (long)tid * G + bx; int v = -1;
                if (L < nwg) { int wgid = (int)L; { const int q = nwg / 8, r = nwg % 8, xcd = wgid % 8, off = wgid / 8; wgid = (xcd < r ? xcd * (q + 1) : r * (q + 1) + (xcd - r) * q) + off; }
                    const int nig = 8 * nN, gid = wgid / nig, fm = gid * 8, gsz = (nM - fm) < 8 ? (nM - fm) : 8; const int pm = fm + ((wgid % nig) % gsz), pn = (wgid % nig) / gsz;
                    int e = 0; for (int k = 1; k < NE; ++k) if (pst[k] <= pm) e = k;
                    v = (pm << 16) | (e * nN + pn); }
                ul[tid] = v; }
            __syncthreads();
            const int nunits = bx < nwg ? (nwg - bx + G - 1) / G : 0;
            pg8::Gemm g{HID, WDN_T + (size_t)l * NE * DM * DE, MPAD, NE * DM, DE}; pg8::ListOrder S{ul, nunits};
            pg8::EpiDown E{YS, exp_b_down + (size_t)l * NE * DM};
            pg8::gemm_phase<pg8::EpiDown, pg8::ListOrder, true, true>(lds + RING_OFF, g, S, E);
        }
        SEAM(pb + 8);
        if (IN(pb + 9) && PON(10)) {
            TID_SETUP(); unsigned char* ws = KWS(); const float* ln2_g = KIN(18); const float* ln2_b = KIN(19); float* out = KOUT(); float* HF = WSP(float, WS_HF); bf16* HB = WSP(bf16, WS_HB);
            const bf16* YS = WSP(bf16, WS_YS); const int* TOKE = WSP(int, WS_TOK); const int* TOKS = TOKE + NTOK * 4; const float* TOKW = (const float*)(TOKS + NTOK * 4); const LAS int* pst = (const LAS int*)(lctl + LC_PSTART);
            const bool lastl = (l == NL - 1);
            for (int m = gw; m < NTOK; m += NGW) { f32x4 v[4];
#pragma unroll
                for (int j = 0; j < 4; ++j) v[j] = *(const f32x4*)(HF + (size_t)m * DM + lane * 4 + 256 * j) * DN_ALPHA;
#pragma unroll
                for (int k = 0; k < 4; ++k) { const float w = TOKW[m * 4 + k]; const bf16* yr = YS + (size_t)(pst[TOKE[m * 4 + k]] * 256 + TOKS[m * 4 + k]) * DM;
#pragma unroll
                    for (int j = 0; j < 4; ++j) { const u16x4 y = *(const u16x4*)(yr + lane * 4 + 256 * j); v[j].x += w * bf2f(y[0]); v[j].y += w * bf2f(y[1]); v[j].z += w * bf2f(y[2]); v[j].w += w * bf2f(y[3]); } }
                ln_row(v, ln2_g + l * DM, ln2_b + l * DM, lastl ? out + (size_t)m * DM : HF + (size_t)m * DM, lastl ? nullptr : HB + (size_t)m * DM, lane); }
        }
        SEAM(pb + 9);
    }
#if PROBE_A >= 0
    { xcd_barrier(bar);
      const unsigned long long* st = (const unsigned long long*)(KWS() + WS_CTL + 65536); unsigned long long T = 0;
      if (PROBE_A & 1) T += st[1] - st[0];
      for (int l = 0; l < NL; ++l) for (int j = 1; j <= 10; ++j) if ((PROBE_A >> j) & 1) T += st[1 + 10 * l + j] - st[10 * l + j];
      T *= 4ull; if (T > 5000000ull) T = 5000000ull;
      const unsigned long long t0 = __builtin_amdgcn_s_memrealtime();
      while (__builtin_amdgcn_s_memrealtime() - t0 < T) __builtin_amdgcn_s_sleep(16); }
#endif
#undef IN
#undef SEAM
}

#ifndef MK_PER_PHASE
#define MK_PER_PHASE 0
#endif
extern "C" void kernel_launch(void* const* d_in, const int* in_sizes, int n_in, void* d_out, int out_size, void* d_ws, size_t ws_size, hipStream_t stream) {
    static int grid = 0;
    if (grid == 0) {
        if (n_in != 20 || in_sizes[0] != NTOK * DM || out_size != NTOK * DM || ws_size < WS_END) { fprintf(stderr, "kernel_launch: unexpected shapes (n_in %d, in0 %d, out %d, ws %zu); nothing launched\n", n_in, n_in > 0 ? in_sizes[0] : -1, out_size, ws_size); grid = -1; return; }
        int dev = 0, cus = 0, per_cu = 0;
        if (hipGetDevice(&dev) != hipSuccess || hipDeviceGetAttribute(&cus, hipDeviceAttributeMultiprocessorCount, dev) != hipSuccess) { grid = -1; return; }
        if (hipFuncSetAttribute((const void*)fwd, hipFuncAttributeMaxDynamicSharedMemorySize, LDS_BYTES) != hipSuccess) { fprintf(stderr, "kernel_launch: hipFuncSetAttribute failed\n"); grid = -1; return; }
        if (hipOccupancyMaxActiveBlocksPerMultiprocessor(&per_cu, (const void*)fwd, NWAVES * 64, LDS_BYTES) != hipSuccess || per_cu < 1) fprintf(stderr, "kernel_launch: occupancy query reports %d\n", per_cu);
        (void)hipGetLastError();
        grid = cus;
    }
    if (grid < 0) return;
    if (hipMemsetAsync((char*)d_ws + WS_CTL, 0, CTL_ZERO_BYTES, stream) != hipSuccess) return;
    Args a{};
    for (int i = 0; i < 20; ++i) a.in[i] = (const float*)d_in[i];
    a.out = (float*)d_out; a.ws = (unsigned char*)d_ws;
#if MK_PER_PHASE
    for (int p = 0; p < N_PHASES; ++p) { a.ph_lo = p; a.ph_hi = p + 1; hipLaunchKernelGGL(fwd, dim3(grid), dim3(NWAVES * 64), LDS_BYTES, stream, a); }
#else
    a.ph_lo = 0; a.ph_hi = N_PHASES;
    hipLaunchKernelGGL(fwd, dim3(grid), dim3(NWAVES * 64), LDS_BYTES, stream, a);
#endif
    const hipError_t le = hipPeekAtLastError();
    if (le != hipSuccess) fprintf(stderr, "kernel_launch: launch failed: %s\n", hipGetErrorName(le));
}
```

```cpp
#include <hip/hip_runtime.h>
#include <hip/hip_bf16.h>
#include <cstdio>
#include <cstdint>
#include <cmath>
namespace pg8 {
#define PG8_LAS __attribute__((address_space(3)))
typedef unsigned short bf16_t;
typedef short bf16x8 __attribute__((ext_vector_type(8)));
typedef float f32x4 __attribute__((ext_vector_type(4)));
typedef unsigned u32x4 __attribute__((ext_vector_type(4)));
constexpr int BM = 256, BK = 64, HALF = 128, HTB = HALF * BK * 2  , STAGE_BYTES = 8 * HTB, NXCD = 8, WGM = 8;

__host__ __device__ __forceinline__ int lds_byte(int r, int c) { const int st = (r >> 4) * 2 + (c >> 5), rr = r & 15, cc = c & 31, ob = rr * 64 + cc * 2; return st * 1024 + (ob ^ (((ob >> 9) & 1) << 5)); }
__host__ __device__ __forceinline__ void stage_rc(int b, int& R, int& C) { const int st = b / 1024, sb = b % 1024, swz = sb ^ (((sb >> 9) & 1) << 5); R = (st >> 1) * 16 + swz / 64; C = (st & 1) * 32 + (swz % 64) / 2; }
__host__ __device__ __forceinline__ int perm32(int rho) { const int n = rho >> 4, i = rho & 15; return 8 * (i >> 2) + 4 * n + (i & 3); }

struct Unit { int pm, pn; };
struct Gemm { const bf16_t* A; const bf16_t* Bt; int M, N, K; };

struct StaticOrder {
    int nM, nN, nwg, G, c;
    __host__ __device__ void init(int M, int N, int G_, int c_) { nM = M / BM; nN = N / BM; nwg = nM * nN; G = G_; c = c_; }
    __host__ __device__ bool next(int i, Unit& u) const {
        const long L = (long)i * G + c; if (L >= nwg) return false;
        int wgid = (int)L; { const int q = nwg / NXCD, r = nwg % NXCD, xcd = wgid % NXCD, off = wgid / NXCD; wgid = (xcd < r ? xcd * (q + 1) : r * (q + 1) + (xcd - r) * q) + off; }
        const int nig = WGM * nN, gid = wgid / nig, fm = gid * WGM, gsz = (nM - fm) < WGM ? (nM - fm) : WGM;
        u.pm = fm + ((wgid % nig) % gsz); u.pn = (wgid % nig) / gsz; return true;
    }
    __device__ __forceinline__ void a_ready(const Unit&) const {}
    __device__ __forceinline__ void done(const Unit&) const {}
};

__device__ __forceinline__ unsigned cvt_pk_bf16(float lo, float hi) { unsigned r; asm volatile("v_cvt_pk_bf16_f32 %0, %1, %2" : "=v"(r) : "v"(lo), "v"(hi)); return r; }
typedef float f32x2 __attribute__((ext_vector_type(2)));
__device__ __forceinline__ u32x4 pack8(const f32x4 v0, const f32x4 v1) { u32x4 w; w.x = cvt_pk_bf16(v0[0], v0[1]); w.y = cvt_pk_bf16(v0[2], v0[3]); w.z = cvt_pk_bf16(v1[0], v1[1]); w.w = cvt_pk_bf16(v1[2], v1[3]); return w; }

struct EpiPlainBf16 {
    static constexpr bool PERM = true, AFTER_DRAIN = false;
    bf16_t* O; int ldc;
    __device__ __forceinline__ void operator()(const f32x4 (&acc)[2][2][4][2], const Unit& u, int wr, int wc, int fr, int fq) const {
        const int row0 = u.pm * BM + wr * 64 + fr, col0 = u.pn * BM + wc * 32 + 8 * fq;
#pragma unroll
        for (int ai = 0; ai < 2; ++ai)
#pragma unroll
            for (int m = 0; m < 4; ++m) { bf16_t* rowp = O + (size_t)(row0 + ai * HALF + m * 16) * ldc + col0;
#pragma unroll
                for (int bj = 0; bj < 2; ++bj) *(u32x4*)(rowp + bj * HALF) = pack8(acc[ai][bj][m][0], acc[ai][bj][m][1]); }
    }
};
struct EpiFnet {
    static constexpr bool PERM = true, AFTER_DRAIN = false;
    bf16_t* MIX;
    __device__ __forceinline__ void operator()(const f32x4 (&acc)[2][2][4][2], const Unit& u, int wr, int wc, int fr, int fq) const {
        const int row0 = u.pn * 4096 + u.pm * BM + wr * 64 + fr, col0 = 768 + wc * 32 + 8 * fq;
#pragma unroll
        for (int ai = 0; ai < 2; ++ai)
#pragma unroll
            for (int m = 0; m < 4; ++m) { bf16_t* rowp = MIX + (size_t)(row0 + ai * HALF + m * 16) * 1024 + col0;
#pragma unroll
                for (int bj = 0; bj < 2; ++bj) *(u32x4*)(rowp + bj * HALF) = pack8(acc[ai][bj][m][0], acc[ai][bj][m][1]); }
    }
};
struct EpiResF32 {
    static constexpr bool PERM = false, AFTER_DRAIN = false;
    const float* base; float* out; int ldc; float alpha;
    __device__ __forceinline__ void operator()(const f32x4 (&acc)[2][2][4][2], const Unit& u, int wr, int wc, int fr, int fq) const {
        const int row0 = u.pm * BM + wr * 64 + fr, col0 = u.pn * BM + wc * 32 + 4 * fq;
#pragma unroll
        for (int ai = 0; ai < 2; ++ai)
#pragma unroll
            for (int m = 0; m < 4; ++m) { const size_t off = (size_t)(row0 + ai * HALF + m * 16) * ldc + col0;
#pragma unroll
                for (int bj = 0; bj < 2; ++bj)
#pragma unroll
                    for (int n = 0; n < 2; ++n) { const f32x4 b = *(const f32x4*)(base + off + bj * HALF + n * 16); *(f32x4*)(out + off + bj * HALF + n * 16) = b * alpha + acc[ai][bj][m][n]; } }
    }
};
__device__ __forceinline__ float swiglu1(float g, float u) { g = fminf(g, 7.0f); u = fminf(fmaxf(u, -7.0f), 7.0f); return (u + 1.0f) * g * __builtin_amdgcn_rcpf(1.0f + __expf(-1.702f * g)); }
struct EpiSwiglu {
    static constexpr bool PERM = true, AFTER_DRAIN = false;
    bf16_t* HID; const float* bgu;
    __device__ __forceinline__ void operator()(const f32x4 (&acc)[2][2][4][2], const Unit& u, int wr, int wc, int fr, int fq) const {
        const int e = u.pn >> 3, pnl = u.pn & 7; const int row0 = u.pm * BM + wr * 64 + fr, jj0 = pnl * 128 + wc * 32 + 8 * fq;
        const float* bg = bgu + (size_t)e * 2048 + jj0;
        const f32x4 bg0 = *(const f32x4*)bg, bg1 = *(const f32x4*)(bg + 4), bu0 = *(const f32x4*)(bg + 1024), bu1 = *(const f32x4*)(bg + 1028);
#pragma unroll
        for (int ai = 0; ai < 2; ++ai)
#pragma unroll
            for (int m = 0; m < 4; ++m) { bf16_t* rowp = HID + (size_t)(row0 + ai * HALF + m * 16) * 1024 + jj0;
                const f32x4 g0 = acc[ai][0][m][0] + bg0, g1 = acc[ai][0][m][1] + bg1, u0 = acc[ai][1][m][0] + bu0, u1 = acc[ai][1][m][1] + bu1;
                f32x4 h0, h1;
#pragma unroll
                for (int i = 0; i < 4; ++i) { h0[i] = swiglu1(g0[i], u0[i]); h1[i] = swiglu1(g1[i], u1[i]); }
                *(u32x4*)rowp = pack8(h0, h1); }
    }
};
struct EpiDown {
    static constexpr bool PERM = true, AFTER_DRAIN = false;
    bf16_t* Y; const float* bd;
    __device__ __forceinline__ void operator()(const f32x4 (&acc)[2][2][4][2], const Unit& u, int wr, int wc, int fr, int fq) const {
        const int e = u.pn >> 2, pnl = u.pn & 3; const int row0 = u.pm * BM + wr * 64 + fr, col0 = pnl * BM + wc * 32 + 8 * fq;
        const float* bp = bd + (size_t)e * 1024 + col0;
        f32x4 bv[2][2];
#pragma unroll
        for (int bj = 0; bj < 2; ++bj)
#pragma unroll
            for (int n = 0; n < 2; ++n) bv[bj][n] = *(const f32x4*)(bp + bj * HALF + 4 * n);
#pragma unroll
        for (int ai = 0; ai < 2; ++ai)
#pragma unroll
            for (int m = 0; m < 4; ++m) { bf16_t* rowp = Y + (size_t)(row0 + ai * HALF + m * 16) * 1024 + col0;
#pragma unroll
                for (int bj = 0; bj < 2; ++bj) *(u32x4*)(rowp + bj * HALF) = pack8(acc[ai][bj][m][0] + bv[bj][0], acc[ai][bj][m][1] + bv[bj][1]); }
    }
};
struct ListOrder {
    const PG8_LAS int* list; int n;
    __device__ __forceinline__ bool next(int i, Unit& u) const { if (i >= n) return false; const int v = __builtin_amdgcn_readfirstlane(list[i]); u.pm = v >> 16; u.pn = v & 0xffff; return true; }
    __device__ __forceinline__ void a_ready(const Unit&) const {}
    __device__ __forceinline__ void done(const Unit&) const {}
};
template <class Epi, class Sched, bool ALIGN_EPI = false, bool SP2 = false>
__device__ __forceinline__ void gemm_phase(PG8_LAS unsigned char* lds, const Gemm g, const Sched& S, const Epi& E) {
    int tid_ = threadIdx.x; asm volatile("" : "+v"(tid_));
    const int tid = tid_, wid = __builtin_amdgcn_readfirstlane(tid >> 6), lane = tid & 63, wr = wid >> 2, wc = wid & 3, fr = lane & 15, fq = lane >> 4;
    const int K = g.K, nt = K / BK;
    unsigned voffA[2], voffB[2];
#pragma unroll
    for (int i = 0; i < 2; ++i) { int R, C; stage_rc(tid * 16 + i * 8192, R, C); const int Rb = Epi::PERM ? ((R & ~31) + perm32(R & 31)) : R;
        voffA[i] = (unsigned)(R * K + C) * 2u; voffB[i] = (unsigned)(Rb * K + C) * 2u; }
    const size_t kstep = (size_t)(BK * 2);
    const size_t hstep = (size_t)HALF * K * 2;
    const size_t tstep = 2 * hstep;
    const unsigned ldsw = (unsigned)wid * 1024u;
    const int aoff = lds_byte(wr * 64 + fr, fq * 8), boff = lds_byte(wc * 32 + fr, fq * 8);
#define PG8_SA(b, h) (((b) * 2 + (h)) * HTB)
#define PG8_SB(b, h) ((4 + (b) * 2 + (h)) * HTB)
#define PG8_STAGE(bufoff, gbase, voff) do { _Pragma("unroll") for (int _i = 0; _i < 2; ++_i) \
        __builtin_amdgcn_global_load_lds((const unsigned*)((const char*)(gbase) + (voff)[_i]), (PG8_LAS unsigned*)(lds + (bufoff) + ldsw + _i * 8192), 16, 0, 0); } while (0)
#define PG8_LDA(dst, b, h) do { _Pragma("unroll") for (int m = 0; m < 4; ++m) _Pragma("unroll") for (int k = 0; k < 2; ++k) dst[m][k] = *(const PG8_LAS bf16x8*)(lds + PG8_SA(b, h) + aoff + m * 2048 + k * 1024); } while (0)
#define PG8_LDB(dst, b, h) do { _Pragma("unroll") for (int n = 0; n < 2; ++n) _Pragma("unroll") for (int k = 0; k < 2; ++k) dst[n][k] = *(const PG8_LAS bf16x8*)(lds + PG8_SB(b, h) + boff + n * 2048 + k * 1024); } while (0)
#define PG8_MMA(ai, bj, At, Bt) do { __builtin_amdgcn_s_setprio(1); _Pragma("unroll") for (int m = 0; m < 4; ++m) _Pragma("unroll") for (int n = 0; n < 2; ++n) _Pragma("unroll") for (int k = 0; k < 2; ++k) \
        acc[ai][bj][m][n] = __builtin_amdgcn_mfma_f32_16x16x32_bf16(Bt[n][k], At[m][k], acc[ai][bj][m][n], 0, 0, 0); __builtin_amdgcn_s_setprio(0); } while (0)
#define PG8_WAIT_V(n) asm volatile("s_waitcnt vmcnt(" #n ")" ::: "memory")
#define PG8_WAIT_L(n) asm volatile("s_waitcnt lgkmcnt(" #n ")" ::: "memory")
#define PG8_BAR __builtin_amdgcn_s_barrier()
#define PG8_SCHED __builtin_amdgcn_sched_barrier(0)
    Unit cur, nxt; int ui = 0;
    if (!S.next(0, cur)) return;
    f32x4 acc[2][2][4][2];
#pragma unroll
    for (int a = 0; a < 2; ++a)
#pragma unroll
        for (int b = 0; b < 2; ++b)
#pragma unroll
            for (int m = 0; m < 4; ++m)
#pragma unroll
                for (int n = 0; n < 2; ++n) acc[a][b][m][n] = (f32x4){0.f, 0.f, 0.f, 0.f};
    bf16x8 At[4][2], B0[2][2], B1[2][2];
    const char* cA = (const char*)g.A + (size_t)cur.pm * tstep; const char* cB = (const char*)g.Bt + (size_t)cur.pn * tstep;
    S.a_ready(cur);
    if constexpr (SP2) {
        PG8_STAGE(PG8_SB(0, 0), cB, voffB); PG8_STAGE(PG8_SB(0, 1), cB + hstep, voffB); PG8_STAGE(PG8_SA(0, 0), cA, voffA); PG8_STAGE(PG8_SA(0, 1), cA + hstep, voffA);
        if (wr == 1) PG8_BAR;
        PG8_WAIT_V(2); PG8_BAR;
        PG8_STAGE(PG8_SB(1, 0), cB + kstep, voffB); PG8_STAGE(PG8_SA(1, 0), cA + kstep, voffA); PG8_STAGE(PG8_SB(1, 1), cB + hstep + kstep, voffB);
        PG8_WAIT_V(6); PG8_BAR;
    } else {
        PG8_STAGE(PG8_SB(0, 0), cB, voffB); PG8_STAGE(PG8_SA(0, 0), cA, voffA); PG8_STAGE(PG8_SB(0, 1), cB + hstep, voffB); PG8_STAGE(PG8_SA(0, 1), cA + hstep, voffA);
        if (wr == 1) PG8_BAR;
        PG8_WAIT_V(4); PG8_BAR;
        PG8_STAGE(PG8_SB(1, 0), cB + kstep, voffB); PG8_STAGE(PG8_SA(1, 0), cA + kstep, voffA); PG8_STAGE(PG8_SB(1, 1), cB + hstep + kstep, voffB);
        PG8_WAIT_V(6); PG8_BAR;
    }
    for (;;) {
        const bool has_next = S.next(ui + 1, nxt);
        const char* nA = has_next ? (const char*)g.A + (size_t)nxt.pm * tstep : cA; const char* nB = has_next ? (const char*)g.Bt + (size_t)nxt.pn * tstep : cB;
        for (int t = 0; t < nt; t += 2) {
            const bool last = (t == nt - 2);
            const char* a1 = cA + (size_t)(t + 1) * kstep;
            const char* a2 = last ? nA : cA + (size_t)(t + 2) * kstep; const char* b2 = last ? nB : cB + (size_t)(t + 2) * kstep;
            const char* a3 = a2 + kstep; const char* b3 = b2 + kstep;
            if (last && has_next) S.a_ready(nxt);
            if constexpr (SP2) {
            PG8_LDB(B0, 0, 0); PG8_LDB(B1, 0, 1); PG8_SCHED; PG8_LDA(At, 0, 0); PG8_STAGE(PG8_SA(1, 1), a1 + hstep, voffA);
            PG8_WAIT_V(8); PG8_WAIT_L(0); PG8_BAR; PG8_MMA(0, 0, At, B0); PG8_MMA(0, 1, At, B1); PG8_BAR; PG8_SCHED;
            PG8_LDA(At, 0, 1); PG8_STAGE(PG8_SB(0, 0), b2, voffB); PG8_STAGE(PG8_SB(0, 1), b2 + hstep, voffB); PG8_STAGE(PG8_SA(0, 0), a2, voffA);
            PG8_WAIT_V(8); PG8_WAIT_L(0); PG8_BAR; PG8_MMA(1, 0, At, B0); PG8_MMA(1, 1, At, B1); PG8_BAR; PG8_SCHED;
            PG8_LDB(B0, 1, 0); PG8_LDB(B1, 1, 1); PG8_SCHED; PG8_LDA(At, 1, 0); PG8_STAGE(PG8_SA(0, 1), a2 + hstep, voffA);
            PG8_WAIT_V(8); PG8_WAIT_L(0); PG8_BAR; PG8_MMA(0, 0, At, B0); PG8_MMA(0, 1, At, B1); PG8_BAR; PG8_SCHED;
            PG8_LDA(At, 1, 1); PG8_STAGE(PG8_SB(1, 0), b3, voffB); PG8_STAGE(PG8_SB(1, 1), b3 + hstep, voffB); PG8_STAGE(PG8_SA(1, 0), a3, voffA);
            PG8_WAIT_V(8); PG8_WAIT_L(0); PG8_BAR; PG8_MMA(1, 0, At, B0); PG8_MMA(1, 1, At, B1); PG8_BAR; PG8_SCHED;
            } else {
            PG8_LDB(B0, 0, 0); PG8_SCHED; PG8_LDA(At, 0, 0); PG8_STAGE(PG8_SA(1, 1), a1 + hstep, voffA);
            PG8_WAIT_L(8); PG8_BAR; PG8_WAIT_L(0); PG8_MMA(0, 0, At, B0); PG8_BAR; PG8_SCHED;
            PG8_LDB(B1, 0, 1); PG8_STAGE(PG8_SB(0, 0), b2, voffB);
            PG8_BAR; PG8_WAIT_L(0); PG8_MMA(0, 1, At, B1); PG8_BAR;
            PG8_LDA(At, 0, 1); PG8_STAGE(PG8_SA(0, 0), a2, voffA);
            PG8_BAR; PG8_WAIT_L(0); PG8_MMA(1, 0, At, B0); PG8_BAR; PG8_SCHED;
            PG8_STAGE(PG8_SB(0, 1), b2 + hstep, voffB);
            PG8_WAIT_V(6); PG8_BAR; PG8_MMA(1, 1, At, B1); PG8_BAR;
            PG8_LDB(B0, 1, 0); PG8_SCHED; PG8_LDA(At, 1, 0); PG8_STAGE(PG8_SA(0, 1), a2 + hstep, voffA);
            PG8_WAIT_L(8); PG8_BAR; PG8_WAIT_L(0); PG8_MMA(0, 0, At, B0); PG8_BAR; PG8_SCHED;
            PG8_LDB(B1, 1, 1); PG8_STAGE(PG8_SB(1, 0), b3, voffB);
            PG8_BAR; PG8_WAIT_L(0); PG8_MMA(0, 1, At, B1); PG8_BAR;
            PG8_LDA(At, 1, 1); PG8_STAGE(PG8_SA(1, 0), a3, voffA);
            PG8_BAR; PG8_WAIT_L(0); PG8_MMA(1, 0, At, B0); PG8_BAR; PG8_SCHED;
            PG8_STAGE(PG8_SB(1, 1), b3 + hstep, voffB);
            PG8_WAIT_V(6); PG8_BAR; PG8_MMA(1, 1, At, B1); PG8_BAR;
            }
        }
        if constexpr (ALIGN_EPI) { if (wr == 0) PG8_BAR; }
        if constexpr (!Epi::AFTER_DRAIN) { E(acc, cur, wr, wc, fr, fq); S.done(cur); }
        if (!has_next) break;
#pragma unroll
        for (int a = 0; a < 2; ++a)
#pragma unroll
            for (int b = 0; b < 2; ++b)
#pragma unroll
                for (int m = 0; m < 4; ++m)
#pragma unroll
                    for (int n = 0; n < 2; ++n) acc[a][b][m][n] = (f32x4){0.f, 0.f, 0.f, 0.f};
        cur = nxt; cA = nA; cB = nB; ++ui;
        if constexpr (ALIGN_EPI) { if (wr == 1) PG8_BAR; }
    }
    PG8_WAIT_V(0);
    if constexpr (!ALIGN_EPI) { if (wr == 0) PG8_BAR; }
    PG8_BAR;
    if constexpr (Epi::AFTER_DRAIN) { E.fused(acc, cur, wr, wc, fr, fq, lds, wid, lane); S.done(cur); }
#undef PG8_SA
#undef PG8_SB
#undef PG8_STAGE
#undef PG8_LDA
#undef PG8_LDB
#undef PG8_MMA
#undef PG8_WAIT_V
#undef PG8_WAIT_L
#undef PG8_BAR
#undef PG8_SCHED
}
}
namespace pg8 {
template <class Epi, class Sched, bool ALIGN_EPI>
__device__ __forceinline__ void gemm_phase_gather(PG8_LAS unsigned char* lds, const Gemm g, const Sched& S, const Epi& E, const PG8_LAS unsigned short* rows16) {
    int tid_ = threadIdx.x; asm volatile("" : "+v"(tid_));
    const int tid = tid_, wid = __builtin_amdgcn_readfirstlane(tid >> 6), lane = tid & 63, wr = wid >> 2, wc = wid & 3, fr = lane & 15, fq = lane >> 4;
    const int K = g.K, nt = K / BK;
    unsigned voffB[2]; int RA[2]; unsigned CA2[2];
#pragma unroll
    for (int i = 0; i < 2; ++i) { int R, C; stage_rc(tid * 16 + i * 8192, R, C); const int Rb = Epi::PERM ? ((R & ~31) + perm32(R & 31)) : R;
        RA[i] = R; CA2[i] = (unsigned)C * 2u; voffB[i] = (unsigned)(Rb * K + C) * 2u; }
    const size_t kstep = (size_t)(BK * 2);
    const size_t hstep = (size_t)HALF * K * 2;
    const size_t tstep = 2 * hstep;
    const unsigned ldsw = (unsigned)wid * 1024u;
    const unsigned rowb = (unsigned)K * 2u;
    const int aoff = lds_byte(wr * 64 + fr, fq * 8), boff = lds_byte(wc * 32 + fr, fq * 8);
#define PG8_SA(b, h) (((b) * 2 + (h)) * HTB)
#define PG8_SB(b, h) ((4 + (b) * 2 + (h)) * HTB)
#define PG8_STAGE(bufoff, gbase, voff) do { _Pragma("unroll") for (int _i = 0; _i < 2; ++_i) \
        __builtin_amdgcn_global_load_lds((const unsigned*)((const char*)(gbase) + (voff)[_i]), (PG8_LAS unsigned*)(lds + (bufoff) + ldsw + _i * 8192), 16, 0, 0); } while (0)
#define PG8_LDA(dst, b, h) do { _Pragma("unroll") for (int m = 0; m < 4; ++m) _Pragma("unroll") for (int k = 0; k < 2; ++k) dst[m][k] = *(const PG8_LAS bf16x8*)(lds + PG8_SA(b, h) + aoff + m * 2048 + k * 1024); } while (0)
#define PG8_LDB(dst, b, h) do { _Pragma("unroll") for (int n = 0; n < 2; ++n) _Pragma("unroll") for (int k = 0; k < 2; ++k) dst[n][k] = *(const PG8_LAS bf16x8*)(lds + PG8_SB(b, h) + boff + n * 2048 + k * 1024); } while (0)
#define PG8_MMA(ai, bj, At, Bt) do { __builtin_amdgcn_s_setprio(1); _Pragma("unroll") for (int m = 0; m < 4; ++m) _Pragma("unroll") for (int n = 0; n < 2; ++n) _Pragma("unroll") for (int k = 0; k < 2; ++k) \
        acc[ai][bj][m][n] = __builtin_amdgcn_mfma_f32_16x16x32_bf16(Bt[n][k], At[m][k], acc[ai][bj][m][n], 0, 0, 0); __builtin_amdgcn_s_setprio(0); } while (0)
#define PG8_WAIT_V(n) asm volatile("s_waitcnt vmcnt(" #n ")" ::: "memory")
#define PG8_WAIT_L(n) asm volatile("s_waitcnt lgkmcnt(" #n ")" ::: "memory")
#define PG8_BAR __builtin_amdgcn_s_barrier()
#define PG8_SCHED __builtin_amdgcn_sched_barrier(0)
#define PG8_GOFF(dst, U) do { _Pragma("unroll") for (int h_ = 0; h_ < 2; ++h_) _Pragma("unroll") for (int i_ = 0; i_ < 2; ++i_) dst[h_][i_] = (unsigned)rows16[(U) * 256 + h_ * HALF + RA[i_]] * rowb + CA2[i_]; } while (0)
    Unit cur, nxt; int ui = 0;
    if (!S.next(0, cur)) return;
    f32x4 acc[2][2][4][2];
#pragma unroll
    for (int a = 0; a < 2; ++a)
#pragma unroll
        for (int b = 0; b < 2; ++b)
#pragma unroll
            for (int m = 0; m < 4; ++m)
#pragma unroll
                for (int n = 0; n < 2; ++n) acc[a][b][m][n] = (f32x4){0.f, 0.f, 0.f, 0.f};
    bf16x8 At[4][2], B0[2][2], B1[2][2];
    const char* const Ab = (const char*)g.A;
    const char* cB = (const char*)g.Bt + (size_t)cur.pn * tstep;
    unsigned gc[2][2], gn[2][2];
    PG8_GOFF(gc, 0);
    S.a_ready(cur);
    PG8_STAGE(PG8_SB(0, 0), cB, voffB); PG8_STAGE(PG8_SB(0, 1), cB + hstep, voffB); PG8_STAGE(PG8_SA(0, 0), Ab, gc[0]); PG8_STAGE(PG8_SA(0, 1), Ab, gc[1]);
    if (wr == 1) PG8_BAR;
    PG8_WAIT_V(2); PG8_BAR;
    PG8_STAGE(PG8_SB(1, 0), cB + kstep, voffB); PG8_STAGE(PG8_SA(1, 0), Ab + kstep, gc[0]); PG8_STAGE(PG8_SB(1, 1), cB + hstep + kstep, voffB);
    PG8_WAIT_V(6); PG8_BAR;
    for (;;) {
        const bool has_next = S.next(ui + 1, nxt);
        const char* nB = has_next ? (const char*)g.Bt + (size_t)nxt.pn * tstep : cB;
        if (has_next) { PG8_GOFF(gn, ui + 1); } else {
#pragma unroll
            for (int h_ = 0; h_ < 2; ++h_)
#pragma unroll
                for (int i_ = 0; i_ < 2; ++i_) gn[h_][i_] = gc[h_][i_]; }
        for (int t = 0; t < nt; t += 2) {
            const bool last = (t == nt - 2);
            const char* a1 = Ab + (size_t)(t + 1) * kstep;
            const char* a2 = last ? Ab : Ab + (size_t)(t + 2) * kstep; const char* b2 = last ? nB : cB + (size_t)(t + 2) * kstep;
            const char* a3 = a2 + kstep; const char* b3 = b2 + kstep;
            unsigned g2[2][2];
#pragma unroll
            for (int h_ = 0; h_ < 2; ++h_)
#pragma unroll
                for (int i_ = 0; i_ < 2; ++i_) g2[h_][i_] = last ? gn[h_][i_] : gc[h_][i_];
            if (last && has_next) S.a_ready(nxt);
            PG8_LDB(B0, 0, 0); PG8_LDB(B1, 0, 1); PG8_SCHED; PG8_LDA(At, 0, 0); PG8_STAGE(PG8_SA(1, 1), a1, gc[1]);
            PG8_WAIT_V(8); PG8_WAIT_L(0); PG8_BAR; PG8_MMA(0, 0, At, B0); PG8_MMA(0, 1, At, B1); PG8_BAR; PG8_SCHED;
            PG8_LDA(At, 0, 1); PG8_STAGE(PG8_SB(0, 0), b2, voffB); PG8_STAGE(PG8_SB(0, 1), b2 + hstep, voffB); PG8_STAGE(PG8_SA(0, 0), a2, g2[0]);
            PG8_WAIT_V(8); PG8_WAIT_L(0); PG8_BAR; PG8_MMA(1, 0, At, B0); PG8_MMA(1, 1, At, B1); PG8_BAR; PG8_SCHED;
            PG8_LDB(B0, 1, 0); PG8_LDB(B1, 1, 1); PG8_SCHED; PG8_LDA(At, 1, 0); PG8_STAGE(PG8_SA(0, 1), a2, g2[1]);
            PG8_WAIT_V(8); PG8_WAIT_L(0); PG8_BAR; PG8_MMA(0, 0, At, B0); PG8_MMA(0, 1, At, B1); PG8_BAR; PG8_SCHED;
            PG8_LDA(At, 1, 1); PG8_STAGE(PG8_SB(1, 0), b3, voffB); PG8_STAGE(PG8_SB(1, 1), b3 + hstep, voffB); PG8_STAGE(PG8_SA(1, 0), a3, g2[0]);
            PG8_WAIT_V(8); PG8_WAIT_L(0); PG8_BAR; PG8_MMA(1, 0, At, B0); PG8_MMA(1, 1, At, B1); PG8_BAR; PG8_SCHED;
        }
        if constexpr (ALIGN_EPI) { if (wr == 0) PG8_BAR; }
        E(acc, cur, wr, wc, fr, fq); S.done(cur);
        if (!has_next) break;
#pragma unroll
        for (int a = 0; a < 2; ++a)
#pragma unroll
            for (int b = 0; b < 2; ++b)
#pragma unroll
                for (int m = 0; m < 4; ++m)
#pragma unroll
                    for (int n = 0; n < 2; ++n) acc[a][b][m][n] = (f32x4){0.f, 0.f, 0.f, 0.f};
        cur = nxt; cB = nB; ++ui;
#pragma unroll
        for (int h_ = 0; h_ < 2; ++h_)
#pragma unroll
            for (int i_ = 0; i_ < 2; ++i_) gc[h_][i_] = gn[h_][i_];
        if constexpr (ALIGN_EPI) { if (wr == 1) PG8_BAR; }
    }
    PG8_WAIT_V(0);
    if constexpr (!ALIGN_EPI) { if (wr == 0) PG8_BAR; }
    PG8_BAR;
#undef PG8_SA
#undef PG8_SB
#undef PG8_STAGE
#undef PG8_LDA
#undef PG8_LDB
#undef PG8_MMA
#undef PG8_WAIT_V
#undef PG8_WAIT_L
#undef PG8_BAR
#undef PG8_SCHED
#undef PG8_GOFF
}
}
#define GAS __attribute__((address_space(1)))
#define LAS __attribute__((address_space(3)))
typedef unsigned short bf16;
typedef unsigned v4u __attribute__((ext_vector_type(4)));
typedef float f32x4 __attribute__((ext_vector_type(4)));
typedef short bf16x8 __attribute__((ext_vector_type(8)));
typedef GAS unsigned gu32;
typedef GAS unsigned long long gu64;
#define RLX_AGENT __ATOMIC_RELAXED, __HIP_MEMORY_SCOPE_AGENT
#define LDS_WAIT() asm volatile("s_waitcnt lgkmcnt(0)" ::: "memory")
#define VM_WAIT() asm volatile("s_waitcnt vmcnt(0)" ::: "memory")
__device__ __forceinline__ unsigned long long rt() { return __builtin_amdgcn_s_memrealtime(); }
__device__ __forceinline__ unsigned f2bf(float f) { unsigned u = __builtin_bit_cast(unsigned, f); return (u + 0x7fffu + ((u >> 16) & 1u)) >> 16; }
__device__ __forceinline__ unsigned pk2(float lo, float hi) { return f2bf(lo) | (f2bf(hi) << 16); }
#define XB_TMO      128
#define XB_XCNT(j)  (256  + 64 * (j))
#define XB_XSUB(j)  (1280 + 64 * (j))
#define XB_XGEN(j)  (2304 + 64 * (j))
#define XB_TOP      3328
#define XB_TOPGEN   3392
#define XCD_BAR_WORDS 3456
#define XB_SPIN_CAP (1u << 18)

__device__ __forceinline__ unsigned xb_ld(unsigned* p)              { return __hip_atomic_load(p, __ATOMIC_RELAXED, __HIP_MEMORY_SCOPE_AGENT); }
__device__ __forceinline__ unsigned xb_add(unsigned* p, unsigned v) { return __hip_atomic_fetch_add(p, v, __ATOMIC_RELAXED, __HIP_MEMORY_SCOPE_AGENT); }
__device__ __forceinline__ unsigned xb_xcc_id() { return (unsigned)__builtin_amdgcn_s_getreg((3 << 11) | 20) & 0xFu; }
#define XB_SPIN(cond, bar) do { unsigned _sp = 0; while (cond) { __builtin_amdgcn_s_sleep(1); \
    if ((++_sp & 255u) == 0u) { if (xb_ld(&(bar)[XB_TMO])) break; if (_sp > XB_SPIN_CAP) { atomicAdd(&(bar)[XB_TMO], 1u); break; } } } } while (0)

struct XcdBarrier {
    unsigned* bar; unsigned x;
    volatile LAS unsigned* st;
};

__device__ __forceinline__ XcdBarrier xcd_barrier_post(unsigned* bar, volatile LAS unsigned* st) {
    XcdBarrier b; b.bar = bar; b.x = xb_xcc_id(); b.st = st;
    if (threadIdx.x == 0) (void)xb_add(&bar[XB_XCNT(b.x)], 1u);
    return b;
}
__device__ __forceinline__ void xcd_barrier_complete(unsigned* bar, unsigned x, unsigned& nloc, unsigned& nx) {
    const unsigned G = gridDim.x * gridDim.y * gridDim.z;
    unsigned sum, cnt, mine, sp = 0u;
    for (;;) {
        sum = 0u; cnt = 0u; mine = 0u;
#pragma unroll
        for (unsigned j = 0; j < 16; ++j) { const unsigned c = xb_ld(&bar[XB_XCNT(j)]); sum += c; cnt += (c > 0u) ? 1u : 0u; mine = (j == x) ? c : mine; }
        if (sum == G) break;
        __builtin_amdgcn_s_sleep(1);
        if ((++sp & 255u) == 0u) { if (xb_ld(&bar[XB_TMO])) break; if (sp > XB_SPIN_CAP) { atomicAdd(&bar[XB_TMO], 1u); break; } }
    }
    nloc = mine > 0u ? mine : 1u; nx = cnt > 0u ? cnt : 1u;
}

__device__ __forceinline__ void xcd_barrier(const XcdBarrier& b) {
    asm volatile("s_waitcnt vmcnt(0)" ::: "memory");
    __syncthreads();
    if (threadIdx.x == 0) {
        unsigned* bar = b.bar;
        __builtin_amdgcn_s_waitcnt(0);
        unsigned nloc = b.st[0], nx = b.st[1];
        if (nloc == 0u) { xcd_barrier_complete(bar, b.x, nloc, nx); b.st[0] = nloc; b.st[1] = nx; }
        const unsigned old = xb_add(&bar[XB_XSUB(b.x)], 1u);
        const unsigned gen = old / nloc;
        if (old + 1u == (gen + 1u) * nloc) {
            __builtin_amdgcn_fence(__ATOMIC_RELEASE, "agent");
            asm volatile("s_waitcnt vmcnt(0)" ::: "memory");
            const unsigned og = xb_add(&bar[XB_TOP], 1u);
            const unsigned tg = og / nx;
            if (og + 1u == (tg + 1u) * nx) xb_add(&bar[XB_TOPGEN], 1u);
            else XB_SPIN(xb_ld(&bar[XB_TOPGEN]) == tg, bar);
            __builtin_amdgcn_fence(__ATOMIC_ACQUIRE, "agent");
            xb_add(&bar[XB_XGEN(b.x)], 1u);
            asm volatile("s_waitcnt vmcnt(0)" ::: "memory");
        } else {
            XB_SPIN(xb_ld(&bar[XB_XGEN(b.x)]) == gen, bar);
            __builtin_amdgcn_fence(__ATOMIC_ACQUIRE, "agent");
            asm volatile("s_waitcnt vmcnt(0)" ::: "memory");
        }
    }
    __syncthreads();
}
namespace attn_body {
using bf16=__hip_bfloat16;
using bf16x8=__attribute__((ext_vector_type(8)))short;
using s16x4=__attribute__((ext_vector_type(4)))short;
using f32x16=__attribute__((ext_vector_type(16)))float;
using u32x4=__attribute__((ext_vector_type(4)))unsigned;
constexpr int BATCH=8,NHEAD=8,NKVH=2,SEQ=4096,D=64;
constexpr int DMQ=512,DMK=128,DMV=2048,DMO=1024;
constexpr int NW=8,QBLK=32,QB=QBLK*NW,KVBLK=64,NQB=SEQ/QB;
constexpr int ATTN_UNIT_ROWS=QB;
__device__ __forceinline__ int crow(int r,int hi){return (r&3)+8*(r>>2)+4*hi;}
#define SBAR() __builtin_amdgcn_sched_barrier(0)
__device__ __forceinline__ void cmask(f32x16&p0,f32x16&p1,int jb,int qrel,int hi){
  const float NEG=-INFINITY; int kb=64*jb+4*hi;
  #pragma unroll
  for(int r=0;r<16;++r){int kv=kb+(r&3)+8*(r>>2); if(kv>qrel)p0[r]=NEG; if(kv+32>qrel)p1[r]=NEG;}
}

constexpr int NSLOT=3, SLOTB=8192;
constexpr int LDS_K=0, LDS_V=NSLOT*SLOTB, LDS_WS=2*NSLOT*SLOTB, LDS_OST=LDS_WS+NW*64*4, LDS_BYTES=LDS_OST+NW*4096;
constexpr float C2=0.125f*1.4426950408889634f;
__device__ __forceinline__ void glds16(const void*gsrc,unsigned lds_dst){unsigned keep;
  asm volatile("s_mov_b32 %0, m0\n\ts_mov_b32 m0, %2\n\ts_nop 0\n\tglobal_load_lds_dwordx4 %1, off\n\ts_mov_b32 m0, %0":"=&s"(keep):"v"(gsrc),"s"(lds_dst):"memory");}
__device__ __forceinline__ float max3f(float a,float b,float c){float r;asm("v_max3_f32 %0, %1, %2, %3":"=v"(r):"v"(a),"v"(b),"v"(c));return r;}
__device__ __forceinline__ float max2f(float a,float b){float r;asm("v_max_f32_e32 %0, %1, %2":"=v"(r):"v"(a),"v"(b));return r;}
__device__ __forceinline__ float fadd_s(float a,float b){float r;asm("v_add_f32_e32 %0, %1, %2":"=v"(r):"v"(a),"v"(b));return r;}
__device__ __forceinline__ float fsub_s(float a,float b){float r;asm("v_sub_f32_e32 %0, %1, %2":"=v"(r):"v"(a),"v"(b));return r;}
typedef float f32x2_t __attribute__((ext_vector_type(2))); typedef __bf16 bf16x2_t __attribute__((ext_vector_type(2)));
__device__ __forceinline__ unsigned cvtpk_s(float lo,float hi){f32x2_t v={lo,hi};bf16x2_t b=__builtin_convertvector(v,bf16x2_t);return __builtin_bit_cast(unsigned,b);}
#define WAIT_BAR(N) asm volatile("s_waitcnt vmcnt(" #N ") lgkmcnt(0)\n\ts_barrier":::"memory")

__device__ __forceinline__ void qkt(f32x16&p0,f32x16&p1,const char*Kslot,const bf16x8*qr,const f32x16&negm,int r32,int hi){
  const char*kb=Kslot+hi*1024+r32*16;
  #pragma unroll
  for(int d0=0;d0<4;++d0){
    const bf16x8 b0=*reinterpret_cast<const bf16x8*>(kb+d0*2048);
    const bf16x8 b1=*reinterpret_cast<const bf16x8*>(kb+d0*2048+512);
    if(d0==0){p0=__builtin_amdgcn_mfma_f32_32x32x16_bf16(b0,qr[0],negm,0,0,0);p1=__builtin_amdgcn_mfma_f32_32x32x16_bf16(b1,qr[0],negm,0,0,0);}
    else{p0=__builtin_amdgcn_mfma_f32_32x32x16_bf16(b0,qr[d0],p0,0,0,0);p1=__builtin_amdgcn_mfma_f32_32x32x16_bf16(b1,qr[d0],p1,0,0,0);}}
}
typedef __attribute__((address_space(3))) const char* lds_cptr;
typedef short v4i16_t __attribute__((ext_vector_type(4)));
__device__ __forceinline__ void kload8(bf16x8*kf,lds_cptr kp){
  kf[0]=*(const __attribute__((address_space(3))) bf16x8*)(kp);      kf[1]=*(const __attribute__((address_space(3))) bf16x8*)(kp+512);
  kf[2]=*(const __attribute__((address_space(3))) bf16x8*)(kp+2048); kf[3]=*(const __attribute__((address_space(3))) bf16x8*)(kp+2560);
  kf[4]=*(const __attribute__((address_space(3))) bf16x8*)(kp+4096); kf[5]=*(const __attribute__((address_space(3))) bf16x8*)(kp+4608);
  kf[6]=*(const __attribute__((address_space(3))) bf16x8*)(kp+6144); kf[7]=*(const __attribute__((address_space(3))) bf16x8*)(kp+6656);
}
__device__ __forceinline__ void kload2(bf16x8*kf,lds_cptr kp,int j){ kf[2*j]=*(const __attribute__((address_space(3))) bf16x8*)(kp+j*2048); kf[2*j+1]=*(const __attribute__((address_space(3))) bf16x8*)(kp+j*2048+512); }
__device__ __forceinline__ s16x4 vtr(lds_cptr p){ return __builtin_bit_cast(s16x4,__builtin_amdgcn_ds_read_tr16_b64_v4i16((__attribute__((address_space(3))) v4i16_t*)p)); }
__device__ __forceinline__ float rowmax(const f32x16&p0,const f32x16&p1){
  float a=max3f(p0[0],p0[1],p1[0]),b=max3f(p0[2],p0[3],p1[1]);a=max3f(a,p1[2],p1[3]);
  #pragma unroll
  for(int r=4;r<16;r+=4){a=max3f(a,p0[r],p0[r+1]);b=max3f(b,p0[r+2],p0[r+3]);a=max3f(a,p1[r],p1[r+1]);b=max3f(b,p1[r+2],p1[r+3]);}
  const float m=max2f(a,b);
  auto rr=__builtin_amdgcn_permlane32_swap(__float_as_uint(m),__float_as_uint(m),false,false);
  return max2f(__uint_as_float(rr[0]),__uint_as_float(rr[1]));
}
__device__ __forceinline__ void pv(f32x16*o,int vb,bf16x8 pa0,bf16x8 pa1,bf16x8 pa2,bf16x8 pa3){
  #pragma unroll
  for(int d0=0;d0<2;++d0){s16x4 lo[4],hi[4];
    #pragma unroll
    for(int ks=0;ks<4;++ks){
      asm volatile("ds_read_b64_tr_b16 %0,%1 offset:%c2":"=&v"(lo[ks]):"v"(vb),"i"(d0*4096+ks*1024):"memory");
      asm volatile("ds_read_b64_tr_b16 %0,%1 offset:%c2":"=&v"(hi[ks]):"v"(vb),"i"(d0*4096+ks*1024+512):"memory");}
    asm volatile("s_waitcnt lgkmcnt(0)":::"memory");SBAR();
    #define PK(k) (bf16x8){lo[k][0],lo[k][1],lo[k][2],lo[k][3],hi[k][0],hi[k][1],hi[k][2],hi[k][3]}
    o[d0]=__builtin_amdgcn_mfma_f32_32x32x16_bf16(pa0,PK(0),o[d0],0,0,0);
    o[d0]=__builtin_amdgcn_mfma_f32_32x32x16_bf16(pa1,PK(1),o[d0],0,0,0);
    o[d0]=__builtin_amdgcn_mfma_f32_32x32x16_bf16(pa2,PK(2),o[d0],0,0,0);
    o[d0]=__builtin_amdgcn_mfma_f32_32x32x16_bf16(pa3,PK(3),o[d0],0,0,0);
    #undef PK
  }
}

#ifndef ATTN_STORE16
#define ATTN_STORE16(p,v) (*(u32x4*)(p)=(v))
#endif
template<int THRL> __device__ __forceinline__ void attn_unit(int b,int h,int qb,const bf16*Q,const bf16*__restrict__ K,const bf16*__restrict__ V,bf16*O,char*shm){
  int tid_=threadIdx.x; asm volatile("":"+v"(tid_)); const int tid=tid_,lane=tid&63,r32=lane&31,hi=lane>>5; const int wid=__builtin_amdgcn_readfirstlane(tid>>6);
  const long rowbase=(long)b*SEQ; const int q0=qb*QB;
  const bf16*Qw=Q+(rowbase+q0+wid*QBLK)*DMQ+h*D; const int kvh=h>>2;
  const bf16*Kh=K+rowbase*DMK+kvh*D,*Vh=V+rowbase*DMV+kvh*D;
  const unsigned lds0=(unsigned)(uintptr_t)shm;
  float*wsf=(float*)(shm+LDS_WS)+wid*64;
  const bf16*ksrc=Kh+(long)lane*DMK+wid*8;
  const bf16*vsrc=Vh+(long)(16*(wid&3)+(lane>>2))*DMV+(wid>>2)*32+(lane&3)*8;
  const unsigned kdst=lds0+LDS_K+wid*1024, vdst=lds0+LDS_V+wid*1024;
  #define DMA_K(t,slot) glds16(ksrc+(long)(t)*KVBLK*DMK,(unsigned)__builtin_amdgcn_readfirstlane(kdst+(slot)))
  #define DMA_V(t,slot) glds16(vsrc+(long)(t)*KVBLK*DMV,(unsigned)__builtin_amdgcn_readfirstlane(vdst+(slot)))
  const int vb0=(int)(lds0+LDS_V)+((lane>>4)&1)*32+(lane&3)*8+(4*hi+((lane&15)>>2))*64;
  const char*Kbase=shm+LDS_K; bf16x8 kf[8];
  const lds_cptr shm3=(lds_cptr)shm; const lds_cptr kp0=shm3+LDS_K+hi*1024+r32*16; const lds_cptr vp0=shm3+LDS_V+((lane>>4)&1)*32+(lane&3)*8+(4*hi+((lane&15)>>2))*64;
  constexpr int NT=SEQ/KVBLK;
  DMA_K(0,0);DMA_V(0,0);DMA_K(1,SLOTB);
  bf16x8 qr[4];
  #pragma unroll
  for(int d0=0;d0<4;++d0)qr[d0]=*reinterpret_cast<const bf16x8*>(&Qw[(long)r32*DMQ+d0*16+hi*8]);
  float mhat=0.f,l_reg=0.f;f32x16 o[2];o[0]=f32x16{};o[1]=f32x16{};f32x16 negm=f32x16{};asm volatile("":"+v"(negm));
  #define CMASK(P0,P1,t) do{}while(0)
  bool resc=false;
  #define START(P0,P1) do{ const float rm=rowmax(P0,P1); resc=false; \
    { const float dl=rm; mhat=fadd_s(mhat,dl); \
      _Pragma("unroll") for(int r=0;r<16;++r){P0[r]=fsub_s(P0[r],dl);P1[r]=fsub_s(P1[r],dl);} \
      _Pragma("unroll") for(int r=0;r<16;++r)negm[r]=-mhat; asm volatile("":"+v"(negm)); } \
    _Pragma("unroll") for(int r=0;r<16;++r)P0[r]=__builtin_amdgcn_exp2f(P0[r]); }while(0)
  #define RESC() do{ if(resc){ asm volatile("s_waitcnt lgkmcnt(0)":::"memory"); \
      _Pragma("unroll") for(int d_=0;d_<2;++d_) _Pragma("unroll") for(int r=0;r<16;++r)o[d_][r]*=wsf[crow(r,hi)]; } }while(0)
  f32x16 pA0,pA1,pB0,pB1;
  int sl_prev=0,sl_cur=0,sl_next=SLOTB;
  #define ROT() do{sl_prev=sl_cur;sl_cur=sl_next;sl_next=(sl_next==(NSLOT-1)*SLOTB)?0:sl_next+SLOTB;}while(0)
  DMA_K(2,2*SLOTB);
  WAIT_BAR(3);
  qkt(pA0,pA1,Kbase,qr,negm,r32,hi);asm volatile("s_nop 15\n\ts_nop 7":"+v"(pA0),"+v"(pA1));CMASK(pA0,pA1,0);
  START(pA0,pA1);
  _Pragma("unroll") for(int r=0;r<16;++r)pA1[r]=__builtin_amdgcn_exp2f(pA1[r]);
  WAIT_BAR(0);
  DMA_K(3,0);DMA_V(1,SLOTB);
  ROT();
  kload8(kf,kp0+sl_cur);
  WAIT_BAR(2);
  s16x4 vlo[8],vhi[8]; u32x4 pw0,pw1,pw2,pw3;
  #define PKW(P,B) cvtpk_s(P[B],P[B+1])
  #define PAF(k) __builtin_bit_cast(bf16x8,pw##k)
  #define VFR(i) (bf16x8){vlo[i][0],vlo[i][1],vlo[i][2],vlo[i][3],vhi[i][0],vhi[i][1],vhi[i][2],vhi[i][3]}
  #define PIN(x) asm volatile("":"+v"(x))
  #define MX3(a,b,c) __builtin_fmaxf(__builtin_fmaxf((a),(b)),(c))
  #define GAPA(MF,A0,A1,A2,A3,W0,W1,PW) do{ MF; sacc+=A0; sacc+=A1; sacc+=A2; sacc+=A3; PIN(sacc); W0; W1; PIN(PW); SBAR(); }while(0)
  #define EX(v) __builtin_amdgcn_exp2f(v)
  #define GAPB(MF,X,B) do{ MF; X[B]=EX(X[B]); X[B+1]=EX(X[B+1]); X[B+2]=EX(X[B+2]); X[B+3]=EX(X[B+3]); PIN(X); SBAR(); }while(0)
  #define VRD(i) do{ vlo[i]=vtr(vp_+(((i)>>2)*4096+((i)&3)*1024)); vhi[i]=vtr(vp_+(((i)>>2)*4096+((i)&3)*1024+512)); }while(0)
  #define KRD(G,j) do{ if(G){ kload2(kf,kp0+sl_next,j); SBAR(); } }while(0)
  #define STEP(C0,C1,P0,P1,t,GK,GV,GL) do{ SBAR(); \
    const lds_cptr vp_=vp0+sl_prev; \
    VRD(0); SBAR(); float sacc=(P0[0]+P0[1]); \
    GAPA(C0=__builtin_amdgcn_mfma_f32_32x32x16_bf16(kf[0],qr[0],negm,0,0,0), P0[2],P0[3],P0[4],P0[5],     pw0[0]=PKW(P0,0), pw0[1]=PKW(P0,2), pw0); \
    VRD(4); SBAR(); GAPA(C1=__builtin_amdgcn_mfma_f32_32x32x16_bf16(kf[1],qr[0],negm,0,0,0), P0[6],P0[7],P0[8],P0[9],     pw0[2]=PKW(P0,4), pw0[3]=PKW(P0,6), pw0); \
    VRD(1); SBAR(); GAPA(C0=__builtin_amdgcn_mfma_f32_32x32x16_bf16(kf[2],qr[1],C0,0,0,0),   P0[10],P0[11],P0[12],P0[13], pw1[0]=PKW(P0,8), pw1[1]=PKW(P0,10), pw1); \
    VRD(5); SBAR(); GAPA(C1=__builtin_amdgcn_mfma_f32_32x32x16_bf16(kf[3],qr[1],C1,0,0,0),   P0[14],P0[15],P1[0],P1[1],   pw1[2]=PKW(P0,12),pw1[3]=PKW(P0,14), pw1); \
    VRD(2); SBAR(); GAPA(C0=__builtin_amdgcn_mfma_f32_32x32x16_bf16(kf[4],qr[2],C0,0,0,0),   P1[2],P1[3],P1[4],P1[5],     pw2[0]=PKW(P1,0), pw2[1]=PKW(P1,2), pw2); \
    VRD(6); SBAR(); GAPA(C1=__builtin_amdgcn_mfma_f32_32x32x16_bf16(kf[5],qr[2],C1,0,0,0),   P1[6],P1[7],P1[8],P1[9],     pw2[2]=PKW(P1,4), pw2[3]=PKW(P1,6), pw2); \
    VRD(3); SBAR(); GAPA(C0=__builtin_amdgcn_mfma_f32_32x32x16_bf16(kf[6],qr[3],C0,0,0,0),   P1[10],P1[11],P1[12],P1[13], pw3[0]=PKW(P1,8), pw3[1]=PKW(P1,10), pw3); \
    VRD(7); SBAR(); GAPA(C1=__builtin_amdgcn_mfma_f32_32x32x16_bf16(kf[7],qr[3],C1,0,0,0),   P1[14],P1[15],0.f,0.f,       pw3[2]=PKW(P1,12),pw3[3]=PKW(P1,14), pw3); \
    l_reg+=sacc; \
    if(GK){DMA_K((t)+3,sl_cur);} if(GV){DMA_V((t)+1,sl_next);} \
    CMASK(C0,C1,t); \
    { float a=MX3(C0[0],C0[1],C1[0]),b=MX3(C0[2],C0[3],C1[1]); a=MX3(a,C1[2],C1[3]); \
      _Pragma("unroll") for(int r=4;r<16;r+=4){a=MX3(a,C0[r],C0[r+1]);b=MX3(b,C0[r+2],C0[r+3]);a=MX3(a,C1[r],C1[r+1]);b=MX3(b,C1[r+2],C1[r+3]);} \
      float rm=__builtin_fmaxf(a,b); { auto rr=__builtin_amdgcn_permlane32_swap(__float_as_uint(rm),__float_as_uint(rm),false,false); rm=__builtin_fmaxf(__uint_as_float(rr[0]),__uint_as_float(rr[1])); } \
      resc=false; \
      if(__builtin_expect(__any(rm>(float)THRL),0)){ const float dl=__builtin_fmaxf(rm,0.f); mhat+=dl; \
        _Pragma("unroll") for(int r=0;r<16;++r){C0[r]-=dl;C1[r]-=dl;} \
        _Pragma("unroll") for(int r=0;r<16;++r)negm[r]=-mhat; asm volatile("":"+v"(negm)); \
        const float f=__builtin_amdgcn_exp2f(-dl); l_reg*=f; if(hi==0)wsf[r32]=f; resc=true; } } \
    SBAR(); \
    GAPB(o[0]=__builtin_amdgcn_mfma_f32_32x32x16_bf16(PAF(0),VFR(0),o[0],0,0,0), C0,0); \
    GAPB(o[1]=__builtin_amdgcn_mfma_f32_32x32x16_bf16(PAF(0),VFR(4),o[1],0,0,0), C0,4); \
    KRD(GL,0); GAPB(o[0]=__builtin_amdgcn_mfma_f32_32x32x16_bf16(PAF(1),VFR(1),o[0],0,0,0), C0,8); \
    KRD(GL,1); GAPB(o[1]=__builtin_amdgcn_mfma_f32_32x32x16_bf16(PAF(1),VFR(5),o[1],0,0,0), C0,12); \
    KRD(GL,2); GAPB(o[0]=__builtin_amdgcn_mfma_f32_32x32x16_bf16(PAF(2),VFR(2),o[0],0,0,0), C1,0); \
    KRD(GL,3); GAPB(o[1]=__builtin_amdgcn_mfma_f32_32x32x16_bf16(PAF(2),VFR(6),o[1],0,0,0), C1,4); \
    GAPB(o[0]=__builtin_amdgcn_mfma_f32_32x32x16_bf16(PAF(3),VFR(3),o[0],0,0,0), C1,8); \
    GAPB(o[1]=__builtin_amdgcn_mfma_f32_32x32x16_bf16(PAF(3),VFR(7),o[1],0,0,0), C1,12); \
    }while(0)
  int t=1;
  #undef CMASK
  #define CMASK(P0,P1,t) do{}while(0)
  for(;t+5<NT;t+=2){
    STEP(pB0,pB1,pA0,pA1,t,true,true,true);     WAIT_BAR(2); RESC(); ROT();
    STEP(pA0,pA1,pB0,pB1,t+1,true,true,true);   WAIT_BAR(2); RESC(); ROT();
  }
  #undef CMASK
  #define CMASK(P0,P1,t) do{}while(0)
  #define ENDW(tt) do{ if((tt)+3<NT){WAIT_BAR(2);} else if((tt)+2<NT){WAIT_BAR(1);} else {WAIT_BAR(0);} }while(0)
  for(;t+1<NT;t+=2){
    STEP(pB0,pB1,pA0,pA1,t,(t+3<NT),(t+1<NT),(t+1<NT));       ENDW(t);   RESC(); ROT();
    STEP(pA0,pA1,pB0,pB1,t+1,(t+4<NT),(t+2<NT),(t+2<NT));     ENDW(t+1); RESC(); ROT();
  }
  STEP(pB0,pB1,pA0,pA1,NT-1,false,false,false); RESC();
  { float sacc=pB0[0]+pB0[1]; _Pragma("unroll") for(int r=2;r<16;++r)sacc+=pB0[r]; _Pragma("unroll") for(int r=0;r<16;++r)sacc+=pB1[r]; l_reg+=sacc;
    pw0=(u32x4){PKW(pB0,0),PKW(pB0,2),PKW(pB0,4),PKW(pB0,6)};pw1=(u32x4){PKW(pB0,8),PKW(pB0,10),PKW(pB0,12),PKW(pB0,14)};pw2=(u32x4){PKW(pB1,0),PKW(pB1,2),PKW(pB1,4),PKW(pB1,6)};pw3=(u32x4){PKW(pB1,8),PKW(pB1,10),PKW(pB1,12),PKW(pB1,14)};
    SBAR(); pv(o,vb0+sl_cur,PAF(0),PAF(1),PAF(2),PAF(3)); }
  #undef PKW
  #undef PAF
  #undef VFR
  #undef PIN
  #undef MX3
  #undef GAPA
  #undef GAPB
  #undef EX
  #undef VRD
  #undef KRD
  #undef STEP
  #undef ENDW
  {auto rr=__builtin_amdgcn_permlane32_swap(__float_as_uint(l_reg),__float_as_uint(l_reg),false,false);l_reg=__uint_as_float(rr[0])+__uint_as_float(rr[1]);}
  if(hi==0)wsf[32+r32]=l_reg;asm volatile("s_waitcnt lgkmcnt(0)":::"memory");
  float rli[16];
  #pragma unroll
  for(int r=0;r<16;++r)rli[r]=__builtin_amdgcn_rcpf(wsf[32+crow(r,hi)]);
  bf16*Ow=O+(rowbase+q0+wid*QBLK)*DMO+h*D;
  { bf16*stg=(bf16*)(shm+LDS_OST)+wid*2048;
    #pragma unroll
    for(int r=0;r<16;++r){const int orow=crow(r,hi);
      #pragma unroll
      for(int d0=0;d0<2;++d0)stg[orow*64+d0*32+r32]=__float2bfloat16(o[d0][r]*rli[r]);}
    asm volatile("s_waitcnt lgkmcnt(0)":::"memory");
    #pragma unroll
    for(int i=0;i<4;++i){const int row=i*8+(lane>>3),ch=lane&7; const u32x4 v=*(const u32x4*)(stg+row*64+ch*8); ATTN_STORE16(Ow+(long)row*DMO+ch*8,v);} }
  asm volatile("s_waitcnt lgkmcnt(0)\n\ts_barrier":::"memory");
  #undef DMA_K
  #undef DMA_V
  #undef CMASK
  #undef START
  #undef RESC
  #undef ROT
}
constexpr int ATTN_LDS_BYTES=LDS_BYTES;
struct AttnTensors { const bf16* Q; const bf16* K; const bf16* V; bf16* O; };
struct AttnUnit { int bh; int qb; };
struct StaticOrder {
  int vcu, G;
  __device__ __forceinline__ explicit StaticOrder(int grid,int block):vcu((grid%8==0)?(block%8)*(grid/8)+block/8:block),G(grid){}
  __device__ __forceinline__ bool next(int i,AttnUnit&u)const{ const int per=(BATCH*NHEAD*NQB+G-1)/G; if(i>=per)return false; const int idx=vcu*per+i; if(idx>=BATCH*NHEAD*NQB)return false;
    const int qb=idx%NQB, hq=(idx/NQB)&3, bk=idx/(NQB*4), kvh=bk&1, b=bk>>1; u.bh=b*NHEAD+kvh*4+hq; u.qb=qb; return true; }
  __device__ __forceinline__ void a_ready(const AttnUnit&)const{}
  __device__ __forceinline__ void done(const AttnUnit&)const{}
};
template<class Sched,int THRL=8> __device__ __forceinline__ void attn_phase(char*lds,const AttnTensors&T,const Sched&S){
  AttnUnit u;
  for(int i=0;S.next(i,u);++i){ S.a_ready(u); attn_unit<THRL>(u.bh/NHEAD,u.bh%NHEAD,u.qb,T.Q,T.K,T.V,T.O,lds); S.done(u); }
}
#undef SBAR
#undef WAIT_BAR
}
constexpr int NB = 8, SEQ = 4096, DM = 1024, NL = 4, NTOK = NB * SEQ;
constexpr int INW = 1824, INP = 2048;
constexpr int C_AQ = 0, C_AK = 512, C_AV = 640, C_GQ = 768, C_GK = 896, C_GV = 1024, C_GR = 1280, C_FX = 1536, C_GLR = 1792;
constexpr int NE = 32, TOPK = 4, DE = 1024;
constexpr int MPAD = NTOK * TOPK + NE * 256;
constexpr float LN_EPS = 1e-5f, RMS_EPS = 1e-6f;
constexpr float DN_ALPHA = 1.681792830507429f;
constexpr float QSCALE = 0.125f * 1.4426950408889634f;
constexpr float GLA_QSCALE = 0.17677669529663687f;

constexpr size_t MiB = 1u << 20;
constexpr size_t WS_CTL = 0, CTL_ZERO_BYTES = 1 * MiB;
constexpr size_t WS_ROPE = 1 * MiB;
constexpr size_t WS_WIN_T = 2 * MiB;
constexpr size_t WS_WOUT_T = 18 * MiB;
constexpr size_t WS_FTAB = 26 * MiB;
constexpr size_t WS_TW = WS_FTAB + 65536;
constexpr size_t WS_FTMP = 27 * MiB;
constexpr size_t WS_WGU_T = 90 * MiB;
constexpr size_t WS_WDN_T = 602 * MiB;
constexpr size_t WS_HF = 858 * MiB;
constexpr size_t WS_HB = 986 * MiB;
constexpr size_t WS_PROJ = 1050 * MiB;
constexpr size_t WS_QB = 1178 * MiB;
constexpr size_t WS_KB = 1210 * MiB;
constexpr size_t WS_MIX = 1218 * MiB;
constexpr size_t WS_T1 = 1282 * MiB;
constexpr size_t WS_UVT = 1410 * MiB;
constexpr size_t WS_LA = 1442 * MiB;
constexpr size_t WS_OF = 1474 * MiB;
constexpr size_t WS_OB = 1506 * MiB;
constexpr size_t WS_TOK = 1538 * MiB;
constexpr size_t WS_XS = 1542 * MiB;
constexpr size_t WS_HID = 1814 * MiB;
constexpr size_t WS_YS = 2086 * MiB;
constexpr size_t WS_END = 2358 * MiB;
static_assert((size_t)MPAD * 2048 == 272 * MiB, "sorted buffers");
constexpr int CW_TMO = 0, CW_CODE = 1, CW_BAR = 4096, CW_CNT = 8192;

constexpr int RING_OFF = 0, RING_BYTES = 131072;
constexpr int LDSCTL_OFF = RING_BYTES;
constexpr int LDS_BYTES = 147456;
constexpr int LC_MISC = 0;
constexpr int LC_PSTART = 128;
constexpr int LC_ULIST = 384;
constexpr int LC_CNT = 640;
constexpr int LC_BASE = 768;
constexpr int LC_SELE = 1024;
constexpr int LC_SELS = 1024 + 2048;
constexpr int LC_COS64 = 5120;
constexpr int LC_ROWS = 6144;

constexpr int NWAVES = 8;
constexpr int N_PHASES = 1 + 10 * NL;

__device__ __forceinline__ float bf2f(unsigned short b) { return __uint_as_float((unsigned)b << 16); }
__device__ __forceinline__ float wave_sum(float v) {
#pragma unroll
    for (int o = 1; o < 64; o <<= 1) v += __shfl_xor(v, o);
    return v;
}
typedef unsigned short u16x8 __attribute__((ext_vector_type(8)));
typedef unsigned short u16x4 __attribute__((ext_vector_type(4)));

typedef float f32x2v __attribute__((ext_vector_type(2)));
__device__ __forceinline__ void tr_task(const float* W, int K, int Nsrc, int srcn, bf16* WT, int dst_n, int k0) {
#pragma unroll 1
    for (int hf = 0; hf < 2; ++hf) { const int kk = k0 + hf * 64; f32x2v v[64];
        if (srcn >= 0) { const float* p = W + (size_t)kk * Nsrc + srcn;
#pragma unroll
            for (int i = 0; i < 64; ++i) v[i] = __builtin_nontemporal_load((const f32x2v*)(p + (size_t)i * Nsrc)); }
        else {
#pragma unroll
            for (int i = 0; i < 64; ++i) v[i] = (f32x2v){0.f, 0.f}; }
        bf16* o0 = WT + (size_t)dst_n * K + kk; bf16* o1 = o0 + K;
#pragma unroll
        for (int j = 0; j < 8; ++j) { v4u w0, w1;
            w0.x = pk2(v[8 * j].x, v[8 * j + 1].x); w0.y = pk2(v[8 * j + 2].x, v[8 * j + 3].x); w0.z = pk2(v[8 * j + 4].x, v[8 * j + 5].x); w0.w = pk2(v[8 * j + 6].x, v[8 * j + 7].x);
            w1.x = pk2(v[8 * j].y, v[8 * j + 1].y); w1.y = pk2(v[8 * j + 2].y, v[8 * j + 3].y); w1.z = pk2(v[8 * j + 4].y, v[8 * j + 5].y); w1.w = pk2(v[8 * j + 6].y, v[8 * j + 7].y);
            *(v4u*)(o0 + 8 * j) = w0; *(v4u*)(o1 + 8 * j) = w1; } }
}

__device__ __forceinline__ void ln_row(f32x4 (&v)[4], const float* g, const float* bt, float* of32, bf16* obf, int lane) {
    float s = 0.f;
#pragma unroll
    for (int j = 0; j < 4; ++j) s += (v[j].x + v[j].y) + (v[j].z + v[j].w);
    const float mean = wave_sum(s) * (1.f / DM); float s2 = 0.f;
#pragma unroll
    for (int j = 0; j < 4; ++j) { v[j] = v[j] - mean; s2 += (v[j].x * v[j].x + v[j].y * v[j].y) + (v[j].z * v[j].z + v[j].w * v[j].w); }
    const float rstd = 1.f / sqrtf(wave_sum(s2) * (1.f / DM) + LN_EPS);
#pragma unroll
    for (int j = 0; j < 4; ++j) { const f32x4 gg = *(const f32x4*)(g + lane * 4 + 256 * j), bb = *(const f32x4*)(bt + lane * 4 + 256 * j);
        v[j] = v[j] * rstd * gg + bb;
        if (of32) *(f32x4*)(of32 + lane * 4 + 256 * j) = v[j];
        if (obf) *(unsigned long long*)(obf + lane * 4 + 256 * j) = (unsigned long long)pk2(v[j].x, v[j].y) | ((unsigned long long)pk2(v[j].z, v[j].w) << 32); }
}


constexpr int GL_QF = 0, GL_KF = 2112, GL_QB = 4224, GL_KB = 6336, GL_BC = 8448, GL_V = 12672, GL_P = 16768, GL_HF = 20928, GL_HB = 22976, GL_END = 25024;
static_assert(GL_END * 4 <= RING_BYTES, "GLA chunk image fits the ring region");
__device__ __forceinline__ void gla_stage(LAS float* L, const bf16* PROJ, const float* LA, size_t tok0, int hd, int tid) {
    __syncthreads();
#pragma unroll
    for (int r = 0; r < 8; ++r) { const int idx = tid + 512 * r, dir = idx >> 11, j = (idx >> 5) & 63, d = idx & 31; L[GL_BC + dir * 2112 + j * 33 + d] = LA[(tok0 + j) * 256 + dir * 128 + hd * 32 + d]; }
    { const int j = tid >> 3, v0 = (tid & 7) * 8; const u16x8 f = *(const u16x8*)(PROJ + (tok0 + j) * INP + C_GV + hd * 64 + v0);
#pragma unroll
      for (int i = 0; i < 8; ++i) L[GL_V + j * 64 + v0 + i] = bf2f(f[i]); }
    const int qj = tid >> 3, qd = (tid & 7) * 4;
    const u16x4 q4 = *(const u16x4*)(PROJ + (tok0 + qj) * INP + C_GQ + hd * 32 + qd), k4 = *(const u16x4*)(PROJ + (tok0 + qj) * INP + C_GK + hd * 32 + qd);
    __syncthreads();
    { const int lane_ = tid & 63, w_ = tid >> 6;
#pragma unroll
      for (int cc = 0; cc < 8; ++cc) { const int col = w_ * 8 + cc, dir = col >> 5, d = col & 31; LAS float* p = L + GL_BC + dir * 2112 + lane_ * 33 + d; float x = *p;
          if (dir == 0) {
#pragma unroll
              for (int o = 1; o < 64; o <<= 1) { const float y = __shfl_up(x, o); if (lane_ >= o) x += y; } }
          else {
#pragma unroll
              for (int o = 1; o < 64; o <<= 1) { const float y = __shfl_down(x, o); if (lane_ + o < 64) x += y; } }
          *p = x; } }
    __syncthreads();
#pragma unroll
    for (int i = 0; i < 4; ++i) { const float bf_ = L[GL_BC + qj * 33 + qd + i], bb_ = L[GL_BC + 2112 + qj * 33 + qd + i]; const float qv = bf2f(q4[i]) * GLA_QSCALE, kv = bf2f(k4[i]);
        L[GL_QF + qj * 33 + qd + i] = qv * expf(bf_); L[GL_KF + qj * 33 + qd + i] = kv * expf(-bf_); L[GL_QB + qj * 33 + qd + i] = qv * expf(bb_); L[GL_KB + qj * 33 + qd + i] = kv * expf(-bb_); }
    __syncthreads();
}


typedef float f32x16 __attribute__((ext_vector_type(16)));
typedef short s16x4 __attribute__((ext_vector_type(4)));
typedef float f32x2_t __attribute__((ext_vector_type(2))); typedef __bf16 bf16x2_t __attribute__((ext_vector_type(2)));
__device__ __forceinline__ unsigned cvtpk2(float lo, float hi) { f32x2_t v = {lo, hi}; bf16x2_t b = __builtin_convertvector(v, bf16x2_t); return __builtin_bit_cast(unsigned, b); }
__device__ __forceinline__ bf16x8 pack_step(const f32x16& x, int s) { v4u p; p.x = cvtpk2(x[8 * s], x[8 * s + 1]); p.y = cvtpk2(x[8 * s + 2], x[8 * s + 3]); p.z = cvtpk2(x[8 * s + 4], x[8 * s + 5]); p.w = cvtpk2(x[8 * s + 6], x[8 * s + 7]); return __builtin_bit_cast(bf16x8, p); }
__device__ __forceinline__ int crow16(int i, int h) { return (i & 3) + 8 * (i >> 2) + 4 * h; }
#define MFMA32(a, b, c) __builtin_amdgcn_mfma_f32_32x32x16_bf16((a), (b), (c), 0, 0, 0)
constexpr int FT_PITCH = 72, FT_TAB = 64 * FT_PITCH;
constexpr int FFT_LDS_TAB = 0, FFT_LDS_TW = 28672, FFT_LDS_HT = 28672, FFT_HT_PAIR = 2 * 64 * FT_PITCH * 2;

struct Args { const float* in[20]; float* out; unsigned char* ws; int ph_lo, ph_hi; };
static_assert(sizeof(Args) == 20 * 8 + 8 + 8 + 8, "no padding bytes in Args");


typedef __attribute__((address_space(4))) const unsigned char* kptr_t;
__device__ __forceinline__ kptr_t karg() { kptr_t p = (kptr_t)__builtin_amdgcn_kernarg_segment_ptr(); asm volatile("" : "+s"(p)); return p; }
#define KIN(i) (*(const float* const __attribute__((address_space(4)))*)(karg() + 8 * (i)))
#define KOUT() (*(float* const __attribute__((address_space(4)))*)(karg() + 160))
#define KWS() (*(unsigned char* const __attribute__((address_space(4)))*)(karg() + 168))
#define WSP(T, off) ((T*)(ws + (off)))

#ifndef NAIVE_ATTN
#define NAIVE_ATTN 0
#endif

__global__ void __launch_bounds__(NWAVES * 64, 2) fwd(Args args) {
    extern __shared__ __attribute__((aligned(16))) unsigned char lds_raw[];
    LAS unsigned char* lds = (LAS unsigned char*)lds_raw;
    LAS unsigned char* lctl = lds + LDSCTL_OFF;
    const int G = gridDim.x, bx = blockIdx.x;
    const int NGW = G * NWAVES, NGT = G * NWAVES * 64;
#define TID_SETUP() int tid_ = threadIdx.x; asm volatile("" : "+v"(tid_)); const int tid = tid_, lane = tid & 63, wave = __builtin_amdgcn_readfirstlane(tid >> 6); \
    const int gw = bx * NWAVES + wave, gt = bx * (NWAVES * 64) + tid; (void)lane; (void)gw; (void)gt
    for (int u = threadIdx.x; u < (LDS_BYTES - LDSCTL_OFF) / 4; u += NWAVES * 64) ((LAS unsigned*)lctl)[u] = 0u;
    __syncthreads();
    volatile LAS unsigned* MISC = (volatile LAS unsigned*)(lctl + LC_MISC);
    XcdBarrier bar = xcd_barrier_post((unsigned*)(KWS() + WS_CTL) + CW_BAR, MISC + 8);
    const int lo = args.ph_lo, hi = args.ph_hi;
#ifndef PH_OFF
#define PH_OFF 0
#endif
#define PON(j) (!((PH_OFF >> (j)) & 1))
#define IN(k) (lo <= (k) && (k) < hi)
#ifndef PROBE_A
#define PROBE_A -1
#endif
#ifndef PROBE_B
#define PROBE_B -1
#endif
#if PROBE_A >= 0
#define STAMP(k) do { if (blockIdx.x == 0 && threadIdx.x == 0) { ((unsigned long long*)(KWS() + WS_CTL + 65536))[(k)] = __builtin_amdgcn_s_memrealtime(); } } while (0)
#else
#define STAMP(k) do {} while (0)
#endif
#define SEAM(k) do { if (IN(k) && IN((k) + 1)) xcd_barrier(bar); STAMP((k) + 1); } while (0)
    STAMP(0);

    if (IN(0) && PON(0)) {
        TID_SETUP(); unsigned char* ws = KWS(); const float* x_in = KIN(0); const float* ln_in_g = KIN(1); const float* ln_in_b = KIN(2); const float* w_in = KIN(3); const float* w_out = KIN(9);
        const float* exp_w_gu = KIN(14); const float* exp_w_down = KIN(16);
        float* ROPE = WSP(float, WS_ROPE); bf16* WIN_T = WSP(bf16, WS_WIN_T); bf16* WOUT_T = WSP(bf16, WS_WOUT_T); bf16* WGU_T = WSP(bf16, WS_WGU_T); bf16* WDN_T = WSP(bf16, WS_WDN_T);
        float* HF = WSP(float, WS_HF); bf16* HB = WSP(bf16, WS_HB);
        constexpr int I_WIN = NL * 16 * 8, I_WOUT = NL * 8 * 8, I_WGU = NL * NE * 16 * 8, I_WDN = NL * NE * 8 * 8;
        constexpr int NTASK = I_WIN + I_WOUT + I_WGU + I_WDN;
        { const int t_lo = (int)(((long)gw * NTASK) / NGW), t_hi = (int)(((long)(gw + 1) * NTASK) / NGW);
          for (int it = t_lo; it < t_hi; ++it) {
            int r = it;
            if (r < I_WIN) { const int l = r / 128, q = r % 128, nb = q / 8, k8 = q % 8, n = nb * 128 + 2 * lane;
                const int src = n < 1536 ? n : (n < 1792 ? n + 32 : (n < 1824 ? n - 256 : -1));
                tr_task(w_in + (size_t)l * DM * INW, DM, INW, src, WIN_T + (size_t)l * INP * DM, n, k8 * 128); continue; }
            r -= I_WIN;
            if (r < I_WOUT) { const int l = r / 64, q = r % 64, nb = q / 8, k8 = q % 8, n = nb * 128 + 2 * lane;
                tr_task(w_out + (size_t)l * DM * DM, DM, DM, n, WOUT_T + (size_t)l * DM * DM, n, k8 * 128); continue; }
            r -= I_WOUT;
            if (r < I_WGU) { const int le = r / 128, q = r % 128, nb = q / 8, k8 = q % 8, n = nb * 128 + 2 * lane;
                const int pn = n >> 8, bj = (n >> 7) & 1, j = n & 127, src = bj * 1024 + pn * 128 + j;
                tr_task(exp_w_gu + (size_t)le * DM * 2048, DM, 2048, src, WGU_T + (size_t)le * 2048 * DM, n, k8 * 128); continue; }
            r -= I_WGU;
            { const int le = r / 64, q = r % 64, nb = q / 8, k8 = q % 8, n = nb * 128 + 2 * lane;
                tr_task(exp_w_down + (size_t)le * DE * DM, DE, DM, n, WDN_T + (size_t)le * DM * DE, n, k8 * 128); }
          } }
        { bf16* FTAB = WSP(bf16, WS_FTAB); float* TW = WSP(float, WS_TW);
          for (int it = gt; it < 3 * FT_TAB; it += NGT) { const int t = it / FT_TAB, q = it % FT_TAB, row = q / FT_PITCH, col = q % FT_PITCH; float sn, cs; sincospif((float)((row * col) & 63) * (1.0f / 32.0f), &sn, &cs);
              const float v = col >= 64 ? 0.f : (t == 0 ? cs : (t == 1 ? sn : -sn)); FTAB[it] = (bf16)f2bf(v); }
          for (int it = gt; it < 4096; it += NGT) { float sn, cs; sincospif((float)it * (1.0f / 2048.0f), &sn, &cs); TW[2 * it] = cs; TW[2 * it + 1] = -sn; } }
        for (int it = gt; it < SEQ * 32; it += NGT) { const int t = it >> 5, i = it & 31, a = i >> 4, f = i & 15; const int pos = a ? (t & 63) : (t >> 6);
            const double inv = exp(-9.210340371976184 * (double)f / 16.0); const double ang = (double)pos * inv;
            ROPE[it] = (float)cos(ang); ROPE[SEQ * 32 + it] = (float)sin(ang); }
        for (int m = gw; m < NTOK; m += NGW) { f32x4 v[4];
#pragma unroll
            for (int j = 0; j < 4; ++j) v[j] = *(const f32x4*)(x_in + (size_t)m * DM + lane * 4 + 256 * j);
            ln_row(v, ln_in_g, ln_in_b, HF + (size_t)m * DM, HB + (size_t)m * DM, lane); }
    }
    SEAM(0);

    for (int l = 0; l < NL; ++l) {
        const int pb = 1 + 10 * l;
        if (IN(pb + 0) && PON(1)) {
            TID_SETUP(); unsigned char* ws = KWS(); bf16* HB = WSP(bf16, WS_HB); bf16* WIN_T = WSP(bf16, WS_WIN_T); bf16* PROJ = WSP(bf16, WS_PROJ);
            pg8::Gemm g{HB, WIN_T + (size_t)l * INP * DM, NTOK, INP, DM}; pg8::StaticOrder S; S.init(NTOK, INP, G, bx);
            pg8::EpiPlainBf16 E{PROJ, INP};
            pg8::gemm_phase<pg8::EpiPlainBf16, pg8::StaticOrder, true, true>(lds + RING_OFF, g, S, E);
        }
        SEAM(pb + 0);
        if (IN(pb + 1) && PON(2)) {
            TID_SETUP(); unsigned char* ws = KWS(); const float* att_q_gain = KIN(4); const float* att_k_gain = KIN(5); const float* gla_gate_w = KIN(6); const float* gla_gate_b = KIN(7);
            const float* ROPE = WSP(float, WS_ROPE); const bf16* PROJ = WSP(bf16, WS_PROJ); bf16* QB = WSP(bf16, WS_QB); bf16* KB = WSP(bf16, WS_KB); float* LA = WSP(float, WS_LA);
            const float* qg = att_q_gain + l * 64; const float* kg = att_k_gain + l * 64;
            for (int m = gw; m < NTOK; m += NGW) { const int t = m & (SEQ - 1); const int ri = (lane >> 5) * 16 + (lane & 15);
                const float cs = ROPE[t * 32 + ri], sn = ROPE[SEQ * 32 + t * 32 + ri]; const float sg = ((lane >> 4) & 1) ? 1.f : -1.f;
#pragma unroll
                for (int h = 0; h < 10; ++h) { const float xv = bf2f(PROJ[(size_t)m * INP + h * 64 + lane]);
                    const float ms = wave_sum(xv * xv) * (1.f / 64.f); const float xn = xv * (1.f / sqrtf(ms + RMS_EPS)) * (h < 8 ? qg[lane] : kg[lane]);
                    const float pr = __shfl_xor(xn, 16); float o = xn * cs + sg * pr * sn;
                    if (h < 8) { o *= QSCALE; QB[(size_t)m * 512 + h * 64 + lane] = (bf16)f2bf(o); } else KB[(size_t)m * 128 + (h - 8) * 64 + lane] = (bf16)f2bf(o); } }
            { const float* gw_l = gla_gate_w + (size_t)l * 2 * 16 * 128; const float* gb_l = gla_gate_b + (size_t)l * 2 * 128;
              for (int m = gw; m < NTOK; m += NGW) { const float lr = (lane < 32) ? bf2f(PROJ[(size_t)m * INP + C_GLR + lane]) : 0.f;
                const int dir = lane >> 5, kc = (lane & 31) * 4; f32x4 z = *(const f32x4*)(gb_l + dir * 128 + kc);
#pragma unroll
                for (int r = 0; r < 16; ++r) { const float a = __shfl(lr, dir * 16 + r); const f32x4 w = *(const f32x4*)(gw_l + (size_t)(dir * 16 + r) * 128 + kc); z = z + w * a; }
                f32x4 o;
#pragma unroll
                for (int i = 0; i < 4; ++i) o[i] = (fminf(z[i], 0.f) - log1pf(expf(-fabsf(z[i])))) * (1.f / 16.f);
                *(f32x4*)(LA + (size_t)m * 256 + dir * 128 + kc) = o; } }
            { __syncthreads();
              { const v4u* src = (const v4u*)WSP(bf16, WS_FTAB); LAS v4u* dst = (LAS v4u*)(lds + RING_OFF + FFT_LDS_TAB); for (int i = tid; i < 3 * FT_TAB * 2 / 16; i += NWAVES * 64) dst[i] = src[i];
                const v4u* s2_ = (const v4u*)WSP(float, WS_TW); LAS v4u* d2_ = (LAS v4u*)(lds + RING_OFF + FFT_LDS_TW); for (int i = tid; i < 4096 * 8 / 16; i += NWAVES * 64) d2_[i] = s2_[i]; }
              __syncthreads();
              const LAS bf16* FT = (const LAS bf16*)(lds + RING_OFF + FFT_LDS_TAB); const LAS float* TWL = (const LAS float*)(lds + RING_OFF + FFT_LDS_TW); bf16* FTMP = WSP(bf16, WS_FTMP);
              const int pair = wave >> 1, cb = wave & 1, r = lane & 31, h = lane >> 5;
              for (int ub = bx; ub < NB * 4 * 64 / 4; ub += G) { const int u = ub * 4 + pair, s2 = u & 63, g4 = (u >> 6) & 3, b = u >> 8;
                bf16x8 xa[2][4];
#pragma unroll
                for (int R = 0; R < 2; ++R)
#pragma unroll
                    for (int ks = 0; ks < 4; ++ks) xa[R][ks] = *(const bf16x8*)(PROJ + ((size_t)b * SEQ + 64 * (32 * R + r) + s2) * INP + C_FX + g4 * 64 + 16 * ks + 8 * h);
                f32x16 Tr[2], Ti[2];
#pragma unroll
                for (int R = 0; R < 2; ++R)
#pragma unroll
                    for (int i = 0; i < 16; ++i) { Tr[R][i] = 0.f; Ti[R][i] = 0.f; }
#pragma unroll
                for (int ks = 0; ks < 4; ++ks) { const bf16x8 bc = *(const LAS bf16x8*)(FT + (32 * cb + r) * FT_PITCH + 16 * ks + 8 * h), bs = *(const LAS bf16x8*)(FT + 2 * FT_TAB + (32 * cb + r) * FT_PITCH + 16 * ks + 8 * h);
#pragma unroll
                    for (int R = 0; R < 2; ++R) { Tr[R] = MFMA32(xa[R][ks], bc, Tr[R]); Ti[R] = MFMA32(xa[R][ks], bs, Ti[R]); } }
#pragma unroll
                for (int Rp = 0; Rp < 2; ++Rp) { f32x16 Gr, Gi;
#pragma unroll
                    for (int i = 0; i < 16; ++i) { Gr[i] = 0.f; Gi[i] = 0.f; }
#pragma unroll
                    for (int R = 0; R < 2; ++R)
#pragma unroll
                        for (int s_ = 0; s_ < 2; ++s_) { const bf16x8 xr = pack_step(Tr[R], s_), xi = pack_step(Ti[R], s_);
                            const int kb = 32 * R + 16 * s_ + 4 * h, ro = (32 * Rp + r) * FT_PITCH + kb;
                            const s16x4 c0 = *(const LAS s16x4*)(FT + ro), c1 = *(const LAS s16x4*)(FT + ro + 8), s0 = *(const LAS s16x4*)(FT + FT_TAB + ro), s1 = *(const LAS s16x4*)(FT + FT_TAB + ro + 8),
                                        n0 = *(const LAS s16x4*)(FT + 2 * FT_TAB + ro), n1 = *(const LAS s16x4*)(FT + 2 * FT_TAB + ro + 8);
                            const bf16x8 ca = __builtin_shufflevector(c0, c1, 0, 1, 2, 3, 4, 5, 6, 7), sa = __builtin_shufflevector(s0, s1, 0, 1, 2, 3, 4, 5, 6, 7), na = __builtin_shufflevector(n0, n1, 0, 1, 2, 3, 4, 5, 6, 7);
                            Gr = MFMA32(ca, xr, Gr); Gr = MFMA32(sa, xi, Gr); Gi = MFMA32(ca, xi, Gi); Gi = MFMA32(na, xr, Gi); }
#pragma unroll
                    for (int i = 0; i < 16; ++i) { const int s1p = 32 * Rp + crow16(i, h); const int m = (s2 * s1p) & 4095; const float wr = TWL[2 * m], wi = TWL[2 * m + 1];
                        const size_t o = ((((size_t)(b * 4 + g4) * 64 + s1p) * 2) * 64 + s2) * 64 + 32 * cb + r;
                        FTMP[o] = (bf16)f2bf(Gr[i] * wr - Gi[i] * wi); FTMP[o + 4096] = (bf16)f2bf(Gr[i] * wi + Gi[i] * wr); } }
              }
              __syncthreads(); }
            { LAS float* L = (LAS float*)(lds + RING_OFF); float* GS = WSP(float, WS_OF); float* GD = WSP(float, WS_OB);
              for (int u = bx; u < NB * 4 * 64; u += G) { const int c = u & 63, bh = u >> 6, hd = bh & 3, b = bh >> 2; const size_t tok0 = (size_t)b * SEQ + c * 64;
                gla_stage(L, PROJ, LA, tok0, hd, tid);
                const int dir = tid >> 8, d0 = ((tid >> 4) & 15) * 2, v0 = (tid & 15) * 4; const LAS float* Kd = L + (dir ? GL_KB : GL_KF);
                f32x4 a0 = {0.f, 0.f, 0.f, 0.f}, a1 = {0.f, 0.f, 0.f, 0.f};
#pragma unroll 8
                for (int j = 0; j < 64; ++j) { const float k0 = Kd[j * 33 + d0], k1 = Kd[j * 33 + d0 + 1]; const f32x4 vv = *(const LAS f32x4*)(L + GL_V + j * 64 + v0); a0 = a0 + vv * k0; a1 = a1 + vv * k1; }
                const int jl = dir ? 0 : 63; const float D0 = expf(L[GL_BC + dir * 2112 + jl * 33 + d0]), D1 = expf(L[GL_BC + dir * 2112 + jl * 33 + d0 + 1]);
                const size_t sidx = ((size_t)u * 2 + dir);
                *(f32x4*)(GS + sidx * 2048 + d0 * 64 + v0) = a0 * D0; *(f32x4*)(GS + sidx * 2048 + (d0 + 1) * 64 + v0) = a1 * D1;
                if ((tid & 15) == 0) { GD[sidx * 32 + d0] = D0; GD[sidx * 32 + d0 + 1] = D1; } }
              __syncthreads(); }
        }
        SEAM(pb + 1);
        if (IN(pb + 2) && PON(3)) {
            TID_SETUP(); unsigned char* ws = KWS(); float* GS = WSP(float, WS_OF); const float* GD = WSP(float, WS_OB);
            for (int e = gt; e < NB * 4 * 2 * 2048; e += NGT) { const int dv = e & 2047, dir = (e >> 11) & 1, bh = e >> 12, d = dv >> 6; float H = 0.f;
                for (int c8 = 0; c8 < 64; c8 += 8) { float sv[8], dd[8];
#pragma unroll
                    for (int i = 0; i < 8; ++i) { const int c = dir ? 63 - (c8 + i) : (c8 + i); const size_t sidx = ((size_t)(bh * 64 + c) * 2 + dir); sv[i] = GS[sidx * 2048 + dv]; dd[i] = GD[sidx * 32 + d]; }
#pragma unroll
                    for (int i = 0; i < 8; ++i) { const int c = dir ? 63 - (c8 + i) : (c8 + i); const size_t sidx = ((size_t)(bh * 64 + c) * 2 + dir); GS[sidx * 2048 + dv] = H; H = H * dd[i] + sv[i]; } } }
        }
        SEAM(pb + 2);
        if (IN(pb + 3) && PON(4)) {
            TID_SETUP(); unsigned char* ws = KWS(); const float* gla_norm_g = KIN(8); const bf16* PROJ = WSP(bf16, WS_PROJ);
            bf16* MIX = WSP(bf16, WS_MIX); const bf16* QB = WSP(bf16, WS_QB); const bf16* KB = WSP(bf16, WS_KB);
            { __syncthreads();
              { const v4u* src = (const v4u*)WSP(bf16, WS_FTAB); LAS v4u* dst = (LAS v4u*)(lds + RING_OFF + FFT_LDS_TAB); for (int i = tid; i < 3 * FT_TAB * 2 / 16; i += NWAVES * 64) dst[i] = src[i]; }
              const LAS bf16* FT = (const LAS bf16*)(lds + RING_OFF + FFT_LDS_TAB); const bf16* FTMP = WSP(bf16, WS_FTMP);
              const int pair = wave >> 1, cb = wave & 1, r = lane & 31, h = lane >> 5;
              LAS bf16* HT = (LAS bf16*)(lds + RING_OFF + FFT_LDS_HT + pair * FFT_HT_PAIR);
              for (int ub = bx; ub < NB * 4 * 64 / 4; ub += G) { const int u = ub * 4 + pair, s1p = u & 63, g4 = (u >> 6) & 3, b = u >> 8;
                const bf16* src = FTMP + (size_t)u * 2 * 4096;
                __syncthreads();
#pragma unroll
                for (int q = 0; q < 8; ++q) { const int p = cb * 64 + lane + 128 * q, ri = p >> 9, s2 = (p >> 3) & 63, c0 = (p & 7) * 8; const u16x8 v = *(const u16x8*)(src + p * 8);
#pragma unroll
                    for (int i = 0; i < 8; ++i) HT[(ri * 64 + c0 + i) * FT_PITCH + s2] = v[i]; }
                __syncthreads();
#pragma unroll
                for (int Rp = 0; Rp < 2; ++Rp) { f32x16 acc;
#pragma unroll
                    for (int i = 0; i < 16; ++i) acc[i] = 0.f;
#pragma unroll
                    for (int ks = 0; ks < 4; ++ks) { const int ko = 16 * ks + 8 * h;
                        const bf16x8 ca = *(const LAS bf16x8*)(FT + (32 * Rp + r) * FT_PITCH + ko), sa = *(const LAS bf16x8*)(FT + FT_TAB + (32 * Rp + r) * FT_PITCH + ko);
                        const bf16x8 hr = *(const LAS bf16x8*)(HT + (32 * cb + r) * FT_PITCH + ko), hi_ = *(const LAS bf16x8*)(HT + (64 + 32 * cb + r) * FT_PITCH + ko);
                        acc = MFMA32(ca, hr, acc); acc = MFMA32(sa, hi_, acc); }
#pragma unroll
                    for (int i = 0; i < 16; ++i) { const int s2p = 32 * Rp + crow16(i, h); MIX[((size_t)b * SEQ + s1p + 64 * s2p) * DM + 768 + g4 * 64 + 32 * cb + r] = (bf16)f2bf(acc[i] * (1.0f / 512.0f)); } }
              }
              __syncthreads(); }
            { LAS float* L = (LAS float*)(lds + RING_OFF); const float* GS = WSP(float, WS_OF); const float* LA = WSP(float, WS_LA);
              for (int u = bx; u < NB * 4 * 64; u += G) { const int c = u & 63, bh = u >> 6, hd = bh & 3, b = bh >> 2; const size_t tok0 = (size_t)b * SEQ + c * 64;
                gla_stage(L, PROJ, LA, tok0, hd, tid);
                { const f32x4* src = (const f32x4*)(GS + (size_t)u * 2 * 2048) + tid * 2; LAS f32x4* dst = (LAS f32x4*)(L + GL_HF) + tid * 2; dst[0] = src[0]; dst[1] = src[1]; }
                const int i0 = (tid >> 4) * 2, j0 = (tid & 15) * 4;
                { float pf[2][4], pb[2][4];
#pragma unroll
                  for (int a_ = 0; a_ < 2; ++a_)
#pragma unroll
                      for (int c_ = 0; c_ < 4; ++c_) { pf[a_][c_] = 0.f; pb[a_][c_] = 0.f; }
#pragma unroll 4
                  for (int d = 0; d < 32; ++d) { const float qf0 = L[GL_QF + i0 * 33 + d], qf1 = L[GL_QF + (i0 + 1) * 33 + d], qb0 = L[GL_QB + i0 * 33 + d], qb1 = L[GL_QB + (i0 + 1) * 33 + d];
#pragma unroll
                      for (int c_ = 0; c_ < 4; ++c_) { const float kf = L[GL_KF + (j0 + c_) * 33 + d], kb = L[GL_KB + (j0 + c_) * 33 + d]; pf[0][c_] += qf0 * kf; pf[1][c_] += qf1 * kf; pb[0][c_] += qb0 * kb; pb[1][c_] += qb1 * kb; } }
#pragma unroll
                  for (int a_ = 0; a_ < 2; ++a_)
#pragma unroll
                      for (int c_ = 0; c_ < 4; ++c_) L[GL_P + (i0 + a_) * 65 + j0 + c_] = (j0 + c_ <= i0 + a_) ? pf[a_][c_] : pb[a_][c_]; }
                __syncthreads();
                f32x4 o0 = {0.f, 0.f, 0.f, 0.f}, o1 = {0.f, 0.f, 0.f, 0.f}; const int v0 = j0;
#pragma unroll 8
                for (int j = 0; j < 64; ++j) { const float p0 = L[GL_P + i0 * 65 + j], p1 = L[GL_P + (i0 + 1) * 65 + j]; const f32x4 vv = *(const LAS f32x4*)(L + GL_V + j * 64 + v0); o0 = o0 + vv * p0; o1 = o1 + vv * p1; }
#pragma unroll 8
                for (int d = 0; d < 32; ++d) { const f32x4 hf = *(const LAS f32x4*)(L + GL_HF + d * 64 + v0), hb = *(const LAS f32x4*)(L + GL_HB + d * 64 + v0);
                    o0 = o0 + hf * L[GL_QF + i0 * 33 + d] + hb * L[GL_QB + i0 * 33 + d]; o1 = o1 + hf * L[GL_QF + (i0 + 1) * 33 + d] + hb * L[GL_QB + (i0 + 1) * 33 + d]; }
                float s0 = (o0.x * o0.x + o0.y * o0.y) + (o0.z * o0.z + o0.w * o0.w), s1 = (o1.x * o1.x + o1.y * o1.y) + (o1.z * o1.z + o1.w * o1.w);
#pragma unroll
                for (int m_ = 1; m_ < 16; m_ <<= 1) { s0 += __shfl_xor(s0, m_); s1 += __shfl_xor(s1, m_); }
                const f32x4 gn = *(const f32x4*)(gla_norm_g + l * 64 + v0);
#pragma unroll
                for (int a_ = 0; a_ < 2; ++a_) { const f32x4 ov = a_ ? o1 : o0; const float rs = 1.f / sqrtf((a_ ? s1 : s0) * (1.f / 64.f) + RMS_EPS); const size_t m = tok0 + i0 + a_;
                    const u16x4 r4 = *(const u16x4*)(PROJ + m * INP + C_GR + hd * 64 + v0); float y[4];
#pragma unroll
                    for (int i = 0; i < 4; ++i) { const float r = bf2f(r4[i]); y[i] = ov[i] * rs * gn[i] * (r / (1.f + expf(-r))); }
                    *(unsigned long long*)(MIX + m * DM + 512 + hd * 64 + v0) = (unsigned long long)pk2(y[0], y[1]) | ((unsigned long long)pk2(y[2], y[3]) << 32); } }
              __syncthreads(); }
#if NAIVE_ATTN
            { LAS float* Kt = (LAS float*)(lds + RING_OFF); LAS float* Vt = Kt + 64 * 64;
              for (int unit = bx; unit < NB * 8 * 8; unit += G) { const int rb = unit & 7, h = (unit >> 3) & 7, b = unit >> 6, kvh = h >> 2;
                const size_t qrow = (size_t)b * SEQ + rb * 512 + tid;
                float q[64], o[64]; float mrun = -INFINITY, lrun = 0.f;
#pragma unroll
                for (int c8 = 0; c8 < 8; ++c8) { const u16x8 f = *(const u16x8*)(QB + qrow * 512 + h * 64 + c8 * 8);
#pragma unroll
                    for (int i = 0; i < 8; ++i) { q[c8 * 8 + i] = bf2f(f[i]); o[c8 * 8 + i] = 0.f; } }
                for (int kt = 0; kt < SEQ; kt += 64) {
                    __syncthreads();
                    { const int kr = tid >> 3, c8 = (tid & 7) * 8; const size_t krow = (size_t)b * SEQ + kt + kr;
                      const u16x8 kf = *(const u16x8*)(KB + krow * 128 + kvh * 64 + c8); const u16x8 vf = *(const u16x8*)(PROJ + krow * INP + C_AV + kvh * 64 + c8);
#pragma unroll
                      for (int i = 0; i < 8; ++i) { Kt[kr * 64 + c8 + i] = bf2f(kf[i]); Vt[kr * 64 + c8 + i] = bf2f(vf[i]); } }
                    __syncthreads();
#pragma unroll 1
                    for (int j = 0; j < 64; ++j) { float a = 0.f;
#pragma unroll
                        for (int d4 = 0; d4 < 16; ++d4) { const f32x4 kv = *(const LAS f32x4*)(Kt + j * 64 + d4 * 4); a += (q[d4 * 4] * kv.x + q[d4 * 4 + 1] * kv.y) + (q[d4 * 4 + 2] * kv.z + q[d4 * 4 + 3] * kv.w); }
                        if (a > mrun) { const float al = exp2f(mrun - a); mrun = a; lrun *= al;
#pragma unroll
                            for (int d = 0; d < 64; ++d) o[d] *= al; }
                        const float p = exp2f(a - mrun); lrun += p;
#pragma unroll
                        for (int d4 = 0; d4 < 16; ++d4) { const f32x4 vv = *(const LAS f32x4*)(Vt + j * 64 + d4 * 4); o[d4 * 4] += p * vv.x; o[d4 * 4 + 1] += p * vv.y; o[d4 * 4 + 2] += p * vv.z; o[d4 * 4 + 3] += p * vv.w; } }
                }
                const float rl = 1.f / lrun;
#pragma unroll
                for (int c8 = 0; c8 < 8; ++c8) { v4u w; w.x = pk2(o[c8 * 8] * rl, o[c8 * 8 + 1] * rl); w.y = pk2(o[c8 * 8 + 2] * rl, o[c8 * 8 + 3] * rl); w.z = pk2(o[c8 * 8 + 4] * rl, o[c8 * 8 + 5] * rl); w.w = pk2(o[c8 * 8 + 6] * rl, o[c8 * 8 + 7] * rl);
                    *(v4u*)(MIX + qrow * DM + h * 64 + c8 * 8) = w; }
              }
              __syncthreads(); }
#else
            { const attn_body::AttnTensors AT{(const attn_body::bf16*)QB, (const attn_body::bf16*)KB, (const attn_body::bf16*)(PROJ + C_AV), (attn_body::bf16*)MIX};
              const attn_body::StaticOrder S(G, bx);
              attn_body::attn_phase<attn_body::StaticOrder>((char*)lds_raw + RING_OFF, AT, S); }
#endif
        }
        SEAM(pb + 3);
        if (IN(pb + 4) && PON(5)) {
            TID_SETUP(); unsigned char* ws = KWS(); const bf16* MIX = WSP(bf16, WS_MIX); const bf16* WOUT_T = WSP(bf16, WS_WOUT_T); const float* HF = WSP(float, WS_HF); float* T1 = WSP(float, WS_T1);
            pg8::Gemm g{MIX, WOUT_T + (size_t)l * DM * DM, NTOK, DM, DM}; pg8::StaticOrder S; S.init(NTOK, DM, G, bx);
            pg8::EpiResF32 E{HF, T1, DM, DN_ALPHA};
            pg8::gemm_phase<pg8::EpiResF32, pg8::StaticOrder, true, true>(lds + RING_OFF, g, S, E);
        }
        SEAM(pb + 4);
        if (IN(pb + 5) && PON(6)) {
            TID_SETUP(); unsigned char* ws = KWS(); gu32* ctl = (gu32*)(ws + WS_CTL); const float* ln1_g = KIN(10); const float* ln1_b = KIN(11); const float* router_w = KIN(12); const float* router_b = KIN(13);
            const float* T1 = WSP(float, WS_T1); float* HF = WSP(float, WS_HF); bf16* HB = WSP(bf16, WS_HB); int* TOKE = WSP(int, WS_TOK); int* TOKS = TOKE + NTOK * 4; float* TOKW = (float*)(TOKS + NTOK * 4); int* LIST = WSP(int, WS_XS);
            LAS float* RW = (LAS float*)(lds + RING_OFF);
            { const float* rw = router_w + (size_t)l * DM * NE; for (int i = tid; i < DM * NE; i += NWAVES * 64) { const int c = i >> 5, e = i & 31; RW[e * DM + c] = rw[i]; } }
            LAS int* lcnt = (LAS int*)(lctl + LC_CNT); LAS int* lbase = (LAS int*)(lctl + LC_BASE); LAS int* sele = (LAS int*)(lctl + LC_SELE); LAS int* sels = (LAS int*)(lctl + LC_SELS);
            const float* rb = router_b + l * NE;
            for (int r0 = bx * 128; r0 < NTOK; r0 += G * 128) {
                if (tid < 32) lcnt[tid] = 0;
                __syncthreads();
                LAS float* LG = (LAS float*)(lctl + LC_ROWS) + wave * 64;
                for (int rr = 0; rr < 16; rr += 2) { const int lr = wave * 16 + rr; const size_t m = (size_t)r0 + lr; f32x4 v[2][4];
#pragma unroll
                    for (int q = 0; q < 2; ++q)
#pragma unroll
                        for (int j = 0; j < 4; ++j) v[q][j] = *(const f32x4*)(T1 + (m + q) * DM + lane * 4 + 256 * j);
                    ln_row(v[0], ln1_g + l * DM, ln1_b + l * DM, HF + m * DM, HB + m * DM, lane);
                    ln_row(v[1], ln1_g + l * DM, ln1_b + l * DM, HF + (m + 1) * DM, HB + (m + 1) * DM, lane);
                    float a0[32], a1[32];
#pragma unroll
                    for (int e = 0; e < 32; ++e) { float s0 = 0.f, s1 = 0.f;
#pragma unroll
                        for (int j = 0; j < 4; ++j) { const f32x4 w = *(const LAS f32x4*)(RW + e * DM + lane * 4 + 256 * j);
                            s0 += (v[0][j].x * w.x + v[0][j].y * w.y) + (v[0][j].z * w.z + v[0][j].w * w.w); s1 += (v[1][j].x * w.x + v[1][j].y * w.y) + (v[1][j].z * w.z + v[1][j].w * w.w); }
                        a0[e] = s0; a1[e] = s1; }
#define TRSTEP(SRC, DST, N, MASK) _Pragma("unroll") for (int e = 0; e < (N); ++e) { const bool hi_ = (lane & (MASK)) != 0; const float keep = hi_ ? SRC[e + (N)] : SRC[e], send = hi_ ? SRC[e] : SRC[e + (N)]; DST[e] = keep + __shfl_xor(send, (MASK)); }
                    float t0, t1;
                    { float b_[16], c_[8], d_[4], e_[2], f_[1]; TRSTEP(a0, b_, 16, 32) TRSTEP(b_, c_, 8, 16) TRSTEP(c_, d_, 4, 8) TRSTEP(d_, e_, 2, 4) TRSTEP(e_, f_, 1, 2) t0 = f_[0] + __shfl_xor(f_[0], 1); }
                    { float b_[16], c_[8], d_[4], e_[2], f_[1]; TRSTEP(a1, b_, 16, 32) TRSTEP(b_, c_, 8, 16) TRSTEP(c_, d_, 4, 8) TRSTEP(d_, e_, 2, 4) TRSTEP(e_, f_, 1, 2) t1 = f_[0] + __shfl_xor(f_[0], 1); }
#undef TRSTEP
                    { const int E = (lane >> 1) & 31; const float bias = rb[E]; if ((lane & 1) == 0) { LG[E] = t0 + bias; LG[32 + E] = t1 + bias; } }
                    asm volatile("s_waitcnt lgkmcnt(0)" ::: "memory");
#pragma unroll
                    for (int q = 0; q < 2; ++q) { float lg[32];
#pragma unroll
                        for (int e4 = 0; e4 < 8; ++e4) { const f32x4 x = *(const LAS f32x4*)(LG + q * 32 + e4 * 4); lg[e4 * 4] = x.x; lg[e4 * 4 + 1] = x.y; lg[e4 * 4 + 2] = x.z; lg[e4 * 4 + 3] = x.w; }
                        int se[4]; float sv[4];
#pragma unroll
                        for (int k = 0; k < 4; ++k) { float best = -INFINITY; int bi = 0;
#pragma unroll
                            for (int e = 0; e < 32; ++e) { if (lg[e] > best) { best = lg[e]; bi = e; } }
                            se[k] = bi; sv[k] = best;
#pragma unroll
                            for (int e = 0; e < 32; ++e) if (e == bi) lg[e] = -INFINITY; }
                        const float e1 = expf(sv[1] - sv[0]), e2 = expf(sv[2] - sv[0]), e3 = expf(sv[3] - sv[0]); const float inv = 1.f / (1.f + e1 + e2 + e3);
                        if (lane == 0) { const float wts[4] = {inv, e1 * inv, e2 * inv, e3 * inv};
#pragma unroll
                            for (int k = 0; k < 4; ++k) { const int ls = __hip_atomic_fetch_add(lcnt + se[k], 1, __ATOMIC_RELAXED, __HIP_MEMORY_SCOPE_WORKGROUP); sele[(lr + q) * 4 + k] = se[k]; sels[(lr + q) * 4 + k] = ls; TOKW[(m + q) * 4 + k] = wts[k]; } } }
                    asm volatile("s_waitcnt lgkmcnt(0)" ::: "memory");
                }
                __syncthreads();
                if (tid < 32) lbase[tid] = (int)__hip_atomic_fetch_add(ctl + CW_CNT + l * 32 + tid, (unsigned)lcnt[tid], RLX_AGENT);
                __syncthreads();
                { const int e = sele[tid], sl = lbase[e] + sels[tid]; TOKE[(size_t)r0 * 4 + tid] = e; TOKS[(size_t)r0 * 4 + tid] = sl; LIST[(size_t)e * NTOK + sl] = r0 + (tid >> 2); }
                __syncthreads();
            }
        }
        SEAM(pb + 5);
        STAMP(pb + 7);
        if (IN(pb + 7) || IN(pb + 8) || IN(pb + 9)) {
            LAS int* pst = (LAS int*)(lctl + LC_PSTART); LAS int* ecnt = (LAS int*)(lctl + LC_BASE); gu32* ctl = (gu32*)(KWS() + WS_CTL);
            __syncthreads();
            if (threadIdx.x == 0) { int acc = 0; for (int e = 0; e < NE; ++e) { pst[e] = acc; const int c = (int)__hip_atomic_load(ctl + CW_CNT + l * 32 + e, RLX_AGENT); ecnt[e] = c; acc += (c + 255) >> 8; } pst[NE] = acc; }
            __syncthreads();
        }
        if (IN(pb + 7) && PON(8)) {
            TID_SETUP(); unsigned char* ws = KWS(); const float* exp_b_gu = KIN(15); const bf16* HB = WSP(bf16, WS_HB); const int* LIST = WSP(int, WS_XS); const bf16* WGU_T = WSP(bf16, WS_WGU_T); bf16* HID = WSP(bf16, WS_HID);
            const LAS int* pst = (const LAS int*)(lctl + LC_PSTART); LAS int* ul = (LAS int*)(lctl + LC_ULIST);
            const int nM = pst[NE], nN = 8, nwg = nM * nN;
            if (tid < 64) { const long L = (long)tid * G + bx; int v = -1;
                if (L < nwg) { int wgid = (int)L; { const int q = nwg / 8, r = nwg % 8, xcd = wgid % 8, off = wgid / 8; wgid = (xcd < r ? xcd * (q + 1) : r * (q + 1) + (xcd - r) * q) + off; }
                    const int nig = 8 * nN, gid = wgid / nig, fm = gid * 8, gsz = (nM - fm) < 8 ? (nM - fm) : 8; const int pm = fm + ((wgid % nig) % gsz), pn = (wgid % nig) / gsz;
                    int e = 0; for (int k = 1; k < NE; ++k) if (pst[k] <= pm) e = k;
                    v = (pm << 16) | (e * nN + pn); }
                ul[tid] = v; }
            __syncthreads();
            const int nunits = bx < nwg ? (nwg - bx + G - 1) / G : 0;
            LAS unsigned short* rows16 = (LAS unsigned short*)(lctl + LC_ROWS); const LAS int* ecnt = (const LAS int*)(lctl + LC_BASE);
            for (int sl = 0; sl < nunits; ++sl) { const int v = ul[sl]; const int pm = v >> 16, e = (v & 0xffff) >> 3, pl = pm - pst[e];
                if (tid < 256) { const int idx = pl * 256 + tid; rows16[sl * 256 + tid] = (idx < ecnt[e]) ? (unsigned short)LIST[(size_t)e * NTOK + idx] : (unsigned short)0; } }
            __syncthreads();
            pg8::Gemm g{HB, WGU_T + (size_t)l * NE * 2048 * DM, NTOK, NE * 2048, DM}; pg8::ListOrder S{ul, nunits};
            pg8::EpiSwiglu E{HID, exp_b_gu + (size_t)l * NE * 2048};
            pg8::gemm_phase_gather<pg8::EpiSwiglu, pg8::ListOrder, true>(lds + RING_OFF, g, S, E, rows16);
        }
        SEAM(pb + 7);
        if (IN(pb + 8) && PON(9)) {
            TID_SETUP(); unsigned char* ws = KWS(); const float* exp_b_down = KIN(17); const bf16* HID = WSP(bf16, WS_HID); const bf16* WDN_T = WSP(bf16, WS_WDN_T); bf16* YS = WSP(bf16, WS_YS);
            const LAS int* pst = (const LAS int*)(lctl + LC_PSTART); LAS int* ul = (LAS int*)(lctl + LC_ULIST);
            const int nM = pst[NE], nN = 4, nwg = nM * nN;
            __syncthreads();
            if (tid < 64) { const long L = (long)tid * G + bx; int v = -1;
                if (L < nwg) { int wgid = (int)L; { const int q = nwg / 8, r = nwg % 8, xcd = wgid % 8, off = wgid / 8; wgid = (xcd < r ? xcd * (q + 1) : r * (q + 1) + (xcd - r) * q) + off; }
                    const int nig = 8 * nN, gid = wgid / nig, fm = gid * 8, gsz = (nM - fm) < 8 ? (nM - fm) : 8; const int pm = fm + ((wgid % nig) % gsz), pn = (wgid % nig) / gsz;
                    int e = 0; for (int k = 1; k < NE; ++k) if (pst[k] <= pm) e = k;
                    v = (pm << 16) | (e * nN + pn); }
                ul[tid] = v; }
            __syncthreads();
            const int nunits = bx < nwg ? (nwg - bx + G - 1) / G : 0;
            pg8::Gemm g{HID, WDN_T + (size_t)l * NE * DM * DE, MPAD, NE * DM, DE}; pg8::ListOrder S{ul, nunits};
            pg8::EpiDown E{YS, exp_b_down + (size_t)l * NE * DM};
            pg8::gemm_phase<pg8::EpiDown, pg8::ListOrder, true, true>(lds + RING_OFF, g, S, E);
        }
        SEAM(pb + 8);
        if (IN(pb + 9) && PON(10)) {
            TID_SETUP(); unsigned char* ws = KWS(); const float* ln2_g = KIN(18); const float* ln2_b = KIN(19); float* out = KOUT(); float* HF = WSP(float, WS_HF); bf16* HB = WSP(bf16, WS_HB);
            const bf16* YS = WSP(bf16, WS_YS); const int* TOKE = WSP(int, WS_TOK); const int* TOKS = TOKE + NTOK * 4; const float* TOKW = (const float*)(TOKS + NTOK * 4); const LAS int* pst = (const LAS int*)(lctl + LC_PSTART);
            const bool lastl = (l == NL - 1);
            for (int m0 = gw; m0 < NTOK; m0 += 2 * NGW) { f32x4 v[2][4]; const bf16* yr[2][4]; float wk[2][4];
#pragma unroll
                for (int q = 0; q < 2; ++q) { const int m = m0 + q * NGW;
#pragma unroll
                    for (int k = 0; k < 4; ++k) { wk[q][k] = TOKW[m * 4 + k]; yr[q][k] = YS + (size_t)(pst[TOKE[m * 4 + k]] * 256 + TOKS[m * 4 + k]) * DM; }
#pragma unroll
                    for (int j = 0; j < 4; ++j) v[q][j] = *(const f32x4*)(HF + (size_t)m * DM + lane * 4 + 256 * j) * DN_ALPHA; }
#pragma unroll
                for (int q = 0; q < 2; ++q)
#pragma unroll
                    for (int k = 0; k < 4; ++k)
#pragma unroll
                        for (int j = 0; j < 4; ++j) { const u16x4 y = *(const u16x4*)(yr[q][k] + lane * 4 + 256 * j); const float w = wk[q][k]; v[q][j].x += w * bf2f(y[0]); v[q][j].y += w * bf2f(y[1]); v[q][j].z += w * bf2f(y[2]); v[q][j].w += w * bf2f(y[3]); }
#pragma unroll
                for (int q = 0; q < 2; ++q) { const int m = m0 + q * NGW;
                    ln_row(v[q], ln2_g + l * DM, ln2_b + l * DM, lastl ? out + (size_t)m * DM : HF + (size_t)m * DM, lastl ? nullptr : HB + (size_t)m * DM, lane); } }
        }
        SEAM(pb + 9);
    }
#if PROBE_A >= 0
    { xcd_barrier(bar);
      const unsigned long long* st = (const unsigned long long*)(KWS() + WS_CTL + 65536); unsigned long long T = 0;
      if (PROBE_A & 1) T += st[1] - st[0];
      for (int l = 0; l < NL; ++l) for (int j = 1; j <= 10; ++j) if ((PROBE_A >> j) & 1) T += st[1 + 10 * l + j] - st[10 * l + j];
      T *= 4ull; if (T > 5000000ull) T = 5000000ull;
      const unsigned long long t0 = __builtin_amdgcn_s_memrealtime();
      while (__builtin_amdgcn_s_memrealtime() - t0 < T) __builtin_amdgcn_s_sleep(16); }
#endif
#undef IN
#undef SEAM
}

#ifndef MK_PER_PHASE
#define MK_PER_PHASE 0
#endif
extern "C" void kernel_launch(void* const* d_in, const int* in_sizes, int n_in, void* d_out, int out_size, void* d_ws, size_t ws_size, hipStream_t stream) {
    static int grid = 0;
    if (grid == 0) {
        if (n_in != 20 || in_sizes[0] != NTOK * DM || out_size != NTOK * DM || ws_size < WS_END) { fprintf(stderr, "kernel_launch: unexpected shapes (n_in %d, in0 %d, out %d, ws %zu); nothing launched\n", n_in, n_in > 0 ? in_sizes[0] : -1, out_size, ws_size); grid = -1; return; }
        int dev = 0, cus = 0, per_cu = 0;
        if (hipGetDevice(&dev) != hipSuccess || hipDeviceGetAttribute(&cus, hipDeviceAttributeMultiprocessorCount, dev) != hipSuccess) { grid = -1; return; }
        if (hipFuncSetAttribute((const void*)fwd, hipFuncAttributeMaxDynamicSharedMemorySize, LDS_BYTES) != hipSuccess) { fprintf(stderr, "kernel_launch: hipFuncSetAttribute failed\n"); grid = -1; return; }
        if (hipOccupancyMaxActiveBlocksPerMultiprocessor(&per_cu, (const void*)fwd, NWAVES * 64, LDS_BYTES) != hipSuccess || per_cu < 1) fprintf(stderr, "kernel_launch: occupancy query reports %d\n", per_cu);
        (void)hipGetLastError();
        grid = cus;
    }
    if (grid < 0) return;
    if (hipMemsetAsync((char*)d_ws + WS_CTL, 0, CTL_ZERO_BYTES, stream) != hipSuccess) return;
    Args a{};
    for (int i = 0; i < 20; ++i) a.in[i] = (const float*)d_in[i];
    a.out = (float*)d_out; a.ws = (unsigned char*)d_ws;
#if MK_PER_PHASE
    for (int p = 0; p < N_PHASES; ++p) { a.ph_lo = p; a.ph_hi = p + 1; hipLaunchKernelGGL(fwd, dim3(grid), dim3(NWAVES * 64), LDS_BYTES, stream, a); }
#else
    a.ph_lo = 0; a.ph_hi = N_PHASES;
    hipLaunchKernelGGL(fwd, dim3(grid), dim3(NWAVES * 64), LDS_BYTES, stream, a);
#endif
    const hipError_t le = hipPeekAtLastError();
    if (le != hipSuccess) fprintf(stderr, "kernel_launch: launch failed: %s\n", hipGetErrorName(le));
}
```

```cpp
#include <hip/hip_runtime.h>
#include <hip/hip_bf16.h>
#include <cstdio>
#include <cstdint>
#include <cmath>
namespace pg8 {
#define PG8_LAS __attribute__((address_space(3)))
typedef unsigned short bf16_t;
typedef short bf16x8 __attribute__((ext_vector_type(8)));
typedef float f32x4 __attribute__((ext_vector_type(4)));
typedef unsigned u32x4 __attribute__((ext_vector_type(4)));
constexpr int BM = 256, BK = 64, HALF = 128, HTB = HALF * BK * 2  , STAGE_BYTES = 8 * HTB, NXCD = 8, WGM = 8;

__host__ __device__ __forceinline__ int lds_byte(int r, int c) { const int st = (r >> 4) * 2 + (c >> 5), rr = r & 15, cc = c & 31, ob = rr * 64 + cc * 2; return st * 1024 + (ob ^ (((ob >> 9) & 1) << 5)); }
__host__ __device__ __forceinline__ void stage_rc(int b, int& R, int& C) { const int st = b / 1024, sb = b % 1024, swz = sb ^ (((sb >> 9) & 1) << 5); R = (st >> 1) * 16 + swz / 64; C = (st & 1) * 32 + (swz % 64) / 2; }
__host__ __device__ __forceinline__ int perm32(int rho) { const int n = rho >> 4, i = rho & 15; return 8 * (i >> 2) + 4 * n + (i & 3); }

struct Unit { int pm, pn; };
struct Gemm { const bf16_t* A; const bf16_t* Bt; int M, N, K; };

struct StaticOrder {
    int nM, nN, nwg, G, c;
    __host__ __device__ void init(int M, int N, int G_, int c_) { nM = M / BM; nN = N / BM; nwg = nM * nN; G = G_; c = c_; }
    __host__ __device__ bool next(int i, Unit& u) const {
        const long L = (long)i * G + c; if (L >= nwg) return false;
        int wgid = (int)L; { const int q = nwg / NXCD, r = nwg % NXCD, xcd = wgid % NXCD, off = wgid / NXCD; wgid = (xcd < r ? xcd * (q + 1) : r * (q + 1) + (xcd - r) * q) + off; }
        const int nig = WGM * nN, gid = wgid / nig, fm = gid * WGM, gsz = (nM - fm) < WGM ? (nM - fm) : WGM;
        u.pm = fm + ((wgid % nig) % gsz); u.pn = (wgid % nig) / gsz; return true;
    }
    __device__ __forceinline__ void a_ready(const Unit&) const {}
    __device__ __forceinline__ void done(const Unit&) const {}
};

__device__ __forceinline__ unsigned cvt_pk_bf16(float lo, float hi) { unsigned r; asm volatile("v_cvt_pk_bf16_f32 %0, %1, %2" : "=v"(r) : "v"(lo), "v"(hi)); return r; }
typedef float f32x2 __attribute__((ext_vector_type(2)));
__device__ __forceinline__ u32x4 pack8(const f32x4 v0, const f32x4 v1) { u32x4 w; w.x = cvt_pk_bf16(v0[0], v0[1]); w.y = cvt_pk_bf16(v0[2], v0[3]); w.z = cvt_pk_bf16(v1[0], v1[1]); w.w = cvt_pk_bf16(v1[2], v1[3]); return w; }

struct EpiPlainBf16 {
    static constexpr bool PERM = true, AFTER_DRAIN = false;
    bf16_t* O; int ldc;
    __device__ __forceinline__ void operator()(const f32x4 (&acc)[2][2][4][2], const Unit& u, int wr, int wc, int fr, int fq) const {
        const int row0 = u.pm * BM + wr * 64 + fr, col0 = u.pn * BM + wc * 32 + 8 * fq;
#pragma unroll
        for (int ai = 0; ai < 2; ++ai)
#pragma unroll
            for (int m = 0; m < 4; ++m) { bf16_t* rowp = O + (size_t)(row0 + ai * HALF + m * 16) * ldc + col0;
#pragma unroll
                for (int bj = 0; bj < 2; ++bj) *(u32x4*)(rowp + bj * HALF) = pack8(acc[ai][bj][m][0], acc[ai][bj][m][1]); }
    }
};
struct EpiFnet {
    static constexpr bool PERM = true, AFTER_DRAIN = false;
    bf16_t* MIX;
    __device__ __forceinline__ void operator()(const f32x4 (&acc)[2][2][4][2], const Unit& u, int wr, int wc, int fr, int fq) const {
        const int row0 = u.pn * 4096 + u.pm * BM + wr * 64 + fr, col0 = 768 + wc * 32 + 8 * fq;
#pragma unroll
        for (int ai = 0; ai < 2; ++ai)
#pragma unroll
            for (int m = 0; m < 4; ++m) { bf16_t* rowp = MIX + (size_t)(row0 + ai * HALF + m * 16) * 1024 + col0;
#pragma unroll
                for (int bj = 0; bj < 2; ++bj) *(u32x4*)(rowp + bj * HALF) = pack8(acc[ai][bj][m][0], acc[ai][bj][m][1]); }
    }
};
struct EpiResF32 {
    static constexpr bool PERM = false, AFTER_DRAIN = false;
    const float* base; float* out; int ldc; float alpha;
    __device__ __forceinline__ void operator()(const f32x4 (&acc)[2][2][4][2], const Unit& u, int wr, int wc, int fr, int fq) const {
        const int row0 = u.pm * BM + wr * 64 + fr, col0 = u.pn * BM + wc * 32 + 4 * fq;
#pragma unroll
        for (int ai = 0; ai < 2; ++ai)
#pragma unroll
            for (int m = 0; m < 4; ++m) { const size_t off = (size_t)(row0 + ai * HALF + m * 16) * ldc + col0;
#pragma unroll
                for (int bj = 0; bj < 2; ++bj)
#pragma unroll
                    for (int n = 0; n < 2; ++n) { const f32x4 b = *(const f32x4*)(base + off + bj * HALF + n * 16); *(f32x4*)(out + off + bj * HALF + n * 16) = b * alpha + acc[ai][bj][m][n]; } }
    }
};
__device__ __forceinline__ float swiglu1(float g, float u) { g = fminf(g, 7.0f); u = fminf(fmaxf(u, -7.0f), 7.0f); return (u + 1.0f) * g * __builtin_amdgcn_rcpf(1.0f + __expf(-1.702f * g)); }
struct EpiSwiglu {
    static constexpr bool PERM = true, AFTER_DRAIN = false;
    bf16_t* HID; const float* bgu;
    __device__ __forceinline__ void operator()(const f32x4 (&acc)[2][2][4][2], const Unit& u, int wr, int wc, int fr, int fq) const {
        const int e = u.pn >> 3, pnl = u.pn & 7; const int row0 = u.pm * BM + wr * 64 + fr, jj0 = pnl * 128 + wc * 32 + 8 * fq;
        const float* bg = bgu + (size_t)e * 2048 + jj0;
        const f32x4 bg0 = *(const f32x4*)bg, bg1 = *(const f32x4*)(bg + 4), bu0 = *(const f32x4*)(bg + 1024), bu1 = *(const f32x4*)(bg + 1028);
#pragma unroll
        for (int ai = 0; ai < 2; ++ai)
#pragma unroll
            for (int m = 0; m < 4; ++m) { bf16_t* rowp = HID + (size_t)(row0 + ai * HALF + m * 16) * 1024 + jj0;
                const f32x4 g0 = acc[ai][0][m][0] + bg0, g1 = acc[ai][0][m][1] + bg1, u0 = acc[ai][1][m][0] + bu0, u1 = acc[ai][1][m][1] + bu1;
                f32x4 h0, h1;
#pragma unroll
                for (int i = 0; i < 4; ++i) { h0[i] = swiglu1(g0[i], u0[i]); h1[i] = swiglu1(g1[i], u1[i]); }
                *(u32x4*)rowp = pack8(h0, h1); }
    }
};
struct EpiDown {
    static constexpr bool PERM = true, AFTER_DRAIN = false;
    bf16_t* Y; const float* bd;
    __device__ __forceinline__ void operator()(const f32x4 (&acc)[2][2][4][2], const Unit& u, int wr, int wc, int fr, int fq) const {
        const int e = u.pn >> 2, pnl = u.pn & 3; const int row0 = u.pm * BM + wr * 64 + fr, col0 = pnl * BM + wc * 32 + 8 * fq;
        const float* bp = bd + (size_t)e * 1024 + col0;
        f32x4 bv[2][2];
#pragma unroll
        for (int bj = 0; bj < 2; ++bj)
#pragma unroll
            for (int n = 0; n < 2; ++n) bv[bj][n] = *(const f32x4*)(bp + bj * HALF + 4 * n);
#pragma unroll
        for (int ai = 0; ai < 2; ++ai)
#pragma unroll
            for (int m = 0; m < 4; ++m) { bf16_t* rowp = Y + (size_t)(row0 + ai * HALF + m * 16) * 1024 + col0;
#pragma unroll
                for (int bj = 0; bj < 2; ++bj) *(u32x4*)(rowp + bj * HALF) = pack8(acc[ai][bj][m][0] + bv[bj][0], acc[ai][bj][m][1] + bv[bj][1]); }
    }
};
struct ListOrder {
    const PG8_LAS int* list; int n;
    __device__ __forceinline__ bool next(int i, Unit& u) const { if (i >= n) return false; const int v = __builtin_amdgcn_readfirstlane(list[i]); u.pm = v >> 16; u.pn = v & 0xffff; return true; }
    __device__ __forceinline__ void a_ready(const Unit&) const {}
    __device__ __forceinline__ void done(const Unit&) const {}
};
template <class Epi, class Sched, bool ALIGN_EPI = false, bool SP2 = false>
__device__ __forceinline__ void gemm_phase(PG8_LAS unsigned char* lds, const Gemm g, const Sched& S, const Epi& E) {
    int tid_ = threadIdx.x; asm volatile("" : "+v"(tid_));
    const int tid = tid_, wid = __builtin_amdgcn_readfirstlane(tid >> 6), lane = tid & 63, wr = wid >> 2, wc = wid & 3, fr = lane & 15, fq = lane >> 4;
    const int K = g.K, nt = K / BK;
    unsigned voffA[2], voffB[2];
#pragma unroll
    for (int i = 0; i < 2; ++i) { int R, C; stage_rc(tid * 16 + i * 8192, R, C); const int Rb = Epi::PERM ? ((R & ~31) + perm32(R & 31)) : R;
        voffA[i] = (unsigned)(R * K + C) * 2u; voffB[i] = (unsigned)(Rb * K + C) * 2u; }
    const size_t kstep = (size_t)(BK * 2);
    const size_t hstep = (size_t)HALF * K * 2;
    const size_t tstep = 2 * hstep;
    const unsigned ldsw = (unsigned)wid * 1024u;
    const int aoff = lds_byte(wr * 64 + fr, fq * 8), boff = lds_byte(wc * 32 + fr, fq * 8);
#define PG8_SA(b, h) (((b) * 2 + (h)) * HTB)
#define PG8_SB(b, h) ((4 + (b) * 2 + (h)) * HTB)
#define PG8_STAGE(bufoff, gbase, voff) do { _Pragma("unroll") for (int _i = 0; _i < 2; ++_i) \
        __builtin_amdgcn_global_load_lds((const unsigned*)((const char*)(gbase) + (voff)[_i]), (PG8_LAS unsigned*)(lds + (bufoff) + ldsw + _i * 8192), 16, 0, 0); } while (0)
#define PG8_LDA(dst, b, h) do { _Pragma("unroll") for (int m = 0; m < 4; ++m) _Pragma("unroll") for (int k = 0; k < 2; ++k) dst[m][k] = *(const PG8_LAS bf16x8*)(lds + PG8_SA(b, h) + aoff + m * 2048 + k * 1024); } while (0)
#define PG8_LDB(dst, b, h) do { _Pragma("unroll") for (int n = 0; n < 2; ++n) _Pragma("unroll") for (int k = 0; k < 2; ++k) dst[n][k] = *(const PG8_LAS bf16x8*)(lds + PG8_SB(b, h) + boff + n * 2048 + k * 1024); } while (0)
#define PG8_MMA(ai, bj, At, Bt) do { __builtin_amdgcn_s_setprio(1); _Pragma("unroll") for (int m = 0; m < 4; ++m) _Pragma("unroll") for (int n = 0; n < 2; ++n) _Pragma("unroll") for (int k = 0; k < 2; ++k) \
        acc[ai][bj][m][n] = __builtin_amdgcn_mfma_f32_16x16x32_bf16(Bt[n][k], At[m][k], acc[ai][bj][m][n], 0, 0, 0); __builtin_amdgcn_s_setprio(0); } while (0)
#define PG8_WAIT_V(n) asm volatile("s_waitcnt vmcnt(" #n ")" ::: "memory")
#define PG8_WAIT_L(n) asm volatile("s_waitcnt lgkmcnt(" #n ")" ::: "memory")
#define PG8_BAR __builtin_amdgcn_s_barrier()
#define PG8_SCHED __builtin_amdgcn_sched_barrier(0)
    Unit cur, nxt; int ui = 0;
    if (!S.next(0, cur)) return;
    f32x4 acc[2][2][4][2];
#pragma unroll
    for (int a = 0; a < 2; ++a)
#pragma unroll
        for (int b = 0; b < 2; ++b)
#pragma unroll
            for (int m = 0; m < 4; ++m)
#pragma unroll
                for (int n = 0; n < 2; ++n) acc[a][b][m][n] = (f32x4){0.f, 0.f, 0.f, 0.f};
    bf16x8 At[4][2], B0[2][2], B1[2][2];
    const char* cA = (const char*)g.A + (size_t)cur.pm * tstep; const char* cB = (const char*)g.Bt + (size_t)cur.pn * tstep;
    S.a_ready(cur);
    if constexpr (SP2) {
        PG8_STAGE(PG8_SB(0, 0), cB, voffB); PG8_STAGE(PG8_SB(0, 1), cB + hstep, voffB); PG8_STAGE(PG8_SA(0, 0), cA, voffA); PG8_STAGE(PG8_SA(0, 1), cA + hstep, voffA);
        if (wr == 1) PG8_BAR;
        PG8_WAIT_V(2); PG8_BAR;
        PG8_STAGE(PG8_SB(1, 0), cB + kstep, voffB); PG8_STAGE(PG8_SA(1, 0), cA + kstep, voffA); PG8_STAGE(PG8_SB(1, 1), cB + hstep + kstep, voffB);
        PG8_WAIT_V(6); PG8_BAR;
    } else {
        PG8_STAGE(PG8_SB(0, 0), cB, voffB); PG8_STAGE(PG8_SA(0, 0), cA, voffA); PG8_STAGE(PG8_SB(0, 1), cB + hstep, voffB); PG8_STAGE(PG8_SA(0, 1), cA + hstep, voffA);
        if (wr == 1) PG8_BAR;
        PG8_WAIT_V(4); PG8_BAR;
        PG8_STAGE(PG8_SB(1, 0), cB + kstep, voffB); PG8_STAGE(PG8_SA(1, 0), cA + kstep, voffA); PG8_STAGE(PG8_SB(1, 1), cB + hstep + kstep, voffB);
        PG8_WAIT_V(6); PG8_BAR;
    }
    for (;;) {
        const bool has_next = S.next(ui + 1, nxt);
        const char* nA = has_next ? (const char*)g.A + (size_t)nxt.pm * tstep : cA; const char* nB = has_next ? (const char*)g.Bt + (size_t)nxt.pn * tstep : cB;
        for (int t = 0; t < nt; t += 2) {
            const bool last = (t == nt - 2);
            const char* a1 = cA + (size_t)(t + 1) * kstep;
            const char* a2 = last ? nA : cA + (size_t)(t + 2) * kstep; const char* b2 = last ? nB : cB + (size_t)(t + 2) * kstep;
            const char* a3 = a2 + kstep; const char* b3 = b2 + kstep;
            if (last && has_next) S.a_ready(nxt);
            if constexpr (SP2) {
            PG8_LDB(B0, 0, 0); PG8_LDB(B1, 0, 1); PG8_SCHED; PG8_LDA(At, 0, 0); PG8_STAGE(PG8_SA(1, 1), a1 + hstep, voffA);
            PG8_WAIT_V(8); PG8_WAIT_L(0); PG8_BAR; PG8_MMA(0, 0, At, B0); PG8_MMA(0, 1, At, B1); PG8_BAR; PG8_SCHED;
            PG8_LDA(At, 0, 1); PG8_STAGE(PG8_SB(0, 0), b2, voffB); PG8_STAGE(PG8_SB(0, 1), b2 + hstep, voffB); PG8_STAGE(PG8_SA(0, 0), a2, voffA);
            PG8_WAIT_V(8); PG8_WAIT_L(0); PG8_BAR; PG8_MMA(1, 0, At, B0); PG8_MMA(1, 1, At, B1); PG8_BAR; PG8_SCHED;
            PG8_LDB(B0, 1, 0); PG8_LDB(B1, 1, 1); PG8_SCHED; PG8_LDA(At, 1, 0); PG8_STAGE(PG8_SA(0, 1), a2 + hstep, voffA);
            PG8_WAIT_V(8); PG8_WAIT_L(0); PG8_BAR; PG8_MMA(0, 0, At, B0); PG8_MMA(0, 1, At, B1); PG8_BAR; PG8_SCHED;
            PG8_LDA(At, 1, 1); PG8_STAGE(PG8_SB(1, 0), b3, voffB); PG8_STAGE(PG8_SB(1, 1), b3 + hstep, voffB); PG8_STAGE(PG8_SA(1, 0), a3, voffA);
            PG8_WAIT_V(8); PG8_WAIT_L(0); PG8_BAR; PG8_MMA(1, 0, At, B0); PG8_MMA(1, 1, At, B1); PG8_BAR; PG8_SCHED;
            } else {
            PG8_LDB(B0, 0, 0); PG8_SCHED; PG8_LDA(At, 0, 0); PG8_STAGE(PG8_SA(1, 1), a1 + hstep, voffA);
            PG8_WAIT_L(8); PG8_BAR; PG8_WAIT_L(0); PG8_MMA(0, 0, At, B0); PG8_BAR; PG8_SCHED;
            PG8_LDB(B1, 0, 1); PG8_STAGE(PG8_SB(0, 0), b2, voffB);
            PG8_BAR; PG8_WAIT_L(0); PG8_MMA(0, 1, At, B1); PG8_BAR;
            PG8_LDA(At, 0, 1); PG8_STAGE(PG8_SA(0, 0), a2, voffA);
            PG8_BAR; PG8_WAIT_L(0); PG8_MMA(1, 0, At, B0); PG8_BAR; PG8_SCHED;
            PG8_STAGE(PG8_SB(0, 1), b2 + hstep, voffB);
            PG8_WAIT_V(6); PG8_BAR; PG8_MMA(1, 1, At, B1); PG8_BAR;
            PG8_LDB(B0, 1, 0); PG8_SCHED; PG8_LDA(At, 1, 0); PG8_STAGE(PG8_SA(0, 1), a2 + hstep, voffA);
            PG8_WAIT_L(8); PG8_BAR; PG8_WAIT_L(0); PG8_MMA(0, 0, At, B0); PG8_BAR; PG8_SCHED;
            PG8_LDB(B1, 1, 1); PG8_STAGE(PG8_SB(1, 0), b3, voffB);
            PG8_BAR; PG8_WAIT_L(0); PG8_MMA(0, 1, At, B1); PG8_BAR;
            PG8_LDA(At, 1, 1); PG8_STAGE(PG8_SA(1, 0), a3, voffA);
            PG8_BAR; PG8_WAIT_L(0); PG8_MMA(1, 0, At, B0); PG8_BAR; PG8_SCHED;
            PG8_STAGE(PG8_SB(1, 1), b3 + hstep, voffB);
            PG8_WAIT_V(6); PG8_BAR; PG8_MMA(1, 1, At, B1); PG8_BAR;
            }
        }
        if constexpr (ALIGN_EPI) { if (wr == 0) PG8_BAR; }
        if constexpr (!Epi::AFTER_DRAIN) { E(acc, cur, wr, wc, fr, fq); S.done(cur); }
        if (!has_next) break;
#pragma unroll
        for (int a = 0; a < 2; ++a)
#pragma unroll
            for (int b = 0; b < 2; ++b)
#pragma unroll
                for (int m = 0; m < 4; ++m)
#pragma unroll
                    for (int n = 0; n < 2; ++n) acc[a][b][m][n] = (f32x4){0.f, 0.f, 0.f, 0.f};
        cur = nxt; cA = nA; cB = nB; ++ui;
        if constexpr (ALIGN_EPI) { if (wr == 1) PG8_BAR; }
    }
    PG8_WAIT_V(0);
    if constexpr (!ALIGN_EPI) { if (wr == 0) PG8_BAR; }
    PG8_BAR;
    if constexpr (Epi::AFTER_DRAIN) { E.fused(acc, cur, wr, wc, fr, fq, lds, wid, lane); S.done(cur); }
#undef PG8_SA
#undef PG8_SB
#undef PG8_STAGE
#undef PG8_LDA
#undef PG8_LDB
#undef PG8_MMA
#undef PG8_WAIT_V
#undef PG8_WAIT_L
#undef PG8_BAR
#undef PG8_SCHED
}
}
namespace pg8 {
template <class Epi, class Sched, bool ALIGN_EPI>
__device__ __forceinline__ void gemm_phase_gather(PG8_LAS unsigned char* lds, const Gemm g, const Sched& S, const Epi& E, const PG8_LAS unsigned short* rows16) {
    int tid_ = threadIdx.x; asm volatile("" : "+v"(tid_));
    const int tid = tid_, wid = __builtin_amdgcn_readfirstlane(tid >> 6), lane = tid & 63, wr = wid >> 2, wc = wid & 3, fr = lane & 15, fq = lane >> 4;
    const int K = g.K, nt = K / BK;
    unsigned voffB[2]; int RA[2]; unsigned CA2[2];
#pragma unroll
    for (int i = 0; i < 2; ++i) { int R, C; stage_rc(tid * 16 + i * 8192, R, C); const int Rb = Epi::PERM ? ((R & ~31) + perm32(R & 31)) : R;
        RA[i] = R; CA2[i] = (unsigned)C * 2u; voffB[i] = (unsigned)(Rb * K + C) * 2u; }
    const size_t kstep = (size_t)(BK * 2);
    const size_t hstep = (size_t)HALF * K * 2;
    const size_t tstep = 2 * hstep;
    const unsigned ldsw = (unsigned)wid * 1024u;
    const unsigned rowb = (unsigned)K * 2u;
    const int aoff = lds_byte(wr * 64 + fr, fq * 8), boff = lds_byte(wc * 32 + fr, fq * 8);
#define PG8_SA(b, h) (((b) * 2 + (h)) * HTB)
#define PG8_SB(b, h) ((4 + (b) * 2 + (h)) * HTB)
#define PG8_STAGE(bufoff, gbase, voff) do { _Pragma("unroll") for (int _i = 0; _i < 2; ++_i) \
        __builtin_amdgcn_global_load_lds((const unsigned*)((const char*)(gbase) + (voff)[_i]), (PG8_LAS unsigned*)(lds + (bufoff) + ldsw + _i * 8192), 16, 0, 0); } while (0)
#define PG8_LDA(dst, b, h) do { _Pragma("unroll") for (int m = 0; m < 4; ++m) _Pragma("unroll") for (int k = 0; k < 2; ++k) dst[m][k] = *(const PG8_LAS bf16x8*)(lds + PG8_SA(b, h) + aoff + m * 2048 + k * 1024); } while (0)
#define PG8_LDB(dst, b, h) do { _Pragma("unroll") for (int n = 0; n < 2; ++n) _Pragma("unroll") for (int k = 0; k < 2; ++k) dst[n][k] = *(const PG8_LAS bf16x8*)(lds + PG8_SB(b, h) + boff + n * 2048 + k * 1024); } while (0)
#define PG8_MMA(ai, bj, At, Bt) do { __builtin_amdgcn_s_setprio(1); _Pragma("unroll") for (int m = 0; m < 4; ++m) _Pragma("unroll") for (int n = 0; n < 2; ++n) _Pragma("unroll") for (int k = 0; k < 2; ++k) \
        acc[ai][bj][m][n] = __builtin_amdgcn_mfma_f32_16x16x32_bf16(Bt[n][k], At[m][k], acc[ai][bj][m][n], 0, 0, 0); __builtin_amdgcn_s_setprio(0); } while (0)
#define PG8_WAIT_V(n) asm volatile("s_waitcnt vmcnt(" #n ")" ::: "memory")
#define PG8_WAIT_L(n) asm volatile("s_waitcnt lgkmcnt(" #n ")" ::: "memory")
#define PG8_BAR __builtin_amdgcn_s_barrier()
#define PG8_SCHED __builtin_amdgcn_sched_barrier(0)
#define PG8_GOFF(dst, U) do { _Pragma("unroll") for (int h_ = 0; h_ < 2; ++h_) _Pragma("unroll") for (int i_ = 0; i_ < 2; ++i_) dst[h_][i_] = (unsigned)rows16[(U) * 256 + h_ * HALF + RA[i_]] * rowb + CA2[i_]; } while (0)
    Unit cur, nxt; int ui = 0;
    if (!S.next(0, cur)) return;
    f32x4 acc[2][2][4][2];
#pragma unroll
    for (int a = 0; a < 2; ++a)
#pragma unroll
        for (int b = 0; b < 2; ++b)
#pragma unroll
            for (int m = 0; m < 4; ++m)
#pragma unroll
                for (int n = 0; n < 2; ++n) acc[a][b][m][n] = (f32x4){0.f, 0.f, 0.f, 0.f};
    bf16x8 At[4][2], B0[2][2], B1[2][2];
    const char* const Ab = (const char*)g.A;
    const char* cB = (const char*)g.Bt + (size_t)cur.pn * tstep;
    unsigned gc[2][2], gn[2][2];
    PG8_GOFF(gc, 0);
    S.a_ready(cur);
    PG8_STAGE(PG8_SB(0, 0), cB, voffB); PG8_STAGE(PG8_SB(0, 1), cB + hstep, voffB); PG8_STAGE(PG8_SA(0, 0), Ab, gc[0]); PG8_STAGE(PG8_SA(0, 1), Ab, gc[1]);
    if (wr == 1) PG8_BAR;
    PG8_WAIT_V(2); PG8_BAR;
    PG8_STAGE(PG8_SB(1, 0), cB + kstep, voffB); PG8_STAGE(PG8_SA(1, 0), Ab + kstep, gc[0]); PG8_STAGE(PG8_SB(1, 1), cB + hstep + kstep, voffB);
    PG8_WAIT_V(6); PG8_BAR;
    for (;;) {
        const bool has_next = S.next(ui + 1, nxt);
        const char* nB = has_next ? (const char*)g.Bt + (size_t)nxt.pn * tstep : cB;
        if (has_next) { PG8_GOFF(gn, ui + 1); } else {
#pragma unroll
            for (int h_ = 0; h_ < 2; ++h_)
#pragma unroll
                for (int i_ = 0; i_ < 2; ++i_) gn[h_][i_] = gc[h_][i_]; }
        for (int t = 0; t < nt; t += 2) {
            const bool last = (t == nt - 2);
            const char* a1 = Ab + (size_t)(t + 1) * kstep;
            const char* a2 = last ? Ab : Ab + (size_t)(t + 2) * kstep; const char* b2 = last ? nB : cB + (size_t)(t + 2) * kstep;
            const char* a3 = a2 + kstep; const char* b3 = b2 + kstep;
            unsigned g2[2][2];
#pragma unroll
            for (int h_ = 0; h_ < 2; ++h_)
#pragma unroll
                for (int i_ = 0; i_ < 2; ++i_) g2[h_][i_] = last ? gn[h_][i_] : gc[h_][i_];
            if (last && has_next) S.a_ready(nxt);
            PG8_LDB(B0, 0, 0); PG8_LDB(B1, 0, 1); PG8_SCHED; PG8_LDA(At, 0, 0); PG8_STAGE(PG8_SA(1, 1), a1, gc[1]);
            PG8_WAIT_V(8); PG8_WAIT_L(0); PG8_BAR; PG8_MMA(0, 0, At, B0); PG8_MMA(0, 1, At, B1); PG8_BAR; PG8_SCHED;
            PG8_LDA(At, 0, 1); PG8_STAGE(PG8_SB(0, 0), b2, voffB); PG8_STAGE(PG8_SB(0, 1), b2 + hstep, voffB); PG8_STAGE(PG8_SA(0, 0), a2, g2[0]);
            PG8_WAIT_V(8); PG8_WAIT_L(0); PG8_BAR; PG8_MMA(1, 0, At, B0); PG8_MMA(1, 1, At, B1); PG8_BAR; PG8_SCHED;
            PG8_LDB(B0, 1, 0); PG8_LDB(B1, 1, 1); PG8_SCHED; PG8_LDA(At, 1, 0); PG8_STAGE(PG8_SA(0, 1), a2, g2[1]);
            PG8_WAIT_V(8); PG8_WAIT_L(0); PG8_BAR; PG8_MMA(0, 0, At, B0); PG8_MMA(0, 1, At, B1); PG8_BAR; PG8_SCHED;
            PG8_LDA(At, 1, 1); PG8_STAGE(PG8_SB(1, 0), b3, voffB); PG8_STAGE(PG8_SB(1, 1), b3 + hstep, voffB); PG8_STAGE(PG8_SA(1, 0), a3, g2[0]);
            PG8_WAIT_V(8); PG8_WAIT_L(0); PG8_BAR; PG8_MMA(1, 0, At, B0); PG8_MMA(1, 1, At, B1); PG8_BAR; PG8_SCHED;
        }
        if constexpr (ALIGN_EPI) { if (wr == 0) PG8_BAR; }
        E(acc, cur, wr, wc, fr, fq); S.done(cur);
        if (!has_next) break;
#pragma unroll
        for (int a = 0; a < 2; ++a)
#pragma unroll
            for (int b = 0; b < 2; ++b)
#pragma unroll
                for (int m = 0; m < 4; ++m)
#pragma unroll
                    for (int n = 0; n < 2; ++n) acc[a][b][m][n] = (f32x4){0.f, 0.f, 0.f, 0.f};
        cur = nxt; cB = nB; ++ui;
#pragma unroll
        for (int h_ = 0; h_ < 2; ++h_)
#pragma unroll
            for (int i_ = 0; i_ < 2; ++i_) gc[h_][i_] = gn[h_][i_];
        if constexpr (ALIGN_EPI) { if (wr == 1) PG8_BAR; }
    }
    PG8_WAIT_V(0);
    if constexpr (!ALIGN_EPI) { if (wr == 0) PG8_BAR; }
    PG8_BAR;
#undef PG8_SA
#undef PG8_SB
#undef PG8_STAGE
#undef PG8_LDA
#undef PG8_LDB
#undef PG8_MMA
#undef PG8_WAIT_V
#undef PG8_WAIT_L
#undef PG8_BAR
#undef PG8_SCHED
#undef PG8_GOFF
}
}
#define GAS __attribute__((address_space(1)))
#define LAS __attribute__((address_space(3)))
typedef unsigned short bf16;
typedef unsigned v4u __attribute__((ext_vector_type(4)));
typedef float f32x4 __attribute__((ext_vector_type(4)));
typedef short bf16x8 __attribute__((ext_vector_type(8)));
typedef GAS unsigned gu32;
typedef GAS unsigned long long gu64;
#define RLX_AGENT __ATOMIC_RELAXED, __HIP_MEMORY_SCOPE_AGENT
#define LDS_WAIT() asm volatile("s_waitcnt lgkmcnt(0)" ::: "memory")
#define VM_WAIT() asm volatile("s_waitcnt vmcnt(0)" ::: "memory")
__device__ __forceinline__ unsigned long long rt() { return __builtin_amdgcn_s_memrealtime(); }
__device__ __forceinline__ unsigned f2bf(float f) { unsigned u = __builtin_bit_cast(unsigned, f); return (u + 0x7fffu + ((u >> 16) & 1u)) >> 16; }
__device__ __forceinline__ unsigned pk2(float lo, float hi) { return f2bf(lo) | (f2bf(hi) << 16); }
#define XB_TMO      128
#define XB_XCNT(j)  (256  + 64 * (j))
#define XB_XSUB(j)  (1280 + 64 * (j))
#define XB_XGEN(j)  (2304 + 64 * (j))
#define XB_TOP      3328
#define XB_TOPGEN   3392
#define XCD_BAR_WORDS 3456
#define XB_SPIN_CAP (1u << 18)

__device__ __forceinline__ unsigned xb_ld(unsigned* p)              { return __hip_atomic_load(p, __ATOMIC_RELAXED, __HIP_MEMORY_SCOPE_AGENT); }
__device__ __forceinline__ unsigned xb_add(unsigned* p, unsigned v) { return __hip_atomic_fetch_add(p, v, __ATOMIC_RELAXED, __HIP_MEMORY_SCOPE_AGENT); }
__device__ __forceinline__ unsigned xb_xcc_id() { return (unsigned)__builtin_amdgcn_s_getreg((3 << 11) | 20) & 0xFu; }
#define XB_SPIN(cond, bar) do { unsigned _sp = 0; while (cond) { __builtin_amdgcn_s_sleep(1); \
    if ((++_sp & 255u) == 0u) { if (xb_ld(&(bar)[XB_TMO])) break; if (_sp > XB_SPIN_CAP) { atomicAdd(&(bar)[XB_TMO], 1u); break; } } } } while (0)

struct XcdBarrier {
    unsigned* bar; unsigned x;
    volatile LAS unsigned* st;
};

__device__ __forceinline__ XcdBarrier xcd_barrier_post(unsigned* bar, volatile LAS unsigned* st) {
    XcdBarrier b; b.bar = bar; b.x = xb_xcc_id(); b.st = st;
    if (threadIdx.x == 0) (void)xb_add(&bar[XB_XCNT(b.x)], 1u);
    return b;
}
__device__ __forceinline__ void xcd_barrier_complete(unsigned* bar, unsigned x, unsigned& nloc, unsigned& nx) {
    const unsigned G = gridDim.x * gridDim.y * gridDim.z;
    unsigned sum, cnt, mine, sp = 0u;
    for (;;) {
        sum = 0u; cnt = 0u; mine = 0u;
#pragma unroll
        for (unsigned j = 0; j < 16; ++j) { const unsigned c = xb_ld(&bar[XB_XCNT(j)]); sum += c; cnt += (c > 0u) ? 1u : 0u; mine = (j == x) ? c : mine; }
        if (sum == G) break;
        __builtin_amdgcn_s_sleep(1);
        if ((++sp & 255u) == 0u) { if (xb_ld(&bar[XB_TMO])) break; if (sp > XB_SPIN_CAP) { atomicAdd(&bar[XB_TMO], 1u); break; } }
    }
    nloc = mine > 0u ? mine : 1u; nx = cnt > 0u ? cnt : 1u;
}

__device__ __forceinline__ void xcd_barrier(const XcdBarrier& b) {
    asm volatile("s_waitcnt vmcnt(0)" ::: "memory");
    __syncthreads();
    if (threadIdx.x == 0) {
        unsigned* bar = b.bar;
        __builtin_amdgcn_s_waitcnt(0);
        unsigned nloc = b.st[0], nx = b.st[1];
        if (nloc == 0u) { xcd_barrier_complete(bar, b.x, nloc, nx); b.st[0] = nloc; b.st[1] = nx; }
        const unsigned old = xb_add(&bar[XB_XSUB(b.x)], 1u);
        const unsigned gen = old / nloc;
        if (old + 1u == (gen + 1u) * nloc) {
            __builtin_amdgcn_fence(__ATOMIC_RELEASE, "agent");
            asm volatile("s_waitcnt vmcnt(0)" ::: "memory");
            const unsigned og = xb_add(&bar[XB_TOP], 1u);
            const unsigned tg = og / nx;
            if (og + 1u == (tg + 1u) * nx) xb_add(&bar[XB_TOPGEN], 1u);
            else XB_SPIN(xb_ld(&bar[XB_TOPGEN]) == tg, bar);
            __builtin_amdgcn_fence(__ATOMIC_ACQUIRE, "agent");
            xb_add(&bar[XB_XGEN(b.x)], 1u);
            asm volatile("s_waitcnt vmcnt(0)" ::: "memory");
        } else {
            XB_SPIN(xb_ld(&bar[XB_XGEN(b.x)]) == gen, bar);
            __builtin_amdgcn_fence(__ATOMIC_ACQUIRE, "agent");
            asm volatile("s_waitcnt vmcnt(0)" ::: "memory");
        }
    }
    __syncthreads();
}
namespace attn_body {
using bf16=__hip_bfloat16;
using bf16x8=__attribute__((ext_vector_type(8)))short;
using s16x4=__attribute__((ext_vector_type(4)))short;
using f32x16=__attribute__((ext_vector_type(16)))float;
using u32x4=__attribute__((ext_vector_type(4)))unsigned;
constexpr int BATCH=8,NHEAD=8,NKVH=2,SEQ=4096,D=64;
constexpr int DMQ=512,DMK=128,DMV=2048,DMO=1024;
constexpr int NW=8,QBLK=32,QB=QBLK*NW,KVBLK=64,NQB=SEQ/QB;
constexpr int ATTN_UNIT_ROWS=QB;
__device__ __forceinline__ int crow(int r,int hi){return (r&3)+8*(r>>2)+4*hi;}
#define SBAR() __builtin_amdgcn_sched_barrier(0)
__device__ __forceinline__ void cmask(f32x16&p0,f32x16&p1,int jb,int qrel,int hi){
  const float NEG=-INFINITY; int kb=64*jb+4*hi;
  #pragma unroll
  for(int r=0;r<16;++r){int kv=kb+(r&3)+8*(r>>2); if(kv>qrel)p0[r]=NEG; if(kv+32>qrel)p1[r]=NEG;}
}

constexpr int NSLOT=3, SLOTB=8192;
constexpr int LDS_K=0, LDS_V=NSLOT*SLOTB, LDS_WS=2*NSLOT*SLOTB, LDS_OST=LDS_WS+NW*64*4, LDS_BYTES=LDS_OST+NW*4096;
constexpr float C2=0.125f*1.4426950408889634f;
__device__ __forceinline__ void glds16(const void*gsrc,unsigned lds_dst){unsigned keep;
  asm volatile("s_mov_b32 %0, m0\n\ts_mov_b32 m0, %2\n\ts_nop 0\n\tglobal_load_lds_dwordx4 %1, off\n\ts_mov_b32 m0, %0":"=&s"(keep):"v"(gsrc),"s"(lds_dst):"memory");}
__device__ __forceinline__ float max3f(float a,float b,float c){float r;asm("v_max3_f32 %0, %1, %2, %3":"=v"(r):"v"(a),"v"(b),"v"(c));return r;}
__device__ __forceinline__ float max2f(float a,float b){float r;asm("v_max_f32_e32 %0, %1, %2":"=v"(r):"v"(a),"v"(b));return r;}
__device__ __forceinline__ float fadd_s(float a,float b){float r;asm("v_add_f32_e32 %0, %1, %2":"=v"(r):"v"(a),"v"(b));return r;}
__device__ __forceinline__ float fsub_s(float a,float b){float r;asm("v_sub_f32_e32 %0, %1, %2":"=v"(r):"v"(a),"v"(b));return r;}
typedef float f32x2_t __attribute__((ext_vector_type(2))); typedef __bf16 bf16x2_t __attribute__((ext_vector_type(2)));
__device__ __forceinline__ unsigned cvtpk_s(float lo,float hi){f32x2_t v={lo,hi};bf16x2_t b=__builtin_convertvector(v,bf16x2_t);return __builtin_bit_cast(unsigned,b);}
#define WAIT_BAR(N) asm volatile("s_waitcnt vmcnt(" #N ") lgkmcnt(0)\n\ts_barrier":::"memory")

__device__ __forceinline__ void qkt(f32x16&p0,f32x16&p1,const char*Kslot,const bf16x8*qr,const f32x16&negm,int r32,int hi){
  const char*kb=Kslot+hi*1024+r32*16;
  #pragma unroll
  for(int d0=0;d0<4;++d0){
    const bf16x8 b0=*reinterpret_cast<const bf16x8*>(kb+d0*2048);
    const bf16x8 b1=*reinterpret_cast<const bf16x8*>(kb+d0*2048+512);
    if(d0==0){p0=__builtin_amdgcn_mfma_f32_32x32x16_bf16(b0,qr[0],negm,0,0,0);p1=__builtin_amdgcn_mfma_f32_32x32x16_bf16(b1,qr[0],negm,0,0,0);}
    else{p0=__builtin_amdgcn_mfma_f32_32x32x16_bf16(b0,qr[d0],p0,0,0,0);p1=__builtin_amdgcn_mfma_f32_32x32x16_bf16(b1,qr[d0],p1,0,0,0);}}
}
typedef __attribute__((address_space(3))) const char* lds_cptr;
typedef short v4i16_t __attribute__((ext_vector_type(4)));
__device__ __forceinline__ void kload8(bf16x8*kf,lds_cptr kp){
  kf[0]=*(const __attribute__((address_space(3))) bf16x8*)(kp);      kf[1]=*(const __attribute__((address_space(3))) bf16x8*)(kp+512);
  kf[2]=*(const __attribute__((address_space(3))) bf16x8*)(kp+2048); kf[3]=*(const __attribute__((address_space(3))) bf16x8*)(kp+2560);
  kf[4]=*(const __attribute__((address_space(3))) bf16x8*)(kp+4096); kf[5]=*(const __attribute__((address_space(3))) bf16x8*)(kp+4608);
  kf[6]=*(const __attribute__((address_space(3))) bf16x8*)(kp+6144); kf[7]=*(const __attribute__((address_space(3))) bf16x8*)(kp+6656);
}
__device__ __forceinline__ void kload2(bf16x8*kf,lds_cptr kp,int j){ kf[2*j]=*(const __attribute__((address_space(3))) bf16x8*)(kp+j*2048); kf[2*j+1]=*(const __attribute__((address_space(3))) bf16x8*)(kp+j*2048+512); }
__device__ __forceinline__ s16x4 vtr(lds_cptr p){ return __builtin_bit_cast(s16x4,__builtin_amdgcn_ds_read_tr16_b64_v4i16((__attribute__((address_space(3))) v4i16_t*)p)); }
__device__ __forceinline__ float rowmax(const f32x16&p0,const f32x16&p1){
  float a=max3f(p0[0],p0[1],p1[0]),b=max3f(p0[2],p0[3],p1[1]);a=max3f(a,p1[2],p1[3]);
  #pragma unroll
  for(int r=4;r<16;r+=4){a=max3f(a,p0[r],p0[r+1]);b=max3f(b,p0[r+2],p0[r+3]);a=max3f(a,p1[r],p1[r+1]);b=max3f(b,p1[r+2],p1[r+3]);}
  const float m=max2f(a,b);
  auto rr=__builtin_amdgcn_permlane32_swap(__float_as_uint(m),__float_as_uint(m),false,false);
  return max2f(__uint_as_float(rr[0]),__uint_as_float(rr[1]));
}
__device__ __forceinline__ void pv(f32x16*o,int vb,bf16x8 pa0,bf16x8 pa1,bf16x8 pa2,bf16x8 pa3){
  #pragma unroll
  for(int d0=0;d0<2;++d0){s16x4 lo[4],hi[4];
    #pragma unroll
    for(int ks=0;ks<4;++ks){
      asm volatile("ds_read_b64_tr_b16 %0,%1 offset:%c2":"=&v"(lo[ks]):"v"(vb),"i"(d0*4096+ks*1024):"memory");
      asm volatile("ds_read_b64_tr_b16 %0,%1 offset:%c2":"=&v"(hi[ks]):"v"(vb),"i"(d0*4096+ks*1024+512):"memory");}
    asm volatile("s_waitcnt lgkmcnt(0)":::"memory");SBAR();
    #define PK(k) (bf16x8){lo[k][0],lo[k][1],lo[k][2],lo[k][3],hi[k][0],hi[k][1],hi[k][2],hi[k][3]}
    o[d0]=__builtin_amdgcn_mfma_f32_32x32x16_bf16(pa0,PK(0),o[d0],0,0,0);
    o[d0]=__builtin_amdgcn_mfma_f32_32x32x16_bf16(pa1,PK(1),o[d0],0,0,0);
    o[d0]=__builtin_amdgcn_mfma_f32_32x32x16_bf16(pa2,PK(2),o[d0],0,0,0);
    o[d0]=__builtin_amdgcn_mfma_f32_32x32x16_bf16(pa3,PK(3),o[d0],0,0,0);
    #undef PK
  }
}

#ifndef ATTN_STORE16
#define ATTN_STORE16(p,v) (*(u32x4*)(p)=(v))
#endif
template<int THRL> __device__ __forceinline__ void attn_unit(int b,int h,int qb,const bf16*Q,const bf16*__restrict__ K,const bf16*__restrict__ V,bf16*O,char*shm){
  int tid_=threadIdx.x; asm volatile("":"+v"(tid_)); const int tid=tid_,lane=tid&63,r32=lane&31,hi=lane>>5; const int wid=__builtin_amdgcn_readfirstlane(tid>>6);
  const long rowbase=(long)b*SEQ; const int q0=qb*QB;
  const bf16*Qw=Q+(rowbase+q0+wid*QBLK)*DMQ+h*D; const int kvh=h>>2;
  const bf16*Kh=K+rowbase*DMK+kvh*D,*Vh=V+rowbase*DMV+kvh*D;
  const unsigned lds0=(unsigned)(uintptr_t)shm;
  float*wsf=(float*)(shm+LDS_WS)+wid*64;
  const bf16*ksrc=Kh+(long)lane*DMK+wid*8;
  const bf16*vsrc=Vh+(long)(16*(wid&3)+(lane>>2))*DMV+(wid>>2)*32+(lane&3)*8;
  const unsigned kdst=lds0+LDS_K+wid*1024, vdst=lds0+LDS_V+wid*1024;
  #define DMA_K(t,slot) glds16(ksrc+(long)(t)*KVBLK*DMK,(unsigned)__builtin_amdgcn_readfirstlane(kdst+(slot)))
  #define DMA_V(t,slot) glds16(vsrc+(long)(t)*KVBLK*DMV,(unsigned)__builtin_amdgcn_readfirstlane(vdst+(slot)))
  const int vb0=(int)(lds0+LDS_V)+((lane>>4)&1)*32+(lane&3)*8+(4*hi+((lane&15)>>2))*64;
  const char*Kbase=shm+LDS_K; bf16x8 kf[8];
  const lds_cptr shm3=(lds_cptr)shm; const lds_cptr kp0=shm3+LDS_K+hi*1024+r32*16; const lds_cptr vp0=shm3+LDS_V+((lane>>4)&1)*32+(lane&3)*8+(4*hi+((lane&15)>>2))*64;
  constexpr int NT=SEQ/KVBLK;
  DMA_K(0,0);DMA_V(0,0);DMA_K(1,SLOTB);
  bf16x8 qr[4];
  #pragma unroll
  for(int d0=0;d0<4;++d0)qr[d0]=*reinterpret_cast<const bf16x8*>(&Qw[(long)r32*DMQ+d0*16+hi*8]);
  float mhat=0.f,l_reg=0.f;f32x16 o[2];o[0]=f32x16{};o[1]=f32x16{};f32x16 negm=f32x16{};asm volatile("":"+v"(negm));
  #define CMASK(P0,P1,t) do{}while(0)
  bool resc=false;
  #define START(P0,P1) do{ const float rm=rowmax(P0,P1); resc=false; \
    { const float dl=rm; mhat=fadd_s(mhat,dl); \
      _Pragma("unroll") for(int r=0;r<16;++r){P0[r]=fsub_s(P0[r],dl);P1[r]=fsub_s(P1[r],dl);} \
      _Pragma("unroll") for(int r=0;r<16;++r)negm[r]=-mhat; asm volatile("":"+v"(negm)); } \
    _Pragma("unroll") for(int r=0;r<16;++r)P0[r]=__builtin_amdgcn_exp2f(P0[r]); }while(0)
  #define RESC() do{ if(resc){ asm volatile("s_waitcnt lgkmcnt(0)":::"memory"); \
      _Pragma("unroll") for(int d_=0;d_<2;++d_) _Pragma("unroll") for(int r=0;r<16;++r)o[d_][r]*=wsf[crow(r,hi)]; } }while(0)
  f32x16 pA0,pA1,pB0,pB1;
  int sl_prev=0,sl_cur=0,sl_next=SLOTB;
  #define ROT() do{sl_prev=sl_cur;sl_cur=sl_next;sl_next=(sl_next==(NSLOT-1)*SLOTB)?0:sl_next+SLOTB;}while(0)
  DMA_K(2,2*SLOTB);
  WAIT_BAR(3);
  qkt(pA0,pA1,Kbase,qr,negm,r32,hi);asm volatile("s_nop 15\n\ts_nop 7":"+v"(pA0),"+v"(pA1));CMASK(pA0,pA1,0);
  START(pA0,pA1);
  _Pragma("unroll") for(int r=0;r<16;++r)pA1[r]=__builtin_amdgcn_exp2f(pA1[r]);
  WAIT_BAR(0);
  DMA_K(3,0);DMA_V(1,SLOTB);
  ROT();
  kload8(kf,kp0+sl_cur);
  WAIT_BAR(2);
  s16x4 vlo[8],vhi[8]; u32x4 pw0,pw1,pw2,pw3;
  #define PKW(P,B) cvtpk_s(P[B],P[B+1])
  #define PAF(k) __builtin_bit_cast(bf16x8,pw##k)
  #define VFR(i) (bf16x8){vlo[i][0],vlo[i][1],vlo[i][2],vlo[i][3],vhi[i][0],vhi[i][1],vhi[i][2],vhi[i][3]}
  #define PIN(x) asm volatile("":"+v"(x))
  #define MX3(a,b,c) __builtin_fmaxf(__builtin_fmaxf((a),(b)),(c))
  #define GAPA(MF,A0,A1,A2,A3,W0,W1,PW) do{ MF; sacc+=A0; sacc+=A1; sacc+=A2; sacc+=A3; PIN(sacc); W0; W1; PIN(PW); SBAR(); }while(0)
  #define EX(v) __builtin_amdgcn_exp2f(v)
  #define GAPB(MF,X,B) do{ MF; X[B]=EX(X[B]); X[B+1]=EX(X[B+1]); X[B+2]=EX(X[B+2]); X[B+3]=EX(X[B+3]); PIN(X); SBAR(); }while(0)
  #define VRD(i) do{ vlo[i]=vtr(vp_+(((i)>>2)*4096+((i)&3)*1024)); vhi[i]=vtr(vp_+(((i)>>2)*4096+((i)&3)*1024+512)); }while(0)
  #define KRD(G,j) do{ if(G){ kload2(kf,kp0+sl_next,j); SBAR(); } }while(0)
  #define STEP(C0,C1,P0,P1,t,GK,GV,GL) do{ SBAR(); \
    const lds_cptr vp_=vp0+sl_prev; \
    VRD(0); SBAR(); float sacc=(P0[0]+P0[1]); \
    GAPA(C0=__builtin_amdgcn_mfma_f32_32x32x16_bf16(kf[0],qr[0],negm,0,0,0), P0[2],P0[3],P0[4],P0[5],     pw0[0]=PKW(P0,0), pw0[1]=PKW(P0,2), pw0); \
    VRD(4); SBAR(); GAPA(C1=__builtin_amdgcn_mfma_f32_32x32x16_bf16(kf[1],qr[0],negm,0,0,0), P0[6],P0[7],P0[8],P0[9],     pw0[2]=PKW(P0,4), pw0[3]=PKW(P0,6), pw0); \
    VRD(1); SBAR(); GAPA(C0=__builtin_amdgcn_mfma_f32_32x32x16_bf16(kf[2],qr[1],C0,0,0,0),   P0[10],P0[11],P0[12],P0[13], pw1[0]=PKW(P0,8), pw1[1]=PKW(P0,10), pw1); \
    VRD(5); SBAR(); GAPA(C1=__builtin_amdgcn_mfma_f32_32x32x16_bf16(kf[3],qr[1],C1,0,0,0),   P0[14],P0[15],P1[0],P1[1],   pw1[2]=PKW(P0,12),pw1[3]=PKW(P0,14), pw1); \
    VRD(2); SBAR(); GAPA(C0=__builtin_amdgcn_mfma_f32_32x32x16_bf16(kf[4],qr[2],C0,0,0,0),   P1[2],P1[3],P1[4],P1[5],     pw2[0]=PKW(P1,0), pw2[1]=PKW(P1,2), pw2); \
    VRD(6); SBAR(); GAPA(C1=__builtin_amdgcn_mfma_f32_32x32x16_bf16(kf[5],qr[2],C1,0,0,0),   P1[6],P1[7],P1[8],P1[9],     pw2[2]=PKW(P1,4), pw2[3]=PKW(P1,6), pw2); \
    VRD(3); SBAR(); GAPA(C0=__builtin_amdgcn_mfma_f32_32x32x16_bf16(kf[6],qr[3],C0,0,0,0),   P1[10],P1[11],P1[12],P1[13], pw3[0]=PKW(P1,8), pw3[1]=PKW(P1,10), pw3); \
    VRD(7); SBAR(); GAPA(C1=__builtin_amdgcn_mfma_f32_32x32x16_bf16(kf[7],qr[3],C1,0,0,0),   P1[14],P1[15],0.f,0.f,       pw3[2]=PKW(P1,12),pw3[3]=PKW(P1,14), pw3); \
    l_reg+=sacc; \
    if(GK){DMA_K((t)+3,sl_cur);} if(GV){DMA_V((t)+1,sl_next);} \
    CMASK(C0,C1,t); \
    { float a=MX3(C0[0],C0[1],C1[0]),b=MX3(C0[2],C0[3],C1[1]); a=MX3(a,C1[2],C1[3]); \
      _Pragma("unroll") for(int r=4;r<16;r+=4){a=MX3(a,C0[r],C0[r+1]);b=MX3(b,C0[r+2],C0[r+3]);a=MX3(a,C1[r],C1[r+1]);b=MX3(b,C1[r+2],C1[r+3]);} \
      float rm=__builtin_fmaxf(a,b); { auto rr=__builtin_amdgcn_permlane32_swap(__float_as_uint(rm),__float_as_uint(rm),false,false); rm=__builtin_fmaxf(__uint_as_float(rr[0]),__uint_as_float(rr[1])); } \
      resc=false; \
      if(__builtin_expect(__any(rm>(float)THRL),0)){ const float dl=__builtin_fmaxf(rm,0.f); mhat+=dl; \
        _Pragma("unroll") for(int r=0;r<16;++r){C0[r]-=dl;C1[r]-=dl;} \
        _Pragma("unroll") for(int r=0;r<16;++r)negm[r]=-mhat; asm volatile("":"+v"(negm)); \
        const float f=__builtin_amdgcn_exp2f(-dl); l_reg*=f; if(hi==0)wsf[r32]=f; resc=true; } } \
    SBAR(); \
    GAPB(o[0]=__builtin_amdgcn_mfma_f32_32x32x16_bf16(PAF(0),VFR(0),o[0],0,0,0), C0,0); \
    GAPB(o[1]=__builtin_amdgcn_mfma_f32_32x32x16_bf16(PAF(0),VFR(4),o[1],0,0,0), C0,4); \
    KRD(GL,0); GAPB(o[0]=__builtin_amdgcn_mfma_f32_32x32x16_bf16(PAF(1),VFR(1),o[0],0,0,0), C0,8); \
    KRD(GL,1); GAPB(o[1]=__builtin_amdgcn_mfma_f32_32x32x16_bf16(PAF(1),VFR(5),o[1],0,0,0), C0,12); \
    KRD(GL,2); GAPB(o[0]=__builtin_amdgcn_mfma_f32_32x32x16_bf16(PAF(2),VFR(2),o[0],0,0,0), C1,0); \
    KRD(GL,3); GAPB(o[1]=__builtin_amdgcn_mfma_f32_32x32x16_bf16(PAF(2),VFR(6),o[1],0,0,0), C1,4); \
    GAPB(o[0]=__builtin_amdgcn_mfma_f32_32x32x16_bf16(PAF(3),VFR(3),o[0],0,0,0), C1,8); \
    GAPB(o[1]=__builtin_amdgcn_mfma_f32_32x32x16_bf16(PAF(3),VFR(7),o[1],0,0,0), C1,12); \
    }while(0)
  int t=1;
  #undef CMASK
  #define CMASK(P0,P1,t) do{}while(0)
  for(;t+5<NT;t+=2){
    STEP(pB0,pB1,pA0,pA1,t,true,true,true);     WAIT_BAR(2); RESC(); ROT();
    STEP(pA0,pA1,pB0,pB1,t+1,true,true,true);   WAIT_BAR(2); RESC(); ROT();
  }
  #undef CMASK
  #define CMASK(P0,P1,t) do{}while(0)
  #define ENDW(tt) do{ if((tt)+3<NT){WAIT_BAR(2);} else if((tt)+2<NT){WAIT_BAR(1);} else {WAIT_BAR(0);} }while(0)
  for(;t+1<NT;t+=2){
    STEP(pB0,pB1,pA0,pA1,t,(t+3<NT),(t+1<NT),(t+1<NT));       ENDW(t);   RESC(); ROT();
    STEP(pA0,pA1,pB0,pB1,t+1,(t+4<NT),(t+2<NT),(t+2<NT));     ENDW(t+1); RESC(); ROT();
  }
  STEP(pB0,pB1,pA0,pA1,NT-1,false,false,false); RESC();
  { float sacc=pB0[0]+pB0[1]; _Pragma("unroll") for(int r=2;r<16;++r)sacc+=pB0[r]; _Pragma("unroll") for(int r=0;r<16;++r)sacc+=pB1[r]; l_reg+=sacc;
    pw0=(u32x4){PKW(pB0,0),PKW(pB0,2),PKW(pB0,4),PKW(pB0,6)};pw1=(u32x4){PKW(pB0,8),PKW(pB0,10),PKW(pB0,12),PKW(pB0,14)};pw2=(u32x4){PKW(pB1,0),PKW(pB1,2),PKW(pB1,4),PKW(pB1,6)};pw3=(u32x4){PKW(pB1,8),PKW(pB1,10),PKW(pB1,12),PKW(pB1,14)};
    SBAR(); pv(o,vb0+sl_cur,PAF(0),PAF(1),PAF(2),PAF(3)); }
  #undef PKW
  #undef PAF
  #undef VFR
  #undef PIN
  #undef MX3
  #undef GAPA
  #undef GAPB
  #undef EX
  #undef VRD
  #undef KRD
  #undef STEP
  #undef ENDW
  {auto rr=__builtin_amdgcn_permlane32_swap(__float_as_uint(l_reg),__float_as_uint(l_reg),false,false);l_reg=__uint_as_float(rr[0])+__uint_as_float(rr[1]);}
  if(hi==0)wsf[32+r32]=l_reg;asm volatile("s_waitcnt lgkmcnt(0)":::"memory");
  float rli[16];
  #pragma unroll
  for(int r=0;r<16;++r)rli[r]=__builtin_amdgcn_rcpf(wsf[32+crow(r,hi)]);
  bf16*Ow=O+(rowbase+q0+wid*QBLK)*DMO+h*D;
  { bf16*stg=(bf16*)(shm+LDS_OST)+wid*2048;
    #pragma unroll
    for(int r=0;r<16;++r){const int orow=crow(r,hi);
      #pragma unroll
      for(int d0=0;d0<2;++d0)stg[orow*64+d0*32+r32]=__float2bfloat16(o[d0][r]*rli[r]);}
    asm volatile("s_waitcnt lgkmcnt(0)":::"memory");
    #pragma unroll
    for(int i=0;i<4;++i){const int row=i*8+(lane>>3),ch=lane&7; const u32x4 v=*(const u32x4*)(stg+row*64+ch*8); ATTN_STORE16(Ow+(long)row*DMO+ch*8,v);} }
  asm volatile("s_waitcnt lgkmcnt(0)\n\ts_barrier":::"memory");
  #undef DMA_K
  #undef DMA_V
  #undef CMASK
  #undef START
  #undef RESC
  #undef ROT
}
constexpr int ATTN_LDS_BYTES=LDS_BYTES;
struct AttnTensors { const bf16* Q; const bf16* K; const bf16* V; bf16* O; };
struct AttnUnit { int bh; int qb; };
struct StaticOrder {
  int vcu, G;
  __device__ __forceinline__ explicit StaticOrder(int grid,int block):vcu((grid%8==0)?(block%8)*(grid/8)+block/8:block),G(grid){}
  __device__ __forceinline__ bool next(int i,AttnUnit&u)const{ const int per=(BATCH*NHEAD*NQB+G-1)/G; if(i>=per)return false; const int idx=vcu*per+i; if(idx>=BATCH*NHEAD*NQB)return false;
    const int qb=idx%NQB, hq=(idx/NQB)&3, bk=idx/(NQB*4), kvh=bk&1, b=bk>>1; u.bh=b*NHEAD+kvh*4+hq; u.qb=qb; return true; }
  __device__ __forceinline__ void a_ready(const AttnUnit&)const{}
  __device__ __forceinline__ void done(const AttnUnit&)const{}
};
template<class Sched,int THRL=8> __device__ __forceinline__ void attn_phase(char*lds,const AttnTensors&T,const Sched&S){
  AttnUnit u;
  for(int i=0;S.next(i,u);++i){ S.a_ready(u); attn_unit<THRL>(u.bh/NHEAD,u.bh%NHEAD,u.qb,T.Q,T.K,T.V,T.O,lds); S.done(u); }
}
#undef SBAR
#undef WAIT_BAR
}
constexpr int NB = 8, SEQ = 4096, DM = 1024, NL = 4, NTOK = NB * SEQ;
constexpr int INW = 1824, INP = 2048;
constexpr int C_AQ = 0, C_AK = 512, C_AV = 640, C_GQ = 768, C_GK = 896, C_GV = 1024, C_GR = 1280, C_FX = 1536, C_GLR = 1792;
constexpr int NE = 32, TOPK = 4, DE = 1024;
constexpr int MPAD = NTOK * TOPK + NE * 256;
constexpr float LN_EPS = 1e-5f, RMS_EPS = 1e-6f;
constexpr float DN_ALPHA = 1.681792830507429f;
constexpr float QSCALE = 0.125f * 1.4426950408889634f;
constexpr float GLA_QSCALE = 0.17677669529663687f;

constexpr size_t MiB = 1u << 20;
constexpr size_t WS_CTL = 0, CTL_ZERO_BYTES = 1 * MiB;
constexpr size_t WS_ROPE = 1 * MiB;
constexpr size_t WS_WIN_T = 2 * MiB;
constexpr size_t WS_WOUT_T = 18 * MiB;
constexpr size_t WS_FTAB = 26 * MiB;
constexpr size_t WS_TW = WS_FTAB + 65536;
constexpr size_t WS_FTMP = 27 * MiB;
constexpr size_t WS_WGU_T = 90 * MiB;
constexpr size_t WS_WDN_T = 602 * MiB;
constexpr size_t WS_HF = 858 * MiB;
constexpr size_t WS_HB = 986 * MiB;
constexpr size_t WS_PROJ = 1050 * MiB;
constexpr size_t WS_QB = 1178 * MiB;
constexpr size_t WS_KB = 1210 * MiB;
constexpr size_t WS_MIX = 1218 * MiB;
constexpr size_t WS_T1 = 1282 * MiB;
constexpr size_t WS_UVT = 1410 * MiB;
constexpr size_t WS_LA = 1442 * MiB;
constexpr size_t WS_OF = 1474 * MiB;
constexpr size_t WS_OB = 1506 * MiB;
constexpr size_t WS_TOK = 1538 * MiB;
constexpr size_t WS_XS = 1542 * MiB;
constexpr size_t WS_HID = 1814 * MiB;
constexpr size_t WS_YS = 2086 * MiB;
constexpr size_t WS_END = 2358 * MiB;
static_assert((size_t)MPAD * 2048 == 272 * MiB, "sorted buffers");
constexpr int CW_TMO = 0, CW_CODE = 1, CW_BAR = 4096, CW_CNT = 8192;

constexpr int RING_OFF = 0, RING_BYTES = 131072;
constexpr int LDSCTL_OFF = RING_BYTES;
constexpr int LDS_BYTES = 163840;
constexpr int LC_MISC = 0;
constexpr int LC_PSTART = 128;
constexpr int LC_ULIST = 384;
constexpr int LC_CNT = 640;
constexpr int LC_BASE = 768;
constexpr int LC_SELE = 1024;
constexpr int LC_SELS = 1024 + 2048;
constexpr int LC_COS64 = 5120;
constexpr int LC_ROWS = 6144;
constexpr int LC_LG = 16384;

constexpr int NWAVES = 8;
constexpr int N_PHASES = 1 + 10 * NL;

typedef float f32x2_t __attribute__((ext_vector_type(2))); typedef __bf16 bf16x2_t __attribute__((ext_vector_type(2)));
__device__ __forceinline__ unsigned cvtpk2(float lo, float hi) { f32x2_t v = {lo, hi}; bf16x2_t b = __builtin_convertvector(v, bf16x2_t); return __builtin_bit_cast(unsigned, b); }
#define pk2(lo, hi) cvtpk2((lo), (hi))
#define f2bf(x) (cvtpk2((x), 0.f) & 0xffffu)
__device__ __forceinline__ float bf2f(unsigned short b) { return __uint_as_float((unsigned)b << 16); }
__device__ __forceinline__ float wave_sum(float v) {
#pragma unroll
    for (int o = 1; o < 64; o <<= 1) v += __shfl_xor(v, o);
    return v;
}
typedef unsigned short u16x8 __attribute__((ext_vector_type(8)));
typedef unsigned short u16x4 __attribute__((ext_vector_type(4)));

typedef float f32x2v __attribute__((ext_vector_type(2)));
__device__ __forceinline__ void tr_task(const float* W, int K, int Nsrc, int srcn, bf16* WT, int dst_n, int k0) {
#pragma unroll 1
    for (int hf = 0; hf < 2; ++hf) { const int kk = k0 + hf * 64; f32x2v v[64];
        if (srcn >= 0) { const float* p = W + (size_t)kk * Nsrc + srcn;
#pragma unroll
            for (int i = 0; i < 64; ++i) v[i] = __builtin_nontemporal_load((const f32x2v*)(p + (size_t)i * Nsrc)); }
        else {
#pragma unroll
            for (int i = 0; i < 64; ++i) v[i] = (f32x2v){0.f, 0.f}; }
        bf16* o0 = WT + (size_t)dst_n * K + kk; bf16* o1 = o0 + K;
#pragma unroll
        for (int j = 0; j < 8; ++j) { v4u w0, w1;
            w0.x = pk2(v[8 * j].x, v[8 * j + 1].x); w0.y = pk2(v[8 * j + 2].x, v[8 * j + 3].x); w0.z = pk2(v[8 * j + 4].x, v[8 * j + 5].x); w0.w = pk2(v[8 * j + 6].x, v[8 * j + 7].x);
            w1.x = pk2(v[8 * j].y, v[8 * j + 1].y); w1.y = pk2(v[8 * j + 2].y, v[8 * j + 3].y); w1.z = pk2(v[8 * j + 4].y, v[8 * j + 5].y); w1.w = pk2(v[8 * j + 6].y, v[8 * j + 7].y);
            *(v4u*)(o0 + 8 * j) = w0; *(v4u*)(o1 + 8 * j) = w1; } }
}

__device__ __forceinline__ void ln_row(f32x4 (&v)[4], const float* g, const float* bt, float* of32, bf16* obf, int lane) {
    float s = 0.f;
#pragma unroll
    for (int j = 0; j < 4; ++j) s += (v[j].x + v[j].y) + (v[j].z + v[j].w);
    const float mean = wave_sum(s) * (1.f / DM); float s2 = 0.f;
#pragma unroll
    for (int j = 0; j < 4; ++j) { v[j] = v[j] - mean; s2 += (v[j].x * v[j].x + v[j].y * v[j].y) + (v[j].z * v[j].z + v[j].w * v[j].w); }
    const float rstd = 1.f / sqrtf(wave_sum(s2) * (1.f / DM) + LN_EPS);
#pragma unroll
    for (int j = 0; j < 4; ++j) { const f32x4 gg = *(const f32x4*)(g + lane * 4 + 256 * j), bb = *(const f32x4*)(bt + lane * 4 + 256 * j);
        v[j] = v[j] * rstd * gg + bb;
        if (of32) *(f32x4*)(of32 + lane * 4 + 256 * j) = v[j];
        if (obf) *(unsigned long long*)(obf + lane * 4 + 256 * j) = (unsigned long long)pk2(v[j].x, v[j].y) | ((unsigned long long)pk2(v[j].z, v[j].w) << 32); }
}


constexpr int GL_QF = 0, GL_KF = 2112, GL_QB = 4224, GL_KB = 6336, GL_BC = 8448, GL_V = 12672, GL_P = 16768, GL_HF = 20928, GL_HB = 22976, GL_END = 25024;
static_assert(GL_END * 4 <= RING_BYTES, "GLA chunk image fits the ring region");
__device__ __forceinline__ void gla_stage(LAS float* L, const bf16* PROJ, const float* LA, size_t tok0, int hd, int tid) {
    __syncthreads();
#pragma unroll
    for (int r = 0; r < 8; ++r) { const int idx = tid + 512 * r, dir = idx >> 11, j = (idx >> 5) & 63, d = idx & 31; L[GL_BC + dir * 2112 + j * 33 + d] = LA[(tok0 + j) * 256 + dir * 128 + hd * 32 + d]; }
    { const int j = tid >> 3, v0 = (tid & 7) * 8; const u16x8 f = *(const u16x8*)(PROJ + (tok0 + j) * INP + C_GV + hd * 64 + v0);
#pragma unroll
      for (int i = 0; i < 8; ++i) L[GL_V + j * 64 + v0 + i] = bf2f(f[i]); }
    const int qj = tid >> 3, qd = (tid & 7) * 4;
    const u16x4 q4 = *(const u16x4*)(PROJ + (tok0 + qj) * INP + C_GQ + hd * 32 + qd), k4 = *(const u16x4*)(PROJ + (tok0 + qj) * INP + C_GK + hd * 32 + qd);
    __syncthreads();
    { const int lane_ = tid & 63, w_ = tid >> 6;
#pragma unroll
      for (int cc = 0; cc < 8; ++cc) { const int col = w_ * 8 + cc, dir = col >> 5, d = col & 31; LAS float* p = L + GL_BC + dir * 2112 + lane_ * 33 + d; float x = *p;
          if (dir == 0) {
#pragma unroll
              for (int o = 1; o < 64; o <<= 1) { const float y = __shfl_up(x, o); if (lane_ >= o) x += y; } }
          else {
#pragma unroll
              for (int o = 1; o < 64; o <<= 1) { const float y = __shfl_down(x, o); if (lane_ + o < 64) x += y; } }
          *p = x; } }
    __syncthreads();
#pragma unroll
    for (int i = 0; i < 4; ++i) { const float bf_ = L[GL_BC + qj * 33 + qd + i], bb_ = L[GL_BC + 2112 + qj * 33 + qd + i]; const float qv = bf2f(q4[i]) * GLA_QSCALE, kv = bf2f(k4[i]);
        L[GL_QF + qj * 33 + qd + i] = qv * expf(bf_); L[GL_KF + qj * 33 + qd + i] = kv * expf(-bf_); L[GL_QB + qj * 33 + qd + i] = qv * expf(bb_); L[GL_KB + qj * 33 + qd + i] = kv * expf(-bb_); }
    __syncthreads();
}


typedef float f32x16 __attribute__((ext_vector_type(16)));
typedef short s16x4 __attribute__((ext_vector_type(4)));
__device__ __forceinline__ bf16x8 pack_step(const f32x16& x, int s) { v4u p; p.x = cvtpk2(x[8 * s], x[8 * s + 1]); p.y = cvtpk2(x[8 * s + 2], x[8 * s + 3]); p.z = cvtpk2(x[8 * s + 4], x[8 * s + 5]); p.w = cvtpk2(x[8 * s + 6], x[8 * s + 7]); return __builtin_bit_cast(bf16x8, p); }
__device__ __forceinline__ int crow16(int i, int h) { return (i & 3) + 8 * (i >> 2) + 4 * h; }
#define MFMA32(a, b, c) __builtin_amdgcn_mfma_f32_32x32x16_bf16((a), (b), (c), 0, 0, 0)
constexpr int FT_PITCH = 72, FT_TAB = 64 * FT_PITCH;
constexpr int FFT_LDS_TAB = 0, FFT_LDS_TW = 28672, FFT_LDS_HT = 28672, FFT_HT_PAIR = 2 * 64 * FT_PITCH * 2;

struct Args { const float* in[20]; float* out; unsigned char* ws; int ph_lo, ph_hi; };
static_assert(sizeof(Args) == 20 * 8 + 8 + 8 + 8, "no padding bytes in Args");


typedef __attribute__((address_space(4))) const unsigned char* kptr_t;
__device__ __forceinline__ kptr_t karg() { kptr_t p = (kptr_t)__builtin_amdgcn_kernarg_segment_ptr(); asm volatile("" : "+s"(p)); return p; }
#define KIN(i) (*(const float* const __attribute__((address_space(4)))*)(karg() + 8 * (i)))
#define KOUT() (*(float* const __attribute__((address_space(4)))*)(karg() + 160))
#define KWS() (*(unsigned char* const __attribute__((address_space(4)))*)(karg() + 168))
#define WSP(T, off) ((T*)(ws + (off)))

#ifndef NAIVE_ATTN
#define NAIVE_ATTN 0
#endif

__global__ void __launch_bounds__(NWAVES * 64, 2) fwd(Args args) {
    extern __shared__ __attribute__((aligned(16))) unsigned char lds_raw[];
    LAS unsigned char* lds = (LAS unsigned char*)lds_raw;
    LAS unsigned char* lctl = lds + LDSCTL_OFF;
    const int G = gridDim.x, bx = blockIdx.x;
    const int NGW = G * NWAVES, NGT = G * NWAVES * 64;
#define TID_SETUP() int tid_ = threadIdx.x; asm volatile("" : "+v"(tid_)); const int tid = tid_, lane = tid & 63, wave = __builtin_amdgcn_readfirstlane(tid >> 6); \
    const int gw = bx * NWAVES + wave, gt = bx * (NWAVES * 64) + tid; (void)lane; (void)gw; (void)gt
    for (int u = threadIdx.x; u < (LDS_BYTES - LDSCTL_OFF) / 4; u += NWAVES * 64) ((LAS unsigned*)lctl)[u] = 0u;
    __syncthreads();
    volatile LAS unsigned* MISC = (volatile LAS unsigned*)(lctl + LC_MISC);
    XcdBarrier bar = xcd_barrier_post((unsigned*)(KWS() + WS_CTL) + CW_BAR, MISC + 8);
    const int lo = args.ph_lo, hi = args.ph_hi;
#ifndef PH_OFF
#define PH_OFF 0
#endif
#define PON(j) (!((PH_OFF >> (j)) & 1))
#define IN(k) (lo <= (k) && (k) < hi)
#ifndef PROBE_A
#define PROBE_A -1
#endif
#ifndef PROBE_B
#define PROBE_B -1
#endif
#if PROBE_A >= 0
#define STAMP(k) do { if (blockIdx.x == 0 && threadIdx.x == 0) { ((unsigned long long*)(KWS() + WS_CTL + 65536))[(k)] = __builtin_amdgcn_s_memrealtime(); } } while (0)
#else
#define STAMP(k) do {} while (0)
#endif
#define SEAM(k) do { if (IN(k) && IN((k) + 1)) xcd_barrier(bar); STAMP((k) + 1); } while (0)
    STAMP(0);

    if (IN(0) && PON(0)) {
        TID_SETUP(); unsigned char* ws = KWS(); const float* x_in = KIN(0); const float* ln_in_g = KIN(1); const float* ln_in_b = KIN(2); const float* w_in = KIN(3); const float* w_out = KIN(9);
        const float* exp_w_gu = KIN(14); const float* exp_w_down = KIN(16);
        float* ROPE = WSP(float, WS_ROPE); bf16* WIN_T = WSP(bf16, WS_WIN_T); bf16* WOUT_T = WSP(bf16, WS_WOUT_T); bf16* WGU_T = WSP(bf16, WS_WGU_T); bf16* WDN_T = WSP(bf16, WS_WDN_T);
        float* HF = WSP(float, WS_HF); bf16* HB = WSP(bf16, WS_HB);
        constexpr int I_WIN = NL * 16 * 8, I_WOUT = NL * 8 * 8, I_WGU = NL * NE * 16 * 8, I_WDN = NL * NE * 8 * 8;
        constexpr int NTASK = I_WIN + I_WOUT + I_WGU + I_WDN;
        { const int t_lo = (int)(((long)gw * NTASK) / NGW), t_hi = (int)(((long)(gw + 1) * NTASK) / NGW);
          for (int it = t_lo; it < t_hi; ++it) {
            int r = it;
            if (r < I_WIN) { const int l = r / 128, q = r % 128, nb = q / 8, k8 = q % 8, n = nb * 128 + 2 * lane;
                const int src = n < 1536 ? n : (n < 1792 ? n + 32 : (n < 1824 ? n - 256 : -1));
                tr_task(w_in + (size_t)l * DM * INW, DM, INW, src, WIN_T + (size_t)l * INP * DM, n, k8 * 128); continue; }
            r -= I_WIN;
            if (r < I_WOUT) { const int l = r / 64, q = r % 64, nb = q / 8, k8 = q % 8, n = nb * 128 + 2 * lane;
                tr_task(w_out + (size_t)l * DM * DM, DM, DM, n, WOUT_T + (size_t)l * DM * DM, n, k8 * 128); continue; }
            r -= I_WOUT;
            if (r < I_WGU) { const int le = r / 128, q = r % 128, nb = q / 8, k8 = q % 8, n = nb * 128 + 2 * lane;
                const int pn = n >> 8, bj = (n >> 7) & 1, j = n & 127, src = bj * 1024 + pn * 128 + j;
                tr_task(exp_w_gu + (size_t)le * DM * 2048, DM, 2048, src, WGU_T + (size_t)le * 2048 * DM, n, k8 * 128); continue; }
            r -= I_WGU;
            { const int le = r / 64, q = r % 64, nb = q / 8, k8 = q % 8, n = nb * 128 + 2 * lane;
                tr_task(exp_w_down + (size_t)le * DE * DM, DE, DM, n, WDN_T + (size_t)le * DM * DE, n, k8 * 128); }
          } }
        { bf16* FTAB = WSP(bf16, WS_FTAB); float* TW = WSP(float, WS_TW);
          for (int it = gt; it < 3 * FT_TAB; it += NGT) { const int t = it / FT_TAB, q = it % FT_TAB, row = q / FT_PITCH, col = q % FT_PITCH; float sn, cs; sincospif((float)((row * col) & 63) * (1.0f / 32.0f), &sn, &cs);
              const float v = col >= 64 ? 0.f : (t == 0 ? cs : (t == 1 ? sn : -sn)); FTAB[it] = (bf16)f2bf(v); }
          for (int it = gt; it < 4096; it += NGT) { float sn, cs; sincospif((float)it * (1.0f / 2048.0f), &sn, &cs); TW[2 * it] = cs; TW[2 * it + 1] = -sn; } }
        for (int it = gt; it < SEQ * 32; it += NGT) { const int t = it >> 5, i = it & 31, a = i >> 4, f = i & 15; const int pos = a ? (t & 63) : (t >> 6);
            const double inv = exp(-9.210340371976184 * (double)f / 16.0); const double ang = (double)pos * inv;
            ROPE[it] = (float)cos(ang); ROPE[SEQ * 32 + it] = (float)sin(ang); }
        for (int m = gw; m < NTOK; m += NGW) { f32x4 v[4];
#pragma unroll
            for (int j = 0; j < 4; ++j) v[j] = *(const f32x4*)(x_in + (size_t)m * DM + lane * 4 + 256 * j);
            ln_row(v, ln_in_g, ln_in_b, HF + (size_t)m * DM, HB + (size_t)m * DM, lane); }
    }
    SEAM(0);

    for (int l = 0; l < NL; ++l) {
        const int pb = 1 + 10 * l;
        if (IN(pb + 0) && PON(1)) {
            TID_SETUP(); unsigned char* ws = KWS(); bf16* HB = WSP(bf16, WS_HB); bf16* WIN_T = WSP(bf16, WS_WIN_T); bf16* PROJ = WSP(bf16, WS_PROJ);
            pg8::Gemm g{HB, WIN_T + (size_t)l * INP * DM, NTOK, INP, DM}; pg8::StaticOrder S; S.init(NTOK, INP, G, bx);
            pg8::EpiPlainBf16 E{PROJ, INP};
            pg8::gemm_phase<pg8::EpiPlainBf16, pg8::StaticOrder, true, true>(lds + RING_OFF, g, S, E);
        }
        SEAM(pb + 0);
        if (IN(pb + 1) && PON(2)) {
            TID_SETUP(); unsigned char* ws = KWS(); const float* att_q_gain = KIN(4); const float* att_k_gain = KIN(5); const float* gla_gate_w = KIN(6); const float* gla_gate_b = KIN(7);
            const float* ROPE = WSP(float, WS_ROPE); const bf16* PROJ = WSP(bf16, WS_PROJ); bf16* QB = WSP(bf16, WS_QB); bf16* KB = WSP(bf16, WS_KB); float* LA = WSP(float, WS_LA);
            const float* qg = att_q_gain + l * 64; const float* kg = att_k_gain + l * 64;
            for (int m = gw; m < NTOK; m += NGW) { const int t = m & (SEQ - 1); const int ri = (lane >> 5) * 16 + (lane & 15);
                const float cs = ROPE[t * 32 + ri], sn = ROPE[SEQ * 32 + t * 32 + ri]; const float sg = ((lane >> 4) & 1) ? 1.f : -1.f;
#pragma unroll
                for (int h = 0; h < 10; ++h) { const float xv = bf2f(PROJ[(size_t)m * INP + h * 64 + lane]);
                    const float ms = wave_sum(xv * xv) * (1.f / 64.f); const float xn = xv * (1.f / sqrtf(ms + RMS_EPS)) * (h < 8 ? qg[lane] : kg[lane]);
                    const float pr = __shfl_xor(xn, 16); float o = xn * cs + sg * pr * sn;
                    if (h < 8) { o *= QSCALE; QB[(size_t)m * 512 + h * 64 + lane] = (bf16)f2bf(o); } else KB[(size_t)m * 128 + (h - 8) * 64 + lane] = (bf16)f2bf(o); } }
            { const float* gw_l = gla_gate_w + (size_t)l * 2 * 16 * 128; const float* gb_l = gla_gate_b + (size_t)l * 2 * 128;
              for (int m = gw; m < NTOK; m += NGW) { const float lr = (lane < 32) ? bf2f(PROJ[(size_t)m * INP + C_GLR + lane]) : 0.f;
                const int dir = lane >> 5, kc = (lane & 31) * 4; f32x4 z = *(const f32x4*)(gb_l + dir * 128 + kc);
#pragma unroll
                for (int r = 0; r < 16; ++r) { const float a = __shfl(lr, dir * 16 + r); const f32x4 w = *(const f32x4*)(gw_l + (size_t)(dir * 16 + r) * 128 + kc); z = z + w * a; }
                f32x4 o;
#pragma unroll
                for (int i = 0; i < 4; ++i) o[i] = (fminf(z[i], 0.f) - log1pf(expf(-fabsf(z[i])))) * (1.f / 16.f);
                *(f32x4*)(LA + (size_t)m * 256 + dir * 128 + kc) = o; } }
            { __syncthreads();
              { const v4u* src = (const v4u*)WSP(bf16, WS_FTAB); LAS v4u* dst = (LAS v4u*)(lds + RING_OFF + FFT_LDS_TAB); for (int i = tid; i < 3 * FT_TAB * 2 / 16; i += NWAVES * 64) dst[i] = src[i];
                const v4u* s2_ = (const v4u*)WSP(float, WS_TW); LAS v4u* d2_ = (LAS v4u*)(lds + RING_OFF + FFT_LDS_TW); for (int i = tid; i < 4096 * 8 / 16; i += NWAVES * 64) d2_[i] = s2_[i]; }
              __syncthreads();
              const LAS bf16* FT = (const LAS bf16*)(lds + RING_OFF + FFT_LDS_TAB); const LAS float* TWL = (const LAS float*)(lds + RING_OFF + FFT_LDS_TW); bf16* FTMP = WSP(bf16, WS_FTMP);
              const int pair = wave >> 1, cb = wave & 1, r = lane & 31, h = lane >> 5;
              for (int ub = bx; ub < NB * 4 * 64 / 4; ub += G) { const int u = ub * 4 + pair, s2 = u & 63, g4 = (u >> 6) & 3, b = u >> 8;
                bf16x8 xa[2][4];
#pragma unroll
                for (int R = 0; R < 2; ++R)
#pragma unroll
                    for (int ks = 0; ks < 4; ++ks) xa[R][ks] = *(const bf16x8*)(PROJ + ((size_t)b * SEQ + 64 * (32 * R + r) + s2) * INP + C_FX + g4 * 64 + 16 * ks + 8 * h);
                f32x16 Tr[2], Ti[2];
#pragma unroll
                for (int R = 0; R < 2; ++R)
#pragma unroll
                    for (int i = 0; i < 16; ++i) { Tr[R][i] = 0.f; Ti[R][i] = 0.f; }
#pragma unroll
                for (int ks = 0; ks < 4; ++ks) { const bf16x8 bc = *(const LAS bf16x8*)(FT + (32 * cb + r) * FT_PITCH + 16 * ks + 8 * h), bs = *(const LAS bf16x8*)(FT + 2 * FT_TAB + (32 * cb + r) * FT_PITCH + 16 * ks + 8 * h);
#pragma unroll
                    for (int R = 0; R < 2; ++R) { Tr[R] = MFMA32(xa[R][ks], bc, Tr[R]); Ti[R] = MFMA32(xa[R][ks], bs, Ti[R]); } }
#pragma unroll
                for (int Rp = 0; Rp < 2; ++Rp) { f32x16 Gr, Gi;
#pragma unroll
                    for (int i = 0; i < 16; ++i) { Gr[i] = 0.f; Gi[i] = 0.f; }
#pragma unroll
                    for (int R = 0; R < 2; ++R)
#pragma unroll
                        for (int s_ = 0; s_ < 2; ++s_) { const bf16x8 xr = pack_step(Tr[R], s_), xi = pack_step(Ti[R], s_);
                            const int kb = 32 * R + 16 * s_ + 4 * h, ro = (32 * Rp + r) * FT_PITCH + kb;
                            const s16x4 c0 = *(const LAS s16x4*)(FT + ro), c1 = *(const LAS s16x4*)(FT + ro + 8), s0 = *(const LAS s16x4*)(FT + FT_TAB + ro), s1 = *(const LAS s16x4*)(FT + FT_TAB + ro + 8),
                                        n0 = *(const LAS s16x4*)(FT + 2 * FT_TAB + ro), n1 = *(const LAS s16x4*)(FT + 2 * FT_TAB + ro + 8);
                            const bf16x8 ca = __builtin_shufflevector(c0, c1, 0, 1, 2, 3, 4, 5, 6, 7), sa = __builtin_shufflevector(s0, s1, 0, 1, 2, 3, 4, 5, 6, 7), na = __builtin_shufflevector(n0, n1, 0, 1, 2, 3, 4, 5, 6, 7);
                            Gr = MFMA32(ca, xr, Gr); Gr = MFMA32(sa, xi, Gr); Gi = MFMA32(ca, xi, Gi); Gi = MFMA32(na, xr, Gi); }
#pragma unroll
                    for (int i = 0; i < 16; ++i) { const int s1p = 32 * Rp + crow16(i, h); const int m = (s2 * s1p) & 4095; const float wr = TWL[2 * m], wi = TWL[2 * m + 1];
                        const size_t o = ((((size_t)(b * 4 + g4) * 64 + s1p) * 2) * 64 + s2) * 64 + 32 * cb + r;
                        FTMP[o] = (bf16)f2bf(Gr[i] * wr - Gi[i] * wi); FTMP[o + 4096] = (bf16)f2bf(Gr[i] * wi + Gi[i] * wr); } }
              }
              __syncthreads(); }
            { LAS float* L = (LAS float*)(lds + RING_OFF); float* GS = WSP(float, WS_OF); float* GD = WSP(float, WS_OB);
              for (int u = bx; u < NB * 4 * 64; u += G) { const int c = u & 63, bh = u >> 6, hd = bh & 3, b = bh >> 2; const size_t tok0 = (size_t)b * SEQ + c * 64;
                gla_stage(L, PROJ, LA, tok0, hd, tid);
                const int dir = tid >> 8, d0 = ((tid >> 4) & 15) * 2, v0 = (tid & 15) * 4; const LAS float* Kd = L + (dir ? GL_KB : GL_KF);
                f32x4 a0 = {0.f, 0.f, 0.f, 0.f}, a1 = {0.f, 0.f, 0.f, 0.f};
#pragma unroll 8
                for (int j = 0; j < 64; ++j) { const float k0 = Kd[j * 33 + d0], k1 = Kd[j * 33 + d0 + 1]; const f32x4 vv = *(const LAS f32x4*)(L + GL_V + j * 64 + v0); a0 = a0 + vv * k0; a1 = a1 + vv * k1; }
                const int jl = dir ? 0 : 63; const float D0 = expf(L[GL_BC + dir * 2112 + jl * 33 + d0]), D1 = expf(L[GL_BC + dir * 2112 + jl * 33 + d0 + 1]);
                const size_t sidx = ((size_t)u * 2 + dir);
                *(f32x4*)(GS + sidx * 2048 + d0 * 64 + v0) = a0 * D0; *(f32x4*)(GS + sidx * 2048 + (d0 + 1) * 64 + v0) = a1 * D1;
                if ((tid & 15) == 0) { GD[sidx * 32 + d0] = D0; GD[sidx * 32 + d0 + 1] = D1; } }
              __syncthreads(); }
        }
        SEAM(pb + 1);
        if (IN(pb + 2) && PON(3)) {
            TID_SETUP(); unsigned char* ws = KWS(); float* GS = WSP(float, WS_OF); const float* GD = WSP(float, WS_OB);
            for (int e = gt; e < NB * 4 * 2 * 2048; e += NGT) { const int dv = e & 2047, dir = (e >> 11) & 1, bh = e >> 12, d = dv >> 6; float H = 0.f;
                for (int c8 = 0; c8 < 64; c8 += 8) { float sv[8], dd[8];
#pragma unroll
                    for (int i = 0; i < 8; ++i) { const int c = dir ? 63 - (c8 + i) : (c8 + i); const size_t sidx = ((size_t)(bh * 64 + c) * 2 + dir); sv[i] = GS[sidx * 2048 + dv]; dd[i] = GD[sidx * 32 + d]; }
#pragma unroll
                    for (int i = 0; i < 8; ++i) { const int c = dir ? 63 - (c8 + i) : (c8 + i); const size_t sidx = ((size_t)(bh * 64 + c) * 2 + dir); GS[sidx * 2048 + dv] = H; H = H * dd[i] + sv[i]; } } }
        }
        SEAM(pb + 2);
        if (IN(pb + 3) && PON(4)) {
            TID_SETUP(); unsigned char* ws = KWS(); const float* gla_norm_g = KIN(8); const bf16* PROJ = WSP(bf16, WS_PROJ);
            bf16* MIX = WSP(bf16, WS_MIX); const bf16* QB = WSP(bf16, WS_QB); const bf16* KB = WSP(bf16, WS_KB);
            { __syncthreads();
              { const v4u* src = (const v4u*)WSP(bf16, WS_FTAB); LAS v4u* dst = (LAS v4u*)(lds + RING_OFF + FFT_LDS_TAB); for (int i = tid; i < 3 * FT_TAB * 2 / 16; i += NWAVES * 64) dst[i] = src[i]; }
              const LAS bf16* FT = (const LAS bf16*)(lds + RING_OFF + FFT_LDS_TAB); const bf16* FTMP = WSP(bf16, WS_FTMP);
              const int pair = wave >> 1, cb = wave & 1, r = lane & 31, h = lane >> 5;
              LAS bf16* HT = (LAS bf16*)(lds + RING_OFF + FFT_LDS_HT + pair * FFT_HT_PAIR);
              for (int ub = bx; ub < NB * 4 * 64 / 4; ub += G) { const int u = ub * 4 + pair, s1p = u & 63, g4 = (u >> 6) & 3, b = u >> 8;
                const bf16* src = FTMP + (size_t)u * 2 * 4096;
                __syncthreads();
#pragma unroll
                for (int q = 0; q < 8; ++q) { const int p = cb * 64 + lane + 128 * q, ri = p >> 9, s2 = (p >> 3) & 63, c0 = (p & 7) * 8; const u16x8 v = *(const u16x8*)(src + p * 8);
#pragma unroll
                    for (int i = 0; i < 8; ++i) HT[(ri * 64 + c0 + i) * FT_PITCH + s2] = v[i]; }
                __syncthreads();
#pragma unroll
                for (int Rp = 0; Rp < 2; ++Rp) { f32x16 acc;
#pragma unroll
                    for (int i = 0; i < 16; ++i) acc[i] = 0.f;
#pragma unroll
                    for (int ks = 0; ks < 4; ++ks) { const int ko = 16 * ks + 8 * h;
                        const bf16x8 ca = *(const LAS bf16x8*)(FT + (32 * Rp + r) * FT_PITCH + ko), sa = *(const LAS bf16x8*)(FT + FT_TAB + (32 * Rp + r) * FT_PITCH + ko);
                        const bf16x8 hr = *(const LAS bf16x8*)(HT + (32 * cb + r) * FT_PITCH + ko), hi_ = *(const LAS bf16x8*)(HT + (64 + 32 * cb + r) * FT_PITCH + ko);
                        acc = MFMA32(ca, hr, acc); acc = MFMA32(sa, hi_, acc); }
#pragma unroll
                    for (int i = 0; i < 16; ++i) { const int s2p = 32 * Rp + crow16(i, h); MIX[((size_t)b * SEQ + s1p + 64 * s2p) * DM + 768 + g4 * 64 + 32 * cb + r] = (bf16)f2bf(acc[i] * (1.0f / 512.0f)); } }
              }
              __syncthreads(); }
            { LAS float* L = (LAS float*)(lds + RING_OFF); const float* GS = WSP(float, WS_OF); const float* LA = WSP(float, WS_LA);
              for (int u = bx; u < NB * 4 * 64; u += G) { const int c = u & 63, bh = u >> 6, hd = bh & 3, b = bh >> 2; const size_t tok0 = (size_t)b * SEQ + c * 64;
                gla_stage(L, PROJ, LA, tok0, hd, tid);
                { const f32x4* src = (const f32x4*)(GS + (size_t)u * 2 * 2048) + tid * 2; LAS f32x4* dst = (LAS f32x4*)(L + GL_HF) + tid * 2; dst[0] = src[0]; dst[1] = src[1]; }
                const int i0 = (tid >> 4) * 2, j0 = (tid & 15) * 4;
                { float pf[2][4], pb[2][4];
#pragma unroll
                  for (int a_ = 0; a_ < 2; ++a_)
#pragma unroll
                      for (int c_ = 0; c_ < 4; ++c_) { pf[a_][c_] = 0.f; pb[a_][c_] = 0.f; }
#pragma unroll 4
                  for (int d = 0; d < 32; ++d) { const float qf0 = L[GL_QF + i0 * 33 + d], qf1 = L[GL_QF + (i0 + 1) * 33 + d], qb0 = L[GL_QB + i0 * 33 + d], qb1 = L[GL_QB + (i0 + 1) * 33 + d];
#pragma unroll
                      for (int c_ = 0; c_ < 4; ++c_) { const float kf = L[GL_KF + (j0 + c_) * 33 + d], kb = L[GL_KB + (j0 + c_) * 33 + d]; pf[0][c_] += qf0 * kf; pf[1][c_] += qf1 * kf; pb[0][c_] += qb0 * kb; pb[1][c_] += qb1 * kb; } }
#pragma unroll
                  for (int a_ = 0; a_ < 2; ++a_)
#pragma unroll
                      for (int c_ = 0; c_ < 4; ++c_) L[GL_P + (i0 + a_) * 65 + j0 + c_] = (j0 + c_ <= i0 + a_) ? pf[a_][c_] : pb[a_][c_]; }
                __syncthreads();
                f32x4 o0 = {0.f, 0.f, 0.f, 0.f}, o1 = {0.f, 0.f, 0.f, 0.f}; const int v0 = j0;
#pragma unroll 8
                for (int j = 0; j < 64; ++j) { const float p0 = L[GL_P + i0 * 65 + j], p1 = L[GL_P + (i0 + 1) * 65 + j]; const f32x4 vv = *(const LAS f32x4*)(L + GL_V + j * 64 + v0); o0 = o0 + vv * p0; o1 = o1 + vv * p1; }
#pragma unroll 8
                for (int d = 0; d < 32; ++d) { const f32x4 hf = *(const LAS f32x4*)(L + GL_HF + d * 64 + v0), hb = *(const LAS f32x4*)(L + GL_HB + d * 64 + v0);
                    o0 = o0 + hf * L[GL_QF + i0 * 33 + d] + hb * L[GL_QB + i0 * 33 + d]; o1 = o1 + hf * L[GL_QF + (i0 + 1) * 33 + d] + hb * L[GL_QB + (i0 + 1) * 33 + d]; }
                float s0 = (o0.x * o0.x + o0.y * o0.y) + (o0.z * o0.z + o0.w * o0.w), s1 = (o1.x * o1.x + o1.y * o1.y) + (o1.z * o1.z + o1.w * o1.w);
#pragma unroll
                for (int m_ = 1; m_ < 16; m_ <<= 1) { s0 += __shfl_xor(s0, m_); s1 += __shfl_xor(s1, m_); }
                const f32x4 gn = *(const f32x4*)(gla_norm_g + l * 64 + v0);
#pragma unroll
                for (int a_ = 0; a_ < 2; ++a_) { const f32x4 ov = a_ ? o1 : o0; const float rs = 1.f / sqrtf((a_ ? s1 : s0) * (1.f / 64.f) + RMS_EPS); const size_t m = tok0 + i0 + a_;
                    const u16x4 r4 = *(const u16x4*)(PROJ + m * INP + C_GR + hd * 64 + v0); float y[4];
#pragma unroll
                    for (int i = 0; i < 4; ++i) { const float r = bf2f(r4[i]); y[i] = ov[i] * rs * gn[i] * (r / (1.f + expf(-r))); }
                    *(unsigned long long*)(MIX + m * DM + 512 + hd * 64 + v0) = (unsigned long long)pk2(y[0], y[1]) | ((unsigned long long)pk2(y[2], y[3]) << 32); } }
              __syncthreads(); }
#if NAIVE_ATTN
            { LAS float* Kt = (LAS float*)(lds + RING_OFF); LAS float* Vt = Kt + 64 * 64;
              for (int unit = bx; unit < NB * 8 * 8; unit += G) { const int rb = unit & 7, h = (unit >> 3) & 7, b = unit >> 6, kvh = h >> 2;
                const size_t qrow = (size_t)b * SEQ + rb * 512 + tid;
                float q[64], o[64]; float mrun = -INFINITY, lrun = 0.f;
#pragma unroll
                for (int c8 = 0; c8 < 8; ++c8) { const u16x8 f = *(const u16x8*)(QB + qrow * 512 + h * 64 + c8 * 8);
#pragma unroll
                    for (int i = 0; i < 8; ++i) { q[c8 * 8 + i] = bf2f(f[i]); o[c8 * 8 + i] = 0.f; } }
                for (int kt = 0; kt < SEQ; kt += 64) {
                    __syncthreads();
                    { const int kr = tid >> 3, c8 = (tid & 7) * 8; const size_t krow = (size_t)b * SEQ + kt + kr;
                      const u16x8 kf = *(const u16x8*)(KB + krow * 128 + kvh * 64 + c8); const u16x8 vf = *(const u16x8*)(PROJ + krow * INP + C_AV + kvh * 64 + c8);
#pragma unroll
                      for (int i = 0; i < 8; ++i) { Kt[kr * 64 + c8 + i] = bf2f(kf[i]); Vt[kr * 64 + c8 + i] = bf2f(vf[i]); } }
                    __syncthreads();
#pragma unroll 1
                    for (int j = 0; j < 64; ++j) { float a = 0.f;
#pragma unroll
                        for (int d4 = 0; d4 < 16; ++d4) { const f32x4 kv = *(const LAS f32x4*)(Kt + j * 64 + d4 * 4); a += (q[d4 * 4] * kv.x + q[d4 * 4 + 1] * kv.y) + (q[d4 * 4 + 2] * kv.z + q[d4 * 4 + 3] * kv.w); }
                        if (a > mrun) { const float al = exp2f(mrun - a); mrun = a; lrun *= al;
#pragma unroll
                            for (int d = 0; d < 64; ++d) o[d] *= al; }
                        const float p = exp2f(a - mrun); lrun += p;
#pragma unroll
                        for (int d4 = 0; d4 < 16; ++d4) { const f32x4 vv = *(const LAS f32x4*)(Vt + j * 64 + d4 * 4); o[d4 * 4] += p * vv.x; o[d4 * 4 + 1] += p * vv.y; o[d4 * 4 + 2] += p * vv.z; o[d4 * 4 + 3] += p * vv.w; } }
                }
                const float rl = 1.f / lrun;
#pragma unroll
                for (int c8 = 0; c8 < 8; ++c8) { v4u w; w.x = pk2(o[c8 * 8] * rl, o[c8 * 8 + 1] * rl); w.y = pk2(o[c8 * 8 + 2] * rl, o[c8 * 8 + 3] * rl); w.z = pk2(o[c8 * 8 + 4] * rl, o[c8 * 8 + 5] * rl); w.w = pk2(o[c8 * 8 + 6] * rl, o[c8 * 8 + 7] * rl);
                    *(v4u*)(MIX + qrow * DM + h * 64 + c8 * 8) = w; }
              }
              __syncthreads(); }
#else
            { const attn_body::AttnTensors AT{(const attn_body::bf16*)QB, (const attn_body::bf16*)KB, (const attn_body::bf16*)(PROJ + C_AV), (attn_body::bf16*)MIX};
              const attn_body::StaticOrder S(G, bx);
              attn_body::attn_phase<attn_body::StaticOrder>((char*)lds_raw + RING_OFF, AT, S); }
#endif
        }
        SEAM(pb + 3);
        if (IN(pb + 4) && PON(5)) {
            TID_SETUP(); unsigned char* ws = KWS(); const bf16* MIX = WSP(bf16, WS_MIX); const bf16* WOUT_T = WSP(bf16, WS_WOUT_T); const float* HF = WSP(float, WS_HF); float* T1 = WSP(float, WS_T1);
            pg8::Gemm g{MIX, WOUT_T + (size_t)l * DM * DM, NTOK, DM, DM}; pg8::StaticOrder S; S.init(NTOK, DM, G, bx);
            pg8::EpiResF32 E{HF, T1, DM, DN_ALPHA};
            pg8::gemm_phase<pg8::EpiResF32, pg8::StaticOrder, true, true>(lds + RING_OFF, g, S, E);
        }
        SEAM(pb + 4);
        if (IN(pb + 5) && PON(6)) {
            TID_SETUP(); unsigned char* ws = KWS(); gu32* ctl = (gu32*)(ws + WS_CTL); const float* ln1_g = KIN(10); const float* ln1_b = KIN(11); const float* router_w = KIN(12); const float* router_b = KIN(13);
            const float* T1 = WSP(float, WS_T1); float* HF = WSP(float, WS_HF); bf16* HB = WSP(bf16, WS_HB); int* TOKE = WSP(int, WS_TOK); int* TOKS = TOKE + NTOK * 4; float* TOKW = (float*)(TOKS + NTOK * 4); int* LIST = WSP(int, WS_XS);
            LAS float* RW = (LAS float*)(lds + RING_OFF);
            { const float* rw = router_w + (size_t)l * DM * NE; for (int i = tid; i < DM * NE; i += NWAVES * 64) { const int c = i >> 5, e = i & 31; RW[e * DM + c] = rw[i]; } }
            LAS int* lcnt = (LAS int*)(lctl + LC_CNT); LAS int* lbase = (LAS int*)(lctl + LC_BASE); LAS int* sele = (LAS int*)(lctl + LC_SELE); LAS int* sels = (LAS int*)(lctl + LC_SELS);
            const float* rb = router_b + l * NE;
            for (int r0 = bx * 128; r0 < NTOK; r0 += G * 128) {
                if (tid < 32) lcnt[tid] = 0;
                __syncthreads();
                LAS float* LG = (LAS float*)(lctl + LC_LG) + wave * 512;
                f32x4 gam[4], bet[4];
#pragma unroll
                for (int j = 0; j < 4; ++j) { gam[j] = *(const f32x4*)(ln1_g + l * DM + lane * 4 + 256 * j); bet[j] = *(const f32x4*)(ln1_b + l * DM + lane * 4 + 256 * j); }
                for (int rr = 0; rr < 16; rr += 2) { const int lr = wave * 16 + rr; const size_t m = (size_t)r0 + lr; f32x4 v[2][4];
#pragma unroll
                    for (int q = 0; q < 2; ++q)
#pragma unroll
                        for (int j = 0; j < 4; ++j) v[q][j] = *(const f32x4*)(T1 + (m + q) * DM + lane * 4 + 256 * j);
#pragma unroll
                    for (int q = 0; q < 2; ++q) { float s_ = 0.f;
#pragma unroll
                        for (int j = 0; j < 4; ++j) s_ += (v[q][j].x + v[q][j].y) + (v[q][j].z + v[q][j].w);
                        const float mean = wave_sum(s_) * (1.f / DM); float s2_ = 0.f;
#pragma unroll
                        for (int j = 0; j < 4; ++j) { v[q][j] = v[q][j] - mean; s2_ += (v[q][j].x * v[q][j].x + v[q][j].y * v[q][j].y) + (v[q][j].z * v[q][j].z + v[q][j].w * v[q][j].w); }
                        const float rstd = 1.f / sqrtf(wave_sum(s2_) * (1.f / DM) + LN_EPS);
#pragma unroll
                        for (int j = 0; j < 4; ++j) { v[q][j] = v[q][j] * rstd * gam[j] + bet[j];
                            *(f32x4*)(HF + (m + q) * DM + lane * 4 + 256 * j) = v[q][j];
                            *(unsigned long long*)(HB + (m + q) * DM + lane * 4 + 256 * j) = (unsigned long long)pk2(v[q][j].x, v[q][j].y) | ((unsigned long long)pk2(v[q][j].z, v[q][j].w) << 32); } }
                    float a0[32], a1[32];
#pragma unroll
                    for (int e = 0; e < 32; ++e) { f32x2_t s0 = {0.f, 0.f}, s1 = {0.f, 0.f};
#pragma unroll
                        for (int j = 0; j < 4; ++j) { const f32x4 w = *(const LAS f32x4*)(RW + e * DM + lane * 4 + 256 * j); const f32x2_t wl = {w.x, w.y}, wh = {w.z, w.w};
                            s0 += (f32x2_t){v[0][j].x, v[0][j].y} * wl; s0 += (f32x2_t){v[0][j].z, v[0][j].w} * wh; s1 += (f32x2_t){v[1][j].x, v[1][j].y} * wl; s1 += (f32x2_t){v[1][j].z, v[1][j].w} * wh; }
                        a0[e] = s0.x + s0.y; a1[e] = s1.x + s1.y; }
#define TRSTEP(SRC, DST, N, MASK) _Pragma("unroll") for (int e = 0; e < (N); ++e) { const bool hi_ = (lane & (MASK)) != 0; const float keep = hi_ ? SRC[e + (N)] : SRC[e], send = hi_ ? SRC[e] : SRC[e + (N)]; DST[e] = keep + __shfl_xor(send, (MASK)); }
                    float t0, t1;
                    { float b_[16], c_[8], d_[4], e_[2], f_[1]; TRSTEP(a0, b_, 16, 32) TRSTEP(b_, c_, 8, 16) TRSTEP(c_, d_, 4, 8) TRSTEP(d_, e_, 2, 4) TRSTEP(e_, f_, 1, 2) t0 = f_[0] + __shfl_xor(f_[0], 1); }
                    { float b_[16], c_[8], d_[4], e_[2], f_[1]; TRSTEP(a1, b_, 16, 32) TRSTEP(b_, c_, 8, 16) TRSTEP(c_, d_, 4, 8) TRSTEP(d_, e_, 2, 4) TRSTEP(e_, f_, 1, 2) t1 = f_[0] + __shfl_xor(f_[0], 1); }
#undef TRSTEP
                    { const int E = (lane >> 1) & 31; const float bias = rb[E]; if ((lane & 1) == 0) { LG[rr * 32 + E] = t0 + bias; LG[(rr + 1) * 32 + E] = t1 + bias; } }
                }
                asm volatile("s_waitcnt lgkmcnt(0)" ::: "memory");
                if (lane < 16) { const int lr = wave * 16 + lane; const size_t m = (size_t)r0 + lr; float lg[32];
#pragma unroll
                    for (int e4 = 0; e4 < 8; ++e4) { const f32x4 x = *(const LAS f32x4*)(LG + lane * 32 + e4 * 4); lg[e4 * 4] = x.x; lg[e4 * 4 + 1] = x.y; lg[e4 * 4 + 2] = x.z; lg[e4 * 4 + 3] = x.w; }
                    int se[4]; float sv[4];
#pragma unroll
                    for (int k = 0; k < 4; ++k) { float best = -INFINITY; int bi = 0;
#pragma unroll
                        for (int e = 0; e < 32; ++e) { if (lg[e] > best) { best = lg[e]; bi = e; } }
                        se[k] = bi; sv[k] = best;
#pragma unroll
                        for (int e = 0; e < 32; ++e) if (e == bi) lg[e] = -INFINITY; }
                    const float e1 = expf(sv[1] - sv[0]), e2 = expf(sv[2] - sv[0]), e3 = expf(sv[3] - sv[0]); const float inv = 1.f / (1.f + e1 + e2 + e3);
                    const float wts[4] = {inv, e1 * inv, e2 * inv, e3 * inv};
#pragma unroll
                    for (int k = 0; k < 4; ++k) { const int ls = __hip_atomic_fetch_add(lcnt + se[k], 1, __ATOMIC_RELAXED, __HIP_MEMORY_SCOPE_WORKGROUP); sele[lr * 4 + k] = se[k]; sels[lr * 4 + k] = ls; TOKW[m * 4 + k] = wts[k]; } }
                __syncthreads();
                if (tid < 32) lbase[tid] = (int)__hip_atomic_fetch_add(ctl + CW_CNT + l * 32 + tid, (unsigned)lcnt[tid], RLX_AGENT);
                __syncthreads();
                { const int e = sele[tid], sl = lbase[e] + sels[tid]; TOKE[(size_t)r0 * 4 + tid] = e; TOKS[(size_t)r0 * 4 + tid] = sl; LIST[(size_t)e * NTOK + sl] = r0 + (tid >> 2); }
                __syncthreads();
            }
        }
        SEAM(pb + 5);
        STAMP(pb + 7);
        if (IN(pb + 7) || IN(pb + 8) || IN(pb + 9)) {
            LAS int* pst = (LAS int*)(lctl + LC_PSTART); LAS int* ecnt = (LAS int*)(lctl + LC_BASE); gu32* ctl = (gu32*)(KWS() + WS_CTL);
            __syncthreads();
            if (threadIdx.x == 0) { int acc = 0; for (int e = 0; e < NE; ++e) { pst[e] = acc; const int c = (int)__hip_atomic_load(ctl + CW_CNT + l * 32 + e, RLX_AGENT); ecnt[e] = c; acc += (c + 255) >> 8; } pst[NE] = acc; }
            __syncthreads();
        }
        if (IN(pb + 7) && PON(8)) {
            TID_SETUP(); unsigned char* ws = KWS(); const float* exp_b_gu = KIN(15); const bf16* HB = WSP(bf16, WS_HB); const int* LIST = WSP(int, WS_XS); const bf16* WGU_T = WSP(bf16, WS_WGU_T); bf16* HID = WSP(bf16, WS_HID);
            const LAS int* pst = (const LAS int*)(lctl + LC_PSTART); LAS int* ul = (LAS int*)(lctl + LC_ULIST);
            const int nM = pst[NE], nN = 8, nwg = nM * nN;
            if (tid < 64) { const long L = (long)tid * G + bx; int v = -1;
                if (L < nwg) { int wgid = (int)L; { const int q = nwg / 8, r = nwg % 8, xcd = wgid % 8, off = wgid / 8; wgid = (xcd < r ? xcd * (q + 1) : r * (q + 1) + (xcd - r) * q) + off; }
                    const int nig = 8 * nN, gid = wgid / nig, fm = gid * 8, gsz = (nM - fm) < 8 ? (nM - fm) : 8; const int pm = fm + ((wgid % nig) % gsz), pn = (wgid % nig) / gsz;
                    int e = 0; for (int k = 1; k < NE; ++k) if (pst[k] <= pm) e = k;
                    v = (pm << 16) | (e * nN + pn); }
                ul[tid] = v; }
            __syncthreads();
            const int nunits = bx < nwg ? (nwg - bx + G - 1) / G : 0;
            LAS unsigned short* rows16 = (LAS unsigned short*)(lctl + LC_ROWS); const LAS int* ecnt = (const LAS int*)(lctl + LC_BASE);
            for (int sl = 0; sl < nunits; ++sl) { const int v = ul[sl]; const int pm = v >> 16, e = (v & 0xffff) >> 3, pl = pm - pst[e];
                if (tid < 256) { const int idx = pl * 256 + tid; rows16[sl * 256 + tid] = (idx < ecnt[e]) ? (unsigned short)LIST[(size_t)e * NTOK + idx] : (unsigned short)0; } }
            __syncthreads();
            pg8::Gemm g{HB, WGU_T + (size_t)l * NE * 2048 * DM, NTOK, NE * 2048, DM}; pg8::ListOrder S{ul, nunits};
            pg8::EpiSwiglu E{HID, exp_b_gu + (size_t)l * NE * 2048};
            pg8::gemm_phase_gather<pg8::EpiSwiglu, pg8::ListOrder, true>(lds + RING_OFF, g, S, E, rows16);
        }
        SEAM(pb + 7);
        if (IN(pb + 8) && PON(9)) {
            TID_SETUP(); unsigned char* ws = KWS(); const float* exp_b_down = KIN(17); const bf16* HID = WSP(bf16, WS_HID); const bf16* WDN_T = WSP(bf16, WS_WDN_T); bf16* YS = WSP(bf16, WS_YS);
            const LAS int* pst = (const LAS int*)(lctl + LC_PSTART); LAS int* ul = (LAS int*)(lctl + LC_ULIST);
            const int nM = pst[NE], nN = 4, nwg = nM * nN;
            __syncthreads();
            if (tid < 64) { const long L = (long)tid * G + bx; int v = -1;
                if (L < nwg) { int wgid = (int)L; { const int q = nwg / 8, r = nwg % 8, xcd = wgid % 8, off = wgid / 8; wgid = (xcd < r ? xcd * (q + 1) : r * (q + 1) + (xcd - r) * q) + off; }
                    const int nig = 8 * nN, gid = wgid / nig, fm = gid * 8, gsz = (nM - fm) < 8 ? (nM - fm) : 8; const int pm = fm + ((wgid % nig) % gsz), pn = (wgid % nig) / gsz;
                    int e = 0; for (int k = 1; k < NE; ++k) if (pst[k] <= pm) e = k;
                    v = (pm << 16) | (e * nN + pn); }
                ul[tid] = v; }
            __syncthreads();
            const int nunits = bx < nwg ? (nwg - bx + G - 1) / G : 0;
            pg8::Gemm g{HID, WDN_T + (size_t)l * NE * DM * DE, MPAD, NE * DM, DE}; pg8::ListOrder S{ul, nunits};
            pg8::EpiDown E{YS, exp_b_down + (size_t)l * NE * DM};
            pg8::gemm_phase<pg8::EpiDown, pg8::ListOrder, true, true>(lds + RING_OFF, g, S, E);
        }
        SEAM(pb + 8);
        if (IN(pb + 9) && PON(10)) {
            TID_SETUP(); unsigned char* ws = KWS(); const float* ln2_g = KIN(18); const float* ln2_b = KIN(19); float* out = KOUT(); float* HF = WSP(float, WS_HF); bf16* HB = WSP(bf16, WS_HB);
            const bf16* YS = WSP(bf16, WS_YS); const int* TOKE = WSP(int, WS_TOK); const int* TOKS = TOKE + NTOK * 4; const float* TOKW = (const float*)(TOKS + NTOK * 4); const LAS int* pst = (const LAS int*)(lctl + LC_PSTART);
            const bool lastl = (l == NL - 1);
            for (int m0 = gw; m0 < NTOK; m0 += 2 * NGW) { f32x4 v[2][4]; const bf16* yr[2][4]; float wk[2][4];
#pragma unroll
                for (int q = 0; q < 2; ++q) { const int m = m0 + q * NGW;
#pragma unroll
                    for (int k = 0; k < 4; ++k) { wk[q][k] = TOKW[m * 4 + k]; yr[q][k] = YS + (size_t)(pst[TOKE[m * 4 + k]] * 256 + TOKS[m * 4 + k]) * DM; }
#pragma unroll
                    for (int j = 0; j < 4; ++j) v[q][j] = *(const f32x4*)(HF + (size_t)m * DM + lane * 4 + 256 * j) * DN_ALPHA; }
#pragma unroll
                for (int q = 0; q < 2; ++q)
#pragma unroll
                    for (int k = 0; k < 4; ++k)
#pragma unroll
                        for (int j = 0; j < 4; ++j) { const u16x4 y = *(const u16x4*)(yr[q][k] + lane * 4 + 256 * j); const float w = wk[q][k]; v[q][j].x += w * bf2f(y[0]); v[q][j].y += w * bf2f(y[1]); v[q][j].z += w * bf2f(y[2]); v[q][j].w += w * bf2f(y[3]); }
#pragma unroll
                for (int q = 0; q < 2; ++q) { const int m = m0 + q * NGW;
                    ln_row(v[q], ln2_g + l * DM, ln2_b + l * DM, lastl ? out + (size_t)m * DM : HF + (size_t)m * DM, lastl ? nullptr : HB + (size_t)m * DM, lane); } }
        }
        SEAM(pb + 9);
    }
#if PROBE_A >= 0
    { xcd_barrier(bar);
      const unsigned long long* st = (const unsigned long long*)(KWS() + WS_CTL + 65536); unsigned long long T = 0;
      if (PROBE_A & 1) T += st[1] - st[0];
      for (int l = 0; l < NL; ++l) for (int j = 1; j <= 10; ++j) if ((PROBE_A >> j) & 1) T += st[1 + 10 * l + j] - st[10 * l + j];
      T *= 4ull; if (T > 5000000ull) T = 5000000ull;
      const unsigned long long t0 = __builtin_amdgcn_s_memrealtime();
      while (__builtin_amdgcn_s_memrealtime() - t0 < T) __builtin_amdgcn_s_sleep(16); }
#endif
#undef IN
#undef SEAM
}

#ifndef MK_PER_PHASE
#define MK_PER_PHASE 0
#endif
extern "C" void kernel_launch(void* const* d_in, const int* in_sizes, int n_in, void* d_out, int out_size, void* d_ws, size_t ws_size, hipStream_t stream) {
    static int grid = 0;
    if (grid == 0) {
        if (n_in != 20 || in_sizes[0] != NTOK * DM || out_size != NTOK * DM || ws_size < WS_END) { fprintf(stderr, "kernel_launch: unexpected shapes (n_in %d, in0 %d, out %d, ws %zu); nothing launched\n", n_in, n_in > 0 ? in_sizes[0] : -1, out_size, ws_size); grid = -1; return; }
        int dev = 0, cus = 0, per_cu = 0;
        if (hipGetDevice(&dev) != hipSuccess || hipDeviceGetAttribute(&cus, hipDeviceAttributeMultiprocessorCount, dev) != hipSuccess) { grid = -1; return; }
        if (hipFuncSetAttribute((const void*)fwd, hipFuncAttributeMaxDynamicSharedMemorySize, LDS_BYTES) != hipSuccess) { fprintf(stderr, "kernel_launch: hipFuncSetAttribute failed\n"); grid = -1; return; }
        if (hipOccupancyMaxActiveBlocksPerMultiprocessor(&per_cu, (const void*)fwd, NWAVES * 64, LDS_BYTES) != hipSuccess || per_cu < 1) fprintf(stderr, "kernel_launch: occupancy query reports %d\n", per_cu);
        (void)hipGetLastError();
        grid = cus;
    }
    if (grid < 0) return;
    if (hipMemsetAsync((char*)d_ws + WS_CTL, 0, CTL_ZERO_BYTES, stream) != hipSuccess) return;
    Args a{};
    for (int i = 0; i < 20; ++i) a.in[i] = (const float*)d_in[i];
    a.out = (float*)d_out; a.ws = (unsigned char*)d_ws;
#if MK_PER_PHASE
    for (int p = 0; p < N_PHASES; ++p) { a.ph_lo = p; a.ph_hi = p + 1; hipLaunchKernelGGL(fwd, dim3(grid), dim3(NWAVES * 64), LDS_BYTES, stream, a); }
#else
    a.ph_lo = 0; a.ph_hi = N_PHASES;
    hipLaunchKernelGGL(fwd, dim3(grid), dim3(NWAVES * 64), LDS_BYTES, stream, a);
#endif
    const hipError_t le = hipPeekAtLastError();
    if (le != hipSuccess) fprintf(stderr, "kernel_launch: launch failed: %s\n", hipGetErrorName(le));
}
```

```cpp
#include <hip/hip_runtime.h>
#include <hip/hip_bf16.h>
#include <cstdio>
#include <cstdint>
#include <cmath>
namespace pg8 {
#define PG8_LAS __attribute__((address_space(3)))
typedef unsigned short bf16_t;
typedef short bf16x8 __attribute__((ext_vector_type(8)));
typedef float f32x4 __attribute__((ext_vector_type(4)));
typedef unsigned u32x4 __attribute__((ext_vector_type(4)));
constexpr int BM = 256, BK = 64, HALF = 128, HTB = HALF * BK * 2  , STAGE_BYTES = 8 * HTB, NXCD = 8, WGM = 8;

__host__ __device__ __forceinline__ int lds_byte(int r, int c) { const int st = (r >> 4) * 2 + (c >> 5), rr = r & 15, cc = c & 31, ob = rr * 64 + cc * 2; return st * 1024 + (ob ^ (((ob >> 9) & 1) << 5)); }
__host__ __device__ __forceinline__ void stage_rc(int b, int& R, int& C) { const int st = b / 1024, sb = b % 1024, swz = sb ^ (((sb >> 9) & 1) << 5); R = (st >> 1) * 16 + swz / 64; C = (st & 1) * 32 + (swz % 64) / 2; }
__host__ __device__ __forceinline__ int perm32(int rho) { const int n = rho >> 4, i = rho & 15; return 8 * (i >> 2) + 4 * n + (i & 3); }

struct Unit { int pm, pn; };
struct Gemm { const bf16_t* A; const bf16_t* Bt; int M, N, K; };

struct StaticOrder {
    int nM, nN, nwg, G, c;
    __host__ __device__ void init(int M, int N, int G_, int c_) { nM = M / BM; nN = N / BM; nwg = nM * nN; G = G_; c = c_; }
    __host__ __device__ bool next(int i, Unit& u) const {
        const long L = (long)i * G + c; if (L >= nwg) return false;
        int wgid = (int)L; { const int q = nwg / NXCD, r = nwg % NXCD, xcd = wgid % NXCD, off = wgid / NXCD; wgid = (xcd < r ? xcd * (q + 1) : r * (q + 1) + (xcd - r) * q) + off; }
        const int nig = WGM * nN, gid = wgid / nig, fm = gid * WGM, gsz = (nM - fm) < WGM ? (nM - fm) : WGM;
        u.pm = fm + ((wgid % nig) % gsz); u.pn = (wgid % nig) / gsz; return true;
    }
    __device__ __forceinline__ void a_ready(const Unit&) const {}
    __device__ __forceinline__ void done(const Unit&) const {}
};

__device__ __forceinline__ unsigned cvt_pk_bf16(float lo, float hi) { unsigned r; asm volatile("v_cvt_pk_bf16_f32 %0, %1, %2" : "=v"(r) : "v"(lo), "v"(hi)); return r; }
typedef float f32x2 __attribute__((ext_vector_type(2)));
__device__ __forceinline__ u32x4 pack8(const f32x4 v0, const f32x4 v1) { u32x4 w; w.x = cvt_pk_bf16(v0[0], v0[1]); w.y = cvt_pk_bf16(v0[2], v0[3]); w.z = cvt_pk_bf16(v1[0], v1[1]); w.w = cvt_pk_bf16(v1[2], v1[3]); return w; }

struct EpiPlainBf16 {
    static constexpr bool PERM = true, AFTER_DRAIN = false;
    bf16_t* O; int ldc;
    __device__ __forceinline__ void operator()(const f32x4 (&acc)[2][2][4][2], const Unit& u, int wr, int wc, int fr, int fq) const {
        const int row0 = u.pm * BM + wr * 64 + fr, col0 = u.pn * BM + wc * 32 + 8 * fq;
#pragma unroll
        for (int ai = 0; ai < 2; ++ai)
#pragma unroll
            for (int m = 0; m < 4; ++m) { bf16_t* rowp = O + (size_t)(row0 + ai * HALF + m * 16) * ldc + col0;
#pragma unroll
                for (int bj = 0; bj < 2; ++bj) *(u32x4*)(rowp + bj * HALF) = pack8(acc[ai][bj][m][0], acc[ai][bj][m][1]); }
    }
};
struct EpiFnet {
    static constexpr bool PERM = true, AFTER_DRAIN = false;
    bf16_t* MIX;
    __device__ __forceinline__ void operator()(const f32x4 (&acc)[2][2][4][2], const Unit& u, int wr, int wc, int fr, int fq) const {
        const int row0 = u.pn * 4096 + u.pm * BM + wr * 64 + fr, col0 = 768 + wc * 32 + 8 * fq;
#pragma unroll
        for (int ai = 0; ai < 2; ++ai)
#pragma unroll
            for (int m = 0; m < 4; ++m) { bf16_t* rowp = MIX + (size_t)(row0 + ai * HALF + m * 16) * 1024 + col0;
#pragma unroll
                for (int bj = 0; bj < 2; ++bj) *(u32x4*)(rowp + bj * HALF) = pack8(acc[ai][bj][m][0], acc[ai][bj][m][1]); }
    }
};
struct EpiResF32 {
    static constexpr bool PERM = false, AFTER_DRAIN = false;
    const float* base; float* out; int ldc; float alpha;
    __device__ __forceinline__ void operator()(const f32x4 (&acc)[2][2][4][2], const Unit& u, int wr, int wc, int fr, int fq) const {
        const int row0 = u.pm * BM + wr * 64 + fr, col0 = u.pn * BM + wc * 32 + 4 * fq;
#pragma unroll
        for (int ai = 0; ai < 2; ++ai)
#pragma unroll
            for (int m = 0; m < 4; ++m) { const size_t off = (size_t)(row0 + ai * HALF + m * 16) * ldc + col0;
#pragma unroll
                for (int bj = 0; bj < 2; ++bj)
#pragma unroll
                    for (int n = 0; n < 2; ++n) { const f32x4 b = *(const f32x4*)(base + off + bj * HALF + n * 16); *(f32x4*)(out + off + bj * HALF + n * 16) = b * alpha + acc[ai][bj][m][n]; } }
    }
};
__device__ __forceinline__ float swiglu1(float g, float u) { g = fminf(g, 7.0f); u = fminf(fmaxf(u, -7.0f), 7.0f); return (u + 1.0f) * g * __builtin_amdgcn_rcpf(1.0f + __expf(-1.702f * g)); }
struct EpiSwiglu {
    static constexpr bool PERM = true, AFTER_DRAIN = false;
    bf16_t* HID; const float* bgu;
    __device__ __forceinline__ void operator()(const f32x4 (&acc)[2][2][4][2], const Unit& u, int wr, int wc, int fr, int fq) const {
        const int e = u.pn >> 3, pnl = u.pn & 7; const int row0 = u.pm * BM + wr * 64 + fr, jj0 = pnl * 128 + wc * 32 + 8 * fq;
        const float* bg = bgu + (size_t)e * 2048 + jj0;
        const f32x4 bg0 = *(const f32x4*)bg, bg1 = *(const f32x4*)(bg + 4), bu0 = *(const f32x4*)(bg + 1024), bu1 = *(const f32x4*)(bg + 1028);
#pragma unroll
        for (int ai = 0; ai < 2; ++ai)
#pragma unroll
            for (int m = 0; m < 4; ++m) { bf16_t* rowp = HID + (size_t)(row0 + ai * HALF + m * 16) * 1024 + jj0;
                const f32x4 g0 = acc[ai][0][m][0] + bg0, g1 = acc[ai][0][m][1] + bg1, u0 = acc[ai][1][m][0] + bu0, u1 = acc[ai][1][m][1] + bu1;
                f32x4 h0, h1;
#pragma unroll
                for (int i = 0; i < 4; ++i) { h0[i] = swiglu1(g0[i], u0[i]); h1[i] = swiglu1(g1[i], u1[i]); }
                *(u32x4*)rowp = pack8(h0, h1); }
    }
};
struct EpiDown {
    static constexpr bool PERM = true, AFTER_DRAIN = false;
    bf16_t* Y; const float* bd;
    __device__ __forceinline__ void operator()(const f32x4 (&acc)[2][2][4][2], const Unit& u, int wr, int wc, int fr, int fq) const {
        const int e = u.pn >> 2, pnl = u.pn & 3; const int row0 = u.pm * BM + wr * 64 + fr, col0 = pnl * BM + wc * 32 + 8 * fq;
        const float* bp = bd + (size_t)e * 1024 + col0;
        f32x4 bv[2][2];
#pragma unroll
        for (int bj = 0; bj < 2; ++bj)
#pragma unroll
            for (int n = 0; n < 2; ++n) bv[bj][n] = *(const f32x4*)(bp + bj * HALF + 4 * n);
#pragma unroll
        for (int ai = 0; ai < 2; ++ai)
#pragma unroll
            for (int m = 0; m < 4; ++m) { bf16_t* rowp = Y + (size_t)(row0 + ai * HALF + m * 16) * 1024 + col0;
#pragma unroll
                for (int bj = 0; bj < 2; ++bj) *(u32x4*)(rowp + bj * HALF) = pack8(acc[ai][bj][m][0] + bv[bj][0], acc[ai][bj][m][1] + bv[bj][1]); }
    }
};
struct ListOrder {
    const PG8_LAS int* list; int n;
    __device__ __forceinline__ bool next(int i, Unit& u) const { if (i >= n) return false; const int v = __builtin_amdgcn_readfirstlane(list[i]); u.pm = v >> 16; u.pn = v & 0xffff; return true; }
    __device__ __forceinline__ void a_ready(const Unit&) const {}
    __device__ __forceinline__ void done(const Unit&) const {}
};
template <class Epi, class Sched, bool ALIGN_EPI = false, bool SP2 = false>
__device__ __forceinline__ void gemm_phase(PG8_LAS unsigned char* lds, const Gemm g, const Sched& S, const Epi& E) {
    int tid_ = threadIdx.x; asm volatile("" : "+v"(tid_));
    const int tid = tid_, wid = __builtin_amdgcn_readfirstlane(tid >> 6), lane = tid & 63, wr = wid >> 2, wc = wid & 3, fr = lane & 15, fq = lane >> 4;
    const int K = g.K, nt = K / BK;
    unsigned voffA[2], voffB[2];
#pragma unroll
    for (int i = 0; i < 2; ++i) { int R, C; stage_rc(tid * 16 + i * 8192, R, C); const int Rb = Epi::PERM ? ((R & ~31) + perm32(R & 31)) : R;
        voffA[i] = (unsigned)(R * K + C) * 2u; voffB[i] = (unsigned)(Rb * K + C) * 2u; }
    const size_t kstep = (size_t)(BK * 2);
    const size_t hstep = (size_t)HALF * K * 2;
    const size_t tstep = 2 * hstep;
    const unsigned ldsw = (unsigned)wid * 1024u;
    const int aoff = lds_byte(wr * 64 + fr, fq * 8), boff = lds_byte(wc * 32 + fr, fq * 8);
#define PG8_SA(b, h) (((b) * 2 + (h)) * HTB)
#define PG8_SB(b, h) ((4 + (b) * 2 + (h)) * HTB)
#define PG8_STAGE(bufoff, gbase, voff) do { _Pragma("unroll") for (int _i = 0; _i < 2; ++_i) \
        __builtin_amdgcn_global_load_lds((const unsigned*)((const char*)(gbase) + (voff)[_i]), (PG8_LAS unsigned*)(lds + (bufoff) + ldsw + _i * 8192), 16, 0, 0); } while (0)
#define PG8_LDA(dst, b, h) do { _Pragma("unroll") for (int m = 0; m < 4; ++m) _Pragma("unroll") for (int k = 0; k < 2; ++k) dst[m][k] = *(const PG8_LAS bf16x8*)(lds + PG8_SA(b, h) + aoff + m * 2048 + k * 1024); } while (0)
#define PG8_LDB(dst, b, h) do { _Pragma("unroll") for (int n = 0; n < 2; ++n) _Pragma("unroll") for (int k = 0; k < 2; ++k) dst[n][k] = *(const PG8_LAS bf16x8*)(lds + PG8_SB(b, h) + boff + n * 2048 + k * 1024); } while (0)
#define PG8_MMA(ai, bj, At, Bt) do { __builtin_amdgcn_s_setprio(1); _Pragma("unroll") for (int m = 0; m < 4; ++m) _Pragma("unroll") for (int n = 0; n < 2; ++n) _Pragma("unroll") for (int k = 0; k < 2; ++k) \
        acc[ai][bj][m][n] = __builtin_amdgcn_mfma_f32_16x16x32_bf16(Bt[n][k], At[m][k], acc[ai][bj][m][n], 0, 0, 0); __builtin_amdgcn_s_setprio(0); } while (0)
#define PG8_WAIT_V(n) asm volatile("s_waitcnt vmcnt(" #n ")" ::: "memory")
#define PG8_WAIT_L(n) asm volatile("s_waitcnt lgkmcnt(" #n ")" ::: "memory")
#define PG8_BAR __builtin_amdgcn_s_barrier()
#define PG8_SCHED __builtin_amdgcn_sched_barrier(0)
    Unit cur, nxt; int ui = 0;
    if (!S.next(0, cur)) return;
    f32x4 acc[2][2][4][2];
#pragma unroll
    for (int a = 0; a < 2; ++a)
#pragma unroll
        for (int b = 0; b < 2; ++b)
#pragma unroll
            for (int m = 0; m < 4; ++m)
#pragma unroll
                for (int n = 0; n < 2; ++n) acc[a][b][m][n] = (f32x4){0.f, 0.f, 0.f, 0.f};
    bf16x8 At[4][2], B0[2][2], B1[2][2];
    const char* cA = (const char*)g.A + (size_t)cur.pm * tstep; const char* cB = (const char*)g.Bt + (size_t)cur.pn * tstep;
    S.a_ready(cur);
    if constexpr (SP2) {
        PG8_STAGE(PG8_SB(0, 0), cB, voffB); PG8_STAGE(PG8_SB(0, 1), cB + hstep, voffB); PG8_STAGE(PG8_SA(0, 0), cA, voffA); PG8_STAGE(PG8_SA(0, 1), cA + hstep, voffA);
        if (wr == 1) PG8_BAR;
        PG8_WAIT_V(2); PG8_BAR;
        PG8_STAGE(PG8_SB(1, 0), cB + kstep, voffB); PG8_STAGE(PG8_SA(1, 0), cA + kstep, voffA); PG8_STAGE(PG8_SB(1, 1), cB + hstep + kstep, voffB);
        PG8_WAIT_V(6); PG8_BAR;
    } else {
        PG8_STAGE(PG8_SB(0, 0), cB, voffB); PG8_STAGE(PG8_SA(0, 0), cA, voffA); PG8_STAGE(PG8_SB(0, 1), cB + hstep, voffB); PG8_STAGE(PG8_SA(0, 1), cA + hstep, voffA);
        if (wr == 1) PG8_BAR;
        PG8_WAIT_V(4); PG8_BAR;
        PG8_STAGE(PG8_SB(1, 0), cB + kstep, voffB); PG8_STAGE(PG8_SA(1, 0), cA + kstep, voffA); PG8_STAGE(PG8_SB(1, 1), cB + hstep + kstep, voffB);
        PG8_WAIT_V(6); PG8_BAR;
    }
    for (;;) {
        const bool has_next = S.next(ui + 1, nxt);
        const char* nA = has_next ? (const char*)g.A + (size_t)nxt.pm * tstep : cA; const char* nB = has_next ? (const char*)g.Bt + (size_t)nxt.pn * tstep : cB;
        for (int t = 0; t < nt; t += 2) {
            const bool last = (t == nt - 2);
            const char* a1 = cA + (size_t)(t + 1) * kstep;
            const char* a2 = last ? nA : cA + (size_t)(t + 2) * kstep; const char* b2 = last ? nB : cB + (size_t)(t + 2) * kstep;
            const char* a3 = a2 + kstep; const char* b3 = b2 + kstep;
            if (last && has_next) S.a_ready(nxt);
            if constexpr (SP2) {
            PG8_LDB(B0, 0, 0); PG8_LDB(B1, 0, 1); PG8_SCHED; PG8_LDA(At, 0, 0); PG8_STAGE(PG8_SA(1, 1), a1 + hstep, voffA);
            PG8_WAIT_V(8); PG8_WAIT_L(0); PG8_BAR; PG8_MMA(0, 0, At, B0); PG8_MMA(0, 1, At, B1); PG8_BAR; PG8_SCHED;
            PG8_LDA(At, 0, 1); PG8_STAGE(PG8_SB(0, 0), b2, voffB); PG8_STAGE(PG8_SB(0, 1), b2 + hstep, voffB); PG8_STAGE(PG8_SA(0, 0), a2, voffA);
            PG8_WAIT_V(8); PG8_WAIT_L(0); PG8_BAR; PG8_MMA(1, 0, At, B0); PG8_MMA(1, 1, At, B1); PG8_BAR; PG8_SCHED;
            PG8_LDB(B0, 1, 0); PG8_LDB(B1, 1, 1); PG8_SCHED; PG8_LDA(At, 1, 0); PG8_STAGE(PG8_SA(0, 1), a2 + hstep, voffA);
            PG8_WAIT_V(8); PG8_WAIT_L(0); PG8_BAR; PG8_MMA(0, 0, At, B0); PG8_MMA(0, 1, At, B1); PG8_BAR; PG8_SCHED;
            PG8_LDA(At, 1, 1); PG8_STAGE(PG8_SB(1, 0), b3, voffB); PG8_STAGE(PG8_SB(1, 1), b3 + hstep, voffB); PG8_STAGE(PG8_SA(1, 0), a3, voffA);
            PG8_WAIT_V(8); PG8_WAIT_L(0); PG8_BAR; PG8_MMA(1, 0, At, B0); PG8_MMA(1, 1, At, B1); PG8_BAR; PG8_SCHED;
            } else {
            PG8_LDB(B0, 0, 0); PG8_SCHED; PG8_LDA(At, 0, 0); PG8_STAGE(PG8_SA(1, 1), a1 + hstep, voffA);
            PG8_WAIT_L(8); PG8_BAR; PG8_WAIT_L(0); PG8_MMA(0, 0, At, B0); PG8_BAR; PG8_SCHED;
            PG8_LDB(B1, 0, 1); PG8_STAGE(PG8_SB(0, 0), b2, voffB);
            PG8_BAR; PG8_WAIT_L(0); PG8_MMA(0, 1, At, B1); PG8_BAR;
            PG8_LDA(At, 0, 1); PG8_STAGE(PG8_SA(0, 0), a2, voffA);
            PG8_BAR; PG8_WAIT_L(0); PG8_MMA(1, 0, At, B0); PG8_BAR; PG8_SCHED;
            PG8_STAGE(PG8_SB(0, 1), b2 + hstep, voffB);
            PG8_WAIT_V(6); PG8_BAR; PG8_MMA(1, 1, At, B1); PG8_BAR;
            PG8_LDB(B0, 1, 0); PG8_SCHED; PG8_LDA(At, 1, 0); PG8_STAGE(PG8_SA(0, 1), a2 + hstep, voffA);
            PG8_WAIT_L(8); PG8_BAR; PG8_WAIT_L(0); PG8_MMA(0, 0, At, B0); PG8_BAR; PG8_SCHED;
            PG8_LDB(B1, 1, 1); PG8_STAGE(PG8_SB(1, 0), b3, voffB);
            PG8_BAR; PG8_WAIT_L(0); PG8_MMA(0, 1, At, B1); PG8_BAR;
            PG8_LDA(At, 1, 1); PG8_STAGE(PG8_SA(1, 0), a3, voffA);
            PG8_BAR; PG8_WAIT_L(0); PG8_MMA(1, 0, At, B0); PG8_BAR; PG8_SCHED;
            PG8_STAGE(PG8_SB(1, 1), b3 + hstep, voffB);
            PG8_WAIT_V(6); PG8_BAR; PG8_MMA(1, 1, At, B1); PG8_BAR;
            }
        }
        if constexpr (ALIGN_EPI) { if (wr == 0) PG8_BAR; }
        if constexpr (!Epi::AFTER_DRAIN) { E(acc, cur, wr, wc, fr, fq); S.done(cur); }
        if (!has_next) break;
#pragma unroll
        for (int a = 0; a < 2; ++a)
#pragma unroll
            for (int b = 0; b < 2; ++b)
#pragma unroll
                for (int m = 0; m < 4; ++m)
#pragma unroll
                    for (int n = 0; n < 2; ++n) acc[a][b][m][n] = (f32x4){0.f, 0.f, 0.f, 0.f};
        cur = nxt; cA = nA; cB = nB; ++ui;
        if constexpr (ALIGN_EPI) { if (wr == 1) PG8_BAR; }
    }
    PG8_WAIT_V(0);
    if constexpr (!ALIGN_EPI) { if (wr == 0) PG8_BAR; }
    PG8_BAR;
    if constexpr (Epi::AFTER_DRAIN) { E.fused(acc, cur, wr, wc, fr, fq, lds, wid, lane); S.done(cur); }
#undef PG8_SA
#undef PG8_SB
#undef PG8_STAGE
#undef PG8_LDA
#undef PG8_LDB
#undef PG8_MMA
#undef PG8_WAIT_V
#undef PG8_WAIT_L
#undef PG8_BAR
#undef PG8_SCHED
}
}
namespace pg8 {
template <class Epi, class Sched, bool ALIGN_EPI>
__device__ __forceinline__ void gemm_phase_gather(PG8_LAS unsigned char* lds, const Gemm g, const Sched& S, const Epi& E, const PG8_LAS unsigned short* rows16) {
    int tid_ = threadIdx.x; asm volatile("" : "+v"(tid_));
    const int tid = tid_, wid = __builtin_amdgcn_readfirstlane(tid >> 6), lane = tid & 63, wr = wid >> 2, wc = wid & 3, fr = lane & 15, fq = lane >> 4;
    const int K = g.K, nt = K / BK;
    unsigned voffB[2]; int RA[2]; unsigned CA2[2];
#pragma unroll
    for (int i = 0; i < 2; ++i) { int R, C; stage_rc(tid * 16 + i * 8192, R, C); const int Rb = Epi::PERM ? ((R & ~31) + perm32(R & 31)) : R;
        RA[i] = R; CA2[i] = (unsigned)C * 2u; voffB[i] = (unsigned)(Rb * K + C) * 2u; }
    const size_t kstep = (size_t)(BK * 2);
    const size_t hstep = (size_t)HALF * K * 2;
    const size_t tstep = 2 * hstep;
    const unsigned ldsw = (unsigned)wid * 1024u;
    const unsigned rowb = (unsigned)K * 2u;
    const int aoff = lds_byte(wr * 64 + fr, fq * 8), boff = lds_byte(wc * 32 + fr, fq * 8);
#define PG8_SA(b, h) (((b) * 2 + (h)) * HTB)
#define PG8_SB(b, h) ((4 + (b) * 2 + (h)) * HTB)
#define PG8_STAGE(bufoff, gbase, voff) do { _Pragma("unroll") for (int _i = 0; _i < 2; ++_i) \
        __builtin_amdgcn_global_load_lds((const unsigned*)((const char*)(gbase) + (voff)[_i]), (PG8_LAS unsigned*)(lds + (bufoff) + ldsw + _i * 8192), 16, 0, 0); } while (0)
#define PG8_LDA(dst, b, h) do { _Pragma("unroll") for (int m = 0; m < 4; ++m) _Pragma("unroll") for (int k = 0; k < 2; ++k) dst[m][k] = *(const PG8_LAS bf16x8*)(lds + PG8_SA(b, h) + aoff + m * 2048 + k * 1024); } while (0)
#define PG8_LDB(dst, b, h) do { _Pragma("unroll") for (int n = 0; n < 2; ++n) _Pragma("unroll") for (int k = 0; k < 2; ++k) dst[n][k] = *(const PG8_LAS bf16x8*)(lds + PG8_SB(b, h) + boff + n * 2048 + k * 1024); } while (0)
#define PG8_MMA(ai, bj, At, Bt) do { __builtin_amdgcn_s_setprio(1); _Pragma("unroll") for (int m = 0; m < 4; ++m) _Pragma("unroll") for (int n = 0; n < 2; ++n) _Pragma("unroll") for (int k = 0; k < 2; ++k) \
        acc[ai][bj][m][n] = __builtin_amdgcn_mfma_f32_16x16x32_bf16(Bt[n][k], At[m][k], acc[ai][bj][m][n], 0, 0, 0); __builtin_amdgcn_s_setprio(0); } while (0)
#define PG8_WAIT_V(n) asm volatile("s_waitcnt vmcnt(" #n ")" ::: "memory")
#define PG8_WAIT_L(n) asm volatile("s_waitcnt lgkmcnt(" #n ")" ::: "memory")
#define PG8_BAR __builtin_amdgcn_s_barrier()
#define PG8_SCHED __builtin_amdgcn_sched_barrier(0)
#define PG8_GOFF(dst, U) do { _Pragma("unroll") for (int h_ = 0; h_ < 2; ++h_) _Pragma("unroll") for (int i_ = 0; i_ < 2; ++i_) dst[h_][i_] = (unsigned)rows16[(U) * 256 + h_ * HALF + RA[i_]] * rowb + CA2[i_]; } while (0)
    Unit cur, nxt; int ui = 0;
    if (!S.next(0, cur)) return;
    f32x4 acc[2][2][4][2];
#pragma unroll
    for (int a = 0; a < 2; ++a)
#pragma unroll
        for (int b = 0; b < 2; ++b)
#pragma unroll
            for (int m = 0; m < 4; ++m)
#pragma unroll
                for (int n = 0; n < 2; ++n) acc[a][b][m][n] = (f32x4){0.f, 0.f, 0.f, 0.f};
    bf16x8 At[4][2], B0[2][2], B1[2][2];
    const char* const Ab = (const char*)g.A;
    const char* cB = (const char*)g.Bt + (size_t)cur.pn * tstep;
    unsigned gc[2][2], gn[2][2];
    PG8_GOFF(gc, 0);
    S.a_ready(cur);
    PG8_STAGE(PG8_SB(0, 0), cB, voffB); PG8_STAGE(PG8_SB(0, 1), cB + hstep, voffB); PG8_STAGE(PG8_SA(0, 0), Ab, gc[0]); PG8_STAGE(PG8_SA(0, 1), Ab, gc[1]);
    if (wr == 1) PG8_BAR;
    PG8_WAIT_V(2); PG8_BAR;
    PG8_STAGE(PG8_SB(1, 0), cB + kstep, voffB); PG8_STAGE(PG8_SA(1, 0), Ab + kstep, gc[0]); PG8_STAGE(PG8_SB(1, 1), cB + hstep + kstep, voffB);
    PG8_WAIT_V(6); PG8_BAR;
    for (;;) {
        const bool has_next = S.next(ui + 1, nxt);
        const char* nB = has_next ? (const char*)g.Bt + (size_t)nxt.pn * tstep : cB;
        if (has_next) { PG8_GOFF(gn, ui + 1); } else {
#pragma unroll
            for (int h_ = 0; h_ < 2; ++h_)
#pragma unroll
                for (int i_ = 0; i_ < 2; ++i_) gn[h_][i_] = gc[h_][i_]; }
        for (int t = 0; t < nt; t += 2) {
            const bool last = (t == nt - 2);
            const char* a1 = Ab + (size_t)(t + 1) * kstep;
            const char* a2 = last ? Ab : Ab + (size_t)(t + 2) * kstep; const char* b2 = last ? nB : cB + (size_t)(t + 2) * kstep;
            const char* a3 = a2 + kstep; const char* b3 = b2 + kstep;
            unsigned g2[2][2];
#pragma unroll
            for (int h_ = 0; h_ < 2; ++h_)
#pragma unroll
                for (int i_ = 0; i_ < 2; ++i_) g2[h_][i_] = last ? gn[h_][i_] : gc[h_][i_];
            if (last && has_next) S.a_ready(nxt);
            PG8_LDB(B0, 0, 0); PG8_LDB(B1, 0, 1); PG8_SCHED; PG8_LDA(At, 0, 0); PG8_STAGE(PG8_SA(1, 1), a1, gc[1]);
            PG8_WAIT_V(8); PG8_WAIT_L(0); PG8_BAR; PG8_MMA(0, 0, At, B0); PG8_MMA(0, 1, At, B1); PG8_BAR; PG8_SCHED;
            PG8_LDA(At, 0, 1); PG8_STAGE(PG8_SB(0, 0), b2, voffB); PG8_STAGE(PG8_SB(0, 1), b2 + hstep, voffB); PG8_STAGE(PG8_SA(0, 0), a2, g2[0]);
            PG8_WAIT_V(8); PG8_WAIT_L(0); PG8_BAR; PG8_MMA(1, 0, At, B0); PG8_MMA(1, 1, At, B1); PG8_BAR; PG8_SCHED;
            PG8_LDB(B0, 1, 0); PG8_LDB(B1, 1, 1); PG8_SCHED; PG8_LDA(At, 1, 0); PG8_STAGE(PG8_SA(0, 1), a2, g2[1]);
            PG8_WAIT_V(8); PG8_WAIT_L(0); PG8_BAR; PG8_MMA(0, 0, At, B0); PG8_MMA(0, 1, At, B1); PG8_BAR; PG8_SCHED;
            PG8_LDA(At, 1, 1); PG8_STAGE(PG8_SB(1, 0), b3, voffB); PG8_STAGE(PG8_SB(1, 1), b3 + hstep, voffB); PG8_STAGE(PG8_SA(1, 0), a3, g2[0]);
            PG8_WAIT_V(8); PG8_WAIT_L(0); PG8_BAR; PG8_MMA(1, 0, At, B0); PG8_MMA(1, 1, At, B1); PG8_BAR; PG8_SCHED;
        }
        if constexpr (ALIGN_EPI) { if (wr == 0) PG8_BAR; }
        E(acc, cur, wr, wc, fr, fq); S.done(cur);
        if (!has_next) break;
#pragma unroll
        for (int a = 0; a < 2; ++a)
#pragma unroll
            for (int b = 0; b < 2; ++b)
#pragma unroll
                for (int m = 0; m < 4; ++m)
#pragma unroll
                    for (int n = 0; n < 2; ++n) acc[a][b][m][n] = (f32x4){0.f, 0.f, 0.f, 0.f};
        cur = nxt; cB = nB; ++ui;
#pragma unroll
        for (int h_ = 0; h_ < 2; ++h_)
#pragma unroll
            for (int i_ = 0; i_ < 2; ++i_) gc[h_][i_] = gn[h_][i_];
        if constexpr (ALIGN_EPI) { if (wr == 1) PG8_BAR; }
    }
    PG8_WAIT_V(0);
    if constexpr (!ALIGN_EPI) { if (wr == 0) PG8_BAR; }
    PG8_BAR;
#undef PG8_SA
#undef PG8_SB
#undef PG8_STAGE
#undef PG8_LDA
#undef PG8_LDB
#undef PG8_MMA
#undef PG8_WAIT_V
#undef PG8_WAIT_L
#undef PG8_BAR
#undef PG8_SCHED
#undef PG8_GOFF
}
}
#define GAS __attribute__((address_space(1)))
#define LAS __attribute__((address_space(3)))
typedef unsigned short bf16;
typedef unsigned v4u __attribute__((ext_vector_type(4)));
typedef float f32x4 __attribute__((ext_vector_type(4)));
typedef short bf16x8 __attribute__((ext_vector_type(8)));
typedef GAS unsigned gu32;
typedef GAS unsigned long long gu64;
#define RLX_AGENT __ATOMIC_RELAXED, __HIP_MEMORY_SCOPE_AGENT
#define LDS_WAIT() asm volatile("s_waitcnt lgkmcnt(0)" ::: "memory")
#define VM_WAIT() asm volatile("s_waitcnt vmcnt(0)" ::: "memory")
__device__ __forceinline__ unsigned long long rt() { return __builtin_amdgcn_s_memrealtime(); }
__device__ __forceinline__ unsigned f2bf(float f) { unsigned u = __builtin_bit_cast(unsigned, f); return (u + 0x7fffu + ((u >> 16) & 1u)) >> 16; }
__device__ __forceinline__ unsigned pk2(float lo, float hi) { return f2bf(lo) | (f2bf(hi) << 16); }
#define XB_TMO      128
#define XB_XCNT(j)  (256  + 64 * (j))
#define XB_XSUB(j)  (1280 + 64 * (j))
#define XB_XGEN(j)  (2304 + 64 * (j))
#define XB_TOP      3328
#define XB_TOPGEN   3392
#define XCD_BAR_WORDS 3456
#define XB_SPIN_CAP (1u << 18)

__device__ __forceinline__ unsigned xb_ld(unsigned* p)              { return __hip_atomic_load(p, __ATOMIC_RELAXED, __HIP_MEMORY_SCOPE_AGENT); }
__device__ __forceinline__ unsigned xb_add(unsigned* p, unsigned v) { return __hip_atomic_fetch_add(p, v, __ATOMIC_RELAXED, __HIP_MEMORY_SCOPE_AGENT); }
__device__ __forceinline__ unsigned xb_xcc_id() { return (unsigned)__builtin_amdgcn_s_getreg((3 << 11) | 20) & 0xFu; }
#define XB_SPIN(cond, bar) do { unsigned _sp = 0; while (cond) { __builtin_amdgcn_s_sleep(1); \
    if ((++_sp & 255u) == 0u) { if (xb_ld(&(bar)[XB_TMO])) break; if (_sp > XB_SPIN_CAP) { atomicAdd(&(bar)[XB_TMO], 1u); break; } } } } while (0)

struct XcdBarrier {
    unsigned* bar; unsigned x;
    volatile LAS unsigned* st;
};

__device__ __forceinline__ XcdBarrier xcd_barrier_post(unsigned* bar, volatile LAS unsigned* st) {
    XcdBarrier b; b.bar = bar; b.x = xb_xcc_id(); b.st = st;
    if (threadIdx.x == 0) (void)xb_add(&bar[XB_XCNT(b.x)], 1u);
    return b;
}
__device__ __forceinline__ void xcd_barrier_complete(unsigned* bar, unsigned x, unsigned& nloc, unsigned& nx) {
    const unsigned G = gridDim.x * gridDim.y * gridDim.z;
    unsigned sum, cnt, mine, sp = 0u;
    for (;;) {
        sum = 0u; cnt = 0u; mine = 0u;
#pragma unroll
        for (unsigned j = 0; j < 16; ++j) { const unsigned c = xb_ld(&bar[XB_XCNT(j)]); sum += c; cnt += (c > 0u) ? 1u : 0u; mine = (j == x) ? c : mine; }
        if (sum == G) break;
        __builtin_amdgcn_s_sleep(1);
        if ((++sp & 255u) == 0u) { if (xb_ld(&bar[XB_TMO])) break; if (sp > XB_SPIN_CAP) { atomicAdd(&bar[XB_TMO], 1u); break; } }
    }
    nloc = mine > 0u ? mine : 1u; nx = cnt > 0u ? cnt : 1u;
}

__device__ __forceinline__ void xcd_barrier(const XcdBarrier& b) {
    asm volatile("s_waitcnt vmcnt(0)" ::: "memory");
    __syncthreads();
    if (threadIdx.x == 0) {
        unsigned* bar = b.bar;
        __builtin_amdgcn_s_waitcnt(0);
        unsigned nloc = b.st[0], nx = b.st[1];
        if (nloc == 0u) { xcd_barrier_complete(bar, b.x, nloc, nx); b.st[0] = nloc; b.st[1] = nx; }
        const unsigned old = xb_add(&bar[XB_XSUB(b.x)], 1u);
        const unsigned gen = old / nloc;
        if (old + 1u == (gen + 1u) * nloc) {
            __builtin_amdgcn_fence(__ATOMIC_RELEASE, "agent");
            asm volatile("s_waitcnt vmcnt(0)" ::: "memory");
            const unsigned og = xb_add(&bar[XB_TOP], 1u);
            const unsigned tg = og / nx;
            if (og + 1u == (tg + 1u) * nx) xb_add(&bar[XB_TOPGEN], 1u);
            else XB_SPIN(xb_ld(&bar[XB_TOPGEN]) == tg, bar);
            __builtin_amdgcn_fence(__ATOMIC_ACQUIRE, "agent");
            xb_add(&bar[XB_XGEN(b.x)], 1u);
            asm volatile("s_waitcnt vmcnt(0)" ::: "memory");
        } else {
            XB_SPIN(xb_ld(&bar[XB_XGEN(b.x)]) == gen, bar);
            __builtin_amdgcn_fence(__ATOMIC_ACQUIRE, "agent");
            asm volatile("s_waitcnt vmcnt(0)" ::: "memory");
        }
    }
    __syncthreads();
}
namespace attn_body {
using bf16=__hip_bfloat16;
using bf16x8=__attribute__((ext_vector_type(8)))short;
using s16x4=__attribute__((ext_vector_type(4)))short;
using f32x16=__attribute__((ext_vector_type(16)))float;
using u32x4=__attribute__((ext_vector_type(4)))unsigned;
constexpr int BATCH=8,NHEAD=8,NKVH=2,SEQ=4096,D=64;
constexpr int DMQ=512,DMK=128,DMV=2048,DMO=1024;
constexpr int NW=8,QBLK=32,QB=QBLK*NW,KVBLK=64,NQB=SEQ/QB;
constexpr int ATTN_UNIT_ROWS=QB;
__device__ __forceinline__ int crow(int r,int hi){return (r&3)+8*(r>>2)+4*hi;}
#define SBAR() __builtin_amdgcn_sched_barrier(0)
__device__ __forceinline__ void cmask(f32x16&p0,f32x16&p1,int jb,int qrel,int hi){
  const float NEG=-INFINITY; int kb=64*jb+4*hi;
  #pragma unroll
  for(int r=0;r<16;++r){int kv=kb+(r&3)+8*(r>>2); if(kv>qrel)p0[r]=NEG; if(kv+32>qrel)p1[r]=NEG;}
}

constexpr int NSLOT=3, SLOTB=8192;
constexpr int LDS_K=0, LDS_V=NSLOT*SLOTB, LDS_WS=2*NSLOT*SLOTB, LDS_OST=LDS_WS+NW*64*4, LDS_BYTES=LDS_OST+NW*4096;
constexpr float C2=0.125f*1.4426950408889634f;
__device__ __forceinline__ void glds16(const void*gsrc,unsigned lds_dst){unsigned keep;
  asm volatile("s_mov_b32 %0, m0\n\ts_mov_b32 m0, %2\n\ts_nop 0\n\tglobal_load_lds_dwordx4 %1, off\n\ts_mov_b32 m0, %0":"=&s"(keep):"v"(gsrc),"s"(lds_dst):"memory");}
__device__ __forceinline__ float max3f(float a,float b,float c){float r;asm("v_max3_f32 %0, %1, %2, %3":"=v"(r):"v"(a),"v"(b),"v"(c));return r;}
__device__ __forceinline__ float max2f(float a,float b){float r;asm("v_max_f32_e32 %0, %1, %2":"=v"(r):"v"(a),"v"(b));return r;}
__device__ __forceinline__ float fadd_s(float a,float b){float r;asm("v_add_f32_e32 %0, %1, %2":"=v"(r):"v"(a),"v"(b));return r;}
__device__ __forceinline__ float fsub_s(float a,float b){float r;asm("v_sub_f32_e32 %0, %1, %2":"=v"(r):"v"(a),"v"(b));return r;}
typedef float f32x2_t __attribute__((ext_vector_type(2))); typedef __bf16 bf16x2_t __attribute__((ext_vector_type(2)));
__device__ __forceinline__ unsigned cvtpk_s(float lo,float hi){f32x2_t v={lo,hi};bf16x2_t b=__builtin_convertvector(v,bf16x2_t);return __builtin_bit_cast(unsigned,b);}
#define WAIT_BAR(N) asm volatile("s_waitcnt vmcnt(" #N ") lgkmcnt(0)\n\ts_barrier":::"memory")

__device__ __forceinline__ void qkt(f32x16&p0,f32x16&p1,const char*Kslot,const bf16x8*qr,const f32x16&negm,int r32,int hi){
  const char*kb=Kslot+hi*1024+r32*16;
  #pragma unroll
  for(int d0=0;d0<4;++d0){
    const bf16x8 b0=*reinterpret_cast<const bf16x8*>(kb+d0*2048);
    const bf16x8 b1=*reinterpret_cast<const bf16x8*>(kb+d0*2048+512);
    if(d0==0){p0=__builtin_amdgcn_mfma_f32_32x32x16_bf16(b0,qr[0],negm,0,0,0);p1=__builtin_amdgcn_mfma_f32_32x32x16_bf16(b1,qr[0],negm,0,0,0);}
    else{p0=__builtin_amdgcn_mfma_f32_32x32x16_bf16(b0,qr[d0],p0,0,0,0);p1=__builtin_amdgcn_mfma_f32_32x32x16_bf16(b1,qr[d0],p1,0,0,0);}}
}
typedef __attribute__((address_space(3))) const char* lds_cptr;
typedef short v4i16_t __attribute__((ext_vector_type(4)));
__device__ __forceinline__ void kload8(bf16x8*kf,lds_cptr kp){
  kf[0]=*(const __attribute__((address_space(3))) bf16x8*)(kp);      kf[1]=*(const __attribute__((address_space(3))) bf16x8*)(kp+512);
  kf[2]=*(const __attribute__((address_space(3))) bf16x8*)(kp+2048); kf[3]=*(const __attribute__((address_space(3))) bf16x8*)(kp+2560);
  kf[4]=*(const __attribute__((address_space(3))) bf16x8*)(kp+4096); kf[5]=*(const __attribute__((address_space(3))) bf16x8*)(kp+4608);
  kf[6]=*(const __attribute__((address_space(3))) bf16x8*)(kp+6144); kf[7]=*(const __attribute__((address_space(3))) bf16x8*)(kp+6656);
}
__device__ __forceinline__ void kload2(bf16x8*kf,lds_cptr kp,int j){ kf[2*j]=*(const __attribute__((address_space(3))) bf16x8*)(kp+j*2048); kf[2*j+1]=*(const __attribute__((address_space(3))) bf16x8*)(kp+j*2048+512); }
__device__ __forceinline__ s16x4 vtr(lds_cptr p){ return __builtin_bit_cast(s16x4,__builtin_amdgcn_ds_read_tr16_b64_v4i16((__attribute__((address_space(3))) v4i16_t*)p)); }
__device__ __forceinline__ float rowmax(const f32x16&p0,const f32x16&p1){
  float a=max3f(p0[0],p0[1],p1[0]),b=max3f(p0[2],p0[3],p1[1]);a=max3f(a,p1[2],p1[3]);
  #pragma unroll
  for(int r=4;r<16;r+=4){a=max3f(a,p0[r],p0[r+1]);b=max3f(b,p0[r+2],p0[r+3]);a=max3f(a,p1[r],p1[r+1]);b=max3f(b,p1[r+2],p1[r+3]);}
  const float m=max2f(a,b);
  auto rr=__builtin_amdgcn_permlane32_swap(__float_as_uint(m),__float_as_uint(m),false,false);
  return max2f(__uint_as_float(rr[0]),__uint_as_float(rr[1]));
}
__device__ __forceinline__ void pv(f32x16*o,int vb,bf16x8 pa0,bf16x8 pa1,bf16x8 pa2,bf16x8 pa3){
  #pragma unroll
  for(int d0=0;d0<2;++d0){s16x4 lo[4],hi[4];
    #pragma unroll
    for(int ks=0;ks<4;++ks){
      asm volatile("ds_read_b64_tr_b16 %0,%1 offset:%c2":"=&v"(lo[ks]):"v"(vb),"i"(d0*4096+ks*1024):"memory");
      asm volatile("ds_read_b64_tr_b16 %0,%1 offset:%c2":"=&v"(hi[ks]):"v"(vb),"i"(d0*4096+ks*1024+512):"memory");}
    asm volatile("s_waitcnt lgkmcnt(0)":::"memory");SBAR();
    #define PK(k) (bf16x8){lo[k][0],lo[k][1],lo[k][2],lo[k][3],hi[k][0],hi[k][1],hi[k][2],hi[k][3]}
    o[d0]=__builtin_amdgcn_mfma_f32_32x32x16_bf16(pa0,PK(0),o[d0],0,0,0);
    o[d0]=__builtin_amdgcn_mfma_f32_32x32x16_bf16(pa1,PK(1),o[d0],0,0,0);
    o[d0]=__builtin_amdgcn_mfma_f32_32x32x16_bf16(pa2,PK(2),o[d0],0,0,0);
    o[d0]=__builtin_amdgcn_mfma_f32_32x32x16_bf16(pa3,PK(3),o[d0],0,0,0);
    #undef PK
  }
}

#ifndef ATTN_STORE16
#define ATTN_STORE16(p,v) (*(u32x4*)(p)=(v))
#endif
template<int THRL> __device__ __forceinline__ void attn_unit(int b,int h,int qb,const bf16*Q,const bf16*__restrict__ K,const bf16*__restrict__ V,bf16*O,char*shm){
  int tid_=threadIdx.x; asm volatile("":"+v"(tid_)); const int tid=tid_,lane=tid&63,r32=lane&31,hi=lane>>5; const int wid=__builtin_amdgcn_readfirstlane(tid>>6);
  const long rowbase=(long)b*SEQ; const int q0=qb*QB;
  const bf16*Qw=Q+(rowbase+q0+wid*QBLK)*DMQ+h*D; const int kvh=h>>2;
  const bf16*Kh=K+rowbase*DMK+kvh*D,*Vh=V+rowbase*DMV+kvh*D;
  const unsigned lds0=(unsigned)(uintptr_t)shm;
  float*wsf=(float*)(shm+LDS_WS)+wid*64;
  const bf16*ksrc=Kh+(long)lane*DMK+wid*8;
  const bf16*vsrc=Vh+(long)(16*(wid&3)+(lane>>2))*DMV+(wid>>2)*32+(lane&3)*8;
  const unsigned kdst=lds0+LDS_K+wid*1024, vdst=lds0+LDS_V+wid*1024;
  #define DMA_K(t,slot) glds16(ksrc+(long)(t)*KVBLK*DMK,(unsigned)__builtin_amdgcn_readfirstlane(kdst+(slot)))
  #define DMA_V(t,slot) glds16(vsrc+(long)(t)*KVBLK*DMV,(unsigned)__builtin_amdgcn_readfirstlane(vdst+(slot)))
  const int vb0=(int)(lds0+LDS_V)+((lane>>4)&1)*32+(lane&3)*8+(4*hi+((lane&15)>>2))*64;
  const char*Kbase=shm+LDS_K; bf16x8 kf[8];
  const lds_cptr shm3=(lds_cptr)shm; const lds_cptr kp0=shm3+LDS_K+hi*1024+r32*16; const lds_cptr vp0=shm3+LDS_V+((lane>>4)&1)*32+(lane&3)*8+(4*hi+((lane&15)>>2))*64;
  constexpr int NT=SEQ/KVBLK;
  DMA_K(0,0);DMA_V(0,0);DMA_K(1,SLOTB);
  bf16x8 qr[4];
  #pragma unroll
  for(int d0=0;d0<4;++d0)qr[d0]=*reinterpret_cast<const bf16x8*>(&Qw[(long)r32*DMQ+d0*16+hi*8]);
  float mhat=0.f,l_reg=0.f;f32x16 o[2];o[0]=f32x16{};o[1]=f32x16{};f32x16 negm=f32x16{};asm volatile("":"+v"(negm));
  #define CMASK(P0,P1,t) do{}while(0)
  bool resc=false;
  #define START(P0,P1) do{ const float rm=rowmax(P0,P1); resc=false; \
    { const float dl=rm; mhat=fadd_s(mhat,dl); \
      _Pragma("unroll") for(int r=0;r<16;++r){P0[r]=fsub_s(P0[r],dl);P1[r]=fsub_s(P1[r],dl);} \
      _Pragma("unroll") for(int r=0;r<16;++r)negm[r]=-mhat; asm volatile("":"+v"(negm)); } \
    _Pragma("unroll") for(int r=0;r<16;++r)P0[r]=__builtin_amdgcn_exp2f(P0[r]); }while(0)
  #define RESC() do{ if(resc){ asm volatile("s_waitcnt lgkmcnt(0)":::"memory"); \
      _Pragma("unroll") for(int d_=0;d_<2;++d_) _Pragma("unroll") for(int r=0;r<16;++r)o[d_][r]*=wsf[crow(r,hi)]; } }while(0)
  f32x16 pA0,pA1,pB0,pB1;
  int sl_prev=0,sl_cur=0,sl_next=SLOTB;
  #define ROT() do{sl_prev=sl_cur;sl_cur=sl_next;sl_next=(sl_next==(NSLOT-1)*SLOTB)?0:sl_next+SLOTB;}while(0)
  DMA_K(2,2*SLOTB);
  WAIT_BAR(3);
  qkt(pA0,pA1,Kbase,qr,negm,r32,hi);asm volatile("s_nop 15\n\ts_nop 7":"+v"(pA0),"+v"(pA1));CMASK(pA0,pA1,0);
  START(pA0,pA1);
  _Pragma("unroll") for(int r=0;r<16;++r)pA1[r]=__builtin_amdgcn_exp2f(pA1[r]);
  WAIT_BAR(0);
  DMA_K(3,0);DMA_V(1,SLOTB);
  ROT();
  kload8(kf,kp0+sl_cur);
  WAIT_BAR(2);
  s16x4 vlo[8],vhi[8]; u32x4 pw0,pw1,pw2,pw3;
  #define PKW(P,B) cvtpk_s(P[B],P[B+1])
  #define PAF(k) __builtin_bit_cast(bf16x8,pw##k)
  #define VFR(i) (bf16x8){vlo[i][0],vlo[i][1],vlo[i][2],vlo[i][3],vhi[i][0],vhi[i][1],vhi[i][2],vhi[i][3]}
  #define PIN(x) asm volatile("":"+v"(x))
  #define MX3(a,b,c) __builtin_fmaxf(__builtin_fmaxf((a),(b)),(c))
  #define GAPA(MF,A0,A1,A2,A3,W0,W1,PW) do{ MF; sacc+=A0; sacc+=A1; sacc+=A2; sacc+=A3; PIN(sacc); W0; W1; PIN(PW); SBAR(); }while(0)
  #define EX(v) __builtin_amdgcn_exp2f(v)
  #define GAPB(MF,X,B) do{ MF; X[B]=EX(X[B]); X[B+1]=EX(X[B+1]); X[B+2]=EX(X[B+2]); X[B+3]=EX(X[B+3]); PIN(X); SBAR(); }while(0)
  #define VRD(i) do{ vlo[i]=vtr(vp_+(((i)>>2)*4096+((i)&3)*1024)); vhi[i]=vtr(vp_+(((i)>>2)*4096+((i)&3)*1024+512)); }while(0)
  #define KRD(G,j) do{ if(G){ kload2(kf,kp0+sl_next,j); SBAR(); } }while(0)
  #define STEP(C0,C1,P0,P1,t,GK,GV,GL) do{ SBAR(); \
    const lds_cptr vp_=vp0+sl_prev; \
    VRD(0); SBAR(); float sacc=(P0[0]+P0[1]); \
    GAPA(C0=__builtin_amdgcn_mfma_f32_32x32x16_bf16(kf[0],qr[0],negm,0,0,0), P0[2],P0[3],P0[4],P0[5],     pw0[0]=PKW(P0,0), pw0[1]=PKW(P0,2), pw0); \
    VRD(4); SBAR(); GAPA(C1=__builtin_amdgcn_mfma_f32_32x32x16_bf16(kf[1],qr[0],negm,0,0,0), P0[6],P0[7],P0[8],P0[9],     pw0[2]=PKW(P0,4), pw0[3]=PKW(P0,6), pw0); \
    VRD(1); SBAR(); GAPA(C0=__builtin_amdgcn_mfma_f32_32x32x16_bf16(kf[2],qr[1],C0,0,0,0),   P0[10],P0[11],P0[12],P0[13], pw1[0]=PKW(P0,8), pw1[1]=PKW(P0,10), pw1); \
    VRD(5); SBAR(); GAPA(C1=__builtin_amdgcn_mfma_f32_32x32x16_bf16(kf[3],qr[1],C1,0,0,0),   P0[14],P0[15],P1[0],P1[1],   pw1[2]=PKW(P0,12),pw1[3]=PKW(P0,14), pw1); \
    VRD(2); SBAR(); GAPA(C0=__builtin_amdgcn_mfma_f32_32x32x16_bf16(kf[4],qr[2],C0,0,0,0),   P1[2],P1[3],P1[4],P1[5],     pw2[0]=PKW(P1,0), pw2[1]=PKW(P1,2), pw2); \
    VRD(6); SBAR(); GAPA(C1=__builtin_amdgcn_mfma_f32_32x32x16_bf16(kf[5],qr[2],C1,0,0,0),   P1[6],P1[7],P1[8],P1[9],     pw2[2]=PKW(P1,4), pw2[3]=PKW(P1,6), pw2); \
    VRD(3); SBAR(); GAPA(C0=__builtin_amdgcn_mfma_f32_32x32x16_bf16(kf[6],qr[3],C0,0,0,0),   P1[10],P1[11],P1[12],P1[13], pw3[0]=PKW(P1,8), pw3[1]=PKW(P1,10), pw3); \
    VRD(7); SBAR(); GAPA(C1=__builtin_amdgcn_mfma_f32_32x32x16_bf16(kf[7],qr[3],C1,0,0,0),   P1[14],P1[15],0.f,0.f,       pw3[2]=PKW(P1,12),pw3[3]=PKW(P1,14), pw3); \
    l_reg+=sacc; \
    if(GK){DMA_K((t)+3,sl_cur);} if(GV){DMA_V((t)+1,sl_next);} \
    CMASK(C0,C1,t); \
    { float a=MX3(C0[0],C0[1],C1[0]),b=MX3(C0[2],C0[3],C1[1]); a=MX3(a,C1[2],C1[3]); \
      _Pragma("unroll") for(int r=4;r<16;r+=4){a=MX3(a,C0[r],C0[r+1]);b=MX3(b,C0[r+2],C0[r+3]);a=MX3(a,C1[r],C1[r+1]);b=MX3(b,C1[r+2],C1[r+3]);} \
      float rm=__builtin_fmaxf(a,b); { auto rr=__builtin_amdgcn_permlane32_swap(__float_as_uint(rm),__float_as_uint(rm),false,false); rm=__builtin_fmaxf(__uint_as_float(rr[0]),__uint_as_float(rr[1])); } \
      resc=false; \
      if(__builtin_expect(__any(rm>(float)THRL),0)){ const float dl=__builtin_fmaxf(rm,0.f); mhat+=dl; \
        _Pragma("unroll") for(int r=0;r<16;++r){C0[r]-=dl;C1[r]-=dl;} \
        _Pragma("unroll") for(int r=0;r<16;++r)negm[r]=-mhat; asm volatile("":"+v"(negm)); \
        const float f=__builtin_amdgcn_exp2f(-dl); l_reg*=f; if(hi==0)wsf[r32]=f; resc=true; } } \
    SBAR(); \
    GAPB(o[0]=__builtin_amdgcn_mfma_f32_32x32x16_bf16(PAF(0),VFR(0),o[0],0,0,0), C0,0); \
    GAPB(o[1]=__builtin_amdgcn_mfma_f32_32x32x16_bf16(PAF(0),VFR(4),o[1],0,0,0), C0,4); \
    KRD(GL,0); GAPB(o[0]=__builtin_amdgcn_mfma_f32_32x32x16_bf16(PAF(1),VFR(1),o[0],0,0,0), C0,8); \
    KRD(GL,1); GAPB(o[1]=__builtin_amdgcn_mfma_f32_32x32x16_bf16(PAF(1),VFR(5),o[1],0,0,0), C0,12); \
    KRD(GL,2); GAPB(o[0]=__builtin_amdgcn_mfma_f32_32x32x16_bf16(PAF(2),VFR(2),o[0],0,0,0), C1,0); \
    KRD(GL,3); GAPB(o[1]=__builtin_amdgcn_mfma_f32_32x32x16_bf16(PAF(2),VFR(6),o[1],0,0,0), C1,4); \
    GAPB(o[0]=__builtin_amdgcn_mfma_f32_32x32x16_bf16(PAF(3),VFR(3),o[0],0,0,0), C1,8); \
    GAPB(o[1]=__builtin_amdgcn_mfma_f32_32x32x16_bf16(PAF(3),VFR(7),o[1],0,0,0), C1,12); \
    }while(0)
  int t=1;
  #undef CMASK
  #define CMASK(P0,P1,t) do{}while(0)
  for(;t+5<NT;t+=2){
    STEP(pB0,pB1,pA0,pA1,t,true,true,true);     WAIT_BAR(2); RESC(); ROT();
    STEP(pA0,pA1,pB0,pB1,t+1,true,true,true);   WAIT_BAR(2); RESC(); ROT();
  }
  #undef CMASK
  #define CMASK(P0,P1,t) do{}while(0)
  #define ENDW(tt) do{ if((tt)+3<NT){WAIT_BAR(2);} else if((tt)+2<NT){WAIT_BAR(1);} else {WAIT_BAR(0);} }while(0)
  for(;t+1<NT;t+=2){
    STEP(pB0,pB1,pA0,pA1,t,(t+3<NT),(t+1<NT),(t+1<NT));       ENDW(t);   RESC(); ROT();
    STEP(pA0,pA1,pB0,pB1,t+1,(t+4<NT),(t+2<NT),(t+2<NT));     ENDW(t+1); RESC(); ROT();
  }
  STEP(pB0,pB1,pA0,pA1,NT-1,false,false,false); RESC();
  { float sacc=pB0[0]+pB0[1]; _Pragma("unroll") for(int r=2;r<16;++r)sacc+=pB0[r]; _Pragma("unroll") for(int r=0;r<16;++r)sacc+=pB1[r]; l_reg+=sacc;
    pw0=(u32x4){PKW(pB0,0),PKW(pB0,2),PKW(pB0,4),PKW(pB0,6)};pw1=(u32x4){PKW(pB0,8),PKW(pB0,10),PKW(pB0,12),PKW(pB0,14)};pw2=(u32x4){PKW(pB1,0),PKW(pB1,2),PKW(pB1,4),PKW(pB1,6)};pw3=(u32x4){PKW(pB1,8),PKW(pB1,10),PKW(pB1,12),PKW(pB1,14)};
    SBAR(); pv(o,vb0+sl_cur,PAF(0),PAF(1),PAF(2),PAF(3)); }
  #undef PKW
  #undef PAF
  #undef VFR
  #undef PIN
  #undef MX3
  #undef GAPA
  #undef GAPB
  #undef EX
  #undef VRD
  #undef KRD
  #undef STEP
  #undef ENDW
  {auto rr=__builtin_amdgcn_permlane32_swap(__float_as_uint(l_reg),__float_as_uint(l_reg),false,false);l_reg=__uint_as_float(rr[0])+__uint_as_float(rr[1]);}
  if(hi==0)wsf[32+r32]=l_reg;asm volatile("s_waitcnt lgkmcnt(0)":::"memory");
  float rli[16];
  #pragma unroll
  for(int r=0;r<16;++r)rli[r]=__builtin_amdgcn_rcpf(wsf[32+crow(r,hi)]);
  bf16*Ow=O+(rowbase+q0+wid*QBLK)*DMO+h*D;
  { bf16*stg=(bf16*)(shm+LDS_OST)+wid*2048;
    #pragma unroll
    for(int r=0;r<16;++r){const int orow=crow(r,hi);
      #pragma unroll
      for(int d0=0;d0<2;++d0)stg[orow*64+d0*32+r32]=__float2bfloat16(o[d0][r]*rli[r]);}
    asm volatile("s_waitcnt lgkmcnt(0)":::"memory");
    #pragma unroll
    for(int i=0;i<4;++i){const int row=i*8+(lane>>3),ch=lane&7; const u32x4 v=*(const u32x4*)(stg+row*64+ch*8); ATTN_STORE16(Ow+(long)row*DMO+ch*8,v);} }
  asm volatile("s_waitcnt lgkmcnt(0)\n\ts_barrier":::"memory");
  #undef DMA_K
  #undef DMA_V
  #undef CMASK
  #undef START
  #undef RESC
  #undef ROT
}
constexpr int ATTN_LDS_BYTES=LDS_BYTES;
struct AttnTensors { const bf16* Q; const bf16* K; const bf16* V; bf16* O; };
struct AttnUnit { int bh; int qb; };
struct StaticOrder {
  int vcu, G;
  __device__ __forceinline__ explicit StaticOrder(int grid,int block):vcu((grid%8==0)?(block%8)*(grid/8)+block/8:block),G(grid){}
  __device__ __forceinline__ bool next(int i,AttnUnit&u)const{ const int per=(BATCH*NHEAD*NQB+G-1)/G; if(i>=per)return false; const int idx=vcu*per+i; if(idx>=BATCH*NHEAD*NQB)return false;
    const int qb=idx%NQB, hq=(idx/NQB)&3, bk=idx/(NQB*4), kvh=bk&1, b=bk>>1; u.bh=b*NHEAD+kvh*4+hq; u.qb=qb; return true; }
  __device__ __forceinline__ void a_ready(const AttnUnit&)const{}
  __device__ __forceinline__ void done(const AttnUnit&)const{}
};
template<class Sched,int THRL=8> __device__ __forceinline__ void attn_phase(char*lds,const AttnTensors&T,const Sched&S){
  AttnUnit u;
  for(int i=0;S.next(i,u);++i){ S.a_ready(u); attn_unit<THRL>(u.bh/NHEAD,u.bh%NHEAD,u.qb,T.Q,T.K,T.V,T.O,lds); S.done(u); }
}
#undef SBAR
#undef WAIT_BAR
}
constexpr int NB = 8, SEQ = 4096, DM = 1024, NL = 4, NTOK = NB * SEQ;
constexpr int INW = 1824, INP = 2048;
constexpr int C_AQ = 0, C_AK = 512, C_AV = 640, C_GQ = 768, C_GK = 896, C_GV = 1024, C_GR = 1280, C_FX = 1536, C_GLR = 1792;
constexpr int NE = 32, TOPK = 4, DE = 1024;
constexpr int MPAD = NTOK * TOPK + NE * 256;
constexpr float LN_EPS = 1e-5f, RMS_EPS = 1e-6f;
constexpr float DN_ALPHA = 1.681792830507429f;
constexpr float QSCALE = 0.125f * 1.4426950408889634f;
constexpr float GLA_QSCALE = 0.17677669529663687f;

constexpr size_t MiB = 1u << 20;
constexpr size_t WS_CTL = 0, CTL_ZERO_BYTES = 1 * MiB;
constexpr size_t WS_ROPE = 1 * MiB;
constexpr size_t WS_WIN_T = 2 * MiB;
constexpr size_t WS_WOUT_T = 18 * MiB;
constexpr size_t WS_FTAB = 26 * MiB;
constexpr size_t WS_TW = WS_FTAB + 65536;
constexpr size_t WS_FTMP = 27 * MiB;
constexpr size_t WS_WGU_T = 90 * MiB;
constexpr size_t WS_WDN_T = 602 * MiB;
constexpr size_t WS_HF = 858 * MiB;
constexpr size_t WS_HB = 986 * MiB;
constexpr size_t WS_PROJ = 1050 * MiB;
constexpr size_t WS_QB = 1178 * MiB;
constexpr size_t WS_KB = 1210 * MiB;
constexpr size_t WS_MIX = 1218 * MiB;
constexpr size_t WS_T1 = 1282 * MiB;
constexpr size_t WS_UVT = 1410 * MiB;
constexpr size_t WS_LA = 1442 * MiB;
constexpr size_t WS_OF = 1474 * MiB;
constexpr size_t WS_OB = 1506 * MiB;
constexpr size_t WS_TOK = 1538 * MiB;
constexpr size_t WS_XS = 1542 * MiB;
constexpr size_t WS_HID = 1814 * MiB;
constexpr size_t WS_YS = 2086 * MiB;
constexpr size_t WS_END = 2358 * MiB;
static_assert((size_t)MPAD * 2048 == 272 * MiB, "sorted buffers");
constexpr int CW_TMO = 0, CW_CODE = 1, CW_BAR = 4096, CW_CNT = 8192;

constexpr int RING_OFF = 0, RING_BYTES = 131072;
constexpr int LDSCTL_OFF = RING_BYTES;
constexpr int LDS_BYTES = 163840;
constexpr int LC_MISC = 0;
constexpr int LC_PSTART = 128;
constexpr int LC_ULIST = 384;
constexpr int LC_CNT = 640;
constexpr int LC_BASE = 768;
constexpr int LC_SELE = 1024;
constexpr int LC_SELS = 1024 + 2048;
constexpr int LC_COS64 = 5120;
constexpr int LC_ROWS = 6144;
constexpr int LC_LG = 16384;

constexpr int NWAVES = 8;
constexpr int N_PHASES = 1 + 10 * NL;

typedef float f32x2_t __attribute__((ext_vector_type(2))); typedef __bf16 bf16x2_t __attribute__((ext_vector_type(2)));
__device__ __forceinline__ unsigned cvtpk2(float lo, float hi) { f32x2_t v = {lo, hi}; bf16x2_t b = __builtin_convertvector(v, bf16x2_t); return __builtin_bit_cast(unsigned, b); }
#define pk2(lo, hi) cvtpk2((lo), (hi))
#define f2bf(x) (cvtpk2((x), 0.f) & 0xffffu)
__device__ __forceinline__ float bf2f(unsigned short b) { return __uint_as_float((unsigned)b << 16); }
__device__ __forceinline__ float wave_sum(float v) {
#pragma unroll
    for (int o = 1; o < 64; o <<= 1) v += __shfl_xor(v, o);
    return v;
}
typedef unsigned short u16x8 __attribute__((ext_vector_type(8)));
typedef unsigned short u16x4 __attribute__((ext_vector_type(4)));

typedef float f32x2v __attribute__((ext_vector_type(2)));
__device__ __forceinline__ void tr_task(const float* W, int K, int Nsrc, int srcn, bf16* WT, int dst_n, int k0) {
#pragma unroll 1
    for (int hf = 0; hf < 2; ++hf) { const int kk = k0 + hf * 64; f32x2v v[64];
        if (srcn >= 0) { const float* p = W + (size_t)kk * Nsrc + srcn;
#pragma unroll
            for (int i = 0; i < 64; ++i) v[i] = __builtin_nontemporal_load((const f32x2v*)(p + (size_t)i * Nsrc)); }
        else {
#pragma unroll
            for (int i = 0; i < 64; ++i) v[i] = (f32x2v){0.f, 0.f}; }
        bf16* o0 = WT + (size_t)dst_n * K + kk; bf16* o1 = o0 + K;
#pragma unroll
        for (int j = 0; j < 8; ++j) { v4u w0, w1;
            w0.x = pk2(v[8 * j].x, v[8 * j + 1].x); w0.y = pk2(v[8 * j + 2].x, v[8 * j + 3].x); w0.z = pk2(v[8 * j + 4].x, v[8 * j + 5].x); w0.w = pk2(v[8 * j + 6].x, v[8 * j + 7].x);
            w1.x = pk2(v[8 * j].y, v[8 * j + 1].y); w1.y = pk2(v[8 * j + 2].y, v[8 * j + 3].y); w1.z = pk2(v[8 * j + 4].y, v[8 * j + 5].y); w1.w = pk2(v[8 * j + 6].y, v[8 * j + 7].y);
            *(v4u*)(o0 + 8 * j) = w0; *(v4u*)(o1 + 8 * j) = w1; } }
}

__device__ __forceinline__ void ln_row(f32x4 (&v)[4], const float* g, const float* bt, float* of32, bf16* obf, int lane) {
    float s = 0.f;
#pragma unroll
    for (int j = 0; j < 4; ++j) s += (v[j].x + v[j].y) + (v[j].z + v[j].w);
    const float mean = wave_sum(s) * (1.f / DM); float s2 = 0.f;
#pragma unroll
    for (int j = 0; j < 4; ++j) { v[j] = v[j] - mean; s2 += (v[j].x * v[j].x + v[j].y * v[j].y) + (v[j].z * v[j].z + v[j].w * v[j].w); }
    const float rstd = 1.f / sqrtf(wave_sum(s2) * (1.f / DM) + LN_EPS);
#pragma unroll
    for (int j = 0; j < 4; ++j) { const f32x4 gg = *(const f32x4*)(g + lane * 4 + 256 * j), bb = *(const f32x4*)(bt + lane * 4 + 256 * j);
        v[j] = v[j] * rstd * gg + bb;
        if (of32) *(f32x4*)(of32 + lane * 4 + 256 * j) = v[j];
        if (obf) *(unsigned long long*)(obf + lane * 4 + 256 * j) = (unsigned long long)pk2(v[j].x, v[j].y) | ((unsigned long long)pk2(v[j].z, v[j].w) << 32); }
}


constexpr int GM_QF = 0, GM_KF = 5120, GM_QB = 10240, GM_KB = 15360, GM_VT = 20480, GM_P = 29696, GM_HTF = 38912, GM_HTB = 44032, GM_DL = 38912, GM_SLOT = 49152;
static_assert(2 * GM_SLOT <= RING_BYTES, "two GLA chunk images fit the phase scratch");
#define MFMA16(a, b, c) __builtin_amdgcn_mfma_f32_16x16x32_bf16((a), (b), (c), 0, 0, 0)
template <bool OUT>
__device__ __forceinline__ void gla_stage_mfma(LAS unsigned char* Ls, const bf16* PROJ, const float* LA, const float* HIN, size_t tok0, int hd, int w4, int lane) {
    if (w4 < 2) { const int dir = lane >> 5, d = lane & 31; float bc[64]; unsigned short x[64];
        const float* lap = LA + tok0 * 256 + dir * 128 + hd * 32 + d; const bf16* xp = PROJ + tok0 * INP + (w4 == 0 ? C_GQ : C_GK) + hd * 32 + d;
#pragma unroll
        for (int j = 0; j < 64; ++j) { bc[j] = lap[(size_t)j * 256]; x[j] = xp[(size_t)j * INP]; }
        float acc = 0.f;
        if (dir == 0) {
#pragma unroll
            for (int j = 0; j < 64; ++j) { acc += bc[j]; bc[j] = acc; } }
        else {
#pragma unroll
            for (int j = 63; j >= 0; --j) { acc += bc[j]; bc[j] = acc; } }
        if (w4 == 0) { LAS bf16* dst = (LAS bf16*)(Ls + (dir ? GM_QB : GM_QF)) + d;
#pragma unroll
            for (int j = 0; j < 64; ++j) dst[j * 40] = (bf16)f2bf(bf2f(x[j]) * GLA_QSCALE * expf(bc[j])); }
        else if (OUT) { LAS bf16* dst = (LAS bf16*)(Ls + (dir ? GM_KB : GM_KF)) + d;
#pragma unroll
            for (int j = 0; j < 64; ++j) dst[j * 40] = (bf16)f2bf(bf2f(x[j]) * expf(-bc[j])); }
        else { LAS bf16* dst = (LAS bf16*)(Ls + GM_P + dir * 4608) + d * 72;
#pragma unroll
            for (int j8 = 0; j8 < 8; ++j8) { float t[8];
#pragma unroll
                for (int i = 0; i < 8; ++i) t[i] = bf2f(x[j8 * 8 + i]) * expf(-bc[j8 * 8 + i]);
                v4u w; w.x = pk2(t[0], t[1]); w.y = pk2(t[2], t[3]); w.z = pk2(t[4], t[5]); w.w = pk2(t[6], t[7]); *(LAS v4u*)(dst + j8 * 8) = w; }
            ((LAS float*)(Ls + GM_DL))[lane] = expf(acc); } }
    else if (w4 == 2) { unsigned short x[64]; const bf16* xp = PROJ + tok0 * INP + C_GV + hd * 64 + lane;
#pragma unroll
        for (int j = 0; j < 64; ++j) x[j] = xp[(size_t)j * INP];
        LAS bf16* dst = (LAS bf16*)(Ls + GM_VT) + lane * 72;
#pragma unroll
        for (int j8 = 0; j8 < 8; ++j8) { v4u w; w.x = (unsigned)x[j8 * 8] | ((unsigned)x[j8 * 8 + 1] << 16); w.y = (unsigned)x[j8 * 8 + 2] | ((unsigned)x[j8 * 8 + 3] << 16); w.z = (unsigned)x[j8 * 8 + 4] | ((unsigned)x[j8 * 8 + 5] << 16); w.w = (unsigned)x[j8 * 8 + 6] | ((unsigned)x[j8 * 8 + 7] << 16);
            *(LAS v4u*)(dst + j8 * 8) = w; } }
    else if (OUT) {
#pragma unroll
        for (int dir = 0; dir < 2; ++dir) { const f32x4* src = (const f32x4*)(HIN + ((size_t)dir * 64 + lane) * 32); LAS bf16* dst = (LAS bf16*)(Ls + (dir ? GM_HTB : GM_HTF)) + lane * 40;
#pragma unroll
            for (int c8 = 0; c8 < 4; ++c8) { const f32x4 a_ = src[2 * c8], b_ = src[2 * c8 + 1]; v4u w; w.x = pk2(a_.x, a_.y); w.y = pk2(a_.z, a_.w); w.z = pk2(b_.x, b_.y); w.w = pk2(b_.z, b_.w); *(LAS v4u*)(dst + c8 * 8) = w; } } }
}

typedef float f32x16 __attribute__((ext_vector_type(16)));
typedef short s16x4 __attribute__((ext_vector_type(4)));
__device__ __forceinline__ bf16x8 pack_step(const f32x16& x, int s) { v4u p; p.x = cvtpk2(x[8 * s], x[8 * s + 1]); p.y = cvtpk2(x[8 * s + 2], x[8 * s + 3]); p.z = cvtpk2(x[8 * s + 4], x[8 * s + 5]); p.w = cvtpk2(x[8 * s + 6], x[8 * s + 7]); return __builtin_bit_cast(bf16x8, p); }
__device__ __forceinline__ int crow16(int i, int h) { return (i & 3) + 8 * (i >> 2) + 4 * h; }
#define MFMA32(a, b, c) __builtin_amdgcn_mfma_f32_32x32x16_bf16((a), (b), (c), 0, 0, 0)
constexpr int FT_PITCH = 72, FT_TAB = 64 * FT_PITCH;
constexpr int FFT_LDS_TAB = 0, FFT_LDS_TW = 28672, FFT_LDS_HT = 28672, FFT_HT_PAIR = 2 * 64 * FT_PITCH * 2;

struct Args { const float* in[20]; float* out; unsigned char* ws; int ph_lo, ph_hi; };
static_assert(sizeof(Args) == 20 * 8 + 8 + 8 + 8, "no padding bytes in Args");


typedef __attribute__((address_space(4))) const unsigned char* kptr_t;
__device__ __forceinline__ kptr_t karg() { kptr_t p = (kptr_t)__builtin_amdgcn_kernarg_segment_ptr(); asm volatile("" : "+s"(p)); return p; }
#define KIN(i) (*(const float* const __attribute__((address_space(4)))*)(karg() + 8 * (i)))
#define KOUT() (*(float* const __attribute__((address_space(4)))*)(karg() + 160))
#define KWS() (*(unsigned char* const __attribute__((address_space(4)))*)(karg() + 168))
#define WSP(T, off) ((T*)(ws + (off)))

#ifndef NAIVE_ATTN
#define NAIVE_ATTN 0
#endif

__global__ void __launch_bounds__(NWAVES * 64, 2) fwd(Args args) {
    extern __shared__ __attribute__((aligned(16))) unsigned char lds_raw[];
    LAS unsigned char* lds = (LAS unsigned char*)lds_raw;
    LAS unsigned char* lctl = lds + LDSCTL_OFF;
    const int G = gridDim.x, bx = blockIdx.x;
    const int NGW = G * NWAVES, NGT = G * NWAVES * 64;
#define TID_SETUP() int tid_ = threadIdx.x; asm volatile("" : "+v"(tid_)); const int tid = tid_, lane = tid & 63, wave = __builtin_amdgcn_readfirstlane(tid >> 6); \
    const int gw = bx * NWAVES + wave, gt = bx * (NWAVES * 64) + tid; (void)lane; (void)gw; (void)gt
    for (int u = threadIdx.x; u < (LDS_BYTES - LDSCTL_OFF) / 4; u += NWAVES * 64) ((LAS unsigned*)lctl)[u] = 0u;
    __syncthreads();
    volatile LAS unsigned* MISC = (volatile LAS unsigned*)(lctl + LC_MISC);
    XcdBarrier bar = xcd_barrier_post((unsigned*)(KWS() + WS_CTL) + CW_BAR, MISC + 8);
    const int lo = args.ph_lo, hi = args.ph_hi;
#ifndef PH_OFF
#define PH_OFF 0
#endif
#define PON(j) (!((PH_OFF >> (j)) & 1))
#define IN(k) (lo <= (k) && (k) < hi)
#ifndef PROBE_A
#define PROBE_A -1
#endif
#ifndef PROBE_B
#define PROBE_B -1
#endif
#if PROBE_A >= 0
#define STAMP(k) do { if (blockIdx.x == 0 && threadIdx.x == 0) { ((unsigned long long*)(KWS() + WS_CTL + 65536))[(k)] = __builtin_amdgcn_s_memrealtime(); } } while (0)
#else
#define STAMP(k) do {} while (0)
#endif
#define SEAM(k) do { if (IN(k) && IN((k) + 1)) xcd_barrier(bar); STAMP((k) + 1); } while (0)
    STAMP(0);

    if (IN(0) && PON(0)) {
        TID_SETUP(); unsigned char* ws = KWS(); const float* x_in = KIN(0); const float* ln_in_g = KIN(1); const float* ln_in_b = KIN(2); const float* w_in = KIN(3); const float* w_out = KIN(9);
        const float* exp_w_gu = KIN(14); const float* exp_w_down = KIN(16);
        float* ROPE = WSP(float, WS_ROPE); bf16* WIN_T = WSP(bf16, WS_WIN_T); bf16* WOUT_T = WSP(bf16, WS_WOUT_T); bf16* WGU_T = WSP(bf16, WS_WGU_T); bf16* WDN_T = WSP(bf16, WS_WDN_T);
        float* HF = WSP(float, WS_HF); bf16* HB = WSP(bf16, WS_HB);
        constexpr int I_WIN = NL * 16 * 8, I_WOUT = NL * 8 * 8, I_WGU = NL * NE * 16 * 8, I_WDN = NL * NE * 8 * 8;
        constexpr int NTASK = I_WIN + I_WOUT + I_WGU + I_WDN;
        { const int t_lo = (int)(((long)gw * NTASK) / NGW), t_hi = (int)(((long)(gw + 1) * NTASK) / NGW);
          for (int it = t_lo; it < t_hi; ++it) {
            int r = it;
            if (r < I_WIN) { const int l = r / 128, q = r % 128, nb = q / 8, k8 = q % 8, n = nb * 128 + 2 * lane;
                const int src = n < 1536 ? n : (n < 1792 ? n + 32 : (n < 1824 ? n - 256 : -1));
                tr_task(w_in + (size_t)l * DM * INW, DM, INW, src, WIN_T + (size_t)l * INP * DM, n, k8 * 128); continue; }
            r -= I_WIN;
            if (r < I_WOUT) { const int l = r / 64, q = r % 64, nb = q / 8, k8 = q % 8, n = nb * 128 + 2 * lane;
                tr_task(w_out + (size_t)l * DM * DM, DM, DM, n, WOUT_T + (size_t)l * DM * DM, n, k8 * 128); continue; }
            r -= I_WOUT;
            if (r < I_WGU) { const int le = r / 128, q = r % 128, nb = q / 8, k8 = q % 8, n = nb * 128 + 2 * lane;
                const int pn = n >> 8, bj = (n >> 7) & 1, j = n & 127, src = bj * 1024 + pn * 128 + j;
                tr_task(exp_w_gu + (size_t)le * DM * 2048, DM, 2048, src, WGU_T + (size_t)le * 2048 * DM, n, k8 * 128); continue; }
            r -= I_WGU;
            { const int le = r / 64, q = r % 64, nb = q / 8, k8 = q % 8, n = nb * 128 + 2 * lane;
                tr_task(exp_w_down + (size_t)le * DE * DM, DE, DM, n, WDN_T + (size_t)le * DM * DE, n, k8 * 128); }
          } }
        { bf16* FTAB = WSP(bf16, WS_FTAB); float* TW = WSP(float, WS_TW);
          for (int it = gt; it < 3 * FT_TAB; it += NGT) { const int t = it / FT_TAB, q = it % FT_TAB, row = q / FT_PITCH, col = q % FT_PITCH; float sn, cs; sincospif((float)((row * col) & 63) * (1.0f / 32.0f), &sn, &cs);
              const float v = col >= 64 ? 0.f : (t == 0 ? cs : (t == 1 ? sn : -sn)); FTAB[it] = (bf16)f2bf(v); }
          for (int it = gt; it < 4096; it += NGT) { float sn, cs; sincospif((float)it * (1.0f / 2048.0f), &sn, &cs); TW[2 * it] = cs; TW[2 * it + 1] = -sn; } }
        for (int it = gt; it < SEQ * 32; it += NGT) { const int t = it >> 5, i = it & 31, a = i >> 4, f = i & 15; const int pos = a ? (t & 63) : (t >> 6);
            const double inv = exp(-9.210340371976184 * (double)f / 16.0); const double ang = (double)pos * inv;
            ROPE[it] = (float)cos(ang); ROPE[SEQ * 32 + it] = (float)sin(ang); }
        for (int m = gw; m < NTOK; m += NGW) { f32x4 v[4];
#pragma unroll
            for (int j = 0; j < 4; ++j) v[j] = *(const f32x4*)(x_in + (size_t)m * DM + lane * 4 + 256 * j);
            ln_row(v, ln_in_g, ln_in_b, HF + (size_t)m * DM, HB + (size_t)m * DM, lane); }
    }
    SEAM(0);

    for (int l = 0; l < NL; ++l) {
        const int pb = 1 + 10 * l;
        if (IN(pb + 0) && PON(1)) {
            TID_SETUP(); unsigned char* ws = KWS(); bf16* HB = WSP(bf16, WS_HB); bf16* WIN_T = WSP(bf16, WS_WIN_T); bf16* PROJ = WSP(bf16, WS_PROJ);
            pg8::Gemm g{HB, WIN_T + (size_t)l * INP * DM, NTOK, INP, DM}; pg8::StaticOrder S; S.init(NTOK, INP, G, bx);
            pg8::EpiPlainBf16 E{PROJ, INP};
            pg8::gemm_phase<pg8::EpiPlainBf16, pg8::StaticOrder, true, true>(lds + RING_OFF, g, S, E);
        }
        SEAM(pb + 0);
        if (IN(pb + 1) && PON(2)) {
            TID_SETUP(); unsigned char* ws = KWS(); const float* att_q_gain = KIN(4); const float* att_k_gain = KIN(5); const float* gla_gate_w = KIN(6); const float* gla_gate_b = KIN(7);
            const float* ROPE = WSP(float, WS_ROPE); const bf16* PROJ = WSP(bf16, WS_PROJ); bf16* QB = WSP(bf16, WS_QB); bf16* KB = WSP(bf16, WS_KB); float* LA = WSP(float, WS_LA);
            const float* qg = att_q_gain + l * 64; const float* kg = att_k_gain + l * 64;
            for (int m = gw; m < NTOK; m += NGW) { const int t = m & (SEQ - 1); const int ri = (lane >> 5) * 16 + (lane & 15);
                const float cs = ROPE[t * 32 + ri], sn = ROPE[SEQ * 32 + t * 32 + ri]; const float sg = ((lane >> 4) & 1) ? 1.f : -1.f;
#pragma unroll
                for (int h = 0; h < 10; ++h) { const float xv = bf2f(PROJ[(size_t)m * INP + h * 64 + lane]);
                    const float ms = wave_sum(xv * xv) * (1.f / 64.f); const float xn = xv * (1.f / sqrtf(ms + RMS_EPS)) * (h < 8 ? qg[lane] : kg[lane]);
                    const float pr = __shfl_xor(xn, 16); float o = xn * cs + sg * pr * sn;
                    if (h < 8) { o *= QSCALE; QB[(size_t)m * 512 + h * 64 + lane] = (bf16)f2bf(o); } else KB[(size_t)m * 128 + (h - 8) * 64 + lane] = (bf16)f2bf(o); } }
            { const float* gw_l = gla_gate_w + (size_t)l * 2 * 16 * 128; const float* gb_l = gla_gate_b + (size_t)l * 2 * 128;
              for (int m = gw; m < NTOK; m += NGW) { const float lr = (lane < 32) ? bf2f(PROJ[(size_t)m * INP + C_GLR + lane]) : 0.f;
                const int dir = lane >> 5, kc = (lane & 31) * 4; f32x4 z = *(const f32x4*)(gb_l + dir * 128 + kc);
#pragma unroll
                for (int r = 0; r < 16; ++r) { const float a = __shfl(lr, dir * 16 + r); const f32x4 w = *(const f32x4*)(gw_l + (size_t)(dir * 16 + r) * 128 + kc); z = z + w * a; }
                f32x4 o;
#pragma unroll
                for (int i = 0; i < 4; ++i) o[i] = (fminf(z[i], 0.f) - log1pf(expf(-fabsf(z[i])))) * (1.f / 16.f);
                *(f32x4*)(LA + (size_t)m * 256 + dir * 128 + kc) = o; } }
            { __syncthreads();
              { const v4u* src = (const v4u*)WSP(bf16, WS_FTAB); LAS v4u* dst = (LAS v4u*)(lds + RING_OFF + FFT_LDS_TAB); for (int i = tid; i < 3 * FT_TAB * 2 / 16; i += NWAVES * 64) dst[i] = src[i];
                const v4u* s2_ = (const v4u*)WSP(float, WS_TW); LAS v4u* d2_ = (LAS v4u*)(lds + RING_OFF + FFT_LDS_TW); for (int i = tid; i < 4096 * 8 / 16; i += NWAVES * 64) d2_[i] = s2_[i]; }
              __syncthreads();
              const LAS bf16* FT = (const LAS bf16*)(lds + RING_OFF + FFT_LDS_TAB); const LAS float* TWL = (const LAS float*)(lds + RING_OFF + FFT_LDS_TW); bf16* FTMP = WSP(bf16, WS_FTMP);
              const int pair = wave >> 1, cb = wave & 1, r = lane & 31, h = lane >> 5;
              for (int ub = bx; ub < NB * 4 * 64 / 4; ub += G) { const int u = ub * 4 + pair, s2 = u & 63, g4 = (u >> 6) & 3, b = u >> 8;
                bf16x8 xa[2][4];
#pragma unroll
                for (int R = 0; R < 2; ++R)
#pragma unroll
                    for (int ks = 0; ks < 4; ++ks) xa[R][ks] = *(const bf16x8*)(PROJ + ((size_t)b * SEQ + 64 * (32 * R + r) + s2) * INP + C_FX + g4 * 64 + 16 * ks + 8 * h);
                f32x16 Tr[2], Ti[2];
#pragma unroll
                for (int R = 0; R < 2; ++R)
#pragma unroll
                    for (int i = 0; i < 16; ++i) { Tr[R][i] = 0.f; Ti[R][i] = 0.f; }
#pragma unroll
                for (int ks = 0; ks < 4; ++ks) { const bf16x8 bc = *(const LAS bf16x8*)(FT + (32 * cb + r) * FT_PITCH + 16 * ks + 8 * h), bs = *(const LAS bf16x8*)(FT + 2 * FT_TAB + (32 * cb + r) * FT_PITCH + 16 * ks + 8 * h);
#pragma unroll
                    for (int R = 0; R < 2; ++R) { Tr[R] = MFMA32(xa[R][ks], bc, Tr[R]); Ti[R] = MFMA32(xa[R][ks], bs, Ti[R]); } }
#pragma unroll
                for (int Rp = 0; Rp < 2; ++Rp) { f32x16 Gr, Gi;
#pragma unroll
                    for (int i = 0; i < 16; ++i) { Gr[i] = 0.f; Gi[i] = 0.f; }
#pragma unroll
                    for (int R = 0; R < 2; ++R)
#pragma unroll
                        for (int s_ = 0; s_ < 2; ++s_) { const bf16x8 xr = pack_step(Tr[R], s_), xi = pack_step(Ti[R], s_);
                            const int kb = 32 * R + 16 * s_ + 4 * h, ro = (32 * Rp + r) * FT_PITCH + kb;
                            const s16x4 c0 = *(const LAS s16x4*)(FT + ro), c1 = *(const LAS s16x4*)(FT + ro + 8), s0 = *(const LAS s16x4*)(FT + FT_TAB + ro), s1 = *(const LAS s16x4*)(FT + FT_TAB + ro + 8),
                                        n0 = *(const LAS s16x4*)(FT + 2 * FT_TAB + ro), n1 = *(const LAS s16x4*)(FT + 2 * FT_TAB + ro + 8);
                            const bf16x8 ca = __builtin_shufflevector(c0, c1, 0, 1, 2, 3, 4, 5, 6, 7), sa = __builtin_shufflevector(s0, s1, 0, 1, 2, 3, 4, 5, 6, 7), na = __builtin_shufflevector(n0, n1, 0, 1, 2, 3, 4, 5, 6, 7);
                            Gr = MFMA32(ca, xr, Gr); Gr = MFMA32(sa, xi, Gr); Gi = MFMA32(ca, xi, Gi); Gi = MFMA32(na, xr, Gi); }
#pragma unroll
                    for (int i = 0; i < 16; ++i) { const int s1p = 32 * Rp + crow16(i, h); const int m = (s2 * s1p) & 4095; const float wr = TWL[2 * m], wi = TWL[2 * m + 1];
                        const size_t o = ((((size_t)(b * 4 + g4) * 64 + s1p) * 2) * 64 + s2) * 64 + 32 * cb + r;
                        FTMP[o] = (bf16)f2bf(Gr[i] * wr - Gi[i] * wi); FTMP[o + 4096] = (bf16)f2bf(Gr[i] * wi + Gi[i] * wr); } }
              }
              __syncthreads(); }
            { float* GS = WSP(float, WS_OF); float* GD = WSP(float, WS_OB);
              const int slot = wave >> 2, w4 = wave & 3, fr = lane & 15, fq = lane >> 4; LAS unsigned char* Ls = lds + RING_OFF + slot * GM_SLOT;
              for (int ub = bx; ub < NB * 4 * 64 / 2; ub += G) { const int u = ub * 2 + slot, c = u & 63, bh = u >> 6, hd = bh & 3, b = bh >> 2; const size_t tok0 = (size_t)b * SEQ + c * 64;
                __syncthreads();
                gla_stage_mfma<false>(Ls, PROJ, LA, nullptr, tok0, hd, w4, lane);
                __syncthreads();
                const LAS bf16* VT = (const LAS bf16*)(Ls + GM_VT); const LAS float* DL = (const LAS float*)(Ls + GM_DL);
#pragma unroll
                for (int dir = 0; dir < 2; ++dir) { const LAS bf16* KT = (const LAS bf16*)(Ls + GM_P + dir * 4608);
#pragma unroll
                    for (int Cd = 0; Cd < 2; ++Cd) { f32x4 acc = {0.f, 0.f, 0.f, 0.f};
#pragma unroll
                        for (int ks = 0; ks < 2; ++ks) { const bf16x8 a_ = *(const LAS bf16x8*)(VT + (16 * w4 + fr) * 72 + 32 * ks + 8 * fq), b_ = *(const LAS bf16x8*)(KT + (16 * Cd + fr) * 72 + 32 * ks + 8 * fq); acc = MFMA16(a_, b_, acc); }
                        const float Dd = DL[dir * 32 + 16 * Cd + fr]; float* o = GS + (((size_t)u * 2 + dir) * 64 + 16 * w4 + 4 * fq) * 32 + 16 * Cd + fr;
#pragma unroll
                        for (int r = 0; r < 4; ++r) o[r * 32] = acc[r] * Dd; } }
                if (w4 == 3) GD[((size_t)u * 2 + (lane >> 5)) * 32 + (lane & 31)] = DL[lane]; }
              __syncthreads(); }
        }
        SEAM(pb + 1);
        if (IN(pb + 2) && PON(3)) {
            TID_SETUP(); unsigned char* ws = KWS(); float* GS = WSP(float, WS_OF); const float* GD = WSP(float, WS_OB);
            for (int e = gt; e < NB * 4 * 2 * 2048; e += NGT) { const int dv = e & 2047, dir = (e >> 11) & 1, bh = e >> 12, d = dv & 31; float H = 0.f;
                for (int c8 = 0; c8 < 64; c8 += 8) { float sv[8], dd[8];
#pragma unroll
                    for (int i = 0; i < 8; ++i) { const int c = dir ? 63 - (c8 + i) : (c8 + i); const size_t sidx = ((size_t)(bh * 64 + c) * 2 + dir); sv[i] = GS[sidx * 2048 + dv]; dd[i] = GD[sidx * 32 + d]; }
#pragma unroll
                    for (int i = 0; i < 8; ++i) { const int c = dir ? 63 - (c8 + i) : (c8 + i); const size_t sidx = ((size_t)(bh * 64 + c) * 2 + dir); GS[sidx * 2048 + dv] = H; H = H * dd[i] + sv[i]; } } }
        }
        SEAM(pb + 2);
        if (IN(pb + 3) && PON(4)) {
            TID_SETUP(); unsigned char* ws = KWS(); const float* gla_norm_g = KIN(8); const bf16* PROJ = WSP(bf16, WS_PROJ);
            bf16* MIX = WSP(bf16, WS_MIX); const bf16* QB = WSP(bf16, WS_QB); const bf16* KB = WSP(bf16, WS_KB);
            { __syncthreads();
              { const v4u* src = (const v4u*)WSP(bf16, WS_FTAB); LAS v4u* dst = (LAS v4u*)(lds + RING_OFF + FFT_LDS_TAB); for (int i = tid; i < 3 * FT_TAB * 2 / 16; i += NWAVES * 64) dst[i] = src[i]; }
              const LAS bf16* FT = (const LAS bf16*)(lds + RING_OFF + FFT_LDS_TAB); const bf16* FTMP = WSP(bf16, WS_FTMP);
              const int pair = wave >> 1, cb = wave & 1, r = lane & 31, h = lane >> 5;
              LAS bf16* HT = (LAS bf16*)(lds + RING_OFF + FFT_LDS_HT + pair * FFT_HT_PAIR);
              for (int ub = bx; ub < NB * 4 * 64 / 4; ub += G) { const int u = ub * 4 + pair, s1p = u & 63, g4 = (u >> 6) & 3, b = u >> 8;
                const bf16* src = FTMP + (size_t)u * 2 * 4096;
                __syncthreads();
#pragma unroll
                for (int q = 0; q < 8; ++q) { const int p = cb * 64 + lane + 128 * q, ri = p >> 9, s2 = (p >> 3) & 63, c0 = (p & 7) * 8; const u16x8 v = *(const u16x8*)(src + p * 8);
#pragma unroll
                    for (int i = 0; i < 8; ++i) HT[(ri * 64 + c0 + i) * FT_PITCH + s2] = v[i]; }
                __syncthreads();
#pragma unroll
                for (int Rp = 0; Rp < 2; ++Rp) { f32x16 acc;
#pragma unroll
                    for (int i = 0; i < 16; ++i) acc[i] = 0.f;
#pragma unroll
                    for (int ks = 0; ks < 4; ++ks) { const int ko = 16 * ks + 8 * h;
                        const bf16x8 ca = *(const LAS bf16x8*)(FT + (32 * Rp + r) * FT_PITCH + ko), sa = *(const LAS bf16x8*)(FT + FT_TAB + (32 * Rp + r) * FT_PITCH + ko);
                        const bf16x8 hr = *(const LAS bf16x8*)(HT + (32 * cb + r) * FT_PITCH + ko), hi_ = *(const LAS bf16x8*)(HT + (64 + 32 * cb + r) * FT_PITCH + ko);
                        acc = MFMA32(ca, hr, acc); acc = MFMA32(sa, hi_, acc); }
#pragma unroll
                    for (int i = 0; i < 16; ++i) { const int s2p = 32 * Rp + crow16(i, h); MIX[((size_t)b * SEQ + s1p + 64 * s2p) * DM + 768 + g4 * 64 + 32 * cb + r] = (bf16)f2bf(acc[i] * (1.0f / 512.0f)); } }
              }
              __syncthreads(); }
            { const float* GS = WSP(float, WS_OF); const float* LA = WSP(float, WS_LA);
              const int slot = wave >> 2, w4 = wave & 3, fr = lane & 15, fq = lane >> 4, I0 = 16 * w4; LAS unsigned char* Ls = lds + RING_OFF + slot * GM_SLOT;
              for (int ub = bx; ub < NB * 4 * 64 / 2; ub += G) { const int u = ub * 2 + slot, c = u & 63, bh = u >> 6, hd = bh & 3, b = bh >> 2; const size_t tok0 = (size_t)b * SEQ + c * 64;
                __syncthreads();
                gla_stage_mfma<true>(Ls, PROJ, LA, GS + (size_t)u * 2 * 2048, tok0, hd, w4, lane);
                __syncthreads();
                const LAS bf16* QF = (const LAS bf16*)(Ls + GM_QF); const LAS bf16* KF = (const LAS bf16*)(Ls + GM_KF); const LAS bf16* QBm = (const LAS bf16*)(Ls + GM_QB); const LAS bf16* KBm = (const LAS bf16*)(Ls + GM_KB);
                const LAS bf16* VT = (const LAS bf16*)(Ls + GM_VT); LAS bf16* P = (LAS bf16*)(Ls + GM_P); const LAS bf16* HTF = (const LAS bf16*)(Ls + GM_HTF); const LAS bf16* HTB = (const LAS bf16*)(Ls + GM_HTB);
                const bf16x8 qfa = *(const LAS bf16x8*)(QF + (I0 + fr) * 40 + 8 * fq), qba = *(const LAS bf16x8*)(QBm + (I0 + fr) * 40 + 8 * fq);
#pragma unroll
                for (int Cj = 0; Cj < 4; ++Cj) { const f32x4 z = {0.f, 0.f, 0.f, 0.f};
                    const f32x4 pf = MFMA16(qfa, *(const LAS bf16x8*)(KF + (16 * Cj + fr) * 40 + 8 * fq), z), pb = MFMA16(qba, *(const LAS bf16x8*)(KBm + (16 * Cj + fr) * 40 + 8 * fq), z);
#pragma unroll
                    for (int r = 0; r < 4; ++r) { const int i = I0 + 4 * fq + r, j = 16 * Cj + fr; P[i * 72 + j] = (bf16)f2bf(j <= i ? pf[r] : pb[r]); } }
                asm volatile("s_waitcnt lgkmcnt(0)" ::: "memory");
                f32x4 o[4];
#pragma unroll
                for (int Cv = 0; Cv < 4; ++Cv) { f32x4 acc = {0.f, 0.f, 0.f, 0.f};
#pragma unroll
                    for (int ks = 0; ks < 2; ++ks) acc = MFMA16(*(const LAS bf16x8*)(P + (I0 + fr) * 72 + 32 * ks + 8 * fq), *(const LAS bf16x8*)(VT + (16 * Cv + fr) * 72 + 32 * ks + 8 * fq), acc);
                    acc = MFMA16(qfa, *(const LAS bf16x8*)(HTF + (16 * Cv + fr) * 40 + 8 * fq), acc); acc = MFMA16(qba, *(const LAS bf16x8*)(HTB + (16 * Cv + fr) * 40 + 8 * fq), acc);
                    o[Cv] = acc; }
                float rs[4];
#pragma unroll
                for (int r = 0; r < 4; ++r) { float ss = (o[0][r] * o[0][r] + o[1][r] * o[1][r]) + (o[2][r] * o[2][r] + o[3][r] * o[3][r]);
#pragma unroll
                    for (int m_ = 1; m_ < 16; m_ <<= 1) ss += __shfl_xor(ss, m_);
                    rs[r] = 1.f / sqrtf(ss * (1.f / 64.f) + RMS_EPS); }
#pragma unroll
                for (int Cv = 0; Cv < 4; ++Cv) { const int v = 16 * Cv + fr; const float gn = gla_norm_g[l * 64 + v];
#pragma unroll
                    for (int r = 0; r < 4; ++r) { const size_t m = tok0 + I0 + 4 * fq + r; const float rg = bf2f(PROJ[m * INP + C_GR + hd * 64 + v]);
                        MIX[m * DM + 512 + hd * 64 + v] = (bf16)f2bf(o[Cv][r] * rs[r] * gn * (rg / (1.f + expf(-rg)))); } } }
              __syncthreads(); }
#if NAIVE_ATTN
            { LAS float* Kt = (LAS float*)(lds + RING_OFF); LAS float* Vt = Kt + 64 * 64;
              for (int unit = bx; unit < NB * 8 * 8; unit += G) { const int rb = unit & 7, h = (unit >> 3) & 7, b = unit >> 6, kvh = h >> 2;
                const size_t qrow = (size_t)b * SEQ + rb * 512 + tid;
                float q[64], o[64]; float mrun = -INFINITY, lrun = 0.f;
#pragma unroll
                for (int c8 = 0; c8 < 8; ++c8) { const u16x8 f = *(const u16x8*)(QB + qrow * 512 + h * 64 + c8 * 8);
#pragma unroll
                    for (int i = 0; i < 8; ++i) { q[c8 * 8 + i] = bf2f(f[i]); o[c8 * 8 + i] = 0.f; } }
                for (int kt = 0; kt < SEQ; kt += 64) {
                    __syncthreads();
                    { const int kr = tid >> 3, c8 = (tid & 7) * 8; const size_t krow = (size_t)b * SEQ + kt + kr;
                      const u16x8 kf = *(const u16x8*)(KB + krow * 128 + kvh * 64 + c8); const u16x8 vf = *(const u16x8*)(PROJ + krow * INP + C_AV + kvh * 64 + c8);
#pragma unroll
                      for (int i = 0; i < 8; ++i) { Kt[kr * 64 + c8 + i] = bf2f(kf[i]); Vt[kr * 64 + c8 + i] = bf2f(vf[i]); } }
                    __syncthreads();
#pragma unroll 1
                    for (int j = 0; j < 64; ++j) { float a = 0.f;
#pragma unroll
                        for (int d4 = 0; d4 < 16; ++d4) { const f32x4 kv = *(const LAS f32x4*)(Kt + j * 64 + d4 * 4); a += (q[d4 * 4] * kv.x + q[d4 * 4 + 1] * kv.y) + (q[d4 * 4 + 2] * kv.z + q[d4 * 4 + 3] * kv.w); }
                        if (a > mrun) { const float al = exp2f(mrun - a); mrun = a; lrun *= al;
#pragma unroll
                            for (int d = 0; d < 64; ++d) o[d] *= al; }
                        const float p = exp2f(a - mrun); lrun += p;
#pragma unroll
                        for (int d4 = 0; d4 < 16; ++d4) { const f32x4 vv = *(const LAS f32x4*)(Vt + j * 64 + d4 * 4); o[d4 * 4] += p * vv.x; o[d4 * 4 + 1] += p * vv.y; o[d4 * 4 + 2] += p * vv.z; o[d4 * 4 + 3] += p * vv.w; } }
                }
                const float rl = 1.f / lrun;
#pragma unroll
                for (int c8 = 0; c8 < 8; ++c8) { v4u w; w.x = pk2(o[c8 * 8] * rl, o[c8 * 8 + 1] * rl); w.y = pk2(o[c8 * 8 + 2] * rl, o[c8 * 8 + 3] * rl); w.z = pk2(o[c8 * 8 + 4] * rl, o[c8 * 8 + 5] * rl); w.w = pk2(o[c8 * 8 + 6] * rl, o[c8 * 8 + 7] * rl);
                    *(v4u*)(MIX + qrow * DM + h * 64 + c8 * 8) = w; }
              }
              __syncthreads(); }
#else
            { const attn_body::AttnTensors AT{(const attn_body::bf16*)QB, (const attn_body::bf16*)KB, (const attn_body::bf16*)(PROJ + C_AV), (attn_body::bf16*)MIX};
              const attn_body::StaticOrder S(G, bx);
              attn_body::attn_phase<attn_body::StaticOrder>((char*)lds_raw + RING_OFF, AT, S); }
#endif
        }
        SEAM(pb + 3);
        if (IN(pb + 4) && PON(5)) {
            TID_SETUP(); unsigned char* ws = KWS(); const bf16* MIX = WSP(bf16, WS_MIX); const bf16* WOUT_T = WSP(bf16, WS_WOUT_T); const float* HF = WSP(float, WS_HF); float* T1 = WSP(float, WS_T1);
            pg8::Gemm g{MIX, WOUT_T + (size_t)l * DM * DM, NTOK, DM, DM}; pg8::StaticOrder S; S.init(NTOK, DM, G, bx);
            pg8::EpiResF32 E{HF, T1, DM, DN_ALPHA};
            pg8::gemm_phase<pg8::EpiResF32, pg8::StaticOrder, true, true>(lds + RING_OFF, g, S, E);
        }
        SEAM(pb + 4);
        if (IN(pb + 5) && PON(6)) {
            TID_SETUP(); unsigned char* ws = KWS(); gu32* ctl = (gu32*)(ws + WS_CTL); const float* ln1_g = KIN(10); const float* ln1_b = KIN(11); const float* router_w = KIN(12); const float* router_b = KIN(13);
            const float* T1 = WSP(float, WS_T1); float* HF = WSP(float, WS_HF); bf16* HB = WSP(bf16, WS_HB); int* TOKE = WSP(int, WS_TOK); int* TOKS = TOKE + NTOK * 4; float* TOKW = (float*)(TOKS + NTOK * 4); int* LIST = WSP(int, WS_XS);
            LAS float* RW = (LAS float*)(lds + RING_OFF);
            { const float* rw = router_w + (size_t)l * DM * NE; for (int i = tid; i < DM * NE; i += NWAVES * 64) { const int c = i >> 5, e = i & 31; RW[e * DM + c] = rw[i]; } }
            LAS int* lcnt = (LAS int*)(lctl + LC_CNT); LAS int* lbase = (LAS int*)(lctl + LC_BASE); LAS int* sele = (LAS int*)(lctl + LC_SELE); LAS int* sels = (LAS int*)(lctl + LC_SELS);
            const float* rb = router_b + l * NE;
            for (int r0 = bx * 128; r0 < NTOK; r0 += G * 128) {
                if (tid < 32) lcnt[tid] = 0;
                __syncthreads();
                LAS float* LG = (LAS float*)(lctl + LC_LG) + wave * 512;
                f32x4 gam[4], bet[4];
#pragma unroll
                for (int j = 0; j < 4; ++j) { gam[j] = *(const f32x4*)(ln1_g + l * DM + lane * 4 + 256 * j); bet[j] = *(const f32x4*)(ln1_b + l * DM + lane * 4 + 256 * j); }
                for (int rr = 0; rr < 16; rr += 2) { const int lr = wave * 16 + rr; const size_t m = (size_t)r0 + lr; f32x4 v[2][4];
#pragma unroll
                    for (int q = 0; q < 2; ++q)
#pragma unroll
                        for (int j = 0; j < 4; ++j) v[q][j] = *(const f32x4*)(T1 + (m + q) * DM + lane * 4 + 256 * j);
#pragma unroll
                    for (int q = 0; q < 2; ++q) { float s_ = 0.f;
#pragma unroll
                        for (int j = 0; j < 4; ++j) s_ += (v[q][j].x + v[q][j].y) + (v[q][j].z + v[q][j].w);
                        const float mean = wave_sum(s_) * (1.f / DM); float s2_ = 0.f;
#pragma unroll
                        for (int j = 0; j < 4; ++j) { v[q][j] = v[q][j] - mean; s2_ += (v[q][j].x * v[q][j].x + v[q][j].y * v[q][j].y) + (v[q][j].z * v[q][j].z + v[q][j].w * v[q][j].w); }
                        const float rstd = 1.f / sqrtf(wave_sum(s2_) * (1.f / DM) + LN_EPS);
#pragma unroll
                        for (int j = 0; j < 4; ++j) { v[q][j] = v[q][j] * rstd * gam[j] + bet[j];
                            *(f32x4*)(HF + (m + q) * DM + lane * 4 + 256 * j) = v[q][j];
                            *(unsigned long long*)(HB + (m + q) * DM + lane * 4 + 256 * j) = (unsigned long long)pk2(v[q][j].x, v[q][j].y) | ((unsigned long long)pk2(v[q][j].z, v[q][j].w) << 32); } }
                    float a0[32], a1[32];
#pragma unroll
                    for (int e = 0; e < 32; ++e) { f32x2_t s0 = {0.f, 0.f}, s1 = {0.f, 0.f};
#pragma unroll
                        for (int j = 0; j < 4; ++j) { const f32x4 w = *(const LAS f32x4*)(RW + e * DM + lane * 4 + 256 * j); const f32x2_t wl = {w.x, w.y}, wh = {w.z, w.w};
                            s0 += (f32x2_t){v[0][j].x, v[0][j].y} * wl; s0 += (f32x2_t){v[0][j].z, v[0][j].w} * wh; s1 += (f32x2_t){v[1][j].x, v[1][j].y} * wl; s1 += (f32x2_t){v[1][j].z, v[1][j].w} * wh; }
                        a0[e] = s0.x + s0.y; a1[e] = s1.x + s1.y; }
#define TRSTEP(SRC, DST, N, MASK) _Pragma("unroll") for (int e = 0; e < (N); ++e) { const bool hi_ = (lane & (MASK)) != 0; const float keep = hi_ ? SRC[e + (N)] : SRC[e], send = hi_ ? SRC[e] : SRC[e + (N)]; DST[e] = keep + __shfl_xor(send, (MASK)); }
                    float t0, t1;
                    { float b_[16], c_[8], d_[4], e_[2], f_[1]; TRSTEP(a0, b_, 16, 32) TRSTEP(b_, c_, 8, 16) TRSTEP(c_, d_, 4, 8) TRSTEP(d_, e_, 2, 4) TRSTEP(e_, f_, 1, 2) t0 = f_[0] + __shfl_xor(f_[0], 1); }
                    { float b_[16], c_[8], d_[4], e_[2], f_[1]; TRSTEP(a1, b_, 16, 32) TRSTEP(b_, c_, 8, 16) TRSTEP(c_, d_, 4, 8) TRSTEP(d_, e_, 2, 4) TRSTEP(e_, f_, 1, 2) t1 = f_[0] + __shfl_xor(f_[0], 1); }
#undef TRSTEP
                    { const int E = (lane >> 1) & 31; const float bias = rb[E]; if ((lane & 1) == 0) { LG[rr * 32 + E] = t0 + bias; LG[(rr + 1) * 32 + E] = t1 + bias; } }
                }
                asm volatile("s_waitcnt lgkmcnt(0)" ::: "memory");
                if (lane < 16) { const int lr = wave * 16 + lane; const size_t m = (size_t)r0 + lr; float lg[32];
#pragma unroll
                    for (int e4 = 0; e4 < 8; ++e4) { const f32x4 x = *(const LAS f32x4*)(LG + lane * 32 + e4 * 4); lg[e4 * 4] = x.x; lg[e4 * 4 + 1] = x.y; lg[e4 * 4 + 2] = x.z; lg[e4 * 4 + 3] = x.w; }
                    int se[4]; float sv[4];
#pragma unroll
                    for (int k = 0; k < 4; ++k) { float best = -INFINITY; int bi = 0;
#pragma unroll
                        for (int e = 0; e < 32; ++e) { if (lg[e] > best) { best = lg[e]; bi = e; } }
                        se[k] = bi; sv[k] = best;
#pragma unroll
                        for (int e = 0; e < 32; ++e) if (e == bi) lg[e] = -INFINITY; }
                    const float e1 = expf(sv[1] - sv[0]), e2 = expf(sv[2] - sv[0]), e3 = expf(sv[3] - sv[0]); const float inv = 1.f / (1.f + e1 + e2 + e3);
                    const float wts[4] = {inv, e1 * inv, e2 * inv, e3 * inv};
#pragma unroll
                    for (int k = 0; k < 4; ++k) { const int ls = __hip_atomic_fetch_add(lcnt + se[k], 1, __ATOMIC_RELAXED, __HIP_MEMORY_SCOPE_WORKGROUP); sele[lr * 4 + k] = se[k]; sels[lr * 4 + k] = ls; TOKW[m * 4 + k] = wts[k]; } }
                __syncthreads();
                if (tid < 32) lbase[tid] = (int)__hip_atomic_fetch_add(ctl + CW_CNT + l * 32 + tid, (unsigned)lcnt[tid], RLX_AGENT);
                __syncthreads();
                { const int e = sele[tid], sl = lbase[e] + sels[tid]; TOKE[(size_t)r0 * 4 + tid] = e; TOKS[(size_t)r0 * 4 + tid] = sl; LIST[(size_t)e * NTOK + sl] = r0 + (tid >> 2); }
                __syncthreads();
            }
        }
        SEAM(pb + 5);
        STAMP(pb + 7);
        if (IN(pb + 7) || IN(pb + 8) || IN(pb + 9)) {
            LAS int* pst = (LAS int*)(lctl + LC_PSTART); LAS int* ecnt = (LAS int*)(lctl + LC_BASE); gu32* ctl = (gu32*)(KWS() + WS_CTL);
            __syncthreads();
            if (threadIdx.x == 0) { int acc = 0; for (int e = 0; e < NE; ++e) { pst[e] = acc; const int c = (int)__hip_atomic_load(ctl + CW_CNT + l * 32 + e, RLX_AGENT); ecnt[e] = c; acc += (c + 255) >> 8; } pst[NE] = acc; }
            __syncthreads();
        }
        if (IN(pb + 7) && PON(8)) {
            TID_SETUP(); unsigned char* ws = KWS(); const float* exp_b_gu = KIN(15); const bf16* HB = WSP(bf16, WS_HB); const int* LIST = WSP(int, WS_XS); const bf16* WGU_T = WSP(bf16, WS_WGU_T); bf16* HID = WSP(bf16, WS_HID);
            const LAS int* pst = (const LAS int*)(lctl + LC_PSTART); LAS int* ul = (LAS int*)(lctl + LC_ULIST);
            const int nM = pst[NE], nN = 8, nwg = nM * nN;
            if (tid < 64) { const long L = (long)tid * G + bx; int v = -1;
                if (L < nwg) { int wgid = (int)L; { const int q = nwg / 8, r = nwg % 8, xcd = wgid % 8, off = wgid / 8; wgid = (xcd < r ? xcd * (q + 1) : r * (q + 1) + (xcd - r) * q) + off; }
                    const int nig = 8 * nN, gid = wgid / nig, fm = gid * 8, gsz = (nM - fm) < 8 ? (nM - fm) : 8; const int pm = fm + ((wgid % nig) % gsz), pn = (wgid % nig) / gsz;
                    int e = 0; for (int k = 1; k < NE; ++k) if (pst[k] <= pm) e = k;
                    v = (pm << 16) | (e * nN + pn); }
                ul[tid] = v; }
            __syncthreads();
            const int nunits = bx < nwg ? (nwg - bx + G - 1) / G : 0;
            LAS unsigned short* rows16 = (LAS unsigned short*)(lctl + LC_ROWS); const LAS int* ecnt = (const LAS int*)(lctl + LC_BASE);
            for (int sl = 0; sl < nunits; ++sl) { const int v = ul[sl]; const int pm = v >> 16, e = (v & 0xffff) >> 3, pl = pm - pst[e];
                if (tid < 256) { const int idx = pl * 256 + tid; rows16[sl * 256 + tid] = (idx < ecnt[e]) ? (unsigned short)LIST[(size_t)e * NTOK + idx] : (unsigned short)0; } }
            __syncthreads();
            pg8::Gemm g{HB, WGU_T + (size_t)l * NE * 2048 * DM, NTOK, NE * 2048, DM}; pg8::ListOrder S{ul, nunits};
            pg8::EpiSwiglu E{HID, exp_b_gu + (size_t)l * NE * 2048};
            pg8::gemm_phase_gather<pg8::EpiSwiglu, pg8::ListOrder, true>(lds + RING_OFF, g, S, E, rows16);
        }
        SEAM(pb + 7);
        if (IN(pb + 8) && PON(9)) {
            TID_SETUP(); unsigned char* ws = KWS(); const float* exp_b_down = KIN(17); const bf16* HID = WSP(bf16, WS_HID); const bf16* WDN_T = WSP(bf16, WS_WDN_T); bf16* YS = WSP(bf16, WS_YS);
            const LAS int* pst = (const LAS int*)(lctl + LC_PSTART); LAS int* ul = (LAS int*)(lctl + LC_ULIST);
            const int nM = pst[NE], nN = 4, nwg = nM * nN;
            __syncthreads();
            if (tid < 64) { const long L = (long)tid * G + bx; int v = -1;
                if (L < nwg) { int wgid = (int)L; { const int q = nwg / 8, r = nwg % 8, xcd = wgid % 8, off = wgid / 8; wgid = (xcd < r ? xcd * (q + 1) : r * (q + 1) + (xcd - r) * q) + off; }
                    const int nig = 8 * nN, gid = wgid / nig, fm = gid * 8, gsz = (nM - fm) < 8 ? (nM - fm) : 8; const int pm = fm + ((wgid % nig) % gsz), pn = (wgid % nig) / gsz;
                    int e = 0; for (int k = 1; k < NE; ++k) if (pst[k] <= pm) e = k;
                    v = (pm << 16) | (e * nN + pn); }
                ul[tid] = v; }
            __syncthreads();
            const int nunits = bx < nwg ? (nwg - bx + G - 1) / G : 0;
            pg8::Gemm g{HID, WDN_T + (size_t)l * NE * DM * DE, MPAD, NE * DM, DE}; pg8::ListOrder S{ul, nunits};
            pg8::EpiDown E{YS, exp_b_down + (size_t)l * NE * DM};
            pg8::gemm_phase<pg8::EpiDown, pg8::ListOrder, true, true>(lds + RING_OFF, g, S, E);
        }
        SEAM(pb + 8);
        if (IN(pb + 9) && PON(10)) {
            TID_SETUP(); unsigned char* ws = KWS(); const float* ln2_g = KIN(18); const float* ln2_b = KIN(19); float* out = KOUT(); float* HF = WSP(float, WS_HF); bf16* HB = WSP(bf16, WS_HB);
            const bf16* YS = WSP(bf16, WS_YS); const int* TOKE = WSP(int, WS_TOK); const int* TOKS = TOKE + NTOK * 4; const float* TOKW = (const float*)(TOKS + NTOK * 4); const LAS int* pst = (const LAS int*)(lctl + LC_PSTART);
            const bool lastl = (l == NL - 1);
            for (int m0 = gw; m0 < NTOK; m0 += 2 * NGW) { f32x4 v[2][4]; const bf16* yr[2][4]; float wk[2][4];
#pragma unroll
                for (int q = 0; q < 2; ++q) { const int m = m0 + q * NGW;
#pragma unroll
                    for (int k = 0; k < 4; ++k) { wk[q][k] = TOKW[m * 4 + k]; yr[q][k] = YS + (size_t)(pst[TOKE[m * 4 + k]] * 256 + TOKS[m * 4 + k]) * DM; }
#pragma unroll
                    for (int j = 0; j < 4; ++j) v[q][j] = *(const f32x4*)(HF + (size_t)m * DM + lane * 4 + 256 * j) * DN_ALPHA; }
#pragma unroll
                for (int q = 0; q < 2; ++q)
#pragma unroll
                    for (int k = 0; k < 4; ++k)
#pragma unroll
                        for (int j = 0; j < 4; ++j) { const u16x4 y = *(const u16x4*)(yr[q][k] + lane * 4 + 256 * j); const float w = wk[q][k]; v[q][j].x += w * bf2f(y[0]); v[q][j].y += w * bf2f(y[1]); v[q][j].z += w * bf2f(y[2]); v[q][j].w += w * bf2f(y[3]); }
#pragma unroll
                for (int q = 0; q < 2; ++q) { const int m = m0 + q * NGW;
                    ln_row(v[q], ln2_g + l * DM, ln2_b + l * DM, lastl ? out + (size_t)m * DM : HF + (size_t)m * DM, lastl ? nullptr : HB + (size_t)m * DM, lane); } }
        }
        SEAM(pb + 9);
    }
#if PROBE_A >= 0
    { xcd_barrier(bar);
      const unsigned long long* st = (const unsigned long long*)(KWS() + WS_CTL + 65536); unsigned long long T = 0;
      if (PROBE_A & 1) T += st[1] - st[0];
      for (int l = 0; l < NL; ++l) for (int j = 1; j <= 10; ++j) if ((PROBE_A >> j) & 1) T += st[1 + 10 * l + j] - st[10 * l + j];
      T *= 4ull; if (T > 5000000ull) T = 5000000ull;
      const unsigned long long t0 = __builtin_amdgcn_s_memrealtime();
      while (__builtin_amdgcn_s_memrealtime() - t0 < T) __builtin_amdgcn_s_sleep(16); }
#endif
#undef IN
#undef SEAM
}

#ifndef MK_PER_PHASE
#define MK_PER_PHASE 0
#endif
extern "C" void kernel_launch(void* const* d_in, const int* in_sizes, int n_in, void* d_out, int out_size, void* d_ws, size_t ws_size, hipStream_t stream) {
    static int grid = 0;
    if (grid == 0) {
        if (n_in != 20 || in_sizes[0] != NTOK * DM || out_size != NTOK * DM || ws_size < WS_END) { fprintf(stderr, "kernel_launch: unexpected shapes (n_in %d, in0 %d, out %d, ws %zu); nothing launched\n", n_in, n_in > 0 ? in_sizes[0] : -1, out_size, ws_size); grid = -1; return; }
        int dev = 0, cus = 0, per_cu = 0;
        if (hipGetDevice(&dev) != hipSuccess || hipDeviceGetAttribute(&cus, hipDeviceAttributeMultiprocessorCount, dev) != hipSuccess) { grid = -1; return; }
        if (hipFuncSetAttribute((const void*)fwd, hipFuncAttributeMaxDynamicSharedMemorySize, LDS_BYTES) != hipSuccess) { fprintf(stderr, "kernel_launch: hipFuncSetAttribute failed\n"); grid = -1; return; }
        if (hipOccupancyMaxActiveBlocksPerMultiprocessor(&per_cu, (const void*)fwd, NWAVES * 64, LDS_BYTES) != hipSuccess || per_cu < 1) fprintf(stderr, "kernel_launch: occupancy query reports %d\n", per_cu);
        (void)hipGetLastError();
        grid = cus;
    }
    if (grid < 0) return;
    if (hipMemsetAsync((char*)d_ws + WS_CTL, 0, CTL_ZERO_BYTES, stream) != hipSuccess) return;
    Args a{};
    for (int i = 0; i < 20; ++i) a.in[i] = (const float*)d_in[i];
    a.out = (float*)d_out; a.ws = (unsigned char*)d_ws;
#if MK_PER_PHASE
    for (int p = 0; p < N_PHASES; ++p) { a.ph_lo = p; a.ph_hi = p + 1; hipLaunchKernelGGL(fwd, dim3(grid), dim3(NWAVES * 64), LDS_BYTES, stream, a); }
#else
    a.ph_lo = 0; a.ph_hi = N_PHASES;
    hipLaunchKernelGGL(fwd, dim3(grid), dim3(NWAVES * 64), LDS_BYTES, stream, a);
#endif
    const hipError_t le = hipPeekAtLastError();
    if (le != hipSuccess) fprintf(stderr, "kernel_launch: launch failed: %s\n", hipGetErrorName(le));
}
```

```cpp
#include <hip/hip_runtime.h>
#include <hip/hip_bf16.h>
#include <cstdio>
#include <cstdint>
#include <cmath>
namespace pg8 {
#define PG8_LAS __attribute__((address_space(3)))
typedef unsigned short bf16_t;
typedef short bf16x8 __attribute__((ext_vector_type(8)));
typedef float f32x4 __attribute__((ext_vector_type(4)));
typedef unsigned u32x4 __attribute__((ext_vector_type(4)));
constexpr int BM = 256, BK = 64, HALF = 128, HTB = HALF * BK * 2  , STAGE_BYTES = 8 * HTB, NXCD = 8, WGM = 8;

__host__ __device__ __forceinline__ int lds_byte(int r, int c) { const int st = (r >> 4) * 2 + (c >> 5), rr = r & 15, cc = c & 31, ob = rr * 64 + cc * 2; return st * 1024 + (ob ^ (((ob >> 9) & 1) << 5)); }
__host__ __device__ __forceinline__ void stage_rc(int b, int& R, int& C) { const int st = b / 1024, sb = b % 1024, swz = sb ^ (((sb >> 9) & 1) << 5); R = (st >> 1) * 16 + swz / 64; C = (st & 1) * 32 + (swz % 64) / 2; }
__host__ __device__ __forceinline__ int perm32(int rho) { const int n = rho >> 4, i = rho & 15; return 8 * (i >> 2) + 4 * n + (i & 3); }

struct Unit { int pm, pn; };
struct Gemm { const bf16_t* A; const bf16_t* Bt; int M, N, K; };

struct StaticOrder {
    int nM, nN, nwg, G, c;
    __host__ __device__ void init(int M, int N, int G_, int c_) { nM = M / BM; nN = N / BM; nwg = nM * nN; G = G_; c = c_; }
    __host__ __device__ bool next(int i, Unit& u) const {
        const long L = (long)i * G + c; if (L >= nwg) return false;
        int wgid = (int)L; { const int q = nwg / NXCD, r = nwg % NXCD, xcd = wgid % NXCD, off = wgid / NXCD; wgid = (xcd < r ? xcd * (q + 1) : r * (q + 1) + (xcd - r) * q) + off; }
        const int nig = WGM * nN, gid = wgid / nig, fm = gid * WGM, gsz = (nM - fm) < WGM ? (nM - fm) : WGM;
        u.pm = fm + ((wgid % nig) % gsz); u.pn = (wgid % nig) / gsz; return true;
    }
    __device__ __forceinline__ void a_ready(const Unit&) const {}
    __device__ __forceinline__ void done(const Unit&) const {}
};

__device__ __forceinline__ unsigned cvt_pk_bf16(float lo, float hi) { unsigned r; asm volatile("v_cvt_pk_bf16_f32 %0, %1, %2" : "=v"(r) : "v"(lo), "v"(hi)); return r; }
typedef float f32x2 __attribute__((ext_vector_type(2)));
__device__ __forceinline__ u32x4 pack8(const f32x4 v0, const f32x4 v1) { u32x4 w; w.x = cvt_pk_bf16(v0[0], v0[1]); w.y = cvt_pk_bf16(v0[2], v0[3]); w.z = cvt_pk_bf16(v1[0], v1[1]); w.w = cvt_pk_bf16(v1[2], v1[3]); return w; }

struct EpiPlainBf16 {
    static constexpr bool PERM = true, AFTER_DRAIN = false;
    bf16_t* O; int ldc;
    __device__ __forceinline__ void operator()(const f32x4 (&acc)[2][2][4][2], const Unit& u, int wr, int wc, int fr, int fq) const {
        const int row0 = u.pm * BM + wr * 64 + fr, col0 = u.pn * BM + wc * 32 + 8 * fq;
#pragma unroll
        for (int ai = 0; ai < 2; ++ai)
#pragma unroll
            for (int m = 0; m < 4; ++m) { bf16_t* rowp = O + (size_t)(row0 + ai * HALF + m * 16) * ldc + col0;
#pragma unroll
                for (int bj = 0; bj < 2; ++bj) *(u32x4*)(rowp + bj * HALF) = pack8(acc[ai][bj][m][0], acc[ai][bj][m][1]); }
    }
};
struct EpiFnet {
    static constexpr bool PERM = true, AFTER_DRAIN = false;
    bf16_t* MIX;
    __device__ __forceinline__ void operator()(const f32x4 (&acc)[2][2][4][2], const Unit& u, int wr, int wc, int fr, int fq) const {
        const int row0 = u.pn * 4096 + u.pm * BM + wr * 64 + fr, col0 = 768 + wc * 32 + 8 * fq;
#pragma unroll
        for (int ai = 0; ai < 2; ++ai)
#pragma unroll
            for (int m = 0; m < 4; ++m) { bf16_t* rowp = MIX + (size_t)(row0 + ai * HALF + m * 16) * 1024 + col0;
#pragma unroll
                for (int bj = 0; bj < 2; ++bj) *(u32x4*)(rowp + bj * HALF) = pack8(acc[ai][bj][m][0], acc[ai][bj][m][1]); }
    }
};
struct EpiResF32 {
    static constexpr bool PERM = false, AFTER_DRAIN = false;
    const float* base; float* out; int ldc; float alpha;
    __device__ __forceinline__ void operator()(const f32x4 (&acc)[2][2][4][2], const Unit& u, int wr, int wc, int fr, int fq) const {
        const int row0 = u.pm * BM + wr * 64 + fr, col0 = u.pn * BM + wc * 32 + 4 * fq;
#pragma unroll
        for (int ai = 0; ai < 2; ++ai)
#pragma unroll
            for (int m = 0; m < 4; ++m) { const size_t off = (size_t)(row0 + ai * HALF + m * 16) * ldc + col0;
#pragma unroll
                for (int bj = 0; bj < 2; ++bj)
#pragma unroll
                    for (int n = 0; n < 2; ++n) { const f32x4 b = *(const f32x4*)(base + off + bj * HALF + n * 16); *(f32x4*)(out + off + bj * HALF + n * 16) = b * alpha + acc[ai][bj][m][n]; } }
    }
};
struct EpiResBf16 {
    static constexpr bool PERM = true, AFTER_DRAIN = false;
    const bf16_t* base; bf16_t* out; int ldc; float alpha;
    __device__ __forceinline__ void operator()(const f32x4 (&acc)[2][2][4][2], const Unit& u, int wr, int wc, int fr, int fq) const {
        const int row0 = u.pm * BM + wr * 64 + fr, col0 = u.pn * BM + wc * 32 + 8 * fq;
#pragma unroll
        for (int ai = 0; ai < 2; ++ai)
#pragma unroll
            for (int m = 0; m < 4; ++m) { const size_t off = (size_t)(row0 + ai * HALF + m * 16) * ldc + col0;
#pragma unroll
                for (int bj = 0; bj < 2; ++bj) { const u32x4 b = *(const u32x4*)(base + off + bj * HALF);
                    const f32x4 b0 = {__uint_as_float(b.x << 16), __uint_as_float(b.x & 0xffff0000u), __uint_as_float(b.y << 16), __uint_as_float(b.y & 0xffff0000u)};
                    const f32x4 b1 = {__uint_as_float(b.z << 16), __uint_as_float(b.z & 0xffff0000u), __uint_as_float(b.w << 16), __uint_as_float(b.w & 0xffff0000u)};
                    *(u32x4*)(out + off + bj * HALF) = pack8(b0 * alpha + acc[ai][bj][m][0], b1 * alpha + acc[ai][bj][m][1]); } }
    }
};
__device__ __forceinline__ float swiglu1(float g, float u) { g = fminf(g, 7.0f); u = fminf(fmaxf(u, -7.0f), 7.0f); return (u + 1.0f) * g * __builtin_amdgcn_rcpf(1.0f + __expf(-1.702f * g)); }
struct EpiSwiglu {
    static constexpr bool PERM = true, AFTER_DRAIN = false;
    bf16_t* HID; const float* bgu;
    __device__ __forceinline__ void operator()(const f32x4 (&acc)[2][2][4][2], const Unit& u, int wr, int wc, int fr, int fq) const {
        const int e = u.pn >> 3, pnl = u.pn & 7; const int row0 = u.pm * BM + wr * 64 + fr, jj0 = pnl * 128 + wc * 32 + 8 * fq;
        const float* bg = bgu + (size_t)e * 2048 + jj0;
        const f32x4 bg0 = *(const f32x4*)bg, bg1 = *(const f32x4*)(bg + 4), bu0 = *(const f32x4*)(bg + 1024), bu1 = *(const f32x4*)(bg + 1028);
#pragma unroll
        for (int ai = 0; ai < 2; ++ai)
#pragma unroll
            for (int m = 0; m < 4; ++m) { bf16_t* rowp = HID + (size_t)(row0 + ai * HALF + m * 16) * 1024 + jj0;
                const f32x4 g0 = acc[ai][0][m][0] + bg0, g1 = acc[ai][0][m][1] + bg1, u0 = acc[ai][1][m][0] + bu0, u1 = acc[ai][1][m][1] + bu1;
                f32x4 h0, h1;
#pragma unroll
                for (int i = 0; i < 4; ++i) { h0[i] = swiglu1(g0[i], u0[i]); h1[i] = swiglu1(g1[i], u1[i]); }
                *(u32x4*)rowp = pack8(h0, h1); }
    }
};
struct EpiDown {
    static constexpr bool PERM = true, AFTER_DRAIN = false;
    bf16_t* Y; const float* bd;
    __device__ __forceinline__ void operator()(const f32x4 (&acc)[2][2][4][2], const Unit& u, int wr, int wc, int fr, int fq) const {
        const int e = u.pn >> 2, pnl = u.pn & 3; const int row0 = u.pm * BM + wr * 64 + fr, col0 = pnl * BM + wc * 32 + 8 * fq;
        const float* bp = bd + (size_t)e * 1024 + col0;
        f32x4 bv[2][2];
#pragma unroll
        for (int bj = 0; bj < 2; ++bj)
#pragma unroll
            for (int n = 0; n < 2; ++n) bv[bj][n] = *(const f32x4*)(bp + bj * HALF + 4 * n);
#pragma unroll
        for (int ai = 0; ai < 2; ++ai)
#pragma unroll
            for (int m = 0; m < 4; ++m) { bf16_t* rowp = Y + (size_t)(row0 + ai * HALF + m * 16) * 1024 + col0;
#pragma unroll
                for (int bj = 0; bj < 2; ++bj) *(u32x4*)(rowp + bj * HALF) = pack8(acc[ai][bj][m][0] + bv[bj][0], acc[ai][bj][m][1] + bv[bj][1]); }
    }
};
struct EpiNull {
    static constexpr bool PERM = true, AFTER_DRAIN = false;
    bf16_t* O;
    __device__ __forceinline__ void operator()(const f32x4 (&acc)[2][2][4][2], const Unit& u, int wr, int wc, int fr, int fq) const {
#pragma unroll
        for (int ai = 0; ai < 2; ++ai)
#pragma unroll
            for (int bj = 0; bj < 2; ++bj)
#pragma unroll
                for (int m = 0; m < 4; ++m)
#pragma unroll
                    for (int n = 0; n < 2; ++n) asm volatile("" :: "v"(acc[ai][bj][m][n]));
    }
};
struct ListOrder {
    const PG8_LAS int* list; int n;
    __device__ __forceinline__ bool next(int i, Unit& u) const { if (i >= n) return false; const int v = __builtin_amdgcn_readfirstlane(list[i]); u.pm = v >> 16; u.pn = v & 0xffff; return true; }
    __device__ __forceinline__ void a_ready(const Unit&) const {}
    __device__ __forceinline__ void done(const Unit&) const {}
};
template <class Epi, class Sched, bool ALIGN_EPI = false, bool SP2 = false>
__device__ __forceinline__ void gemm_phase(PG8_LAS unsigned char* lds, const Gemm g, const Sched& S, const Epi& E) {
    int tid_ = threadIdx.x; asm volatile("" : "+v"(tid_));
    const int tid = tid_, wid = __builtin_amdgcn_readfirstlane(tid >> 6), lane = tid & 63, wr = wid >> 2, wc = wid & 3, fr = lane & 15, fq = lane >> 4;
    const int K = g.K, nt = K / BK;
    unsigned voffA[2], voffB[2];
#pragma unroll
    for (int i = 0; i < 2; ++i) { int R, C; stage_rc(tid * 16 + i * 8192, R, C); const int Rb = Epi::PERM ? ((R & ~31) + perm32(R & 31)) : R;
        voffA[i] = (unsigned)(R * K + C) * 2u; voffB[i] = (unsigned)(Rb * K + C) * 2u; }
    const size_t kstep = (size_t)(BK * 2);
    const size_t hstep = (size_t)HALF * K * 2;
    const size_t tstep = 2 * hstep;
    const unsigned ldsw = (unsigned)wid * 1024u;
    const int aoff = lds_byte(wr * 64 + fr, fq * 8), boff = lds_byte(wc * 32 + fr, fq * 8);
#define PG8_SA(b, h) (((b) * 2 + (h)) * HTB)
#define PG8_SB(b, h) ((4 + (b) * 2 + (h)) * HTB)
#define PG8_STAGE(bufoff, gbase, voff) do { _Pragma("unroll") for (int _i = 0; _i < 2; ++_i) \
        __builtin_amdgcn_global_load_lds((const unsigned*)((const char*)(gbase) + (voff)[_i]), (PG8_LAS unsigned*)(lds + (bufoff) + ldsw + _i * 8192), 16, 0, 0); } while (0)
#define PG8_LDA(dst, b, h) do { _Pragma("unroll") for (int m = 0; m < 4; ++m) _Pragma("unroll") for (int k = 0; k < 2; ++k) dst[m][k] = *(const PG8_LAS bf16x8*)(lds + PG8_SA(b, h) + aoff + m * 2048 + k * 1024); } while (0)
#define PG8_LDB(dst, b, h) do { _Pragma("unroll") for (int n = 0; n < 2; ++n) _Pragma("unroll") for (int k = 0; k < 2; ++k) dst[n][k] = *(const PG8_LAS bf16x8*)(lds + PG8_SB(b, h) + boff + n * 2048 + k * 1024); } while (0)
#define PG8_MMA(ai, bj, At, Bt) do { __builtin_amdgcn_s_setprio(1); _Pragma("unroll") for (int m = 0; m < 4; ++m) _Pragma("unroll") for (int n = 0; n < 2; ++n) _Pragma("unroll") for (int k = 0; k < 2; ++k) \
        acc[ai][bj][m][n] = __builtin_amdgcn_mfma_f32_16x16x32_bf16(Bt[n][k], At[m][k], acc[ai][bj][m][n], 0, 0, 0); __builtin_amdgcn_s_setprio(0); } while (0)
#define PG8_WAIT_V(n) asm volatile("s_waitcnt vmcnt(" #n ")" ::: "memory")
#define PG8_WAIT_L(n) asm volatile("s_waitcnt lgkmcnt(" #n ")" ::: "memory")
#define PG8_BAR __builtin_amdgcn_s_barrier()
#define PG8_SCHED __builtin_amdgcn_sched_barrier(0)
    Unit cur, nxt; int ui = 0;
    if (!S.next(0, cur)) return;
    f32x4 acc[2][2][4][2];
#pragma unroll
    for (int a = 0; a < 2; ++a)
#pragma unroll
        for (int b = 0; b < 2; ++b)
#pragma unroll
            for (int m = 0; m < 4; ++m)
#pragma unroll
                for (int n = 0; n < 2; ++n) acc[a][b][m][n] = (f32x4){0.f, 0.f, 0.f, 0.f};
    bf16x8 At[4][2], B0[2][2], B1[2][2];
    const char* cA = (const char*)g.A + (size_t)cur.pm * tstep; const char* cB = (const char*)g.Bt + (size_t)cur.pn * tstep;
    S.a_ready(cur);
    if constexpr (SP2) {
        PG8_STAGE(PG8_SB(0, 0), cB, voffB); PG8_STAGE(PG8_SB(0, 1), cB + hstep, voffB); PG8_STAGE(PG8_SA(0, 0), cA, voffA); PG8_STAGE(PG8_SA(0, 1), cA + hstep, voffA);
        if (wr == 1) PG8_BAR;
        PG8_WAIT_V(2); PG8_BAR;
        PG8_STAGE(PG8_SB(1, 0), cB + kstep, voffB); PG8_STAGE(PG8_SA(1, 0), cA + kstep, voffA); PG8_STAGE(PG8_SB(1, 1), cB + hstep + kstep, voffB);
        PG8_WAIT_V(6); PG8_BAR;
    } else {
        PG8_STAGE(PG8_SB(0, 0), cB, voffB); PG8_STAGE(PG8_SA(0, 0), cA, voffA); PG8_STAGE(PG8_SB(0, 1), cB + hstep, voffB); PG8_STAGE(PG8_SA(0, 1), cA + hstep, voffA);
        if (wr == 1) PG8_BAR;
        PG8_WAIT_V(4); PG8_BAR;
        PG8_STAGE(PG8_SB(1, 0), cB + kstep, voffB); PG8_STAGE(PG8_SA(1, 0), cA + kstep, voffA); PG8_STAGE(PG8_SB(1, 1), cB + hstep + kstep, voffB);
        PG8_WAIT_V(6); PG8_BAR;
    }
    for (;;) {
        const bool has_next = S.next(ui + 1, nxt);
        const char* nA = has_next ? (const char*)g.A + (size_t)nxt.pm * tstep : cA; const char* nB = has_next ? (const char*)g.Bt + (size_t)nxt.pn * tstep : cB;
        for (int t = 0; t < nt; t += 2) {
            const bool last = (t == nt - 2);
            const char* a1 = cA + (size_t)(t + 1) * kstep;
            const char* a2 = last ? nA : cA + (size_t)(t + 2) * kstep; const char* b2 = last ? nB : cB + (size_t)(t + 2) * kstep;
            const char* a3 = a2 + kstep; const char* b3 = b2 + kstep;
            if (last && has_next) S.a_ready(nxt);
            if constexpr (SP2) {
            PG8_LDB(B0, 0, 0); PG8_LDB(B1, 0, 1); PG8_SCHED; PG8_LDA(At, 0, 0); PG8_STAGE(PG8_SA(1, 1), a1 + hstep, voffA);
            PG8_WAIT_V(8); PG8_WAIT_L(0); PG8_BAR; PG8_MMA(0, 0, At, B0); PG8_MMA(0, 1, At, B1); PG8_BAR; PG8_SCHED;
            PG8_LDA(At, 0, 1); PG8_STAGE(PG8_SB(0, 0), b2, voffB); PG8_STAGE(PG8_SB(0, 1), b2 + hstep, voffB); PG8_STAGE(PG8_SA(0, 0), a2, voffA);
            PG8_WAIT_V(8); PG8_WAIT_L(0); PG8_BAR; PG8_MMA(1, 0, At, B0); PG8_MMA(1, 1, At, B1); PG8_BAR; PG8_SCHED;
            PG8_LDB(B0, 1, 0); PG8_LDB(B1, 1, 1); PG8_SCHED; PG8_LDA(At, 1, 0); PG8_STAGE(PG8_SA(0, 1), a2 + hstep, voffA);
            PG8_WAIT_V(8); PG8_WAIT_L(0); PG8_BAR; PG8_MMA(0, 0, At, B0); PG8_MMA(0, 1, At, B1); PG8_BAR; PG8_SCHED;
            PG8_LDA(At, 1, 1); PG8_STAGE(PG8_SB(1, 0), b3, voffB); PG8_STAGE(PG8_SB(1, 1), b3 + hstep, voffB); PG8_STAGE(PG8_SA(1, 0), a3, voffA);
            PG8_WAIT_V(8); PG8_WAIT_L(0); PG8_BAR; PG8_MMA(1, 0, At, B0); PG8_MMA(1, 1, At, B1); PG8_BAR; PG8_SCHED;
            } else {
            PG8_LDB(B0, 0, 0); PG8_SCHED; PG8_LDA(At, 0, 0); PG8_STAGE(PG8_SA(1, 1), a1 + hstep, voffA);
            PG8_WAIT_L(8); PG8_BAR; PG8_WAIT_L(0); PG8_MMA(0, 0, At, B0); PG8_BAR; PG8_SCHED;
            PG8_LDB(B1, 0, 1); PG8_STAGE(PG8_SB(0, 0), b2, voffB);
            PG8_BAR; PG8_WAIT_L(0); PG8_MMA(0, 1, At, B1); PG8_BAR;
            PG8_LDA(At, 0, 1); PG8_STAGE(PG8_SA(0, 0), a2, voffA);
            PG8_BAR; PG8_WAIT_L(0); PG8_MMA(1, 0, At, B0); PG8_BAR; PG8_SCHED;
            PG8_STAGE(PG8_SB(0, 1), b2 + hstep, voffB);
            PG8_WAIT_V(6); PG8_BAR; PG8_MMA(1, 1, At, B1); PG8_BAR;
            PG8_LDB(B0, 1, 0); PG8_SCHED; PG8_LDA(At, 1, 0); PG8_STAGE(PG8_SA(0, 1), a2 + hstep, voffA);
            PG8_WAIT_L(8); PG8_BAR; PG8_WAIT_L(0); PG8_MMA(0, 0, At, B0); PG8_BAR; PG8_SCHED;
            PG8_LDB(B1, 1, 1); PG8_STAGE(PG8_SB(1, 0), b3, voffB);
            PG8_BAR; PG8_WAIT_L(0); PG8_MMA(0, 1, At, B1); PG8_BAR;
            PG8_LDA(At, 1, 1); PG8_STAGE(PG8_SA(1, 0), a3, voffA);
            PG8_BAR; PG8_WAIT_L(0); PG8_MMA(1, 0, At, B0); PG8_BAR; PG8_SCHED;
            PG8_STAGE(PG8_SB(1, 1), b3 + hstep, voffB);
            PG8_WAIT_V(6); PG8_BAR; PG8_MMA(1, 1, At, B1); PG8_BAR;
            }
        }
        if constexpr (ALIGN_EPI) { if (wr == 0) PG8_BAR; }
        if constexpr (!Epi::AFTER_DRAIN) { E(acc, cur, wr, wc, fr, fq); S.done(cur); }
        if (!has_next) break;
#pragma unroll
        for (int a = 0; a < 2; ++a)
#pragma unroll
            for (int b = 0; b < 2; ++b)
#pragma unroll
                for (int m = 0; m < 4; ++m)
#pragma unroll
                    for (int n = 0; n < 2; ++n) acc[a][b][m][n] = (f32x4){0.f, 0.f, 0.f, 0.f};
        cur = nxt; cA = nA; cB = nB; ++ui;
        if constexpr (ALIGN_EPI) { if (wr == 1) PG8_BAR; }
    }
    PG8_WAIT_V(0);
    if constexpr (!ALIGN_EPI) { if (wr == 0) PG8_BAR; }
    PG8_BAR;
    if constexpr (Epi::AFTER_DRAIN) { E.fused(acc, cur, wr, wc, fr, fq, lds, wid, lane); S.done(cur); }
#undef PG8_SA
#undef PG8_SB
#undef PG8_STAGE
#undef PG8_LDA
#undef PG8_LDB
#undef PG8_MMA
#undef PG8_WAIT_V
#undef PG8_WAIT_L
#undef PG8_BAR
#undef PG8_SCHED
}
}
namespace pg8 {
template <class Epi, class Sched, bool ALIGN_EPI>
__device__ __forceinline__ void gemm_phase_gather(PG8_LAS unsigned char* lds, const Gemm g, const Sched& S, const Epi& E, const PG8_LAS unsigned short* rows16) {
    int tid_ = threadIdx.x; asm volatile("" : "+v"(tid_));
    const int tid = tid_, wid = __builtin_amdgcn_readfirstlane(tid >> 6), lane = tid & 63, wr = wid >> 2, wc = wid & 3, fr = lane & 15, fq = lane >> 4;
    const int K = g.K, nt = K / BK;
    unsigned voffB[2]; int RA[2]; unsigned CA2[2];
#pragma unroll
    for (int i = 0; i < 2; ++i) { int R, C; stage_rc(tid * 16 + i * 8192, R, C); const int Rb = Epi::PERM ? ((R & ~31) + perm32(R & 31)) : R;
        RA[i] = R; CA2[i] = (unsigned)C * 2u; voffB[i] = (unsigned)(Rb * K + C) * 2u; }
    const size_t kstep = (size_t)(BK * 2);
    const size_t hstep = (size_t)HALF * K * 2;
    const size_t tstep = 2 * hstep;
    const unsigned ldsw = (unsigned)wid * 1024u;
    const unsigned rowb = (unsigned)K * 2u;
    const int aoff = lds_byte(wr * 64 + fr, fq * 8), boff = lds_byte(wc * 32 + fr, fq * 8);
#define PG8_SA(b, h) (((b) * 2 + (h)) * HTB)
#define PG8_SB(b, h) ((4 + (b) * 2 + (h)) * HTB)
#define PG8_STAGE(bufoff, gbase, voff) do { _Pragma("unroll") for (int _i = 0; _i < 2; ++_i) \
        __builtin_amdgcn_global_load_lds((const unsigned*)((const char*)(gbase) + (voff)[_i]), (PG8_LAS unsigned*)(lds + (bufoff) + ldsw + _i * 8192), 16, 0, 0); } while (0)
#define PG8_LDA(dst, b, h) do { _Pragma("unroll") for (int m = 0; m < 4; ++m) _Pragma("unroll") for (int k = 0; k < 2; ++k) dst[m][k] = *(const PG8_LAS bf16x8*)(lds + PG8_SA(b, h) + aoff + m * 2048 + k * 1024); } while (0)
#define PG8_LDB(dst, b, h) do { _Pragma("unroll") for (int n = 0; n < 2; ++n) _Pragma("unroll") for (int k = 0; k < 2; ++k) dst[n][k] = *(const PG8_LAS bf16x8*)(lds + PG8_SB(b, h) + boff + n * 2048 + k * 1024); } while (0)
#define PG8_MMA(ai, bj, At, Bt) do { __builtin_amdgcn_s_setprio(1); _Pragma("unroll") for (int m = 0; m < 4; ++m) _Pragma("unroll") for (int n = 0; n < 2; ++n) _Pragma("unroll") for (int k = 0; k < 2; ++k) \
        acc[ai][bj][m][n] = __builtin_amdgcn_mfma_f32_16x16x32_bf16(Bt[n][k], At[m][k], acc[ai][bj][m][n], 0, 0, 0); __builtin_amdgcn_s_setprio(0); } while (0)
#define PG8_WAIT_V(n) asm volatile("s_waitcnt vmcnt(" #n ")" ::: "memory")
#define PG8_WAIT_L(n) asm volatile("s_waitcnt lgkmcnt(" #n ")" ::: "memory")
#define PG8_BAR __builtin_amdgcn_s_barrier()
#define PG8_SCHED __builtin_amdgcn_sched_barrier(0)
#define PG8_GOFF(dst, U) do { _Pragma("unroll") for (int h_ = 0; h_ < 2; ++h_) _Pragma("unroll") for (int i_ = 0; i_ < 2; ++i_) dst[h_][i_] = (unsigned)rows16[(U) * 256 + h_ * HALF + RA[i_]] * rowb + CA2[i_]; } while (0)
    Unit cur, nxt; int ui = 0;
    if (!S.next(0, cur)) return;
    f32x4 acc[2][2][4][2];
#pragma unroll
    for (int a = 0; a < 2; ++a)
#pragma unroll
        for (int b = 0; b < 2; ++b)
#pragma unroll
            for (int m = 0; m < 4; ++m)
#pragma unroll
                for (int n = 0; n < 2; ++n) acc[a][b][m][n] = (f32x4){0.f, 0.f, 0.f, 0.f};
    bf16x8 At[4][2], B0[2][2], B1[2][2];
    const char* const Ab = (const char*)g.A;
    const char* cB = (const char*)g.Bt + (size_t)cur.pn * tstep;
    unsigned gc[2][2], gn[2][2];
    PG8_GOFF(gc, 0);
    S.a_ready(cur);
    PG8_STAGE(PG8_SB(0, 0), cB, voffB); PG8_STAGE(PG8_SB(0, 1), cB + hstep, voffB); PG8_STAGE(PG8_SA(0, 0), Ab, gc[0]); PG8_STAGE(PG8_SA(0, 1), Ab, gc[1]);
    if (wr == 1) PG8_BAR;
    PG8_WAIT_V(2); PG8_BAR;
    PG8_STAGE(PG8_SB(1, 0), cB + kstep, voffB); PG8_STAGE(PG8_SA(1, 0), Ab + kstep, gc[0]); PG8_STAGE(PG8_SB(1, 1), cB + hstep + kstep, voffB);
    PG8_WAIT_V(6); PG8_BAR;
    for (;;) {
        const bool has_next = S.next(ui + 1, nxt);
        const char* nB = has_next ? (const char*)g.Bt + (size_t)nxt.pn * tstep : cB;
        if (has_next) { PG8_GOFF(gn, ui + 1); } else {
#pragma unroll
            for (int h_ = 0; h_ < 2; ++h_)
#pragma unroll
                for (int i_ = 0; i_ < 2; ++i_) gn[h_][i_] = gc[h_][i_]; }
        for (int t = 0; t < nt; t += 2) {
            const bool last = (t == nt - 2);
            const char* a1 = Ab + (size_t)(t + 1) * kstep;
            const char* a2 = last ? Ab : Ab + (size_t)(t + 2) * kstep; const char* b2 = last ? nB : cB + (size_t)(t + 2) * kstep;
            const char* a3 = a2 + kstep; const char* b3 = b2 + kstep;
            unsigned g2[2][2];
#pragma unroll
            for (int h_ = 0; h_ < 2; ++h_)
#pragma unroll
                for (int i_ = 0; i_ < 2; ++i_) g2[h_][i_] = last ? gn[h_][i_] : gc[h_][i_];
            if (last && has_next) S.a_ready(nxt);
            PG8_LDB(B0, 0, 0); PG8_LDB(B1, 0, 1); PG8_SCHED; PG8_LDA(At, 0, 0); PG8_STAGE(PG8_SA(1, 1), a1, gc[1]);
            PG8_WAIT_V(8); PG8_WAIT_L(0); PG8_BAR; PG8_MMA(0, 0, At, B0); PG8_MMA(0, 1, At, B1); PG8_BAR; PG8_SCHED;
            PG8_LDA(At, 0, 1); PG8_STAGE(PG8_SB(0, 0), b2, voffB); PG8_STAGE(PG8_SB(0, 1), b2 + hstep, voffB); PG8_STAGE(PG8_SA(0, 0), a2, g2[0]);
            PG8_WAIT_V(8); PG8_WAIT_L(0); PG8_BAR; PG8_MMA(1, 0, At, B0); PG8_MMA(1, 1, At, B1); PG8_BAR; PG8_SCHED;
            PG8_LDB(B0, 1, 0); PG8_LDB(B1, 1, 1); PG8_SCHED; PG8_LDA(At, 1, 0); PG8_STAGE(PG8_SA(0, 1), a2, g2[1]);
            PG8_WAIT_V(8); PG8_WAIT_L(0); PG8_BAR; PG8_MMA(0, 0, At, B0); PG8_MMA(0, 1, At, B1); PG8_BAR; PG8_SCHED;
            PG8_LDA(At, 1, 1); PG8_STAGE(PG8_SB(1, 0), b3, voffB); PG8_STAGE(PG8_SB(1, 1), b3 + hstep, voffB); PG8_STAGE(PG8_SA(1, 0), a3, g2[0]);
            PG8_WAIT_V(8); PG8_WAIT_L(0); PG8_BAR; PG8_MMA(1, 0, At, B0); PG8_MMA(1, 1, At, B1); PG8_BAR; PG8_SCHED;
        }
        if constexpr (ALIGN_EPI) { if (wr == 0) PG8_BAR; }
        E(acc, cur, wr, wc, fr, fq); S.done(cur);
        if (!has_next) break;
#pragma unroll
        for (int a = 0; a < 2; ++a)
#pragma unroll
            for (int b = 0; b < 2; ++b)
#pragma unroll
                for (int m = 0; m < 4; ++m)
#pragma unroll
                    for (int n = 0; n < 2; ++n) acc[a][b][m][n] = (f32x4){0.f, 0.f, 0.f, 0.f};
        cur = nxt; cB = nB; ++ui;
#pragma unroll
        for (int h_ = 0; h_ < 2; ++h_)
#pragma unroll
            for (int i_ = 0; i_ < 2; ++i_) gc[h_][i_] = gn[h_][i_];
        if constexpr (ALIGN_EPI) { if (wr == 1) PG8_BAR; }
    }
    PG8_WAIT_V(0);
    if constexpr (!ALIGN_EPI) { if (wr == 0) PG8_BAR; }
    PG8_BAR;
#undef PG8_SA
#undef PG8_SB
#undef PG8_STAGE
#undef PG8_LDA
#undef PG8_LDB
#undef PG8_MMA
#undef PG8_WAIT_V
#undef PG8_WAIT_L
#undef PG8_BAR
#undef PG8_SCHED
#undef PG8_GOFF
}
}
#define GAS __attribute__((address_space(1)))
#define LAS __attribute__((address_space(3)))
typedef unsigned short bf16;
typedef unsigned v4u __attribute__((ext_vector_type(4)));
typedef float f32x4 __attribute__((ext_vector_type(4)));
typedef short bf16x8 __attribute__((ext_vector_type(8)));
typedef GAS unsigned gu32;
typedef GAS unsigned long long gu64;
#define RLX_AGENT __ATOMIC_RELAXED, __HIP_MEMORY_SCOPE_AGENT
#define LDS_WAIT() asm volatile("s_waitcnt lgkmcnt(0)" ::: "memory")
#define VM_WAIT() asm volatile("s_waitcnt vmcnt(0)" ::: "memory")
__device__ __forceinline__ unsigned long long rt() { return __builtin_amdgcn_s_memrealtime(); }
__device__ __forceinline__ unsigned f2bf(float f) { unsigned u = __builtin_bit_cast(unsigned, f); return (u + 0x7fffu + ((u >> 16) & 1u)) >> 16; }
__device__ __forceinline__ unsigned pk2(float lo, float hi) { return f2bf(lo) | (f2bf(hi) << 16); }
#define XB_TMO      128
#define XB_XCNT(j)  (256  + 64 * (j))
#define XB_XSUB(j)  (1280 + 64 * (j))
#define XB_XGEN(j)  (2304 + 64 * (j))
#define XB_TOP      3328
#define XB_TOPGEN   3392
#define XCD_BAR_WORDS 3456
#define XB_SPIN_CAP (1u << 18)

__device__ __forceinline__ unsigned xb_ld(unsigned* p)              { return __hip_atomic_load(p, __ATOMIC_RELAXED, __HIP_MEMORY_SCOPE_AGENT); }
__device__ __forceinline__ unsigned xb_add(unsigned* p, unsigned v) { return __hip_atomic_fetch_add(p, v, __ATOMIC_RELAXED, __HIP_MEMORY_SCOPE_AGENT); }
__device__ __forceinline__ unsigned xb_xcc_id() { return (unsigned)__builtin_amdgcn_s_getreg((3 << 11) | 20) & 0xFu; }
#define XB_SPIN(cond, bar) do { unsigned _sp = 0; while (cond) { __builtin_amdgcn_s_sleep(1); \
    if ((++_sp & 255u) == 0u) { if (xb_ld(&(bar)[XB_TMO])) break; if (_sp > XB_SPIN_CAP) { atomicAdd(&(bar)[XB_TMO], 1u); break; } } } } while (0)

struct XcdBarrier {
    unsigned* bar; unsigned x;
    volatile LAS unsigned* st;
};

__device__ __forceinline__ XcdBarrier xcd_barrier_post(unsigned* bar, volatile LAS unsigned* st) {
    XcdBarrier b; b.bar = bar; b.x = xb_xcc_id(); b.st = st;
    if (threadIdx.x == 0) (void)xb_add(&bar[XB_XCNT(b.x)], 1u);
    return b;
}
__device__ __forceinline__ void xcd_barrier_complete(unsigned* bar, unsigned x, unsigned& nloc, unsigned& nx) {
    const unsigned G = gridDim.x * gridDim.y * gridDim.z;
    unsigned sum, cnt, mine, sp = 0u;
    for (;;) {
        sum = 0u; cnt = 0u; mine = 0u;
#pragma unroll
        for (unsigned j = 0; j < 16; ++j) { const unsigned c = xb_ld(&bar[XB_XCNT(j)]); sum += c; cnt += (c > 0u) ? 1u : 0u; mine = (j == x) ? c : mine; }
        if (sum == G) break;
        __builtin_amdgcn_s_sleep(1);
        if ((++sp & 255u) == 0u) { if (xb_ld(&bar[XB_TMO])) break; if (sp > XB_SPIN_CAP) { atomicAdd(&bar[XB_TMO], 1u); break; } }
    }
    nloc = mine > 0u ? mine : 1u; nx = cnt > 0u ? cnt : 1u;
}

__device__ __forceinline__ void xcd_barrier(const XcdBarrier& b) {
    asm volatile("s_waitcnt vmcnt(0)" ::: "memory");
    __syncthreads();
    if (threadIdx.x == 0) {
        unsigned* bar = b.bar;
        __builtin_amdgcn_s_waitcnt(0);
        unsigned nloc = b.st[0], nx = b.st[1];
        if (nloc == 0u) { xcd_barrier_complete(bar, b.x, nloc, nx); b.st[0] = nloc; b.st[1] = nx; }
        const unsigned old = xb_add(&bar[XB_XSUB(b.x)], 1u);
        const unsigned gen = old / nloc;
        if (old + 1u == (gen + 1u) * nloc) {
            __builtin_amdgcn_fence(__ATOMIC_RELEASE, "agent");
            asm volatile("s_waitcnt vmcnt(0)" ::: "memory");
            const unsigned og = xb_add(&bar[XB_TOP], 1u);
            const unsigned tg = og / nx;
            if (og + 1u == (tg + 1u) * nx) xb_add(&bar[XB_TOPGEN], 1u);
            else XB_SPIN(xb_ld(&bar[XB_TOPGEN]) == tg, bar);
            __builtin_amdgcn_fence(__ATOMIC_ACQUIRE, "agent");
            xb_add(&bar[XB_XGEN(b.x)], 1u);
            asm volatile("s_waitcnt vmcnt(0)" ::: "memory");
        } else {
            XB_SPIN(xb_ld(&bar[XB_XGEN(b.x)]) == gen, bar);
            __builtin_amdgcn_fence(__ATOMIC_ACQUIRE, "agent");
            asm volatile("s_waitcnt vmcnt(0)" ::: "memory");
        }
    }
    __syncthreads();
}
namespace attn_body {
using bf16=__hip_bfloat16;
using bf16x8=__attribute__((ext_vector_type(8)))short;
using s16x4=__attribute__((ext_vector_type(4)))short;
using f32x16=__attribute__((ext_vector_type(16)))float;
using u32x4=__attribute__((ext_vector_type(4)))unsigned;
constexpr int BATCH=8,NHEAD=8,NKVH=2,SEQ=4096,D=64;
constexpr int DMQ=512,DMK=128,DMV=2048,DMO=1024;
constexpr int NW=8,QBLK=32,QB=QBLK*NW,KVBLK=64,NQB=SEQ/QB;
constexpr int ATTN_UNIT_ROWS=QB;
__device__ __forceinline__ int crow(int r,int hi){return (r&3)+8*(r>>2)+4*hi;}
#define SBAR() __builtin_amdgcn_sched_barrier(0)
__device__ __forceinline__ void cmask(f32x16&p0,f32x16&p1,int jb,int qrel,int hi){
  const float NEG=-INFINITY; int kb=64*jb+4*hi;
  #pragma unroll
  for(int r=0;r<16;++r){int kv=kb+(r&3)+8*(r>>2); if(kv>qrel)p0[r]=NEG; if(kv+32>qrel)p1[r]=NEG;}
}

constexpr int NSLOT=3, SLOTB=8192;
constexpr int LDS_K=0, LDS_V=NSLOT*SLOTB, LDS_WS=2*NSLOT*SLOTB, LDS_OST=LDS_WS+NW*64*4, LDS_BYTES=LDS_OST+NW*4096;
constexpr float C2=0.125f*1.4426950408889634f;
__device__ __forceinline__ void glds16(const void*gsrc,unsigned lds_dst){unsigned keep;
  asm volatile("s_mov_b32 %0, m0\n\ts_mov_b32 m0, %2\n\ts_nop 0\n\tglobal_load_lds_dwordx4 %1, off\n\ts_mov_b32 m0, %0":"=&s"(keep):"v"(gsrc),"s"(lds_dst):"memory");}
__device__ __forceinline__ float max3f(float a,float b,float c){float r;asm("v_max3_f32 %0, %1, %2, %3":"=v"(r):"v"(a),"v"(b),"v"(c));return r;}
__device__ __forceinline__ float max2f(float a,float b){float r;asm("v_max_f32_e32 %0, %1, %2":"=v"(r):"v"(a),"v"(b));return r;}
__device__ __forceinline__ float fadd_s(float a,float b){float r;asm("v_add_f32_e32 %0, %1, %2":"=v"(r):"v"(a),"v"(b));return r;}
__device__ __forceinline__ float fsub_s(float a,float b){float r;asm("v_sub_f32_e32 %0, %1, %2":"=v"(r):"v"(a),"v"(b));return r;}
typedef float f32x2_t __attribute__((ext_vector_type(2))); typedef __bf16 bf16x2_t __attribute__((ext_vector_type(2)));
__device__ __forceinline__ unsigned cvtpk_s(float lo,float hi){f32x2_t v={lo,hi};bf16x2_t b=__builtin_convertvector(v,bf16x2_t);return __builtin_bit_cast(unsigned,b);}
#define WAIT_BAR(N) asm volatile("s_waitcnt vmcnt(" #N ") lgkmcnt(0)\n\ts_barrier":::"memory")

__device__ __forceinline__ void qkt(f32x16&p0,f32x16&p1,const char*Kslot,const bf16x8*qr,const f32x16&negm,int r32,int hi){
  const char*kb=Kslot+hi*1024+r32*16;
  #pragma unroll
  for(int d0=0;d0<4;++d0){
    const bf16x8 b0=*reinterpret_cast<const bf16x8*>(kb+d0*2048);
    const bf16x8 b1=*reinterpret_cast<const bf16x8*>(kb+d0*2048+512);
    if(d0==0){p0=__builtin_amdgcn_mfma_f32_32x32x16_bf16(b0,qr[0],negm,0,0,0);p1=__builtin_amdgcn_mfma_f32_32x32x16_bf16(b1,qr[0],negm,0,0,0);}
    else{p0=__builtin_amdgcn_mfma_f32_32x32x16_bf16(b0,qr[d0],p0,0,0,0);p1=__builtin_amdgcn_mfma_f32_32x32x16_bf16(b1,qr[d0],p1,0,0,0);}}
}
typedef __attribute__((address_space(3))) const char* lds_cptr;
typedef short v4i16_t __attribute__((ext_vector_type(4)));
__device__ __forceinline__ void kload8(bf16x8*kf,lds_cptr kp){
  kf[0]=*(const __attribute__((address_space(3))) bf16x8*)(kp);      kf[1]=*(const __attribute__((address_space(3))) bf16x8*)(kp+512);
  kf[2]=*(const __attribute__((address_space(3))) bf16x8*)(kp+2048); kf[3]=*(const __attribute__((address_space(3))) bf16x8*)(kp+2560);
  kf[4]=*(const __attribute__((address_space(3))) bf16x8*)(kp+4096); kf[5]=*(const __attribute__((address_space(3))) bf16x8*)(kp+4608);
  kf[6]=*(const __attribute__((address_space(3))) bf16x8*)(kp+6144); kf[7]=*(const __attribute__((address_space(3))) bf16x8*)(kp+6656);
}
__device__ __forceinline__ void kload2(bf16x8*kf,lds_cptr kp,int j){ kf[2*j]=*(const __attribute__((address_space(3))) bf16x8*)(kp+j*2048); kf[2*j+1]=*(const __attribute__((address_space(3))) bf16x8*)(kp+j*2048+512); }
__device__ __forceinline__ s16x4 vtr(lds_cptr p){ return __builtin_bit_cast(s16x4,__builtin_amdgcn_ds_read_tr16_b64_v4i16((__attribute__((address_space(3))) v4i16_t*)p)); }
__device__ __forceinline__ float rowmax(const f32x16&p0,const f32x16&p1){
  float a=max3f(p0[0],p0[1],p1[0]),b=max3f(p0[2],p0[3],p1[1]);a=max3f(a,p1[2],p1[3]);
  #pragma unroll
  for(int r=4;r<16;r+=4){a=max3f(a,p0[r],p0[r+1]);b=max3f(b,p0[r+2],p0[r+3]);a=max3f(a,p1[r],p1[r+1]);b=max3f(b,p1[r+2],p1[r+3]);}
  const float m=max2f(a,b);
  auto rr=__builtin_amdgcn_permlane32_swap(__float_as_uint(m),__float_as_uint(m),false,false);
  return max2f(__uint_as_float(rr[0]),__uint_as_float(rr[1]));
}
__device__ __forceinline__ void pv(f32x16*o,int vb,bf16x8 pa0,bf16x8 pa1,bf16x8 pa2,bf16x8 pa3){
  #pragma unroll
  for(int d0=0;d0<2;++d0){s16x4 lo[4],hi[4];
    #pragma unroll
    for(int ks=0;ks<4;++ks){
      asm volatile("ds_read_b64_tr_b16 %0,%1 offset:%c2":"=&v"(lo[ks]):"v"(vb),"i"(d0*4096+ks*1024):"memory");
      asm volatile("ds_read_b64_tr_b16 %0,%1 offset:%c2":"=&v"(hi[ks]):"v"(vb),"i"(d0*4096+ks*1024+512):"memory");}
    asm volatile("s_waitcnt lgkmcnt(0)":::"memory");SBAR();
    #define PK(k) (bf16x8){lo[k][0],lo[k][1],lo[k][2],lo[k][3],hi[k][0],hi[k][1],hi[k][2],hi[k][3]}
    o[d0]=__builtin_amdgcn_mfma_f32_32x32x16_bf16(pa0,PK(0),o[d0],0,0,0);
    o[d0]=__builtin_amdgcn_mfma_f32_32x32x16_bf16(pa1,PK(1),o[d0],0,0,0);
    o[d0]=__builtin_amdgcn_mfma_f32_32x32x16_bf16(pa2,PK(2),o[d0],0,0,0);
    o[d0]=__builtin_amdgcn_mfma_f32_32x32x16_bf16(pa3,PK(3),o[d0],0,0,0);
    #undef PK
  }
}

#ifndef ATTN_STORE16
#define ATTN_STORE16(p,v) (*(u32x4*)(p)=(v))
#endif
template<int THRL> __device__ __forceinline__ void attn_unit(int b,int h,int qb,const bf16*Q,const bf16*__restrict__ K,const bf16*__restrict__ V,bf16*O,char*shm){
  int tid_=threadIdx.x; asm volatile("":"+v"(tid_)); const int tid=tid_,lane=tid&63,r32=lane&31,hi=lane>>5; const int wid=__builtin_amdgcn_readfirstlane(tid>>6);
  const long rowbase=(long)b*SEQ; const int q0=qb*QB;
  const bf16*Qw=Q+(rowbase+q0+wid*QBLK)*DMQ+h*D; const int kvh=h>>2;
  const bf16*Kh=K+rowbase*DMK+kvh*D,*Vh=V+rowbase*DMV+kvh*D;
  const unsigned lds0=(unsigned)(uintptr_t)shm;
  float*wsf=(float*)(shm+LDS_WS)+wid*64;
  const bf16*ksrc=Kh+(long)lane*DMK+wid*8;
  const bf16*vsrc=Vh+(long)(16*(wid&3)+(lane>>2))*DMV+(wid>>2)*32+(lane&3)*8;
  const unsigned kdst=lds0+LDS_K+wid*1024, vdst=lds0+LDS_V+wid*1024;
  #define DMA_K(t,slot) glds16(ksrc+(long)(t)*KVBLK*DMK,(unsigned)__builtin_amdgcn_readfirstlane(kdst+(slot)))
  #define DMA_V(t,slot) glds16(vsrc+(long)(t)*KVBLK*DMV,(unsigned)__builtin_amdgcn_readfirstlane(vdst+(slot)))
  const int vb0=(int)(lds0+LDS_V)+((lane>>4)&1)*32+(lane&3)*8+(4*hi+((lane&15)>>2))*64;
  const char*Kbase=shm+LDS_K; bf16x8 kf[8];
  const lds_cptr shm3=(lds_cptr)shm; const lds_cptr kp0=shm3+LDS_K+hi*1024+r32*16; const lds_cptr vp0=shm3+LDS_V+((lane>>4)&1)*32+(lane&3)*8+(4*hi+((lane&15)>>2))*64;
  constexpr int NT=SEQ/KVBLK;
  DMA_K(0,0);DMA_V(0,0);DMA_K(1,SLOTB);
  bf16x8 qr[4];
  #pragma unroll
  for(int d0=0;d0<4;++d0)qr[d0]=*reinterpret_cast<const bf16x8*>(&Qw[(long)r32*DMQ+d0*16+hi*8]);
  float mhat=0.f,l_reg=0.f;f32x16 o[2];o[0]=f32x16{};o[1]=f32x16{};f32x16 negm=f32x16{};asm volatile("":"+v"(negm));
  #define CMASK(P0,P1,t) do{}while(0)
  bool resc=false;
  #define START(P0,P1) do{ const float rm=rowmax(P0,P1); resc=false; \
    { const float dl=rm; mhat=fadd_s(mhat,dl); \
      _Pragma("unroll") for(int r=0;r<16;++r){P0[r]=fsub_s(P0[r],dl);P1[r]=fsub_s(P1[r],dl);} \
      _Pragma("unroll") for(int r=0;r<16;++r)negm[r]=-mhat; asm volatile("":"+v"(negm)); } \
    _Pragma("unroll") for(int r=0;r<16;++r)P0[r]=__builtin_amdgcn_exp2f(P0[r]); }while(0)
  #define RESC() do{ if(resc){ asm volatile("s_waitcnt lgkmcnt(0)":::"memory"); \
      _Pragma("unroll") for(int d_=0;d_<2;++d_) _Pragma("unroll") for(int r=0;r<16;++r)o[d_][r]*=wsf[crow(r,hi)]; } }while(0)
  f32x16 pA0,pA1,pB0,pB1;
  int sl_prev=0,sl_cur=0,sl_next=SLOTB;
  #define ROT() do{sl_prev=sl_cur;sl_cur=sl_next;sl_next=(sl_next==(NSLOT-1)*SLOTB)?0:sl_next+SLOTB;}while(0)
  DMA_K(2,2*SLOTB);
  WAIT_BAR(3);
  qkt(pA0,pA1,Kbase,qr,negm,r32,hi);asm volatile("s_nop 15\n\ts_nop 7":"+v"(pA0),"+v"(pA1));CMASK(pA0,pA1,0);
  START(pA0,pA1);
  _Pragma("unroll") for(int r=0;r<16;++r)pA1[r]=__builtin_amdgcn_exp2f(pA1[r]);
  WAIT_BAR(0);
  DMA_K(3,0);DMA_V(1,SLOTB);
  ROT();
  kload8(kf,kp0+sl_cur);
  WAIT_BAR(2);
  s16x4 vlo[8],vhi[8]; u32x4 pw0,pw1,pw2,pw3;
  #define PKW(P,B) cvtpk_s(P[B],P[B+1])
  #define PAF(k) __builtin_bit_cast(bf16x8,pw##k)
  #define VFR(i) (bf16x8){vlo[i][0],vlo[i][1],vlo[i][2],vlo[i][3],vhi[i][0],vhi[i][1],vhi[i][2],vhi[i][3]}
  #define PIN(x) asm volatile("":"+v"(x))
  #define MX3(a,b,c) __builtin_fmaxf(__builtin_fmaxf((a),(b)),(c))
  #define GAPA(MF,A0,A1,A2,A3,W0,W1,PW) do{ MF; sacc+=A0; sacc+=A1; sacc+=A2; sacc+=A3; PIN(sacc); W0; W1; PIN(PW); SBAR(); }while(0)
  #define EX(v) __builtin_amdgcn_exp2f(v)
  #define GAPB(MF,X,B) do{ MF; X[B]=EX(X[B]); X[B+1]=EX(X[B+1]); X[B+2]=EX(X[B+2]); X[B+3]=EX(X[B+3]); PIN(X); SBAR(); }while(0)
  #define VRD(i) do{ vlo[i]=vtr(vp_+(((i)>>2)*4096+((i)&3)*1024)); vhi[i]=vtr(vp_+(((i)>>2)*4096+((i)&3)*1024+512)); }while(0)
  #define KRD(G,j) do{ if(G){ kload2(kf,kp0+sl_next,j); SBAR(); } }while(0)
  #define STEP(C0,C1,P0,P1,t,GK,GV,GL) do{ SBAR(); \
    const lds_cptr vp_=vp0+sl_prev; \
    VRD(0); SBAR(); float sacc=(P0[0]+P0[1]); \
    GAPA(C0=__builtin_amdgcn_mfma_f32_32x32x16_bf16(kf[0],qr[0],negm,0,0,0), P0[2],P0[3],P0[4],P0[5],     pw0[0]=PKW(P0,0), pw0[1]=PKW(P0,2), pw0); \
    VRD(4); SBAR(); GAPA(C1=__builtin_amdgcn_mfma_f32_32x32x16_bf16(kf[1],qr[0],negm,0,0,0), P0[6],P0[7],P0[8],P0[9],     pw0[2]=PKW(P0,4), pw0[3]=PKW(P0,6), pw0); \
    VRD(1); SBAR(); GAPA(C0=__builtin_amdgcn_mfma_f32_32x32x16_bf16(kf[2],qr[1],C0,0,0,0),   P0[10],P0[11],P0[12],P0[13], pw1[0]=PKW(P0,8), pw1[1]=PKW(P0,10), pw1); \
    VRD(5); SBAR(); GAPA(C1=__builtin_amdgcn_mfma_f32_32x32x16_bf16(kf[3],qr[1],C1,0,0,0),   P0[14],P0[15],P1[0],P1[1],   pw1[2]=PKW(P0,12),pw1[3]=PKW(P0,14), pw1); \
    VRD(2); SBAR(); GAPA(C0=__builtin_amdgcn_mfma_f32_32x32x16_bf16(kf[4],qr[2],C0,0,0,0),   P1[2],P1[3],P1[4],P1[5],     pw2[0]=PKW(P1,0), pw2[1]=PKW(P1,2), pw2); \
    VRD(6); SBAR(); GAPA(C1=__builtin_amdgcn_mfma_f32_32x32x16_bf16(kf[5],qr[2],C1,0,0,0),   P1[6],P1[7],P1[8],P1[9],     pw2[2]=PKW(P1,4), pw2[3]=PKW(P1,6), pw2); \
    VRD(3); SBAR(); GAPA(C0=__builtin_amdgcn_mfma_f32_32x32x16_bf16(kf[6],qr[3],C0,0,0,0),   P1[10],P1[11],P1[12],P1[13], pw3[0]=PKW(P1,8), pw3[1]=PKW(P1,10), pw3); \
    VRD(7); SBAR(); GAPA(C1=__builtin_amdgcn_mfma_f32_32x32x16_bf16(kf[7],qr[3],C1,0,0,0),   P1[14],P1[15],0.f,0.f,       pw3[2]=PKW(P1,12),pw3[3]=PKW(P1,14), pw3); \
    l_reg+=sacc; \
    if(GK){DMA_K((t)+3,sl_cur);} if(GV){DMA_V((t)+1,sl_next);} \
    CMASK(C0,C1,t); \
    { float a=MX3(C0[0],C0[1],C1[0]),b=MX3(C0[2],C0[3],C1[1]); a=MX3(a,C1[2],C1[3]); \
      _Pragma("unroll") for(int r=4;r<16;r+=4){a=MX3(a,C0[r],C0[r+1]);b=MX3(b,C0[r+2],C0[r+3]);a=MX3(a,C1[r],C1[r+1]);b=MX3(b,C1[r+2],C1[r+3]);} \
      float rm=__builtin_fmaxf(a,b); { auto rr=__builtin_amdgcn_permlane32_swap(__float_as_uint(rm),__float_as_uint(rm),false,false); rm=__builtin_fmaxf(__uint_as_float(rr[0]),__uint_as_float(rr[1])); } \
      resc=false; \
      if(__builtin_expect(__any(rm>(float)THRL),0)){ const float dl=__builtin_fmaxf(rm,0.f); mhat+=dl; \
        _Pragma("unroll") for(int r=0;r<16;++r){C0[r]-=dl;C1[r]-=dl;} \
        _Pragma("unroll") for(int r=0;r<16;++r)negm[r]=-mhat; asm volatile("":"+v"(negm)); \
        const float f=__builtin_amdgcn_exp2f(-dl); l_reg*=f; if(hi==0)wsf[r32]=f; resc=true; } } \
    SBAR(); \
    GAPB(o[0]=__builtin_amdgcn_mfma_f32_32x32x16_bf16(PAF(0),VFR(0),o[0],0,0,0), C0,0); \
    GAPB(o[1]=__builtin_amdgcn_mfma_f32_32x32x16_bf16(PAF(0),VFR(4),o[1],0,0,0), C0,4); \
    KRD(GL,0); GAPB(o[0]=__builtin_amdgcn_mfma_f32_32x32x16_bf16(PAF(1),VFR(1),o[0],0,0,0), C0,8); \
    KRD(GL,1); GAPB(o[1]=__builtin_amdgcn_mfma_f32_32x32x16_bf16(PAF(1),VFR(5),o[1],0,0,0), C0,12); \
    KRD(GL,2); GAPB(o[0]=__builtin_amdgcn_mfma_f32_32x32x16_bf16(PAF(2),VFR(2),o[0],0,0,0), C1,0); \
    KRD(GL,3); GAPB(o[1]=__builtin_amdgcn_mfma_f32_32x32x16_bf16(PAF(2),VFR(6),o[1],0,0,0), C1,4); \
    GAPB(o[0]=__builtin_amdgcn_mfma_f32_32x32x16_bf16(PAF(3),VFR(3),o[0],0,0,0), C1,8); \
    GAPB(o[1]=__builtin_amdgcn_mfma_f32_32x32x16_bf16(PAF(3),VFR(7),o[1],0,0,0), C1,12); \
    }while(0)
  int t=1;
  #undef CMASK
  #define CMASK(P0,P1,t) do{}while(0)
  for(;t+5<NT;t+=2){
    STEP(pB0,pB1,pA0,pA1,t,true,true,true);     WAIT_BAR(2); RESC(); ROT();
    STEP(pA0,pA1,pB0,pB1,t+1,true,true,true);   WAIT_BAR(2); RESC(); ROT();
  }
  #undef CMASK
  #define CMASK(P0,P1,t) do{}while(0)
  #define ENDW(tt) do{ if((tt)+3<NT){WAIT_BAR(2);} else if((tt)+2<NT){WAIT_BAR(1);} else {WAIT_BAR(0);} }while(0)
  for(;t+1<NT;t+=2){
    STEP(pB0,pB1,pA0,pA1,t,(t+3<NT),(t+1<NT),(t+1<NT));       ENDW(t);   RESC(); ROT();
    STEP(pA0,pA1,pB0,pB1,t+1,(t+4<NT),(t+2<NT),(t+2<NT));     ENDW(t+1); RESC(); ROT();
  }
  STEP(pB0,pB1,pA0,pA1,NT-1,false,false,false); RESC();
  { float sacc=pB0[0]+pB0[1]; _Pragma("unroll") for(int r=2;r<16;++r)sacc+=pB0[r]; _Pragma("unroll") for(int r=0;r<16;++r)sacc+=pB1[r]; l_reg+=sacc;
    pw0=(u32x4){PKW(pB0,0),PKW(pB0,2),PKW(pB0,4),PKW(pB0,6)};pw1=(u32x4){PKW(pB0,8),PKW(pB0,10),PKW(pB0,12),PKW(pB0,14)};pw2=(u32x4){PKW(pB1,0),PKW(pB1,2),PKW(pB1,4),PKW(pB1,6)};pw3=(u32x4){PKW(pB1,8),PKW(pB1,10),PKW(pB1,12),PKW(pB1,14)};
    SBAR(); pv(o,vb0+sl_cur,PAF(0),PAF(1),PAF(2),PAF(3)); }
  #undef PKW
  #undef PAF
  #undef VFR
  #undef PIN
  #undef MX3
  #undef GAPA
  #undef GAPB
  #undef EX
  #undef VRD
  #undef KRD
  #undef STEP
  #undef ENDW
  {auto rr=__builtin_amdgcn_permlane32_swap(__float_as_uint(l_reg),__float_as_uint(l_reg),false,false);l_reg=__uint_as_float(rr[0])+__uint_as_float(rr[1]);}
  if(hi==0)wsf[32+r32]=l_reg;asm volatile("s_waitcnt lgkmcnt(0)":::"memory");
  float rli[16];
  #pragma unroll
  for(int r=0;r<16;++r)rli[r]=__builtin_amdgcn_rcpf(wsf[32+crow(r,hi)]);
  bf16*Ow=O+(rowbase+q0+wid*QBLK)*DMO+h*D;
  { bf16*stg=(bf16*)(shm+LDS_OST)+wid*2048;
    #pragma unroll
    for(int r=0;r<16;++r){const int orow=crow(r,hi);
      #pragma unroll
      for(int d0=0;d0<2;++d0)stg[orow*64+d0*32+r32]=__float2bfloat16(o[d0][r]*rli[r]);}
    asm volatile("s_waitcnt lgkmcnt(0)":::"memory");
    #pragma unroll
    for(int i=0;i<4;++i){const int row=i*8+(lane>>3),ch=lane&7; const u32x4 v=*(const u32x4*)(stg+row*64+ch*8); ATTN_STORE16(Ow+(long)row*DMO+ch*8,v);} }
  asm volatile("s_waitcnt lgkmcnt(0)\n\ts_barrier":::"memory");
  #undef DMA_K
  #undef DMA_V
  #undef CMASK
  #undef START
  #undef RESC
  #undef ROT
}
constexpr int ATTN_LDS_BYTES=LDS_BYTES;
struct AttnTensors { const bf16* Q; const bf16* K; const bf16* V; bf16* O; };
struct AttnUnit { int bh; int qb; };
struct StaticOrder {
  int vcu, G;
  __device__ __forceinline__ explicit StaticOrder(int grid,int block):vcu((grid%8==0)?(block%8)*(grid/8)+block/8:block),G(grid){}
  __device__ __forceinline__ bool next(int i,AttnUnit&u)const{ const int per=(BATCH*NHEAD*NQB+G-1)/G; if(i>=per)return false; const int idx=vcu*per+i; if(idx>=BATCH*NHEAD*NQB)return false;
    const int qb=idx%NQB, hq=(idx/NQB)&3, bk=idx/(NQB*4), kvh=bk&1, b=bk>>1; u.bh=b*NHEAD+kvh*4+hq; u.qb=qb; return true; }
  __device__ __forceinline__ void a_ready(const AttnUnit&)const{}
  __device__ __forceinline__ void done(const AttnUnit&)const{}
};
template<class Sched,int THRL=8> __device__ __forceinline__ void attn_phase(char*lds,const AttnTensors&T,const Sched&S){
  AttnUnit u;
  for(int i=0;S.next(i,u);++i){ S.a_ready(u); attn_unit<THRL>(u.bh/NHEAD,u.bh%NHEAD,u.qb,T.Q,T.K,T.V,T.O,lds); S.done(u); }
}
#undef SBAR
#undef WAIT_BAR
}
constexpr int NB = 8, SEQ = 4096, DM = 1024, NL = 4, NTOK = NB * SEQ;
constexpr int INW = 1824, INP = 2048;
constexpr int C_AQ = 0, C_AK = 512, C_AV = 640, C_GQ = 768, C_GK = 896, C_GV = 1024, C_GR = 1280, C_FX = 1536, C_GLR = 1792;
constexpr int NE = 32, TOPK = 4, DE = 1024;
constexpr int MPAD = NTOK * TOPK + NE * 256;
constexpr float LN_EPS = 1e-5f, RMS_EPS = 1e-6f;
constexpr float DN_ALPHA = 1.681792830507429f;
constexpr float QSCALE = 0.125f * 1.4426950408889634f;
constexpr float GLA_QSCALE = 0.17677669529663687f;

constexpr size_t MiB = 1u << 20;
constexpr size_t WS_CTL = 0, CTL_ZERO_BYTES = 1 * MiB;
constexpr size_t WS_ROPE = 1 * MiB;
constexpr size_t WS_WIN_T = 2 * MiB;
constexpr size_t WS_WOUT_T = 18 * MiB;
constexpr size_t WS_FTAB = 26 * MiB;
constexpr size_t WS_TW = WS_FTAB + 65536;
constexpr size_t WS_FTMP = 27 * MiB;
constexpr size_t WS_WGU_T = 90 * MiB;
constexpr size_t WS_WDN_T = 602 * MiB;
constexpr size_t WS_HF = 858 * MiB;
constexpr size_t WS_HB = 986 * MiB;
constexpr size_t WS_PROJ = 1050 * MiB;
constexpr size_t WS_QB = 1178 * MiB;
constexpr size_t WS_KB = 1210 * MiB;
constexpr size_t WS_MIX = 1218 * MiB;
constexpr size_t WS_T1 = 1282 * MiB;
constexpr size_t WS_UVT = 1410 * MiB;
constexpr size_t WS_LA = 1442 * MiB;
constexpr size_t WS_OF = 1474 * MiB;
constexpr size_t WS_OB = 1506 * MiB;
constexpr size_t WS_TOK = 1538 * MiB;
constexpr size_t WS_XS = 1542 * MiB;
constexpr size_t WS_HID = 1814 * MiB;
constexpr size_t WS_YS = 2086 * MiB;
constexpr size_t WS_END = 2358 * MiB;
static_assert((size_t)MPAD * 2048 == 272 * MiB, "sorted buffers");
constexpr int CW_TMO = 0, CW_CODE = 1, CW_BAR = 4096, CW_CNT = 8192;

constexpr int RING_OFF = 0, RING_BYTES = 131072;
constexpr int LDSCTL_OFF = RING_BYTES;
constexpr int LDS_BYTES = 163840;
constexpr int LC_MISC = 0;
constexpr int LC_PSTART = 128;
constexpr int LC_ULIST = 384;
constexpr int LC_CNT = 640;
constexpr int LC_BASE = 768;
constexpr int LC_SELE = 1024;
constexpr int LC_SELS = 1024 + 2048;
constexpr int LC_COS64 = 5120;
constexpr int LC_ROWS = 6144;
constexpr int LC_LG = 16384;

constexpr int NWAVES = 8;
constexpr int N_PHASES = 1 + 10 * NL;

typedef float f32x2_t __attribute__((ext_vector_type(2))); typedef __bf16 bf16x2_t __attribute__((ext_vector_type(2)));
__device__ __forceinline__ unsigned cvtpk2(float lo, float hi) { f32x2_t v = {lo, hi}; bf16x2_t b = __builtin_convertvector(v, bf16x2_t); return __builtin_bit_cast(unsigned, b); }
#define pk2(lo, hi) cvtpk2((lo), (hi))
#define f2bf(x) (cvtpk2((x), 0.f) & 0xffffu)
__device__ __forceinline__ float bf2f(unsigned short b) { return __uint_as_float((unsigned)b << 16); }
__device__ __forceinline__ float wave_sum(float v) {
#pragma unroll
    for (int o = 1; o < 64; o <<= 1) v += __shfl_xor(v, o);
    return v;
}
typedef unsigned short u16x8 __attribute__((ext_vector_type(8)));
typedef unsigned short u16x4 __attribute__((ext_vector_type(4)));

typedef float f32x2v __attribute__((ext_vector_type(2)));
__device__ __forceinline__ void tr_task(const float* W, int K, int Nsrc, int srcn, bf16* WT, int dst_n, int k0) {
#pragma unroll 1
    for (int hf = 0; hf < 2; ++hf) { const int kk = k0 + hf * 64; f32x2v v[64];
        if (srcn >= 0) { const float* p = W + (size_t)kk * Nsrc + srcn;
#pragma unroll
            for (int i = 0; i < 64; ++i) v[i] = __builtin_nontemporal_load((const f32x2v*)(p + (size_t)i * Nsrc)); }
        else {
#pragma unroll
            for (int i = 0; i < 64; ++i) v[i] = (f32x2v){0.f, 0.f}; }
        bf16* o0 = WT + (size_t)dst_n * K + kk; bf16* o1 = o0 + K;
#pragma unroll
        for (int j = 0; j < 8; ++j) { v4u w0, w1;
            w0.x = pk2(v[8 * j].x, v[8 * j + 1].x); w0.y = pk2(v[8 * j + 2].x, v[8 * j + 3].x); w0.z = pk2(v[8 * j + 4].x, v[8 * j + 5].x); w0.w = pk2(v[8 * j + 6].x, v[8 * j + 7].x);
            w1.x = pk2(v[8 * j].y, v[8 * j + 1].y); w1.y = pk2(v[8 * j + 2].y, v[8 * j + 3].y); w1.z = pk2(v[8 * j + 4].y, v[8 * j + 5].y); w1.w = pk2(v[8 * j + 6].y, v[8 * j + 7].y);
            *(v4u*)(o0 + 8 * j) = w0; *(v4u*)(o1 + 8 * j) = w1; } }
}

__device__ __forceinline__ void ln_row(f32x4 (&v)[4], const float* g, const float* bt, float* of32, bf16* obf, int lane) {
    float s = 0.f;
#pragma unroll
    for (int j = 0; j < 4; ++j) s += (v[j].x + v[j].y) + (v[j].z + v[j].w);
    const float mean = wave_sum(s) * (1.f / DM); float s2 = 0.f;
#pragma unroll
    for (int j = 0; j < 4; ++j) { v[j] = v[j] - mean; s2 += (v[j].x * v[j].x + v[j].y * v[j].y) + (v[j].z * v[j].z + v[j].w * v[j].w); }
    const float rstd = 1.f / sqrtf(wave_sum(s2) * (1.f / DM) + LN_EPS);
#pragma unroll
    for (int j = 0; j < 4; ++j) { const f32x4 gg = *(const f32x4*)(g + lane * 4 + 256 * j), bb = *(const f32x4*)(bt + lane * 4 + 256 * j);
        v[j] = v[j] * rstd * gg + bb;
        if (of32) *(f32x4*)(of32 + lane * 4 + 256 * j) = v[j];
        if (obf) *(unsigned long long*)(obf + lane * 4 + 256 * j) = (unsigned long long)pk2(v[j].x, v[j].y) | ((unsigned long long)pk2(v[j].z, v[j].w) << 32); }
}


constexpr int GM_QF = 0, GM_KF = 5120, GM_QB = 10240, GM_KB = 15360, GM_VT = 20480, GM_P = 29696, GM_HTF = 38912, GM_HTB = 44032, GM_DL = 38912, GM_SLOT = 49152;
static_assert(2 * GM_SLOT <= RING_BYTES, "two GLA chunk images fit the phase scratch");
#define MFMA16(a, b, c) __builtin_amdgcn_mfma_f32_16x16x32_bf16((a), (b), (c), 0, 0, 0)
template <bool OUT>
__device__ __forceinline__ void gla_stage_mfma(LAS unsigned char* Ls, const bf16* PROJ, const float* LA, const float* HIN, size_t tok0, int hd, int w4, int lane) {
    if (w4 < 2) { const int dir = lane >> 5, d = lane & 31; float bc[64]; unsigned short x[64];
        const float* lap = LA + tok0 * 256 + dir * 128 + hd * 32 + d; const bf16* xp = PROJ + tok0 * INP + (w4 == 0 ? C_GQ : C_GK) + hd * 32 + d;
#pragma unroll
        for (int j = 0; j < 64; ++j) { bc[j] = lap[(size_t)j * 256]; x[j] = xp[(size_t)j * INP]; }
        float acc = 0.f;
        if (dir == 0) {
#pragma unroll
            for (int j = 0; j < 64; ++j) { acc += bc[j]; bc[j] = acc; } }
        else {
#pragma unroll
            for (int j = 63; j >= 0; --j) { acc += bc[j]; bc[j] = acc; } }
        if (w4 == 0) { LAS bf16* dst = (LAS bf16*)(Ls + (dir ? GM_QB : GM_QF)) + d;
#pragma unroll
            for (int j = 0; j < 64; ++j) dst[j * 40] = (bf16)f2bf(bf2f(x[j]) * GLA_QSCALE * __expf(bc[j])); }
        else if (OUT) { LAS bf16* dst = (LAS bf16*)(Ls + (dir ? GM_KB : GM_KF)) + d;
#pragma unroll
            for (int j = 0; j < 64; ++j) dst[j * 40] = (bf16)f2bf(bf2f(x[j]) * __expf(-bc[j])); }
        else { LAS bf16* dst = (LAS bf16*)(Ls + GM_P + dir * 4608) + d * 72;
#pragma unroll
            for (int j8 = 0; j8 < 8; ++j8) { float t[8];
#pragma unroll
                for (int i = 0; i < 8; ++i) t[i] = bf2f(x[j8 * 8 + i]) * __expf(-bc[j8 * 8 + i]);
                v4u w; w.x = pk2(t[0], t[1]); w.y = pk2(t[2], t[3]); w.z = pk2(t[4], t[5]); w.w = pk2(t[6], t[7]); *(LAS v4u*)(dst + j8 * 8) = w; }
            ((LAS float*)(Ls + GM_DL))[lane] = __expf(acc); } }
    else if (w4 == 2) { unsigned short x[64]; const bf16* xp = PROJ + tok0 * INP + C_GV + hd * 64 + lane;
#pragma unroll
        for (int j = 0; j < 64; ++j) x[j] = xp[(size_t)j * INP];
        LAS bf16* dst = (LAS bf16*)(Ls + GM_VT) + lane * 72;
#pragma unroll
        for (int j8 = 0; j8 < 8; ++j8) { v4u w; w.x = (unsigned)x[j8 * 8] | ((unsigned)x[j8 * 8 + 1] << 16); w.y = (unsigned)x[j8 * 8 + 2] | ((unsigned)x[j8 * 8 + 3] << 16); w.z = (unsigned)x[j8 * 8 + 4] | ((unsigned)x[j8 * 8 + 5] << 16); w.w = (unsigned)x[j8 * 8 + 6] | ((unsigned)x[j8 * 8 + 7] << 16);
            *(LAS v4u*)(dst + j8 * 8) = w; } }
    else if (OUT) {
#pragma unroll
        for (int dir = 0; dir < 2; ++dir) { const f32x4* src = (const f32x4*)(HIN + ((size_t)dir * 64 + lane) * 32); LAS bf16* dst = (LAS bf16*)(Ls + (dir ? GM_HTB : GM_HTF)) + lane * 40;
#pragma unroll
            for (int c8 = 0; c8 < 4; ++c8) { const f32x4 a_ = src[2 * c8], b_ = src[2 * c8 + 1]; v4u w; w.x = pk2(a_.x, a_.y); w.y = pk2(a_.z, a_.w); w.z = pk2(b_.x, b_.y); w.w = pk2(b_.z, b_.w); *(LAS v4u*)(dst + c8 * 8) = w; } } }
}

typedef float f32x16 __attribute__((ext_vector_type(16)));
typedef short s16x4 __attribute__((ext_vector_type(4)));
__device__ __forceinline__ bf16x8 pack_step(const f32x16& x, int s) { v4u p; p.x = cvtpk2(x[8 * s], x[8 * s + 1]); p.y = cvtpk2(x[8 * s + 2], x[8 * s + 3]); p.z = cvtpk2(x[8 * s + 4], x[8 * s + 5]); p.w = cvtpk2(x[8 * s + 6], x[8 * s + 7]); return __builtin_bit_cast(bf16x8, p); }
__device__ __forceinline__ int crow16(int i, int h) { return (i & 3) + 8 * (i >> 2) + 4 * h; }
#define MFMA32(a, b, c) __builtin_amdgcn_mfma_f32_32x32x16_bf16((a), (b), (c), 0, 0, 0)
constexpr int FT_PITCH = 72, FT_TAB = 64 * FT_PITCH;
constexpr int FFT_LDS_TAB = 0, FFT_LDS_TW = 28672, FFT_LDS_HT = 28672, FFT_HT_PAIR = 2 * 64 * FT_PITCH * 2;

struct Args { const float* in[20]; float* out; unsigned char* ws; int ph_lo, ph_hi; };
static_assert(sizeof(Args) == 20 * 8 + 8 + 8 + 8, "no padding bytes in Args");


typedef __attribute__((address_space(4))) const unsigned char* kptr_t;
__device__ __forceinline__ kptr_t karg() { kptr_t p = (kptr_t)__builtin_amdgcn_kernarg_segment_ptr(); asm volatile("" : "+s"(p)); return p; }
#define KIN(i) (*(const float* const __attribute__((address_space(4)))*)(karg() + 8 * (i)))
#define KOUT() (*(float* const __attribute__((address_space(4)))*)(karg() + 160))
#define KWS() (*(unsigned char* const __attribute__((address_space(4)))*)(karg() + 168))
#define WSP(T, off) ((T*)(ws + (off)))

#ifndef NAIVE_ATTN
#define NAIVE_ATTN 0
#endif

__global__ void __launch_bounds__(NWAVES * 64, 2) fwd(Args args) {
    extern __shared__ __attribute__((aligned(16))) unsigned char lds_raw[];
    LAS unsigned char* lds = (LAS unsigned char*)lds_raw;
    LAS unsigned char* lctl = lds + LDSCTL_OFF;
    const int G = gridDim.x, bx = blockIdx.x;
    const int NGW = G * NWAVES, NGT = G * NWAVES * 64;
#define TID_SETUP() int tid_ = threadIdx.x; asm volatile("" : "+v"(tid_)); const int tid = tid_, lane = tid & 63, wave = __builtin_amdgcn_readfirstlane(tid >> 6); \
    const int gw = bx * NWAVES + wave, gt = bx * (NWAVES * 64) + tid; (void)lane; (void)gw; (void)gt
    for (int u = threadIdx.x; u < (LDS_BYTES - LDSCTL_OFF) / 4; u += NWAVES * 64) ((LAS unsigned*)lctl)[u] = 0u;
    __syncthreads();
    volatile LAS unsigned* MISC = (volatile LAS unsigned*)(lctl + LC_MISC);
    XcdBarrier bar = xcd_barrier_post((unsigned*)(KWS() + WS_CTL) + CW_BAR, MISC + 8);
    const int lo = args.ph_lo, hi = args.ph_hi;
#ifndef PH_OFF
#define PH_OFF 0
#endif
#define PON(j) (!((PH_OFF >> (j)) & 1))
#define IN(k) (lo <= (k) && (k) < hi)
#ifndef PROBE_A
#define PROBE_A -1
#endif
#ifndef PROBE_B
#define PROBE_B -1
#endif
#if PROBE_A >= 0
#define STAMP(k) do { if (blockIdx.x == 0 && threadIdx.x == 0) { ((unsigned long long*)(KWS() + WS_CTL + 65536))[(k)] = __builtin_amdgcn_s_memrealtime(); } } while (0)
#define STAMP2(i) do { __syncthreads(); if (blockIdx.x == 0 && threadIdx.x == 0) { ((unsigned long long*)(KWS() + WS_CTL + 65536))[128 + l * 16 + (i)] = __builtin_amdgcn_s_memrealtime(); } } while (0)
#else
#define STAMP(k) do {} while (0)
#define STAMP2(i) do {} while (0)
#endif
#ifndef PROBE_SUB_A
#define PROBE_SUB_A -1
#define PROBE_SUB_B -1
#endif
#define SEAM(k) do { if (IN(k) && IN((k) + 1)) xcd_barrier(bar); STAMP((k) + 1); } while (0)
    STAMP(0);

    if (IN(0) && PON(0)) {
        TID_SETUP(); unsigned char* ws = KWS(); const float* x_in = KIN(0); const float* ln_in_g = KIN(1); const float* ln_in_b = KIN(2); const float* w_in = KIN(3); const float* w_out = KIN(9);
        const float* exp_w_gu = KIN(14); const float* exp_w_down = KIN(16);
        float* ROPE = WSP(float, WS_ROPE); bf16* WIN_T = WSP(bf16, WS_WIN_T); bf16* WOUT_T = WSP(bf16, WS_WOUT_T); bf16* WGU_T = WSP(bf16, WS_WGU_T); bf16* WDN_T = WSP(bf16, WS_WDN_T);
        bf16* HB = WSP(bf16, WS_HB);
        constexpr int I_WIN = NL * 16 * 8, I_WOUT = NL * 8 * 8, I_WGU = NL * NE * 16 * 8, I_WDN = NL * NE * 8 * 8;
        constexpr int NTASK = I_WIN + I_WOUT + I_WGU + I_WDN;
        { const int t_lo = (int)(((long)gw * NTASK) / NGW), t_hi = (int)(((long)(gw + 1) * NTASK) / NGW);
          for (int it = t_lo; it < t_hi; ++it) {
            int r = it;
            if (r < I_WIN) { const int l = r / 128, q = r % 128, nb = q / 8, k8 = q % 8, n = nb * 128 + 2 * lane;
                const int src = n < 1536 ? n : (n < 1792 ? n + 32 : (n < 1824 ? n - 256 : -1));
                tr_task(w_in + (size_t)l * DM * INW, DM, INW, src, WIN_T + (size_t)l * INP * DM, n, k8 * 128); continue; }
            r -= I_WIN;
            if (r < I_WOUT) { const int l = r / 64, q = r % 64, nb = q / 8, k8 = q % 8, n = nb * 128 + 2 * lane;
                tr_task(w_out + (size_t)l * DM * DM, DM, DM, n, WOUT_T + (size_t)l * DM * DM, n, k8 * 128); continue; }
            r -= I_WOUT;
            if (r < I_WGU) { const int le = r / 128, q = r % 128, nb = q / 8, k8 = q % 8, n = nb * 128 + 2 * lane;
                const int pn = n >> 8, bj = (n >> 7) & 1, j = n & 127, src = bj * 1024 + pn * 128 + j;
                tr_task(exp_w_gu + (size_t)le * DM * 2048, DM, 2048, src, WGU_T + (size_t)le * 2048 * DM, n, k8 * 128); continue; }
            r -= I_WGU;
            { const int le = r / 64, q = r % 64, nb = q / 8, k8 = q % 8, n = nb * 128 + 2 * lane;
                tr_task(exp_w_down + (size_t)le * DE * DM, DE, DM, n, WDN_T + (size_t)le * DM * DE, n, k8 * 128); }
          } }
        { bf16* FTAB = WSP(bf16, WS_FTAB); float* TW = WSP(float, WS_TW);
          for (int it = gt; it < 3 * FT_TAB; it += NGT) { const int t = it / FT_TAB, q = it % FT_TAB, row = q / FT_PITCH, col = q % FT_PITCH; float sn, cs; sincospif((float)((row * col) & 63) * (1.0f / 32.0f), &sn, &cs);
              const float v = col >= 64 ? 0.f : (t == 0 ? cs : (t == 1 ? sn : -sn)); FTAB[it] = (bf16)f2bf(v); }
          for (int it = gt; it < 4096; it += NGT) { float sn, cs; sincospif((float)it * (1.0f / 2048.0f), &sn, &cs); TW[2 * it] = cs; TW[2 * it + 1] = -sn; } }
        for (int it = gt; it < SEQ * 32; it += NGT) { const int t = it >> 5, i = it & 31, a = i >> 4, f = i & 15; const int pos = a ? (t & 63) : (t >> 6);
            const double inv = exp(-9.210340371976184 * (double)f / 16.0); const double ang = (double)pos * inv;
            ROPE[it] = (float)cos(ang); ROPE[SEQ * 32 + it] = (float)sin(ang); }
        for (int m = gw; m < NTOK; m += NGW) { f32x4 v[4];
#pragma unroll
            for (int j = 0; j < 4; ++j) v[j] = *(const f32x4*)(x_in + (size_t)m * DM + lane * 4 + 256 * j);
            ln_row(v, ln_in_g, ln_in_b, nullptr, HB + (size_t)m * DM, lane); }
    }
    SEAM(0);

    for (int l = 0; l < NL; ++l) {
        const int pb = 1 + 10 * l;
        if (IN(pb + 0) && PON(1)) {
            TID_SETUP(); unsigned char* ws = KWS(); bf16* HB = WSP(bf16, WS_HB); bf16* WIN_T = WSP(bf16, WS_WIN_T); bf16* PROJ = WSP(bf16, WS_PROJ);
            pg8::Gemm g{HB, WIN_T + (size_t)l * INP * DM, NTOK, INP, DM}; pg8::StaticOrder S; S.init(NTOK, INP, G, bx);
            pg8::EpiPlainBf16 E{PROJ, INP};
            STAMP2(2);
            pg8::gemm_phase<pg8::EpiPlainBf16, pg8::StaticOrder, true, true>(lds + RING_OFF, g, S, E);
            STAMP2(3);
        }
        SEAM(pb + 0);
        if (IN(pb + 1) && PON(2)) {
            TID_SETUP(); unsigned char* ws = KWS(); const float* att_q_gain = KIN(4); const float* att_k_gain = KIN(5); const float* gla_gate_w = KIN(6); const float* gla_gate_b = KIN(7);
            const float* ROPE = WSP(float, WS_ROPE); const bf16* PROJ = WSP(bf16, WS_PROJ); bf16* QB = WSP(bf16, WS_QB); bf16* KB = WSP(bf16, WS_KB); float* LA = WSP(float, WS_LA);
            STAMP2(8);
            { const float qgv = att_q_gain[l * 64 + lane], kgv = att_k_gain[l * 64 + lane]; const int ri = (lane >> 5) * 16 + (lane & 15); const float sg = ((lane >> 4) & 1) ? 1.f : -1.f;
              const float* gw_l = gla_gate_w + (size_t)l * 2 * 16 * 128; const float* gb_l = gla_gate_b + (size_t)l * 2 * 128; const int dir = lane >> 5, kc = (lane & 31) * 4;
              f32x4 gwr[16]; const f32x4 gbv = *(const f32x4*)(gb_l + dir * 128 + kc);
#pragma unroll
              for (int r = 0; r < 16; ++r) gwr[r] = *(const f32x4*)(gw_l + (size_t)(dir * 16 + r) * 128 + kc);
              for (int m0 = gw; m0 < NTOK; m0 += 2 * NGW) { unsigned short xh[2][10], xl[2]; float cs[2], sn[2];
#pragma unroll
                for (int q = 0; q < 2; ++q) { const size_t m = (size_t)m0 + q * NGW; const int t = (int)(m & (SEQ - 1));
#pragma unroll
                    for (int h = 0; h < 10; ++h) xh[q][h] = PROJ[m * INP + h * 64 + lane];
                    xl[q] = PROJ[m * INP + C_GLR + (lane & 31)]; cs[q] = ROPE[t * 32 + ri]; sn[q] = ROPE[SEQ * 32 + t * 32 + ri]; }
#pragma unroll
                for (int q = 0; q < 2; ++q) { const size_t m = (size_t)m0 + q * NGW;
#pragma unroll
                    for (int h = 0; h < 10; ++h) { const float xv = bf2f(xh[q][h]);
                        const float ms = wave_sum(xv * xv) * (1.f / 64.f); const float xn = xv * __builtin_amdgcn_rsqf(ms + RMS_EPS) * (h < 8 ? qgv : kgv);
                        const float pr = __shfl_xor(xn, 16); float o = xn * cs[q] + sg * pr * sn[q];
                        if (h < 8) { o *= QSCALE; QB[m * 512 + h * 64 + lane] = (bf16)f2bf(o); } else KB[m * 128 + (h - 8) * 64 + lane] = (bf16)f2bf(o); }
                    const float lr = bf2f(xl[q]); f32x4 z = gbv;
#pragma unroll
                    for (int r = 0; r < 16; ++r) { const float a_ = __shfl(lr, dir * 16 + r); z = z + gwr[r] * a_; }
                    f32x4 o4;
#pragma unroll
                    for (int i = 0; i < 4; ++i) o4[i] = (fminf(z[i], 0.f) - __logf(1.f + __expf(-fabsf(z[i])))) * (1.f / 16.f);
                    *(f32x4*)(LA + m * 256 + dir * 128 + kc) = o4; } } }
            STAMP2(4);
            { __syncthreads();
              { const v4u* src = (const v4u*)WSP(bf16, WS_FTAB); LAS v4u* dst = (LAS v4u*)(lds + RING_OFF + FFT_LDS_TAB); for (int i = tid; i < 3 * FT_TAB * 2 / 16; i += NWAVES * 64) dst[i] = src[i];
                const v4u* s2_ = (const v4u*)WSP(float, WS_TW); LAS v4u* d2_ = (LAS v4u*)(lds + RING_OFF + FFT_LDS_TW); for (int i = tid; i < 4096 * 8 / 16; i += NWAVES * 64) d2_[i] = s2_[i]; }
              __syncthreads();
              const LAS bf16* FT = (const LAS bf16*)(lds + RING_OFF + FFT_LDS_TAB); const LAS float* TWL = (const LAS float*)(lds + RING_OFF + FFT_LDS_TW); bf16* FTMP = WSP(bf16, WS_FTMP);
              const int pair = wave >> 1, cb = wave & 1, r = lane & 31, h = lane >> 5;
              for (int ub = bx; ub < NB * 4 * 64 / 4; ub += G) { const int u = ub * 4 + pair, s2 = u & 63, g4 = (u >> 6) & 3, b = u >> 8;
                bf16x8 xa[2][4];
#pragma unroll
                for (int R = 0; R < 2; ++R)
#pragma unroll
                    for (int ks = 0; ks < 4; ++ks) xa[R][ks] = *(const bf16x8*)(PROJ + ((size_t)b * SEQ + 64 * (32 * R + r) + s2) * INP + C_FX + g4 * 64 + 16 * ks + 8 * h);
                f32x16 Tr[2], Ti[2];
#pragma unroll
                for (int R = 0; R < 2; ++R)
#pragma unroll
                    for (int i = 0; i < 16; ++i) { Tr[R][i] = 0.f; Ti[R][i] = 0.f; }
#pragma unroll
                for (int ks = 0; ks < 4; ++ks) { const bf16x8 bc = *(const LAS bf16x8*)(FT + (32 * cb + r) * FT_PITCH + 16 * ks + 8 * h), bs = *(const LAS bf16x8*)(FT + 2 * FT_TAB + (32 * cb + r) * FT_PITCH + 16 * ks + 8 * h);
#pragma unroll
                    for (int R = 0; R < 2; ++R) { Tr[R] = MFMA32(xa[R][ks], bc, Tr[R]); Ti[R] = MFMA32(xa[R][ks], bs, Ti[R]); } }
#pragma unroll
                for (int Rp = 0; Rp < 2; ++Rp) { f32x16 Gr, Gi;
#pragma unroll
                    for (int i = 0; i < 16; ++i) { Gr[i] = 0.f; Gi[i] = 0.f; }
#pragma unroll
                    for (int R = 0; R < 2; ++R)
#pragma unroll
                        for (int s_ = 0; s_ < 2; ++s_) { const bf16x8 xr = pack_step(Tr[R], s_), xi = pack_step(Ti[R], s_);
                            const int kb = 32 * R + 16 * s_ + 4 * h, ro = (32 * Rp + r) * FT_PITCH + kb;
                            const s16x4 c0 = *(const LAS s16x4*)(FT + ro), c1 = *(const LAS s16x4*)(FT + ro + 8), s0 = *(const LAS s16x4*)(FT + FT_TAB + ro), s1 = *(const LAS s16x4*)(FT + FT_TAB + ro + 8),
                                        n0 = *(const LAS s16x4*)(FT + 2 * FT_TAB + ro), n1 = *(const LAS s16x4*)(FT + 2 * FT_TAB + ro + 8);
                            const bf16x8 ca = __builtin_shufflevector(c0, c1, 0, 1, 2, 3, 4, 5, 6, 7), sa = __builtin_shufflevector(s0, s1, 0, 1, 2, 3, 4, 5, 6, 7), na = __builtin_shufflevector(n0, n1, 0, 1, 2, 3, 4, 5, 6, 7);
                            Gr = MFMA32(ca, xr, Gr); Gr = MFMA32(sa, xi, Gr); Gi = MFMA32(ca, xi, Gi); Gi = MFMA32(na, xr, Gi); }
#pragma unroll
                    for (int i = 0; i < 16; ++i) { const int s1p = 32 * Rp + crow16(i, h); const int m = (s2 * s1p) & 4095; const float wr = TWL[2 * m], wi = TWL[2 * m + 1];
                        const size_t o = ((((size_t)(b * 4 + g4) * 64 + s1p) * 2) * 64 + s2) * 64 + 32 * cb + r;
                        FTMP[o] = (bf16)f2bf(Gr[i] * wr - Gi[i] * wi); FTMP[o + 4096] = (bf16)f2bf(Gr[i] * wi + Gi[i] * wr); } }
              }
              __syncthreads(); }
            STAMP2(5);
            { float* GS = WSP(float, WS_OF); float* GD = WSP(float, WS_OB);
              const int slot = wave >> 2, w4 = wave & 3, fr = lane & 15, fq = lane >> 4; LAS unsigned char* Ls = lds + RING_OFF + slot * GM_SLOT;
              for (int ub = bx; ub < NB * 4 * 64 / 2; ub += G) { const int u = ub * 2 + slot, c = u & 63, bh = u >> 6, hd = bh & 3, b = bh >> 2; const size_t tok0 = (size_t)b * SEQ + c * 64;
                __syncthreads();
                gla_stage_mfma<false>(Ls, PROJ, LA, nullptr, tok0, hd, w4, lane);
                __syncthreads();
                const LAS bf16* VT = (const LAS bf16*)(Ls + GM_VT); const LAS float* DL = (const LAS float*)(Ls + GM_DL);
#pragma unroll
                for (int dir = 0; dir < 2; ++dir) { const LAS bf16* KT = (const LAS bf16*)(Ls + GM_P + dir * 4608);
#pragma unroll
                    for (int Cd = 0; Cd < 2; ++Cd) { f32x4 acc = {0.f, 0.f, 0.f, 0.f};
#pragma unroll
                        for (int ks = 0; ks < 2; ++ks) { const bf16x8 a_ = *(const LAS bf16x8*)(VT + (16 * w4 + fr) * 72 + 32 * ks + 8 * fq), b_ = *(const LAS bf16x8*)(KT + (16 * Cd + fr) * 72 + 32 * ks + 8 * fq); acc = MFMA16(a_, b_, acc); }
                        const float Dd = DL[dir * 32 + 16 * Cd + fr]; float* o = GS + (((size_t)u * 2 + dir) * 64 + 16 * w4 + 4 * fq) * 32 + 16 * Cd + fr;
#pragma unroll
                        for (int r = 0; r < 4; ++r) o[r * 32] = acc[r] * Dd; } }
                if (w4 == 3) GD[((size_t)u * 2 + (lane >> 5)) * 32 + (lane & 31)] = DL[lane]; }
              __syncthreads(); }
            STAMP2(9);
        }
        SEAM(pb + 1);
        if (IN(pb + 2) && PON(3)) {
            TID_SETUP(); unsigned char* ws = KWS(); float* GS = WSP(float, WS_OF); const float* GD = WSP(float, WS_OB);
            for (int e = gt; e < NB * 4 * 2 * 2048; e += NGT) { const int dv = e & 2047, dir = (e >> 11) & 1, bh = e >> 12, d = dv & 31; float H = 0.f;
                for (int c8 = 0; c8 < 64; c8 += 8) { float sv[8], dd[8];
#pragma unroll
                    for (int i = 0; i < 8; ++i) { const int c = dir ? 63 - (c8 + i) : (c8 + i); const size_t sidx = ((size_t)(bh * 64 + c) * 2 + dir); sv[i] = GS[sidx * 2048 + dv]; dd[i] = GD[sidx * 32 + d]; }
#pragma unroll
                    for (int i = 0; i < 8; ++i) { const int c = dir ? 63 - (c8 + i) : (c8 + i); const size_t sidx = ((size_t)(bh * 64 + c) * 2 + dir); GS[sidx * 2048 + dv] = H; H = H * dd[i] + sv[i]; } } }
        }
        SEAM(pb + 2);
        if (IN(pb + 3) && PON(4)) {
            TID_SETUP(); unsigned char* ws = KWS(); const float* gla_norm_g = KIN(8); const bf16* PROJ = WSP(bf16, WS_PROJ);
            bf16* MIX = WSP(bf16, WS_MIX); const bf16* QB = WSP(bf16, WS_QB); const bf16* KB = WSP(bf16, WS_KB);
            { __syncthreads();
              { const v4u* src = (const v4u*)WSP(bf16, WS_FTAB); LAS v4u* dst = (LAS v4u*)(lds + RING_OFF + FFT_LDS_TAB); for (int i = tid; i < 3 * FT_TAB * 2 / 16; i += NWAVES * 64) dst[i] = src[i]; }
              const LAS bf16* FT = (const LAS bf16*)(lds + RING_OFF + FFT_LDS_TAB); const bf16* FTMP = WSP(bf16, WS_FTMP);
              const int pair = wave >> 1, cb = wave & 1, r = lane & 31, h = lane >> 5;
              LAS bf16* HT = (LAS bf16*)(lds + RING_OFF + FFT_LDS_HT + pair * FFT_HT_PAIR);
              for (int ub = bx; ub < NB * 4 * 64 / 4; ub += G) { const int u = ub * 4 + pair, s1p = u & 63, g4 = (u >> 6) & 3, b = u >> 8;
                const bf16* src = FTMP + (size_t)u * 2 * 4096;
                __syncthreads();
#pragma unroll
                for (int q = 0; q < 8; ++q) { const int p = cb * 64 + lane + 128 * q, ri = p >> 9, s2 = (p >> 3) & 63, c0 = (p & 7) * 8; const u16x8 v = *(const u16x8*)(src + p * 8);
#pragma unroll
                    for (int i = 0; i < 8; ++i) HT[(ri * 64 + c0 + i) * FT_PITCH + s2] = v[i]; }
                __syncthreads();
#pragma unroll
                for (int Rp = 0; Rp < 2; ++Rp) { f32x16 acc;
#pragma unroll
                    for (int i = 0; i < 16; ++i) acc[i] = 0.f;
#pragma unroll
                    for (int ks = 0; ks < 4; ++ks) { const int ko = 16 * ks + 8 * h;
                        const bf16x8 ca = *(const LAS bf16x8*)(FT + (32 * Rp + r) * FT_PITCH + ko), sa = *(const LAS bf16x8*)(FT + FT_TAB + (32 * Rp + r) * FT_PITCH + ko);
                        const bf16x8 hr = *(const LAS bf16x8*)(HT + (32 * cb + r) * FT_PITCH + ko), hi_ = *(const LAS bf16x8*)(HT + (64 + 32 * cb + r) * FT_PITCH + ko);
                        acc = MFMA32(ca, hr, acc); acc = MFMA32(sa, hi_, acc); }
#pragma unroll
                    for (int i = 0; i < 16; ++i) { const int s2p = 32 * Rp + crow16(i, h); MIX[((size_t)b * SEQ + s1p + 64 * s2p) * DM + 768 + g4 * 64 + 32 * cb + r] = (bf16)f2bf(acc[i] * (1.0f / 512.0f)); } }
              }
              __syncthreads(); }
            STAMP2(6);
            { const float* GS = WSP(float, WS_OF); const float* LA = WSP(float, WS_LA);
              const int slot = wave >> 2, w4 = wave & 3, fr = lane & 15, fq = lane >> 4, I0 = 16 * w4; LAS unsigned char* Ls = lds + RING_OFF + slot * GM_SLOT;
              for (int ub = bx; ub < NB * 4 * 64 / 2; ub += G) { const int u = ub * 2 + slot, c = u & 63, bh = u >> 6, hd = bh & 3, b = bh >> 2; const size_t tok0 = (size_t)b * SEQ + c * 64;
                __syncthreads();
                gla_stage_mfma<true>(Ls, PROJ, LA, GS + (size_t)u * 2 * 2048, tok0, hd, w4, lane);
                __syncthreads();
                const LAS bf16* QF = (const LAS bf16*)(Ls + GM_QF); const LAS bf16* KF = (const LAS bf16*)(Ls + GM_KF); const LAS bf16* QBm = (const LAS bf16*)(Ls + GM_QB); const LAS bf16* KBm = (const LAS bf16*)(Ls + GM_KB);
                const LAS bf16* VT = (const LAS bf16*)(Ls + GM_VT); LAS bf16* P = (LAS bf16*)(Ls + GM_P); const LAS bf16* HTF = (const LAS bf16*)(Ls + GM_HTF); const LAS bf16* HTB = (const LAS bf16*)(Ls + GM_HTB);
                const bf16x8 qfa = *(const LAS bf16x8*)(QF + (I0 + fr) * 40 + 8 * fq), qba = *(const LAS bf16x8*)(QBm + (I0 + fr) * 40 + 8 * fq);
#pragma unroll
                for (int Cj = 0; Cj < 4; ++Cj) { const f32x4 z = {0.f, 0.f, 0.f, 0.f};
                    const f32x4 pf = MFMA16(qfa, *(const LAS bf16x8*)(KF + (16 * Cj + fr) * 40 + 8 * fq), z), pb = MFMA16(qba, *(const LAS bf16x8*)(KBm + (16 * Cj + fr) * 40 + 8 * fq), z);
#pragma unroll
                    for (int r = 0; r < 4; ++r) { const int i = I0 + 4 * fq + r, j = 16 * Cj + fr; P[i * 72 + j] = (bf16)f2bf(j <= i ? pf[r] : pb[r]); } }
                asm volatile("s_waitcnt lgkmcnt(0)" ::: "memory");
                f32x4 o[4];
#pragma unroll
                for (int Cv = 0; Cv < 4; ++Cv) { f32x4 acc = {0.f, 0.f, 0.f, 0.f};
#pragma unroll
                    for (int ks = 0; ks < 2; ++ks) acc = MFMA16(*(const LAS bf16x8*)(P + (I0 + fr) * 72 + 32 * ks + 8 * fq), *(const LAS bf16x8*)(VT + (16 * Cv + fr) * 72 + 32 * ks + 8 * fq), acc);
                    acc = MFMA16(qfa, *(const LAS bf16x8*)(HTF + (16 * Cv + fr) * 40 + 8 * fq), acc); acc = MFMA16(qba, *(const LAS bf16x8*)(HTB + (16 * Cv + fr) * 40 + 8 * fq), acc);
                    o[Cv] = acc; }
                float rs[4];
#pragma unroll
                for (int r = 0; r < 4; ++r) { float ss = (o[0][r] * o[0][r] + o[1][r] * o[1][r]) + (o[2][r] * o[2][r] + o[3][r] * o[3][r]);
#pragma unroll
                    for (int m_ = 1; m_ < 16; m_ <<= 1) ss += __shfl_xor(ss, m_);
                    rs[r] = 1.f / sqrtf(ss * (1.f / 64.f) + RMS_EPS); }
#pragma unroll
                for (int Cv = 0; Cv < 4; ++Cv) { const int v = 16 * Cv + fr; const float gn = gla_norm_g[l * 64 + v];
#pragma unroll
                    for (int r = 0; r < 4; ++r) { const size_t m = tok0 + I0 + 4 * fq + r; const float rg = bf2f(PROJ[m * INP + C_GR + hd * 64 + v]);
                        MIX[m * DM + 512 + hd * 64 + v] = (bf16)f2bf(o[Cv][r] * rs[r] * gn * (rg / (1.f + expf(-rg)))); } } }
              __syncthreads(); }
            STAMP2(7);
#if NAIVE_ATTN
            { LAS float* Kt = (LAS float*)(lds + RING_OFF); LAS float* Vt = Kt + 64 * 64;
              for (int unit = bx; unit < NB * 8 * 8; unit += G) { const int rb = unit & 7, h = (unit >> 3) & 7, b = unit >> 6, kvh = h >> 2;
                const size_t qrow = (size_t)b * SEQ + rb * 512 + tid;
                float q[64], o[64]; float mrun = -INFINITY, lrun = 0.f;
#pragma unroll
                for (int c8 = 0; c8 < 8; ++c8) { const u16x8 f = *(const u16x8*)(QB + qrow * 512 + h * 64 + c8 * 8);
#pragma unroll
                    for (int i = 0; i < 8; ++i) { q[c8 * 8 + i] = bf2f(f[i]); o[c8 * 8 + i] = 0.f; } }
                for (int kt = 0; kt < SEQ; kt += 64) {
                    __syncthreads();
                    { const int kr = tid >> 3, c8 = (tid & 7) * 8; const size_t krow = (size_t)b * SEQ + kt + kr;
                      const u16x8 kf = *(const u16x8*)(KB + krow * 128 + kvh * 64 + c8); const u16x8 vf = *(const u16x8*)(PROJ + krow * INP + C_AV + kvh * 64 + c8);
#pragma unroll
                      for (int i = 0; i < 8; ++i) { Kt[kr * 64 + c8 + i] = bf2f(kf[i]); Vt[kr * 64 + c8 + i] = bf2f(vf[i]); } }
                    __syncthreads();
#pragma unroll 1
                    for (int j = 0; j < 64; ++j) { float a = 0.f;
#pragma unroll
                        for (int d4 = 0; d4 < 16; ++d4) { const f32x4 kv = *(const LAS f32x4*)(Kt + j * 64 + d4 * 4); a += (q[d4 * 4] * kv.x + q[d4 * 4 + 1] * kv.y) + (q[d4 * 4 + 2] * kv.z + q[d4 * 4 + 3] * kv.w); }
                        if (a > mrun) { const float al = exp2f(mrun - a); mrun = a; lrun *= al;
#pragma unroll
                            for (int d = 0; d < 64; ++d) o[d] *= al; }
                        const float p = exp2f(a - mrun); lrun += p;
#pragma unroll
                        for (int d4 = 0; d4 < 16; ++d4) { const f32x4 vv = *(const LAS f32x4*)(Vt + j * 64 + d4 * 4); o[d4 * 4] += p * vv.x; o[d4 * 4 + 1] += p * vv.y; o[d4 * 4 + 2] += p * vv.z; o[d4 * 4 + 3] += p * vv.w; } }
                }
                const float rl = 1.f / lrun;
#pragma unroll
                for (int c8 = 0; c8 < 8; ++c8) { v4u w; w.x = pk2(o[c8 * 8] * rl, o[c8 * 8 + 1] * rl); w.y = pk2(o[c8 * 8 + 2] * rl, o[c8 * 8 + 3] * rl); w.z = pk2(o[c8 * 8 + 4] * rl, o[c8 * 8 + 5] * rl); w.w = pk2(o[c8 * 8 + 6] * rl, o[c8 * 8 + 7] * rl);
                    *(v4u*)(MIX + qrow * DM + h * 64 + c8 * 8) = w; }
              }
              __syncthreads(); }
#else
            { const attn_body::AttnTensors AT{(const attn_body::bf16*)QB, (const attn_body::bf16*)KB, (const attn_body::bf16*)(PROJ + C_AV), (attn_body::bf16*)MIX};
              const attn_body::StaticOrder S(G, bx);
              attn_body::attn_phase<attn_body::StaticOrder>((char*)lds_raw + RING_OFF, AT, S); }
#endif
        }
        SEAM(pb + 3);
        if (IN(pb + 4) && PON(5)) {
            TID_SETUP(); unsigned char* ws = KWS(); const bf16* MIX = WSP(bf16, WS_MIX); const bf16* WOUT_T = WSP(bf16, WS_WOUT_T); const bf16* HB = WSP(bf16, WS_HB); bf16* T1 = WSP(bf16, WS_T1);
            pg8::Gemm g{MIX, WOUT_T + (size_t)l * DM * DM, NTOK, DM, DM}; pg8::StaticOrder S; S.init(NTOK, DM, G, bx);
            pg8::EpiResBf16 E{HB, T1, DM, DN_ALPHA};
            pg8::gemm_phase<pg8::EpiResBf16, pg8::StaticOrder, true, true>(lds + RING_OFF, g, S, E);
        }
        SEAM(pb + 4);
        if (IN(pb + 5) && PON(6)) {
            TID_SETUP(); unsigned char* ws = KWS(); gu32* ctl = (gu32*)(ws + WS_CTL); const float* ln1_g = KIN(10); const float* ln1_b = KIN(11); const float* router_w = KIN(12); const float* router_b = KIN(13);
            const bf16* T1 = WSP(bf16, WS_T1); bf16* HB = WSP(bf16, WS_HB); int* TOKE = WSP(int, WS_TOK); int* TOKS = TOKE + NTOK * 4; float* TOKW = (float*)(TOKS + NTOK * 4); int* LIST = WSP(int, WS_XS);
            LAS float* RW = (LAS float*)(lds + RING_OFF);
            { const float* rw = router_w + (size_t)l * DM * NE; for (int i = tid; i < DM * NE; i += NWAVES * 64) { const int c = i >> 5, e = i & 31; RW[e * DM + c] = rw[i]; } }
            LAS int* lcnt = (LAS int*)(lctl + LC_CNT); LAS int* lbase = (LAS int*)(lctl + LC_BASE); LAS int* sele = (LAS int*)(lctl + LC_SELE); LAS int* sels = (LAS int*)(lctl + LC_SELS);
            const float* rb = router_b + l * NE;
            for (int r0 = bx * 128; r0 < NTOK; r0 += G * 128) {
                if (tid < 32) lcnt[tid] = 0;
                __syncthreads();
                LAS float* LG = (LAS float*)(lctl + LC_LG) + wave * 512;
                f32x4 gam[4], bet[4];
#pragma unroll
                for (int j = 0; j < 4; ++j) { gam[j] = *(const f32x4*)(ln1_g + l * DM + lane * 4 + 256 * j); bet[j] = *(const f32x4*)(ln1_b + l * DM + lane * 4 + 256 * j); }
                for (int rr = 0; rr < 16; rr += 2) { const int lr = wave * 16 + rr; const size_t m = (size_t)r0 + lr; f32x4 v[2][4];
#pragma unroll
                    for (int q = 0; q < 2; ++q)
#pragma unroll
                        for (int j = 0; j < 4; ++j) { const u16x4 t_ = *(const u16x4*)(T1 + (m + q) * DM + lane * 4 + 256 * j); v[q][j] = (f32x4){bf2f(t_[0]), bf2f(t_[1]), bf2f(t_[2]), bf2f(t_[3])}; }
#pragma unroll
                    for (int q = 0; q < 2; ++q) { float s_ = 0.f;
#pragma unroll
                        for (int j = 0; j < 4; ++j) s_ += (v[q][j].x + v[q][j].y) + (v[q][j].z + v[q][j].w);
                        const float mean = wave_sum(s_) * (1.f / DM); float s2_ = 0.f;
#pragma unroll
                        for (int j = 0; j < 4; ++j) { v[q][j] = v[q][j] - mean; s2_ += (v[q][j].x * v[q][j].x + v[q][j].y * v[q][j].y) + (v[q][j].z * v[q][j].z + v[q][j].w * v[q][j].w); }
                        const float rstd = 1.f / sqrtf(wave_sum(s2_) * (1.f / DM) + LN_EPS);
#pragma unroll
                        for (int j = 0; j < 4; ++j) { v[q][j] = v[q][j] * rstd * gam[j] + bet[j];
                            *(unsigned long long*)(HB + (m + q) * DM + lane * 4 + 256 * j) = (unsigned long long)pk2(v[q][j].x, v[q][j].y) | ((unsigned long long)pk2(v[q][j].z, v[q][j].w) << 32); } }
                    float a0[32], a1[32];
#pragma unroll
                    for (int e = 0; e < 32; ++e) { f32x2_t s0 = {0.f, 0.f}, s1 = {0.f, 0.f};
#pragma unroll
                        for (int j = 0; j < 4; ++j) { const f32x4 w = *(const LAS f32x4*)(RW + e * DM + lane * 4 + 256 * j); const f32x2_t wl = {w.x, w.y}, wh = {w.z, w.w};
                            s0 += (f32x2_t){v[0][j].x, v[0][j].y} * wl; s0 += (f32x2_t){v[0][j].z, v[0][j].w} * wh; s1 += (f32x2_t){v[1][j].x, v[1][j].y} * wl; s1 += (f32x2_t){v[1][j].z, v[1][j].w} * wh; }
                        a0[e] = s0.x + s0.y; a1[e] = s1.x + s1.y; }
#define TRSTEP(SRC, DST, N, MASK) _Pragma("unroll") for (int e = 0; e < (N); ++e) { const bool hi_ = (lane & (MASK)) != 0; const float keep = hi_ ? SRC[e + (N)] : SRC[e], send = hi_ ? SRC[e] : SRC[e + (N)]; DST[e] = keep + __shfl_xor(send, (MASK)); }
                    float t0, t1;
                    { float b_[16], c_[8], d_[4], e_[2], f_[1]; TRSTEP(a0, b_, 16, 32) TRSTEP(b_, c_, 8, 16) TRSTEP(c_, d_, 4, 8) TRSTEP(d_, e_, 2, 4) TRSTEP(e_, f_, 1, 2) t0 = f_[0] + __shfl_xor(f_[0], 1); }
                    { float b_[16], c_[8], d_[4], e_[2], f_[1]; TRSTEP(a1, b_, 16, 32) TRSTEP(b_, c_, 8, 16) TRSTEP(c_, d_, 4, 8) TRSTEP(d_, e_, 2, 4) TRSTEP(e_, f_, 1, 2) t1 = f_[0] + __shfl_xor(f_[0], 1); }
#undef TRSTEP
                    { const int E = (lane >> 1) & 31; const float bias = rb[E]; if ((lane & 1) == 0) { LG[rr * 32 + E] = t0 + bias; LG[(rr + 1) * 32 + E] = t1 + bias; } }
                }
                asm volatile("s_waitcnt lgkmcnt(0)" ::: "memory");
                if (lane < 16) { const int lr = wave * 16 + lane; const size_t m = (size_t)r0 + lr; float lg[32];
#pragma unroll
                    for (int e4 = 0; e4 < 8; ++e4) { const f32x4 x = *(const LAS f32x4*)(LG + lane * 32 + e4 * 4); lg[e4 * 4] = x.x; lg[e4 * 4 + 1] = x.y; lg[e4 * 4 + 2] = x.z; lg[e4 * 4 + 3] = x.w; }
                    int se[4]; float sv[4];
#pragma unroll
                    for (int k = 0; k < 4; ++k) { float best = -INFINITY; int bi = 0;
#pragma unroll
                        for (int e = 0; e < 32; ++e) { if (lg[e] > best) { best = lg[e]; bi = e; } }
                        se[k] = bi; sv[k] = best;
#pragma unroll
                        for (int e = 0; e < 32; ++e) if (e == bi) lg[e] = -INFINITY; }
                    const float e1 = expf(sv[1] - sv[0]), e2 = expf(sv[2] - sv[0]), e3 = expf(sv[3] - sv[0]); const float inv = 1.f / (1.f + e1 + e2 + e3);
                    const float wts[4] = {inv, e1 * inv, e2 * inv, e3 * inv};
#pragma unroll
                    for (int k = 0; k < 4; ++k) { const int ls = __hip_atomic_fetch_add(lcnt + se[k], 1, __ATOMIC_RELAXED, __HIP_MEMORY_SCOPE_WORKGROUP); sele[lr * 4 + k] = se[k]; sels[lr * 4 + k] = ls; TOKW[m * 4 + k] = wts[k]; } }
                __syncthreads();
                if (tid < 32) lbase[tid] = (int)__hip_atomic_fetch_add(ctl + CW_CNT + l * 32 + tid, (unsigned)lcnt[tid], RLX_AGENT);
                __syncthreads();
                { const int e = sele[tid], sl = lbase[e] + sels[tid]; TOKE[(size_t)r0 * 4 + tid] = e; TOKS[(size_t)r0 * 4 + tid] = sl; LIST[(size_t)e * NTOK + sl] = r0 + (tid >> 2); }
                __syncthreads();
            }
        }
        SEAM(pb + 5);
#if defined(EXP_P1_NOEPI)
        if (IN(pb + 6)) {
            TID_SETUP(); unsigned char* ws = KWS(); bf16* HB = WSP(bf16, WS_HB); bf16* WIN_T = WSP(bf16, WS_WIN_T); bf16* PROJ = WSP(bf16, WS_PROJ);
            pg8::Gemm g{HB, WIN_T + (size_t)l * INP * DM, NTOK, INP, DM}; pg8::StaticOrder S; S.init(NTOK, INP, G, bx);
            pg8::EpiNull EN{PROJ}; pg8::gemm_phase<pg8::EpiNull, pg8::StaticOrder, true, true>(lds + RING_OFF, g, S, EN);
            __syncthreads(); }
#endif
        STAMP(pb + 7);
        if (IN(pb + 7) || IN(pb + 8) || IN(pb + 9)) {
            LAS int* pst = (LAS int*)(lctl + LC_PSTART); LAS int* ecnt = (LAS int*)(lctl + LC_BASE); gu32* ctl = (gu32*)(KWS() + WS_CTL);
            __syncthreads();
            if (threadIdx.x == 0) { int acc = 0; for (int e = 0; e < NE; ++e) { pst[e] = acc; const int c = (int)__hip_atomic_load(ctl + CW_CNT + l * 32 + e, RLX_AGENT); ecnt[e] = c; acc += (c + 255) >> 8; } pst[NE] = acc; }
            __syncthreads();
        }
        if (IN(pb + 7) && PON(8)) {
            TID_SETUP(); unsigned char* ws = KWS(); const float* exp_b_gu = KIN(15); const bf16* HB = WSP(bf16, WS_HB); const int* LIST = WSP(int, WS_XS); const bf16* WGU_T = WSP(bf16, WS_WGU_T); bf16* HID = WSP(bf16, WS_HID);
            const LAS int* pst = (const LAS int*)(lctl + LC_PSTART); LAS int* ul = (LAS int*)(lctl + LC_ULIST);
            const int nM = pst[NE], nN = 8, nwg = nM * nN;
            if (tid < 64) { const long L = (long)tid * G + bx; int v = -1;
                if (L < nwg) { int wgid = (int)L; { const int q = nwg / 8, r = nwg % 8, xcd = wgid % 8, off = wgid / 8; wgid = (xcd < r ? xcd * (q + 1) : r * (q + 1) + (xcd - r) * q) + off; }
                    const int nig = 8 * nN, gid = wgid / nig, fm = gid * 8, gsz = (nM - fm) < 8 ? (nM - fm) : 8; const int pm = fm + ((wgid % nig) % gsz), pn = (wgid % nig) / gsz;
                    int e = 0; for (int k = 1; k < NE; ++k) if (pst[k] <= pm) e = k;
                    v = (pm << 16) | (e * nN + pn); }
                ul[tid] = v; }
            __syncthreads();
            const int nunits = bx < nwg ? (nwg - bx + G - 1) / G : 0;
            LAS unsigned short* rows16 = (LAS unsigned short*)(lctl + LC_ROWS); const LAS int* ecnt = (const LAS int*)(lctl + LC_BASE);
            for (int sl = 0; sl < nunits; ++sl) { const int v = ul[sl]; const int pm = v >> 16, e = (v & 0xffff) >> 3, pl = pm - pst[e];
                if (tid < 256) { const int idx = pl * 256 + tid; rows16[sl * 256 + tid] = (idx < ecnt[e]) ? (unsigned short)LIST[(size_t)e * NTOK + idx] : (unsigned short)0; } }
            __syncthreads();
            pg8::Gemm g{HB, WGU_T + (size_t)l * NE * 2048 * DM, NTOK, NE * 2048, DM}; pg8::ListOrder S{ul, nunits};
            pg8::EpiSwiglu E{HID, exp_b_gu + (size_t)l * NE * 2048};
            pg8::gemm_phase_gather<pg8::EpiSwiglu, pg8::ListOrder, true>(lds + RING_OFF, g, S, E, rows16);
        }
        SEAM(pb + 7);
        if (IN(pb + 8) && PON(9)) {
            TID_SETUP(); unsigned char* ws = KWS(); const float* exp_b_down = KIN(17); const bf16* HID = WSP(bf16, WS_HID); const bf16* WDN_T = WSP(bf16, WS_WDN_T); bf16* YS = WSP(bf16, WS_YS);
            const LAS int* pst = (const LAS int*)(lctl + LC_PSTART); LAS int* ul = (LAS int*)(lctl + LC_ULIST);
            const int nM = pst[NE], nN = 4, nwg = nM * nN;
            __syncthreads();
            if (tid < 64) { const long L = (long)tid * G + bx; int v = -1;
                if (L < nwg) { int wgid = (int)L; { const int q = nwg / 8, r = nwg % 8, xcd = wgid % 8, off = wgid / 8; wgid = (xcd < r ? xcd * (q + 1) : r * (q + 1) + (xcd - r) * q) + off; }
                    const int nig = 8 * nN, gid = wgid / nig, fm = gid * 8, gsz = (nM - fm) < 8 ? (nM - fm) : 8; const int pm = fm + ((wgid % nig) % gsz), pn = (wgid % nig) / gsz;
                    int e = 0; for (int k = 1; k < NE; ++k) if (pst[k] <= pm) e = k;
                    v = (pm << 16) | (e * nN + pn); }
                ul[tid] = v; }
            __syncthreads();
            const int nunits = bx < nwg ? (nwg - bx + G - 1) / G : 0;
            pg8::Gemm g{HID, WDN_T + (size_t)l * NE * DM * DE, MPAD, NE * DM, DE}; pg8::ListOrder S{ul, nunits};
            pg8::EpiDown E{YS, exp_b_down + (size_t)l * NE * DM};
            pg8::gemm_phase<pg8::EpiDown, pg8::ListOrder, true, true>(lds + RING_OFF, g, S, E);
        }
        SEAM(pb + 8);
        if (IN(pb + 9) && PON(10)) {
            TID_SETUP(); unsigned char* ws = KWS(); const float* ln2_g = KIN(18); const float* ln2_b = KIN(19); float* out = KOUT(); bf16* HB = WSP(bf16, WS_HB);
            const bf16* YS = WSP(bf16, WS_YS); const int* TOKE = WSP(int, WS_TOK); const int* TOKS = TOKE + NTOK * 4; const float* TOKW = (const float*)(TOKS + NTOK * 4); const LAS int* pst = (const LAS int*)(lctl + LC_PSTART);
            const bool lastl = (l == NL - 1);
            for (int m0 = gw; m0 < NTOK; m0 += 2 * NGW) { f32x4 v[2][4]; const bf16* yr[2][4]; float wk[2][4];
#pragma unroll
                for (int q = 0; q < 2; ++q) { const int m = m0 + q * NGW;
#pragma unroll
                    for (int k = 0; k < 4; ++k) { wk[q][k] = TOKW[m * 4 + k]; yr[q][k] = YS + (size_t)(pst[TOKE[m * 4 + k]] * 256 + TOKS[m * 4 + k]) * DM; }
#pragma unroll
                    for (int j = 0; j < 4; ++j) { const u16x4 t_ = *(const u16x4*)(HB + (size_t)m * DM + lane * 4 + 256 * j); v[q][j] = (f32x4){bf2f(t_[0]), bf2f(t_[1]), bf2f(t_[2]), bf2f(t_[3])} * DN_ALPHA; } }
#pragma unroll
                for (int q = 0; q < 2; ++q)
#pragma unroll
                    for (int k = 0; k < 4; ++k)
#pragma unroll
                        for (int j = 0; j < 4; ++j) { const u16x4 y = *(const u16x4*)(yr[q][k] + lane * 4 + 256 * j); const float w = wk[q][k]; v[q][j].x += w * bf2f(y[0]); v[q][j].y += w * bf2f(y[1]); v[q][j].z += w * bf2f(y[2]); v[q][j].w += w * bf2f(y[3]); }
#pragma unroll
                for (int q = 0; q < 2; ++q) { const int m = m0 + q * NGW;
                    ln_row(v[q], ln2_g + l * DM, ln2_b + l * DM, lastl ? out + (size_t)m * DM : nullptr, lastl ? nullptr : HB + (size_t)m * DM, lane); } }
        }
        SEAM(pb + 9);
    }
#if PROBE_A >= 0
    { xcd_barrier(bar);
      const unsigned long long* st = (const unsigned long long*)(KWS() + WS_CTL + 65536); unsigned long long T = 0;
      if (PROBE_A & 1) T += st[1] - st[0];
      for (int l = 0; l < NL; ++l) for (int j = 1; j <= 10; ++j) if ((PROBE_A >> j) & 1) T += st[1 + 10 * l + j] - st[10 * l + j];
      if (PROBE_SUB_A >= 0) for (int l = 0; l < NL; ++l) T += st[128 + l * 16 + PROBE_SUB_B] - st[128 + l * 16 + PROBE_SUB_A];
      T *= 4ull; if (T > 5000000ull) T = 5000000ull;
      const unsigned long long t0 = __builtin_amdgcn_s_memrealtime();
      while (__builtin_amdgcn_s_memrealtime() - t0 < T) __builtin_amdgcn_s_sleep(16); }
#endif
#undef IN
#undef SEAM
}

#ifndef MK_PER_PHASE
#define MK_PER_PHASE 0
#endif
extern "C" void kernel_launch(void* const* d_in, const int* in_sizes, int n_in, void* d_out, int out_size, void* d_ws, size_t ws_size, hipStream_t stream) {
    static int grid = 0;
    if (grid == 0) {
        if (n_in != 20 || in_sizes[0] != NTOK * DM || out_size != NTOK * DM || ws_size < WS_END) { fprintf(stderr, "kernel_launch: unexpected shapes (n_in %d, in0 %d, out %d, ws %zu); nothing launched\n", n_in, n_in > 0 ? in_sizes[0] : -1, out_size, ws_size); grid = -1; return; }
        int dev = 0, cus = 0, per_cu = 0;
        if (hipGetDevice(&dev) != hipSuccess || hipDeviceGetAttribute(&cus, hipDeviceAttributeMultiprocessorCount, dev) != hipSuccess) { grid = -1; return; }
        if (hipFuncSetAttribute((const void*)fwd, hipFuncAttributeMaxDynamicSharedMemorySize, LDS_BYTES) != hipSuccess) { fprintf(stderr, "kernel_launch: hipFuncSetAttribute failed\n"); grid = -1; return; }
        if (hipOccupancyMaxActiveBlocksPerMultiprocessor(&per_cu, (const void*)fwd, NWAVES * 64, LDS_BYTES) != hipSuccess || per_cu < 1) fprintf(stderr, "kernel_launch: occupancy query reports %d\n", per_cu);
        (void)hipGetLastError();
        grid = cus;
    }
    if (grid < 0) return;
    if (hipMemsetAsync((char*)d_ws + WS_CTL, 0, CTL_ZERO_BYTES, stream) != hipSuccess) return;
    Args a{};
    for (int i = 0; i < 20; ++i) a.in[i] = (const float*)d_in[i];
    a.out = (float*)d_out; a.ws = (unsigned char*)d_ws;
#if MK_PER_PHASE
    for (int p = 0; p < N_PHASES; ++p) { a.ph_lo = p; a.ph_hi = p + 1; hipLaunchKernelGGL(fwd, dim3(grid), dim3(NWAVES * 64), LDS_BYTES, stream, a); }
#else
    a.ph_lo = 0; a.ph_hi = N_PHASES;
    hipLaunchKernelGGL(fwd, dim3(grid), dim3(NWAVES * 64), LDS_BYTES, stream, a);
#endif
    const hipError_t le = hipPeekAtLastError();
    if (le != hipSuccess) fprintf(stderr, "kernel_launch: launch failed: %s\n", hipGetErrorName(le));
}
```

```cpp
#include <hip/hip_runtime.h>
#include <hip/hip_bf16.h>
#include <cstdio>
#include <cstdint>
#include <cmath>
namespace pg8 {
#define PG8_LAS __attribute__((address_space(3)))
typedef unsigned short bf16_t;
typedef short bf16x8 __attribute__((ext_vector_type(8)));
typedef float f32x4 __attribute__((ext_vector_type(4)));
typedef unsigned u32x4 __attribute__((ext_vector_type(4)));
constexpr int BM = 256, BK = 64, HALF = 128, HTB = HALF * BK * 2  , STAGE_BYTES = 8 * HTB, NXCD = 8, WGM = 8;

__host__ __device__ __forceinline__ int lds_byte(int r, int c) { const int st = (r >> 4) * 2 + (c >> 5), rr = r & 15, cc = c & 31, ob = rr * 64 + cc * 2; return st * 1024 + (ob ^ (((ob >> 9) & 1) << 5)); }
__host__ __device__ __forceinline__ void stage_rc(int b, int& R, int& C) { const int st = b / 1024, sb = b % 1024, swz = sb ^ (((sb >> 9) & 1) << 5); R = (st >> 1) * 16 + swz / 64; C = (st & 1) * 32 + (swz % 64) / 2; }
__host__ __device__ __forceinline__ int perm32(int rho) { const int n = rho >> 4, i = rho & 15; return 8 * (i >> 2) + 4 * n + (i & 3); }

struct Unit { int pm, pn; };
struct Gemm { const bf16_t* A; const bf16_t* Bt; int M, N, K; };

struct StaticOrder {
    int nM, nN, nwg, G, c;
    __host__ __device__ void init(int M, int N, int G_, int c_) { nM = M / BM; nN = N / BM; nwg = nM * nN; G = G_; c = c_; }
    __host__ __device__ bool next(int i, Unit& u) const {
        const long L = (long)i * G + c; if (L >= nwg) return false;
        int wgid = (int)L; { const int q = nwg / NXCD, r = nwg % NXCD, xcd = wgid % NXCD, off = wgid / NXCD; wgid = (xcd < r ? xcd * (q + 1) : r * (q + 1) + (xcd - r) * q) + off; }
        const int nig = WGM * nN, gid = wgid / nig, fm = gid * WGM, gsz = (nM - fm) < WGM ? (nM - fm) : WGM;
        u.pm = fm + ((wgid % nig) % gsz); u.pn = (wgid % nig) / gsz; return true;
    }
    __device__ __forceinline__ void a_ready(const Unit&) const {}
    __device__ __forceinline__ void done(const Unit&) const {}
};

__device__ __forceinline__ unsigned cvt_pk_bf16(float lo, float hi) { unsigned r; asm volatile("v_cvt_pk_bf16_f32 %0, %1, %2" : "=v"(r) : "v"(lo), "v"(hi)); return r; }
typedef float f32x2 __attribute__((ext_vector_type(2)));
__device__ __forceinline__ u32x4 pack8(const f32x4 v0, const f32x4 v1) { u32x4 w; w.x = cvt_pk_bf16(v0[0], v0[1]); w.y = cvt_pk_bf16(v0[2], v0[3]); w.z = cvt_pk_bf16(v1[0], v1[1]); w.w = cvt_pk_bf16(v1[2], v1[3]); return w; }

struct EpiPlainBf16 {
    static constexpr bool PERM = true, AFTER_DRAIN = false;
    bf16_t* O; int ldc;
    __device__ __forceinline__ void operator()(const f32x4 (&acc)[2][2][4][2], const Unit& u, int wr, int wc, int fr, int fq) const {
        const int row0 = u.pm * BM + wr * 64 + fr, col0 = u.pn * BM + wc * 32 + 8 * fq;
#pragma unroll
        for (int ai = 0; ai < 2; ++ai)
#pragma unroll
            for (int m = 0; m < 4; ++m) { bf16_t* rowp = O + (size_t)(row0 + ai * HALF + m * 16) * ldc + col0;
#pragma unroll
                for (int bj = 0; bj < 2; ++bj) *(u32x4*)(rowp + bj * HALF) = pack8(acc[ai][bj][m][0], acc[ai][bj][m][1]); }
    }
};
struct EpiFnet {
    static constexpr bool PERM = true, AFTER_DRAIN = false;
    bf16_t* MIX;
    __device__ __forceinline__ void operator()(const f32x4 (&acc)[2][2][4][2], const Unit& u, int wr, int wc, int fr, int fq) const {
        const int row0 = u.pn * 4096 + u.pm * BM + wr * 64 + fr, col0 = 768 + wc * 32 + 8 * fq;
#pragma unroll
        for (int ai = 0; ai < 2; ++ai)
#pragma unroll
            for (int m = 0; m < 4; ++m) { bf16_t* rowp = MIX + (size_t)(row0 + ai * HALF + m * 16) * 1024 + col0;
#pragma unroll
                for (int bj = 0; bj < 2; ++bj) *(u32x4*)(rowp + bj * HALF) = pack8(acc[ai][bj][m][0], acc[ai][bj][m][1]); }
    }
};
struct EpiResF32 {
    static constexpr bool PERM = false, AFTER_DRAIN = false;
    const float* base; float* out; int ldc; float alpha;
    __device__ __forceinline__ void operator()(const f32x4 (&acc)[2][2][4][2], const Unit& u, int wr, int wc, int fr, int fq) const {
        const int row0 = u.pm * BM + wr * 64 + fr, col0 = u.pn * BM + wc * 32 + 4 * fq;
#pragma unroll
        for (int ai = 0; ai < 2; ++ai)
#pragma unroll
            for (int m = 0; m < 4; ++m) { const size_t off = (size_t)(row0 + ai * HALF + m * 16) * ldc + col0;
#pragma unroll
                for (int bj = 0; bj < 2; ++bj)
#pragma unroll
                    for (int n = 0; n < 2; ++n) { const f32x4 b = *(const f32x4*)(base + off + bj * HALF + n * 16); *(f32x4*)(out + off + bj * HALF + n * 16) = b * alpha + acc[ai][bj][m][n]; } }
    }
};
struct EpiResBf16 {
    static constexpr bool PERM = true, AFTER_DRAIN = false;
    const bf16_t* base; bf16_t* out; int ldc; float alpha;
    __device__ __forceinline__ void operator()(const f32x4 (&acc)[2][2][4][2], const Unit& u, int wr, int wc, int fr, int fq) const {
        const int row0 = u.pm * BM + wr * 64 + fr, col0 = u.pn * BM + wc * 32 + 8 * fq;
#pragma unroll
        for (int ai = 0; ai < 2; ++ai)
#pragma unroll
            for (int m = 0; m < 4; ++m) { const size_t off = (size_t)(row0 + ai * HALF + m * 16) * ldc + col0;
#pragma unroll
                for (int bj = 0; bj < 2; ++bj) { const u32x4 b = *(const u32x4*)(base + off + bj * HALF);
                    const f32x4 b0 = {__uint_as_float(b.x << 16), __uint_as_float(b.x & 0xffff0000u), __uint_as_float(b.y << 16), __uint_as_float(b.y & 0xffff0000u)};
                    const f32x4 b1 = {__uint_as_float(b.z << 16), __uint_as_float(b.z & 0xffff0000u), __uint_as_float(b.w << 16), __uint_as_float(b.w & 0xffff0000u)};
                    *(u32x4*)(out + off + bj * HALF) = pack8(b0 * alpha + acc[ai][bj][m][0], b1 * alpha + acc[ai][bj][m][1]); } }
    }
};
__device__ __forceinline__ float swiglu1(float g, float u) { g = fminf(g, 7.0f); u = fminf(fmaxf(u, -7.0f), 7.0f); return (u + 1.0f) * g * __builtin_amdgcn_rcpf(1.0f + __expf(-1.702f * g)); }
struct EpiSwiglu {
    static constexpr bool PERM = true, AFTER_DRAIN = false;
    bf16_t* HID; const float* bgu;
    __device__ __forceinline__ void operator()(const f32x4 (&acc)[2][2][4][2], const Unit& u, int wr, int wc, int fr, int fq) const {
        const int e = u.pn >> 3, pnl = u.pn & 7; const int row0 = u.pm * BM + wr * 64 + fr, jj0 = pnl * 128 + wc * 32 + 8 * fq;
        const float* bg = bgu + (size_t)e * 2048 + jj0;
        const f32x4 bg0 = *(const f32x4*)bg, bg1 = *(const f32x4*)(bg + 4), bu0 = *(const f32x4*)(bg + 1024), bu1 = *(const f32x4*)(bg + 1028);
#pragma unroll
        for (int ai = 0; ai < 2; ++ai)
#pragma unroll
            for (int m = 0; m < 4; ++m) { bf16_t* rowp = HID + (size_t)(row0 + ai * HALF + m * 16) * 1024 + jj0;
                const f32x4 g0 = acc[ai][0][m][0] + bg0, g1 = acc[ai][0][m][1] + bg1, u0 = acc[ai][1][m][0] + bu0, u1 = acc[ai][1][m][1] + bu1;
                f32x4 h0, h1;
#pragma unroll
                for (int i = 0; i < 4; ++i) { h0[i] = swiglu1(g0[i], u0[i]); h1[i] = swiglu1(g1[i], u1[i]); }
                *(u32x4*)rowp = pack8(h0, h1); }
    }
};
struct EpiDown {
    static constexpr bool PERM = true, AFTER_DRAIN = false;
    bf16_t* Y; const float* bd;
    __device__ __forceinline__ void operator()(const f32x4 (&acc)[2][2][4][2], const Unit& u, int wr, int wc, int fr, int fq) const {
        const int e = u.pn >> 2, pnl = u.pn & 3; const int row0 = u.pm * BM + wr * 64 + fr, col0 = pnl * BM + wc * 32 + 8 * fq;
        const float* bp = bd + (size_t)e * 1024 + col0;
        f32x4 bv[2][2];
#pragma unroll
        for (int bj = 0; bj < 2; ++bj)
#pragma unroll
            for (int n = 0; n < 2; ++n) bv[bj][n] = *(const f32x4*)(bp + bj * HALF + 4 * n);
#pragma unroll
        for (int ai = 0; ai < 2; ++ai)
#pragma unroll
            for (int m = 0; m < 4; ++m) { bf16_t* rowp = Y + (size_t)(row0 + ai * HALF + m * 16) * 1024 + col0;
#pragma unroll
                for (int bj = 0; bj < 2; ++bj) *(u32x4*)(rowp + bj * HALF) = pack8(acc[ai][bj][m][0] + bv[bj][0], acc[ai][bj][m][1] + bv[bj][1]); }
    }
};
struct EpiNull {
    static constexpr bool PERM = true, AFTER_DRAIN = false;
    bf16_t* O;
    __device__ __forceinline__ void operator()(const f32x4 (&acc)[2][2][4][2], const Unit& u, int wr, int wc, int fr, int fq) const {
#pragma unroll
        for (int ai = 0; ai < 2; ++ai)
#pragma unroll
            for (int bj = 0; bj < 2; ++bj)
#pragma unroll
                for (int m = 0; m < 4; ++m)
#pragma unroll
                    for (int n = 0; n < 2; ++n) asm volatile("" :: "v"(acc[ai][bj][m][n]));
    }
};
struct ListOrder {
    const PG8_LAS int* list; int n;
    __device__ __forceinline__ bool next(int i, Unit& u) const { if (i >= n) return false; const int v = __builtin_amdgcn_readfirstlane(list[i]); u.pm = v >> 16; u.pn = v & 0xffff; return true; }
    __device__ __forceinline__ void a_ready(const Unit&) const {}
    __device__ __forceinline__ void done(const Unit&) const {}
};
template <class Epi, class Sched, bool ALIGN_EPI = false, bool SP2 = false>
__device__ __forceinline__ void gemm_phase(PG8_LAS unsigned char* lds, const Gemm g, const Sched& S, const Epi& E) {
    int tid_ = threadIdx.x; asm volatile("" : "+v"(tid_));
    const int tid = tid_, wid = __builtin_amdgcn_readfirstlane(tid >> 6), lane = tid & 63, wr = wid >> 2, wc = wid & 3, fr = lane & 15, fq = lane >> 4;
    const int K = g.K, nt = K / BK;
    unsigned voffA[2], voffB[2];
#pragma unroll
    for (int i = 0; i < 2; ++i) { int R, C; stage_rc(tid * 16 + i * 8192, R, C); const int Rb = Epi::PERM ? ((R & ~31) + perm32(R & 31)) : R;
        voffA[i] = (unsigned)(R * K + C) * 2u; voffB[i] = (unsigned)(Rb * K + C) * 2u; }
    const size_t kstep = (size_t)(BK * 2);
    const size_t hstep = (size_t)HALF * K * 2;
    const size_t tstep = 2 * hstep;
    const unsigned ldsw = (unsigned)wid * 1024u;
    const int aoff = lds_byte(wr * 64 + fr, fq * 8), boff = lds_byte(wc * 32 + fr, fq * 8);
#define PG8_SA(b, h) (((b) * 2 + (h)) * HTB)
#define PG8_SB(b, h) ((4 + (b) * 2 + (h)) * HTB)
#define PG8_STAGE(bufoff, gbase, voff) do { _Pragma("unroll") for (int _i = 0; _i < 2; ++_i) \
        __builtin_amdgcn_global_load_lds((const unsigned*)((const char*)(gbase) + (voff)[_i]), (PG8_LAS unsigned*)(lds + (bufoff) + ldsw + _i * 8192), 16, 0, 0); } while (0)
#define PG8_LDA(dst, b, h) do { _Pragma("unroll") for (int m = 0; m < 4; ++m) _Pragma("unroll") for (int k = 0; k < 2; ++k) dst[m][k] = *(const PG8_LAS bf16x8*)(lds + PG8_SA(b, h) + aoff + m * 2048 + k * 1024); } while (0)
#define PG8_LDB(dst, b, h) do { _Pragma("unroll") for (int n = 0; n < 2; ++n) _Pragma("unroll") for (int k = 0; k < 2; ++k) dst[n][k] = *(const PG8_LAS bf16x8*)(lds + PG8_SB(b, h) + boff + n * 2048 + k * 1024); } while (0)
#define PG8_MMA(ai, bj, At, Bt) do { __builtin_amdgcn_s_setprio(1); _Pragma("unroll") for (int m = 0; m < 4; ++m) _Pragma("unroll") for (int n = 0; n < 2; ++n) _Pragma("unroll") for (int k = 0; k < 2; ++k) \
        acc[ai][bj][m][n] = __builtin_amdgcn_mfma_f32_16x16x32_bf16(Bt[n][k], At[m][k], acc[ai][bj][m][n], 0, 0, 0); __builtin_amdgcn_s_setprio(0); } while (0)
#define PG8_WAIT_V(n) asm volatile("s_waitcnt vmcnt(" #n ")" ::: "memory")
#define PG8_WAIT_L(n) asm volatile("s_waitcnt lgkmcnt(" #n ")" ::: "memory")
#define PG8_BAR __builtin_amdgcn_s_barrier()
#define PG8_SCHED __builtin_amdgcn_sched_barrier(0)
    Unit cur, nxt; int ui = 0;
    if (!S.next(0, cur)) return;
    f32x4 acc[2][2][4][2];
#pragma unroll
    for (int a = 0; a < 2; ++a)
#pragma unroll
        for (int b = 0; b < 2; ++b)
#pragma unroll
            for (int m = 0; m < 4; ++m)
#pragma unroll
                for (int n = 0; n < 2; ++n) acc[a][b][m][n] = (f32x4){0.f, 0.f, 0.f, 0.f};
    bf16x8 At[4][2], B0[2][2], B1[2][2];
    const char* cA = (const char*)g.A + (size_t)cur.pm * tstep; const char* cB = (const char*)g.Bt + (size_t)cur.pn * tstep;
    S.a_ready(cur);
    if constexpr (SP2) {
        PG8_STAGE(PG8_SB(0, 0), cB, voffB); PG8_STAGE(PG8_SB(0, 1), cB + hstep, voffB); PG8_STAGE(PG8_SA(0, 0), cA, voffA); PG8_STAGE(PG8_SA(0, 1), cA + hstep, voffA);
        if (wr == 1) PG8_BAR;
        PG8_WAIT_V(2); PG8_BAR;
        PG8_STAGE(PG8_SB(1, 0), cB + kstep, voffB); PG8_STAGE(PG8_SA(1, 0), cA + kstep, voffA); PG8_STAGE(PG8_SB(1, 1), cB + hstep + kstep, voffB);
        PG8_WAIT_V(6); PG8_BAR;
    } else {
        PG8_STAGE(PG8_SB(0, 0), cB, voffB); PG8_STAGE(PG8_SA(0, 0), cA, voffA); PG8_STAGE(PG8_SB(0, 1), cB + hstep, voffB); PG8_STAGE(PG8_SA(0, 1), cA + hstep, voffA);
        if (wr == 1) PG8_BAR;
        PG8_WAIT_V(4); PG8_BAR;
        PG8_STAGE(PG8_SB(1, 0), cB + kstep, voffB); PG8_STAGE(PG8_SA(1, 0), cA + kstep, voffA); PG8_STAGE(PG8_SB(1, 1), cB + hstep + kstep, voffB);
        PG8_WAIT_V(6); PG8_BAR;
    }
    for (;;) {
        const bool has_next = S.next(ui + 1, nxt);
        const char* nA = has_next ? (const char*)g.A + (size_t)nxt.pm * tstep : cA; const char* nB = has_next ? (const char*)g.Bt + (size_t)nxt.pn * tstep : cB;
        for (int t = 0; t < nt; t += 2) {
            const bool last = (t == nt - 2);
            const char* a1 = cA + (size_t)(t + 1) * kstep;
            const char* a2 = last ? nA : cA + (size_t)(t + 2) * kstep; const char* b2 = last ? nB : cB + (size_t)(t + 2) * kstep;
            const char* a3 = a2 + kstep; const char* b3 = b2 + kstep;
            if (last && has_next) S.a_ready(nxt);
            if constexpr (SP2) {
            PG8_LDB(B0, 0, 0); PG8_LDB(B1, 0, 1); PG8_SCHED; PG8_LDA(At, 0, 0); PG8_STAGE(PG8_SA(1, 1), a1 + hstep, voffA);
            PG8_WAIT_V(8); PG8_WAIT_L(0); PG8_BAR; PG8_MMA(0, 0, At, B0); PG8_MMA(0, 1, At, B1); PG8_BAR; PG8_SCHED;
            PG8_LDA(At, 0, 1); PG8_STAGE(PG8_SB(0, 0), b2, voffB); PG8_STAGE(PG8_SB(0, 1), b2 + hstep, voffB); PG8_STAGE(PG8_SA(0, 0), a2, voffA);
            PG8_WAIT_V(8); PG8_WAIT_L(0); PG8_BAR; PG8_MMA(1, 0, At, B0); PG8_MMA(1, 1, At, B1); PG8_BAR; PG8_SCHED;
            PG8_LDB(B0, 1, 0); PG8_LDB(B1, 1, 1); PG8_SCHED; PG8_LDA(At, 1, 0); PG8_STAGE(PG8_SA(0, 1), a2 + hstep, voffA);
            PG8_WAIT_V(8); PG8_WAIT_L(0); PG8_BAR; PG8_MMA(0, 0, At, B0); PG8_MMA(0, 1, At, B1); PG8_BAR; PG8_SCHED;
            PG8_LDA(At, 1, 1); PG8_STAGE(PG8_SB(1, 0), b3, voffB); PG8_STAGE(PG8_SB(1, 1), b3 + hstep, voffB); PG8_STAGE(PG8_SA(1, 0), a3, voffA);
            PG8_WAIT_V(8); PG8_WAIT_L(0); PG8_BAR; PG8_MMA(1, 0, At, B0); PG8_MMA(1, 1, At, B1); PG8_BAR; PG8_SCHED;
            } else {
            PG8_LDB(B0, 0, 0); PG8_SCHED; PG8_LDA(At, 0, 0); PG8_STAGE(PG8_SA(1, 1), a1 + hstep, voffA);
            PG8_WAIT_L(8); PG8_BAR; PG8_WAIT_L(0); PG8_MMA(0, 0, At, B0); PG8_BAR; PG8_SCHED;
            PG8_LDB(B1, 0, 1); PG8_STAGE(PG8_SB(0, 0), b2, voffB);
            PG8_BAR; PG8_WAIT_L(0); PG8_MMA(0, 1, At, B1); PG8_BAR;
            PG8_LDA(At, 0, 1); PG8_STAGE(PG8_SA(0, 0), a2, voffA);
            PG8_BAR; PG8_WAIT_L(0); PG8_MMA(1, 0, At, B0); PG8_BAR; PG8_SCHED;
            PG8_STAGE(PG8_SB(0, 1), b2 + hstep, voffB);
            PG8_WAIT_V(6); PG8_BAR; PG8_MMA(1, 1, At, B1); PG8_BAR;
            PG8_LDB(B0, 1, 0); PG8_SCHED; PG8_LDA(At, 1, 0); PG8_STAGE(PG8_SA(0, 1), a2 + hstep, voffA);
            PG8_WAIT_L(8); PG8_BAR; PG8_WAIT_L(0); PG8_MMA(0, 0, At, B0); PG8_BAR; PG8_SCHED;
            PG8_LDB(B1, 1, 1); PG8_STAGE(PG8_SB(1, 0), b3, voffB);
            PG8_BAR; PG8_WAIT_L(0); PG8_MMA(0, 1, At, B1); PG8_BAR;
            PG8_LDA(At, 1, 1); PG8_STAGE(PG8_SA(1, 0), a3, voffA);
            PG8_BAR; PG8_WAIT_L(0); PG8_MMA(1, 0, At, B0); PG8_BAR; PG8_SCHED;
            PG8_STAGE(PG8_SB(1, 1), b3 + hstep, voffB);
            PG8_WAIT_V(6); PG8_BAR; PG8_MMA(1, 1, At, B1); PG8_BAR;
            }
        }
        if constexpr (ALIGN_EPI) { if (wr == 0) PG8_BAR; }
        if constexpr (!Epi::AFTER_DRAIN) { E(acc, cur, wr, wc, fr, fq); S.done(cur); }
        if (!has_next) break;
#pragma unroll
        for (int a = 0; a < 2; ++a)
#pragma unroll
            for (int b = 0; b < 2; ++b)
#pragma unroll
                for (int m = 0; m < 4; ++m)
#pragma unroll
                    for (int n = 0; n < 2; ++n) acc[a][b][m][n] = (f32x4){0.f, 0.f, 0.f, 0.f};
        cur = nxt; cA = nA; cB = nB; ++ui;
        if constexpr (ALIGN_EPI) { if (wr == 1) PG8_BAR; }
    }
    PG8_WAIT_V(0);
    if constexpr (!ALIGN_EPI) { if (wr == 0) PG8_BAR; }
    PG8_BAR;
    if constexpr (Epi::AFTER_DRAIN) { E.fused(acc, cur, wr, wc, fr, fq, lds, wid, lane); S.done(cur); }
#undef PG8_SA
#undef PG8_SB
#undef PG8_STAGE
#undef PG8_LDA
#undef PG8_LDB
#undef PG8_MMA
#undef PG8_WAIT_V
#undef PG8_WAIT_L
#undef PG8_BAR
#undef PG8_SCHED
}
}
namespace pg8 {
template <class Epi, class Sched, bool ALIGN_EPI>
__device__ __forceinline__ void gemm_phase_gather(PG8_LAS unsigned char* lds, const Gemm g, const Sched& S, const Epi& E, const PG8_LAS unsigned short* rows16) {
    int tid_ = threadIdx.x; asm volatile("" : "+v"(tid_));
    const int tid = tid_, wid = __builtin_amdgcn_readfirstlane(tid >> 6), lane = tid & 63, wr = wid >> 2, wc = wid & 3, fr = lane & 15, fq = lane >> 4;
    const int K = g.K, nt = K / BK;
    unsigned voffB[2]; int RA[2]; unsigned CA2[2];
#pragma unroll
    for (int i = 0; i < 2; ++i) { int R, C; stage_rc(tid * 16 + i * 8192, R, C); const int Rb = Epi::PERM ? ((R & ~31) + perm32(R & 31)) : R;
        RA[i] = R; CA2[i] = (unsigned)C * 2u; voffB[i] = (unsigned)(Rb * K + C) * 2u; }
    const size_t kstep = (size_t)(BK * 2);
    const size_t hstep = (size_t)HALF * K * 2;
    const size_t tstep = 2 * hstep;
    const unsigned ldsw = (unsigned)wid * 1024u;
    const unsigned rowb = (unsigned)K * 2u;
    const int aoff = lds_byte(wr * 64 + fr, fq * 8), boff = lds_byte(wc * 32 + fr, fq * 8);
#define PG8_SA(b, h) (((b) * 2 + (h)) * HTB)
#define PG8_SB(b, h) ((4 + (b) * 2 + (h)) * HTB)
#define PG8_STAGE(bufoff, gbase, voff) do { _Pragma("unroll") for (int _i = 0; _i < 2; ++_i) \
        __builtin_amdgcn_global_load_lds((const unsigned*)((const char*)(gbase) + (voff)[_i]), (PG8_LAS unsigned*)(lds + (bufoff) + ldsw + _i * 8192), 16, 0, 0); } while (0)
#define PG8_LDA(dst, b, h) do { _Pragma("unroll") for (int m = 0; m < 4; ++m) _Pragma("unroll") for (int k = 0; k < 2; ++k) dst[m][k] = *(const PG8_LAS bf16x8*)(lds + PG8_SA(b, h) + aoff + m * 2048 + k * 1024); } while (0)
#define PG8_LDB(dst, b, h) do { _Pragma("unroll") for (int n = 0; n < 2; ++n) _Pragma("unroll") for (int k = 0; k < 2; ++k) dst[n][k] = *(const PG8_LAS bf16x8*)(lds + PG8_SB(b, h) + boff + n * 2048 + k * 1024); } while (0)
#define PG8_MMA(ai, bj, At, Bt) do { __builtin_amdgcn_s_setprio(1); _Pragma("unroll") for (int m = 0; m < 4; ++m) _Pragma("unroll") for (int n = 0; n < 2; ++n) _Pragma("unroll") for (int k = 0; k < 2; ++k) \
        acc[ai][bj][m][n] = __builtin_amdgcn_mfma_f32_16x16x32_bf16(Bt[n][k], At[m][k], acc[ai][bj][m][n], 0, 0, 0); __builtin_amdgcn_s_setprio(0); } while (0)
#define PG8_WAIT_V(n) asm volatile("s_waitcnt vmcnt(" #n ")" ::: "memory")
#define PG8_WAIT_L(n) asm volatile("s_waitcnt lgkmcnt(" #n ")" ::: "memory")
#define PG8_BAR __builtin_amdgcn_s_barrier()
#define PG8_SCHED __builtin_amdgcn_sched_barrier(0)
#define PG8_GOFF(dst, U) do { _Pragma("unroll") for (int h_ = 0; h_ < 2; ++h_) _Pragma("unroll") for (int i_ = 0; i_ < 2; ++i_) dst[h_][i_] = (unsigned)rows16[(U) * 256 + h_ * HALF + RA[i_]] * rowb + CA2[i_]; } while (0)
    Unit cur, nxt; int ui = 0;
    if (!S.next(0, cur)) return;
    f32x4 acc[2][2][4][2];
#pragma unroll
    for (int a = 0; a < 2; ++a)
#pragma unroll
        for (int b = 0; b < 2; ++b)
#pragma unroll
            for (int m = 0; m < 4; ++m)
#pragma unroll
                for (int n = 0; n < 2; ++n) acc[a][b][m][n] = (f32x4){0.f, 0.f, 0.f, 0.f};
    bf16x8 At[4][2], B0[2][2], B1[2][2];
    const char* const Ab = (const char*)g.A;
    const char* cB = (const char*)g.Bt + (size_t)cur.pn * tstep;
    unsigned gc[2][2], gn[2][2];
    PG8_GOFF(gc, 0);
    S.a_ready(cur);
    PG8_STAGE(PG8_SB(0, 0), cB, voffB); PG8_STAGE(PG8_SB(0, 1), cB + hstep, voffB); PG8_STAGE(PG8_SA(0, 0), Ab, gc[0]); PG8_STAGE(PG8_SA(0, 1), Ab, gc[1]);
    if (wr == 1) PG8_BAR;
    PG8_WAIT_V(2); PG8_BAR;
    PG8_STAGE(PG8_SB(1, 0), cB + kstep, voffB); PG8_STAGE(PG8_SA(1, 0), Ab + kstep, gc[0]); PG8_STAGE(PG8_SB(1, 1), cB + hstep + kstep, voffB);
    PG8_WAIT_V(6); PG8_BAR;
    for (;;) {
        const bool has_next = S.next(ui + 1, nxt);
        const char* nB = has_next ? (const char*)g.Bt + (size_t)nxt.pn * tstep : cB;
        if (has_next) { PG8_GOFF(gn, ui + 1); } else {
#pragma unroll
            for (int h_ = 0; h_ < 2; ++h_)
#pragma unroll
                for (int i_ = 0; i_ < 2; ++i_) gn[h_][i_] = gc[h_][i_]; }
        for (int t = 0; t < nt; t += 2) {
            const bool last = (t == nt - 2);
            const char* a1 = Ab + (size_t)(t + 1) * kstep;
            const char* a2 = last ? Ab : Ab + (size_t)(t + 2) * kstep; const char* b2 = last ? nB : cB + (size_t)(t + 2) * kstep;
            const char* a3 = a2 + kstep; const char* b3 = b2 + kstep;
            unsigned g2[2][2];
#pragma unroll
            for (int h_ = 0; h_ < 2; ++h_)
#pragma unroll
                for (int i_ = 0; i_ < 2; ++i_) g2[h_][i_] = last ? gn[h_][i_] : gc[h_][i_];
            if (last && has_next) S.a_ready(nxt);
            PG8_LDB(B0, 0, 0); PG8_LDB(B1, 0, 1); PG8_SCHED; PG8_LDA(At, 0, 0); PG8_STAGE(PG8_SA(1, 1), a1, gc[1]);
            PG8_WAIT_V(8); PG8_WAIT_L(0); PG8_BAR; PG8_MMA(0, 0, At, B0); PG8_MMA(0, 1, At, B1); PG8_BAR; PG8_SCHED;
            PG8_LDA(At, 0, 1); PG8_STAGE(PG8_SB(0, 0), b2, voffB); PG8_STAGE(PG8_SB(0, 1), b2 + hstep, voffB); PG8_STAGE(PG8_SA(0, 0), a2, g2[0]);
            PG8_WAIT_V(8); PG8_WAIT_L(0); PG8_BAR; PG8_MMA(1, 0, At, B0); PG8_MMA(1, 1, At, B1); PG8_BAR; PG8_SCHED;
            PG8_LDB(B0, 1, 0); PG8_LDB(B1, 1, 1); PG8_SCHED; PG8_LDA(At, 1, 0); PG8_STAGE(PG8_SA(0, 1), a2, g2[1]);
            PG8_WAIT_V(8); PG8_WAIT_L(0); PG8_BAR; PG8_MMA(0, 0, At, B0); PG8_MMA(0, 1, At, B1); PG8_BAR; PG8_SCHED;
            PG8_LDA(At, 1, 1); PG8_STAGE(PG8_SB(1, 0), b3, voffB); PG8_STAGE(PG8_SB(1, 1), b3 + hstep, voffB); PG8_STAGE(PG8_SA(1, 0), a3, g2[0]);
            PG8_WAIT_V(8); PG8_WAIT_L(0); PG8_BAR; PG8_MMA(1, 0, At, B0); PG8_MMA(1, 1, At, B1); PG8_BAR; PG8_SCHED;
        }
        if constexpr (ALIGN_EPI) { if (wr == 0) PG8_BAR; }
        E(acc, cur, wr, wc, fr, fq); S.done(cur);
        if (!has_next) break;
#pragma unroll
        for (int a = 0; a < 2; ++a)
#pragma unroll
            for (int b = 0; b < 2; ++b)
#pragma unroll
                for (int m = 0; m < 4; ++m)
#pragma unroll
                    for (int n = 0; n < 2; ++n) acc[a][b][m][n] = (f32x4){0.f, 0.f, 0.f, 0.f};
        cur = nxt; cB = nB; ++ui;
#pragma unroll
        for (int h_ = 0; h_ < 2; ++h_)
#pragma unroll
            for (int i_ = 0; i_ < 2; ++i_) gc[h_][i_] = gn[h_][i_];
        if constexpr (ALIGN_EPI) { if (wr == 1) PG8_BAR; }
    }
    PG8_WAIT_V(0);
    if constexpr (!ALIGN_EPI) { if (wr == 0) PG8_BAR; }
    PG8_BAR;
#undef PG8_SA
#undef PG8_SB
#undef PG8_STAGE
#undef PG8_LDA
#undef PG8_LDB
#undef PG8_MMA
#undef PG8_WAIT_V
#undef PG8_WAIT_L
#undef PG8_BAR
#undef PG8_SCHED
#undef PG8_GOFF
}
}
#define GAS __attribute__((address_space(1)))
#define LAS __attribute__((address_space(3)))
typedef unsigned short bf16;
typedef unsigned v4u __attribute__((ext_vector_type(4)));
typedef float f32x4 __attribute__((ext_vector_type(4)));
typedef short bf16x8 __attribute__((ext_vector_type(8)));
typedef GAS unsigned gu32;
typedef GAS unsigned long long gu64;
#define RLX_AGENT __ATOMIC_RELAXED, __HIP_MEMORY_SCOPE_AGENT
#define LDS_WAIT() asm volatile("s_waitcnt lgkmcnt(0)" ::: "memory")
#define VM_WAIT() asm volatile("s_waitcnt vmcnt(0)" ::: "memory")
__device__ __forceinline__ unsigned long long rt() { return __builtin_amdgcn_s_memrealtime(); }
__device__ __forceinline__ unsigned f2bf(float f) { unsigned u = __builtin_bit_cast(unsigned, f); return (u + 0x7fffu + ((u >> 16) & 1u)) >> 16; }
__device__ __forceinline__ unsigned pk2(float lo, float hi) { return f2bf(lo) | (f2bf(hi) << 16); }
#define XB_TMO      128
#define XB_XCNT(j)  (256  + 64 * (j))
#define XB_XSUB(j)  (1280 + 64 * (j))
#define XB_XGEN(j)  (2304 + 64 * (j))
#define XB_TOP      3328
#define XB_TOPGEN   3392
#define XCD_BAR_WORDS 3456
#define XB_SPIN_CAP (1u << 18)

__device__ __forceinline__ unsigned xb_ld(unsigned* p)              { return __hip_atomic_load(p, __ATOMIC_RELAXED, __HIP_MEMORY_SCOPE_AGENT); }
__device__ __forceinline__ unsigned xb_add(unsigned* p, unsigned v) { return __hip_atomic_fetch_add(p, v, __ATOMIC_RELAXED, __HIP_MEMORY_SCOPE_AGENT); }
__device__ __forceinline__ unsigned xb_xcc_id() { return (unsigned)__builtin_amdgcn_s_getreg((3 << 11) | 20) & 0xFu; }
#define XB_SPIN(cond, bar) do { unsigned _sp = 0; while (cond) { __builtin_amdgcn_s_sleep(1); \
    if ((++_sp & 255u) == 0u) { if (xb_ld(&(bar)[XB_TMO])) break; if (_sp > XB_SPIN_CAP) { atomicAdd(&(bar)[XB_TMO], 1u); break; } } } } while (0)

struct XcdBarrier {
    unsigned* bar; unsigned x;
    volatile LAS unsigned* st;
};

__device__ __forceinline__ XcdBarrier xcd_barrier_post(unsigned* bar, volatile LAS unsigned* st) {
    XcdBarrier b; b.bar = bar; b.x = xb_xcc_id(); b.st = st;
    if (threadIdx.x == 0) (void)xb_add(&bar[XB_XCNT(b.x)], 1u);
    return b;
}
__device__ __forceinline__ void xcd_barrier_complete(unsigned* bar, unsigned x, unsigned& nloc, unsigned& nx) {
    const unsigned G = gridDim.x * gridDim.y * gridDim.z;
    unsigned sum, cnt, mine, sp = 0u;
    for (;;) {
        sum = 0u; cnt = 0u; mine = 0u;
#pragma unroll
        for (unsigned j = 0; j < 16; ++j) { const unsigned c = xb_ld(&bar[XB_XCNT(j)]); sum += c; cnt += (c > 0u) ? 1u : 0u; mine = (j == x) ? c : mine; }
        if (sum == G) break;
        __builtin_amdgcn_s_sleep(1);
        if ((++sp & 255u) == 0u) { if (xb_ld(&bar[XB_TMO])) break; if (sp > XB_SPIN_CAP) { atomicAdd(&bar[XB_TMO], 1u); break; } }
    }
    nloc = mine > 0u ? mine : 1u; nx = cnt > 0u ? cnt : 1u;
}

__device__ __forceinline__ void xcd_barrier(const XcdBarrier& b) {
    asm volatile("s_waitcnt vmcnt(0)" ::: "memory");
    __syncthreads();
    if (threadIdx.x == 0) {
        unsigned* bar = b.bar;
        __builtin_amdgcn_s_waitcnt(0);
        unsigned nloc = b.st[0], nx = b.st[1];
        if (nloc == 0u) { xcd_barrier_complete(bar, b.x, nloc, nx); b.st[0] = nloc; b.st[1] = nx; }
        const unsigned old = xb_add(&bar[XB_XSUB(b.x)], 1u);
        const unsigned gen = old / nloc;
        if (old + 1u == (gen + 1u) * nloc) {
            __builtin_amdgcn_fence(__ATOMIC_RELEASE, "agent");
            asm volatile("s_waitcnt vmcnt(0)" ::: "memory");
            const unsigned og = xb_add(&bar[XB_TOP], 1u);
            const unsigned tg = og / nx;
            if (og + 1u == (tg + 1u) * nx) xb_add(&bar[XB_TOPGEN], 1u);
            else XB_SPIN(xb_ld(&bar[XB_TOPGEN]) == tg, bar);
            __builtin_amdgcn_fence(__ATOMIC_ACQUIRE, "agent");
            xb_add(&bar[XB_XGEN(b.x)], 1u);
            asm volatile("s_waitcnt vmcnt(0)" ::: "memory");
        } else {
            XB_SPIN(xb_ld(&bar[XB_XGEN(b.x)]) == gen, bar);
            __builtin_amdgcn_fence(__ATOMIC_ACQUIRE, "agent");
            asm volatile("s_waitcnt vmcnt(0)" ::: "memory");
        }
    }
    __syncthreads();
}
namespace attn_body {
using bf16=__hip_bfloat16;
using bf16x8=__attribute__((ext_vector_type(8)))short;
using s16x4=__attribute__((ext_vector_type(4)))short;
using f32x16=__attribute__((ext_vector_type(16)))float;
using u32x4=__attribute__((ext_vector_type(4)))unsigned;
constexpr int BATCH=8,NHEAD=8,NKVH=2,SEQ=4096,D=64;
constexpr int DMQ=512,DMK=128,DMV=2048,DMO=1024;
constexpr int NW=8,QBLK=32,QB=QBLK*NW,KVBLK=64,NQB=SEQ/QB;
constexpr int ATTN_UNIT_ROWS=QB;
__device__ __forceinline__ int crow(int r,int hi){return (r&3)+8*(r>>2)+4*hi;}
#define SBAR() __builtin_amdgcn_sched_barrier(0)
__device__ __forceinline__ void cmask(f32x16&p0,f32x16&p1,int jb,int qrel,int hi){
  const float NEG=-INFINITY; int kb=64*jb+4*hi;
  #pragma unroll
  for(int r=0;r<16;++r){int kv=kb+(r&3)+8*(r>>2); if(kv>qrel)p0[r]=NEG; if(kv+32>qrel)p1[r]=NEG;}
}

constexpr int NSLOT=3, SLOTB=8192;
constexpr int LDS_K=0, LDS_V=NSLOT*SLOTB, LDS_WS=2*NSLOT*SLOTB, LDS_OST=LDS_WS+NW*64*4, LDS_BYTES=LDS_OST+NW*4096;
constexpr float C2=0.125f*1.4426950408889634f;
__device__ __forceinline__ void glds16(const void*gsrc,unsigned lds_dst){unsigned keep;
  asm volatile("s_mov_b32 %0, m0\n\ts_mov_b32 m0, %2\n\ts_nop 0\n\tglobal_load_lds_dwordx4 %1, off\n\ts_mov_b32 m0, %0":"=&s"(keep):"v"(gsrc),"s"(lds_dst):"memory");}
__device__ __forceinline__ float max3f(float a,float b,float c){float r;asm("v_max3_f32 %0, %1, %2, %3":"=v"(r):"v"(a),"v"(b),"v"(c));return r;}
__device__ __forceinline__ float max2f(float a,float b){float r;asm("v_max_f32_e32 %0, %1, %2":"=v"(r):"v"(a),"v"(b));return r;}
__device__ __forceinline__ float fadd_s(float a,float b){float r;asm("v_add_f32_e32 %0, %1, %2":"=v"(r):"v"(a),"v"(b));return r;}
__device__ __forceinline__ float fsub_s(float a,float b){float r;asm("v_sub_f32_e32 %0, %1, %2":"=v"(r):"v"(a),"v"(b));return r;}
typedef float f32x2_t __attribute__((ext_vector_type(2))); typedef __bf16 bf16x2_t __attribute__((ext_vector_type(2)));
__device__ __forceinline__ unsigned cvtpk_s(float lo,float hi){f32x2_t v={lo,hi};bf16x2_t b=__builtin_convertvector(v,bf16x2_t);return __builtin_bit_cast(unsigned,b);}
#define WAIT_BAR(N) asm volatile("s_waitcnt vmcnt(" #N ") lgkmcnt(0)\n\ts_barrier":::"memory")

__device__ __forceinline__ void qkt(f32x16&p0,f32x16&p1,const char*Kslot,const bf16x8*qr,const f32x16&negm,int r32,int hi){
  const char*kb=Kslot+hi*1024+r32*16;
  #pragma unroll
  for(int d0=0;d0<4;++d0){
    const bf16x8 b0=*reinterpret_cast<const bf16x8*>(kb+d0*2048);
    const bf16x8 b1=*reinterpret_cast<const bf16x8*>(kb+d0*2048+512);
    if(d0==0){p0=__builtin_amdgcn_mfma_f32_32x32x16_bf16(b0,qr[0],negm,0,0,0);p1=__builtin_amdgcn_mfma_f32_32x32x16_bf16(b1,qr[0],negm,0,0,0);}
    else{p0=__builtin_amdgcn_mfma_f32_32x32x16_bf16(b0,qr[d0],p0,0,0,0);p1=__builtin_amdgcn_mfma_f32_32x32x16_bf16(b1,qr[d0],p1,0,0,0);}}
}
typedef __attribute__((address_space(3))) const char* lds_cptr;
typedef short v4i16_t __attribute__((ext_vector_type(4)));
__device__ __forceinline__ void kload8(bf16x8*kf,lds_cptr kp){
  kf[0]=*(const __attribute__((address_space(3))) bf16x8*)(kp);      kf[1]=*(const __attribute__((address_space(3))) bf16x8*)(kp+512);
  kf[2]=*(const __attribute__((address_space(3))) bf16x8*)(kp+2048); kf[3]=*(const __attribute__((address_space(3))) bf16x8*)(kp+2560);
  kf[4]=*(const __attribute__((address_space(3))) bf16x8*)(kp+4096); kf[5]=*(const __attribute__((address_space(3))) bf16x8*)(kp+4608);
  kf[6]=*(const __attribute__((address_space(3))) bf16x8*)(kp+6144); kf[7]=*(const __attribute__((address_space(3))) bf16x8*)(kp+6656);
}
__device__ __forceinline__ void kload2(bf16x8*kf,lds_cptr kp,int j){ kf[2*j]=*(const __attribute__((address_space(3))) bf16x8*)(kp+j*2048); kf[2*j+1]=*(const __attribute__((address_space(3))) bf16x8*)(kp+j*2048+512); }
__device__ __forceinline__ s16x4 vtr(lds_cptr p){ return __builtin_bit_cast(s16x4,__builtin_amdgcn_ds_read_tr16_b64_v4i16((__attribute__((address_space(3))) v4i16_t*)p)); }
__device__ __forceinline__ float rowmax(const f32x16&p0,const f32x16&p1){
  float a=max3f(p0[0],p0[1],p1[0]),b=max3f(p0[2],p0[3],p1[1]);a=max3f(a,p1[2],p1[3]);
  #pragma unroll
  for(int r=4;r<16;r+=4){a=max3f(a,p0[r],p0[r+1]);b=max3f(b,p0[r+2],p0[r+3]);a=max3f(a,p1[r],p1[r+1]);b=max3f(b,p1[r+2],p1[r+3]);}
  const float m=max2f(a,b);
  auto rr=__builtin_amdgcn_permlane32_swap(__float_as_uint(m),__float_as_uint(m),false,false);
  return max2f(__uint_as_float(rr[0]),__uint_as_float(rr[1]));
}
__device__ __forceinline__ void pv(f32x16*o,int vb,bf16x8 pa0,bf16x8 pa1,bf16x8 pa2,bf16x8 pa3){
  #pragma unroll
  for(int d0=0;d0<2;++d0){s16x4 lo[4],hi[4];
    #pragma unroll
    for(int ks=0;ks<4;++ks){
      asm volatile("ds_read_b64_tr_b16 %0,%1 offset:%c2":"=&v"(lo[ks]):"v"(vb),"i"(d0*4096+ks*1024):"memory");
      asm volatile("ds_read_b64_tr_b16 %0,%1 offset:%c2":"=&v"(hi[ks]):"v"(vb),"i"(d0*4096+ks*1024+512):"memory");}
    asm volatile("s_waitcnt lgkmcnt(0)":::"memory");SBAR();
    #define PK(k) (bf16x8){lo[k][0],lo[k][1],lo[k][2],lo[k][3],hi[k][0],hi[k][1],hi[k][2],hi[k][3]}
    o[d0]=__builtin_amdgcn_mfma_f32_32x32x16_bf16(pa0,PK(0),o[d0],0,0,0);
    o[d0]=__builtin_amdgcn_mfma_f32_32x32x16_bf16(pa1,PK(1),o[d0],0,0,0);
    o[d0]=__builtin_amdgcn_mfma_f32_32x32x16_bf16(pa2,PK(2),o[d0],0,0,0);
    o[d0]=__builtin_amdgcn_mfma_f32_32x32x16_bf16(pa3,PK(3),o[d0],0,0,0);
    #undef PK
  }
}

#ifndef ATTN_STORE16
#define ATTN_STORE16(p,v) (*(u32x4*)(p)=(v))
#endif
template<int THRL> __device__ __forceinline__ void attn_unit(int b,int h,int qb,const bf16*Q,const bf16*__restrict__ K,const bf16*__restrict__ V,bf16*O,char*shm){
  int tid_=threadIdx.x; asm volatile("":"+v"(tid_)); const int tid=tid_,lane=tid&63,r32=lane&31,hi=lane>>5; const int wid=__builtin_amdgcn_readfirstlane(tid>>6);
  const long rowbase=(long)b*SEQ; const int q0=qb*QB;
  const bf16*Qw=Q+(rowbase+q0+wid*QBLK)*DMQ+h*D; const int kvh=h>>2;
  const bf16*Kh=K+rowbase*DMK+kvh*D,*Vh=V+rowbase*DMV+kvh*D;
  const unsigned lds0=(unsigned)(uintptr_t)shm;
  float*wsf=(float*)(shm+LDS_WS)+wid*64;
  const bf16*ksrc=Kh+(long)lane*DMK+wid*8;
  const bf16*vsrc=Vh+(long)(16*(wid&3)+(lane>>2))*DMV+(wid>>2)*32+(lane&3)*8;
  const unsigned kdst=lds0+LDS_K+wid*1024, vdst=lds0+LDS_V+wid*1024;
  #define DMA_K(t,slot) glds16(ksrc+(long)(t)*KVBLK*DMK,(unsigned)__builtin_amdgcn_readfirstlane(kdst+(slot)))
  #define DMA_V(t,slot) glds16(vsrc+(long)(t)*KVBLK*DMV,(unsigned)__builtin_amdgcn_readfirstlane(vdst+(slot)))
  const int vb0=(int)(lds0+LDS_V)+((lane>>4)&1)*32+(lane&3)*8+(4*hi+((lane&15)>>2))*64;
  const char*Kbase=shm+LDS_K; bf16x8 kf[8];
  const lds_cptr shm3=(lds_cptr)shm; const lds_cptr kp0=shm3+LDS_K+hi*1024+r32*16; const lds_cptr vp0=shm3+LDS_V+((lane>>4)&1)*32+(lane&3)*8+(4*hi+((lane&15)>>2))*64;
  constexpr int NT=SEQ/KVBLK;
  DMA_K(0,0);DMA_V(0,0);DMA_K(1,SLOTB);
  bf16x8 qr[4];
  #pragma unroll
  for(int d0=0;d0<4;++d0)qr[d0]=*reinterpret_cast<const bf16x8*>(&Qw[(long)r32*DMQ+d0*16+hi*8]);
  float mhat=0.f,l_reg=0.f;f32x16 o[2];o[0]=f32x16{};o[1]=f32x16{};f32x16 negm=f32x16{};asm volatile("":"+v"(negm));
  #define CMASK(P0,P1,t) do{}while(0)
  bool resc=false;
  #define START(P0,P1) do{ const float rm=rowmax(P0,P1); resc=false; \
    { const float dl=rm; mhat=fadd_s(mhat,dl); \
      _Pragma("unroll") for(int r=0;r<16;++r){P0[r]=fsub_s(P0[r],dl);P1[r]=fsub_s(P1[r],dl);} \
      _Pragma("unroll") for(int r=0;r<16;++r)negm[r]=-mhat; asm volatile("":"+v"(negm)); } \
    _Pragma("unroll") for(int r=0;r<16;++r)P0[r]=__builtin_amdgcn_exp2f(P0[r]); }while(0)
  #define RESC() do{ if(resc){ asm volatile("s_waitcnt lgkmcnt(0)":::"memory"); \
      _Pragma("unroll") for(int d_=0;d_<2;++d_) _Pragma("unroll") for(int r=0;r<16;++r)o[d_][r]*=wsf[crow(r,hi)]; } }while(0)
  f32x16 pA0,pA1,pB0,pB1;
  int sl_prev=0,sl_cur=0,sl_next=SLOTB;
  #define ROT() do{sl_prev=sl_cur;sl_cur=sl_next;sl_next=(sl_next==(NSLOT-1)*SLOTB)?0:sl_next+SLOTB;}while(0)
  DMA_K(2,2*SLOTB);
  WAIT_BAR(3);
  qkt(pA0,pA1,Kbase,qr,negm,r32,hi);asm volatile("s_nop 15\n\ts_nop 7":"+v"(pA0),"+v"(pA1));CMASK(pA0,pA1,0);
  START(pA0,pA1);
  _Pragma("unroll") for(int r=0;r<16;++r)pA1[r]=__builtin_amdgcn_exp2f(pA1[r]);
  WAIT_BAR(0);
  DMA_K(3,0);DMA_V(1,SLOTB);
  ROT();
  kload8(kf,kp0+sl_cur);
  WAIT_BAR(2);
  s16x4 vlo[8],vhi[8]; u32x4 pw0,pw1,pw2,pw3;
  #define PKW(P,B) cvtpk_s(P[B],P[B+1])
  #define PAF(k) __builtin_bit_cast(bf16x8,pw##k)
  #define VFR(i) (bf16x8){vlo[i][0],vlo[i][1],vlo[i][2],vlo[i][3],vhi[i][0],vhi[i][1],vhi[i][2],vhi[i][3]}
  #define PIN(x) asm volatile("":"+v"(x))
  #define MX3(a,b,c) __builtin_fmaxf(__builtin_fmaxf((a),(b)),(c))
  #define GAPA(MF,A0,A1,A2,A3,W0,W1,PW) do{ MF; sacc+=A0; sacc+=A1; sacc+=A2; sacc+=A3; PIN(sacc); W0; W1; PIN(PW); SBAR(); }while(0)
  #define EX(v) __builtin_amdgcn_exp2f(v)
  #define GAPB(MF,X,B) do{ MF; X[B]=EX(X[B]); X[B+1]=EX(X[B+1]); X[B+2]=EX(X[B+2]); X[B+3]=EX(X[B+3]); PIN(X); SBAR(); }while(0)
  #define VRD(i) do{ vlo[i]=vtr(vp_+(((i)>>2)*4096+((i)&3)*1024)); vhi[i]=vtr(vp_+(((i)>>2)*4096+((i)&3)*1024+512)); }while(0)
  #define KRD(G,j) do{ if(G){ kload2(kf,kp0+sl_next,j); SBAR(); } }while(0)
  #define STEP(C0,C1,P0,P1,t,GK,GV,GL) do{ SBAR(); \
    const lds_cptr vp_=vp0+sl_prev; \
    VRD(0); SBAR(); float sacc=(P0[0]+P0[1]); \
    GAPA(C0=__builtin_amdgcn_mfma_f32_32x32x16_bf16(kf[0],qr[0],negm,0,0,0), P0[2],P0[3],P0[4],P0[5],     pw0[0]=PKW(P0,0), pw0[1]=PKW(P0,2), pw0); \
    VRD(4); SBAR(); GAPA(C1=__builtin_amdgcn_mfma_f32_32x32x16_bf16(kf[1],qr[0],negm,0,0,0), P0[6],P0[7],P0[8],P0[9],     pw0[2]=PKW(P0,4), pw0[3]=PKW(P0,6), pw0); \
    VRD(1); SBAR(); GAPA(C0=__builtin_amdgcn_mfma_f32_32x32x16_bf16(kf[2],qr[1],C0,0,0,0),   P0[10],P0[11],P0[12],P0[13], pw1[0]=PKW(P0,8), pw1[1]=PKW(P0,10), pw1); \
    VRD(5); SBAR(); GAPA(C1=__builtin_amdgcn_mfma_f32_32x32x16_bf16(kf[3],qr[1],C1,0,0,0),   P0[14],P0[15],P1[0],P1[1],   pw1[2]=PKW(P0,12),pw1[3]=PKW(P0,14), pw1); \
    VRD(2); SBAR(); GAPA(C0=__builtin_amdgcn_mfma_f32_32x32x16_bf16(kf[4],qr[2],C0,0,0,0),   P1[2],P1[3],P1[4],P1[5],     pw2[0]=PKW(P1,0), pw2[1]=PKW(P1,2), pw2); \
    VRD(6); SBAR(); GAPA(C1=__builtin_amdgcn_mfma_f32_32x32x16_bf16(kf[5],qr[2],C1,0,0,0),   P1[6],P1[7],P1[8],P1[9],     pw2[2]=PKW(P1,4), pw2[3]=PKW(P1,6), pw2); \
    VRD(3); SBAR(); GAPA(C0=__builtin_amdgcn_mfma_f32_32x32x16_bf16(kf[6],qr[3],C0,0,0,0),   P1[10],P1[11],P1[12],P1[13], pw3[0]=PKW(P1,8), pw3[1]=PKW(P1,10), pw3); \
    VRD(7); SBAR(); GAPA(C1=__builtin_amdgcn_mfma_f32_32x32x16_bf16(kf[7],qr[3],C1,0,0,0),   P1[14],P1[15],0.f,0.f,       pw3[2]=PKW(P1,12),pw3[3]=PKW(P1,14), pw3); \
    l_reg+=sacc; \
    if(GK){DMA_K((t)+3,sl_cur);} if(GV){DMA_V((t)+1,sl_next);} \
    CMASK(C0,C1,t); \
    { float a=MX3(C0[0],C0[1],C1[0]),b=MX3(C0[2],C0[3],C1[1]); a=MX3(a,C1[2],C1[3]); \
      _Pragma("unroll") for(int r=4;r<16;r+=4){a=MX3(a,C0[r],C0[r+1]);b=MX3(b,C0[r+2],C0[r+3]);a=MX3(a,C1[r],C1[r+1]);b=MX3(b,C1[r+2],C1[r+3]);} \
      float rm=__builtin_fmaxf(a,b); { auto rr=__builtin_amdgcn_permlane32_swap(__float_as_uint(rm),__float_as_uint(rm),false,false); rm=__builtin_fmaxf(__uint_as_float(rr[0]),__uint_as_float(rr[1])); } \
      resc=false; \
      if(__builtin_expect(__any(rm>(float)THRL),0)){ const float dl=__builtin_fmaxf(rm,0.f); mhat+=dl; \
        _Pragma("unroll") for(int r=0;r<16;++r){C0[r]-=dl;C1[r]-=dl;} \
        _Pragma("unroll") for(int r=0;r<16;++r)negm[r]=-mhat; asm volatile("":"+v"(negm)); \
        const float f=__builtin_amdgcn_exp2f(-dl); l_reg*=f; if(hi==0)wsf[r32]=f; resc=true; } } \
    SBAR(); \
    GAPB(o[0]=__builtin_amdgcn_mfma_f32_32x32x16_bf16(PAF(0),VFR(0),o[0],0,0,0), C0,0); \
    GAPB(o[1]=__builtin_amdgcn_mfma_f32_32x32x16_bf16(PAF(0),VFR(4),o[1],0,0,0), C0,4); \
    KRD(GL,0); GAPB(o[0]=__builtin_amdgcn_mfma_f32_32x32x16_bf16(PAF(1),VFR(1),o[0],0,0,0), C0,8); \
    KRD(GL,1); GAPB(o[1]=__builtin_amdgcn_mfma_f32_32x32x16_bf16(PAF(1),VFR(5),o[1],0,0,0), C0,12); \
    KRD(GL,2); GAPB(o[0]=__builtin_amdgcn_mfma_f32_32x32x16_bf16(PAF(2),VFR(2),o[0],0,0,0), C1,0); \
    KRD(GL,3); GAPB(o[1]=__builtin_amdgcn_mfma_f32_32x32x16_bf16(PAF(2),VFR(6),o[1],0,0,0), C1,4); \
    GAPB(o[0]=__builtin_amdgcn_mfma_f32_32x32x16_bf16(PAF(3),VFR(3),o[0],0,0,0), C1,8); \
    GAPB(o[1]=__builtin_amdgcn_mfma_f32_32x32x16_bf16(PAF(3),VFR(7),o[1],0,0,0), C1,12); \
    }while(0)
  int t=1;
  #undef CMASK
  #define CMASK(P0,P1,t) do{}while(0)
  for(;t+5<NT;t+=2){
    STEP(pB0,pB1,pA0,pA1,t,true,true,true);     WAIT_BAR(2); RESC(); ROT();
    STEP(pA0,pA1,pB0,pB1,t+1,true,true,true);   WAIT_BAR(2); RESC(); ROT();
  }
  #undef CMASK
  #define CMASK(P0,P1,t) do{}while(0)
  #define ENDW(tt) do{ if((tt)+3<NT){WAIT_BAR(2);} else if((tt)+2<NT){WAIT_BAR(1);} else {WAIT_BAR(0);} }while(0)
  for(;t+1<NT;t+=2){
    STEP(pB0,pB1,pA0,pA1,t,(t+3<NT),(t+1<NT),(t+1<NT));       ENDW(t);   RESC(); ROT();
    STEP(pA0,pA1,pB0,pB1,t+1,(t+4<NT),(t+2<NT),(t+2<NT));     ENDW(t+1); RESC(); ROT();
  }
  STEP(pB0,pB1,pA0,pA1,NT-1,false,false,false); RESC();
  { float sacc=pB0[0]+pB0[1]; _Pragma("unroll") for(int r=2;r<16;++r)sacc+=pB0[r]; _Pragma("unroll") for(int r=0;r<16;++r)sacc+=pB1[r]; l_reg+=sacc;
    pw0=(u32x4){PKW(pB0,0),PKW(pB0,2),PKW(pB0,4),PKW(pB0,6)};pw1=(u32x4){PKW(pB0,8),PKW(pB0,10),PKW(pB0,12),PKW(pB0,14)};pw2=(u32x4){PKW(pB1,0),PKW(pB1,2),PKW(pB1,4),PKW(pB1,6)};pw3=(u32x4){PKW(pB1,8),PKW(pB1,10),PKW(pB1,12),PKW(pB1,14)};
    SBAR(); pv(o,vb0+sl_cur,PAF(0),PAF(1),PAF(2),PAF(3)); }
  #undef PKW
  #undef PAF
  #undef VFR
  #undef PIN
  #undef MX3
  #undef GAPA
  #undef GAPB
  #undef EX
  #undef VRD
  #undef KRD
  #undef STEP
  #undef ENDW
  {auto rr=__builtin_amdgcn_permlane32_swap(__float_as_uint(l_reg),__float_as_uint(l_reg),false,false);l_reg=__uint_as_float(rr[0])+__uint_as_float(rr[1]);}
  if(hi==0)wsf[32+r32]=l_reg;asm volatile("s_waitcnt lgkmcnt(0)":::"memory");
  float rli[16];
  #pragma unroll
  for(int r=0;r<16;++r)rli[r]=__builtin_amdgcn_rcpf(wsf[32+crow(r,hi)]);
  bf16*Ow=O+(rowbase+q0+wid*QBLK)*DMO+h*D;
  { bf16*stg=(bf16*)(shm+LDS_OST)+wid*2048;
    #pragma unroll
    for(int r=0;r<16;++r){const int orow=crow(r,hi);
      #pragma unroll
      for(int d0=0;d0<2;++d0)stg[orow*64+d0*32+r32]=__float2bfloat16(o[d0][r]*rli[r]);}
    asm volatile("s_waitcnt lgkmcnt(0)":::"memory");
    #pragma unroll
    for(int i=0;i<4;++i){const int row=i*8+(lane>>3),ch=lane&7; const u32x4 v=*(const u32x4*)(stg+row*64+ch*8); ATTN_STORE16(Ow+(long)row*DMO+ch*8,v);} }
  asm volatile("s_waitcnt lgkmcnt(0)\n\ts_barrier":::"memory");
  #undef DMA_K
  #undef DMA_V
  #undef CMASK
  #undef START
  #undef RESC
  #undef ROT
}
constexpr int ATTN_LDS_BYTES=LDS_BYTES;
struct AttnTensors { const bf16* Q; const bf16* K; const bf16* V; bf16* O; };
struct AttnUnit { int bh; int qb; };
struct StaticOrder {
  int vcu, G;
  __device__ __forceinline__ explicit StaticOrder(int grid,int block):vcu((grid%8==0)?(block%8)*(grid/8)+block/8:block),G(grid){}
  __device__ __forceinline__ bool next(int i,AttnUnit&u)const{ const int per=(BATCH*NHEAD*NQB+G-1)/G; if(i>=per)return false; const int idx=vcu*per+i; if(idx>=BATCH*NHEAD*NQB)return false;
    const int qb=idx%NQB, hq=(idx/NQB)&3, bk=idx/(NQB*4), kvh=bk&1, b=bk>>1; u.bh=b*NHEAD+kvh*4+hq; u.qb=qb; return true; }
  __device__ __forceinline__ void a_ready(const AttnUnit&)const{}
  __device__ __forceinline__ void done(const AttnUnit&)const{}
};
template<class Sched,int THRL=8> __device__ __forceinline__ void attn_phase(char*lds,const AttnTensors&T,const Sched&S){
  AttnUnit u;
  for(int i=0;S.next(i,u);++i){ S.a_ready(u); attn_unit<THRL>(u.bh/NHEAD,u.bh%NHEAD,u.qb,T.Q,T.K,T.V,T.O,lds); S.done(u); }
}
#undef SBAR
#undef WAIT_BAR
}
constexpr int NB = 8, SEQ = 4096, DM = 1024, NL = 4, NTOK = NB * SEQ;
constexpr int INW = 1824, INP = 2048;
constexpr int C_AQ = 0, C_AK = 512, C_AV = 640, C_GQ = 768, C_GK = 896, C_GV = 1024, C_GR = 1280, C_FX = 1536, C_GLR = 1792;
constexpr int NE = 32, TOPK = 4, DE = 1024;
constexpr int MPAD = NTOK * TOPK + NE * 256;
constexpr float LN_EPS = 1e-5f, RMS_EPS = 1e-6f;
constexpr float DN_ALPHA = 1.681792830507429f;
constexpr float QSCALE = 0.125f * 1.4426950408889634f;
constexpr float GLA_QSCALE = 0.17677669529663687f;

constexpr size_t MiB = 1u << 20;
constexpr size_t WS_CTL = 0, CTL_ZERO_BYTES = 1 * MiB;
constexpr size_t WS_ROPE = 1 * MiB;
constexpr size_t WS_WIN_T = 2 * MiB;
constexpr size_t WS_WOUT_T = 18 * MiB;
constexpr size_t WS_FTAB = 26 * MiB;
constexpr size_t WS_TW = WS_FTAB + 65536;
constexpr size_t WS_FTMP = 27 * MiB;
constexpr size_t WS_WGU_T = 90 * MiB;
constexpr size_t WS_WDN_T = 602 * MiB;
constexpr size_t WS_HF = 858 * MiB;
constexpr size_t WS_HB = 986 * MiB;
constexpr size_t WS_PROJ = 1050 * MiB;
constexpr size_t WS_QB = 1178 * MiB;
constexpr size_t WS_KB = 1210 * MiB;
constexpr size_t WS_MIX = 1218 * MiB;
constexpr size_t WS_T1 = 1282 * MiB;
constexpr size_t WS_UVT = 1410 * MiB;
constexpr size_t WS_LA = 1442 * MiB;
constexpr size_t WS_OF = 1474 * MiB;
constexpr size_t WS_OB = 1506 * MiB;
constexpr size_t WS_TOK = 1538 * MiB;
constexpr size_t WS_XS = 1542 * MiB;
constexpr size_t WS_HID = 1814 * MiB;
constexpr size_t WS_YS = 2086 * MiB;
constexpr size_t WS_END = 2358 * MiB;
static_assert((size_t)MPAD * 2048 == 272 * MiB, "sorted buffers");
constexpr int CW_TMO = 0, CW_CODE = 1, CW_BAR = 4096, CW_CNT = 8192;

constexpr int RING_OFF = 0, RING_BYTES = 131072;
constexpr int LDSCTL_OFF = RING_BYTES;
constexpr int LDS_BYTES = 163840;
constexpr int LC_MISC = 0;
constexpr int LC_PSTART = 128;
constexpr int LC_ULIST = 384;
constexpr int LC_CNT = 640;
constexpr int LC_BASE = 768;
constexpr int LC_SELE = 1024;
constexpr int LC_SELS = 1024 + 2048;
constexpr int LC_COS64 = 5120;
constexpr int LC_ROWS = 6144;
constexpr int LC_LG = 16384;

constexpr int NWAVES = 8;
constexpr int N_PHASES = 1 + 10 * NL;

typedef float f32x2_t __attribute__((ext_vector_type(2))); typedef __bf16 bf16x2_t __attribute__((ext_vector_type(2)));
__device__ __forceinline__ unsigned cvtpk2(float lo, float hi) { f32x2_t v = {lo, hi}; bf16x2_t b = __builtin_convertvector(v, bf16x2_t); return __builtin_bit_cast(unsigned, b); }
#define pk2(lo, hi) cvtpk2((lo), (hi))
#define f2bf(x) (cvtpk2((x), 0.f) & 0xffffu)
__device__ __forceinline__ float bf2f(unsigned short b) { return __uint_as_float((unsigned)b << 16); }
__device__ __forceinline__ float wave_sum(float v) {
#pragma unroll
    for (int o = 1; o < 64; o <<= 1) v += __shfl_xor(v, o);
    return v;
}
typedef unsigned short u16x8 __attribute__((ext_vector_type(8)));
typedef unsigned short u16x4 __attribute__((ext_vector_type(4)));

typedef float f32x2v __attribute__((ext_vector_type(2)));
__device__ __forceinline__ void tr_task(const float* W, int K, int Nsrc, int srcn, bf16* WT, int dst_n, int k0) {
#pragma unroll 1
    for (int hf = 0; hf < 2; ++hf) { const int kk = k0 + hf * 64; f32x2v v[64];
        if (srcn >= 0) { const float* p = W + (size_t)kk * Nsrc + srcn;
#pragma unroll
            for (int i = 0; i < 64; ++i) v[i] = __builtin_nontemporal_load((const f32x2v*)(p + (size_t)i * Nsrc)); }
        else {
#pragma unroll
            for (int i = 0; i < 64; ++i) v[i] = (f32x2v){0.f, 0.f}; }
        bf16* o0 = WT + (size_t)dst_n * K + kk; bf16* o1 = o0 + K;
#pragma unroll
        for (int j = 0; j < 8; ++j) { v4u w0, w1;
            w0.x = pk2(v[8 * j].x, v[8 * j + 1].x); w0.y = pk2(v[8 * j + 2].x, v[8 * j + 3].x); w0.z = pk2(v[8 * j + 4].x, v[8 * j + 5].x); w0.w = pk2(v[8 * j + 6].x, v[8 * j + 7].x);
            w1.x = pk2(v[8 * j].y, v[8 * j + 1].y); w1.y = pk2(v[8 * j + 2].y, v[8 * j + 3].y); w1.z = pk2(v[8 * j + 4].y, v[8 * j + 5].y); w1.w = pk2(v[8 * j + 6].y, v[8 * j + 7].y);
            *(v4u*)(o0 + 8 * j) = w0; *(v4u*)(o1 + 8 * j) = w1; } }
}

__device__ __forceinline__ void ln_row(f32x4 (&v)[4], const float* g, const float* bt, float* of32, bf16* obf, int lane) {
    float s = 0.f;
#pragma unroll
    for (int j = 0; j < 4; ++j) s += (v[j].x + v[j].y) + (v[j].z + v[j].w);
    const float mean = wave_sum(s) * (1.f / DM); float s2 = 0.f;
#pragma unroll
    for (int j = 0; j < 4; ++j) { v[j] = v[j] - mean; s2 += (v[j].x * v[j].x + v[j].y * v[j].y) + (v[j].z * v[j].z + v[j].w * v[j].w); }
    const float rstd = 1.f / sqrtf(wave_sum(s2) * (1.f / DM) + LN_EPS);
#pragma unroll
    for (int j = 0; j < 4; ++j) { const f32x4 gg = *(const f32x4*)(g + lane * 4 + 256 * j), bb = *(const f32x4*)(bt + lane * 4 + 256 * j);
        v[j] = v[j] * rstd * gg + bb;
        if (of32) *(f32x4*)(of32 + lane * 4 + 256 * j) = v[j];
        if (obf) *(unsigned long long*)(obf + lane * 4 + 256 * j) = (unsigned long long)pk2(v[j].x, v[j].y) | ((unsigned long long)pk2(v[j].z, v[j].w) << 32); }
}


constexpr int GM_QF = 0, GM_KF = 5120, GM_QB = 10240, GM_KB = 15360, GM_VT = 20480, GM_P = 29696, GM_HTF = 38912, GM_HTB = 44032, GM_DL = 38912, GM_SLOT = 49152;
static_assert(2 * GM_SLOT <= RING_BYTES, "two GLA chunk images fit the phase scratch");
#define MFMA16(a, b, c) __builtin_amdgcn_mfma_f32_16x16x32_bf16((a), (b), (c), 0, 0, 0)
template <bool OUT>
__device__ __forceinline__ void gla_stage_mfma(LAS unsigned char* Ls, const bf16* PROJ, const float* LA, const float* HIN, size_t tok0, int hd, int w4, int lane) {
    if (w4 < 2) { const int dir = w4, g = lane >> 3, c4 = (lane & 7) * 4; f32x4 bc[8]; u16x4 kx[8], qx[8];
        const float* lap = LA + (tok0 + 8 * g) * 256 + dir * 128 + hd * 32 + c4; const bf16* xp = PROJ + (tok0 + 8 * g) * INP + hd * 32 + c4;
#pragma unroll
        for (int i = 0; i < 8; ++i) { bc[i] = *(const f32x4*)(lap + (size_t)i * 256); kx[i] = *(const u16x4*)(xp + (size_t)i * INP + C_GK); if (OUT) qx[i] = *(const u16x4*)(xp + (size_t)i * INP + C_GQ); }
        f32x4 inc;
        if (dir == 0) {
#pragma unroll
            for (int i = 1; i < 8; ++i) bc[i] = bc[i] + bc[i - 1];
            inc = bc[7];
#pragma unroll
            for (int o = 1; o < 8; o <<= 1) { f32x4 y; y.x = __shfl_up(inc.x, 8 * o); y.y = __shfl_up(inc.y, 8 * o); y.z = __shfl_up(inc.z, 8 * o); y.w = __shfl_up(inc.w, 8 * o); if (g >= o) inc = inc + y; }
            const f32x4 off = inc - bc[7];
#pragma unroll
            for (int i = 0; i < 8; ++i) bc[i] = bc[i] + off; }
        else {
#pragma unroll
            for (int i = 6; i >= 0; --i) bc[i] = bc[i] + bc[i + 1];
            inc = bc[0];
#pragma unroll
            for (int o = 1; o < 8; o <<= 1) { f32x4 y; y.x = __shfl_down(inc.x, 8 * o); y.y = __shfl_down(inc.y, 8 * o); y.z = __shfl_down(inc.z, 8 * o); y.w = __shfl_down(inc.w, 8 * o); if (g + o < 8) inc = inc + y; }
            const f32x4 off = inc - bc[0];
#pragma unroll
            for (int i = 0; i < 8; ++i) bc[i] = bc[i] + off; }
        if (OUT) { LAS bf16* qd = (LAS bf16*)(Ls + (dir ? GM_QB : GM_QF)) + (8 * g) * 40 + c4; LAS bf16* kd = (LAS bf16*)(Ls + (dir ? GM_KB : GM_KF)) + (8 * g) * 40 + c4;
#pragma unroll
            for (int i = 0; i < 8; ++i) { float qv[4], kv[4];
#pragma unroll
                for (int c = 0; c < 4; ++c) { const float e_ = __expf(bc[i][c]); qv[c] = bf2f(qx[i][c]) * GLA_QSCALE * e_; kv[c] = bf2f(kx[i][c]) * __builtin_amdgcn_rcpf(e_); }
                *(LAS unsigned long long*)(qd + i * 40) = (unsigned long long)pk2(qv[0], qv[1]) | ((unsigned long long)pk2(qv[2], qv[3]) << 32);
                *(LAS unsigned long long*)(kd + i * 40) = (unsigned long long)pk2(kv[0], kv[1]) | ((unsigned long long)pk2(kv[2], kv[3]) << 32); } }
        else { LAS bf16* kt = (LAS bf16*)(Ls + GM_P + dir * 4608) + c4 * 72 + 8 * g;
#pragma unroll
            for (int c = 0; c < 4; ++c) { float t[8];
#pragma unroll
                for (int i = 0; i < 8; ++i) t[i] = bf2f(kx[i][c]) * __expf(-bc[i][c]);
                v4u w; w.x = pk2(t[0], t[1]); w.y = pk2(t[2], t[3]); w.z = pk2(t[4], t[5]); w.w = pk2(t[6], t[7]); *(LAS v4u*)(kt + c * 72) = w; }
            if (g == (dir ? 0 : 7)) { const f32x4 tot = dir ? bc[0] : bc[7]; LAS float* dl = (LAS float*)(Ls + GM_DL) + dir * 32 + c4; dl[0] = __expf(tot.x); dl[1] = __expf(tot.y); dl[2] = __expf(tot.z); dl[3] = __expf(tot.w); } } }
    else if (w4 == 2) { const int g = lane >> 3, v0 = (lane & 7) * 8; u16x8 x[8]; const bf16* xp = PROJ + (tok0 + 8 * g) * INP + C_GV + hd * 64 + v0;
#pragma unroll
        for (int i = 0; i < 8; ++i) x[i] = *(const u16x8*)(xp + (size_t)i * INP);
        LAS bf16* dst = (LAS bf16*)(Ls + GM_VT) + v0 * 72 + 8 * g;
#pragma unroll
        for (int c = 0; c < 8; ++c) { v4u w; w.x = (unsigned)x[0][c] | ((unsigned)x[1][c] << 16); w.y = (unsigned)x[2][c] | ((unsigned)x[3][c] << 16); w.z = (unsigned)x[4][c] | ((unsigned)x[5][c] << 16); w.w = (unsigned)x[6][c] | ((unsigned)x[7][c] << 16);
            *(LAS v4u*)(dst + c * 72) = w; } }
    else if (OUT) {
#pragma unroll
        for (int dir = 0; dir < 2; ++dir) { const f32x4* src = (const f32x4*)(HIN + ((size_t)dir * 64 + lane) * 32); LAS bf16* dst = (LAS bf16*)(Ls + (dir ? GM_HTB : GM_HTF)) + lane * 40;
#pragma unroll
            for (int c8 = 0; c8 < 4; ++c8) { const f32x4 a_ = src[2 * c8], b_ = src[2 * c8 + 1]; v4u w; w.x = pk2(a_.x, a_.y); w.y = pk2(a_.z, a_.w); w.z = pk2(b_.x, b_.y); w.w = pk2(b_.z, b_.w); *(LAS v4u*)(dst + c8 * 8) = w; } } }
}

typedef float f32x16 __attribute__((ext_vector_type(16)));
typedef short s16x4 __attribute__((ext_vector_type(4)));
__device__ __forceinline__ bf16x8 pack_step(const f32x16& x, int s) { v4u p; p.x = cvtpk2(x[8 * s], x[8 * s + 1]); p.y = cvtpk2(x[8 * s + 2], x[8 * s + 3]); p.z = cvtpk2(x[8 * s + 4], x[8 * s + 5]); p.w = cvtpk2(x[8 * s + 6], x[8 * s + 7]); return __builtin_bit_cast(bf16x8, p); }
__device__ __forceinline__ int crow16(int i, int h) { return (i & 3) + 8 * (i >> 2) + 4 * h; }
#define MFMA32(a, b, c) __builtin_amdgcn_mfma_f32_32x32x16_bf16((a), (b), (c), 0, 0, 0)
constexpr int FT_PITCH = 72, FT_TAB = 64 * FT_PITCH;
constexpr int FFT_LDS_TAB = 0, FFT_LDS_TW = 28672, FFT_LDS_HT = 28672, FFT_HT_PAIR = 2 * 64 * FT_PITCH * 2;

struct Args { const float* in[20]; float* out; unsigned char* ws; int ph_lo, ph_hi; };
static_assert(sizeof(Args) == 20 * 8 + 8 + 8 + 8, "no padding bytes in Args");


typedef __attribute__((address_space(4))) const unsigned char* kptr_t;
__device__ __forceinline__ kptr_t karg() { kptr_t p = (kptr_t)__builtin_amdgcn_kernarg_segment_ptr(); asm volatile("" : "+s"(p)); return p; }
#define KIN(i) (*(const float* const __attribute__((address_space(4)))*)(karg() + 8 * (i)))
#define KOUT() (*(float* const __attribute__((address_space(4)))*)(karg() + 160))
#define KWS() (*(unsigned char* const __attribute__((address_space(4)))*)(karg() + 168))
#define WSP(T, off) ((T*)(ws + (off)))

#ifndef NAIVE_ATTN
#define NAIVE_ATTN 0
#endif

__global__ void __launch_bounds__(NWAVES * 64, 2) fwd(Args args) {
    extern __shared__ __attribute__((aligned(16))) unsigned char lds_raw[];
    LAS unsigned char* lds = (LAS unsigned char*)lds_raw;
    LAS unsigned char* lctl = lds + LDSCTL_OFF;
    const int G = gridDim.x, bx = blockIdx.x;
    const int NGW = G * NWAVES, NGT = G * NWAVES * 64;
#define TID_SETUP() int tid_ = threadIdx.x; asm volatile("" : "+v"(tid_)); const int tid = tid_, lane = tid & 63, wave = __builtin_amdgcn_readfirstlane(tid >> 6); \
    const int gw = bx * NWAVES + wave, gt = bx * (NWAVES * 64) + tid; (void)lane; (void)gw; (void)gt
    for (int u = threadIdx.x; u < (LDS_BYTES - LDSCTL_OFF) / 4; u += NWAVES * 64) ((LAS unsigned*)lctl)[u] = 0u;
    __syncthreads();
    volatile LAS unsigned* MISC = (volatile LAS unsigned*)(lctl + LC_MISC);
    XcdBarrier bar = xcd_barrier_post((unsigned*)(KWS() + WS_CTL) + CW_BAR, MISC + 8);
    const int lo = args.ph_lo, hi = args.ph_hi;
#ifndef PH_OFF
#define PH_OFF 0
#endif
#define PON(j) (!((PH_OFF >> (j)) & 1))
#define IN(k) (lo <= (k) && (k) < hi)
#ifndef PROBE_A
#define PROBE_A -1
#endif
#ifndef PROBE_B
#define PROBE_B -1
#endif
#if PROBE_A >= 0
#define STAMP(k) do { if (blockIdx.x == 0 && threadIdx.x == 0) { ((unsigned long long*)(KWS() + WS_CTL + 65536))[(k)] = __builtin_amdgcn_s_memrealtime(); } } while (0)
#define STAMP2(i) do { __syncthreads(); if (blockIdx.x == 0 && threadIdx.x == 0) { ((unsigned long long*)(KWS() + WS_CTL + 65536))[128 + l * 16 + (i)] = __builtin_amdgcn_s_memrealtime(); } } while (0)
#else
#define STAMP(k) do {} while (0)
#define STAMP2(i) do {} while (0)
#endif
#ifndef PROBE_SUB_A
#define PROBE_SUB_A -1
#define PROBE_SUB_B -1
#endif
#define SEAM(k) do { if (IN(k) && IN((k) + 1)) xcd_barrier(bar); STAMP((k) + 1); } while (0)
    STAMP(0);

    if (IN(0) && PON(0)) {
        TID_SETUP(); unsigned char* ws = KWS(); const float* x_in = KIN(0); const float* ln_in_g = KIN(1); const float* ln_in_b = KIN(2); const float* w_in = KIN(3); const float* w_out = KIN(9);
        const float* exp_w_gu = KIN(14); const float* exp_w_down = KIN(16);
        float* ROPE = WSP(float, WS_ROPE); bf16* WIN_T = WSP(bf16, WS_WIN_T); bf16* WOUT_T = WSP(bf16, WS_WOUT_T); bf16* WGU_T = WSP(bf16, WS_WGU_T); bf16* WDN_T = WSP(bf16, WS_WDN_T);
        bf16* HB = WSP(bf16, WS_HB);
        constexpr int I_WIN = NL * 16 * 8, I_WOUT = NL * 8 * 8, I_WGU = NL * NE * 16 * 8, I_WDN = NL * NE * 8 * 8;
        constexpr int NTASK = I_WIN + I_WOUT + I_WGU + I_WDN;
        { const int t_lo = (int)(((long)gw * NTASK) / NGW), t_hi = (int)(((long)(gw + 1) * NTASK) / NGW);
          for (int it = t_lo; it < t_hi; ++it) {
            int r = it;
            if (r < I_WIN) { const int l = r / 128, q = r % 128, nb = q / 8, k8 = q % 8, n = nb * 128 + 2 * lane;
                const int src = n < 1536 ? n : (n < 1792 ? n + 32 : (n < 1824 ? n - 256 : -1));
                tr_task(w_in + (size_t)l * DM * INW, DM, INW, src, WIN_T + (size_t)l * INP * DM, n, k8 * 128); continue; }
            r -= I_WIN;
            if (r < I_WOUT) { const int l = r / 64, q = r % 64, nb = q / 8, k8 = q % 8, n = nb * 128 + 2 * lane;
                tr_task(w_out + (size_t)l * DM * DM, DM, DM, n, WOUT_T + (size_t)l * DM * DM, n, k8 * 128); continue; }
            r -= I_WOUT;
            if (r < I_WGU) { const int le = r / 128, q = r % 128, nb = q / 8, k8 = q % 8, n = nb * 128 + 2 * lane;
                const int pn = n >> 8, bj = (n >> 7) & 1, j = n & 127, src = bj * 1024 + pn * 128 + j;
                tr_task(exp_w_gu + (size_t)le * DM * 2048, DM, 2048, src, WGU_T + (size_t)le * 2048 * DM, n, k8 * 128); continue; }
            r -= I_WGU;
            { const int le = r / 64, q = r % 64, nb = q / 8, k8 = q % 8, n = nb * 128 + 2 * lane;
                tr_task(exp_w_down + (size_t)le * DE * DM, DE, DM, n, WDN_T + (size_t)le * DM * DE, n, k8 * 128); }
          } }
        { bf16* FTAB = WSP(bf16, WS_FTAB); float* TW = WSP(float, WS_TW);
          for (int it = gt; it < 3 * FT_TAB; it += NGT) { const int t = it / FT_TAB, q = it % FT_TAB, row = q / FT_PITCH, col = q % FT_PITCH; float sn, cs; sincospif((float)((row * col) & 63) * (1.0f / 32.0f), &sn, &cs);
              const float v = col >= 64 ? 0.f : (t == 0 ? cs : (t == 1 ? sn : -sn)); FTAB[it] = (bf16)f2bf(v); }
          for (int it = gt; it < 4096; it += NGT) { float sn, cs; sincospif((float)it * (1.0f / 2048.0f), &sn, &cs); TW[2 * it] = cs; TW[2 * it + 1] = -sn; } }
        for (int it = gt; it < SEQ * 32; it += NGT) { const int t = it >> 5, i = it & 31, a = i >> 4, f = i & 15; const int pos = a ? (t & 63) : (t >> 6);
            const double inv = exp(-9.210340371976184 * (double)f / 16.0); const double ang = (double)pos * inv;
            ROPE[it] = (float)cos(ang); ROPE[SEQ * 32 + it] = (float)sin(ang); }
        for (int m = gw; m < NTOK; m += NGW) { f32x4 v[4];
#pragma unroll
            for (int j = 0; j < 4; ++j) v[j] = *(const f32x4*)(x_in + (size_t)m * DM + lane * 4 + 256 * j);
            ln_row(v, ln_in_g, ln_in_b, nullptr, HB + (size_t)m * DM, lane); }
    }
    SEAM(0);

    for (int l = 0; l < NL; ++l) {
        const int pb = 1 + 10 * l;
        if (IN(pb + 0) && PON(1)) {
            TID_SETUP(); unsigned char* ws = KWS(); bf16* HB = WSP(bf16, WS_HB); bf16* WIN_T = WSP(bf16, WS_WIN_T); bf16* PROJ = WSP(bf16, WS_PROJ);
            pg8::Gemm g{HB, WIN_T + (size_t)l * INP * DM, NTOK, INP, DM}; pg8::StaticOrder S; S.init(NTOK, INP, G, bx);
            pg8::EpiPlainBf16 E{PROJ, INP};
            STAMP2(2);
            pg8::gemm_phase<pg8::EpiPlainBf16, pg8::StaticOrder, true, true>(lds + RING_OFF, g, S, E);
            STAMP2(3);
        }
        SEAM(pb + 0);
        if (IN(pb + 1) && PON(2)) {
            TID_SETUP(); unsigned char* ws = KWS(); const float* att_q_gain = KIN(4); const float* att_k_gain = KIN(5); const float* gla_gate_w = KIN(6); const float* gla_gate_b = KIN(7);
            const float* ROPE = WSP(float, WS_ROPE); const bf16* PROJ = WSP(bf16, WS_PROJ); bf16* QB = WSP(bf16, WS_QB); bf16* KB = WSP(bf16, WS_KB); float* LA = WSP(float, WS_LA);
            STAMP2(8);
            { const float qgv = att_q_gain[l * 64 + lane], kgv = att_k_gain[l * 64 + lane]; const int ri = (lane >> 5) * 16 + (lane & 15); const float sg = ((lane >> 4) & 1) ? 1.f : -1.f;
              const float* gw_l = gla_gate_w + (size_t)l * 2 * 16 * 128; const float* gb_l = gla_gate_b + (size_t)l * 2 * 128; const int dir = lane >> 5, kc = (lane & 31) * 4;
              f32x4 gwr[16]; const f32x4 gbv = *(const f32x4*)(gb_l + dir * 128 + kc);
#pragma unroll
              for (int r = 0; r < 16; ++r) gwr[r] = *(const f32x4*)(gw_l + (size_t)(dir * 16 + r) * 128 + kc);
              for (int m0 = gw; m0 < NTOK; m0 += 2 * NGW) { unsigned short xh[2][10], xl[2]; float cs[2], sn[2];
#pragma unroll
                for (int q = 0; q < 2; ++q) { const size_t m = (size_t)m0 + q * NGW; const int t = (int)(m & (SEQ - 1));
#pragma unroll
                    for (int h = 0; h < 10; ++h) xh[q][h] = PROJ[m * INP + h * 64 + lane];
                    xl[q] = PROJ[m * INP + C_GLR + (lane & 31)]; cs[q] = ROPE[t * 32 + ri]; sn[q] = ROPE[SEQ * 32 + t * 32 + ri]; }
#pragma unroll
                for (int q = 0; q < 2; ++q) { const size_t m = (size_t)m0 + q * NGW;
#pragma unroll
                    for (int h = 0; h < 10; ++h) { const float xv = bf2f(xh[q][h]);
                        const float ms = wave_sum(xv * xv) * (1.f / 64.f); const float xn = xv * __builtin_amdgcn_rsqf(ms + RMS_EPS) * (h < 8 ? qgv : kgv);
                        const float pr = __shfl_xor(xn, 16); float o = xn * cs[q] + sg * pr * sn[q];
                        if (h < 8) { o *= QSCALE; QB[m * 512 + h * 64 + lane] = (bf16)f2bf(o); } else KB[m * 128 + (h - 8) * 64 + lane] = (bf16)f2bf(o); }
                    const float lr = bf2f(xl[q]); f32x4 z = gbv;
#pragma unroll
                    for (int r = 0; r < 16; ++r) { const float a_ = __shfl(lr, dir * 16 + r); z = z + gwr[r] * a_; }
                    f32x4 o4;
#pragma unroll
                    for (int i = 0; i < 4; ++i) o4[i] = (fminf(z[i], 0.f) - __logf(1.f + __expf(-fabsf(z[i])))) * (1.f / 16.f);
                    *(f32x4*)(LA + m * 256 + dir * 128 + kc) = o4; } } }
            STAMP2(4);
            { __syncthreads();
              { const v4u* src = (const v4u*)WSP(bf16, WS_FTAB); LAS v4u* dst = (LAS v4u*)(lds + RING_OFF + FFT_LDS_TAB); for (int i = tid; i < 3 * FT_TAB * 2 / 16; i += NWAVES * 64) dst[i] = src[i];
                const v4u* s2_ = (const v4u*)WSP(float, WS_TW); LAS v4u* d2_ = (LAS v4u*)(lds + RING_OFF + FFT_LDS_TW); for (int i = tid; i < 4096 * 8 / 16; i += NWAVES * 64) d2_[i] = s2_[i]; }
              __syncthreads();
              const LAS bf16* FT = (const LAS bf16*)(lds + RING_OFF + FFT_LDS_TAB); const LAS float* TWL = (const LAS float*)(lds + RING_OFF + FFT_LDS_TW); bf16* FTMP = WSP(bf16, WS_FTMP);
              const int pair = wave >> 1, cb = wave & 1, r = lane & 31, h = lane >> 5;
              for (int ub = bx; ub < NB * 4 * 64 / 4; ub += G) { const int u = ub * 4 + pair, s2 = u & 63, g4 = (u >> 6) & 3, b = u >> 8;
                bf16x8 xa[2][4];
#pragma unroll
                for (int R = 0; R < 2; ++R)
#pragma unroll
                    for (int ks = 0; ks < 4; ++ks) xa[R][ks] = *(const bf16x8*)(PROJ + ((size_t)b * SEQ + 64 * (32 * R + r) + s2) * INP + C_FX + g4 * 64 + 16 * ks + 8 * h);
                f32x16 Tr[2], Ti[2];
#pragma unroll
                for (int R = 0; R < 2; ++R)
#pragma unroll
                    for (int i = 0; i < 16; ++i) { Tr[R][i] = 0.f; Ti[R][i] = 0.f; }
#pragma unroll
                for (int ks = 0; ks < 4; ++ks) { const bf16x8 bc = *(const LAS bf16x8*)(FT + (32 * cb + r) * FT_PITCH + 16 * ks + 8 * h), bs = *(const LAS bf16x8*)(FT + 2 * FT_TAB + (32 * cb + r) * FT_PITCH + 16 * ks + 8 * h);
#pragma unroll
                    for (int R = 0; R < 2; ++R) { Tr[R] = MFMA32(xa[R][ks], bc, Tr[R]); Ti[R] = MFMA32(xa[R][ks], bs, Ti[R]); } }
#pragma unroll
                for (int Rp = 0; Rp < 2; ++Rp) { f32x16 Gr, Gi;
#pragma unroll
                    for (int i = 0; i < 16; ++i) { Gr[i] = 0.f; Gi[i] = 0.f; }
#pragma unroll
                    for (int R = 0; R < 2; ++R)
#pragma unroll
                        for (int s_ = 0; s_ < 2; ++s_) { const bf16x8 xr = pack_step(Tr[R], s_), xi = pack_step(Ti[R], s_);
                            const int kb = 32 * R + 16 * s_ + 4 * h, ro = (32 * Rp + r) * FT_PITCH + kb;
                            const s16x4 c0 = *(const LAS s16x4*)(FT + ro), c1 = *(const LAS s16x4*)(FT + ro + 8), s0 = *(const LAS s16x4*)(FT + FT_TAB + ro), s1 = *(const LAS s16x4*)(FT + FT_TAB + ro + 8),
                                        n0 = *(const LAS s16x4*)(FT + 2 * FT_TAB + ro), n1 = *(const LAS s16x4*)(FT + 2 * FT_TAB + ro + 8);
                            const bf16x8 ca = __builtin_shufflevector(c0, c1, 0, 1, 2, 3, 4, 5, 6, 7), sa = __builtin_shufflevector(s0, s1, 0, 1, 2, 3, 4, 5, 6, 7), na = __builtin_shufflevector(n0, n1, 0, 1, 2, 3, 4, 5, 6, 7);
                            Gr = MFMA32(ca, xr, Gr); Gr = MFMA32(sa, xi, Gr); Gi = MFMA32(ca, xi, Gi); Gi = MFMA32(na, xr, Gi); }
#pragma unroll
                    for (int i = 0; i < 16; ++i) { const int s1p = 32 * Rp + crow16(i, h); const int m = (s2 * s1p) & 4095; const float wr = TWL[2 * m], wi = TWL[2 * m + 1];
                        const size_t o = ((((size_t)(b * 4 + g4) * 64 + s1p) * 2) * 64 + s2) * 64 + 32 * cb + r;
                        FTMP[o] = (bf16)f2bf(Gr[i] * wr - Gi[i] * wi); FTMP[o + 4096] = (bf16)f2bf(Gr[i] * wi + Gi[i] * wr); } }
              }
              __syncthreads(); }
            STAMP2(5);
            { float* GS = WSP(float, WS_OF); float* GD = WSP(float, WS_OB);
              const int slot = wave >> 2, w4 = wave & 3, fr = lane & 15, fq = lane >> 4; LAS unsigned char* Ls = lds + RING_OFF + slot * GM_SLOT;
              for (int ub = bx; ub < NB * 4 * 64 / 2; ub += G) { const int u = ub * 2 + slot, c = u & 63, bh = u >> 6, hd = bh & 3, b = bh >> 2; const size_t tok0 = (size_t)b * SEQ + c * 64;
                __syncthreads();
                gla_stage_mfma<false>(Ls, PROJ, LA, nullptr, tok0, hd, w4, lane);
                __syncthreads();
                const LAS bf16* VT = (const LAS bf16*)(Ls + GM_VT); const LAS float* DL = (const LAS float*)(Ls + GM_DL);
#pragma unroll
                for (int dir = 0; dir < 2; ++dir) { const LAS bf16* KT = (const LAS bf16*)(Ls + GM_P + dir * 4608);
#pragma unroll
                    for (int Cd = 0; Cd < 2; ++Cd) { f32x4 acc = {0.f, 0.f, 0.f, 0.f};
#pragma unroll
                        for (int ks = 0; ks < 2; ++ks) { const bf16x8 a_ = *(const LAS bf16x8*)(VT + (16 * w4 + fr) * 72 + 32 * ks + 8 * fq), b_ = *(const LAS bf16x8*)(KT + (16 * Cd + fr) * 72 + 32 * ks + 8 * fq); acc = MFMA16(a_, b_, acc); }
                        const float Dd = DL[dir * 32 + 16 * Cd + fr]; float* o = GS + (((size_t)u * 2 + dir) * 64 + 16 * w4 + 4 * fq) * 32 + 16 * Cd + fr;
#pragma unroll
                        for (int r = 0; r < 4; ++r) o[r * 32] = acc[r] * Dd; } }
                if (w4 == 3) GD[((size_t)u * 2 + (lane >> 5)) * 32 + (lane & 31)] = DL[lane]; }
              __syncthreads(); }
            STAMP2(9);
        }
        SEAM(pb + 1);
        if (IN(pb + 2) && PON(3)) {
            TID_SETUP(); unsigned char* ws = KWS(); float* GS = WSP(float, WS_OF); const float* GD = WSP(float, WS_OB);
            for (int e = gt; e < NB * 4 * 2 * 2048; e += NGT) { const int dv = e & 2047, dir = (e >> 11) & 1, bh = e >> 12, d = dv & 31; float H = 0.f;
                for (int c8 = 0; c8 < 64; c8 += 8) { float sv[8], dd[8];
#pragma unroll
                    for (int i = 0; i < 8; ++i) { const int c = dir ? 63 - (c8 + i) : (c8 + i); const size_t sidx = ((size_t)(bh * 64 + c) * 2 + dir); sv[i] = GS[sidx * 2048 + dv]; dd[i] = GD[sidx * 32 + d]; }
#pragma unroll
                    for (int i = 0; i < 8; ++i) { const int c = dir ? 63 - (c8 + i) : (c8 + i); const size_t sidx = ((size_t)(bh * 64 + c) * 2 + dir); GS[sidx * 2048 + dv] = H; H = H * dd[i] + sv[i]; } } }
        }
        SEAM(pb + 2);
        if (IN(pb + 3) && PON(4)) {
            TID_SETUP(); unsigned char* ws = KWS(); const float* gla_norm_g = KIN(8); const bf16* PROJ = WSP(bf16, WS_PROJ);
            bf16* MIX = WSP(bf16, WS_MIX); const bf16* QB = WSP(bf16, WS_QB); const bf16* KB = WSP(bf16, WS_KB);
            { __syncthreads();
              { const v4u* src = (const v4u*)WSP(bf16, WS_FTAB); LAS v4u* dst = (LAS v4u*)(lds + RING_OFF + FFT_LDS_TAB); for (int i = tid; i < 3 * FT_TAB * 2 / 16; i += NWAVES * 64) dst[i] = src[i]; }
              const LAS bf16* FT = (const LAS bf16*)(lds + RING_OFF + FFT_LDS_TAB); const bf16* FTMP = WSP(bf16, WS_FTMP);
              const int pair = wave >> 1, cb = wave & 1, r = lane & 31, h = lane >> 5;
              LAS bf16* HT = (LAS bf16*)(lds + RING_OFF + FFT_LDS_HT + pair * FFT_HT_PAIR);
              for (int ub = bx; ub < NB * 4 * 64 / 4; ub += G) { const int u = ub * 4 + pair, s1p = u & 63, g4 = (u >> 6) & 3, b = u >> 8;
                const bf16* src = FTMP + (size_t)u * 2 * 4096;
                __syncthreads();
#pragma unroll
                for (int q = 0; q < 8; ++q) { const int p = cb * 64 + lane + 128 * q, ri = p >> 9, s2 = (p >> 3) & 63, c0 = (p & 7) * 8; const u16x8 v = *(const u16x8*)(src + p * 8);
#pragma unroll
                    for (int i = 0; i < 8; ++i) HT[(ri * 64 + c0 + i) * FT_PITCH + s2] = v[i]; }
                __syncthreads();
#pragma unroll
                for (int Rp = 0; Rp < 2; ++Rp) { f32x16 acc;
#pragma unroll
                    for (int i = 0; i < 16; ++i) acc[i] = 0.f;
#pragma unroll
                    for (int ks = 0; ks < 4; ++ks) { const int ko = 16 * ks + 8 * h;
                        const bf16x8 ca = *(const LAS bf16x8*)(FT + (32 * Rp + r) * FT_PITCH + ko), sa = *(const LAS bf16x8*)(FT + FT_TAB + (32 * Rp + r) * FT_PITCH + ko);
                        const bf16x8 hr = *(const LAS bf16x8*)(HT + (32 * cb + r) * FT_PITCH + ko), hi_ = *(const LAS bf16x8*)(HT + (64 + 32 * cb + r) * FT_PITCH + ko);
                        acc = MFMA32(ca, hr, acc); acc = MFMA32(sa, hi_, acc); }
#pragma unroll
                    for (int i = 0; i < 16; ++i) { const int s2p = 32 * Rp + crow16(i, h); MIX[((size_t)b * SEQ + s1p + 64 * s2p) * DM + 768 + g4 * 64 + 32 * cb + r] = (bf16)f2bf(acc[i] * (1.0f / 512.0f)); } }
              }
              __syncthreads(); }
            STAMP2(6);
            { const float* GS = WSP(float, WS_OF); const float* LA = WSP(float, WS_LA);
              const int slot = wave >> 2, w4 = wave & 3, fr = lane & 15, fq = lane >> 4, I0 = 16 * w4; LAS unsigned char* Ls = lds + RING_OFF + slot * GM_SLOT;
              for (int ub = bx; ub < NB * 4 * 64 / 2; ub += G) { const int u = ub * 2 + slot, c = u & 63, bh = u >> 6, hd = bh & 3, b = bh >> 2; const size_t tok0 = (size_t)b * SEQ + c * 64;
                __syncthreads();
                gla_stage_mfma<true>(Ls, PROJ, LA, GS + (size_t)u * 2 * 2048, tok0, hd, w4, lane);
                __syncthreads();
                const LAS bf16* QF = (const LAS bf16*)(Ls + GM_QF); const LAS bf16* KF = (const LAS bf16*)(Ls + GM_KF); const LAS bf16* QBm = (const LAS bf16*)(Ls + GM_QB); const LAS bf16* KBm = (const LAS bf16*)(Ls + GM_KB);
                const LAS bf16* VT = (const LAS bf16*)(Ls + GM_VT); LAS bf16* P = (LAS bf16*)(Ls + GM_P); const LAS bf16* HTF = (const LAS bf16*)(Ls + GM_HTF); const LAS bf16* HTB = (const LAS bf16*)(Ls + GM_HTB);
                const bf16x8 qfa = *(const LAS bf16x8*)(QF + (I0 + fr) * 40 + 8 * fq), qba = *(const LAS bf16x8*)(QBm + (I0 + fr) * 40 + 8 * fq);
#pragma unroll
                for (int Cj = 0; Cj < 4; ++Cj) { const f32x4 z = {0.f, 0.f, 0.f, 0.f};
                    const f32x4 pf = MFMA16(qfa, *(const LAS bf16x8*)(KF + (16 * Cj + fr) * 40 + 8 * fq), z), pb = MFMA16(qba, *(const LAS bf16x8*)(KBm + (16 * Cj + fr) * 40 + 8 * fq), z);
#pragma unroll
                    for (int r = 0; r < 4; ++r) { const int i = I0 + 4 * fq + r, j = 16 * Cj + fr; P[i * 72 + j] = (bf16)f2bf(j <= i ? pf[r] : pb[r]); } }
                asm volatile("s_waitcnt lgkmcnt(0)" ::: "memory");
                f32x4 o[4];
#pragma unroll
                for (int Cv = 0; Cv < 4; ++Cv) { f32x4 acc = {0.f, 0.f, 0.f, 0.f};
#pragma unroll
                    for (int ks = 0; ks < 2; ++ks) acc = MFMA16(*(const LAS bf16x8*)(P + (I0 + fr) * 72 + 32 * ks + 8 * fq), *(const LAS bf16x8*)(VT + (16 * Cv + fr) * 72 + 32 * ks + 8 * fq), acc);
                    acc = MFMA16(qfa, *(const LAS bf16x8*)(HTF + (16 * Cv + fr) * 40 + 8 * fq), acc); acc = MFMA16(qba, *(const LAS bf16x8*)(HTB + (16 * Cv + fr) * 40 + 8 * fq), acc);
                    o[Cv] = acc; }
                float rs[4];
#pragma unroll
                for (int r = 0; r < 4; ++r) { float ss = (o[0][r] * o[0][r] + o[1][r] * o[1][r]) + (o[2][r] * o[2][r] + o[3][r] * o[3][r]);
#pragma unroll
                    for (int m_ = 1; m_ < 16; m_ <<= 1) ss += __shfl_xor(ss, m_);
                    rs[r] = 1.f / sqrtf(ss * (1.f / 64.f) + RMS_EPS); }
#pragma unroll
                for (int Cv = 0; Cv < 4; ++Cv) { const int v = 16 * Cv + fr; const float gn = gla_norm_g[l * 64 + v];
#pragma unroll
                    for (int r = 0; r < 4; ++r) { const size_t m = tok0 + I0 + 4 * fq + r; const float rg = bf2f(PROJ[m * INP + C_GR + hd * 64 + v]);
                        MIX[m * DM + 512 + hd * 64 + v] = (bf16)f2bf(o[Cv][r] * rs[r] * gn * (rg / (1.f + expf(-rg)))); } } }
              __syncthreads(); }
            STAMP2(7);
#if NAIVE_ATTN
            { LAS float* Kt = (LAS float*)(lds + RING_OFF); LAS float* Vt = Kt + 64 * 64;
              for (int unit = bx; unit < NB * 8 * 8; unit += G) { const int rb = unit & 7, h = (unit >> 3) & 7, b = unit >> 6, kvh = h >> 2;
                const size_t qrow = (size_t)b * SEQ + rb * 512 + tid;
                float q[64], o[64]; float mrun = -INFINITY, lrun = 0.f;
#pragma unroll
                for (int c8 = 0; c8 < 8; ++c8) { const u16x8 f = *(const u16x8*)(QB + qrow * 512 + h * 64 + c8 * 8);
#pragma unroll
                    for (int i = 0; i < 8; ++i) { q[c8 * 8 + i] = bf2f(f[i]); o[c8 * 8 + i] = 0.f; } }
                for (int kt = 0; kt < SEQ; kt += 64) {
                    __syncthreads();
                    { const int kr = tid >> 3, c8 = (tid & 7) * 8; const size_t krow = (size_t)b * SEQ + kt + kr;
                      const u16x8 kf = *(const u16x8*)(KB + krow * 128 + kvh * 64 + c8); const u16x8 vf = *(const u16x8*)(PROJ + krow * INP + C_AV + kvh * 64 + c8);
#pragma unroll
                      for (int i = 0; i < 8; ++i) { Kt[kr * 64 + c8 + i] = bf2f(kf[i]); Vt[kr * 64 + c8 + i] = bf2f(vf[i]); } }
                    __syncthreads();
#pragma unroll 1
                    for (int j = 0; j < 64; ++j) { float a = 0.f;
#pragma unroll
                        for (int d4 = 0; d4 < 16; ++d4) { const f32x4 kv = *(const LAS f32x4*)(Kt + j * 64 + d4 * 4); a += (q[d4 * 4] * kv.x + q[d4 * 4 + 1] * kv.y) + (q[d4 * 4 + 2] * kv.z + q[d4 * 4 + 3] * kv.w); }
                        if (a > mrun) { const float al = exp2f(mrun - a); mrun = a; lrun *= al;
#pragma unroll
                            for (int d = 0; d < 64; ++d) o[d] *= al; }
                        const float p = exp2f(a - mrun); lrun += p;
#pragma unroll
                        for (int d4 = 0; d4 < 16; ++d4) { const f32x4 vv = *(const LAS f32x4*)(Vt + j * 64 + d4 * 4); o[d4 * 4] += p * vv.x; o[d4 * 4 + 1] += p * vv.y; o[d4 * 4 + 2] += p * vv.z; o[d4 * 4 + 3] += p * vv.w; } }
                }
                const float rl = 1.f / lrun;
#pragma unroll
                for (int c8 = 0; c8 < 8; ++c8) { v4u w; w.x = pk2(o[c8 * 8] * rl, o[c8 * 8 + 1] * rl); w.y = pk2(o[c8 * 8 + 2] * rl, o[c8 * 8 + 3] * rl); w.z = pk2(o[c8 * 8 + 4] * rl, o[c8 * 8 + 5] * rl); w.w = pk2(o[c8 * 8 + 6] * rl, o[c8 * 8 + 7] * rl);
                    *(v4u*)(MIX + qrow * DM + h * 64 + c8 * 8) = w; }
              }
              __syncthreads(); }
#else
            { const attn_body::AttnTensors AT{(const attn_body::bf16*)QB, (const attn_body::bf16*)KB, (const attn_body::bf16*)(PROJ + C_AV), (attn_body::bf16*)MIX};
              const attn_body::StaticOrder S(G, bx);
              attn_body::attn_phase<attn_body::StaticOrder>((char*)lds_raw + RING_OFF, AT, S); }
#endif
        }
        SEAM(pb + 3);
        if (IN(pb + 4) && PON(5)) {
            TID_SETUP(); unsigned char* ws = KWS(); const bf16* MIX = WSP(bf16, WS_MIX); const bf16* WOUT_T = WSP(bf16, WS_WOUT_T); const bf16* HB = WSP(bf16, WS_HB); bf16* T1 = WSP(bf16, WS_T1);
            pg8::Gemm g{MIX, WOUT_T + (size_t)l * DM * DM, NTOK, DM, DM}; pg8::StaticOrder S; S.init(NTOK, DM, G, bx);
            pg8::EpiResBf16 E{HB, T1, DM, DN_ALPHA};
            pg8::gemm_phase<pg8::EpiResBf16, pg8::StaticOrder, true, true>(lds + RING_OFF, g, S, E);
        }
        SEAM(pb + 4);
        if (IN(pb + 5) && PON(6)) {
            TID_SETUP(); unsigned char* ws = KWS(); gu32* ctl = (gu32*)(ws + WS_CTL); const float* ln1_g = KIN(10); const float* ln1_b = KIN(11); const float* router_w = KIN(12); const float* router_b = KIN(13);
            const bf16* T1 = WSP(bf16, WS_T1); bf16* HB = WSP(bf16, WS_HB); int* TOKE = WSP(int, WS_TOK); int* TOKS = TOKE + NTOK * 4; float* TOKW = (float*)(TOKS + NTOK * 4); int* LIST = WSP(int, WS_XS);
            LAS float* RW = (LAS float*)(lds + RING_OFF);
            { const float* rw = router_w + (size_t)l * DM * NE; for (int i = tid; i < DM * NE; i += NWAVES * 64) { const int c = i >> 5, e = i & 31; RW[e * DM + c] = rw[i]; } }
            LAS int* lcnt = (LAS int*)(lctl + LC_CNT); LAS int* lbase = (LAS int*)(lctl + LC_BASE); LAS int* sele = (LAS int*)(lctl + LC_SELE); LAS int* sels = (LAS int*)(lctl + LC_SELS);
            const float* rb = router_b + l * NE;
            for (int r0 = bx * 128; r0 < NTOK; r0 += G * 128) {
                if (tid < 32) lcnt[tid] = 0;
                __syncthreads();
                LAS float* LG = (LAS float*)(lctl + LC_LG) + wave * 512;
                f32x4 gam[4], bet[4];
#pragma unroll
                for (int j = 0; j < 4; ++j) { gam[j] = *(const f32x4*)(ln1_g + l * DM + lane * 4 + 256 * j); bet[j] = *(const f32x4*)(ln1_b + l * DM + lane * 4 + 256 * j); }
                for (int rr = 0; rr < 16; rr += 2) { const int lr = wave * 16 + rr; const size_t m = (size_t)r0 + lr; f32x4 v[2][4];
#pragma unroll
                    for (int q = 0; q < 2; ++q)
#pragma unroll
                        for (int j = 0; j < 4; ++j) { const u16x4 t_ = *(const u16x4*)(T1 + (m + q) * DM + lane * 4 + 256 * j); v[q][j] = (f32x4){bf2f(t_[0]), bf2f(t_[1]), bf2f(t_[2]), bf2f(t_[3])}; }
#pragma unroll
                    for (int q = 0; q < 2; ++q) { float s_ = 0.f;
#pragma unroll
                        for (int j = 0; j < 4; ++j) s_ += (v[q][j].x + v[q][j].y) + (v[q][j].z + v[q][j].w);
                        const float mean = wave_sum(s_) * (1.f / DM); float s2_ = 0.f;
#pragma unroll
                        for (int j = 0; j < 4; ++j) { v[q][j] = v[q][j] - mean; s2_ += (v[q][j].x * v[q][j].x + v[q][j].y * v[q][j].y) + (v[q][j].z * v[q][j].z + v[q][j].w * v[q][j].w); }
                        const float rstd = 1.f / sqrtf(wave_sum(s2_) * (1.f / DM) + LN_EPS);
#pragma unroll
                        for (int j = 0; j < 4; ++j) { v[q][j] = v[q][j] * rstd * gam[j] + bet[j];
                            *(unsigned long long*)(HB + (m + q) * DM + lane * 4 + 256 * j) = (unsigned long long)pk2(v[q][j].x, v[q][j].y) | ((unsigned long long)pk2(v[q][j].z, v[q][j].w) << 32); } }
                    float a0[32], a1[32];
#pragma unroll
                    for (int e = 0; e < 32; ++e) { f32x2_t s0 = {0.f, 0.f}, s1 = {0.f, 0.f};
#pragma unroll
                        for (int j = 0; j < 4; ++j) { const f32x4 w = *(const LAS f32x4*)(RW + e * DM + lane * 4 + 256 * j); const f32x2_t wl = {w.x, w.y}, wh = {w.z, w.w};
                            s0 += (f32x2_t){v[0][j].x, v[0][j].y} * wl; s0 += (f32x2_t){v[0][j].z, v[0][j].w} * wh; s1 += (f32x2_t){v[1][j].x, v[1][j].y} * wl; s1 += (f32x2_t){v[1][j].z, v[1][j].w} * wh; }
                        a0[e] = s0.x + s0.y; a1[e] = s1.x + s1.y; }
#define TRSTEP(SRC, DST, N, MASK) _Pragma("unroll") for (int e = 0; e < (N); ++e) { const bool hi_ = (lane & (MASK)) != 0; const float keep = hi_ ? SRC[e + (N)] : SRC[e], send = hi_ ? SRC[e] : SRC[e + (N)]; DST[e] = keep + __shfl_xor(send, (MASK)); }
                    float t0, t1;
                    { float b_[16], c_[8], d_[4], e_[2], f_[1]; TRSTEP(a0, b_, 16, 32) TRSTEP(b_, c_, 8, 16) TRSTEP(c_, d_, 4, 8) TRSTEP(d_, e_, 2, 4) TRSTEP(e_, f_, 1, 2) t0 = f_[0] + __shfl_xor(f_[0], 1); }
                    { float b_[16], c_[8], d_[4], e_[2], f_[1]; TRSTEP(a1, b_, 16, 32) TRSTEP(b_, c_, 8, 16) TRSTEP(c_, d_, 4, 8) TRSTEP(d_, e_, 2, 4) TRSTEP(e_, f_, 1, 2) t1 = f_[0] + __shfl_xor(f_[0], 1); }
#undef TRSTEP
                    { const int E = (lane >> 1) & 31; const float bias = rb[E]; if ((lane & 1) == 0) { LG[rr * 32 + E] = t0 + bias; LG[(rr + 1) * 32 + E] = t1 + bias; } }
                }
                asm volatile("s_waitcnt lgkmcnt(0)" ::: "memory");
                if (lane < 16) { const int lr = wave * 16 + lane; const size_t m = (size_t)r0 + lr; float lg[32];
#pragma unroll
                    for (int e4 = 0; e4 < 8; ++e4) { const f32x4 x = *(const LAS f32x4*)(LG + lane * 32 + e4 * 4); lg[e4 * 4] = x.x; lg[e4 * 4 + 1] = x.y; lg[e4 * 4 + 2] = x.z; lg[e4 * 4 + 3] = x.w; }
                    int se[4]; float sv[4];
#pragma unroll
                    for (int k = 0; k < 4; ++k) { float best = -INFINITY; int bi = 0;
#pragma unroll
                        for (int e = 0; e < 32; ++e) { if (lg[e] > best) { best = lg[e]; bi = e; } }
                        se[k] = bi; sv[k] = best;
#pragma unroll
                        for (int e = 0; e < 32; ++e) if (e == bi) lg[e] = -INFINITY; }
                    const float e1 = expf(sv[1] - sv[0]), e2 = expf(sv[2] - sv[0]), e3 = expf(sv[3] - sv[0]); const float inv = 1.f / (1.f + e1 + e2 + e3);
                    const float wts[4] = {inv, e1 * inv, e2 * inv, e3 * inv};
#pragma unroll
                    for (int k = 0; k < 4; ++k) { const int ls = __hip_atomic_fetch_add(lcnt + se[k], 1, __ATOMIC_RELAXED, __HIP_MEMORY_SCOPE_WORKGROUP); sele[lr * 4 + k] = se[k]; sels[lr * 4 + k] = ls; TOKW[m * 4 + k] = wts[k]; } }
                __syncthreads();
                if (tid < 32) lbase[tid] = (int)__hip_atomic_fetch_add(ctl + CW_CNT + l * 32 + tid, (unsigned)lcnt[tid], RLX_AGENT);
                __syncthreads();
                { const int e = sele[tid], sl = lbase[e] + sels[tid]; TOKE[(size_t)r0 * 4 + tid] = e; TOKS[(size_t)r0 * 4 + tid] = sl; LIST[(size_t)e * NTOK + sl] = r0 + (tid >> 2); }
                __syncthreads();
            }
        }
        SEAM(pb + 5);
#if defined(EXP_P1_NOEPI)
        if (IN(pb + 6)) {
            TID_SETUP(); unsigned char* ws = KWS(); bf16* HB = WSP(bf16, WS_HB); bf16* WIN_T = WSP(bf16, WS_WIN_T); bf16* PROJ = WSP(bf16, WS_PROJ);
            pg8::Gemm g{HB, WIN_T + (size_t)l * INP * DM, NTOK, INP, DM}; pg8::StaticOrder S; S.init(NTOK, INP, G, bx);
            pg8::EpiNull EN{PROJ}; pg8::gemm_phase<pg8::EpiNull, pg8::StaticOrder, true, true>(lds + RING_OFF, g, S, EN);
            __syncthreads(); }
#endif
        STAMP(pb + 7);
        if (IN(pb + 7) || IN(pb + 8) || IN(pb + 9)) {
            LAS int* pst = (LAS int*)(lctl + LC_PSTART); LAS int* ecnt = (LAS int*)(lctl + LC_BASE); gu32* ctl = (gu32*)(KWS() + WS_CTL);
            __syncthreads();
            if (threadIdx.x == 0) { int acc = 0; for (int e = 0; e < NE; ++e) { pst[e] = acc; const int c = (int)__hip_atomic_load(ctl + CW_CNT + l * 32 + e, RLX_AGENT); ecnt[e] = c; acc += (c + 255) >> 8; } pst[NE] = acc; }
            __syncthreads();
        }
        if (IN(pb + 7) && PON(8)) {
            TID_SETUP(); unsigned char* ws = KWS(); const float* exp_b_gu = KIN(15); const bf16* HB = WSP(bf16, WS_HB); const int* LIST = WSP(int, WS_XS); const bf16* WGU_T = WSP(bf16, WS_WGU_T); bf16* HID = WSP(bf16, WS_HID);
            const LAS int* pst = (const LAS int*)(lctl + LC_PSTART); LAS int* ul = (LAS int*)(lctl + LC_ULIST);
            const int nM = pst[NE], nN = 8, nwg = nM * nN;
            if (tid < 64) { const long L = (long)tid * G + bx; int v = -1;
                if (L < nwg) { int wgid = (int)L; { const int q = nwg / 8, r = nwg % 8, xcd = wgid % 8, off = wgid / 8; wgid = (xcd < r ? xcd * (q + 1) : r * (q + 1) + (xcd - r) * q) + off; }
                    const int nig = 8 * nN, gid = wgid / nig, fm = gid * 8, gsz = (nM - fm) < 8 ? (nM - fm) : 8; const int pm = fm + ((wgid % nig) % gsz), pn = (wgid % nig) / gsz;
                    int e = 0; for (int k = 1; k < NE; ++k) if (pst[k] <= pm) e = k;
                    v = (pm << 16) | (e * nN + pn); }
                ul[tid] = v; }
            __syncthreads();
            const int nunits = bx < nwg ? (nwg - bx + G - 1) / G : 0;
            LAS unsigned short* rows16 = (LAS unsigned short*)(lctl + LC_ROWS); const LAS int* ecnt = (const LAS int*)(lctl + LC_BASE);
            for (int sl = 0; sl < nunits; ++sl) { const int v = ul[sl]; const int pm = v >> 16, e = (v & 0xffff) >> 3, pl = pm - pst[e];
                if (tid < 256) { const int idx = pl * 256 + tid; rows16[sl * 256 + tid] = (idx < ecnt[e]) ? (unsigned short)LIST[(size_t)e * NTOK + idx] : (unsigned short)0; } }
            __syncthreads();
            pg8::Gemm g{HB, WGU_T + (size_t)l * NE * 2048 * DM, NTOK, NE * 2048, DM}; pg8::ListOrder S{ul, nunits};
            pg8::EpiSwiglu E{HID, exp_b_gu + (size_t)l * NE * 2048};
            pg8::gemm_phase_gather<pg8::EpiSwiglu, pg8::ListOrder, true>(lds + RING_OFF, g, S, E, rows16);
        }
        SEAM(pb + 7);
        if (IN(pb + 8) && PON(9)) {
            TID_SETUP(); unsigned char* ws = KWS(); const float* exp_b_down = KIN(17); const bf16* HID = WSP(bf16, WS_HID); const bf16* WDN_T = WSP(bf16, WS_WDN_T); bf16* YS = WSP(bf16, WS_YS);
            const LAS int* pst = (const LAS int*)(lctl + LC_PSTART); LAS int* ul = (LAS int*)(lctl + LC_ULIST);
            const int nM = pst[NE], nN = 4, nwg = nM * nN;
            __syncthreads();
            if (tid < 64) { const long L = (long)tid * G + bx; int v = -1;
                if (L < nwg) { int wgid = (int)L; { const int q = nwg / 8, r = nwg % 8, xcd = wgid % 8, off = wgid / 8; wgid = (xcd < r ? xcd * (q + 1) : r * (q + 1) + (xcd - r) * q) + off; }
                    const int nig = 8 * nN, gid = wgid / nig, fm = gid * 8, gsz = (nM - fm) < 8 ? (nM - fm) : 8; const int pm = fm + ((wgid % nig) % gsz), pn = (wgid % nig) / gsz;
                    int e = 0; for (int k = 1; k < NE; ++k) if (pst[k] <= pm) e = k;
                    v = (pm << 16) | (e * nN + pn); }
                ul[tid] = v; }
            __syncthreads();
            const int nunits = bx < nwg ? (nwg - bx + G - 1) / G : 0;
            pg8::Gemm g{HID, WDN_T + (size_t)l * NE * DM * DE, MPAD, NE * DM, DE}; pg8::ListOrder S{ul, nunits};
            pg8::EpiDown E{YS, exp_b_down + (size_t)l * NE * DM};
            pg8::gemm_phase<pg8::EpiDown, pg8::ListOrder, true, true>(lds + RING_OFF, g, S, E);
        }
        SEAM(pb + 8);
        if (IN(pb + 9) && PON(10)) {
            TID_SETUP(); unsigned char* ws = KWS(); const float* ln2_g = KIN(18); const float* ln2_b = KIN(19); float* out = KOUT(); bf16* HB = WSP(bf16, WS_HB);
            const bf16* YS = WSP(bf16, WS_YS); const int* TOKE = WSP(int, WS_TOK); const int* TOKS = TOKE + NTOK * 4; const float* TOKW = (const float*)(TOKS + NTOK * 4); const LAS int* pst = (const LAS int*)(lctl + LC_PSTART);
            const bool lastl = (l == NL - 1);
            for (int m0 = gw; m0 < NTOK; m0 += 2 * NGW) { f32x4 v[2][4]; const bf16* yr[2][4]; float wk[2][4];
#pragma unroll
                for (int q = 0; q < 2; ++q) { const int m = m0 + q * NGW;
#pragma unroll
                    for (int k = 0; k < 4; ++k) { wk[q][k] = TOKW[m * 4 + k]; yr[q][k] = YS + (size_t)(pst[TOKE[m * 4 + k]] * 256 + TOKS[m * 4 + k]) * DM; }
#pragma unroll
                    for (int j = 0; j < 4; ++j) { const u16x4 t_ = *(const u16x4*)(HB + (size_t)m * DM + lane * 4 + 256 * j); v[q][j] = (f32x4){bf2f(t_[0]), bf2f(t_[1]), bf2f(t_[2]), bf2f(t_[3])} * DN_ALPHA; } }
#pragma unroll
                for (int q = 0; q < 2; ++q)
#pragma unroll
                    for (int k = 0; k < 4; ++k)
#pragma unroll
                        for (int j = 0; j < 4; ++j) { const u16x4 y = *(const u16x4*)(yr[q][k] + lane * 4 + 256 * j); const float w = wk[q][k]; v[q][j].x += w * bf2f(y[0]); v[q][j].y += w * bf2f(y[1]); v[q][j].z += w * bf2f(y[2]); v[q][j].w += w * bf2f(y[3]); }
#pragma unroll
                for (int q = 0; q < 2; ++q) { const int m = m0 + q * NGW;
                    ln_row(v[q], ln2_g + l * DM, ln2_b + l * DM, lastl ? out + (size_t)m * DM : nullptr, lastl ? nullptr : HB + (size_t)m * DM, lane); } }
        }
        SEAM(pb + 9);
    }
#if PROBE_A >= 0
    { xcd_barrier(bar);
      const unsigned long long* st = (const unsigned long long*)(KWS() + WS_CTL + 65536); unsigned long long T = 0;
      if (PROBE_A & 1) T += st[1] - st[0];
      for (int l = 0; l < NL; ++l) for (int j = 1; j <= 10; ++j) if ((PROBE_A >> j) & 1) T += st[1 + 10 * l + j] - st[10 * l + j];
      if (PROBE_SUB_A >= 0) for (int l = 0; l < NL; ++l) T += st[128 + l * 16 + PROBE_SUB_B] - st[128 + l * 16 + PROBE_SUB_A];
      T *= 4ull; if (T > 5000000ull) T = 5000000ull;
      const unsigned long long t0 = __builtin_amdgcn_s_memrealtime();
      while (__builtin_amdgcn_s_memrealtime() - t0 < T) __builtin_amdgcn_s_sleep(16); }
#endif
#undef IN
#undef SEAM
}

#ifndef MK_PER_PHASE
#define MK_PER_PHASE 0
#endif
extern "C" void kernel_launch(void* const* d_in, const int* in_sizes, int n_in, void* d_out, int out_size, void* d_ws, size_t ws_size, hipStream_t stream) {
    static int grid = 0;
    if (grid == 0) {
        if (n_in != 20 || in_sizes[0] != NTOK * DM || out_size != NTOK * DM || ws_size < WS_END) { fprintf(stderr, "kernel_launch: unexpected shapes (n_in %d, in0 %d, out %d, ws %zu); nothing launched\n", n_in, n_in > 0 ? in_sizes[0] : -1, out_size, ws_size); grid = -1; return; }
        int dev = 0, cus = 0, per_cu = 0;
        if (hipGetDevice(&dev) != hipSuccess || hipDeviceGetAttribute(&cus, hipDeviceAttributeMultiprocessorCount, dev) != hipSuccess) { grid = -1; return; }
        if (hipFuncSetAttribute((const void*)fwd, hipFuncAttributeMaxDynamicSharedMemorySize, LDS_BYTES) != hipSuccess) { fprintf(stderr, "kernel_launch: hipFuncSetAttribute failed\n"); grid = -1; return; }
        if (hipOccupancyMaxActiveBlocksPerMultiprocessor(&per_cu, (const void*)fwd, NWAVES * 64, LDS_BYTES) != hipSuccess || per_cu < 1) fprintf(stderr, "kernel_launch: occupancy query reports %d\n", per_cu);
        (void)hipGetLastError();
        grid = cus;
    }
    if (grid < 0) return;
    if (hipMemsetAsync((char*)d_ws + WS_CTL, 0, CTL_ZERO_BYTES, stream) != hipSuccess) return;
    Args a{};
    for (int i = 0; i < 20; ++i) a.in[i] = (const float*)d_in[i];
    a.out = (float*)d_out; a.ws = (unsigned char*)d_ws;
#if MK_PER_PHASE
    for (int p = 0; p < N_PHASES; ++p) { a.ph_lo = p; a.ph_hi = p + 1; hipLaunchKernelGGL(fwd, dim3(grid), dim3(NWAVES * 64), LDS_BYTES, stream, a); }
#else
    a.ph_lo = 0; a.ph_hi = N_PHASES;
    hipLaunchKernelGGL(fwd, dim3(grid), dim3(NWAVES * 64), LDS_BYTES, stream, a);
#endif
    const hipError_t le = hipPeekAtLastError();
    if (le != hipSuccess) fprintf(stderr, "kernel_launch: launch failed: %s\n", hipGetErrorName(le));
}
```

```cpp
#include <hip/hip_runtime.h>
#include <hip/hip_bf16.h>
#include <cstdio>
#include <cstdint>
#include <cmath>
namespace pg8 {
#define PG8_LAS __attribute__((address_space(3)))
typedef unsigned short bf16_t;
typedef short bf16x8 __attribute__((ext_vector_type(8)));
typedef float f32x4 __attribute__((ext_vector_type(4)));
typedef unsigned u32x4 __attribute__((ext_vector_type(4)));
constexpr int BM = 256, BK = 64, HALF = 128, HTB = HALF * BK * 2  , STAGE_BYTES = 8 * HTB, NXCD = 8, WGM = 8;

__host__ __device__ __forceinline__ int lds_byte(int r, int c) { const int st = (r >> 4) * 2 + (c >> 5), rr = r & 15, cc = c & 31, ob = rr * 64 + cc * 2; return st * 1024 + (ob ^ (((ob >> 9) & 1) << 5)); }
__host__ __device__ __forceinline__ void stage_rc(int b, int& R, int& C) { const int st = b / 1024, sb = b % 1024, swz = sb ^ (((sb >> 9) & 1) << 5); R = (st >> 1) * 16 + swz / 64; C = (st & 1) * 32 + (swz % 64) / 2; }
__host__ __device__ __forceinline__ int perm32(int rho) { const int n = rho >> 4, i = rho & 15; return 8 * (i >> 2) + 4 * n + (i & 3); }

struct Unit { int pm, pn; };
struct Gemm { const bf16_t* A; const bf16_t* Bt; int M, N, K; };

struct StaticOrder {
    int nM, nN, nwg, G, c;
    __host__ __device__ void init(int M, int N, int G_, int c_) { nM = M / BM; nN = N / BM; nwg = nM * nN; G = G_; c = c_; }
    __host__ __device__ bool next(int i, Unit& u) const {
        const long L = (long)i * G + c; if (L >= nwg) return false;
        int wgid = (int)L; { const int q = nwg / NXCD, r = nwg % NXCD, xcd = wgid % NXCD, off = wgid / NXCD; wgid = (xcd < r ? xcd * (q + 1) : r * (q + 1) + (xcd - r) * q) + off; }
        const int nig = WGM * nN, gid = wgid / nig, fm = gid * WGM, gsz = (nM - fm) < WGM ? (nM - fm) : WGM;
        u.pm = fm + ((wgid % nig) % gsz); u.pn = (wgid % nig) / gsz; return true;
    }
    __device__ __forceinline__ void a_ready(const Unit&) const {}
    __device__ __forceinline__ void done(const Unit&) const {}
};

__device__ __forceinline__ unsigned cvt_pk_bf16(float lo, float hi) { unsigned r; asm volatile("v_cvt_pk_bf16_f32 %0, %1, %2" : "=v"(r) : "v"(lo), "v"(hi)); return r; }
typedef float f32x2 __attribute__((ext_vector_type(2)));
__device__ __forceinline__ u32x4 pack8(const f32x4 v0, const f32x4 v1) { u32x4 w; w.x = cvt_pk_bf16(v0[0], v0[1]); w.y = cvt_pk_bf16(v0[2], v0[3]); w.z = cvt_pk_bf16(v1[0], v1[1]); w.w = cvt_pk_bf16(v1[2], v1[3]); return w; }

struct EpiPlainBf16 {
    static constexpr bool PERM = true, AFTER_DRAIN = false;
    bf16_t* O; int ldc;
    __device__ __forceinline__ void operator()(const f32x4 (&acc)[2][2][4][2], const Unit& u, int wr, int wc, int fr, int fq) const {
        const int row0 = u.pm * BM + wr * 64 + fr, col0 = u.pn * BM + wc * 32 + 8 * fq;
#pragma unroll
        for (int ai = 0; ai < 2; ++ai)
#pragma unroll
            for (int m = 0; m < 4; ++m) { bf16_t* rowp = O + (size_t)(row0 + ai * HALF + m * 16) * ldc + col0;
#pragma unroll
                for (int bj = 0; bj < 2; ++bj) *(u32x4*)(rowp + bj * HALF) = pack8(acc[ai][bj][m][0], acc[ai][bj][m][1]); }
    }
};
struct EpiFnet {
    static constexpr bool PERM = true, AFTER_DRAIN = false;
    bf16_t* MIX;
    __device__ __forceinline__ void operator()(const f32x4 (&acc)[2][2][4][2], const Unit& u, int wr, int wc, int fr, int fq) const {
        const int row0 = u.pn * 4096 + u.pm * BM + wr * 64 + fr, col0 = 768 + wc * 32 + 8 * fq;
#pragma unroll
        for (int ai = 0; ai < 2; ++ai)
#pragma unroll
            for (int m = 0; m < 4; ++m) { bf16_t* rowp = MIX + (size_t)(row0 + ai * HALF + m * 16) * 1024 + col0;
#pragma unroll
                for (int bj = 0; bj < 2; ++bj) *(u32x4*)(rowp + bj * HALF) = pack8(acc[ai][bj][m][0], acc[ai][bj][m][1]); }
    }
};
struct EpiResF32 {
    static constexpr bool PERM = false, AFTER_DRAIN = false;
    const float* base; float* out; int ldc; float alpha;
    __device__ __forceinline__ void operator()(const f32x4 (&acc)[2][2][4][2], const Unit& u, int wr, int wc, int fr, int fq) const {
        const int row0 = u.pm * BM + wr * 64 + fr, col0 = u.pn * BM + wc * 32 + 4 * fq;
#pragma unroll
        for (int ai = 0; ai < 2; ++ai)
#pragma unroll
            for (int m = 0; m < 4; ++m) { const size_t off = (size_t)(row0 + ai * HALF + m * 16) * ldc + col0;
#pragma unroll
                for (int bj = 0; bj < 2; ++bj)
#pragma unroll
                    for (int n = 0; n < 2; ++n) { const f32x4 b = *(const f32x4*)(base + off + bj * HALF + n * 16); *(f32x4*)(out + off + bj * HALF + n * 16) = b * alpha + acc[ai][bj][m][n]; } }
    }
};
struct EpiResBf16 {
    static constexpr bool PERM = true, AFTER_DRAIN = false;
    const bf16_t* base; bf16_t* out; int ldc; float alpha;
    __device__ __forceinline__ void operator()(const f32x4 (&acc)[2][2][4][2], const Unit& u, int wr, int wc, int fr, int fq) const {
        const int row0 = u.pm * BM + wr * 64 + fr, col0 = u.pn * BM + wc * 32 + 8 * fq;
#pragma unroll
        for (int ai = 0; ai < 2; ++ai)
#pragma unroll
            for (int m = 0; m < 4; ++m) { const size_t off = (size_t)(row0 + ai * HALF + m * 16) * ldc + col0;
#pragma unroll
                for (int bj = 0; bj < 2; ++bj) { const u32x4 b = *(const u32x4*)(base + off + bj * HALF);
                    const f32x4 b0 = {__uint_as_float(b.x << 16), __uint_as_float(b.x & 0xffff0000u), __uint_as_float(b.y << 16), __uint_as_float(b.y & 0xffff0000u)};
                    const f32x4 b1 = {__uint_as_float(b.z << 16), __uint_as_float(b.z & 0xffff0000u), __uint_as_float(b.w << 16), __uint_as_float(b.w & 0xffff0000u)};
                    *(u32x4*)(out + off + bj * HALF) = pack8(b0 * alpha + acc[ai][bj][m][0], b1 * alpha + acc[ai][bj][m][1]); } }
    }
};
__device__ __forceinline__ float swiglu1(float g, float u) { g = fminf(g, 7.0f); u = fminf(fmaxf(u, -7.0f), 7.0f); return (u + 1.0f) * g * __builtin_amdgcn_rcpf(1.0f + __expf(-1.702f * g)); }
struct EpiSwiglu {
    static constexpr bool PERM = true, AFTER_DRAIN = false;
    bf16_t* HID; const float* bgu;
    __device__ __forceinline__ void operator()(const f32x4 (&acc)[2][2][4][2], const Unit& u, int wr, int wc, int fr, int fq) const {
        const int e = u.pn >> 3, pnl = u.pn & 7; const int row0 = u.pm * BM + wr * 64 + fr, jj0 = pnl * 128 + wc * 32 + 8 * fq;
        const float* bg = bgu + (size_t)e * 2048 + jj0;
        const f32x4 bg0 = *(const f32x4*)bg, bg1 = *(const f32x4*)(bg + 4), bu0 = *(const f32x4*)(bg + 1024), bu1 = *(const f32x4*)(bg + 1028);
#pragma unroll
        for (int ai = 0; ai < 2; ++ai)
#pragma unroll
            for (int m = 0; m < 4; ++m) { bf16_t* rowp = HID + (size_t)(row0 + ai * HALF + m * 16) * 1024 + jj0;
                const f32x4 g0 = acc[ai][0][m][0] + bg0, g1 = acc[ai][0][m][1] + bg1, u0 = acc[ai][1][m][0] + bu0, u1 = acc[ai][1][m][1] + bu1;
                f32x4 h0, h1;
#pragma unroll
                for (int i = 0; i < 4; ++i) { h0[i] = swiglu1(g0[i], u0[i]); h1[i] = swiglu1(g1[i], u1[i]); }
                *(u32x4*)rowp = pack8(h0, h1); }
    }
};
struct EpiDown {
    static constexpr bool PERM = true, AFTER_DRAIN = false;
    bf16_t* Y; const float* bd;
    __device__ __forceinline__ void operator()(const f32x4 (&acc)[2][2][4][2], const Unit& u, int wr, int wc, int fr, int fq) const {
        const int e = u.pn >> 2, pnl = u.pn & 3; const int row0 = u.pm * BM + wr * 64 + fr, col0 = pnl * BM + wc * 32 + 8 * fq;
        const float* bp = bd + (size_t)e * 1024 + col0;
        f32x4 bv[2][2];
#pragma unroll
        for (int bj = 0; bj < 2; ++bj)
#pragma unroll
            for (int n = 0; n < 2; ++n) bv[bj][n] = *(const f32x4*)(bp + bj * HALF + 4 * n);
#pragma unroll
        for (int ai = 0; ai < 2; ++ai)
#pragma unroll
            for (int m = 0; m < 4; ++m) { bf16_t* rowp = Y + (size_t)(row0 + ai * HALF + m * 16) * 1024 + col0;
#pragma unroll
                for (int bj = 0; bj < 2; ++bj) *(u32x4*)(rowp + bj * HALF) = pack8(acc[ai][bj][m][0] + bv[bj][0], acc[ai][bj][m][1] + bv[bj][1]); }
    }
};
struct EpiNull {
    static constexpr bool PERM = true, AFTER_DRAIN = false;
    bf16_t* O;
    __device__ __forceinline__ void operator()(const f32x4 (&acc)[2][2][4][2], const Unit& u, int wr, int wc, int fr, int fq) const {
#pragma unroll
        for (int ai = 0; ai < 2; ++ai)
#pragma unroll
            for (int bj = 0; bj < 2; ++bj)
#pragma unroll
                for (int m = 0; m < 4; ++m)
#pragma unroll
                    for (int n = 0; n < 2; ++n) asm volatile("" :: "v"(acc[ai][bj][m][n]));
    }
};
struct ListOrder {
    const PG8_LAS int* list; int n;
    __device__ __forceinline__ bool next(int i, Unit& u) const { if (i >= n) return false; const int v = __builtin_amdgcn_readfirstlane(list[i]); u.pm = v >> 16; u.pn = v & 0xffff; return true; }
    __device__ __forceinline__ void a_ready(const Unit&) const {}
    __device__ __forceinline__ void done(const Unit&) const {}
};
template <class Epi, class Sched, bool ALIGN_EPI = false, bool SP2 = false>
__device__ __forceinline__ void gemm_phase(PG8_LAS unsigned char* lds, const Gemm g, const Sched& S, const Epi& E) {
    int tid_ = threadIdx.x; asm volatile("" : "+v"(tid_));
    const int tid = tid_, wid = __builtin_amdgcn_readfirstlane(tid >> 6), lane = tid & 63, wr = wid >> 2, wc = wid & 3, fr = lane & 15, fq = lane >> 4;
    const int K = g.K, nt = K / BK;
    unsigned voffA[2], voffB[2];
#pragma unroll
    for (int i = 0; i < 2; ++i) { int R, C; stage_rc(tid * 16 + i * 8192, R, C); const int Rb = Epi::PERM ? ((R & ~31) + perm32(R & 31)) : R;
        voffA[i] = (unsigned)(R * K + C) * 2u; voffB[i] = (unsigned)(Rb * K + C) * 2u; }
    const size_t kstep = (size_t)(BK * 2);
    const size_t hstep = (size_t)HALF * K * 2;
    const size_t tstep = 2 * hstep;
    const unsigned ldsw = (unsigned)wid * 1024u;
    const int aoff = lds_byte(wr * 64 + fr, fq * 8), boff = lds_byte(wc * 32 + fr, fq * 8);
#define PG8_SA(b, h) (((b) * 2 + (h)) * HTB)
#define PG8_SB(b, h) ((4 + (b) * 2 + (h)) * HTB)
#define PG8_STAGE(bufoff, gbase, voff) do { _Pragma("unroll") for (int _i = 0; _i < 2; ++_i) \
        __builtin_amdgcn_global_load_lds((const unsigned*)((const char*)(gbase) + (voff)[_i]), (PG8_LAS unsigned*)(lds + (bufoff) + ldsw + _i * 8192), 16, 0, 0); } while (0)
#define PG8_LDA(dst, b, h) do { _Pragma("unroll") for (int m = 0; m < 4; ++m) _Pragma("unroll") for (int k = 0; k < 2; ++k) dst[m][k] = *(const PG8_LAS bf16x8*)(lds + PG8_SA(b, h) + aoff + m * 2048 + k * 1024); } while (0)
#define PG8_LDB(dst, b, h) do { _Pragma("unroll") for (int n = 0; n < 2; ++n) _Pragma("unroll") for (int k = 0; k < 2; ++k) dst[n][k] = *(const PG8_LAS bf16x8*)(lds + PG8_SB(b, h) + boff + n * 2048 + k * 1024); } while (0)
#define PG8_MMA(ai, bj, At, Bt) do { __builtin_amdgcn_s_setprio(1); _Pragma("unroll") for (int m = 0; m < 4; ++m) _Pragma("unroll") for (int n = 0; n < 2; ++n) _Pragma("unroll") for (int k = 0; k < 2; ++k) \
        acc[ai][bj][m][n] = __builtin_amdgcn_mfma_f32_16x16x32_bf16(Bt[n][k], At[m][k], acc[ai][bj][m][n], 0, 0, 0); __builtin_amdgcn_s_setprio(0); } while (0)
#define PG8_WAIT_V(n) asm volatile("s_waitcnt vmcnt(" #n ")" ::: "memory")
#define PG8_WAIT_L(n) asm volatile("s_waitcnt lgkmcnt(" #n ")" ::: "memory")
#define PG8_BAR __builtin_amdgcn_s_barrier()
#define PG8_SCHED __builtin_amdgcn_sched_barrier(0)
    Unit cur, nxt; int ui = 0;
    if (!S.next(0, cur)) return;
    f32x4 acc[2][2][4][2];
#pragma unroll
    for (int a = 0; a < 2; ++a)
#pragma unroll
        for (int b = 0; b < 2; ++b)
#pragma unroll
            for (int m = 0; m < 4; ++m)
#pragma unroll
                for (int n = 0; n < 2; ++n) acc[a][b][m][n] = (f32x4){0.f, 0.f, 0.f, 0.f};
    bf16x8 At[4][2], B0[2][2], B1[2][2];
    const char* cA = (const char*)g.A + (size_t)cur.pm * tstep; const char* cB = (const char*)g.Bt + (size_t)cur.pn * tstep;
    S.a_ready(cur);
    if constexpr (SP2) {
        PG8_STAGE(PG8_SB(0, 0), cB, voffB); PG8_STAGE(PG8_SB(0, 1), cB + hstep, voffB); PG8_STAGE(PG8_SA(0, 0), cA, voffA); PG8_STAGE(PG8_SA(0, 1), cA + hstep, voffA);
        if (wr == 1) PG8_BAR;
        PG8_WAIT_V(2); PG8_BAR;
        PG8_STAGE(PG8_SB(1, 0), cB + kstep, voffB); PG8_STAGE(PG8_SA(1, 0), cA + kstep, voffA); PG8_STAGE(PG8_SB(1, 1), cB + hstep + kstep, voffB);
        PG8_WAIT_V(6); PG8_BAR;
    } else {
        PG8_STAGE(PG8_SB(0, 0), cB, voffB); PG8_STAGE(PG8_SA(0, 0), cA, voffA); PG8_STAGE(PG8_SB(0, 1), cB + hstep, voffB); PG8_STAGE(PG8_SA(0, 1), cA + hstep, voffA);
        if (wr == 1) PG8_BAR;
        PG8_WAIT_V(4); PG8_BAR;
        PG8_STAGE(PG8_SB(1, 0), cB + kstep, voffB); PG8_STAGE(PG8_SA(1, 0), cA + kstep, voffA); PG8_STAGE(PG8_SB(1, 1), cB + hstep + kstep, voffB);
        PG8_WAIT_V(6); PG8_BAR;
    }
    for (;;) {
        const bool has_next = S.next(ui + 1, nxt);
        const char* nA = has_next ? (const char*)g.A + (size_t)nxt.pm * tstep : cA; const char* nB = has_next ? (const char*)g.Bt + (size_t)nxt.pn * tstep : cB;
        for (int t = 0; t < nt; t += 2) {
            const bool last = (t == nt - 2);
            const char* a1 = cA + (size_t)(t + 1) * kstep;
            const char* a2 = last ? nA : cA + (size_t)(t + 2) * kstep; const char* b2 = last ? nB : cB + (size_t)(t + 2) * kstep;
            const char* a3 = a2 + kstep; const char* b3 = b2 + kstep;
            if (last && has_next) S.a_ready(nxt);
            if constexpr (SP2) {
            PG8_LDB(B0, 0, 0); PG8_LDB(B1, 0, 1); PG8_SCHED; PG8_LDA(At, 0, 0); PG8_STAGE(PG8_SA(1, 1), a1 + hstep, voffA);
            PG8_WAIT_V(8); PG8_WAIT_L(0); PG8_BAR; PG8_MMA(0, 0, At, B0); PG8_MMA(0, 1, At, B1); PG8_BAR; PG8_SCHED;
            PG8_LDA(At, 0, 1); PG8_STAGE(PG8_SB(0, 0), b2, voffB); PG8_STAGE(PG8_SB(0, 1), b2 + hstep, voffB); PG8_STAGE(PG8_SA(0, 0), a2, voffA);
            PG8_WAIT_V(8); PG8_WAIT_L(0); PG8_BAR; PG8_MMA(1, 0, At, B0); PG8_MMA(1, 1, At, B1); PG8_BAR; PG8_SCHED;
            PG8_LDB(B0, 1, 0); PG8_LDB(B1, 1, 1); PG8_SCHED; PG8_LDA(At, 1, 0); PG8_STAGE(PG8_SA(0, 1), a2 + hstep, voffA);
            PG8_WAIT_V(8); PG8_WAIT_L(0); PG8_BAR; PG8_MMA(0, 0, At, B0); PG8_MMA(0, 1, At, B1); PG8_BAR; PG8_SCHED;
            PG8_LDA(At, 1, 1); PG8_STAGE(PG8_SB(1, 0), b3, voffB); PG8_STAGE(PG8_SB(1, 1), b3 + hstep, voffB); PG8_STAGE(PG8_SA(1, 0), a3, voffA);
            PG8_WAIT_V(8); PG8_WAIT_L(0); PG8_BAR; PG8_MMA(1, 0, At, B0); PG8_MMA(1, 1, At, B1); PG8_BAR; PG8_SCHED;
            } else {
            PG8_LDB(B0, 0, 0); PG8_SCHED; PG8_LDA(At, 0, 0); PG8_STAGE(PG8_SA(1, 1), a1 + hstep, voffA);
            PG8_WAIT_L(8); PG8_BAR; PG8_WAIT_L(0); PG8_MMA(0, 0, At, B0); PG8_BAR; PG8_SCHED;
            PG8_LDB(B1, 0, 1); PG8_STAGE(PG8_SB(0, 0), b2, voffB);
            PG8_BAR; PG8_WAIT_L(0); PG8_MMA(0, 1, At, B1); PG8_BAR;
            PG8_LDA(At, 0, 1); PG8_STAGE(PG8_SA(0, 0), a2, voffA);
            PG8_BAR; PG8_WAIT_L(0); PG8_MMA(1, 0, At, B0); PG8_BAR; PG8_SCHED;
            PG8_STAGE(PG8_SB(0, 1), b2 + hstep, voffB);
            PG8_WAIT_V(6); PG8_BAR; PG8_MMA(1, 1, At, B1); PG8_BAR;
            PG8_LDB(B0, 1, 0); PG8_SCHED; PG8_LDA(At, 1, 0); PG8_STAGE(PG8_SA(0, 1), a2 + hstep, voffA);
            PG8_WAIT_L(8); PG8_BAR; PG8_WAIT_L(0); PG8_MMA(0, 0, At, B0); PG8_BAR; PG8_SCHED;
            PG8_LDB(B1, 1, 1); PG8_STAGE(PG8_SB(1, 0), b3, voffB);
            PG8_BAR; PG8_WAIT_L(0); PG8_MMA(0, 1, At, B1); PG8_BAR;
            PG8_LDA(At, 1, 1); PG8_STAGE(PG8_SA(1, 0), a3, voffA);
            PG8_BAR; PG8_WAIT_L(0); PG8_MMA(1, 0, At, B0); PG8_BAR; PG8_SCHED;
            PG8_STAGE(PG8_SB(1, 1), b3 + hstep, voffB);
            PG8_WAIT_V(6); PG8_BAR; PG8_MMA(1, 1, At, B1); PG8_BAR;
            }
        }
        if constexpr (ALIGN_EPI) { if (wr == 0) PG8_BAR; }
        if constexpr (!Epi::AFTER_DRAIN) { E(acc, cur, wr, wc, fr, fq); S.done(cur); }
        if (!has_next) break;
#pragma unroll
        for (int a = 0; a < 2; ++a)
#pragma unroll
            for (int b = 0; b < 2; ++b)
#pragma unroll
                for (int m = 0; m < 4; ++m)
#pragma unroll
                    for (int n = 0; n < 2; ++n) acc[a][b][m][n] = (f32x4){0.f, 0.f, 0.f, 0.f};
        cur = nxt; cA = nA; cB = nB; ++ui;
        if constexpr (ALIGN_EPI) { if (wr == 1) PG8_BAR; }
    }
    PG8_WAIT_V(0);
    if constexpr (!ALIGN_EPI) { if (wr == 0) PG8_BAR; }
    PG8_BAR;
    if constexpr (Epi::AFTER_DRAIN) { E.fused(acc, cur, wr, wc, fr, fq, lds, wid, lane); S.done(cur); }
#undef PG8_SA
#undef PG8_SB
#undef PG8_STAGE
#undef PG8_LDA
#undef PG8_LDB
#undef PG8_MMA
#undef PG8_WAIT_V
#undef PG8_WAIT_L
#undef PG8_BAR
#undef PG8_SCHED
}
}
namespace pg8 {
template <class Epi, class Sched, bool ALIGN_EPI>
__device__ __forceinline__ void gemm_phase_gather(PG8_LAS unsigned char* lds, const Gemm g, const Sched& S, const Epi& E, const PG8_LAS unsigned short* rows16) {
    int tid_ = threadIdx.x; asm volatile("" : "+v"(tid_));
    const int tid = tid_, wid = __builtin_amdgcn_readfirstlane(tid >> 6), lane = tid & 63, wr = wid >> 2, wc = wid & 3, fr = lane & 15, fq = lane >> 4;
    const int K = g.K, nt = K / BK;
    unsigned voffB[2]; int RA[2]; unsigned CA2[2];
#pragma unroll
    for (int i = 0; i < 2; ++i) { int R, C; stage_rc(tid * 16 + i * 8192, R, C); const int Rb = Epi::PERM ? ((R & ~31) + perm32(R & 31)) : R;
        RA[i] = R; CA2[i] = (unsigned)C * 2u; voffB[i] = (unsigned)(Rb * K + C) * 2u; }
    const size_t kstep = (size_t)(BK * 2);
    const size_t hstep = (size_t)HALF * K * 2;
    const size_t tstep = 2 * hstep;
    const unsigned ldsw = (unsigned)wid * 1024u;
    const unsigned rowb = (unsigned)K * 2u;
    const int aoff = lds_byte(wr * 64 + fr, fq * 8), boff = lds_byte(wc * 32 + fr, fq * 8);
#define PG8_SA(b, h) (((b) * 2 + (h)) * HTB)
#define PG8_SB(b, h) ((4 + (b) * 2 + (h)) * HTB)
#define PG8_STAGE(bufoff, gbase, voff) do { _Pragma("unroll") for (int _i = 0; _i < 2; ++_i) \
        __builtin_amdgcn_global_load_lds((const unsigned*)((const char*)(gbase) + (voff)[_i]), (PG8_LAS unsigned*)(lds + (bufoff) + ldsw + _i * 8192), 16, 0, 0); } while (0)
#define PG8_LDA(dst, b, h) do { _Pragma("unroll") for (int m = 0; m < 4; ++m) _Pragma("unroll") for (int k = 0; k < 2; ++k) dst[m][k] = *(const PG8_LAS bf16x8*)(lds + PG8_SA(b, h) + aoff + m * 2048 + k * 1024); } while (0)
#define PG8_LDB(dst, b, h) do { _Pragma("unroll") for (int n = 0; n < 2; ++n) _Pragma("unroll") for (int k = 0; k < 2; ++k) dst[n][k] = *(const PG8_LAS bf16x8*)(lds + PG8_SB(b, h) + boff + n * 2048 + k * 1024); } while (0)
#define PG8_MMA(ai, bj, At, Bt) do { __builtin_amdgcn_s_setprio(1); _Pragma("unroll") for (int m = 0; m < 4; ++m) _Pragma("unroll") for (int n = 0; n < 2; ++n) _Pragma("unroll") for (int k = 0; k < 2; ++k) \
        acc[ai][bj][m][n] = __builtin_amdgcn_mfma_f32_16x16x32_bf16(Bt[n][k], At[m][k], acc[ai][bj][m][n], 0, 0, 0); __builtin_amdgcn_s_setprio(0); } while (0)
#define PG8_WAIT_V(n) asm volatile("s_waitcnt vmcnt(" #n ")" ::: "memory")
#define PG8_WAIT_L(n) asm volatile("s_waitcnt lgkmcnt(" #n ")" ::: "memory")
#define PG8_BAR __builtin_amdgcn_s_barrier()
#define PG8_SCHED __builtin_amdgcn_sched_barrier(0)
#define PG8_GOFF(dst, U) do { _Pragma("unroll") for (int h_ = 0; h_ < 2; ++h_) _Pragma("unroll") for (int i_ = 0; i_ < 2; ++i_) dst[h_][i_] = (unsigned)rows16[(U) * 256 + h_ * HALF + RA[i_]] * rowb + CA2[i_]; } while (0)
    Unit cur, nxt; int ui = 0;
    if (!S.next(0, cur)) return;
    f32x4 acc[2][2][4][2];
#pragma unroll
    for (int a = 0; a < 2; ++a)
#pragma unroll
        for (int b = 0; b < 2; ++b)
#pragma unroll
            for (int m = 0; m < 4; ++m)
#pragma unroll
                for (int n = 0; n < 2; ++n) acc[a][b][m][n] = (f32x4){0.f, 0.f, 0.f, 0.f};
    bf16x8 At[4][2], B0[2][2], B1[2][2];
    const char* const Ab = (const char*)g.A;
    const char* cB = (const char*)g.Bt + (size_t)cur.pn * tstep;
    unsigned gc[2][2], gn[2][2];
    PG8_GOFF(gc, 0);
    S.a_ready(cur);
    PG8_STAGE(PG8_SB(0, 0), cB, voffB); PG8_STAGE(PG8_SB(0, 1), cB + hstep, voffB); PG8_STAGE(PG8_SA(0, 0), Ab, gc[0]); PG8_STAGE(PG8_SA(0, 1), Ab, gc[1]);
    if (wr == 1) PG8_BAR;
    PG8_WAIT_V(2); PG8_BAR;
    PG8_STAGE(PG8_SB(1, 0), cB + kstep, voffB); PG8_STAGE(PG8_SA(1, 0), Ab + kstep, gc[0]); PG8_STAGE(PG8_SB(1, 1), cB + hstep + kstep, voffB);
    PG8_WAIT_V(6); PG8_BAR;
    for (;;) {
        const bool has_next = S.next(ui + 1, nxt);
        const char* nB = has_next ? (const char*)g.Bt + (size_t)nxt.pn * tstep : cB;
        if (has_next) { PG8_GOFF(gn, ui + 1); } else {
#pragma unroll
            for (int h_ = 0; h_ < 2; ++h_)
#pragma unroll
                for (int i_ = 0; i_ < 2; ++i_) gn[h_][i_] = gc[h_][i_]; }
        for (int t = 0; t < nt; t += 2) {
            const bool last = (t == nt - 2);
            const char* a1 = Ab + (size_t)(t + 1) * kstep;
            const char* a2 = last ? Ab : Ab + (size_t)(t + 2) * kstep; const char* b2 = last ? nB : cB + (size_t)(t + 2) * kstep;
            const char* a3 = a2 + kstep; const char* b3 = b2 + kstep;
            unsigned g2[2][2];
#pragma unroll
            for (int h_ = 0; h_ < 2; ++h_)
#pragma unroll
                for (int i_ = 0; i_ < 2; ++i_) g2[h_][i_] = last ? gn[h_][i_] : gc[h_][i_];
            if (last && has_next) S.a_ready(nxt);
            PG8_LDB(B0, 0, 0); PG8_LDB(B1, 0, 1); PG8_SCHED; PG8_LDA(At, 0, 0); PG8_STAGE(PG8_SA(1, 1), a1, gc[1]);
            PG8_WAIT_V(8); PG8_WAIT_L(0); PG8_BAR; PG8_MMA(0, 0, At, B0); PG8_MMA(0, 1, At, B1); PG8_BAR; PG8_SCHED;
            PG8_LDA(At, 0, 1); PG8_STAGE(PG8_SB(0, 0), b2, voffB); PG8_STAGE(PG8_SB(0, 1), b2 + hstep, voffB); PG8_STAGE(PG8_SA(0, 0), a2, g2[0]);
            PG8_WAIT_V(8); PG8_WAIT_L(0); PG8_BAR; PG8_MMA(1, 0, At, B0); PG8_MMA(1, 1, At, B1); PG8_BAR; PG8_SCHED;
            PG8_LDB(B0, 1, 0); PG8_LDB(B1, 1, 1); PG8_SCHED; PG8_LDA(At, 1, 0); PG8_STAGE(PG8_SA(0, 1), a2, g2[1]);
            PG8_WAIT_V(8); PG8_WAIT_L(0); PG8_BAR; PG8_MMA(0, 0, At, B0); PG8_MMA(0, 1, At, B1); PG8_BAR; PG8_SCHED;
            PG8_LDA(At, 1, 1); PG8_STAGE(PG8_SB(1, 0), b3, voffB); PG8_STAGE(PG8_SB(1, 1), b3 + hstep, voffB); PG8_STAGE(PG8_SA(1, 0), a3, g2[0]);
            PG8_WAIT_V(8); PG8_WAIT_L(0); PG8_BAR; PG8_MMA(1, 0, At, B0); PG8_MMA(1, 1, At, B1); PG8_BAR; PG8_SCHED;
        }
        if constexpr (ALIGN_EPI) { if (wr == 0) PG8_BAR; }
        E(acc, cur, wr, wc, fr, fq); S.done(cur);
        if (!has_next) break;
#pragma unroll
        for (int a = 0; a < 2; ++a)
#pragma unroll
            for (int b = 0; b < 2; ++b)
#pragma unroll
                for (int m = 0; m < 4; ++m)
#pragma unroll
                    for (int n = 0; n < 2; ++n) acc[a][b][m][n] = (f32x4){0.f, 0.f, 0.f, 0.f};
        cur = nxt; cB = nB; ++ui;
#pragma unroll
        for (int h_ = 0; h_ < 2; ++h_)
#pragma unroll
            for (int i_ = 0; i_ < 2; ++i_) gc[h_][i_] = gn[h_][i_];
        if constexpr (ALIGN_EPI) { if (wr == 1) PG8_BAR; }
    }
    PG8_WAIT_V(0);
    if constexpr (!ALIGN_EPI) { if (wr == 0) PG8_BAR; }
    PG8_BAR;
#undef PG8_SA
#undef PG8_SB
#undef PG8_STAGE
#undef PG8_LDA
#undef PG8_LDB
#undef PG8_MMA
#undef PG8_WAIT_V
#undef PG8_WAIT_L
#undef PG8_BAR
#undef PG8_SCHED
#undef PG8_GOFF
}
}
#define GAS __attribute__((address_space(1)))
#define LAS __attribute__((address_space(3)))
typedef unsigned short bf16;
typedef unsigned v4u __attribute__((ext_vector_type(4)));
typedef float f32x4 __attribute__((ext_vector_type(4)));
typedef short bf16x8 __attribute__((ext_vector_type(8)));
typedef GAS unsigned gu32;
typedef GAS unsigned long long gu64;
#define RLX_AGENT __ATOMIC_RELAXED, __HIP_MEMORY_SCOPE_AGENT
#define LDS_WAIT() asm volatile("s_waitcnt lgkmcnt(0)" ::: "memory")
#define VM_WAIT() asm volatile("s_waitcnt vmcnt(0)" ::: "memory")
__device__ __forceinline__ unsigned long long rt() { return __builtin_amdgcn_s_memrealtime(); }
__device__ __forceinline__ unsigned f2bf(float f) { unsigned u = __builtin_bit_cast(unsigned, f); return (u + 0x7fffu + ((u >> 16) & 1u)) >> 16; }
__device__ __forceinline__ unsigned pk2(float lo, float hi) { return f2bf(lo) | (f2bf(hi) << 16); }
#define XB_TMO      128
#define XB_XCNT(j)  (256  + 64 * (j))
#define XB_XSUB(j)  (1280 + 64 * (j))
#define XB_XGEN(j)  (2304 + 64 * (j))
#define XB_TOP      3328
#define XB_TOPGEN   3392
#define XCD_BAR_WORDS 3456
#define XB_SPIN_CAP (1u << 18)

__device__ __forceinline__ unsigned xb_ld(unsigned* p)              { return __hip_atomic_load(p, __ATOMIC_RELAXED, __HIP_MEMORY_SCOPE_AGENT); }
__device__ __forceinline__ unsigned xb_add(unsigned* p, unsigned v) { return __hip_atomic_fetch_add(p, v, __ATOMIC_RELAXED, __HIP_MEMORY_SCOPE_AGENT); }
__device__ __forceinline__ unsigned xb_xcc_id() { return (unsigned)__builtin_amdgcn_s_getreg((3 << 11) | 20) & 0xFu; }
#define XB_SPIN(cond, bar) do { unsigned _sp = 0; while (cond) { __builtin_amdgcn_s_sleep(1); \
    if ((++_sp & 255u) == 0u) { if (xb_ld(&(bar)[XB_TMO])) break; if (_sp > XB_SPIN_CAP) { atomicAdd(&(bar)[XB_TMO], 1u); break; } } } } while (0)

struct XcdBarrier {
    unsigned* bar; unsigned x;
    volatile LAS unsigned* st;
};

__device__ __forceinline__ XcdBarrier xcd_barrier_post(unsigned* bar, volatile LAS unsigned* st) {
    XcdBarrier b; b.bar = bar; b.x = xb_xcc_id(); b.st = st;
    if (threadIdx.x == 0) (void)xb_add(&bar[XB_XCNT(b.x)], 1u);
    return b;
}
__device__ __forceinline__ void xcd_barrier_complete(unsigned* bar, unsigned x, unsigned& nloc, unsigned& nx) {
    const unsigned G = gridDim.x * gridDim.y * gridDim.z;
    unsigned sum, cnt, mine, sp = 0u;
    for (;;) {
        sum = 0u; cnt = 0u; mine = 0u;
#pragma unroll
        for (unsigned j = 0; j < 16; ++j) { const unsigned c = xb_ld(&bar[XB_XCNT(j)]); sum += c; cnt += (c > 0u) ? 1u : 0u; mine = (j == x) ? c : mine; }
        if (sum == G) break;
        __builtin_amdgcn_s_sleep(1);
        if ((++sp & 255u) == 0u) { if (xb_ld(&bar[XB_TMO])) break; if (sp > XB_SPIN_CAP) { atomicAdd(&bar[XB_TMO], 1u); break; } }
    }
    nloc = mine > 0u ? mine : 1u; nx = cnt > 0u ? cnt : 1u;
}

__device__ __forceinline__ void xcd_barrier(const XcdBarrier& b) {
    asm volatile("s_waitcnt vmcnt(0)" ::: "memory");
    __syncthreads();
    if (threadIdx.x == 0) {
        unsigned* bar = b.bar;
        __builtin_amdgcn_s_waitcnt(0);
        unsigned nloc = b.st[0], nx = b.st[1];
        if (nloc == 0u) { xcd_barrier_complete(bar, b.x, nloc, nx); b.st[0] = nloc; b.st[1] = nx; }
        const unsigned old = xb_add(&bar[XB_XSUB(b.x)], 1u);
        const unsigned gen = old / nloc;
        if (old + 1u == (gen + 1u) * nloc) {
            __builtin_amdgcn_fence(__ATOMIC_RELEASE, "agent");
            asm volatile("s_waitcnt vmcnt(0)" ::: "memory");
            const unsigned og = xb_add(&bar[XB_TOP], 1u);
            const unsigned tg = og / nx;
            if (og + 1u == (tg + 1u) * nx) xb_add(&bar[XB_TOPGEN], 1u);
            else XB_SPIN(xb_ld(&bar[XB_TOPGEN]) == tg, bar);
            __builtin_amdgcn_fence(__ATOMIC_ACQUIRE, "agent");
            xb_add(&bar[XB_XGEN(b.x)], 1u);
            asm volatile("s_waitcnt vmcnt(0)" ::: "memory");
        } else {
            XB_SPIN(xb_ld(&bar[XB_XGEN(b.x)]) == gen, bar);
            __builtin_amdgcn_fence(__ATOMIC_ACQUIRE, "agent");
            asm volatile("s_waitcnt vmcnt(0)" ::: "memory");
        }
    }
    __syncthreads();
}
namespace attn_body {
using bf16=__hip_bfloat16;
using bf16x8=__attribute__((ext_vector_type(8)))short;
using s16x4=__attribute__((ext_vector_type(4)))short;
using f32x16=__attribute__((ext_vector_type(16)))float;
using u32x4=__attribute__((ext_vector_type(4)))unsigned;
constexpr int BATCH=8,NHEAD=8,NKVH=2,SEQ=4096,D=64;
constexpr int DMQ=512,DMK=128,DMV=2048,DMO=1024;
constexpr int NW=8,QBLK=32,QB=QBLK*NW,KVBLK=64,NQB=SEQ/QB;
constexpr int ATTN_UNIT_ROWS=QB;
__device__ __forceinline__ int crow(int r,int hi){return (r&3)+8*(r>>2)+4*hi;}
#define SBAR() __builtin_amdgcn_sched_barrier(0)
__device__ __forceinline__ void cmask(f32x16&p0,f32x16&p1,int jb,int qrel,int hi){
  const float NEG=-INFINITY; int kb=64*jb+4*hi;
  #pragma unroll
  for(int r=0;r<16;++r){int kv=kb+(r&3)+8*(r>>2); if(kv>qrel)p0[r]=NEG; if(kv+32>qrel)p1[r]=NEG;}
}

constexpr int NSLOT=3, SLOTB=8192;
constexpr int LDS_K=0, LDS_V=NSLOT*SLOTB, LDS_WS=2*NSLOT*SLOTB, LDS_OST=LDS_WS+NW*64*4, LDS_BYTES=LDS_OST+NW*4096;
constexpr float C2=0.125f*1.4426950408889634f;
__device__ __forceinline__ void glds16(const void*gsrc,unsigned lds_dst){unsigned keep;
  asm volatile("s_mov_b32 %0, m0\n\ts_mov_b32 m0, %2\n\ts_nop 0\n\tglobal_load_lds_dwordx4 %1, off\n\ts_mov_b32 m0, %0":"=&s"(keep):"v"(gsrc),"s"(lds_dst):"memory");}
__device__ __forceinline__ float max3f(float a,float b,float c){float r;asm("v_max3_f32 %0, %1, %2, %3":"=v"(r):"v"(a),"v"(b),"v"(c));return r;}
__device__ __forceinline__ float max2f(float a,float b){float r;asm("v_max_f32_e32 %0, %1, %2":"=v"(r):"v"(a),"v"(b));return r;}
__device__ __forceinline__ float fadd_s(float a,float b){float r;asm("v_add_f32_e32 %0, %1, %2":"=v"(r):"v"(a),"v"(b));return r;}
__device__ __forceinline__ float fsub_s(float a,float b){float r;asm("v_sub_f32_e32 %0, %1, %2":"=v"(r):"v"(a),"v"(b));return r;}
typedef float f32x2_t __attribute__((ext_vector_type(2))); typedef __bf16 bf16x2_t __attribute__((ext_vector_type(2)));
__device__ __forceinline__ unsigned cvtpk_s(float lo,float hi){f32x2_t v={lo,hi};bf16x2_t b=__builtin_convertvector(v,bf16x2_t);return __builtin_bit_cast(unsigned,b);}
#define WAIT_BAR(N) asm volatile("s_waitcnt vmcnt(" #N ") lgkmcnt(0)\n\ts_barrier":::"memory")

__device__ __forceinline__ void qkt(f32x16&p0,f32x16&p1,const char*Kslot,const bf16x8*qr,const f32x16&negm,int r32,int hi){
  const char*kb=Kslot+hi*1024+r32*16;
  #pragma unroll
  for(int d0=0;d0<4;++d0){
    const bf16x8 b0=*reinterpret_cast<const bf16x8*>(kb+d0*2048);
    const bf16x8 b1=*reinterpret_cast<const bf16x8*>(kb+d0*2048+512);
    if(d0==0){p0=__builtin_amdgcn_mfma_f32_32x32x16_bf16(b0,qr[0],negm,0,0,0);p1=__builtin_amdgcn_mfma_f32_32x32x16_bf16(b1,qr[0],negm,0,0,0);}
    else{p0=__builtin_amdgcn_mfma_f32_32x32x16_bf16(b0,qr[d0],p0,0,0,0);p1=__builtin_amdgcn_mfma_f32_32x32x16_bf16(b1,qr[d0],p1,0,0,0);}}
}
typedef __attribute__((address_space(3))) const char* lds_cptr;
typedef short v4i16_t __attribute__((ext_vector_type(4)));
__device__ __forceinline__ void kload8(bf16x8*kf,lds_cptr kp){
  kf[0]=*(const __attribute__((address_space(3))) bf16x8*)(kp);      kf[1]=*(const __attribute__((address_space(3))) bf16x8*)(kp+512);
  kf[2]=*(const __attribute__((address_space(3))) bf16x8*)(kp+2048); kf[3]=*(const __attribute__((address_space(3))) bf16x8*)(kp+2560);
  kf[4]=*(const __attribute__((address_space(3))) bf16x8*)(kp+4096); kf[5]=*(const __attribute__((address_space(3))) bf16x8*)(kp+4608);
  kf[6]=*(const __attribute__((address_space(3))) bf16x8*)(kp+6144); kf[7]=*(const __attribute__((address_space(3))) bf16x8*)(kp+6656);
}
__device__ __forceinline__ void kload2(bf16x8*kf,lds_cptr kp,int j){ kf[2*j]=*(const __attribute__((address_space(3))) bf16x8*)(kp+j*2048); kf[2*j+1]=*(const __attribute__((address_space(3))) bf16x8*)(kp+j*2048+512); }
__device__ __forceinline__ s16x4 vtr(lds_cptr p){ return __builtin_bit_cast(s16x4,__builtin_amdgcn_ds_read_tr16_b64_v4i16((__attribute__((address_space(3))) v4i16_t*)p)); }
__device__ __forceinline__ float rowmax(const f32x16&p0,const f32x16&p1){
  float a=max3f(p0[0],p0[1],p1[0]),b=max3f(p0[2],p0[3],p1[1]);a=max3f(a,p1[2],p1[3]);
  #pragma unroll
  for(int r=4;r<16;r+=4){a=max3f(a,p0[r],p0[r+1]);b=max3f(b,p0[r+2],p0[r+3]);a=max3f(a,p1[r],p1[r+1]);b=max3f(b,p1[r+2],p1[r+3]);}
  const float m=max2f(a,b);
  auto rr=__builtin_amdgcn_permlane32_swap(__float_as_uint(m),__float_as_uint(m),false,false);
  return max2f(__uint_as_float(rr[0]),__uint_as_float(rr[1]));
}
__device__ __forceinline__ void pv(f32x16*o,int vb,bf16x8 pa0,bf16x8 pa1,bf16x8 pa2,bf16x8 pa3){
  #pragma unroll
  for(int d0=0;d0<2;++d0){s16x4 lo[4],hi[4];
    #pragma unroll
    for(int ks=0;ks<4;++ks){
      asm volatile("ds_read_b64_tr_b16 %0,%1 offset:%c2":"=&v"(lo[ks]):"v"(vb),"i"(d0*4096+ks*1024):"memory");
      asm volatile("ds_read_b64_tr_b16 %0,%1 offset:%c2":"=&v"(hi[ks]):"v"(vb),"i"(d0*4096+ks*1024+512):"memory");}
    asm volatile("s_waitcnt lgkmcnt(0)":::"memory");SBAR();
    #define PK(k) (bf16x8){lo[k][0],lo[k][1],lo[k][2],lo[k][3],hi[k][0],hi[k][1],hi[k][2],hi[k][3]}
    o[d0]=__builtin_amdgcn_mfma_f32_32x32x16_bf16(pa0,PK(0),o[d0],0,0,0);
    o[d0]=__builtin_amdgcn_mfma_f32_32x32x16_bf16(pa1,PK(1),o[d0],0,0,0);
    o[d0]=__builtin_amdgcn_mfma_f32_32x32x16_bf16(pa2,PK(2),o[d0],0,0,0);
    o[d0]=__builtin_amdgcn_mfma_f32_32x32x16_bf16(pa3,PK(3),o[d0],0,0,0);
    #undef PK
  }
}

#ifndef ATTN_STORE16
#define ATTN_STORE16(p,v) (*(u32x4*)(p)=(v))
#endif
template<int THRL> __device__ __forceinline__ void attn_unit(int b,int h,int qb,const bf16*Q,const bf16*__restrict__ K,const bf16*__restrict__ V,bf16*O,char*shm){
  int tid_=threadIdx.x; asm volatile("":"+v"(tid_)); const int tid=tid_,lane=tid&63,r32=lane&31,hi=lane>>5; const int wid=__builtin_amdgcn_readfirstlane(tid>>6);
  const long rowbase=(long)b*SEQ; const int q0=qb*QB;
  const bf16*Qw=Q+(rowbase+q0+wid*QBLK)*DMQ+h*D; const int kvh=h>>2;
  const bf16*Kh=K+rowbase*DMK+kvh*D,*Vh=V+rowbase*DMV+kvh*D;
  const unsigned lds0=(unsigned)(uintptr_t)shm;
  float*wsf=(float*)(shm+LDS_WS)+wid*64;
  const bf16*ksrc=Kh+(long)lane*DMK+wid*8;
  const bf16*vsrc=Vh+(long)(16*(wid&3)+(lane>>2))*DMV+(wid>>2)*32+(lane&3)*8;
  const unsigned kdst=lds0+LDS_K+wid*1024, vdst=lds0+LDS_V+wid*1024;
  #define DMA_K(t,slot) glds16(ksrc+(long)(t)*KVBLK*DMK,(unsigned)__builtin_amdgcn_readfirstlane(kdst+(slot)))
  #define DMA_V(t,slot) glds16(vsrc+(long)(t)*KVBLK*DMV,(unsigned)__builtin_amdgcn_readfirstlane(vdst+(slot)))
  const int vb0=(int)(lds0+LDS_V)+((lane>>4)&1)*32+(lane&3)*8+(4*hi+((lane&15)>>2))*64;
  const char*Kbase=shm+LDS_K; bf16x8 kf[8];
  const lds_cptr shm3=(lds_cptr)shm; const lds_cptr kp0=shm3+LDS_K+hi*1024+r32*16; const lds_cptr vp0=shm3+LDS_V+((lane>>4)&1)*32+(lane&3)*8+(4*hi+((lane&15)>>2))*64;
  constexpr int NT=SEQ/KVBLK;
  DMA_K(0,0);DMA_V(0,0);DMA_K(1,SLOTB);
  bf16x8 qr[4];
  #pragma unroll
  for(int d0=0;d0<4;++d0)qr[d0]=*reinterpret_cast<const bf16x8*>(&Qw[(long)r32*DMQ+d0*16+hi*8]);
  float mhat=0.f,l_reg=0.f;f32x16 o[2];o[0]=f32x16{};o[1]=f32x16{};f32x16 negm=f32x16{};asm volatile("":"+v"(negm));
  #define CMASK(P0,P1,t) do{}while(0)
  bool resc=false;
  #define START(P0,P1) do{ const float rm=rowmax(P0,P1); resc=false; \
    { const float dl=rm; mhat=fadd_s(mhat,dl); \
      _Pragma("unroll") for(int r=0;r<16;++r){P0[r]=fsub_s(P0[r],dl);P1[r]=fsub_s(P1[r],dl);} \
      _Pragma("unroll") for(int r=0;r<16;++r)negm[r]=-mhat; asm volatile("":"+v"(negm)); } \
    _Pragma("unroll") for(int r=0;r<16;++r)P0[r]=__builtin_amdgcn_exp2f(P0[r]); }while(0)
  #define RESC() do{ if(resc){ asm volatile("s_waitcnt lgkmcnt(0)":::"memory"); \
      _Pragma("unroll") for(int d_=0;d_<2;++d_) _Pragma("unroll") for(int r=0;r<16;++r)o[d_][r]*=wsf[crow(r,hi)]; } }while(0)
  f32x16 pA0,pA1,pB0,pB1;
  int sl_prev=0,sl_cur=0,sl_next=SLOTB;
  #define ROT() do{sl_prev=sl_cur;sl_cur=sl_next;sl_next=(sl_next==(NSLOT-1)*SLOTB)?0:sl_next+SLOTB;}while(0)
  DMA_K(2,2*SLOTB);
  WAIT_BAR(3);
  qkt(pA0,pA1,Kbase,qr,negm,r32,hi);asm volatile("s_nop 15\n\ts_nop 7":"+v"(pA0),"+v"(pA1));CMASK(pA0,pA1,0);
  START(pA0,pA1);
  _Pragma("unroll") for(int r=0;r<16;++r)pA1[r]=__builtin_amdgcn_exp2f(pA1[r]);
  WAIT_BAR(0);
  DMA_K(3,0);DMA_V(1,SLOTB);
  ROT();
  kload8(kf,kp0+sl_cur);
  WAIT_BAR(2);
  s16x4 vlo[8],vhi[8]; u32x4 pw0,pw1,pw2,pw3;
  #define PKW(P,B) cvtpk_s(P[B],P[B+1])
  #define PAF(k) __builtin_bit_cast(bf16x8,pw##k)
  #define VFR(i) (bf16x8){vlo[i][0],vlo[i][1],vlo[i][2],vlo[i][3],vhi[i][0],vhi[i][1],vhi[i][2],vhi[i][3]}
  #define PIN(x) asm volatile("":"+v"(x))
  #define MX3(a,b,c) __builtin_fmaxf(__builtin_fmaxf((a),(b)),(c))
  #define GAPA(MF,A0,A1,A2,A3,W0,W1,PW) do{ MF; sacc+=A0; sacc+=A1; sacc+=A2; sacc+=A3; PIN(sacc); W0; W1; PIN(PW); SBAR(); }while(0)
  #define EX(v) __builtin_amdgcn_exp2f(v)
  #define GAPB(MF,X,B) do{ MF; X[B]=EX(X[B]); X[B+1]=EX(X[B+1]); X[B+2]=EX(X[B+2]); X[B+3]=EX(X[B+3]); PIN(X); SBAR(); }while(0)
  #define VRD(i) do{ vlo[i]=vtr(vp_+(((i)>>2)*4096+((i)&3)*1024)); vhi[i]=vtr(vp_+(((i)>>2)*4096+((i)&3)*1024+512)); }while(0)
  #define KRD(G,j) do{ if(G){ kload2(kf,kp0+sl_next,j); SBAR(); } }while(0)
  #define STEP(C0,C1,P0,P1,t,GK,GV,GL) do{ SBAR(); \
    const lds_cptr vp_=vp0+sl_prev; \
    VRD(0); SBAR(); float sacc=(P0[0]+P0[1]); \
    GAPA(C0=__builtin_amdgcn_mfma_f32_32x32x16_bf16(kf[0],qr[0],negm,0,0,0), P0[2],P0[3],P0[4],P0[5],     pw0[0]=PKW(P0,0), pw0[1]=PKW(P0,2), pw0); \
    VRD(4); SBAR(); GAPA(C1=__builtin_amdgcn_mfma_f32_32x32x16_bf16(kf[1],qr[0],negm,0,0,0), P0[6],P0[7],P0[8],P0[9],     pw0[2]=PKW(P0,4), pw0[3]=PKW(P0,6), pw0); \
    VRD(1); SBAR(); GAPA(C0=__builtin_amdgcn_mfma_f32_32x32x16_bf16(kf[2],qr[1],C0,0,0,0),   P0[10],P0[11],P0[12],P0[13], pw1[0]=PKW(P0,8), pw1[1]=PKW(P0,10), pw1); \
    VRD(5); SBAR(); GAPA(C1=__builtin_amdgcn_mfma_f32_32x32x16_bf16(kf[3],qr[1],C1,0,0,0),   P0[14],P0[15],P1[0],P1[1],   pw1[2]=PKW(P0,12),pw1[3]=PKW(P0,14), pw1); \
    VRD(2); SBAR(); GAPA(C0=__builtin_amdgcn_mfma_f32_32x32x16_bf16(kf[4],qr[2],C0,0,0,0),   P1[2],P1[3],P1[4],P1[5],     pw2[0]=PKW(P1,0), pw2[1]=PKW(P1,2), pw2); \
    VRD(6); SBAR(); GAPA(C1=__builtin_amdgcn_mfma_f32_32x32x16_bf16(kf[5],qr[2],C1,0,0,0),   P1[6],P1[7],P1[8],P1[9],     pw2[2]=PKW(P1,4), pw2[3]=PKW(P1,6), pw2); \
    VRD(3); SBAR(); GAPA(C0=__builtin_amdgcn_mfma_f32_32x32x16_bf16(kf[6],qr[3],C0,0,0,0),   P1[10],P1[11],P1[12],P1[13], pw3[0]=PKW(P1,8), pw3[1]=PKW(P1,10), pw3); \
    VRD(7); SBAR(); GAPA(C1=__builtin_amdgcn_mfma_f32_32x32x16_bf16(kf[7],qr[3],C1,0,0,0),   P1[14],P1[15],0.f,0.f,       pw3[2]=PKW(P1,12),pw3[3]=PKW(P1,14), pw3); \
    l_reg+=sacc; \
    if(GK){DMA_K((t)+3,sl_cur);} if(GV){DMA_V((t)+1,sl_next);} \
    CMASK(C0,C1,t); \
    { float a=MX3(C0[0],C0[1],C1[0]),b=MX3(C0[2],C0[3],C1[1]); a=MX3(a,C1[2],C1[3]); \
      _Pragma("unroll") for(int r=4;r<16;r+=4){a=MX3(a,C0[r],C0[r+1]);b=MX3(b,C0[r+2],C0[r+3]);a=MX3(a,C1[r],C1[r+1]);b=MX3(b,C1[r+2],C1[r+3]);} \
      float rm=__builtin_fmaxf(a,b); { auto rr=__builtin_amdgcn_permlane32_swap(__float_as_uint(rm),__float_as_uint(rm),false,false); rm=__builtin_fmaxf(__uint_as_float(rr[0]),__uint_as_float(rr[1])); } \
      resc=false; \
      if(__builtin_expect(__any(rm>(float)THRL),0)){ const float dl=__builtin_fmaxf(rm,0.f); mhat+=dl; \
        _Pragma("unroll") for(int r=0;r<16;++r){C0[r]-=dl;C1[r]-=dl;} \
        _Pragma("unroll") for(int r=0;r<16;++r)negm[r]=-mhat; asm volatile("":"+v"(negm)); \
        const float f=__builtin_amdgcn_exp2f(-dl); l_reg*=f; if(hi==0)wsf[r32]=f; resc=true; } } \
    SBAR(); \
    GAPB(o[0]=__builtin_amdgcn_mfma_f32_32x32x16_bf16(PAF(0),VFR(0),o[0],0,0,0), C0,0); \
    GAPB(o[1]=__builtin_amdgcn_mfma_f32_32x32x16_bf16(PAF(0),VFR(4),o[1],0,0,0), C0,4); \
    KRD(GL,0); GAPB(o[0]=__builtin_amdgcn_mfma_f32_32x32x16_bf16(PAF(1),VFR(1),o[0],0,0,0), C0,8); \
    KRD(GL,1); GAPB(o[1]=__builtin_amdgcn_mfma_f32_32x32x16_bf16(PAF(1),VFR(5),o[1],0,0,0), C0,12); \
    KRD(GL,2); GAPB(o[0]=__builtin_amdgcn_mfma_f32_32x32x16_bf16(PAF(2),VFR(2),o[0],0,0,0), C1,0); \
    KRD(GL,3); GAPB(o[1]=__builtin_amdgcn_mfma_f32_32x32x16_bf16(PAF(2),VFR(6),o[1],0,0,0), C1,4); \
    GAPB(o[0]=__builtin_amdgcn_mfma_f32_32x32x16_bf16(PAF(3),VFR(3),o[0],0,0,0), C1,8); \
    GAPB(o[1]=__builtin_amdgcn_mfma_f32_32x32x16_bf16(PAF(3),VFR(7),o[1],0,0,0), C1,12); \
    }while(0)
  int t=1;
  #undef CMASK
  #define CMASK(P0,P1,t) do{}while(0)
  for(;t+5<NT;t+=2){
    STEP(pB0,pB1,pA0,pA1,t,true,true,true);     WAIT_BAR(2); RESC(); ROT();
    STEP(pA0,pA1,pB0,pB1,t+1,true,true,true);   WAIT_BAR(2); RESC(); ROT();
  }
  #undef CMASK
  #define CMASK(P0,P1,t) do{}while(0)
  #define ENDW(tt) do{ if((tt)+3<NT){WAIT_BAR(2);} else if((tt)+2<NT){WAIT_BAR(1);} else {WAIT_BAR(0);} }while(0)
  for(;t+1<NT;t+=2){
    STEP(pB0,pB1,pA0,pA1,t,(t+3<NT),(t+1<NT),(t+1<NT));       ENDW(t);   RESC(); ROT();
    STEP(pA0,pA1,pB0,pB1,t+1,(t+4<NT),(t+2<NT),(t+2<NT));     ENDW(t+1); RESC(); ROT();
  }
  STEP(pB0,pB1,pA0,pA1,NT-1,false,false,false); RESC();
  { float sacc=pB0[0]+pB0[1]; _Pragma("unroll") for(int r=2;r<16;++r)sacc+=pB0[r]; _Pragma("unroll") for(int r=0;r<16;++r)sacc+=pB1[r]; l_reg+=sacc;
    pw0=(u32x4){PKW(pB0,0),PKW(pB0,2),PKW(pB0,4),PKW(pB0,6)};pw1=(u32x4){PKW(pB0,8),PKW(pB0,10),PKW(pB0,12),PKW(pB0,14)};pw2=(u32x4){PKW(pB1,0),PKW(pB1,2),PKW(pB1,4),PKW(pB1,6)};pw3=(u32x4){PKW(pB1,8),PKW(pB1,10),PKW(pB1,12),PKW(pB1,14)};
    SBAR(); pv(o,vb0+sl_cur,PAF(0),PAF(1),PAF(2),PAF(3)); }
  #undef PKW
  #undef PAF
  #undef VFR
  #undef PIN
  #undef MX3
  #undef GAPA
  #undef GAPB
  #undef EX
  #undef VRD
  #undef KRD
  #undef STEP
  #undef ENDW
  {auto rr=__builtin_amdgcn_permlane32_swap(__float_as_uint(l_reg),__float_as_uint(l_reg),false,false);l_reg=__uint_as_float(rr[0])+__uint_as_float(rr[1]);}
  if(hi==0)wsf[32+r32]=l_reg;asm volatile("s_waitcnt lgkmcnt(0)":::"memory");
  float rli[16];
  #pragma unroll
  for(int r=0;r<16;++r)rli[r]=__builtin_amdgcn_rcpf(wsf[32+crow(r,hi)]);
  bf16*Ow=O+(rowbase+q0+wid*QBLK)*DMO+h*D;
  { bf16*stg=(bf16*)(shm+LDS_OST)+wid*2048;
    #pragma unroll
    for(int r=0;r<16;++r){const int orow=crow(r,hi);
      #pragma unroll
      for(int d0=0;d0<2;++d0)stg[orow*64+d0*32+r32]=__float2bfloat16(o[d0][r]*rli[r]);}
    asm volatile("s_waitcnt lgkmcnt(0)":::"memory");
    #pragma unroll
    for(int i=0;i<4;++i){const int row=i*8+(lane>>3),ch=lane&7; const u32x4 v=*(const u32x4*)(stg+row*64+ch*8); ATTN_STORE16(Ow+(long)row*DMO+ch*8,v);} }
  asm volatile("s_waitcnt lgkmcnt(0)\n\ts_barrier":::"memory");
  #undef DMA_K
  #undef DMA_V
  #undef CMASK
  #undef START
  #undef RESC
  #undef ROT
}
constexpr int ATTN_LDS_BYTES=LDS_BYTES;
struct AttnTensors { const bf16* Q; const bf16* K; const bf16* V; bf16* O; };
struct AttnUnit { int bh; int qb; };
struct StaticOrder {
  int vcu, G;
  __device__ __forceinline__ explicit StaticOrder(int grid,int block):vcu((grid%8==0)?(block%8)*(grid/8)+block/8:block),G(grid){}
  __device__ __forceinline__ bool next(int i,AttnUnit&u)const{ const int per=(BATCH*NHEAD*NQB+G-1)/G; if(i>=per)return false; const int idx=vcu*per+i; if(idx>=BATCH*NHEAD*NQB)return false;
    const int qb=idx%NQB, hq=(idx/NQB)&3, bk=idx/(NQB*4), kvh=bk&1, b=bk>>1; u.bh=b*NHEAD+kvh*4+hq; u.qb=qb; return true; }
  __device__ __forceinline__ void a_ready(const AttnUnit&)const{}
  __device__ __forceinline__ void done(const AttnUnit&)const{}
};
template<class Sched,int THRL=8> __device__ __forceinline__ void attn_phase(char*lds,const AttnTensors&T,const Sched&S){
  AttnUnit u;
  for(int i=0;S.next(i,u);++i){ S.a_ready(u); attn_unit<THRL>(u.bh/NHEAD,u.bh%NHEAD,u.qb,T.Q,T.K,T.V,T.O,lds); S.done(u); }
}
#undef SBAR
#undef WAIT_BAR
}
constexpr int NB = 8, SEQ = 4096, DM = 1024, NL = 4, NTOK = NB * SEQ;
constexpr int INW = 1824, INP = 2048;
constexpr int C_AQ = 0, C_AK = 512, C_AV = 640, C_GQ = 768, C_GK = 896, C_GV = 1024, C_GR = 1280, C_FX = 1536, C_GLR = 1792;
constexpr int NE = 32, TOPK = 4, DE = 1024;
constexpr int MPAD = NTOK * TOPK + NE * 256;
constexpr float LN_EPS = 1e-5f, RMS_EPS = 1e-6f;
constexpr float DN_ALPHA = 1.681792830507429f;
constexpr float QSCALE = 0.125f * 1.4426950408889634f;
constexpr float GLA_QSCALE = 0.17677669529663687f;

constexpr size_t MiB = 1u << 20;
constexpr size_t WS_CTL = 0, CTL_ZERO_BYTES = 1 * MiB;
constexpr size_t WS_ROPE = 1 * MiB;
constexpr size_t WS_WIN_T = 2 * MiB;
constexpr size_t WS_WOUT_T = 18 * MiB;
constexpr size_t WS_FTAB = 26 * MiB;
constexpr size_t WS_TW = WS_FTAB + 65536;
constexpr size_t WS_FTMP = 27 * MiB;
constexpr size_t WS_WGU_T = 90 * MiB;
constexpr size_t WS_WDN_T = 602 * MiB;
constexpr size_t WS_HF = 858 * MiB;
constexpr size_t WS_HB = 986 * MiB;
constexpr size_t WS_PROJ = 1050 * MiB;
constexpr size_t WS_QB = 1178 * MiB;
constexpr size_t WS_KB = 1210 * MiB;
constexpr size_t WS_MIX = 1218 * MiB;
constexpr size_t WS_T1 = 1282 * MiB;
constexpr size_t WS_UVT = 1410 * MiB;
constexpr size_t WS_LA = 1442 * MiB;
constexpr size_t WS_OF = 1474 * MiB;
constexpr size_t WS_OB = 1506 * MiB;
constexpr size_t WS_TOK = 1538 * MiB;
constexpr size_t WS_XS = 1542 * MiB;
constexpr size_t WS_HID = 1814 * MiB;
constexpr size_t WS_YS = 2086 * MiB;
constexpr size_t WS_END = 2358 * MiB;
static_assert((size_t)MPAD * 2048 == 272 * MiB, "sorted buffers");
constexpr int CW_TMO = 0, CW_CODE = 1, CW_BAR = 4096, CW_CNT = 8192;

constexpr int RING_OFF = 0, RING_BYTES = 131072;
constexpr int LDSCTL_OFF = RING_BYTES;
constexpr int LDS_BYTES = 163840;
constexpr int LC_MISC = 0;
constexpr int LC_PSTART = 128;
constexpr int LC_ULIST = 384;
constexpr int LC_CNT = 640;
constexpr int LC_BASE = 768;
constexpr int LC_SELE = 1024;
constexpr int LC_SELS = 1024 + 2048;
constexpr int LC_COS64 = 5120;
constexpr int LC_ROWS = 6144;
constexpr int LC_LG = 16384;

constexpr int NWAVES = 8;
constexpr int N_PHASES = 1 + 10 * NL;

typedef float f32x2_t __attribute__((ext_vector_type(2))); typedef __bf16 bf16x2_t __attribute__((ext_vector_type(2)));
__device__ __forceinline__ unsigned cvtpk2(float lo, float hi) { f32x2_t v = {lo, hi}; bf16x2_t b = __builtin_convertvector(v, bf16x2_t); return __builtin_bit_cast(unsigned, b); }
#define pk2(lo, hi) cvtpk2((lo), (hi))
#define f2bf(x) (cvtpk2((x), 0.f) & 0xffffu)
__device__ __forceinline__ float bf2f(unsigned short b) { return __uint_as_float((unsigned)b << 16); }
__device__ __forceinline__ float wave_sum(float v) {
#pragma unroll
    for (int o = 1; o < 64; o <<= 1) v += __shfl_xor(v, o);
    return v;
}
typedef unsigned short u16x8 __attribute__((ext_vector_type(8)));
typedef unsigned short u16x4 __attribute__((ext_vector_type(4)));

typedef float f32x2v __attribute__((ext_vector_type(2)));
__device__ __forceinline__ void tr_task(const float* W, int K, int Nsrc, int srcn, bf16* WT, int dst_n, int k0) {
#pragma unroll 1
    for (int hf = 0; hf < 2; ++hf) { const int kk = k0 + hf * 64; f32x2v v[64];
        if (srcn >= 0) { const float* p = W + (size_t)kk * Nsrc + srcn;
#pragma unroll
            for (int i = 0; i < 64; ++i) v[i] = __builtin_nontemporal_load((const f32x2v*)(p + (size_t)i * Nsrc)); }
        else {
#pragma unroll
            for (int i = 0; i < 64; ++i) v[i] = (f32x2v){0.f, 0.f}; }
        bf16* o0 = WT + (size_t)dst_n * K + kk; bf16* o1 = o0 + K;
#pragma unroll
        for (int j = 0; j < 8; ++j) { v4u w0, w1;
            w0.x = pk2(v[8 * j].x, v[8 * j + 1].x); w0.y = pk2(v[8 * j + 2].x, v[8 * j + 3].x); w0.z = pk2(v[8 * j + 4].x, v[8 * j + 5].x); w0.w = pk2(v[8 * j + 6].x, v[8 * j + 7].x);
            w1.x = pk2(v[8 * j].y, v[8 * j + 1].y); w1.y = pk2(v[8 * j + 2].y, v[8 * j + 3].y); w1.z = pk2(v[8 * j + 4].y, v[8 * j + 5].y); w1.w = pk2(v[8 * j + 6].y, v[8 * j + 7].y);
            *(v4u*)(o0 + 8 * j) = w0; *(v4u*)(o1 + 8 * j) = w1; } }
}

#define RC(l, j) (((j) >> 1) * 512 + 8 * (l) + ((j) & 1) * 4)
__device__ __forceinline__ void row_load_bf16(f32x4 (&v)[4], const bf16* row, int lane) {
#pragma unroll
    for (int h = 0; h < 2; ++h) { const v4u t = *(const v4u*)(row + h * 512 + 8 * lane);
        v[2 * h] = (f32x4){__uint_as_float(t.x << 16), __uint_as_float(t.x & 0xffff0000u), __uint_as_float(t.y << 16), __uint_as_float(t.y & 0xffff0000u)};
        v[2 * h + 1] = (f32x4){__uint_as_float(t.z << 16), __uint_as_float(t.z & 0xffff0000u), __uint_as_float(t.w << 16), __uint_as_float(t.w & 0xffff0000u)}; }
}
__device__ __forceinline__ void row_store_bf16(const f32x4 (&v)[4], bf16* row, int lane) {
#pragma unroll
    for (int h = 0; h < 2; ++h) { v4u w; w.x = pk2(v[2 * h].x, v[2 * h].y); w.y = pk2(v[2 * h].z, v[2 * h].w); w.z = pk2(v[2 * h + 1].x, v[2 * h + 1].y); w.w = pk2(v[2 * h + 1].z, v[2 * h + 1].w); *(v4u*)(row + h * 512 + 8 * lane) = w; }
}
__device__ __forceinline__ void ln_row8(f32x4 (&v)[4], const f32x4 (&gam)[4], const f32x4 (&bet)[4]) {
    float s = 0.f;
#pragma unroll
    for (int j = 0; j < 4; ++j) s += (v[j].x + v[j].y) + (v[j].z + v[j].w);
    const float mean = wave_sum(s) * (1.f / DM); float s2 = 0.f;
#pragma unroll
    for (int j = 0; j < 4; ++j) { v[j] = v[j] - mean; s2 += (v[j].x * v[j].x + v[j].y * v[j].y) + (v[j].z * v[j].z + v[j].w * v[j].w); }
    const float rstd = __builtin_amdgcn_rsqf(wave_sum(s2) * (1.f / DM) + LN_EPS);
#pragma unroll
    for (int j = 0; j < 4; ++j) v[j] = v[j] * rstd * gam[j] + bet[j];
}

constexpr int GM_QF = 0, GM_KF = 5120, GM_QB = 10240, GM_KB = 15360, GM_VT = 20480, GM_P = 29696, GM_HTF = 38912, GM_HTB = 44032, GM_DL = 38912, GM_SLOT = 49152;
static_assert(2 * GM_SLOT <= RING_BYTES, "two GLA chunk images fit the phase scratch");
#define MFMA16(a, b, c) __builtin_amdgcn_mfma_f32_16x16x32_bf16((a), (b), (c), 0, 0, 0)
template <bool OUT>
__device__ __forceinline__ void gla_stage_mfma(LAS unsigned char* Ls, const bf16* PROJ, const float* LA, const float* HIN, size_t tok0, int hd, int w4, int lane) {
    if (w4 < 2) { const int dir = w4, g = lane >> 3, c4 = (lane & 7) * 4; f32x4 bc[8]; u16x4 kx[8], qx[8];
        const float* lap = LA + (tok0 + 8 * g) * 256 + dir * 128 + hd * 32 + c4; const bf16* xp = PROJ + (tok0 + 8 * g) * INP + hd * 32 + c4;
#pragma unroll
        for (int i = 0; i < 8; ++i) { bc[i] = *(const f32x4*)(lap + (size_t)i * 256); kx[i] = *(const u16x4*)(xp + (size_t)i * INP + C_GK); if (OUT) qx[i] = *(const u16x4*)(xp + (size_t)i * INP + C_GQ); }
        f32x4 inc;
        if (dir == 0) {
#pragma unroll
            for (int i = 1; i < 8; ++i) bc[i] = bc[i] + bc[i - 1];
            inc = bc[7];
#pragma unroll
            for (int o = 1; o < 8; o <<= 1) { f32x4 y; y.x = __shfl_up(inc.x, 8 * o); y.y = __shfl_up(inc.y, 8 * o); y.z = __shfl_up(inc.z, 8 * o); y.w = __shfl_up(inc.w, 8 * o); if (g >= o) inc = inc + y; }
            const f32x4 off = inc - bc[7];
#pragma unroll
            for (int i = 0; i < 8; ++i) bc[i] = bc[i] + off; }
        else {
#pragma unroll
            for (int i = 6; i >= 0; --i) bc[i] = bc[i] + bc[i + 1];
            inc = bc[0];
#pragma unroll
            for (int o = 1; o < 8; o <<= 1) { f32x4 y; y.x = __shfl_down(inc.x, 8 * o); y.y = __shfl_down(inc.y, 8 * o); y.z = __shfl_down(inc.z, 8 * o); y.w = __shfl_down(inc.w, 8 * o); if (g + o < 8) inc = inc + y; }
            const f32x4 off = inc - bc[0];
#pragma unroll
            for (int i = 0; i < 8; ++i) bc[i] = bc[i] + off; }
        if (OUT) { LAS bf16* qd = (LAS bf16*)(Ls + (dir ? GM_QB : GM_QF)) + (8 * g) * 40 + c4; LAS bf16* kd = (LAS bf16*)(Ls + (dir ? GM_KB : GM_KF)) + (8 * g) * 40 + c4;
#pragma unroll
            for (int i = 0; i < 8; ++i) { float qv[4], kv[4];
#pragma unroll
                for (int c = 0; c < 4; ++c) { const float e_ = __expf(bc[i][c]); qv[c] = bf2f(qx[i][c]) * GLA_QSCALE * e_; kv[c] = bf2f(kx[i][c]) * __builtin_amdgcn_rcpf(e_); }
                *(LAS unsigned long long*)(qd + i * 40) = (unsigned long long)pk2(qv[0], qv[1]) | ((unsigned long long)pk2(qv[2], qv[3]) << 32);
                *(LAS unsigned long long*)(kd + i * 40) = (unsigned long long)pk2(kv[0], kv[1]) | ((unsigned long long)pk2(kv[2], kv[3]) << 32); } }
        else { LAS bf16* kt = (LAS bf16*)(Ls + GM_P + dir * 4608) + c4 * 72 + 8 * g;
#pragma unroll
            for (int c = 0; c < 4; ++c) { float t[8];
#pragma unroll
                for (int i = 0; i < 8; ++i) t[i] = bf2f(kx[i][c]) * __expf(-bc[i][c]);
                v4u w; w.x = pk2(t[0], t[1]); w.y = pk2(t[2], t[3]); w.z = pk2(t[4], t[5]); w.w = pk2(t[6], t[7]); *(LAS v4u*)(kt + c * 72) = w; }
            if (g == (dir ? 0 : 7)) { const f32x4 tot = dir ? bc[0] : bc[7]; LAS float* dl = (LAS float*)(Ls + GM_DL) + dir * 32 + c4; dl[0] = __expf(tot.x); dl[1] = __expf(tot.y); dl[2] = __expf(tot.z); dl[3] = __expf(tot.w); } } }
    else if (w4 == 2) { const int g = lane >> 3, v0 = (lane & 7) * 8; u16x8 x[8]; const bf16* xp = PROJ + (tok0 + 8 * g) * INP + C_GV + hd * 64 + v0;
#pragma unroll
        for (int i = 0; i < 8; ++i) x[i] = *(const u16x8*)(xp + (size_t)i * INP);
        LAS bf16* dst = (LAS bf16*)(Ls + GM_VT) + v0 * 72 + 8 * g;
#pragma unroll
        for (int c = 0; c < 8; ++c) { v4u w; w.x = (unsigned)x[0][c] | ((unsigned)x[1][c] << 16); w.y = (unsigned)x[2][c] | ((unsigned)x[3][c] << 16); w.z = (unsigned)x[4][c] | ((unsigned)x[5][c] << 16); w.w = (unsigned)x[6][c] | ((unsigned)x[7][c] << 16);
            *(LAS v4u*)(dst + c * 72) = w; } }
    else if (OUT) {
#pragma unroll
        for (int dir = 0; dir < 2; ++dir) { const f32x4* src = (const f32x4*)(HIN + ((size_t)dir * 64 + lane) * 32); LAS bf16* dst = (LAS bf16*)(Ls + (dir ? GM_HTB : GM_HTF)) + lane * 40;
#pragma unroll
            for (int c8 = 0; c8 < 4; ++c8) { const f32x4 a_ = src[2 * c8], b_ = src[2 * c8 + 1]; v4u w; w.x = pk2(a_.x, a_.y); w.y = pk2(a_.z, a_.w); w.z = pk2(b_.x, b_.y); w.w = pk2(b_.z, b_.w); *(LAS v4u*)(dst + c8 * 8) = w; } } }
}

typedef float f32x16 __attribute__((ext_vector_type(16)));
typedef short s16x4 __attribute__((ext_vector_type(4)));
__device__ __forceinline__ bf16x8 pack_step(const f32x16& x, int s) { v4u p; p.x = cvtpk2(x[8 * s], x[8 * s + 1]); p.y = cvtpk2(x[8 * s + 2], x[8 * s + 3]); p.z = cvtpk2(x[8 * s + 4], x[8 * s + 5]); p.w = cvtpk2(x[8 * s + 6], x[8 * s + 7]); return __builtin_bit_cast(bf16x8, p); }
__device__ __forceinline__ int crow16(int i, int h) { return (i & 3) + 8 * (i >> 2) + 4 * h; }
#define MFMA32(a, b, c) __builtin_amdgcn_mfma_f32_32x32x16_bf16((a), (b), (c), 0, 0, 0)
constexpr int FT_PITCH = 72, FT_TAB = 64 * FT_PITCH;
constexpr int FFT_LDS_TAB = 0, FFT_LDS_TW = 28672, FFT_LDS_HT = 28672, FFT_HT_PAIR = 2 * 64 * FT_PITCH * 2;

struct Args { const float* in[20]; float* out; unsigned char* ws; int ph_lo, ph_hi; };
static_assert(sizeof(Args) == 20 * 8 + 8 + 8 + 8, "no padding bytes in Args");


typedef __attribute__((address_space(4))) const unsigned char* kptr_t;
__device__ __forceinline__ kptr_t karg() { kptr_t p = (kptr_t)__builtin_amdgcn_kernarg_segment_ptr(); asm volatile("" : "+s"(p)); return p; }
#define KIN(i) (*(const float* const __attribute__((address_space(4)))*)(karg() + 8 * (i)))
#define KOUT() (*(float* const __attribute__((address_space(4)))*)(karg() + 160))
#define KWS() (*(unsigned char* const __attribute__((address_space(4)))*)(karg() + 168))
#define WSP(T, off) ((T*)(ws + (off)))

#ifndef NAIVE_ATTN
#define NAIVE_ATTN 0
#endif

__global__ void __launch_bounds__(NWAVES * 64, 2) fwd(Args args) {
    extern __shared__ __attribute__((aligned(16))) unsigned char lds_raw[];
    LAS unsigned char* lds = (LAS unsigned char*)lds_raw;
    LAS unsigned char* lctl = lds + LDSCTL_OFF;
    const int G = gridDim.x, bx = blockIdx.x;
    const int NGW = G * NWAVES, NGT = G * NWAVES * 64;
#define TID_SETUP() int tid_ = threadIdx.x; asm volatile("" : "+v"(tid_)); const int tid = tid_, lane = tid & 63, wave = __builtin_amdgcn_readfirstlane(tid >> 6); \
    const int gw = bx * NWAVES + wave, gt = bx * (NWAVES * 64) + tid; (void)lane; (void)gw; (void)gt
    for (int u = threadIdx.x; u < (LDS_BYTES - LDSCTL_OFF) / 4; u += NWAVES * 64) ((LAS unsigned*)lctl)[u] = 0u;
    __syncthreads();
    volatile LAS unsigned* MISC = (volatile LAS unsigned*)(lctl + LC_MISC);
    XcdBarrier bar = xcd_barrier_post((unsigned*)(KWS() + WS_CTL) + CW_BAR, MISC + 8);
    const int lo = args.ph_lo, hi = args.ph_hi;
#ifndef PH_OFF
#define PH_OFF 0
#endif
#define PON(j) (!((PH_OFF >> (j)) & 1))
#define IN(k) (lo <= (k) && (k) < hi)
#ifndef PROBE_A
#define PROBE_A -1
#endif
#ifndef PROBE_B
#define PROBE_B -1
#endif
#if PROBE_A >= 0
#define STAMP(k) do { if (blockIdx.x == 0 && threadIdx.x == 0) { ((unsigned long long*)(KWS() + WS_CTL + 65536))[(k)] = __builtin_amdgcn_s_memrealtime(); } } while (0)
#define STAMP2(i) do { __syncthreads(); if (blockIdx.x == 0 && threadIdx.x == 0) { ((unsigned long long*)(KWS() + WS_CTL + 65536))[128 + l * 16 + (i)] = __builtin_amdgcn_s_memrealtime(); } } while (0)
#else
#define STAMP(k) do {} while (0)
#define STAMP2(i) do {} while (0)
#endif
#ifndef PROBE_SUB_A
#define PROBE_SUB_A -1
#define PROBE_SUB_B -1
#endif
#define SEAM(k) do { if (IN(k) && IN((k) + 1)) xcd_barrier(bar); STAMP((k) + 1); } while (0)
    STAMP(0);

    if (IN(0) && PON(0)) {
        TID_SETUP(); unsigned char* ws = KWS(); const float* x_in = KIN(0); const float* ln_in_g = KIN(1); const float* ln_in_b = KIN(2); const float* w_in = KIN(3); const float* w_out = KIN(9);
        const float* exp_w_gu = KIN(14); const float* exp_w_down = KIN(16);
        float* ROPE = WSP(float, WS_ROPE); bf16* WIN_T = WSP(bf16, WS_WIN_T); bf16* WOUT_T = WSP(bf16, WS_WOUT_T); bf16* WGU_T = WSP(bf16, WS_WGU_T); bf16* WDN_T = WSP(bf16, WS_WDN_T);
        bf16* HB = WSP(bf16, WS_HB);
        constexpr int I_WIN = NL * 16 * 8, I_WOUT = NL * 8 * 8, I_WGU = NL * NE * 16 * 8, I_WDN = NL * NE * 8 * 8;
        constexpr int NTASK = I_WIN + I_WOUT + I_WGU + I_WDN;
        { const int t_lo = (int)(((long)gw * NTASK) / NGW), t_hi = (int)(((long)(gw + 1) * NTASK) / NGW);
          for (int it = t_lo; it < t_hi; ++it) {
            int r = it;
            if (r < I_WIN) { const int l = r / 128, q = r % 128, nb = q / 8, k8 = q % 8, n = nb * 128 + 2 * lane;
                const int src = n < 1536 ? n : (n < 1792 ? n + 32 : (n < 1824 ? n - 256 : -1));
                tr_task(w_in + (size_t)l * DM * INW, DM, INW, src, WIN_T + (size_t)l * INP * DM, n, k8 * 128); continue; }
            r -= I_WIN;
            if (r < I_WOUT) { const int l = r / 64, q = r % 64, nb = q / 8, k8 = q % 8, n = nb * 128 + 2 * lane;
                tr_task(w_out + (size_t)l * DM * DM, DM, DM, n, WOUT_T + (size_t)l * DM * DM, n, k8 * 128); continue; }
            r -= I_WOUT;
            if (r < I_WGU) { const int le = r / 128, q = r % 128, nb = q / 8, k8 = q % 8, n = nb * 128 + 2 * lane;
                const int pn = n >> 8, bj = (n >> 7) & 1, j = n & 127, src = bj * 1024 + pn * 128 + j;
                tr_task(exp_w_gu + (size_t)le * DM * 2048, DM, 2048, src, WGU_T + (size_t)le * 2048 * DM, n, k8 * 128); continue; }
            r -= I_WGU;
            { const int le = r / 64, q = r % 64, nb = q / 8, k8 = q % 8, n = nb * 128 + 2 * lane;
                tr_task(exp_w_down + (size_t)le * DE * DM, DE, DM, n, WDN_T + (size_t)le * DM * DE, n, k8 * 128); }
          } }
        { bf16* FTAB = WSP(bf16, WS_FTAB); float* TW = WSP(float, WS_TW);
          for (int it = gt; it < 3 * FT_TAB; it += NGT) { const int t = it / FT_TAB, q = it % FT_TAB, row = q / FT_PITCH, col = q % FT_PITCH; float sn, cs; sincospif((float)((row * col) & 63) * (1.0f / 32.0f), &sn, &cs);
              const float v = col >= 64 ? 0.f : (t == 0 ? cs : (t == 1 ? sn : -sn)); FTAB[it] = (bf16)f2bf(v); }
          for (int it = gt; it < 4096; it += NGT) { float sn, cs; sincospif((float)it * (1.0f / 2048.0f), &sn, &cs); TW[2 * it] = cs; TW[2 * it + 1] = -sn; } }
        for (int it = gt; it < SEQ * 32; it += NGT) { const int t = it >> 5, i = it & 31, a = i >> 4, f = i & 15; const int pos = a ? (t & 63) : (t >> 6);
            const double inv = exp(-9.210340371976184 * (double)f / 16.0); const double ang = (double)pos * inv;
            ROPE[it] = (float)cos(ang); ROPE[SEQ * 32 + it] = (float)sin(ang); }
        { f32x4 gam[4], bet[4];
#pragma unroll
          for (int j = 0; j < 4; ++j) { gam[j] = *(const f32x4*)(ln_in_g + RC(lane, j)); bet[j] = *(const f32x4*)(ln_in_b + RC(lane, j)); }
          for (int m0 = gw; m0 < NTOK; m0 += 2 * NGW) { f32x4 v[2][4];
#pragma unroll
            for (int q = 0; q < 2; ++q)
#pragma unroll
                for (int j = 0; j < 4; ++j) v[q][j] = *(const f32x4*)(x_in + (size_t)(m0 + q * NGW) * DM + RC(lane, j));
#pragma unroll
            for (int q = 0; q < 2; ++q) { ln_row8(v[q], gam, bet); row_store_bf16(v[q], HB + (size_t)(m0 + q * NGW) * DM, lane); } } }
    }
    SEAM(0);

    for (int l = 0; l < NL; ++l) {
        const int pb = 1 + 10 * l;
        if (IN(pb + 0) && PON(1)) {
            TID_SETUP(); unsigned char* ws = KWS(); bf16* HB = WSP(bf16, WS_HB); bf16* WIN_T = WSP(bf16, WS_WIN_T); bf16* PROJ = WSP(bf16, WS_PROJ);
            pg8::Gemm g{HB, WIN_T + (size_t)l * INP * DM, NTOK, INP, DM}; pg8::StaticOrder S; S.init(NTOK, INP, G, bx);
            pg8::EpiPlainBf16 E{PROJ, INP};
            STAMP2(2);
            pg8::gemm_phase<pg8::EpiPlainBf16, pg8::StaticOrder, true, true>(lds + RING_OFF, g, S, E);
            STAMP2(3);
        }
        SEAM(pb + 0);
        if (IN(pb + 1) && PON(2)) {
            TID_SETUP(); unsigned char* ws = KWS(); const float* att_q_gain = KIN(4); const float* att_k_gain = KIN(5); const float* gla_gate_w = KIN(6); const float* gla_gate_b = KIN(7);
            const float* ROPE = WSP(float, WS_ROPE); const bf16* PROJ = WSP(bf16, WS_PROJ); bf16* QB = WSP(bf16, WS_QB); bf16* KB = WSP(bf16, WS_KB); float* LA = WSP(float, WS_LA);
            STAMP2(8);
            { LAS float* RTC = (LAS float*)(lds + RING_OFF + 65536);
              for (int i = tid; i < 1024; i += NWAVES * 64) { const int pos = i >> 4, f = i & 15; RTC[i] = ROPE[(pos * 64) * 32 + f]; RTC[1024 + i] = ROPE[SEQ * 32 + (pos * 64) * 32 + f]; RTC[2048 + i] = ROPE[pos * 32 + 16 + f]; RTC[3072 + i] = ROPE[SEQ * 32 + pos * 32 + 16 + f]; }
              __syncthreads();
              const int li = lane & 7, ax = li >> 2, f0 = 8 * (li & 1); const float sg = ((li >> 1) & 1) ? 1.f : -1.f;
              f32x4 qg8[2], kg8[2];
#pragma unroll
              for (int c = 0; c < 2; ++c) { qg8[c] = *(const f32x4*)(att_q_gain + l * 64 + 8 * li + 4 * c); kg8[c] = *(const f32x4*)(att_k_gain + l * 64 + 8 * li + 4 * c); }
              for (int m0 = gw; m0 < NTOK; m0 += 4 * NGW) { v4u xp[5];
#pragma unroll
                for (int i = 0; i < 5; ++i) { const int P = lane + 64 * i, q = P / 80, p = P % 80; xp[i] = *(const v4u*)(PROJ + (size_t)(m0 + q * NGW) * INP + p * 8); }
#pragma unroll
                for (int i = 0; i < 5; ++i) { const int P = lane + 64 * i, q = P / 80, p = P % 80, head = p >> 3; const size_t m = (size_t)(m0 + q * NGW); const int t = (int)(m & (SEQ - 1));
                    float xv[8] = {__uint_as_float(xp[i].x << 16), __uint_as_float(xp[i].x & 0xffff0000u), __uint_as_float(xp[i].y << 16), __uint_as_float(xp[i].y & 0xffff0000u),
                                   __uint_as_float(xp[i].z << 16), __uint_as_float(xp[i].z & 0xffff0000u), __uint_as_float(xp[i].w << 16), __uint_as_float(xp[i].w & 0xffff0000u)};
                    float ss = 0.f;
#pragma unroll
                    for (int c = 0; c < 8; ++c) ss += xv[c] * xv[c];
                    ss += __shfl_xor(ss, 1); ss += __shfl_xor(ss, 2); ss += __shfl_xor(ss, 4);
                    const float rs = __builtin_amdgcn_rsqf(ss * (1.f / 64.f) + RMS_EPS); const bool isq = head < 8;
                    const LAS float* tb = RTC + (ax ? 2048 : 0) + (ax ? (t & 63) : (t >> 6)) * 16 + f0;
                    const f32x4 c0 = *(const LAS f32x4*)tb, c1 = *(const LAS f32x4*)(tb + 4), s0 = *(const LAS f32x4*)(tb + 1024), s1 = *(const LAS f32x4*)(tb + 1028);
                    const float csv[8] = {c0.x, c0.y, c0.z, c0.w, c1.x, c1.y, c1.z, c1.w}, snv[8] = {s0.x, s0.y, s0.z, s0.w, s1.x, s1.y, s1.z, s1.w};
                    const f32x4 g0 = isq ? qg8[0] : kg8[0], g1 = isq ? qg8[1] : kg8[1]; const float gv[8] = {g0.x, g0.y, g0.z, g0.w, g1.x, g1.y, g1.z, g1.w};
                    const float osc = isq ? QSCALE : 1.f; float o[8];
#pragma unroll
                    for (int c = 0; c < 8; ++c) { const float xn = xv[c] * rs * gv[c]; const float pr = __shfl_xor(xn, 2); o[c] = (xn * csv[c] + sg * pr * snv[c]) * osc; }
                    v4u w; w.x = pk2(o[0], o[1]); w.y = pk2(o[2], o[3]); w.z = pk2(o[4], o[5]); w.w = pk2(o[6], o[7]);
                    bf16* dst = isq ? (QB + m * 512 + head * 64 + 8 * li) : (KB + m * 128 + (head - 8) * 64 + 8 * li);
                    *(v4u*)dst = w; } }
              const float* gw_l = gla_gate_w + (size_t)l * 2 * 16 * 128; const float* gb_l = gla_gate_b + (size_t)l * 2 * 128; const int dir = lane >> 5, kc = (lane & 31) * 4;
              f32x4 gwr[16]; const f32x4 gbv = *(const f32x4*)(gb_l + dir * 128 + kc);
#pragma unroll
              for (int r = 0; r < 16; ++r) gwr[r] = *(const f32x4*)(gw_l + (size_t)(dir * 16 + r) * 128 + kc);
              for (int m0 = gw; m0 < NTOK; m0 += 4 * NGW) { v4u gl[4][2];
#pragma unroll
                for (int q = 0; q < 4; ++q) { const bf16* gp = PROJ + (size_t)(m0 + q * NGW) * INP + C_GLR + dir * 16; gl[q][0] = *(const v4u*)gp; gl[q][1] = *(const v4u*)(gp + 8); }
#pragma unroll
                for (int q = 0; q < 4; ++q) { const size_t m = (size_t)(m0 + q * NGW); f32x4 z = gbv;
                    const unsigned gu[8] = {gl[q][0].x, gl[q][0].y, gl[q][0].z, gl[q][0].w, gl[q][1].x, gl[q][1].y, gl[q][1].z, gl[q][1].w};
#pragma unroll
                    for (int r2 = 0; r2 < 8; ++r2) { z = z + gwr[2 * r2] * __uint_as_float(gu[r2] << 16); z = z + gwr[2 * r2 + 1] * __uint_as_float(gu[r2] & 0xffff0000u); }
                    f32x4 o4;
#pragma unroll
                    for (int i = 0; i < 4; ++i) o4[i] = (fminf(z[i], 0.f) - __logf(1.f + __expf(-fabsf(z[i])))) * (1.f / 16.f);
                    *(f32x4*)(LA + m * 256 + dir * 128 + kc) = o4; } }
              __syncthreads(); }
            STAMP2(4);
            { __syncthreads();
              { const v4u* src = (const v4u*)WSP(bf16, WS_FTAB); LAS v4u* dst = (LAS v4u*)(lds + RING_OFF + FFT_LDS_TAB); for (int i = tid; i < 3 * FT_TAB * 2 / 16; i += NWAVES * 64) dst[i] = src[i];
                const v4u* s2_ = (const v4u*)WSP(float, WS_TW); LAS v4u* d2_ = (LAS v4u*)(lds + RING_OFF + FFT_LDS_TW); for (int i = tid; i < 4096 * 8 / 16; i += NWAVES * 64) d2_[i] = s2_[i]; }
              __syncthreads();
              const LAS bf16* FT = (const LAS bf16*)(lds + RING_OFF + FFT_LDS_TAB); const LAS float* TWL = (const LAS float*)(lds + RING_OFF + FFT_LDS_TW); bf16* FTMP = WSP(bf16, WS_FTMP);
              const int pair = wave >> 1, cb = wave & 1, r = lane & 31, h = lane >> 5;
              for (int ub = bx; ub < NB * 4 * 64 / 4; ub += G) { const int u = ub * 4 + pair, s2 = u & 63, g4 = (u >> 6) & 3, b = u >> 8;
                bf16x8 xa[2][4];
#pragma unroll
                for (int R = 0; R < 2; ++R)
#pragma unroll
                    for (int ks = 0; ks < 4; ++ks) xa[R][ks] = *(const bf16x8*)(PROJ + ((size_t)b * SEQ + 64 * (32 * R + r) + s2) * INP + C_FX + g4 * 64 + 16 * ks + 8 * h);
                f32x16 Tr[2], Ti[2];
#pragma unroll
                for (int R = 0; R < 2; ++R)
#pragma unroll
                    for (int i = 0; i < 16; ++i) { Tr[R][i] = 0.f; Ti[R][i] = 0.f; }
#pragma unroll
                for (int ks = 0; ks < 4; ++ks) { const bf16x8 bc = *(const LAS bf16x8*)(FT + (32 * cb + r) * FT_PITCH + 16 * ks + 8 * h), bs = *(const LAS bf16x8*)(FT + 2 * FT_TAB + (32 * cb + r) * FT_PITCH + 16 * ks + 8 * h);
#pragma unroll
                    for (int R = 0; R < 2; ++R) { Tr[R] = MFMA32(xa[R][ks], bc, Tr[R]); Ti[R] = MFMA32(xa[R][ks], bs, Ti[R]); } }
#pragma unroll
                for (int Rp = 0; Rp < 2; ++Rp) { f32x16 Gr, Gi;
#pragma unroll
                    for (int i = 0; i < 16; ++i) { Gr[i] = 0.f; Gi[i] = 0.f; }
#pragma unroll
                    for (int R = 0; R < 2; ++R)
#pragma unroll
                        for (int s_ = 0; s_ < 2; ++s_) { const bf16x8 xr = pack_step(Tr[R], s_), xi = pack_step(Ti[R], s_);
                            const int kb = 32 * R + 16 * s_ + 4 * h, ro = (32 * Rp + r) * FT_PITCH + kb;
                            const s16x4 c0 = *(const LAS s16x4*)(FT + ro), c1 = *(const LAS s16x4*)(FT + ro + 8), s0 = *(const LAS s16x4*)(FT + FT_TAB + ro), s1 = *(const LAS s16x4*)(FT + FT_TAB + ro + 8),
                                        n0 = *(const LAS s16x4*)(FT + 2 * FT_TAB + ro), n1 = *(const LAS s16x4*)(FT + 2 * FT_TAB + ro + 8);
                            const bf16x8 ca = __builtin_shufflevector(c0, c1, 0, 1, 2, 3, 4, 5, 6, 7), sa = __builtin_shufflevector(s0, s1, 0, 1, 2, 3, 4, 5, 6, 7), na = __builtin_shufflevector(n0, n1, 0, 1, 2, 3, 4, 5, 6, 7);
                            Gr = MFMA32(ca, xr, Gr); Gr = MFMA32(sa, xi, Gr); Gi = MFMA32(ca, xi, Gi); Gi = MFMA32(na, xr, Gi); }
#pragma unroll
                    for (int i = 0; i < 16; ++i) { const int s1p = 32 * Rp + crow16(i, h); const int m = (s2 * s1p) & 4095; const float wr = TWL[2 * m], wi = TWL[2 * m + 1];
                        const size_t o = ((((size_t)(b * 4 + g4) * 64 + s1p) * 2) * 64 + s2) * 64 + 32 * cb + r;
                        FTMP[o] = (bf16)f2bf(Gr[i] * wr - Gi[i] * wi); FTMP[o + 4096] = (bf16)f2bf(Gr[i] * wi + Gi[i] * wr); } }
              }
              __syncthreads(); }
            STAMP2(5);
            { float* GS = WSP(float, WS_OF); float* GD = WSP(float, WS_OB);
              const int slot = wave >> 2, w4 = wave & 3, fr = lane & 15, fq = lane >> 4; LAS unsigned char* Ls = lds + RING_OFF + slot * GM_SLOT;
              for (int ub = bx; ub < NB * 4 * 64 / 2; ub += G) { const int u = ub * 2 + slot, c = u & 63, bh = u >> 6, hd = bh & 3, b = bh >> 2; const size_t tok0 = (size_t)b * SEQ + c * 64;
                __syncthreads();
                gla_stage_mfma<false>(Ls, PROJ, LA, nullptr, tok0, hd, w4, lane);
                __syncthreads();
                const LAS bf16* VT = (const LAS bf16*)(Ls + GM_VT); const LAS float* DL = (const LAS float*)(Ls + GM_DL);
#pragma unroll
                for (int dir = 0; dir < 2; ++dir) { const LAS bf16* KT = (const LAS bf16*)(Ls + GM_P + dir * 4608);
#pragma unroll
                    for (int Cd = 0; Cd < 2; ++Cd) { f32x4 acc = {0.f, 0.f, 0.f, 0.f};
#pragma unroll
                        for (int ks = 0; ks < 2; ++ks) { const bf16x8 a_ = *(const LAS bf16x8*)(VT + (16 * w4 + fr) * 72 + 32 * ks + 8 * fq), b_ = *(const LAS bf16x8*)(KT + (16 * Cd + fr) * 72 + 32 * ks + 8 * fq); acc = MFMA16(a_, b_, acc); }
                        const float Dd = DL[dir * 32 + 16 * Cd + fr]; float* o = GS + (((size_t)u * 2 + dir) * 64 + 16 * w4 + 4 * fq) * 32 + 16 * Cd + fr;
#pragma unroll
                        for (int r = 0; r < 4; ++r) o[r * 32] = acc[r] * Dd; } }
                if (w4 == 3) GD[((size_t)u * 2 + (lane >> 5)) * 32 + (lane & 31)] = DL[lane]; }
              __syncthreads(); }
            STAMP2(9);
        }
        SEAM(pb + 1);
        if (IN(pb + 2) && PON(3)) {
            TID_SETUP(); unsigned char* ws = KWS(); float* GS = WSP(float, WS_OF); const float* GD = WSP(float, WS_OB);
            for (int e = gt; e < NB * 4 * 2 * 2048; e += NGT) { const int dv = e & 2047, dir = (e >> 11) & 1, bh = e >> 12, d = dv & 31; float H = 0.f;
                for (int c8 = 0; c8 < 64; c8 += 8) { float sv[8], dd[8];
#pragma unroll
                    for (int i = 0; i < 8; ++i) { const int c = dir ? 63 - (c8 + i) : (c8 + i); const size_t sidx = ((size_t)(bh * 64 + c) * 2 + dir); sv[i] = GS[sidx * 2048 + dv]; dd[i] = GD[sidx * 32 + d]; }
#pragma unroll
                    for (int i = 0; i < 8; ++i) { const int c = dir ? 63 - (c8 + i) : (c8 + i); const size_t sidx = ((size_t)(bh * 64 + c) * 2 + dir); GS[sidx * 2048 + dv] = H; H = H * dd[i] + sv[i]; } } }
        }
        SEAM(pb + 2);
        if (IN(pb + 3) && PON(4)) {
            TID_SETUP(); unsigned char* ws = KWS(); const float* gla_norm_g = KIN(8); const bf16* PROJ = WSP(bf16, WS_PROJ);
            bf16* MIX = WSP(bf16, WS_MIX); const bf16* QB = WSP(bf16, WS_QB); const bf16* KB = WSP(bf16, WS_KB);
            { __syncthreads();
              { const v4u* src = (const v4u*)WSP(bf16, WS_FTAB); LAS v4u* dst = (LAS v4u*)(lds + RING_OFF + FFT_LDS_TAB); for (int i = tid; i < 3 * FT_TAB * 2 / 16; i += NWAVES * 64) dst[i] = src[i]; }
              const LAS bf16* FT = (const LAS bf16*)(lds + RING_OFF + FFT_LDS_TAB); const bf16* FTMP = WSP(bf16, WS_FTMP);
              const int pair = wave >> 1, cb = wave & 1, r = lane & 31, h = lane >> 5;
              LAS bf16* HT = (LAS bf16*)(lds + RING_OFF + FFT_LDS_HT + pair * FFT_HT_PAIR);
              for (int ub = bx; ub < NB * 4 * 64 / 4; ub += G) { const int u = ub * 4 + pair, s1p = u & 63, g4 = (u >> 6) & 3, b = u >> 8;
                const bf16* src = FTMP + (size_t)u * 2 * 4096;
                __syncthreads();
#pragma unroll
                for (int q = 0; q < 8; ++q) { const int p = cb * 64 + lane + 128 * q, ri = p >> 9, s2 = (p >> 3) & 63, c0 = (p & 7) * 8; const u16x8 v = *(const u16x8*)(src + p * 8);
#pragma unroll
                    for (int i = 0; i < 8; ++i) HT[(ri * 64 + c0 + i) * FT_PITCH + s2] = v[i]; }
                __syncthreads();
#pragma unroll
                for (int Rp = 0; Rp < 2; ++Rp) { f32x16 acc;
#pragma unroll
                    for (int i = 0; i < 16; ++i) acc[i] = 0.f;
#pragma unroll
                    for (int ks = 0; ks < 4; ++ks) { const int ko = 16 * ks + 8 * h;
                        const bf16x8 ca = *(const LAS bf16x8*)(FT + (32 * Rp + r) * FT_PITCH + ko), sa = *(const LAS bf16x8*)(FT + FT_TAB + (32 * Rp + r) * FT_PITCH + ko);
                        const bf16x8 hr = *(const LAS bf16x8*)(HT + (32 * cb + r) * FT_PITCH + ko), hi_ = *(const LAS bf16x8*)(HT + (64 + 32 * cb + r) * FT_PITCH + ko);
                        acc = MFMA32(ca, hr, acc); acc = MFMA32(sa, hi_, acc); }
#pragma unroll
                    for (int i = 0; i < 16; ++i) { const int s2p = 32 * Rp + crow16(i, h); MIX[((size_t)b * SEQ + s1p + 64 * s2p) * DM + 768 + g4 * 64 + 32 * cb + r] = (bf16)f2bf(acc[i] * (1.0f / 512.0f)); } }
              }
              __syncthreads(); }
            STAMP2(6);
            { const float* GS = WSP(float, WS_OF); const float* LA = WSP(float, WS_LA);
              const int slot = wave >> 2, w4 = wave & 3, fr = lane & 15, fq = lane >> 4, I0 = 16 * w4; LAS unsigned char* Ls = lds + RING_OFF + slot * GM_SLOT;
              for (int ub = bx; ub < NB * 4 * 64 / 2; ub += G) { const int u = ub * 2 + slot, c = u & 63, bh = u >> 6, hd = bh & 3, b = bh >> 2; const size_t tok0 = (size_t)b * SEQ + c * 64;
                __syncthreads();
                gla_stage_mfma<true>(Ls, PROJ, LA, GS + (size_t)u * 2 * 2048, tok0, hd, w4, lane);
                __syncthreads();
                const LAS bf16* QF = (const LAS bf16*)(Ls + GM_QF); const LAS bf16* KF = (const LAS bf16*)(Ls + GM_KF); const LAS bf16* QBm = (const LAS bf16*)(Ls + GM_QB); const LAS bf16* KBm = (const LAS bf16*)(Ls + GM_KB);
                const LAS bf16* VT = (const LAS bf16*)(Ls + GM_VT); LAS bf16* P = (LAS bf16*)(Ls + GM_P); const LAS bf16* HTF = (const LAS bf16*)(Ls + GM_HTF); const LAS bf16* HTB = (const LAS bf16*)(Ls + GM_HTB);
                const bf16x8 qfa = *(const LAS bf16x8*)(QF + (I0 + fr) * 40 + 8 * fq), qba = *(const LAS bf16x8*)(QBm + (I0 + fr) * 40 + 8 * fq);
#pragma unroll
                for (int Cj = 0; Cj < 4; ++Cj) { const f32x4 z = {0.f, 0.f, 0.f, 0.f};
                    const f32x4 pf = MFMA16(qfa, *(const LAS bf16x8*)(KF + (16 * Cj + fr) * 40 + 8 * fq), z), pb = MFMA16(qba, *(const LAS bf16x8*)(KBm + (16 * Cj + fr) * 40 + 8 * fq), z);
#pragma unroll
                    for (int r = 0; r < 4; ++r) { const int i = I0 + 4 * fq + r, j = 16 * Cj + fr; P[i * 72 + j] = (bf16)f2bf(j <= i ? pf[r] : pb[r]); } }
                asm volatile("s_waitcnt lgkmcnt(0)" ::: "memory");
                f32x4 o[4];
#pragma unroll
                for (int Cv = 0; Cv < 4; ++Cv) { f32x4 acc = {0.f, 0.f, 0.f, 0.f};
#pragma unroll
                    for (int ks = 0; ks < 2; ++ks) acc = MFMA16(*(const LAS bf16x8*)(P + (I0 + fr) * 72 + 32 * ks + 8 * fq), *(const LAS bf16x8*)(VT + (16 * Cv + fr) * 72 + 32 * ks + 8 * fq), acc);
                    acc = MFMA16(qfa, *(const LAS bf16x8*)(HTF + (16 * Cv + fr) * 40 + 8 * fq), acc); acc = MFMA16(qba, *(const LAS bf16x8*)(HTB + (16 * Cv + fr) * 40 + 8 * fq), acc);
                    o[Cv] = acc; }
                float rs[4];
#pragma unroll
                for (int r = 0; r < 4; ++r) { float ss = (o[0][r] * o[0][r] + o[1][r] * o[1][r]) + (o[2][r] * o[2][r] + o[3][r] * o[3][r]);
#pragma unroll
                    for (int m_ = 1; m_ < 16; m_ <<= 1) ss += __shfl_xor(ss, m_);
                    rs[r] = 1.f / sqrtf(ss * (1.f / 64.f) + RMS_EPS); }
#pragma unroll
                for (int Cv = 0; Cv < 4; ++Cv) { const int v = 16 * Cv + fr; const float gn = gla_norm_g[l * 64 + v];
#pragma unroll
                    for (int r = 0; r < 4; ++r) { const size_t m = tok0 + I0 + 4 * fq + r; const float rg = bf2f(PROJ[m * INP + C_GR + hd * 64 + v]);
                        MIX[m * DM + 512 + hd * 64 + v] = (bf16)f2bf(o[Cv][r] * rs[r] * gn * (rg / (1.f + expf(-rg)))); } } }
              __syncthreads(); }
            STAMP2(7);
#if NAIVE_ATTN
            { LAS float* Kt = (LAS float*)(lds + RING_OFF); LAS float* Vt = Kt + 64 * 64;
              for (int unit = bx; unit < NB * 8 * 8; unit += G) { const int rb = unit & 7, h = (unit >> 3) & 7, b = unit >> 6, kvh = h >> 2;
                const size_t qrow = (size_t)b * SEQ + rb * 512 + tid;
                float q[64], o[64]; float mrun = -INFINITY, lrun = 0.f;
#pragma unroll
                for (int c8 = 0; c8 < 8; ++c8) { const u16x8 f = *(const u16x8*)(QB + qrow * 512 + h * 64 + c8 * 8);
#pragma unroll
                    for (int i = 0; i < 8; ++i) { q[c8 * 8 + i] = bf2f(f[i]); o[c8 * 8 + i] = 0.f; } }
                for (int kt = 0; kt < SEQ; kt += 64) {
                    __syncthreads();
                    { const int kr = tid >> 3, c8 = (tid & 7) * 8; const size_t krow = (size_t)b * SEQ + kt + kr;
                      const u16x8 kf = *(const u16x8*)(KB + krow * 128 + kvh * 64 + c8); const u16x8 vf = *(const u16x8*)(PROJ + krow * INP + C_AV + kvh * 64 + c8);
#pragma unroll
                      for (int i = 0; i < 8; ++i) { Kt[kr * 64 + c8 + i] = bf2f(kf[i]); Vt[kr * 64 + c8 + i] = bf2f(vf[i]); } }
                    __syncthreads();
#pragma unroll 1
                    for (int j = 0; j < 64; ++j) { float a = 0.f;
#pragma unroll
                        for (int d4 = 0; d4 < 16; ++d4) { const f32x4 kv = *(const LAS f32x4*)(Kt + j * 64 + d4 * 4); a += (q[d4 * 4] * kv.x + q[d4 * 4 + 1] * kv.y) + (q[d4 * 4 + 2] * kv.z + q[d4 * 4 + 3] * kv.w); }
                        if (a > mrun) { const float al = exp2f(mrun - a); mrun = a; lrun *= al;
#pragma unroll
                            for (int d = 0; d < 64; ++d) o[d] *= al; }
                        const float p = exp2f(a - mrun); lrun += p;
#pragma unroll
                        for (int d4 = 0; d4 < 16; ++d4) { const f32x4 vv = *(const LAS f32x4*)(Vt + j * 64 + d4 * 4); o[d4 * 4] += p * vv.x; o[d4 * 4 + 1] += p * vv.y; o[d4 * 4 + 2] += p * vv.z; o[d4 * 4 + 3] += p * vv.w; } }
                }
                const float rl = 1.f / lrun;
#pragma unroll
                for (int c8 = 0; c8 < 8; ++c8) { v4u w; w.x = pk2(o[c8 * 8] * rl, o[c8 * 8 + 1] * rl); w.y = pk2(o[c8 * 8 + 2] * rl, o[c8 * 8 + 3] * rl); w.z = pk2(o[c8 * 8 + 4] * rl, o[c8 * 8 + 5] * rl); w.w = pk2(o[c8 * 8 + 6] * rl, o[c8 * 8 + 7] * rl);
                    *(v4u*)(MIX + qrow * DM + h * 64 + c8 * 8) = w; }
              }
              __syncthreads(); }
#else
            { const attn_body::AttnTensors AT{(const attn_body::bf16*)QB, (const attn_body::bf16*)KB, (const attn_body::bf16*)(PROJ + C_AV), (attn_body::bf16*)MIX};
              const attn_body::StaticOrder S(G, bx);
              attn_body::attn_phase<attn_body::StaticOrder>((char*)lds_raw + RING_OFF, AT, S); }
#endif
        }
        SEAM(pb + 3);
        if (IN(pb + 4) && PON(5)) {
            TID_SETUP(); unsigned char* ws = KWS(); const bf16* MIX = WSP(bf16, WS_MIX); const bf16* WOUT_T = WSP(bf16, WS_WOUT_T); const bf16* HB = WSP(bf16, WS_HB); bf16* T1 = WSP(bf16, WS_T1);
            pg8::Gemm g{MIX, WOUT_T + (size_t)l * DM * DM, NTOK, DM, DM}; pg8::StaticOrder S; S.init(NTOK, DM, G, bx);
            pg8::EpiResBf16 E{HB, T1, DM, DN_ALPHA};
            pg8::gemm_phase<pg8::EpiResBf16, pg8::StaticOrder, true, true>(lds + RING_OFF, g, S, E);
        }
        SEAM(pb + 4);
        if (IN(pb + 5) && PON(6)) {
            TID_SETUP(); unsigned char* ws = KWS(); gu32* ctl = (gu32*)(ws + WS_CTL); const float* ln1_g = KIN(10); const float* ln1_b = KIN(11); const float* router_w = KIN(12); const float* router_b = KIN(13);
            const bf16* T1 = WSP(bf16, WS_T1); bf16* HB = WSP(bf16, WS_HB); int* TOKE = WSP(int, WS_TOK); int* TOKS = TOKE + NTOK * 4; float* TOKW = (float*)(TOKS + NTOK * 4); int* LIST = WSP(int, WS_XS);
            LAS float* RW = (LAS float*)(lds + RING_OFF);
            { const float* rw = router_w + (size_t)l * DM * NE; for (int i = tid; i < DM * NE; i += NWAVES * 64) { const int c = i >> 5, e = i & 31; RW[e * DM + c] = rw[i]; } }
            LAS int* lcnt = (LAS int*)(lctl + LC_CNT); LAS int* lbase = (LAS int*)(lctl + LC_BASE); LAS int* sele = (LAS int*)(lctl + LC_SELE); LAS int* sels = (LAS int*)(lctl + LC_SELS);
            const float* rb = router_b + l * NE;
            for (int r0 = bx * 128; r0 < NTOK; r0 += G * 128) {
                if (tid < 32) lcnt[tid] = 0;
                __syncthreads();
                LAS float* LG = (LAS float*)(lctl + LC_LG) + wave * 512;
                f32x4 gam[4], bet[4];
#pragma unroll
                for (int j = 0; j < 4; ++j) { gam[j] = *(const f32x4*)(ln1_g + l * DM + RC(lane, j)); bet[j] = *(const f32x4*)(ln1_b + l * DM + RC(lane, j)); }
                for (int rr = 0; rr < 16; rr += 2) { const int lr = wave * 16 + rr; const size_t m = (size_t)r0 + lr; f32x4 v[2][4];
                    row_load_bf16(v[0], T1 + m * DM, lane); row_load_bf16(v[1], T1 + (m + 1) * DM, lane);
#pragma unroll
                    for (int q = 0; q < 2; ++q) { ln_row8(v[q], gam, bet); row_store_bf16(v[q], HB + (m + q) * DM, lane); }
                    float a0[32], a1[32];
#pragma unroll
                    for (int e = 0; e < 32; ++e) { f32x2_t s0 = {0.f, 0.f}, s1 = {0.f, 0.f};
#pragma unroll
                        for (int j = 0; j < 4; ++j) { const f32x4 w = *(const LAS f32x4*)(RW + e * DM + RC(lane, j)); const f32x2_t wl = {w.x, w.y}, wh = {w.z, w.w};
                            s0 += (f32x2_t){v[0][j].x, v[0][j].y} * wl; s0 += (f32x2_t){v[0][j].z, v[0][j].w} * wh; s1 += (f32x2_t){v[1][j].x, v[1][j].y} * wl; s1 += (f32x2_t){v[1][j].z, v[1][j].w} * wh; }
                        a0[e] = s0.x + s0.y; a1[e] = s1.x + s1.y; }
#define TRSTEP(SRC, DST, N, MASK) _Pragma("unroll") for (int e = 0; e < (N); ++e) { const bool hi_ = (lane & (MASK)) != 0; const float keep = hi_ ? SRC[e + (N)] : SRC[e], send = hi_ ? SRC[e] : SRC[e + (N)]; DST[e] = keep + __shfl_xor(send, (MASK)); }
                    float t0, t1;
                    { float b_[16], c_[8], d_[4], e_[2], f_[1]; TRSTEP(a0, b_, 16, 32) TRSTEP(b_, c_, 8, 16) TRSTEP(c_, d_, 4, 8) TRSTEP(d_, e_, 2, 4) TRSTEP(e_, f_, 1, 2) t0 = f_[0] + __shfl_xor(f_[0], 1); }
                    { float b_[16], c_[8], d_[4], e_[2], f_[1]; TRSTEP(a1, b_, 16, 32) TRSTEP(b_, c_, 8, 16) TRSTEP(c_, d_, 4, 8) TRSTEP(d_, e_, 2, 4) TRSTEP(e_, f_, 1, 2) t1 = f_[0] + __shfl_xor(f_[0], 1); }
#undef TRSTEP
                    { const int E = (lane >> 1) & 31; const float bias = rb[E]; if ((lane & 1) == 0) { LG[rr * 32 + E] = t0 + bias; LG[(rr + 1) * 32 + E] = t1 + bias; } }
                }
                asm volatile("s_waitcnt lgkmcnt(0)" ::: "memory");
                if (lane < 16) { const int lr = wave * 16 + lane; const size_t m = (size_t)r0 + lr; float lg[32];
#pragma unroll
                    for (int e4 = 0; e4 < 8; ++e4) { const f32x4 x = *(const LAS f32x4*)(LG + lane * 32 + e4 * 4); lg[e4 * 4] = x.x; lg[e4 * 4 + 1] = x.y; lg[e4 * 4 + 2] = x.z; lg[e4 * 4 + 3] = x.w; }
                    int se[4]; float sv[4];
#pragma unroll
                    for (int k = 0; k < 4; ++k) { float best = -INFINITY; int bi = 0;
#pragma unroll
                        for (int e = 0; e < 32; ++e) { if (lg[e] > best) { best = lg[e]; bi = e; } }
                        se[k] = bi; sv[k] = best;
#pragma unroll
                        for (int e = 0; e < 32; ++e) if (e == bi) lg[e] = -INFINITY; }
                    const float e1 = expf(sv[1] - sv[0]), e2 = expf(sv[2] - sv[0]), e3 = expf(sv[3] - sv[0]); const float inv = 1.f / (1.f + e1 + e2 + e3);
                    const float wts[4] = {inv, e1 * inv, e2 * inv, e3 * inv};
#pragma unroll
                    for (int k = 0; k < 4; ++k) { const int ls = __hip_atomic_fetch_add(lcnt + se[k], 1, __ATOMIC_RELAXED, __HIP_MEMORY_SCOPE_WORKGROUP); sele[lr * 4 + k] = se[k]; sels[lr * 4 + k] = ls; TOKW[m * 4 + k] = wts[k]; } }
                __syncthreads();
                if (tid < 32) lbase[tid] = (int)__hip_atomic_fetch_add(ctl + CW_CNT + l * 32 + tid, (unsigned)lcnt[tid], RLX_AGENT);
                __syncthreads();
                { const int e = sele[tid], sl = lbase[e] + sels[tid]; TOKE[(size_t)r0 * 4 + tid] = e; TOKS[(size_t)r0 * 4 + tid] = sl; LIST[(size_t)e * NTOK + sl] = r0 + (tid >> 2); }
                __syncthreads();
            }
        }
        SEAM(pb + 5);
#if defined(EXP_P1_NOEPI)
        if (IN(pb + 6)) {
            TID_SETUP(); unsigned char* ws = KWS(); bf16* HB = WSP(bf16, WS_HB); bf16* WIN_T = WSP(bf16, WS_WIN_T); bf16* PROJ = WSP(bf16, WS_PROJ);
            pg8::Gemm g{HB, WIN_T + (size_t)l * INP * DM, NTOK, INP, DM}; pg8::StaticOrder S; S.init(NTOK, INP, G, bx);
            pg8::EpiNull EN{PROJ}; pg8::gemm_phase<pg8::EpiNull, pg8::StaticOrder, true, true>(lds + RING_OFF, g, S, EN);
            __syncthreads(); }
#endif
        STAMP(pb + 7);
        if (IN(pb + 7) || IN(pb + 8) || IN(pb + 9)) {
            LAS int* pst = (LAS int*)(lctl + LC_PSTART); LAS int* ecnt = (LAS int*)(lctl + LC_BASE); gu32* ctl = (gu32*)(KWS() + WS_CTL);
            __syncthreads();
            if (threadIdx.x == 0) { int acc = 0; for (int e = 0; e < NE; ++e) { pst[e] = acc; const int c = (int)__hip_atomic_load(ctl + CW_CNT + l * 32 + e, RLX_AGENT); ecnt[e] = c; acc += (c + 255) >> 8; } pst[NE] = acc; }
            __syncthreads();
        }
        if (IN(pb + 7) && PON(8)) {
            TID_SETUP(); unsigned char* ws = KWS(); const float* exp_b_gu = KIN(15); const bf16* HB = WSP(bf16, WS_HB); const int* LIST = WSP(int, WS_XS); const bf16* WGU_T = WSP(bf16, WS_WGU_T); bf16* HID = WSP(bf16, WS_HID);
            const LAS int* pst = (const LAS int*)(lctl + LC_PSTART); LAS int* ul = (LAS int*)(lctl + LC_ULIST);
            const int nM = pst[NE], nN = 8, nwg = nM * nN;
            if (tid < 64) { const long L = (long)tid * G + bx; int v = -1;
                if (L < nwg) { int wgid = (int)L; { const int q = nwg / 8, r = nwg % 8, xcd = wgid % 8, off = wgid / 8; wgid = (xcd < r ? xcd * (q + 1) : r * (q + 1) + (xcd - r) * q) + off; }
                    const int nig = 8 * nN, gid = wgid / nig, fm = gid * 8, gsz = (nM - fm) < 8 ? (nM - fm) : 8; const int pm = fm + ((wgid % nig) % gsz), pn = (wgid % nig) / gsz;
                    int e = 0; for (int k = 1; k < NE; ++k) if (pst[k] <= pm) e = k;
                    v = (pm << 16) | (e * nN + pn); }
                ul[tid] = v; }
            __syncthreads();
            const int nunits = bx < nwg ? (nwg - bx + G - 1) / G : 0;
            LAS unsigned short* rows16 = (LAS unsigned short*)(lctl + LC_ROWS); const LAS int* ecnt = (const LAS int*)(lctl + LC_BASE);
            for (int sl = 0; sl < nunits; ++sl) { const int v = ul[sl]; const int pm = v >> 16, e = (v & 0xffff) >> 3, pl = pm - pst[e];
                if (tid < 256) { const int idx = pl * 256 + tid; rows16[sl * 256 + tid] = (idx < ecnt[e]) ? (unsigned short)LIST[(size_t)e * NTOK + idx] : (unsigned short)0; } }
            __syncthreads();
            pg8::Gemm g{HB, WGU_T + (size_t)l * NE * 2048 * DM, NTOK, NE * 2048, DM}; pg8::ListOrder S{ul, nunits};
            pg8::EpiSwiglu E{HID, exp_b_gu + (size_t)l * NE * 2048};
            pg8::gemm_phase_gather<pg8::EpiSwiglu, pg8::ListOrder, true>(lds + RING_OFF, g, S, E, rows16);
        }
        SEAM(pb + 7);
        if (IN(pb + 8) && PON(9)) {
            TID_SETUP(); unsigned char* ws = KWS(); const float* exp_b_down = KIN(17); const bf16* HID = WSP(bf16, WS_HID); const bf16* WDN_T = WSP(bf16, WS_WDN_T); bf16* YS = WSP(bf16, WS_YS);
            const LAS int* pst = (const LAS int*)(lctl + LC_PSTART); LAS int* ul = (LAS int*)(lctl + LC_ULIST);
            const int nM = pst[NE], nN = 4, nwg = nM * nN;
            __syncthreads();
            if (tid < 64) { const long L = (long)tid * G + bx; int v = -1;
                if (L < nwg) { int wgid = (int)L; { const int q = nwg / 8, r = nwg % 8, xcd = wgid % 8, off = wgid / 8; wgid = (xcd < r ? xcd * (q + 1) : r * (q + 1) + (xcd - r) * q) + off; }
                    const int nig = 8 * nN, gid = wgid / nig, fm = gid * 8, gsz = (nM - fm) < 8 ? (nM - fm) : 8; const int pm = fm + ((wgid % nig) % gsz), pn = (wgid % nig) / gsz;
                    int e = 0; for (int k = 1; k < NE; ++k) if (pst[k] <= pm) e = k;
                    v = (pm << 16) | (e * nN + pn); }
                ul[tid] = v; }
            __syncthreads();
            const int nunits = bx < nwg ? (nwg - bx + G - 1) / G : 0;
            pg8::Gemm g{HID, WDN_T + (size_t)l * NE * DM * DE, MPAD, NE * DM, DE}; pg8::ListOrder S{ul, nunits};
            pg8::EpiDown E{YS, exp_b_down + (size_t)l * NE * DM};
            pg8::gemm_phase<pg8::EpiDown, pg8::ListOrder, true, true>(lds + RING_OFF, g, S, E);
        }
        SEAM(pb + 8);
        if (IN(pb + 9) && PON(10)) {
            TID_SETUP(); unsigned char* ws = KWS(); const float* ln2_g = KIN(18); const float* ln2_b = KIN(19); float* out = KOUT(); bf16* HB = WSP(bf16, WS_HB);
            const bf16* YS = WSP(bf16, WS_YS); const int* TOKE = WSP(int, WS_TOK); const int* TOKS = TOKE + NTOK * 4; const float* TOKW = (const float*)(TOKS + NTOK * 4); const LAS int* pst = (const LAS int*)(lctl + LC_PSTART);
            const bool lastl = (l == NL - 1);
            f32x4 gam[4], bet[4];
#pragma unroll
            for (int j = 0; j < 4; ++j) { gam[j] = *(const f32x4*)(ln2_g + l * DM + RC(lane, j)); bet[j] = *(const f32x4*)(ln2_b + l * DM + RC(lane, j)); }
            for (int m0 = gw; m0 < NTOK; m0 += 2 * NGW) { f32x4 v[2][4]; const bf16* yr[2][4]; f32x4 wk[2];
#pragma unroll
                for (int q = 0; q < 2; ++q) { const int m = m0 + q * NGW; const v4u te = *(const v4u*)(TOKE + m * 4), ts = *(const v4u*)(TOKS + m * 4); wk[q] = *(const f32x4*)(TOKW + m * 4);
                    yr[q][0] = YS + (size_t)(pst[te.x] * 256 + (int)ts.x) * DM; yr[q][1] = YS + (size_t)(pst[te.y] * 256 + (int)ts.y) * DM; yr[q][2] = YS + (size_t)(pst[te.z] * 256 + (int)ts.z) * DM; yr[q][3] = YS + (size_t)(pst[te.w] * 256 + (int)ts.w) * DM;
                    row_load_bf16(v[q], HB + (size_t)m * DM, lane);
#pragma unroll
                    for (int j = 0; j < 4; ++j) v[q][j] = v[q][j] * DN_ALPHA; }
#pragma unroll
                for (int q = 0; q < 2; ++q)
#pragma unroll
                    for (int k = 0; k < 4; ++k) { f32x4 y[4]; row_load_bf16(y, yr[q][k], lane); const float w = wk[q][k];
#pragma unroll
                        for (int j = 0; j < 4; ++j) v[q][j] = v[q][j] + y[j] * w; }
#pragma unroll
                for (int q = 0; q < 2; ++q) { const int m = m0 + q * NGW; ln_row8(v[q], gam, bet);
                    if (lastl) {
#pragma unroll
                        for (int j = 0; j < 4; ++j) *(f32x4*)(out + (size_t)m * DM + RC(lane, j)) = v[q][j]; }
                    else row_store_bf16(v[q], HB + (size_t)m * DM, lane); } }
        }
        SEAM(pb + 9);
    }
#if PROBE_A >= 0
    { xcd_barrier(bar);
      const unsigned long long* st = (const unsigned long long*)(KWS() + WS_CTL + 65536); unsigned long long T = 0;
      if (PROBE_A & 1) T += st[1] - st[0];
      for (int l = 0; l < NL; ++l) for (int j = 1; j <= 10; ++j) if ((PROBE_A >> j) & 1) T += st[1 + 10 * l + j] - st[10 * l + j];
      if (PROBE_SUB_A >= 0) for (int l = 0; l < NL; ++l) T += st[128 + l * 16 + PROBE_SUB_B] - st[128 + l * 16 + PROBE_SUB_A];
      T *= 4ull; if (T > 5000000ull) T = 5000000ull;
      const unsigned long long t0 = __builtin_amdgcn_s_memrealtime();
      while (__builtin_amdgcn_s_memrealtime() - t0 < T) __builtin_amdgcn_s_sleep(16); }
#endif
#undef IN
#undef SEAM
}

#ifndef MK_PER_PHASE
#define MK_PER_PHASE 0
#endif
extern "C" void kernel_launch(void* const* d_in, const int* in_sizes, int n_in, void* d_out, int out_size, void* d_ws, size_t ws_size, hipStream_t stream) {
    static int grid = 0;
    if (grid == 0) {
        if (n_in != 20 || in_sizes[0] != NTOK * DM || out_size != NTOK * DM || ws_size < WS_END) { fprintf(stderr, "kernel_launch: unexpected shapes (n_in %d, in0 %d, out %d, ws %zu); nothing launched\n", n_in, n_in > 0 ? in_sizes[0] : -1, out_size, ws_size); grid = -1; return; }
        int dev = 0, cus = 0, per_cu = 0;
        if (hipGetDevice(&dev) != hipSuccess || hipDeviceGetAttribute(&cus, hipDeviceAttributeMultiprocessorCount, dev) != hipSuccess) { grid = -1; return; }
        if (hipFuncSetAttribute((const void*)fwd, hipFuncAttributeMaxDynamicSharedMemorySize, LDS_BYTES) != hipSuccess) { fprintf(stderr, "kernel_launch: hipFuncSetAttribute failed\n"); grid = -1; return; }
        if (hipOccupancyMaxActiveBlocksPerMultiprocessor(&per_cu, (const void*)fwd, NWAVES * 64, LDS_BYTES) != hipSuccess || per_cu < 1) fprintf(stderr, "kernel_launch: occupancy query reports %d\n", per_cu);
        (void)hipGetLastError();
        grid = cus;
    }
    if (grid < 0) return;
    if (hipMemsetAsync((char*)d_ws + WS_CTL, 0, CTL_ZERO_BYTES, stream) != hipSuccess) return;
    Args a{};
    for (int i = 0; i < 20; ++i) a.in[i] = (const float*)d_in[i];
    a.out = (float*)d_out; a.ws = (unsigned char*)d_ws;
#if MK_PER_PHASE
    for (int p = 0; p < N_PHASES; ++p) { a.ph_lo = p; a.ph_hi = p + 1; hipLaunchKernelGGL(fwd, dim3(grid), dim3(NWAVES * 64), LDS_BYTES, stream, a); }
#else
    a.ph_lo = 0; a.ph_hi = N_PHASES;
    hipLaunchKernelGGL(fwd, dim3(grid), dim3(NWAVES * 64), LDS_BYTES, stream, a);
#endif
    const hipError_t le = hipPeekAtLastError();
    if (le != hipSuccess) fprintf(stderr, "kernel_launch: launch failed: %s\n", hipGetErrorName(le));
}
```

```cpp
#include <hip/hip_runtime.h>
#include <hip/hip_bf16.h>
#include <cstdio>
#include <cstdint>
#include <cmath>
namespace pg8 {
#define PG8_LAS __attribute__((address_space(3)))
typedef unsigned short bf16_t;
typedef short bf16x8 __attribute__((ext_vector_type(8)));
typedef float f32x4 __attribute__((ext_vector_type(4)));
typedef unsigned u32x4 __attribute__((ext_vector_type(4)));
constexpr int BM = 256, BK = 64, HALF = 128, HTB = HALF * BK * 2  , STAGE_BYTES = 8 * HTB, NXCD = 8, WGM = 8;

__host__ __device__ __forceinline__ int lds_byte(int r, int c) { const int st = (r >> 4) * 2 + (c >> 5), rr = r & 15, cc = c & 31, ob = rr * 64 + cc * 2; return st * 1024 + (ob ^ (((ob >> 9) & 1) << 5)); }
__host__ __device__ __forceinline__ void stage_rc(int b, int& R, int& C) { const int st = b / 1024, sb = b % 1024, swz = sb ^ (((sb >> 9) & 1) << 5); R = (st >> 1) * 16 + swz / 64; C = (st & 1) * 32 + (swz % 64) / 2; }
__host__ __device__ __forceinline__ int perm32(int rho) { const int n = rho >> 4, i = rho & 15; return 8 * (i >> 2) + 4 * n + (i & 3); }

struct Unit { int pm, pn; };
struct Gemm { const bf16_t* A; const bf16_t* Bt; int M, N, K; };

struct StaticOrder {
    int nM, nN, nwg, G, c;
    __host__ __device__ void init(int M, int N, int G_, int c_) { nM = M / BM; nN = N / BM; nwg = nM * nN; G = G_; c = c_; }
    __host__ __device__ bool next(int i, Unit& u) const {
        const long L = (long)i * G + c; if (L >= nwg) return false;
        int wgid = (int)L; { const int q = nwg / NXCD, r = nwg % NXCD, xcd = wgid % NXCD, off = wgid / NXCD; wgid = (xcd < r ? xcd * (q + 1) : r * (q + 1) + (xcd - r) * q) + off; }
        const int nig = WGM * nN, gid = wgid / nig, fm = gid * WGM, gsz = (nM - fm) < WGM ? (nM - fm) : WGM;
        u.pm = fm + ((wgid % nig) % gsz); u.pn = (wgid % nig) / gsz; return true;
    }
    __device__ __forceinline__ void a_ready(const Unit&) const {}
    __device__ __forceinline__ void done(const Unit&) const {}
};

__device__ __forceinline__ unsigned cvt_pk_bf16(float lo, float hi) { unsigned r; asm volatile("v_cvt_pk_bf16_f32 %0, %1, %2" : "=v"(r) : "v"(lo), "v"(hi)); return r; }
typedef float f32x2 __attribute__((ext_vector_type(2)));
__device__ __forceinline__ u32x4 pack8(const f32x4 v0, const f32x4 v1) { u32x4 w; w.x = cvt_pk_bf16(v0[0], v0[1]); w.y = cvt_pk_bf16(v0[2], v0[3]); w.z = cvt_pk_bf16(v1[0], v1[1]); w.w = cvt_pk_bf16(v1[2], v1[3]); return w; }

struct EpiPlainBf16 {
    static constexpr bool PERM = true, AFTER_DRAIN = false;
    bf16_t* O; int ldc;
    __device__ __forceinline__ void operator()(const f32x4 (&acc)[2][2][4][2], const Unit& u, int wr, int wc, int fr, int fq) const {
        const int row0 = u.pm * BM + wr * 64 + fr, col0 = u.pn * BM + wc * 32 + 8 * fq;
#pragma unroll
        for (int ai = 0; ai < 2; ++ai)
#pragma unroll
            for (int m = 0; m < 4; ++m) { bf16_t* rowp = O + (size_t)(row0 + ai * HALF + m * 16) * ldc + col0;
#pragma unroll
                for (int bj = 0; bj < 2; ++bj) *(u32x4*)(rowp + bj * HALF) = pack8(acc[ai][bj][m][0], acc[ai][bj][m][1]); }
    }
};
struct EpiFnet {
    static constexpr bool PERM = true, AFTER_DRAIN = false;
    bf16_t* MIX;
    __device__ __forceinline__ void operator()(const f32x4 (&acc)[2][2][4][2], const Unit& u, int wr, int wc, int fr, int fq) const {
        const int row0 = u.pn * 4096 + u.pm * BM + wr * 64 + fr, col0 = 768 + wc * 32 + 8 * fq;
#pragma unroll
        for (int ai = 0; ai < 2; ++ai)
#pragma unroll
            for (int m = 0; m < 4; ++m) { bf16_t* rowp = MIX + (size_t)(row0 + ai * HALF + m * 16) * 1024 + col0;
#pragma unroll
                for (int bj = 0; bj < 2; ++bj) *(u32x4*)(rowp + bj * HALF) = pack8(acc[ai][bj][m][0], acc[ai][bj][m][1]); }
    }
};
struct EpiResF32 {
    static constexpr bool PERM = false, AFTER_DRAIN = false;
    const float* base; float* out; int ldc; float alpha;
    __device__ __forceinline__ void operator()(const f32x4 (&acc)[2][2][4][2], const Unit& u, int wr, int wc, int fr, int fq) const {
        const int row0 = u.pm * BM + wr * 64 + fr, col0 = u.pn * BM + wc * 32 + 4 * fq;
#pragma unroll
        for (int ai = 0; ai < 2; ++ai)
#pragma unroll
            for (int m = 0; m < 4; ++m) { const size_t off = (size_t)(row0 + ai * HALF + m * 16) * ldc + col0;
#pragma unroll
                for (int bj = 0; bj < 2; ++bj)
#pragma unroll
                    for (int n = 0; n < 2; ++n) { const f32x4 b = *(const f32x4*)(base + off + bj * HALF + n * 16); *(f32x4*)(out + off + bj * HALF + n * 16) = b * alpha + acc[ai][bj][m][n]; } }
    }
};
struct EpiResBf16 {
    static constexpr bool PERM = true, AFTER_DRAIN = false;
    const bf16_t* base; bf16_t* out; int ldc; float alpha;
    __device__ __forceinline__ void operator()(const f32x4 (&acc)[2][2][4][2], const Unit& u, int wr, int wc, int fr, int fq) const {
        const int row0 = u.pm * BM + wr * 64 + fr, col0 = u.pn * BM + wc * 32 + 8 * fq;
#pragma unroll
        for (int ai = 0; ai < 2; ++ai)
#pragma unroll
            for (int m = 0; m < 4; ++m) { const size_t off = (size_t)(row0 + ai * HALF + m * 16) * ldc + col0;
#pragma unroll
                for (int bj = 0; bj < 2; ++bj) { const u32x4 b = *(const u32x4*)(base + off + bj * HALF);
                    const f32x4 b0 = {__uint_as_float(b.x << 16), __uint_as_float(b.x & 0xffff0000u), __uint_as_float(b.y << 16), __uint_as_float(b.y & 0xffff0000u)};
                    const f32x4 b1 = {__uint_as_float(b.z << 16), __uint_as_float(b.z & 0xffff0000u), __uint_as_float(b.w << 16), __uint_as_float(b.w & 0xffff0000u)};
                    *(u32x4*)(out + off + bj * HALF) = pack8(b0 * alpha + acc[ai][bj][m][0], b1 * alpha + acc[ai][bj][m][1]); } }
    }
};
__device__ __forceinline__ float swiglu1(float g, float u) { g = fminf(g, 7.0f); u = fminf(fmaxf(u, -7.0f), 7.0f); return (u + 1.0f) * g * __builtin_amdgcn_rcpf(1.0f + __expf(-1.702f * g)); }
struct EpiSwiglu {
    static constexpr bool PERM = true, AFTER_DRAIN = false;
    bf16_t* HID; const float* bgu;
    __device__ __forceinline__ void operator()(const f32x4 (&acc)[2][2][4][2], const Unit& u, int wr, int wc, int fr, int fq) const {
        const int e = u.pn >> 3, pnl = u.pn & 7; const int row0 = u.pm * BM + wr * 64 + fr, jj0 = pnl * 128 + wc * 32 + 8 * fq;
        const float* bg = bgu + (size_t)e * 2048 + jj0;
        const f32x4 bg0 = *(const f32x4*)bg, bg1 = *(const f32x4*)(bg + 4), bu0 = *(const f32x4*)(bg + 1024), bu1 = *(const f32x4*)(bg + 1028);
#pragma unroll
        for (int ai = 0; ai < 2; ++ai)
#pragma unroll
            for (int m = 0; m < 4; ++m) { bf16_t* rowp = HID + (size_t)(row0 + ai * HALF + m * 16) * 1024 + jj0;
                const f32x4 g0 = acc[ai][0][m][0] + bg0, g1 = acc[ai][0][m][1] + bg1, u0 = acc[ai][1][m][0] + bu0, u1 = acc[ai][1][m][1] + bu1;
                f32x4 h0, h1;
#pragma unroll
                for (int i = 0; i < 4; ++i) { h0[i] = swiglu1(g0[i], u0[i]); h1[i] = swiglu1(g1[i], u1[i]); }
                *(u32x4*)rowp = pack8(h0, h1); }
    }
};
struct EpiDown {
    static constexpr bool PERM = true, AFTER_DRAIN = false;
    bf16_t* Y; const float* bd;
    __device__ __forceinline__ void operator()(const f32x4 (&acc)[2][2][4][2], const Unit& u, int wr, int wc, int fr, int fq) const {
        const int e = u.pn >> 2, pnl = u.pn & 3; const int row0 = u.pm * BM + wr * 64 + fr, col0 = pnl * BM + wc * 32 + 8 * fq;
        const float* bp = bd + (size_t)e * 1024 + col0;
        f32x4 bv[2][2];
#pragma unroll
        for (int bj = 0; bj < 2; ++bj)
#pragma unroll
            for (int n = 0; n < 2; ++n) bv[bj][n] = *(const f32x4*)(bp + bj * HALF + 4 * n);
#pragma unroll
        for (int ai = 0; ai < 2; ++ai)
#pragma unroll
            for (int m = 0; m < 4; ++m) { bf16_t* rowp = Y + (size_t)(row0 + ai * HALF + m * 16) * 1024 + col0;
#pragma unroll
                for (int bj = 0; bj < 2; ++bj) *(u32x4*)(rowp + bj * HALF) = pack8(acc[ai][bj][m][0] + bv[bj][0], acc[ai][bj][m][1] + bv[bj][1]); }
    }
};
struct EpiNull {
    static constexpr bool PERM = true, AFTER_DRAIN = false;
    bf16_t* O;
    __device__ __forceinline__ void operator()(const f32x4 (&acc)[2][2][4][2], const Unit& u, int wr, int wc, int fr, int fq) const {
#pragma unroll
        for (int ai = 0; ai < 2; ++ai)
#pragma unroll
            for (int bj = 0; bj < 2; ++bj)
#pragma unroll
                for (int m = 0; m < 4; ++m)
#pragma unroll
                    for (int n = 0; n < 2; ++n) asm volatile("" :: "v"(acc[ai][bj][m][n]));
    }
};
struct ListOrder {
    const PG8_LAS int* list; int n;
    __device__ __forceinline__ bool next(int i, Unit& u) const { if (i >= n) return false; const int v = __builtin_amdgcn_readfirstlane(list[i]); u.pm = v >> 16; u.pn = v & 0xffff; return true; }
    __device__ __forceinline__ void a_ready(const Unit&) const {}
    __device__ __forceinline__ void done(const Unit&) const {}
};
template <class Epi, class Sched, bool ALIGN_EPI = false, bool SP2 = false>
__device__ __forceinline__ void gemm_phase(PG8_LAS unsigned char* lds, const Gemm g, const Sched& S, const Epi& E) {
    int tid_ = threadIdx.x; asm volatile("" : "+v"(tid_));
    const int tid = tid_, wid = __builtin_amdgcn_readfirstlane(tid >> 6), lane = tid & 63, wr = wid >> 2, wc = wid & 3, fr = lane & 15, fq = lane >> 4;
    const int K = g.K, nt = K / BK;
    unsigned voffA[2], voffB[2];
#pragma unroll
    for (int i = 0; i < 2; ++i) { int R, C; stage_rc(tid * 16 + i * 8192, R, C); const int Rb = Epi::PERM ? ((R & ~31) + perm32(R & 31)) : R;
        voffA[i] = (unsigned)(R * K + C) * 2u; voffB[i] = (unsigned)(Rb * K + C) * 2u; }
    const size_t kstep = (size_t)(BK * 2);
    const size_t hstep = (size_t)HALF * K * 2;
    const size_t tstep = 2 * hstep;
    const unsigned ldsw = (unsigned)wid * 1024u;
    const int aoff = lds_byte(wr * 64 + fr, fq * 8), boff = lds_byte(wc * 32 + fr, fq * 8);
#define PG8_SA(b, h) (((b) * 2 + (h)) * HTB)
#define PG8_SB(b, h) ((4 + (b) * 2 + (h)) * HTB)
#define PG8_STAGE(bufoff, gbase, voff) do { _Pragma("unroll") for (int _i = 0; _i < 2; ++_i) \
        __builtin_amdgcn_global_load_lds((const unsigned*)((const char*)(gbase) + (voff)[_i]), (PG8_LAS unsigned*)(lds + (bufoff) + ldsw + _i * 8192), 16, 0, 0); } while (0)
#define PG8_LDA(dst, b, h) do { _Pragma("unroll") for (int m = 0; m < 4; ++m) _Pragma("unroll") for (int k = 0; k < 2; ++k) dst[m][k] = *(const PG8_LAS bf16x8*)(lds + PG8_SA(b, h) + aoff + m * 2048 + k * 1024); } while (0)
#define PG8_LDB(dst, b, h) do { _Pragma("unroll") for (int n = 0; n < 2; ++n) _Pragma("unroll") for (int k = 0; k < 2; ++k) dst[n][k] = *(const PG8_LAS bf16x8*)(lds + PG8_SB(b, h) + boff + n * 2048 + k * 1024); } while (0)
#define PG8_MMA(ai, bj, At, Bt) do { __builtin_amdgcn_s_setprio(1); _Pragma("unroll") for (int m = 0; m < 4; ++m) _Pragma("unroll") for (int n = 0; n < 2; ++n) _Pragma("unroll") for (int k = 0; k < 2; ++k) \
        acc[ai][bj][m][n] = __builtin_amdgcn_mfma_f32_16x16x32_bf16(Bt[n][k], At[m][k], acc[ai][bj][m][n], 0, 0, 0); __builtin_amdgcn_s_setprio(0); } while (0)
#define PG8_WAIT_V(n) asm volatile("s_waitcnt vmcnt(" #n ")" ::: "memory")
#define PG8_WAIT_L(n) asm volatile("s_waitcnt lgkmcnt(" #n ")" ::: "memory")
#define PG8_BAR __builtin_amdgcn_s_barrier()
#define PG8_SCHED __builtin_amdgcn_sched_barrier(0)
    Unit cur, nxt; int ui = 0;
    if (!S.next(0, cur)) return;
    f32x4 acc[2][2][4][2];
#pragma unroll
    for (int a = 0; a < 2; ++a)
#pragma unroll
        for (int b = 0; b < 2; ++b)
#pragma unroll
            for (int m = 0; m < 4; ++m)
#pragma unroll
                for (int n = 0; n < 2; ++n) acc[a][b][m][n] = (f32x4){0.f, 0.f, 0.f, 0.f};
    bf16x8 At[4][2], B0[2][2], B1[2][2];
    const char* cA = (const char*)g.A + (size_t)cur.pm * tstep; const char* cB = (const char*)g.Bt + (size_t)cur.pn * tstep;
    S.a_ready(cur);
    if constexpr (SP2) {
        PG8_STAGE(PG8_SB(0, 0), cB, voffB); PG8_STAGE(PG8_SB(0, 1), cB + hstep, voffB); PG8_STAGE(PG8_SA(0, 0), cA, voffA); PG8_STAGE(PG8_SA(0, 1), cA + hstep, voffA);
        if (wr == 1) PG8_BAR;
        PG8_WAIT_V(2); PG8_BAR;
        PG8_STAGE(PG8_SB(1, 0), cB + kstep, voffB); PG8_STAGE(PG8_SA(1, 0), cA + kstep, voffA); PG8_STAGE(PG8_SB(1, 1), cB + hstep + kstep, voffB);
        PG8_WAIT_V(6); PG8_BAR;
    } else {
        PG8_STAGE(PG8_SB(0, 0), cB, voffB); PG8_STAGE(PG8_SA(0, 0), cA, voffA); PG8_STAGE(PG8_SB(0, 1), cB + hstep, voffB); PG8_STAGE(PG8_SA(0, 1), cA + hstep, voffA);
        if (wr == 1) PG8_BAR;
        PG8_WAIT_V(4); PG8_BAR;
        PG8_STAGE(PG8_SB(1, 0), cB + kstep, voffB); PG8_STAGE(PG8_SA(1, 0), cA + kstep, voffA); PG8_STAGE(PG8_SB(1, 1), cB + hstep + kstep, voffB);
        PG8_WAIT_V(6); PG8_BAR;
    }
    for (;;) {
        const bool has_next = S.next(ui + 1, nxt);
        const char* nA = has_next ? (const char*)g.A + (size_t)nxt.pm * tstep : cA; const char* nB = has_next ? (const char*)g.Bt + (size_t)nxt.pn * tstep : cB;
        for (int t = 0; t < nt; t += 2) {
            const bool last = (t == nt - 2);
            const char* a1 = cA + (size_t)(t + 1) * kstep;
            const char* a2 = last ? nA : cA + (size_t)(t + 2) * kstep; const char* b2 = last ? nB : cB + (size_t)(t + 2) * kstep;
            const char* a3 = a2 + kstep; const char* b3 = b2 + kstep;
            if (last && has_next) S.a_ready(nxt);
            if constexpr (SP2) {
            PG8_LDB(B0, 0, 0); PG8_LDB(B1, 0, 1); PG8_SCHED; PG8_LDA(At, 0, 0); PG8_STAGE(PG8_SA(1, 1), a1 + hstep, voffA);
            PG8_WAIT_V(8); PG8_WAIT_L(0); PG8_BAR; PG8_MMA(0, 0, At, B0); PG8_MMA(0, 1, At, B1); PG8_BAR; PG8_SCHED;
            PG8_LDA(At, 0, 1); PG8_STAGE(PG8_SB(0, 0), b2, voffB); PG8_STAGE(PG8_SB(0, 1), b2 + hstep, voffB); PG8_STAGE(PG8_SA(0, 0), a2, voffA);
            PG8_WAIT_V(8); PG8_WAIT_L(0); PG8_BAR; PG8_MMA(1, 0, At, B0); PG8_MMA(1, 1, At, B1); PG8_BAR; PG8_SCHED;
            PG8_LDB(B0, 1, 0); PG8_LDB(B1, 1, 1); PG8_SCHED; PG8_LDA(At, 1, 0); PG8_STAGE(PG8_SA(0, 1), a2 + hstep, voffA);
            PG8_WAIT_V(8); PG8_WAIT_L(0); PG8_BAR; PG8_MMA(0, 0, At, B0); PG8_MMA(0, 1, At, B1); PG8_BAR; PG8_SCHED;
            PG8_LDA(At, 1, 1); PG8_STAGE(PG8_SB(1, 0), b3, voffB); PG8_STAGE(PG8_SB(1, 1), b3 + hstep, voffB); PG8_STAGE(PG8_SA(1, 0), a3, voffA);
            PG8_WAIT_V(8); PG8_WAIT_L(0); PG8_BAR; PG8_MMA(1, 0, At, B0); PG8_MMA(1, 1, At, B1); PG8_BAR; PG8_SCHED;
            } else {
            PG8_LDB(B0, 0, 0); PG8_SCHED; PG8_LDA(At, 0, 0); PG8_STAGE(PG8_SA(1, 1), a1 + hstep, voffA);
            PG8_WAIT_L(8); PG8_BAR; PG8_WAIT_L(0); PG8_MMA(0, 0, At, B0); PG8_BAR; PG8_SCHED;
            PG8_LDB(B1, 0, 1); PG8_STAGE(PG8_SB(0, 0), b2, voffB);
            PG8_BAR; PG8_WAIT_L(0); PG8_MMA(0, 1, At, B1); PG8_BAR;
            PG8_LDA(At, 0, 1); PG8_STAGE(PG8_SA(0, 0), a2, voffA);
            PG8_BAR; PG8_WAIT_L(0); PG8_MMA(1, 0, At, B0); PG8_BAR; PG8_SCHED;
            PG8_STAGE(PG8_SB(0, 1), b2 + hstep, voffB);
            PG8_WAIT_V(6); PG8_BAR; PG8_MMA(1, 1, At, B1); PG8_BAR;
            PG8_LDB(B0, 1, 0); PG8_SCHED; PG8_LDA(At, 1, 0); PG8_STAGE(PG8_SA(0, 1), a2 + hstep, voffA);
            PG8_WAIT_L(8); PG8_BAR; PG8_WAIT_L(0); PG8_MMA(0, 0, At, B0); PG8_BAR; PG8_SCHED;
            PG8_LDB(B1, 1, 1); PG8_STAGE(PG8_SB(1, 0), b3, voffB);
            PG8_BAR; PG8_WAIT_L(0); PG8_MMA(0, 1, At, B1); PG8_BAR;
            PG8_LDA(At, 1, 1); PG8_STAGE(PG8_SA(1, 0), a3, voffA);
            PG8_BAR; PG8_WAIT_L(0); PG8_MMA(1, 0, At, B0); PG8_BAR; PG8_SCHED;
            PG8_STAGE(PG8_SB(1, 1), b3 + hstep, voffB);
            PG8_WAIT_V(6); PG8_BAR; PG8_MMA(1, 1, At, B1); PG8_BAR;
            }
        }
        if constexpr (ALIGN_EPI) { if (wr == 0) PG8_BAR; }
        if constexpr (!Epi::AFTER_DRAIN) { E(acc, cur, wr, wc, fr, fq); S.done(cur); }
        if (!has_next) break;
#pragma unroll
        for (int a = 0; a < 2; ++a)
#pragma unroll
            for (int b = 0; b < 2; ++b)
#pragma unroll
                for (int m = 0; m < 4; ++m)
#pragma unroll
                    for (int n = 0; n < 2; ++n) acc[a][b][m][n] = (f32x4){0.f, 0.f, 0.f, 0.f};
        cur = nxt; cA = nA; cB = nB; ++ui;
        if constexpr (ALIGN_EPI) { if (wr == 1) PG8_BAR; }
    }
    PG8_WAIT_V(0);
    if constexpr (!ALIGN_EPI) { if (wr == 0) PG8_BAR; }
    PG8_BAR;
    if constexpr (Epi::AFTER_DRAIN) { E.fused(acc, cur, wr, wc, fr, fq, lds, wid, lane); S.done(cur); }
#undef PG8_SA
#undef PG8_SB
#undef PG8_STAGE
#undef PG8_LDA
#undef PG8_LDB
#undef PG8_MMA
#undef PG8_WAIT_V
#undef PG8_WAIT_L
#undef PG8_BAR
#undef PG8_SCHED
}
}
namespace pg8 {
template <class Epi, class Sched, bool ALIGN_EPI>
__device__ __forceinline__ void gemm_phase_gather(PG8_LAS unsigned char* lds, const Gemm g, const Sched& S, const Epi& E, const PG8_LAS unsigned short* rows16) {
    int tid_ = threadIdx.x; asm volatile("" : "+v"(tid_));
    const int tid = tid_, wid = __builtin_amdgcn_readfirstlane(tid >> 6), lane = tid & 63, wr = wid >> 2, wc = wid & 3, fr = lane & 15, fq = lane >> 4;
    const int K = g.K, nt = K / BK;
    unsigned voffB[2]; int RA[2]; unsigned CA2[2];
#pragma unroll
    for (int i = 0; i < 2; ++i) { int R, C; stage_rc(tid * 16 + i * 8192, R, C); const int Rb = Epi::PERM ? ((R & ~31) + perm32(R & 31)) : R;
        RA[i] = R; CA2[i] = (unsigned)C * 2u; voffB[i] = (unsigned)(Rb * K + C) * 2u; }
    const size_t kstep = (size_t)(BK * 2);
    const size_t hstep = (size_t)HALF * K * 2;
    const size_t tstep = 2 * hstep;
    const unsigned ldsw = (unsigned)wid * 1024u;
    const unsigned rowb = (unsigned)K * 2u;
    const int aoff = lds_byte(wr * 64 + fr, fq * 8), boff = lds_byte(wc * 32 + fr, fq * 8);
#define PG8_SA(b, h) (((b) * 2 + (h)) * HTB)
#define PG8_SB(b, h) ((4 + (b) * 2 + (h)) * HTB)
#define PG8_STAGE(bufoff, gbase, voff) do { _Pragma("unroll") for (int _i = 0; _i < 2; ++_i) \
        __builtin_amdgcn_global_load_lds((const unsigned*)((const char*)(gbase) + (voff)[_i]), (PG8_LAS unsigned*)(lds + (bufoff) + ldsw + _i * 8192), 16, 0, 0); } while (0)
#define PG8_LDA(dst, b, h) do { _Pragma("unroll") for (int m = 0; m < 4; ++m) _Pragma("unroll") for (int k = 0; k < 2; ++k) dst[m][k] = *(const PG8_LAS bf16x8*)(lds + PG8_SA(b, h) + aoff + m * 2048 + k * 1024); } while (0)
#define PG8_LDB(dst, b, h) do { _Pragma("unroll") for (int n = 0; n < 2; ++n) _Pragma("unroll") for (int k = 0; k < 2; ++k) dst[n][k] = *(const PG8_LAS bf16x8*)(lds + PG8_SB(b, h) + boff + n * 2048 + k * 1024); } while (0)
#define PG8_MMA(ai, bj, At, Bt) do { __builtin_amdgcn_s_setprio(1); _Pragma("unroll") for (int m = 0; m < 4; ++m) _Pragma("unroll") for (int n = 0; n < 2; ++n) _Pragma("unroll") for (int k = 0; k < 2; ++k) \
        acc[ai][bj][m][n] = __builtin_amdgcn_mfma_f32_16x16x32_bf16(Bt[n][k], At[m][k], acc[ai][bj][m][n], 0, 0, 0); __builtin_amdgcn_s_setprio(0); } while (0)
#define PG8_WAIT_V(n) asm volatile("s_waitcnt vmcnt(" #n ")" ::: "memory")
#define PG8_WAIT_L(n) asm volatile("s_waitcnt lgkmcnt(" #n ")" ::: "memory")
#define PG8_BAR __builtin_amdgcn_s_barrier()
#define PG8_SCHED __builtin_amdgcn_sched_barrier(0)
#define PG8_GOFF(dst, U) do { _Pragma("unroll") for (int h_ = 0; h_ < 2; ++h_) _Pragma("unroll") for (int i_ = 0; i_ < 2; ++i_) dst[h_][i_] = (unsigned)rows16[(U) * 256 + h_ * HALF + RA[i_]] * rowb + CA2[i_]; } while (0)
    Unit cur, nxt; int ui = 0;
    if (!S.next(0, cur)) return;
    f32x4 acc[2][2][4][2];
#pragma unroll
    for (int a = 0; a < 2; ++a)
#pragma unroll
        for (int b = 0; b < 2; ++b)
#pragma unroll
            for (int m = 0; m < 4; ++m)
#pragma unroll
                for (int n = 0; n < 2; ++n) acc[a][b][m][n] = (f32x4){0.f, 0.f, 0.f, 0.f};
    bf16x8 At[4][2], B0[2][2], B1[2][2];
    const char* const Ab = (const char*)g.A;
    const char* cB = (const char*)g.Bt + (size_t)cur.pn * tstep;
    unsigned gc[2][2], gn[2][2];
    PG8_GOFF(gc, 0);
    S.a_ready(cur);
    PG8_STAGE(PG8_SB(0, 0), cB, voffB); PG8_STAGE(PG8_SB(0, 1), cB + hstep, voffB); PG8_STAGE(PG8_SA(0, 0), Ab, gc[0]); PG8_STAGE(PG8_SA(0, 1), Ab, gc[1]);
    if (wr == 1) PG8_BAR;
    PG8_WAIT_V(2); PG8_BAR;
    PG8_STAGE(PG8_SB(1, 0), cB + kstep, voffB); PG8_STAGE(PG8_SA(1, 0), Ab + kstep, gc[0]); PG8_STAGE(PG8_SB(1, 1), cB + hstep + kstep, voffB);
    PG8_WAIT_V(6); PG8_BAR;
    for (;;) {
        const bool has_next = S.next(ui + 1, nxt);
        const char* nB = has_next ? (const char*)g.Bt + (size_t)nxt.pn * tstep : cB;
        if (has_next) { PG8_GOFF(gn, ui + 1); } else {
#pragma unroll
            for (int h_ = 0; h_ < 2; ++h_)
#pragma unroll
                for (int i_ = 0; i_ < 2; ++i_) gn[h_][i_] = gc[h_][i_]; }
        for (int t = 0; t < nt; t += 2) {
            const bool last = (t == nt - 2);
            const char* a1 = Ab + (size_t)(t + 1) * kstep;
            const char* a2 = last ? Ab : Ab + (size_t)(t + 2) * kstep; const char* b2 = last ? nB : cB + (size_t)(t + 2) * kstep;
            const char* a3 = a2 + kstep; const char* b3 = b2 + kstep;
            unsigned g2[2][2];
#pragma unroll
            for (int h_ = 0; h_ < 2; ++h_)
#pragma unroll
                for (int i_ = 0; i_ < 2; ++i_) g2[h_][i_] = last ? gn[h_][i_] : gc[h_][i_];
            if (last && has_next) S.a_ready(nxt);
            PG8_LDB(B0, 0, 0); PG8_LDB(B1, 0, 1); PG8_SCHED; PG8_LDA(At, 0, 0); PG8_STAGE(PG8_SA(1, 1), a1, gc[1]);
            PG8_WAIT_V(8); PG8_WAIT_L(0); PG8_BAR; PG8_MMA(0, 0, At, B0); PG8_MMA(0, 1, At, B1); PG8_BAR; PG8_SCHED;
            PG8_LDA(At, 0, 1); PG8_STAGE(PG8_SB(0, 0), b2, voffB); PG8_STAGE(PG8_SB(0, 1), b2 + hstep, voffB); PG8_STAGE(PG8_SA(0, 0), a2, g2[0]);
            PG8_WAIT_V(8); PG8_WAIT_L(0); PG8_BAR; PG8_MMA(1, 0, At, B0); PG8_MMA(1, 1, At, B1); PG8_BAR; PG8_SCHED;
            PG8_LDB(B0, 1, 0); PG8_LDB(B1, 1, 1); PG8_SCHED; PG8_LDA(At, 1, 0); PG8_STAGE(PG8_SA(0, 1), a2, g2[1]);
            PG8_WAIT_V(8); PG8_WAIT_L(0); PG8_BAR; PG8_MMA(0, 0, At, B0); PG8_MMA(0, 1, At, B1); PG8_BAR; PG8_SCHED;
            PG8_LDA(At, 1, 1); PG8_STAGE(PG8_SB(1, 0), b3, voffB); PG8_STAGE(PG8_SB(1, 1), b3 + hstep, voffB); PG8_STAGE(PG8_SA(1, 0), a3, g2[0]);
            PG8_WAIT_V(8); PG8_WAIT_L(0); PG8_BAR; PG8_MMA(1, 0, At, B0); PG8_MMA(1, 1, At, B1); PG8_BAR; PG8_SCHED;
        }
        if constexpr (ALIGN_EPI) { if (wr == 0) PG8_BAR; }
        E(acc, cur, wr, wc, fr, fq); S.done(cur);
        if (!has_next) break;
#pragma unroll
        for (int a = 0; a < 2; ++a)
#pragma unroll
            for (int b = 0; b < 2; ++b)
#pragma unroll
                for (int m = 0; m < 4; ++m)
#pragma unroll
                    for (int n = 0; n < 2; ++n) acc[a][b][m][n] = (f32x4){0.f, 0.f, 0.f, 0.f};
        cur = nxt; cB = nB; ++ui;
#pragma unroll
        for (int h_ = 0; h_ < 2; ++h_)
#pragma unroll
            for (int i_ = 0; i_ < 2; ++i_) gc[h_][i_] = gn[h_][i_];
        if constexpr (ALIGN_EPI) { if (wr == 1) PG8_BAR; }
    }
    PG8_WAIT_V(0);
    if constexpr (!ALIGN_EPI) { if (wr == 0) PG8_BAR; }
    PG8_BAR;
#undef PG8_SA
#undef PG8_SB
#undef PG8_STAGE
#undef PG8_LDA
#undef PG8_LDB
#undef PG8_MMA
#undef PG8_WAIT_V
#undef PG8_WAIT_L
#undef PG8_BAR
#undef PG8_SCHED
#undef PG8_GOFF
}
}
#define GAS __attribute__((address_space(1)))
#define LAS __attribute__((address_space(3)))
typedef unsigned short bf16;
typedef unsigned v4u __attribute__((ext_vector_type(4)));
typedef float f32x4 __attribute__((ext_vector_type(4)));
typedef short bf16x8 __attribute__((ext_vector_type(8)));
typedef GAS unsigned gu32;
typedef GAS unsigned long long gu64;
#define RLX_AGENT __ATOMIC_RELAXED, __HIP_MEMORY_SCOPE_AGENT
#define LDS_WAIT() asm volatile("s_waitcnt lgkmcnt(0)" ::: "memory")
#define VM_WAIT() asm volatile("s_waitcnt vmcnt(0)" ::: "memory")
__device__ __forceinline__ unsigned long long rt() { return __builtin_amdgcn_s_memrealtime(); }
__device__ __forceinline__ unsigned f2bf(float f) { unsigned u = __builtin_bit_cast(unsigned, f); return (u + 0x7fffu + ((u >> 16) & 1u)) >> 16; }
__device__ __forceinline__ unsigned pk2(float lo, float hi) { return f2bf(lo) | (f2bf(hi) << 16); }
#define XB_TMO      128
#define XB_XCNT(j)  (256  + 64 * (j))
#define XB_XSUB(j)  (1280 + 64 * (j))
#define XB_XGEN(j)  (2304 + 64 * (j))
#define XB_TOP      3328
#define XB_TOPGEN   3392
#define XCD_BAR_WORDS 3456
#define XB_SPIN_CAP (1u << 18)

__device__ __forceinline__ unsigned xb_ld(unsigned* p)              { return __hip_atomic_load(p, __ATOMIC_RELAXED, __HIP_MEMORY_SCOPE_AGENT); }
__device__ __forceinline__ unsigned xb_add(unsigned* p, unsigned v) { return __hip_atomic_fetch_add(p, v, __ATOMIC_RELAXED, __HIP_MEMORY_SCOPE_AGENT); }
__device__ __forceinline__ unsigned xb_xcc_id() { return (unsigned)__builtin_amdgcn_s_getreg((3 << 11) | 20) & 0xFu; }
#define XB_SPIN(cond, bar) do { unsigned _sp = 0; while (cond) { __builtin_amdgcn_s_sleep(1); \
    if ((++_sp & 255u) == 0u) { if (xb_ld(&(bar)[XB_TMO])) break; if (_sp > XB_SPIN_CAP) { atomicAdd(&(bar)[XB_TMO], 1u); break; } } } } while (0)

struct XcdBarrier {
    unsigned* bar; unsigned x;
    volatile LAS unsigned* st;
};

__device__ __forceinline__ XcdBarrier xcd_barrier_post(unsigned* bar, volatile LAS unsigned* st) {
    XcdBarrier b; b.bar = bar; b.x = xb_xcc_id(); b.st = st;
    if (threadIdx.x == 0) (void)xb_add(&bar[XB_XCNT(b.x)], 1u);
    return b;
}
__device__ __forceinline__ void xcd_barrier_complete(unsigned* bar, unsigned x, unsigned& nloc, unsigned& nx) {
    const unsigned G = gridDim.x * gridDim.y * gridDim.z;
    unsigned sum, cnt, mine, sp = 0u;
    for (;;) {
        sum = 0u; cnt = 0u; mine = 0u;
#pragma unroll
        for (unsigned j = 0; j < 16; ++j) { const unsigned c = xb_ld(&bar[XB_XCNT(j)]); sum += c; cnt += (c > 0u) ? 1u : 0u; mine = (j == x) ? c : mine; }
        if (sum == G) break;
        __builtin_amdgcn_s_sleep(1);
        if ((++sp & 255u) == 0u) { if (xb_ld(&bar[XB_TMO])) break; if (sp > XB_SPIN_CAP) { atomicAdd(&bar[XB_TMO], 1u); break; } }
    }
    nloc = mine > 0u ? mine : 1u; nx = cnt > 0u ? cnt : 1u;
}

__device__ __forceinline__ void xcd_barrier(const XcdBarrier& b) {
    asm volatile("s_waitcnt vmcnt(0)" ::: "memory");
    __syncthreads();
    if (threadIdx.x == 0) {
        unsigned* bar = b.bar;
        __builtin_amdgcn_s_waitcnt(0);
        unsigned nloc = b.st[0], nx = b.st[1];
        if (nloc == 0u) { xcd_barrier_complete(bar, b.x, nloc, nx); b.st[0] = nloc; b.st[1] = nx; }
        const unsigned old = xb_add(&bar[XB_XSUB(b.x)], 1u);
        const unsigned gen = old / nloc;
        if (old + 1u == (gen + 1u) * nloc) {
            __builtin_amdgcn_fence(__ATOMIC_RELEASE, "agent");
            asm volatile("s_waitcnt vmcnt(0)" ::: "memory");
            const unsigned og = xb_add(&bar[XB_TOP], 1u);
            const unsigned tg = og / nx;
            if (og + 1u == (tg + 1u) * nx) xb_add(&bar[XB_TOPGEN], 1u);
            else XB_SPIN(xb_ld(&bar[XB_TOPGEN]) == tg, bar);
            __builtin_amdgcn_fence(__ATOMIC_ACQUIRE, "agent");
            xb_add(&bar[XB_XGEN(b.x)], 1u);
            asm volatile("s_waitcnt vmcnt(0)" ::: "memory");
        } else {
            XB_SPIN(xb_ld(&bar[XB_XGEN(b.x)]) == gen, bar);
            __builtin_amdgcn_fence(__ATOMIC_ACQUIRE, "agent");
            asm volatile("s_waitcnt vmcnt(0)" ::: "memory");
        }
    }
    __syncthreads();
}
namespace attn_body {
using bf16=__hip_bfloat16;
using bf16x8=__attribute__((ext_vector_type(8)))short;
using s16x4=__attribute__((ext_vector_type(4)))short;
using f32x16=__attribute__((ext_vector_type(16)))float;
using u32x4=__attribute__((ext_vector_type(4)))unsigned;
constexpr int BATCH=8,NHEAD=8,NKVH=2,SEQ=4096,D=64;
constexpr int DMQ=512,DMK=128,DMV=2048,DMO=1024;
constexpr int NW=8,QBLK=32,QB=QBLK*NW,KVBLK=64,NQB=SEQ/QB;
constexpr int ATTN_UNIT_ROWS=QB;
__device__ __forceinline__ int crow(int r,int hi){return (r&3)+8*(r>>2)+4*hi;}
#define SBAR() __builtin_amdgcn_sched_barrier(0)
__device__ __forceinline__ void cmask(f32x16&p0,f32x16&p1,int jb,int qrel,int hi){
  const float NEG=-INFINITY; int kb=64*jb+4*hi;
  #pragma unroll
  for(int r=0;r<16;++r){int kv=kb+(r&3)+8*(r>>2); if(kv>qrel)p0[r]=NEG; if(kv+32>qrel)p1[r]=NEG;}
}

constexpr int NSLOT=3, SLOTB=8192;
constexpr int LDS_K=0, LDS_V=NSLOT*SLOTB, LDS_WS=2*NSLOT*SLOTB, LDS_OST=LDS_WS+NW*64*4, LDS_BYTES=LDS_OST+NW*4096;
constexpr float C2=0.125f*1.4426950408889634f;
__device__ __forceinline__ void glds16(const void*gsrc,unsigned lds_dst){unsigned keep;
  asm volatile("s_mov_b32 %0, m0\n\ts_mov_b32 m0, %2\n\ts_nop 0\n\tglobal_load_lds_dwordx4 %1, off\n\ts_mov_b32 m0, %0":"=&s"(keep):"v"(gsrc),"s"(lds_dst):"memory");}
__device__ __forceinline__ float max3f(float a,float b,float c){float r;asm("v_max3_f32 %0, %1, %2, %3":"=v"(r):"v"(a),"v"(b),"v"(c));return r;}
__device__ __forceinline__ float max2f(float a,float b){float r;asm("v_max_f32_e32 %0, %1, %2":"=v"(r):"v"(a),"v"(b));return r;}
__device__ __forceinline__ float fadd_s(float a,float b){float r;asm("v_add_f32_e32 %0, %1, %2":"=v"(r):"v"(a),"v"(b));return r;}
__device__ __forceinline__ float fsub_s(float a,float b){float r;asm("v_sub_f32_e32 %0, %1, %2":"=v"(r):"v"(a),"v"(b));return r;}
typedef float f32x2_t __attribute__((ext_vector_type(2))); typedef __bf16 bf16x2_t __attribute__((ext_vector_type(2)));
__device__ __forceinline__ unsigned cvtpk_s(float lo,float hi){f32x2_t v={lo,hi};bf16x2_t b=__builtin_convertvector(v,bf16x2_t);return __builtin_bit_cast(unsigned,b);}
#define WAIT_BAR(N) asm volatile("s_waitcnt vmcnt(" #N ") lgkmcnt(0)\n\ts_barrier":::"memory")

__device__ __forceinline__ void qkt(f32x16&p0,f32x16&p1,const char*Kslot,const bf16x8*qr,const f32x16&negm,int r32,int hi){
  const char*kb=Kslot+hi*1024+r32*16;
  #pragma unroll
  for(int d0=0;d0<4;++d0){
    const bf16x8 b0=*reinterpret_cast<const bf16x8*>(kb+d0*2048);
    const bf16x8 b1=*reinterpret_cast<const bf16x8*>(kb+d0*2048+512);
    if(d0==0){p0=__builtin_amdgcn_mfma_f32_32x32x16_bf16(b0,qr[0],negm,0,0,0);p1=__builtin_amdgcn_mfma_f32_32x32x16_bf16(b1,qr[0],negm,0,0,0);}
    else{p0=__builtin_amdgcn_mfma_f32_32x32x16_bf16(b0,qr[d0],p0,0,0,0);p1=__builtin_amdgcn_mfma_f32_32x32x16_bf16(b1,qr[d0],p1,0,0,0);}}
}
typedef __attribute__((address_space(3))) const char* lds_cptr;
typedef short v4i16_t __attribute__((ext_vector_type(4)));
__device__ __forceinline__ void kload8(bf16x8*kf,lds_cptr kp){
  kf[0]=*(const __attribute__((address_space(3))) bf16x8*)(kp);      kf[1]=*(const __attribute__((address_space(3))) bf16x8*)(kp+512);
  kf[2]=*(const __attribute__((address_space(3))) bf16x8*)(kp+2048); kf[3]=*(const __attribute__((address_space(3))) bf16x8*)(kp+2560);
  kf[4]=*(const __attribute__((address_space(3))) bf16x8*)(kp+4096); kf[5]=*(const __attribute__((address_space(3))) bf16x8*)(kp+4608);
  kf[6]=*(const __attribute__((address_space(3))) bf16x8*)(kp+6144); kf[7]=*(const __attribute__((address_space(3))) bf16x8*)(kp+6656);
}
__device__ __forceinline__ void kload2(bf16x8*kf,lds_cptr kp,int j){ kf[2*j]=*(const __attribute__((address_space(3))) bf16x8*)(kp+j*2048); kf[2*j+1]=*(const __attribute__((address_space(3))) bf16x8*)(kp+j*2048+512); }
__device__ __forceinline__ s16x4 vtr(lds_cptr p){ return __builtin_bit_cast(s16x4,__builtin_amdgcn_ds_read_tr16_b64_v4i16((__attribute__((address_space(3))) v4i16_t*)p)); }
__device__ __forceinline__ float rowmax(const f32x16&p0,const f32x16&p1){
  float a=max3f(p0[0],p0[1],p1[0]),b=max3f(p0[2],p0[3],p1[1]);a=max3f(a,p1[2],p1[3]);
  #pragma unroll
  for(int r=4;r<16;r+=4){a=max3f(a,p0[r],p0[r+1]);b=max3f(b,p0[r+2],p0[r+3]);a=max3f(a,p1[r],p1[r+1]);b=max3f(b,p1[r+2],p1[r+3]);}
  const float m=max2f(a,b);
  auto rr=__builtin_amdgcn_permlane32_swap(__float_as_uint(m),__float_as_uint(m),false,false);
  return max2f(__uint_as_float(rr[0]),__uint_as_float(rr[1]));
}
__device__ __forceinline__ void pv(f32x16*o,int vb,bf16x8 pa0,bf16x8 pa1,bf16x8 pa2,bf16x8 pa3){
  #pragma unroll
  for(int d0=0;d0<2;++d0){s16x4 lo[4],hi[4];
    #pragma unroll
    for(int ks=0;ks<4;++ks){
      asm volatile("ds_read_b64_tr_b16 %0,%1 offset:%c2":"=&v"(lo[ks]):"v"(vb),"i"(d0*4096+ks*1024):"memory");
      asm volatile("ds_read_b64_tr_b16 %0,%1 offset:%c2":"=&v"(hi[ks]):"v"(vb),"i"(d0*4096+ks*1024+512):"memory");}
    asm volatile("s_waitcnt lgkmcnt(0)":::"memory");SBAR();
    #define PK(k) (bf16x8){lo[k][0],lo[k][1],lo[k][2],lo[k][3],hi[k][0],hi[k][1],hi[k][2],hi[k][3]}
    o[d0]=__builtin_amdgcn_mfma_f32_32x32x16_bf16(pa0,PK(0),o[d0],0,0,0);
    o[d0]=__builtin_amdgcn_mfma_f32_32x32x16_bf16(pa1,PK(1),o[d0],0,0,0);
    o[d0]=__builtin_amdgcn_mfma_f32_32x32x16_bf16(pa2,PK(2),o[d0],0,0,0);
    o[d0]=__builtin_amdgcn_mfma_f32_32x32x16_bf16(pa3,PK(3),o[d0],0,0,0);
    #undef PK
  }
}

#ifndef ATTN_STORE16
#define ATTN_STORE16(p,v) (*(u32x4*)(p)=(v))
#endif
template<int THRL> __device__ __forceinline__ void attn_unit(int b,int h,int qb,const bf16*Q,const bf16*__restrict__ K,const bf16*__restrict__ V,bf16*O,char*shm){
  int tid_=threadIdx.x; asm volatile("":"+v"(tid_)); const int tid=tid_,lane=tid&63,r32=lane&31,hi=lane>>5; const int wid=__builtin_amdgcn_readfirstlane(tid>>6);
  const long rowbase=(long)b*SEQ; const int q0=qb*QB;
  const bf16*Qw=Q+(rowbase+q0+wid*QBLK)*DMQ+h*D; const int kvh=h>>2;
  const bf16*Kh=K+rowbase*DMK+kvh*D,*Vh=V+rowbase*DMV+kvh*D;
  const unsigned lds0=(unsigned)(uintptr_t)shm;
  float*wsf=(float*)(shm+LDS_WS)+wid*64;
  const bf16*ksrc=Kh+(long)lane*DMK+wid*8;
  const bf16*vsrc=Vh+(long)(16*(wid&3)+(lane>>2))*DMV+(wid>>2)*32+(lane&3)*8;
  const unsigned kdst=lds0+LDS_K+wid*1024, vdst=lds0+LDS_V+wid*1024;
  #define DMA_K(t,slot) glds16(ksrc+(long)(t)*KVBLK*DMK,(unsigned)__builtin_amdgcn_readfirstlane(kdst+(slot)))
  #define DMA_V(t,slot) glds16(vsrc+(long)(t)*KVBLK*DMV,(unsigned)__builtin_amdgcn_readfirstlane(vdst+(slot)))
  const int vb0=(int)(lds0+LDS_V)+((lane>>4)&1)*32+(lane&3)*8+(4*hi+((lane&15)>>2))*64;
  const char*Kbase=shm+LDS_K; bf16x8 kf[8];
  const lds_cptr shm3=(lds_cptr)shm; const lds_cptr kp0=shm3+LDS_K+hi*1024+r32*16; const lds_cptr vp0=shm3+LDS_V+((lane>>4)&1)*32+(lane&3)*8+(4*hi+((lane&15)>>2))*64;
  constexpr int NT=SEQ/KVBLK;
  DMA_K(0,0);DMA_V(0,0);DMA_K(1,SLOTB);
  bf16x8 qr[4];
  #pragma unroll
  for(int d0=0;d0<4;++d0)qr[d0]=*reinterpret_cast<const bf16x8*>(&Qw[(long)r32*DMQ+d0*16+hi*8]);
  float mhat=0.f,l_reg=0.f;f32x16 o[2];o[0]=f32x16{};o[1]=f32x16{};f32x16 negm=f32x16{};asm volatile("":"+v"(negm));
  #define CMASK(P0,P1,t) do{}while(0)
  bool resc=false;
  #define START(P0,P1) do{ const float rm=rowmax(P0,P1); resc=false; \
    { const float dl=rm; mhat=fadd_s(mhat,dl); \
      _Pragma("unroll") for(int r=0;r<16;++r){P0[r]=fsub_s(P0[r],dl);P1[r]=fsub_s(P1[r],dl);} \
      _Pragma("unroll") for(int r=0;r<16;++r)negm[r]=-mhat; asm volatile("":"+v"(negm)); } \
    _Pragma("unroll") for(int r=0;r<16;++r)P0[r]=__builtin_amdgcn_exp2f(P0[r]); }while(0)
  #define RESC() do{ if(resc){ asm volatile("s_waitcnt lgkmcnt(0)":::"memory"); \
      _Pragma("unroll") for(int d_=0;d_<2;++d_) _Pragma("unroll") for(int r=0;r<16;++r)o[d_][r]*=wsf[crow(r,hi)]; } }while(0)
  f32x16 pA0,pA1,pB0,pB1;
  int sl_prev=0,sl_cur=0,sl_next=SLOTB;
  #define ROT() do{sl_prev=sl_cur;sl_cur=sl_next;sl_next=(sl_next==(NSLOT-1)*SLOTB)?0:sl_next+SLOTB;}while(0)
  DMA_K(2,2*SLOTB);
  WAIT_BAR(3);
  qkt(pA0,pA1,Kbase,qr,negm,r32,hi);asm volatile("s_nop 15\n\ts_nop 7":"+v"(pA0),"+v"(pA1));CMASK(pA0,pA1,0);
  START(pA0,pA1);
  _Pragma("unroll") for(int r=0;r<16;++r)pA1[r]=__builtin_amdgcn_exp2f(pA1[r]);
  WAIT_BAR(0);
  DMA_K(3,0);DMA_V(1,SLOTB);
  ROT();
  kload8(kf,kp0+sl_cur);
  WAIT_BAR(2);
  s16x4 vlo[8],vhi[8]; u32x4 pw0,pw1,pw2,pw3;
  #define PKW(P,B) cvtpk_s(P[B],P[B+1])
  #define PAF(k) __builtin_bit_cast(bf16x8,pw##k)
  #define VFR(i) (bf16x8){vlo[i][0],vlo[i][1],vlo[i][2],vlo[i][3],vhi[i][0],vhi[i][1],vhi[i][2],vhi[i][3]}
  #define PIN(x) asm volatile("":"+v"(x))
  #define MX3(a,b,c) __builtin_fmaxf(__builtin_fmaxf((a),(b)),(c))
  #define GAPA(MF,A0,A1,A2,A3,W0,W1,PW) do{ MF; sacc+=A0; sacc+=A1; sacc+=A2; sacc+=A3; PIN(sacc); W0; W1; PIN(PW); SBAR(); }while(0)
  #define EX(v) __builtin_amdgcn_exp2f(v)
  #define GAPB(MF,X,B) do{ MF; X[B]=EX(X[B]); X[B+1]=EX(X[B+1]); X[B+2]=EX(X[B+2]); X[B+3]=EX(X[B+3]); PIN(X); SBAR(); }while(0)
  #define VRD(i) do{ vlo[i]=vtr(vp_+(((i)>>2)*4096+((i)&3)*1024)); vhi[i]=vtr(vp_+(((i)>>2)*4096+((i)&3)*1024+512)); }while(0)
  #define KRD(G,j) do{ if(G){ kload2(kf,kp0+sl_next,j); SBAR(); } }while(0)
  #define STEP(C0,C1,P0,P1,t,GK,GV,GL) do{ SBAR(); \
    const lds_cptr vp_=vp0+sl_prev; \
    VRD(0); SBAR(); float sacc=(P0[0]+P0[1]); \
    GAPA(C0=__builtin_amdgcn_mfma_f32_32x32x16_bf16(kf[0],qr[0],negm,0,0,0), P0[2],P0[3],P0[4],P0[5],     pw0[0]=PKW(P0,0), pw0[1]=PKW(P0,2), pw0); \
    VRD(4); SBAR(); GAPA(C1=__builtin_amdgcn_mfma_f32_32x32x16_bf16(kf[1],qr[0],negm,0,0,0), P0[6],P0[7],P0[8],P0[9],     pw0[2]=PKW(P0,4), pw0[3]=PKW(P0,6), pw0); \
    VRD(1); SBAR(); GAPA(C0=__builtin_amdgcn_mfma_f32_32x32x16_bf16(kf[2],qr[1],C0,0,0,0),   P0[10],P0[11],P0[12],P0[13], pw1[0]=PKW(P0,8), pw1[1]=PKW(P0,10), pw1); \
    VRD(5); SBAR(); GAPA(C1=__builtin_amdgcn_mfma_f32_32x32x16_bf16(kf[3],qr[1],C1,0,0,0),   P0[14],P0[15],P1[0],P1[1],   pw1[2]=PKW(P0,12),pw1[3]=PKW(P0,14), pw1); \
    VRD(2); SBAR(); GAPA(C0=__builtin_amdgcn_mfma_f32_32x32x16_bf16(kf[4],qr[2],C0,0,0,0),   P1[2],P1[3],P1[4],P1[5],     pw2[0]=PKW(P1,0), pw2[1]=PKW(P1,2), pw2); \
    VRD(6); SBAR(); GAPA(C1=__builtin_amdgcn_mfma_f32_32x32x16_bf16(kf[5],qr[2],C1,0,0,0),   P1[6],P1[7],P1[8],P1[9],     pw2[2]=PKW(P1,4), pw2[3]=PKW(P1,6), pw2); \
    VRD(3); SBAR(); GAPA(C0=__builtin_amdgcn_mfma_f32_32x32x16_bf16(kf[6],qr[3],C0,0,0,0),   P1[10],P1[11],P1[12],P1[13], pw3[0]=PKW(P1,8), pw3[1]=PKW(P1,10), pw3); \
    VRD(7); SBAR(); GAPA(C1=__builtin_amdgcn_mfma_f32_32x32x16_bf16(kf[7],qr[3],C1,0,0,0),   P1[14],P1[15],0.f,0.f,       pw3[2]=PKW(P1,12),pw3[3]=PKW(P1,14), pw3); \
    l_reg+=sacc; \
    if(GK){DMA_K((t)+3,sl_cur);} if(GV){DMA_V((t)+1,sl_next);} \
    CMASK(C0,C1,t); \
    { float a=MX3(C0[0],C0[1],C1[0]),b=MX3(C0[2],C0[3],C1[1]); a=MX3(a,C1[2],C1[3]); \
      _Pragma("unroll") for(int r=4;r<16;r+=4){a=MX3(a,C0[r],C0[r+1]);b=MX3(b,C0[r+2],C0[r+3]);a=MX3(a,C1[r],C1[r+1]);b=MX3(b,C1[r+2],C1[r+3]);} \
      float rm=__builtin_fmaxf(a,b); { auto rr=__builtin_amdgcn_permlane32_swap(__float_as_uint(rm),__float_as_uint(rm),false,false); rm=__builtin_fmaxf(__uint_as_float(rr[0]),__uint_as_float(rr[1])); } \
      resc=false; \
      if(__builtin_expect(__any(rm>(float)THRL),0)){ const float dl=__builtin_fmaxf(rm,0.f); mhat+=dl; \
        _Pragma("unroll") for(int r=0;r<16;++r){C0[r]-=dl;C1[r]-=dl;} \
        _Pragma("unroll") for(int r=0;r<16;++r)negm[r]=-mhat; asm volatile("":"+v"(negm)); \
        const float f=__builtin_amdgcn_exp2f(-dl); l_reg*=f; if(hi==0)wsf[r32]=f; resc=true; } } \
    SBAR(); \
    GAPB(o[0]=__builtin_amdgcn_mfma_f32_32x32x16_bf16(PAF(0),VFR(0),o[0],0,0,0), C0,0); \
    GAPB(o[1]=__builtin_amdgcn_mfma_f32_32x32x16_bf16(PAF(0),VFR(4),o[1],0,0,0), C0,4); \
    KRD(GL,0); GAPB(o[0]=__builtin_amdgcn_mfma_f32_32x32x16_bf16(PAF(1),VFR(1),o[0],0,0,0), C0,8); \
    KRD(GL,1); GAPB(o[1]=__builtin_amdgcn_mfma_f32_32x32x16_bf16(PAF(1),VFR(5),o[1],0,0,0), C0,12); \
    KRD(GL,2); GAPB(o[0]=__builtin_amdgcn_mfma_f32_32x32x16_bf16(PAF(2),VFR(2),o[0],0,0,0), C1,0); \
    KRD(GL,3); GAPB(o[1]=__builtin_amdgcn_mfma_f32_32x32x16_bf16(PAF(2),VFR(6),o[1],0,0,0), C1,4); \
    GAPB(o[0]=__builtin_amdgcn_mfma_f32_32x32x16_bf16(PAF(3),VFR(3),o[0],0,0,0), C1,8); \
    GAPB(o[1]=__builtin_amdgcn_mfma_f32_32x32x16_bf16(PAF(3),VFR(7),o[1],0,0,0), C1,12); \
    }while(0)
  int t=1;
  #undef CMASK
  #define CMASK(P0,P1,t) do{}while(0)
  for(;t+5<NT;t+=2){
    STEP(pB0,pB1,pA0,pA1,t,true,true,true);     WAIT_BAR(2); RESC(); ROT();
    STEP(pA0,pA1,pB0,pB1,t+1,true,true,true);   WAIT_BAR(2); RESC(); ROT();
  }
  #undef CMASK
  #define CMASK(P0,P1,t) do{}while(0)
  #define ENDW(tt) do{ if((tt)+3<NT){WAIT_BAR(2);} else if((tt)+2<NT){WAIT_BAR(1);} else {WAIT_BAR(0);} }while(0)
  for(;t+1<NT;t+=2){
    STEP(pB0,pB1,pA0,pA1,t,(t+3<NT),(t+1<NT),(t+1<NT));       ENDW(t);   RESC(); ROT();
    STEP(pA0,pA1,pB0,pB1,t+1,(t+4<NT),(t+2<NT),(t+2<NT));     ENDW(t+1); RESC(); ROT();
  }
  STEP(pB0,pB1,pA0,pA1,NT-1,false,false,false); RESC();
  { float sacc=pB0[0]+pB0[1]; _Pragma("unroll") for(int r=2;r<16;++r)sacc+=pB0[r]; _Pragma("unroll") for(int r=0;r<16;++r)sacc+=pB1[r]; l_reg+=sacc;
    pw0=(u32x4){PKW(pB0,0),PKW(pB0,2),PKW(pB0,4),PKW(pB0,6)};pw1=(u32x4){PKW(pB0,8),PKW(pB0,10),PKW(pB0,12),PKW(pB0,14)};pw2=(u32x4){PKW(pB1,0),PKW(pB1,2),PKW(pB1,4),PKW(pB1,6)};pw3=(u32x4){PKW(pB1,8),PKW(pB1,10),PKW(pB1,12),PKW(pB1,14)};
    SBAR(); pv(o,vb0+sl_cur,PAF(0),PAF(1),PAF(2),PAF(3)); }
  #undef PKW
  #undef PAF
  #undef VFR
  #undef PIN
  #undef MX3
  #undef GAPA
  #undef GAPB
  #undef EX
  #undef VRD
  #undef KRD
  #undef STEP
  #undef ENDW
  {auto rr=__builtin_amdgcn_permlane32_swap(__float_as_uint(l_reg),__float_as_uint(l_reg),false,false);l_reg=__uint_as_float(rr[0])+__uint_as_float(rr[1]);}
  if(hi==0)wsf[32+r32]=l_reg;asm volatile("s_waitcnt lgkmcnt(0)":::"memory");
  float rli[16];
  #pragma unroll
  for(int r=0;r<16;++r)rli[r]=__builtin_amdgcn_rcpf(wsf[32+crow(r,hi)]);
  bf16*Ow=O+(rowbase+q0+wid*QBLK)*DMO+h*D;
  { bf16*stg=(bf16*)(shm+LDS_OST)+wid*2048;
    #pragma unroll
    for(int r=0;r<16;++r){const int orow=crow(r,hi);
      #pragma unroll
      for(int d0=0;d0<2;++d0)stg[orow*64+d0*32+r32]=__float2bfloat16(o[d0][r]*rli[r]);}
    asm volatile("s_waitcnt lgkmcnt(0)":::"memory");
    #pragma unroll
    for(int i=0;i<4;++i){const int row=i*8+(lane>>3),ch=lane&7; const u32x4 v=*(const u32x4*)(stg+row*64+ch*8); ATTN_STORE16(Ow+(long)row*DMO+ch*8,v);} }
  asm volatile("s_waitcnt lgkmcnt(0)\n\ts_barrier":::"memory");
  #undef DMA_K
  #undef DMA_V
  #undef CMASK
  #undef START
  #undef RESC
  #undef ROT
}
constexpr int ATTN_LDS_BYTES=LDS_BYTES;
struct AttnTensors { const bf16* Q; const bf16* K; const bf16* V; bf16* O; };
struct AttnUnit { int bh; int qb; };
struct StaticOrder {
  int vcu, G;
  __device__ __forceinline__ explicit StaticOrder(int grid,int block):vcu((grid%8==0)?(block%8)*(grid/8)+block/8:block),G(grid){}
  __device__ __forceinline__ bool next(int i,AttnUnit&u)const{ const int per=(BATCH*NHEAD*NQB+G-1)/G; if(i>=per)return false; const int idx=vcu*per+i; if(idx>=BATCH*NHEAD*NQB)return false;
    const int qb=idx%NQB, hq=(idx/NQB)&3, bk=idx/(NQB*4), kvh=bk&1, b=bk>>1; u.bh=b*NHEAD+kvh*4+hq; u.qb=qb; return true; }
  __device__ __forceinline__ void a_ready(const AttnUnit&)const{}
  __device__ __forceinline__ void done(const AttnUnit&)const{}
};
template<class Sched,int THRL=8> __device__ __forceinline__ void attn_phase(char*lds,const AttnTensors&T,const Sched&S){
  AttnUnit u;
  for(int i=0;S.next(i,u);++i){ S.a_ready(u); attn_unit<THRL>(u.bh/NHEAD,u.bh%NHEAD,u.qb,T.Q,T.K,T.V,T.O,lds); S.done(u); }
}
#undef SBAR
#undef WAIT_BAR
}
constexpr int NB = 8, SEQ = 4096, DM = 1024, NL = 4, NTOK = NB * SEQ;
constexpr int INW = 1824, INP = 2048;
constexpr int C_AQ = 0, C_AK = 512, C_AV = 640, C_GQ = 768, C_GK = 896, C_GV = 1024, C_GR = 1280, C_FX = 1536, C_GLR = 1792;
constexpr int NE = 32, TOPK = 4, DE = 1024;
constexpr int MPAD = NTOK * TOPK + NE * 256;
constexpr float LN_EPS = 1e-5f, RMS_EPS = 1e-6f;
constexpr float DN_ALPHA = 1.681792830507429f;
constexpr float QSCALE = 0.125f * 1.4426950408889634f;
constexpr float GLA_QSCALE = 0.17677669529663687f;

constexpr size_t MiB = 1u << 20;
constexpr size_t WS_CTL = 0, CTL_ZERO_BYTES = 1 * MiB;
constexpr size_t WS_ROPE = 1 * MiB;
constexpr size_t WS_WIN_T = 2 * MiB;
constexpr size_t WS_WOUT_T = 18 * MiB;
constexpr size_t WS_FTAB = 26 * MiB;
constexpr size_t WS_TW = WS_FTAB + 65536;
constexpr size_t WS_FTMP = 27 * MiB;
constexpr size_t WS_WGU_T = 90 * MiB;
constexpr size_t WS_WDN_T = 602 * MiB;
constexpr size_t WS_HF = 858 * MiB;
constexpr size_t WS_HB = 986 * MiB;
constexpr size_t WS_PROJ = 1050 * MiB;
constexpr size_t WS_QB = 1178 * MiB;
constexpr size_t WS_KB = 1210 * MiB;
constexpr size_t WS_MIX = 1218 * MiB;
constexpr size_t WS_T1 = 1282 * MiB;
constexpr size_t WS_UVT = 1410 * MiB;
constexpr size_t WS_LA = 1442 * MiB;
constexpr size_t WS_OF = 1474 * MiB;
constexpr size_t WS_OB = 1506 * MiB;
constexpr size_t WS_TOK = 1538 * MiB;
constexpr size_t WS_XS = 1542 * MiB;
constexpr size_t WS_HID = 1814 * MiB;
constexpr size_t WS_YS = 2086 * MiB;
constexpr size_t WS_END = 2358 * MiB;
static_assert((size_t)MPAD * 2048 == 272 * MiB, "sorted buffers");
constexpr int CW_TMO = 0, CW_CODE = 1, CW_BAR = 4096, CW_CNT = 8192;

constexpr int RING_OFF = 0, RING_BYTES = 131072;
constexpr int LDSCTL_OFF = RING_BYTES;
constexpr int LDS_BYTES = 163840;
constexpr int LC_MISC = 0;
constexpr int LC_PSTART = 128;
constexpr int LC_ULIST = 384;
constexpr int LC_CNT = 640;
constexpr int LC_BASE = 768;
constexpr int LC_SELE = 1024;
constexpr int LC_SELS = 1024 + 2048;
constexpr int LC_COS64 = 5120;
constexpr int LC_ROWS = 6144;
constexpr int LC_LG = 16384;

constexpr int NWAVES = 8;
constexpr int N_PHASES = 1 + 10 * NL;

typedef float f32x2_t __attribute__((ext_vector_type(2))); typedef __bf16 bf16x2_t __attribute__((ext_vector_type(2)));
__device__ __forceinline__ unsigned cvtpk2(float lo, float hi) { f32x2_t v = {lo, hi}; bf16x2_t b = __builtin_convertvector(v, bf16x2_t); return __builtin_bit_cast(unsigned, b); }
#define pk2(lo, hi) cvtpk2((lo), (hi))
#define f2bf(x) (cvtpk2((x), 0.f) & 0xffffu)
__device__ __forceinline__ float bf2f(unsigned short b) { return __uint_as_float((unsigned)b << 16); }
__device__ __forceinline__ float wave_sum(float v) {
#pragma unroll
    for (int o = 1; o < 64; o <<= 1) v += __shfl_xor(v, o);
    return v;
}
typedef unsigned short u16x8 __attribute__((ext_vector_type(8)));
typedef unsigned short u16x4 __attribute__((ext_vector_type(4)));

typedef float f32x2v __attribute__((ext_vector_type(2)));
__device__ __forceinline__ void tr_task(const float* W, int K, int Nsrc, int srcn, bf16* WT, int dst_n, int k0) {
#pragma unroll 1
    for (int hf = 0; hf < 2; ++hf) { const int kk = k0 + hf * 64; f32x2v v[64];
        if (srcn >= 0) { const float* p = W + (size_t)kk * Nsrc + srcn;
#pragma unroll
            for (int i = 0; i < 64; ++i) v[i] = __builtin_nontemporal_load((const f32x2v*)(p + (size_t)i * Nsrc)); }
        else {
#pragma unroll
            for (int i = 0; i < 64; ++i) v[i] = (f32x2v){0.f, 0.f}; }
        bf16* o0 = WT + (size_t)dst_n * K + kk; bf16* o1 = o0 + K;
#pragma unroll
        for (int j = 0; j < 8; ++j) { v4u w0, w1;
            w0.x = pk2(v[8 * j].x, v[8 * j + 1].x); w0.y = pk2(v[8 * j + 2].x, v[8 * j + 3].x); w0.z = pk2(v[8 * j + 4].x, v[8 * j + 5].x); w0.w = pk2(v[8 * j + 6].x, v[8 * j + 7].x);
            w1.x = pk2(v[8 * j].y, v[8 * j + 1].y); w1.y = pk2(v[8 * j + 2].y, v[8 * j + 3].y); w1.z = pk2(v[8 * j + 4].y, v[8 * j + 5].y); w1.w = pk2(v[8 * j + 6].y, v[8 * j + 7].y);
            *(v4u*)(o0 + 8 * j) = w0; *(v4u*)(o1 + 8 * j) = w1; } }
}

#define RC(l, j) (((j) >> 1) * 512 + 8 * (l) + ((j) & 1) * 4)
__device__ __forceinline__ void row_load_bf16(f32x4 (&v)[4], const bf16* row, int lane) {
#pragma unroll
    for (int h = 0; h < 2; ++h) { const v4u t = *(const v4u*)(row + h * 512 + 8 * lane);
        v[2 * h] = (f32x4){__uint_as_float(t.x << 16), __uint_as_float(t.x & 0xffff0000u), __uint_as_float(t.y << 16), __uint_as_float(t.y & 0xffff0000u)};
        v[2 * h + 1] = (f32x4){__uint_as_float(t.z << 16), __uint_as_float(t.z & 0xffff0000u), __uint_as_float(t.w << 16), __uint_as_float(t.w & 0xffff0000u)}; }
}
__device__ __forceinline__ void row_store_bf16(const f32x4 (&v)[4], bf16* row, int lane) {
#pragma unroll
    for (int h = 0; h < 2; ++h) { v4u w; w.x = pk2(v[2 * h].x, v[2 * h].y); w.y = pk2(v[2 * h].z, v[2 * h].w); w.z = pk2(v[2 * h + 1].x, v[2 * h + 1].y); w.w = pk2(v[2 * h + 1].z, v[2 * h + 1].w); *(v4u*)(row + h * 512 + 8 * lane) = w; }
}
__device__ __forceinline__ void ln_row8(f32x4 (&v)[4], const f32x4 (&gam)[4], const f32x4 (&bet)[4]) {
    float s = 0.f;
#pragma unroll
    for (int j = 0; j < 4; ++j) s += (v[j].x + v[j].y) + (v[j].z + v[j].w);
    const float mean = wave_sum(s) * (1.f / DM); float s2 = 0.f;
#pragma unroll
    for (int j = 0; j < 4; ++j) { v[j] = v[j] - mean; s2 += (v[j].x * v[j].x + v[j].y * v[j].y) + (v[j].z * v[j].z + v[j].w * v[j].w); }
    const float rstd = __builtin_amdgcn_rsqf(wave_sum(s2) * (1.f / DM) + LN_EPS);
#pragma unroll
    for (int j = 0; j < 4; ++j) v[j] = v[j] * rstd * gam[j] + bet[j];
}

constexpr int GM_QF = 0, GM_KF = 5120, GM_QB = 10240, GM_KB = 15360, GM_VT = 20480, GM_P = 29696, GM_HTF = 38912, GM_HTB = 44032, GM_DL = 38912, GM_SLOT = 49152;
static_assert(2 * GM_SLOT <= RING_BYTES, "two GLA chunk images fit the phase scratch");
#define MFMA16(a, b, c) __builtin_amdgcn_mfma_f32_16x16x32_bf16((a), (b), (c), 0, 0, 0)
template <bool OUT>
__device__ __forceinline__ void gla_stage_mfma(LAS unsigned char* Ls, const bf16* PROJ, const float* LA, const float* HIN, size_t tok0, int hd, int w4, int lane) {
    if (w4 < 2) { const int dir = w4, g = lane >> 3, c4 = (lane & 7) * 4; f32x4 bc[8]; u16x4 kx[8], qx[8];
        const float* lap = LA + (tok0 + 8 * g) * 256 + dir * 128 + hd * 32 + c4; const bf16* xp = PROJ + (tok0 + 8 * g) * INP + hd * 32 + c4;
#pragma unroll
        for (int i = 0; i < 8; ++i) { bc[i] = *(const f32x4*)(lap + (size_t)i * 256); kx[i] = *(const u16x4*)(xp + (size_t)i * INP + C_GK); if (OUT) qx[i] = *(const u16x4*)(xp + (size_t)i * INP + C_GQ); }
        f32x4 inc;
        if (dir == 0) {
#pragma unroll
            for (int i = 1; i < 8; ++i) bc[i] = bc[i] + bc[i - 1];
            inc = bc[7];
#pragma unroll
            for (int o = 1; o < 8; o <<= 1) { f32x4 y; y.x = __shfl_up(inc.x, 8 * o); y.y = __shfl_up(inc.y, 8 * o); y.z = __shfl_up(inc.z, 8 * o); y.w = __shfl_up(inc.w, 8 * o); if (g >= o) inc = inc + y; }
            const f32x4 off = inc - bc[7];
#pragma unroll
            for (int i = 0; i < 8; ++i) bc[i] = bc[i] + off; }
        else {
#pragma unroll
            for (int i = 6; i >= 0; --i) bc[i] = bc[i] + bc[i + 1];
            inc = bc[0];
#pragma unroll
            for (int o = 1; o < 8; o <<= 1) { f32x4 y; y.x = __shfl_down(inc.x, 8 * o); y.y = __shfl_down(inc.y, 8 * o); y.z = __shfl_down(inc.z, 8 * o); y.w = __shfl_down(inc.w, 8 * o); if (g + o < 8) inc = inc + y; }
            const f32x4 off = inc - bc[0];
#pragma unroll
            for (int i = 0; i < 8; ++i) bc[i] = bc[i] + off; }
        if (OUT) { LAS bf16* qd = (LAS bf16*)(Ls + (dir ? GM_QB : GM_QF)) + (8 * g) * 40 + c4; LAS bf16* kd = (LAS bf16*)(Ls + (dir ? GM_KB : GM_KF)) + (8 * g) * 40 + c4;
#pragma unroll
            for (int i = 0; i < 8; ++i) { float qv[4], kv[4];
#pragma unroll
                for (int c = 0; c < 4; ++c) { const float e_ = __expf(bc[i][c]); qv[c] = bf2f(qx[i][c]) * GLA_QSCALE * e_; kv[c] = bf2f(kx[i][c]) * __builtin_amdgcn_rcpf(e_); }
                *(LAS unsigned long long*)(qd + i * 40) = (unsigned long long)pk2(qv[0], qv[1]) | ((unsigned long long)pk2(qv[2], qv[3]) << 32);
                *(LAS unsigned long long*)(kd + i * 40) = (unsigned long long)pk2(kv[0], kv[1]) | ((unsigned long long)pk2(kv[2], kv[3]) << 32); } }
        else { LAS bf16* kt = (LAS bf16*)(Ls + GM_P + dir * 4608) + c4 * 72 + 8 * g;
#pragma unroll
            for (int c = 0; c < 4; ++c) { float t[8];
#pragma unroll
                for (int i = 0; i < 8; ++i) t[i] = bf2f(kx[i][c]) * __expf(-bc[i][c]);
                v4u w; w.x = pk2(t[0], t[1]); w.y = pk2(t[2], t[3]); w.z = pk2(t[4], t[5]); w.w = pk2(t[6], t[7]); *(LAS v4u*)(kt + c * 72) = w; }
            if (g == (dir ? 0 : 7)) { const f32x4 tot = dir ? bc[0] : bc[7]; LAS float* dl = (LAS float*)(Ls + GM_DL) + dir * 32 + c4; dl[0] = __expf(tot.x); dl[1] = __expf(tot.y); dl[2] = __expf(tot.z); dl[3] = __expf(tot.w); } } }
    else if (w4 == 2) { const int g = lane >> 3, v0 = (lane & 7) * 8; u16x8 x[8]; const bf16* xp = PROJ + (tok0 + 8 * g) * INP + C_GV + hd * 64 + v0;
#pragma unroll
        for (int i = 0; i < 8; ++i) x[i] = *(const u16x8*)(xp + (size_t)i * INP);
        LAS bf16* dst = (LAS bf16*)(Ls + GM_VT) + v0 * 72 + 8 * g;
#pragma unroll
        for (int c = 0; c < 8; ++c) { v4u w; w.x = (unsigned)x[0][c] | ((unsigned)x[1][c] << 16); w.y = (unsigned)x[2][c] | ((unsigned)x[3][c] << 16); w.z = (unsigned)x[4][c] | ((unsigned)x[5][c] << 16); w.w = (unsigned)x[6][c] | ((unsigned)x[7][c] << 16);
            *(LAS v4u*)(dst + c * 72) = w; } }
    else if (OUT) {
#pragma unroll
        for (int dir = 0; dir < 2; ++dir) { const f32x4* src = (const f32x4*)(HIN + ((size_t)dir * 64 + lane) * 32); LAS bf16* dst = (LAS bf16*)(Ls + (dir ? GM_HTB : GM_HTF)) + lane * 40;
#pragma unroll
            for (int c8 = 0; c8 < 4; ++c8) { const f32x4 a_ = src[2 * c8], b_ = src[2 * c8 + 1]; v4u w; w.x = pk2(a_.x, a_.y); w.y = pk2(a_.z, a_.w); w.z = pk2(b_.x, b_.y); w.w = pk2(b_.z, b_.w); *(LAS v4u*)(dst + c8 * 8) = w; } } }
}

typedef float f32x16 __attribute__((ext_vector_type(16)));
typedef short s16x4 __attribute__((ext_vector_type(4)));
__device__ __forceinline__ bf16x8 pack_step(const f32x16& x, int s) { v4u p; p.x = cvtpk2(x[8 * s], x[8 * s + 1]); p.y = cvtpk2(x[8 * s + 2], x[8 * s + 3]); p.z = cvtpk2(x[8 * s + 4], x[8 * s + 5]); p.w = cvtpk2(x[8 * s + 6], x[8 * s + 7]); return __builtin_bit_cast(bf16x8, p); }
__device__ __forceinline__ int crow16(int i, int h) { return (i & 3) + 8 * (i >> 2) + 4 * h; }
#define MFMA32(a, b, c) __builtin_amdgcn_mfma_f32_32x32x16_bf16((a), (b), (c), 0, 0, 0)
constexpr int FT_PITCH = 72, FT_TAB = 64 * FT_PITCH;
constexpr int FFT_LDS_TAB = 0, FFT_LDS_TW = 28672, FFT_LDS_HT = 28672, FFT_HT_PAIR = 2 * 64 * FT_PITCH * 2;

struct Args { const float* in[20]; float* out; unsigned char* ws; int ph_lo, ph_hi; };
static_assert(sizeof(Args) == 20 * 8 + 8 + 8 + 8, "no padding bytes in Args");


typedef __attribute__((address_space(4))) const unsigned char* kptr_t;
__device__ __forceinline__ kptr_t karg() { kptr_t p = (kptr_t)__builtin_amdgcn_kernarg_segment_ptr(); asm volatile("" : "+s"(p)); return p; }
#define KIN(i) (*(const float* const __attribute__((address_space(4)))*)(karg() + 8 * (i)))
#define KOUT() (*(float* const __attribute__((address_space(4)))*)(karg() + 160))
#define KWS() (*(unsigned char* const __attribute__((address_space(4)))*)(karg() + 168))
#define WSP(T, off) ((T*)(ws + (off)))

#ifndef NAIVE_ATTN
#define NAIVE_ATTN 0
#endif

__global__ void __launch_bounds__(NWAVES * 64, 2) fwd(Args args) {
    extern __shared__ __attribute__((aligned(16))) unsigned char lds_raw[];
    LAS unsigned char* lds = (LAS unsigned char*)lds_raw;
    LAS unsigned char* lctl = lds + LDSCTL_OFF;
    const int G = gridDim.x, bx = blockIdx.x;
    const int NGW = G * NWAVES, NGT = G * NWAVES * 64;
#define TID_SETUP() int tid_ = threadIdx.x; asm volatile("" : "+v"(tid_)); const int tid = tid_, lane = tid & 63, wave = __builtin_amdgcn_readfirstlane(tid >> 6); \
    const int gw = bx * NWAVES + wave, gt = bx * (NWAVES * 64) + tid; (void)lane; (void)gw; (void)gt
    for (int u = threadIdx.x; u < (LDS_BYTES - LDSCTL_OFF) / 4; u += NWAVES * 64) ((LAS unsigned*)lctl)[u] = 0u;
    __syncthreads();
    volatile LAS unsigned* MISC = (volatile LAS unsigned*)(lctl + LC_MISC);
    XcdBarrier bar = xcd_barrier_post((unsigned*)(KWS() + WS_CTL) + CW_BAR, MISC + 8);
    const int lo = args.ph_lo, hi = args.ph_hi;
#ifndef PH_OFF
#define PH_OFF 0
#endif
#define PON(j) (!((PH_OFF >> (j)) & 1))
#define IN(k) (lo <= (k) && (k) < hi)
#ifndef PROBE_A
#define PROBE_A -1
#endif
#ifndef PROBE_B
#define PROBE_B -1
#endif
#if PROBE_A >= 0
#define STAMP(k) do { if (blockIdx.x == 0 && threadIdx.x == 0) { ((unsigned long long*)(KWS() + WS_CTL + 65536))[(k)] = __builtin_amdgcn_s_memrealtime(); } } while (0)
#define STAMP2(i) do { __syncthreads(); if (blockIdx.x == 0 && threadIdx.x == 0) { ((unsigned long long*)(KWS() + WS_CTL + 65536))[128 + l * 16 + (i)] = __builtin_amdgcn_s_memrealtime(); } } while (0)
#else
#define STAMP(k) do {} while (0)
#define STAMP2(i) do {} while (0)
#endif
#ifndef PROBE_SUB_A
#define PROBE_SUB_A -1
#define PROBE_SUB_B -1
#endif
#define SEAM(k) do { if (IN(k) && IN((k) + 1)) xcd_barrier(bar); STAMP((k) + 1); } while (0)
    STAMP(0);

    if (IN(0) && PON(0)) {
        TID_SETUP(); unsigned char* ws = KWS(); const float* x_in = KIN(0); const float* ln_in_g = KIN(1); const float* ln_in_b = KIN(2); const float* w_in = KIN(3); const float* w_out = KIN(9);
        const float* exp_w_gu = KIN(14); const float* exp_w_down = KIN(16);
        float* ROPE = WSP(float, WS_ROPE); bf16* WIN_T = WSP(bf16, WS_WIN_T); bf16* WOUT_T = WSP(bf16, WS_WOUT_T); bf16* WGU_T = WSP(bf16, WS_WGU_T); bf16* WDN_T = WSP(bf16, WS_WDN_T);
        bf16* HB = WSP(bf16, WS_HB);
        { LAS unsigned* Lt = (LAS unsigned*)(lds + RING_OFF);
          constexpr int T_WIN = NL * 16 * 4, T_WOUT = NL * 8 * 4, T_WGU = NL * NE * 16 * 4, T_WDN = NL * NE * 8 * 4, NTILE = T_WIN + T_WOUT + T_WGU + T_WDN;
          for (int it = bx; it < NTILE; it += G) {
            int r = it; const float* W; bf16* WT; int Nsrc, nb, kq, mode;
            if (r < T_WIN) { const int l = r / 64, q = r % 64; nb = q / 4; kq = q % 4; W = w_in + (size_t)l * DM * INW; WT = WIN_T + (size_t)l * INP * DM; Nsrc = INW; mode = 0; }
            else if ((r -= T_WIN) < T_WOUT) { const int l = r / 32, q = r % 32; nb = q / 4; kq = q % 4; W = w_out + (size_t)l * DM * DM; WT = WOUT_T + (size_t)l * DM * DM; Nsrc = DM; mode = 1; }
            else if ((r -= T_WOUT) < T_WGU) { const int le = r / 64, q = r % 64; nb = q / 4; kq = q % 4; W = exp_w_gu + (size_t)le * DM * 2048; WT = WGU_T + (size_t)le * 2048 * DM; Nsrc = 2048; mode = 2; }
            else { r -= T_WGU; const int le = r / 32, q = r % 32; nb = q / 4; kq = q % 4; W = exp_w_down + (size_t)le * DE * DM; WT = WDN_T + (size_t)le * DM * DE; Nsrc = DM; mode = 1; }
            const int n = nb * 128 + 2 * lane;
            int src = n;
            if (mode == 0) src = n < 1536 ? n : (n < 1792 ? n + 32 : (n < 1824 ? n - 256 : -1));
            else if (mode == 2) { const int pn = n >> 8, bj = (n >> 7) & 1, j = n & 127; src = bj * 1024 + pn * 128 + j; }
            f32x2v v[32];
            if (src >= 0) { const float* p = W + (size_t)(kq * 256 + 32 * wave) * Nsrc + src;
#pragma unroll
                for (int i = 0; i < 32; ++i) v[i] = __builtin_nontemporal_load((const f32x2v*)(p + (size_t)i * Nsrc)); }
            else {
#pragma unroll
                for (int i = 0; i < 32; ++i) v[i] = (f32x2v){0.f, 0.f}; }
            __syncthreads();
#pragma unroll
            for (int i2 = 0; i2 < 16; ++i2) { Lt[(2 * lane) * 129 + 16 * wave + i2] = pk2(v[2 * i2].x, v[2 * i2 + 1].x); Lt[(2 * lane + 1) * 129 + 16 * wave + i2] = pk2(v[2 * i2].y, v[2 * i2 + 1].y); }
            __syncthreads();
            const int p4 = (lane & 31) * 4;
#pragma unroll
            for (int j = 0; j < 8; ++j) { const int row = 16 * wave + 2 * j + (lane >> 5); const LAS unsigned* lp = Lt + row * 129 + p4; v4u o; o.x = lp[0]; o.y = lp[1]; o.z = lp[2]; o.w = lp[3];
                *(v4u*)(WT + (size_t)(nb * 128 + row) * DM + kq * 256 + 2 * p4) = o; }
          }
          __syncthreads(); }
        { bf16* FTAB = WSP(bf16, WS_FTAB); float* TW = WSP(float, WS_TW);
          for (int it = gt; it < 3 * FT_TAB; it += NGT) { const int t = it / FT_TAB, q = it % FT_TAB, row = q / FT_PITCH, col = q % FT_PITCH; float sn, cs; sincospif((float)((row * col) & 63) * (1.0f / 32.0f), &sn, &cs);
              const float v = col >= 64 ? 0.f : (t == 0 ? cs : (t == 1 ? sn : -sn)); FTAB[it] = (bf16)f2bf(v); }
          for (int it = gt; it < 4096; it += NGT) { float sn, cs; sincospif((float)it * (1.0f / 2048.0f), &sn, &cs); TW[2 * it] = cs; TW[2 * it + 1] = -sn; } }
        for (int it = gt; it < SEQ * 32; it += NGT) { const int t = it >> 5, i = it & 31, a = i >> 4, f = i & 15; const int pos = a ? (t & 63) : (t >> 6);
            const double inv = exp(-9.210340371976184 * (double)f / 16.0); const double ang = (double)pos * inv;
            ROPE[it] = (float)cos(ang); ROPE[SEQ * 32 + it] = (float)sin(ang); }
        { f32x4 gam[4], bet[4];
#pragma unroll
          for (int j = 0; j < 4; ++j) { gam[j] = *(const f32x4*)(ln_in_g + RC(lane, j)); bet[j] = *(const f32x4*)(ln_in_b + RC(lane, j)); }
          for (int m0 = gw; m0 < NTOK; m0 += 2 * NGW) { f32x4 v[2][4];
#pragma unroll
            for (int q = 0; q < 2; ++q)
#pragma unroll
                for (int j = 0; j < 4; ++j) v[q][j] = *(const f32x4*)(x_in + (size_t)(m0 + q * NGW) * DM + RC(lane, j));
#pragma unroll
            for (int q = 0; q < 2; ++q) { ln_row8(v[q], gam, bet); row_store_bf16(v[q], HB + (size_t)(m0 + q * NGW) * DM, lane); } } }
    }
    SEAM(0);

    for (int l = 0; l < NL; ++l) {
        const int pb = 1 + 10 * l;
        if (IN(pb + 0) && PON(1)) {
            TID_SETUP(); unsigned char* ws = KWS(); bf16* HB = WSP(bf16, WS_HB); bf16* WIN_T = WSP(bf16, WS_WIN_T); bf16* PROJ = WSP(bf16, WS_PROJ);
            pg8::Gemm g{HB, WIN_T + (size_t)l * INP * DM, NTOK, INP, DM}; pg8::StaticOrder S; S.init(NTOK, INP, G, bx);
            pg8::EpiPlainBf16 E{PROJ, INP};
            STAMP2(2);
            pg8::gemm_phase<pg8::EpiPlainBf16, pg8::StaticOrder, true, true>(lds + RING_OFF, g, S, E);
            STAMP2(3);
        }
        SEAM(pb + 0);
        if (IN(pb + 1) && PON(2)) {
            TID_SETUP(); unsigned char* ws = KWS(); const float* att_q_gain = KIN(4); const float* att_k_gain = KIN(5); const float* gla_gate_w = KIN(6); const float* gla_gate_b = KIN(7);
            const float* ROPE = WSP(float, WS_ROPE); const bf16* PROJ = WSP(bf16, WS_PROJ); bf16* QB = WSP(bf16, WS_QB); bf16* KB = WSP(bf16, WS_KB); float* LA = WSP(float, WS_LA);
            STAMP2(8);
            { LAS float* RTC = (LAS float*)(lds + RING_OFF + 65536);
              for (int i = tid; i < 1024; i += NWAVES * 64) { const int pos = i >> 4, f = i & 15; RTC[i] = ROPE[(pos * 64) * 32 + f]; RTC[1024 + i] = ROPE[SEQ * 32 + (pos * 64) * 32 + f]; RTC[2048 + i] = ROPE[pos * 32 + 16 + f]; RTC[3072 + i] = ROPE[SEQ * 32 + pos * 32 + 16 + f]; }
              __syncthreads();
              const int li = lane & 7, ax = li >> 2, f0 = 8 * (li & 1); const float sg = ((li >> 1) & 1) ? 1.f : -1.f;
              f32x4 qg8[2], kg8[2];
#pragma unroll
              for (int c = 0; c < 2; ++c) { qg8[c] = *(const f32x4*)(att_q_gain + l * 64 + 8 * li + 4 * c); kg8[c] = *(const f32x4*)(att_k_gain + l * 64 + 8 * li + 4 * c); }
              for (int m0 = gw; m0 < NTOK; m0 += 4 * NGW) { v4u xp[5];
#pragma unroll
                for (int i = 0; i < 5; ++i) { const int P = lane + 64 * i, q = P / 80, p = P % 80; xp[i] = *(const v4u*)(PROJ + (size_t)(m0 + q * NGW) * INP + p * 8); }
#pragma unroll
                for (int i = 0; i < 5; ++i) { const int P = lane + 64 * i, q = P / 80, p = P % 80, head = p >> 3; const size_t m = (size_t)(m0 + q * NGW); const int t = (int)(m & (SEQ - 1));
                    float xv[8] = {__uint_as_float(xp[i].x << 16), __uint_as_float(xp[i].x & 0xffff0000u), __uint_as_float(xp[i].y << 16), __uint_as_float(xp[i].y & 0xffff0000u),
                                   __uint_as_float(xp[i].z << 16), __uint_as_float(xp[i].z & 0xffff0000u), __uint_as_float(xp[i].w << 16), __uint_as_float(xp[i].w & 0xffff0000u)};
                    float ss = 0.f;
#pragma unroll
                    for (int c = 0; c < 8; ++c) ss += xv[c] * xv[c];
                    ss += __shfl_xor(ss, 1); ss += __shfl_xor(ss, 2); ss += __shfl_xor(ss, 4);
                    const float rs = __builtin_amdgcn_rsqf(ss * (1.f / 64.f) + RMS_EPS); const bool isq = head < 8;
                    const LAS float* tb = RTC + (ax ? 2048 : 0) + (ax ? (t & 63) : (t >> 6)) * 16 + f0;
                    const f32x4 c0 = *(const LAS f32x4*)tb, c1 = *(const LAS f32x4*)(tb + 4), s0 = *(const LAS f32x4*)(tb + 1024), s1 = *(const LAS f32x4*)(tb + 1028);
                    const float csv[8] = {c0.x, c0.y, c0.z, c0.w, c1.x, c1.y, c1.z, c1.w}, snv[8] = {s0.x, s0.y, s0.z, s0.w, s1.x, s1.y, s1.z, s1.w};
                    const f32x4 g0 = isq ? qg8[0] : kg8[0], g1 = isq ? qg8[1] : kg8[1]; const float gv[8] = {g0.x, g0.y, g0.z, g0.w, g1.x, g1.y, g1.z, g1.w};
                    const float osc = isq ? QSCALE : 1.f; float o[8];
#pragma unroll
                    for (int c = 0; c < 8; ++c) { const float xn = xv[c] * rs * gv[c]; const float pr = __shfl_xor(xn, 2); o[c] = (xn * csv[c] + sg * pr * snv[c]) * osc; }
                    v4u w; w.x = pk2(o[0], o[1]); w.y = pk2(o[2], o[3]); w.z = pk2(o[4], o[5]); w.w = pk2(o[6], o[7]);
                    bf16* dst = isq ? (QB + m * 512 + head * 64 + 8 * li) : (KB + m * 128 + (head - 8) * 64 + 8 * li);
                    *(v4u*)dst = w; } }
              const float* gw_l = gla_gate_w + (size_t)l * 2 * 16 * 128; const float* gb_l = gla_gate_b + (size_t)l * 2 * 128; const int dir = lane >> 5, kc = (lane & 31) * 4;
              f32x4 gwr[16]; const f32x4 gbv = *(const f32x4*)(gb_l + dir * 128 + kc);
#pragma unroll
              for (int r = 0; r < 16; ++r) gwr[r] = *(const f32x4*)(gw_l + (size_t)(dir * 16 + r) * 128 + kc);
              for (int m0 = gw; m0 < NTOK; m0 += 4 * NGW) { v4u gl[4][2];
#pragma unroll
                for (int q = 0; q < 4; ++q) { const bf16* gp = PROJ + (size_t)(m0 + q * NGW) * INP + C_GLR + dir * 16; gl[q][0] = *(const v4u*)gp; gl[q][1] = *(const v4u*)(gp + 8); }
#pragma unroll
                for (int q = 0; q < 4; ++q) { const size_t m = (size_t)(m0 + q * NGW); f32x4 z = gbv;
                    const unsigned gu[8] = {gl[q][0].x, gl[q][0].y, gl[q][0].z, gl[q][0].w, gl[q][1].x, gl[q][1].y, gl[q][1].z, gl[q][1].w};
#pragma unroll
                    for (int r2 = 0; r2 < 8; ++r2) { z = z + gwr[2 * r2] * __uint_as_float(gu[r2] << 16); z = z + gwr[2 * r2 + 1] * __uint_as_float(gu[r2] & 0xffff0000u); }
                    f32x4 o4;
#pragma unroll
                    for (int i = 0; i < 4; ++i) o4[i] = (fminf(z[i], 0.f) - __logf(1.f + __expf(-fabsf(z[i])))) * (1.f / 16.f);
                    *(f32x4*)(LA + m * 256 + dir * 128 + kc) = o4; } }
              __syncthreads(); }
            STAMP2(4);
            { __syncthreads();
              { const v4u* src = (const v4u*)WSP(bf16, WS_FTAB); LAS v4u* dst = (LAS v4u*)(lds + RING_OFF + FFT_LDS_TAB); for (int i = tid; i < 3 * FT_TAB * 2 / 16; i += NWAVES * 64) dst[i] = src[i];
                const v4u* s2_ = (const v4u*)WSP(float, WS_TW); LAS v4u* d2_ = (LAS v4u*)(lds + RING_OFF + FFT_LDS_TW); for (int i = tid; i < 4096 * 8 / 16; i += NWAVES * 64) d2_[i] = s2_[i]; }
              __syncthreads();
              const LAS bf16* FT = (const LAS bf16*)(lds + RING_OFF + FFT_LDS_TAB); const LAS float* TWL = (const LAS float*)(lds + RING_OFF + FFT_LDS_TW); bf16* FTMP = WSP(bf16, WS_FTMP);
              const int pair = wave >> 1, cb = wave & 1, r = lane & 31, h = lane >> 5;
              for (int ub = bx; ub < NB * 4 * 64 / 4; ub += G) { const int u = ub * 4 + pair, s2 = u & 63, g4 = (u >> 6) & 3, b = u >> 8;
                bf16x8 xa[2][4];
#pragma unroll
                for (int R = 0; R < 2; ++R)
#pragma unroll
                    for (int ks = 0; ks < 4; ++ks) xa[R][ks] = *(const bf16x8*)(PROJ + ((size_t)b * SEQ + 64 * (32 * R + r) + s2) * INP + C_FX + g4 * 64 + 16 * ks + 8 * h);
                f32x16 Tr[2], Ti[2];
#pragma unroll
                for (int R = 0; R < 2; ++R)
#pragma unroll
                    for (int i = 0; i < 16; ++i) { Tr[R][i] = 0.f; Ti[R][i] = 0.f; }
#pragma unroll
                for (int ks = 0; ks < 4; ++ks) { const bf16x8 bc = *(const LAS bf16x8*)(FT + (32 * cb + r) * FT_PITCH + 16 * ks + 8 * h), bs = *(const LAS bf16x8*)(FT + 2 * FT_TAB + (32 * cb + r) * FT_PITCH + 16 * ks + 8 * h);
#pragma unroll
                    for (int R = 0; R < 2; ++R) { Tr[R] = MFMA32(xa[R][ks], bc, Tr[R]); Ti[R] = MFMA32(xa[R][ks], bs, Ti[R]); } }
#pragma unroll
                for (int Rp = 0; Rp < 2; ++Rp) { f32x16 Gr, Gi;
#pragma unroll
                    for (int i = 0; i < 16; ++i) { Gr[i] = 0.f; Gi[i] = 0.f; }
#pragma unroll
                    for (int R = 0; R < 2; ++R)
#pragma unroll
                        for (int s_ = 0; s_ < 2; ++s_) { const bf16x8 xr = pack_step(Tr[R], s_), xi = pack_step(Ti[R], s_);
                            const int kb = 32 * R + 16 * s_ + 4 * h, ro = (32 * Rp + r) * FT_PITCH + kb;
                            const s16x4 c0 = *(const LAS s16x4*)(FT + ro), c1 = *(const LAS s16x4*)(FT + ro + 8), s0 = *(const LAS s16x4*)(FT + FT_TAB + ro), s1 = *(const LAS s16x4*)(FT + FT_TAB + ro + 8),
                                        n0 = *(const LAS s16x4*)(FT + 2 * FT_TAB + ro), n1 = *(const LAS s16x4*)(FT + 2 * FT_TAB + ro + 8);
                            const bf16x8 ca = __builtin_shufflevector(c0, c1, 0, 1, 2, 3, 4, 5, 6, 7), sa = __builtin_shufflevector(s0, s1, 0, 1, 2, 3, 4, 5, 6, 7), na = __builtin_shufflevector(n0, n1, 0, 1, 2, 3, 4, 5, 6, 7);
                            Gr = MFMA32(ca, xr, Gr); Gr = MFMA32(sa, xi, Gr); Gi = MFMA32(ca, xi, Gi); Gi = MFMA32(na, xr, Gi); }
#pragma unroll
                    for (int i = 0; i < 16; ++i) { const int s1p = 32 * Rp + crow16(i, h); const int m = (s2 * s1p) & 4095; const float wr = TWL[2 * m], wi = TWL[2 * m + 1];
                        const size_t o = ((((size_t)(b * 4 + g4) * 64 + s1p) * 2) * 64 + s2) * 64 + 32 * cb + r;
                        FTMP[o] = (bf16)f2bf(Gr[i] * wr - Gi[i] * wi); FTMP[o + 4096] = (bf16)f2bf(Gr[i] * wi + Gi[i] * wr); } }
              }
              __syncthreads(); }
            STAMP2(5);
            { float* GS = WSP(float, WS_OF); float* GD = WSP(float, WS_OB);
              const int slot = wave >> 2, w4 = wave & 3, fr = lane & 15, fq = lane >> 4; LAS unsigned char* Ls = lds + RING_OFF + slot * GM_SLOT;
              for (int ub = bx; ub < NB * 4 * 64 / 2; ub += G) { const int u = ub * 2 + slot, c = u & 63, bh = u >> 6, hd = bh & 3, b = bh >> 2; const size_t tok0 = (size_t)b * SEQ + c * 64;
                __syncthreads();
                gla_stage_mfma<false>(Ls, PROJ, LA, nullptr, tok0, hd, w4, lane);
                __syncthreads();
                const LAS bf16* VT = (const LAS bf16*)(Ls + GM_VT); const LAS float* DL = (const LAS float*)(Ls + GM_DL);
#pragma unroll
                for (int dir = 0; dir < 2; ++dir) { const LAS bf16* KT = (const LAS bf16*)(Ls + GM_P + dir * 4608);
#pragma unroll
                    for (int Cd = 0; Cd < 2; ++Cd) { f32x4 acc = {0.f, 0.f, 0.f, 0.f};
#pragma unroll
                        for (int ks = 0; ks < 2; ++ks) { const bf16x8 a_ = *(const LAS bf16x8*)(VT + (16 * w4 + fr) * 72 + 32 * ks + 8 * fq), b_ = *(const LAS bf16x8*)(KT + (16 * Cd + fr) * 72 + 32 * ks + 8 * fq); acc = MFMA16(a_, b_, acc); }
                        const float Dd = DL[dir * 32 + 16 * Cd + fr]; float* o = GS + (((size_t)u * 2 + dir) * 64 + 16 * w4 + 4 * fq) * 32 + 16 * Cd + fr;
#pragma unroll
                        for (int r = 0; r < 4; ++r) o[r * 32] = acc[r] * Dd; } }
                if (w4 == 3) GD[((size_t)u * 2 + (lane >> 5)) * 32 + (lane & 31)] = DL[lane]; }
              __syncthreads(); }
            STAMP2(9);
        }
        SEAM(pb + 1);
        if (IN(pb + 2) && PON(3)) {
            TID_SETUP(); unsigned char* ws = KWS(); float* GS = WSP(float, WS_OF); const float* GD = WSP(float, WS_OB);
            for (int e = gt; e < NB * 4 * 2 * 2048; e += NGT) { const int dv = e & 2047, dir = (e >> 11) & 1, bh = e >> 12, d = dv & 31; float H = 0.f;
                for (int c8 = 0; c8 < 64; c8 += 8) { float sv[8], dd[8];
#pragma unroll
                    for (int i = 0; i < 8; ++i) { const int c = dir ? 63 - (c8 + i) : (c8 + i); const size_t sidx = ((size_t)(bh * 64 + c) * 2 + dir); sv[i] = GS[sidx * 2048 + dv]; dd[i] = GD[sidx * 32 + d]; }
#pragma unroll
                    for (int i = 0; i < 8; ++i) { const int c = dir ? 63 - (c8 + i) : (c8 + i); const size_t sidx = ((size_t)(bh * 64 + c) * 2 + dir); GS[sidx * 2048 + dv] = H; H = H * dd[i] + sv[i]; } } }
        }
        SEAM(pb + 2);
        if (IN(pb + 3) && PON(4)) {
            TID_SETUP(); unsigned char* ws = KWS(); const float* gla_norm_g = KIN(8); const bf16* PROJ = WSP(bf16, WS_PROJ);
            bf16* MIX = WSP(bf16, WS_MIX); const bf16* QB = WSP(bf16, WS_QB); const bf16* KB = WSP(bf16, WS_KB);
            { __syncthreads();
              { const v4u* src = (const v4u*)WSP(bf16, WS_FTAB); LAS v4u* dst = (LAS v4u*)(lds + RING_OFF + FFT_LDS_TAB); for (int i = tid; i < 3 * FT_TAB * 2 / 16; i += NWAVES * 64) dst[i] = src[i]; }
              const LAS bf16* FT = (const LAS bf16*)(lds + RING_OFF + FFT_LDS_TAB); const bf16* FTMP = WSP(bf16, WS_FTMP);
              const int pair = wave >> 1, cb = wave & 1, r = lane & 31, h = lane >> 5;
              LAS bf16* HT = (LAS bf16*)(lds + RING_OFF + FFT_LDS_HT + pair * FFT_HT_PAIR);
              for (int ub = bx; ub < NB * 4 * 64 / 4; ub += G) { const int u = ub * 4 + pair, s1p = u & 63, g4 = (u >> 6) & 3, b = u >> 8;
                const bf16* src = FTMP + (size_t)u * 2 * 4096;
                __syncthreads();
#pragma unroll
                for (int q = 0; q < 8; ++q) { const int p = cb * 64 + lane + 128 * q, ri = p >> 9, s2 = (p >> 3) & 63, c0 = (p & 7) * 8; const u16x8 v = *(const u16x8*)(src + p * 8);
#pragma unroll
                    for (int i = 0; i < 8; ++i) HT[(ri * 64 + c0 + i) * FT_PITCH + s2] = v[i]; }
                __syncthreads();
#pragma unroll
                for (int Rp = 0; Rp < 2; ++Rp) { f32x16 acc;
#pragma unroll
                    for (int i = 0; i < 16; ++i) acc[i] = 0.f;
#pragma unroll
                    for (int ks = 0; ks < 4; ++ks) { const int ko = 16 * ks + 8 * h;
                        const bf16x8 ca = *(const LAS bf16x8*)(FT + (32 * Rp + r) * FT_PITCH + ko), sa = *(const LAS bf16x8*)(FT + FT_TAB + (32 * Rp + r) * FT_PITCH + ko);
                        const bf16x8 hr = *(const LAS bf16x8*)(HT + (32 * cb + r) * FT_PITCH + ko), hi_ = *(const LAS bf16x8*)(HT + (64 + 32 * cb + r) * FT_PITCH + ko);
                        acc = MFMA32(ca, hr, acc); acc = MFMA32(sa, hi_, acc); }
#pragma unroll
                    for (int i = 0; i < 16; ++i) { const int s2p = 32 * Rp + crow16(i, h); MIX[((size_t)b * SEQ + s1p + 64 * s2p) * DM + 768 + g4 * 64 + 32 * cb + r] = (bf16)f2bf(acc[i] * (1.0f / 512.0f)); } }
              }
              __syncthreads(); }
            STAMP2(6);
            { const float* GS = WSP(float, WS_OF); const float* LA = WSP(float, WS_LA);
              const int slot = wave >> 2, w4 = wave & 3, fr = lane & 15, fq = lane >> 4, I0 = 16 * w4; LAS unsigned char* Ls = lds + RING_OFF + slot * GM_SLOT;
              for (int ub = bx; ub < NB * 4 * 64 / 2; ub += G) { const int u = ub * 2 + slot, c = u & 63, bh = u >> 6, hd = bh & 3, b = bh >> 2; const size_t tok0 = (size_t)b * SEQ + c * 64;
                __syncthreads();
                gla_stage_mfma<true>(Ls, PROJ, LA, GS + (size_t)u * 2 * 2048, tok0, hd, w4, lane);
                __syncthreads();
                const LAS bf16* QF = (const LAS bf16*)(Ls + GM_QF); const LAS bf16* KF = (const LAS bf16*)(Ls + GM_KF); const LAS bf16* QBm = (const LAS bf16*)(Ls + GM_QB); const LAS bf16* KBm = (const LAS bf16*)(Ls + GM_KB);
                const LAS bf16* VT = (const LAS bf16*)(Ls + GM_VT); LAS bf16* P = (LAS bf16*)(Ls + GM_P); const LAS bf16* HTF = (const LAS bf16*)(Ls + GM_HTF); const LAS bf16* HTB = (const LAS bf16*)(Ls + GM_HTB);
                const bf16x8 qfa = *(const LAS bf16x8*)(QF + (I0 + fr) * 40 + 8 * fq), qba = *(const LAS bf16x8*)(QBm + (I0 + fr) * 40 + 8 * fq);
#pragma unroll
                for (int Cj = 0; Cj < 4; ++Cj) { const f32x4 z = {0.f, 0.f, 0.f, 0.f};
                    const f32x4 pf = MFMA16(qfa, *(const LAS bf16x8*)(KF + (16 * Cj + fr) * 40 + 8 * fq), z), pb = MFMA16(qba, *(const LAS bf16x8*)(KBm + (16 * Cj + fr) * 40 + 8 * fq), z);
#pragma unroll
                    for (int r = 0; r < 4; ++r) { const int i = I0 + 4 * fq + r, j = 16 * Cj + fr; P[i * 72 + j] = (bf16)f2bf(j <= i ? pf[r] : pb[r]); } }
                asm volatile("s_waitcnt lgkmcnt(0)" ::: "memory");
                f32x4 o[4];
#pragma unroll
                for (int Cv = 0; Cv < 4; ++Cv) { f32x4 acc = {0.f, 0.f, 0.f, 0.f};
#pragma unroll
                    for (int ks = 0; ks < 2; ++ks) acc = MFMA16(*(const LAS bf16x8*)(P + (I0 + fr) * 72 + 32 * ks + 8 * fq), *(const LAS bf16x8*)(VT + (16 * Cv + fr) * 72 + 32 * ks + 8 * fq), acc);
                    acc = MFMA16(qfa, *(const LAS bf16x8*)(HTF + (16 * Cv + fr) * 40 + 8 * fq), acc); acc = MFMA16(qba, *(const LAS bf16x8*)(HTB + (16 * Cv + fr) * 40 + 8 * fq), acc);
                    o[Cv] = acc; }
                float rs[4];
#pragma unroll
                for (int r = 0; r < 4; ++r) { float ss = (o[0][r] * o[0][r] + o[1][r] * o[1][r]) + (o[2][r] * o[2][r] + o[3][r] * o[3][r]);
#pragma unroll
                    for (int m_ = 1; m_ < 16; m_ <<= 1) ss += __shfl_xor(ss, m_);
                    rs[r] = 1.f / sqrtf(ss * (1.f / 64.f) + RMS_EPS); }
#pragma unroll
                for (int Cv = 0; Cv < 4; ++Cv) { const int v = 16 * Cv + fr; const float gn = gla_norm_g[l * 64 + v];
#pragma unroll
                    for (int r = 0; r < 4; ++r) { const size_t m = tok0 + I0 + 4 * fq + r; const float rg = bf2f(PROJ[m * INP + C_GR + hd * 64 + v]);
                        MIX[m * DM + 512 + hd * 64 + v] = (bf16)f2bf(o[Cv][r] * rs[r] * gn * (rg / (1.f + expf(-rg)))); } } }
              __syncthreads(); }
            STAMP2(7);
#if NAIVE_ATTN
            { LAS float* Kt = (LAS float*)(lds + RING_OFF); LAS float* Vt = Kt + 64 * 64;
              for (int unit = bx; unit < NB * 8 * 8; unit += G) { const int rb = unit & 7, h = (unit >> 3) & 7, b = unit >> 6, kvh = h >> 2;
                const size_t qrow = (size_t)b * SEQ + rb * 512 + tid;
                float q[64], o[64]; float mrun = -INFINITY, lrun = 0.f;
#pragma unroll
                for (int c8 = 0; c8 < 8; ++c8) { const u16x8 f = *(const u16x8*)(QB + qrow * 512 + h * 64 + c8 * 8);
#pragma unroll
                    for (int i = 0; i < 8; ++i) { q[c8 * 8 + i] = bf2f(f[i]); o[c8 * 8 + i] = 0.f; } }
                for (int kt = 0; kt < SEQ; kt += 64) {
                    __syncthreads();
                    { const int kr = tid >> 3, c8 = (tid & 7) * 8; const size_t krow = (size_t)b * SEQ + kt + kr;
                      const u16x8 kf = *(const u16x8*)(KB + krow * 128 + kvh * 64 + c8); const u16x8 vf = *(const u16x8*)(PROJ + krow * INP + C_AV + kvh * 64 + c8);
#pragma unroll
                      for (int i = 0; i < 8; ++i) { Kt[kr * 64 + c8 + i] = bf2f(kf[i]); Vt[kr * 64 + c8 + i] = bf2f(vf[i]); } }
                    __syncthreads();
#pragma unroll 1
                    for (int j = 0; j < 64; ++j) { float a = 0.f;
#pragma unroll
                        for (int d4 = 0; d4 < 16; ++d4) { const f32x4 kv = *(const LAS f32x4*)(Kt + j * 64 + d4 * 4); a += (q[d4 * 4] * kv.x + q[d4 * 4 + 1] * kv.y) + (q[d4 * 4 + 2] * kv.z + q[d4 * 4 + 3] * kv.w); }
                        if (a > mrun) { const float al = exp2f(mrun - a); mrun = a; lrun *= al;
#pragma unroll
                            for (int d = 0; d < 64; ++d) o[d] *= al; }
                        const float p = exp2f(a - mrun); lrun += p;
#pragma unroll
                        for (int d4 = 0; d4 < 16; ++d4) { const f32x4 vv = *(const LAS f32x4*)(Vt + j * 64 + d4 * 4); o[d4 * 4] += p * vv.x; o[d4 * 4 + 1] += p * vv.y; o[d4 * 4 + 2] += p * vv.z; o[d4 * 4 + 3] += p * vv.w; } }
                }
                const float rl = 1.f / lrun;
#pragma unroll
                for (int c8 = 0; c8 < 8; ++c8) { v4u w; w.x = pk2(o[c8 * 8] * rl, o[c8 * 8 + 1] * rl); w.y = pk2(o[c8 * 8 + 2] * rl, o[c8 * 8 + 3] * rl); w.z = pk2(o[c8 * 8 + 4] * rl, o[c8 * 8 + 5] * rl); w.w = pk2(o[c8 * 8 + 6] * rl, o[c8 * 8 + 7] * rl);
                    *(v4u*)(MIX + qrow * DM + h * 64 + c8 * 8) = w; }
              }
              __syncthreads(); }
#else
            { const attn_body::AttnTensors AT{(const attn_body::bf16*)QB, (const attn_body::bf16*)KB, (const attn_body::bf16*)(PROJ + C_AV), (attn_body::bf16*)MIX};
              const attn_body::StaticOrder S(G, bx);
              attn_body::attn_phase<attn_body::StaticOrder>((char*)lds_raw + RING_OFF, AT, S); }
#endif
        }
        SEAM(pb + 3);
        if (IN(pb + 4) && PON(5)) {
            TID_SETUP(); unsigned char* ws = KWS(); const bf16* MIX = WSP(bf16, WS_MIX); const bf16* WOUT_T = WSP(bf16, WS_WOUT_T); const bf16* HB = WSP(bf16, WS_HB); bf16* T1 = WSP(bf16, WS_T1);
            pg8::Gemm g{MIX, WOUT_T + (size_t)l * DM * DM, NTOK, DM, DM}; pg8::StaticOrder S; S.init(NTOK, DM, G, bx);
            pg8::EpiResBf16 E{HB, T1, DM, DN_ALPHA};
            pg8::gemm_phase<pg8::EpiResBf16, pg8::StaticOrder, true, true>(lds + RING_OFF, g, S, E);
        }
        SEAM(pb + 4);
        if (IN(pb + 5) && PON(6)) {
            TID_SETUP(); unsigned char* ws = KWS(); gu32* ctl = (gu32*)(ws + WS_CTL); const float* ln1_g = KIN(10); const float* ln1_b = KIN(11); const float* router_w = KIN(12); const float* router_b = KIN(13);
            const bf16* T1 = WSP(bf16, WS_T1); bf16* HB = WSP(bf16, WS_HB); int* TOKE = WSP(int, WS_TOK); int* TOKS = TOKE + NTOK * 4; float* TOKW = (float*)(TOKS + NTOK * 4); int* LIST = WSP(int, WS_XS);
            LAS float* RW = (LAS float*)(lds + RING_OFF);
            { const float* rw = router_w + (size_t)l * DM * NE; for (int i = tid; i < DM * NE; i += NWAVES * 64) { const int c = i >> 5, e = i & 31; RW[e * DM + c] = rw[i]; } }
            LAS int* lcnt = (LAS int*)(lctl + LC_CNT); LAS int* lbase = (LAS int*)(lctl + LC_BASE); LAS int* sele = (LAS int*)(lctl + LC_SELE); LAS int* sels = (LAS int*)(lctl + LC_SELS);
            const float* rb = router_b + l * NE;
            for (int r0 = bx * 128; r0 < NTOK; r0 += G * 128) {
                if (tid < 32) lcnt[tid] = 0;
                __syncthreads();
                LAS float* LG = (LAS float*)(lctl + LC_LG) + wave * 512;
                f32x4 gam[4], bet[4];
#pragma unroll
                for (int j = 0; j < 4; ++j) { gam[j] = *(const f32x4*)(ln1_g + l * DM + RC(lane, j)); bet[j] = *(const f32x4*)(ln1_b + l * DM + RC(lane, j)); }
                for (int rr = 0; rr < 16; rr += 2) { const int lr = wave * 16 + rr; const size_t m = (size_t)r0 + lr; f32x4 v[2][4];
                    row_load_bf16(v[0], T1 + m * DM, lane); row_load_bf16(v[1], T1 + (m + 1) * DM, lane);
#pragma unroll
                    for (int q = 0; q < 2; ++q) { ln_row8(v[q], gam, bet); row_store_bf16(v[q], HB + (m + q) * DM, lane); }
                    float a0[32], a1[32];
#pragma unroll
                    for (int e = 0; e < 32; ++e) { f32x2_t s0 = {0.f, 0.f}, s1 = {0.f, 0.f};
#pragma unroll
                        for (int j = 0; j < 4; ++j) { const f32x4 w = *(const LAS f32x4*)(RW + e * DM + RC(lane, j)); const f32x2_t wl = {w.x, w.y}, wh = {w.z, w.w};
                            s0 += (f32x2_t){v[0][j].x, v[0][j].y} * wl; s0 += (f32x2_t){v[0][j].z, v[0][j].w} * wh; s1 += (f32x2_t){v[1][j].x, v[1][j].y} * wl; s1 += (f32x2_t){v[1][j].z, v[1][j].w} * wh; }
                        a0[e] = s0.x + s0.y; a1[e] = s1.x + s1.y; }
#define TRSTEP(SRC, DST, N, MASK) _Pragma("unroll") for (int e = 0; e < (N); ++e) { const bool hi_ = (lane & (MASK)) != 0; const float keep = hi_ ? SRC[e + (N)] : SRC[e], send = hi_ ? SRC[e] : SRC[e + (N)]; DST[e] = keep + __shfl_xor(send, (MASK)); }
                    float t0, t1;
                    { float b_[16], c_[8], d_[4], e_[2], f_[1]; TRSTEP(a0, b_, 16, 32) TRSTEP(b_, c_, 8, 16) TRSTEP(c_, d_, 4, 8) TRSTEP(d_, e_, 2, 4) TRSTEP(e_, f_, 1, 2) t0 = f_[0] + __shfl_xor(f_[0], 1); }
                    { float b_[16], c_[8], d_[4], e_[2], f_[1]; TRSTEP(a1, b_, 16, 32) TRSTEP(b_, c_, 8, 16) TRSTEP(c_, d_, 4, 8) TRSTEP(d_, e_, 2, 4) TRSTEP(e_, f_, 1, 2) t1 = f_[0] + __shfl_xor(f_[0], 1); }
#undef TRSTEP
                    { const int E = (lane >> 1) & 31; const float bias = rb[E]; if ((lane & 1) == 0) { LG[rr * 32 + E] = t0 + bias; LG[(rr + 1) * 32 + E] = t1 + bias; } }
                }
                asm volatile("s_waitcnt lgkmcnt(0)" ::: "memory");
                if (lane < 16) { const int lr = wave * 16 + lane; const size_t m = (size_t)r0 + lr; float lg[32];
#pragma unroll
                    for (int e4 = 0; e4 < 8; ++e4) { const f32x4 x = *(const LAS f32x4*)(LG + lane * 32 + e4 * 4); lg[e4 * 4] = x.x; lg[e4 * 4 + 1] = x.y; lg[e4 * 4 + 2] = x.z; lg[e4 * 4 + 3] = x.w; }
                    int se[4]; float sv[4];
#pragma unroll
                    for (int k = 0; k < 4; ++k) { float best = -INFINITY; int bi = 0;
#pragma unroll
                        for (int e = 0; e < 32; ++e) { if (lg[e] > best) { best = lg[e]; bi = e; } }
                        se[k] = bi; sv[k] = best;
#pragma unroll
                        for (int e = 0; e < 32; ++e) if (e == bi) lg[e] = -INFINITY; }
                    const float e1 = expf(sv[1] - sv[0]), e2 = expf(sv[2] - sv[0]), e3 = expf(sv[3] - sv[0]); const float inv = 1.f / (1.f + e1 + e2 + e3);
                    const float wts[4] = {inv, e1 * inv, e2 * inv, e3 * inv};
#pragma unroll
                    for (int k = 0; k < 4; ++k) { const int ls = __hip_atomic_fetch_add(lcnt + se[k], 1, __ATOMIC_RELAXED, __HIP_MEMORY_SCOPE_WORKGROUP); sele[lr * 4 + k] = se[k]; sels[lr * 4 + k] = ls; TOKW[m * 4 + k] = wts[k]; } }
                __syncthreads();
                if (tid < 32) lbase[tid] = (int)__hip_atomic_fetch_add(ctl + CW_CNT + l * 32 + tid, (unsigned)lcnt[tid], RLX_AGENT);
                __syncthreads();
                { const int e = sele[tid], sl = lbase[e] + sels[tid]; TOKE[(size_t)r0 * 4 + tid] = e; TOKS[(size_t)r0 * 4 + tid] = sl; LIST[(size_t)e * NTOK + sl] = r0 + (tid >> 2); }
                __syncthreads();
            }
        }
        SEAM(pb + 5);
#if defined(EXP_P1_NOEPI)
        if (IN(pb + 6)) {
            TID_SETUP(); unsigned char* ws = KWS(); bf16* HB = WSP(bf16, WS_HB); bf16* WIN_T = WSP(bf16, WS_WIN_T); bf16* PROJ = WSP(bf16, WS_PROJ);
            pg8::Gemm g{HB, WIN_T + (size_t)l * INP * DM, NTOK, INP, DM}; pg8::StaticOrder S; S.init(NTOK, INP, G, bx);
            pg8::EpiNull EN{PROJ}; pg8::gemm_phase<pg8::EpiNull, pg8::StaticOrder, true, true>(lds + RING_OFF, g, S, EN);
            __syncthreads(); }
#endif
        STAMP(pb + 7);
        if (IN(pb + 7) || IN(pb + 8) || IN(pb + 9)) {
            LAS int* pst = (LAS int*)(lctl + LC_PSTART); LAS int* ecnt = (LAS int*)(lctl + LC_BASE); gu32* ctl = (gu32*)(KWS() + WS_CTL);
            __syncthreads();
            if (threadIdx.x == 0) { int acc = 0; for (int e = 0; e < NE; ++e) { pst[e] = acc; const int c = (int)__hip_atomic_load(ctl + CW_CNT + l * 32 + e, RLX_AGENT); ecnt[e] = c; acc += (c + 255) >> 8; } pst[NE] = acc; }
            __syncthreads();
        }
        if (IN(pb + 7) && PON(8)) {
            TID_SETUP(); unsigned char* ws = KWS(); const float* exp_b_gu = KIN(15); const bf16* HB = WSP(bf16, WS_HB); const int* LIST = WSP(int, WS_XS); const bf16* WGU_T = WSP(bf16, WS_WGU_T); bf16* HID = WSP(bf16, WS_HID);
            const LAS int* pst = (const LAS int*)(lctl + LC_PSTART); LAS int* ul = (LAS int*)(lctl + LC_ULIST);
            const int nM = pst[NE], nN = 8, nwg = nM * nN;
            if (tid < 64) { const long L = (long)tid * G + bx; int v = -1;
                if (L < nwg) { int wgid = (int)L; { const int q = nwg / 8, r = nwg % 8, xcd = wgid % 8, off = wgid / 8; wgid = (xcd < r ? xcd * (q + 1) : r * (q + 1) + (xcd - r) * q) + off; }
                    const int nig = 8 * nN, gid = wgid / nig, fm = gid * 8, gsz = (nM - fm) < 8 ? (nM - fm) : 8; const int pm = fm + ((wgid % nig) % gsz), pn = (wgid % nig) / gsz;
                    int e = 0; for (int k = 1; k < NE; ++k) if (pst[k] <= pm) e = k;
                    v = (pm << 16) | (e * nN + pn); }
                ul[tid] = v; }
            __syncthreads();
            const int nunits = bx < nwg ? (nwg - bx + G - 1) / G : 0;
            LAS unsigned short* rows16 = (LAS unsigned short*)(lctl + LC_ROWS); const LAS int* ecnt = (const LAS int*)(lctl + LC_BASE);
            for (int sl = 0; sl < nunits; ++sl) { const int v = ul[sl]; const int pm = v >> 16, e = (v & 0xffff) >> 3, pl = pm - pst[e];
                if (tid < 256) { const int idx = pl * 256 + tid; rows16[sl * 256 + tid] = (idx < ecnt[e]) ? (unsigned short)LIST[(size_t)e * NTOK + idx] : (unsigned short)0; } }
            __syncthreads();
            pg8::Gemm g{HB, WGU_T + (size_t)l * NE * 2048 * DM, NTOK, NE * 2048, DM}; pg8::ListOrder S{ul, nunits};
            pg8::EpiSwiglu E{HID, exp_b_gu + (size_t)l * NE * 2048};
            pg8::gemm_phase_gather<pg8::EpiSwiglu, pg8::ListOrder, true>(lds + RING_OFF, g, S, E, rows16);
        }
        SEAM(pb + 7);
        if (IN(pb + 8) && PON(9)) {
            TID_SETUP(); unsigned char* ws = KWS(); const float* exp_b_down = KIN(17); const bf16* HID = WSP(bf16, WS_HID); const bf16* WDN_T = WSP(bf16, WS_WDN_T); bf16* YS = WSP(bf16, WS_YS);
            const LAS int* pst = (const LAS int*)(lctl + LC_PSTART); LAS int* ul = (LAS int*)(lctl + LC_ULIST);
            const int nM = pst[NE], nN = 4, nwg = nM * nN;
            __syncthreads();
            if (tid < 64) { const long L = (long)tid * G + bx; int v = -1;
                if (L < nwg) { int wgid = (int)L; { const int q = nwg / 8, r = nwg % 8, xcd = wgid % 8, off = wgid / 8; wgid = (xcd < r ? xcd * (q + 1) : r * (q + 1) + (xcd - r) * q) + off; }
                    const int nig = 8 * nN, gid = wgid / nig, fm = gid * 8, gsz = (nM - fm) < 8 ? (nM - fm) : 8; const int pm = fm + ((wgid % nig) % gsz), pn = (wgid % nig) / gsz;
                    int e = 0; for (int k = 1; k < NE; ++k) if (pst[k] <= pm) e = k;
                    v = (pm << 16) | (e * nN + pn); }
                ul[tid] = v; }
            __syncthreads();
            const int nunits = bx < nwg ? (nwg - bx + G - 1) / G : 0;
            pg8::Gemm g{HID, WDN_T + (size_t)l * NE * DM * DE, MPAD, NE * DM, DE}; pg8::ListOrder S{ul, nunits};
            pg8::EpiDown E{YS, exp_b_down + (size_t)l * NE * DM};
            pg8::gemm_phase<pg8::EpiDown, pg8::ListOrder, true, true>(lds + RING_OFF, g, S, E);
        }
        SEAM(pb + 8);
        if (IN(pb + 9) && PON(10)) {
            TID_SETUP(); unsigned char* ws = KWS(); const float* ln2_g = KIN(18); const float* ln2_b = KIN(19); float* out = KOUT(); bf16* HB = WSP(bf16, WS_HB);
            const bf16* YS = WSP(bf16, WS_YS); const int* TOKE = WSP(int, WS_TOK); const int* TOKS = TOKE + NTOK * 4; const float* TOKW = (const float*)(TOKS + NTOK * 4); const LAS int* pst = (const LAS int*)(lctl + LC_PSTART);
            const bool lastl = (l == NL - 1);
            f32x4 gam[4], bet[4];
#pragma unroll
            for (int j = 0; j < 4; ++j) { gam[j] = *(const f32x4*)(ln2_g + l * DM + RC(lane, j)); bet[j] = *(const f32x4*)(ln2_b + l * DM + RC(lane, j)); }
            for (int m0 = gw; m0 < NTOK; m0 += 2 * NGW) { f32x4 v[2][4]; const bf16* yr[2][4]; f32x4 wk[2];
#pragma unroll
                for (int q = 0; q < 2; ++q) { const int m = m0 + q * NGW; const v4u te = *(const v4u*)(TOKE + m * 4), ts = *(const v4u*)(TOKS + m * 4); wk[q] = *(const f32x4*)(TOKW + m * 4);
                    yr[q][0] = YS + (size_t)(pst[te.x] * 256 + (int)ts.x) * DM; yr[q][1] = YS + (size_t)(pst[te.y] * 256 + (int)ts.y) * DM; yr[q][2] = YS + (size_t)(pst[te.z] * 256 + (int)ts.z) * DM; yr[q][3] = YS + (size_t)(pst[te.w] * 256 + (int)ts.w) * DM;
                    row_load_bf16(v[q], HB + (size_t)m * DM, lane);
#pragma unroll
                    for (int j = 0; j < 4; ++j) v[q][j] = v[q][j] * DN_ALPHA; }
#pragma unroll
                for (int q = 0; q < 2; ++q)
#pragma unroll
                    for (int k = 0; k < 4; ++k) { f32x4 y[4]; row_load_bf16(y, yr[q][k], lane); const float w = wk[q][k];
#pragma unroll
                        for (int j = 0; j < 4; ++j) v[q][j] = v[q][j] + y[j] * w; }
#pragma unroll
                for (int q = 0; q < 2; ++q) { const int m = m0 + q * NGW; ln_row8(v[q], gam, bet);
                    if (lastl) {
#pragma unroll
                        for (int j = 0; j < 4; ++j) *(f32x4*)(out + (size_t)m * DM + RC(lane, j)) = v[q][j]; }
                    else row_store_bf16(v[q], HB + (size_t)m * DM, lane); } }
        }
        SEAM(pb + 9);
    }
#if PROBE_A >= 0
    { xcd_barrier(bar);
      const unsigned long long* st = (const unsigned long long*)(KWS() + WS_CTL + 65536); unsigned long long T = 0;
      if (PROBE_A & 1) T += st[1] - st[0];
      for (int l = 0; l < NL; ++l) for (int j = 1; j <= 10; ++j) if ((PROBE_A >> j) & 1) T += st[1 + 10 * l + j] - st[10 * l + j];
      if (PROBE_SUB_A >= 0) for (int l = 0; l < NL; ++l) T += st[128 + l * 16 + PROBE_SUB_B] - st[128 + l * 16 + PROBE_SUB_A];
      T *= 4ull; if (T > 5000000ull) T = 5000000ull;
      const unsigned long long t0 = __builtin_amdgcn_s_memrealtime();
      while (__builtin_amdgcn_s_memrealtime() - t0 < T) __builtin_amdgcn_s_sleep(16); }
#endif
#undef IN
#undef SEAM
}

#ifndef MK_PER_PHASE
#define MK_PER_PHASE 0
#endif
extern "C" void kernel_launch(void* const* d_in, const int* in_sizes, int n_in, void* d_out, int out_size, void* d_ws, size_t ws_size, hipStream_t stream) {
    static int grid = 0;
    if (grid == 0) {
        if (n_in != 20 || in_sizes[0] != NTOK * DM || out_size != NTOK * DM || ws_size < WS_END) { fprintf(stderr, "kernel_launch: unexpected shapes (n_in %d, in0 %d, out %d, ws %zu); nothing launched\n", n_in, n_in > 0 ? in_sizes[0] : -1, out_size, ws_size); grid = -1; return; }
        int dev = 0, cus = 0, per_cu = 0;
        if (hipGetDevice(&dev) != hipSuccess || hipDeviceGetAttribute(&cus, hipDeviceAttributeMultiprocessorCount, dev) != hipSuccess) { grid = -1; return; }
        if (hipFuncSetAttribute((const void*)fwd, hipFuncAttributeMaxDynamicSharedMemorySize, LDS_BYTES) != hipSuccess) { fprintf(stderr, "kernel_launch: hipFuncSetAttribute failed\n"); grid = -1; return; }
        if (hipOccupancyMaxActiveBlocksPerMultiprocessor(&per_cu, (const void*)fwd, NWAVES * 64, LDS_BYTES) != hipSuccess || per_cu < 1) fprintf(stderr, "kernel_launch: occupancy query reports %d\n", per_cu);
        (void)hipGetLastError();
        grid = cus;
    }
    if (grid < 0) return;
    if (hipMemsetAsync((char*)d_ws + WS_CTL, 0, CTL_ZERO_BYTES, stream) != hipSuccess) return;
    Args a{};
    for (int i = 0; i < 20; ++i) a.in[i] = (const float*)d_in[i];
    a.out = (float*)d_out; a.ws = (unsigned char*)d_ws;
#if MK_PER_PHASE
    for (int p = 0; p < N_PHASES; ++p) { a.ph_lo = p; a.ph_hi = p + 1; hipLaunchKernelGGL(fwd, dim3(grid), dim3(NWAVES * 64), LDS_BYTES, stream, a); }
#else
    a.ph_lo = 0; a.ph_hi = N_PHASES;
    hipLaunchKernelGGL(fwd, dim3(grid), dim3(NWAVES * 64), LDS_BYTES, stream, a);
#endif
    const hipError_t le = hipPeekAtLastError();
    if (le != hipSuccess) fprintf(stderr, "kernel_launch: launch failed: %s\n", hipGetErrorName(le));
}
```

```cpp
#include <hip/hip_runtime.h>
#include <hip/hip_bf16.h>
#include <cstdio>
#include <cstdint>
#include <cmath>
namespace pg8 {
#define PG8_LAS __attribute__((address_space(3)))
typedef unsigned short bf16_t;
typedef short bf16x8 __attribute__((ext_vector_type(8)));
typedef float f32x4 __attribute__((ext_vector_type(4)));
typedef unsigned u32x4 __attribute__((ext_vector_type(4)));
constexpr int BM = 256, BK = 64, HALF = 128, HTB = HALF * BK * 2  , STAGE_BYTES = 8 * HTB, NXCD = 8, WGM = 8;

__host__ __device__ __forceinline__ int lds_byte(int r, int c) { const int st = (r >> 4) * 2 + (c >> 5), rr = r & 15, cc = c & 31, ob = rr * 64 + cc * 2; return st * 1024 + (ob ^ (((ob >> 9) & 1) << 5)); }
__host__ __device__ __forceinline__ void stage_rc(int b, int& R, int& C) { const int st = b / 1024, sb = b % 1024, swz = sb ^ (((sb >> 9) & 1) << 5); R = (st >> 1) * 16 + swz / 64; C = (st & 1) * 32 + (swz % 64) / 2; }
__host__ __device__ __forceinline__ int perm32(int rho) { const int n = rho >> 4, i = rho & 15; return 8 * (i >> 2) + 4 * n + (i & 3); }

struct Unit { int pm, pn; };
struct Gemm { const bf16_t* A; const bf16_t* Bt; int M, N, K; };

struct StaticOrder {
    int nM, nN, nwg, G, c;
    __host__ __device__ void init(int M, int N, int G_, int c_) { nM = M / BM; nN = N / BM; nwg = nM * nN; G = G_; c = c_; }
    __host__ __device__ bool next(int i, Unit& u) const {
        const long L = (long)i * G + c; if (L >= nwg) return false;
        int wgid = (int)L; { const int q = nwg / NXCD, r = nwg % NXCD, xcd = wgid % NXCD, off = wgid / NXCD; wgid = (xcd < r ? xcd * (q + 1) : r * (q + 1) + (xcd - r) * q) + off; }
        const int nig = WGM * nN, gid = wgid / nig, fm = gid * WGM, gsz = (nM - fm) < WGM ? (nM - fm) : WGM;
        u.pm = fm + ((wgid % nig) % gsz); u.pn = (wgid % nig) / gsz; return true;
    }
    __device__ __forceinline__ void a_ready(const Unit&) const {}
    __device__ __forceinline__ void done(const Unit&) const {}
};

__device__ __forceinline__ unsigned cvt_pk_bf16(float lo, float hi) { unsigned r; asm volatile("v_cvt_pk_bf16_f32 %0, %1, %2" : "=v"(r) : "v"(lo), "v"(hi)); return r; }
typedef float f32x2 __attribute__((ext_vector_type(2)));
__device__ __forceinline__ u32x4 pack8(const f32x4 v0, const f32x4 v1) { u32x4 w; w.x = cvt_pk_bf16(v0[0], v0[1]); w.y = cvt_pk_bf16(v0[2], v0[3]); w.z = cvt_pk_bf16(v1[0], v1[1]); w.w = cvt_pk_bf16(v1[2], v1[3]); return w; }

struct EpiPlainBf16 {
    static constexpr bool PERM = true, AFTER_DRAIN = false;
    bf16_t* O; int ldc;
    __device__ __forceinline__ void operator()(const f32x4 (&acc)[2][2][4][2], const Unit& u, int wr, int wc, int fr, int fq) const {
        const int row0 = u.pm * BM + wr * 64 + fr, col0 = u.pn * BM + wc * 32 + 8 * fq;
#pragma unroll
        for (int ai = 0; ai < 2; ++ai)
#pragma unroll
            for (int m = 0; m < 4; ++m) { bf16_t* rowp = O + (size_t)(row0 + ai * HALF + m * 16) * ldc + col0;
#pragma unroll
                for (int bj = 0; bj < 2; ++bj) *(u32x4*)(rowp + bj * HALF) = pack8(acc[ai][bj][m][0], acc[ai][bj][m][1]); }
    }
};
struct EpiFnet {
    static constexpr bool PERM = true, AFTER_DRAIN = false;
    bf16_t* MIX;
    __device__ __forceinline__ void operator()(const f32x4 (&acc)[2][2][4][2], const Unit& u, int wr, int wc, int fr, int fq) const {
        const int row0 = u.pn * 4096 + u.pm * BM + wr * 64 + fr, col0 = 768 + wc * 32 + 8 * fq;
#pragma unroll
        for (int ai = 0; ai < 2; ++ai)
#pragma unroll
            for (int m = 0; m < 4; ++m) { bf16_t* rowp = MIX + (size_t)(row0 + ai * HALF + m * 16) * 1024 + col0;
#pragma unroll
                for (int bj = 0; bj < 2; ++bj) *(u32x4*)(rowp + bj * HALF) = pack8(acc[ai][bj][m][0], acc[ai][bj][m][1]); }
    }
};
struct EpiResF32 {
    static constexpr bool PERM = false, AFTER_DRAIN = false;
    const float* base; float* out; int ldc; float alpha;
    __device__ __forceinline__ void operator()(const f32x4 (&acc)[2][2][4][2], const Unit& u, int wr, int wc, int fr, int fq) const {
        const int row0 = u.pm * BM + wr * 64 + fr, col0 = u.pn * BM + wc * 32 + 4 * fq;
#pragma unroll
        for (int ai = 0; ai < 2; ++ai)
#pragma unroll
            for (int m = 0; m < 4; ++m) { const size_t off = (size_t)(row0 + ai * HALF + m * 16) * ldc + col0;
#pragma unroll
                for (int bj = 0; bj < 2; ++bj)
#pragma unroll
                    for (int n = 0; n < 2; ++n) { const f32x4 b = *(const f32x4*)(base + off + bj * HALF + n * 16); *(f32x4*)(out + off + bj * HALF + n * 16) = b * alpha + acc[ai][bj][m][n]; } }
    }
};
struct EpiResBf16 {
    static constexpr bool PERM = true, AFTER_DRAIN = false;
    const bf16_t* base; bf16_t* out; int ldc; float alpha;
    __device__ __forceinline__ void operator()(const f32x4 (&acc)[2][2][4][2], const Unit& u, int wr, int wc, int fr, int fq) const {
        const int row0 = u.pm * BM + wr * 64 + fr, col0 = u.pn * BM + wc * 32 + 8 * fq;
#pragma unroll
        for (int ai = 0; ai < 2; ++ai)
#pragma unroll
            for (int m = 0; m < 4; ++m) { const size_t off = (size_t)(row0 + ai * HALF + m * 16) * ldc + col0;
#pragma unroll
                for (int bj = 0; bj < 2; ++bj) { const u32x4 b = *(const u32x4*)(base + off + bj * HALF);
                    const f32x4 b0 = {__uint_as_float(b.x << 16), __uint_as_float(b.x & 0xffff0000u), __uint_as_float(b.y << 16), __uint_as_float(b.y & 0xffff0000u)};
                    const f32x4 b1 = {__uint_as_float(b.z << 16), __uint_as_float(b.z & 0xffff0000u), __uint_as_float(b.w << 16), __uint_as_float(b.w & 0xffff0000u)};
                    *(u32x4*)(out + off + bj * HALF) = pack8(b0 * alpha + acc[ai][bj][m][0], b1 * alpha + acc[ai][bj][m][1]); } }
    }
};
__device__ __forceinline__ float swiglu1(float g, float u) { g = fminf(g, 7.0f); u = fminf(fmaxf(u, -7.0f), 7.0f); return (u + 1.0f) * g * __builtin_amdgcn_rcpf(1.0f + __expf(-1.702f * g)); }
struct EpiSwiglu {
    static constexpr bool PERM = true, AFTER_DRAIN = false;
    bf16_t* HID; const float* bgu;
    __device__ __forceinline__ void operator()(const f32x4 (&acc)[2][2][4][2], const Unit& u, int wr, int wc, int fr, int fq) const {
        const int e = u.pn >> 3, pnl = u.pn & 7; const int row0 = u.pm * BM + wr * 64 + fr, jj0 = pnl * 128 + wc * 32 + 8 * fq;
        const float* bg = bgu + (size_t)e * 2048 + jj0;
        const f32x4 bg0 = *(const f32x4*)bg, bg1 = *(const f32x4*)(bg + 4), bu0 = *(const f32x4*)(bg + 1024), bu1 = *(const f32x4*)(bg + 1028);
#pragma unroll
        for (int ai = 0; ai < 2; ++ai)
#pragma unroll
            for (int m = 0; m < 4; ++m) { bf16_t* rowp = HID + (size_t)(row0 + ai * HALF + m * 16) * 1024 + jj0;
                const f32x4 g0 = acc[ai][0][m][0] + bg0, g1 = acc[ai][0][m][1] + bg1, u0 = acc[ai][1][m][0] + bu0, u1 = acc[ai][1][m][1] + bu1;
                f32x4 h0, h1;
#pragma unroll
                for (int i = 0; i < 4; ++i) { h0[i] = swiglu1(g0[i], u0[i]); h1[i] = swiglu1(g1[i], u1[i]); }
                *(u32x4*)rowp = pack8(h0, h1); }
    }
};
struct EpiDown {
    static constexpr bool PERM = true, AFTER_DRAIN = false;
    bf16_t* Y; const float* bd;
    __device__ __forceinline__ void operator()(const f32x4 (&acc)[2][2][4][2], const Unit& u, int wr, int wc, int fr, int fq) const {
        const int e = u.pn >> 2, pnl = u.pn & 3; const int row0 = u.pm * BM + wr * 64 + fr, col0 = pnl * BM + wc * 32 + 8 * fq;
        const float* bp = bd + (size_t)e * 1024 + col0;
        f32x4 bv[2][2];
#pragma unroll
        for (int bj = 0; bj < 2; ++bj)
#pragma unroll
            for (int n = 0; n < 2; ++n) bv[bj][n] = *(const f32x4*)(bp + bj * HALF + 4 * n);
#pragma unroll
        for (int ai = 0; ai < 2; ++ai)
#pragma unroll
            for (int m = 0; m < 4; ++m) { bf16_t* rowp = Y + (size_t)(row0 + ai * HALF + m * 16) * 1024 + col0;
#pragma unroll
                for (int bj = 0; bj < 2; ++bj) *(u32x4*)(rowp + bj * HALF) = pack8(acc[ai][bj][m][0] + bv[bj][0], acc[ai][bj][m][1] + bv[bj][1]); }
    }
};
struct EpiNull {
    static constexpr bool PERM = true, AFTER_DRAIN = false;
    bf16_t* O;
    __device__ __forceinline__ void operator()(const f32x4 (&acc)[2][2][4][2], const Unit& u, int wr, int wc, int fr, int fq) const {
#pragma unroll
        for (int ai = 0; ai < 2; ++ai)
#pragma unroll
            for (int bj = 0; bj < 2; ++bj)
#pragma unroll
                for (int m = 0; m < 4; ++m)
#pragma unroll
                    for (int n = 0; n < 2; ++n) asm volatile("" :: "v"(acc[ai][bj][m][n]));
    }
};
struct ListOrder {
    const PG8_LAS int* list; int n;
    __device__ __forceinline__ bool next(int i, Unit& u) const { if (i >= n) return false; const int v = __builtin_amdgcn_readfirstlane(list[i]); u.pm = v >> 16; u.pn = v & 0xffff; return true; }
    __device__ __forceinline__ void a_ready(const Unit&) const {}
    __device__ __forceinline__ void done(const Unit&) const {}
};
template <class Epi, class Sched, bool ALIGN_EPI = false, bool SP2 = false>
__device__ __forceinline__ void gemm_phase(PG8_LAS unsigned char* lds, const Gemm g, const Sched& S, const Epi& E) {
    int tid_ = threadIdx.x; asm volatile("" : "+v"(tid_));
    const int tid = tid_, wid = __builtin_amdgcn_readfirstlane(tid >> 6), lane = tid & 63, wr = wid >> 2, wc = wid & 3, fr = lane & 15, fq = lane >> 4;
    const int K = g.K, nt = K / BK;
    unsigned voffA[2], voffB[2];
#pragma unroll
    for (int i = 0; i < 2; ++i) { int R, C; stage_rc(tid * 16 + i * 8192, R, C); const int Rb = Epi::PERM ? ((R & ~31) + perm32(R & 31)) : R;
        voffA[i] = (unsigned)(R * K + C) * 2u; voffB[i] = (unsigned)(Rb * K + C) * 2u; }
    const size_t kstep = (size_t)(BK * 2);
    const size_t hstep = (size_t)HALF * K * 2;
    const size_t tstep = 2 * hstep;
    const unsigned ldsw = (unsigned)wid * 1024u;
    const int aoff = lds_byte(wr * 64 + fr, fq * 8), boff = lds_byte(wc * 32 + fr, fq * 8);
#define PG8_SA(b, h) (((b) * 2 + (h)) * HTB)
#define PG8_SB(b, h) ((4 + (b) * 2 + (h)) * HTB)
#define PG8_STAGE(bufoff, gbase, voff) do { _Pragma("unroll") for (int _i = 0; _i < 2; ++_i) \
        __builtin_amdgcn_global_load_lds((const unsigned*)((const char*)(gbase) + (voff)[_i]), (PG8_LAS unsigned*)(lds + (bufoff) + ldsw + _i * 8192), 16, 0, 0); } while (0)
#define PG8_LDA(dst, b, h) do { _Pragma("unroll") for (int m = 0; m < 4; ++m) _Pragma("unroll") for (int k = 0; k < 2; ++k) dst[m][k] = *(const PG8_LAS bf16x8*)(lds + PG8_SA(b, h) + aoff + m * 2048 + k * 1024); } while (0)
#define PG8_LDB(dst, b, h) do { _Pragma("unroll") for (int n = 0; n < 2; ++n) _Pragma("unroll") for (int k = 0; k < 2; ++k) dst[n][k] = *(const PG8_LAS bf16x8*)(lds + PG8_SB(b, h) + boff + n * 2048 + k * 1024); } while (0)
#define PG8_MMA(ai, bj, At, Bt) do { __builtin_amdgcn_s_setprio(1); _Pragma("unroll") for (int m = 0; m < 4; ++m) _Pragma("unroll") for (int n = 0; n < 2; ++n) _Pragma("unroll") for (int k = 0; k < 2; ++k) \
        acc[ai][bj][m][n] = __builtin_amdgcn_mfma_f32_16x16x32_bf16(Bt[n][k], At[m][k], acc[ai][bj][m][n], 0, 0, 0); __builtin_amdgcn_s_setprio(0); } while (0)
#define PG8_WAIT_V(n) asm volatile("s_waitcnt vmcnt(" #n ")" ::: "memory")
#define PG8_WAIT_L(n) asm volatile("s_waitcnt lgkmcnt(" #n ")" ::: "memory")
#define PG8_BAR __builtin_amdgcn_s_barrier()
#define PG8_SCHED __builtin_amdgcn_sched_barrier(0)
    Unit cur, nxt; int ui = 0;
    if (!S.next(0, cur)) return;
    f32x4 acc[2][2][4][2];
#pragma unroll
    for (int a = 0; a < 2; ++a)
#pragma unroll
        for (int b = 0; b < 2; ++b)
#pragma unroll
            for (int m = 0; m < 4; ++m)
#pragma unroll
                for (int n = 0; n < 2; ++n) acc[a][b][m][n] = (f32x4){0.f, 0.f, 0.f, 0.f};
    bf16x8 At[4][2], B0[2][2], B1[2][2];
    const char* cA = (const char*)g.A + (size_t)cur.pm * tstep; const char* cB = (const char*)g.Bt + (size_t)cur.pn * tstep;
    S.a_ready(cur);
    if constexpr (SP2) {
        PG8_STAGE(PG8_SB(0, 0), cB, voffB); PG8_STAGE(PG8_SB(0, 1), cB + hstep, voffB); PG8_STAGE(PG8_SA(0, 0), cA, voffA); PG8_STAGE(PG8_SA(0, 1), cA + hstep, voffA);
        if (wr == 1) PG8_BAR;
        PG8_WAIT_V(2); PG8_BAR;
        PG8_STAGE(PG8_SB(1, 0), cB + kstep, voffB); PG8_STAGE(PG8_SA(1, 0), cA + kstep, voffA); PG8_STAGE(PG8_SB(1, 1), cB + hstep + kstep, voffB);
        PG8_WAIT_V(6); PG8_BAR;
    } else {
        PG8_STAGE(PG8_SB(0, 0), cB, voffB); PG8_STAGE(PG8_SA(0, 0), cA, voffA); PG8_STAGE(PG8_SB(0, 1), cB + hstep, voffB); PG8_STAGE(PG8_SA(0, 1), cA + hstep, voffA);
        if (wr == 1) PG8_BAR;
        PG8_WAIT_V(4); PG8_BAR;
        PG8_STAGE(PG8_SB(1, 0), cB + kstep, voffB); PG8_STAGE(PG8_SA(1, 0), cA + kstep, voffA); PG8_STAGE(PG8_SB(1, 1), cB + hstep + kstep, voffB);
        PG8_WAIT_V(6); PG8_BAR;
    }
    for (;;) {
        const bool has_next = S.next(ui + 1, nxt);
        const char* nA = has_next ? (const char*)g.A + (size_t)nxt.pm * tstep : cA; const char* nB = has_next ? (const char*)g.Bt + (size_t)nxt.pn * tstep : cB;
        for (int t = 0; t < nt; t += 2) {
            const bool last = (t == nt - 2);
            const char* a1 = cA + (size_t)(t + 1) * kstep;
            const char* a2 = last ? nA : cA + (size_t)(t + 2) * kstep; const char* b2 = last ? nB : cB + (size_t)(t + 2) * kstep;
            const char* a3 = a2 + kstep; const char* b3 = b2 + kstep;
            if (last && has_next) S.a_ready(nxt);
            if constexpr (SP2) {
            PG8_LDB(B0, 0, 0); PG8_LDB(B1, 0, 1); PG8_SCHED; PG8_LDA(At, 0, 0); PG8_STAGE(PG8_SA(1, 1), a1 + hstep, voffA);
            PG8_WAIT_V(8); PG8_WAIT_L(0); PG8_BAR; PG8_MMA(0, 0, At, B0); PG8_MMA(0, 1, At, B1); PG8_BAR; PG8_SCHED;
            PG8_LDA(At, 0, 1); PG8_STAGE(PG8_SB(0, 0), b2, voffB); PG8_STAGE(PG8_SB(0, 1), b2 + hstep, voffB); PG8_STAGE(PG8_SA(0, 0), a2, voffA);
            PG8_WAIT_V(8); PG8_WAIT_L(0); PG8_BAR; PG8_MMA(1, 0, At, B0); PG8_MMA(1, 1, At, B1); PG8_BAR; PG8_SCHED;
            PG8_LDB(B0, 1, 0); PG8_LDB(B1, 1, 1); PG8_SCHED; PG8_LDA(At, 1, 0); PG8_STAGE(PG8_SA(0, 1), a2 + hstep, voffA);
            PG8_WAIT_V(8); PG8_WAIT_L(0); PG8_BAR; PG8_MMA(0, 0, At, B0); PG8_MMA(0, 1, At, B1); PG8_BAR; PG8_SCHED;
            PG8_LDA(At, 1, 1); PG8_STAGE(PG8_SB(1, 0), b3, voffB); PG8_STAGE(PG8_SB(1, 1), b3 + hstep, voffB); PG8_STAGE(PG8_SA(1, 0), a3, voffA);
            PG8_WAIT_V(8); PG8_WAIT_L(0); PG8_BAR; PG8_MMA(1, 0, At, B0); PG8_MMA(1, 1, At, B1); PG8_BAR; PG8_SCHED;
            } else {
            PG8_LDB(B0, 0, 0); PG8_SCHED; PG8_LDA(At, 0, 0); PG8_STAGE(PG8_SA(1, 1), a1 + hstep, voffA);
            PG8_WAIT_L(8); PG8_BAR; PG8_WAIT_L(0); PG8_MMA(0, 0, At, B0); PG8_BAR; PG8_SCHED;
            PG8_LDB(B1, 0, 1); PG8_STAGE(PG8_SB(0, 0), b2, voffB);
            PG8_BAR; PG8_WAIT_L(0); PG8_MMA(0, 1, At, B1); PG8_BAR;
            PG8_LDA(At, 0, 1); PG8_STAGE(PG8_SA(0, 0), a2, voffA);
            PG8_BAR; PG8_WAIT_L(0); PG8_MMA(1, 0, At, B0); PG8_BAR; PG8_SCHED;
            PG8_STAGE(PG8_SB(0, 1), b2 + hstep, voffB);
            PG8_WAIT_V(6); PG8_BAR; PG8_MMA(1, 1, At, B1); PG8_BAR;
            PG8_LDB(B0, 1, 0); PG8_SCHED; PG8_LDA(At, 1, 0); PG8_STAGE(PG8_SA(0, 1), a2 + hstep, voffA);
            PG8_WAIT_L(8); PG8_BAR; PG8_WAIT_L(0); PG8_MMA(0, 0, At, B0); PG8_BAR; PG8_SCHED;
            PG8_LDB(B1, 1, 1); PG8_STAGE(PG8_SB(1, 0), b3, voffB);
            PG8_BAR; PG8_WAIT_L(0); PG8_MMA(0, 1, At, B1); PG8_BAR;
            PG8_LDA(At, 1, 1); PG8_STAGE(PG8_SA(1, 0), a3, voffA);
            PG8_BAR; PG8_WAIT_L(0); PG8_MMA(1, 0, At, B0); PG8_BAR; PG8_SCHED;
            PG8_STAGE(PG8_SB(1, 1), b3 + hstep, voffB);
            PG8_WAIT_V(6); PG8_BAR; PG8_MMA(1, 1, At, B1); PG8_BAR;
            }
        }
        if constexpr (ALIGN_EPI) { if (wr == 0) PG8_BAR; }
        if constexpr (!Epi::AFTER_DRAIN) { E(acc, cur, wr, wc, fr, fq); S.done(cur); }
        if (!has_next) break;
#pragma unroll
        for (int a = 0; a < 2; ++a)
#pragma unroll
            for (int b = 0; b < 2; ++b)
#pragma unroll
                for (int m = 0; m < 4; ++m)
#pragma unroll
                    for (int n = 0; n < 2; ++n) acc[a][b][m][n] = (f32x4){0.f, 0.f, 0.f, 0.f};
        cur = nxt; cA = nA; cB = nB; ++ui;
        if constexpr (ALIGN_EPI) { if (wr == 1) PG8_BAR; }
    }
    PG8_WAIT_V(0);
    if constexpr (!ALIGN_EPI) { if (wr == 0) PG8_BAR; }
    PG8_BAR;
    if constexpr (Epi::AFTER_DRAIN) { E.fused(acc, cur, wr, wc, fr, fq, lds, wid, lane); S.done(cur); }
#undef PG8_SA
#undef PG8_SB
#undef PG8_STAGE
#undef PG8_LDA
#undef PG8_LDB
#undef PG8_MMA
#undef PG8_WAIT_V
#undef PG8_WAIT_L
#undef PG8_BAR
#undef PG8_SCHED
}
}
namespace pg8 {
template <class Epi, class Sched, bool ALIGN_EPI>
__device__ __forceinline__ void gemm_phase_gather(PG8_LAS unsigned char* lds, const Gemm g, const Sched& S, const Epi& E, const PG8_LAS unsigned short* rows16) {
    int tid_ = threadIdx.x; asm volatile("" : "+v"(tid_));
    const int tid = tid_, wid = __builtin_amdgcn_readfirstlane(tid >> 6), lane = tid & 63, wr = wid >> 2, wc = wid & 3, fr = lane & 15, fq = lane >> 4;
    const int K = g.K, nt = K / BK;
    unsigned voffB[2]; int RA[2]; unsigned CA2[2];
#pragma unroll
    for (int i = 0; i < 2; ++i) { int R, C; stage_rc(tid * 16 + i * 8192, R, C); const int Rb = Epi::PERM ? ((R & ~31) + perm32(R & 31)) : R;
        RA[i] = R; CA2[i] = (unsigned)C * 2u; voffB[i] = (unsigned)(Rb * K + C) * 2u; }
    const size_t kstep = (size_t)(BK * 2);
    const size_t hstep = (size_t)HALF * K * 2;
    const size_t tstep = 2 * hstep;
    const unsigned ldsw = (unsigned)wid * 1024u;
    const unsigned rowb = (unsigned)K * 2u;
    const int aoff = lds_byte(wr * 64 + fr, fq * 8), boff = lds_byte(wc * 32 + fr, fq * 8);
#define PG8_SA(b, h) (((b) * 2 + (h)) * HTB)
#define PG8_SB(b, h) ((4 + (b) * 2 + (h)) * HTB)
#define PG8_STAGE(bufoff, gbase, voff) do { _Pragma("unroll") for (int _i = 0; _i < 2; ++_i) \
        __builtin_amdgcn_global_load_lds((const unsigned*)((const char*)(gbase) + (voff)[_i]), (PG8_LAS unsigned*)(lds + (bufoff) + ldsw + _i * 8192), 16, 0, 0); } while (0)
#define PG8_LDA(dst, b, h) do { _Pragma("unroll") for (int m = 0; m < 4; ++m) _Pragma("unroll") for (int k = 0; k < 2; ++k) dst[m][k] = *(const PG8_LAS bf16x8*)(lds + PG8_SA(b, h) + aoff + m * 2048 + k * 1024); } while (0)
#define PG8_LDB(dst, b, h) do { _Pragma("unroll") for (int n = 0; n < 2; ++n) _Pragma("unroll") for (int k = 0; k < 2; ++k) dst[n][k] = *(const PG8_LAS bf16x8*)(lds + PG8_SB(b, h) + boff + n * 2048 + k * 1024); } while (0)
#define PG8_MMA(ai, bj, At, Bt) do { __builtin_amdgcn_s_setprio(1); _Pragma("unroll") for (int m = 0; m < 4; ++m) _Pragma("unroll") for (int n = 0; n < 2; ++n) _Pragma("unroll") for (int k = 0; k < 2; ++k) \
        acc[ai][bj][m][n] = __builtin_amdgcn_mfma_f32_16x16x32_bf16(Bt[n][k], At[m][k], acc[ai][bj][m][n], 0, 0, 0); __builtin_amdgcn_s_setprio(0); } while (0)
#define PG8_WAIT_V(n) asm volatile("s_waitcnt vmcnt(" #n ")" ::: "memory")
#define PG8_WAIT_L(n) asm volatile("s_waitcnt lgkmcnt(" #n ")" ::: "memory")
#define PG8_BAR __builtin_amdgcn_s_barrier()
#define PG8_SCHED __builtin_amdgcn_sched_barrier(0)
#define PG8_GOFF(dst, U) do { _Pragma("unroll") for (int h_ = 0; h_ < 2; ++h_) _Pragma("unroll") for (int i_ = 0; i_ < 2; ++i_) dst[h_][i_] = (unsigned)rows16[(U) * 256 + h_ * HALF + RA[i_]] * rowb + CA2[i_]; } while (0)
    Unit cur, nxt; int ui = 0;
    if (!S.next(0, cur)) return;
    f32x4 acc[2][2][4][2];
#pragma unroll
    for (int a = 0; a < 2; ++a)
#pragma unroll
        for (int b = 0; b < 2; ++b)
#pragma unroll
            for (int m = 0; m < 4; ++m)
#pragma unroll
                for (int n = 0; n < 2; ++n) acc[a][b][m][n] = (f32x4){0.f, 0.f, 0.f, 0.f};
    bf16x8 At[4][2], B0[2][2], B1[2][2];
    const char* const Ab = (const char*)g.A;
    const char* cB = (const char*)g.Bt + (size_t)cur.pn * tstep;
    unsigned gc[2][2], gn[2][2];
    PG8_GOFF(gc, 0);
    S.a_ready(cur);
    PG8_STAGE(PG8_SB(0, 0), cB, voffB); PG8_STAGE(PG8_SB(0, 1), cB + hstep, voffB); PG8_STAGE(PG8_SA(0, 0), Ab, gc[0]); PG8_STAGE(PG8_SA(0, 1), Ab, gc[1]);
    if (wr == 1) PG8_BAR;
    PG8_WAIT_V(2); PG8_BAR;
    PG8_STAGE(PG8_SB(1, 0), cB + kstep, voffB); PG8_STAGE(PG8_SA(1, 0), Ab + kstep, gc[0]); PG8_STAGE(PG8_SB(1, 1), cB + hstep + kstep, voffB);
    PG8_WAIT_V(6); PG8_BAR;
    for (;;) {
        const bool has_next = S.next(ui + 1, nxt);
        const char* nB = has_next ? (const char*)g.Bt + (size_t)nxt.pn * tstep : cB;
        if (has_next) { PG8_GOFF(gn, ui + 1); } else {
#pragma unroll
            for (int h_ = 0; h_ < 2; ++h_)
#pragma unroll
                for (int i_ = 0; i_ < 2; ++i_) gn[h_][i_] = gc[h_][i_]; }
        for (int t = 0; t < nt; t += 2) {
            const bool last = (t == nt - 2);
            const char* a1 = Ab + (size_t)(t + 1) * kstep;
            const char* a2 = last ? Ab : Ab + (size_t)(t + 2) * kstep; const char* b2 = last ? nB : cB + (size_t)(t + 2) * kstep;
            const char* a3 = a2 + kstep; const char* b3 = b2 + kstep;
            unsigned g2[2][2];
#pragma unroll
            for (int h_ = 0; h_ < 2; ++h_)
#pragma unroll
                for (int i_ = 0; i_ < 2; ++i_) g2[h_][i_] = last ? gn[h_][i_] : gc[h_][i_];
            if (last && has_next) S.a_ready(nxt);
            PG8_LDB(B0, 0, 0); PG8_LDB(B1, 0, 1); PG8_SCHED; PG8_LDA(At, 0, 0); PG8_STAGE(PG8_SA(1, 1), a1, gc[1]);
            PG8_WAIT_V(8); PG8_WAIT_L(0); PG8_BAR; PG8_MMA(0, 0, At, B0); PG8_MMA(0, 1, At, B1); PG8_BAR; PG8_SCHED;
            PG8_LDA(At, 0, 1); PG8_STAGE(PG8_SB(0, 0), b2, voffB); PG8_STAGE(PG8_SB(0, 1), b2 + hstep, voffB); PG8_STAGE(PG8_SA(0, 0), a2, g2[0]);
            PG8_WAIT_V(8); PG8_WAIT_L(0); PG8_BAR; PG8_MMA(1, 0, At, B0); PG8_MMA(1, 1, At, B1); PG8_BAR; PG8_SCHED;
            PG8_LDB(B0, 1, 0); PG8_LDB(B1, 1, 1); PG8_SCHED; PG8_LDA(At, 1, 0); PG8_STAGE(PG8_SA(0, 1), a2, g2[1]);
            PG8_WAIT_V(8); PG8_WAIT_L(0); PG8_BAR; PG8_MMA(0, 0, At, B0); PG8_MMA(0, 1, At, B1); PG8_BAR; PG8_SCHED;
            PG8_LDA(At, 1, 1); PG8_STAGE(PG8_SB(1, 0), b3, voffB); PG8_STAGE(PG8_SB(1, 1), b3 + hstep, voffB); PG8_STAGE(PG8_SA(1, 0), a3, g2[0]);
            PG8_WAIT_V(8); PG8_WAIT_L(0); PG8_BAR; PG8_MMA(1, 0, At, B0); PG8_MMA(1, 1, At, B1); PG8_BAR; PG8_SCHED;
        }
        if constexpr (ALIGN_EPI) { if (wr == 0) PG8_BAR; }
        E(acc, cur, wr, wc, fr, fq); S.done(cur);
        if (!has_next) break;
#pragma unroll
        for (int a = 0; a < 2; ++a)
#pragma unroll
            for (int b = 0; b < 2; ++b)
#pragma unroll
                for (int m = 0; m < 4; ++m)
#pragma unroll
                    for (int n = 0; n < 2; ++n) acc[a][b][m][n] = (f32x4){0.f, 0.f, 0.f, 0.f};
        cur = nxt; cB = nB; ++ui;
#pragma unroll
        for (int h_ = 0; h_ < 2; ++h_)
#pragma unroll
            for (int i_ = 0; i_ < 2; ++i_) gc[h_][i_] = gn[h_][i_];
        if constexpr (ALIGN_EPI) { if (wr == 1) PG8_BAR; }
    }
    PG8_WAIT_V(0);
    if constexpr (!ALIGN_EPI) { if (wr == 0) PG8_BAR; }
    PG8_BAR;
#undef PG8_SA
#undef PG8_SB
#undef PG8_STAGE
#undef PG8_LDA
#undef PG8_LDB
#undef PG8_MMA
#undef PG8_WAIT_V
#undef PG8_WAIT_L
#undef PG8_BAR
#undef PG8_SCHED
#undef PG8_GOFF
}
}
#define GAS __attribute__((address_space(1)))
#define LAS __attribute__((address_space(3)))
typedef unsigned short bf16;
typedef unsigned v4u __attribute__((ext_vector_type(4)));
typedef float f32x4 __attribute__((ext_vector_type(4)));
typedef short bf16x8 __attribute__((ext_vector_type(8)));
typedef GAS unsigned gu32;
typedef GAS unsigned long long gu64;
#define RLX_AGENT __ATOMIC_RELAXED, __HIP_MEMORY_SCOPE_AGENT
#define LDS_WAIT() asm volatile("s_waitcnt lgkmcnt(0)" ::: "memory")
#define VM_WAIT() asm volatile("s_waitcnt vmcnt(0)" ::: "memory")
__device__ __forceinline__ unsigned long long rt() { return __builtin_amdgcn_s_memrealtime(); }
__device__ __forceinline__ unsigned f2bf(float f) { unsigned u = __builtin_bit_cast(unsigned, f); return (u + 0x7fffu + ((u >> 16) & 1u)) >> 16; }
__device__ __forceinline__ unsigned pk2(float lo, float hi) { return f2bf(lo) | (f2bf(hi) << 16); }
#define XB_TMO      128
#define XB_XCNT(j)  (256  + 64 * (j))
#define XB_XSUB(j)  (1280 + 64 * (j))
#define XB_XGEN(j)  (2304 + 64 * (j))
#define XB_TOP      3328
#define XB_TOPGEN   3392
#define XCD_BAR_WORDS 3456
#define XB_SPIN_CAP (1u << 18)

__device__ __forceinline__ unsigned xb_ld(unsigned* p)              { return __hip_atomic_load(p, __ATOMIC_RELAXED, __HIP_MEMORY_SCOPE_AGENT); }
__device__ __forceinline__ unsigned xb_add(unsigned* p, unsigned v) { return __hip_atomic_fetch_add(p, v, __ATOMIC_RELAXED, __HIP_MEMORY_SCOPE_AGENT); }
__device__ __forceinline__ unsigned xb_xcc_id() { return (unsigned)__builtin_amdgcn_s_getreg((3 << 11) | 20) & 0xFu; }
#define XB_SPIN(cond, bar) do { unsigned _sp = 0; while (cond) { __builtin_amdgcn_s_sleep(1); \
    if ((++_sp & 255u) == 0u) { if (xb_ld(&(bar)[XB_TMO])) break; if (_sp > XB_SPIN_CAP) { atomicAdd(&(bar)[XB_TMO], 1u); break; } } } } while (0)

struct XcdBarrier {
    unsigned* bar; unsigned x;
    volatile LAS unsigned* st;
};

__device__ __forceinline__ XcdBarrier xcd_barrier_post(unsigned* bar, volatile LAS unsigned* st) {
    XcdBarrier b; b.bar = bar; b.x = xb_xcc_id(); b.st = st;
    if (threadIdx.x == 0) (void)xb_add(&bar[XB_XCNT(b.x)], 1u);
    return b;
}
__device__ __forceinline__ void xcd_barrier_complete(unsigned* bar, unsigned x, unsigned& nloc, unsigned& nx) {
    const unsigned G = gridDim.x * gridDim.y * gridDim.z;
    unsigned sum, cnt, mine, sp = 0u;
    for (;;) {
        sum = 0u; cnt = 0u; mine = 0u;
#pragma unroll
        for (unsigned j = 0; j < 16; ++j) { const unsigned c = xb_ld(&bar[XB_XCNT(j)]); sum += c; cnt += (c > 0u) ? 1u : 0u; mine = (j == x) ? c : mine; }
        if (sum == G) break;
        __builtin_amdgcn_s_sleep(1);
        if ((++sp & 255u) == 0u) { if (xb_ld(&bar[XB_TMO])) break; if (sp > XB_SPIN_CAP) { atomicAdd(&bar[XB_TMO], 1u); break; } }
    }
    nloc = mine > 0u ? mine : 1u; nx = cnt > 0u ? cnt : 1u;
}

__device__ __forceinline__ void xcd_barrier(const XcdBarrier& b) {
    asm volatile("s_waitcnt vmcnt(0)" ::: "memory");
    __syncthreads();
    if (threadIdx.x == 0) {
        unsigned* bar = b.bar;
        __builtin_amdgcn_s_waitcnt(0);
        unsigned nloc = b.st[0], nx = b.st[1];
        if (nloc == 0u) { xcd_barrier_complete(bar, b.x, nloc, nx); b.st[0] = nloc; b.st[1] = nx; }
        const unsigned old = xb_add(&bar[XB_XSUB(b.x)], 1u);
        const unsigned gen = old / nloc;
        if (old + 1u == (gen + 1u) * nloc) {
            __builtin_amdgcn_fence(__ATOMIC_RELEASE, "agent");
            asm volatile("s_waitcnt vmcnt(0)" ::: "memory");
            const unsigned og = xb_add(&bar[XB_TOP], 1u);
            const unsigned tg = og / nx;
            if (og + 1u == (tg + 1u) * nx) xb_add(&bar[XB_TOPGEN], 1u);
            else XB_SPIN(xb_ld(&bar[XB_TOPGEN]) == tg, bar);
            __builtin_amdgcn_fence(__ATOMIC_ACQUIRE, "agent");
            xb_add(&bar[XB_XGEN(b.x)], 1u);
            asm volatile("s_waitcnt vmcnt(0)" ::: "memory");
        } else {
            XB_SPIN(xb_ld(&bar[XB_XGEN(b.x)]) == gen, bar);
            __builtin_amdgcn_fence(__ATOMIC_ACQUIRE, "agent");
            asm volatile("s_waitcnt vmcnt(0)" ::: "memory");
        }
    }
    __syncthreads();
}
namespace attn_body {
using bf16=__hip_bfloat16;
using bf16x8=__attribute__((ext_vector_type(8)))short;
using s16x4=__attribute__((ext_vector_type(4)))short;
using f32x16=__attribute__((ext_vector_type(16)))float;
using u32x4=__attribute__((ext_vector_type(4)))unsigned;
constexpr int BATCH=8,NHEAD=8,NKVH=2,SEQ=4096,D=64;
constexpr int DMQ=512,DMK=128,DMV=2048,DMO=1024;
constexpr int NW=8,QBLK=32,QB=QBLK*NW,KVBLK=64,NQB=SEQ/QB;
constexpr int ATTN_UNIT_ROWS=QB;
__device__ __forceinline__ int crow(int r,int hi){return (r&3)+8*(r>>2)+4*hi;}
#define SBAR() __builtin_amdgcn_sched_barrier(0)
__device__ __forceinline__ void cmask(f32x16&p0,f32x16&p1,int jb,int qrel,int hi){
  const float NEG=-INFINITY; int kb=64*jb+4*hi;
  #pragma unroll
  for(int r=0;r<16;++r){int kv=kb+(r&3)+8*(r>>2); if(kv>qrel)p0[r]=NEG; if(kv+32>qrel)p1[r]=NEG;}
}

constexpr int NSLOT=3, SLOTB=8192;
constexpr int LDS_K=0, LDS_V=NSLOT*SLOTB, LDS_WS=2*NSLOT*SLOTB, LDS_OST=LDS_WS+NW*64*4, LDS_BYTES=LDS_OST+NW*4096;
constexpr float C2=0.125f*1.4426950408889634f;
__device__ __forceinline__ void glds16(const void*gsrc,unsigned lds_dst){unsigned keep;
  asm volatile("s_mov_b32 %0, m0\n\ts_mov_b32 m0, %2\n\ts_nop 0\n\tglobal_load_lds_dwordx4 %1, off\n\ts_mov_b32 m0, %0":"=&s"(keep):"v"(gsrc),"s"(lds_dst):"memory");}
__device__ __forceinline__ float max3f(float a,float b,float c){float r;asm("v_max3_f32 %0, %1, %2, %3":"=v"(r):"v"(a),"v"(b),"v"(c));return r;}
__device__ __forceinline__ float max2f(float a,float b){float r;asm("v_max_f32_e32 %0, %1, %2":"=v"(r):"v"(a),"v"(b));return r;}
__device__ __forceinline__ float fadd_s(float a,float b){float r;asm("v_add_f32_e32 %0, %1, %2":"=v"(r):"v"(a),"v"(b));return r;}
__device__ __forceinline__ float fsub_s(float a,float b){float r;asm("v_sub_f32_e32 %0, %1, %2":"=v"(r):"v"(a),"v"(b));return r;}
typedef float f32x2_t __attribute__((ext_vector_type(2))); typedef __bf16 bf16x2_t __attribute__((ext_vector_type(2)));
__device__ __forceinline__ unsigned cvtpk_s(float lo,float hi){f32x2_t v={lo,hi};bf16x2_t b=__builtin_convertvector(v,bf16x2_t);return __builtin_bit_cast(unsigned,b);}
#define WAIT_BAR(N) asm volatile("s_waitcnt vmcnt(" #N ") lgkmcnt(0)\n\ts_barrier":::"memory")

__device__ __forceinline__ void qkt(f32x16&p0,f32x16&p1,const char*Kslot,const bf16x8*qr,const f32x16&negm,int r32,int hi){
  const char*kb=Kslot+hi*1024+r32*16;
  #pragma unroll
  for(int d0=0;d0<4;++d0){
    const bf16x8 b0=*reinterpret_cast<const bf16x8*>(kb+d0*2048);
    const bf16x8 b1=*reinterpret_cast<const bf16x8*>(kb+d0*2048+512);
    if(d0==0){p0=__builtin_amdgcn_mfma_f32_32x32x16_bf16(b0,qr[0],negm,0,0,0);p1=__builtin_amdgcn_mfma_f32_32x32x16_bf16(b1,qr[0],negm,0,0,0);}
    else{p0=__builtin_amdgcn_mfma_f32_32x32x16_bf16(b0,qr[d0],p0,0,0,0);p1=__builtin_amdgcn_mfma_f32_32x32x16_bf16(b1,qr[d0],p1,0,0,0);}}
}
typedef __attribute__((address_space(3))) const char* lds_cptr;
typedef short v4i16_t __attribute__((ext_vector_type(4)));
__device__ __forceinline__ void kload8(bf16x8*kf,lds_cptr kp){
  kf[0]=*(const __attribute__((address_space(3))) bf16x8*)(kp);      kf[1]=*(const __attribute__((address_space(3))) bf16x8*)(kp+512);
  kf[2]=*(const __attribute__((address_space(3))) bf16x8*)(kp+2048); kf[3]=*(const __attribute__((address_space(3))) bf16x8*)(kp+2560);
  kf[4]=*(const __attribute__((address_space(3))) bf16x8*)(kp+4096); kf[5]=*(const __attribute__((address_space(3))) bf16x8*)(kp+4608);
  kf[6]=*(const __attribute__((address_space(3))) bf16x8*)(kp+6144); kf[7]=*(const __attribute__((address_space(3))) bf16x8*)(kp+6656);
}
__device__ __forceinline__ void kload2(bf16x8*kf,lds_cptr kp,int j){ kf[2*j]=*(const __attribute__((address_space(3))) bf16x8*)(kp+j*2048); kf[2*j+1]=*(const __attribute__((address_space(3))) bf16x8*)(kp+j*2048+512); }
__device__ __forceinline__ s16x4 vtr(lds_cptr p){ return __builtin_bit_cast(s16x4,__builtin_amdgcn_ds_read_tr16_b64_v4i16((__attribute__((address_space(3))) v4i16_t*)p)); }
__device__ __forceinline__ float rowmax(const f32x16&p0,const f32x16&p1){
  float a=max3f(p0[0],p0[1],p1[0]),b=max3f(p0[2],p0[3],p1[1]);a=max3f(a,p1[2],p1[3]);
  #pragma unroll
  for(int r=4;r<16;r+=4){a=max3f(a,p0[r],p0[r+1]);b=max3f(b,p0[r+2],p0[r+3]);a=max3f(a,p1[r],p1[r+1]);b=max3f(b,p1[r+2],p1[r+3]);}
  const float m=max2f(a,b);
  auto rr=__builtin_amdgcn_permlane32_swap(__float_as_uint(m),__float_as_uint(m),false,false);
  return max2f(__uint_as_float(rr[0]),__uint_as_float(rr[1]));
}
__device__ __forceinline__ void pv(f32x16*o,int vb,bf16x8 pa0,bf16x8 pa1,bf16x8 pa2,bf16x8 pa3){
  #pragma unroll
  for(int d0=0;d0<2;++d0){s16x4 lo[4],hi[4];
    #pragma unroll
    for(int ks=0;ks<4;++ks){
      asm volatile("ds_read_b64_tr_b16 %0,%1 offset:%c2":"=&v"(lo[ks]):"v"(vb),"i"(d0*4096+ks*1024):"memory");
      asm volatile("ds_read_b64_tr_b16 %0,%1 offset:%c2":"=&v"(hi[ks]):"v"(vb),"i"(d0*4096+ks*1024+512):"memory");}
    asm volatile("s_waitcnt lgkmcnt(0)":::"memory");SBAR();
    #define PK(k) (bf16x8){lo[k][0],lo[k][1],lo[k][2],lo[k][3],hi[k][0],hi[k][1],hi[k][2],hi[k][3]}
    o[d0]=__builtin_amdgcn_mfma_f32_32x32x16_bf16(pa0,PK(0),o[d0],0,0,0);
    o[d0]=__builtin_amdgcn_mfma_f32_32x32x16_bf16(pa1,PK(1),o[d0],0,0,0);
    o[d0]=__builtin_amdgcn_mfma_f32_32x32x16_bf16(pa2,PK(2),o[d0],0,0,0);
    o[d0]=__builtin_amdgcn_mfma_f32_32x32x16_bf16(pa3,PK(3),o[d0],0,0,0);
    #undef PK
  }
}

#ifndef ATTN_STORE16
#define ATTN_STORE16(p,v) (*(u32x4*)(p)=(v))
#endif
template<int THRL> __device__ __forceinline__ void attn_unit(int b,int h,int qb,const bf16*Q,const bf16*__restrict__ K,const bf16*__restrict__ V,bf16*O,char*shm){
  int tid_=threadIdx.x; asm volatile("":"+v"(tid_)); const int tid=tid_,lane=tid&63,r32=lane&31,hi=lane>>5; const int wid=__builtin_amdgcn_readfirstlane(tid>>6);
  const long rowbase=(long)b*SEQ; const int q0=qb*QB;
  const bf16*Qw=Q+(rowbase+q0+wid*QBLK)*DMQ+h*D; const int kvh=h>>2;
  const bf16*Kh=K+rowbase*DMK+kvh*D,*Vh=V+rowbase*DMV+kvh*D;
  const unsigned lds0=(unsigned)(uintptr_t)shm;
  float*wsf=(float*)(shm+LDS_WS)+wid*64;
  const bf16*ksrc=Kh+(long)lane*DMK+wid*8;
  const bf16*vsrc=Vh+(long)(16*(wid&3)+(lane>>2))*DMV+(wid>>2)*32+(lane&3)*8;
  const unsigned kdst=lds0+LDS_K+wid*1024, vdst=lds0+LDS_V+wid*1024;
  #define DMA_K(t,slot) glds16(ksrc+(long)(t)*KVBLK*DMK,(unsigned)__builtin_amdgcn_readfirstlane(kdst+(slot)))
  #define DMA_V(t,slot) glds16(vsrc+(long)(t)*KVBLK*DMV,(unsigned)__builtin_amdgcn_readfirstlane(vdst+(slot)))
  const int vb0=(int)(lds0+LDS_V)+((lane>>4)&1)*32+(lane&3)*8+(4*hi+((lane&15)>>2))*64;
  const char*Kbase=shm+LDS_K; bf16x8 kf[8];
  const lds_cptr shm3=(lds_cptr)shm; const lds_cptr kp0=shm3+LDS_K+hi*1024+r32*16; const lds_cptr vp0=shm3+LDS_V+((lane>>4)&1)*32+(lane&3)*8+(4*hi+((lane&15)>>2))*64;
  constexpr int NT=SEQ/KVBLK;
  DMA_K(0,0);DMA_V(0,0);DMA_K(1,SLOTB);
  bf16x8 qr[4];
  #pragma unroll
  for(int d0=0;d0<4;++d0)qr[d0]=*reinterpret_cast<const bf16x8*>(&Qw[(long)r32*DMQ+d0*16+hi*8]);
  float mhat=0.f,l_reg=0.f;f32x16 o[2];o[0]=f32x16{};o[1]=f32x16{};f32x16 negm=f32x16{};asm volatile("":"+v"(negm));
  #define CMASK(P0,P1,t) do{}while(0)
  bool resc=false;
  #define START(P0,P1) do{ const float rm=rowmax(P0,P1); resc=false; \
    { const float dl=rm; mhat=fadd_s(mhat,dl); \
      _Pragma("unroll") for(int r=0;r<16;++r){P0[r]=fsub_s(P0[r],dl);P1[r]=fsub_s(P1[r],dl);} \
      _Pragma("unroll") for(int r=0;r<16;++r)negm[r]=-mhat; asm volatile("":"+v"(negm)); } \
    _Pragma("unroll") for(int r=0;r<16;++r)P0[r]=__builtin_amdgcn_exp2f(P0[r]); }while(0)
  #define RESC() do{ if(resc){ asm volatile("s_waitcnt lgkmcnt(0)":::"memory"); \
      _Pragma("unroll") for(int d_=0;d_<2;++d_) _Pragma("unroll") for(int r=0;r<16;++r)o[d_][r]*=wsf[crow(r,hi)]; } }while(0)
  f32x16 pA0,pA1,pB0,pB1;
  int sl_prev=0,sl_cur=0,sl_next=SLOTB;
  #define ROT() do{sl_prev=sl_cur;sl_cur=sl_next;sl_next=(sl_next==(NSLOT-1)*SLOTB)?0:sl_next+SLOTB;}while(0)
  DMA_K(2,2*SLOTB);
  WAIT_BAR(3);
  qkt(pA0,pA1,Kbase,qr,negm,r32,hi);asm volatile("s_nop 15\n\ts_nop 7":"+v"(pA0),"+v"(pA1));CMASK(pA0,pA1,0);
  START(pA0,pA1);
  _Pragma("unroll") for(int r=0;r<16;++r)pA1[r]=__builtin_amdgcn_exp2f(pA1[r]);
  WAIT_BAR(0);
  DMA_K(3,0);DMA_V(1,SLOTB);
  ROT();
  kload8(kf,kp0+sl_cur);
  WAIT_BAR(2);
  s16x4 vlo[8],vhi[8]; u32x4 pw0,pw1,pw2,pw3;
  #define PKW(P,B) cvtpk_s(P[B],P[B+1])
  #define PAF(k) __builtin_bit_cast(bf16x8,pw##k)
  #define VFR(i) (bf16x8){vlo[i][0],vlo[i][1],vlo[i][2],vlo[i][3],vhi[i][0],vhi[i][1],vhi[i][2],vhi[i][3]}
  #define PIN(x) asm volatile("":"+v"(x))
  #define MX3(a,b,c) __builtin_fmaxf(__builtin_fmaxf((a),(b)),(c))
  #define GAPA(MF,A0,A1,A2,A3,W0,W1,PW) do{ MF; sacc+=A0; sacc+=A1; sacc+=A2; sacc+=A3; PIN(sacc); W0; W1; PIN(PW); SBAR(); }while(0)
  #define EX(v) __builtin_amdgcn_exp2f(v)
  #define GAPB(MF,X,B) do{ MF; X[B]=EX(X[B]); X[B+1]=EX(X[B+1]); X[B+2]=EX(X[B+2]); X[B+3]=EX(X[B+3]); PIN(X); SBAR(); }while(0)
  #define VRD(i) do{ vlo[i]=vtr(vp_+(((i)>>2)*4096+((i)&3)*1024)); vhi[i]=vtr(vp_+(((i)>>2)*4096+((i)&3)*1024+512)); }while(0)
  #define KRD(G,j) do{ if(G){ kload2(kf,kp0+sl_next,j); SBAR(); } }while(0)
  #define STEP(C0,C1,P0,P1,t,GK,GV,GL) do{ SBAR(); \
    const lds_cptr vp_=vp0+sl_prev; \
    VRD(0); SBAR(); float sacc=(P0[0]+P0[1]); \
    GAPA(C0=__builtin_amdgcn_mfma_f32_32x32x16_bf16(kf[0],qr[0],negm,0,0,0), P0[2],P0[3],P0[4],P0[5],     pw0[0]=PKW(P0,0), pw0[1]=PKW(P0,2), pw0); \
    VRD(4); SBAR(); GAPA(C1=__builtin_amdgcn_mfma_f32_32x32x16_bf16(kf[1],qr[0],negm,0,0,0), P0[6],P0[7],P0[8],P0[9],     pw0[2]=PKW(P0,4), pw0[3]=PKW(P0,6), pw0); \
    VRD(1); SBAR(); GAPA(C0=__builtin_amdgcn_mfma_f32_32x32x16_bf16(kf[2],qr[1],C0,0,0,0),   P0[10],P0[11],P0[12],P0[13], pw1[0]=PKW(P0,8), pw1[1]=PKW(P0,10), pw1); \
    VRD(5); SBAR(); GAPA(C1=__builtin_amdgcn_mfma_f32_32x32x16_bf16(kf[3],qr[1],C1,0,0,0),   P0[14],P0[15],P1[0],P1[1],   pw1[2]=PKW(P0,12),pw1[3]=PKW(P0,14), pw1); \
    VRD(2); SBAR(); GAPA(C0=__builtin_amdgcn_mfma_f32_32x32x16_bf16(kf[4],qr[2],C0,0,0,0),   P1[2],P1[3],P1[4],P1[5],     pw2[0]=PKW(P1,0), pw2[1]=PKW(P1,2), pw2); \
    VRD(6); SBAR(); GAPA(C1=__builtin_amdgcn_mfma_f32_32x32x16_bf16(kf[5],qr[2],C1,0,0,0),   P1[6],P1[7],P1[8],P1[9],     pw2[2]=PKW(P1,4), pw2[3]=PKW(P1,6), pw2); \
    VRD(3); SBAR(); GAPA(C0=__builtin_amdgcn_mfma_f32_32x32x16_bf16(kf[6],qr[3],C0,0,0,0),   P1[10],P1[11],P1[12],P1[13], pw3[0]=PKW(P1,8), pw3[1]=PKW(P1,10), pw3); \
    VRD(7); SBAR(); GAPA(C1=__builtin_amdgcn_mfma_f32_32x32x16_bf16(kf[7],qr[3],C1,0,0,0),   P1[14],P1[15],0.f,0.f,       pw3[2]=PKW(P1,12),pw3[3]=PKW(P1,14), pw3); \
    l_reg+=sacc; \
    if(GK){DMA_K((t)+3,sl_cur);} if(GV){DMA_V((t)+1,sl_next);} \
    CMASK(C0,C1,t); \
    { float a=MX3(C0[0],C0[1],C1[0]),b=MX3(C0[2],C0[3],C1[1]); a=MX3(a,C1[2],C1[3]); \
      _Pragma("unroll") for(int r=4;r<16;r+=4){a=MX3(a,C0[r],C0[r+1]);b=MX3(b,C0[r+2],C0[r+3]);a=MX3(a,C1[r],C1[r+1]);b=MX3(b,C1[r+2],C1[r+3]);} \
      float rm=__builtin_fmaxf(a,b); { auto rr=__builtin_amdgcn_permlane32_swap(__float_as_uint(rm),__float_as_uint(rm),false,false); rm=__builtin_fmaxf(__uint_as_float(rr[0]),__uint_as_float(rr[1])); } \
      resc=false; \
      if(__builtin_expect(__any(rm>(float)THRL),0)){ const float dl=__builtin_fmaxf(rm,0.f); mhat+=dl; \
        _Pragma("unroll") for(int r=0;r<16;++r){C0[r]-=dl;C1[r]-=dl;} \
        _Pragma("unroll") for(int r=0;r<16;++r)negm[r]=-mhat; asm volatile("":"+v"(negm)); \
        const float f=__builtin_amdgcn_exp2f(-dl); l_reg*=f; if(hi==0)wsf[r32]=f; resc=true; } } \
    SBAR(); \
    GAPB(o[0]=__builtin_amdgcn_mfma_f32_32x32x16_bf16(PAF(0),VFR(0),o[0],0,0,0), C0,0); \
    GAPB(o[1]=__builtin_amdgcn_mfma_f32_32x32x16_bf16(PAF(0),VFR(4),o[1],0,0,0), C0,4); \
    KRD(GL,0); GAPB(o[0]=__builtin_amdgcn_mfma_f32_32x32x16_bf16(PAF(1),VFR(1),o[0],0,0,0), C0,8); \
    KRD(GL,1); GAPB(o[1]=__builtin_amdgcn_mfma_f32_32x32x16_bf16(PAF(1),VFR(5),o[1],0,0,0), C0,12); \
    KRD(GL,2); GAPB(o[0]=__builtin_amdgcn_mfma_f32_32x32x16_bf16(PAF(2),VFR(2),o[0],0,0,0), C1,0); \
    KRD(GL,3); GAPB(o[1]=__builtin_amdgcn_mfma_f32_32x32x16_bf16(PAF(2),VFR(6),o[1],0,0,0), C1,4); \
    GAPB(o[0]=__builtin_amdgcn_mfma_f32_32x32x16_bf16(PAF(3),VFR(3),o[0],0,0,0), C1,8); \
    GAPB(o[1]=__builtin_amdgcn_mfma_f32_32x32x16_bf16(PAF(3),VFR(7),o[1],0,0,0), C1,12); \
    }while(0)
  int t=1;
  #undef CMASK
  #define CMASK(P0,P1,t) do{}while(0)
  for(;t+5<NT;t+=2){
    STEP(pB0,pB1,pA0,pA1,t,true,true,true);     WAIT_BAR(2); RESC(); ROT();
    STEP(pA0,pA1,pB0,pB1,t+1,true,true,true);   WAIT_BAR(2); RESC(); ROT();
  }
  #undef CMASK
  #define CMASK(P0,P1,t) do{}while(0)
  #define ENDW(tt) do{ if((tt)+3<NT){WAIT_BAR(2);} else if((tt)+2<NT){WAIT_BAR(1);} else {WAIT_BAR(0);} }while(0)
  for(;t+1<NT;t+=2){
    STEP(pB0,pB1,pA0,pA1,t,(t+3<NT),(t+1<NT),(t+1<NT));       ENDW(t);   RESC(); ROT();
    STEP(pA0,pA1,pB0,pB1,t+1,(t+4<NT),(t+2<NT),(t+2<NT));     ENDW(t+1); RESC(); ROT();
  }
  STEP(pB0,pB1,pA0,pA1,NT-1,false,false,false); RESC();
  { float sacc=pB0[0]+pB0[1]; _Pragma("unroll") for(int r=2;r<16;++r)sacc+=pB0[r]; _Pragma("unroll") for(int r=0;r<16;++r)sacc+=pB1[r]; l_reg+=sacc;
    pw0=(u32x4){PKW(pB0,0),PKW(pB0,2),PKW(pB0,4),PKW(pB0,6)};pw1=(u32x4){PKW(pB0,8),PKW(pB0,10),PKW(pB0,12),PKW(pB0,14)};pw2=(u32x4){PKW(pB1,0),PKW(pB1,2),PKW(pB1,4),PKW(pB1,6)};pw3=(u32x4){PKW(pB1,8),PKW(pB1,10),PKW(pB1,12),PKW(pB1,14)};
    SBAR(); pv(o,vb0+sl_cur,PAF(0),PAF(1),PAF(2),PAF(3)); }
  #undef PKW
  #undef PAF
  #undef VFR
  #undef PIN
  #undef MX3
  #undef GAPA
  #undef GAPB
  #undef EX
  #undef VRD
  #undef KRD
  #undef STEP
  #undef ENDW
  {auto rr=__builtin_amdgcn_permlane32_swap(__float_as_uint(l_reg),__float_as_uint(l_reg),false,false);l_reg=__uint_as_float(rr[0])+__uint_as_float(rr[1]);}
  if(hi==0)wsf[32+r32]=l_reg;asm volatile("s_waitcnt lgkmcnt(0)":::"memory");
  float rli[16];
  #pragma unroll
  for(int r=0;r<16;++r)rli[r]=__builtin_amdgcn_rcpf(wsf[32+crow(r,hi)]);
  bf16*Ow=O+(rowbase+q0+wid*QBLK)*DMO+h*D;
  { bf16*stg=(bf16*)(shm+LDS_OST)+wid*2048;
    #pragma unroll
    for(int r=0;r<16;++r){const int orow=crow(r,hi);
      #pragma unroll
      for(int d0=0;d0<2;++d0)stg[orow*64+d0*32+r32]=__float2bfloat16(o[d0][r]*rli[r]);}
    asm volatile("s_waitcnt lgkmcnt(0)":::"memory");
    #pragma unroll
    for(int i=0;i<4;++i){const int row=i*8+(lane>>3),ch=lane&7; const u32x4 v=*(const u32x4*)(stg+row*64+ch*8); ATTN_STORE16(Ow+(long)row*DMO+ch*8,v);} }
  asm volatile("s_waitcnt lgkmcnt(0)\n\ts_barrier":::"memory");
  #undef DMA_K
  #undef DMA_V
  #undef CMASK
  #undef START
  #undef RESC
  #undef ROT
}
constexpr int ATTN_LDS_BYTES=LDS_BYTES;
struct AttnTensors { const bf16* Q; const bf16* K; const bf16* V; bf16* O; };
struct AttnUnit { int bh; int qb; };
struct StaticOrder {
  int vcu, G;
  __device__ __forceinline__ explicit StaticOrder(int grid,int block):vcu((grid%8==0)?(block%8)*(grid/8)+block/8:block),G(grid){}
  __device__ __forceinline__ bool next(int i,AttnUnit&u)const{ const int per=(BATCH*NHEAD*NQB+G-1)/G; if(i>=per)return false; const int idx=vcu*per+i; if(idx>=BATCH*NHEAD*NQB)return false;
    const int qb=idx%NQB, hq=(idx/NQB)&3, bk=idx/(NQB*4), kvh=bk&1, b=bk>>1; u.bh=b*NHEAD+kvh*4+hq; u.qb=qb; return true; }
  __device__ __forceinline__ void a_ready(const AttnUnit&)const{}
  __device__ __forceinline__ void done(const AttnUnit&)const{}
};
template<class Sched,int THRL=8> __device__ __forceinline__ void attn_phase(char*lds,const AttnTensors&T,const Sched&S){
  AttnUnit u;
  for(int i=0;S.next(i,u);++i){ S.a_ready(u); attn_unit<THRL>(u.bh/NHEAD,u.bh%NHEAD,u.qb,T.Q,T.K,T.V,T.O,lds); S.done(u); }
}
#undef SBAR
#undef WAIT_BAR
}
constexpr int NB = 8, SEQ = 4096, DM = 1024, NL = 4, NTOK = NB * SEQ;
constexpr int INW = 1824, INP = 2048;
constexpr int C_AQ = 0, C_AK = 512, C_AV = 640, C_GQ = 768, C_GK = 896, C_GV = 1024, C_GR = 1280, C_FX = 1536, C_GLR = 1792;
constexpr int NE = 32, TOPK = 4, DE = 1024;
constexpr int MPAD = NTOK * TOPK + NE * 256;
constexpr float LN_EPS = 1e-5f, RMS_EPS = 1e-6f;
constexpr float DN_ALPHA = 1.681792830507429f;
constexpr float QSCALE = 0.125f * 1.4426950408889634f;
constexpr float GLA_QSCALE = 0.17677669529663687f;

constexpr size_t MiB = 1u << 20;
constexpr size_t WS_CTL = 0, CTL_ZERO_BYTES = 1 * MiB;
constexpr size_t WS_ROPE = 1 * MiB;
constexpr size_t WS_WIN_T = 2 * MiB;
constexpr size_t WS_WOUT_T = 18 * MiB;
constexpr size_t WS_FTAB = 26 * MiB;
constexpr size_t WS_TW = WS_FTAB + 65536;
constexpr size_t WS_RWT = WS_FTAB + 131072;
constexpr size_t WS_FTMP = 27 * MiB;
constexpr size_t WS_WGU_T = 90 * MiB;
constexpr size_t WS_WDN_T = 602 * MiB;
constexpr size_t WS_HF = 858 * MiB;
constexpr size_t WS_HB = 986 * MiB;
constexpr size_t WS_PROJ = 1050 * MiB;
constexpr size_t WS_QB = 1178 * MiB;
constexpr size_t WS_KB = 1210 * MiB;
constexpr size_t WS_MIX = 1218 * MiB;
constexpr size_t WS_T1 = 1282 * MiB;
constexpr size_t WS_UVT = 1410 * MiB;
constexpr size_t WS_LA = 1442 * MiB;
constexpr size_t WS_OF = 1474 * MiB;
constexpr size_t WS_OB = 1506 * MiB;
constexpr size_t WS_TOK = 1538 * MiB;
constexpr size_t WS_XS = 1542 * MiB;
constexpr size_t WS_HID = 1814 * MiB;
constexpr size_t WS_YS = 2086 * MiB;
constexpr size_t WS_END = 2358 * MiB;
static_assert((size_t)MPAD * 2048 == 272 * MiB, "sorted buffers");
constexpr int CW_TMO = 0, CW_CODE = 1, CW_BAR = 4096, CW_CNT = 8192;

constexpr int RING_OFF = 0, RING_BYTES = 131072;
constexpr int LDSCTL_OFF = RING_BYTES;
constexpr int LDS_BYTES = 163840;
constexpr int LC_MISC = 0;
constexpr int LC_PSTART = 128;
constexpr int LC_ULIST = 384;
constexpr int LC_CNT = 640;
constexpr int LC_BASE = 768;
constexpr int LC_SELE = 1024;
constexpr int LC_SELS = 1024 + 2048;
constexpr int LC_COS64 = 5120;
constexpr int LC_ROWS = 6144;
constexpr int LC_LG = 16384;

constexpr int NWAVES = 8;
constexpr int N_PHASES = 1 + 10 * NL;

typedef float f32x2_t __attribute__((ext_vector_type(2))); typedef __bf16 bf16x2_t __attribute__((ext_vector_type(2)));
__device__ __forceinline__ unsigned cvtpk2(float lo, float hi) { f32x2_t v = {lo, hi}; bf16x2_t b = __builtin_convertvector(v, bf16x2_t); return __builtin_bit_cast(unsigned, b); }
#define pk2(lo, hi) cvtpk2((lo), (hi))
#define f2bf(x) (cvtpk2((x), 0.f) & 0xffffu)
__device__ __forceinline__ float bf2f(unsigned short b) { return __uint_as_float((unsigned)b << 16); }
__device__ __forceinline__ float wave_sum(float v) {
#pragma unroll
    for (int o = 1; o < 64; o <<= 1) v += __shfl_xor(v, o);
    return v;
}
typedef unsigned short u16x8 __attribute__((ext_vector_type(8)));
typedef unsigned short u16x4 __attribute__((ext_vector_type(4)));

typedef float f32x2v __attribute__((ext_vector_type(2)));
__device__ __forceinline__ void tr_task(const float* W, int K, int Nsrc, int srcn, bf16* WT, int dst_n, int k0) {
#pragma unroll 1
    for (int hf = 0; hf < 2; ++hf) { const int kk = k0 + hf * 64; f32x2v v[64];
        if (srcn >= 0) { const float* p = W + (size_t)kk * Nsrc + srcn;
#pragma unroll
            for (int i = 0; i < 64; ++i) v[i] = __builtin_nontemporal_load((const f32x2v*)(p + (size_t)i * Nsrc)); }
        else {
#pragma unroll
            for (int i = 0; i < 64; ++i) v[i] = (f32x2v){0.f, 0.f}; }
        bf16* o0 = WT + (size_t)dst_n * K + kk; bf16* o1 = o0 + K;
#pragma unroll
        for (int j = 0; j < 8; ++j) { v4u w0, w1;
            w0.x = pk2(v[8 * j].x, v[8 * j + 1].x); w0.y = pk2(v[8 * j + 2].x, v[8 * j + 3].x); w0.z = pk2(v[8 * j + 4].x, v[8 * j + 5].x); w0.w = pk2(v[8 * j + 6].x, v[8 * j + 7].x);
            w1.x = pk2(v[8 * j].y, v[8 * j + 1].y); w1.y = pk2(v[8 * j + 2].y, v[8 * j + 3].y); w1.z = pk2(v[8 * j + 4].y, v[8 * j + 5].y); w1.w = pk2(v[8 * j + 6].y, v[8 * j + 7].y);
            *(v4u*)(o0 + 8 * j) = w0; *(v4u*)(o1 + 8 * j) = w1; } }
}

#define RC(l, j) (((j) >> 1) * 512 + 8 * (l) + ((j) & 1) * 4)
__device__ __forceinline__ void row_load_bf16(f32x4 (&v)[4], const bf16* row, int lane) {
#pragma unroll
    for (int h = 0; h < 2; ++h) { const v4u t = *(const v4u*)(row + h * 512 + 8 * lane);
        v[2 * h] = (f32x4){__uint_as_float(t.x << 16), __uint_as_float(t.x & 0xffff0000u), __uint_as_float(t.y << 16), __uint_as_float(t.y & 0xffff0000u)};
        v[2 * h + 1] = (f32x4){__uint_as_float(t.z << 16), __uint_as_float(t.z & 0xffff0000u), __uint_as_float(t.w << 16), __uint_as_float(t.w & 0xffff0000u)}; }
}
__device__ __forceinline__ void row_store_bf16(const f32x4 (&v)[4], bf16* row, int lane) {
#pragma unroll
    for (int h = 0; h < 2; ++h) { v4u w; w.x = pk2(v[2 * h].x, v[2 * h].y); w.y = pk2(v[2 * h].z, v[2 * h].w); w.z = pk2(v[2 * h + 1].x, v[2 * h + 1].y); w.w = pk2(v[2 * h + 1].z, v[2 * h + 1].w); *(v4u*)(row + h * 512 + 8 * lane) = w; }
}
__device__ __forceinline__ void ln_row8(f32x4 (&v)[4], const f32x4 (&gam)[4], const f32x4 (&bet)[4]) {
    float s = 0.f;
#pragma unroll
    for (int j = 0; j < 4; ++j) s += (v[j].x + v[j].y) + (v[j].z + v[j].w);
    const float mean = wave_sum(s) * (1.f / DM); float s2 = 0.f;
#pragma unroll
    for (int j = 0; j < 4; ++j) { v[j] = v[j] - mean; s2 += (v[j].x * v[j].x + v[j].y * v[j].y) + (v[j].z * v[j].z + v[j].w * v[j].w); }
    const float rstd = __builtin_amdgcn_rsqf(wave_sum(s2) * (1.f / DM) + LN_EPS);
#pragma unroll
    for (int j = 0; j < 4; ++j) v[j] = v[j] * rstd * gam[j] + bet[j];
}

constexpr int GM_QF = 0, GM_KF = 5120, GM_QB = 10240, GM_KB = 15360, GM_VT = 20480, GM_P = 29696, GM_HTF = 38912, GM_HTB = 44032, GM_DL = 38912, GM_SLOT = 49152;
static_assert(2 * GM_SLOT <= RING_BYTES, "two GLA chunk images fit the phase scratch");
#define MFMA16(a, b, c) __builtin_amdgcn_mfma_f32_16x16x32_bf16((a), (b), (c), 0, 0, 0)
template <bool OUT>
__device__ __forceinline__ void gla_stage_mfma(LAS unsigned char* Ls, const bf16* PROJ, const float* LA, const float* HIN, size_t tok0, int hd, int w4, int lane) {
    if (w4 < 2) { const int dir = w4, g = lane >> 3, c4 = (lane & 7) * 4; f32x4 bc[8]; u16x4 kx[8], qx[8];
        const float* lap = LA + (tok0 + 8 * g) * 256 + dir * 128 + hd * 32 + c4; const bf16* xp = PROJ + (tok0 + 8 * g) * INP + hd * 32 + c4;
#pragma unroll
        for (int i = 0; i < 8; ++i) { bc[i] = *(const f32x4*)(lap + (size_t)i * 256); kx[i] = *(const u16x4*)(xp + (size_t)i * INP + C_GK); if (OUT) qx[i] = *(const u16x4*)(xp + (size_t)i * INP + C_GQ); }
        f32x4 inc;
        if (dir == 0) {
#pragma unroll
            for (int i = 1; i < 8; ++i) bc[i] = bc[i] + bc[i - 1];
            inc = bc[7];
#pragma unroll
            for (int o = 1; o < 8; o <<= 1) { f32x4 y; y.x = __shfl_up(inc.x, 8 * o); y.y = __shfl_up(inc.y, 8 * o); y.z = __shfl_up(inc.z, 8 * o); y.w = __shfl_up(inc.w, 8 * o); if (g >= o) inc = inc + y; }
            const f32x4 off = inc - bc[7];
#pragma unroll
            for (int i = 0; i < 8; ++i) bc[i] = bc[i] + off; }
        else {
#pragma unroll
            for (int i = 6; i >= 0; --i) bc[i] = bc[i] + bc[i + 1];
            inc = bc[0];
#pragma unroll
            for (int o = 1; o < 8; o <<= 1) { f32x4 y; y.x = __shfl_down(inc.x, 8 * o); y.y = __shfl_down(inc.y, 8 * o); y.z = __shfl_down(inc.z, 8 * o); y.w = __shfl_down(inc.w, 8 * o); if (g + o < 8) inc = inc + y; }
            const f32x4 off = inc - bc[0];
#pragma unroll
            for (int i = 0; i < 8; ++i) bc[i] = bc[i] + off; }
        if (OUT) { LAS bf16* qd = (LAS bf16*)(Ls + (dir ? GM_QB : GM_QF)) + (8 * g) * 40 + c4; LAS bf16* kd = (LAS bf16*)(Ls + (dir ? GM_KB : GM_KF)) + (8 * g) * 40 + c4;
#pragma unroll
            for (int i = 0; i < 8; ++i) { float qv[4], kv[4];
#pragma unroll
                for (int c = 0; c < 4; ++c) { const float e_ = __expf(bc[i][c]); qv[c] = bf2f(qx[i][c]) * GLA_QSCALE * e_; kv[c] = bf2f(kx[i][c]) * __builtin_amdgcn_rcpf(e_); }
                *(LAS unsigned long long*)(qd + i * 40) = (unsigned long long)pk2(qv[0], qv[1]) | ((unsigned long long)pk2(qv[2], qv[3]) << 32);
                *(LAS unsigned long long*)(kd + i * 40) = (unsigned long long)pk2(kv[0], kv[1]) | ((unsigned long long)pk2(kv[2], kv[3]) << 32); } }
        else { LAS bf16* kt = (LAS bf16*)(Ls + GM_P + dir * 4608) + c4 * 72 + 8 * g;
#pragma unroll
            for (int c = 0; c < 4; ++c) { float t[8];
#pragma unroll
                for (int i = 0; i < 8; ++i) t[i] = bf2f(kx[i][c]) * __expf(-bc[i][c]);
                v4u w; w.x = pk2(t[0], t[1]); w.y = pk2(t[2], t[3]); w.z = pk2(t[4], t[5]); w.w = pk2(t[6], t[7]); *(LAS v4u*)(kt + c * 72) = w; }
            if (g == (dir ? 0 : 7)) { const f32x4 tot = dir ? bc[0] : bc[7]; LAS float* dl = (LAS float*)(Ls + GM_DL) + dir * 32 + c4; dl[0] = __expf(tot.x); dl[1] = __expf(tot.y); dl[2] = __expf(tot.z); dl[3] = __expf(tot.w); } } }
    else if (w4 == 2) { const int g = lane >> 3, v0 = (lane & 7) * 8; u16x8 x[8]; const bf16* xp = PROJ + (tok0 + 8 * g) * INP + C_GV + hd * 64 + v0;
#pragma unroll
        for (int i = 0; i < 8; ++i) x[i] = *(const u16x8*)(xp + (size_t)i * INP);
        LAS bf16* dst = (LAS bf16*)(Ls + GM_VT) + v0 * 72 + 8 * g;
#pragma unroll
        for (int c = 0; c < 8; ++c) { v4u w; w.x = (unsigned)x[0][c] | ((unsigned)x[1][c] << 16); w.y = (unsigned)x[2][c] | ((unsigned)x[3][c] << 16); w.z = (unsigned)x[4][c] | ((unsigned)x[5][c] << 16); w.w = (unsigned)x[6][c] | ((unsigned)x[7][c] << 16);
            *(LAS v4u*)(dst + c * 72) = w; } }
    else if (OUT) {
#pragma unroll
        for (int dir = 0; dir < 2; ++dir) { const f32x4* src = (const f32x4*)(HIN + ((size_t)dir * 64 + lane) * 32); LAS bf16* dst = (LAS bf16*)(Ls + (dir ? GM_HTB : GM_HTF)) + lane * 40;
#pragma unroll
            for (int c8 = 0; c8 < 4; ++c8) { const f32x4 a_ = src[2 * c8], b_ = src[2 * c8 + 1]; v4u w; w.x = pk2(a_.x, a_.y); w.y = pk2(a_.z, a_.w); w.z = pk2(b_.x, b_.y); w.w = pk2(b_.z, b_.w); *(LAS v4u*)(dst + c8 * 8) = w; } } }
}

typedef float f32x16 __attribute__((ext_vector_type(16)));
typedef short s16x4 __attribute__((ext_vector_type(4)));
__device__ __forceinline__ bf16x8 pack_step(const f32x16& x, int s) { v4u p; p.x = cvtpk2(x[8 * s], x[8 * s + 1]); p.y = cvtpk2(x[8 * s + 2], x[8 * s + 3]); p.z = cvtpk2(x[8 * s + 4], x[8 * s + 5]); p.w = cvtpk2(x[8 * s + 6], x[8 * s + 7]); return __builtin_bit_cast(bf16x8, p); }
__device__ __forceinline__ int crow16(int i, int h) { return (i & 3) + 8 * (i >> 2) + 4 * h; }
#define MFMA32(a, b, c) __builtin_amdgcn_mfma_f32_32x32x16_bf16((a), (b), (c), 0, 0, 0)
constexpr int FT_PITCH = 72, FT_TAB = 64 * FT_PITCH;
constexpr int FFT_LDS_TAB = 0, FFT_LDS_TW = 28672, FFT_LDS_HT = 28672, FFT_HT_PAIR = 2 * 64 * FT_PITCH * 2;

struct Args { const float* in[20]; float* out; unsigned char* ws; int ph_lo, ph_hi; };
static_assert(sizeof(Args) == 20 * 8 + 8 + 8 + 8, "no padding bytes in Args");


typedef __attribute__((address_space(4))) const unsigned char* kptr_t;
__device__ __forceinline__ kptr_t karg() { kptr_t p = (kptr_t)__builtin_amdgcn_kernarg_segment_ptr(); asm volatile("" : "+s"(p)); return p; }
#define KIN(i) (*(const float* const __attribute__((address_space(4)))*)(karg() + 8 * (i)))
#define KOUT() (*(float* const __attribute__((address_space(4)))*)(karg() + 160))
#define KWS() (*(unsigned char* const __attribute__((address_space(4)))*)(karg() + 168))
#define WSP(T, off) ((T*)(ws + (off)))

#ifndef NAIVE_ATTN
#define NAIVE_ATTN 0
#endif

__global__ void __launch_bounds__(NWAVES * 64, 2) fwd(Args args) {
    extern __shared__ __attribute__((aligned(16))) unsigned char lds_raw[];
    LAS unsigned char* lds = (LAS unsigned char*)lds_raw;
    LAS unsigned char* lctl = lds + LDSCTL_OFF;
    const int G = gridDim.x, bx = blockIdx.x;
    const int NGW = G * NWAVES, NGT = G * NWAVES * 64;
#define TID_SETUP() int tid_ = threadIdx.x; asm volatile("" : "+v"(tid_)); const int tid = tid_, lane = tid & 63, wave = __builtin_amdgcn_readfirstlane(tid >> 6); \
    const int gw = bx * NWAVES + wave, gt = bx * (NWAVES * 64) + tid; (void)lane; (void)gw; (void)gt
    for (int u = threadIdx.x; u < (LDS_BYTES - LDSCTL_OFF) / 4; u += NWAVES * 64) ((LAS unsigned*)lctl)[u] = 0u;
    __syncthreads();
    volatile LAS unsigned* MISC = (volatile LAS unsigned*)(lctl + LC_MISC);
    XcdBarrier bar = xcd_barrier_post((unsigned*)(KWS() + WS_CTL) + CW_BAR, MISC + 8);
    const int lo = args.ph_lo, hi = args.ph_hi;
#ifndef PH_OFF
#define PH_OFF 0
#endif
#define PON(j) (!((PH_OFF >> (j)) & 1))
#define IN(k) (lo <= (k) && (k) < hi)
#ifndef PROBE_A
#define PROBE_A -1
#endif
#ifndef PROBE_B
#define PROBE_B -1
#endif
#if PROBE_A >= 0
#define STAMP(k) do { if (blockIdx.x == 0 && threadIdx.x == 0) { ((unsigned long long*)(KWS() + WS_CTL + 65536))[(k)] = __builtin_amdgcn_s_memrealtime(); } } while (0)
#define STAMP2(i) do { __syncthreads(); if (blockIdx.x == 0 && threadIdx.x == 0) { ((unsigned long long*)(KWS() + WS_CTL + 65536))[128 + l * 16 + (i)] = __builtin_amdgcn_s_memrealtime(); } } while (0)
#else
#define STAMP(k) do {} while (0)
#define STAMP2(i) do {} while (0)
#endif
#ifndef PROBE_SUB_A
#define PROBE_SUB_A -1
#define PROBE_SUB_B -1
#endif
#define SEAM(k) do { if (IN(k) && IN((k) + 1)) xcd_barrier(bar); STAMP((k) + 1); } while (0)
    STAMP(0);

    if (IN(0) && PON(0)) {
        TID_SETUP(); unsigned char* ws = KWS(); const float* x_in = KIN(0); const float* ln_in_g = KIN(1); const float* ln_in_b = KIN(2); const float* w_in = KIN(3); const float* w_out = KIN(9);
        const float* exp_w_gu = KIN(14); const float* exp_w_down = KIN(16);
        float* ROPE = WSP(float, WS_ROPE); bf16* WIN_T = WSP(bf16, WS_WIN_T); bf16* WOUT_T = WSP(bf16, WS_WOUT_T); bf16* WGU_T = WSP(bf16, WS_WGU_T); bf16* WDN_T = WSP(bf16, WS_WDN_T);
        bf16* HB = WSP(bf16, WS_HB);
        { LAS unsigned* Lt = (LAS unsigned*)(lds + RING_OFF);
          constexpr int T_WIN = NL * 16 * 4, T_WOUT = NL * 8 * 4, T_WGU = NL * NE * 16 * 4, T_WDN = NL * NE * 8 * 4, NTILE = T_WIN + T_WOUT + T_WGU + T_WDN;
          for (int it = bx; it < NTILE; it += G) {
            int r = it; const float* W; bf16* WT; int Nsrc, nb, kq, mode;
            if (r < T_WIN) { const int l = r / 64, q = r % 64; nb = q / 4; kq = q % 4; W = w_in + (size_t)l * DM * INW; WT = WIN_T + (size_t)l * INP * DM; Nsrc = INW; mode = 0; }
            else if ((r -= T_WIN) < T_WOUT) { const int l = r / 32, q = r % 32; nb = q / 4; kq = q % 4; W = w_out + (size_t)l * DM * DM; WT = WOUT_T + (size_t)l * DM * DM; Nsrc = DM; mode = 1; }
            else if ((r -= T_WOUT) < T_WGU) { const int le = r / 64, q = r % 64; nb = q / 4; kq = q % 4; W = exp_w_gu + (size_t)le * DM * 2048; WT = WGU_T + (size_t)le * 2048 * DM; Nsrc = 2048; mode = 2; }
            else { r -= T_WGU; const int le = r / 32, q = r % 32; nb = q / 4; kq = q % 4; W = exp_w_down + (size_t)le * DE * DM; WT = WDN_T + (size_t)le * DM * DE; Nsrc = DM; mode = 1; }
            const int n = nb * 128 + 2 * lane;
            int src = n;
            if (mode == 0) src = n < 1536 ? n : (n < 1792 ? n + 32 : (n < 1824 ? n - 256 : -1));
            else if (mode == 2) { const int pn = n >> 8, bj = (n >> 7) & 1, j = n & 127; src = bj * 1024 + pn * 128 + j; }
            f32x2v v[32];
            if (src >= 0) { const float* p = W + (size_t)(kq * 256 + 32 * wave) * Nsrc + src;
#pragma unroll
                for (int i = 0; i < 32; ++i) v[i] = __builtin_nontemporal_load((const f32x2v*)(p + (size_t)i * Nsrc)); }
            else {
#pragma unroll
                for (int i = 0; i < 32; ++i) v[i] = (f32x2v){0.f, 0.f}; }
            __syncthreads();
#pragma unroll
            for (int i2 = 0; i2 < 16; ++i2) { Lt[(2 * lane) * 129 + 16 * wave + i2] = pk2(v[2 * i2].x, v[2 * i2 + 1].x); Lt[(2 * lane + 1) * 129 + 16 * wave + i2] = pk2(v[2 * i2].y, v[2 * i2 + 1].y); }
            __syncthreads();
            const int p4 = (lane & 31) * 4;
#pragma unroll
            for (int j = 0; j < 8; ++j) { const int row = 16 * wave + 2 * j + (lane >> 5); const LAS unsigned* lp = Lt + row * 129 + p4; v4u o; o.x = lp[0]; o.y = lp[1]; o.z = lp[2]; o.w = lp[3];
                *(v4u*)(WT + (size_t)(nb * 128 + row) * DM + kq * 256 + 2 * p4) = o; }
          }
          __syncthreads(); }
        { bf16* FTAB = WSP(bf16, WS_FTAB); float* TW = WSP(float, WS_TW);
          for (int it = gt; it < 3 * FT_TAB; it += NGT) { const int t = it / FT_TAB, q = it % FT_TAB, row = q / FT_PITCH, col = q % FT_PITCH; float sn, cs; sincospif((float)((row * col) & 63) * (1.0f / 32.0f), &sn, &cs);
              const float v = col >= 64 ? 0.f : (t == 0 ? cs : (t == 1 ? sn : -sn)); FTAB[it] = (bf16)f2bf(v); }
          for (int it = gt; it < 4096; it += NGT) { float sn, cs; sincospif((float)it * (1.0f / 2048.0f), &sn, &cs); TW[2 * it] = cs; TW[2 * it + 1] = -sn; } }
        { const float* router_w = KIN(12); bf16* RWT = WSP(bf16, WS_RWT);
          for (int it = gt; it < NL * NE * DM; it += NGT) { const int k = it & (DM - 1), e = (it >> 10) & 31, l = it >> 15; const float w = router_w[((size_t)l * DM + k) * NE + e];
              const unsigned hi = f2bf(w); const float lo = w - __uint_as_float(hi << 16); RWT[((size_t)(l * 2 + 0) * NE + e) * DM + k] = (bf16)hi; RWT[((size_t)(l * 2 + 1) * NE + e) * DM + k] = (bf16)f2bf(lo); } }
        for (int it = gt; it < SEQ * 32; it += NGT) { const int t = it >> 5, i = it & 31, a = i >> 4, f = i & 15; const int pos = a ? (t & 63) : (t >> 6);
            const double inv = exp(-9.210340371976184 * (double)f / 16.0); const double ang = (double)pos * inv;
            ROPE[it] = (float)cos(ang); ROPE[SEQ * 32 + it] = (float)sin(ang); }
        { f32x4 gam[4], bet[4];
#pragma unroll
          for (int j = 0; j < 4; ++j) { gam[j] = *(const f32x4*)(ln_in_g + RC(lane, j)); bet[j] = *(const f32x4*)(ln_in_b + RC(lane, j)); }
          for (int m0 = gw; m0 < NTOK; m0 += 2 * NGW) { f32x4 v[2][4];
#pragma unroll
            for (int q = 0; q < 2; ++q)
#pragma unroll
                for (int j = 0; j < 4; ++j) v[q][j] = *(const f32x4*)(x_in + (size_t)(m0 + q * NGW) * DM + RC(lane, j));
#pragma unroll
            for (int q = 0; q < 2; ++q) { ln_row8(v[q], gam, bet); row_store_bf16(v[q], HB + (size_t)(m0 + q * NGW) * DM, lane); } } }
    }
    SEAM(0);

    for (int l = 0; l < NL; ++l) {
        const int pb = 1 + 10 * l;
        if (IN(pb + 0) && PON(1)) {
            TID_SETUP(); unsigned char* ws = KWS(); bf16* HB = WSP(bf16, WS_HB); bf16* WIN_T = WSP(bf16, WS_WIN_T); bf16* PROJ = WSP(bf16, WS_PROJ);
            pg8::Gemm g{HB, WIN_T + (size_t)l * INP * DM, NTOK, INP, DM}; pg8::StaticOrder S; S.init(NTOK, INP, G, bx);
            pg8::EpiPlainBf16 E{PROJ, INP};
            STAMP2(2);
            pg8::gemm_phase<pg8::EpiPlainBf16, pg8::StaticOrder, true, true>(lds + RING_OFF, g, S, E);
            STAMP2(3);
        }
        SEAM(pb + 0);
        if (IN(pb + 1) && PON(2)) {
            TID_SETUP(); unsigned char* ws = KWS(); const float* att_q_gain = KIN(4); const float* att_k_gain = KIN(5); const float* gla_gate_w = KIN(6); const float* gla_gate_b = KIN(7);
            const float* ROPE = WSP(float, WS_ROPE); const bf16* PROJ = WSP(bf16, WS_PROJ); bf16* QB = WSP(bf16, WS_QB); bf16* KB = WSP(bf16, WS_KB); float* LA = WSP(float, WS_LA);
            STAMP2(8);
            { LAS float* RTC = (LAS float*)(lds + RING_OFF + 65536);
              for (int i = tid; i < 1024; i += NWAVES * 64) { const int pos = i >> 4, f = i & 15; RTC[i] = ROPE[(pos * 64) * 32 + f]; RTC[1024 + i] = ROPE[SEQ * 32 + (pos * 64) * 32 + f]; RTC[2048 + i] = ROPE[pos * 32 + 16 + f]; RTC[3072 + i] = ROPE[SEQ * 32 + pos * 32 + 16 + f]; }
              __syncthreads();
              const int li = lane & 7, ax = li >> 2, f0 = 8 * (li & 1); const float sg = ((li >> 1) & 1) ? 1.f : -1.f;
              f32x4 qg8[2], kg8[2];
#pragma unroll
              for (int c = 0; c < 2; ++c) { qg8[c] = *(const f32x4*)(att_q_gain + l * 64 + 8 * li + 4 * c); kg8[c] = *(const f32x4*)(att_k_gain + l * 64 + 8 * li + 4 * c); }
              for (int m0 = gw; m0 < NTOK; m0 += 4 * NGW) { v4u xp[5];
#pragma unroll
                for (int i = 0; i < 5; ++i) { const int P = lane + 64 * i, q = P / 80, p = P % 80; xp[i] = *(const v4u*)(PROJ + (size_t)(m0 + q * NGW) * INP + p * 8); }
#pragma unroll
                for (int i = 0; i < 5; ++i) { const int P = lane + 64 * i, q = P / 80, p = P % 80, head = p >> 3; const size_t m = (size_t)(m0 + q * NGW); const int t = (int)(m & (SEQ - 1));
                    float xv[8] = {__uint_as_float(xp[i].x << 16), __uint_as_float(xp[i].x & 0xffff0000u), __uint_as_float(xp[i].y << 16), __uint_as_float(xp[i].y & 0xffff0000u),
                                   __uint_as_float(xp[i].z << 16), __uint_as_float(xp[i].z & 0xffff0000u), __uint_as_float(xp[i].w << 16), __uint_as_float(xp[i].w & 0xffff0000u)};
                    float ss = 0.f;
#pragma unroll
                    for (int c = 0; c < 8; ++c) ss += xv[c] * xv[c];
                    ss += __shfl_xor(ss, 1); ss += __shfl_xor(ss, 2); ss += __shfl_xor(ss, 4);
                    const float rs = __builtin_amdgcn_rsqf(ss * (1.f / 64.f) + RMS_EPS); const bool isq = head < 8;
                    const LAS float* tb = RTC + (ax ? 2048 : 0) + (ax ? (t & 63) : (t >> 6)) * 16 + f0;
                    const f32x4 c0 = *(const LAS f32x4*)tb, c1 = *(const LAS f32x4*)(tb + 4), s0 = *(const LAS f32x4*)(tb + 1024), s1 = *(const LAS f32x4*)(tb + 1028);
                    const float csv[8] = {c0.x, c0.y, c0.z, c0.w, c1.x, c1.y, c1.z, c1.w}, snv[8] = {s0.x, s0.y, s0.z, s0.w, s1.x, s1.y, s1.z, s1.w};
                    const f32x4 g0 = isq ? qg8[0] : kg8[0], g1 = isq ? qg8[1] : kg8[1]; const float gv[8] = {g0.x, g0.y, g0.z, g0.w, g1.x, g1.y, g1.z, g1.w};
                    const float osc = isq ? QSCALE : 1.f; float o[8];
#pragma unroll
                    for (int c = 0; c < 8; ++c) { const float xn = xv[c] * rs * gv[c]; const float pr = __shfl_xor(xn, 2); o[c] = (xn * csv[c] + sg * pr * snv[c]) * osc; }
                    v4u w; w.x = pk2(o[0], o[1]); w.y = pk2(o[2], o[3]); w.z = pk2(o[4], o[5]); w.w = pk2(o[6], o[7]);
                    bf16* dst = isq ? (QB + m * 512 + head * 64 + 8 * li) : (KB + m * 128 + (head - 8) * 64 + 8 * li);
                    *(v4u*)dst = w; } }
              const float* gw_l = gla_gate_w + (size_t)l * 2 * 16 * 128; const float* gb_l = gla_gate_b + (size_t)l * 2 * 128; const int dir = lane >> 5, kc = (lane & 31) * 4;
              f32x4 gwr[16]; const f32x4 gbv = *(const f32x4*)(gb_l + dir * 128 + kc);
#pragma unroll
              for (int r = 0; r < 16; ++r) gwr[r] = *(const f32x4*)(gw_l + (size_t)(dir * 16 + r) * 128 + kc);
              for (int m0 = gw; m0 < NTOK; m0 += 4 * NGW) { v4u gl[4][2];
#pragma unroll
                for (int q = 0; q < 4; ++q) { const bf16* gp = PROJ + (size_t)(m0 + q * NGW) * INP + C_GLR + dir * 16; gl[q][0] = *(const v4u*)gp; gl[q][1] = *(const v4u*)(gp + 8); }
#pragma unroll
                for (int q = 0; q < 4; ++q) { const size_t m = (size_t)(m0 + q * NGW); f32x4 z = gbv;
                    const unsigned gu[8] = {gl[q][0].x, gl[q][0].y, gl[q][0].z, gl[q][0].w, gl[q][1].x, gl[q][1].y, gl[q][1].z, gl[q][1].w};
#pragma unroll
                    for (int r2 = 0; r2 < 8; ++r2) { z = z + gwr[2 * r2] * __uint_as_float(gu[r2] << 16); z = z + gwr[2 * r2 + 1] * __uint_as_float(gu[r2] & 0xffff0000u); }
                    f32x4 o4;
#pragma unroll
                    for (int i = 0; i < 4; ++i) o4[i] = (fminf(z[i], 0.f) - __logf(1.f + __expf(-fabsf(z[i])))) * (1.f / 16.f);
                    *(f32x4*)(LA + m * 256 + dir * 128 + kc) = o4; } }
              __syncthreads(); }
            STAMP2(4);
            { __syncthreads();
              { const v4u* src = (const v4u*)WSP(bf16, WS_FTAB); LAS v4u* dst = (LAS v4u*)(lds + RING_OFF + FFT_LDS_TAB); for (int i = tid; i < 3 * FT_TAB * 2 / 16; i += NWAVES * 64) dst[i] = src[i];
                const v4u* s2_ = (const v4u*)WSP(float, WS_TW); LAS v4u* d2_ = (LAS v4u*)(lds + RING_OFF + FFT_LDS_TW); for (int i = tid; i < 4096 * 8 / 16; i += NWAVES * 64) d2_[i] = s2_[i]; }
              __syncthreads();
              const LAS bf16* FT = (const LAS bf16*)(lds + RING_OFF + FFT_LDS_TAB); const LAS float* TWL = (const LAS float*)(lds + RING_OFF + FFT_LDS_TW); bf16* FTMP = WSP(bf16, WS_FTMP);
              const int pair = wave >> 1, cb = wave & 1, r = lane & 31, h = lane >> 5;
              for (int ub = bx; ub < NB * 4 * 64 / 4; ub += G) { const int u = ub * 4 + pair, s2 = u & 63, g4 = (u >> 6) & 3, b = u >> 8;
                bf16x8 xa[2][4];
#pragma unroll
                for (int R = 0; R < 2; ++R)
#pragma unroll
                    for (int ks = 0; ks < 4; ++ks) xa[R][ks] = *(const bf16x8*)(PROJ + ((size_t)b * SEQ + 64 * (32 * R + r) + s2) * INP + C_FX + g4 * 64 + 16 * ks + 8 * h);
                f32x16 Tr[2], Ti[2];
#pragma unroll
                for (int R = 0; R < 2; ++R)
#pragma unroll
                    for (int i = 0; i < 16; ++i) { Tr[R][i] = 0.f; Ti[R][i] = 0.f; }
#pragma unroll
                for (int ks = 0; ks < 4; ++ks) { const bf16x8 bc = *(const LAS bf16x8*)(FT + (32 * cb + r) * FT_PITCH + 16 * ks + 8 * h), bs = *(const LAS bf16x8*)(FT + 2 * FT_TAB + (32 * cb + r) * FT_PITCH + 16 * ks + 8 * h);
#pragma unroll
                    for (int R = 0; R < 2; ++R) { Tr[R] = MFMA32(xa[R][ks], bc, Tr[R]); Ti[R] = MFMA32(xa[R][ks], bs, Ti[R]); } }
#pragma unroll
                for (int Rp = 0; Rp < 2; ++Rp) { f32x16 Gr, Gi;
#pragma unroll
                    for (int i = 0; i < 16; ++i) { Gr[i] = 0.f; Gi[i] = 0.f; }
#pragma unroll
                    for (int R = 0; R < 2; ++R)
#pragma unroll
                        for (int s_ = 0; s_ < 2; ++s_) { const bf16x8 xr = pack_step(Tr[R], s_), xi = pack_step(Ti[R], s_);
                            const int kb = 32 * R + 16 * s_ + 4 * h, ro = (32 * Rp + r) * FT_PITCH + kb;
                            const s16x4 c0 = *(const LAS s16x4*)(FT + ro), c1 = *(const LAS s16x4*)(FT + ro + 8), s0 = *(const LAS s16x4*)(FT + FT_TAB + ro), s1 = *(const LAS s16x4*)(FT + FT_TAB + ro + 8),
                                        n0 = *(const LAS s16x4*)(FT + 2 * FT_TAB + ro), n1 = *(const LAS s16x4*)(FT + 2 * FT_TAB + ro + 8);
                            const bf16x8 ca = __builtin_shufflevector(c0, c1, 0, 1, 2, 3, 4, 5, 6, 7), sa = __builtin_shufflevector(s0, s1, 0, 1, 2, 3, 4, 5, 6, 7), na = __builtin_shufflevector(n0, n1, 0, 1, 2, 3, 4, 5, 6, 7);
                            Gr = MFMA32(ca, xr, Gr); Gr = MFMA32(sa, xi, Gr); Gi = MFMA32(ca, xi, Gi); Gi = MFMA32(na, xr, Gi); }
#pragma unroll
                    for (int i = 0; i < 16; ++i) { const int s1p = 32 * Rp + crow16(i, h); const int m = (s2 * s1p) & 4095; const float wr = TWL[2 * m], wi = TWL[2 * m + 1];
                        const size_t o = ((((size_t)(b * 4 + g4) * 64 + s1p) * 2) * 64 + s2) * 64 + 32 * cb + r;
                        FTMP[o] = (bf16)f2bf(Gr[i] * wr - Gi[i] * wi); FTMP[o + 4096] = (bf16)f2bf(Gr[i] * wi + Gi[i] * wr); } }
              }
              __syncthreads(); }
            STAMP2(5);
            { float* GS = WSP(float, WS_OF); float* GD = WSP(float, WS_OB);
              const int slot = wave >> 2, w4 = wave & 3, fr = lane & 15, fq = lane >> 4; LAS unsigned char* Ls = lds + RING_OFF + slot * GM_SLOT;
              for (int ub = bx; ub < NB * 4 * 64 / 2; ub += G) { const int u = ub * 2 + slot, c = u & 63, bh = u >> 6, hd = bh & 3, b = bh >> 2; const size_t tok0 = (size_t)b * SEQ + c * 64;
                __syncthreads();
                gla_stage_mfma<false>(Ls, PROJ, LA, nullptr, tok0, hd, w4, lane);
                __syncthreads();
                const LAS bf16* VT = (const LAS bf16*)(Ls + GM_VT); const LAS float* DL = (const LAS float*)(Ls + GM_DL);
#pragma unroll
                for (int dir = 0; dir < 2; ++dir) { const LAS bf16* KT = (const LAS bf16*)(Ls + GM_P + dir * 4608);
#pragma unroll
                    for (int Cd = 0; Cd < 2; ++Cd) { f32x4 acc = {0.f, 0.f, 0.f, 0.f};
#pragma unroll
                        for (int ks = 0; ks < 2; ++ks) { const bf16x8 a_ = *(const LAS bf16x8*)(VT + (16 * w4 + fr) * 72 + 32 * ks + 8 * fq), b_ = *(const LAS bf16x8*)(KT + (16 * Cd + fr) * 72 + 32 * ks + 8 * fq); acc = MFMA16(a_, b_, acc); }
                        const float Dd = DL[dir * 32 + 16 * Cd + fr]; float* o = GS + (((size_t)u * 2 + dir) * 64 + 16 * w4 + 4 * fq) * 32 + 16 * Cd + fr;
#pragma unroll
                        for (int r = 0; r < 4; ++r) o[r * 32] = acc[r] * Dd; } }
                if (w4 == 3) GD[((size_t)u * 2 + (lane >> 5)) * 32 + (lane & 31)] = DL[lane]; }
              __syncthreads(); }
            STAMP2(9);
        }
        SEAM(pb + 1);
        if (IN(pb + 2) && PON(3)) {
            TID_SETUP(); unsigned char* ws = KWS(); float* GS = WSP(float, WS_OF); const float* GD = WSP(float, WS_OB);
            for (int e = gt; e < NB * 4 * 2 * 2048; e += NGT) { const int dv = e & 2047, dir = (e >> 11) & 1, bh = e >> 12, d = dv & 31; float H = 0.f;
                for (int c8 = 0; c8 < 64; c8 += 8) { float sv[8], dd[8];
#pragma unroll
                    for (int i = 0; i < 8; ++i) { const int c = dir ? 63 - (c8 + i) : (c8 + i); const size_t sidx = ((size_t)(bh * 64 + c) * 2 + dir); sv[i] = GS[sidx * 2048 + dv]; dd[i] = GD[sidx * 32 + d]; }
#pragma unroll
                    for (int i = 0; i < 8; ++i) { const int c = dir ? 63 - (c8 + i) : (c8 + i); const size_t sidx = ((size_t)(bh * 64 + c) * 2 + dir); GS[sidx * 2048 + dv] = H; H = H * dd[i] + sv[i]; } } }
        }
        SEAM(pb + 2);
        if (IN(pb + 3) && PON(4)) {
            TID_SETUP(); unsigned char* ws = KWS(); const float* gla_norm_g = KIN(8); const bf16* PROJ = WSP(bf16, WS_PROJ);
            bf16* MIX = WSP(bf16, WS_MIX); const bf16* QB = WSP(bf16, WS_QB); const bf16* KB = WSP(bf16, WS_KB);
            { __syncthreads();
              { const v4u* src = (const v4u*)WSP(bf16, WS_FTAB); LAS v4u* dst = (LAS v4u*)(lds + RING_OFF + FFT_LDS_TAB); for (int i = tid; i < 3 * FT_TAB * 2 / 16; i += NWAVES * 64) dst[i] = src[i]; }
              const LAS bf16* FT = (const LAS bf16*)(lds + RING_OFF + FFT_LDS_TAB); const bf16* FTMP = WSP(bf16, WS_FTMP);
              const int pair = wave >> 1, cb = wave & 1, r = lane & 31, h = lane >> 5;
              LAS bf16* HT = (LAS bf16*)(lds + RING_OFF + FFT_LDS_HT + pair * FFT_HT_PAIR);
              for (int ub = bx; ub < NB * 4 * 64 / 4; ub += G) { const int u = ub * 4 + pair, s1p = u & 63, g4 = (u >> 6) & 3, b = u >> 8;
                const bf16* src = FTMP + (size_t)u * 2 * 4096;
                __syncthreads();
#pragma unroll
                for (int q = 0; q < 8; ++q) { const int p = cb * 64 + lane + 128 * q, ri = p >> 9, s2 = (p >> 3) & 63, c0 = (p & 7) * 8; const u16x8 v = *(const u16x8*)(src + p * 8);
#pragma unroll
                    for (int i = 0; i < 8; ++i) HT[(ri * 64 + c0 + i) * FT_PITCH + s2] = v[i]; }
                __syncthreads();
#pragma unroll
                for (int Rp = 0; Rp < 2; ++Rp) { f32x16 acc;
#pragma unroll
                    for (int i = 0; i < 16; ++i) acc[i] = 0.f;
#pragma unroll
                    for (int ks = 0; ks < 4; ++ks) { const int ko = 16 * ks + 8 * h;
                        const bf16x8 ca = *(const LAS bf16x8*)(FT + (32 * Rp + r) * FT_PITCH + ko), sa = *(const LAS bf16x8*)(FT + FT_TAB + (32 * Rp + r) * FT_PITCH + ko);
                        const bf16x8 hr = *(const LAS bf16x8*)(HT + (32 * cb + r) * FT_PITCH + ko), hi_ = *(const LAS bf16x8*)(HT + (64 + 32 * cb + r) * FT_PITCH + ko);
                        acc = MFMA32(ca, hr, acc); acc = MFMA32(sa, hi_, acc); }
#pragma unroll
                    for (int i = 0; i < 16; ++i) { const int s2p = 32 * Rp + crow16(i, h); MIX[((size_t)b * SEQ + s1p + 64 * s2p) * DM + 768 + g4 * 64 + 32 * cb + r] = (bf16)f2bf(acc[i] * (1.0f / 512.0f)); } }
              }
              __syncthreads(); }
            STAMP2(6);
            { const float* GS = WSP(float, WS_OF); const float* LA = WSP(float, WS_LA);
              const int slot = wave >> 2, w4 = wave & 3, fr = lane & 15, fq = lane >> 4, I0 = 16 * w4; LAS unsigned char* Ls = lds + RING_OFF + slot * GM_SLOT;
              for (int ub = bx; ub < NB * 4 * 64 / 2; ub += G) { const int u = ub * 2 + slot, c = u & 63, bh = u >> 6, hd = bh & 3, b = bh >> 2; const size_t tok0 = (size_t)b * SEQ + c * 64;
                __syncthreads();
                gla_stage_mfma<true>(Ls, PROJ, LA, GS + (size_t)u * 2 * 2048, tok0, hd, w4, lane);
                __syncthreads();
                const LAS bf16* QF = (const LAS bf16*)(Ls + GM_QF); const LAS bf16* KF = (const LAS bf16*)(Ls + GM_KF); const LAS bf16* QBm = (const LAS bf16*)(Ls + GM_QB); const LAS bf16* KBm = (const LAS bf16*)(Ls + GM_KB);
                const LAS bf16* VT = (const LAS bf16*)(Ls + GM_VT); LAS bf16* P = (LAS bf16*)(Ls + GM_P); const LAS bf16* HTF = (const LAS bf16*)(Ls + GM_HTF); const LAS bf16* HTB = (const LAS bf16*)(Ls + GM_HTB);
                const bf16x8 qfa = *(const LAS bf16x8*)(QF + (I0 + fr) * 40 + 8 * fq), qba = *(const LAS bf16x8*)(QBm + (I0 + fr) * 40 + 8 * fq);
#pragma unroll
                for (int Cj = 0; Cj < 4; ++Cj) { const f32x4 z = {0.f, 0.f, 0.f, 0.f};
                    const f32x4 pf = MFMA16(qfa, *(const LAS bf16x8*)(KF + (16 * Cj + fr) * 40 + 8 * fq), z), pb = MFMA16(qba, *(const LAS bf16x8*)(KBm + (16 * Cj + fr) * 40 + 8 * fq), z);
#pragma unroll
                    for (int r = 0; r < 4; ++r) { const int i = I0 + 4 * fq + r, j = 16 * Cj + fr; P[i * 72 + j] = (bf16)f2bf(j <= i ? pf[r] : pb[r]); } }
                asm volatile("s_waitcnt lgkmcnt(0)" ::: "memory");
                f32x4 o[4];
#pragma unroll
                for (int Cv = 0; Cv < 4; ++Cv) { f32x4 acc = {0.f, 0.f, 0.f, 0.f};
#pragma unroll
                    for (int ks = 0; ks < 2; ++ks) acc = MFMA16(*(const LAS bf16x8*)(P + (I0 + fr) * 72 + 32 * ks + 8 * fq), *(const LAS bf16x8*)(VT + (16 * Cv + fr) * 72 + 32 * ks + 8 * fq), acc);
                    acc = MFMA16(qfa, *(const LAS bf16x8*)(HTF + (16 * Cv + fr) * 40 + 8 * fq), acc); acc = MFMA16(qba, *(const LAS bf16x8*)(HTB + (16 * Cv + fr) * 40 + 8 * fq), acc);
                    o[Cv] = acc; }
                float rs[4];
#pragma unroll
                for (int r = 0; r < 4; ++r) { float ss = (o[0][r] * o[0][r] + o[1][r] * o[1][r]) + (o[2][r] * o[2][r] + o[3][r] * o[3][r]);
#pragma unroll
                    for (int m_ = 1; m_ < 16; m_ <<= 1) ss += __shfl_xor(ss, m_);
                    rs[r] = 1.f / sqrtf(ss * (1.f / 64.f) + RMS_EPS); }
#pragma unroll
                for (int Cv = 0; Cv < 4; ++Cv) { const int v = 16 * Cv + fr; const float gn = gla_norm_g[l * 64 + v];
#pragma unroll
                    for (int r = 0; r < 4; ++r) { const size_t m = tok0 + I0 + 4 * fq + r; const float rg = bf2f(PROJ[m * INP + C_GR + hd * 64 + v]);
                        MIX[m * DM + 512 + hd * 64 + v] = (bf16)f2bf(o[Cv][r] * rs[r] * gn * (rg / (1.f + expf(-rg)))); } } }
              __syncthreads(); }
            STAMP2(7);
#if NAIVE_ATTN
            { LAS float* Kt = (LAS float*)(lds + RING_OFF); LAS float* Vt = Kt + 64 * 64;
              for (int unit = bx; unit < NB * 8 * 8; unit += G) { const int rb = unit & 7, h = (unit >> 3) & 7, b = unit >> 6, kvh = h >> 2;
                const size_t qrow = (size_t)b * SEQ + rb * 512 + tid;
                float q[64], o[64]; float mrun = -INFINITY, lrun = 0.f;
#pragma unroll
                for (int c8 = 0; c8 < 8; ++c8) { const u16x8 f = *(const u16x8*)(QB + qrow * 512 + h * 64 + c8 * 8);
#pragma unroll
                    for (int i = 0; i < 8; ++i) { q[c8 * 8 + i] = bf2f(f[i]); o[c8 * 8 + i] = 0.f; } }
                for (int kt = 0; kt < SEQ; kt += 64) {
                    __syncthreads();
                    { const int kr = tid >> 3, c8 = (tid & 7) * 8; const size_t krow = (size_t)b * SEQ + kt + kr;
                      const u16x8 kf = *(const u16x8*)(KB + krow * 128 + kvh * 64 + c8); const u16x8 vf = *(const u16x8*)(PROJ + krow * INP + C_AV + kvh * 64 + c8);
#pragma unroll
                      for (int i = 0; i < 8; ++i) { Kt[kr * 64 + c8 + i] = bf2f(kf[i]); Vt[kr * 64 + c8 + i] = bf2f(vf[i]); } }
                    __syncthreads();
#pragma unroll 1
                    for (int j = 0; j < 64; ++j) { float a = 0.f;
#pragma unroll
                        for (int d4 = 0; d4 < 16; ++d4) { const f32x4 kv = *(const LAS f32x4*)(Kt + j * 64 + d4 * 4); a += (q[d4 * 4] * kv.x + q[d4 * 4 + 1] * kv.y) + (q[d4 * 4 + 2] * kv.z + q[d4 * 4 + 3] * kv.w); }
                        if (a > mrun) { const float al = exp2f(mrun - a); mrun = a; lrun *= al;
#pragma unroll
                            for (int d = 0; d < 64; ++d) o[d] *= al; }
                        const float p = exp2f(a - mrun); lrun += p;
#pragma unroll
                        for (int d4 = 0; d4 < 16; ++d4) { const f32x4 vv = *(const LAS f32x4*)(Vt + j * 64 + d4 * 4); o[d4 * 4] += p * vv.x; o[d4 * 4 + 1] += p * vv.y; o[d4 * 4 + 2] += p * vv.z; o[d4 * 4 + 3] += p * vv.w; } }
                }
                const float rl = 1.f / lrun;
#pragma unroll
                for (int c8 = 0; c8 < 8; ++c8) { v4u w; w.x = pk2(o[c8 * 8] * rl, o[c8 * 8 + 1] * rl); w.y = pk2(o[c8 * 8 + 2] * rl, o[c8 * 8 + 3] * rl); w.z = pk2(o[c8 * 8 + 4] * rl, o[c8 * 8 + 5] * rl); w.w = pk2(o[c8 * 8 + 6] * rl, o[c8 * 8 + 7] * rl);
                    *(v4u*)(MIX + qrow * DM + h * 64 + c8 * 8) = w; }
              }
              __syncthreads(); }
#else
            { const attn_body::AttnTensors AT{(const attn_body::bf16*)QB, (const attn_body::bf16*)KB, (const attn_body::bf16*)(PROJ + C_AV), (attn_body::bf16*)MIX};
              const attn_body::StaticOrder S(G, bx);
              attn_body::attn_phase<attn_body::StaticOrder>((char*)lds_raw + RING_OFF, AT, S); }
#endif
        }
        SEAM(pb + 3);
        if (IN(pb + 4) && PON(5)) {
            TID_SETUP(); unsigned char* ws = KWS(); const bf16* MIX = WSP(bf16, WS_MIX); const bf16* WOUT_T = WSP(bf16, WS_WOUT_T); const bf16* HB = WSP(bf16, WS_HB); bf16* T1 = WSP(bf16, WS_T1);
            pg8::Gemm g{MIX, WOUT_T + (size_t)l * DM * DM, NTOK, DM, DM}; pg8::StaticOrder S; S.init(NTOK, DM, G, bx);
            pg8::EpiResBf16 E{HB, T1, DM, DN_ALPHA};
            pg8::gemm_phase<pg8::EpiResBf16, pg8::StaticOrder, true, true>(lds + RING_OFF, g, S, E);
        }
        SEAM(pb + 4);
        if (IN(pb + 5) && PON(6)) {
            TID_SETUP(); unsigned char* ws = KWS(); gu32* ctl = (gu32*)(ws + WS_CTL); const float* ln1_g = KIN(10); const float* ln1_b = KIN(11); const float* router_w = KIN(12); const float* router_b = KIN(13);
            const bf16* T1 = WSP(bf16, WS_T1); bf16* HB = WSP(bf16, WS_HB); int* TOKE = WSP(int, WS_TOK); int* TOKS = TOKE + NTOK * 4; float* TOKW = (float*)(TOKS + NTOK * 4); int* LIST = WSP(int, WS_XS);
            { const v4u* src = (const v4u*)(WSP(bf16, WS_RWT) + (size_t)l * 2 * NE * DM); LAS v4u* dst = (LAS v4u*)(lds + RING_OFF);
              for (int i = tid; i < 2 * NE * DM * 2 / 16; i += NWAVES * 64) { const int row = i >> 7, c = i & 127; dst[row * 128 + (c ^ (row & 7))] = src[i]; }
              LAS float* GBw = (LAS float*)(lctl + LC_ROWS); for (int i = tid; i < DM; i += NWAVES * 64) { GBw[i] = ln1_g[l * DM + i]; GBw[DM + i] = ln1_b[l * DM + i]; } }
            const LAS bf16* RWH = (const LAS bf16*)(lds + RING_OFF); const LAS float* GB = (const LAS float*)(lctl + LC_ROWS); LAS float* ST = (LAS float*)(lctl + LC_ROWS + 8192);
            LAS int* lcnt = (LAS int*)(lctl + LC_CNT); LAS int* lbase = (LAS int*)(lctl + LC_BASE); LAS int* sele = (LAS int*)(lctl + LC_SELE); LAS int* sels = (LAS int*)(lctl + LC_SELS);
            const float* rb = router_b + l * NE;
            for (int r0 = bx * 128; r0 < NTOK; r0 += G * 128) {
                if (tid < 32) lcnt[tid] = 0;
                __syncthreads();
                LAS float* LG = (LAS float*)(lctl + LC_LG) + wave * 512;
                for (int rr = 0; rr < 16; rr += 4) { f32x4 v[4][4];
#pragma unroll
                    for (int q = 0; q < 4; ++q) row_load_bf16(v[q], T1 + ((size_t)r0 + wave * 16 + rr + q) * DM, lane);
#pragma unroll
                    for (int q = 0; q < 4; ++q) { float s_ = 0.f;
#pragma unroll
                        for (int j = 0; j < 4; ++j) s_ += (v[q][j].x + v[q][j].y) + (v[q][j].z + v[q][j].w);
                        const float mean = wave_sum(s_) * (1.f / DM); float s2_ = 0.f;
#pragma unroll
                        for (int j = 0; j < 4; ++j) { const f32x4 d_ = v[q][j] - mean; s2_ += (d_.x * d_.x + d_.y * d_.y) + (d_.z * d_.z + d_.w * d_.w); }
                        const float rstd = __builtin_amdgcn_rsqf(wave_sum(s2_) * (1.f / DM) + LN_EPS);
                        if (lane == 0) { ST[(wave * 16 + rr + q) * 2] = mean; ST[(wave * 16 + rr + q) * 2 + 1] = rstd; } } }
                asm volatile("s_waitcnt lgkmcnt(0)" ::: "memory");
                { const int fr = lane & 15, fq = lane >> 4; const size_t row = (size_t)r0 + wave * 16 + fr; const float mean = ST[(wave * 16 + fr) * 2], rstd = ST[(wave * 16 + fr) * 2 + 1];
                  const bf16* xrow = T1 + row * DM + 8 * fq; bf16* hrow = HB + row * DM + 8 * fq;
                  f32x4 acc0 = {0.f, 0.f, 0.f, 0.f}, acc1 = {0.f, 0.f, 0.f, 0.f};
#pragma unroll 1
                  for (int s8 = 0; s8 < 32; s8 += 8) { v4u xr[8];
#pragma unroll
                    for (int i = 0; i < 8; ++i) xr[i] = *(const v4u*)(xrow + 32 * (s8 + i));
#pragma unroll
                    for (int i = 0; i < 8; ++i) { const int k0 = 32 * (s8 + i) + 8 * fq;
                        const f32x4 g0 = *(const LAS f32x4*)(GB + k0), g1 = *(const LAS f32x4*)(GB + k0 + 4), b0 = *(const LAS f32x4*)(GB + DM + k0), b1 = *(const LAS f32x4*)(GB + DM + k0 + 4);
                        f32x4 x0 = {__uint_as_float(xr[i].x << 16), __uint_as_float(xr[i].x & 0xffff0000u), __uint_as_float(xr[i].y << 16), __uint_as_float(xr[i].y & 0xffff0000u)};
                        f32x4 x1 = {__uint_as_float(xr[i].z << 16), __uint_as_float(xr[i].z & 0xffff0000u), __uint_as_float(xr[i].w << 16), __uint_as_float(xr[i].w & 0xffff0000u)};
                        x0 = (x0 - mean) * rstd * g0 + b0; x1 = (x1 - mean) * rstd * g1 + b1;
                        v4u hi; hi.x = pk2(x0.x, x0.y); hi.y = pk2(x0.z, x0.w); hi.z = pk2(x1.x, x1.y); hi.w = pk2(x1.z, x1.w);
                        *(v4u*)(hrow + 32 * (s8 + i)) = hi;
                        const f32x4 l0 = {x0.x - __uint_as_float(hi.x << 16), x0.y - __uint_as_float(hi.x & 0xffff0000u), x0.z - __uint_as_float(hi.y << 16), x0.w - __uint_as_float(hi.y & 0xffff0000u)};
                        const f32x4 l1 = {x1.x - __uint_as_float(hi.z << 16), x1.y - __uint_as_float(hi.z & 0xffff0000u), x1.z - __uint_as_float(hi.w << 16), x1.w - __uint_as_float(hi.w & 0xffff0000u)};
                        v4u lo; lo.x = pk2(l0.x, l0.y); lo.y = pk2(l0.z, l0.w); lo.z = pk2(l1.x, l1.y); lo.w = pk2(l1.z, l1.w);
                        const bf16x8 ah = __builtin_bit_cast(bf16x8, hi), al = __builtin_bit_cast(bf16x8, lo);
                        const int c = 4 * (s8 + i) + fq;
                        const LAS bf16* w0 = RWH + fr * DM + ((c ^ (fr & 7)) << 3); const LAS bf16* w1 = RWH + (16 + fr) * DM + ((c ^ (fr & 7)) << 3);
                        const bf16x8 bh0 = *(const LAS bf16x8*)w0, bl0 = *(const LAS bf16x8*)(w0 + NE * DM), bh1 = *(const LAS bf16x8*)w1, bl1 = *(const LAS bf16x8*)(w1 + NE * DM);
                        acc0 = MFMA16(ah, bh0, acc0); acc0 = MFMA16(ah, bl0, acc0); acc0 = MFMA16(al, bh0, acc0);
                        acc1 = MFMA16(ah, bh1, acc1); acc1 = MFMA16(ah, bl1, acc1); acc1 = MFMA16(al, bh1, acc1); } }
                  const float bias0 = rb[fr], bias1 = rb[16 + fr];
#pragma unroll
                  for (int r = 0; r < 4; ++r) { LG[(4 * fq + r) * 32 + fr] = acc0[r] + bias0; LG[(4 * fq + r) * 32 + 16 + fr] = acc1[r] + bias1; } }
                asm volatile("s_waitcnt lgkmcnt(0)" ::: "memory");
                if (lane < 16) { const int lr = wave * 16 + lane; const size_t m = (size_t)r0 + lr; float lg[32];
#pragma unroll
                    for (int e4 = 0; e4 < 8; ++e4) { const f32x4 x = *(const LAS f32x4*)(LG + lane * 32 + e4 * 4); lg[e4 * 4] = x.x; lg[e4 * 4 + 1] = x.y; lg[e4 * 4 + 2] = x.z; lg[e4 * 4 + 3] = x.w; }
                    int se[4]; float sv[4];
#pragma unroll
                    for (int k = 0; k < 4; ++k) { float best = -INFINITY; int bi = 0;
#pragma unroll
                        for (int e = 0; e < 32; ++e) { if (lg[e] > best) { best = lg[e]; bi = e; } }
                        se[k] = bi; sv[k] = best;
#pragma unroll
                        for (int e = 0; e < 32; ++e) if (e == bi) lg[e] = -INFINITY; }
                    const float e1 = expf(sv[1] - sv[0]), e2 = expf(sv[2] - sv[0]), e3 = expf(sv[3] - sv[0]); const float inv = 1.f / (1.f + e1 + e2 + e3);
                    const float wts[4] = {inv, e1 * inv, e2 * inv, e3 * inv};
#pragma unroll
                    for (int k = 0; k < 4; ++k) { const int ls = __hip_atomic_fetch_add(lcnt + se[k], 1, __ATOMIC_RELAXED, __HIP_MEMORY_SCOPE_WORKGROUP); sele[lr * 4 + k] = se[k]; sels[lr * 4 + k] = ls; TOKW[m * 4 + k] = wts[k]; } }
                __syncthreads();
                if (tid < 32) lbase[tid] = (int)__hip_atomic_fetch_add(ctl + CW_CNT + l * 32 + tid, (unsigned)lcnt[tid], RLX_AGENT);
                __syncthreads();
                { const int e = sele[tid], sl = lbase[e] + sels[tid]; TOKE[(size_t)r0 * 4 + tid] = e; TOKS[(size_t)r0 * 4 + tid] = sl; LIST[(size_t)e * NTOK + sl] = r0 + (tid >> 2); }
                __syncthreads();
            }
        }
        SEAM(pb + 5);
#if defined(EXP_P1_NOEPI)
        if (IN(pb + 6)) {
            TID_SETUP(); unsigned char* ws = KWS(); bf16* HB = WSP(bf16, WS_HB); bf16* WIN_T = WSP(bf16, WS_WIN_T); bf16* PROJ = WSP(bf16, WS_PROJ);
            pg8::Gemm g{HB, WIN_T + (size_t)l * INP * DM, NTOK, INP, DM}; pg8::StaticOrder S; S.init(NTOK, INP, G, bx);
            pg8::EpiNull EN{PROJ}; pg8::gemm_phase<pg8::EpiNull, pg8::StaticOrder, true, true>(lds + RING_OFF, g, S, EN);
            __syncthreads(); }
#endif
        STAMP(pb + 7);
        if (IN(pb + 7) || IN(pb + 8) || IN(pb + 9)) {
            LAS int* pst = (LAS int*)(lctl + LC_PSTART); LAS int* ecnt = (LAS int*)(lctl + LC_BASE); gu32* ctl = (gu32*)(KWS() + WS_CTL);
            __syncthreads();
            if (threadIdx.x == 0) { int acc = 0; for (int e = 0; e < NE; ++e) { pst[e] = acc; const int c = (int)__hip_atomic_load(ctl + CW_CNT + l * 32 + e, RLX_AGENT); ecnt[e] = c; acc += (c + 255) >> 8; } pst[NE] = acc; }
            __syncthreads();
        }
        if (IN(pb + 7) && PON(8)) {
            TID_SETUP(); unsigned char* ws = KWS(); const float* exp_b_gu = KIN(15); const bf16* HB = WSP(bf16, WS_HB); const int* LIST = WSP(int, WS_XS); const bf16* WGU_T = WSP(bf16, WS_WGU_T); bf16* HID = WSP(bf16, WS_HID);
            const LAS int* pst = (const LAS int*)(lctl + LC_PSTART); LAS int* ul = (LAS int*)(lctl + LC_ULIST);
            const int nM = pst[NE], nN = 8, nwg = nM * nN;
            if (tid < 64) { const long L = (long)tid * G + bx; int v = -1;
                if (L < nwg) { int wgid = (int)L; { const int q = nwg / 8, r = nwg % 8, xcd = wgid % 8, off = wgid / 8; wgid = (xcd < r ? xcd * (q + 1) : r * (q + 1) + (xcd - r) * q) + off; }
                    const int nig = 8 * nN, gid = wgid / nig, fm = gid * 8, gsz = (nM - fm) < 8 ? (nM - fm) : 8; const int pm = fm + ((wgid % nig) % gsz), pn = (wgid % nig) / gsz;
                    int e = 0; for (int k = 1; k < NE; ++k) if (pst[k] <= pm) e = k;
                    v = (pm << 16) | (e * nN + pn); }
                ul[tid] = v; }
            __syncthreads();
            const int nunits = bx < nwg ? (nwg - bx + G - 1) / G : 0;
            LAS unsigned short* rows16 = (LAS unsigned short*)(lctl + LC_ROWS); const LAS int* ecnt = (const LAS int*)(lctl + LC_BASE);
            for (int sl = 0; sl < nunits; ++sl) { const int v = ul[sl]; const int pm = v >> 16, e = (v & 0xffff) >> 3, pl = pm - pst[e];
                if (tid < 256) { const int idx = pl * 256 + tid; rows16[sl * 256 + tid] = (idx < ecnt[e]) ? (unsigned short)LIST[(size_t)e * NTOK + idx] : (unsigned short)0; } }
            __syncthreads();
            pg8::Gemm g{HB, WGU_T + (size_t)l * NE * 2048 * DM, NTOK, NE * 2048, DM}; pg8::ListOrder S{ul, nunits};
            pg8::EpiSwiglu E{HID, exp_b_gu + (size_t)l * NE * 2048};
            pg8::gemm_phase_gather<pg8::EpiSwiglu, pg8::ListOrder, true>(lds + RING_OFF, g, S, E, rows16);
        }
        SEAM(pb + 7);
        if (IN(pb + 8) && PON(9)) {
            TID_SETUP(); unsigned char* ws = KWS(); const float* exp_b_down = KIN(17); const bf16* HID = WSP(bf16, WS_HID); const bf16* WDN_T = WSP(bf16, WS_WDN_T); bf16* YS = WSP(bf16, WS_YS);
            const LAS int* pst = (const LAS int*)(lctl + LC_PSTART); LAS int* ul = (LAS int*)(lctl + LC_ULIST);
            const int nM = pst[NE], nN = 4, nwg = nM * nN;
            __syncthreads();
            if (tid < 64) { const long L = (long)tid * G + bx; int v = -1;
                if (L < nwg) { int wgid = (int)L; { const int q = nwg / 8, r = nwg % 8, xcd = wgid % 8, off = wgid / 8; wgid = (xcd < r ? xcd * (q + 1) : r * (q + 1) + (xcd - r) * q) + off; }
                    const int nig = 8 * nN, gid = wgid / nig, fm = gid * 8, gsz = (nM - fm) < 8 ? (nM - fm) : 8; const int pm = fm + ((wgid % nig) % gsz), pn = (wgid % nig) / gsz;
                    int e = 0; for (int k = 1; k < NE; ++k) if (pst[k] <= pm) e = k;
                    v = (pm << 16) | (e * nN + pn); }
                ul[tid] = v; }
            __syncthreads();
            const int nunits = bx < nwg ? (nwg - bx + G - 1) / G : 0;
            pg8::Gemm g{HID, WDN_T + (size_t)l * NE * DM * DE, MPAD, NE * DM, DE}; pg8::ListOrder S{ul, nunits};
            pg8::EpiDown E{YS, exp_b_down + (size_t)l * NE * DM};
            pg8::gemm_phase<pg8::EpiDown, pg8::ListOrder, true, true>(lds + RING_OFF, g, S, E);
        }
        SEAM(pb + 8);
        if (IN(pb + 9) && PON(10)) {
            TID_SETUP(); unsigned char* ws = KWS(); const float* ln2_g = KIN(18); const float* ln2_b = KIN(19); float* out = KOUT(); bf16* HB = WSP(bf16, WS_HB);
            const bf16* YS = WSP(bf16, WS_YS); const int* TOKE = WSP(int, WS_TOK); const int* TOKS = TOKE + NTOK * 4; const float* TOKW = (const float*)(TOKS + NTOK * 4); const LAS int* pst = (const LAS int*)(lctl + LC_PSTART);
            const bool lastl = (l == NL - 1);
            f32x4 gam[4], bet[4];
#pragma unroll
            for (int j = 0; j < 4; ++j) { gam[j] = *(const f32x4*)(ln2_g + l * DM + RC(lane, j)); bet[j] = *(const f32x4*)(ln2_b + l * DM + RC(lane, j)); }
            for (int m0 = gw; m0 < NTOK; m0 += 2 * NGW) { f32x4 v[2][4]; const bf16* yr[2][4]; f32x4 wk[2];
#pragma unroll
                for (int q = 0; q < 2; ++q) { const int m = m0 + q * NGW; const v4u te = *(const v4u*)(TOKE + m * 4), ts = *(const v4u*)(TOKS + m * 4); wk[q] = *(const f32x4*)(TOKW + m * 4);
                    yr[q][0] = YS + (size_t)(pst[te.x] * 256 + (int)ts.x) * DM; yr[q][1] = YS + (size_t)(pst[te.y] * 256 + (int)ts.y) * DM; yr[q][2] = YS + (size_t)(pst[te.z] * 256 + (int)ts.z) * DM; yr[q][3] = YS + (size_t)(pst[te.w] * 256 + (int)ts.w) * DM;
                    row_load_bf16(v[q], HB + (size_t)m * DM, lane);
#pragma unroll
                    for (int j = 0; j < 4; ++j) v[q][j] = v[q][j] * DN_ALPHA; }
#pragma unroll
                for (int q = 0; q < 2; ++q)
#pragma unroll
                    for (int k = 0; k < 4; ++k) { f32x4 y[4]; row_load_bf16(y, yr[q][k], lane); const float w = wk[q][k];
#pragma unroll
                        for (int j = 0; j < 4; ++j) v[q][j] = v[q][j] + y[j] * w; }
#pragma unroll
                for (int q = 0; q < 2; ++q) { const int m = m0 + q * NGW; ln_row8(v[q], gam, bet);
                    if (lastl) {
#pragma unroll
                        for (int j = 0; j < 4; ++j) *(f32x4*)(out + (size_t)m * DM + RC(lane, j)) = v[q][j]; }
                    else row_store_bf16(v[q], HB + (size_t)m * DM, lane); } }
        }
        SEAM(pb + 9);
    }
#if PROBE_A >= 0
    { xcd_barrier(bar);
      const unsigned long long* st = (const unsigned long long*)(KWS() + WS_CTL + 65536); unsigned long long T = 0;
      if (PROBE_A & 1) T += st[1] - st[0];
      for (int l = 0; l < NL; ++l) for (int j = 1; j <= 10; ++j) if ((PROBE_A >> j) & 1) T += st[1 + 10 * l + j] - st[10 * l + j];
      if (PROBE_SUB_A >= 0) for (int l = 0; l < NL; ++l) T += st[128 + l * 16 + PROBE_SUB_B] - st[128 + l * 16 + PROBE_SUB_A];
      T *= 4ull; if (T > 5000000ull) T = 5000000ull;
      const unsigned long long t0 = __builtin_amdgcn_s_memrealtime();
      while (__builtin_amdgcn_s_memrealtime() - t0 < T) __builtin_amdgcn_s_sleep(16); }
#endif
#undef IN
#undef SEAM
}

#ifndef MK_PER_PHASE
#define MK_PER_PHASE 0
#endif
extern "C" void kernel_launch(void* const* d_in, const int* in_sizes, int n_in, void* d_out, int out_size, void* d_ws, size_t ws_size, hipStream_t stream) {
    static int grid = 0;
    if (grid == 0) {
        if (n_in != 20 || in_sizes[0] != NTOK * DM || out_size != NTOK * DM || ws_size < WS_END) { fprintf(stderr, "kernel_launch: unexpected shapes (n_in %d, in0 %d, out %d, ws %zu); nothing launched\n", n_in, n_in > 0 ? in_sizes[0] : -1, out_size, ws_size); grid = -1; return; }
        int dev = 0, cus = 0, per_cu = 0;
        if (hipGetDevice(&dev) != hipSuccess || hipDeviceGetAttribute(&cus, hipDeviceAttributeMultiprocessorCount, dev) != hipSuccess) { grid = -1; return; }
        if (hipFuncSetAttribute((const void*)fwd, hipFuncAttributeMaxDynamicSharedMemorySize, LDS_BYTES) != hipSuccess) { fprintf(stderr, "kernel_launch: hipFuncSetAttribute failed\n"); grid = -1; return; }
        if (hipOccupancyMaxActiveBlocksPerMultiprocessor(&per_cu, (const void*)fwd, NWAVES * 64, LDS_BYTES) != hipSuccess || per_cu < 1) fprintf(stderr, "kernel_launch: occupancy query reports %d\n", per_cu);
        (void)hipGetLastError();
        grid = cus;
    }
    if (grid < 0) return;
    if (hipMemsetAsync((char*)d_ws + WS_CTL, 0, CTL_ZERO_BYTES, stream) != hipSuccess) return;
    Args a{};
    for (int i = 0; i < 20; ++i) a.in[i] = (const float*)d_in[i];
    a.out = (float*)d_out; a.ws = (unsigned char*)d_ws;
#if MK_PER_PHASE
    for (int p = 0; p < N_PHASES; ++p) { a.ph_lo = p; a.ph_hi = p + 1; hipLaunchKernelGGL(fwd, dim3(grid), dim3(NWAVES * 64), LDS_BYTES, stream, a); }
#else
    a.ph_lo = 0; a.ph_hi = N_PHASES;
    hipLaunchKernelGGL(fwd, dim3(grid), dim3(NWAVES * 64), LDS_BYTES, stream, a);
#endif
    const hipError_t le = hipPeekAtLastError();
    if (le != hipSuccess) fprintf(stderr, "kernel_launch: launch failed: %s\n", hipGetErrorName(le));
}
```

```cpp
#include <hip/hip_runtime.h>
#include <hip/hip_bf16.h>
#include <cstdio>
#include <cstdint>
#include <cmath>
namespace pg8 {
#define PG8_LAS __attribute__((address_space(3)))
typedef unsigned short bf16_t;
typedef short bf16x8 __attribute__((ext_vector_type(8)));
typedef float f32x4 __attribute__((ext_vector_type(4)));
typedef unsigned u32x4 __attribute__((ext_vector_type(4)));
constexpr int BM = 256, BK = 64, HALF = 128, HTB = HALF * BK * 2  , STAGE_BYTES = 8 * HTB, NXCD = 8, WGM = 8;

__host__ __device__ __forceinline__ int lds_byte(int r, int c) { const int st = (r >> 4) * 2 + (c >> 5), rr = r & 15, cc = c & 31, ob = rr * 64 + cc * 2; return st * 1024 + (ob ^ (((ob >> 9) & 1) << 5)); }
__host__ __device__ __forceinline__ void stage_rc(int b, int& R, int& C) { const int st = b / 1024, sb = b % 1024, swz = sb ^ (((sb >> 9) & 1) << 5); R = (st >> 1) * 16 + swz / 64; C = (st & 1) * 32 + (swz % 64) / 2; }
__host__ __device__ __forceinline__ int perm32(int rho) { const int n = rho >> 4, i = rho & 15; return 8 * (i >> 2) + 4 * n + (i & 3); }

struct Unit { int pm, pn; };
struct Gemm { const bf16_t* A; const bf16_t* Bt; int M, N, K; };

struct StaticOrder {
    int nM, nN, nwg, G, c;
    __host__ __device__ void init(int M, int N, int G_, int c_) { nM = M / BM; nN = N / BM; nwg = nM * nN; G = G_; c = c_; }
    __host__ __device__ bool next(int i, Unit& u) const {
        const long L = (long)i * G + c; if (L >= nwg) return false;
        int wgid = (int)L; { const int q = nwg / NXCD, r = nwg % NXCD, xcd = wgid % NXCD, off = wgid / NXCD; wgid = (xcd < r ? xcd * (q + 1) : r * (q + 1) + (xcd - r) * q) + off; }
        const int nig = WGM * nN, gid = wgid / nig, fm = gid * WGM, gsz = (nM - fm) < WGM ? (nM - fm) : WGM;
        u.pm = fm + ((wgid % nig) % gsz); u.pn = (wgid % nig) / gsz; return true;
    }
    __device__ __forceinline__ void a_ready(const Unit&) const {}
    __device__ __forceinline__ void done(const Unit&) const {}
};

__device__ __forceinline__ unsigned cvt_pk_bf16(float lo, float hi) { unsigned r; asm volatile("v_cvt_pk_bf16_f32 %0, %1, %2" : "=v"(r) : "v"(lo), "v"(hi)); return r; }
typedef float f32x2 __attribute__((ext_vector_type(2)));
__device__ __forceinline__ u32x4 pack8(const f32x4 v0, const f32x4 v1) { u32x4 w; w.x = cvt_pk_bf16(v0[0], v0[1]); w.y = cvt_pk_bf16(v0[2], v0[3]); w.z = cvt_pk_bf16(v1[0], v1[1]); w.w = cvt_pk_bf16(v1[2], v1[3]); return w; }

struct EpiPlainBf16 {
    static constexpr bool PERM = true, AFTER_DRAIN = false;
    bf16_t* O; int ldc;
    __device__ __forceinline__ void operator()(const f32x4 (&acc)[2][2][4][2], const Unit& u, int wr, int wc, int fr, int fq) const {
        const int row0 = u.pm * BM + wr * 64 + fr, col0 = u.pn * BM + wc * 32 + 8 * fq;
#pragma unroll
        for (int ai = 0; ai < 2; ++ai)
#pragma unroll
            for (int m = 0; m < 4; ++m) { bf16_t* rowp = O + (size_t)(row0 + ai * HALF + m * 16) * ldc + col0;
#pragma unroll
                for (int bj = 0; bj < 2; ++bj) *(u32x4*)(rowp + bj * HALF) = pack8(acc[ai][bj][m][0], acc[ai][bj][m][1]); }
    }
};
struct EpiFnet {
    static constexpr bool PERM = true, AFTER_DRAIN = false;
    bf16_t* MIX;
    __device__ __forceinline__ void operator()(const f32x4 (&acc)[2][2][4][2], const Unit& u, int wr, int wc, int fr, int fq) const {
        const int row0 = u.pn * 4096 + u.pm * BM + wr * 64 + fr, col0 = 768 + wc * 32 + 8 * fq;
#pragma unroll
        for (int ai = 0; ai < 2; ++ai)
#pragma unroll
            for (int m = 0; m < 4; ++m) { bf16_t* rowp = MIX + (size_t)(row0 + ai * HALF + m * 16) * 1024 + col0;
#pragma unroll
                for (int bj = 0; bj < 2; ++bj) *(u32x4*)(rowp + bj * HALF) = pack8(acc[ai][bj][m][0], acc[ai][bj][m][1]); }
    }
};
struct EpiResF32 {
    static constexpr bool PERM = false, AFTER_DRAIN = false;
    const float* base; float* out; int ldc; float alpha;
    __device__ __forceinline__ void operator()(const f32x4 (&acc)[2][2][4][2], const Unit& u, int wr, int wc, int fr, int fq) const {
        const int row0 = u.pm * BM + wr * 64 + fr, col0 = u.pn * BM + wc * 32 + 4 * fq;
#pragma unroll
        for (int ai = 0; ai < 2; ++ai)
#pragma unroll
            for (int m = 0; m < 4; ++m) { const size_t off = (size_t)(row0 + ai * HALF + m * 16) * ldc + col0;
#pragma unroll
                for (int bj = 0; bj < 2; ++bj)
#pragma unroll
                    for (int n = 0; n < 2; ++n) { const f32x4 b = *(const f32x4*)(base + off + bj * HALF + n * 16); *(f32x4*)(out + off + bj * HALF + n * 16) = b * alpha + acc[ai][bj][m][n]; } }
    }
};
struct EpiResBf16 {
    static constexpr bool PERM = true, AFTER_DRAIN = false;
    const bf16_t* base; bf16_t* out; int ldc; float alpha;
    __device__ __forceinline__ void operator()(const f32x4 (&acc)[2][2][4][2], const Unit& u, int wr, int wc, int fr, int fq) const {
        const int row0 = u.pm * BM + wr * 64 + fr, col0 = u.pn * BM + wc * 32 + 8 * fq;
#pragma unroll
        for (int ai = 0; ai < 2; ++ai)
#pragma unroll
            for (int m = 0; m < 4; ++m) { const size_t off = (size_t)(row0 + ai * HALF + m * 16) * ldc + col0;
#pragma unroll
                for (int bj = 0; bj < 2; ++bj) { const u32x4 b = *(const u32x4*)(base + off + bj * HALF);
                    const f32x4 b0 = {__uint_as_float(b.x << 16), __uint_as_float(b.x & 0xffff0000u), __uint_as_float(b.y << 16), __uint_as_float(b.y & 0xffff0000u)};
                    const f32x4 b1 = {__uint_as_float(b.z << 16), __uint_as_float(b.z & 0xffff0000u), __uint_as_float(b.w << 16), __uint_as_float(b.w & 0xffff0000u)};
                    *(u32x4*)(out + off + bj * HALF) = pack8(b0 * alpha + acc[ai][bj][m][0], b1 * alpha + acc[ai][bj][m][1]); } }
    }
};
__device__ __forceinline__ float swiglu1(float g, float u) { g = fminf(g, 7.0f); u = fminf(fmaxf(u, -7.0f), 7.0f); return (u + 1.0f) * g * __builtin_amdgcn_rcpf(1.0f + __expf(-1.702f * g)); }
struct EpiSwiglu {
    static constexpr bool PERM = true, AFTER_DRAIN = false;
    bf16_t* HID; const float* bgu;
    __device__ __forceinline__ void operator()(const f32x4 (&acc)[2][2][4][2], const Unit& u, int wr, int wc, int fr, int fq) const {
        const int e = u.pn >> 3, pnl = u.pn & 7; const int row0 = u.pm * BM + wr * 64 + fr, jj0 = pnl * 128 + wc * 32 + 8 * fq;
        const float* bg = bgu + (size_t)e * 2048 + jj0;
        const f32x4 bg0 = *(const f32x4*)bg, bg1 = *(const f32x4*)(bg + 4), bu0 = *(const f32x4*)(bg + 1024), bu1 = *(const f32x4*)(bg + 1028);
#pragma unroll
        for (int ai = 0; ai < 2; ++ai)
#pragma unroll
            for (int m = 0; m < 4; ++m) { bf16_t* rowp = HID + (size_t)(row0 + ai * HALF + m * 16) * 1024 + jj0;
                const f32x4 g0 = acc[ai][0][m][0] + bg0, g1 = acc[ai][0][m][1] + bg1, u0 = acc[ai][1][m][0] + bu0, u1 = acc[ai][1][m][1] + bu1;
                f32x4 h0, h1;
#pragma unroll
                for (int i = 0; i < 4; ++i) { h0[i] = swiglu1(g0[i], u0[i]); h1[i] = swiglu1(g1[i], u1[i]); }
                *(u32x4*)rowp = pack8(h0, h1); }
    }
};
struct EpiDown {
    static constexpr bool PERM = true, AFTER_DRAIN = false;
    bf16_t* Y; const float* bd;
    __device__ __forceinline__ void operator()(const f32x4 (&acc)[2][2][4][2], const Unit& u, int wr, int wc, int fr, int fq) const {
        const int e = u.pn >> 2, pnl = u.pn & 3; const int row0 = u.pm * BM + wr * 64 + fr, col0 = pnl * BM + wc * 32 + 8 * fq;
        const float* bp = bd + (size_t)e * 1024 + col0;
        f32x4 bv[2][2];
#pragma unroll
        for (int bj = 0; bj < 2; ++bj)
#pragma unroll
            for (int n = 0; n < 2; ++n) bv[bj][n] = *(const f32x4*)(bp + bj * HALF + 4 * n);
#pragma unroll
        for (int ai = 0; ai < 2; ++ai)
#pragma unroll
            for (int m = 0; m < 4; ++m) { bf16_t* rowp = Y + (size_t)(row0 + ai * HALF + m * 16) * 1024 + col0;
#pragma unroll
                for (int bj = 0; bj < 2; ++bj) *(u32x4*)(rowp + bj * HALF) = pack8(acc[ai][bj][m][0] + bv[bj][0], acc[ai][bj][m][1] + bv[bj][1]); }
    }
};
struct EpiNull {
    static constexpr bool PERM = true, AFTER_DRAIN = false;
    bf16_t* O;
    __device__ __forceinline__ void operator()(const f32x4 (&acc)[2][2][4][2], const Unit& u, int wr, int wc, int fr, int fq) const {
#pragma unroll
        for (int ai = 0; ai < 2; ++ai)
#pragma unroll
            for (int bj = 0; bj < 2; ++bj)
#pragma unroll
                for (int m = 0; m < 4; ++m)
#pragma unroll
                    for (int n = 0; n < 2; ++n) asm volatile("" :: "v"(acc[ai][bj][m][n]));
    }
};
struct ListOrder {
    const PG8_LAS int* list; int n;
    __device__ __forceinline__ bool next(int i, Unit& u) const { if (i >= n) return false; const int v = __builtin_amdgcn_readfirstlane(list[i]); u.pm = v >> 16; u.pn = v & 0xffff; return true; }
    __device__ __forceinline__ void a_ready(const Unit&) const {}
    __device__ __forceinline__ void done(const Unit&) const {}
};
template <class Epi, class Sched, bool ALIGN_EPI = false, bool SP2 = false>
__device__ __forceinline__ void gemm_phase(PG8_LAS unsigned char* lds, const Gemm g, const Sched& S, const Epi& E) {
    int tid_ = threadIdx.x; asm volatile("" : "+v"(tid_));
    const int tid = tid_, wid = __builtin_amdgcn_readfirstlane(tid >> 6), lane = tid & 63, wr = wid >> 2, wc = wid & 3, fr = lane & 15, fq = lane >> 4;
    const int K = g.K, nt = K / BK;
    unsigned voffA[2], voffB[2];
#pragma unroll
    for (int i = 0; i < 2; ++i) { int R, C; stage_rc(tid * 16 + i * 8192, R, C); const int Rb = Epi::PERM ? ((R & ~31) + perm32(R & 31)) : R;
        voffA[i] = (unsigned)(R * K + C) * 2u; voffB[i] = (unsigned)(Rb * K + C) * 2u; }
    const size_t kstep = (size_t)(BK * 2);
    const size_t hstep = (size_t)HALF * K * 2;
    const size_t tstep = 2 * hstep;
    const unsigned ldsw = (unsigned)wid * 1024u;
    const int aoff = lds_byte(wr * 64 + fr, fq * 8), boff = lds_byte(wc * 32 + fr, fq * 8);
#define PG8_SA(b, h) (((b) * 2 + (h)) * HTB)
#define PG8_SB(b, h) ((4 + (b) * 2 + (h)) * HTB)
#define PG8_STAGE(bufoff, gbase, voff) do { _Pragma("unroll") for (int _i = 0; _i < 2; ++_i) \
        __builtin_amdgcn_global_load_lds((const unsigned*)((const char*)(gbase) + (voff)[_i]), (PG8_LAS unsigned*)(lds + (bufoff) + ldsw + _i * 8192), 16, 0, 0); } while (0)
#define PG8_LDA(dst, b, h) do { _Pragma("unroll") for (int m = 0; m < 4; ++m) _Pragma("unroll") for (int k = 0; k < 2; ++k) dst[m][k] = *(const PG8_LAS bf16x8*)(lds + PG8_SA(b, h) + aoff + m * 2048 + k * 1024); } while (0)
#define PG8_LDB(dst, b, h) do { _Pragma("unroll") for (int n = 0; n < 2; ++n) _Pragma("unroll") for (int k = 0; k < 2; ++k) dst[n][k] = *(const PG8_LAS bf16x8*)(lds + PG8_SB(b, h) + boff + n * 2048 + k * 1024); } while (0)
#define PG8_MMA(ai, bj, At, Bt) do { __builtin_amdgcn_s_setprio(1); _Pragma("unroll") for (int m = 0; m < 4; ++m) _Pragma("unroll") for (int n = 0; n < 2; ++n) _Pragma("unroll") for (int k = 0; k < 2; ++k) \
        acc[ai][bj][m][n] = __builtin_amdgcn_mfma_f32_16x16x32_bf16(Bt[n][k], At[m][k], acc[ai][bj][m][n], 0, 0, 0); __builtin_amdgcn_s_setprio(0); } while (0)
#define PG8_WAIT_V(n) asm volatile("s_waitcnt vmcnt(" #n ")" ::: "memory")
#define PG8_WAIT_L(n) asm volatile("s_waitcnt lgkmcnt(" #n ")" ::: "memory")
#define PG8_BAR __builtin_amdgcn_s_barrier()
#define PG8_SCHED __builtin_amdgcn_sched_barrier(0)
    Unit cur, nxt; int ui = 0;
    if (!S.next(0, cur)) return;
    f32x4 acc[2][2][4][2];
#pragma unroll
    for (int a = 0; a < 2; ++a)
#pragma unroll
        for (int b = 0; b < 2; ++b)
#pragma unroll
            for (int m = 0; m < 4; ++m)
#pragma unroll
                for (int n = 0; n < 2; ++n) acc[a][b][m][n] = (f32x4){0.f, 0.f, 0.f, 0.f};
    bf16x8 At[4][2], B0[2][2], B1[2][2];
    const char* cA = (const char*)g.A + (size_t)cur.pm * tstep; const char* cB = (const char*)g.Bt + (size_t)cur.pn * tstep;
    S.a_ready(cur);
    if constexpr (SP2) {
        PG8_STAGE(PG8_SB(0, 0), cB, voffB); PG8_STAGE(PG8_SB(0, 1), cB + hstep, voffB); PG8_STAGE(PG8_SA(0, 0), cA, voffA); PG8_STAGE(PG8_SA(0, 1), cA + hstep, voffA);
        if (wr == 1) PG8_BAR;
        PG8_WAIT_V(2); PG8_BAR;
        PG8_STAGE(PG8_SB(1, 0), cB + kstep, voffB); PG8_STAGE(PG8_SA(1, 0), cA + kstep, voffA); PG8_STAGE(PG8_SB(1, 1), cB + hstep + kstep, voffB);
        PG8_WAIT_V(6); PG8_BAR;
    } else {
        PG8_STAGE(PG8_SB(0, 0), cB, voffB); PG8_STAGE(PG8_SA(0, 0), cA, voffA); PG8_STAGE(PG8_SB(0, 1), cB + hstep, voffB); PG8_STAGE(PG8_SA(0, 1), cA + hstep, voffA);
        if (wr == 1) PG8_BAR;
        PG8_WAIT_V(4); PG8_BAR;
        PG8_STAGE(PG8_SB(1, 0), cB + kstep, voffB); PG8_STAGE(PG8_SA(1, 0), cA + kstep, voffA); PG8_STAGE(PG8_SB(1, 1), cB + hstep + kstep, voffB);
        PG8_WAIT_V(6); PG8_BAR;
    }
    for (;;) {
        const bool has_next = S.next(ui + 1, nxt);
        const char* nA = has_next ? (const char*)g.A + (size_t)nxt.pm * tstep : cA; const char* nB = has_next ? (const char*)g.Bt + (size_t)nxt.pn * tstep : cB;
        for (int t = 0; t < nt; t += 2) {
            const bool last = (t == nt - 2);
            const char* a1 = cA + (size_t)(t + 1) * kstep;
            const char* a2 = last ? nA : cA + (size_t)(t + 2) * kstep; const char* b2 = last ? nB : cB + (size_t)(t + 2) * kstep;
            const char* a3 = a2 + kstep; const char* b3 = b2 + kstep;
            if (last && has_next) S.a_ready(nxt);
            if constexpr (SP2) {
            PG8_LDB(B0, 0, 0); PG8_LDB(B1, 0, 1); PG8_SCHED; PG8_LDA(At, 0, 0); PG8_STAGE(PG8_SA(1, 1), a1 + hstep, voffA);
            PG8_WAIT_V(8); PG8_WAIT_L(0); PG8_BAR; PG8_MMA(0, 0, At, B0); PG8_MMA(0, 1, At, B1); PG8_BAR; PG8_SCHED;
            PG8_LDA(At, 0, 1); PG8_STAGE(PG8_SB(0, 0), b2, voffB); PG8_STAGE(PG8_SB(0, 1), b2 + hstep, voffB); PG8_STAGE(PG8_SA(0, 0), a2, voffA);
            PG8_WAIT_V(8); PG8_WAIT_L(0); PG8_BAR; PG8_MMA(1, 0, At, B0); PG8_MMA(1, 1, At, B1); PG8_BAR; PG8_SCHED;
            PG8_LDB(B0, 1, 0); PG8_LDB(B1, 1, 1); PG8_SCHED; PG8_LDA(At, 1, 0); PG8_STAGE(PG8_SA(0, 1), a2 + hstep, voffA);
            PG8_WAIT_V(8); PG8_WAIT_L(0); PG8_BAR; PG8_MMA(0, 0, At, B0); PG8_MMA(0, 1, At, B1); PG8_BAR; PG8_SCHED;
            PG8_LDA(At, 1, 1); PG8_STAGE(PG8_SB(1, 0), b3, voffB); PG8_STAGE(PG8_SB(1, 1), b3 + hstep, voffB); PG8_STAGE(PG8_SA(1, 0), a3, voffA);
            PG8_WAIT_V(8); PG8_WAIT_L(0); PG8_BAR; PG8_MMA(1, 0, At, B0); PG8_MMA(1, 1, At, B1); PG8_BAR; PG8_SCHED;
            } else {
            PG8_LDB(B0, 0, 0); PG8_SCHED; PG8_LDA(At, 0, 0); PG8_STAGE(PG8_SA(1, 1), a1 + hstep, voffA);
            PG8_WAIT_L(8); PG8_BAR; PG8_WAIT_L(0); PG8_MMA(0, 0, At, B0); PG8_BAR; PG8_SCHED;
            PG8_LDB(B1, 0, 1); PG8_STAGE(PG8_SB(0, 0), b2, voffB);
            PG8_BAR; PG8_WAIT_L(0); PG8_MMA(0, 1, At, B1); PG8_BAR;
            PG8_LDA(At, 0, 1); PG8_STAGE(PG8_SA(0, 0), a2, voffA);
            PG8_BAR; PG8_WAIT_L(0); PG8_MMA(1, 0, At, B0); PG8_BAR; PG8_SCHED;
            PG8_STAGE(PG8_SB(0, 1), b2 + hstep, voffB);
            PG8_WAIT_V(6); PG8_BAR; PG8_MMA(1, 1, At, B1); PG8_BAR;
            PG8_LDB(B0, 1, 0); PG8_SCHED; PG8_LDA(At, 1, 0); PG8_STAGE(PG8_SA(0, 1), a2 + hstep, voffA);
            PG8_WAIT_L(8); PG8_BAR; PG8_WAIT_L(0); PG8_MMA(0, 0, At, B0); PG8_BAR; PG8_SCHED;
            PG8_LDB(B1, 1, 1); PG8_STAGE(PG8_SB(1, 0), b3, voffB);
            PG8_BAR; PG8_WAIT_L(0); PG8_MMA(0, 1, At, B1); PG8_BAR;
            PG8_LDA(At, 1, 1); PG8_STAGE(PG8_SA(1, 0), a3, voffA);
            PG8_BAR; PG8_WAIT_L(0); PG8_MMA(1, 0, At, B0); PG8_BAR; PG8_SCHED;
            PG8_STAGE(PG8_SB(1, 1), b3 + hstep, voffB);
            PG8_WAIT_V(6); PG8_BAR; PG8_MMA(1, 1, At, B1); PG8_BAR;
            }
        }
        if constexpr (ALIGN_EPI) { if (wr == 0) PG8_BAR; }
        if constexpr (!Epi::AFTER_DRAIN) { E(acc, cur, wr, wc, fr, fq); S.done(cur); }
        if (!has_next) break;
#pragma unroll
        for (int a = 0; a < 2; ++a)
#pragma unroll
            for (int b = 0; b < 2; ++b)
#pragma unroll
                for (int m = 0; m < 4; ++m)
#pragma unroll
                    for (int n = 0; n < 2; ++n) acc[a][b][m][n] = (f32x4){0.f, 0.f, 0.f, 0.f};
        cur = nxt; cA = nA; cB = nB; ++ui;
        if constexpr (ALIGN_EPI) { if (wr == 1) PG8_BAR; }
    }
    PG8_WAIT_V(0);
    if constexpr (!ALIGN_EPI) { if (wr == 0) PG8_BAR; }
    PG8_BAR;
    if constexpr (Epi::AFTER_DRAIN) { E.fused(acc, cur, wr, wc, fr, fq, lds, wid, lane); S.done(cur); }
#undef PG8_SA
#undef PG8_SB
#undef PG8_STAGE
#undef PG8_LDA
#undef PG8_LDB
#undef PG8_MMA
#undef PG8_WAIT_V
#undef PG8_WAIT_L
#undef PG8_BAR
#undef PG8_SCHED
}
}
namespace pg8 {
template <class Epi, class Sched, bool ALIGN_EPI>
__device__ __forceinline__ void gemm_phase_gather(PG8_LAS unsigned char* lds, const Gemm g, const Sched& S, const Epi& E, const PG8_LAS unsigned short* rows16) {
    int tid_ = threadIdx.x; asm volatile("" : "+v"(tid_));
    const int tid = tid_, wid = __builtin_amdgcn_readfirstlane(tid >> 6), lane = tid & 63, wr = wid >> 2, wc = wid & 3, fr = lane & 15, fq = lane >> 4;
    const int K = g.K, nt = K / BK;
    unsigned voffB[2]; int RA[2]; unsigned CA2[2];
#pragma unroll
    for (int i = 0; i < 2; ++i) { int R, C; stage_rc(tid * 16 + i * 8192, R, C); const int Rb = Epi::PERM ? ((R & ~31) + perm32(R & 31)) : R;
        RA[i] = R; CA2[i] = (unsigned)C * 2u; voffB[i] = (unsigned)(Rb * K + C) * 2u; }
    const size_t kstep = (size_t)(BK * 2);
    const size_t hstep = (size_t)HALF * K * 2;
    const size_t tstep = 2 * hstep;
    const unsigned ldsw = (unsigned)wid * 1024u;
    const unsigned rowb = (unsigned)K * 2u;
    const int aoff = lds_byte(wr * 64 + fr, fq * 8), boff = lds_byte(wc * 32 + fr, fq * 8);
#define PG8_SA(b, h) (((b) * 2 + (h)) * HTB)
#define PG8_SB(b, h) ((4 + (b) * 2 + (h)) * HTB)
#define PG8_STAGE(bufoff, gbase, voff) do { _Pragma("unroll") for (int _i = 0; _i < 2; ++_i) \
        __builtin_amdgcn_global_load_lds((const unsigned*)((const char*)(gbase) + (voff)[_i]), (PG8_LAS unsigned*)(lds + (bufoff) + ldsw + _i * 8192), 16, 0, 0); } while (0)
#define PG8_LDA(dst, b, h) do { _Pragma("unroll") for (int m = 0; m < 4; ++m) _Pragma("unroll") for (int k = 0; k < 2; ++k) dst[m][k] = *(const PG8_LAS bf16x8*)(lds + PG8_SA(b, h) + aoff + m * 2048 + k * 1024); } while (0)
#define PG8_LDB(dst, b, h) do { _Pragma("unroll") for (int n = 0; n < 2; ++n) _Pragma("unroll") for (int k = 0; k < 2; ++k) dst[n][k] = *(const PG8_LAS bf16x8*)(lds + PG8_SB(b, h) + boff + n * 2048 + k * 1024); } while (0)
#define PG8_MMA(ai, bj, At, Bt) do { __builtin_amdgcn_s_setprio(1); _Pragma("unroll") for (int m = 0; m < 4; ++m) _Pragma("unroll") for (int n = 0; n < 2; ++n) _Pragma("unroll") for (int k = 0; k < 2; ++k) \
        acc[ai][bj][m][n] = __builtin_amdgcn_mfma_f32_16x16x32_bf16(Bt[n][k], At[m][k], acc[ai][bj][m][n], 0, 0, 0); __builtin_amdgcn_s_setprio(0); } while (0)
#define PG8_WAIT_V(n) asm volatile("s_waitcnt vmcnt(" #n ")" ::: "memory")
#define PG8_WAIT_L(n) asm volatile("s_waitcnt lgkmcnt(" #n ")" ::: "memory")
#define PG8_BAR __builtin_amdgcn_s_barrier()
#define PG8_SCHED __builtin_amdgcn_sched_barrier(0)
#define PG8_GOFF(dst, U) do { _Pragma("unroll") for (int h_ = 0; h_ < 2; ++h_) _Pragma("unroll") for (int i_ = 0; i_ < 2; ++i_) dst[h_][i_] = (unsigned)rows16[(U) * 256 + h_ * HALF + RA[i_]] * rowb + CA2[i_]; } while (0)
    Unit cur, nxt; int ui = 0;
    if (!S.next(0, cur)) return;
    f32x4 acc[2][2][4][2];
#pragma unroll
    for (int a = 0; a < 2; ++a)
#pragma unroll
        for (int b = 0; b < 2; ++b)
#pragma unroll
            for (int m = 0; m < 4; ++m)
#pragma unroll
                for (int n = 0; n < 2; ++n) acc[a][b][m][n] = (f32x4){0.f, 0.f, 0.f, 0.f};
    bf16x8 At[4][2], B0[2][2], B1[2][2];
    const char* const Ab = (const char*)g.A;
    const char* cB = (const char*)g.Bt + (size_t)cur.pn * tstep;
    unsigned gc[2][2], gn[2][2];
    PG8_GOFF(gc, 0);
    S.a_ready(cur);
    PG8_STAGE(PG8_SB(0, 0), cB, voffB); PG8_STAGE(PG8_SB(0, 1), cB + hstep, voffB); PG8_STAGE(PG8_SA(0, 0), Ab, gc[0]); PG8_STAGE(PG8_SA(0, 1), Ab, gc[1]);
    if (wr == 1) PG8_BAR;
    PG8_WAIT_V(2); PG8_BAR;
    PG8_STAGE(PG8_SB(1, 0), cB + kstep, voffB); PG8_STAGE(PG8_SA(1, 0), Ab + kstep, gc[0]); PG8_STAGE(PG8_SB(1, 1), cB + hstep + kstep, voffB);
    PG8_WAIT_V(6); PG8_BAR;
    for (;;) {
        const bool has_next = S.next(ui + 1, nxt);
        const char* nB = has_next ? (const char*)g.Bt + (size_t)nxt.pn * tstep : cB;
        if (has_next) { PG8_GOFF(gn, ui + 1); } else {
#pragma unroll
            for (int h_ = 0; h_ < 2; ++h_)
#pragma unroll
                for (int i_ = 0; i_ < 2; ++i_) gn[h_][i_] = gc[h_][i_]; }
        for (int t = 0; t < nt; t += 2) {
            const bool last = (t == nt - 2);
            const char* a1 = Ab + (size_t)(t + 1) * kstep;
            const char* a2 = last ? Ab : Ab + (size_t)(t + 2) * kstep; const char* b2 = last ? nB : cB + (size_t)(t + 2) * kstep;
            const char* a3 = a2 + kstep; const char* b3 = b2 + kstep;
            unsigned g2[2][2];
#pragma unroll
            for (int h_ = 0; h_ < 2; ++h_)
#pragma unroll
                for (int i_ = 0; i_ < 2; ++i_) g2[h_][i_] = last ? gn[h_][i_] : gc[h_][i_];
            if (last && has_next) S.a_ready(nxt);
            PG8_LDB(B0, 0, 0); PG8_LDB(B1, 0, 1); PG8_SCHED; PG8_LDA(At, 0, 0); PG8_STAGE(PG8_SA(1, 1), a1, gc[1]);
            PG8_WAIT_V(8); PG8_WAIT_L(0); PG8_BAR; PG8_MMA(0, 0, At, B0); PG8_MMA(0, 1, At, B1); PG8_BAR; PG8_SCHED;
            PG8_LDA(At, 0, 1); PG8_STAGE(PG8_SB(0, 0), b2, voffB); PG8_STAGE(PG8_SB(0, 1), b2 + hstep, voffB); PG8_STAGE(PG8_SA(0, 0), a2, g2[0]);
            PG8_WAIT_V(8); PG8_WAIT_L(0); PG8_BAR; PG8_MMA(1, 0, At, B0); PG8_MMA(1, 1, At, B1); PG8_BAR; PG8_SCHED;
            PG8_LDB(B0, 1, 0); PG8_LDB(B1, 1, 1); PG8_SCHED; PG8_LDA(At, 1, 0); PG8_STAGE(PG8_SA(0, 1), a2, g2[1]);
            PG8_WAIT_V(8); PG8_WAIT_L(0); PG8_BAR; PG8_MMA(0, 0, At, B0); PG8_MMA(0, 1, At, B1); PG8_BAR; PG8_SCHED;
            PG8_LDA(At, 1, 1); PG8_STAGE(PG8_SB(1, 0), b3, voffB); PG8_STAGE(PG8_SB(1, 1), b3 + hstep, voffB); PG8_STAGE(PG8_SA(1, 0), a3, g2[0]);
            PG8_WAIT_V(8); PG8_WAIT_L(0); PG8_BAR; PG8_MMA(1, 0, At, B0); PG8_MMA(1, 1, At, B1); PG8_BAR; PG8_SCHED;
        }
        if constexpr (ALIGN_EPI) { if (wr == 0) PG8_BAR; }
        E(acc, cur, wr, wc, fr, fq); S.done(cur);
        if (!has_next) break;
#pragma unroll
        for (int a = 0; a < 2; ++a)
#pragma unroll
            for (int b = 0; b < 2; ++b)
#pragma unroll
                for (int m = 0; m < 4; ++m)
#pragma unroll
                    for (int n = 0; n < 2; ++n) acc[a][b][m][n] = (f32x4){0.f, 0.f, 0.f, 0.f};
        cur = nxt; cB = nB; ++ui;
#pragma unroll
        for (int h_ = 0; h_ < 2; ++h_)
#pragma unroll
            for (int i_ = 0; i_ < 2; ++i_) gc[h_][i_] = gn[h_][i_];
        if constexpr (ALIGN_EPI) { if (wr == 1) PG8_BAR; }
    }
    PG8_WAIT_V(0);
    if constexpr (!ALIGN_EPI) { if (wr == 0) PG8_BAR; }
    PG8_BAR;
#undef PG8_SA
#undef PG8_SB
#undef PG8_STAGE
#undef PG8_LDA
#undef PG8_LDB
#undef PG8_MMA
#undef PG8_WAIT_V
#undef PG8_WAIT_L
#undef PG8_BAR
#undef PG8_SCHED
#undef PG8_GOFF
}
}
#define GAS __attribute__((address_space(1)))
#define LAS __attribute__((address_space(3)))
typedef unsigned short bf16;
typedef unsigned v4u __attribute__((ext_vector_type(4)));
typedef float f32x4 __attribute__((ext_vector_type(4)));
typedef short bf16x8 __attribute__((ext_vector_type(8)));
typedef GAS unsigned gu32;
typedef GAS unsigned long long gu64;
#define RLX_AGENT __ATOMIC_RELAXED, __HIP_MEMORY_SCOPE_AGENT
#define LDS_WAIT() asm volatile("s_waitcnt lgkmcnt(0)" ::: "memory")
#define VM_WAIT() asm volatile("s_waitcnt vmcnt(0)" ::: "memory")
__device__ __forceinline__ unsigned long long rt() { return __builtin_amdgcn_s_memrealtime(); }
__device__ __forceinline__ unsigned f2bf(float f) { unsigned u = __builtin_bit_cast(unsigned, f); return (u + 0x7fffu + ((u >> 16) & 1u)) >> 16; }
__device__ __forceinline__ unsigned pk2(float lo, float hi) { return f2bf(lo) | (f2bf(hi) << 16); }
#define XB_TMO      128
#define XB_XCNT(j)  (256  + 64 * (j))
#define XB_XSUB(j)  (1280 + 64 * (j))
#define XB_XGEN(j)  (2304 + 64 * (j))
#define XB_TOP      3328
#define XB_TOPGEN   3392
#define XCD_BAR_WORDS 3456
#define XB_SPIN_CAP (1u << 18)

__device__ __forceinline__ unsigned xb_ld(unsigned* p)              { return __hip_atomic_load(p, __ATOMIC_RELAXED, __HIP_MEMORY_SCOPE_AGENT); }
__device__ __forceinline__ unsigned xb_add(unsigned* p, unsigned v) { return __hip_atomic_fetch_add(p, v, __ATOMIC_RELAXED, __HIP_MEMORY_SCOPE_AGENT); }
__device__ __forceinline__ unsigned xb_xcc_id() { return (unsigned)__builtin_amdgcn_s_getreg((3 << 11) | 20) & 0xFu; }
#define XB_SPIN(cond, bar) do { unsigned _sp = 0; while (cond) { __builtin_amdgcn_s_sleep(1); \
    if ((++_sp & 255u) == 0u) { if (xb_ld(&(bar)[XB_TMO])) break; if (_sp > XB_SPIN_CAP) { atomicAdd(&(bar)[XB_TMO], 1u); break; } } } } while (0)

struct XcdBarrier {
    unsigned* bar; unsigned x;
    volatile LAS unsigned* st;
};

__device__ __forceinline__ XcdBarrier xcd_barrier_post(unsigned* bar, volatile LAS unsigned* st) {
    XcdBarrier b; b.bar = bar; b.x = xb_xcc_id(); b.st = st;
    if (threadIdx.x == 0) (void)xb_add(&bar[XB_XCNT(b.x)], 1u);
    return b;
}
__device__ __forceinline__ void xcd_barrier_complete(unsigned* bar, unsigned x, unsigned& nloc, unsigned& nx) {
    const unsigned G = gridDim.x * gridDim.y * gridDim.z;
    unsigned sum, cnt, mine, sp = 0u;
    for (;;) {
        sum = 0u; cnt = 0u; mine = 0u;
#pragma unroll
        for (unsigned j = 0; j < 16; ++j) { const unsigned c = xb_ld(&bar[XB_XCNT(j)]); sum += c; cnt += (c > 0u) ? 1u : 0u; mine = (j == x) ? c : mine; }
        if (sum == G) break;
        __builtin_amdgcn_s_sleep(1);
        if ((++sp & 255u) == 0u) { if (xb_ld(&bar[XB_TMO])) break; if (sp > XB_SPIN_CAP) { atomicAdd(&bar[XB_TMO], 1u); break; } }
    }
    nloc = mine > 0u ? mine : 1u; nx = cnt > 0u ? cnt : 1u;
}

__device__ __forceinline__ void xcd_barrier(const XcdBarrier& b) {
    asm volatile("s_waitcnt vmcnt(0)" ::: "memory");
    __syncthreads();
    if (threadIdx.x == 0) {
        unsigned* bar = b.bar;
        __builtin_amdgcn_s_waitcnt(0);
        unsigned nloc = b.st[0], nx = b.st[1];
        if (nloc == 0u) { xcd_barrier_complete(bar, b.x, nloc, nx); b.st[0] = nloc; b.st[1] = nx; }
        const unsigned old = xb_add(&bar[XB_XSUB(b.x)], 1u);
        const unsigned gen = old / nloc;
        if (old + 1u == (gen + 1u) * nloc) {
            __builtin_amdgcn_fence(__ATOMIC_RELEASE, "agent");
            asm volatile("s_waitcnt vmcnt(0)" ::: "memory");
            const unsigned og = xb_add(&bar[XB_TOP], 1u);
            const unsigned tg = og / nx;
            if (og + 1u == (tg + 1u) * nx) xb_add(&bar[XB_TOPGEN], 1u);
            else XB_SPIN(xb_ld(&bar[XB_TOPGEN]) == tg, bar);
            __builtin_amdgcn_fence(__ATOMIC_ACQUIRE, "agent");
            xb_add(&bar[XB_XGEN(b.x)], 1u);
            asm volatile("s_waitcnt vmcnt(0)" ::: "memory");
        } else {
            XB_SPIN(xb_ld(&bar[XB_XGEN(b.x)]) == gen, bar);
            __builtin_amdgcn_fence(__ATOMIC_ACQUIRE, "agent");
            asm volatile("s_waitcnt vmcnt(0)" ::: "memory");
        }
    }
    __syncthreads();
}
namespace attn_body {
using bf16=__hip_bfloat16;
using bf16x8=__attribute__((ext_vector_type(8)))short;
using s16x4=__attribute__((ext_vector_type(4)))short;
using f32x16=__attribute__((ext_vector_type(16)))float;
using u32x4=__attribute__((ext_vector_type(4)))unsigned;
constexpr int BATCH=8,NHEAD=8,NKVH=2,SEQ=4096,D=64;
constexpr int DMQ=512,DMK=128,DMV=2048,DMO=1024;
constexpr int NW=8,QBLK=32,QB=QBLK*NW,KVBLK=64,NQB=SEQ/QB;
constexpr int ATTN_UNIT_ROWS=QB;
__device__ __forceinline__ int crow(int r,int hi){return (r&3)+8*(r>>2)+4*hi;}
#define SBAR() __builtin_amdgcn_sched_barrier(0)
__device__ __forceinline__ void cmask(f32x16&p0,f32x16&p1,int jb,int qrel,int hi){
  const float NEG=-INFINITY; int kb=64*jb+4*hi;
  #pragma unroll
  for(int r=0;r<16;++r){int kv=kb+(r&3)+8*(r>>2); if(kv>qrel)p0[r]=NEG; if(kv+32>qrel)p1[r]=NEG;}
}

constexpr int NSLOT=3, SLOTB=8192;
constexpr int LDS_K=0, LDS_V=NSLOT*SLOTB, LDS_WS=2*NSLOT*SLOTB, LDS_OST=LDS_WS+NW*64*4, LDS_BYTES=LDS_OST+NW*4096;
constexpr float C2=0.125f*1.4426950408889634f;
__device__ __forceinline__ void glds16(const void*gsrc,unsigned lds_dst){unsigned keep;
  asm volatile("s_mov_b32 %0, m0\n\ts_mov_b32 m0, %2\n\ts_nop 0\n\tglobal_load_lds_dwordx4 %1, off\n\ts_mov_b32 m0, %0":"=&s"(keep):"v"(gsrc),"s"(lds_dst):"memory");}
__device__ __forceinline__ float max3f(float a,float b,float c){float r;asm("v_max3_f32 %0, %1, %2, %3":"=v"(r):"v"(a),"v"(b),"v"(c));return r;}
__device__ __forceinline__ float max2f(float a,float b){float r;asm("v_max_f32_e32 %0, %1, %2":"=v"(r):"v"(a),"v"(b));return r;}
__device__ __forceinline__ float fadd_s(float a,float b){float r;asm("v_add_f32_e32 %0, %1, %2":"=v"(r):"v"(a),"v"(b));return r;}
__device__ __forceinline__ float fsub_s(float a,float b){float r;asm("v_sub_f32_e32 %0, %1, %2":"=v"(r):"v"(a),"v"(b));return r;}
typedef float f32x2_t __attribute__((ext_vector_type(2))); typedef __bf16 bf16x2_t __attribute__((ext_vector_type(2)));
__device__ __forceinline__ unsigned cvtpk_s(float lo,float hi){f32x2_t v={lo,hi};bf16x2_t b=__builtin_convertvector(v,bf16x2_t);return __builtin_bit_cast(unsigned,b);}
#define WAIT_BAR(N) asm volatile("s_waitcnt vmcnt(" #N ") lgkmcnt(0)\n\ts_barrier":::"memory")

__device__ __forceinline__ void qkt(f32x16&p0,f32x16&p1,const char*Kslot,const bf16x8*qr,const f32x16&negm,int r32,int hi){
  const char*kb=Kslot+hi*1024+r32*16;
  #pragma unroll
  for(int d0=0;d0<4;++d0){
    const bf16x8 b0=*reinterpret_cast<const bf16x8*>(kb+d0*2048);
    const bf16x8 b1=*reinterpret_cast<const bf16x8*>(kb+d0*2048+512);
    if(d0==0){p0=__builtin_amdgcn_mfma_f32_32x32x16_bf16(b0,qr[0],negm,0,0,0);p1=__builtin_amdgcn_mfma_f32_32x32x16_bf16(b1,qr[0],negm,0,0,0);}
    else{p0=__builtin_amdgcn_mfma_f32_32x32x16_bf16(b0,qr[d0],p0,0,0,0);p1=__builtin_amdgcn_mfma_f32_32x32x16_bf16(b1,qr[d0],p1,0,0,0);}}
}
typedef __attribute__((address_space(3))) const char* lds_cptr;
typedef short v4i16_t __attribute__((ext_vector_type(4)));
__device__ __forceinline__ void kload8(bf16x8*kf,lds_cptr kp){
  kf[0]=*(const __attribute__((address_space(3))) bf16x8*)(kp);      kf[1]=*(const __attribute__((address_space(3))) bf16x8*)(kp+512);
  kf[2]=*(const __attribute__((address_space(3))) bf16x8*)(kp+2048); kf[3]=*(const __attribute__((address_space(3))) bf16x8*)(kp+2560);
  kf[4]=*(const __attribute__((address_space(3))) bf16x8*)(kp+4096); kf[5]=*(const __attribute__((address_space(3))) bf16x8*)(kp+4608);
  kf[6]=*(const __attribute__((address_space(3))) bf16x8*)(kp+6144); kf[7]=*(const __attribute__((address_space(3))) bf16x8*)(kp+6656);
}
__device__ __forceinline__ void kload2(bf16x8*kf,lds_cptr kp,int j){ kf[2*j]=*(const __attribute__((address_space(3))) bf16x8*)(kp+j*2048); kf[2*j+1]=*(const __attribute__((address_space(3))) bf16x8*)(kp+j*2048+512); }
__device__ __forceinline__ s16x4 vtr(lds_cptr p){ return __builtin_bit_cast(s16x4,__builtin_amdgcn_ds_read_tr16_b64_v4i16((__attribute__((address_space(3))) v4i16_t*)p)); }
__device__ __forceinline__ float rowmax(const f32x16&p0,const f32x16&p1){
  float a=max3f(p0[0],p0[1],p1[0]),b=max3f(p0[2],p0[3],p1[1]);a=max3f(a,p1[2],p1[3]);
  #pragma unroll
  for(int r=4;r<16;r+=4){a=max3f(a,p0[r],p0[r+1]);b=max3f(b,p0[r+2],p0[r+3]);a=max3f(a,p1[r],p1[r+1]);b=max3f(b,p1[r+2],p1[r+3]);}
  const float m=max2f(a,b);
  auto rr=__builtin_amdgcn_permlane32_swap(__float_as_uint(m),__float_as_uint(m),false,false);
  return max2f(__uint_as_float(rr[0]),__uint_as_float(rr[1]));
}
__device__ __forceinline__ void pv(f32x16*o,int vb,bf16x8 pa0,bf16x8 pa1,bf16x8 pa2,bf16x8 pa3){
  #pragma unroll
  for(int d0=0;d0<2;++d0){s16x4 lo[4],hi[4];
    #pragma unroll
    for(int ks=0;ks<4;++ks){
      asm volatile("ds_read_b64_tr_b16 %0,%1 offset:%c2":"=&v"(lo[ks]):"v"(vb),"i"(d0*4096+ks*1024):"memory");
      asm volatile("ds_read_b64_tr_b16 %0,%1 offset:%c2":"=&v"(hi[ks]):"v"(vb),"i"(d0*4096+ks*1024+512):"memory");}
    asm volatile("s_waitcnt lgkmcnt(0)":::"memory");SBAR();
    #define PK(k) (bf16x8){lo[k][0],lo[k][1],lo[k][2],lo[k][3],hi[k][0],hi[k][1],hi[k][2],hi[k][3]}
    o[d0]=__builtin_amdgcn_mfma_f32_32x32x16_bf16(pa0,PK(0),o[d0],0,0,0);
    o[d0]=__builtin_amdgcn_mfma_f32_32x32x16_bf16(pa1,PK(1),o[d0],0,0,0);
    o[d0]=__builtin_amdgcn_mfma_f32_32x32x16_bf16(pa2,PK(2),o[d0],0,0,0);
    o[d0]=__builtin_amdgcn_mfma_f32_32x32x16_bf16(pa3,PK(3),o[d0],0,0,0);
    #undef PK
  }
}

#ifndef ATTN_STORE16
#define ATTN_STORE16(p,v) (*(u32x4*)(p)=(v))
#endif
template<int THRL> __device__ __forceinline__ void attn_unit(int b,int h,int qb,const bf16*Q,const bf16*__restrict__ K,const bf16*__restrict__ V,bf16*O,char*shm){
  int tid_=threadIdx.x; asm volatile("":"+v"(tid_)); const int tid=tid_,lane=tid&63,r32=lane&31,hi=lane>>5; const int wid=__builtin_amdgcn_readfirstlane(tid>>6);
  const long rowbase=(long)b*SEQ; const int q0=qb*QB;
  const bf16*Qw=Q+(rowbase+q0+wid*QBLK)*DMQ+h*D; const int kvh=h>>2;
  const bf16*Kh=K+rowbase*DMK+kvh*D,*Vh=V+rowbase*DMV+kvh*D;
  const unsigned lds0=(unsigned)(uintptr_t)shm;
  float*wsf=(float*)(shm+LDS_WS)+wid*64;
  const bf16*ksrc=Kh+(long)lane*DMK+wid*8;
  const bf16*vsrc=Vh+(long)(16*(wid&3)+(lane>>2))*DMV+(wid>>2)*32+(lane&3)*8;
  const unsigned kdst=lds0+LDS_K+wid*1024, vdst=lds0+LDS_V+wid*1024;
  #define DMA_K(t,slot) glds16(ksrc+(long)(t)*KVBLK*DMK,(unsigned)__builtin_amdgcn_readfirstlane(kdst+(slot)))
  #define DMA_V(t,slot) glds16(vsrc+(long)(t)*KVBLK*DMV,(unsigned)__builtin_amdgcn_readfirstlane(vdst+(slot)))
  const int vb0=(int)(lds0+LDS_V)+((lane>>4)&1)*32+(lane&3)*8+(4*hi+((lane&15)>>2))*64;
  const char*Kbase=shm+LDS_K; bf16x8 kf[8];
  const lds_cptr shm3=(lds_cptr)shm; const lds_cptr kp0=shm3+LDS_K+hi*1024+r32*16; const lds_cptr vp0=shm3+LDS_V+((lane>>4)&1)*32+(lane&3)*8+(4*hi+((lane&15)>>2))*64;
  constexpr int NT=SEQ/KVBLK;
  DMA_K(0,0);DMA_V(0,0);DMA_K(1,SLOTB);
  bf16x8 qr[4];
  #pragma unroll
  for(int d0=0;d0<4;++d0)qr[d0]=*reinterpret_cast<const bf16x8*>(&Qw[(long)r32*DMQ+d0*16+hi*8]);
  float mhat=0.f,l_reg=0.f;f32x16 o[2];o[0]=f32x16{};o[1]=f32x16{};f32x16 negm=f32x16{};asm volatile("":"+v"(negm));
  #define CMASK(P0,P1,t) do{}while(0)
  bool resc=false;
  #define START(P0,P1) do{ const float rm=rowmax(P0,P1); resc=false; \
    { const float dl=rm; mhat=fadd_s(mhat,dl); \
      _Pragma("unroll") for(int r=0;r<16;++r){P0[r]=fsub_s(P0[r],dl);P1[r]=fsub_s(P1[r],dl);} \
      _Pragma("unroll") for(int r=0;r<16;++r)negm[r]=-mhat; asm volatile("":"+v"(negm)); } \
    _Pragma("unroll") for(int r=0;r<16;++r)P0[r]=__builtin_amdgcn_exp2f(P0[r]); }while(0)
  #define RESC() do{ if(resc){ asm volatile("s_waitcnt lgkmcnt(0)":::"memory"); \
      _Pragma("unroll") for(int d_=0;d_<2;++d_) _Pragma("unroll") for(int r=0;r<16;++r)o[d_][r]*=wsf[crow(r,hi)]; } }while(0)
  f32x16 pA0,pA1,pB0,pB1;
  int sl_prev=0,sl_cur=0,sl_next=SLOTB;
  #define ROT() do{sl_prev=sl_cur;sl_cur=sl_next;sl_next=(sl_next==(NSLOT-1)*SLOTB)?0:sl_next+SLOTB;}while(0)
  DMA_K(2,2*SLOTB);
  WAIT_BAR(3);
  qkt(pA0,pA1,Kbase,qr,negm,r32,hi);asm volatile("s_nop 15\n\ts_nop 7":"+v"(pA0),"+v"(pA1));CMASK(pA0,pA1,0);
  START(pA0,pA1);
  _Pragma("unroll") for(int r=0;r<16;++r)pA1[r]=__builtin_amdgcn_exp2f(pA1[r]);
  WAIT_BAR(0);
  DMA_K(3,0);DMA_V(1,SLOTB);
  ROT();
  kload8(kf,kp0+sl_cur);
  WAIT_BAR(2);
  s16x4 vlo[8],vhi[8]; u32x4 pw0,pw1,pw2,pw3;
  #define PKW(P,B) cvtpk_s(P[B],P[B+1])
  #define PAF(k) __builtin_bit_cast(bf16x8,pw##k)
  #define VFR(i) (bf16x8){vlo[i][0],vlo[i][1],vlo[i][2],vlo[i][3],vhi[i][0],vhi[i][1],vhi[i][2],vhi[i][3]}
  #define PIN(x) asm volatile("":"+v"(x))
  #define MX3(a,b,c) __builtin_fmaxf(__builtin_fmaxf((a),(b)),(c))
  #define GAPA(MF,A0,A1,A2,A3,W0,W1,PW) do{ MF; sacc+=A0; sacc+=A1; sacc+=A2; sacc+=A3; PIN(sacc); W0; W1; PIN(PW); SBAR(); }while(0)
  #define EX(v) __builtin_amdgcn_exp2f(v)
  #define GAPB(MF,X,B) do{ MF; X[B]=EX(X[B]); X[B+1]=EX(X[B+1]); X[B+2]=EX(X[B+2]); X[B+3]=EX(X[B+3]); PIN(X); SBAR(); }while(0)
  #define VRD(i) do{ vlo[i]=vtr(vp_+(((i)>>2)*4096+((i)&3)*1024)); vhi[i]=vtr(vp_+(((i)>>2)*4096+((i)&3)*1024+512)); }while(0)
  #define KRD(G,j) do{ if(G){ kload2(kf,kp0+sl_next,j); SBAR(); } }while(0)
  #define STEP(C0,C1,P0,P1,t,GK,GV,GL) do{ SBAR(); \
    const lds_cptr vp_=vp0+sl_prev; \
    VRD(0); SBAR(); float sacc=(P0[0]+P0[1]); \
    GAPA(C0=__builtin_amdgcn_mfma_f32_32x32x16_bf16(kf[0],qr[0],negm,0,0,0), P0[2],P0[3],P0[4],P0[5],     pw0[0]=PKW(P0,0), pw0[1]=PKW(P0,2), pw0); \
    VRD(4); SBAR(); GAPA(C1=__builtin_amdgcn_mfma_f32_32x32x16_bf16(kf[1],qr[0],negm,0,0,0), P0[6],P0[7],P0[8],P0[9],     pw0[2]=PKW(P0,4), pw0[3]=PKW(P0,6), pw0); \
    VRD(1); SBAR(); GAPA(C0=__builtin_amdgcn_mfma_f32_32x32x16_bf16(kf[2],qr[1],C0,0,0,0),   P0[10],P0[11],P0[12],P0[13], pw1[0]=PKW(P0,8), pw1[1]=PKW(P0,10), pw1); \
    VRD(5); SBAR(); GAPA(C1=__builtin_amdgcn_mfma_f32_32x32x16_bf16(kf[3],qr[1],C1,0,0,0),   P0[14],P0[15],P1[0],P1[1],   pw1[2]=PKW(P0,12),pw1[3]=PKW(P0,14), pw1); \
    VRD(2); SBAR(); GAPA(C0=__builtin_amdgcn_mfma_f32_32x32x16_bf16(kf[4],qr[2],C0,0,0,0),   P1[2],P1[3],P1[4],P1[5],     pw2[0]=PKW(P1,0), pw2[1]=PKW(P1,2), pw2); \
    VRD(6); SBAR(); GAPA(C1=__builtin_amdgcn_mfma_f32_32x32x16_bf16(kf[5],qr[2],C1,0,0,0),   P1[6],P1[7],P1[8],P1[9],     pw2[2]=PKW(P1,4), pw2[3]=PKW(P1,6), pw2); \
    VRD(3); SBAR(); GAPA(C0=__builtin_amdgcn_mfma_f32_32x32x16_bf16(kf[6],qr[3],C0,0,0,0),   P1[10],P1[11],P1[12],P1[13], pw3[0]=PKW(P1,8), pw3[1]=PKW(P1,10), pw3); \
    VRD(7); SBAR(); GAPA(C1=__builtin_amdgcn_mfma_f32_32x32x16_bf16(kf[7],qr[3],C1,0,0,0),   P1[14],P1[15],0.f,0.f,       pw3[2]=PKW(P1,12),pw3[3]=PKW(P1,14), pw3); \
    l_reg+=sacc; \
    if(GK){DMA_K((t)+3,sl_cur);} if(GV){DMA_V((t)+1,sl_next);} \
    CMASK(C0,C1,t); \
    { float a=MX3(C0[0],C0[1],C1[0]),b=MX3(C0[2],C0[3],C1[1]); a=MX3(a,C1[2],C1[3]); \
      _Pragma("unroll") for(int r=4;r<16;r+=4){a=MX3(a,C0[r],C0[r+1]);b=MX3(b,C0[r+2],C0[r+3]);a=MX3(a,C1[r],C1[r+1]);b=MX3(b,C1[r+2],C1[r+3]);} \
      float rm=__builtin_fmaxf(a,b); { auto rr=__builtin_amdgcn_permlane32_swap(__float_as_uint(rm),__float_as_uint(rm),false,false); rm=__builtin_fmaxf(__uint_as_float(rr[0]),__uint_as_float(rr[1])); } \
      resc=false; \
      if(__builtin_expect(__any(rm>(float)THRL),0)){ const float dl=__builtin_fmaxf(rm,0.f); mhat+=dl; \
        _Pragma("unroll") for(int r=0;r<16;++r){C0[r]-=dl;C1[r]-=dl;} \
        _Pragma("unroll") for(int r=0;r<16;++r)negm[r]=-mhat; asm volatile("":"+v"(negm)); \
        const float f=__builtin_amdgcn_exp2f(-dl); l_reg*=f; if(hi==0)wsf[r32]=f; resc=true; } } \
    SBAR(); \
    GAPB(o[0]=__builtin_amdgcn_mfma_f32_32x32x16_bf16(PAF(0),VFR(0),o[0],0,0,0), C0,0); \
    GAPB(o[1]=__builtin_amdgcn_mfma_f32_32x32x16_bf16(PAF(0),VFR(4),o[1],0,0,0), C0,4); \
    KRD(GL,0); GAPB(o[0]=__builtin_amdgcn_mfma_f32_32x32x16_bf16(PAF(1),VFR(1),o[0],0,0,0), C0,8); \
    KRD(GL,1); GAPB(o[1]=__builtin_amdgcn_mfma_f32_32x32x16_bf16(PAF(1),VFR(5),o[1],0,0,0), C0,12); \
    KRD(GL,2); GAPB(o[0]=__builtin_amdgcn_mfma_f32_32x32x16_bf16(PAF(2),VFR(2),o[0],0,0,0), C1,0); \
    KRD(GL,3); GAPB(o[1]=__builtin_amdgcn_mfma_f32_32x32x16_bf16(PAF(2),VFR(6),o[1],0,0,0), C1,4); \
    GAPB(o[0]=__builtin_amdgcn_mfma_f32_32x32x16_bf16(PAF(3),VFR(3),o[0],0,0,0), C1,8); \
    GAPB(o[1]=__builtin_amdgcn_mfma_f32_32x32x16_bf16(PAF(3),VFR(7),o[1],0,0,0), C1,12); \
    }while(0)
  int t=1;
  #undef CMASK
  #define CMASK(P0,P1,t) do{}while(0)
  for(;t+5<NT;t+=2){
    STEP(pB0,pB1,pA0,pA1,t,true,true,true);     WAIT_BAR(2); RESC(); ROT();
    STEP(pA0,pA1,pB0,pB1,t+1,true,true,true);   WAIT_BAR(2); RESC(); ROT();
  }
  #undef CMASK
  #define CMASK(P0,P1,t) do{}while(0)
  #define ENDW(tt) do{ if((tt)+3<NT){WAIT_BAR(2);} else if((tt)+2<NT){WAIT_BAR(1);} else {WAIT_BAR(0);} }while(0)
  for(;t+1<NT;t+=2){
    STEP(pB0,pB1,pA0,pA1,t,(t+3<NT),(t+1<NT),(t+1<NT));       ENDW(t);   RESC(); ROT();
    STEP(pA0,pA1,pB0,pB1,t+1,(t+4<NT),(t+2<NT),(t+2<NT));     ENDW(t+1); RESC(); ROT();
  }
  STEP(pB0,pB1,pA0,pA1,NT-1,false,false,false); RESC();
  { float sacc=pB0[0]+pB0[1]; _Pragma("unroll") for(int r=2;r<16;++r)sacc+=pB0[r]; _Pragma("unroll") for(int r=0;r<16;++r)sacc+=pB1[r]; l_reg+=sacc;
    pw0=(u32x4){PKW(pB0,0),PKW(pB0,2),PKW(pB0,4),PKW(pB0,6)};pw1=(u32x4){PKW(pB0,8),PKW(pB0,10),PKW(pB0,12),PKW(pB0,14)};pw2=(u32x4){PKW(pB1,0),PKW(pB1,2),PKW(pB1,4),PKW(pB1,6)};pw3=(u32x4){PKW(pB1,8),PKW(pB1,10),PKW(pB1,12),PKW(pB1,14)};
    SBAR(); pv(o,vb0+sl_cur,PAF(0),PAF(1),PAF(2),PAF(3)); }
  #undef PKW
  #undef PAF
  #undef VFR
  #undef PIN
  #undef MX3
  #undef GAPA
  #undef GAPB
  #undef EX
  #undef VRD
  #undef KRD
  #undef STEP
  #undef ENDW
  {auto rr=__builtin_amdgcn_permlane32_swap(__float_as_uint(l_reg),__float_as_uint(l_reg),false,false);l_reg=__uint_as_float(rr[0])+__uint_as_float(rr[1]);}
  if(hi==0)wsf[32+r32]=l_reg;asm volatile("s_waitcnt lgkmcnt(0)":::"memory");
  float rli[16];
  #pragma unroll
  for(int r=0;r<16;++r)rli[r]=__builtin_amdgcn_rcpf(wsf[32+crow(r,hi)]);
  bf16*Ow=O+(rowbase+q0+wid*QBLK)*DMO+h*D;
  { bf16*stg=(bf16*)(shm+LDS_OST)+wid*2048;
    #pragma unroll
    for(int r=0;r<16;++r){const int orow=crow(r,hi);
      #pragma unroll
      for(int d0=0;d0<2;++d0)stg[orow*64+d0*32+r32]=__float2bfloat16(o[d0][r]*rli[r]);}
    asm volatile("s_waitcnt lgkmcnt(0)":::"memory");
    #pragma unroll
    for(int i=0;i<4;++i){const int row=i*8+(lane>>3),ch=lane&7; const u32x4 v=*(const u32x4*)(stg+row*64+ch*8); ATTN_STORE16(Ow+(long)row*DMO+ch*8,v);} }
  asm volatile("s_waitcnt lgkmcnt(0)\n\ts_barrier":::"memory");
  #undef DMA_K
  #undef DMA_V
  #undef CMASK
  #undef START
  #undef RESC
  #undef ROT
}
constexpr int ATTN_LDS_BYTES=LDS_BYTES;
struct AttnTensors { const bf16* Q; const bf16* K; const bf16* V; bf16* O; };
struct AttnUnit { int bh; int qb; };
struct StaticOrder {
  int vcu, G;
  __device__ __forceinline__ explicit StaticOrder(int grid,int block):vcu((grid%8==0)?(block%8)*(grid/8)+block/8:block),G(grid){}
  __device__ __forceinline__ bool next(int i,AttnUnit&u)const{ const int per=(BATCH*NHEAD*NQB+G-1)/G; if(i>=per)return false; const int idx=vcu*per+i; if(idx>=BATCH*NHEAD*NQB)return false;
    const int qb=idx%NQB, hq=(idx/NQB)&3, bk=idx/(NQB*4), kvh=bk&1, b=bk>>1; u.bh=b*NHEAD+kvh*4+hq; u.qb=qb; return true; }
  __device__ __forceinline__ void a_ready(const AttnUnit&)const{}
  __device__ __forceinline__ void done(const AttnUnit&)const{}
};
template<class Sched,int THRL=8> __device__ __forceinline__ void attn_phase(char*lds,const AttnTensors&T,const Sched&S){
  AttnUnit u;
  for(int i=0;S.next(i,u);++i){ S.a_ready(u); attn_unit<THRL>(u.bh/NHEAD,u.bh%NHEAD,u.qb,T.Q,T.K,T.V,T.O,lds); S.done(u); }
}
#undef SBAR
#undef WAIT_BAR
}
constexpr int NB = 8, SEQ = 4096, DM = 1024, NL = 4, NTOK = NB * SEQ;
constexpr int INW = 1824, INP = 2048;
constexpr int C_AQ = 0, C_AK = 512, C_AV = 640, C_GQ = 768, C_GK = 896, C_GV = 1024, C_GR = 1280, C_FX = 1536, C_GLR = 1792;
constexpr int NE = 32, TOPK = 4, DE = 1024;
constexpr int MPAD = NTOK * TOPK + NE * 256;
constexpr float LN_EPS = 1e-5f, RMS_EPS = 1e-6f;
constexpr float DN_ALPHA = 1.681792830507429f;
constexpr float QSCALE = 0.125f * 1.4426950408889634f;
constexpr float GLA_QSCALE = 0.17677669529663687f;

constexpr size_t MiB = 1u << 20;
constexpr size_t WS_CTL = 0, CTL_ZERO_BYTES = 1 * MiB;
constexpr size_t WS_ROPE = 1 * MiB;
constexpr size_t WS_WIN_T = 2 * MiB;
constexpr size_t WS_WOUT_T = 18 * MiB;
constexpr size_t WS_FTAB = 26 * MiB;
constexpr size_t WS_TW = WS_FTAB + 65536;
constexpr size_t WS_RWT = WS_FTAB + 131072;
constexpr size_t WS_FTMP = 27 * MiB;
constexpr size_t WS_WGU_T = 90 * MiB;
constexpr size_t WS_WDN_T = 602 * MiB;
constexpr size_t WS_HF = 858 * MiB;
constexpr size_t WS_HB = 986 * MiB;
constexpr size_t WS_PROJ = 1050 * MiB;
constexpr size_t WS_QB = 1178 * MiB;
constexpr size_t WS_KB = 1210 * MiB;
constexpr size_t WS_MIX = 1218 * MiB;
constexpr size_t WS_T1 = 1282 * MiB;
constexpr size_t WS_UVT = 1410 * MiB;
constexpr size_t WS_LA = 1442 * MiB;
constexpr size_t WS_OF = 1474 * MiB;
constexpr size_t WS_OB = 1506 * MiB;
constexpr size_t WS_TOK = 1538 * MiB;
constexpr size_t WS_XS = 1542 * MiB;
constexpr size_t WS_HID = 1814 * MiB;
constexpr size_t WS_YS = 2086 * MiB;
constexpr size_t WS_END = 2358 * MiB;
static_assert((size_t)MPAD * 2048 == 272 * MiB, "sorted buffers");
constexpr int CW_TMO = 0, CW_CODE = 1, CW_BAR = 4096, CW_CNT = 8192;

constexpr int RING_OFF = 0, RING_BYTES = 131072;
constexpr int LDSCTL_OFF = RING_BYTES;
constexpr int LDS_BYTES = 163840;
constexpr int LC_MISC = 0;
constexpr int LC_PSTART = 128;
constexpr int LC_ULIST = 384;
constexpr int LC_CNT = 640;
constexpr int LC_BASE = 768;
constexpr int LC_SELE = 1024;
constexpr int LC_SELS = 1024 + 2048;
constexpr int LC_COS64 = 5120;
constexpr int LC_ROWS = 6144;
constexpr int LC_LG = 16384;

constexpr int NWAVES = 8;
constexpr int N_PHASES = 1 + 10 * NL;

typedef float f32x2_t __attribute__((ext_vector_type(2))); typedef __bf16 bf16x2_t __attribute__((ext_vector_type(2)));
__device__ __forceinline__ unsigned cvtpk2(float lo, float hi) { f32x2_t v = {lo, hi}; bf16x2_t b = __builtin_convertvector(v, bf16x2_t); return __builtin_bit_cast(unsigned, b); }
#define pk2(lo, hi) cvtpk2((lo), (hi))
#define f2bf(x) (cvtpk2((x), 0.f) & 0xffffu)
__device__ __forceinline__ float bf2f(unsigned short b) { return __uint_as_float((unsigned)b << 16); }
__device__ __forceinline__ float wave_sum(float v) {
#pragma unroll
    for (int o = 1; o < 64; o <<= 1) v += __shfl_xor(v, o);
    return v;
}
typedef unsigned short u16x8 __attribute__((ext_vector_type(8)));
typedef unsigned short u16x4 __attribute__((ext_vector_type(4)));

typedef float f32x2v __attribute__((ext_vector_type(2)));
__device__ __forceinline__ void tr_task(const float* W, int K, int Nsrc, int srcn, bf16* WT, int dst_n, int k0) {
#pragma unroll 1
    for (int hf = 0; hf < 2; ++hf) { const int kk = k0 + hf * 64; f32x2v v[64];
        if (srcn >= 0) { const float* p = W + (size_t)kk * Nsrc + srcn;
#pragma unroll
            for (int i = 0; i < 64; ++i) v[i] = __builtin_nontemporal_load((const f32x2v*)(p + (size_t)i * Nsrc)); }
        else {
#pragma unroll
            for (int i = 0; i < 64; ++i) v[i] = (f32x2v){0.f, 0.f}; }
        bf16* o0 = WT + (size_t)dst_n * K + kk; bf16* o1 = o0 + K;
#pragma unroll
        for (int j = 0; j < 8; ++j) { v4u w0, w1;
            w0.x = pk2(v[8 * j].x, v[8 * j + 1].x); w0.y = pk2(v[8 * j + 2].x, v[8 * j + 3].x); w0.z = pk2(v[8 * j + 4].x, v[8 * j + 5].x); w0.w = pk2(v[8 * j + 6].x, v[8 * j + 7].x);
            w1.x = pk2(v[8 * j].y, v[8 * j + 1].y); w1.y = pk2(v[8 * j + 2].y, v[8 * j + 3].y); w1.z = pk2(v[8 * j + 4].y, v[8 * j + 5].y); w1.w = pk2(v[8 * j + 6].y, v[8 * j + 7].y);
            *(v4u*)(o0 + 8 * j) = w0; *(v4u*)(o1 + 8 * j) = w1; } }
}

#define RC(l, j) (((j) >> 1) * 512 + 8 * (l) + ((j) & 1) * 4)
__device__ __forceinline__ void row_load_bf16(f32x4 (&v)[4], const bf16* row, int lane) {
#pragma unroll
    for (int h = 0; h < 2; ++h) { const v4u t = *(const v4u*)(row + h * 512 + 8 * lane);
        v[2 * h] = (f32x4){__uint_as_float(t.x << 16), __uint_as_float(t.x & 0xffff0000u), __uint_as_float(t.y << 16), __uint_as_float(t.y & 0xffff0000u)};
        v[2 * h + 1] = (f32x4){__uint_as_float(t.z << 16), __uint_as_float(t.z & 0xffff0000u), __uint_as_float(t.w << 16), __uint_as_float(t.w & 0xffff0000u)}; }
}
__device__ __forceinline__ void row_store_bf16(const f32x4 (&v)[4], bf16* row, int lane) {
#pragma unroll
    for (int h = 0; h < 2; ++h) { v4u w; w.x = pk2(v[2 * h].x, v[2 * h].y); w.y = pk2(v[2 * h].z, v[2 * h].w); w.z = pk2(v[2 * h + 1].x, v[2 * h + 1].y); w.w = pk2(v[2 * h + 1].z, v[2 * h + 1].w); *(v4u*)(row + h * 512 + 8 * lane) = w; }
}
__device__ __forceinline__ void ln_row8(f32x4 (&v)[4], const f32x4 (&gam)[4], const f32x4 (&bet)[4]) {
    float s = 0.f;
#pragma unroll
    for (int j = 0; j < 4; ++j) s += (v[j].x + v[j].y) + (v[j].z + v[j].w);
    const float mean = wave_sum(s) * (1.f / DM); float s2 = 0.f;
#pragma unroll
    for (int j = 0; j < 4; ++j) { v[j] = v[j] - mean; s2 += (v[j].x * v[j].x + v[j].y * v[j].y) + (v[j].z * v[j].z + v[j].w * v[j].w); }
    const float rstd = __builtin_amdgcn_rsqf(wave_sum(s2) * (1.f / DM) + LN_EPS);
#pragma unroll
    for (int j = 0; j < 4; ++j) v[j] = v[j] * rstd * gam[j] + bet[j];
}

constexpr int GM_QF = 0, GM_KF = 5120, GM_QB = 10240, GM_KB = 15360, GM_VT = 20480, GM_P = 29696, GM_HTF = 38912, GM_HTB = 44032, GM_DL = 38912, GM_SLOT = 49152;
static_assert(2 * GM_SLOT <= RING_BYTES, "two GLA chunk images fit the phase scratch");
#define MFMA16(a, b, c) __builtin_amdgcn_mfma_f32_16x16x32_bf16((a), (b), (c), 0, 0, 0)
template <bool OUT>
__device__ __forceinline__ void gla_stage_mfma(LAS unsigned char* Ls, const bf16* PROJ, const float* LA, const float* HIN, size_t tok0, int hd, int w4, int lane) {
    if (w4 < 2) { const int dir = w4, g = lane >> 3, c4 = (lane & 7) * 4; f32x4 bc[8]; u16x4 kx[8], qx[8];
        const float* lap = LA + (tok0 + 8 * g) * 256 + dir * 128 + hd * 32 + c4; const bf16* xp = PROJ + (tok0 + 8 * g) * INP + hd * 32 + c4;
#pragma unroll
        for (int i = 0; i < 8; ++i) { bc[i] = *(const f32x4*)(lap + (size_t)i * 256); kx[i] = *(const u16x4*)(xp + (size_t)i * INP + C_GK); if (OUT) qx[i] = *(const u16x4*)(xp + (size_t)i * INP + C_GQ); }
        f32x4 inc;
        if (dir == 0) {
#pragma unroll
            for (int i = 1; i < 8; ++i) bc[i] = bc[i] + bc[i - 1];
            inc = bc[7];
#pragma unroll
            for (int o = 1; o < 8; o <<= 1) { f32x4 y; y.x = __shfl_up(inc.x, 8 * o); y.y = __shfl_up(inc.y, 8 * o); y.z = __shfl_up(inc.z, 8 * o); y.w = __shfl_up(inc.w, 8 * o); if (g >= o) inc = inc + y; }
            const f32x4 off = inc - bc[7];
#pragma unroll
            for (int i = 0; i < 8; ++i) bc[i] = bc[i] + off; }
        else {
#pragma unroll
            for (int i = 6; i >= 0; --i) bc[i] = bc[i] + bc[i + 1];
            inc = bc[0];
#pragma unroll
            for (int o = 1; o < 8; o <<= 1) { f32x4 y; y.x = __shfl_down(inc.x, 8 * o); y.y = __shfl_down(inc.y, 8 * o); y.z = __shfl_down(inc.z, 8 * o); y.w = __shfl_down(inc.w, 8 * o); if (g + o < 8) inc = inc + y; }
            const f32x4 off = inc - bc[0];
#pragma unroll
            for (int i = 0; i < 8; ++i) bc[i] = bc[i] + off; }
        if (OUT) { LAS bf16* qd = (LAS bf16*)(Ls + (dir ? GM_QB : GM_QF)) + (8 * g) * 40 + c4; LAS bf16* kd = (LAS bf16*)(Ls + (dir ? GM_KB : GM_KF)) + (8 * g) * 40 + c4;
#pragma unroll
            for (int i = 0; i < 8; ++i) { float qv[4], kv[4];
#pragma unroll
                for (int c = 0; c < 4; ++c) { const float e_ = __expf(bc[i][c]); qv[c] = bf2f(qx[i][c]) * GLA_QSCALE * e_; kv[c] = bf2f(kx[i][c]) * __builtin_amdgcn_rcpf(e_); }
                *(LAS unsigned long long*)(qd + i * 40) = (unsigned long long)pk2(qv[0], qv[1]) | ((unsigned long long)pk2(qv[2], qv[3]) << 32);
                *(LAS unsigned long long*)(kd + i * 40) = (unsigned long long)pk2(kv[0], kv[1]) | ((unsigned long long)pk2(kv[2], kv[3]) << 32); } }
        else { LAS bf16* kt = (LAS bf16*)(Ls + GM_P + dir * 4608) + c4 * 72 + 8 * g;
#pragma unroll
            for (int c = 0; c < 4; ++c) { float t[8];
#pragma unroll
                for (int i = 0; i < 8; ++i) t[i] = bf2f(kx[i][c]) * __expf(-bc[i][c]);
                v4u w; w.x = pk2(t[0], t[1]); w.y = pk2(t[2], t[3]); w.z = pk2(t[4], t[5]); w.w = pk2(t[6], t[7]); *(LAS v4u*)(kt + c * 72) = w; }
            if (g == (dir ? 0 : 7)) { const f32x4 tot = dir ? bc[0] : bc[7]; LAS float* dl = (LAS float*)(Ls + GM_DL) + dir * 32 + c4; dl[0] = __expf(tot.x); dl[1] = __expf(tot.y); dl[2] = __expf(tot.z); dl[3] = __expf(tot.w); } } }
    else if (w4 == 2) { const int g = lane >> 3, v0 = (lane & 7) * 8; u16x8 x[8]; const bf16* xp = PROJ + (tok0 + 8 * g) * INP + C_GV + hd * 64 + v0;
#pragma unroll
        for (int i = 0; i < 8; ++i) x[i] = *(const u16x8*)(xp + (size_t)i * INP);
        LAS bf16* dst = (LAS bf16*)(Ls + GM_VT) + v0 * 72 + 8 * g;
#pragma unroll
        for (int c = 0; c < 8; ++c) { v4u w; w.x = (unsigned)x[0][c] | ((unsigned)x[1][c] << 16); w.y = (unsigned)x[2][c] | ((unsigned)x[3][c] << 16); w.z = (unsigned)x[4][c] | ((unsigned)x[5][c] << 16); w.w = (unsigned)x[6][c] | ((unsigned)x[7][c] << 16);
            *(LAS v4u*)(dst + c * 72) = w; } }
    else if (OUT) {
#pragma unroll
        for (int dir = 0; dir < 2; ++dir) { const f32x4* src = (const f32x4*)(HIN + ((size_t)dir * 64 + lane) * 32); LAS bf16* dst = (LAS bf16*)(Ls + (dir ? GM_HTB : GM_HTF)) + lane * 40;
#pragma unroll
            for (int c8 = 0; c8 < 4; ++c8) { const f32x4 a_ = src[2 * c8], b_ = src[2 * c8 + 1]; v4u w; w.x = pk2(a_.x, a_.y); w.y = pk2(a_.z, a_.w); w.z = pk2(b_.x, b_.y); w.w = pk2(b_.z, b_.w); *(LAS v4u*)(dst + c8 * 8) = w; } } }
}

typedef float f32x16 __attribute__((ext_vector_type(16)));
typedef short s16x4 __attribute__((ext_vector_type(4)));
__device__ __forceinline__ bf16x8 pack_step(const f32x16& x, int s) { v4u p; p.x = cvtpk2(x[8 * s], x[8 * s + 1]); p.y = cvtpk2(x[8 * s + 2], x[8 * s + 3]); p.z = cvtpk2(x[8 * s + 4], x[8 * s + 5]); p.w = cvtpk2(x[8 * s + 6], x[8 * s + 7]); return __builtin_bit_cast(bf16x8, p); }
__device__ __forceinline__ int crow16(int i, int h) { return (i & 3) + 8 * (i >> 2) + 4 * h; }
#define MFMA32(a, b, c) __builtin_amdgcn_mfma_f32_32x32x16_bf16((a), (b), (c), 0, 0, 0)
constexpr int FT_PITCH = 72, FT_TAB = 64 * FT_PITCH;
constexpr int FFT_LDS_TAB = 0, FFT_LDS_TW = 28672, FFT_LDS_HT = 28672, FFT_HT_PAIR = 2 * 64 * FT_PITCH * 2;

struct Args { const float* in[20]; float* out; unsigned char* ws; int ph_lo, ph_hi; };
static_assert(sizeof(Args) == 20 * 8 + 8 + 8 + 8, "no padding bytes in Args");


typedef __attribute__((address_space(4))) const unsigned char* kptr_t;
__device__ __forceinline__ kptr_t karg() { kptr_t p = (kptr_t)__builtin_amdgcn_kernarg_segment_ptr(); asm volatile("" : "+s"(p)); return p; }
#define KIN(i) (*(const float* const __attribute__((address_space(4)))*)(karg() + 8 * (i)))
#define KOUT() (*(float* const __attribute__((address_space(4)))*)(karg() + 160))
#define KWS() (*(unsigned char* const __attribute__((address_space(4)))*)(karg() + 168))
#define WSP(T, off) ((T*)(ws + (off)))

#ifndef NAIVE_ATTN
#define NAIVE_ATTN 0
#endif

__global__ void __launch_bounds__(NWAVES * 64, 2) fwd(Args args) {
    extern __shared__ __attribute__((aligned(16))) unsigned char lds_raw[];
    LAS unsigned char* lds = (LAS unsigned char*)lds_raw;
    LAS unsigned char* lctl = lds + LDSCTL_OFF;
    const int G = gridDim.x, bx = blockIdx.x;
    const int NGW = G * NWAVES, NGT = G * NWAVES * 64;
#define TID_SETUP() int tid_ = threadIdx.x; asm volatile("" : "+v"(tid_)); const int tid = tid_, lane = tid & 63, wave = __builtin_amdgcn_readfirstlane(tid >> 6); \
    const int gw = bx * NWAVES + wave, gt = bx * (NWAVES * 64) + tid; (void)lane; (void)gw; (void)gt
    for (int u = threadIdx.x; u < (LDS_BYTES - LDSCTL_OFF) / 4; u += NWAVES * 64) ((LAS unsigned*)lctl)[u] = 0u;
    __syncthreads();
    volatile LAS unsigned* MISC = (volatile LAS unsigned*)(lctl + LC_MISC);
    XcdBarrier bar = xcd_barrier_post((unsigned*)(KWS() + WS_CTL) + CW_BAR, MISC + 8);
    const int lo = args.ph_lo, hi = args.ph_hi;
#ifndef PH_OFF
#define PH_OFF 0
#endif
#define PON(j) (!((PH_OFF >> (j)) & 1))
#define IN(k) (lo <= (k) && (k) < hi)
#ifndef PROBE_A
#define PROBE_A -1
#endif
#ifndef PROBE_B
#define PROBE_B -1
#endif
#if PROBE_A >= 0
#define STAMP(k) do { if (blockIdx.x == 0 && threadIdx.x == 0) { ((unsigned long long*)(KWS() + WS_CTL + 65536))[(k)] = __builtin_amdgcn_s_memrealtime(); } } while (0)
#define STAMP2(i) do { __syncthreads(); if (blockIdx.x == 0 && threadIdx.x == 0) { ((unsigned long long*)(KWS() + WS_CTL + 65536))[128 + l * 16 + (i)] = __builtin_amdgcn_s_memrealtime(); } } while (0)
#else
#define STAMP(k) do {} while (0)
#define STAMP2(i) do {} while (0)
#endif
#ifndef PROBE_SUB_A
#define PROBE_SUB_A -1
#define PROBE_SUB_B -1
#endif
#define SEAM(k) do { if (IN(k) && IN((k) + 1)) xcd_barrier(bar); STAMP((k) + 1); } while (0)
    STAMP(0);

    if (IN(0) && PON(0)) {
        TID_SETUP(); unsigned char* ws = KWS(); const float* x_in = KIN(0); const float* ln_in_g = KIN(1); const float* ln_in_b = KIN(2); const float* w_in = KIN(3); const float* w_out = KIN(9);
        const float* exp_w_gu = KIN(14); const float* exp_w_down = KIN(16);
        float* ROPE = WSP(float, WS_ROPE); bf16* WIN_T = WSP(bf16, WS_WIN_T); bf16* WOUT_T = WSP(bf16, WS_WOUT_T); bf16* WGU_T = WSP(bf16, WS_WGU_T); bf16* WDN_T = WSP(bf16, WS_WDN_T);
        bf16* HB = WSP(bf16, WS_HB);
        { LAS unsigned* Lt = (LAS unsigned*)(lds + RING_OFF);
          constexpr int T_WIN = NL * 16 * 4, T_WOUT = NL * 8 * 4, T_WGU = NL * NE * 16 * 4, T_WDN = NL * NE * 8 * 4, NTILE = T_WIN + T_WOUT + T_WGU + T_WDN;
          for (int it = bx; it < NTILE; it += G) {
            int r = it; const float* W; bf16* WT; int Nsrc, nb, kq, mode;
            if (r < T_WIN) { const int l = r / 64, q = r % 64; nb = q / 4; kq = q % 4; W = w_in + (size_t)l * DM * INW; WT = WIN_T + (size_t)l * INP * DM; Nsrc = INW; mode = 0; }
            else if ((r -= T_WIN) < T_WOUT) { const int l = r / 32, q = r % 32; nb = q / 4; kq = q % 4; W = w_out + (size_t)l * DM * DM; WT = WOUT_T + (size_t)l * DM * DM; Nsrc = DM; mode = 1; }
            else if ((r -= T_WOUT) < T_WGU) { const int le = r / 64, q = r % 64; nb = q / 4; kq = q % 4; W = exp_w_gu + (size_t)le * DM * 2048; WT = WGU_T + (size_t)le * 2048 * DM; Nsrc = 2048; mode = 2; }
            else { r -= T_WGU; const int le = r / 32, q = r % 32; nb = q / 4; kq = q % 4; W = exp_w_down + (size_t)le * DE * DM; WT = WDN_T + (size_t)le * DM * DE; Nsrc = DM; mode = 1; }
            const int n = nb * 128 + 2 * lane;
            int src = n;
            if (mode == 0) src = n < 1536 ? n : (n < 1792 ? n + 32 : (n < 1824 ? n - 256 : -1));
            else if (mode == 2) { const int pn = n >> 8, bj = (n >> 7) & 1, j = n & 127; src = bj * 1024 + pn * 128 + j; }
            f32x2v v[32];
            if (src >= 0) { const float* p = W + (size_t)(kq * 256 + 32 * wave) * Nsrc + src;
#pragma unroll
                for (int i = 0; i < 32; ++i) v[i] = __builtin_nontemporal_load((const f32x2v*)(p + (size_t)i * Nsrc)); }
            else {
#pragma unroll
                for (int i = 0; i < 32; ++i) v[i] = (f32x2v){0.f, 0.f}; }
            __syncthreads();
#pragma unroll
            for (int i2 = 0; i2 < 16; ++i2) { Lt[(2 * lane) * 129 + 16 * wave + i2] = pk2(v[2 * i2].x, v[2 * i2 + 1].x); Lt[(2 * lane + 1) * 129 + 16 * wave + i2] = pk2(v[2 * i2].y, v[2 * i2 + 1].y); }
            __syncthreads();
            const int p4 = (lane & 31) * 4;
#pragma unroll
            for (int j = 0; j < 8; ++j) { const int row = 16 * wave + 2 * j + (lane >> 5); const LAS unsigned* lp = Lt + row * 129 + p4; v4u o; o.x = lp[0]; o.y = lp[1]; o.z = lp[2]; o.w = lp[3];
                *(v4u*)(WT + (size_t)(nb * 128 + row) * DM + kq * 256 + 2 * p4) = o; }
          }
          __syncthreads(); }
        { bf16* FTAB = WSP(bf16, WS_FTAB); float* TW = WSP(float, WS_TW);
          for (int it = gt; it < 3 * FT_TAB; it += NGT) { const int t = it / FT_TAB, q = it % FT_TAB, row = q / FT_PITCH, col = q % FT_PITCH; float sn, cs; sincospif((float)((row * col) & 63) * (1.0f / 32.0f), &sn, &cs);
              const float v = col >= 64 ? 0.f : (t == 0 ? cs : (t == 1 ? sn : -sn)); FTAB[it] = (bf16)f2bf(v); }
          for (int it = gt; it < 4096; it += NGT) { float sn, cs; sincospif((float)it * (1.0f / 2048.0f), &sn, &cs); TW[2 * it] = cs; TW[2 * it + 1] = -sn; } }
        { const float* router_w = KIN(12); bf16* RWT = WSP(bf16, WS_RWT);
          for (int it = gt; it < NL * NE * DM; it += NGT) { const int k = it & (DM - 1), e = (it >> 10) & 31, l = it >> 15; const float w = router_w[((size_t)l * DM + k) * NE + e];
              const unsigned hi = f2bf(w); const float lo = w - __uint_as_float(hi << 16); RWT[((size_t)(l * 2 + 0) * NE + e) * DM + k] = (bf16)hi; RWT[((size_t)(l * 2 + 1) * NE + e) * DM + k] = (bf16)f2bf(lo); } }
        for (int it = gt; it < SEQ * 32; it += NGT) { const int t = it >> 5, i = it & 31, a = i >> 4, f = i & 15; const int pos = a ? (t & 63) : (t >> 6);
            const double inv = exp(-9.210340371976184 * (double)f / 16.0); const double ang = (double)pos * inv;
            ROPE[it] = (float)cos(ang); ROPE[SEQ * 32 + it] = (float)sin(ang); }
        { f32x4 gam[4], bet[4];
#pragma unroll
          for (int j = 0; j < 4; ++j) { gam[j] = *(const f32x4*)(ln_in_g + RC(lane, j)); bet[j] = *(const f32x4*)(ln_in_b + RC(lane, j)); }
          for (int m0 = gw; m0 < NTOK; m0 += 2 * NGW) { f32x4 v[2][4];
#pragma unroll
            for (int q = 0; q < 2; ++q)
#pragma unroll
                for (int j = 0; j < 4; ++j) v[q][j] = *(const f32x4*)(x_in + (size_t)(m0 + q * NGW) * DM + RC(lane, j));
#pragma unroll
            for (int q = 0; q < 2; ++q) { ln_row8(v[q], gam, bet); row_store_bf16(v[q], HB + (size_t)(m0 + q * NGW) * DM, lane); } } }
    }
    SEAM(0);

    for (int l = 0; l < NL; ++l) {
        const int pb = 1 + 10 * l;
        if (IN(pb + 0) && PON(1)) {
            TID_SETUP(); unsigned char* ws = KWS(); bf16* HB = WSP(bf16, WS_HB); bf16* WIN_T = WSP(bf16, WS_WIN_T); bf16* PROJ = WSP(bf16, WS_PROJ);
            pg8::Gemm g{HB, WIN_T + (size_t)l * INP * DM, NTOK, INP, DM}; pg8::StaticOrder S; S.init(NTOK, INP, G, bx);
            pg8::EpiPlainBf16 E{PROJ, INP};
            STAMP2(2);
            pg8::gemm_phase<pg8::EpiPlainBf16, pg8::StaticOrder, true, true>(lds + RING_OFF, g, S, E);
            STAMP2(3);
        }
        SEAM(pb + 0);
        if (IN(pb + 1) && PON(2)) {
            TID_SETUP(); unsigned char* ws = KWS(); const float* att_q_gain = KIN(4); const float* att_k_gain = KIN(5); const float* gla_gate_w = KIN(6); const float* gla_gate_b = KIN(7);
            const float* ROPE = WSP(float, WS_ROPE); const bf16* PROJ = WSP(bf16, WS_PROJ); bf16* QB = WSP(bf16, WS_QB); bf16* KB = WSP(bf16, WS_KB); float* LA = WSP(float, WS_LA);
            STAMP2(8);
            { LAS float* RTC = (LAS float*)(lds + RING_OFF + 65536);
              for (int i = tid; i < 1024; i += NWAVES * 64) { const int pos = i >> 4, f = i & 15; RTC[i] = ROPE[(pos * 64) * 32 + f]; RTC[1024 + i] = ROPE[SEQ * 32 + (pos * 64) * 32 + f]; RTC[2048 + i] = ROPE[pos * 32 + 16 + f]; RTC[3072 + i] = ROPE[SEQ * 32 + pos * 32 + 16 + f]; }
              __syncthreads();
              const int li = lane & 7, ax = li >> 2, f0 = 8 * (li & 1); const float sg = ((li >> 1) & 1) ? 1.f : -1.f;
              f32x4 qg8[2], kg8[2];
#pragma unroll
              for (int c = 0; c < 2; ++c) { qg8[c] = *(const f32x4*)(att_q_gain + l * 64 + 8 * li + 4 * c); kg8[c] = *(const f32x4*)(att_k_gain + l * 64 + 8 * li + 4 * c); }
              for (int m0 = gw; m0 < NTOK; m0 += 4 * NGW) { v4u xp[5];
#pragma unroll
                for (int i = 0; i < 5; ++i) { const int P = lane + 64 * i, q = P / 80, p = P % 80; xp[i] = *(const v4u*)(PROJ + (size_t)(m0 + q * NGW) * INP + p * 8); }
#pragma unroll
                for (int i = 0; i < 5; ++i) { const int P = lane + 64 * i, q = P / 80, p = P % 80, head = p >> 3; const size_t m = (size_t)(m0 + q * NGW); const int t = (int)(m & (SEQ - 1));
                    float xv[8] = {__uint_as_float(xp[i].x << 16), __uint_as_float(xp[i].x & 0xffff0000u), __uint_as_float(xp[i].y << 16), __uint_as_float(xp[i].y & 0xffff0000u),
                                   __uint_as_float(xp[i].z << 16), __uint_as_float(xp[i].z & 0xffff0000u), __uint_as_float(xp[i].w << 16), __uint_as_float(xp[i].w & 0xffff0000u)};
                    float ss = 0.f;
#pragma unroll
                    for (int c = 0; c < 8; ++c) ss += xv[c] * xv[c];
                    ss += __shfl_xor(ss, 1); ss += __shfl_xor(ss, 2); ss += __shfl_xor(ss, 4);
                    const float rs = __builtin_amdgcn_rsqf(ss * (1.f / 64.f) + RMS_EPS); const bool isq = head < 8;
                    const LAS float* tb = RTC + (ax ? 2048 : 0) + (ax ? (t & 63) : (t >> 6)) * 16 + f0;
                    const f32x4 c0 = *(const LAS f32x4*)tb, c1 = *(const LAS f32x4*)(tb + 4), s0 = *(const LAS f32x4*)(tb + 1024), s1 = *(const LAS f32x4*)(tb + 1028);
                    const float csv[8] = {c0.x, c0.y, c0.z, c0.w, c1.x, c1.y, c1.z, c1.w}, snv[8] = {s0.x, s0.y, s0.z, s0.w, s1.x, s1.y, s1.z, s1.w};
                    const f32x4 g0 = isq ? qg8[0] : kg8[0], g1 = isq ? qg8[1] : kg8[1]; const float gv[8] = {g0.x, g0.y, g0.z, g0.w, g1.x, g1.y, g1.z, g1.w};
                    const float osc = isq ? QSCALE : 1.f; float o[8];
#pragma unroll
                    for (int c = 0; c < 8; ++c) { const float xn = xv[c] * rs * gv[c]; const float pr = __shfl_xor(xn, 2); o[c] = (xn * csv[c] + sg * pr * snv[c]) * osc; }
                    v4u w; w.x = pk2(o[0], o[1]); w.y = pk2(o[2], o[3]); w.z = pk2(o[4], o[5]); w.w = pk2(o[6], o[7]);
                    bf16* dst = isq ? (QB + m * 512 + head * 64 + 8 * li) : (KB + m * 128 + (head - 8) * 64 + 8 * li);
                    *(v4u*)dst = w; } }
              const float* gw_l = gla_gate_w + (size_t)l * 2 * 16 * 128; const float* gb_l = gla_gate_b + (size_t)l * 2 * 128; const int dir = lane >> 5, kc = (lane & 31) * 4;
              f32x4 gwr[16]; const f32x4 gbv = *(const f32x4*)(gb_l + dir * 128 + kc);
#pragma unroll
              for (int r = 0; r < 16; ++r) gwr[r] = *(const f32x4*)(gw_l + (size_t)(dir * 16 + r) * 128 + kc);
              for (int m0 = gw; m0 < NTOK; m0 += 4 * NGW) { v4u gl[4][2];
#pragma unroll
                for (int q = 0; q < 4; ++q) { const bf16* gp = PROJ + (size_t)(m0 + q * NGW) * INP + C_GLR + dir * 16; gl[q][0] = *(const v4u*)gp; gl[q][1] = *(const v4u*)(gp + 8); }
#pragma unroll
                for (int q = 0; q < 4; ++q) { const size_t m = (size_t)(m0 + q * NGW); f32x4 z = gbv;
                    const unsigned gu[8] = {gl[q][0].x, gl[q][0].y, gl[q][0].z, gl[q][0].w, gl[q][1].x, gl[q][1].y, gl[q][1].z, gl[q][1].w};
#pragma unroll
                    for (int r2 = 0; r2 < 8; ++r2) { z = z + gwr[2 * r2] * __uint_as_float(gu[r2] << 16); z = z + gwr[2 * r2 + 1] * __uint_as_float(gu[r2] & 0xffff0000u); }
                    f32x4 o4;
#pragma unroll
                    for (int i = 0; i < 4; ++i) o4[i] = (fminf(z[i], 0.f) - __logf(1.f + __expf(-fabsf(z[i])))) * (1.f / 16.f);
                    *(f32x4*)(LA + m * 256 + dir * 128 + kc) = o4; } }
              __syncthreads(); }
            STAMP2(4);
            { __syncthreads();
              { const v4u* src = (const v4u*)WSP(bf16, WS_FTAB); LAS v4u* dst = (LAS v4u*)(lds + RING_OFF + FFT_LDS_TAB); for (int i = tid; i < 3 * FT_TAB * 2 / 16; i += NWAVES * 64) dst[i] = src[i];
                const v4u* s2_ = (const v4u*)WSP(float, WS_TW); LAS v4u* d2_ = (LAS v4u*)(lds + RING_OFF + FFT_LDS_TW); for (int i = tid; i < 4096 * 8 / 16; i += NWAVES * 64) d2_[i] = s2_[i]; }
              __syncthreads();
              const LAS bf16* FT = (const LAS bf16*)(lds + RING_OFF + FFT_LDS_TAB); const LAS float* TWL = (const LAS float*)(lds + RING_OFF + FFT_LDS_TW); bf16* FTMP = WSP(bf16, WS_FTMP);
              const int pair = wave >> 1, cb = wave & 1, r = lane & 31, h = lane >> 5;
              for (int ub = bx; ub < NB * 4 * 64 / 4; ub += G) { const int u = ub * 4 + pair, s2 = u & 63, g4 = (u >> 6) & 3, b = u >> 8;
                bf16x8 xa[2][4];
#pragma unroll
                for (int R = 0; R < 2; ++R)
#pragma unroll
                    for (int ks = 0; ks < 4; ++ks) xa[R][ks] = *(const bf16x8*)(PROJ + ((size_t)b * SEQ + 64 * (32 * R + r) + s2) * INP + C_FX + g4 * 64 + 16 * ks + 8 * h);
                f32x16 Tr[2], Ti[2];
#pragma unroll
                for (int R = 0; R < 2; ++R)
#pragma unroll
                    for (int i = 0; i < 16; ++i) { Tr[R][i] = 0.f; Ti[R][i] = 0.f; }
#pragma unroll
                for (int ks = 0; ks < 4; ++ks) { const bf16x8 bc = *(const LAS bf16x8*)(FT + (32 * cb + r) * FT_PITCH + 16 * ks + 8 * h), bs = *(const LAS bf16x8*)(FT + 2 * FT_TAB + (32 * cb + r) * FT_PITCH + 16 * ks + 8 * h);
#pragma unroll
                    for (int R = 0; R < 2; ++R) { Tr[R] = MFMA32(xa[R][ks], bc, Tr[R]); Ti[R] = MFMA32(xa[R][ks], bs, Ti[R]); } }
#pragma unroll
                for (int Rp = 0; Rp < 2; ++Rp) { f32x16 Gr, Gi;
#pragma unroll
                    for (int i = 0; i < 16; ++i) { Gr[i] = 0.f; Gi[i] = 0.f; }
#pragma unroll
                    for (int R = 0; R < 2; ++R)
#pragma unroll
                        for (int s_ = 0; s_ < 2; ++s_) { const bf16x8 xr = pack_step(Tr[R], s_), xi = pack_step(Ti[R], s_);
                            const int kb = 32 * R + 16 * s_ + 4 * h, ro = (32 * Rp + r) * FT_PITCH + kb;
                            const s16x4 c0 = *(const LAS s16x4*)(FT + ro), c1 = *(const LAS s16x4*)(FT + ro + 8), s0 = *(const LAS s16x4*)(FT + FT_TAB + ro), s1 = *(const LAS s16x4*)(FT + FT_TAB + ro + 8),
                                        n0 = *(const LAS s16x4*)(FT + 2 * FT_TAB + ro), n1 = *(const LAS s16x4*)(FT + 2 * FT_TAB + ro + 8);
                            const bf16x8 ca = __builtin_shufflevector(c0, c1, 0, 1, 2, 3, 4, 5, 6, 7), sa = __builtin_shufflevector(s0, s1, 0, 1, 2, 3, 4, 5, 6, 7), na = __builtin_shufflevector(n0, n1, 0, 1, 2, 3, 4, 5, 6, 7);
                            Gr = MFMA32(ca, xr, Gr); Gr = MFMA32(sa, xi, Gr); Gi = MFMA32(ca, xi, Gi); Gi = MFMA32(na, xr, Gi); }
#pragma unroll
                    for (int i = 0; i < 16; ++i) { const int s1p = 32 * Rp + crow16(i, h); const int m = (s2 * s1p) & 4095; const float wr = TWL[2 * m], wi = TWL[2 * m + 1];
                        const size_t o = ((((size_t)(b * 4 + g4) * 64 + s1p) * 2) * 64 + s2) * 64 + 32 * cb + r;
                        FTMP[o] = (bf16)f2bf(Gr[i] * wr - Gi[i] * wi); FTMP[o + 4096] = (bf16)f2bf(Gr[i] * wi + Gi[i] * wr); } }
              }
              __syncthreads(); }
            STAMP2(5);
            { float* GS = WSP(float, WS_OF); float* GD = WSP(float, WS_OB);
              const int slot = wave >> 2, w4 = wave & 3, fr = lane & 15, fq = lane >> 4; LAS unsigned char* Ls = lds + RING_OFF + slot * GM_SLOT;
              for (int ub = bx; ub < NB * 4 * 64 / 2; ub += G) { const int u = ub * 2 + slot, c = u & 63, bh = u >> 6, hd = bh & 3, b = bh >> 2; const size_t tok0 = (size_t)b * SEQ + c * 64;
                __syncthreads();
                gla_stage_mfma<false>(Ls, PROJ, LA, nullptr, tok0, hd, w4, lane);
                __syncthreads();
                const LAS bf16* VT = (const LAS bf16*)(Ls + GM_VT); const LAS float* DL = (const LAS float*)(Ls + GM_DL);
#pragma unroll
                for (int dir = 0; dir < 2; ++dir) { const LAS bf16* KT = (const LAS bf16*)(Ls + GM_P + dir * 4608);
#pragma unroll
                    for (int Cd = 0; Cd < 2; ++Cd) { f32x4 acc = {0.f, 0.f, 0.f, 0.f};
#pragma unroll
                        for (int ks = 0; ks < 2; ++ks) { const bf16x8 a_ = *(const LAS bf16x8*)(VT + (16 * w4 + fr) * 72 + 32 * ks + 8 * fq), b_ = *(const LAS bf16x8*)(KT + (16 * Cd + fr) * 72 + 32 * ks + 8 * fq); acc = MFMA16(a_, b_, acc); }
                        const float Dd = DL[dir * 32 + 16 * Cd + fr]; float* o = GS + (((size_t)u * 2 + dir) * 64 + 16 * w4 + 4 * fq) * 32 + 16 * Cd + fr;
#pragma unroll
                        for (int r = 0; r < 4; ++r) o[r * 32] = acc[r] * Dd; } }
                if (w4 == 3) GD[((size_t)u * 2 + (lane >> 5)) * 32 + (lane & 31)] = DL[lane]; }
              __syncthreads(); }
            STAMP2(9);
        }
        SEAM(pb + 1);
        if (IN(pb + 2) && PON(3)) {
            TID_SETUP(); unsigned char* ws = KWS(); float* GS = WSP(float, WS_OF); const float* GD = WSP(float, WS_OB);
            for (int e = gt; e < NB * 4 * 2 * 2048; e += NGT) { const int dv = e & 2047, dir = (e >> 11) & 1, bh = e >> 12, d = dv & 31; float H = 0.f;
                for (int c8 = 0; c8 < 64; c8 += 8) { float sv[8], dd[8];
#pragma unroll
                    for (int i = 0; i < 8; ++i) { const int c = dir ? 63 - (c8 + i) : (c8 + i); const size_t sidx = ((size_t)(bh * 64 + c) * 2 + dir); sv[i] = GS[sidx * 2048 + dv]; dd[i] = GD[sidx * 32 + d]; }
#pragma unroll
                    for (int i = 0; i < 8; ++i) { const int c = dir ? 63 - (c8 + i) : (c8 + i); const size_t sidx = ((size_t)(bh * 64 + c) * 2 + dir); GS[sidx * 2048 + dv] = H; H = H * dd[i] + sv[i]; } } }
        }
        SEAM(pb + 2);
        if (IN(pb + 3) && PON(4)) {
            TID_SETUP(); unsigned char* ws = KWS(); const float* gla_norm_g = KIN(8); const bf16* PROJ = WSP(bf16, WS_PROJ);
            bf16* MIX = WSP(bf16, WS_MIX); const bf16* QB = WSP(bf16, WS_QB); const bf16* KB = WSP(bf16, WS_KB);
            STAMP2(10);
            { __syncthreads();
              { const v4u* src = (const v4u*)WSP(bf16, WS_FTAB); LAS v4u* dst = (LAS v4u*)(lds + RING_OFF + FFT_LDS_TAB); for (int i = tid; i < 3 * FT_TAB * 2 / 16; i += NWAVES * 64) dst[i] = src[i]; }
              const LAS bf16* FT = (const LAS bf16*)(lds + RING_OFF + FFT_LDS_TAB); const bf16* FTMP = WSP(bf16, WS_FTMP);
              const int pair = wave >> 1, cb = wave & 1, r = lane & 31, h = lane >> 5;
              LAS bf16* HT = (LAS bf16*)(lds + RING_OFF + FFT_LDS_HT + pair * FFT_HT_PAIR);
              for (int ub = bx; ub < NB * 4 * 64 / 4; ub += G) { const int u = ub * 4 + pair, s1p = u & 63, g4 = (u >> 6) & 3, b = u >> 8;
                const bf16* src = FTMP + (size_t)u * 2 * 4096;
                __syncthreads();
#pragma unroll
                for (int q = 0; q < 8; ++q) { const int p = cb * 64 + lane + 128 * q, ri = p >> 9, s2 = (p >> 3) & 63, c0 = (p & 7) * 8; const u16x8 v = *(const u16x8*)(src + p * 8);
#pragma unroll
                    for (int i = 0; i < 8; ++i) HT[(ri * 64 + c0 + i) * FT_PITCH + s2] = v[i]; }
                __syncthreads();
#pragma unroll
                for (int Rp = 0; Rp < 2; ++Rp) { f32x16 acc;
#pragma unroll
                    for (int i = 0; i < 16; ++i) acc[i] = 0.f;
#pragma unroll
                    for (int ks = 0; ks < 4; ++ks) { const int ko = 16 * ks + 8 * h;
                        const bf16x8 ca = *(const LAS bf16x8*)(FT + (32 * Rp + r) * FT_PITCH + ko), sa = *(const LAS bf16x8*)(FT + FT_TAB + (32 * Rp + r) * FT_PITCH + ko);
                        const bf16x8 hr = *(const LAS bf16x8*)(HT + (32 * cb + r) * FT_PITCH + ko), hi_ = *(const LAS bf16x8*)(HT + (64 + 32 * cb + r) * FT_PITCH + ko);
                        acc = MFMA32(ca, hr, acc); acc = MFMA32(sa, hi_, acc); }
#pragma unroll
                    for (int i = 0; i < 16; ++i) { const int s2p = 32 * Rp + crow16(i, h); MIX[((size_t)b * SEQ + s1p + 64 * s2p) * DM + 768 + g4 * 64 + 32 * cb + r] = (bf16)f2bf(acc[i] * (1.0f / 512.0f)); } }
              }
              __syncthreads(); }
            STAMP2(6);
            { const float* GS = WSP(float, WS_OF); const float* LA = WSP(float, WS_LA);
              const int slot = wave >> 2, w4 = wave & 3, fr = lane & 15, fq = lane >> 4, I0 = 16 * w4; LAS unsigned char* Ls = lds + RING_OFF + slot * GM_SLOT;
              for (int ub = bx; ub < NB * 4 * 64 / 2; ub += G) { const int u = ub * 2 + slot, c = u & 63, bh = u >> 6, hd = bh & 3, b = bh >> 2; const size_t tok0 = (size_t)b * SEQ + c * 64;
                unsigned short rgv[4][4]; float gnv[4];
#pragma unroll
                for (int Cv = 0; Cv < 4; ++Cv) { gnv[Cv] = gla_norm_g[l * 64 + 16 * Cv + fr];
#pragma unroll
                    for (int r = 0; r < 4; ++r) rgv[Cv][r] = PROJ[(tok0 + I0 + 4 * fq + r) * INP + C_GR + hd * 64 + 16 * Cv + fr]; }
                __syncthreads();
                gla_stage_mfma<true>(Ls, PROJ, LA, GS + (size_t)u * 2 * 2048, tok0, hd, w4, lane);
                __syncthreads();
                const LAS bf16* QF = (const LAS bf16*)(Ls + GM_QF); const LAS bf16* KF = (const LAS bf16*)(Ls + GM_KF); const LAS bf16* QBm = (const LAS bf16*)(Ls + GM_QB); const LAS bf16* KBm = (const LAS bf16*)(Ls + GM_KB);
                const LAS bf16* VT = (const LAS bf16*)(Ls + GM_VT); LAS bf16* P = (LAS bf16*)(Ls + GM_P); const LAS bf16* HTF = (const LAS bf16*)(Ls + GM_HTF); const LAS bf16* HTB = (const LAS bf16*)(Ls + GM_HTB);
                const bf16x8 qfa = *(const LAS bf16x8*)(QF + (I0 + fr) * 40 + 8 * fq), qba = *(const LAS bf16x8*)(QBm + (I0 + fr) * 40 + 8 * fq);
#pragma unroll
                for (int Cj = 0; Cj < 4; ++Cj) { const f32x4 z = {0.f, 0.f, 0.f, 0.f};
                    const f32x4 pf = MFMA16(qfa, *(const LAS bf16x8*)(KF + (16 * Cj + fr) * 40 + 8 * fq), z), pb = MFMA16(qba, *(const LAS bf16x8*)(KBm + (16 * Cj + fr) * 40 + 8 * fq), z);
#pragma unroll
                    for (int r = 0; r < 4; ++r) { const int i = I0 + 4 * fq + r, j = 16 * Cj + fr; P[i * 72 + j] = (bf16)f2bf(j <= i ? pf[r] : pb[r]); } }
                asm volatile("s_waitcnt lgkmcnt(0)" ::: "memory");
                f32x4 o[4];
#pragma unroll
                for (int Cv = 0; Cv < 4; ++Cv) { f32x4 acc = {0.f, 0.f, 0.f, 0.f};
#pragma unroll
                    for (int ks = 0; ks < 2; ++ks) acc = MFMA16(*(const LAS bf16x8*)(P + (I0 + fr) * 72 + 32 * ks + 8 * fq), *(const LAS bf16x8*)(VT + (16 * Cv + fr) * 72 + 32 * ks + 8 * fq), acc);
                    acc = MFMA16(qfa, *(const LAS bf16x8*)(HTF + (16 * Cv + fr) * 40 + 8 * fq), acc); acc = MFMA16(qba, *(const LAS bf16x8*)(HTB + (16 * Cv + fr) * 40 + 8 * fq), acc);
                    o[Cv] = acc; }
                float rs[4];
#pragma unroll
                for (int r = 0; r < 4; ++r) { float ss = (o[0][r] * o[0][r] + o[1][r] * o[1][r]) + (o[2][r] * o[2][r] + o[3][r] * o[3][r]);
#pragma unroll
                    for (int m_ = 1; m_ < 16; m_ <<= 1) ss += __shfl_xor(ss, m_);
                    rs[r] = 1.f / sqrtf(ss * (1.f / 64.f) + RMS_EPS); }
#pragma unroll
                for (int Cv = 0; Cv < 4; ++Cv) { const int v = 16 * Cv + fr; const float gn = gnv[Cv];
#pragma unroll
                    for (int r = 0; r < 4; ++r) { const size_t m = tok0 + I0 + 4 * fq + r; const float rg = bf2f(rgv[Cv][r]);
                        MIX[m * DM + 512 + hd * 64 + v] = (bf16)f2bf(o[Cv][r] * rs[r] * gn * rg * __builtin_amdgcn_rcpf(1.f + __expf(-rg))); } } }
              __syncthreads(); }
            STAMP2(7);
#if NAIVE_ATTN
            { LAS float* Kt = (LAS float*)(lds + RING_OFF); LAS float* Vt = Kt + 64 * 64;
              for (int unit = bx; unit < NB * 8 * 8; unit += G) { const int rb = unit & 7, h = (unit >> 3) & 7, b = unit >> 6, kvh = h >> 2;
                const size_t qrow = (size_t)b * SEQ + rb * 512 + tid;
                float q[64], o[64]; float mrun = -INFINITY, lrun = 0.f;
#pragma unroll
                for (int c8 = 0; c8 < 8; ++c8) { const u16x8 f = *(const u16x8*)(QB + qrow * 512 + h * 64 + c8 * 8);
#pragma unroll
                    for (int i = 0; i < 8; ++i) { q[c8 * 8 + i] = bf2f(f[i]); o[c8 * 8 + i] = 0.f; } }
                for (int kt = 0; kt < SEQ; kt += 64) {
                    __syncthreads();
                    { const int kr = tid >> 3, c8 = (tid & 7) * 8; const size_t krow = (size_t)b * SEQ + kt + kr;
                      const u16x8 kf = *(const u16x8*)(KB + krow * 128 + kvh * 64 + c8); const u16x8 vf = *(const u16x8*)(PROJ + krow * INP + C_AV + kvh * 64 + c8);
#pragma unroll
                      for (int i = 0; i < 8; ++i) { Kt[kr * 64 + c8 + i] = bf2f(kf[i]); Vt[kr * 64 + c8 + i] = bf2f(vf[i]); } }
                    __syncthreads();
#pragma unroll 1
                    for (int j = 0; j < 64; ++j) { float a = 0.f;
#pragma unroll
                        for (int d4 = 0; d4 < 16; ++d4) { const f32x4 kv = *(const LAS f32x4*)(Kt + j * 64 + d4 * 4); a += (q[d4 * 4] * kv.x + q[d4 * 4 + 1] * kv.y) + (q[d4 * 4 + 2] * kv.z + q[d4 * 4 + 3] * kv.w); }
                        if (a > mrun) { const float al = exp2f(mrun - a); mrun = a; lrun *= al;
#pragma unroll
                            for (int d = 0; d < 64; ++d) o[d] *= al; }
                        const float p = exp2f(a - mrun); lrun += p;
#pragma unroll
                        for (int d4 = 0; d4 < 16; ++d4) { const f32x4 vv = *(const LAS f32x4*)(Vt + j * 64 + d4 * 4); o[d4 * 4] += p * vv.x; o[d4 * 4 + 1] += p * vv.y; o[d4 * 4 + 2] += p * vv.z; o[d4 * 4 + 3] += p * vv.w; } }
                }
                const float rl = 1.f / lrun;
#pragma unroll
                for (int c8 = 0; c8 < 8; ++c8) { v4u w; w.x = pk2(o[c8 * 8] * rl, o[c8 * 8 + 1] * rl); w.y = pk2(o[c8 * 8 + 2] * rl, o[c8 * 8 + 3] * rl); w.z = pk2(o[c8 * 8 + 4] * rl, o[c8 * 8 + 5] * rl); w.w = pk2(o[c8 * 8 + 6] * rl, o[c8 * 8 + 7] * rl);
                    *(v4u*)(MIX + qrow * DM + h * 64 + c8 * 8) = w; }
              }
              __syncthreads(); }
#else
            { const attn_body::AttnTensors AT{(const attn_body::bf16*)QB, (const attn_body::bf16*)KB, (const attn_body::bf16*)(PROJ + C_AV), (attn_body::bf16*)MIX};
              const attn_body::StaticOrder S(G, bx);
              attn_body::attn_phase<attn_body::StaticOrder>((char*)lds_raw + RING_OFF, AT, S); }
#endif
            STAMP2(11);
        }
        SEAM(pb + 3);
        if (IN(pb + 4) && PON(5)) {
            TID_SETUP(); unsigned char* ws = KWS(); const bf16* MIX = WSP(bf16, WS_MIX); const bf16* WOUT_T = WSP(bf16, WS_WOUT_T); const bf16* HB = WSP(bf16, WS_HB); bf16* T1 = WSP(bf16, WS_T1);
            pg8::Gemm g{MIX, WOUT_T + (size_t)l * DM * DM, NTOK, DM, DM}; pg8::StaticOrder S; S.init(NTOK, DM, G, bx);
            pg8::EpiResBf16 E{HB, T1, DM, DN_ALPHA};
            pg8::gemm_phase<pg8::EpiResBf16, pg8::StaticOrder, true, true>(lds + RING_OFF, g, S, E);
        }
        SEAM(pb + 4);
        if (IN(pb + 5) && PON(6)) {
            TID_SETUP(); unsigned char* ws = KWS(); gu32* ctl = (gu32*)(ws + WS_CTL); const float* ln1_g = KIN(10); const float* ln1_b = KIN(11); const float* router_w = KIN(12); const float* router_b = KIN(13);
            const bf16* T1 = WSP(bf16, WS_T1); bf16* HB = WSP(bf16, WS_HB); int* TOKE = WSP(int, WS_TOK); int* TOKS = TOKE + NTOK * 4; float* TOKW = (float*)(TOKS + NTOK * 4); int* LIST = WSP(int, WS_XS);
            { const v4u* src = (const v4u*)(WSP(bf16, WS_RWT) + (size_t)l * 2 * NE * DM); LAS v4u* dst = (LAS v4u*)(lds + RING_OFF);
              for (int i = tid; i < 2 * NE * DM * 2 / 16; i += NWAVES * 64) { const int row = i >> 7, c = i & 127; dst[row * 128 + (c ^ (row & 7))] = src[i]; }
              LAS float* GBw = (LAS float*)(lctl + LC_ROWS); for (int i = tid; i < DM; i += NWAVES * 64) { GBw[i] = ln1_g[l * DM + i]; GBw[DM + i] = ln1_b[l * DM + i]; } }
            const LAS bf16* RWH = (const LAS bf16*)(lds + RING_OFF); const LAS float* GB = (const LAS float*)(lctl + LC_ROWS); LAS float* ST = (LAS float*)(lctl + LC_ROWS + 8192);
            LAS int* lcnt = (LAS int*)(lctl + LC_CNT); LAS int* lbase = (LAS int*)(lctl + LC_BASE); LAS int* sele = (LAS int*)(lctl + LC_SELE); LAS int* sels = (LAS int*)(lctl + LC_SELS);
            const float* rb = router_b + l * NE;
            for (int r0 = bx * 128; r0 < NTOK; r0 += G * 128) {
                if (tid < 32) lcnt[tid] = 0;
                __syncthreads();
                LAS float* LG = (LAS float*)(lctl + LC_LG) + wave * 512;
                for (int rr = 0; rr < 16; rr += 4) { f32x4 v[4][4];
#pragma unroll
                    for (int q = 0; q < 4; ++q) row_load_bf16(v[q], T1 + ((size_t)r0 + wave * 16 + rr + q) * DM, lane);
#pragma unroll
                    for (int q = 0; q < 4; ++q) { float s_ = 0.f;
#pragma unroll
                        for (int j = 0; j < 4; ++j) s_ += (v[q][j].x + v[q][j].y) + (v[q][j].z + v[q][j].w);
                        const float mean = wave_sum(s_) * (1.f / DM); float s2_ = 0.f;
#pragma unroll
                        for (int j = 0; j < 4; ++j) { const f32x4 d_ = v[q][j] - mean; s2_ += (d_.x * d_.x + d_.y * d_.y) + (d_.z * d_.z + d_.w * d_.w); }
                        const float rstd = __builtin_amdgcn_rsqf(wave_sum(s2_) * (1.f / DM) + LN_EPS);
                        if (lane == 0) { ST[(wave * 16 + rr + q) * 2] = mean; ST[(wave * 16 + rr + q) * 2 + 1] = rstd; } } }
                asm volatile("s_waitcnt lgkmcnt(0)" ::: "memory");
                { const int fr = lane & 15, fq = lane >> 4; const size_t row = (size_t)r0 + wave * 16 + fr; const float mean = ST[(wave * 16 + fr) * 2], rstd = ST[(wave * 16 + fr) * 2 + 1];
                  const bf16* xrow = T1 + row * DM + 8 * fq; bf16* hrow = HB + row * DM + 8 * fq;
                  f32x4 acc0 = {0.f, 0.f, 0.f, 0.f}, acc1 = {0.f, 0.f, 0.f, 0.f};
#pragma unroll 1
                  for (int s8 = 0; s8 < 32; s8 += 8) { v4u xr[8];
#pragma unroll
                    for (int i = 0; i < 8; ++i) xr[i] = *(const v4u*)(xrow + 32 * (s8 + i));
#pragma unroll
                    for (int i = 0; i < 8; ++i) { const int k0 = 32 * (s8 + i) + 8 * fq;
                        const f32x4 g0 = *(const LAS f32x4*)(GB + k0), g1 = *(const LAS f32x4*)(GB + k0 + 4), b0 = *(const LAS f32x4*)(GB + DM + k0), b1 = *(const LAS f32x4*)(GB + DM + k0 + 4);
                        f32x4 x0 = {__uint_as_float(xr[i].x << 16), __uint_as_float(xr[i].x & 0xffff0000u), __uint_as_float(xr[i].y << 16), __uint_as_float(xr[i].y & 0xffff0000u)};
                        f32x4 x1 = {__uint_as_float(xr[i].z << 16), __uint_as_float(xr[i].z & 0xffff0000u), __uint_as_float(xr[i].w << 16), __uint_as_float(xr[i].w & 0xffff0000u)};
                        x0 = (x0 - mean) * rstd * g0 + b0; x1 = (x1 - mean) * rstd * g1 + b1;
                        v4u hi; hi.x = pk2(x0.x, x0.y); hi.y = pk2(x0.z, x0.w); hi.z = pk2(x1.x, x1.y); hi.w = pk2(x1.z, x1.w);
                        *(v4u*)(hrow + 32 * (s8 + i)) = hi;
                        const f32x4 l0 = {x0.x - __uint_as_float(hi.x << 16), x0.y - __uint_as_float(hi.x & 0xffff0000u), x0.z - __uint_as_float(hi.y << 16), x0.w - __uint_as_float(hi.y & 0xffff0000u)};
                        const f32x4 l1 = {x1.x - __uint_as_float(hi.z << 16), x1.y - __uint_as_float(hi.z & 0xffff0000u), x1.z - __uint_as_float(hi.w << 16), x1.w - __uint_as_float(hi.w & 0xffff0000u)};
                        v4u lo; lo.x = pk2(l0.x, l0.y); lo.y = pk2(l0.z, l0.w); lo.z = pk2(l1.x, l1.y); lo.w = pk2(l1.z, l1.w);
                        const bf16x8 ah = __builtin_bit_cast(bf16x8, hi), al = __builtin_bit_cast(bf16x8, lo);
                        const int c = 4 * (s8 + i) + fq;
                        const LAS bf16* w0 = RWH + fr * DM + ((c ^ (fr & 7)) << 3); const LAS bf16* w1 = RWH + (16 + fr) * DM + ((c ^ (fr & 7)) << 3);
                        const bf16x8 bh0 = *(const LAS bf16x8*)w0, bl0 = *(const LAS bf16x8*)(w0 + NE * DM), bh1 = *(const LAS bf16x8*)w1, bl1 = *(const LAS bf16x8*)(w1 + NE * DM);
                        acc0 = MFMA16(ah, bh0, acc0); acc0 = MFMA16(ah, bl0, acc0); acc0 = MFMA16(al, bh0, acc0);
                        acc1 = MFMA16(ah, bh1, acc1); acc1 = MFMA16(ah, bl1, acc1); acc1 = MFMA16(al, bh1, acc1); } }
                  const float bias0 = rb[fr], bias1 = rb[16 + fr];
#pragma unroll
                  for (int r = 0; r < 4; ++r) { LG[(4 * fq + r) * 32 + fr] = acc0[r] + bias0; LG[(4 * fq + r) * 32 + 16 + fr] = acc1[r] + bias1; } }
                asm volatile("s_waitcnt lgkmcnt(0)" ::: "memory");
                if (lane < 16) { const int lr = wave * 16 + lane; const size_t m = (size_t)r0 + lr; float lg[32];
#pragma unroll
                    for (int e4 = 0; e4 < 8; ++e4) { const f32x4 x = *(const LAS f32x4*)(LG + lane * 32 + e4 * 4); lg[e4 * 4] = x.x; lg[e4 * 4 + 1] = x.y; lg[e4 * 4 + 2] = x.z; lg[e4 * 4 + 3] = x.w; }
                    int se[4]; float sv[4];
#pragma unroll
                    for (int k = 0; k < 4; ++k) { float best = -INFINITY; int bi = 0;
#pragma unroll
                        for (int e = 0; e < 32; ++e) { if (lg[e] > best) { best = lg[e]; bi = e; } }
                        se[k] = bi; sv[k] = best;
#pragma unroll
                        for (int e = 0; e < 32; ++e) if (e == bi) lg[e] = -INFINITY; }
                    const float e1 = expf(sv[1] - sv[0]), e2 = expf(sv[2] - sv[0]), e3 = expf(sv[3] - sv[0]); const float inv = 1.f / (1.f + e1 + e2 + e3);
                    const float wts[4] = {inv, e1 * inv, e2 * inv, e3 * inv};
#pragma unroll
                    for (int k = 0; k < 4; ++k) { const int ls = __hip_atomic_fetch_add(lcnt + se[k], 1, __ATOMIC_RELAXED, __HIP_MEMORY_SCOPE_WORKGROUP); sele[lr * 4 + k] = se[k]; sels[lr * 4 + k] = ls; TOKW[m * 4 + k] = wts[k]; } }
                __syncthreads();
                if (tid < 32) lbase[tid] = (int)__hip_atomic_fetch_add(ctl + CW_CNT + l * 32 + tid, (unsigned)lcnt[tid], RLX_AGENT);
                __syncthreads();
                { const int e = sele[tid], sl = lbase[e] + sels[tid]; TOKE[(size_t)r0 * 4 + tid] = e; TOKS[(size_t)r0 * 4 + tid] = sl; LIST[(size_t)e * NTOK + sl] = r0 + (tid >> 2); }
                __syncthreads();
            }
        }
        SEAM(pb + 5);
#if defined(EXP_P1_NOEPI)
        if (IN(pb + 6)) {
            TID_SETUP(); unsigned char* ws = KWS(); bf16* HB = WSP(bf16, WS_HB); bf16* WIN_T = WSP(bf16, WS_WIN_T); bf16* PROJ = WSP(bf16, WS_PROJ);
            pg8::Gemm g{HB, WIN_T + (size_t)l * INP * DM, NTOK, INP, DM}; pg8::StaticOrder S; S.init(NTOK, INP, G, bx);
            pg8::EpiNull EN{PROJ}; pg8::gemm_phase<pg8::EpiNull, pg8::StaticOrder, true, true>(lds + RING_OFF, g, S, EN);
            __syncthreads(); }
#endif
        STAMP(pb + 7);
        if (IN(pb + 7) || IN(pb + 8) || IN(pb + 9)) {
            LAS int* pst = (LAS int*)(lctl + LC_PSTART); LAS int* ecnt = (LAS int*)(lctl + LC_BASE); gu32* ctl = (gu32*)(KWS() + WS_CTL);
            __syncthreads();
            if (threadIdx.x == 0) { int acc = 0; for (int e = 0; e < NE; ++e) { pst[e] = acc; const int c = (int)__hip_atomic_load(ctl + CW_CNT + l * 32 + e, RLX_AGENT); ecnt[e] = c; acc += (c + 255) >> 8; } pst[NE] = acc; }
            __syncthreads();
        }
        if (IN(pb + 7) && PON(8)) {
            TID_SETUP(); unsigned char* ws = KWS(); const float* exp_b_gu = KIN(15); const bf16* HB = WSP(bf16, WS_HB); const int* LIST = WSP(int, WS_XS); const bf16* WGU_T = WSP(bf16, WS_WGU_T); bf16* HID = WSP(bf16, WS_HID);
            const LAS int* pst = (const LAS int*)(lctl + LC_PSTART); LAS int* ul = (LAS int*)(lctl + LC_ULIST);
            const int nM = pst[NE], nN = 8, nwg = nM * nN;
            if (tid < 64) { const long L = (long)tid * G + bx; int v = -1;
                if (L < nwg) { int wgid = (int)L; { const int q = nwg / 8, r = nwg % 8, xcd = wgid % 8, off = wgid / 8; wgid = (xcd < r ? xcd * (q + 1) : r * (q + 1) + (xcd - r) * q) + off; }
                    const int nig = 8 * nN, gid = wgid / nig, fm = gid * 8, gsz = (nM - fm) < 8 ? (nM - fm) : 8; const int pm = fm + ((wgid % nig) % gsz), pn = (wgid % nig) / gsz;
                    int e = 0; for (int k = 1; k < NE; ++k) if (pst[k] <= pm) e = k;
                    v = (pm << 16) | (e * nN + pn); }
                ul[tid] = v; }
            __syncthreads();
            const int nunits = bx < nwg ? (nwg - bx + G - 1) / G : 0;
            LAS unsigned short* rows16 = (LAS unsigned short*)(lctl + LC_ROWS); const LAS int* ecnt = (const LAS int*)(lctl + LC_BASE);
            for (int sl = 0; sl < nunits; ++sl) { const int v = ul[sl]; const int pm = v >> 16, e = (v & 0xffff) >> 3, pl = pm - pst[e];
                if (tid < 256) { const int idx = pl * 256 + tid; rows16[sl * 256 + tid] = (idx < ecnt[e]) ? (unsigned short)LIST[(size_t)e * NTOK + idx] : (unsigned short)0; } }
            __syncthreads();
            pg8::Gemm g{HB, WGU_T + (size_t)l * NE * 2048 * DM, NTOK, NE * 2048, DM}; pg8::ListOrder S{ul, nunits};
            pg8::EpiSwiglu E{HID, exp_b_gu + (size_t)l * NE * 2048};
            pg8::gemm_phase_gather<pg8::EpiSwiglu, pg8::ListOrder, true>(lds + RING_OFF, g, S, E, rows16);
        }
        SEAM(pb + 7);
        if (IN(pb + 8) && PON(9)) {
            TID_SETUP(); unsigned char* ws = KWS(); const float* exp_b_down = KIN(17); const bf16* HID = WSP(bf16, WS_HID); const bf16* WDN_T = WSP(bf16, WS_WDN_T); bf16* YS = WSP(bf16, WS_YS);
            const LAS int* pst = (const LAS int*)(lctl + LC_PSTART); LAS int* ul = (LAS int*)(lctl + LC_ULIST);
            const int nM = pst[NE], nN = 4, nwg = nM * nN;
            __syncthreads();
            if (tid < 64) { const long L = (long)tid * G + bx; int v = -1;
                if (L < nwg) { int wgid = (int)L; { const int q = nwg / 8, r = nwg % 8, xcd = wgid % 8, off = wgid / 8; wgid = (xcd < r ? xcd * (q + 1) : r * (q + 1) + (xcd - r) * q) + off; }
                    const int nig = 8 * nN, gid = wgid / nig, fm = gid * 8, gsz = (nM - fm) < 8 ? (nM - fm) : 8; const int pm = fm + ((wgid % nig) % gsz), pn = (wgid % nig) / gsz;
                    int e = 0; for (int k = 1; k < NE; ++k) if (pst[k] <= pm) e = k;
                    v = (pm << 16) | (e * nN + pn); }
                ul[tid] = v; }
            __syncthreads();
            const int nunits = bx < nwg ? (nwg - bx + G - 1) / G : 0;
            pg8::Gemm g{HID, WDN_T + (size_t)l * NE * DM * DE, MPAD, NE * DM, DE}; pg8::ListOrder S{ul, nunits};
            pg8::EpiDown E{YS, exp_b_down + (size_t)l * NE * DM};
            pg8::gemm_phase<pg8::EpiDown, pg8::ListOrder, true, true>(lds + RING_OFF, g, S, E);
        }
        SEAM(pb + 8);
        if (IN(pb + 9) && PON(10)) {
            TID_SETUP(); unsigned char* ws = KWS(); const float* ln2_g = KIN(18); const float* ln2_b = KIN(19); float* out = KOUT(); bf16* HB = WSP(bf16, WS_HB);
            const bf16* YS = WSP(bf16, WS_YS); const int* TOKE = WSP(int, WS_TOK); const int* TOKS = TOKE + NTOK * 4; const float* TOKW = (const float*)(TOKS + NTOK * 4); const LAS int* pst = (const LAS int*)(lctl + LC_PSTART);
            const bool lastl = (l == NL - 1);
            f32x4 gam[4], bet[4];
#pragma unroll
            for (int j = 0; j < 4; ++j) { gam[j] = *(const f32x4*)(ln2_g + l * DM + RC(lane, j)); bet[j] = *(const f32x4*)(ln2_b + l * DM + RC(lane, j)); }
            for (int m0 = gw; m0 < NTOK; m0 += 2 * NGW) { f32x4 v[2][4]; const bf16* yr[2][4]; f32x4 wk[2];
#pragma unroll
                for (int q = 0; q < 2; ++q) { const int m = m0 + q * NGW; const v4u te = *(const v4u*)(TOKE + m * 4), ts = *(const v4u*)(TOKS + m * 4); wk[q] = *(const f32x4*)(TOKW + m * 4);
                    yr[q][0] = YS + (size_t)(pst[te.x] * 256 + (int)ts.x) * DM; yr[q][1] = YS + (size_t)(pst[te.y] * 256 + (int)ts.y) * DM; yr[q][2] = YS + (size_t)(pst[te.z] * 256 + (int)ts.z) * DM; yr[q][3] = YS + (size_t)(pst[te.w] * 256 + (int)ts.w) * DM;
                    row_load_bf16(v[q], HB + (size_t)m * DM, lane);
#pragma unroll
                    for (int j = 0; j < 4; ++j) v[q][j] = v[q][j] * DN_ALPHA; }
#pragma unroll
                for (int q = 0; q < 2; ++q)
#pragma unroll
                    for (int k = 0; k < 4; ++k) { f32x4 y[4]; row_load_bf16(y, yr[q][k], lane); const float w = wk[q][k];
#pragma unroll
                        for (int j = 0; j < 4; ++j) v[q][j] = v[q][j] + y[j] * w; }
#pragma unroll
                for (int q = 0; q < 2; ++q) { const int m = m0 + q * NGW; ln_row8(v[q], gam, bet);
                    if (lastl) {
#pragma unroll
                        for (int j = 0; j < 4; ++j) *(f32x4*)(out + (size_t)m * DM + RC(lane, j)) = v[q][j]; }
                    else row_store_bf16(v[q], HB + (size_t)m * DM, lane); } }
        }
        SEAM(pb + 9);
    }
#if PROBE_A >= 0
    { xcd_barrier(bar);
      const unsigned long long* st = (const unsigned long long*)(KWS() + WS_CTL + 65536); unsigned long long T = 0;
      if (PROBE_A & 1) T += st[1] - st[0];
      for (int l = 0; l < NL; ++l) for (int j = 1; j <= 10; ++j) if ((PROBE_A >> j) & 1) T += st[1 + 10 * l + j] - st[10 * l + j];
      if (PROBE_SUB_A >= 0) for (int l = 0; l < NL; ++l) T += st[128 + l * 16 + PROBE_SUB_B] - st[128 + l * 16 + PROBE_SUB_A];
      T *= 4ull; if (T > 5000000ull) T = 5000000ull;
      const unsigned long long t0 = __builtin_amdgcn_s_memrealtime();
      while (__builtin_amdgcn_s_memrealtime() - t0 < T) __builtin_amdgcn_s_sleep(16); }
#endif
#undef IN
#undef SEAM
}

#ifndef MK_PER_PHASE
#define MK_PER_PHASE 0
#endif
extern "C" void kernel_launch(void* const* d_in, const int* in_sizes, int n_in, void* d_out, int out_size, void* d_ws, size_t ws_size, hipStream_t stream) {
    static int grid = 0;
    if (grid == 0) {
        if (n_in != 20 || in_sizes[0] != NTOK * DM || out_size != NTOK * DM || ws_size < WS_END) { fprintf(stderr, "kernel_launch: unexpected shapes (n_in %d, in0 %d, out %d, ws %zu); nothing launched\n", n_in, n_in > 0 ? in_sizes[0] : -1, out_size, ws_size); grid = -1; return; }
        int dev = 0, cus = 0, per_cu = 0;
        if (hipGetDevice(&dev) != hipSuccess || hipDeviceGetAttribute(&cus, hipDeviceAttributeMultiprocessorCount, dev) != hipSuccess) { grid = -1; return; }
        if (hipFuncSetAttribute((const void*)fwd, hipFuncAttributeMaxDynamicSharedMemorySize, LDS_BYTES) != hipSuccess) { fprintf(stderr, "kernel_launch: hipFuncSetAttribute failed\n"); grid = -1; return; }
        if (hipOccupancyMaxActiveBlocksPerMultiprocessor(&per_cu, (const void*)fwd, NWAVES * 64, LDS_BYTES) != hipSuccess || per_cu < 1) fprintf(stderr, "kernel_launch: occupancy query reports %d\n", per_cu);
        (void)hipGetLastError();
        grid = cus;
    }
    if (grid < 0) return;
    if (hipMemsetAsync((char*)d_ws + WS_CTL, 0, CTL_ZERO_BYTES, stream) != hipSuccess) return;
    Args a{};
    for (int i = 0; i < 20; ++i) a.in[i] = (const float*)d_in[i];
    a.out = (float*)d_out; a.ws = (unsigned char*)d_ws;
#if MK_PER_PHASE
    for (int p = 0; p < N_PHASES; ++p) { a.ph_lo = p; a.ph_hi = p + 1; hipLaunchKernelGGL(fwd, dim3(grid), dim3(NWAVES * 64), LDS_BYTES, stream, a); }
#else
    a.ph_lo = 0; a.ph_hi = N_PHASES;
    hipLaunchKernelGGL(fwd, dim3(grid), dim3(NWAVES * 64), LDS_BYTES, stream, a);
#endif
    const hipError_t le = hipPeekAtLastError();
    if (le != hipSuccess) fprintf(stderr, "kernel_launch: launch failed: %s\n", hipGetErrorName(le));
}
```

```cpp
#include <hip/hip_runtime.h>
#include <hip/hip_bf16.h>
#include <cstdio>
#include <cstdint>
#include <cmath>
namespace pg8 {
#define PG8_LAS __attribute__((address_space(3)))
typedef unsigned short bf16_t;
typedef short bf16x8 __attribute__((ext_vector_type(8)));
typedef float f32x4 __attribute__((ext_vector_type(4)));
typedef unsigned u32x4 __attribute__((ext_vector_type(4)));
constexpr int BM = 256, BK = 64, HALF = 128, HTB = HALF * BK * 2  , STAGE_BYTES = 8 * HTB, NXCD = 8, WGM = 8;

__host__ __device__ __forceinline__ int lds_byte(int r, int c) { const int st = (r >> 4) * 2 + (c >> 5), rr = r & 15, cc = c & 31, ob = rr * 64 + cc * 2; return st * 1024 + (ob ^ (((ob >> 9) & 1) << 5)); }
__host__ __device__ __forceinline__ void stage_rc(int b, int& R, int& C) { const int st = b / 1024, sb = b % 1024, swz = sb ^ (((sb >> 9) & 1) << 5); R = (st >> 1) * 16 + swz / 64; C = (st & 1) * 32 + (swz % 64) / 2; }
__host__ __device__ __forceinline__ int perm32(int rho) { const int n = rho >> 4, i = rho & 15; return 8 * (i >> 2) + 4 * n + (i & 3); }

struct Unit { int pm, pn; };
struct Gemm { const bf16_t* A; const bf16_t* Bt; int M, N, K; };

struct StaticOrder {
    int nM, nN, nwg, G, c;
    __host__ __device__ void init(int M, int N, int G_, int c_) { nM = M / BM; nN = N / BM; nwg = nM * nN; G = G_; c = c_; }
    __host__ __device__ bool next(int i, Unit& u) const {
        const long L = (long)i * G + c; if (L >= nwg) return false;
        int wgid = (int)L; { const int q = nwg / NXCD, r = nwg % NXCD, xcd = wgid % NXCD, off = wgid / NXCD; wgid = (xcd < r ? xcd * (q + 1) : r * (q + 1) + (xcd - r) * q) + off; }
        const int nig = WGM * nN, gid = wgid / nig, fm = gid * WGM, gsz = (nM - fm) < WGM ? (nM - fm) : WGM;
        u.pm = fm + ((wgid % nig) % gsz); u.pn = (wgid % nig) / gsz; return true;
    }
    __device__ __forceinline__ void a_ready(const Unit&) const {}
    __device__ __forceinline__ void done(const Unit&) const {}
};

__device__ __forceinline__ unsigned cvt_pk_bf16(float lo, float hi) { unsigned r; asm volatile("v_cvt_pk_bf16_f32 %0, %1, %2" : "=v"(r) : "v"(lo), "v"(hi)); return r; }
typedef float f32x2 __attribute__((ext_vector_type(2)));
__device__ __forceinline__ u32x4 pack8(const f32x4 v0, const f32x4 v1) { u32x4 w; w.x = cvt_pk_bf16(v0[0], v0[1]); w.y = cvt_pk_bf16(v0[2], v0[3]); w.z = cvt_pk_bf16(v1[0], v1[1]); w.w = cvt_pk_bf16(v1[2], v1[3]); return w; }

struct EpiPlainBf16 {
    static constexpr bool PERM = true, AFTER_DRAIN = false;
    bf16_t* O; int ldc;
    __device__ __forceinline__ void operator()(const f32x4 (&acc)[2][2][4][2], const Unit& u, int wr, int wc, int fr, int fq) const {
        const int row0 = u.pm * BM + wr * 64 + fr, col0 = u.pn * BM + wc * 32 + 8 * fq;
#pragma unroll
        for (int ai = 0; ai < 2; ++ai)
#pragma unroll
            for (int m = 0; m < 4; ++m) { bf16_t* rowp = O + (size_t)(row0 + ai * HALF + m * 16) * ldc + col0;
#pragma unroll
                for (int bj = 0; bj < 2; ++bj) *(u32x4*)(rowp + bj * HALF) = pack8(acc[ai][bj][m][0], acc[ai][bj][m][1]); }
    }
};
struct EpiFnet {
    static constexpr bool PERM = true, AFTER_DRAIN = false;
    bf16_t* MIX;
    __device__ __forceinline__ void operator()(const f32x4 (&acc)[2][2][4][2], const Unit& u, int wr, int wc, int fr, int fq) const {
        const int row0 = u.pn * 4096 + u.pm * BM + wr * 64 + fr, col0 = 768 + wc * 32 + 8 * fq;
#pragma unroll
        for (int ai = 0; ai < 2; ++ai)
#pragma unroll
            for (int m = 0; m < 4; ++m) { bf16_t* rowp = MIX + (size_t)(row0 + ai * HALF + m * 16) * 1024 + col0;
#pragma unroll
                for (int bj = 0; bj < 2; ++bj) *(u32x4*)(rowp + bj * HALF) = pack8(acc[ai][bj][m][0], acc[ai][bj][m][1]); }
    }
};
struct EpiResF32 {
    static constexpr bool PERM = false, AFTER_DRAIN = false;
    const float* base; float* out; int ldc; float alpha;
    __device__ __forceinline__ void operator()(const f32x4 (&acc)[2][2][4][2], const Unit& u, int wr, int wc, int fr, int fq) const {
        const int row0 = u.pm * BM + wr * 64 + fr, col0 = u.pn * BM + wc * 32 + 4 * fq;
#pragma unroll
        for (int ai = 0; ai < 2; ++ai)
#pragma unroll
            for (int m = 0; m < 4; ++m) { const size_t off = (size_t)(row0 + ai * HALF + m * 16) * ldc + col0;
#pragma unroll
                for (int bj = 0; bj < 2; ++bj)
#pragma unroll
                    for (int n = 0; n < 2; ++n) { const f32x4 b = *(const f32x4*)(base + off + bj * HALF + n * 16); *(f32x4*)(out + off + bj * HALF + n * 16) = b * alpha + acc[ai][bj][m][n]; } }
    }
};
struct EpiResBf16 {
    static constexpr bool PERM = true, AFTER_DRAIN = false;
    const bf16_t* base; bf16_t* out; int ldc; float alpha;
    __device__ __forceinline__ void operator()(const f32x4 (&acc)[2][2][4][2], const Unit& u, int wr, int wc, int fr, int fq) const {
        const int row0 = u.pm * BM + wr * 64 + fr, col0 = u.pn * BM + wc * 32 + 8 * fq;
#pragma unroll
        for (int ai = 0; ai < 2; ++ai)
#pragma unroll
            for (int m = 0; m < 4; ++m) { const size_t off = (size_t)(row0 + ai * HALF + m * 16) * ldc + col0;
#pragma unroll
                for (int bj = 0; bj < 2; ++bj) { const u32x4 b = *(const u32x4*)(base + off + bj * HALF);
                    const f32x4 b0 = {__uint_as_float(b.x << 16), __uint_as_float(b.x & 0xffff0000u), __uint_as_float(b.y << 16), __uint_as_float(b.y & 0xffff0000u)};
                    const f32x4 b1 = {__uint_as_float(b.z << 16), __uint_as_float(b.z & 0xffff0000u), __uint_as_float(b.w << 16), __uint_as_float(b.w & 0xffff0000u)};
                    *(u32x4*)(out + off + bj * HALF) = pack8(b0 * alpha + acc[ai][bj][m][0], b1 * alpha + acc[ai][bj][m][1]); } }
    }
};
__device__ __forceinline__ float swiglu1(float g, float u) { g = fminf(g, 7.0f); u = fminf(fmaxf(u, -7.0f), 7.0f); return (u + 1.0f) * g * __builtin_amdgcn_rcpf(1.0f + __expf(-1.702f * g)); }
struct EpiSwiglu {
    static constexpr bool PERM = true, AFTER_DRAIN = false;
    bf16_t* HID; const float* bgu;
    __device__ __forceinline__ void operator()(const f32x4 (&acc)[2][2][4][2], const Unit& u, int wr, int wc, int fr, int fq) const {
        const int e = u.pn >> 3, pnl = u.pn & 7; const int row0 = u.pm * BM + wr * 64 + fr, jj0 = pnl * 128 + wc * 32 + 8 * fq;
        const float* bg = bgu + (size_t)e * 2048 + jj0;
        const f32x4 bg0 = *(const f32x4*)bg, bg1 = *(const f32x4*)(bg + 4), bu0 = *(const f32x4*)(bg + 1024), bu1 = *(const f32x4*)(bg + 1028);
#pragma unroll
        for (int ai = 0; ai < 2; ++ai)
#pragma unroll
            for (int m = 0; m < 4; ++m) { bf16_t* rowp = HID + (size_t)(row0 + ai * HALF + m * 16) * 1024 + jj0;
                const f32x4 g0 = acc[ai][0][m][0] + bg0, g1 = acc[ai][0][m][1] + bg1, u0 = acc[ai][1][m][0] + bu0, u1 = acc[ai][1][m][1] + bu1;
                f32x4 h0, h1;
#pragma unroll
                for (int i = 0; i < 4; ++i) { h0[i] = swiglu1(g0[i], u0[i]); h1[i] = swiglu1(g1[i], u1[i]); }
                *(u32x4*)rowp = pack8(h0, h1); }
    }
};
struct EpiDown {
    static constexpr bool PERM = true, AFTER_DRAIN = false;
    bf16_t* Y; const float* bd;
    __device__ __forceinline__ void operator()(const f32x4 (&acc)[2][2][4][2], const Unit& u, int wr, int wc, int fr, int fq) const {
        const int e = u.pn >> 2, pnl = u.pn & 3; const int row0 = u.pm * BM + wr * 64 + fr, col0 = pnl * BM + wc * 32 + 8 * fq;
        const float* bp = bd + (size_t)e * 1024 + col0;
        f32x4 bv[2][2];
#pragma unroll
        for (int bj = 0; bj < 2; ++bj)
#pragma unroll
            for (int n = 0; n < 2; ++n) bv[bj][n] = *(const f32x4*)(bp + bj * HALF + 4 * n);
#pragma unroll
        for (int ai = 0; ai < 2; ++ai)
#pragma unroll
            for (int m = 0; m < 4; ++m) { bf16_t* rowp = Y + (size_t)(row0 + ai * HALF + m * 16) * 1024 + col0;
#pragma unroll
                for (int bj = 0; bj < 2; ++bj) *(u32x4*)(rowp + bj * HALF) = pack8(acc[ai][bj][m][0] + bv[bj][0], acc[ai][bj][m][1] + bv[bj][1]); }
    }
};
struct EpiNull {
    static constexpr bool PERM = true, AFTER_DRAIN = false;
    bf16_t* O;
    __device__ __forceinline__ void operator()(const f32x4 (&acc)[2][2][4][2], const Unit& u, int wr, int wc, int fr, int fq) const {
#pragma unroll
        for (int ai = 0; ai < 2; ++ai)
#pragma unroll
            for (int bj = 0; bj < 2; ++bj)
#pragma unroll
                for (int m = 0; m < 4; ++m)
#pragma unroll
                    for (int n = 0; n < 2; ++n) asm volatile("" :: "v"(acc[ai][bj][m][n]));
    }
};
struct ListOrder {
    const PG8_LAS int* list; int n;
    __device__ __forceinline__ bool next(int i, Unit& u) const { if (i >= n) return false; const int v = __builtin_amdgcn_readfirstlane(list[i]); u.pm = v >> 16; u.pn = v & 0xffff; return true; }
    __device__ __forceinline__ void a_ready(const Unit&) const {}
    __device__ __forceinline__ void done(const Unit&) const {}
};
template <class Epi, class Sched, bool ALIGN_EPI = false, bool SP2 = false>
__device__ __forceinline__ void gemm_phase(PG8_LAS unsigned char* lds, const Gemm g, const Sched& S, const Epi& E) {
    int tid_ = threadIdx.x; asm volatile("" : "+v"(tid_));
    const int tid = tid_, wid = __builtin_amdgcn_readfirstlane(tid >> 6), lane = tid & 63, wr = wid >> 2, wc = wid & 3, fr = lane & 15, fq = lane >> 4;
    const int K = g.K, nt = K / BK;
    unsigned voffA[2], voffB[2];
#pragma unroll
    for (int i = 0; i < 2; ++i) { int R, C; stage_rc(tid * 16 + i * 8192, R, C); const int Rb = Epi::PERM ? ((R & ~31) + perm32(R & 31)) : R;
        voffA[i] = (unsigned)(R * K + C) * 2u; voffB[i] = (unsigned)(Rb * K + C) * 2u; }
    const size_t kstep = (size_t)(BK * 2);
    const size_t hstep = (size_t)HALF * K * 2;
    const size_t tstep = 2 * hstep;
    const unsigned ldsw = (unsigned)wid * 1024u;
    const int aoff = lds_byte(wr * 64 + fr, fq * 8), boff = lds_byte(wc * 32 + fr, fq * 8);
#define PG8_SA(b, h) (((b) * 2 + (h)) * HTB)
#define PG8_SB(b, h) ((4 + (b) * 2 + (h)) * HTB)
#define PG8_STAGE(bufoff, gbase, voff) do { _Pragma("unroll") for (int _i = 0; _i < 2; ++_i) \
        __builtin_amdgcn_global_load_lds((const unsigned*)((const char*)(gbase) + (voff)[_i]), (PG8_LAS unsigned*)(lds + (bufoff) + ldsw + _i * 8192), 16, 0, 0); } while (0)
#define PG8_LDA(dst, b, h) do { _Pragma("unroll") for (int m = 0; m < 4; ++m) _Pragma("unroll") for (int k = 0; k < 2; ++k) dst[m][k] = *(const PG8_LAS bf16x8*)(lds + PG8_SA(b, h) + aoff + m * 2048 + k * 1024); } while (0)
#define PG8_LDB(dst, b, h) do { _Pragma("unroll") for (int n = 0; n < 2; ++n) _Pragma("unroll") for (int k = 0; k < 2; ++k) dst[n][k] = *(const PG8_LAS bf16x8*)(lds + PG8_SB(b, h) + boff + n * 2048 + k * 1024); } while (0)
#define PG8_MMA(ai, bj, At, Bt) do { __builtin_amdgcn_s_setprio(1); _Pragma("unroll") for (int m = 0; m < 4; ++m) _Pragma("unroll") for (int n = 0; n < 2; ++n) _Pragma("unroll") for (int k = 0; k < 2; ++k) \
        acc[ai][bj][m][n] = __builtin_amdgcn_mfma_f32_16x16x32_bf16(Bt[n][k], At[m][k], acc[ai][bj][m][n], 0, 0, 0); __builtin_amdgcn_s_setprio(0); } while (0)
#define PG8_WAIT_V(n) asm volatile("s_waitcnt vmcnt(" #n ")" ::: "memory")
#define PG8_WAIT_L(n) asm volatile("s_waitcnt lgkmcnt(" #n ")" ::: "memory")
#define PG8_BAR __builtin_amdgcn_s_barrier()
#define PG8_SCHED __builtin_amdgcn_sched_barrier(0)
    Unit cur, nxt; int ui = 0;
    if (!S.next(0, cur)) return;
    f32x4 acc[2][2][4][2];
#pragma unroll
    for (int a = 0; a < 2; ++a)
#pragma unroll
        for (int b = 0; b < 2; ++b)
#pragma unroll
            for (int m = 0; m < 4; ++m)
#pragma unroll
                for (int n = 0; n < 2; ++n) acc[a][b][m][n] = (f32x4){0.f, 0.f, 0.f, 0.f};
    bf16x8 At[4][2], B0[2][2], B1[2][2];
    const char* cA = (const char*)g.A + (size_t)cur.pm * tstep; const char* cB = (const char*)g.Bt + (size_t)cur.pn * tstep;
    S.a_ready(cur);
    if constexpr (SP2) {
        PG8_STAGE(PG8_SB(0, 0), cB, voffB); PG8_STAGE(PG8_SB(0, 1), cB + hstep, voffB); PG8_STAGE(PG8_SA(0, 0), cA, voffA); PG8_STAGE(PG8_SA(0, 1), cA + hstep, voffA);
        if (wr == 1) PG8_BAR;
        PG8_WAIT_V(2); PG8_BAR;
        PG8_STAGE(PG8_SB(1, 0), cB + kstep, voffB); PG8_STAGE(PG8_SA(1, 0), cA + kstep, voffA); PG8_STAGE(PG8_SB(1, 1), cB + hstep + kstep, voffB);
        PG8_WAIT_V(6); PG8_BAR;
    } else {
        PG8_STAGE(PG8_SB(0, 0), cB, voffB); PG8_STAGE(PG8_SA(0, 0), cA, voffA); PG8_STAGE(PG8_SB(0, 1), cB + hstep, voffB); PG8_STAGE(PG8_SA(0, 1), cA + hstep, voffA);
        if (wr == 1) PG8_BAR;
        PG8_WAIT_V(4); PG8_BAR;
        PG8_STAGE(PG8_SB(1, 0), cB + kstep, voffB); PG8_STAGE(PG8_SA(1, 0), cA + kstep, voffA); PG8_STAGE(PG8_SB(1, 1), cB + hstep + kstep, voffB);
        PG8_WAIT_V(6); PG8_BAR;
    }
    for (;;) {
        const bool has_next = S.next(ui + 1, nxt);
        const char* nA = has_next ? (const char*)g.A + (size_t)nxt.pm * tstep : cA; const char* nB = has_next ? (const char*)g.Bt + (size_t)nxt.pn * tstep : cB;
        for (int t = 0; t < nt; t += 2) {
            const bool last = (t == nt - 2);
            const char* a1 = cA + (size_t)(t + 1) * kstep;
            const char* a2 = last ? nA : cA + (size_t)(t + 2) * kstep; const char* b2 = last ? nB : cB + (size_t)(t + 2) * kstep;
            const char* a3 = a2 + kstep; const char* b3 = b2 + kstep;
            if (last && has_next) S.a_ready(nxt);
            if constexpr (SP2) {
            PG8_LDB(B0, 0, 0); PG8_LDB(B1, 0, 1); PG8_SCHED; PG8_LDA(At, 0, 0); PG8_STAGE(PG8_SA(1, 1), a1 + hstep, voffA);
            PG8_WAIT_V(8); PG8_WAIT_L(0); PG8_BAR; PG8_MMA(0, 0, At, B0); PG8_MMA(0, 1, At, B1); PG8_BAR; PG8_SCHED;
            PG8_LDA(At, 0, 1); PG8_STAGE(PG8_SB(0, 0), b2, voffB); PG8_STAGE(PG8_SB(0, 1), b2 + hstep, voffB); PG8_STAGE(PG8_SA(0, 0), a2, voffA);
            PG8_WAIT_V(8); PG8_WAIT_L(0); PG8_BAR; PG8_MMA(1, 0, At, B0); PG8_MMA(1, 1, At, B1); PG8_BAR; PG8_SCHED;
            PG8_LDB(B0, 1, 0); PG8_LDB(B1, 1, 1); PG8_SCHED; PG8_LDA(At, 1, 0); PG8_STAGE(PG8_SA(0, 1), a2 + hstep, voffA);
            PG8_WAIT_V(8); PG8_WAIT_L(0); PG8_BAR; PG8_MMA(0, 0, At, B0); PG8_MMA(0, 1, At, B1); PG8_BAR; PG8_SCHED;
            PG8_LDA(At, 1, 1); PG8_STAGE(PG8_SB(1, 0), b3, voffB); PG8_STAGE(PG8_SB(1, 1), b3 + hstep, voffB); PG8_STAGE(PG8_SA(1, 0), a3, voffA);
            PG8_WAIT_V(8); PG8_WAIT_L(0); PG8_BAR; PG8_MMA(1, 0, At, B0); PG8_MMA(1, 1, At, B1); PG8_BAR; PG8_SCHED;
            } else {
            PG8_LDB(B0, 0, 0); PG8_SCHED; PG8_LDA(At, 0, 0); PG8_STAGE(PG8_SA(1, 1), a1 + hstep, voffA);
            PG8_WAIT_L(8); PG8_BAR; PG8_WAIT_L(0); PG8_MMA(0, 0, At, B0); PG8_BAR; PG8_SCHED;
            PG8_LDB(B1, 0, 1); PG8_STAGE(PG8_SB(0, 0), b2, voffB);
            PG8_BAR; PG8_WAIT_L(0); PG8_MMA(0, 1, At, B1); PG8_BAR;
            PG8_LDA(At, 0, 1); PG8_STAGE(PG8_SA(0, 0), a2, voffA);
            PG8_BAR; PG8_WAIT_L(0); PG8_MMA(1, 0, At, B0); PG8_BAR; PG8_SCHED;
            PG8_STAGE(PG8_SB(0, 1), b2 + hstep, voffB);
            PG8_WAIT_V(6); PG8_BAR; PG8_MMA(1, 1, At, B1); PG8_BAR;
            PG8_LDB(B0, 1, 0); PG8_SCHED; PG8_LDA(At, 1, 0); PG8_STAGE(PG8_SA(0, 1), a2 + hstep, voffA);
            PG8_WAIT_L(8); PG8_BAR; PG8_WAIT_L(0); PG8_MMA(0, 0, At, B0); PG8_BAR; PG8_SCHED;
            PG8_LDB(B1, 1, 1); PG8_STAGE(PG8_SB(1, 0), b3, voffB);
            PG8_BAR; PG8_WAIT_L(0); PG8_MMA(0, 1, At, B1); PG8_BAR;
            PG8_LDA(At, 1, 1); PG8_STAGE(PG8_SA(1, 0), a3, voffA);
            PG8_BAR; PG8_WAIT_L(0); PG8_MMA(1, 0, At, B0); PG8_BAR; PG8_SCHED;
            PG8_STAGE(PG8_SB(1, 1), b3 + hstep, voffB);
            PG8_WAIT_V(6); PG8_BAR; PG8_MMA(1, 1, At, B1); PG8_BAR;
            }
        }
        if constexpr (ALIGN_EPI) { if (wr == 0) PG8_BAR; }
        if constexpr (!Epi::AFTER_DRAIN) { E(acc, cur, wr, wc, fr, fq); S.done(cur); }
        if (!has_next) break;
#pragma unroll
        for (int a = 0; a < 2; ++a)
#pragma unroll
            for (int b = 0; b < 2; ++b)
#pragma unroll
                for (int m = 0; m < 4; ++m)
#pragma unroll
                    for (int n = 0; n < 2; ++n) acc[a][b][m][n] = (f32x4){0.f, 0.f, 0.f, 0.f};
        cur = nxt; cA = nA; cB = nB; ++ui;
        if constexpr (ALIGN_EPI) { if (wr == 1) PG8_BAR; }
    }
    PG8_WAIT_V(0);
    if constexpr (!ALIGN_EPI) { if (wr == 0) PG8_BAR; }
    PG8_BAR;
    if constexpr (Epi::AFTER_DRAIN) { E.fused(acc, cur, wr, wc, fr, fq, lds, wid, lane); S.done(cur); }
#undef PG8_SA
#undef PG8_SB
#undef PG8_STAGE
#undef PG8_LDA
#undef PG8_LDB
#undef PG8_MMA
#undef PG8_WAIT_V
#undef PG8_WAIT_L
#undef PG8_BAR
#undef PG8_SCHED
}
}
namespace pg8 {
template <class Epi, class Sched, bool ALIGN_EPI>
__device__ __forceinline__ void gemm_phase_gather(PG8_LAS unsigned char* lds, const Gemm g, const Sched& S, const Epi& E, const PG8_LAS unsigned short* rows16) {
    int tid_ = threadIdx.x; asm volatile("" : "+v"(tid_));
    const int tid = tid_, wid = __builtin_amdgcn_readfirstlane(tid >> 6), lane = tid & 63, wr = wid >> 2, wc = wid & 3, fr = lane & 15, fq = lane >> 4;
    const int K = g.K, nt = K / BK;
    unsigned voffB[2]; int RA[2]; unsigned CA2[2];
#pragma unroll
    for (int i = 0; i < 2; ++i) { int R, C; stage_rc(tid * 16 + i * 8192, R, C); const int Rb = Epi::PERM ? ((R & ~31) + perm32(R & 31)) : R;
        RA[i] = R; CA2[i] = (unsigned)C * 2u; voffB[i] = (unsigned)(Rb * K + C) * 2u; }
    const size_t kstep = (size_t)(BK * 2);
    const size_t hstep = (size_t)HALF * K * 2;
    const size_t tstep = 2 * hstep;
    const unsigned ldsw = (unsigned)wid * 1024u;
    const unsigned rowb = (unsigned)K * 2u;
    const int aoff = lds_byte(wr * 64 + fr, fq * 8), boff = lds_byte(wc * 32 + fr, fq * 8);
#define PG8_SA(b, h) (((b) * 2 + (h)) * HTB)
#define PG8_SB(b, h) ((4 + (b) * 2 + (h)) * HTB)
#define PG8_STAGE(bufoff, gbase, voff) do { _Pragma("unroll") for (int _i = 0; _i < 2; ++_i) \
        __builtin_amdgcn_global_load_lds((const unsigned*)((const char*)(gbase) + (voff)[_i]), (PG8_LAS unsigned*)(lds + (bufoff) + ldsw + _i * 8192), 16, 0, 0); } while (0)
#define PG8_LDA(dst, b, h) do { _Pragma("unroll") for (int m = 0; m < 4; ++m) _Pragma("unroll") for (int k = 0; k < 2; ++k) dst[m][k] = *(const PG8_LAS bf16x8*)(lds + PG8_SA(b, h) + aoff + m * 2048 + k * 1024); } while (0)
#define PG8_LDB(dst, b, h) do { _Pragma("unroll") for (int n = 0; n < 2; ++n) _Pragma("unroll") for (int k = 0; k < 2; ++k) dst[n][k] = *(const PG8_LAS bf16x8*)(lds + PG8_SB(b, h) + boff + n * 2048 + k * 1024); } while (0)
#define PG8_MMA(ai, bj, At, Bt) do { __builtin_amdgcn_s_setprio(1); _Pragma("unroll") for (int m = 0; m < 4; ++m) _Pragma("unroll") for (int n = 0; n < 2; ++n) _Pragma("unroll") for (int k = 0; k < 2; ++k) \
        acc[ai][bj][m][n] = __builtin_amdgcn_mfma_f32_16x16x32_bf16(Bt[n][k], At[m][k], acc[ai][bj][m][n], 0, 0, 0); __builtin_amdgcn_s_setprio(0); } while (0)
#define PG8_WAIT_V(n) asm volatile("s_waitcnt vmcnt(" #n ")" ::: "memory")
#define PG8_WAIT_L(n) asm volatile("s_waitcnt lgkmcnt(" #n ")" ::: "memory")
#define PG8_BAR __builtin_amdgcn_s_barrier()
#define PG8_SCHED __builtin_amdgcn_sched_barrier(0)
#define PG8_GOFF(dst, U) do { _Pragma("unroll") for (int h_ = 0; h_ < 2; ++h_) _Pragma("unroll") for (int i_ = 0; i_ < 2; ++i_) dst[h_][i_] = (unsigned)rows16[(U) * 256 + h_ * HALF + RA[i_]] * rowb + CA2[i_]; } while (0)
    Unit cur, nxt; int ui = 0;
    if (!S.next(0, cur)) return;
    f32x4 acc[2][2][4][2];
#pragma unroll
    for (int a = 0; a < 2; ++a)
#pragma unroll
        for (int b = 0; b < 2; ++b)
#pragma unroll
            for (int m = 0; m < 4; ++m)
#pragma unroll
                for (int n = 0; n < 2; ++n) acc[a][b][m][n] = (f32x4){0.f, 0.f, 0.f, 0.f};
    bf16x8 At[4][2], B0[2][2], B1[2][2];
    const char* const Ab = (const char*)g.A;
    const char* cB = (const char*)g.Bt + (size_t)cur.pn * tstep;
    unsigned gc[2][2], gn[2][2];
    PG8_GOFF(gc, 0);
    S.a_ready(cur);
    PG8_STAGE(PG8_SB(0, 0), cB, voffB); PG8_STAGE(PG8_SB(0, 1), cB + hstep, voffB); PG8_STAGE(PG8_SA(0, 0), Ab, gc[0]); PG8_STAGE(PG8_SA(0, 1), Ab, gc[1]);
    if (wr == 1) PG8_BAR;
    PG8_WAIT_V(2); PG8_BAR;
    PG8_STAGE(PG8_SB(1, 0), cB + kstep, voffB); PG8_STAGE(PG8_SA(1, 0), Ab + kstep, gc[0]); PG8_STAGE(PG8_SB(1, 1), cB + hstep + kstep, voffB);
    PG8_WAIT_V(6); PG8_BAR;
    for (;;) {
        const bool has_next = S.next(ui + 1, nxt);
        const char* nB = has_next ? (const char*)g.Bt + (size_t)nxt.pn * tstep : cB;
        if (has_next) { PG8_GOFF(gn, ui + 1); } else {
#pragma unroll
            for (int h_ = 0; h_ < 2; ++h_)
#pragma unroll
                for (int i_ = 0; i_ < 2; ++i_) gn[h_][i_] = gc[h_][i_]; }
        for (int t = 0; t < nt; t += 2) {
            const bool last = (t == nt - 2);
            const char* a1 = Ab + (size_t)(t + 1) * kstep;
            const char* a2 = last ? Ab : Ab + (size_t)(t + 2) * kstep; const char* b2 = last ? nB : cB + (size_t)(t + 2) * kstep;
            const char* a3 = a2 + kstep; const char* b3 = b2 + kstep;
            unsigned g2[2][2];
#pragma unroll
            for (int h_ = 0; h_ < 2; ++h_)
#pragma unroll
                for (int i_ = 0; i_ < 2; ++i_) g2[h_][i_] = last ? gn[h_][i_] : gc[h_][i_];
            if (last && has_next) S.a_ready(nxt);
            PG8_LDB(B0, 0, 0); PG8_LDB(B1, 0, 1); PG8_SCHED; PG8_LDA(At, 0, 0); PG8_STAGE(PG8_SA(1, 1), a1, gc[1]);
            PG8_WAIT_V(8); PG8_WAIT_L(0); PG8_BAR; PG8_MMA(0, 0, At, B0); PG8_MMA(0, 1, At, B1); PG8_BAR; PG8_SCHED;
            PG8_LDA(At, 0, 1); PG8_STAGE(PG8_SB(0, 0), b2, voffB); PG8_STAGE(PG8_SB(0, 1), b2 + hstep, voffB); PG8_STAGE(PG8_SA(0, 0), a2, g2[0]);
            PG8_WAIT_V(8); PG8_WAIT_L(0); PG8_BAR; PG8_MMA(1, 0, At, B0); PG8_MMA(1, 1, At, B1); PG8_BAR; PG8_SCHED;
            PG8_LDB(B0, 1, 0); PG8_LDB(B1, 1, 1); PG8_SCHED; PG8_LDA(At, 1, 0); PG8_STAGE(PG8_SA(0, 1), a2, g2[1]);
            PG8_WAIT_V(8); PG8_WAIT_L(0); PG8_BAR; PG8_MMA(0, 0, At, B0); PG8_MMA(0, 1, At, B1); PG8_BAR; PG8_SCHED;
            PG8_LDA(At, 1, 1); PG8_STAGE(PG8_SB(1, 0), b3, voffB); PG8_STAGE(PG8_SB(1, 1), b3 + hstep, voffB); PG8_STAGE(PG8_SA(1, 0), a3, g2[0]);
            PG8_WAIT_V(8); PG8_WAIT_L(0); PG8_BAR; PG8_MMA(1, 0, At, B0); PG8_MMA(1, 1, At, B1); PG8_BAR; PG8_SCHED;
        }
        if constexpr (ALIGN_EPI) { if (wr == 0) PG8_BAR; }
        E(acc, cur, wr, wc, fr, fq); S.done(cur);
        if (!has_next) break;
#pragma unroll
        for (int a = 0; a < 2; ++a)
#pragma unroll
            for (int b = 0; b < 2; ++b)
#pragma unroll
                for (int m = 0; m < 4; ++m)
#pragma unroll
                    for (int n = 0; n < 2; ++n) acc[a][b][m][n] = (f32x4){0.f, 0.f, 0.f, 0.f};
        cur = nxt; cB = nB; ++ui;
#pragma unroll
        for (int h_ = 0; h_ < 2; ++h_)
#pragma unroll
            for (int i_ = 0; i_ < 2; ++i_) gc[h_][i_] = gn[h_][i_];
        if constexpr (ALIGN_EPI) { if (wr == 1) PG8_BAR; }
    }
    PG8_WAIT_V(0);
    if constexpr (!ALIGN_EPI) { if (wr == 0) PG8_BAR; }
    PG8_BAR;
#undef PG8_SA
#undef PG8_SB
#undef PG8_STAGE
#undef PG8_LDA
#undef PG8_LDB
#undef PG8_MMA
#undef PG8_WAIT_V
#undef PG8_WAIT_L
#undef PG8_BAR
#undef PG8_SCHED
#undef PG8_GOFF
}
}
#define GAS __attribute__((address_space(1)))
#define LAS __attribute__((address_space(3)))
typedef unsigned short bf16;
typedef unsigned v4u __attribute__((ext_vector_type(4)));
typedef float f32x4 __attribute__((ext_vector_type(4)));
typedef short bf16x8 __attribute__((ext_vector_type(8)));
typedef GAS unsigned gu32;
typedef GAS unsigned long long gu64;
#define RLX_AGENT __ATOMIC_RELAXED, __HIP_MEMORY_SCOPE_AGENT
#define LDS_WAIT() asm volatile("s_waitcnt lgkmcnt(0)" ::: "memory")
#define VM_WAIT() asm volatile("s_waitcnt vmcnt(0)" ::: "memory")
__device__ __forceinline__ unsigned long long rt() { return __builtin_amdgcn_s_memrealtime(); }
__device__ __forceinline__ unsigned f2bf(float f) { unsigned u = __builtin_bit_cast(unsigned, f); return (u + 0x7fffu + ((u >> 16) & 1u)) >> 16; }
__device__ __forceinline__ unsigned pk2(float lo, float hi) { return f2bf(lo) | (f2bf(hi) << 16); }
#define XB_TMO      128
#define XB_XCNT(j)  (256  + 64 * (j))
#define XB_XSUB(j)  (1280 + 64 * (j))
#define XB_XGEN(j)  (2304 + 64 * (j))
#define XB_TOP      3328
#define XB_TOPGEN   3392
#define XCD_BAR_WORDS 3456
#define XB_SPIN_CAP (1u << 18)

__device__ __forceinline__ unsigned xb_ld(unsigned* p)              { return __hip_atomic_load(p, __ATOMIC_RELAXED, __HIP_MEMORY_SCOPE_AGENT); }
__device__ __forceinline__ unsigned xb_add(unsigned* p, unsigned v) { return __hip_atomic_fetch_add(p, v, __ATOMIC_RELAXED, __HIP_MEMORY_SCOPE_AGENT); }
__device__ __forceinline__ unsigned xb_xcc_id() { return (unsigned)__builtin_amdgcn_s_getreg((3 << 11) | 20) & 0xFu; }
#define XB_SPIN(cond, bar) do { unsigned _sp = 0; while (cond) { __builtin_amdgcn_s_sleep(1); \
    if ((++_sp & 255u) == 0u) { if (xb_ld(&(bar)[XB_TMO])) break; if (_sp > XB_SPIN_CAP) { atomicAdd(&(bar)[XB_TMO], 1u); break; } } } } while (0)

struct XcdBarrier {
    unsigned* bar; unsigned x;
    volatile LAS unsigned* st;
};

__device__ __forceinline__ XcdBarrier xcd_barrier_post(unsigned* bar, volatile LAS unsigned* st) {
    XcdBarrier b; b.bar = bar; b.x = xb_xcc_id(); b.st = st;
    if (threadIdx.x == 0) (void)xb_add(&bar[XB_XCNT(b.x)], 1u);
    return b;
}
__device__ __forceinline__ void xcd_barrier_complete(unsigned* bar, unsigned x, unsigned& nloc, unsigned& nx) {
    const unsigned G = gridDim.x * gridDim.y * gridDim.z;
    unsigned sum, cnt, mine, sp = 0u;
    for (;;) {
        sum = 0u; cnt = 0u; mine = 0u;
#pragma unroll
        for (unsigned j = 0; j < 16; ++j) { const unsigned c = xb_ld(&bar[XB_XCNT(j)]); sum += c; cnt += (c > 0u) ? 1u : 0u; mine = (j == x) ? c : mine; }
        if (sum == G) break;
        __builtin_amdgcn_s_sleep(1);
        if ((++sp & 255u) == 0u) { if (xb_ld(&bar[XB_TMO])) break; if (sp > XB_SPIN_CAP) { atomicAdd(&bar[XB_TMO], 1u); break; } }
    }
    nloc = mine > 0u ? mine : 1u; nx = cnt > 0u ? cnt : 1u;
}

__device__ __forceinline__ void xcd_barrier(const XcdBarrier& b) {
    asm volatile("s_waitcnt vmcnt(0)" ::: "memory");
    __syncthreads();
    if (threadIdx.x == 0) {
        unsigned* bar = b.bar;
        __builtin_amdgcn_s_waitcnt(0);
        unsigned nloc = b.st[0], nx = b.st[1];
        if (nloc == 0u) { xcd_barrier_complete(bar, b.x, nloc, nx); b.st[0] = nloc; b.st[1] = nx; }
        const unsigned old = xb_add(&bar[XB_XSUB(b.x)], 1u);
        const unsigned gen = old / nloc;
        if (old + 1u == (gen + 1u) * nloc) {
            __builtin_amdgcn_fence(__ATOMIC_RELEASE, "agent");
            asm volatile("s_waitcnt vmcnt(0)" ::: "memory");
            const unsigned og = xb_add(&bar[XB_TOP], 1u);
            const unsigned tg = og / nx;
            if (og + 1u == (tg + 1u) * nx) xb_add(&bar[XB_TOPGEN], 1u);
            else XB_SPIN(xb_ld(&bar[XB_TOPGEN]) == tg, bar);
            __builtin_amdgcn_fence(__ATOMIC_ACQUIRE, "agent");
            xb_add(&bar[XB_XGEN(b.x)], 1u);
            asm volatile("s_waitcnt vmcnt(0)" ::: "memory");
        } else {
            XB_SPIN(xb_ld(&bar[XB_XGEN(b.x)]) == gen, bar);
            __builtin_amdgcn_fence(__ATOMIC_ACQUIRE, "agent");
            asm volatile("s_waitcnt vmcnt(0)" ::: "memory");
        }
    }
    __syncthreads();
}
namespace attn_body {
using bf16=__hip_bfloat16;
using bf16x8=__attribute__((ext_vector_type(8)))short;
using s16x4=__attribute__((ext_vector_type(4)))short;
using f32x16=__attribute__((ext_vector_type(16)))float;
using u32x4=__attribute__((ext_vector_type(4)))unsigned;
constexpr int BATCH=8,NHEAD=8,NKVH=2,SEQ=4096,D=64;
constexpr int DMQ=512,DMK=128,DMV=2048,DMO=1024;
constexpr int NW=8,QBLK=32,QB=QBLK*NW,KVBLK=64,NQB=SEQ/QB;
constexpr int ATTN_UNIT_ROWS=QB;
__device__ __forceinline__ int crow(int r,int hi){return (r&3)+8*(r>>2)+4*hi;}
#define SBAR() __builtin_amdgcn_sched_barrier(0)
__device__ __forceinline__ void cmask(f32x16&p0,f32x16&p1,int jb,int qrel,int hi){
  const float NEG=-INFINITY; int kb=64*jb+4*hi;
  #pragma unroll
  for(int r=0;r<16;++r){int kv=kb+(r&3)+8*(r>>2); if(kv>qrel)p0[r]=NEG; if(kv+32>qrel)p1[r]=NEG;}
}

constexpr int NSLOT=3, SLOTB=8192;
constexpr int LDS_K=0, LDS_V=NSLOT*SLOTB, LDS_WS=2*NSLOT*SLOTB, LDS_OST=LDS_WS+NW*64*4, LDS_BYTES=LDS_OST+NW*4096;
constexpr float C2=0.125f*1.4426950408889634f;
__device__ __forceinline__ void glds16(const void*gsrc,unsigned lds_dst){unsigned keep;
  asm volatile("s_mov_b32 %0, m0\n\ts_mov_b32 m0, %2\n\ts_nop 0\n\tglobal_load_lds_dwordx4 %1, off\n\ts_mov_b32 m0, %0":"=&s"(keep):"v"(gsrc),"s"(lds_dst):"memory");}
__device__ __forceinline__ float max3f(float a,float b,float c){float r;asm("v_max3_f32 %0, %1, %2, %3":"=v"(r):"v"(a),"v"(b),"v"(c));return r;}
__device__ __forceinline__ float max2f(float a,float b){float r;asm("v_max_f32_e32 %0, %1, %2":"=v"(r):"v"(a),"v"(b));return r;}
__device__ __forceinline__ float fadd_s(float a,float b){float r;asm("v_add_f32_e32 %0, %1, %2":"=v"(r):"v"(a),"v"(b));return r;}
__device__ __forceinline__ float fsub_s(float a,float b){float r;asm("v_sub_f32_e32 %0, %1, %2":"=v"(r):"v"(a),"v"(b));return r;}
typedef float f32x2_t __attribute__((ext_vector_type(2))); typedef __bf16 bf16x2_t __attribute__((ext_vector_type(2)));
__device__ __forceinline__ unsigned cvtpk_s(float lo,float hi){f32x2_t v={lo,hi};bf16x2_t b=__builtin_convertvector(v,bf16x2_t);return __builtin_bit_cast(unsigned,b);}
#define WAIT_BAR(N) asm volatile("s_waitcnt vmcnt(" #N ") lgkmcnt(0)\n\ts_barrier":::"memory")

__device__ __forceinline__ void qkt(f32x16&p0,f32x16&p1,const char*Kslot,const bf16x8*qr,const f32x16&negm,int r32,int hi){
  const char*kb=Kslot+hi*1024+r32*16;
  #pragma unroll
  for(int d0=0;d0<4;++d0){
    const bf16x8 b0=*reinterpret_cast<const bf16x8*>(kb+d0*2048);
    const bf16x8 b1=*reinterpret_cast<const bf16x8*>(kb+d0*2048+512);
    if(d0==0){p0=__builtin_amdgcn_mfma_f32_32x32x16_bf16(b0,qr[0],negm,0,0,0);p1=__builtin_amdgcn_mfma_f32_32x32x16_bf16(b1,qr[0],negm,0,0,0);}
    else{p0=__builtin_amdgcn_mfma_f32_32x32x16_bf16(b0,qr[d0],p0,0,0,0);p1=__builtin_amdgcn_mfma_f32_32x32x16_bf16(b1,qr[d0],p1,0,0,0);}}
}
typedef __attribute__((address_space(3))) const char* lds_cptr;
typedef short v4i16_t __attribute__((ext_vector_type(4)));
__device__ __forceinline__ void kload8(bf16x8*kf,lds_cptr kp){
  kf[0]=*(const __attribute__((address_space(3))) bf16x8*)(kp);      kf[1]=*(const __attribute__((address_space(3))) bf16x8*)(kp+512);
  kf[2]=*(const __attribute__((address_space(3))) bf16x8*)(kp+2048); kf[3]=*(const __attribute__((address_space(3))) bf16x8*)(kp+2560);
  kf[4]=*(const __attribute__((address_space(3))) bf16x8*)(kp+4096); kf[5]=*(const __attribute__((address_space(3))) bf16x8*)(kp+4608);
  kf[6]=*(const __attribute__((address_space(3))) bf16x8*)(kp+6144); kf[7]=*(const __attribute__((address_space(3))) bf16x8*)(kp+6656);
}
__device__ __forceinline__ void kload2(bf16x8*kf,lds_cptr kp,int j){ kf[2*j]=*(const __attribute__((address_space(3))) bf16x8*)(kp+j*2048); kf[2*j+1]=*(const __attribute__((address_space(3))) bf16x8*)(kp+j*2048+512); }
__device__ __forceinline__ s16x4 vtr(lds_cptr p){ return __builtin_bit_cast(s16x4,__builtin_amdgcn_ds_read_tr16_b64_v4i16((__attribute__((address_space(3))) v4i16_t*)p)); }
__device__ __forceinline__ float rowmax(const f32x16&p0,const f32x16&p1){
  float a=max3f(p0[0],p0[1],p1[0]),b=max3f(p0[2],p0[3],p1[1]);a=max3f(a,p1[2],p1[3]);
  #pragma unroll
  for(int r=4;r<16;r+=4){a=max3f(a,p0[r],p0[r+1]);b=max3f(b,p0[r+2],p0[r+3]);a=max3f(a,p1[r],p1[r+1]);b=max3f(b,p1[r+2],p1[r+3]);}
  const float m=max2f(a,b);
  auto rr=__builtin_amdgcn_permlane32_swap(__float_as_uint(m),__float_as_uint(m),false,false);
  return max2f(__uint_as_float(rr[0]),__uint_as_float(rr[1]));
}
__device__ __forceinline__ void pv(f32x16*o,int vb,bf16x8 pa0,bf16x8 pa1,bf16x8 pa2,bf16x8 pa3){
  #pragma unroll
  for(int d0=0;d0<2;++d0){s16x4 lo[4],hi[4];
    #pragma unroll
    for(int ks=0;ks<4;++ks){
      asm volatile("ds_read_b64_tr_b16 %0,%1 offset:%c2":"=&v"(lo[ks]):"v"(vb),"i"(d0*4096+ks*1024):"memory");
      asm volatile("ds_read_b64_tr_b16 %0,%1 offset:%c2":"=&v"(hi[ks]):"v"(vb),"i"(d0*4096+ks*1024+512):"memory");}
    asm volatile("s_waitcnt lgkmcnt(0)":::"memory");SBAR();
    #define PK(k) (bf16x8){lo[k][0],lo[k][1],lo[k][2],lo[k][3],hi[k][0],hi[k][1],hi[k][2],hi[k][3]}
    o[d0]=__builtin_amdgcn_mfma_f32_32x32x16_bf16(pa0,PK(0),o[d0],0,0,0);
    o[d0]=__builtin_amdgcn_mfma_f32_32x32x16_bf16(pa1,PK(1),o[d0],0,0,0);
    o[d0]=__builtin_amdgcn_mfma_f32_32x32x16_bf16(pa2,PK(2),o[d0],0,0,0);
    o[d0]=__builtin_amdgcn_mfma_f32_32x32x16_bf16(pa3,PK(3),o[d0],0,0,0);
    #undef PK
  }
}

#ifndef ATTN_STORE16
#define ATTN_STORE16(p,v) (*(u32x4*)(p)=(v))
#endif
template<int THRL> __device__ __forceinline__ void attn_unit(int b,int h,int qb,const bf16*Q,const bf16*__restrict__ K,const bf16*__restrict__ V,bf16*O,char*shm){
  int tid_=threadIdx.x; asm volatile("":"+v"(tid_)); const int tid=tid_,lane=tid&63,r32=lane&31,hi=lane>>5; const int wid=__builtin_amdgcn_readfirstlane(tid>>6);
  const long rowbase=(long)b*SEQ; const int q0=qb*QB;
  const bf16*Qw=Q+(rowbase+q0+wid*QBLK)*DMQ+h*D; const int kvh=h>>2;
  const bf16*Kh=K+rowbase*DMK+kvh*D,*Vh=V+rowbase*DMV+kvh*D;
  const unsigned lds0=(unsigned)(uintptr_t)shm;
  float*wsf=(float*)(shm+LDS_WS)+wid*64;
  const bf16*ksrc=Kh+(long)lane*DMK+wid*8;
  const bf16*vsrc=Vh+(long)(16*(wid&3)+(lane>>2))*DMV+(wid>>2)*32+(lane&3)*8;
  const unsigned kdst=lds0+LDS_K+wid*1024, vdst=lds0+LDS_V+wid*1024;
  #define DMA_K(t,slot) glds16(ksrc+(long)(t)*KVBLK*DMK,(unsigned)__builtin_amdgcn_readfirstlane(kdst+(slot)))
  #define DMA_V(t,slot) glds16(vsrc+(long)(t)*KVBLK*DMV,(unsigned)__builtin_amdgcn_readfirstlane(vdst+(slot)))
  const int vb0=(int)(lds0+LDS_V)+((lane>>4)&1)*32+(lane&3)*8+(4*hi+((lane&15)>>2))*64;
  const char*Kbase=shm+LDS_K; bf16x8 kf[8];
  const lds_cptr shm3=(lds_cptr)shm; const lds_cptr kp0=shm3+LDS_K+hi*1024+r32*16; const lds_cptr vp0=shm3+LDS_V+((lane>>4)&1)*32+(lane&3)*8+(4*hi+((lane&15)>>2))*64;
  constexpr int NT=SEQ/KVBLK;
  DMA_K(0,0);DMA_V(0,0);DMA_K(1,SLOTB);
  bf16x8 qr[4];
  #pragma unroll
  for(int d0=0;d0<4;++d0)qr[d0]=*reinterpret_cast<const bf16x8*>(&Qw[(long)r32*DMQ+d0*16+hi*8]);
  float mhat=0.f,l_reg=0.f;f32x16 o[2];o[0]=f32x16{};o[1]=f32x16{};f32x16 negm=f32x16{};asm volatile("":"+v"(negm));
  #define CMASK(P0,P1,t) do{}while(0)
  bool resc=false;
  #define START(P0,P1) do{ const float rm=rowmax(P0,P1); resc=false; \
    { const float dl=rm; mhat=fadd_s(mhat,dl); \
      _Pragma("unroll") for(int r=0;r<16;++r){P0[r]=fsub_s(P0[r],dl);P1[r]=fsub_s(P1[r],dl);} \
      _Pragma("unroll") for(int r=0;r<16;++r)negm[r]=-mhat; asm volatile("":"+v"(negm)); } \
    _Pragma("unroll") for(int r=0;r<16;++r)P0[r]=__builtin_amdgcn_exp2f(P0[r]); }while(0)
  #define RESC() do{ if(resc){ asm volatile("s_waitcnt lgkmcnt(0)":::"memory"); \
      _Pragma("unroll") for(int d_=0;d_<2;++d_) _Pragma("unroll") for(int r=0;r<16;++r)o[d_][r]*=wsf[crow(r,hi)]; } }while(0)
  f32x16 pA0,pA1,pB0,pB1;
  int sl_prev=0,sl_cur=0,sl_next=SLOTB;
  #define ROT() do{sl_prev=sl_cur;sl_cur=sl_next;sl_next=(sl_next==(NSLOT-1)*SLOTB)?0:sl_next+SLOTB;}while(0)
  DMA_K(2,2*SLOTB);
  WAIT_BAR(3);
  qkt(pA0,pA1,Kbase,qr,negm,r32,hi);asm volatile("s_nop 15\n\ts_nop 7":"+v"(pA0),"+v"(pA1));CMASK(pA0,pA1,0);
  START(pA0,pA1);
  _Pragma("unroll") for(int r=0;r<16;++r)pA1[r]=__builtin_amdgcn_exp2f(pA1[r]);
  WAIT_BAR(0);
  DMA_K(3,0);DMA_V(1,SLOTB);
  ROT();
  kload8(kf,kp0+sl_cur);
  WAIT_BAR(2);
  s16x4 vlo[8],vhi[8]; u32x4 pw0,pw1,pw2,pw3;
  #define PKW(P,B) cvtpk_s(P[B],P[B+1])
  #define PAF(k) __builtin_bit_cast(bf16x8,pw##k)
  #define VFR(i) (bf16x8){vlo[i][0],vlo[i][1],vlo[i][2],vlo[i][3],vhi[i][0],vhi[i][1],vhi[i][2],vhi[i][3]}
  #define PIN(x) asm volatile("":"+v"(x))
  #define MX3(a,b,c) __builtin_fmaxf(__builtin_fmaxf((a),(b)),(c))
  #define GAPA(MF,A0,A1,A2,A3,W0,W1,PW) do{ MF; sacc+=A0; sacc+=A1; sacc+=A2; sacc+=A3; PIN(sacc); W0; W1; PIN(PW); SBAR(); }while(0)
  #define EX(v) __builtin_amdgcn_exp2f(v)
  #define GAPB(MF,X,B) do{ MF; X[B]=EX(X[B]); X[B+1]=EX(X[B+1]); X[B+2]=EX(X[B+2]); X[B+3]=EX(X[B+3]); PIN(X); SBAR(); }while(0)
  #define VRD(i) do{ vlo[i]=vtr(vp_+(((i)>>2)*4096+((i)&3)*1024)); vhi[i]=vtr(vp_+(((i)>>2)*4096+((i)&3)*1024+512)); }while(0)
  #define KRD(G,j) do{ if(G){ kload2(kf,kp0+sl_next,j); SBAR(); } }while(0)
  #define STEP(C0,C1,P0,P1,t,GK,GV,GL) do{ SBAR(); \
    const lds_cptr vp_=vp0+sl_prev; \
    VRD(0); SBAR(); float sacc=(P0[0]+P0[1]); \
    GAPA(C0=__builtin_amdgcn_mfma_f32_32x32x16_bf16(kf[0],qr[0],negm,0,0,0), P0[2],P0[3],P0[4],P0[5],     pw0[0]=PKW(P0,0), pw0[1]=PKW(P0,2), pw0); \
    VRD(4); SBAR(); GAPA(C1=__builtin_amdgcn_mfma_f32_32x32x16_bf16(kf[1],qr[0],negm,0,0,0), P0[6],P0[7],P0[8],P0[9],     pw0[2]=PKW(P0,4), pw0[3]=PKW(P0,6), pw0); \
    VRD(1); SBAR(); GAPA(C0=__builtin_amdgcn_mfma_f32_32x32x16_bf16(kf[2],qr[1],C0,0,0,0),   P0[10],P0[11],P0[12],P0[13], pw1[0]=PKW(P0,8), pw1[1]=PKW(P0,10), pw1); \
    VRD(5); SBAR(); GAPA(C1=__builtin_amdgcn_mfma_f32_32x32x16_bf16(kf[3],qr[1],C1,0,0,0),   P0[14],P0[15],P1[0],P1[1],   pw1[2]=PKW(P0,12),pw1[3]=PKW(P0,14), pw1); \
    VRD(2); SBAR(); GAPA(C0=__builtin_amdgcn_mfma_f32_32x32x16_bf16(kf[4],qr[2],C0,0,0,0),   P1[2],P1[3],P1[4],P1[5],     pw2[0]=PKW(P1,0), pw2[1]=PKW(P1,2), pw2); \
    VRD(6); SBAR(); GAPA(C1=__builtin_amdgcn_mfma_f32_32x32x16_bf16(kf[5],qr[2],C1,0,0,0),   P1[6],P1[7],P1[8],P1[9],     pw2[2]=PKW(P1,4), pw2[3]=PKW(P1,6), pw2); \
    VRD(3); SBAR(); GAPA(C0=__builtin_amdgcn_mfma_f32_32x32x16_bf16(kf[6],qr[3],C0,0,0,0),   P1[10],P1[11],P1[12],P1[13], pw3[0]=PKW(P1,8), pw3[1]=PKW(P1,10), pw3); \
    VRD(7); SBAR(); GAPA(C1=__builtin_amdgcn_mfma_f32_32x32x16_bf16(kf[7],qr[3],C1,0,0,0),   P1[14],P1[15],0.f,0.f,       pw3[2]=PKW(P1,12),pw3[3]=PKW(P1,14), pw3); \
    l_reg+=sacc; \
    if(GK){DMA_K((t)+3,sl_cur);} if(GV){DMA_V((t)+1,sl_next);} \
    CMASK(C0,C1,t); \
    { float a=MX3(C0[0],C0[1],C1[0]),b=MX3(C0[2],C0[3],C1[1]); a=MX3(a,C1[2],C1[3]); \
      _Pragma("unroll") for(int r=4;r<16;r+=4){a=MX3(a,C0[r],C0[r+1]);b=MX3(b,C0[r+2],C0[r+3]);a=MX3(a,C1[r],C1[r+1]);b=MX3(b,C1[r+2],C1[r+3]);} \
      float rm=__builtin_fmaxf(a,b); { auto rr=__builtin_amdgcn_permlane32_swap(__float_as_uint(rm),__float_as_uint(rm),false,false); rm=__builtin_fmaxf(__uint_as_float(rr[0]),__uint_as_float(rr[1])); } \
      resc=false; \
      if(__builtin_expect(__any(rm>(float)THRL),0)){ const float dl=__builtin_fmaxf(rm,0.f); mhat+=dl; \
        _Pragma("unroll") for(int r=0;r<16;++r){C0[r]-=dl;C1[r]-=dl;} \
        _Pragma("unroll") for(int r=0;r<16;++r)negm[r]=-mhat; asm volatile("":"+v"(negm)); \
        const float f=__builtin_amdgcn_exp2f(-dl); l_reg*=f; if(hi==0)wsf[r32]=f; resc=true; } } \
    SBAR(); \
    GAPB(o[0]=__builtin_amdgcn_mfma_f32_32x32x16_bf16(PAF(0),VFR(0),o[0],0,0,0), C0,0); \
    GAPB(o[1]=__builtin_amdgcn_mfma_f32_32x32x16_bf16(PAF(0),VFR(4),o[1],0,0,0), C0,4); \
    KRD(GL,0); GAPB(o[0]=__builtin_amdgcn_mfma_f32_32x32x16_bf16(PAF(1),VFR(1),o[0],0,0,0), C0,8); \
    KRD(GL,1); GAPB(o[1]=__builtin_amdgcn_mfma_f32_32x32x16_bf16(PAF(1),VFR(5),o[1],0,0,0), C0,12); \
    KRD(GL,2); GAPB(o[0]=__builtin_amdgcn_mfma_f32_32x32x16_bf16(PAF(2),VFR(2),o[0],0,0,0), C1,0); \
    KRD(GL,3); GAPB(o[1]=__builtin_amdgcn_mfma_f32_32x32x16_bf16(PAF(2),VFR(6),o[1],0,0,0), C1,4); \
    GAPB(o[0]=__builtin_amdgcn_mfma_f32_32x32x16_bf16(PAF(3),VFR(3),o[0],0,0,0), C1,8); \
    GAPB(o[1]=__builtin_amdgcn_mfma_f32_32x32x16_bf16(PAF(3),VFR(7),o[1],0,0,0), C1,12); \
    }while(0)
  int t=1;
  #undef CMASK
  #define CMASK(P0,P1,t) do{}while(0)
  for(;t+5<NT;t+=2){
    STEP(pB0,pB1,pA0,pA1,t,true,true,true);     WAIT_BAR(2); RESC(); ROT();
    STEP(pA0,pA1,pB0,pB1,t+1,true,true,true);   WAIT_BAR(2); RESC(); ROT();
  }
  #undef CMASK
  #define CMASK(P0,P1,t) do{}while(0)
  #define ENDW(tt) do{ if((tt)+3<NT){WAIT_BAR(2);} else if((tt)+2<NT){WAIT_BAR(1);} else {WAIT_BAR(0);} }while(0)
  for(;t+1<NT;t+=2){
    STEP(pB0,pB1,pA0,pA1,t,(t+3<NT),(t+1<NT),(t+1<NT));       ENDW(t);   RESC(); ROT();
    STEP(pA0,pA1,pB0,pB1,t+1,(t+4<NT),(t+2<NT),(t+2<NT));     ENDW(t+1); RESC(); ROT();
  }
  STEP(pB0,pB1,pA0,pA1,NT-1,false,false,false); RESC();
  { float sacc=pB0[0]+pB0[1]; _Pragma("unroll") for(int r=2;r<16;++r)sacc+=pB0[r]; _Pragma("unroll") for(int r=0;r<16;++r)sacc+=pB1[r]; l_reg+=sacc;
    pw0=(u32x4){PKW(pB0,0),PKW(pB0,2),PKW(pB0,4),PKW(pB0,6)};pw1=(u32x4){PKW(pB0,8),PKW(pB0,10),PKW(pB0,12),PKW(pB0,14)};pw2=(u32x4){PKW(pB1,0),PKW(pB1,2),PKW(pB1,4),PKW(pB1,6)};pw3=(u32x4){PKW(pB1,8),PKW(pB1,10),PKW(pB1,12),PKW(pB1,14)};
    SBAR(); pv(o,vb0+sl_cur,PAF(0),PAF(1),PAF(2),PAF(3)); }
  #undef PKW
  #undef PAF
  #undef VFR
  #undef PIN
  #undef MX3
  #undef GAPA
  #undef GAPB
  #undef EX
  #undef VRD
  #undef KRD
  #undef STEP
  #undef ENDW
  {auto rr=__builtin_amdgcn_permlane32_swap(__float_as_uint(l_reg),__float_as_uint(l_reg),false,false);l_reg=__uint_as_float(rr[0])+__uint_as_float(rr[1]);}
  if(hi==0)wsf[32+r32]=l_reg;asm volatile("s_waitcnt lgkmcnt(0)":::"memory");
  float rli[16];
  #pragma unroll
  for(int r=0;r<16;++r)rli[r]=__builtin_amdgcn_rcpf(wsf[32+crow(r,hi)]);
  bf16*Ow=O+(rowbase+q0+wid*QBLK)*DMO+h*D;
  { bf16*stg=(bf16*)(shm+LDS_OST)+wid*2048;
    #pragma unroll
    for(int r=0;r<16;++r){const int orow=crow(r,hi);
      #pragma unroll
      for(int d0=0;d0<2;++d0)stg[orow*64+d0*32+r32]=__float2bfloat16(o[d0][r]*rli[r]);}
    asm volatile("s_waitcnt lgkmcnt(0)":::"memory");
    #pragma unroll
    for(int i=0;i<4;++i){const int row=i*8+(lane>>3),ch=lane&7; const u32x4 v=*(const u32x4*)(stg+row*64+ch*8); ATTN_STORE16(Ow+(long)row*DMO+ch*8,v);} }
  asm volatile("s_waitcnt lgkmcnt(0)\n\ts_barrier":::"memory");
  #undef DMA_K
  #undef DMA_V
  #undef CMASK
  #undef START
  #undef RESC
  #undef ROT
}
constexpr int ATTN_LDS_BYTES=LDS_BYTES;
struct AttnTensors { const bf16* Q; const bf16* K; const bf16* V; bf16* O; };
struct AttnUnit { int bh; int qb; };
struct StaticOrder {
  int vcu, G;
  __device__ __forceinline__ explicit StaticOrder(int grid,int block):vcu((grid%8==0)?(block%8)*(grid/8)+block/8:block),G(grid){}
  __device__ __forceinline__ bool next(int i,AttnUnit&u)const{ const int per=(BATCH*NHEAD*NQB+G-1)/G; if(i>=per)return false; const int idx=vcu*per+i; if(idx>=BATCH*NHEAD*NQB)return false;
    const int qb=idx%NQB, hq=(idx/NQB)&3, bk=idx/(NQB*4), kvh=bk&1, b=bk>>1; u.bh=b*NHEAD+kvh*4+hq; u.qb=qb; return true; }
  __device__ __forceinline__ void a_ready(const AttnUnit&)const{}
  __device__ __forceinline__ void done(const AttnUnit&)const{}
};
template<class Sched,int THRL=8> __device__ __forceinline__ void attn_phase(char*lds,const AttnTensors&T,const Sched&S){
  AttnUnit u;
  for(int i=0;S.next(i,u);++i){ S.a_ready(u); attn_unit<THRL>(u.bh/NHEAD,u.bh%NHEAD,u.qb,T.Q,T.K,T.V,T.O,lds); S.done(u); }
}
#undef SBAR
#undef WAIT_BAR
}
constexpr int NB = 8, SEQ = 4096, DM = 1024, NL = 4, NTOK = NB * SEQ;
constexpr int INW = 1824, INP = 2048;
constexpr int C_AQ = 0, C_AK = 512, C_AV = 640, C_GQ = 768, C_GK = 896, C_GV = 1024, C_GR = 1280, C_FX = 1536, C_GLR = 1792;
constexpr int NE = 32, TOPK = 4, DE = 1024;
constexpr int MPAD = NTOK * TOPK + NE * 256;
constexpr float LN_EPS = 1e-5f, RMS_EPS = 1e-6f;
constexpr float DN_ALPHA = 1.681792830507429f;
constexpr float QSCALE = 0.125f * 1.4426950408889634f;
constexpr float GLA_QSCALE = 0.17677669529663687f;

constexpr size_t MiB = 1u << 20;
constexpr size_t WS_CTL = 0, CTL_ZERO_BYTES = 1 * MiB;
constexpr size_t WS_ROPE = 1 * MiB;
constexpr size_t WS_WIN_T = 2 * MiB;
constexpr size_t WS_WOUT_T = 18 * MiB;
constexpr size_t WS_FTAB = 26 * MiB;
constexpr size_t WS_TW = WS_FTAB + 65536;
constexpr size_t WS_RWT = WS_FTAB + 131072;
constexpr size_t WS_FTMP = 27 * MiB;
constexpr size_t WS_WGU_T = 90 * MiB;
constexpr size_t WS_WDN_T = 602 * MiB;
constexpr size_t WS_HF = 858 * MiB;
constexpr size_t WS_HB = 986 * MiB;
constexpr size_t WS_PROJ = 1050 * MiB;
constexpr size_t WS_QB = 1178 * MiB;
constexpr size_t WS_KB = 1210 * MiB;
constexpr size_t WS_MIX = 1218 * MiB;
constexpr size_t WS_T1 = 1282 * MiB;
constexpr size_t WS_UVT = 1410 * MiB;
constexpr size_t WS_LA = 1442 * MiB;
constexpr size_t WS_OF = 1474 * MiB;
constexpr size_t WS_OB = 1506 * MiB;
constexpr size_t WS_TOK = 1538 * MiB;
constexpr size_t WS_XS = 1542 * MiB;
constexpr size_t WS_HID = 1814 * MiB;
constexpr size_t WS_YS = 2086 * MiB;
constexpr size_t WS_END = 2358 * MiB;
static_assert((size_t)MPAD * 2048 == 272 * MiB, "sorted buffers");
constexpr int CW_TMO = 0, CW_CODE = 1, CW_BAR = 4096, CW_CNT = 8192;

constexpr int RING_OFF = 0, RING_BYTES = 131072;
constexpr int LDSCTL_OFF = RING_BYTES;
constexpr int LDS_BYTES = 163840;
constexpr int LC_MISC = 0;
constexpr int LC_PSTART = 128;
constexpr int LC_ULIST = 384;
constexpr int LC_CNT = 640;
constexpr int LC_BASE = 768;
constexpr int LC_SELE = 1024;
constexpr int LC_SELS = 1024 + 2048;
constexpr int LC_COS64 = 5120;
constexpr int LC_ROWS = 6144;
constexpr int LC_LG = 16384;

constexpr int NWAVES = 8;
constexpr int N_PHASES = 1 + 10 * NL;

typedef float f32x2_t __attribute__((ext_vector_type(2))); typedef __bf16 bf16x2_t __attribute__((ext_vector_type(2)));
__device__ __forceinline__ unsigned cvtpk2(float lo, float hi) { f32x2_t v = {lo, hi}; bf16x2_t b = __builtin_convertvector(v, bf16x2_t); return __builtin_bit_cast(unsigned, b); }
#define pk2(lo, hi) cvtpk2((lo), (hi))
#define f2bf(x) (cvtpk2((x), 0.f) & 0xffffu)
__device__ __forceinline__ float bf2f(unsigned short b) { return __uint_as_float((unsigned)b << 16); }
__device__ __forceinline__ float wave_sum(float v) {
#pragma unroll
    for (int o = 1; o < 64; o <<= 1) v += __shfl_xor(v, o);
    return v;
}
typedef unsigned short u16x8 __attribute__((ext_vector_type(8)));
typedef unsigned short u16x4 __attribute__((ext_vector_type(4)));

typedef float f32x2v __attribute__((ext_vector_type(2)));
__device__ __forceinline__ void tr_task(const float* W, int K, int Nsrc, int srcn, bf16* WT, int dst_n, int k0) {
#pragma unroll 1
    for (int hf = 0; hf < 2; ++hf) { const int kk = k0 + hf * 64; f32x2v v[64];
        if (srcn >= 0) { const float* p = W + (size_t)kk * Nsrc + srcn;
#pragma unroll
            for (int i = 0; i < 64; ++i) v[i] = __builtin_nontemporal_load((const f32x2v*)(p + (size_t)i * Nsrc)); }
        else {
#pragma unroll
            for (int i = 0; i < 64; ++i) v[i] = (f32x2v){0.f, 0.f}; }
        bf16* o0 = WT + (size_t)dst_n * K + kk; bf16* o1 = o0 + K;
#pragma unroll
        for (int j = 0; j < 8; ++j) { v4u w0, w1;
            w0.x = pk2(v[8 * j].x, v[8 * j + 1].x); w0.y = pk2(v[8 * j + 2].x, v[8 * j + 3].x); w0.z = pk2(v[8 * j + 4].x, v[8 * j + 5].x); w0.w = pk2(v[8 * j + 6].x, v[8 * j + 7].x);
            w1.x = pk2(v[8 * j].y, v[8 * j + 1].y); w1.y = pk2(v[8 * j + 2].y, v[8 * j + 3].y); w1.z = pk2(v[8 * j + 4].y, v[8 * j + 5].y); w1.w = pk2(v[8 * j + 6].y, v[8 * j + 7].y);
            *(v4u*)(o0 + 8 * j) = w0; *(v4u*)(o1 + 8 * j) = w1; } }
}

#define RC(l, j) (((j) >> 1) * 512 + 8 * (l) + ((j) & 1) * 4)
__device__ __forceinline__ void row_load_bf16(f32x4 (&v)[4], const bf16* row, int lane) {
#pragma unroll
    for (int h = 0; h < 2; ++h) { const v4u t = *(const v4u*)(row + h * 512 + 8 * lane);
        v[2 * h] = (f32x4){__uint_as_float(t.x << 16), __uint_as_float(t.x & 0xffff0000u), __uint_as_float(t.y << 16), __uint_as_float(t.y & 0xffff0000u)};
        v[2 * h + 1] = (f32x4){__uint_as_float(t.z << 16), __uint_as_float(t.z & 0xffff0000u), __uint_as_float(t.w << 16), __uint_as_float(t.w & 0xffff0000u)}; }
}
__device__ __forceinline__ void row_store_bf16(const f32x4 (&v)[4], bf16* row, int lane) {
#pragma unroll
    for (int h = 0; h < 2; ++h) { v4u w; w.x = pk2(v[2 * h].x, v[2 * h].y); w.y = pk2(v[2 * h].z, v[2 * h].w); w.z = pk2(v[2 * h + 1].x, v[2 * h + 1].y); w.w = pk2(v[2 * h + 1].z, v[2 * h + 1].w); *(v4u*)(row + h * 512 + 8 * lane) = w; }
}
__device__ __forceinline__ void ln_row8(f32x4 (&v)[4], const f32x4 (&gam)[4], const f32x4 (&bet)[4]) {
    float s = 0.f;
#pragma unroll
    for (int j = 0; j < 4; ++j) s += (v[j].x + v[j].y) + (v[j].z + v[j].w);
    const float mean = wave_sum(s) * (1.f / DM); float s2 = 0.f;
#pragma unroll
    for (int j = 0; j < 4; ++j) { v[j] = v[j] - mean; s2 += (v[j].x * v[j].x + v[j].y * v[j].y) + (v[j].z * v[j].z + v[j].w * v[j].w); }
    const float rstd = __builtin_amdgcn_rsqf(wave_sum(s2) * (1.f / DM) + LN_EPS);
#pragma unroll
    for (int j = 0; j < 4; ++j) v[j] = v[j] * rstd * gam[j] + bet[j];
}

constexpr int GM_QF = 0, GM_KF = 5120, GM_QB = 10240, GM_KB = 15360, GM_VT = 20480, GM_P = 29696, GM_HTF = 38912, GM_HTB = 44032, GM_DL = 38912, GM_SLOT = 49152;
static_assert(2 * GM_SLOT <= RING_BYTES, "two GLA chunk images fit the phase scratch");
#define MFMA16(a, b, c) __builtin_amdgcn_mfma_f32_16x16x32_bf16((a), (b), (c), 0, 0, 0)
template <bool OUT>
__device__ __forceinline__ void gla_stage_mfma(LAS unsigned char* Ls, const bf16* PROJ, const float* LA, const float* HIN, size_t tok0, int hd, int w4, int lane) {
    if (w4 < 2) { const int dir = w4, g = lane >> 3, c4 = (lane & 7) * 4; f32x4 bc[8]; u16x4 kx[8], qx[8];
        const float* lap = LA + (tok0 + 8 * g) * 256 + dir * 128 + hd * 32 + c4; const bf16* xp = PROJ + (tok0 + 8 * g) * INP + hd * 32 + c4;
#pragma unroll
        for (int i = 0; i < 8; ++i) { bc[i] = *(const f32x4*)(lap + (size_t)i * 256); kx[i] = *(const u16x4*)(xp + (size_t)i * INP + C_GK); if (OUT) qx[i] = *(const u16x4*)(xp + (size_t)i * INP + C_GQ); }
        f32x4 inc;
        if (dir == 0) {
#pragma unroll
            for (int i = 1; i < 8; ++i) bc[i] = bc[i] + bc[i - 1];
            inc = bc[7];
#pragma unroll
            for (int o = 1; o < 8; o <<= 1) { f32x4 y; y.x = __shfl_up(inc.x, 8 * o); y.y = __shfl_up(inc.y, 8 * o); y.z = __shfl_up(inc.z, 8 * o); y.w = __shfl_up(inc.w, 8 * o); if (g >= o) inc = inc + y; }
            const f32x4 off = inc - bc[7];
#pragma unroll
            for (int i = 0; i < 8; ++i) bc[i] = bc[i] + off; }
        else {
#pragma unroll
            for (int i = 6; i >= 0; --i) bc[i] = bc[i] + bc[i + 1];
            inc = bc[0];
#pragma unroll
            for (int o = 1; o < 8; o <<= 1) { f32x4 y; y.x = __shfl_down(inc.x, 8 * o); y.y = __shfl_down(inc.y, 8 * o); y.z = __shfl_down(inc.z, 8 * o); y.w = __shfl_down(inc.w, 8 * o); if (g + o < 8) inc = inc + y; }
            const f32x4 off = inc - bc[0];
#pragma unroll
            for (int i = 0; i < 8; ++i) bc[i] = bc[i] + off; }
        if (OUT) { LAS bf16* qd = (LAS bf16*)(Ls + (dir ? GM_QB : GM_QF)) + (8 * g) * 40 + c4; LAS bf16* kd = (LAS bf16*)(Ls + (dir ? GM_KB : GM_KF)) + (8 * g) * 40 + c4;
#pragma unroll
            for (int i = 0; i < 8; ++i) { float qv[4], kv[4];
#pragma unroll
                for (int c = 0; c < 4; ++c) { const float e_ = __expf(bc[i][c]); qv[c] = bf2f(qx[i][c]) * GLA_QSCALE * e_; kv[c] = bf2f(kx[i][c]) * __builtin_amdgcn_rcpf(e_); }
                *(LAS unsigned long long*)(qd + i * 40) = (unsigned long long)pk2(qv[0], qv[1]) | ((unsigned long long)pk2(qv[2], qv[3]) << 32);
                *(LAS unsigned long long*)(kd + i * 40) = (unsigned long long)pk2(kv[0], kv[1]) | ((unsigned long long)pk2(kv[2], kv[3]) << 32); } }
        else { LAS bf16* kt = (LAS bf16*)(Ls + GM_P + dir * 4608) + c4 * 72 + 8 * g;
#pragma unroll
            for (int c = 0; c < 4; ++c) { float t[8];
#pragma unroll
                for (int i = 0; i < 8; ++i) t[i] = bf2f(kx[i][c]) * __expf(-bc[i][c]);
                v4u w; w.x = pk2(t[0], t[1]); w.y = pk2(t[2], t[3]); w.z = pk2(t[4], t[5]); w.w = pk2(t[6], t[7]); *(LAS v4u*)(kt + c * 72) = w; }
            if (g == (dir ? 0 : 7)) { const f32x4 tot = dir ? bc[0] : bc[7]; LAS float* dl = (LAS float*)(Ls + GM_DL) + dir * 32 + c4; dl[0] = __expf(tot.x); dl[1] = __expf(tot.y); dl[2] = __expf(tot.z); dl[3] = __expf(tot.w); } } }
    else if (w4 == 2) { const int g = lane >> 3, v0 = (lane & 7) * 8; u16x8 x[8]; const bf16* xp = PROJ + (tok0 + 8 * g) * INP + C_GV + hd * 64 + v0;
#pragma unroll
        for (int i = 0; i < 8; ++i) x[i] = *(const u16x8*)(xp + (size_t)i * INP);
        LAS bf16* dst = (LAS bf16*)(Ls + GM_VT) + v0 * 72 + 8 * g;
#pragma unroll
        for (int c = 0; c < 8; ++c) { v4u w; w.x = (unsigned)x[0][c] | ((unsigned)x[1][c] << 16); w.y = (unsigned)x[2][c] | ((unsigned)x[3][c] << 16); w.z = (unsigned)x[4][c] | ((unsigned)x[5][c] << 16); w.w = (unsigned)x[6][c] | ((unsigned)x[7][c] << 16);
            *(LAS v4u*)(dst + c * 72) = w; } }
    else if (OUT) {
#pragma unroll
        for (int dir = 0; dir < 2; ++dir) { const f32x4* src = (const f32x4*)(HIN + ((size_t)dir * 64 + lane) * 32); LAS bf16* dst = (LAS bf16*)(Ls + (dir ? GM_HTB : GM_HTF)) + lane * 40;
#pragma unroll
            for (int c8 = 0; c8 < 4; ++c8) { const f32x4 a_ = src[2 * c8], b_ = src[2 * c8 + 1]; v4u w; w.x = pk2(a_.x, a_.y); w.y = pk2(a_.z, a_.w); w.z = pk2(b_.x, b_.y); w.w = pk2(b_.z, b_.w); *(LAS v4u*)(dst + c8 * 8) = w; } } }
}

typedef float f32x16 __attribute__((ext_vector_type(16)));
typedef short s16x4 __attribute__((ext_vector_type(4)));
__device__ __forceinline__ bf16x8 pack_step(const f32x16& x, int s) { v4u p; p.x = cvtpk2(x[8 * s], x[8 * s + 1]); p.y = cvtpk2(x[8 * s + 2], x[8 * s + 3]); p.z = cvtpk2(x[8 * s + 4], x[8 * s + 5]); p.w = cvtpk2(x[8 * s + 6], x[8 * s + 7]); return __builtin_bit_cast(bf16x8, p); }
__device__ __forceinline__ int crow16(int i, int h) { return (i & 3) + 8 * (i >> 2) + 4 * h; }
#define MFMA32(a, b, c) __builtin_amdgcn_mfma_f32_32x32x16_bf16((a), (b), (c), 0, 0, 0)
constexpr int FT_PITCH = 72, FT_TAB = 64 * FT_PITCH;
constexpr int FFT_LDS_TAB = 0, FFT_LDS_TW = 28672, FFT_LDS_HT = 28672, FFT_HT_PAIR = 2 * 64 * FT_PITCH * 2;

struct Args { const float* in[20]; float* out; unsigned char* ws; int ph_lo, ph_hi; };
static_assert(sizeof(Args) == 20 * 8 + 8 + 8 + 8, "no padding bytes in Args");


typedef __attribute__((address_space(4))) const unsigned char* kptr_t;
__device__ __forceinline__ kptr_t karg() { kptr_t p = (kptr_t)__builtin_amdgcn_kernarg_segment_ptr(); asm volatile("" : "+s"(p)); return p; }
#define KIN(i) (*(const float* const __attribute__((address_space(4)))*)(karg() + 8 * (i)))
#define KOUT() (*(float* const __attribute__((address_space(4)))*)(karg() + 160))
#define KWS() (*(unsigned char* const __attribute__((address_space(4)))*)(karg() + 168))
#define WSP(T, off) ((T*)(ws + (off)))

#ifndef NAIVE_ATTN
#define NAIVE_ATTN 0
#endif

__global__ void __launch_bounds__(NWAVES * 64, 2) fwd(Args args) {
    extern __shared__ __attribute__((aligned(16))) unsigned char lds_raw[];
    LAS unsigned char* lds = (LAS unsigned char*)lds_raw;
    LAS unsigned char* lctl = lds + LDSCTL_OFF;
    const int G = gridDim.x, bx = blockIdx.x;
    const int NGW = G * NWAVES, NGT = G * NWAVES * 64;
#define TID_SETUP() int tid_ = threadIdx.x; asm volatile("" : "+v"(tid_)); const int tid = tid_, lane = tid & 63, wave = __builtin_amdgcn_readfirstlane(tid >> 6); \
    const int gw = bx * NWAVES + wave, gt = bx * (NWAVES * 64) + tid; (void)lane; (void)gw; (void)gt
    for (int u = threadIdx.x; u < (LDS_BYTES - LDSCTL_OFF) / 4; u += NWAVES * 64) ((LAS unsigned*)lctl)[u] = 0u;
    __syncthreads();
    volatile LAS unsigned* MISC = (volatile LAS unsigned*)(lctl + LC_MISC);
    XcdBarrier bar = xcd_barrier_post((unsigned*)(KWS() + WS_CTL) + CW_BAR, MISC + 8);
    const int lo = args.ph_lo, hi = args.ph_hi;
#ifndef PH_OFF
#define PH_OFF 0
#endif
#define PON(j) (!((PH_OFF >> (j)) & 1))
#define IN(k) (lo <= (k) && (k) < hi)
#ifndef PROBE_A
#define PROBE_A -1
#endif
#ifndef PROBE_B
#define PROBE_B -1
#endif
#if PROBE_A >= 0
#define STAMP(k) do { if (blockIdx.x == 0 && threadIdx.x == 0) { ((unsigned long long*)(KWS() + WS_CTL + 65536))[(k)] = __builtin_amdgcn_s_memrealtime(); } } while (0)
#define STAMP2(i) do { __syncthreads(); if (blockIdx.x == 0 && threadIdx.x == 0) { ((unsigned long long*)(KWS() + WS_CTL + 65536))[128 + l * 16 + (i)] = __builtin_amdgcn_s_memrealtime(); } } while (0)
#else
#define STAMP(k) do {} while (0)
#define STAMP2(i) do {} while (0)
#endif
#ifndef PROBE_SUB_A
#define PROBE_SUB_A -1
#define PROBE_SUB_B -1
#endif
#define SEAM(k) do { if (IN(k) && IN((k) + 1)) xcd_barrier(bar); STAMP((k) + 1); } while (0)
    STAMP(0);

    if (IN(0) && PON(0)) {
        TID_SETUP(); unsigned char* ws = KWS(); const float* x_in = KIN(0); const float* ln_in_g = KIN(1); const float* ln_in_b = KIN(2); const float* w_in = KIN(3); const float* w_out = KIN(9);
        const float* exp_w_gu = KIN(14); const float* exp_w_down = KIN(16);
        float* ROPE = WSP(float, WS_ROPE); bf16* WIN_T = WSP(bf16, WS_WIN_T); bf16* WOUT_T = WSP(bf16, WS_WOUT_T); bf16* WGU_T = WSP(bf16, WS_WGU_T); bf16* WDN_T = WSP(bf16, WS_WDN_T);
        bf16* HB = WSP(bf16, WS_HB);
        { LAS unsigned* Lt = (LAS unsigned*)(lds + RING_OFF);
          constexpr int T_WIN = NL * 16 * 4, T_WOUT = NL * 8 * 4, T_WGU = NL * NE * 16 * 4, T_WDN = NL * NE * 8 * 4, NTILE = T_WIN + T_WOUT + T_WGU + T_WDN;
          for (int it = bx; it < NTILE; it += G) {
            int r = it; const float* W; bf16* WT; int Nsrc, nb, kq, mode;
            if (r < T_WIN) { const int l = r / 64, q = r % 64; nb = q / 4; kq = q % 4; W = w_in + (size_t)l * DM * INW; WT = WIN_T + (size_t)l * INP * DM; Nsrc = INW; mode = 0; }
            else if ((r -= T_WIN) < T_WOUT) { const int l = r / 32, q = r % 32; nb = q / 4; kq = q % 4; W = w_out + (size_t)l * DM * DM; WT = WOUT_T + (size_t)l * DM * DM; Nsrc = DM; mode = 1; }
            else if ((r -= T_WOUT) < T_WGU) { const int le = r / 64, q = r % 64; nb = q / 4; kq = q % 4; W = exp_w_gu + (size_t)le * DM * 2048; WT = WGU_T + (size_t)le * 2048 * DM; Nsrc = 2048; mode = 2; }
            else { r -= T_WGU; const int le = r / 32, q = r % 32; nb = q / 4; kq = q % 4; W = exp_w_down + (size_t)le * DE * DM; WT = WDN_T + (size_t)le * DM * DE; Nsrc = DM; mode = 1; }
            const int n = nb * 128 + 2 * lane;
            int src = n;
            if (mode == 0) src = n < 1536 ? n : (n < 1792 ? n + 32 : (n < 1824 ? n - 256 : -1));
            else if (mode == 2) { const int pn = n >> 8, bj = (n >> 7) & 1, j = n & 127; src = bj * 1024 + pn * 128 + j; }
            f32x2v v[32];
            if (src >= 0) { const float* p = W + (size_t)(kq * 256 + 32 * wave) * Nsrc + src;
#pragma unroll
                for (int i = 0; i < 32; ++i) v[i] = __builtin_nontemporal_load((const f32x2v*)(p + (size_t)i * Nsrc)); }
            else {
#pragma unroll
                for (int i = 0; i < 32; ++i) v[i] = (f32x2v){0.f, 0.f}; }
            __syncthreads();
#pragma unroll
            for (int i2 = 0; i2 < 16; ++i2) { Lt[(2 * lane) * 129 + 16 * wave + i2] = pk2(v[2 * i2].x, v[2 * i2 + 1].x); Lt[(2 * lane + 1) * 129 + 16 * wave + i2] = pk2(v[2 * i2].y, v[2 * i2 + 1].y); }
            __syncthreads();
            const int p4 = (lane & 31) * 4;
#pragma unroll
            for (int j = 0; j < 8; ++j) { const int row = 16 * wave + 2 * j + (lane >> 5); const LAS unsigned* lp = Lt + row * 129 + p4; v4u o; o.x = lp[0]; o.y = lp[1]; o.z = lp[2]; o.w = lp[3];
                *(v4u*)(WT + (size_t)(nb * 128 + row) * DM + kq * 256 + 2 * p4) = o; }
          }
          __syncthreads(); }
        { bf16* FTAB = WSP(bf16, WS_FTAB); float* TW = WSP(float, WS_TW);
          for (int it = gt; it < 3 * FT_TAB; it += NGT) { const int t = it / FT_TAB, q = it % FT_TAB, row = q / FT_PITCH, col = q % FT_PITCH; float sn, cs; sincospif((float)((row * col) & 63) * (1.0f / 32.0f), &sn, &cs);
              const float v = col >= 64 ? 0.f : (t == 0 ? cs : (t == 1 ? sn : -sn)); FTAB[it] = (bf16)f2bf(v); }
          for (int it = gt; it < 4096; it += NGT) { float sn, cs; sincospif((float)it * (1.0f / 2048.0f), &sn, &cs); TW[2 * it] = cs; TW[2 * it + 1] = -sn; } }
        { const float* router_w = KIN(12); bf16* RWT = WSP(bf16, WS_RWT);
          for (int it = gt; it < NL * NE * DM; it += NGT) { const int k = it & (DM - 1), e = (it >> 10) & 31, l = it >> 15; const float w = router_w[((size_t)l * DM + k) * NE + e];
              const unsigned hi = f2bf(w); const float lo = w - __uint_as_float(hi << 16); RWT[((size_t)(l * 2 + 0) * NE + e) * DM + k] = (bf16)hi; RWT[((size_t)(l * 2 + 1) * NE + e) * DM + k] = (bf16)f2bf(lo); } }
        for (int it = gt; it < SEQ * 32; it += NGT) { const int t = it >> 5, i = it & 31, a = i >> 4, f = i & 15; const int pos = a ? (t & 63) : (t >> 6);
            const double inv = exp(-9.210340371976184 * (double)f / 16.0); const double ang = (double)pos * inv;
            ROPE[it] = (float)cos(ang); ROPE[SEQ * 32 + it] = (float)sin(ang); }
        { f32x4 gam[4], bet[4];
#pragma unroll
          for (int j = 0; j < 4; ++j) { gam[j] = *(const f32x4*)(ln_in_g + RC(lane, j)); bet[j] = *(const f32x4*)(ln_in_b + RC(lane, j)); }
          for (int m0 = gw; m0 < NTOK; m0 += 2 * NGW) { f32x4 v[2][4];
#pragma unroll
            for (int q = 0; q < 2; ++q)
#pragma unroll
                for (int j = 0; j < 4; ++j) v[q][j] = *(const f32x4*)(x_in + (size_t)(m0 + q * NGW) * DM + RC(lane, j));
#pragma unroll
            for (int q = 0; q < 2; ++q) { ln_row8(v[q], gam, bet); row_store_bf16(v[q], HB + (size_t)(m0 + q * NGW) * DM, lane); } } }
    }
    SEAM(0);

    for (int l = 0; l < NL; ++l) {
        const int pb = 1 + 10 * l;
        if (IN(pb + 0) && PON(1)) {
            TID_SETUP(); unsigned char* ws = KWS(); bf16* HB = WSP(bf16, WS_HB); bf16* WIN_T = WSP(bf16, WS_WIN_T); bf16* PROJ = WSP(bf16, WS_PROJ);
            pg8::Gemm g{HB, WIN_T + (size_t)l * INP * DM, NTOK, INP, DM}; pg8::StaticOrder S; S.init(NTOK, INP, G, bx);
            pg8::EpiPlainBf16 E{PROJ, INP};
            STAMP2(2);
            pg8::gemm_phase<pg8::EpiPlainBf16, pg8::StaticOrder, true, true>(lds + RING_OFF, g, S, E);
            STAMP2(3);
        }
        SEAM(pb + 0);
        if (IN(pb + 1) && PON(2)) {
            TID_SETUP(); unsigned char* ws = KWS(); const float* att_q_gain = KIN(4); const float* att_k_gain = KIN(5); const float* gla_gate_w = KIN(6); const float* gla_gate_b = KIN(7);
            const float* ROPE = WSP(float, WS_ROPE); const bf16* PROJ = WSP(bf16, WS_PROJ); bf16* QB = WSP(bf16, WS_QB); bf16* KB = WSP(bf16, WS_KB); float* LA = WSP(float, WS_LA);
            STAMP2(8);
            { LAS float* RTC = (LAS float*)(lds + RING_OFF + 65536);
              for (int i = tid; i < 1024; i += NWAVES * 64) { const int pos = i >> 4, f = i & 15; RTC[i] = ROPE[(pos * 64) * 32 + f]; RTC[1024 + i] = ROPE[SEQ * 32 + (pos * 64) * 32 + f]; RTC[2048 + i] = ROPE[pos * 32 + 16 + f]; RTC[3072 + i] = ROPE[SEQ * 32 + pos * 32 + 16 + f]; }
              __syncthreads();
              const int li = lane & 7, ax = li >> 2, f0 = 8 * (li & 1); const float sg = ((li >> 1) & 1) ? 1.f : -1.f;
              f32x4 qg8[2], kg8[2];
#pragma unroll
              for (int c = 0; c < 2; ++c) { qg8[c] = *(const f32x4*)(att_q_gain + l * 64 + 8 * li + 4 * c); kg8[c] = *(const f32x4*)(att_k_gain + l * 64 + 8 * li + 4 * c); }
              for (int m0 = gw; m0 < NTOK; m0 += 4 * NGW) { v4u xp[5];
#pragma unroll
                for (int i = 0; i < 5; ++i) { const int P = lane + 64 * i, q = P / 80, p = P % 80; xp[i] = *(const v4u*)(PROJ + (size_t)(m0 + q * NGW) * INP + p * 8); }
#pragma unroll
                for (int i = 0; i < 5; ++i) { const int P = lane + 64 * i, q = P / 80, p = P % 80, head = p >> 3; const size_t m = (size_t)(m0 + q * NGW); const int t = (int)(m & (SEQ - 1));
                    float xv[8] = {__uint_as_float(xp[i].x << 16), __uint_as_float(xp[i].x & 0xffff0000u), __uint_as_float(xp[i].y << 16), __uint_as_float(xp[i].y & 0xffff0000u),
                                   __uint_as_float(xp[i].z << 16), __uint_as_float(xp[i].z & 0xffff0000u), __uint_as_float(xp[i].w << 16), __uint_as_float(xp[i].w & 0xffff0000u)};
                    float ss = 0.f;
#pragma unroll
                    for (int c = 0; c < 8; ++c) ss += xv[c] * xv[c];
                    ss += __shfl_xor(ss, 1); ss += __shfl_xor(ss, 2); ss += __shfl_xor(ss, 4);
                    const float rs = __builtin_amdgcn_rsqf(ss * (1.f / 64.f) + RMS_EPS); const bool isq = head < 8;
                    const LAS float* tb = RTC + (ax ? 2048 : 0) + (ax ? (t & 63) : (t >> 6)) * 16 + f0;
                    const f32x4 c0 = *(const LAS f32x4*)tb, c1 = *(const LAS f32x4*)(tb + 4), s0 = *(const LAS f32x4*)(tb + 1024), s1 = *(const LAS f32x4*)(tb + 1028);
                    const float csv[8] = {c0.x, c0.y, c0.z, c0.w, c1.x, c1.y, c1.z, c1.w}, snv[8] = {s0.x, s0.y, s0.z, s0.w, s1.x, s1.y, s1.z, s1.w};
                    const f32x4 g0 = isq ? qg8[0] : kg8[0], g1 = isq ? qg8[1] : kg8[1]; const float gv[8] = {g0.x, g0.y, g0.z, g0.w, g1.x, g1.y, g1.z, g1.w};
                    const float osc = isq ? QSCALE : 1.f; float o[8];
#pragma unroll
                    for (int c = 0; c < 8; ++c) { const float xn = xv[c] * rs * gv[c]; const float pr = __shfl_xor(xn, 2); o[c] = (xn * csv[c] + sg * pr * snv[c]) * osc; }
                    v4u w; w.x = pk2(o[0], o[1]); w.y = pk2(o[2], o[3]); w.z = pk2(o[4], o[5]); w.w = pk2(o[6], o[7]);
                    bf16* dst = isq ? (QB + m * 512 + head * 64 + 8 * li) : (KB + m * 128 + (head - 8) * 64 + 8 * li);
                    *(v4u*)dst = w; } }
              const float* gw_l = gla_gate_w + (size_t)l * 2 * 16 * 128; const float* gb_l = gla_gate_b + (size_t)l * 2 * 128; const int dir = lane >> 5, kc = (lane & 31) * 4;
              f32x4 gwr[16]; const f32x4 gbv = *(const f32x4*)(gb_l + dir * 128 + kc);
#pragma unroll
              for (int r = 0; r < 16; ++r) gwr[r] = *(const f32x4*)(gw_l + (size_t)(dir * 16 + r) * 128 + kc);
              for (int m0 = gw; m0 < NTOK; m0 += 4 * NGW) { v4u gl[4][2];
#pragma unroll
                for (int q = 0; q < 4; ++q) { const bf16* gp = PROJ + (size_t)(m0 + q * NGW) * INP + C_GLR + dir * 16; gl[q][0] = *(const v4u*)gp; gl[q][1] = *(const v4u*)(gp + 8); }
#pragma unroll
                for (int q = 0; q < 4; ++q) { const size_t m = (size_t)(m0 + q * NGW); f32x4 z = gbv;
                    const unsigned gu[8] = {gl[q][0].x, gl[q][0].y, gl[q][0].z, gl[q][0].w, gl[q][1].x, gl[q][1].y, gl[q][1].z, gl[q][1].w};
#pragma unroll
                    for (int r2 = 0; r2 < 8; ++r2) { z = z + gwr[2 * r2] * __uint_as_float(gu[r2] << 16); z = z + gwr[2 * r2 + 1] * __uint_as_float(gu[r2] & 0xffff0000u); }
                    f32x4 o4;
#pragma unroll
                    for (int i = 0; i < 4; ++i) o4[i] = (fminf(z[i], 0.f) - __logf(1.f + __expf(-fabsf(z[i])))) * (1.f / 16.f);
                    *(f32x4*)(LA + m * 256 + dir * 128 + kc) = o4; } }
              __syncthreads(); }
            STAMP2(4);
            { __syncthreads();
              { const v4u* src = (const v4u*)WSP(bf16, WS_FTAB); LAS v4u* dst = (LAS v4u*)(lds + RING_OFF + FFT_LDS_TAB); for (int i = tid; i < 3 * FT_TAB * 2 / 16; i += NWAVES * 64) dst[i] = src[i];
                const v4u* s2_ = (const v4u*)WSP(float, WS_TW); LAS v4u* d2_ = (LAS v4u*)(lds + RING_OFF + FFT_LDS_TW); for (int i = tid; i < 4096 * 8 / 16; i += NWAVES * 64) d2_[i] = s2_[i]; }
              __syncthreads();
              const LAS bf16* FT = (const LAS bf16*)(lds + RING_OFF + FFT_LDS_TAB); const LAS float* TWL = (const LAS float*)(lds + RING_OFF + FFT_LDS_TW); bf16* FTMP = WSP(bf16, WS_FTMP);
              const int pair = wave >> 1, cb = wave & 1, r = lane & 31, h = lane >> 5;
              for (int ub = bx; ub < NB * 4 * 64 / 4; ub += G) { const int u = ub * 4 + pair, s2 = u & 63, g4 = (u >> 6) & 3, b = u >> 8;
                bf16x8 xa[2][4];
#pragma unroll
                for (int R = 0; R < 2; ++R)
#pragma unroll
                    for (int ks = 0; ks < 4; ++ks) xa[R][ks] = *(const bf16x8*)(PROJ + ((size_t)b * SEQ + 64 * (32 * R + r) + s2) * INP + C_FX + g4 * 64 + 16 * ks + 8 * h);
                f32x16 Tr[2], Ti[2];
#pragma unroll
                for (int R = 0; R < 2; ++R)
#pragma unroll
                    for (int i = 0; i < 16; ++i) { Tr[R][i] = 0.f; Ti[R][i] = 0.f; }
#pragma unroll
                for (int ks = 0; ks < 4; ++ks) { const bf16x8 bc = *(const LAS bf16x8*)(FT + (32 * cb + r) * FT_PITCH + 16 * ks + 8 * h), bs = *(const LAS bf16x8*)(FT + 2 * FT_TAB + (32 * cb + r) * FT_PITCH + 16 * ks + 8 * h);
#pragma unroll
                    for (int R = 0; R < 2; ++R) { Tr[R] = MFMA32(xa[R][ks], bc, Tr[R]); Ti[R] = MFMA32(xa[R][ks], bs, Ti[R]); } }
#pragma unroll
                for (int Rp = 0; Rp < 2; ++Rp) { f32x16 Gr, Gi;
#pragma unroll
                    for (int i = 0; i < 16; ++i) { Gr[i] = 0.f; Gi[i] = 0.f; }
#pragma unroll
                    for (int R = 0; R < 2; ++R)
#pragma unroll
                        for (int s_ = 0; s_ < 2; ++s_) { const bf16x8 xr = pack_step(Tr[R], s_), xi = pack_step(Ti[R], s_);
                            const int kb = 32 * R + 16 * s_ + 4 * h, ro = (32 * Rp + r) * FT_PITCH + kb;
                            const s16x4 c0 = *(const LAS s16x4*)(FT + ro), c1 = *(const LAS s16x4*)(FT + ro + 8), s0 = *(const LAS s16x4*)(FT + FT_TAB + ro), s1 = *(const LAS s16x4*)(FT + FT_TAB + ro + 8),
                                        n0 = *(const LAS s16x4*)(FT + 2 * FT_TAB + ro), n1 = *(const LAS s16x4*)(FT + 2 * FT_TAB + ro + 8);
                            const bf16x8 ca = __builtin_shufflevector(c0, c1, 0, 1, 2, 3, 4, 5, 6, 7), sa = __builtin_shufflevector(s0, s1, 0, 1, 2, 3, 4, 5, 6, 7), na = __builtin_shufflevector(n0, n1, 0, 1, 2, 3, 4, 5, 6, 7);
                            Gr = MFMA32(ca, xr, Gr); Gr = MFMA32(sa, xi, Gr); Gi = MFMA32(ca, xi, Gi); Gi = MFMA32(na, xr, Gi); }
#pragma unroll
                    for (int i = 0; i < 16; ++i) { const int s1p = 32 * Rp + crow16(i, h); const int m = (s2 * s1p) & 4095; const float wr = TWL[2 * m], wi = TWL[2 * m + 1];
                        const size_t o = ((((size_t)(b * 4 + g4) * 64 + s1p) * 2) * 64 + s2) * 64 + 32 * cb + r;
                        FTMP[o] = (bf16)f2bf(Gr[i] * wr - Gi[i] * wi); FTMP[o + 4096] = (bf16)f2bf(Gr[i] * wi + Gi[i] * wr); } }
              }
              __syncthreads(); }
            STAMP2(5);
            { float* GS = WSP(float, WS_OF); float* GD = WSP(float, WS_OB);
              const int slot = wave >> 2, w4 = wave & 3, fr = lane & 15, fq = lane >> 4; LAS unsigned char* Ls = lds + RING_OFF + slot * GM_SLOT;
              for (int ub = bx; ub < NB * 4 * 64 / 2; ub += G) { const int u = ub * 2 + slot, c = u & 63, bh = u >> 6, hd = bh & 3, b = bh >> 2; const size_t tok0 = (size_t)b * SEQ + c * 64;
                __syncthreads();
                gla_stage_mfma<false>(Ls, PROJ, LA, nullptr, tok0, hd, w4, lane);
                __syncthreads();
                const LAS bf16* VT = (const LAS bf16*)(Ls + GM_VT); const LAS float* DL = (const LAS float*)(Ls + GM_DL);
#pragma unroll
                for (int dir = 0; dir < 2; ++dir) { const LAS bf16* KT = (const LAS bf16*)(Ls + GM_P + dir * 4608);
#pragma unroll
                    for (int Cd = 0; Cd < 2; ++Cd) { f32x4 acc = {0.f, 0.f, 0.f, 0.f};
#pragma unroll
                        for (int ks = 0; ks < 2; ++ks) { const bf16x8 a_ = *(const LAS bf16x8*)(VT + (16 * w4 + fr) * 72 + 32 * ks + 8 * fq), b_ = *(const LAS bf16x8*)(KT + (16 * Cd + fr) * 72 + 32 * ks + 8 * fq); acc = MFMA16(a_, b_, acc); }
                        const float Dd = DL[dir * 32 + 16 * Cd + fr]; float* o = GS + (((size_t)u * 2 + dir) * 64 + 16 * w4 + 4 * fq) * 32 + 16 * Cd + fr;
#pragma unroll
                        for (int r = 0; r < 4; ++r) o[r * 32] = acc[r] * Dd; } }
                if (w4 == 3) GD[((size_t)u * 2 + (lane >> 5)) * 32 + (lane & 31)] = DL[lane]; }
              __syncthreads(); }
            STAMP2(9);
        }
        SEAM(pb + 1);
        if (IN(pb + 2) && PON(3)) {
            TID_SETUP(); unsigned char* ws = KWS(); float* GS = WSP(float, WS_OF); const float* GD = WSP(float, WS_OB);
            for (int e = gt; e < NB * 4 * 2 * 2048; e += NGT) { const int dv = e & 2047, dir = (e >> 11) & 1, bh = e >> 12, d = dv & 31; float H = 0.f;
                for (int c8 = 0; c8 < 64; c8 += 8) { float sv[8], dd[8];
#pragma unroll
                    for (int i = 0; i < 8; ++i) { const int c = dir ? 63 - (c8 + i) : (c8 + i); const size_t sidx = ((size_t)(bh * 64 + c) * 2 + dir); sv[i] = GS[sidx * 2048 + dv]; dd[i] = GD[sidx * 32 + d]; }
#pragma unroll
                    for (int i = 0; i < 8; ++i) { const int c = dir ? 63 - (c8 + i) : (c8 + i); const size_t sidx = ((size_t)(bh * 64 + c) * 2 + dir); GS[sidx * 2048 + dv] = H; H = H * dd[i] + sv[i]; } } }
        }
        SEAM(pb + 2);
        if (IN(pb + 3) && PON(4)) {
            TID_SETUP(); unsigned char* ws = KWS(); const float* gla_norm_g = KIN(8); const bf16* PROJ = WSP(bf16, WS_PROJ);
            bf16* MIX = WSP(bf16, WS_MIX); const bf16* QB = WSP(bf16, WS_QB); const bf16* KB = WSP(bf16, WS_KB);
            STAMP2(10);
            { __syncthreads();
              { const v4u* src = (const v4u*)WSP(bf16, WS_FTAB); LAS v4u* dst = (LAS v4u*)(lds + RING_OFF + FFT_LDS_TAB); for (int i = tid; i < 3 * FT_TAB * 2 / 16; i += NWAVES * 64) dst[i] = src[i]; }
              const LAS bf16* FT = (const LAS bf16*)(lds + RING_OFF + FFT_LDS_TAB); const bf16* FTMP = WSP(bf16, WS_FTMP);
              const int pair = wave >> 1, cb = wave & 1, r = lane & 31, h = lane >> 5;
              LAS bf16* HT = (LAS bf16*)(lds + RING_OFF + FFT_LDS_HT + pair * FFT_HT_PAIR);
              for (int ub = bx; ub < NB * 4 * 64 / 4; ub += G) { const int u = ub * 4 + pair, s1p = u & 63, g4 = (u >> 6) & 3, b = u >> 8;
                const bf16* src = FTMP + (size_t)u * 2 * 4096;
                __syncthreads();
#pragma unroll
                for (int q = 0; q < 8; ++q) { const int p = cb * 64 + lane + 128 * q, ri = p >> 9, s2 = (p >> 3) & 63, c0 = (p & 7) * 8; const u16x8 v = *(const u16x8*)(src + p * 8);
#pragma unroll
                    for (int i = 0; i < 8; ++i) HT[(ri * 64 + c0 + i) * FT_PITCH + s2] = v[i]; }
                __syncthreads();
#pragma unroll
                for (int Rp = 0; Rp < 2; ++Rp) { f32x16 acc;
#pragma unroll
                    for (int i = 0; i < 16; ++i) acc[i] = 0.f;
#pragma unroll
                    for (int ks = 0; ks < 4; ++ks) { const int ko = 16 * ks + 8 * h;
                        const bf16x8 ca = *(const LAS bf16x8*)(FT + (32 * Rp + r) * FT_PITCH + ko), sa = *(const LAS bf16x8*)(FT + FT_TAB + (32 * Rp + r) * FT_PITCH + ko);
                        const bf16x8 hr = *(const LAS bf16x8*)(HT + (32 * cb + r) * FT_PITCH + ko), hi_ = *(const LAS bf16x8*)(HT + (64 + 32 * cb + r) * FT_PITCH + ko);
                        acc = MFMA32(ca, hr, acc); acc = MFMA32(sa, hi_, acc); }
#pragma unroll
                    for (int i = 0; i < 16; ++i) { const int s2p = 32 * Rp + crow16(i, h); MIX[((size_t)b * SEQ + s1p + 64 * s2p) * DM + 768 + g4 * 64 + 32 * cb + r] = (bf16)f2bf(acc[i] * (1.0f / 512.0f)); } }
              }
              __syncthreads(); }
            STAMP2(6);
            { const float* GS = WSP(float, WS_OF); const float* LA = WSP(float, WS_LA);
              const int slot = wave >> 2, w4 = wave & 3, fr = lane & 15, fq = lane >> 4, I0 = 16 * w4; LAS unsigned char* Ls = lds + RING_OFF + slot * GM_SLOT;
              for (int ub = bx; ub < NB * 4 * 64 / 2; ub += G) { const int u = ub * 2 + slot, c = u & 63, bh = u >> 6, hd = bh & 3, b = bh >> 2; const size_t tok0 = (size_t)b * SEQ + c * 64;
                unsigned short rgv[4][4]; float gnv[4];
#pragma unroll
                for (int Cv = 0; Cv < 4; ++Cv) { gnv[Cv] = gla_norm_g[l * 64 + 16 * Cv + fr];
#pragma unroll
                    for (int r = 0; r < 4; ++r) rgv[Cv][r] = PROJ[(tok0 + I0 + 4 * fq + r) * INP + C_GR + hd * 64 + 16 * Cv + fr]; }
                __syncthreads();
                gla_stage_mfma<true>(Ls, PROJ, LA, GS + (size_t)u * 2 * 2048, tok0, hd, w4, lane);
                __syncthreads();
                const LAS bf16* QF = (const LAS bf16*)(Ls + GM_QF); const LAS bf16* KF = (const LAS bf16*)(Ls + GM_KF); const LAS bf16* QBm = (const LAS bf16*)(Ls + GM_QB); const LAS bf16* KBm = (const LAS bf16*)(Ls + GM_KB);
                const LAS bf16* VT = (const LAS bf16*)(Ls + GM_VT); LAS bf16* P = (LAS bf16*)(Ls + GM_P); const LAS bf16* HTF = (const LAS bf16*)(Ls + GM_HTF); const LAS bf16* HTB = (const LAS bf16*)(Ls + GM_HTB);
                const bf16x8 qfa = *(const LAS bf16x8*)(QF + (I0 + fr) * 40 + 8 * fq), qba = *(const LAS bf16x8*)(QBm + (I0 + fr) * 40 + 8 * fq);
#pragma unroll
                for (int Cj = 0; Cj < 4; ++Cj) { const f32x4 z = {0.f, 0.f, 0.f, 0.f};
                    const f32x4 pf = MFMA16(qfa, *(const LAS bf16x8*)(KF + (16 * Cj + fr) * 40 + 8 * fq), z), pb = MFMA16(qba, *(const LAS bf16x8*)(KBm + (16 * Cj + fr) * 40 + 8 * fq), z);
#pragma unroll
                    for (int r = 0; r < 4; ++r) { const int i = I0 + 4 * fq + r, j = 16 * Cj + fr; P[i * 72 + j] = (bf16)f2bf(j <= i ? pf[r] : pb[r]); } }
                asm volatile("s_waitcnt lgkmcnt(0)" ::: "memory");
                f32x4 o[4];
#pragma unroll
                for (int Cv = 0; Cv < 4; ++Cv) { f32x4 acc = {0.f, 0.f, 0.f, 0.f};
#pragma unroll
                    for (int ks = 0; ks < 2; ++ks) acc = MFMA16(*(const LAS bf16x8*)(P + (I0 + fr) * 72 + 32 * ks + 8 * fq), *(const LAS bf16x8*)(VT + (16 * Cv + fr) * 72 + 32 * ks + 8 * fq), acc);
                    acc = MFMA16(qfa, *(const LAS bf16x8*)(HTF + (16 * Cv + fr) * 40 + 8 * fq), acc); acc = MFMA16(qba, *(const LAS bf16x8*)(HTB + (16 * Cv + fr) * 40 + 8 * fq), acc);
                    o[Cv] = acc; }
                float rs[4];
#pragma unroll
                for (int r = 0; r < 4; ++r) { float ss = (o[0][r] * o[0][r] + o[1][r] * o[1][r]) + (o[2][r] * o[2][r] + o[3][r] * o[3][r]);
#pragma unroll
                    for (int m_ = 1; m_ < 16; m_ <<= 1) ss += __shfl_xor(ss, m_);
                    rs[r] = 1.f / sqrtf(ss * (1.f / 64.f) + RMS_EPS); }
#pragma unroll
                for (int Cv = 0; Cv < 4; ++Cv) { const int v = 16 * Cv + fr; const float gn = gnv[Cv];
#pragma unroll
                    for (int r = 0; r < 4; ++r) { const size_t m = tok0 + I0 + 4 * fq + r; const float rg = bf2f(rgv[Cv][r]);
                        MIX[m * DM + 512 + hd * 64 + v] = (bf16)f2bf(o[Cv][r] * rs[r] * gn * rg * __builtin_amdgcn_rcpf(1.f + __expf(-rg))); } } }
              __syncthreads(); }
            STAMP2(7);
#if NAIVE_ATTN
            { LAS float* Kt = (LAS float*)(lds + RING_OFF); LAS float* Vt = Kt + 64 * 64;
              for (int unit = bx; unit < NB * 8 * 8; unit += G) { const int rb = unit & 7, h = (unit >> 3) & 7, b = unit >> 6, kvh = h >> 2;
                const size_t qrow = (size_t)b * SEQ + rb * 512 + tid;
                float q[64], o[64]; float mrun = -INFINITY, lrun = 0.f;
#pragma unroll
                for (int c8 = 0; c8 < 8; ++c8) { const u16x8 f = *(const u16x8*)(QB + qrow * 512 + h * 64 + c8 * 8);
#pragma unroll
                    for (int i = 0; i < 8; ++i) { q[c8 * 8 + i] = bf2f(f[i]); o[c8 * 8 + i] = 0.f; } }
                for (int kt = 0; kt < SEQ; kt += 64) {
                    __syncthreads();
                    { const int kr = tid >> 3, c8 = (tid & 7) * 8; const size_t krow = (size_t)b * SEQ + kt + kr;
                      const u16x8 kf = *(const u16x8*)(KB + krow * 128 + kvh * 64 + c8); const u16x8 vf = *(const u16x8*)(PROJ + krow * INP + C_AV + kvh * 64 + c8);
#pragma unroll
                      for (int i = 0; i < 8; ++i) { Kt[kr * 64 + c8 + i] = bf2f(kf[i]); Vt[kr * 64 + c8 + i] = bf2f(vf[i]); } }
                    __syncthreads();
#pragma unroll 1
                    for (int j = 0; j < 64; ++j) { float a = 0.f;
#pragma unroll
                        for (int d4 = 0; d4 < 16; ++d4) { const f32x4 kv = *(const LAS f32x4*)(Kt + j * 64 + d4 * 4); a += (q[d4 * 4] * kv.x + q[d4 * 4 + 1] * kv.y) + (q[d4 * 4 + 2] * kv.z + q[d4 * 4 + 3] * kv.w); }
                        if (a > mrun) { const float al = exp2f(mrun - a); mrun = a; lrun *= al;
#pragma unroll
                            for (int d = 0; d < 64; ++d) o[d] *= al; }
                        const float p = exp2f(a - mrun); lrun += p;
#pragma unroll
                        for (int d4 = 0; d4 < 16; ++d4) { const f32x4 vv = *(const LAS f32x4*)(Vt + j * 64 + d4 * 4); o[d4 * 4] += p * vv.x; o[d4 * 4 + 1] += p * vv.y; o[d4 * 4 + 2] += p * vv.z; o[d4 * 4 + 3] += p * vv.w; } }
                }
                const float rl = 1.f / lrun;
#pragma unroll
                for (int c8 = 0; c8 < 8; ++c8) { v4u w; w.x = pk2(o[c8 * 8] * rl, o[c8 * 8 + 1] * rl); w.y = pk2(o[c8 * 8 + 2] * rl, o[c8 * 8 + 3] * rl); w.z = pk2(o[c8 * 8 + 4] * rl, o[c8 * 8 + 5] * rl); w.w = pk2(o[c8 * 8 + 6] * rl, o[c8 * 8 + 7] * rl);
                    *(v4u*)(MIX + qrow * DM + h * 64 + c8 * 8) = w; }
              }
              __syncthreads(); }
#else
            { const attn_body::AttnTensors AT{(const attn_body::bf16*)QB, (const attn_body::bf16*)KB, (const attn_body::bf16*)(PROJ + C_AV), (attn_body::bf16*)MIX};
              const attn_body::StaticOrder S(G, bx);
              attn_body::attn_phase<attn_body::StaticOrder>((char*)lds_raw + RING_OFF, AT, S); }
#endif
            STAMP2(11);
        }
        SEAM(pb + 3);
        if (IN(pb + 4) && PON(5)) {
            TID_SETUP(); unsigned char* ws = KWS(); const bf16* MIX = WSP(bf16, WS_MIX); const bf16* WOUT_T = WSP(bf16, WS_WOUT_T); const bf16* HB = WSP(bf16, WS_HB); bf16* T1 = WSP(bf16, WS_T1);
            pg8::Gemm g{MIX, WOUT_T + (size_t)l * DM * DM, NTOK, DM, DM}; pg8::StaticOrder S; S.init(NTOK, DM, G, bx);
            pg8::EpiResBf16 E{HB, T1, DM, DN_ALPHA};
            pg8::gemm_phase<pg8::EpiResBf16, pg8::StaticOrder, true, true>(lds + RING_OFF, g, S, E);
        }
        SEAM(pb + 4);
        if (IN(pb + 5) && PON(6)) {
            TID_SETUP(); unsigned char* ws = KWS(); gu32* ctl = (gu32*)(ws + WS_CTL); const float* ln1_g = KIN(10); const float* ln1_b = KIN(11); const float* router_w = KIN(12); const float* router_b = KIN(13);
            const bf16* T1 = WSP(bf16, WS_T1); bf16* HB = WSP(bf16, WS_HB); int* TOKE = WSP(int, WS_TOK); int* TOKS = TOKE + NTOK * 4; float* TOKW = (float*)(TOKS + NTOK * 4); int* LIST = WSP(int, WS_XS);
            { const v4u* src = (const v4u*)(WSP(bf16, WS_RWT) + (size_t)l * 2 * NE * DM); LAS v4u* dst = (LAS v4u*)(lds + RING_OFF);
              for (int i = tid; i < 2 * NE * DM * 2 / 16; i += NWAVES * 64) { const int row = i >> 7, c = i & 127; dst[row * 128 + (c ^ (row & 7))] = src[i]; }
              LAS float* GBw = (LAS float*)(lctl + LC_ROWS); for (int i = tid; i < DM; i += NWAVES * 64) { GBw[i] = ln1_g[l * DM + i]; GBw[DM + i] = ln1_b[l * DM + i]; } }
            const LAS bf16* RWH = (const LAS bf16*)(lds + RING_OFF); const LAS float* GB = (const LAS float*)(lctl + LC_ROWS); LAS float* ST = (LAS float*)(lctl + LC_ROWS + 8192);
            LAS int* lcnt = (LAS int*)(lctl + LC_CNT); LAS int* lbase = (LAS int*)(lctl + LC_BASE); LAS int* sele = (LAS int*)(lctl + LC_SELE); LAS int* sels = (LAS int*)(lctl + LC_SELS);
            const float* rb = router_b + l * NE;
            for (int r0 = bx * 128; r0 < NTOK; r0 += G * 128) {
                if (tid < 32) lcnt[tid] = 0;
                __syncthreads();
                LAS float* LG = (LAS float*)(lctl + LC_LG) + wave * 512;
                for (int rr = 0; rr < 16; rr += 4) { f32x4 v[4][4];
#pragma unroll
                    for (int q = 0; q < 4; ++q) row_load_bf16(v[q], T1 + ((size_t)r0 + wave * 16 + rr + q) * DM, lane);
#pragma unroll
                    for (int q = 0; q < 4; ++q) { float s_ = 0.f;
#pragma unroll
                        for (int j = 0; j < 4; ++j) s_ += (v[q][j].x + v[q][j].y) + (v[q][j].z + v[q][j].w);
                        const float mean = wave_sum(s_) * (1.f / DM); float s2_ = 0.f;
#pragma unroll
                        for (int j = 0; j < 4; ++j) { const f32x4 d_ = v[q][j] - mean; s2_ += (d_.x * d_.x + d_.y * d_.y) + (d_.z * d_.z + d_.w * d_.w); }
                        const float rstd = __builtin_amdgcn_rsqf(wave_sum(s2_) * (1.f / DM) + LN_EPS);
                        if (lane == 0) { ST[(wave * 16 + rr + q) * 2] = mean; ST[(wave * 16 + rr + q) * 2 + 1] = rstd; } } }
                asm volatile("s_waitcnt lgkmcnt(0)" ::: "memory");
                { const int fr = lane & 15, fq = lane >> 4; const size_t row = (size_t)r0 + wave * 16 + fr; const float mean = ST[(wave * 16 + fr) * 2], rstd = ST[(wave * 16 + fr) * 2 + 1];
                  const bf16* xrow = T1 + row * DM + 8 * fq; bf16* hrow = HB + row * DM + 8 * fq;
                  f32x4 acc0 = {0.f, 0.f, 0.f, 0.f}, acc1 = {0.f, 0.f, 0.f, 0.f};
#pragma unroll 1
                  for (int s8 = 0; s8 < 32; s8 += 8) { v4u xr[8];
#pragma unroll
                    for (int i = 0; i < 8; ++i) xr[i] = *(const v4u*)(xrow + 32 * (s8 + i));
#pragma unroll
                    for (int i = 0; i < 8; ++i) { const int k0 = 32 * (s8 + i) + 8 * fq;
                        const f32x4 g0 = *(const LAS f32x4*)(GB + k0), g1 = *(const LAS f32x4*)(GB + k0 + 4), b0 = *(const LAS f32x4*)(GB + DM + k0), b1 = *(const LAS f32x4*)(GB + DM + k0 + 4);
                        f32x4 x0 = {__uint_as_float(xr[i].x << 16), __uint_as_float(xr[i].x & 0xffff0000u), __uint_as_float(xr[i].y << 16), __uint_as_float(xr[i].y & 0xffff0000u)};
                        f32x4 x1 = {__uint_as_float(xr[i].z << 16), __uint_as_float(xr[i].z & 0xffff0000u), __uint_as_float(xr[i].w << 16), __uint_as_float(xr[i].w & 0xffff0000u)};
                        x0 = (x0 - mean) * rstd * g0 + b0; x1 = (x1 - mean) * rstd * g1 + b1;
                        v4u hi; hi.x = pk2(x0.x, x0.y); hi.y = pk2(x0.z, x0.w); hi.z = pk2(x1.x, x1.y); hi.w = pk2(x1.z, x1.w);
                        *(v4u*)(hrow + 32 * (s8 + i)) = hi;
                        const f32x4 l0 = {x0.x - __uint_as_float(hi.x << 16), x0.y - __uint_as_float(hi.x & 0xffff0000u), x0.z - __uint_as_float(hi.y << 16), x0.w - __uint_as_float(hi.y & 0xffff0000u)};
                        const f32x4 l1 = {x1.x - __uint_as_float(hi.z << 16), x1.y - __uint_as_float(hi.z & 0xffff0000u), x1.z - __uint_as_float(hi.w << 16), x1.w - __uint_as_float(hi.w & 0xffff0000u)};
                        v4u lo; lo.x = pk2(l0.x, l0.y); lo.y = pk2(l0.z, l0.w); lo.z = pk2(l1.x, l1.y); lo.w = pk2(l1.z, l1.w);
                        const bf16x8 ah = __builtin_bit_cast(bf16x8, hi), al = __builtin_bit_cast(bf16x8, lo);
                        const int c = 4 * (s8 + i) + fq;
                        const LAS bf16* w0 = RWH + fr * DM + ((c ^ (fr & 7)) << 3); const LAS bf16* w1 = RWH + (16 + fr) * DM + ((c ^ (fr & 7)) << 3);
                        const bf16x8 bh0 = *(const LAS bf16x8*)w0, bl0 = *(const LAS bf16x8*)(w0 + NE * DM), bh1 = *(const LAS bf16x8*)w1, bl1 = *(const LAS bf16x8*)(w1 + NE * DM);
                        acc0 = MFMA16(ah, bh0, acc0); acc0 = MFMA16(ah, bl0, acc0); acc0 = MFMA16(al, bh0, acc0);
                        acc1 = MFMA16(ah, bh1, acc1); acc1 = MFMA16(ah, bl1, acc1); acc1 = MFMA16(al, bh1, acc1); } }
                  const float bias0 = rb[fr], bias1 = rb[16 + fr];
#pragma unroll
                  for (int r = 0; r < 4; ++r) { LG[(4 * fq + r) * 32 + fr] = acc0[r] + bias0; LG[(4 * fq + r) * 32 + 16 + fr] = acc1[r] + bias1; } }
                asm volatile("s_waitcnt lgkmcnt(0)" ::: "memory");
                if (lane < 16) { const int lr = wave * 16 + lane; const size_t m = (size_t)r0 + lr; float lg[32];
#pragma unroll
                    for (int e4 = 0; e4 < 8; ++e4) { const f32x4 x = *(const LAS f32x4*)(LG + lane * 32 + e4 * 4); lg[e4 * 4] = x.x; lg[e4 * 4 + 1] = x.y; lg[e4 * 4 + 2] = x.z; lg[e4 * 4 + 3] = x.w; }
                    int se[4]; float sv[4];
#pragma unroll
                    for (int k = 0; k < 4; ++k) { float best = -INFINITY; int bi = 0;
#pragma unroll
                        for (int e = 0; e < 32; ++e) { if (lg[e] > best) { best = lg[e]; bi = e; } }
                        se[k] = bi; sv[k] = best;
#pragma unroll
                        for (int e = 0; e < 32; ++e) if (e == bi) lg[e] = -INFINITY; }
                    const float e1 = expf(sv[1] - sv[0]), e2 = expf(sv[2] - sv[0]), e3 = expf(sv[3] - sv[0]); const float inv = 1.f / (1.f + e1 + e2 + e3);
                    const float wts[4] = {inv, e1 * inv, e2 * inv, e3 * inv};
#pragma unroll
                    for (int k = 0; k < 4; ++k) { const int ls = __hip_atomic_fetch_add(lcnt + se[k], 1, __ATOMIC_RELAXED, __HIP_MEMORY_SCOPE_WORKGROUP); sele[lr * 4 + k] = se[k]; sels[lr * 4 + k] = ls; TOKW[m * 4 + k] = wts[k]; } }
                __syncthreads();
                if (tid < 32) lbase[tid] = (int)__hip_atomic_fetch_add(ctl + CW_CNT + l * 32 + tid, (unsigned)lcnt[tid], RLX_AGENT);
                __syncthreads();
                { const int e = sele[tid], sl = lbase[e] + sels[tid]; TOKE[(size_t)r0 * 4 + tid] = e; TOKS[(size_t)r0 * 4 + tid] = sl; LIST[(size_t)e * NTOK + sl] = r0 + (tid >> 2); }
                __syncthreads();
            }
        }
        SEAM(pb + 5);
#if defined(EXP_P1_NOEPI)
        if (IN(pb + 6)) {
            TID_SETUP(); unsigned char* ws = KWS(); bf16* HB = WSP(bf16, WS_HB); bf16* WIN_T = WSP(bf16, WS_WIN_T); bf16* PROJ = WSP(bf16, WS_PROJ);
            pg8::Gemm g{HB, WIN_T + (size_t)l * INP * DM, NTOK, INP, DM}; pg8::StaticOrder S; S.init(NTOK, INP, G, bx);
            pg8::EpiNull EN{PROJ}; pg8::gemm_phase<pg8::EpiNull, pg8::StaticOrder, true, true>(lds + RING_OFF, g, S, EN);
            __syncthreads(); }
#endif
        STAMP(pb + 7);
        if (IN(pb + 7) || IN(pb + 8) || IN(pb + 9)) {
            LAS int* pst = (LAS int*)(lctl + LC_PSTART); LAS int* ecnt = (LAS int*)(lctl + LC_BASE); gu32* ctl = (gu32*)(KWS() + WS_CTL);
            __syncthreads();
            if (threadIdx.x == 0) { int acc = 0; for (int e = 0; e < NE; ++e) { pst[e] = acc; const int c = (int)__hip_atomic_load(ctl + CW_CNT + l * 32 + e, RLX_AGENT); ecnt[e] = c; acc += (c + 255) >> 8; } pst[NE] = acc; }
            __syncthreads();
        }
        if (IN(pb + 7) && PON(8)) {
            TID_SETUP(); unsigned char* ws = KWS(); const float* exp_b_gu = KIN(15); const bf16* HB = WSP(bf16, WS_HB); const int* LIST = WSP(int, WS_XS); const bf16* WGU_T = WSP(bf16, WS_WGU_T); bf16* HID = WSP(bf16, WS_HID);
            const LAS int* pst = (const LAS int*)(lctl + LC_PSTART); LAS int* ul = (LAS int*)(lctl + LC_ULIST);
            const int nM = pst[NE], nN = 8, nwg = nM * nN;
            if (tid < 64) { const long L = (long)tid * G + bx; int v = -1;
                if (L < nwg) { int wgid = (int)L; { const int q = nwg / 8, r = nwg % 8, xcd = wgid % 8, off = wgid / 8; wgid = (xcd < r ? xcd * (q + 1) : r * (q + 1) + (xcd - r) * q) + off; }
                    const int nig = 8 * nN, gid = wgid / nig, fm = gid * 8, gsz = (nM - fm) < 8 ? (nM - fm) : 8; const int pm = fm + ((wgid % nig) % gsz), pn = (wgid % nig) / gsz;
                    int e = 0; for (int k = 1; k < NE; ++k) if (pst[k] <= pm) e = k;
                    v = (pm << 16) | (e * nN + pn); }
                ul[tid] = v; }
            __syncthreads();
            const int nunits = bx < nwg ? (nwg - bx + G - 1) / G : 0;
            LAS unsigned short* rows16 = (LAS unsigned short*)(lctl + LC_ROWS); const LAS int* ecnt = (const LAS int*)(lctl + LC_BASE);
            for (int sl = 0; sl < nunits; ++sl) { const int v = ul[sl]; const int pm = v >> 16, e = (v & 0xffff) >> 3, pl = pm - pst[e];
                if (tid < 256) { const int idx = pl * 256 + tid; rows16[sl * 256 + tid] = (idx < ecnt[e]) ? (unsigned short)LIST[(size_t)e * NTOK + idx] : (unsigned short)0; } }
            __syncthreads();
            pg8::Gemm g{HB, WGU_T + (size_t)l * NE * 2048 * DM, NTOK, NE * 2048, DM}; pg8::ListOrder S{ul, nunits};
            pg8::EpiSwiglu E{HID, exp_b_gu + (size_t)l * NE * 2048};
            pg8::gemm_phase_gather<pg8::EpiSwiglu, pg8::ListOrder, true>(lds + RING_OFF, g, S, E, rows16);
        }
        SEAM(pb + 7);
        if (IN(pb + 8) && PON(9)) {
            TID_SETUP(); unsigned char* ws = KWS(); const float* exp_b_down = KIN(17); const bf16* HID = WSP(bf16, WS_HID); const bf16* WDN_T = WSP(bf16, WS_WDN_T); bf16* YS = WSP(bf16, WS_YS);
            const LAS int* pst = (const LAS int*)(lctl + LC_PSTART); LAS int* ul = (LAS int*)(lctl + LC_ULIST);
            const int nM = pst[NE], nN = 4, nwg = nM * nN;
            __syncthreads();
            if (tid < 64) { const long L = (long)tid * G + bx; int v = -1;
                if (L < nwg) { int wgid = (int)L; { const int q = nwg / 8, r = nwg % 8, xcd = wgid % 8, off = wgid / 8; wgid = (xcd < r ? xcd * (q + 1) : r * (q + 1) + (xcd - r) * q) + off; }
                    const int nig = 8 * nN, gid = wgid / nig, fm = gid * 8, gsz = (nM - fm) < 8 ? (nM - fm) : 8; const int pm = fm + ((wgid % nig) % gsz), pn = (wgid % nig) / gsz;
                    int e = 0; for (int k = 1; k < NE; ++k) if (pst[k] <= pm) e = k;
                    v = (pm << 16) | (e * nN + pn); }
                ul[tid] = v; }
            __syncthreads();
            const int nunits = bx < nwg ? (nwg - bx + G - 1) / G : 0;
            pg8::Gemm g{HID, WDN_T + (size_t)l * NE * DM * DE, MPAD, NE * DM, DE}; pg8::ListOrder S{ul, nunits};
            pg8::EpiDown E{YS, exp_b_down + (size_t)l * NE * DM};
            pg8::gemm_phase<pg8::EpiDown, pg8::ListOrder, true, true>(lds + RING_OFF, g, S, E);
        }
        SEAM(pb + 8);
        if (IN(pb + 9) && PON(10)) {
            TID_SETUP(); unsigned char* ws = KWS(); const float* ln2_g = KIN(18); const float* ln2_b = KIN(19); float* out = KOUT(); bf16* HB = WSP(bf16, WS_HB);
            const bf16* YS = WSP(bf16, WS_YS); const int* TOKE = WSP(int, WS_TOK); const int* TOKS = TOKE + NTOK * 4; const float* TOKW = (const float*)(TOKS + NTOK * 4); const LAS int* pst = (const LAS int*)(lctl + LC_PSTART);
            const bool lastl = (l == NL - 1);
            f32x4 gam[4], bet[4];
#pragma unroll
            for (int j = 0; j < 4; ++j) { gam[j] = *(const f32x4*)(ln2_g + l * DM + RC(lane, j)); bet[j] = *(const f32x4*)(ln2_b + l * DM + RC(lane, j)); }
            int yo[4]; f32x4 wl = {0.f, 0.f, 0.f, 0.f};
            { const int m = gw + (lane & 15) * NGW; const v4u te = *(const v4u*)(TOKE + m * 4), ts = *(const v4u*)(TOKS + m * 4); wl = *(const f32x4*)(TOKW + m * 4);
              yo[0] = pst[te.x] * 256 + (int)ts.x; yo[1] = pst[te.y] * 256 + (int)ts.y; yo[2] = pst[te.z] * 256 + (int)ts.z; yo[3] = pst[te.w] * 256 + (int)ts.w; }
            for (int p2 = 0; p2 < NTOK / (2 * NGW); ++p2) { f32x4 v[2][4]; const bf16* yr[2][4]; float wk[2][4];
#pragma unroll
                for (int q = 0; q < 2; ++q) { const int t = 2 * p2 + q, m = gw + t * NGW;
#pragma unroll
                    for (int k = 0; k < 4; ++k) { yr[q][k] = YS + (size_t)__builtin_amdgcn_readfirstlane(__shfl(yo[k], t)) * DM; wk[q][k] = __shfl(wl[k], t); }
                    row_load_bf16(v[q], HB + (size_t)m * DM, lane);
#pragma unroll
                    for (int j = 0; j < 4; ++j) v[q][j] = v[q][j] * DN_ALPHA; }
#pragma unroll
                for (int q = 0; q < 2; ++q)
#pragma unroll
                    for (int k = 0; k < 4; ++k) { f32x4 y[4]; row_load_bf16(y, yr[q][k], lane); const float w = wk[q][k];
#pragma unroll
                        for (int j = 0; j < 4; ++j) v[q][j] = v[q][j] + y[j] * w; }
#pragma unroll
                for (int q = 0; q < 2; ++q) { const int m = gw + (2 * p2 + q) * NGW; ln_row8(v[q], gam, bet);
                    if (lastl) {
#pragma unroll
                        for (int j = 0; j < 4; ++j) *(f32x4*)(out + (size_t)m * DM + RC(lane, j)) = v[q][j]; }
                    else row_store_bf16(v[q], HB + (size_t)m * DM, lane); } }
        }
        SEAM(pb + 9);
    }
#if PROBE_A >= 0
    { xcd_barrier(bar);
      const unsigned long long* st = (const unsigned long long*)(KWS() + WS_CTL + 65536); unsigned long long T = 0;
      if (PROBE_A & 1) T += st[1] - st[0];
      for (int l = 0; l < NL; ++l) for (int j = 1; j <= 10; ++j) if ((PROBE_A >> j) & 1) T += st[1 + 10 * l + j] - st[10 * l + j];
      if (PROBE_SUB_A >= 0) for (int l = 0; l < NL; ++l) T += st[128 + l * 16 + PROBE_SUB_B] - st[128 + l * 16 + PROBE_SUB_A];
      T *= 4ull; if (T > 5000000ull) T = 5000000ull;
      const unsigned long long t0 = __builtin_amdgcn_s_memrealtime();
      while (__builtin_amdgcn_s_memrealtime() - t0 < T) __builtin_amdgcn_s_sleep(16); }
#endif
#undef IN
#undef SEAM
}

#ifndef MK_PER_PHASE
#define MK_PER_PHASE 0
#endif
extern "C" void kernel_launch(void* const* d_in, const int* in_sizes, int n_in, void* d_out, int out_size, void* d_ws, size_t ws_size, hipStream_t stream) {
    static int grid = 0;
    if (grid == 0) {
        if (n_in != 20 || in_sizes[0] != NTOK * DM || out_size != NTOK * DM || ws_size < WS_END) { fprintf(stderr, "kernel_launch: unexpected shapes (n_in %d, in0 %d, out %d, ws %zu); nothing launched\n", n_in, n_in > 0 ? in_sizes[0] : -1, out_size, ws_size); grid = -1; return; }
        int dev = 0, cus = 0, per_cu = 0;
        if (hipGetDevice(&dev) != hipSuccess || hipDeviceGetAttribute(&cus, hipDeviceAttributeMultiprocessorCount, dev) != hipSuccess) { grid = -1; return; }
        if (hipFuncSetAttribute((const void*)fwd, hipFuncAttributeMaxDynamicSharedMemorySize, LDS_BYTES) != hipSuccess) { fprintf(stderr, "kernel_launch: hipFuncSetAttribute failed\n"); grid = -1; return; }
        if (hipOccupancyMaxActiveBlocksPerMultiprocessor(&per_cu, (const void*)fwd, NWAVES * 64, LDS_BYTES) != hipSuccess || per_cu < 1) fprintf(stderr, "kernel_launch: occupancy query reports %d\n", per_cu);
        (void)hipGetLastError();
        if (cus < 256) { fprintf(stderr, "kernel_launch: built for a 256-CU device (got %d CUs); nothing launched\n", cus); grid = -1; return; }
        grid = 256;
    }
    if (grid < 0) return;
    if (hipMemsetAsync((char*)d_ws + WS_CTL, 0, CTL_ZERO_BYTES, stream) != hipSuccess) return;
    Args a{};
    for (int i = 0; i < 20; ++i) a.in[i] = (const float*)d_in[i];
    a.out = (float*)d_out; a.ws = (unsigned char*)d_ws;
#if MK_PER_PHASE
    for (int p = 0; p < N_PHASES; ++p) { a.ph_lo = p; a.ph_hi = p + 1; hipLaunchKernelGGL(fwd, dim3(grid), dim3(NWAVES * 64), LDS_BYTES, stream, a); }
#else
    a.ph_lo = 0; a.ph_hi = N_PHASES;
    hipLaunchKernelGGL(fwd, dim3(grid), dim3(NWAVES * 64), LDS_BYTES, stream, a);
#endif
    const hipError_t le = hipPeekAtLastError();
    if (le != hipSuccess) fprintf(stderr, "kernel_launch: launch failed: %s\n", hipGetErrorName(le));
}
```

```cpp
#include <hip/hip_runtime.h>
#include <hip/hip_bf16.h>
#include <cstdio>
#include <cstdint>
#include <cmath>
namespace pg8 {
#define PG8_LAS __attribute__((address_space(3)))
typedef unsigned short bf16_t;
typedef short bf16x8 __attribute__((ext_vector_type(8)));
typedef float f32x4 __attribute__((ext_vector_type(4)));
typedef unsigned u32x4 __attribute__((ext_vector_type(4)));
constexpr int BM = 256, BK = 64, HALF = 128, HTB = HALF * BK * 2  , STAGE_BYTES = 8 * HTB, NXCD = 8, WGM = 8;

__host__ __device__ __forceinline__ int lds_byte(int r, int c) { const int st = (r >> 4) * 2 + (c >> 5), rr = r & 15, cc = c & 31, ob = rr * 64 + cc * 2; return st * 1024 + (ob ^ (((ob >> 9) & 1) << 5)); }
__host__ __device__ __forceinline__ void stage_rc(int b, int& R, int& C) { const int st = b / 1024, sb = b % 1024, swz = sb ^ (((sb >> 9) & 1) << 5); R = (st >> 1) * 16 + swz / 64; C = (st & 1) * 32 + (swz % 64) / 2; }
__host__ __device__ __forceinline__ int perm32(int rho) { const int n = rho >> 4, i = rho & 15; return 8 * (i >> 2) + 4 * n + (i & 3); }

struct Unit { int pm, pn; };
struct Gemm { const bf16_t* A; const bf16_t* Bt; int M, N, K; };

struct StaticOrder {
    int nM, nN, nwg, G, c;
    __host__ __device__ void init(int M, int N, int G_, int c_) { nM = M / BM; nN = N / BM; nwg = nM * nN; G = G_; c = c_; }
    __host__ __device__ bool next(int i, Unit& u) const {
        const long L = (long)i * G + c; if (L >= nwg) return false;
        int wgid = (int)L; { const int q = nwg / NXCD, r = nwg % NXCD, xcd = wgid % NXCD, off = wgid / NXCD; wgid = (xcd < r ? xcd * (q + 1) : r * (q + 1) + (xcd - r) * q) + off; }
        const int nig = WGM * nN, gid = wgid / nig, fm = gid * WGM, gsz = (nM - fm) < WGM ? (nM - fm) : WGM;
        u.pm = fm + ((wgid % nig) % gsz); u.pn = (wgid % nig) / gsz; return true;
    }
    __device__ __forceinline__ void a_ready(const Unit&) const {}
    __device__ __forceinline__ void done(const Unit&) const {}
};

__device__ __forceinline__ unsigned cvt_pk_bf16(float lo, float hi) { unsigned r; asm volatile("v_cvt_pk_bf16_f32 %0, %1, %2" : "=v"(r) : "v"(lo), "v"(hi)); return r; }
typedef float f32x2 __attribute__((ext_vector_type(2)));
__device__ __forceinline__ u32x4 pack8(const f32x4 v0, const f32x4 v1) { u32x4 w; w.x = cvt_pk_bf16(v0[0], v0[1]); w.y = cvt_pk_bf16(v0[2], v0[3]); w.z = cvt_pk_bf16(v1[0], v1[1]); w.w = cvt_pk_bf16(v1[2], v1[3]); return w; }

struct EpiPlainBf16 {
    static constexpr bool PERM = true, AFTER_DRAIN = false;
    bf16_t* O; int ldc;
    __device__ __forceinline__ void operator()(const f32x4 (&acc)[2][2][4][2], const Unit& u, int wr, int wc, int fr, int fq) const {
        const int row0 = u.pm * BM + wr * 64 + fr, col0 = u.pn * BM + wc * 32 + 8 * fq;
#pragma unroll
        for (int ai = 0; ai < 2; ++ai)
#pragma unroll
            for (int m = 0; m < 4; ++m) { bf16_t* rowp = O + (size_t)(row0 + ai * HALF + m * 16) * ldc + col0;
#pragma unroll
                for (int bj = 0; bj < 2; ++bj) *(u32x4*)(rowp + bj * HALF) = pack8(acc[ai][bj][m][0], acc[ai][bj][m][1]); }
    }
};
struct EpiFnet {
    static constexpr bool PERM = true, AFTER_DRAIN = false;
    bf16_t* MIX;
    __device__ __forceinline__ void operator()(const f32x4 (&acc)[2][2][4][2], const Unit& u, int wr, int wc, int fr, int fq) const {
        const int row0 = u.pn * 4096 + u.pm * BM + wr * 64 + fr, col0 = 768 + wc * 32 + 8 * fq;
#pragma unroll
        for (int ai = 0; ai < 2; ++ai)
#pragma unroll
            for (int m = 0; m < 4; ++m) { bf16_t* rowp = MIX + (size_t)(row0 + ai * HALF + m * 16) * 1024 + col0;
#pragma unroll
                for (int bj = 0; bj < 2; ++bj) *(u32x4*)(rowp + bj * HALF) = pack8(acc[ai][bj][m][0], acc[ai][bj][m][1]); }
    }
};
struct EpiResF32 {
    static constexpr bool PERM = false, AFTER_DRAIN = false;
    const float* base; float* out; int ldc; float alpha;
    __device__ __forceinline__ void operator()(const f32x4 (&acc)[2][2][4][2], const Unit& u, int wr, int wc, int fr, int fq) const {
        const int row0 = u.pm * BM + wr * 64 + fr, col0 = u.pn * BM + wc * 32 + 4 * fq;
#pragma unroll
        for (int ai = 0; ai < 2; ++ai)
#pragma unroll
            for (int m = 0; m < 4; ++m) { const size_t off = (size_t)(row0 + ai * HALF + m * 16) * ldc + col0;
#pragma unroll
                for (int bj = 0; bj < 2; ++bj)
#pragma unroll
                    for (int n = 0; n < 2; ++n) { const f32x4 b = *(const f32x4*)(base + off + bj * HALF + n * 16); *(f32x4*)(out + off + bj * HALF + n * 16) = b * alpha + acc[ai][bj][m][n]; } }
    }
};
struct EpiResBf16 {
    static constexpr bool PERM = true, AFTER_DRAIN = false;
    const bf16_t* base; bf16_t* out; int ldc; float alpha;
    __device__ __forceinline__ void operator()(const f32x4 (&acc)[2][2][4][2], const Unit& u, int wr, int wc, int fr, int fq) const {
        const int row0 = u.pm * BM + wr * 64 + fr, col0 = u.pn * BM + wc * 32 + 8 * fq;
#pragma unroll
        for (int ai = 0; ai < 2; ++ai)
#pragma unroll
            for (int m = 0; m < 4; ++m) { const size_t off = (size_t)(row0 + ai * HALF + m * 16) * ldc + col0;
#pragma unroll
                for (int bj = 0; bj < 2; ++bj) { const u32x4 b = *(const u32x4*)(base + off + bj * HALF);
                    const f32x4 b0 = {__uint_as_float(b.x << 16), __uint_as_float(b.x & 0xffff0000u), __uint_as_float(b.y << 16), __uint_as_float(b.y & 0xffff0000u)};
                    const f32x4 b1 = {__uint_as_float(b.z << 16), __uint_as_float(b.z & 0xffff0000u), __uint_as_float(b.w << 16), __uint_as_float(b.w & 0xffff0000u)};
                    *(u32x4*)(out + off + bj * HALF) = pack8(b0 * alpha + acc[ai][bj][m][0], b1 * alpha + acc[ai][bj][m][1]); } }
    }
};
__device__ __forceinline__ f32x4 swiglu4(f32x4 g, f32x4 u) {
    typedef float f32x2_ __attribute__((ext_vector_type(2)));
    f32x4 h;
#pragma unroll
    for (int p = 0; p < 2; ++p) { f32x2_ gg = {fminf(g[2 * p], 7.0f), fminf(g[2 * p + 1], 7.0f)}; f32x2_ uu = {__builtin_amdgcn_fmed3f(u[2 * p], -7.0f, 7.0f), __builtin_amdgcn_fmed3f(u[2 * p + 1], -7.0f, 7.0f)};
        const f32x2_ t = gg * (-1.702f * 1.4426950408889634f); f32x2_ e = {__builtin_amdgcn_exp2f(t.x), __builtin_amdgcn_exp2f(t.y)}; e = e + 1.0f;
        const f32x2_ r = {__builtin_amdgcn_rcpf(e.x), __builtin_amdgcn_rcpf(e.y)}; const f32x2_ w = (uu * gg + gg) * r; h[2 * p] = w.x; h[2 * p + 1] = w.y; }
    return h;
}
__device__ __forceinline__ float swiglu1(float g, float u) { g = fminf(g, 7.0f); u = fminf(fmaxf(u, -7.0f), 7.0f); return (u + 1.0f) * g * __builtin_amdgcn_rcpf(1.0f + __expf(-1.702f * g)); }
struct EpiSwiglu {
    static constexpr bool PERM = true, AFTER_DRAIN = false;
    bf16_t* HID; const float* bgu;
    __device__ __forceinline__ void operator()(const f32x4 (&acc)[2][2][4][2], const Unit& u, int wr, int wc, int fr, int fq) const {
        const int e = u.pn >> 3, pnl = u.pn & 7; const int row0 = u.pm * BM + wr * 64 + fr, jj0 = pnl * 128 + wc * 32 + 8 * fq;
        const float* bg = bgu + (size_t)e * 2048 + jj0;
        const f32x4 bg0 = *(const f32x4*)bg, bg1 = *(const f32x4*)(bg + 4), bu0 = *(const f32x4*)(bg + 1024), bu1 = *(const f32x4*)(bg + 1028);
#pragma unroll
        for (int ai = 0; ai < 2; ++ai)
#pragma unroll
            for (int m = 0; m < 4; ++m) { bf16_t* rowp = HID + (size_t)(row0 + ai * HALF + m * 16) * 1024 + jj0;
                const f32x4 g0 = acc[ai][0][m][0] + bg0, g1 = acc[ai][0][m][1] + bg1, u0 = acc[ai][1][m][0] + bu0, u1 = acc[ai][1][m][1] + bu1;
                f32x4 h0, h1;
#pragma unroll
                for (int i = 0; i < 4; ++i) { h0[i] = swiglu1(g0[i], u0[i]); h1[i] = swiglu1(g1[i], u1[i]); }
                *(u32x4*)rowp = pack8(h0, h1); }
    }
};
struct EpiDown {
    static constexpr bool PERM = true, AFTER_DRAIN = false;
    bf16_t* Y; const float* bd;
    __device__ __forceinline__ void operator()(const f32x4 (&acc)[2][2][4][2], const Unit& u, int wr, int wc, int fr, int fq) const {
        const int e = u.pn >> 2, pnl = u.pn & 3; const int row0 = u.pm * BM + wr * 64 + fr, col0 = pnl * BM + wc * 32 + 8 * fq;
        const float* bp = bd + (size_t)e * 1024 + col0;
        f32x4 bv[2][2];
#pragma unroll
        for (int bj = 0; bj < 2; ++bj)
#pragma unroll
            for (int n = 0; n < 2; ++n) bv[bj][n] = *(const f32x4*)(bp + bj * HALF + 4 * n);
#pragma unroll
        for (int ai = 0; ai < 2; ++ai)
#pragma unroll
            for (int m = 0; m < 4; ++m) { bf16_t* rowp = Y + (size_t)(row0 + ai * HALF + m * 16) * 1024 + col0;
#pragma unroll
                for (int bj = 0; bj < 2; ++bj) *(u32x4*)(rowp + bj * HALF) = pack8(acc[ai][bj][m][0] + bv[bj][0], acc[ai][bj][m][1] + bv[bj][1]); }
    }
};
struct EpiNull {
    static constexpr bool PERM = true, AFTER_DRAIN = false;
    bf16_t* O;
    __device__ __forceinline__ void operator()(const f32x4 (&acc)[2][2][4][2], const Unit& u, int wr, int wc, int fr, int fq) const {
#pragma unroll
        for (int ai = 0; ai < 2; ++ai)
#pragma unroll
            for (int bj = 0; bj < 2; ++bj)
#pragma unroll
                for (int m = 0; m < 4; ++m)
#pragma unroll
                    for (int n = 0; n < 2; ++n) asm volatile("" :: "v"(acc[ai][bj][m][n]));
    }
};
__device__ __forceinline__ unsigned pk4_fp8e(float a, float b, float c, float d) { int w = 0; w = __builtin_amdgcn_cvt_pk_fp8_f32(a, b, w, false); w = __builtin_amdgcn_cvt_pk_fp8_f32(c, d, w, true); return (unsigned)w; }
struct EpiPlain8 {
    static constexpr bool PERM = true, AFTER_DRAIN = false, HAS_BIAS = false;
    bf16_t* O; int ldc;
    __device__ __forceinline__ void operator()(const f32x4 (&acc)[2][2][4][2], const Unit& u, int wr, int wc, int fr, int fq, int) const {
        const int row0 = u.pm * BM + wr * 64 + fr, col0 = u.pn * BM + wc * 32 + 8 * fq;
#pragma unroll
        for (int ai = 0; ai < 2; ++ai)
#pragma unroll
            for (int m = 0; m < 4; ++m) { bf16_t* rowp = O + (size_t)(row0 + ai * HALF + m * 16) * ldc + col0;
#pragma unroll
                for (int bj = 0; bj < 2; ++bj) *(u32x4*)(rowp + bj * HALF) = pack8(acc[ai][bj][m][0], acc[ai][bj][m][1]); }
    }
};
struct EpiSwiglu8 {
    static constexpr bool PERM = true, AFTER_DRAIN = false, HAS_BIAS = true;
    unsigned char* HID; const float* bgu; PG8_LAS float* bl;
    __device__ __forceinline__ const float* bias_src(const Unit& u, int lane) const { const int e = u.pn >> 3, pnl = u.pn & 7; return bgu + (size_t)e * 2048 + pnl * 128 + (lane >> 5) * 1024 + (lane & 31) * 4; }
    __device__ __forceinline__ void operator()(const f32x4 (&acc)[2][2][4][2], const Unit& u, int wr, int wc, int fr, int fq, int slot) const {
        const int pnl = u.pn & 7; const int row0 = u.pm * BM + wr * 64 + fr, jj0 = pnl * 128 + wc * 32 + 8 * fq;
        const PG8_LAS float* bg = bl + slot * 256 + wc * 32 + 8 * fq;
        const f32x4 bg0 = *(const PG8_LAS f32x4*)bg, bg1 = *(const PG8_LAS f32x4*)(bg + 4), bu0 = *(const PG8_LAS f32x4*)(bg + 128), bu1 = *(const PG8_LAS f32x4*)(bg + 132);
#pragma unroll
        for (int ai = 0; ai < 2; ++ai)
#pragma unroll
            for (int m = 0; m < 4; ++m) { unsigned char* rowp = HID + (size_t)(row0 + ai * HALF + m * 16) * 1024 + jj0;
                const f32x4 g0 = acc[ai][0][m][0] + bg0, g1 = acc[ai][0][m][1] + bg1, u0 = acc[ai][1][m][0] + bu0, u1 = acc[ai][1][m][1] + bu1;
                const f32x4 h0 = swiglu4(g0, u0), h1 = swiglu4(g1, u1);
                *(unsigned long long*)rowp = (unsigned long long)pk4_fp8e(h0[0], h0[1], h0[2], h0[3]) | ((unsigned long long)pk4_fp8e(h1[0], h1[1], h1[2], h1[3]) << 32); }
    }
};
struct EpiDown8 {
    static constexpr bool PERM = true, AFTER_DRAIN = false, HAS_BIAS = true;
    unsigned char* Y; const float* bd; PG8_LAS float* bl;
    __device__ __forceinline__ const float* bias_src(const Unit& u, int lane) const { const int e = u.pn >> 2, pnl = u.pn & 3; return bd + (size_t)e * 1024 + pnl * BM + lane * 4; }
    __device__ __forceinline__ void operator()(const f32x4 (&acc)[2][2][4][2], const Unit& u, int wr, int wc, int fr, int fq, int slot) const {
        const int pnl = u.pn & 3; const int row0 = u.pm * BM + wr * 64 + fr, col0 = pnl * BM + wc * 32 + 8 * fq;
        const PG8_LAS float* bp = bl + slot * 256 + wc * 32 + 8 * fq;
        f32x4 bv[2][2];
#pragma unroll
        for (int bj = 0; bj < 2; ++bj)
#pragma unroll
            for (int n = 0; n < 2; ++n) bv[bj][n] = *(const PG8_LAS f32x4*)(bp + bj * HALF + 4 * n);
#pragma unroll
        for (int ai = 0; ai < 2; ++ai)
#pragma unroll
            for (int m = 0; m < 4; ++m) { unsigned char* rowp = Y + (size_t)(row0 + ai * HALF + m * 16) * 1024 + col0;
#pragma unroll
                for (int bj = 0; bj < 2; ++bj) { const f32x4 y0 = acc[ai][bj][m][0] + bv[bj][0], y1 = acc[ai][bj][m][1] + bv[bj][1];
                    *(unsigned long long*)(rowp + bj * HALF) = (unsigned long long)pk4_fp8e(y0[0], y0[1], y0[2], y0[3]) | ((unsigned long long)pk4_fp8e(y1[0], y1[1], y1[2], y1[3]) << 32); } }
    }
};
struct ListOrder {
    const PG8_LAS int* list; int n;
    __device__ __forceinline__ bool next(int i, Unit& u) const { if (i >= n) return false; const int v = __builtin_amdgcn_readfirstlane(list[i]); u.pm = v >> 16; u.pn = v & 0xffff; return true; }
    __device__ __forceinline__ void a_ready(const Unit&) const {}
    __device__ __forceinline__ void done(const Unit&) const {}
};
template <class Epi, class Sched, bool ALIGN_EPI = false, bool SP2 = false>
__device__ __forceinline__ void gemm_phase(PG8_LAS unsigned char* lds, const Gemm g, const Sched& S, const Epi& E) {
    int tid_ = threadIdx.x; asm volatile("" : "+v"(tid_));
    const int tid = tid_, wid = __builtin_amdgcn_readfirstlane(tid >> 6), lane = tid & 63, wr = wid >> 2, wc = wid & 3, fr = lane & 15, fq = lane >> 4;
    const int K = g.K, nt = K / BK;
    unsigned voffA[2], voffB[2];
#pragma unroll
    for (int i = 0; i < 2; ++i) { int R, C; stage_rc(tid * 16 + i * 8192, R, C); const int Rb = Epi::PERM ? ((R & ~31) + perm32(R & 31)) : R;
        voffA[i] = (unsigned)(R * K + C) * 2u; voffB[i] = (unsigned)(Rb * K + C) * 2u; }
    const size_t kstep = (size_t)(BK * 2);
    const size_t hstep = (size_t)HALF * K * 2;
    const size_t tstep = 2 * hstep;
    const unsigned ldsw = (unsigned)wid * 1024u;
    const int aoff = lds_byte(wr * 64 + fr, fq * 8), boff = lds_byte(wc * 32 + fr, fq * 8);
#define PG8_SA(b, h) (((b) * 2 + (h)) * HTB)
#define PG8_SB(b, h) ((4 + (b) * 2 + (h)) * HTB)
#define PG8_STAGE(bufoff, gbase, voff) do { _Pragma("unroll") for (int _i = 0; _i < 2; ++_i) \
        __builtin_amdgcn_global_load_lds((const unsigned*)((const char*)(gbase) + (voff)[_i]), (PG8_LAS unsigned*)(lds + (bufoff) + ldsw + _i * 8192), 16, 0, 0); } while (0)
#define PG8_LDA(dst, b, h) do { _Pragma("unroll") for (int m = 0; m < 4; ++m) _Pragma("unroll") for (int k = 0; k < 2; ++k) dst[m][k] = *(const PG8_LAS bf16x8*)(lds + PG8_SA(b, h) + aoff + m * 2048 + k * 1024); } while (0)
#define PG8_LDB(dst, b, h) do { _Pragma("unroll") for (int n = 0; n < 2; ++n) _Pragma("unroll") for (int k = 0; k < 2; ++k) dst[n][k] = *(const PG8_LAS bf16x8*)(lds + PG8_SB(b, h) + boff + n * 2048 + k * 1024); } while (0)
#define PG8_MMA(ai, bj, At, Bt) do { __builtin_amdgcn_s_setprio(1); _Pragma("unroll") for (int m = 0; m < 4; ++m) _Pragma("unroll") for (int n = 0; n < 2; ++n) _Pragma("unroll") for (int k = 0; k < 2; ++k) \
        acc[ai][bj][m][n] = __builtin_amdgcn_mfma_f32_16x16x32_bf16(Bt[n][k], At[m][k], acc[ai][bj][m][n], 0, 0, 0); __builtin_amdgcn_s_setprio(0); } while (0)
#define PG8_WAIT_V(n) asm volatile("s_waitcnt vmcnt(" #n ")" ::: "memory")
#define PG8_WAIT_L(n) asm volatile("s_waitcnt lgkmcnt(" #n ")" ::: "memory")
#define PG8_BAR __builtin_amdgcn_s_barrier()
#define PG8_SCHED __builtin_amdgcn_sched_barrier(0)
    Unit cur, nxt; int ui = 0;
    if (!S.next(0, cur)) return;
    f32x4 acc[2][2][4][2];
#pragma unroll
    for (int a = 0; a < 2; ++a)
#pragma unroll
        for (int b = 0; b < 2; ++b)
#pragma unroll
            for (int m = 0; m < 4; ++m)
#pragma unroll
                for (int n = 0; n < 2; ++n) acc[a][b][m][n] = (f32x4){0.f, 0.f, 0.f, 0.f};
    bf16x8 At[4][2], B0[2][2], B1[2][2];
    const char* cA = (const char*)g.A + (size_t)cur.pm * tstep; const char* cB = (const char*)g.Bt + (size_t)cur.pn * tstep;
    S.a_ready(cur);
    if constexpr (SP2) {
        PG8_STAGE(PG8_SB(0, 0), cB, voffB); PG8_STAGE(PG8_SB(0, 1), cB + hstep, voffB); PG8_STAGE(PG8_SA(0, 0), cA, voffA); PG8_STAGE(PG8_SA(0, 1), cA + hstep, voffA);
        if (wr == 1) PG8_BAR;
        PG8_WAIT_V(2); PG8_BAR;
        PG8_STAGE(PG8_SB(1, 0), cB + kstep, voffB); PG8_STAGE(PG8_SA(1, 0), cA + kstep, voffA); PG8_STAGE(PG8_SB(1, 1), cB + hstep + kstep, voffB);
        PG8_WAIT_V(6); PG8_BAR;
    } else {
        PG8_STAGE(PG8_SB(0, 0), cB, voffB); PG8_STAGE(PG8_SA(0, 0), cA, voffA); PG8_STAGE(PG8_SB(0, 1), cB + hstep, voffB); PG8_STAGE(PG8_SA(0, 1), cA + hstep, voffA);
        if (wr == 1) PG8_BAR;
        PG8_WAIT_V(4); PG8_BAR;
        PG8_STAGE(PG8_SB(1, 0), cB + kstep, voffB); PG8_STAGE(PG8_SA(1, 0), cA + kstep, voffA); PG8_STAGE(PG8_SB(1, 1), cB + hstep + kstep, voffB);
        PG8_WAIT_V(6); PG8_BAR;
    }
    for (;;) {
        const bool has_next = S.next(ui + 1, nxt);
        const char* nA = has_next ? (const char*)g.A + (size_t)nxt.pm * tstep : cA; const char* nB = has_next ? (const char*)g.Bt + (size_t)nxt.pn * tstep : cB;
        for (int t = 0; t < nt; t += 2) {
            const bool last = (t == nt - 2);
            const char* a1 = cA + (size_t)(t + 1) * kstep;
            const char* a2 = last ? nA : cA + (size_t)(t + 2) * kstep; const char* b2 = last ? nB : cB + (size_t)(t + 2) * kstep;
            const char* a3 = a2 + kstep; const char* b3 = b2 + kstep;
            if (last && has_next) S.a_ready(nxt);
            if constexpr (SP2) {
            PG8_LDB(B0, 0, 0); PG8_LDB(B1, 0, 1); PG8_SCHED; PG8_LDA(At, 0, 0); PG8_STAGE(PG8_SA(1, 1), a1 + hstep, voffA);
            PG8_WAIT_V(8); PG8_WAIT_L(0); PG8_BAR; PG8_MMA(0, 0, At, B0); PG8_MMA(0, 1, At, B1); PG8_BAR; PG8_SCHED;
            PG8_LDA(At, 0, 1); PG8_STAGE(PG8_SB(0, 0), b2, voffB); PG8_STAGE(PG8_SB(0, 1), b2 + hstep, voffB); PG8_STAGE(PG8_SA(0, 0), a2, voffA);
            PG8_WAIT_V(8); PG8_WAIT_L(0); PG8_BAR; PG8_MMA(1, 0, At, B0); PG8_MMA(1, 1, At, B1); PG8_BAR; PG8_SCHED;
            PG8_LDB(B0, 1, 0); PG8_LDB(B1, 1, 1); PG8_SCHED; PG8_LDA(At, 1, 0); PG8_STAGE(PG8_SA(0, 1), a2 + hstep, voffA);
            PG8_WAIT_V(8); PG8_WAIT_L(0); PG8_BAR; PG8_MMA(0, 0, At, B0); PG8_MMA(0, 1, At, B1); PG8_BAR; PG8_SCHED;
            PG8_LDA(At, 1, 1); PG8_STAGE(PG8_SB(1, 0), b3, voffB); PG8_STAGE(PG8_SB(1, 1), b3 + hstep, voffB); PG8_STAGE(PG8_SA(1, 0), a3, voffA);
            PG8_WAIT_V(8); PG8_WAIT_L(0); PG8_BAR; PG8_MMA(1, 0, At, B0); PG8_MMA(1, 1, At, B1); PG8_BAR; PG8_SCHED;
            } else {
            PG8_LDB(B0, 0, 0); PG8_SCHED; PG8_LDA(At, 0, 0); PG8_STAGE(PG8_SA(1, 1), a1 + hstep, voffA);
            PG8_WAIT_L(8); PG8_BAR; PG8_WAIT_L(0); PG8_MMA(0, 0, At, B0); PG8_BAR; PG8_SCHED;
            PG8_LDB(B1, 0, 1); PG8_STAGE(PG8_SB(0, 0), b2, voffB);
            PG8_BAR; PG8_WAIT_L(0); PG8_MMA(0, 1, At, B1); PG8_BAR;
            PG8_LDA(At, 0, 1); PG8_STAGE(PG8_SA(0, 0), a2, voffA);
            PG8_BAR; PG8_WAIT_L(0); PG8_MMA(1, 0, At, B0); PG8_BAR; PG8_SCHED;
            PG8_STAGE(PG8_SB(0, 1), b2 + hstep, voffB);
            PG8_WAIT_V(6); PG8_BAR; PG8_MMA(1, 1, At, B1); PG8_BAR;
            PG8_LDB(B0, 1, 0); PG8_SCHED; PG8_LDA(At, 1, 0); PG8_STAGE(PG8_SA(0, 1), a2 + hstep, voffA);
            PG8_WAIT_L(8); PG8_BAR; PG8_WAIT_L(0); PG8_MMA(0, 0, At, B0); PG8_BAR; PG8_SCHED;
            PG8_LDB(B1, 1, 1); PG8_STAGE(PG8_SB(1, 0), b3, voffB);
            PG8_BAR; PG8_WAIT_L(0); PG8_MMA(0, 1, At, B1); PG8_BAR;
            PG8_LDA(At, 1, 1); PG8_STAGE(PG8_SA(1, 0), a3, voffA);
            PG8_BAR; PG8_WAIT_L(0); PG8_MMA(1, 0, At, B0); PG8_BAR; PG8_SCHED;
            PG8_STAGE(PG8_SB(1, 1), b3 + hstep, voffB);
            PG8_WAIT_V(6); PG8_BAR; PG8_MMA(1, 1, At, B1); PG8_BAR;
            }
        }
        if constexpr (ALIGN_EPI) { if (wr == 0) PG8_BAR; }
        if constexpr (!Epi::AFTER_DRAIN) { E(acc, cur, wr, wc, fr, fq); S.done(cur); }
        if (!has_next) break;
#pragma unroll
        for (int a = 0; a < 2; ++a)
#pragma unroll
            for (int b = 0; b < 2; ++b)
#pragma unroll
                for (int m = 0; m < 4; ++m)
#pragma unroll
                    for (int n = 0; n < 2; ++n) acc[a][b][m][n] = (f32x4){0.f, 0.f, 0.f, 0.f};
        cur = nxt; cA = nA; cB = nB; ++ui;
        if constexpr (ALIGN_EPI) { if (wr == 1) PG8_BAR; }
    }
    PG8_WAIT_V(0);
    if constexpr (!ALIGN_EPI) { if (wr == 0) PG8_BAR; }
    PG8_BAR;
    if constexpr (Epi::AFTER_DRAIN) { E.fused(acc, cur, wr, wc, fr, fq, lds, wid, lane); S.done(cur); }
#undef PG8_SA
#undef PG8_SB
#undef PG8_STAGE
#undef PG8_LDA
#undef PG8_LDB
#undef PG8_MMA
#undef PG8_WAIT_V
#undef PG8_WAIT_L
#undef PG8_BAR
#undef PG8_SCHED
}
}
namespace pg8 {
template <class Epi, class Sched, bool ALIGN_EPI>
__device__ __forceinline__ void gemm_phase_gather(PG8_LAS unsigned char* lds, const Gemm g, const Sched& S, const Epi& E, const PG8_LAS unsigned short* rows16) {
    int tid_ = threadIdx.x; asm volatile("" : "+v"(tid_));
    const int tid = tid_, wid = __builtin_amdgcn_readfirstlane(tid >> 6), lane = tid & 63, wr = wid >> 2, wc = wid & 3, fr = lane & 15, fq = lane >> 4;
    const int K = g.K, nt = K / BK;
    unsigned voffB[2]; int RA[2]; unsigned CA2[2];
#pragma unroll
    for (int i = 0; i < 2; ++i) { int R, C; stage_rc(tid * 16 + i * 8192, R, C); const int Rb = Epi::PERM ? ((R & ~31) + perm32(R & 31)) : R;
        RA[i] = R; CA2[i] = (unsigned)C * 2u; voffB[i] = (unsigned)(Rb * K + C) * 2u; }
    const size_t kstep = (size_t)(BK * 2);
    const size_t hstep = (size_t)HALF * K * 2;
    const size_t tstep = 2 * hstep;
    const unsigned ldsw = (unsigned)wid * 1024u;
    const unsigned rowb = (unsigned)K * 2u;
    const int aoff = lds_byte(wr * 64 + fr, fq * 8), boff = lds_byte(wc * 32 + fr, fq * 8);
#define PG8_SA(b, h) (((b) * 2 + (h)) * HTB)
#define PG8_SB(b, h) ((4 + (b) * 2 + (h)) * HTB)
#define PG8_STAGE(bufoff, gbase, voff) do { _Pragma("unroll") for (int _i = 0; _i < 2; ++_i) \
        __builtin_amdgcn_global_load_lds((const unsigned*)((const char*)(gbase) + (voff)[_i]), (PG8_LAS unsigned*)(lds + (bufoff) + ldsw + _i * 8192), 16, 0, 0); } while (0)
#define PG8_LDA(dst, b, h) do { _Pragma("unroll") for (int m = 0; m < 4; ++m) _Pragma("unroll") for (int k = 0; k < 2; ++k) dst[m][k] = *(const PG8_LAS bf16x8*)(lds + PG8_SA(b, h) + aoff + m * 2048 + k * 1024); } while (0)
#define PG8_LDB(dst, b, h) do { _Pragma("unroll") for (int n = 0; n < 2; ++n) _Pragma("unroll") for (int k = 0; k < 2; ++k) dst[n][k] = *(const PG8_LAS bf16x8*)(lds + PG8_SB(b, h) + boff + n * 2048 + k * 1024); } while (0)
#define PG8_MMA(ai, bj, At, Bt) do { __builtin_amdgcn_s_setprio(1); _Pragma("unroll") for (int m = 0; m < 4; ++m) _Pragma("unroll") for (int n = 0; n < 2; ++n) _Pragma("unroll") for (int k = 0; k < 2; ++k) \
        acc[ai][bj][m][n] = __builtin_amdgcn_mfma_f32_16x16x32_bf16(Bt[n][k], At[m][k], acc[ai][bj][m][n], 0, 0, 0); __builtin_amdgcn_s_setprio(0); } while (0)
#define PG8_WAIT_V(n) asm volatile("s_waitcnt vmcnt(" #n ")" ::: "memory")
#define PG8_WAIT_L(n) asm volatile("s_waitcnt lgkmcnt(" #n ")" ::: "memory")
#define PG8_BAR __builtin_amdgcn_s_barrier()
#define PG8_SCHED __builtin_amdgcn_sched_barrier(0)
#define PG8_GOFF(dst, U) do { _Pragma("unroll") for (int h_ = 0; h_ < 2; ++h_) _Pragma("unroll") for (int i_ = 0; i_ < 2; ++i_) dst[h_][i_] = (unsigned)rows16[(U) * 256 + h_ * HALF + RA[i_]] * rowb + CA2[i_]; } while (0)
    Unit cur, nxt; int ui = 0;
    if (!S.next(0, cur)) return;
    f32x4 acc[2][2][4][2];
#pragma unroll
    for (int a = 0; a < 2; ++a)
#pragma unroll
        for (int b = 0; b < 2; ++b)
#pragma unroll
            for (int m = 0; m < 4; ++m)
#pragma unroll
                for (int n = 0; n < 2; ++n) acc[a][b][m][n] = (f32x4){0.f, 0.f, 0.f, 0.f};
    bf16x8 At[4][2], B0[2][2], B1[2][2];
    const char* const Ab = (const char*)g.A;
    const char* cB = (const char*)g.Bt + (size_t)cur.pn * tstep;
    unsigned gc[2][2], gn[2][2];
    PG8_GOFF(gc, 0);
    S.a_ready(cur);
    PG8_STAGE(PG8_SB(0, 0), cB, voffB); PG8_STAGE(PG8_SB(0, 1), cB + hstep, voffB); PG8_STAGE(PG8_SA(0, 0), Ab, gc[0]); PG8_STAGE(PG8_SA(0, 1), Ab, gc[1]);
    if (wr == 1) PG8_BAR;
    PG8_WAIT_V(2); PG8_BAR;
    PG8_STAGE(PG8_SB(1, 0), cB + kstep, voffB); PG8_STAGE(PG8_SA(1, 0), Ab + kstep, gc[0]); PG8_STAGE(PG8_SB(1, 1), cB + hstep + kstep, voffB);
    PG8_WAIT_V(6); PG8_BAR;
    for (;;) {
        const bool has_next = S.next(ui + 1, nxt);
        const char* nB = has_next ? (const char*)g.Bt + (size_t)nxt.pn * tstep : cB;
        if (has_next) { PG8_GOFF(gn, ui + 1); } else {
#pragma unroll
            for (int h_ = 0; h_ < 2; ++h_)
#pragma unroll
                for (int i_ = 0; i_ < 2; ++i_) gn[h_][i_] = gc[h_][i_]; }
        for (int t = 0; t < nt; t += 2) {
            const bool last = (t == nt - 2);
            const char* a1 = Ab + (size_t)(t + 1) * kstep;
            const char* a2 = last ? Ab : Ab + (size_t)(t + 2) * kstep; const char* b2 = last ? nB : cB + (size_t)(t + 2) * kstep;
            const char* a3 = a2 + kstep; const char* b3 = b2 + kstep;
            unsigned g2[2][2];
#pragma unroll
            for (int h_ = 0; h_ < 2; ++h_)
#pragma unroll
                for (int i_ = 0; i_ < 2; ++i_) g2[h_][i_] = last ? gn[h_][i_] : gc[h_][i_];
            if (last && has_next) S.a_ready(nxt);
            PG8_LDB(B0, 0, 0); PG8_LDB(B1, 0, 1); PG8_SCHED; PG8_LDA(At, 0, 0); PG8_STAGE(PG8_SA(1, 1), a1, gc[1]);
            PG8_WAIT_V(8); PG8_WAIT_L(0); PG8_BAR; PG8_MMA(0, 0, At, B0); PG8_MMA(0, 1, At, B1); PG8_BAR; PG8_SCHED;
            PG8_LDA(At, 0, 1); PG8_STAGE(PG8_SB(0, 0), b2, voffB); PG8_STAGE(PG8_SB(0, 1), b2 + hstep, voffB); PG8_STAGE(PG8_SA(0, 0), a2, g2[0]);
            PG8_WAIT_V(8); PG8_WAIT_L(0); PG8_BAR; PG8_MMA(1, 0, At, B0); PG8_MMA(1, 1, At, B1); PG8_BAR; PG8_SCHED;
            PG8_LDB(B0, 1, 0); PG8_LDB(B1, 1, 1); PG8_SCHED; PG8_LDA(At, 1, 0); PG8_STAGE(PG8_SA(0, 1), a2, g2[1]);
            PG8_WAIT_V(8); PG8_WAIT_L(0); PG8_BAR; PG8_MMA(0, 0, At, B0); PG8_MMA(0, 1, At, B1); PG8_BAR; PG8_SCHED;
            PG8_LDA(At, 1, 1); PG8_STAGE(PG8_SB(1, 0), b3, voffB); PG8_STAGE(PG8_SB(1, 1), b3 + hstep, voffB); PG8_STAGE(PG8_SA(1, 0), a3, g2[0]);
            PG8_WAIT_V(8); PG8_WAIT_L(0); PG8_BAR; PG8_MMA(1, 0, At, B0); PG8_MMA(1, 1, At, B1); PG8_BAR; PG8_SCHED;
        }
        if constexpr (ALIGN_EPI) { if (wr == 0) PG8_BAR; }
        E(acc, cur, wr, wc, fr, fq); S.done(cur);
        if (!has_next) break;
#pragma unroll
        for (int a = 0; a < 2; ++a)
#pragma unroll
            for (int b = 0; b < 2; ++b)
#pragma unroll
                for (int m = 0; m < 4; ++m)
#pragma unroll
                    for (int n = 0; n < 2; ++n) acc[a][b][m][n] = (f32x4){0.f, 0.f, 0.f, 0.f};
        cur = nxt; cB = nB; ++ui;
#pragma unroll
        for (int h_ = 0; h_ < 2; ++h_)
#pragma unroll
            for (int i_ = 0; i_ < 2; ++i_) gc[h_][i_] = gn[h_][i_];
        if constexpr (ALIGN_EPI) { if (wr == 1) PG8_BAR; }
    }
    PG8_WAIT_V(0);
    if constexpr (!ALIGN_EPI) { if (wr == 0) PG8_BAR; }
    PG8_BAR;
#undef PG8_SA
#undef PG8_SB
#undef PG8_STAGE
#undef PG8_LDA
#undef PG8_LDB
#undef PG8_MMA
#undef PG8_WAIT_V
#undef PG8_WAIT_L
#undef PG8_BAR
#undef PG8_SCHED
#undef PG8_GOFF
}
}
namespace pg8 {
typedef int v8i __attribute__((ext_vector_type(8)));
typedef int v4i __attribute__((ext_vector_type(4)));
template <class Epi, class Sched, bool ALIGN_EPI, bool GATHER>
__device__ __forceinline__ void gemm_phase_fp8(PG8_LAS unsigned char* lds, const Gemm g, const Sched& S, const Epi& E, const PG8_LAS unsigned short* rows16) {
    int tid_ = threadIdx.x; asm volatile("" : "+v"(tid_));
    const int tid = tid_, wid = __builtin_amdgcn_readfirstlane(tid >> 6), lane = tid & 63, wr = wid >> 2, wc = wid & 3, fr = lane & 15, fq = lane >> 4;
    const int K = g.K, nt = K / 128;
    unsigned voffB[2];
#pragma unroll
    for (int i = 0; i < 2; ++i) { int R, C; stage_rc(tid * 16 + i * 8192, R, C); const int Rb = Epi::PERM ? ((R & ~31) + perm32(R & 31)) : R;
        voffB[i] = (unsigned)(Rb * K) + (unsigned)C * 2u; }
    const size_t kstep = (size_t)(BK * 2);
    const size_t hstep = (size_t)HALF * K;
    const size_t tstep = 2 * hstep;
    const unsigned ldsw = (unsigned)wid * 1024u;
    const unsigned rowb = (unsigned)K;
    const int aoff = lds_byte(wr * 64 + fr, fq * 8), boff = lds_byte(wc * 32 + fr, fq * 8);
#define PG8_SA(b, h) (((b) * 2 + (h)) * HTB)
#define PG8_SB(b, h) ((4 + (b) * 2 + (h)) * HTB)
#define PG8_STAGE(bufoff, gbase, voff) do { _Pragma("unroll") for (int _i = 0; _i < 2; ++_i) \
        __builtin_amdgcn_global_load_lds((const unsigned*)((const char*)(gbase) + (voff)[_i]), (PG8_LAS unsigned*)(lds + (bufoff) + ldsw + _i * 8192), 16, 0, 0); } while (0)
#define PG8_LDA(dst, b, h) do { _Pragma("unroll") for (int m = 0; m < 4; ++m) { const v4i lo_ = *(const PG8_LAS v4i*)(lds + PG8_SA(b, h) + aoff + m * 2048), hi_ = *(const PG8_LAS v4i*)(lds + PG8_SA(b, h) + aoff + m * 2048 + 1024); dst[m] = __builtin_shufflevector(lo_, hi_, 0, 1, 2, 3, 4, 5, 6, 7); } } while (0)
#define PG8_LDB(dst, b, h) do { _Pragma("unroll") for (int n = 0; n < 2; ++n) { const v4i lo_ = *(const PG8_LAS v4i*)(lds + PG8_SB(b, h) + boff + n * 2048), hi_ = *(const PG8_LAS v4i*)(lds + PG8_SB(b, h) + boff + n * 2048 + 1024); dst[n] = __builtin_shufflevector(lo_, hi_, 0, 1, 2, 3, 4, 5, 6, 7); } } while (0)
#define PG8_F8(x) (x)
#define PG8_MMA(ai, bj, At, Bt) do { __builtin_amdgcn_s_setprio(1); _Pragma("unroll") for (int m = 0; m < 4; ++m) _Pragma("unroll") for (int n = 0; n < 2; ++n) \
        asm volatile("v_mfma_scale_f32_16x16x128_f8f6f4 %0, %1, %2, %0, %3, %4 op_sel_hi:[0,0,0]" : "+v"(acc[ai][bj][m][n]) : "v"(Bt[n]), "v"(At[m]), "v"(sc2_), "v"(sc1_)); __builtin_amdgcn_s_setprio(0); } while (0)
#define PG8_MMAZ(ai, bj, At, Bt) do { __builtin_amdgcn_s_setprio(1); _Pragma("unroll") for (int m = 0; m < 4; ++m) _Pragma("unroll") for (int n = 0; n < 2; ++n) \
        asm volatile("v_mfma_scale_f32_16x16x128_f8f6f4 %0, %1, %2, 0, %3, %4 op_sel_hi:[0,0,0]" : "=v"(acc[ai][bj][m][n]) : "v"(Bt[n]), "v"(At[m]), "v"(sc2_), "v"(sc1_)); __builtin_amdgcn_s_setprio(0); } while (0)
#define PG8_WAIT_V(n) asm volatile("s_waitcnt vmcnt(" #n ")" ::: "memory")
#define PG8_WAIT_L(n) asm volatile("s_waitcnt lgkmcnt(" #n ")" ::: "memory")
#define PG8_BAR __builtin_amdgcn_s_barrier()
#define PG8_SCHED __builtin_amdgcn_sched_barrier(0)
#define PG8_GOFF(dst, U, PM) do { int t2_ = tid; asm volatile("" : "+v"(t2_)); _Pragma("unroll") for (int i_ = 0; i_ < 2; ++i_) { int R_, C_; stage_rc(t2_ * 16 + i_ * 8192, R_, C_); _Pragma("unroll") for (int h_ = 0; h_ < 2; ++h_) \
        dst[h_][i_] = (GATHER ? (unsigned)rows16[(U) * 256 + h_ * HALF + R_] : (unsigned)((PM) * 256 + h_ * HALF + R_)) * rowb + (unsigned)C_ * 2u; } } while (0)
    Unit cur, nxt; int ui = 0;
    if (!S.next(0, cur)) return;
    int sc1_ = 0x7f7f7f7f, sc2_ = 0x79797979; asm volatile("" : "+v"(sc1_), "+v"(sc2_));
    f32x4 acc[2][2][4][2];
    v8i At[4], B0[2], B1[2];
    const char* const Ab = (const char*)g.A;
    const char* cB = (const char*)g.Bt + (size_t)cur.pn * tstep;
    unsigned gc[2][2], gn[2][2];
    PG8_GOFF(gc, 0, cur.pm);
    S.a_ready(cur);
#define PG8_BIAS(U, SLOT) do { if constexpr (Epi::HAS_BIAS) if (wid == 0) __builtin_amdgcn_global_load_lds((const unsigned*)E.bias_src((U), lane), (PG8_LAS unsigned*)(E.bl + (SLOT) * 256), 16, 0, 0); } while (0)
    PG8_BIAS(cur, 0);
    PG8_STAGE(PG8_SB(0, 0), cB, voffB); PG8_STAGE(PG8_SB(0, 1), cB + hstep, voffB); PG8_STAGE(PG8_SA(0, 0), Ab, gc[0]); PG8_STAGE(PG8_SA(0, 1), Ab, gc[1]);
    if (wr == 1) PG8_BAR;
    PG8_WAIT_V(2); PG8_BAR;
    PG8_STAGE(PG8_SB(1, 0), cB + kstep, voffB); PG8_STAGE(PG8_SA(1, 0), Ab + kstep, gc[0]); PG8_STAGE(PG8_SB(1, 1), cB + hstep + kstep, voffB);
    PG8_WAIT_V(6); PG8_BAR;
    for (;;) {
        const bool has_next = S.next(ui + 1, nxt);
        const char* nB = has_next ? (const char*)g.Bt + (size_t)nxt.pn * tstep : cB;
        if (has_next) { PG8_GOFF(gn, ui + 1, nxt.pm); } else {
#pragma unroll
            for (int h_ = 0; h_ < 2; ++h_)
#pragma unroll
                for (int i_ = 0; i_ < 2; ++i_) gn[h_][i_] = gc[h_][i_]; }
#pragma unroll 1
        for (int t = 0; t < nt; t += 2) {
            const bool last = (t == nt - 2);
            const char* a1 = Ab + (size_t)(t + 1) * kstep;
            const char* a2 = last ? Ab : Ab + (size_t)(t + 2) * kstep; const char* b2 = last ? nB : cB + (size_t)(t + 2) * kstep;
            const char* a3 = a2 + kstep; const char* b3 = b2 + kstep;
            unsigned g2[2][2];
#pragma unroll
            for (int h_ = 0; h_ < 2; ++h_)
#pragma unroll
                for (int i_ = 0; i_ < 2; ++i_) g2[h_][i_] = last ? gn[h_][i_] : gc[h_][i_];
            if (last && has_next) S.a_ready(nxt);
            PG8_LDB(B0, 0, 0); PG8_LDB(B1, 0, 1); PG8_SCHED; PG8_LDA(At, 0, 0); PG8_STAGE(PG8_SA(1, 1), a1, gc[1]);
            PG8_WAIT_V(8); PG8_WAIT_L(0); PG8_BAR; if (t == 0) { PG8_MMAZ(0, 0, At, B0); PG8_MMAZ(0, 1, At, B1); } else { PG8_MMA(0, 0, At, B0); PG8_MMA(0, 1, At, B1); } PG8_BAR; PG8_SCHED;
            PG8_LDA(At, 0, 1); PG8_STAGE(PG8_SB(0, 0), b2, voffB); PG8_STAGE(PG8_SB(0, 1), b2 + hstep, voffB); PG8_STAGE(PG8_SA(0, 0), a2, g2[0]);
            PG8_WAIT_V(8); PG8_WAIT_L(0); PG8_BAR; if (t == 0) { PG8_MMAZ(1, 0, At, B0); PG8_MMAZ(1, 1, At, B1); } else { PG8_MMA(1, 0, At, B0); PG8_MMA(1, 1, At, B1); } PG8_BAR; PG8_SCHED;
            PG8_LDB(B0, 1, 0); PG8_LDB(B1, 1, 1); PG8_SCHED; PG8_LDA(At, 1, 0); PG8_STAGE(PG8_SA(0, 1), a2, g2[1]);
            PG8_WAIT_V(8); PG8_WAIT_L(0); PG8_BAR; PG8_MMA(0, 0, At, B0); PG8_MMA(0, 1, At, B1); PG8_BAR; PG8_SCHED;
            PG8_LDA(At, 1, 1); PG8_STAGE(PG8_SB(1, 0), b3, voffB); PG8_STAGE(PG8_SB(1, 1), b3 + hstep, voffB); PG8_STAGE(PG8_SA(1, 0), a3, g2[0]);
            PG8_WAIT_V(8); PG8_WAIT_L(0); PG8_BAR; PG8_MMA(1, 0, At, B0); PG8_MMA(1, 1, At, B1); PG8_BAR; PG8_SCHED;
        }
        if constexpr (ALIGN_EPI) { if (wr == 0) PG8_BAR; }
        asm volatile("s_nop 15\n\ts_nop 15" ::: "memory");
        E(acc, cur, wr, wc, fr, fq, ui & 1); S.done(cur);
        if (!has_next) break;
        PG8_BIAS(nxt, (ui + 1) & 1);
        cur = nxt; cB = nB; ++ui;
#pragma unroll
        for (int h_ = 0; h_ < 2; ++h_)
#pragma unroll
            for (int i_ = 0; i_ < 2; ++i_) gc[h_][i_] = gn[h_][i_];
        if constexpr (ALIGN_EPI) { if (wr == 1) PG8_BAR; }
    }
    PG8_WAIT_V(0);
    if constexpr (!ALIGN_EPI) { if (wr == 0) PG8_BAR; }
    PG8_BAR;
#undef PG8_SA
#undef PG8_SB
#undef PG8_STAGE
#undef PG8_LDA
#undef PG8_LDB
#undef PG8_MMA
#undef PG8_MMAZ
#undef PG8_WAIT_V
#undef PG8_WAIT_L
#undef PG8_BAR
#undef PG8_SCHED
#undef PG8_GOFF
#undef PG8_F8
#undef PG8_BIAS
}
}
#define GAS __attribute__((address_space(1)))
#define LAS __attribute__((address_space(3)))
typedef unsigned short bf16;
typedef unsigned v4u __attribute__((ext_vector_type(4)));
typedef float f32x4 __attribute__((ext_vector_type(4)));
typedef short bf16x8 __attribute__((ext_vector_type(8)));
typedef GAS unsigned gu32;
typedef GAS unsigned long long gu64;
#define RLX_AGENT __ATOMIC_RELAXED, __HIP_MEMORY_SCOPE_AGENT
#define LDS_WAIT() asm volatile("s_waitcnt lgkmcnt(0)" ::: "memory")
#define VM_WAIT() asm volatile("s_waitcnt vmcnt(0)" ::: "memory")
__device__ __forceinline__ unsigned long long rt() { return __builtin_amdgcn_s_memrealtime(); }
__device__ __forceinline__ unsigned f2bf(float f) { unsigned u = __builtin_bit_cast(unsigned, f); return (u + 0x7fffu + ((u >> 16) & 1u)) >> 16; }
__device__ __forceinline__ unsigned pk2(float lo, float hi) { return f2bf(lo) | (f2bf(hi) << 16); }
#define XB_TMO      128
#define XB_XCNT(j)  (256  + 64 * (j))
#define XB_XSUB(j)  (1280 + 64 * (j))
#define XB_XGEN(j)  (2304 + 64 * (j))
#define XB_TOP      3328
#define XB_TOPGEN   3392
#define XCD_BAR_WORDS 3456
#define XB_SPIN_CAP (1u << 18)

__device__ __forceinline__ unsigned xb_ld(unsigned* p)              { return __hip_atomic_load(p, __ATOMIC_RELAXED, __HIP_MEMORY_SCOPE_AGENT); }
__device__ __forceinline__ unsigned xb_add(unsigned* p, unsigned v) { return __hip_atomic_fetch_add(p, v, __ATOMIC_RELAXED, __HIP_MEMORY_SCOPE_AGENT); }
__device__ __forceinline__ unsigned xb_xcc_id() { return (unsigned)__builtin_amdgcn_s_getreg((3 << 11) | 20) & 0xFu; }
#define XB_SPIN(cond, bar) do { unsigned _sp = 0; while (cond) { __builtin_amdgcn_s_sleep(1); \
    if ((++_sp & 255u) == 0u) { if (xb_ld(&(bar)[XB_TMO])) break; if (_sp > XB_SPIN_CAP) { atomicAdd(&(bar)[XB_TMO], 1u); break; } } } } while (0)

struct XcdBarrier {
    unsigned* bar; unsigned x;
    volatile LAS unsigned* st;
};

__device__ __forceinline__ XcdBarrier xcd_barrier_post(unsigned* bar, volatile LAS unsigned* st) {
    XcdBarrier b; b.bar = bar; b.x = xb_xcc_id(); b.st = st;
    if (threadIdx.x == 0) (void)xb_add(&bar[XB_XCNT(b.x)], 1u);
    return b;
}
__device__ __forceinline__ void xcd_barrier_complete(unsigned* bar, unsigned x, unsigned& nloc, unsigned& nx) {
    const unsigned G = gridDim.x * gridDim.y * gridDim.z;
    unsigned sum, cnt, mine, sp = 0u;
    for (;;) {
        sum = 0u; cnt = 0u; mine = 0u;
#pragma unroll
        for (unsigned j = 0; j < 16; ++j) { const unsigned c = xb_ld(&bar[XB_XCNT(j)]); sum += c; cnt += (c > 0u) ? 1u : 0u; mine = (j == x) ? c : mine; }
        if (sum == G) break;
        __builtin_amdgcn_s_sleep(1);
        if ((++sp & 255u) == 0u) { if (xb_ld(&bar[XB_TMO])) break; if (sp > XB_SPIN_CAP) { atomicAdd(&bar[XB_TMO], 1u); break; } }
    }
    nloc = mine > 0u ? mine : 1u; nx = cnt > 0u ? cnt : 1u;
}

__device__ __forceinline__ void xcd_barrier(const XcdBarrier& b) {
    asm volatile("s_waitcnt vmcnt(0)" ::: "memory");
    __syncthreads();
    if (threadIdx.x == 0) {
        unsigned* bar = b.bar;
        __builtin_amdgcn_s_waitcnt(0);
        unsigned nloc = b.st[0], nx = b.st[1];
        if (nloc == 0u) { xcd_barrier_complete(bar, b.x, nloc, nx); b.st[0] = nloc; b.st[1] = nx; }
        const unsigned old = xb_add(&bar[XB_XSUB(b.x)], 1u);
        const unsigned gen = old / nloc;
        if (old + 1u == (gen + 1u) * nloc) {
            __builtin_amdgcn_fence(__ATOMIC_RELEASE, "agent");
            asm volatile("s_waitcnt vmcnt(0)" ::: "memory");
            const unsigned og = xb_add(&bar[XB_TOP], 1u);
            const unsigned tg = og / nx;
            if (og + 1u == (tg + 1u) * nx) xb_add(&bar[XB_TOPGEN], 1u);
            else XB_SPIN(xb_ld(&bar[XB_TOPGEN]) == tg, bar);
            __builtin_amdgcn_fence(__ATOMIC_ACQUIRE, "agent");
            xb_add(&bar[XB_XGEN(b.x)], 1u);
            asm volatile("s_waitcnt vmcnt(0)" ::: "memory");
        } else {
            XB_SPIN(xb_ld(&bar[XB_XGEN(b.x)]) == gen, bar);
            __builtin_amdgcn_fence(__ATOMIC_ACQUIRE, "agent");
            asm volatile("s_waitcnt vmcnt(0)" ::: "memory");
        }
    }
    __syncthreads();
}
namespace attn_body {
using bf16=__hip_bfloat16;
using bf16x8=__attribute__((ext_vector_type(8)))short;
using s16x4=__attribute__((ext_vector_type(4)))short;
using f32x16=__attribute__((ext_vector_type(16)))float;
using u32x4=__attribute__((ext_vector_type(4)))unsigned;
typedef int v8i_t __attribute__((ext_vector_type(8))); typedef int v4i_t __attribute__((ext_vector_type(4)));
constexpr int BATCH=8,NHEAD=8,NKVH=2,SEQ=4096,D=64;
constexpr int DMQ=512,DMK=128,DMV=2048,DMO=1024;
constexpr int NW=8,QBLK=32,QB=QBLK*NW,KVBLK=64,NQB=SEQ/QB;
constexpr int ATTN_UNIT_ROWS=QB;
__device__ __forceinline__ int crow(int r,int hi){return (r&3)+8*(r>>2)+4*hi;}
#define SBAR() __builtin_amdgcn_sched_barrier(0)
__device__ __forceinline__ void cmask(f32x16&p0,f32x16&p1,int jb,int qrel,int hi){
  const float NEG=-INFINITY; int kb=64*jb+4*hi;
  #pragma unroll
  for(int r=0;r<16;++r){int kv=kb+(r&3)+8*(r>>2); if(kv>qrel)p0[r]=NEG; if(kv+32>qrel)p1[r]=NEG;}
}

constexpr int NSLOT=3, SLOTB=8192;
constexpr int LDS_K=0, LDS_V=NSLOT*SLOTB, LDS_WS=2*NSLOT*SLOTB, LDS_OST=LDS_WS+NW*64*4, LDS_BYTES=LDS_OST+NW*4096;
constexpr float C2=0.125f*1.4426950408889634f;
__device__ __forceinline__ void glds16(const void*gsrc,unsigned lds_dst){unsigned keep;
  asm volatile("s_mov_b32 %0, m0\n\ts_mov_b32 m0, %2\n\ts_nop 0\n\tglobal_load_lds_dwordx4 %1, off\n\ts_mov_b32 m0, %0":"=&s"(keep):"v"(gsrc),"s"(lds_dst):"memory");}
__device__ __forceinline__ float max3f(float a,float b,float c){float r;asm("v_max3_f32 %0, %1, %2, %3":"=v"(r):"v"(a),"v"(b),"v"(c));return r;}
__device__ __forceinline__ float max2f(float a,float b){float r;asm("v_max_f32_e32 %0, %1, %2":"=v"(r):"v"(a),"v"(b));return r;}
__device__ __forceinline__ float fadd_s(float a,float b){float r;asm("v_add_f32_e32 %0, %1, %2":"=v"(r):"v"(a),"v"(b));return r;}
__device__ __forceinline__ float fsub_s(float a,float b){float r;asm("v_sub_f32_e32 %0, %1, %2":"=v"(r):"v"(a),"v"(b));return r;}
typedef float f32x2_t __attribute__((ext_vector_type(2))); typedef __bf16 bf16x2_t __attribute__((ext_vector_type(2)));
__device__ __forceinline__ unsigned cvtpk_s(float lo,float hi){f32x2_t v={lo,hi};bf16x2_t b=__builtin_convertvector(v,bf16x2_t);return __builtin_bit_cast(unsigned,b);}
#define WAIT_BAR(N) asm volatile("s_waitcnt vmcnt(" #N ") lgkmcnt(0)\n\ts_barrier":::"memory")
#define WAIT_BAR2() do{ if(wid<4){WAIT_BAR(2);} else {WAIT_BAR(1);} }while(0)

#define QK8(DST,KF,QF,CSRC) asm volatile("v_mfma_scale_f32_32x32x64_f8f6f4 %0, %1, %2, %3, %4, %5 op_sel_hi:[0,0,0]":"=&v"(DST):"v"(KF),"v"(QF),"v"(CSRC),"v"(scK_),"v"(scQ_))
#define QK8Z(DST,KF,QF) asm volatile("v_mfma_scale_f32_32x32x64_f8f6f4 %0, %1, %2, 0, %3, %4 op_sel_hi:[0,0,0]":"=v"(DST):"v"(KF),"v"(QF),"v"(scK_),"v"(scQ_))
typedef __attribute__((address_space(3))) const char* lds_cptr;
typedef short v4i16_t __attribute__((ext_vector_type(4)));
__device__ __forceinline__ v8i_t kloadh(lds_cptr kp,int ko0,int ko1,int kk){ const v4i_t lo=*(const __attribute__((address_space(3))) v4i_t*)(kp+kk*2048+ko0), hi_=*(const __attribute__((address_space(3))) v4i_t*)(kp+kk*2048+ko1); return __builtin_shufflevector(lo,hi_,0,1,2,3,4,5,6,7); }
__device__ __forceinline__ s16x4 vtr(lds_cptr p){ return __builtin_bit_cast(s16x4,__builtin_amdgcn_ds_read_tr16_b64_v4i16((__attribute__((address_space(3))) v4i16_t*)p)); }
__device__ __forceinline__ float rowmax(const f32x16&p0,const f32x16&p1){
  float a=max3f(p0[0],p0[1],p1[0]),b=max3f(p0[2],p0[3],p1[1]);a=max3f(a,p1[2],p1[3]);
  #pragma unroll
  for(int r=4;r<16;r+=4){a=max3f(a,p0[r],p0[r+1]);b=max3f(b,p0[r+2],p0[r+3]);a=max3f(a,p1[r],p1[r+1]);b=max3f(b,p1[r+2],p1[r+3]);}
  const float m=max2f(a,b);
  auto rr=__builtin_amdgcn_permlane32_swap(__float_as_uint(m),__float_as_uint(m),false,false);
  return max2f(__uint_as_float(rr[0]),__uint_as_float(rr[1]));
}
__device__ __forceinline__ void pv(f32x16*o,int vb,bf16x8 pa0,bf16x8 pa1,bf16x8 pa2,bf16x8 pa3){
  #pragma unroll
  for(int d0=0;d0<2;++d0){s16x4 lo[4],hi[4];
    #pragma unroll
    for(int ks=0;ks<4;++ks){
      asm volatile("ds_read_b64_tr_b16 %0,%1 offset:%c2":"=&v"(lo[ks]):"v"(vb),"i"(d0*4096+ks*1024):"memory");
      asm volatile("ds_read_b64_tr_b16 %0,%1 offset:%c2":"=&v"(hi[ks]):"v"(vb),"i"(d0*4096+ks*1024+512):"memory");}
    asm volatile("s_waitcnt lgkmcnt(0)":::"memory");SBAR();
    #define PK(k) (bf16x8){lo[k][0],lo[k][1],lo[k][2],lo[k][3],hi[k][0],hi[k][1],hi[k][2],hi[k][3]}
    o[d0]=__builtin_amdgcn_mfma_f32_32x32x16_bf16(pa0,PK(0),o[d0],0,0,0);
    o[d0]=__builtin_amdgcn_mfma_f32_32x32x16_bf16(pa1,PK(1),o[d0],0,0,0);
    o[d0]=__builtin_amdgcn_mfma_f32_32x32x16_bf16(pa2,PK(2),o[d0],0,0,0);
    o[d0]=__builtin_amdgcn_mfma_f32_32x32x16_bf16(pa3,PK(3),o[d0],0,0,0);
    #undef PK
  }
}

#ifndef ATTN_STORE16
#define ATTN_STORE16(p,v) (*(u32x4*)(p)=(v))
#endif
template<int THRL,bool FIXED> __device__ __forceinline__ void attn_unit(int b,int h,int qb,const bf16*Q,const bf16*__restrict__ K,const bf16*__restrict__ V,bf16*O,char*shm,float bref){
  int tid_=threadIdx.x; asm volatile("":"+v"(tid_)); const int tid=tid_,lane=tid&63,r32=lane&31,hi=lane>>5; const int wid=__builtin_amdgcn_readfirstlane(tid>>6);
  const long rowbase=(long)b*SEQ; const int q0=qb*QB;
  const unsigned char*Qw8=(const unsigned char*)Q+((rowbase+q0+wid*QBLK)*512+h*64); const int kvh=h>>2;
  const unsigned char*Kh8=(const unsigned char*)K+(long)((b*NKVH+kvh)*(SEQ/KVBLK))*4096; const bf16*Vh=V+rowbase*DMV+kvh*D;
  const unsigned lds0=(unsigned)(uintptr_t)shm;
  float*wsf=(float*)(shm+LDS_WS)+wid*64;
  const unsigned char*ksrc8=Kh8+(wid&3)*1024+lane*16;
  const bf16*vsrc=Vh+(long)(16*(wid&3)+(lane>>2))*DMV+(wid>>2)*32+(lane&3)*8;
  const unsigned kdst=lds0+LDS_K+wid*1024, vdst=lds0+LDS_V+wid*1024;
  #define DMA_K(t,slot) do{ if(wid<4) glds16(ksrc8+(long)(t)*4096,(unsigned)__builtin_amdgcn_readfirstlane(kdst+(slot))); }while(0)
  #define DMA_V(t,slot) glds16(vsrc+(long)(t)*KVBLK*DMV,(unsigned)__builtin_amdgcn_readfirstlane(vdst+(slot)))
  const int vb0=(int)(lds0+LDS_V)+((lane>>4)&1)*32+(lane&3)*8+(4*hi+((lane&15)>>2))*64;
  v8i_t kf[2];
  int scK_=0x7f7f7f7f,scQ_=0x7c7c7c7c; asm volatile("":"+v"(scK_),"+v"(scQ_));
  const lds_cptr shm3=(lds_cptr)shm; const lds_cptr kp0=shm3+LDS_K+r32*64; const int ksw_=(r32>>2)&3, ko0=((2*hi)^ksw_)*16, ko1=((2*hi+1)^ksw_)*16; const lds_cptr vp0=shm3+LDS_V+((lane>>4)&1)*32+(lane&3)*8+(4*hi+((lane&15)>>2))*64;
  constexpr int NT=SEQ/KVBLK;
  DMA_K(0,0);DMA_V(0,0);DMA_K(1,SLOTB);
  v8i_t q8; { const v4i_t lo=*reinterpret_cast<const v4i_t*>(Qw8+(long)r32*512+hi*32), hi_=*reinterpret_cast<const v4i_t*>(Qw8+(long)r32*512+hi*32+16); q8=__builtin_shufflevector(lo,hi_,0,1,2,3,4,5,6,7); }
  float mhat=0.f,l_reg=0.f;f32x16 o[2];o[0]=f32x16{};o[1]=f32x16{};f32x16 negm=f32x16{}; if constexpr(FIXED){ _Pragma("unroll") for(int r=0;r<16;++r)negm[r]=-bref; } asm volatile("":"+v"(negm));
  #define CMASK(P0,P1,t) do{}while(0)
  bool resc=false;
  #define START(P0,P1) do{ if constexpr(!FIXED){ const float rm=rowmax(P0,P1); resc=false; \
    { const float dl=rm; mhat=fadd_s(mhat,dl); \
      _Pragma("unroll") for(int r=0;r<16;++r){P0[r]=fsub_s(P0[r],dl);P1[r]=fsub_s(P1[r],dl);} \
      _Pragma("unroll") for(int r=0;r<16;++r)negm[r]=-mhat; asm volatile("":"+v"(negm)); } } \
    _Pragma("unroll") for(int r=0;r<16;++r)P0[r]=__builtin_amdgcn_exp2f(P0[r]); }while(0)
  #define RESC() do{ if constexpr(!FIXED) if(resc){ asm volatile("s_waitcnt lgkmcnt(0)":::"memory"); \
      _Pragma("unroll") for(int d_=0;d_<2;++d_) _Pragma("unroll") for(int r=0;r<16;++r)o[d_][r]*=wsf[crow(r,hi)]; } }while(0)
  f32x16 pA0,pA1,pB0,pB1;
  int sl_prev=0,sl_cur=0,sl_next=SLOTB;
  #define ROT() do{sl_prev=sl_cur;sl_cur=sl_next;sl_next=(sl_next==(NSLOT-1)*SLOTB)?0:sl_next+SLOTB;}while(0)
  DMA_K(2,2*SLOTB);
  WAIT_BAR(3);
  { const v8i_t k0_=kloadh(kp0,ko0,ko1,0),k1_=kloadh(kp0,ko0,ko1,1); if constexpr(FIXED){ QK8(pA0,k0_,q8,negm); QK8(pA1,k1_,q8,negm); } else { QK8(pA0,k0_,q8,negm); QK8(pA1,k1_,q8,negm); } }
  asm volatile("s_nop 15\n\ts_nop 15\n\ts_nop 15":"+v"(pA0),"+v"(pA1));CMASK(pA0,pA1,0);
  START(pA0,pA1);
  _Pragma("unroll") for(int r=0;r<16;++r)pA1[r]=__builtin_amdgcn_exp2f(pA1[r]);
  WAIT_BAR(0);
  DMA_K(3,0);DMA_V(1,SLOTB);
  ROT();
  kf[0]=kloadh(kp0+sl_cur,ko0,ko1,0); kf[1]=kloadh(kp0+sl_cur,ko0,ko1,1);
  WAIT_BAR(2);
  s16x4 vlo[8],vhi[8]; u32x4 pw0,pw1,pw2,pw3;
  #define PKW(P,B) cvtpk_s(P[B],P[B+1])
  #define PAF(k) __builtin_bit_cast(bf16x8,pw##k)
  #define VFR(i) (bf16x8){vlo[i][0],vlo[i][1],vlo[i][2],vlo[i][3],vhi[i][0],vhi[i][1],vhi[i][2],vhi[i][3]}
  #define PIN(x) asm volatile("":"+v"(x))
  #define MX3(a,b,c) __builtin_fmaxf(__builtin_fmaxf((a),(b)),(c))
  #define GAPA(MF,A0,A1,A2,A3,W0,W1,PW) do{ MF; sacc+=A0; sacc+=A1; sacc+=A2; sacc+=A3; PIN(sacc); W0; W1; PIN(PW); SBAR(); }while(0)
  #define EX(v) __builtin_amdgcn_exp2f(v)
  #define GAPB(MF,X,B) do{ MF; X[B]=EX(X[B]); X[B+1]=EX(X[B+1]); X[B+2]=EX(X[B+2]); X[B+3]=EX(X[B+3]); PIN(X); SBAR(); }while(0)
  #define VRD(i) do{ vlo[i]=vtr(vp_+(((i)>>2)*4096+((i)&3)*1024)); vhi[i]=vtr(vp_+(((i)>>2)*4096+((i)&3)*1024+512)); }while(0)
  #define KRD(G,j) do{ if(G){ if((j)==0)kf[0]=kloadh(kp0+sl_next,ko0,ko1,0); if((j)==2)kf[1]=kloadh(kp0+sl_next,ko0,ko1,1); SBAR(); } }while(0)
  #define STEP(C0,C1,P0,P1,t,GK,GV,GL) do{ SBAR(); \
    const lds_cptr vp_=vp0+sl_prev; \
    VRD(0); SBAR(); float sacc=(P0[0]+P0[1]); \
    GAPA(QK8(C0,kf[0],q8,negm), P0[2],P0[3],P0[4],P0[5],     pw0[0]=PKW(P0,0), pw0[1]=PKW(P0,2), pw0); \
    VRD(4); SBAR(); GAPA(QK8(C1,kf[1],q8,negm), P0[6],P0[7],P0[8],P0[9],     pw0[2]=PKW(P0,4), pw0[3]=PKW(P0,6), pw0); \
    VRD(1); SBAR(); GAPA((void)0,   P0[10],P0[11],P0[12],P0[13], pw1[0]=PKW(P0,8), pw1[1]=PKW(P0,10), pw1); \
    VRD(5); SBAR(); GAPA((void)0,   P0[14],P0[15],P1[0],P1[1],   pw1[2]=PKW(P0,12),pw1[3]=PKW(P0,14), pw1); \
    VRD(2); SBAR(); GAPA((void)0,   P1[2],P1[3],P1[4],P1[5],     pw2[0]=PKW(P1,0), pw2[1]=PKW(P1,2), pw2); \
    VRD(6); SBAR(); GAPA((void)0,   P1[6],P1[7],P1[8],P1[9],     pw2[2]=PKW(P1,4), pw2[3]=PKW(P1,6), pw2); \
    VRD(3); SBAR(); GAPA((void)0,   P1[10],P1[11],P1[12],P1[13], pw3[0]=PKW(P1,8), pw3[1]=PKW(P1,10), pw3); \
    VRD(7); SBAR(); GAPA((void)0,   P1[14],P1[15],0.f,0.f,       pw3[2]=PKW(P1,12),pw3[3]=PKW(P1,14), pw3); \
    l_reg+=sacc; \
    if(GK){DMA_K((t)+3,sl_cur);} if(GV){DMA_V((t)+1,sl_next);} \
    CMASK(C0,C1,t); \
    if constexpr(!FIXED){ float a=MX3(C0[0],C0[1],C1[0]),b=MX3(C0[2],C0[3],C1[1]); a=MX3(a,C1[2],C1[3]); \
      _Pragma("unroll") for(int r=4;r<16;r+=4){a=MX3(a,C0[r],C0[r+1]);b=MX3(b,C0[r+2],C0[r+3]);a=MX3(a,C1[r],C1[r+1]);b=MX3(b,C1[r+2],C1[r+3]);} \
      float rm=__builtin_fmaxf(a,b); { auto rr=__builtin_amdgcn_permlane32_swap(__float_as_uint(rm),__float_as_uint(rm),false,false); rm=__builtin_fmaxf(__uint_as_float(rr[0]),__uint_as_float(rr[1])); } \
      resc=false; \
      if(__builtin_expect(__any(rm>(float)THRL),0)){ const float dl=__builtin_fmaxf(rm,0.f); mhat+=dl; \
        _Pragma("unroll") for(int r=0;r<16;++r){C0[r]-=dl;C1[r]-=dl;} \
        _Pragma("unroll") for(int r=0;r<16;++r)negm[r]=-mhat; asm volatile("":"+v"(negm)); \
        const float f=__builtin_amdgcn_exp2f(-dl); l_reg*=f; if(hi==0)wsf[r32]=f; resc=true; } } \
    SBAR(); \
    GAPB(o[0]=__builtin_amdgcn_mfma_f32_32x32x16_bf16(PAF(0),VFR(0),o[0],0,0,0), C0,0); \
    GAPB(o[1]=__builtin_amdgcn_mfma_f32_32x32x16_bf16(PAF(0),VFR(4),o[1],0,0,0), C0,4); \
    KRD(GL,0); GAPB(o[0]=__builtin_amdgcn_mfma_f32_32x32x16_bf16(PAF(1),VFR(1),o[0],0,0,0), C0,8); \
    KRD(GL,1); GAPB(o[1]=__builtin_amdgcn_mfma_f32_32x32x16_bf16(PAF(1),VFR(5),o[1],0,0,0), C0,12); \
    KRD(GL,2); GAPB(o[0]=__builtin_amdgcn_mfma_f32_32x32x16_bf16(PAF(2),VFR(2),o[0],0,0,0), C1,0); \
    KRD(GL,3); GAPB(o[1]=__builtin_amdgcn_mfma_f32_32x32x16_bf16(PAF(2),VFR(6),o[1],0,0,0), C1,4); \
    GAPB(o[0]=__builtin_amdgcn_mfma_f32_32x32x16_bf16(PAF(3),VFR(3),o[0],0,0,0), C1,8); \
    GAPB(o[1]=__builtin_amdgcn_mfma_f32_32x32x16_bf16(PAF(3),VFR(7),o[1],0,0,0), C1,12); \
    }while(0)
  int t=1;
  #undef CMASK
  #define CMASK(P0,P1,t) do{}while(0)
  for(;t+5<NT;t+=2){
    STEP(pB0,pB1,pA0,pA1,t,true,true,true);     WAIT_BAR2(); RESC(); ROT();
    STEP(pA0,pA1,pB0,pB1,t+1,true,true,true);   WAIT_BAR2(); RESC(); ROT();
  }
  #undef CMASK
  #define CMASK(P0,P1,t) do{}while(0)
  #define ENDW(tt) do{ if((tt)+3<NT){WAIT_BAR2();} else if((tt)+2<NT){WAIT_BAR(1);} else {WAIT_BAR(0);} }while(0)
  for(;t+1<NT;t+=2){
    STEP(pB0,pB1,pA0,pA1,t,(t+3<NT),(t+1<NT),(t+1<NT));       ENDW(t);   RESC(); ROT();
    STEP(pA0,pA1,pB0,pB1,t+1,(t+4<NT),(t+2<NT),(t+2<NT));     ENDW(t+1); RESC(); ROT();
  }
  STEP(pB0,pB1,pA0,pA1,NT-1,false,false,false); RESC();
  { float sacc=pB0[0]+pB0[1]; _Pragma("unroll") for(int r=2;r<16;++r)sacc+=pB0[r]; _Pragma("unroll") for(int r=0;r<16;++r)sacc+=pB1[r]; l_reg+=sacc;
    pw0=(u32x4){PKW(pB0,0),PKW(pB0,2),PKW(pB0,4),PKW(pB0,6)};pw1=(u32x4){PKW(pB0,8),PKW(pB0,10),PKW(pB0,12),PKW(pB0,14)};pw2=(u32x4){PKW(pB1,0),PKW(pB1,2),PKW(pB1,4),PKW(pB1,6)};pw3=(u32x4){PKW(pB1,8),PKW(pB1,10),PKW(pB1,12),PKW(pB1,14)};
    SBAR(); pv(o,vb0+sl_cur,PAF(0),PAF(1),PAF(2),PAF(3)); }
  #undef PKW
  #undef PAF
  #undef VFR
  #undef PIN
  #undef MX3
  #undef GAPA
  #undef GAPB
  #undef EX
  #undef VRD
  #undef KRD
  #undef STEP
  #undef ENDW
  {auto rr=__builtin_amdgcn_permlane32_swap(__float_as_uint(l_reg),__float_as_uint(l_reg),false,false);l_reg=__uint_as_float(rr[0])+__uint_as_float(rr[1]);}
  if(hi==0)wsf[32+r32]=l_reg;asm volatile("s_waitcnt lgkmcnt(0)":::"memory");
  float rli[16];
  #pragma unroll
  for(int r=0;r<16;++r)rli[r]=__builtin_amdgcn_rcpf(wsf[32+crow(r,hi)]);
  bf16*Ow=O+(rowbase+q0+wid*QBLK)*DMO+h*D;
  { bf16*stg=(bf16*)(shm+LDS_OST)+wid*2048;
    #pragma unroll
    for(int r=0;r<16;++r){const int orow=crow(r,hi);
      #pragma unroll
      for(int d0=0;d0<2;++d0)stg[orow*64+d0*32+r32]=__float2bfloat16(o[d0][r]*rli[r]);}
    asm volatile("s_waitcnt lgkmcnt(0)":::"memory");
    #pragma unroll
    for(int i=0;i<4;++i){const int row=i*8+(lane>>3),ch=lane&7; const u32x4 v=*(const u32x4*)(stg+row*64+ch*8); ATTN_STORE16(Ow+(long)row*DMO+ch*8,v);} }
  asm volatile("s_waitcnt lgkmcnt(0)\n\ts_barrier":::"memory");
  #undef DMA_K
  #undef DMA_V
  #undef CMASK
  #undef START
  #undef RESC
  #undef ROT
}
constexpr int ATTN_LDS_BYTES=LDS_BYTES;
struct AttnTensors { const bf16* Q; const bf16* K; const bf16* V; bf16* O; };
struct AttnUnit { int bh; int qb; };
struct StaticOrder {
  int vcu, G;
  __device__ __forceinline__ explicit StaticOrder(int grid,int block):vcu((grid%8==0)?(block%8)*(grid/8)+block/8:block),G(grid){}
  __device__ __forceinline__ bool next(int i,AttnUnit&u)const{ const int per=(BATCH*NHEAD*NQB+G-1)/G; if(i>=per)return false; const int idx=vcu*per+i; if(idx>=BATCH*NHEAD*NQB)return false;
    const int qb=idx%NQB, hq=(idx/NQB)&3, bk=idx/(NQB*4), kvh=bk&1, b=bk>>1; u.bh=b*NHEAD+kvh*4+hq; u.qb=qb; return true; }
  __device__ __forceinline__ void a_ready(const AttnUnit&)const{}
  __device__ __forceinline__ void done(const AttnUnit&)const{}
};
template<class Sched,int THRL=8> __device__ __forceinline__ void attn_phase(char*lds,const AttnTensors&T,const Sched&S,float bref){
  AttnUnit u;
  if(bref>=0.f&&bref<=56.f){ for(int i=0;S.next(i,u);++i){ S.a_ready(u); attn_unit<THRL,true>(u.bh/NHEAD,u.bh%NHEAD,u.qb,T.Q,T.K,T.V,T.O,lds,bref); S.done(u); } }
  else { for(int i=0;S.next(i,u);++i){ S.a_ready(u); attn_unit<THRL,false>(u.bh/NHEAD,u.bh%NHEAD,u.qb,T.Q,T.K,T.V,T.O,lds,0.f); S.done(u); } }
}
#undef SBAR
#undef WAIT_BAR
#undef WAIT_BAR2
#undef QK8
#undef QK8Z
}
constexpr int NB = 8, SEQ = 4096, DM = 1024, NL = 4, NTOK = NB * SEQ;
constexpr int INW = 1824, INP = 2048;
constexpr int C_AQ = 0, C_AK = 512, C_AV = 640, C_GQ = 768, C_GK = 896, C_GV = 1024, C_GR = 1280, C_FX = 1536, C_GLR = 1792;
constexpr int NE = 32, TOPK = 4, DE = 1024;
constexpr int MPAD = NTOK * TOPK + NE * 256;
constexpr float LN_EPS = 1e-5f, RMS_EPS = 1e-6f;
constexpr float DN_ALPHA = 1.681792830507429f;
constexpr float QSCALE = 0.125f * 1.4426950408889634f;
constexpr float GLA_QSCALE = 0.17677669529663687f;

constexpr size_t MiB = 1u << 20;
constexpr size_t WS_CTL = 0, CTL_ZERO_BYTES = 256 * 1024;
constexpr size_t WS_ROPE = 1 * MiB;
constexpr size_t WS_WIN_T = 2 * MiB;
constexpr size_t WS_WOUT_T = 18 * MiB;
constexpr size_t WS_FTAB = 26 * MiB;
constexpr size_t WS_TW = WS_FTAB + 65536;
constexpr size_t WS_RWT = WS_FTAB + 131072;
constexpr size_t WS_FTMP = 27 * MiB;
constexpr size_t WS_WGU_T = 90 * MiB;
constexpr size_t WS_WDN_T = 602 * MiB;
constexpr size_t WS_HF = 858 * MiB;
constexpr size_t WS_HB = 986 * MiB;
constexpr size_t WS_PROJ = 1050 * MiB;
constexpr size_t WS_QB = 1178 * MiB;
constexpr size_t WS_KB = 1210 * MiB;
constexpr size_t WS_MIX = 1218 * MiB;
constexpr size_t WS_T1 = 1282 * MiB;
constexpr size_t WS_UVT = 1410 * MiB;
constexpr size_t WS_LA = 1442 * MiB;
constexpr size_t WS_OF = 1474 * MiB;
constexpr size_t WS_OB = 1506 * MiB;
constexpr size_t WS_TOK = 1538 * MiB;
constexpr size_t WS_XS = 1542 * MiB;
constexpr size_t WS_HID = 1814 * MiB;
constexpr size_t WS_YS = 2086 * MiB;
constexpr size_t WS_HB8L = 2358 * MiB;
constexpr size_t WS_END = 2390 * MiB;
static_assert((size_t)MPAD * 2048 == 272 * MiB, "sorted buffers");
constexpr int CW_TMO = 0, CW_CODE = 1, CW_BAR = 4096, CW_CNT = 8192;

constexpr int RING_OFF = 0, RING_BYTES = 131072;
constexpr int LDSCTL_OFF = RING_BYTES;
constexpr int LDS_BYTES = 163840;
constexpr int LC_MISC = 0;
constexpr int LC_PSTART = 128;
constexpr int LC_ULIST = 384;
constexpr int LC_CNT = 640;
constexpr int LC_BASE = 768;
constexpr int LC_SELE = 1024;
constexpr int LC_SELS = 1024 + 2048;
constexpr int LC_COS64 = 5120;
constexpr int LC_ROWS = 6144;
constexpr int LC_LG = 16384;

constexpr int NWAVES = 8;
constexpr int N_PHASES = 1 + 10 * NL;

typedef float f32x2_t __attribute__((ext_vector_type(2))); typedef __bf16 bf16x2_t __attribute__((ext_vector_type(2)));
__device__ __forceinline__ unsigned cvtpk2(float lo, float hi) { f32x2_t v = {lo, hi}; bf16x2_t b = __builtin_convertvector(v, bf16x2_t); return __builtin_bit_cast(unsigned, b); }
#define pk2(lo, hi) cvtpk2((lo), (hi))
__device__ __forceinline__ unsigned pk4_fp8(float a, float b, float c, float d) { int w = 0; w = __builtin_amdgcn_cvt_pk_fp8_f32(a, b, w, false); w = __builtin_amdgcn_cvt_pk_fp8_f32(c, d, w, true); return (unsigned)w; }
constexpr float W8_SCALE = 64.f, W8_INV = 1.f / 64.f;
#define f2bf(x) (cvtpk2((x), 0.f) & 0xffffu)
__device__ __forceinline__ float bf2f(unsigned short b) { return __uint_as_float((unsigned)b << 16); }
__device__ __forceinline__ float wave_sum(float v) {
#pragma unroll
    for (int o = 1; o < 64; o <<= 1) v += __shfl_xor(v, o);
    return v;
}
typedef unsigned short u16x8 __attribute__((ext_vector_type(8)));
typedef unsigned short u16x4 __attribute__((ext_vector_type(4)));

typedef float f32x2v __attribute__((ext_vector_type(2)));
__device__ __forceinline__ void tr_task(const float* W, int K, int Nsrc, int srcn, bf16* WT, int dst_n, int k0) {
#pragma unroll 1
    for (int hf = 0; hf < 2; ++hf) { const int kk = k0 + hf * 64; f32x2v v[64];
        if (srcn >= 0) { const float* p = W + (size_t)kk * Nsrc + srcn;
#pragma unroll
            for (int i = 0; i < 64; ++i) v[i] = __builtin_nontemporal_load((const f32x2v*)(p + (size_t)i * Nsrc)); }
        else {
#pragma unroll
            for (int i = 0; i < 64; ++i) v[i] = (f32x2v){0.f, 0.f}; }
        bf16* o0 = WT + (size_t)dst_n * K + kk; bf16* o1 = o0 + K;
#pragma unroll
        for (int j = 0; j < 8; ++j) { v4u w0, w1;
            w0.x = pk2(v[8 * j].x, v[8 * j + 1].x); w0.y = pk2(v[8 * j + 2].x, v[8 * j + 3].x); w0.z = pk2(v[8 * j + 4].x, v[8 * j + 5].x); w0.w = pk2(v[8 * j + 6].x, v[8 * j + 7].x);
            w1.x = pk2(v[8 * j].y, v[8 * j + 1].y); w1.y = pk2(v[8 * j + 2].y, v[8 * j + 3].y); w1.z = pk2(v[8 * j + 4].y, v[8 * j + 5].y); w1.w = pk2(v[8 * j + 6].y, v[8 * j + 7].y);
            *(v4u*)(o0 + 8 * j) = w0; *(v4u*)(o1 + 8 * j) = w1; } }
}

#define RC(l, j) (((j) >> 1) * 512 + 8 * (l) + ((j) & 1) * 4)
__device__ __forceinline__ void row_load_bf16(f32x4 (&v)[4], const bf16* row, int lane) {
#pragma unroll
    for (int h = 0; h < 2; ++h) { const v4u t = *(const v4u*)(row + h * 512 + 8 * lane);
        v[2 * h] = (f32x4){__uint_as_float(t.x << 16), __uint_as_float(t.x & 0xffff0000u), __uint_as_float(t.y << 16), __uint_as_float(t.y & 0xffff0000u)};
        v[2 * h + 1] = (f32x4){__uint_as_float(t.z << 16), __uint_as_float(t.z & 0xffff0000u), __uint_as_float(t.w << 16), __uint_as_float(t.w & 0xffff0000u)}; }
}
__device__ __forceinline__ void row_store_bf16(const f32x4 (&v)[4], bf16* row, int lane) {
#pragma unroll
    for (int h = 0; h < 2; ++h) { v4u w; w.x = pk2(v[2 * h].x, v[2 * h].y); w.y = pk2(v[2 * h].z, v[2 * h].w); w.z = pk2(v[2 * h + 1].x, v[2 * h + 1].y); w.w = pk2(v[2 * h + 1].z, v[2 * h + 1].w); *(v4u*)(row + h * 512 + 8 * lane) = w; }
}
__device__ __forceinline__ void ln_row8(f32x4 (&v)[4], const f32x4 (&gam)[4], const f32x4 (&bet)[4]) {
    float s = 0.f;
#pragma unroll
    for (int j = 0; j < 4; ++j) s += (v[j].x + v[j].y) + (v[j].z + v[j].w);
    const float mean = wave_sum(s) * (1.f / DM); float s2 = 0.f;
#pragma unroll
    for (int j = 0; j < 4; ++j) { v[j] = v[j] - mean; s2 += (v[j].x * v[j].x + v[j].y * v[j].y) + (v[j].z * v[j].z + v[j].w * v[j].w); }
    const float rstd = __builtin_amdgcn_rsqf(wave_sum(s2) * (1.f / DM) + LN_EPS);
#pragma unroll
    for (int j = 0; j < 4; ++j) v[j] = v[j] * rstd * gam[j] + bet[j];
}

constexpr int GM_QF = 0, GM_KF = 5120, GM_QB = 10240, GM_KB = 15360, GM_VT = 20480, GM_P = 29696, GM_HTF = 38912, GM_HTB = 44032, GM_DL = 38912, GM_RG = 49152, GM_SLOT = 65536;
#define LBAR() asm volatile("s_waitcnt lgkmcnt(0)\n\ts_barrier" ::: "memory")
static_assert(2 * GM_SLOT <= RING_BYTES, "two GLA chunk images fit the phase scratch");
#define MFMA16(a, b, c) __builtin_amdgcn_mfma_f32_16x16x32_bf16((a), (b), (c), 0, 0, 0)
template <bool OUT>
__device__ __forceinline__ void gla_stage_mfma(LAS unsigned char* Ls, const bf16* PROJ, const float* LA, const float* HIN, size_t tok0, int hd, int w4, int lane) {
    if (w4 < 2) { const int dir = w4, g = lane >> 3, c4 = (lane & 7) * 4; f32x4 bc[8]; u16x4 kx[8], qx[8];
        const float* lap = LA + (tok0 + 8 * g) * 256 + dir * 128 + hd * 32 + c4; const bf16* xp = PROJ + (tok0 + 8 * g) * INP + hd * 32 + c4;
#pragma unroll
        for (int i = 0; i < 8; ++i) { bc[i] = *(const f32x4*)(lap + (size_t)i * 256); kx[i] = *(const u16x4*)(xp + (size_t)i * INP + C_GK); if (OUT) qx[i] = *(const u16x4*)(xp + (size_t)i * INP + C_GQ); }
        f32x4 inc;
        if (dir == 0) {
#pragma unroll
            for (int i = 1; i < 8; ++i) bc[i] = bc[i] + bc[i - 1];
            inc = bc[7];
#pragma unroll
            for (int o = 1; o < 8; o <<= 1) { f32x4 y; y.x = __shfl_up(inc.x, 8 * o); y.y = __shfl_up(inc.y, 8 * o); y.z = __shfl_up(inc.z, 8 * o); y.w = __shfl_up(inc.w, 8 * o); if (g >= o) inc = inc + y; }
            const f32x4 off = inc - bc[7];
#pragma unroll
            for (int i = 0; i < 8; ++i) bc[i] = bc[i] + off; }
        else {
#pragma unroll
            for (int i = 6; i >= 0; --i) bc[i] = bc[i] + bc[i + 1];
            inc = bc[0];
#pragma unroll
            for (int o = 1; o < 8; o <<= 1) { f32x4 y; y.x = __shfl_down(inc.x, 8 * o); y.y = __shfl_down(inc.y, 8 * o); y.z = __shfl_down(inc.z, 8 * o); y.w = __shfl_down(inc.w, 8 * o); if (g + o < 8) inc = inc + y; }
            const f32x4 off = inc - bc[0];
#pragma unroll
            for (int i = 0; i < 8; ++i) bc[i] = bc[i] + off; }
        if (OUT) { LAS bf16* qd = (LAS bf16*)(Ls + (dir ? GM_QB : GM_QF)) + (8 * g) * 40 + c4; LAS bf16* kd = (LAS bf16*)(Ls + (dir ? GM_KB : GM_KF)) + (8 * g) * 40 + c4;
#pragma unroll
            for (int i = 0; i < 8; ++i) { float qv[4], kv[4];
#pragma unroll
                for (int c = 0; c < 4; ++c) { const float e_ = __expf(fmaxf(bc[i][c], -60.f)); qv[c] = bf2f(qx[i][c]) * GLA_QSCALE * e_; kv[c] = bf2f(kx[i][c]) * __builtin_amdgcn_rcpf(e_); }
                *(LAS unsigned long long*)(qd + i * 40) = (unsigned long long)pk2(qv[0], qv[1]) | ((unsigned long long)pk2(qv[2], qv[3]) << 32);
                *(LAS unsigned long long*)(kd + i * 40) = (unsigned long long)pk2(kv[0], kv[1]) | ((unsigned long long)pk2(kv[2], kv[3]) << 32); } }
        else { LAS bf16* kt = (LAS bf16*)(Ls + GM_P + dir * 4608) + c4 * 72 + 8 * g;
#pragma unroll
            for (int c = 0; c < 4; ++c) { float t[8];
#pragma unroll
                for (int i = 0; i < 8; ++i) t[i] = bf2f(kx[i][c]) * __expf(fminf(-bc[i][c], 60.f));
                v4u w; w.x = pk2(t[0], t[1]); w.y = pk2(t[2], t[3]); w.z = pk2(t[4], t[5]); w.w = pk2(t[6], t[7]); *(LAS v4u*)(kt + c * 72) = w; }
            if (g == (dir ? 0 : 7)) { const f32x4 tot = dir ? bc[0] : bc[7]; LAS float* dl = (LAS float*)(Ls + GM_DL) + dir * 32 + c4; dl[0] = __expf(tot.x); dl[1] = __expf(tot.y); dl[2] = __expf(tot.z); dl[3] = __expf(tot.w); } } }
    else if (w4 == 2) { const int g = lane >> 3, v0 = (lane & 7) * 8; u16x8 x[8]; const bf16* xp = PROJ + (tok0 + 8 * g) * INP + C_GV + hd * 64 + v0;
#pragma unroll
        for (int i = 0; i < 8; ++i) x[i] = *(const u16x8*)(xp + (size_t)i * INP);
        u16x8 rgx[8];
        if (OUT) { const bf16* rp = PROJ + (tok0 + 8 * g) * INP + C_GR + hd * 64 + v0;
#pragma unroll
            for (int i = 0; i < 8; ++i) rgx[i] = *(const u16x8*)(rp + (size_t)i * INP); }
        LAS bf16* dst = (LAS bf16*)(Ls + GM_VT) + v0 * 72 + 8 * g;
#pragma unroll
        for (int c = 0; c < 8; ++c) { v4u w; w.x = (unsigned)x[0][c] | ((unsigned)x[1][c] << 16); w.y = (unsigned)x[2][c] | ((unsigned)x[3][c] << 16); w.z = (unsigned)x[4][c] | ((unsigned)x[5][c] << 16); w.w = (unsigned)x[6][c] | ((unsigned)x[7][c] << 16);
            *(LAS v4u*)(dst + c * 72) = w; }
        if (OUT) { LAS bf16* rd = (LAS bf16*)(Ls + GM_RG) + (8 * g) * 72 + v0;
#pragma unroll
            for (int i = 0; i < 8; ++i) *(LAS u16x8*)(rd + i * 72) = rgx[i]; } }
    else if (OUT) {
#pragma unroll
        for (int dir = 0; dir < 2; ++dir) { const f32x4* src = (const f32x4*)(HIN + ((size_t)dir * 64 + lane) * 32); LAS bf16* dst = (LAS bf16*)(Ls + (dir ? GM_HTB : GM_HTF)) + lane * 40;
#pragma unroll
            for (int c8 = 0; c8 < 4; ++c8) { const f32x4 a_ = src[2 * c8], b_ = src[2 * c8 + 1]; v4u w; w.x = pk2(a_.x, a_.y); w.y = pk2(a_.z, a_.w); w.z = pk2(b_.x, b_.y); w.w = pk2(b_.z, b_.w); *(LAS v4u*)(dst + c8 * 8) = w; } } }
}

typedef float f32x16 __attribute__((ext_vector_type(16)));
typedef short s16x4 __attribute__((ext_vector_type(4)));
__device__ __forceinline__ bf16x8 pack_step(const f32x16& x, int s) { v4u p; p.x = cvtpk2(x[8 * s], x[8 * s + 1]); p.y = cvtpk2(x[8 * s + 2], x[8 * s + 3]); p.z = cvtpk2(x[8 * s + 4], x[8 * s + 5]); p.w = cvtpk2(x[8 * s + 6], x[8 * s + 7]); return __builtin_bit_cast(bf16x8, p); }
__device__ __forceinline__ int crow16(int i, int h) { return (i & 3) + 8 * (i >> 2) + 4 * h; }
#define MFMA32(a, b, c) __builtin_amdgcn_mfma_f32_32x32x16_bf16((a), (b), (c), 0, 0, 0)
constexpr int FT_PITCH = 72, FT_TAB = 64 * FT_PITCH;
constexpr int FFT_LDS_TAB = 0, FFT_LDS_TW = 28672, FFT_LDS_HT = 28672, FFT_HT_PAIR = 2 * 64 * FT_PITCH * 2;

struct Args { const float* in[20]; float* out; unsigned char* ws; int ph_lo, ph_hi; };
static_assert(sizeof(Args) == 20 * 8 + 8 + 8 + 8, "no padding bytes in Args");


typedef __attribute__((address_space(4))) const unsigned char* kptr_t;
__device__ __forceinline__ kptr_t karg() { kptr_t p = (kptr_t)__builtin_amdgcn_kernarg_segment_ptr(); asm volatile("" : "+s"(p)); return p; }
#define KIN(i) (*(const float* const __attribute__((address_space(4)))*)(karg() + 8 * (i)))
#define KOUT() (*(float* const __attribute__((address_space(4)))*)(karg() + 160))
#define KWS() (*(unsigned char* const __attribute__((address_space(4)))*)(karg() + 168))
#define WSP(T, off) ((T*)(ws + (off)))

#ifndef NAIVE_ATTN
#define NAIVE_ATTN 0
#ifndef P2_TOKB
#define P2_TOKB 8
#endif
#ifndef P6_ROWS
#define P6_ROWS 16
#endif
#ifndef P3_BATCH
#define P3_BATCH 32
#endif
#endif

__global__ void __launch_bounds__(NWAVES * 64, 2) fwd(Args args) {
    extern __shared__ __attribute__((aligned(16))) unsigned char lds_raw[];
    LAS unsigned char* lds = (LAS unsigned char*)lds_raw;
    LAS unsigned char* lctl = lds + LDSCTL_OFF;
    const int G = gridDim.x, bx = blockIdx.x;
    const int NGW = G * NWAVES, NGT = G * NWAVES * 64;
#define TID_SETUP() int tid_ = threadIdx.x; asm volatile("" : "+v"(tid_)); const int tid = tid_, lane = tid & 63, wave = __builtin_amdgcn_readfirstlane(tid >> 6); \
    const int gw = bx * NWAVES + wave, gt = bx * (NWAVES * 64) + tid; (void)lane; (void)gw; (void)gt
    for (int u = threadIdx.x; u < (LDS_BYTES - LDSCTL_OFF) / 4; u += NWAVES * 64) ((LAS unsigned*)lctl)[u] = 0u;
    __syncthreads();
    volatile LAS unsigned* MISC = (volatile LAS unsigned*)(lctl + LC_MISC);
    XcdBarrier bar = xcd_barrier_post((unsigned*)(KWS() + WS_CTL) + CW_BAR, MISC + 8);
    const int lo = args.ph_lo, hi = args.ph_hi;
#ifndef PH_OFF
#define PH_OFF 0
#endif
#define PON(j) (!((PH_OFF >> (j)) & 1))
#define IN(k) (lo <= (k) && (k) < hi)
#ifndef PROBE_A
#define PROBE_A -1
#endif
#ifndef PROBE_B
#define PROBE_B -1
#endif
#if PROBE_A >= 0
#define STAMP(k) do { if (blockIdx.x == 0 && threadIdx.x == 0) { ((unsigned long long*)(KWS() + WS_CTL + 65536))[(k)] = __builtin_amdgcn_s_memrealtime(); } } while (0)
#define STAMP2(i) do { __syncthreads(); if (blockIdx.x == 0 && threadIdx.x == 0) { ((unsigned long long*)(KWS() + WS_CTL + 65536))[128 + l * 16 + (i)] = __builtin_amdgcn_s_memrealtime(); } } while (0)
#else
#define STAMP(k) do {} while (0)
#define STAMP2(i) do {} while (0)
#endif
#ifndef PROBE_SUB_A
#define PROBE_SUB_A -1
#define PROBE_SUB_B -1
#endif
#define SEAM(k) do { if (IN(k) && IN((k) + 1)) xcd_barrier(bar); STAMP((k) + 1); } while (0)
    STAMP(0);

    if (IN(0) && PON(0)) {
        TID_SETUP(); unsigned char* ws = KWS(); const float* x_in = KIN(0); const float* ln_in_g = KIN(1); const float* ln_in_b = KIN(2); const float* w_in = KIN(3); const float* w_out = KIN(9);
        const float* exp_w_gu = KIN(14); const float* exp_w_down = KIN(16);
        float* ROPE = WSP(float, WS_ROPE); bf16* WIN_T = WSP(bf16, WS_WIN_T); bf16* WOUT_T = WSP(bf16, WS_WOUT_T); bf16* WGU_T = WSP(bf16, WS_WGU_T); bf16* WDN_T = WSP(bf16, WS_WDN_T);
        bf16* HB = WSP(bf16, WS_HB); unsigned char* HB8L = WSP(unsigned char, WS_HB8L);
        { LAS unsigned* Lt = (LAS unsigned*)(lds + RING_OFF);
          constexpr int T_WIN = NL * 16 * 2, T_WOUT = NL * 8 * 4, T_WGU = NL * NE * 16 * 2, T_WDN = NL * NE * 8 * 2, NTILE = T_WIN + T_WOUT + T_WGU + T_WDN;
#define P0_DECODE_AND_LOAD(IT) do { int r = (IT); const float* W; int Nsrc, mode; \
            if (r < T_WIN) { const int l_ = r / 32, q = r % 32; nb = q / 2; kq = q % 2; W = w_in + (size_t)l_ * DM * INW; WT = (unsigned char*)WIN_T + (size_t)l_ * INP * DM; Nsrc = INW; mode = 0; f8 = 1; } \
            else if ((r -= T_WIN) < T_WOUT) { const int l_ = r / 32, q = r % 32; nb = q / 4; kq = q % 4; W = w_out + (size_t)l_ * DM * DM; WT = (unsigned char*)(WOUT_T + (size_t)l_ * DM * DM); Nsrc = DM; mode = 1; f8 = 0; } \
            else if ((r -= T_WOUT) < T_WGU) { const int le = r / 32, q = r % 32; nb = q / 2; kq = q % 2; W = exp_w_gu + (size_t)le * DM * 2048; WT = (unsigned char*)WGU_T + (size_t)le * 2048 * DM; Nsrc = 2048; mode = 2; f8 = 1; } \
            else { r -= T_WGU; const int le = r / 16, q = r % 16; nb = q / 2; kq = q % 2; W = exp_w_down + (size_t)le * DE * DM; WT = (unsigned char*)WDN_T + (size_t)le * DM * DE; Nsrc = DM; mode = 1; f8 = 1; } \
            const int n = nb * 128 + 2 * lane; int src = n; \
            if (mode == 0) src = n < 1536 ? n : (n < 1792 ? n + 32 : (n < 1824 ? n - 256 : -1)); \
            else if (mode == 2) { const int pn = n >> 8, bj = (n >> 7) & 1, j = n & 127; src = bj * 1024 + pn * 128 + j; } \
            if (f8 && src >= 0) { const float* p = W + (size_t)(kq * 512 + 64 * wave) * Nsrc + src; \
                _Pragma("unroll") for (int i = 0; i < 64; ++i) v[i] = __builtin_nontemporal_load((const f32x2v*)(p + (size_t)i * Nsrc)); } \
            else if (f8) { _Pragma("unroll") for (int i = 0; i < 64; ++i) v[i] = (f32x2v){0.f, 0.f}; } \
            else if (src >= 0) { const float* p = W + (size_t)(kq * 256 + 32 * wave) * Nsrc + src; \
                _Pragma("unroll") for (int i = 0; i < 32; ++i) v[i] = __builtin_nontemporal_load((const f32x2v*)(p + (size_t)i * Nsrc)); } \
            else { _Pragma("unroll") for (int i = 0; i < 32; ++i) v[i] = (f32x2v){0.f, 0.f}; } } while (0)
          f32x2v v[64]; unsigned char* WT; int nb, kq, f8;
          if (bx < NTILE) P0_DECODE_AND_LOAD(bx);
          for (int it = bx; it < NTILE; it += G) {
            __syncthreads();
            if (f8) {
#pragma unroll
                for (int i4 = 0; i4 < 16; ++i4) { Lt[(2 * lane) * 129 + 16 * wave + i4] = pk4_fp8(v[4 * i4].x * W8_SCALE, v[4 * i4 + 1].x * W8_SCALE, v[4 * i4 + 2].x * W8_SCALE, v[4 * i4 + 3].x * W8_SCALE);
                    Lt[(2 * lane + 1) * 129 + 16 * wave + i4] = pk4_fp8(v[4 * i4].y * W8_SCALE, v[4 * i4 + 1].y * W8_SCALE, v[4 * i4 + 2].y * W8_SCALE, v[4 * i4 + 3].y * W8_SCALE); } }
            else {
#pragma unroll
                for (int i2 = 0; i2 < 16; ++i2) { Lt[(2 * lane) * 129 + 16 * wave + i2] = pk2(v[2 * i2].x, v[2 * i2 + 1].x); Lt[(2 * lane + 1) * 129 + 16 * wave + i2] = pk2(v[2 * i2].y, v[2 * i2 + 1].y); } }
            __syncthreads();
            unsigned char* const WTc = WT; const int nbc = nb, kqc = kq; const int pitchc = f8 ? 1024 : 2048;
            if (it + G < NTILE) P0_DECODE_AND_LOAD(it + G);
            const int p4 = (lane & 31) * 4;
#pragma unroll
            for (int j = 0; j < 8; ++j) { const int row = 16 * wave + 2 * j + (lane >> 5); const LAS unsigned* lp = Lt + row * 129 + p4; v4u o; o.x = lp[0]; o.y = lp[1]; o.z = lp[2]; o.w = lp[3];
                *(v4u*)(WTc + (size_t)(nbc * 128 + row) * pitchc + kqc * 512 + 4 * p4) = o; }
          }
#undef P0_DECODE_AND_LOAD
          __syncthreads(); }
        { bf16* FTAB = WSP(bf16, WS_FTAB); float* TW = WSP(float, WS_TW);
          for (int it = gt; it < 3 * FT_TAB; it += NGT) { const int t = it / FT_TAB, q = it % FT_TAB, row = q / FT_PITCH, col = q % FT_PITCH; float sn, cs; sincospif((float)((row * col) & 63) * (1.0f / 32.0f), &sn, &cs);
              const float v = col >= 64 ? 0.f : (t == 0 ? cs : (t == 1 ? sn : -sn)); FTAB[it] = (bf16)f2bf(v); }
          for (int it = gt; it < 4096; it += NGT) { float sn, cs; sincospif((float)it * (1.0f / 2048.0f), &sn, &cs); TW[2 * it] = cs; TW[2 * it + 1] = -sn; } }
        { const float* router_w = KIN(12); bf16* RWT = WSP(bf16, WS_RWT);
          for (int it = gt; it < NL * NE * DM; it += NGT) { const int k = it & (DM - 1), e = (it >> 10) & 31, l = it >> 15; const float w = router_w[((size_t)l * DM + k) * NE + e];
              const unsigned hi = f2bf(w); const float lo = w - __uint_as_float(hi << 16); RWT[((size_t)(l * 2 + 0) * NE + e) * DM + k] = (bf16)hi; RWT[((size_t)(l * 2 + 1) * NE + e) * DM + k] = (bf16)f2bf(lo); } }
        for (int it = gt; it < SEQ * 32; it += NGT) { const int t = it >> 5, i = it & 31, a = i >> 4, f = i & 15; const int pos = a ? (t & 63) : (t >> 6);
            const double inv = exp(-9.210340371976184 * (double)f / 16.0); const double ang = (double)pos * inv;
            ROPE[it] = (float)cos(ang); ROPE[SEQ * 32 + it] = (float)sin(ang); }
        { f32x4 gam[4], bet[4];
#pragma unroll
          for (int j = 0; j < 4; ++j) { gam[j] = *(const f32x4*)(ln_in_g + RC(lane, j)); bet[j] = *(const f32x4*)(ln_in_b + RC(lane, j)); }
          for (int m0 = gw; m0 < NTOK; m0 += 2 * NGW) { f32x4 v[2][4];
#pragma unroll
            for (int q = 0; q < 2; ++q)
#pragma unroll
                for (int j = 0; j < 4; ++j) v[q][j] = *(const f32x4*)(x_in + (size_t)(m0 + q * NGW) * DM + RC(lane, j));
#pragma unroll
            for (int q = 0; q < 2; ++q) { ln_row8(v[q], gam, bet); row_store_bf16(v[q], HB + (size_t)(m0 + q * NGW) * DM, lane);
#pragma unroll
                for (int h = 0; h < 2; ++h) *(unsigned long long*)(HB8L + (size_t)(m0 + q * NGW) * DM + h * 512 + 8 * lane) = (unsigned long long)pk4_fp8(v[q][2 * h].x, v[q][2 * h].y, v[q][2 * h].z, v[q][2 * h].w) | ((unsigned long long)pk4_fp8(v[q][2 * h + 1].x, v[q][2 * h + 1].y, v[q][2 * h + 1].z, v[q][2 * h + 1].w) << 32); } } }
    }
    SEAM(0);

    for (int l = 0; l < NL; ++l) {
        const int pb = 1 + 10 * l;
        if (IN(pb + 0) && PON(1)) {
            TID_SETUP(); unsigned char* ws = KWS(); const unsigned char* HB8L = WSP(unsigned char, WS_HB8L); const unsigned char* WIN8 = WSP(unsigned char, WS_WIN_T); bf16* PROJ = WSP(bf16, WS_PROJ);
            pg8::Gemm g{(const pg8::bf16_t*)HB8L, (const pg8::bf16_t*)(WIN8 + (size_t)l * INP * DM), NTOK, INP, DM}; pg8::StaticOrder S; S.init(NTOK, INP, G, bx);
            pg8::EpiPlain8 E{PROJ, INP};
            STAMP2(2);
            pg8::gemm_phase_fp8<pg8::EpiPlain8, pg8::StaticOrder, true, false>(lds + RING_OFF, g, S, E, nullptr);
            STAMP2(3);
        }
        SEAM(pb + 0);
        if (IN(pb + 1) && PON(2)) {
            TID_SETUP(); unsigned char* ws = KWS(); const float* att_q_gain = KIN(4); const float* att_k_gain = KIN(5); const float* gla_gate_w = KIN(6); const float* gla_gate_b = KIN(7);
            const float* ROPE = WSP(float, WS_ROPE); const bf16* PROJ = WSP(bf16, WS_PROJ); bf16* QB = WSP(bf16, WS_QB); bf16* KB = WSP(bf16, WS_KB); float* LA = WSP(float, WS_LA);
            STAMP2(8);
            { LAS float* RTC = (LAS float*)(lds + RING_OFF + 65536);
              for (int i = tid; i < 1024; i += NWAVES * 64) { const int pos = i >> 4, f = i & 15; RTC[i] = ROPE[(pos * 64) * 32 + f]; RTC[1024 + i] = ROPE[SEQ * 32 + (pos * 64) * 32 + f]; RTC[2048 + i] = ROPE[pos * 32 + 16 + f]; RTC[3072 + i] = ROPE[SEQ * 32 + pos * 32 + 16 + f]; }
              __syncthreads();
              const int li = lane & 7, ax = li >> 2, f0 = 8 * (li & 1); const float sg = ((li >> 1) & 1) ? 1.f : -1.f;
              f32x4 qg8[2], kg8[2];
#pragma unroll
              for (int c = 0; c < 2; ++c) { qg8[c] = *(const f32x4*)(att_q_gain + l * 64 + 8 * li + 4 * c); kg8[c] = *(const f32x4*)(att_k_gain + l * 64 + 8 * li + 4 * c); }
              for (int m0 = gw; m0 < NTOK; m0 += 4 * NGW) { v4u xp[5];
#pragma unroll
                for (int i = 0; i < 5; ++i) { const int P = lane + 64 * i, q = P / 80, p = P % 80; xp[i] = *(const v4u*)(PROJ + (size_t)(m0 + q * NGW) * INP + p * 8); }
#pragma unroll
                for (int i = 0; i < 5; ++i) { const int P = lane + 64 * i, q = P / 80, p = P % 80, head = p >> 3; const size_t m = (size_t)(m0 + q * NGW); const int t = (int)(m & (SEQ - 1));
                    float xv[8] = {__uint_as_float(xp[i].x << 16), __uint_as_float(xp[i].x & 0xffff0000u), __uint_as_float(xp[i].y << 16), __uint_as_float(xp[i].y & 0xffff0000u),
                                   __uint_as_float(xp[i].z << 16), __uint_as_float(xp[i].z & 0xffff0000u), __uint_as_float(xp[i].w << 16), __uint_as_float(xp[i].w & 0xffff0000u)};
                    float ss = 0.f;
#pragma unroll
                    for (int c = 0; c < 8; ++c) ss += xv[c] * xv[c];
                    ss += __shfl_xor(ss, 1); ss += __shfl_xor(ss, 2); ss += __shfl_xor(ss, 4);
                    const float rs = __builtin_amdgcn_rsqf(ss * (1.f / 64.f) + RMS_EPS); const bool isq = head < 8;
                    const LAS float* tb = RTC + (ax ? 2048 : 0) + (ax ? (t & 63) : (t >> 6)) * 16 + f0;
                    const f32x4 c0 = *(const LAS f32x4*)tb, c1 = *(const LAS f32x4*)(tb + 4), s0 = *(const LAS f32x4*)(tb + 1024), s1 = *(const LAS f32x4*)(tb + 1028);
                    const float csv[8] = {c0.x, c0.y, c0.z, c0.w, c1.x, c1.y, c1.z, c1.w}, snv[8] = {s0.x, s0.y, s0.z, s0.w, s1.x, s1.y, s1.z, s1.w};
                    const f32x4 g0 = isq ? qg8[0] : kg8[0], g1 = isq ? qg8[1] : kg8[1]; const float gv[8] = {g0.x, g0.y, g0.z, g0.w, g1.x, g1.y, g1.z, g1.w};
                    const float osc = isq ? QSCALE * 8.f : 1.f; float o[8];
#pragma unroll
                    for (int c = 0; c < 8; ++c) { const float xn = xv[c] * rs * gv[c]; const float pr = __shfl_xor(xn, 2); o[c] = (xn * csv[c] + sg * pr * snv[c]) * osc; }
                    const unsigned long long w8 = (unsigned long long)pk4_fp8(o[0], o[1], o[2], o[3]) | ((unsigned long long)pk4_fp8(o[4], o[5], o[6], o[7]) << 32);
                    const int r_ = (int)(m & 63), c_ = li >> 1;
                    unsigned char* dst = isq ? ((unsigned char*)QB + m * 512 + head * 64 + 8 * li)
                                             : ((unsigned char*)KB + (size_t)((((m >> 12) * 2 + (head - 8)) * 64 + ((m & 4095) >> 6))) * 4096 + r_ * 64 + ((c_ ^ ((r_ >> 2) & 3)) * 16) + (li & 1) * 8);
                    *(unsigned long long*)dst = w8; } }
              const float* gw_l = gla_gate_w + (size_t)l * 2 * 16 * 128; const float* gb_l = gla_gate_b + (size_t)l * 2 * 128; const int dir = lane >> 5, kc = (lane & 31) * 4;
              f32x4 gwr[16]; const f32x4 gbv = *(const f32x4*)(gb_l + dir * 128 + kc);
#pragma unroll
              for (int r = 0; r < 16; ++r) gwr[r] = *(const f32x4*)(gw_l + (size_t)(dir * 16 + r) * 128 + kc);
              for (int m0 = gw; m0 < NTOK; m0 += P2_TOKB * NGW) { v4u gl[P2_TOKB][2];
#pragma unroll
                for (int q = 0; q < P2_TOKB; ++q) { const bf16* gp = PROJ + (size_t)(m0 + q * NGW) * INP + C_GLR + dir * 16; gl[q][0] = *(const v4u*)gp; gl[q][1] = *(const v4u*)(gp + 8); }
#pragma unroll
                for (int q = 0; q < P2_TOKB; ++q) { const size_t m = (size_t)(m0 + q * NGW); f32x4 z = gbv;
                    const unsigned gu[8] = {gl[q][0].x, gl[q][0].y, gl[q][0].z, gl[q][0].w, gl[q][1].x, gl[q][1].y, gl[q][1].z, gl[q][1].w};
#pragma unroll
                    for (int r2 = 0; r2 < 8; ++r2) { z = z + gwr[2 * r2] * __uint_as_float(gu[r2] << 16); z = z + gwr[2 * r2 + 1] * __uint_as_float(gu[r2] & 0xffff0000u); }
                    f32x4 o4;
#pragma unroll
                    for (int i = 0; i < 4; ++i) o4[i] = (fminf(z[i], 0.f) - __logf(1.f + __expf(-fabsf(z[i])))) * (1.f / 16.f);
                    *(f32x4*)(LA + m * 256 + dir * 128 + kc) = o4; } }
              __syncthreads(); }
            STAMP2(4);
            { __syncthreads();
              { const v4u* src = (const v4u*)WSP(bf16, WS_FTAB); LAS v4u* dst = (LAS v4u*)(lds + RING_OFF + FFT_LDS_TAB); for (int i = tid; i < 3 * FT_TAB * 2 / 16; i += NWAVES * 64) dst[i] = src[i];
                const v4u* s2_ = (const v4u*)WSP(float, WS_TW); LAS v4u* d2_ = (LAS v4u*)(lds + RING_OFF + FFT_LDS_TW); for (int i = tid; i < 4096 * 8 / 16; i += NWAVES * 64) d2_[i] = s2_[i]; }
              __syncthreads();
              const LAS bf16* FT = (const LAS bf16*)(lds + RING_OFF + FFT_LDS_TAB); const LAS float* TWL = (const LAS float*)(lds + RING_OFF + FFT_LDS_TW); bf16* FTMP = WSP(bf16, WS_FTMP);
              const int pair = wave >> 1, cb = wave & 1, r = lane & 31, h = lane >> 5;
              for (int ub = bx; ub < NB * 4 * 64 / 4; ub += G) { const int u = ub * 4 + pair, s2 = u & 63, g4 = (u >> 6) & 3, b = u >> 8;
                bf16x8 xa[2][4];
#pragma unroll
                for (int R = 0; R < 2; ++R)
#pragma unroll
                    for (int ks = 0; ks < 4; ++ks) xa[R][ks] = *(const bf16x8*)(PROJ + ((size_t)b * SEQ + 64 * (32 * R + r) + s2) * INP + C_FX + g4 * 64 + 16 * ks + 8 * h);
                f32x16 Tr[2], Ti[2];
#pragma unroll
                for (int R = 0; R < 2; ++R)
#pragma unroll
                    for (int i = 0; i < 16; ++i) { Tr[R][i] = 0.f; Ti[R][i] = 0.f; }
#pragma unroll
                for (int ks = 0; ks < 4; ++ks) { const bf16x8 bc = *(const LAS bf16x8*)(FT + (32 * cb + r) * FT_PITCH + 16 * ks + 8 * h), bs = *(const LAS bf16x8*)(FT + 2 * FT_TAB + (32 * cb + r) * FT_PITCH + 16 * ks + 8 * h);
#pragma unroll
                    for (int R = 0; R < 2; ++R) { Tr[R] = MFMA32(xa[R][ks], bc, Tr[R]); Ti[R] = MFMA32(xa[R][ks], bs, Ti[R]); } }
#pragma unroll
                for (int Rp = 0; Rp < 2; ++Rp) { f32x16 Gr, Gi;
#pragma unroll
                    for (int i = 0; i < 16; ++i) { Gr[i] = 0.f; Gi[i] = 0.f; }
#pragma unroll
                    for (int R = 0; R < 2; ++R)
#pragma unroll
                        for (int s_ = 0; s_ < 2; ++s_) { const bf16x8 xr = pack_step(Tr[R], s_), xi = pack_step(Ti[R], s_);
                            const int kb = 32 * R + 16 * s_ + 4 * h, ro = (32 * Rp + r) * FT_PITCH + kb;
                            const s16x4 c0 = *(const LAS s16x4*)(FT + ro), c1 = *(const LAS s16x4*)(FT + ro + 8), s0 = *(const LAS s16x4*)(FT + FT_TAB + ro), s1 = *(const LAS s16x4*)(FT + FT_TAB + ro + 8),
                                        n0 = *(const LAS s16x4*)(FT + 2 * FT_TAB + ro), n1 = *(const LAS s16x4*)(FT + 2 * FT_TAB + ro + 8);
                            const bf16x8 ca = __builtin_shufflevector(c0, c1, 0, 1, 2, 3, 4, 5, 6, 7), sa = __builtin_shufflevector(s0, s1, 0, 1, 2, 3, 4, 5, 6, 7), na = __builtin_shufflevector(n0, n1, 0, 1, 2, 3, 4, 5, 6, 7);
                            Gr = MFMA32(ca, xr, Gr); Gr = MFMA32(sa, xi, Gr); Gi = MFMA32(ca, xi, Gi); Gi = MFMA32(na, xr, Gi); }
#pragma unroll
                    for (int i = 0; i < 16; ++i) { const int s1p = 32 * Rp + crow16(i, h); const int m = (s2 * s1p) & 4095; const float wr = TWL[2 * m], wi = TWL[2 * m + 1];
                        const size_t o = ((((size_t)(b * 4 + g4) * 64 + s1p) * 2) * 64 + s2) * 64 + 32 * cb + r;
                        FTMP[o] = (bf16)f2bf(Gr[i] * wr - Gi[i] * wi); FTMP[o + 4096] = (bf16)f2bf(Gr[i] * wi + Gi[i] * wr); } }
              }
              __syncthreads(); }
            STAMP2(5);
            { float* GS = WSP(float, WS_OF); float* GD = WSP(float, WS_OB);
              const int slot = wave >> 2, w4 = wave & 3, fr = lane & 15, fq = lane >> 4; LAS unsigned char* Ls = lds + RING_OFF + slot * GM_SLOT;
              for (int ub = bx; ub < NB * 4 * 64 / 2; ub += G) { const int u = ub * 2 + slot, c = u & 63, bh = u >> 6, hd = bh & 3, b = bh >> 2; const size_t tok0 = (size_t)b * SEQ + c * 64;
                LBAR();
                gla_stage_mfma<false>(Ls, PROJ, LA, nullptr, tok0, hd, w4, lane);
                LBAR();
                const LAS bf16* VT = (const LAS bf16*)(Ls + GM_VT); const LAS float* DL = (const LAS float*)(Ls + GM_DL);
#pragma unroll
                for (int dir = 0; dir < 2; ++dir) { const LAS bf16* KT = (const LAS bf16*)(Ls + GM_P + dir * 4608);
#pragma unroll
                    for (int Cd = 0; Cd < 2; ++Cd) { f32x4 acc = {0.f, 0.f, 0.f, 0.f};
#pragma unroll
                        for (int ks = 0; ks < 2; ++ks) { const bf16x8 a_ = *(const LAS bf16x8*)(VT + (16 * w4 + fr) * 72 + 32 * ks + 8 * fq), b_ = *(const LAS bf16x8*)(KT + (16 * Cd + fr) * 72 + 32 * ks + 8 * fq); acc = MFMA16(a_, b_, acc); }
                        const float Dd = DL[dir * 32 + 16 * Cd + fr]; float* o = GS + (((size_t)u * 2 + dir) * 64 + 16 * w4 + 4 * fq) * 32 + 16 * Cd + fr;
#pragma unroll
                        for (int r = 0; r < 4; ++r) o[r * 32] = acc[r] * Dd; } }
                if (w4 == 3) GD[((size_t)u * 2 + (lane >> 5)) * 32 + (lane & 31)] = DL[lane]; }
              __syncthreads(); }
            STAMP2(9);
        }
        SEAM(pb + 1);
        if (IN(pb + 2) && PON(3)) {
            TID_SETUP(); unsigned char* ws = KWS(); float* GS = WSP(float, WS_OF); const float* GD = WSP(float, WS_OB);
            for (int e = gt; e < NB * 4 * 2 * 2048; e += NGT) { const int dv = e & 2047, dir = (e >> 11) & 1, bh = e >> 12, d = dv & 31; float H = 0.f;
                for (int c8 = 0; c8 < 64; c8 += P3_BATCH) { float sv[P3_BATCH], dd[P3_BATCH];
#pragma unroll
                    for (int i = 0; i < P3_BATCH; ++i) { const int c = dir ? 63 - (c8 + i) : (c8 + i); const size_t sidx = ((size_t)(bh * 64 + c) * 2 + dir); sv[i] = GS[sidx * 2048 + dv]; dd[i] = GD[sidx * 32 + d]; }
#pragma unroll
                    for (int i = 0; i < P3_BATCH; ++i) { const int c = dir ? 63 - (c8 + i) : (c8 + i); const size_t sidx = ((size_t)(bh * 64 + c) * 2 + dir); GS[sidx * 2048 + dv] = H; H = H * dd[i] + sv[i]; } } }
        }
        SEAM(pb + 2);
        if (IN(pb + 3) && PON(4)) {
            TID_SETUP(); unsigned char* ws = KWS(); const float* gla_norm_g = KIN(8); const bf16* PROJ = WSP(bf16, WS_PROJ);
            bf16* MIX = WSP(bf16, WS_MIX); const bf16* QB = WSP(bf16, WS_QB); const bf16* KB = WSP(bf16, WS_KB);
            STAMP2(10);
            { __syncthreads();
              { const v4u* src = (const v4u*)WSP(bf16, WS_FTAB); LAS v4u* dst = (LAS v4u*)(lds + RING_OFF + FFT_LDS_TAB); for (int i = tid; i < 3 * FT_TAB * 2 / 16; i += NWAVES * 64) dst[i] = src[i]; }
              const LAS bf16* FT = (const LAS bf16*)(lds + RING_OFF + FFT_LDS_TAB); const bf16* FTMP = WSP(bf16, WS_FTMP);
              const int pair = wave >> 1, cb = wave & 1, r = lane & 31, h = lane >> 5;
              LAS bf16* HT = (LAS bf16*)(lds + RING_OFF + FFT_LDS_HT + pair * FFT_HT_PAIR);
              for (int ub = bx; ub < NB * 4 * 64 / 4; ub += G) { const int u = ub * 4 + pair, s1p = u & 63, g4 = (u >> 6) & 3, b = u >> 8;
                const bf16* src = FTMP + (size_t)u * 2 * 4096;
                LBAR();
#pragma unroll
                for (int q = 0; q < 8; ++q) { const int p = cb * 64 + lane + 128 * q, ri = p >> 9, s2 = (p >> 3) & 63, c0 = (p & 7) * 8; const u16x8 v = *(const u16x8*)(src + p * 8);
#pragma unroll
                    for (int i = 0; i < 8; ++i) HT[(ri * 64 + c0 + i) * FT_PITCH + s2] = v[i]; }
                LBAR();
#pragma unroll
                for (int Rp = 0; Rp < 2; ++Rp) { f32x16 acc;
#pragma unroll
                    for (int i = 0; i < 16; ++i) acc[i] = 0.f;
#pragma unroll
                    for (int ks = 0; ks < 4; ++ks) { const int ko = 16 * ks + 8 * h;
                        const bf16x8 ca = *(const LAS bf16x8*)(FT + (32 * Rp + r) * FT_PITCH + ko), sa = *(const LAS bf16x8*)(FT + FT_TAB + (32 * Rp + r) * FT_PITCH + ko);
                        const bf16x8 hr = *(const LAS bf16x8*)(HT + (32 * cb + r) * FT_PITCH + ko), hi_ = *(const LAS bf16x8*)(HT + (64 + 32 * cb + r) * FT_PITCH + ko);
                        acc = MFMA32(ca, hr, acc); acc = MFMA32(sa, hi_, acc); }
#pragma unroll
                    for (int i = 0; i < 16; ++i) { const int s2p = 32 * Rp + crow16(i, h); MIX[((size_t)b * SEQ + s1p + 64 * s2p) * DM + 768 + g4 * 64 + 32 * cb + r] = (bf16)f2bf(acc[i] * (1.0f / 512.0f)); } }
              }
              __syncthreads(); }
            STAMP2(6);
            { const float* GS = WSP(float, WS_OF); const float* LA = WSP(float, WS_LA);
              const int slot = wave >> 2, w4 = wave & 3, fr = lane & 15, fq = lane >> 4, I0 = 16 * w4; LAS unsigned char* Ls = lds + RING_OFF + slot * GM_SLOT;
              for (int ub = bx; ub < NB * 4 * 64 / 2; ub += G) { const int u = ub * 2 + slot, c = u & 63, bh = u >> 6, hd = bh & 3, b = bh >> 2; const size_t tok0 = (size_t)b * SEQ + c * 64;
                float gnv[4];
#pragma unroll
                for (int Cv = 0; Cv < 4; ++Cv) gnv[Cv] = gla_norm_g[l * 64 + 16 * Cv + fr];
                LBAR();
                gla_stage_mfma<true>(Ls, PROJ, LA, GS + (size_t)u * 2 * 2048, tok0, hd, w4, lane);
                LBAR();
                const LAS bf16* QF = (const LAS bf16*)(Ls + GM_QF); const LAS bf16* KF = (const LAS bf16*)(Ls + GM_KF); const LAS bf16* QBm = (const LAS bf16*)(Ls + GM_QB); const LAS bf16* KBm = (const LAS bf16*)(Ls + GM_KB);
                const LAS bf16* VT = (const LAS bf16*)(Ls + GM_VT); LAS bf16* P = (LAS bf16*)(Ls + GM_P); const LAS bf16* HTF = (const LAS bf16*)(Ls + GM_HTF); const LAS bf16* HTB = (const LAS bf16*)(Ls + GM_HTB);
                const bf16x8 qfa = *(const LAS bf16x8*)(QF + (I0 + fr) * 40 + 8 * fq), qba = *(const LAS bf16x8*)(QBm + (I0 + fr) * 40 + 8 * fq);
#pragma unroll
                for (int Cj = 0; Cj < 4; ++Cj) { const f32x4 z = {0.f, 0.f, 0.f, 0.f};
                    const f32x4 pf = MFMA16(qfa, *(const LAS bf16x8*)(KF + (16 * Cj + fr) * 40 + 8 * fq), z), pb = MFMA16(qba, *(const LAS bf16x8*)(KBm + (16 * Cj + fr) * 40 + 8 * fq), z);
#pragma unroll
                    for (int r = 0; r < 4; ++r) { const int i = I0 + 4 * fq + r, j = 16 * Cj + fr; P[i * 72 + j] = (bf16)f2bf(j <= i ? pf[r] : pb[r]); } }
                asm volatile("s_waitcnt lgkmcnt(0)" ::: "memory");
                f32x4 o[4];
#pragma unroll
                for (int Cv = 0; Cv < 4; ++Cv) { f32x4 acc = {0.f, 0.f, 0.f, 0.f};
#pragma unroll
                    for (int ks = 0; ks < 2; ++ks) acc = MFMA16(*(const LAS bf16x8*)(P + (I0 + fr) * 72 + 32 * ks + 8 * fq), *(const LAS bf16x8*)(VT + (16 * Cv + fr) * 72 + 32 * ks + 8 * fq), acc);
                    acc = MFMA16(qfa, *(const LAS bf16x8*)(HTF + (16 * Cv + fr) * 40 + 8 * fq), acc); acc = MFMA16(qba, *(const LAS bf16x8*)(HTB + (16 * Cv + fr) * 40 + 8 * fq), acc);
                    o[Cv] = acc; }
                float rs[4];
#pragma unroll
                for (int r = 0; r < 4; ++r) { float ss = (o[0][r] * o[0][r] + o[1][r] * o[1][r]) + (o[2][r] * o[2][r] + o[3][r] * o[3][r]);
#pragma unroll
                    for (int m_ = 1; m_ < 16; m_ <<= 1) ss += __shfl_xor(ss, m_);
                    rs[r] = 1.f / sqrtf(ss * (1.f / 64.f) + RMS_EPS); }
                { const LAS unsigned short* RG = (const LAS unsigned short*)(Ls + GM_RG); LAS unsigned short* PO = (LAS unsigned short*)(Ls + GM_P);
#pragma unroll
                  for (int Cv = 0; Cv < 4; ++Cv) { const int v = 16 * Cv + fr; const float gn = gnv[Cv];
#pragma unroll
                    for (int r = 0; r < 4; ++r) { const int i = I0 + 4 * fq + r; const float rg = bf2f(RG[i * 72 + v]);
                        PO[i * 72 + v] = (unsigned short)f2bf(o[Cv][r] * rs[r] * gn * rg * __builtin_amdgcn_rcpf(1.f + __expf(-rg))); } }
                  asm volatile("s_waitcnt lgkmcnt(0)" ::: "memory");
#pragma unroll
                  for (int k = 0; k < 2; ++k) { const int p_ = lane + 64 * k, row = p_ >> 3, ch = p_ & 7; const v4u w = *(const LAS v4u*)(PO + (I0 + row) * 72 + ch * 8);
                      *(v4u*)(MIX + (tok0 + I0 + row) * DM + 512 + hd * 64 + ch * 8) = w; } } }
              __syncthreads(); }
            STAMP2(7);
#if NAIVE_ATTN
            { LAS float* Kt = (LAS float*)(lds + RING_OFF); LAS float* Vt = Kt + 64 * 64;
              for (int unit = bx; unit < NB * 8 * 8; unit += G) { const int rb = unit & 7, h = (unit >> 3) & 7, b = unit >> 6, kvh = h >> 2;
                const size_t qrow = (size_t)b * SEQ + rb * 512 + tid;
                float q[64], o[64]; float mrun = -INFINITY, lrun = 0.f;
#pragma unroll
                for (int c8 = 0; c8 < 8; ++c8) { const u16x8 f = *(const u16x8*)(QB + qrow * 512 + h * 64 + c8 * 8);
#pragma unroll
                    for (int i = 0; i < 8; ++i) { q[c8 * 8 + i] = bf2f(f[i]); o[c8 * 8 + i] = 0.f; } }
                for (int kt = 0; kt < SEQ; kt += 64) {
                    __syncthreads();
                    { const int kr = tid >> 3, c8 = (tid & 7) * 8; const size_t krow = (size_t)b * SEQ + kt + kr;
                      const u16x8 kf = *(const u16x8*)(KB + krow * 128 + kvh * 64 + c8); const u16x8 vf = *(const u16x8*)(PROJ + krow * INP + C_AV + kvh * 64 + c8);
#pragma unroll
                      for (int i = 0; i < 8; ++i) { Kt[kr * 64 + c8 + i] = bf2f(kf[i]); Vt[kr * 64 + c8 + i] = bf2f(vf[i]); } }
                    __syncthreads();
#pragma unroll 1
                    for (int j = 0; j < 64; ++j) { float a = 0.f;
#pragma unroll
                        for (int d4 = 0; d4 < 16; ++d4) { const f32x4 kv = *(const LAS f32x4*)(Kt + j * 64 + d4 * 4); a += (q[d4 * 4] * kv.x + q[d4 * 4 + 1] * kv.y) + (q[d4 * 4 + 2] * kv.z + q[d4 * 4 + 3] * kv.w); }
                        if (a > mrun) { const float al = exp2f(mrun - a); mrun = a; lrun *= al;
#pragma unroll
                            for (int d = 0; d < 64; ++d) o[d] *= al; }
                        const float p = exp2f(a - mrun); lrun += p;
#pragma unroll
                        for (int d4 = 0; d4 < 16; ++d4) { const f32x4 vv = *(const LAS f32x4*)(Vt + j * 64 + d4 * 4); o[d4 * 4] += p * vv.x; o[d4 * 4 + 1] += p * vv.y; o[d4 * 4 + 2] += p * vv.z; o[d4 * 4 + 3] += p * vv.w; } }
                }
                const float rl = 1.f / lrun;
#pragma unroll
                for (int c8 = 0; c8 < 8; ++c8) { v4u w; w.x = pk2(o[c8 * 8] * rl, o[c8 * 8 + 1] * rl); w.y = pk2(o[c8 * 8 + 2] * rl, o[c8 * 8 + 3] * rl); w.z = pk2(o[c8 * 8 + 4] * rl, o[c8 * 8 + 5] * rl); w.w = pk2(o[c8 * 8 + 6] * rl, o[c8 * 8 + 7] * rl);
                    *(v4u*)(MIX + qrow * DM + h * 64 + c8 * 8) = w; }
              }
              __syncthreads(); }
#else
            { const attn_body::AttnTensors AT{(const attn_body::bf16*)QB, (const attn_body::bf16*)KB, (const attn_body::bf16*)(PROJ + C_AV), (attn_body::bf16*)MIX};
              const attn_body::StaticOrder S(G, bx);
              float bq_ = fabsf(KIN(4)[l * 64 + lane]), bk_ = fabsf(KIN(5)[l * 64 + lane]);
#pragma unroll
              for (int m_ = 1; m_ < 64; m_ <<= 1) { bq_ = fmaxf(bq_, __shfl_xor(bq_, m_)); bk_ = fmaxf(bk_, __shfl_xor(bk_, m_)); }
              const float bref = __uint_as_float(__builtin_amdgcn_readfirstlane(__float_as_uint(64.f * QSCALE * 1.02f * bq_ * bk_)));
              attn_body::attn_phase<attn_body::StaticOrder>((char*)lds_raw + RING_OFF, AT, S, bref); }
#endif
            STAMP2(11);
        }
        SEAM(pb + 3);
        if (IN(pb + 4) && PON(5)) {
            TID_SETUP(); unsigned char* ws = KWS(); const bf16* MIX = WSP(bf16, WS_MIX); const bf16* WOUT_T = WSP(bf16, WS_WOUT_T); const bf16* HB = WSP(bf16, WS_HB); bf16* T1 = WSP(bf16, WS_T1);
            pg8::Gemm g{MIX, WOUT_T + (size_t)l * DM * DM, NTOK, DM, DM}; pg8::StaticOrder S; S.init(NTOK, DM, G, bx);
            pg8::EpiResBf16 E{HB, T1, DM, DN_ALPHA};
            pg8::gemm_phase<pg8::EpiResBf16, pg8::StaticOrder, true, true>(lds + RING_OFF, g, S, E);
        }
        SEAM(pb + 4);
        if (IN(pb + 5) && PON(6)) {
            TID_SETUP(); unsigned char* ws = KWS(); gu32* ctl = (gu32*)(ws + WS_CTL); const float* ln1_g = KIN(10); const float* ln1_b = KIN(11); const float* router_w = KIN(12); const float* router_b = KIN(13);
            const bf16* T1 = WSP(bf16, WS_T1); bf16* HB = WSP(bf16, WS_HB); unsigned char* HB8 = WSP(unsigned char, WS_UVT); int* TOKE = WSP(int, WS_TOK); int* TOKS = TOKE + NTOK * 4; float* TOKW = (float*)(TOKS + NTOK * 4); int* LIST = WSP(int, WS_XS);
            { const v4u* src = (const v4u*)(WSP(bf16, WS_RWT) + (size_t)l * 2 * NE * DM); LAS v4u* dst = (LAS v4u*)(lds + RING_OFF);
              for (int i = tid; i < 2 * NE * DM * 2 / 16; i += NWAVES * 64) { const int row = i >> 7, c = i & 127; dst[row * 128 + (c ^ (row & 7))] = src[i]; }
              LAS float* GBw = (LAS float*)(lctl + LC_ROWS); for (int i = tid; i < DM; i += NWAVES * 64) { GBw[i] = ln1_g[l * DM + i]; GBw[DM + i] = ln1_b[l * DM + i]; } }
            const LAS bf16* RWH = (const LAS bf16*)(lds + RING_OFF); const LAS float* GB = (const LAS float*)(lctl + LC_ROWS); LAS float* ST = (LAS float*)(lctl + LC_ROWS + 8192);
            LAS int* lcnt = (LAS int*)(lctl + LC_CNT); LAS int* lbase = (LAS int*)(lctl + LC_BASE); LAS int* sele = (LAS int*)(lctl + LC_SELE); LAS int* sels = (LAS int*)(lctl + LC_SELS);
            const float* rb = router_b + l * NE;
            for (int r0 = bx * 128; r0 < NTOK; r0 += G * 128) {
                if (tid < 32) lcnt[tid] = 0;
                __syncthreads();
                LAS float* LG = (LAS float*)(lctl + LC_LG) + wave * 512;
                for (int rr = 0; rr < 16; rr += P6_ROWS) { v4u raw[P6_ROWS][2];
#pragma unroll
                    for (int q = 0; q < P6_ROWS; ++q)
#pragma unroll
                        for (int h = 0; h < 2; ++h) raw[q][h] = *(const v4u*)(T1 + ((size_t)r0 + wave * 16 + rr + q) * DM + h * 512 + 8 * lane);
#pragma unroll
                    for (int q = 0; q < P6_ROWS; ++q) { f32x4 v[4];
#pragma unroll
                        for (int h = 0; h < 2; ++h) { const v4u t = raw[q][h];
                            v[2 * h] = (f32x4){__uint_as_float(t.x << 16), __uint_as_float(t.x & 0xffff0000u), __uint_as_float(t.y << 16), __uint_as_float(t.y & 0xffff0000u)};
                            v[2 * h + 1] = (f32x4){__uint_as_float(t.z << 16), __uint_as_float(t.z & 0xffff0000u), __uint_as_float(t.w << 16), __uint_as_float(t.w & 0xffff0000u)}; }
                        float s_ = 0.f;
#pragma unroll
                        for (int j = 0; j < 4; ++j) s_ += (v[j].x + v[j].y) + (v[j].z + v[j].w);
                        const float mean = wave_sum(s_) * (1.f / DM); float s2_ = 0.f;
#pragma unroll
                        for (int j = 0; j < 4; ++j) { const f32x4 d_ = v[j] - mean; s2_ += (d_.x * d_.x + d_.y * d_.y) + (d_.z * d_.z + d_.w * d_.w); }
                        const float rstd = __builtin_amdgcn_rsqf(wave_sum(s2_) * (1.f / DM) + LN_EPS);
                        if (lane == 0) { ST[(wave * 16 + rr + q) * 2] = mean; ST[(wave * 16 + rr + q) * 2 + 1] = rstd; } } }
                asm volatile("s_waitcnt lgkmcnt(0)" ::: "memory");
                { const int fr = lane & 15, fq = lane >> 4; const size_t row = (size_t)r0 + wave * 16 + fr; const float mean = ST[(wave * 16 + fr) * 2], rstd = ST[(wave * 16 + fr) * 2 + 1];
                  const bf16* xrow = T1 + row * DM + 8 * fq; bf16* hrow = HB + row * DM + 8 * fq;
                  f32x4 acc0 = {0.f, 0.f, 0.f, 0.f}, acc1 = {0.f, 0.f, 0.f, 0.f};
#pragma unroll 1
                  for (int s8 = 0; s8 < 32; s8 += 8) { v4u xr[8];
#pragma unroll
                    for (int i = 0; i < 8; ++i) xr[i] = *(const v4u*)(xrow + 32 * (s8 + i));
#pragma unroll
                    for (int i = 0; i < 8; ++i) { const int k0 = 32 * (s8 + i) + 8 * fq;
                        const f32x4 g0 = *(const LAS f32x4*)(GB + k0), g1 = *(const LAS f32x4*)(GB + k0 + 4), b0 = *(const LAS f32x4*)(GB + DM + k0), b1 = *(const LAS f32x4*)(GB + DM + k0 + 4);
                        f32x4 x0 = {__uint_as_float(xr[i].x << 16), __uint_as_float(xr[i].x & 0xffff0000u), __uint_as_float(xr[i].y << 16), __uint_as_float(xr[i].y & 0xffff0000u)};
                        f32x4 x1 = {__uint_as_float(xr[i].z << 16), __uint_as_float(xr[i].z & 0xffff0000u), __uint_as_float(xr[i].w << 16), __uint_as_float(xr[i].w & 0xffff0000u)};
                        x0 = (x0 - mean) * rstd * g0 + b0; x1 = (x1 - mean) * rstd * g1 + b1;
                        v4u hi; hi.x = pk2(x0.x, x0.y); hi.y = pk2(x0.z, x0.w); hi.z = pk2(x1.x, x1.y); hi.w = pk2(x1.z, x1.w);
                        *(v4u*)(hrow + 32 * (s8 + i)) = hi;
                        *(unsigned long long*)(HB8 + row * DM + 32 * (s8 + i) + 8 * fq) = (unsigned long long)pk4_fp8(x0.x, x0.y, x0.z, x0.w) | ((unsigned long long)pk4_fp8(x1.x, x1.y, x1.z, x1.w) << 32);
                        const f32x4 l0 = {x0.x - __uint_as_float(hi.x << 16), x0.y - __uint_as_float(hi.x & 0xffff0000u), x0.z - __uint_as_float(hi.y << 16), x0.w - __uint_as_float(hi.y & 0xffff0000u)};
                        const f32x4 l1 = {x1.x - __uint_as_float(hi.z << 16), x1.y - __uint_as_float(hi.z & 0xffff0000u), x1.z - __uint_as_float(hi.w << 16), x1.w - __uint_as_float(hi.w & 0xffff0000u)};
                        v4u lo; lo.x = pk2(l0.x, l0.y); lo.y = pk2(l0.z, l0.w); lo.z = pk2(l1.x, l1.y); lo.w = pk2(l1.z, l1.w);
                        const bf16x8 ah = __builtin_bit_cast(bf16x8, hi), al = __builtin_bit_cast(bf16x8, lo);
                        const int c = 4 * (s8 + i) + fq;
                        const LAS bf16* w0 = RWH + fr * DM + ((c ^ (fr & 7)) << 3); const LAS bf16* w1 = RWH + (16 + fr) * DM + ((c ^ (fr & 7)) << 3);
                        const bf16x8 bh0 = *(const LAS bf16x8*)w0, bl0 = *(const LAS bf16x8*)(w0 + NE * DM), bh1 = *(const LAS bf16x8*)w1, bl1 = *(const LAS bf16x8*)(w1 + NE * DM);
                        acc0 = MFMA16(ah, bh0, acc0); acc0 = MFMA16(ah, bl0, acc0); acc0 = MFMA16(al, bh0, acc0);
                        acc1 = MFMA16(ah, bh1, acc1); acc1 = MFMA16(ah, bl1, acc1); acc1 = MFMA16(al, bh1, acc1); } }
                  const float bias0 = rb[fr], bias1 = rb[16 + fr];
#pragma unroll
                  for (int r = 0; r < 4; ++r) { LG[(4 * fq + r) * 32 + fr] = acc0[r] + bias0; LG[(4 * fq + r) * 32 + 16 + fr] = acc1[r] + bias1; } }
                asm volatile("s_waitcnt lgkmcnt(0)" ::: "memory");
                if (lane < 16) { const int lr = wave * 16 + lane; const size_t m = (size_t)r0 + lr; float lg[32];
#pragma unroll
                    for (int e4 = 0; e4 < 8; ++e4) { const f32x4 x = *(const LAS f32x4*)(LG + lane * 32 + e4 * 4); lg[e4 * 4] = x.x; lg[e4 * 4 + 1] = x.y; lg[e4 * 4 + 2] = x.z; lg[e4 * 4 + 3] = x.w; }
                    int se[4]; float sv[4];
#pragma unroll
                    for (int k = 0; k < 4; ++k) { float best = -INFINITY; int bi = 0;
#pragma unroll
                        for (int e = 0; e < 32; ++e) { if (lg[e] > best) { best = lg[e]; bi = e; } }
                        se[k] = bi; sv[k] = best;
#pragma unroll
                        for (int e = 0; e < 32; ++e) if (e == bi) lg[e] = -INFINITY; }
                    const float e1 = expf(sv[1] - sv[0]), e2 = expf(sv[2] - sv[0]), e3 = expf(sv[3] - sv[0]); const float inv = 1.f / (1.f + e1 + e2 + e3);
                    const float wts[4] = {inv, e1 * inv, e2 * inv, e3 * inv};
#pragma unroll
                    for (int k = 0; k < 4; ++k) { const int ls = __hip_atomic_fetch_add(lcnt + se[k], 1, __ATOMIC_RELAXED, __HIP_MEMORY_SCOPE_WORKGROUP); sele[lr * 4 + k] = se[k]; sels[lr * 4 + k] = ls; TOKW[m * 4 + k] = wts[k]; } }
                __syncthreads();
                if (tid < 32) lbase[tid] = (int)__hip_atomic_fetch_add(ctl + CW_CNT + l * 32 + tid, (unsigned)lcnt[tid], RLX_AGENT);
                __syncthreads();
                { const int e = sele[tid], sl = lbase[e] + sels[tid]; TOKE[(size_t)r0 * 4 + tid] = e; TOKS[(size_t)r0 * 4 + tid] = sl; LIST[(size_t)e * NTOK + sl] = r0 + (tid >> 2); }
                __syncthreads();
            }
        }
        SEAM(pb + 5);
#if defined(EXP_P1_NOEPI)
        if (IN(pb + 6)) {
            TID_SETUP(); unsigned char* ws = KWS(); bf16* HB = WSP(bf16, WS_HB); bf16* WIN_T = WSP(bf16, WS_WIN_T); bf16* PROJ = WSP(bf16, WS_PROJ);
            pg8::Gemm g{HB, WIN_T + (size_t)l * INP * DM, NTOK, INP, DM}; pg8::StaticOrder S; S.init(NTOK, INP, G, bx);
            pg8::EpiNull EN{PROJ}; pg8::gemm_phase<pg8::EpiNull, pg8::StaticOrder, true, true>(lds + RING_OFF, g, S, EN);
            __syncthreads(); }
#endif
        STAMP(pb + 7);
        if (IN(pb + 7) || IN(pb + 8) || IN(pb + 9)) {
            LAS int* pst = (LAS int*)(lctl + LC_PSTART); LAS int* ecnt = (LAS int*)(lctl + LC_BASE); gu32* ctl = (gu32*)(KWS() + WS_CTL);
            __syncthreads();
            int ln_ = threadIdx.x; asm volatile("" : "+v"(ln_));
            if (ln_ < 64) { const int e = ln_ & 31;
                const int c = (int)__hip_atomic_load(ctl + CW_CNT + l * 32 + e, RLX_AGENT); const int p_ = (c + 255) >> 8; int incl = p_;
#pragma unroll
                for (int o = 1; o < 32; o <<= 1) { const int y = __shfl_up(incl, o); if (e >= o) incl += y; }
                if (ln_ < 32) { pst[e] = incl - p_; ecnt[e] = c; if (e == NE - 1) pst[NE] = incl; } }
            __syncthreads();
        }
        if (IN(pb + 7) && PON(8)) {
            TID_SETUP(); unsigned char* ws = KWS(); const float* exp_b_gu = KIN(15); const unsigned char* HB8 = WSP(unsigned char, WS_UVT); const int* LIST = WSP(int, WS_XS); const unsigned char* WGU8 = WSP(unsigned char, WS_WGU_T); unsigned char* HID8 = WSP(unsigned char, WS_HID);
            const LAS int* pst = (const LAS int*)(lctl + LC_PSTART); LAS int* ul = (LAS int*)(lctl + LC_ULIST);
            const int nM = pst[NE], nN = 8, nwg = nM * nN;
            if (tid < 64) { const long L = (long)tid * G + bx; int v = -1;
                if (L < nwg) { int wgid = (int)L; { const int q = nwg / 8, r = nwg % 8, xcd = wgid % 8, off = wgid / 8; wgid = (xcd < r ? xcd * (q + 1) : r * (q + 1) + (xcd - r) * q) + off; }
                    const int nig = 8 * nN, gid = wgid / nig, fm = gid * 8, gsz = (nM - fm) < 8 ? (nM - fm) : 8; const int pm = fm + ((wgid % nig) % gsz), pn = (wgid % nig) / gsz;
                    int e = 0; for (int k = 1; k < NE; ++k) if (pst[k] <= pm) e = k;
                    v = (pm << 16) | (e * nN + pn); }
                ul[tid] = v; }
            __syncthreads();
            const int nunits = bx < nwg ? (nwg - bx + G - 1) / G : 0;
            LAS unsigned short* rows16 = (LAS unsigned short*)(lctl + LC_ROWS); const LAS int* ecnt = (const LAS int*)(lctl + LC_BASE);
            if (nunits > 0) { int tok_[10]; int tid3 = tid; asm volatile("" : "+v"(tid3));
#pragma unroll
                for (int j = 0; j < 10; ++j) { const int i = tid3 + 512 * j; int sl = i >> 8; sl = sl < nunits ? sl : nunits - 1; const int v = ul[sl]; const int pm = v >> 16, e = (v & 0xffff) >> 3, pl = pm - pst[e]; const int idx = pl * 256 + (i & 255);
                    const bool ok = idx < ecnt[e]; const int t_ = LIST[(size_t)e * NTOK + (ok ? idx : 0)]; tok_[j] = ok ? t_ : 0; }
#pragma unroll
                for (int j = 0; j < 10; ++j) { const int i = tid3 + 512 * j; if (i < nunits * 256) rows16[i] = (unsigned short)tok_[j]; } }
            __syncthreads();
            pg8::Gemm g{(const pg8::bf16_t*)HB8, (const pg8::bf16_t*)(WGU8 + (size_t)l * NE * 2048 * DM), NTOK, NE * 2048, DM}; pg8::ListOrder S{ul, nunits};
            pg8::EpiSwiglu8 E{HID8, exp_b_gu + (size_t)l * NE * 2048, (LAS float*)(lctl + LC_LG)};
            pg8::gemm_phase_fp8<pg8::EpiSwiglu8, pg8::ListOrder, true, true>(lds + RING_OFF, g, S, E, rows16);
        }
        SEAM(pb + 7);
        if (IN(pb + 8) && PON(9)) {
            TID_SETUP(); unsigned char* ws = KWS(); const float* exp_b_down = KIN(17); const unsigned char* HID8 = WSP(unsigned char, WS_HID); const unsigned char* WDN8 = WSP(unsigned char, WS_WDN_T); unsigned char* YS = WSP(unsigned char, WS_YS);
            const LAS int* pst = (const LAS int*)(lctl + LC_PSTART); LAS int* ul = (LAS int*)(lctl + LC_ULIST);
            const int nM = pst[NE], nN = 4, nwg = nM * nN;
            __syncthreads();
            if (tid < 64) { const long L = (long)tid * G + bx; int v = -1;
                if (L < nwg) { int wgid = (int)L; { const int q = nwg / 8, r = nwg % 8, xcd = wgid % 8, off = wgid / 8; wgid = (xcd < r ? xcd * (q + 1) : r * (q + 1) + (xcd - r) * q) + off; }
                    const int nig = 8 * nN, gid = wgid / nig, fm = gid * 8, gsz = (nM - fm) < 8 ? (nM - fm) : 8; const int pm = fm + ((wgid % nig) % gsz), pn = (wgid % nig) / gsz;
                    int e = 0; for (int k = 1; k < NE; ++k) if (pst[k] <= pm) e = k;
                    v = (pm << 16) | (e * nN + pn); }
                ul[tid] = v; }
            __syncthreads();
            const int nunits = bx < nwg ? (nwg - bx + G - 1) / G : 0;
            pg8::Gemm g{(const pg8::bf16_t*)HID8, (const pg8::bf16_t*)(WDN8 + (size_t)l * NE * DM * DE), MPAD, NE * DM, DE}; pg8::ListOrder S{ul, nunits};
            pg8::EpiDown8 E{YS, exp_b_down + (size_t)l * NE * DM, (LAS float*)(lctl + LC_LG)};
            pg8::gemm_phase_fp8<pg8::EpiDown8, pg8::ListOrder, true, false>(lds + RING_OFF, g, S, E, nullptr);
        }
        SEAM(pb + 8);
        if (IN(pb + 9) && PON(10)) {
            TID_SETUP(); unsigned char* ws = KWS(); const float* ln2_g = KIN(18); const float* ln2_b = KIN(19); float* out = KOUT(); bf16* HB = WSP(bf16, WS_HB); unsigned char* HB8L = WSP(unsigned char, WS_HB8L);
            const unsigned char* YS = WSP(unsigned char, WS_YS); const int* TOKE = WSP(int, WS_TOK); const int* TOKS = TOKE + NTOK * 4; const float* TOKW = (const float*)(TOKS + NTOK * 4); const LAS int* pst = (const LAS int*)(lctl + LC_PSTART);
            const bool lastl = (l == NL - 1);
            f32x4 gam[4], bet[4];
#pragma unroll
            for (int j = 0; j < 4; ++j) { gam[j] = *(const f32x4*)(ln2_g + l * DM + 16 * lane + 4 * j); bet[j] = *(const f32x4*)(ln2_b + l * DM + 16 * lane + 4 * j); }
            int yo[4]; f32x4 wl = {0.f, 0.f, 0.f, 0.f};
            { const int m = gw + (lane & 15) * NGW; const v4u te = *(const v4u*)(TOKE + m * 4), ts = *(const v4u*)(TOKS + m * 4); wl = *(const f32x4*)(TOKW + m * 4);
              yo[0] = pst[te.x] * 256 + (int)ts.x; yo[1] = pst[te.y] * 256 + (int)ts.y; yo[2] = pst[te.z] * 256 + (int)ts.z; yo[3] = pst[te.w] * 256 + (int)ts.w; }
            for (int p2 = 0; p2 < NTOK / (2 * NGW); ++p2) { f32x4 v[2][4]; v4u yraw[2][4]; float wk[2][4];
#pragma unroll
                for (int q = 0; q < 2; ++q) { const int t = 2 * p2 + q, m = gw + t * NGW;
#pragma unroll
                    for (int k = 0; k < 4; ++k) { yraw[q][k] = *(const v4u*)(YS + (size_t)__builtin_amdgcn_readfirstlane(__shfl(yo[k], t)) * DM + 16 * lane); wk[q][k] = __shfl(wl[k], t); }
                    const v4u h0 = *(const v4u*)(HB + (size_t)m * DM + 16 * lane), h1 = *(const v4u*)(HB + (size_t)m * DM + 16 * lane + 8);
                    v[q][0] = (f32x4){__uint_as_float(h0.x << 16), __uint_as_float(h0.x & 0xffff0000u), __uint_as_float(h0.y << 16), __uint_as_float(h0.y & 0xffff0000u)} * DN_ALPHA;
                    v[q][1] = (f32x4){__uint_as_float(h0.z << 16), __uint_as_float(h0.z & 0xffff0000u), __uint_as_float(h0.w << 16), __uint_as_float(h0.w & 0xffff0000u)} * DN_ALPHA;
                    v[q][2] = (f32x4){__uint_as_float(h1.x << 16), __uint_as_float(h1.x & 0xffff0000u), __uint_as_float(h1.y << 16), __uint_as_float(h1.y & 0xffff0000u)} * DN_ALPHA;
                    v[q][3] = (f32x4){__uint_as_float(h1.z << 16), __uint_as_float(h1.z & 0xffff0000u), __uint_as_float(h1.w << 16), __uint_as_float(h1.w & 0xffff0000u)} * DN_ALPHA; }
#pragma unroll
                for (int q = 0; q < 2; ++q)
#pragma unroll
                    for (int k = 0; k < 4; ++k) { const float w = wk[q][k]; const unsigned yw[4] = {yraw[q][k].x, yraw[q][k].y, yraw[q][k].z, yraw[q][k].w};
#pragma unroll
                        for (int j = 0; j < 4; ++j) { const f32x2_t lo = __builtin_amdgcn_cvt_pk_f32_fp8((int)yw[j], false), hi = __builtin_amdgcn_cvt_pk_f32_fp8((int)yw[j], true);
                            v[q][j] = v[q][j] + (f32x4){lo.x, lo.y, hi.x, hi.y} * w; } }
#pragma unroll
                for (int q = 0; q < 2; ++q) { const int m = gw + (2 * p2 + q) * NGW; ln_row8(v[q], gam, bet);
                    if (lastl) {
#pragma unroll
                        for (int j = 0; j < 4; ++j) *(f32x4*)(out + (size_t)m * DM + 16 * lane + 4 * j) = v[q][j]; }
                    else { v4u w0, w1; w0.x = pk2(v[q][0].x, v[q][0].y); w0.y = pk2(v[q][0].z, v[q][0].w); w0.z = pk2(v[q][1].x, v[q][1].y); w0.w = pk2(v[q][1].z, v[q][1].w);
                        w1.x = pk2(v[q][2].x, v[q][2].y); w1.y = pk2(v[q][2].z, v[q][2].w); w1.z = pk2(v[q][3].x, v[q][3].y); w1.w = pk2(v[q][3].z, v[q][3].w);
                        *(v4u*)(HB + (size_t)m * DM + 16 * lane) = w0; *(v4u*)(HB + (size_t)m * DM + 16 * lane + 8) = w1;
                        v4u w8; w8.x = pk4_fp8(v[q][0].x, v[q][0].y, v[q][0].z, v[q][0].w); w8.y = pk4_fp8(v[q][1].x, v[q][1].y, v[q][1].z, v[q][1].w); w8.z = pk4_fp8(v[q][2].x, v[q][2].y, v[q][2].z, v[q][2].w); w8.w = pk4_fp8(v[q][3].x, v[q][3].y, v[q][3].z, v[q][3].w);
                        *(v4u*)(HB8L + (size_t)m * DM + 16 * lane) = w8; } } }
        }
        SEAM(pb + 9);
    }
#if PROBE_A >= 0
    { xcd_barrier(bar);
      const unsigned long long* st = (const unsigned long long*)(KWS() + WS_CTL + 65536); unsigned long long T = 0;
      if (PROBE_A & 1) T += st[1] - st[0];
      for (int l = 0; l < NL; ++l) for (int j = 1; j <= 10; ++j) if ((PROBE_A >> j) & 1) T += st[1 + 10 * l + j] - st[10 * l + j];
      if (PROBE_SUB_A >= 0) for (int l = 0; l < NL; ++l) T += st[128 + l * 16 + PROBE_SUB_B] - st[128 + l * 16 + PROBE_SUB_A];
      T *= 4ull; if (T > 5000000ull) T = 5000000ull;
      const unsigned long long t0 = __builtin_amdgcn_s_memrealtime();
      while (__builtin_amdgcn_s_memrealtime() - t0 < T) __builtin_amdgcn_s_sleep(16); }
#endif
#undef IN
#undef SEAM
}

#ifndef MK_PER_PHASE
#define MK_PER_PHASE 0
#endif
extern "C" void kernel_launch(void* const* d_in, const int* in_sizes, int n_in, void* d_out, int out_size, void* d_ws, size_t ws_size, hipStream_t stream) {
    static int grid = 0;
    if (grid == 0) {
        if (n_in != 20 || in_sizes[0] != NTOK * DM || out_size != NTOK * DM || ws_size < WS_END) { fprintf(stderr, "kernel_launch: unexpected shapes (n_in %d, in0 %d, out %d, ws %zu); nothing launched\n", n_in, n_in > 0 ? in_sizes[0] : -1, out_size, ws_size); grid = -1; return; }
        int dev = 0, cus = 0, per_cu = 0;
        if (hipGetDevice(&dev) != hipSuccess || hipDeviceGetAttribute(&cus, hipDeviceAttributeMultiprocessorCount, dev) != hipSuccess) { grid = -1; return; }
        if (hipFuncSetAttribute((const void*)fwd, hipFuncAttributeMaxDynamicSharedMemorySize, LDS_BYTES) != hipSuccess) { fprintf(stderr, "kernel_launch: hipFuncSetAttribute failed\n"); grid = -1; return; }
        if (hipOccupancyMaxActiveBlocksPerMultiprocessor(&per_cu, (const void*)fwd, NWAVES * 64, LDS_BYTES) != hipSuccess || per_cu < 1) fprintf(stderr, "kernel_launch: occupancy query reports %d\n", per_cu);
        (void)hipGetLastError();
        if (cus < 256) { fprintf(stderr, "kernel_launch: built for a 256-CU device (got %d CUs); nothing launched\n", cus); grid = -1; return; }
        grid = 256;
    }
    if (grid < 0) return;
    if (hipMemsetAsync((char*)d_ws + WS_CTL, 0, CTL_ZERO_BYTES, stream) != hipSuccess) return;
    Args a{};
    for (int i = 0; i < 20; ++i) a.in[i] = (const float*)d_in[i];
    a.out = (float*)d_out; a.ws = (unsigned char*)d_ws;
#if MK_PER_PHASE
    for (int p = 0; p < N_PHASES; ++p) { a.ph_lo = p; a.ph_hi = p + 1; hipLaunchKernelGGL(fwd, dim3(grid), dim3(NWAVES * 64), LDS_BYTES, stream, a); }
#else
    a.ph_lo = 0; a.ph_hi = N_PHASES;
    hipLaunchKernelGGL(fwd, dim3(grid), dim3(NWAVES * 64), LDS_BYTES, stream, a);
#endif
    const hipError_t le = hipPeekAtLastError();
    if (le != hipSuccess) fprintf(stderr, "kernel_launch: launch failed: %s\n", hipGetErrorName(le));
}
```

```cpp
#include <hip/hip_runtime.h>
#include <hip/hip_bf16.h>
#include <cstdio>
#include <cstdint>
#include <cmath>
namespace pg8 {
#define PG8_LAS __attribute__((address_space(3)))
typedef unsigned short bf16_t;
typedef short bf16x8 __attribute__((ext_vector_type(8)));
typedef float f32x4 __attribute__((ext_vector_type(4)));
typedef unsigned u32x4 __attribute__((ext_vector_type(4)));
constexpr int BM = 256, BK = 64, HALF = 128, HTB = HALF * BK * 2  , STAGE_BYTES = 8 * HTB, NXCD = 8, WGM = 8;

__host__ __device__ __forceinline__ int lds_byte(int r, int c) { const int st = (r >> 4) * 2 + (c >> 5), rr = r & 15, cc = c & 31, ob = rr * 64 + cc * 2; return st * 1024 + (ob ^ (((ob >> 9) & 1) << 5)); }
__host__ __device__ __forceinline__ void stage_rc(int b, int& R, int& C) { const int st = b / 1024, sb = b % 1024, swz = sb ^ (((sb >> 9) & 1) << 5); R = (st >> 1) * 16 + swz / 64; C = (st & 1) * 32 + (swz % 64) / 2; }
__host__ __device__ __forceinline__ int perm32(int rho) { const int n = rho >> 4, i = rho & 15; return 8 * (i >> 2) + 4 * n + (i & 3); }

struct Unit { int pm, pn; };
struct Gemm { const bf16_t* A; const bf16_t* Bt; int M, N, K; };

struct StaticOrder {
    int nM, nN, nwg, G, c;
    __host__ __device__ void init(int M, int N, int G_, int c_) { nM = M / BM; nN = N / BM; nwg = nM * nN; G = G_; c = c_; }
    __host__ __device__ bool next(int i, Unit& u) const {
        const long L = (long)i * G + c; if (L >= nwg) return false;
        int wgid = (int)L; { const int q = nwg / NXCD, r = nwg % NXCD, xcd = wgid % NXCD, off = wgid / NXCD; wgid = (xcd < r ? xcd * (q + 1) : r * (q + 1) + (xcd - r) * q) + off; }
        const int nig = WGM * nN, gid = wgid / nig, fm = gid * WGM, gsz = (nM - fm) < WGM ? (nM - fm) : WGM;
        u.pm = fm + ((wgid % nig) % gsz); u.pn = (wgid % nig) / gsz; return true;
    }
    __device__ __forceinline__ void a_ready(const Unit&) const {}
    __device__ __forceinline__ void done(const Unit&) const {}
};

__device__ __forceinline__ unsigned cvt_pk_bf16(float lo, float hi) { unsigned r; asm volatile("v_cvt_pk_bf16_f32 %0, %1, %2" : "=v"(r) : "v"(lo), "v"(hi)); return r; }
typedef float f32x2 __attribute__((ext_vector_type(2)));
__device__ __forceinline__ u32x4 pack8(const f32x4 v0, const f32x4 v1) { u32x4 w; w.x = cvt_pk_bf16(v0[0], v0[1]); w.y = cvt_pk_bf16(v0[2], v0[3]); w.z = cvt_pk_bf16(v1[0], v1[1]); w.w = cvt_pk_bf16(v1[2], v1[3]); return w; }

struct EpiPlainBf16 {
    static constexpr bool PERM = true, AFTER_DRAIN = false;
    bf16_t* O; int ldc;
    __device__ __forceinline__ void operator()(const f32x4 (&acc)[2][2][4][2], const Unit& u, int wr, int wc, int fr, int fq) const {
        const int row0 = u.pm * BM + wr * 64 + fr, col0 = u.pn * BM + wc * 32 + 8 * fq;
#pragma unroll
        for (int ai = 0; ai < 2; ++ai)
#pragma unroll
            for (int m = 0; m < 4; ++m) { bf16_t* rowp = O + (size_t)(row0 + ai * HALF + m * 16) * ldc + col0;
#pragma unroll
                for (int bj = 0; bj < 2; ++bj) *(u32x4*)(rowp + bj * HALF) = pack8(acc[ai][bj][m][0], acc[ai][bj][m][1]); }
    }
};
struct EpiFnet {
    static constexpr bool PERM = true, AFTER_DRAIN = false;
    bf16_t* MIX;
    __device__ __forceinline__ void operator()(const f32x4 (&acc)[2][2][4][2], const Unit& u, int wr, int wc, int fr, int fq) const {
        const int row0 = u.pn * 4096 + u.pm * BM + wr * 64 + fr, col0 = 768 + wc * 32 + 8 * fq;
#pragma unroll
        for (int ai = 0; ai < 2; ++ai)
#pragma unroll
            for (int m = 0; m < 4; ++m) { bf16_t* rowp = MIX + (size_t)(row0 + ai * HALF + m * 16) * 1024 + col0;
#pragma unroll
                for (int bj = 0; bj < 2; ++bj) *(u32x4*)(rowp + bj * HALF) = pack8(acc[ai][bj][m][0], acc[ai][bj][m][1]); }
    }
};
struct EpiResF32 {
    static constexpr bool PERM = false, AFTER_DRAIN = false;
    const float* base; float* out; int ldc; float alpha;
    __device__ __forceinline__ void operator()(const f32x4 (&acc)[2][2][4][2], const Unit& u, int wr, int wc, int fr, int fq) const {
        const int row0 = u.pm * BM + wr * 64 + fr, col0 = u.pn * BM + wc * 32 + 4 * fq;
#pragma unroll
        for (int ai = 0; ai < 2; ++ai)
#pragma unroll
            for (int m = 0; m < 4; ++m) { const size_t off = (size_t)(row0 + ai * HALF + m * 16) * ldc + col0;
#pragma unroll
                for (int bj = 0; bj < 2; ++bj)
#pragma unroll
                    for (int n = 0; n < 2; ++n) { const f32x4 b = *(const f32x4*)(base + off + bj * HALF + n * 16); *(f32x4*)(out + off + bj * HALF + n * 16) = b * alpha + acc[ai][bj][m][n]; } }
    }
};
struct EpiResBf16 {
    static constexpr bool PERM = true, AFTER_DRAIN = false;
    const bf16_t* base; bf16_t* out; int ldc; float alpha;
    __device__ __forceinline__ void operator()(const f32x4 (&acc)[2][2][4][2], const Unit& u, int wr, int wc, int fr, int fq) const {
        const int row0 = u.pm * BM + wr * 64 + fr, col0 = u.pn * BM + wc * 32 + 8 * fq;
#pragma unroll
        for (int ai = 0; ai < 2; ++ai)
#pragma unroll
            for (int m = 0; m < 4; ++m) { const size_t off = (size_t)(row0 + ai * HALF + m * 16) * ldc + col0;
#pragma unroll
                for (int bj = 0; bj < 2; ++bj) { const u32x4 b = *(const u32x4*)(base + off + bj * HALF);
                    const f32x4 b0 = {__uint_as_float(b.x << 16), __uint_as_float(b.x & 0xffff0000u), __uint_as_float(b.y << 16), __uint_as_float(b.y & 0xffff0000u)};
                    const f32x4 b1 = {__uint_as_float(b.z << 16), __uint_as_float(b.z & 0xffff0000u), __uint_as_float(b.w << 16), __uint_as_float(b.w & 0xffff0000u)};
                    *(u32x4*)(out + off + bj * HALF) = pack8(b0 * alpha + acc[ai][bj][m][0], b1 * alpha + acc[ai][bj][m][1]); } }
    }
};
__device__ __forceinline__ f32x4 swiglu4(f32x4 g, f32x4 u) {
    typedef float f32x2_ __attribute__((ext_vector_type(2)));
    f32x4 h;
#pragma unroll
    for (int p = 0; p < 2; ++p) { f32x2_ gg = {fminf(g[2 * p], 7.0f), fminf(g[2 * p + 1], 7.0f)}; f32x2_ uu = {__builtin_amdgcn_fmed3f(u[2 * p], -7.0f, 7.0f), __builtin_amdgcn_fmed3f(u[2 * p + 1], -7.0f, 7.0f)};
        const f32x2_ t = gg * (-1.702f * 1.4426950408889634f); f32x2_ e = {__builtin_amdgcn_exp2f(t.x), __builtin_amdgcn_exp2f(t.y)}; e = e + 1.0f;
        const f32x2_ r = {__builtin_amdgcn_rcpf(e.x), __builtin_amdgcn_rcpf(e.y)}; const f32x2_ w = (uu * gg + gg) * r; h[2 * p] = w.x; h[2 * p + 1] = w.y; }
    return h;
}
__device__ __forceinline__ float swiglu1(float g, float u) { g = fminf(g, 7.0f); u = fminf(fmaxf(u, -7.0f), 7.0f); return (u + 1.0f) * g * __builtin_amdgcn_rcpf(1.0f + __expf(-1.702f * g)); }
struct EpiSwiglu {
    static constexpr bool PERM = true, AFTER_DRAIN = false;
    bf16_t* HID; const float* bgu;
    __device__ __forceinline__ void operator()(const f32x4 (&acc)[2][2][4][2], const Unit& u, int wr, int wc, int fr, int fq) const {
        const int e = u.pn >> 3, pnl = u.pn & 7; const int row0 = u.pm * BM + wr * 64 + fr, jj0 = pnl * 128 + wc * 32 + 8 * fq;
        const float* bg = bgu + (size_t)e * 2048 + jj0;
        const f32x4 bg0 = *(const f32x4*)bg, bg1 = *(const f32x4*)(bg + 4), bu0 = *(const f32x4*)(bg + 1024), bu1 = *(const f32x4*)(bg + 1028);
#pragma unroll
        for (int ai = 0; ai < 2; ++ai)
#pragma unroll
            for (int m = 0; m < 4; ++m) { bf16_t* rowp = HID + (size_t)(row0 + ai * HALF + m * 16) * 1024 + jj0;
                const f32x4 g0 = acc[ai][0][m][0] + bg0, g1 = acc[ai][0][m][1] + bg1, u0 = acc[ai][1][m][0] + bu0, u1 = acc[ai][1][m][1] + bu1;
                f32x4 h0, h1;
#pragma unroll
                for (int i = 0; i < 4; ++i) { h0[i] = swiglu1(g0[i], u0[i]); h1[i] = swiglu1(g1[i], u1[i]); }
                *(u32x4*)rowp = pack8(h0, h1); }
    }
};
struct EpiDown {
    static constexpr bool PERM = true, AFTER_DRAIN = false;
    bf16_t* Y; const float* bd;
    __device__ __forceinline__ void operator()(const f32x4 (&acc)[2][2][4][2], const Unit& u, int wr, int wc, int fr, int fq) const {
        const int e = u.pn >> 2, pnl = u.pn & 3; const int row0 = u.pm * BM + wr * 64 + fr, col0 = pnl * BM + wc * 32 + 8 * fq;
        const float* bp = bd + (size_t)e * 1024 + col0;
        f32x4 bv[2][2];
#pragma unroll
        for (int bj = 0; bj < 2; ++bj)
#pragma unroll
            for (int n = 0; n < 2; ++n) bv[bj][n] = *(const f32x4*)(bp + bj * HALF + 4 * n);
#pragma unroll
        for (int ai = 0; ai < 2; ++ai)
#pragma unroll
            for (int m = 0; m < 4; ++m) { bf16_t* rowp = Y + (size_t)(row0 + ai * HALF + m * 16) * 1024 + col0;
#pragma unroll
                for (int bj = 0; bj < 2; ++bj) *(u32x4*)(rowp + bj * HALF) = pack8(acc[ai][bj][m][0] + bv[bj][0], acc[ai][bj][m][1] + bv[bj][1]); }
    }
};
struct EpiNull {
    static constexpr bool PERM = true, AFTER_DRAIN = false;
    bf16_t* O;
    __device__ __forceinline__ void operator()(const f32x4 (&acc)[2][2][4][2], const Unit& u, int wr, int wc, int fr, int fq) const {
#pragma unroll
        for (int ai = 0; ai < 2; ++ai)
#pragma unroll
            for (int bj = 0; bj < 2; ++bj)
#pragma unroll
                for (int m = 0; m < 4; ++m)
#pragma unroll
                    for (int n = 0; n < 2; ++n) asm volatile("" :: "v"(acc[ai][bj][m][n]));
    }
};
__device__ __forceinline__ unsigned pk4_fp8e(float a, float b, float c, float d) { int w = 0; w = __builtin_amdgcn_cvt_pk_fp8_f32(a, b, w, false); w = __builtin_amdgcn_cvt_pk_fp8_f32(c, d, w, true); return (unsigned)w; }
struct EpiPlain8 {
    static constexpr bool PERM = true, AFTER_DRAIN = false, HAS_BIAS = false;
    bf16_t* O; int ldc;
    __device__ __forceinline__ void operator()(const f32x4 (&acc)[2][2][4][2], const Unit& u, int wr, int wc, int fr, int fq, int) const {
        const int row0 = u.pm * BM + wr * 64 + fr, col0 = u.pn * BM + wc * 32 + 8 * fq;
#pragma unroll
        for (int ai = 0; ai < 2; ++ai)
#pragma unroll
            for (int m = 0; m < 4; ++m) { bf16_t* rowp = O + (size_t)(row0 + ai * HALF + m * 16) * ldc + col0;
#pragma unroll
                for (int bj = 0; bj < 2; ++bj) *(u32x4*)(rowp + bj * HALF) = pack8(acc[ai][bj][m][0], acc[ai][bj][m][1]); }
    }
};
struct EpiSwiglu8 {
    static constexpr bool PERM = true, AFTER_DRAIN = false, HAS_BIAS = true;
    unsigned char* HID; const float* bgu; PG8_LAS float* bl;
    __device__ __forceinline__ const float* bias_src(const Unit& u, int lane) const { const int e = u.pn >> 3, pnl = u.pn & 7; return bgu + (size_t)e * 2048 + pnl * 128 + (lane >> 5) * 1024 + (lane & 31) * 4; }
    __device__ __forceinline__ void operator()(const f32x4 (&acc)[2][2][4][2], const Unit& u, int wr, int wc, int fr, int fq, int slot) const {
        const int pnl = u.pn & 7; const int row0 = u.pm * BM + wr * 64 + fr, jj0 = pnl * 128 + wc * 32 + 8 * fq;
        const PG8_LAS float* bg = bl + slot * 256 + wc * 32 + 8 * fq;
        const f32x4 bg0 = *(const PG8_LAS f32x4*)bg, bg1 = *(const PG8_LAS f32x4*)(bg + 4), bu0 = *(const PG8_LAS f32x4*)(bg + 128), bu1 = *(const PG8_LAS f32x4*)(bg + 132);
#pragma unroll
        for (int ai = 0; ai < 2; ++ai)
#pragma unroll
            for (int m = 0; m < 4; ++m) { unsigned char* rowp = HID + (size_t)(row0 + ai * HALF + m * 16) * 1024 + jj0;
                const f32x4 g0 = acc[ai][0][m][0] + bg0, g1 = acc[ai][0][m][1] + bg1, u0 = acc[ai][1][m][0] + bu0, u1 = acc[ai][1][m][1] + bu1;
                const f32x4 h0 = swiglu4(g0, u0), h1 = swiglu4(g1, u1);
                *(unsigned long long*)rowp = (unsigned long long)pk4_fp8e(h0[0], h0[1], h0[2], h0[3]) | ((unsigned long long)pk4_fp8e(h1[0], h1[1], h1[2], h1[3]) << 32); }
    }
};
struct EpiDown8 {
    static constexpr bool PERM = true, AFTER_DRAIN = false, HAS_BIAS = true;
    unsigned char* Y; const float* bd; PG8_LAS float* bl;
    __device__ __forceinline__ const float* bias_src(const Unit& u, int lane) const { const int e = u.pn >> 2, pnl = u.pn & 3; return bd + (size_t)e * 1024 + pnl * BM + lane * 4; }
    __device__ __forceinline__ void operator()(const f32x4 (&acc)[2][2][4][2], const Unit& u, int wr, int wc, int fr, int fq, int slot) const {
        const int pnl = u.pn & 3; const int row0 = u.pm * BM + wr * 64 + fr, col0 = pnl * BM + wc * 32 + 8 * fq;
        const PG8_LAS float* bp = bl + slot * 256 + wc * 32 + 8 * fq;
        f32x4 bv[2][2];
#pragma unroll
        for (int bj = 0; bj < 2; ++bj)
#pragma unroll
            for (int n = 0; n < 2; ++n) bv[bj][n] = *(const PG8_LAS f32x4*)(bp + bj * HALF + 4 * n);
#pragma unroll
        for (int ai = 0; ai < 2; ++ai)
#pragma unroll
            for (int m = 0; m < 4; ++m) { unsigned char* rowp = Y + (size_t)(row0 + ai * HALF + m * 16) * 1024 + col0;
#pragma unroll
                for (int bj = 0; bj < 2; ++bj) { const f32x4 y0 = acc[ai][bj][m][0] + bv[bj][0], y1 = acc[ai][bj][m][1] + bv[bj][1];
                    *(unsigned long long*)(rowp + bj * HALF) = (unsigned long long)pk4_fp8e(y0[0], y0[1], y0[2], y0[3]) | ((unsigned long long)pk4_fp8e(y1[0], y1[1], y1[2], y1[3]) << 32); } }
    }
};
struct ListOrder {
    const PG8_LAS int* list; int n;
    __device__ __forceinline__ bool next(int i, Unit& u) const { if (i >= n) return false; const int v = __builtin_amdgcn_readfirstlane(list[i]); u.pm = v >> 16; u.pn = v & 0xffff; return true; }
    __device__ __forceinline__ void a_ready(const Unit&) const {}
    __device__ __forceinline__ void done(const Unit&) const {}
};
template <class Epi, class Sched, bool ALIGN_EPI = false, bool SP2 = false>
__device__ __forceinline__ void gemm_phase(PG8_LAS unsigned char* lds, const Gemm g, const Sched& S, const Epi& E) {
    int tid_ = threadIdx.x; asm volatile("" : "+v"(tid_));
    const int tid = tid_, wid = __builtin_amdgcn_readfirstlane(tid >> 6), lane = tid & 63, wr = wid >> 2, wc = wid & 3, fr = lane & 15, fq = lane >> 4;
    const int K = g.K, nt = K / BK;
    unsigned voffA[2], voffB[2];
#pragma unroll
    for (int i = 0; i < 2; ++i) { int R, C; stage_rc(tid * 16 + i * 8192, R, C); const int Rb = Epi::PERM ? ((R & ~31) + perm32(R & 31)) : R;
        voffA[i] = (unsigned)(R * K + C) * 2u; voffB[i] = (unsigned)(Rb * K + C) * 2u; }
    const size_t kstep = (size_t)(BK * 2);
    const size_t hstep = (size_t)HALF * K * 2;
    const size_t tstep = 2 * hstep;
    const unsigned ldsw = (unsigned)wid * 1024u;
    const int aoff = lds_byte(wr * 64 + fr, fq * 8), boff = lds_byte(wc * 32 + fr, fq * 8);
#define PG8_SA(b, h) (((b) * 2 + (h)) * HTB)
#define PG8_SB(b, h) ((4 + (b) * 2 + (h)) * HTB)
#define PG8_STAGE(bufoff, gbase, voff) do { _Pragma("unroll") for (int _i = 0; _i < 2; ++_i) \
        __builtin_amdgcn_global_load_lds((const unsigned*)((const char*)(gbase) + (voff)[_i]), (PG8_LAS unsigned*)(lds + (bufoff) + ldsw + _i * 8192), 16, 0, 0); } while (0)
#define PG8_LDA(dst, b, h) do { _Pragma("unroll") for (int m = 0; m < 4; ++m) _Pragma("unroll") for (int k = 0; k < 2; ++k) dst[m][k] = *(const PG8_LAS bf16x8*)(lds + PG8_SA(b, h) + aoff + m * 2048 + k * 1024); } while (0)
#define PG8_LDB(dst, b, h) do { _Pragma("unroll") for (int n = 0; n < 2; ++n) _Pragma("unroll") for (int k = 0; k < 2; ++k) dst[n][k] = *(const PG8_LAS bf16x8*)(lds + PG8_SB(b, h) + boff + n * 2048 + k * 1024); } while (0)
#define PG8_MMA(ai, bj, At, Bt) do { __builtin_amdgcn_s_setprio(1); _Pragma("unroll") for (int m = 0; m < 4; ++m) _Pragma("unroll") for (int n = 0; n < 2; ++n) _Pragma("unroll") for (int k = 0; k < 2; ++k) \
        acc[ai][bj][m][n] = __builtin_amdgcn_mfma_f32_16x16x32_bf16(Bt[n][k], At[m][k], acc[ai][bj][m][n], 0, 0, 0); __builtin_amdgcn_s_setprio(0); } while (0)
#define PG8_WAIT_V(n) asm volatile("s_waitcnt vmcnt(" #n ")" ::: "memory")
#define PG8_WAIT_L(n) asm volatile("s_waitcnt lgkmcnt(" #n ")" ::: "memory")
#define PG8_BAR __builtin_amdgcn_s_barrier()
#define PG8_SCHED __builtin_amdgcn_sched_barrier(0)
    Unit cur, nxt; int ui = 0;
    if (!S.next(0, cur)) return;
    f32x4 acc[2][2][4][2];
#pragma unroll
    for (int a = 0; a < 2; ++a)
#pragma unroll
        for (int b = 0; b < 2; ++b)
#pragma unroll
            for (int m = 0; m < 4; ++m)
#pragma unroll
                for (int n = 0; n < 2; ++n) acc[a][b][m][n] = (f32x4){0.f, 0.f, 0.f, 0.f};
    bf16x8 At[4][2], B0[2][2], B1[2][2];
    const char* cA = (const char*)g.A + (size_t)cur.pm * tstep; const char* cB = (const char*)g.Bt + (size_t)cur.pn * tstep;
    S.a_ready(cur);
    if constexpr (SP2) {
        PG8_STAGE(PG8_SB(0, 0), cB, voffB); PG8_STAGE(PG8_SB(0, 1), cB + hstep, voffB); PG8_STAGE(PG8_SA(0, 0), cA, voffA); PG8_STAGE(PG8_SA(0, 1), cA + hstep, voffA);
        if (wr == 1) PG8_BAR;
        PG8_WAIT_V(2); PG8_BAR;
        PG8_STAGE(PG8_SB(1, 0), cB + kstep, voffB); PG8_STAGE(PG8_SA(1, 0), cA + kstep, voffA); PG8_STAGE(PG8_SB(1, 1), cB + hstep + kstep, voffB);
        PG8_WAIT_V(6); PG8_BAR;
    } else {
        PG8_STAGE(PG8_SB(0, 0), cB, voffB); PG8_STAGE(PG8_SA(0, 0), cA, voffA); PG8_STAGE(PG8_SB(0, 1), cB + hstep, voffB); PG8_STAGE(PG8_SA(0, 1), cA + hstep, voffA);
        if (wr == 1) PG8_BAR;
        PG8_WAIT_V(4); PG8_BAR;
        PG8_STAGE(PG8_SB(1, 0), cB + kstep, voffB); PG8_STAGE(PG8_SA(1, 0), cA + kstep, voffA); PG8_STAGE(PG8_SB(1, 1), cB + hstep + kstep, voffB);
        PG8_WAIT_V(6); PG8_BAR;
    }
    for (;;) {
        const bool has_next = S.next(ui + 1, nxt);
        const char* nA = has_next ? (const char*)g.A + (size_t)nxt.pm * tstep : cA; const char* nB = has_next ? (const char*)g.Bt + (size_t)nxt.pn * tstep : cB;
        for (int t = 0; t < nt; t += 2) {
            const bool last = (t == nt - 2);
            const char* a1 = cA + (size_t)(t + 1) * kstep;
            const char* a2 = last ? nA : cA + (size_t)(t + 2) * kstep; const char* b2 = last ? nB : cB + (size_t)(t + 2) * kstep;
            const char* a3 = a2 + kstep; const char* b3 = b2 + kstep;
            if (last && has_next) S.a_ready(nxt);
            if constexpr (SP2) {
            PG8_LDB(B0, 0, 0); PG8_LDB(B1, 0, 1); PG8_SCHED; PG8_LDA(At, 0, 0); PG8_STAGE(PG8_SA(1, 1), a1 + hstep, voffA);
            PG8_WAIT_V(8); PG8_WAIT_L(0); PG8_BAR; PG8_MMA(0, 0, At, B0); PG8_MMA(0, 1, At, B1); PG8_BAR; PG8_SCHED;
            PG8_LDA(At, 0, 1); PG8_STAGE(PG8_SB(0, 0), b2, voffB); PG8_STAGE(PG8_SB(0, 1), b2 + hstep, voffB); PG8_STAGE(PG8_SA(0, 0), a2, voffA);
            PG8_WAIT_V(8); PG8_WAIT_L(0); PG8_BAR; PG8_MMA(1, 0, At, B0); PG8_MMA(1, 1, At, B1); PG8_BAR; PG8_SCHED;
            PG8_LDB(B0, 1, 0); PG8_LDB(B1, 1, 1); PG8_SCHED; PG8_LDA(At, 1, 0); PG8_STAGE(PG8_SA(0, 1), a2 + hstep, voffA);
            PG8_WAIT_V(8); PG8_WAIT_L(0); PG8_BAR; PG8_MMA(0, 0, At, B0); PG8_MMA(0, 1, At, B1); PG8_BAR; PG8_SCHED;
            PG8_LDA(At, 1, 1); PG8_STAGE(PG8_SB(1, 0), b3, voffB); PG8_STAGE(PG8_SB(1, 1), b3 + hstep, voffB); PG8_STAGE(PG8_SA(1, 0), a3, voffA);
            PG8_WAIT_V(8); PG8_WAIT_L(0); PG8_BAR; PG8_MMA(1, 0, At, B0); PG8_MMA(1, 1, At, B1); PG8_BAR; PG8_SCHED;
            } else {
            PG8_LDB(B0, 0, 0); PG8_SCHED; PG8_LDA(At, 0, 0); PG8_STAGE(PG8_SA(1, 1), a1 + hstep, voffA);
            PG8_WAIT_L(8); PG8_BAR; PG8_WAIT_L(0); PG8_MMA(0, 0, At, B0); PG8_BAR; PG8_SCHED;
            PG8_LDB(B1, 0, 1); PG8_STAGE(PG8_SB(0, 0), b2, voffB);
            PG8_BAR; PG8_WAIT_L(0); PG8_MMA(0, 1, At, B1); PG8_BAR;
            PG8_LDA(At, 0, 1); PG8_STAGE(PG8_SA(0, 0), a2, voffA);
            PG8_BAR; PG8_WAIT_L(0); PG8_MMA(1, 0, At, B0); PG8_BAR; PG8_SCHED;
            PG8_STAGE(PG8_SB(0, 1), b2 + hstep, voffB);
            PG8_WAIT_V(6); PG8_BAR; PG8_MMA(1, 1, At, B1); PG8_BAR;
            PG8_LDB(B0, 1, 0); PG8_SCHED; PG8_LDA(At, 1, 0); PG8_STAGE(PG8_SA(0, 1), a2 + hstep, voffA);
            PG8_WAIT_L(8); PG8_BAR; PG8_WAIT_L(0); PG8_MMA(0, 0, At, B0); PG8_BAR; PG8_SCHED;
            PG8_LDB(B1, 1, 1); PG8_STAGE(PG8_SB(1, 0), b3, voffB);
            PG8_BAR; PG8_WAIT_L(0); PG8_MMA(0, 1, At, B1); PG8_BAR;
            PG8_LDA(At, 1, 1); PG8_STAGE(PG8_SA(1, 0), a3, voffA);
            PG8_BAR; PG8_WAIT_L(0); PG8_MMA(1, 0, At, B0); PG8_BAR; PG8_SCHED;
            PG8_STAGE(PG8_SB(1, 1), b3 + hstep, voffB);
            PG8_WAIT_V(6); PG8_BAR; PG8_MMA(1, 1, At, B1); PG8_BAR;
            }
        }
        if constexpr (ALIGN_EPI) { if (wr == 0) PG8_BAR; }
        if constexpr (!Epi::AFTER_DRAIN) { E(acc, cur, wr, wc, fr, fq); S.done(cur); }
        if (!has_next) break;
#pragma unroll
        for (int a = 0; a < 2; ++a)
#pragma unroll
            for (int b = 0; b < 2; ++b)
#pragma unroll
                for (int m = 0; m < 4; ++m)
#pragma unroll
                    for (int n = 0; n < 2; ++n) acc[a][b][m][n] = (f32x4){0.f, 0.f, 0.f, 0.f};
        cur = nxt; cA = nA; cB = nB; ++ui;
        if constexpr (ALIGN_EPI) { if (wr == 1) PG8_BAR; }
    }
    PG8_WAIT_V(0);
    if constexpr (!ALIGN_EPI) { if (wr == 0) PG8_BAR; }
    PG8_BAR;
    if constexpr (Epi::AFTER_DRAIN) { E.fused(acc, cur, wr, wc, fr, fq, lds, wid, lane); S.done(cur); }
#undef PG8_SA
#undef PG8_SB
#undef PG8_STAGE
#undef PG8_LDA
#undef PG8_LDB
#undef PG8_MMA
#undef PG8_WAIT_V
#undef PG8_WAIT_L
#undef PG8_BAR
#undef PG8_SCHED
}
}
namespace pg8 {
template <class Epi, class Sched, bool ALIGN_EPI>
__device__ __forceinline__ void gemm_phase_gather(PG8_LAS unsigned char* lds, const Gemm g, const Sched& S, const Epi& E, const PG8_LAS unsigned short* rows16) {
    int tid_ = threadIdx.x; asm volatile("" : "+v"(tid_));
    const int tid = tid_, wid = __builtin_amdgcn_readfirstlane(tid >> 6), lane = tid & 63, wr = wid >> 2, wc = wid & 3, fr = lane & 15, fq = lane >> 4;
    const int K = g.K, nt = K / BK;
    unsigned voffB[2]; int RA[2]; unsigned CA2[2];
#pragma unroll
    for (int i = 0; i < 2; ++i) { int R, C; stage_rc(tid * 16 + i * 8192, R, C); const int Rb = Epi::PERM ? ((R & ~31) + perm32(R & 31)) : R;
        RA[i] = R; CA2[i] = (unsigned)C * 2u; voffB[i] = (unsigned)(Rb * K + C) * 2u; }
    const size_t kstep = (size_t)(BK * 2);
    const size_t hstep = (size_t)HALF * K * 2;
    const size_t tstep = 2 * hstep;
    const unsigned ldsw = (unsigned)wid * 1024u;
    const unsigned rowb = (unsigned)K * 2u;
    const int aoff = lds_byte(wr * 64 + fr, fq * 8), boff = lds_byte(wc * 32 + fr, fq * 8);
#define PG8_SA(b, h) (((b) * 2 + (h)) * HTB)
#define PG8_SB(b, h) ((4 + (b) * 2 + (h)) * HTB)
#define PG8_STAGE(bufoff, gbase, voff) do { _Pragma("unroll") for (int _i = 0; _i < 2; ++_i) \
        __builtin_amdgcn_global_load_lds((const unsigned*)((const char*)(gbase) + (voff)[_i]), (PG8_LAS unsigned*)(lds + (bufoff) + ldsw + _i * 8192), 16, 0, 0); } while (0)
#define PG8_LDA(dst, b, h) do { _Pragma("unroll") for (int m = 0; m < 4; ++m) _Pragma("unroll") for (int k = 0; k < 2; ++k) dst[m][k] = *(const PG8_LAS bf16x8*)(lds + PG8_SA(b, h) + aoff + m * 2048 + k * 1024); } while (0)
#define PG8_LDB(dst, b, h) do { _Pragma("unroll") for (int n = 0; n < 2; ++n) _Pragma("unroll") for (int k = 0; k < 2; ++k) dst[n][k] = *(const PG8_LAS bf16x8*)(lds + PG8_SB(b, h) + boff + n * 2048 + k * 1024); } while (0)
#define PG8_MMA(ai, bj, At, Bt) do { __builtin_amdgcn_s_setprio(1); _Pragma("unroll") for (int m = 0; m < 4; ++m) _Pragma("unroll") for (int n = 0; n < 2; ++n) _Pragma("unroll") for (int k = 0; k < 2; ++k) \
        acc[ai][bj][m][n] = __builtin_amdgcn_mfma_f32_16x16x32_bf16(Bt[n][k], At[m][k], acc[ai][bj][m][n], 0, 0, 0); __builtin_amdgcn_s_setprio(0); } while (0)
#define PG8_WAIT_V(n) asm volatile("s_waitcnt vmcnt(" #n ")" ::: "memory")
#define PG8_WAIT_L(n) asm volatile("s_waitcnt lgkmcnt(" #n ")" ::: "memory")
#define PG8_BAR __builtin_amdgcn_s_barrier()
#define PG8_SCHED __builtin_amdgcn_sched_barrier(0)
#define PG8_GOFF(dst, U) do { _Pragma("unroll") for (int h_ = 0; h_ < 2; ++h_) _Pragma("unroll") for (int i_ = 0; i_ < 2; ++i_) dst[h_][i_] = (unsigned)rows16[(U) * 256 + h_ * HALF + RA[i_]] * rowb + CA2[i_]; } while (0)
    Unit cur, nxt; int ui = 0;
    if (!S.next(0, cur)) return;
    f32x4 acc[2][2][4][2];
#pragma unroll
    for (int a = 0; a < 2; ++a)
#pragma unroll
        for (int b = 0; b < 2; ++b)
#pragma unroll
            for (int m = 0; m < 4; ++m)
#pragma unroll
                for (int n = 0; n < 2; ++n) acc[a][b][m][n] = (f32x4){0.f, 0.f, 0.f, 0.f};
    bf16x8 At[4][2], B0[2][2], B1[2][2];
    const char* const Ab = (const char*)g.A;
    const char* cB = (const char*)g.Bt + (size_t)cur.pn * tstep;
    unsigned gc[2][2], gn[2][2];
    PG8_GOFF(gc, 0);
    S.a_ready(cur);
    PG8_STAGE(PG8_SB(0, 0), cB, voffB); PG8_STAGE(PG8_SB(0, 1), cB + hstep, voffB); PG8_STAGE(PG8_SA(0, 0), Ab, gc[0]); PG8_STAGE(PG8_SA(0, 1), Ab, gc[1]);
    if (wr == 1) PG8_BAR;
    PG8_WAIT_V(2); PG8_BAR;
    PG8_STAGE(PG8_SB(1, 0), cB + kstep, voffB); PG8_STAGE(PG8_SA(1, 0), Ab + kstep, gc[0]); PG8_STAGE(PG8_SB(1, 1), cB + hstep + kstep, voffB);
    PG8_WAIT_V(6); PG8_BAR;
    for (;;) {
        const bool has_next = S.next(ui + 1, nxt);
        const char* nB = has_next ? (const char*)g.Bt + (size_t)nxt.pn * tstep : cB;
        if (has_next) { PG8_GOFF(gn, ui + 1); } else {
#pragma unroll
            for (int h_ = 0; h_ < 2; ++h_)
#pragma unroll
                for (int i_ = 0; i_ < 2; ++i_) gn[h_][i_] = gc[h_][i_]; }
        for (int t = 0; t < nt; t += 2) {
            const bool last = (t == nt - 2);
            const char* a1 = Ab + (size_t)(t + 1) * kstep;
            const char* a2 = last ? Ab : Ab + (size_t)(t + 2) * kstep; const char* b2 = last ? nB : cB + (size_t)(t + 2) * kstep;
            const char* a3 = a2 + kstep; const char* b3 = b2 + kstep;
            unsigned g2[2][2];
#pragma unroll
            for (int h_ = 0; h_ < 2; ++h_)
#pragma unroll
                for (int i_ = 0; i_ < 2; ++i_) g2[h_][i_] = last ? gn[h_][i_] : gc[h_][i_];
            if (last && has_next) S.a_ready(nxt);
            PG8_LDB(B0, 0, 0); PG8_LDB(B1, 0, 1); PG8_SCHED; PG8_LDA(At, 0, 0); PG8_STAGE(PG8_SA(1, 1), a1, gc[1]);
            PG8_WAIT_V(8); PG8_WAIT_L(0); PG8_BAR; PG8_MMA(0, 0, At, B0); PG8_MMA(0, 1, At, B1); PG8_BAR; PG8_SCHED;
            PG8_LDA(At, 0, 1); PG8_STAGE(PG8_SB(0, 0), b2, voffB); PG8_STAGE(PG8_SB(0, 1), b2 + hstep, voffB); PG8_STAGE(PG8_SA(0, 0), a2, g2[0]);
            PG8_WAIT_V(8); PG8_WAIT_L(0); PG8_BAR; PG8_MMA(1, 0, At, B0); PG8_MMA(1, 1, At, B1); PG8_BAR; PG8_SCHED;
            PG8_LDB(B0, 1, 0); PG8_LDB(B1, 1, 1); PG8_SCHED; PG8_LDA(At, 1, 0); PG8_STAGE(PG8_SA(0, 1), a2, g2[1]);
            PG8_WAIT_V(8); PG8_WAIT_L(0); PG8_BAR; PG8_MMA(0, 0, At, B0); PG8_MMA(0, 1, At, B1); PG8_BAR; PG8_SCHED;
            PG8_LDA(At, 1, 1); PG8_STAGE(PG8_SB(1, 0), b3, voffB); PG8_STAGE(PG8_SB(1, 1), b3 + hstep, voffB); PG8_STAGE(PG8_SA(1, 0), a3, g2[0]);
            PG8_WAIT_V(8); PG8_WAIT_L(0); PG8_BAR; PG8_MMA(1, 0, At, B0); PG8_MMA(1, 1, At, B1); PG8_BAR; PG8_SCHED;
        }
        if constexpr (ALIGN_EPI) { if (wr == 0) PG8_BAR; }
        E(acc, cur, wr, wc, fr, fq); S.done(cur);
        if (!has_next) break;
#pragma unroll
        for (int a = 0; a < 2; ++a)
#pragma unroll
            for (int b = 0; b < 2; ++b)
#pragma unroll
                for (int m = 0; m < 4; ++m)
#pragma unroll
                    for (int n = 0; n < 2; ++n) acc[a][b][m][n] = (f32x4){0.f, 0.f, 0.f, 0.f};
        cur = nxt; cB = nB; ++ui;
#pragma unroll
        for (int h_ = 0; h_ < 2; ++h_)
#pragma unroll
            for (int i_ = 0; i_ < 2; ++i_) gc[h_][i_] = gn[h_][i_];
        if constexpr (ALIGN_EPI) { if (wr == 1) PG8_BAR; }
    }
    PG8_WAIT_V(0);
    if constexpr (!ALIGN_EPI) { if (wr == 0) PG8_BAR; }
    PG8_BAR;
#undef PG8_SA
#undef PG8_SB
#undef PG8_STAGE
#undef PG8_LDA
#undef PG8_LDB
#undef PG8_MMA
#undef PG8_WAIT_V
#undef PG8_WAIT_L
#undef PG8_BAR
#undef PG8_SCHED
#undef PG8_GOFF
}
}
namespace pg8 {
typedef int v8i __attribute__((ext_vector_type(8)));
typedef int v4i __attribute__((ext_vector_type(4)));
template <class Epi, class Sched, bool ALIGN_EPI, bool GATHER>
__device__ __forceinline__ void gemm_phase_fp8(PG8_LAS unsigned char* lds, const Gemm g, const Sched& S, const Epi& E, const PG8_LAS unsigned short* rows16) {
    int tid_ = threadIdx.x; asm volatile("" : "+v"(tid_));
    const int tid = tid_, wid = __builtin_amdgcn_readfirstlane(tid >> 6), lane = tid & 63, wr = wid >> 2, wc = wid & 3, fr = lane & 15, fq = lane >> 4;
    const int K = g.K, nt = K / 128;
    unsigned voffB[2];
#pragma unroll
    for (int i = 0; i < 2; ++i) { int R, C; stage_rc(tid * 16 + i * 8192, R, C); const int Rb = Epi::PERM ? ((R & ~31) + perm32(R & 31)) : R;
        voffB[i] = (unsigned)(Rb * K) + (unsigned)C * 2u; }
    const size_t kstep = (size_t)(BK * 2);
    const size_t hstep = (size_t)HALF * K;
    const size_t tstep = 2 * hstep;
    const unsigned ldsw = (unsigned)wid * 1024u;
    const unsigned rowb = (unsigned)K;
    const int aoff = lds_byte(wr * 64 + fr, fq * 8), boff = lds_byte(wc * 32 + fr, fq * 8);
#define PG8_SA(b, h) (((b) * 2 + (h)) * HTB)
#define PG8_SB(b, h) ((4 + (b) * 2 + (h)) * HTB)
#define PG8_STAGE(bufoff, gbase, voff) do { _Pragma("unroll") for (int _i = 0; _i < 2; ++_i) \
        __builtin_amdgcn_global_load_lds((const unsigned*)((const char*)(gbase) + (voff)[_i]), (PG8_LAS unsigned*)(lds + (bufoff) + ldsw + _i * 8192), 16, 0, 0); } while (0)
#define PG8_LDA(dst, b, h) do { _Pragma("unroll") for (int m = 0; m < 4; ++m) { const v4i lo_ = *(const PG8_LAS v4i*)(lds + PG8_SA(b, h) + aoff + m * 2048), hi_ = *(const PG8_LAS v4i*)(lds + PG8_SA(b, h) + aoff + m * 2048 + 1024); dst[m] = __builtin_shufflevector(lo_, hi_, 0, 1, 2, 3, 4, 5, 6, 7); } } while (0)
#define PG8_LDB(dst, b, h) do { _Pragma("unroll") for (int n = 0; n < 2; ++n) { const v4i lo_ = *(const PG8_LAS v4i*)(lds + PG8_SB(b, h) + boff + n * 2048), hi_ = *(const PG8_LAS v4i*)(lds + PG8_SB(b, h) + boff + n * 2048 + 1024); dst[n] = __builtin_shufflevector(lo_, hi_, 0, 1, 2, 3, 4, 5, 6, 7); } } while (0)
#define PG8_F8(x) (x)
#define PG8_MMA(ai, bj, At, Bt) do { __builtin_amdgcn_s_setprio(1); _Pragma("unroll") for (int m = 0; m < 4; ++m) _Pragma("unroll") for (int n = 0; n < 2; ++n) \
        asm volatile("v_mfma_scale_f32_16x16x128_f8f6f4 %0, %1, %2, %0, %3, %4 op_sel_hi:[0,0,0]" : "+v"(acc[ai][bj][m][n]) : "v"(Bt[n]), "v"(At[m]), "v"(sc2_), "v"(sc1_)); __builtin_amdgcn_s_setprio(0); } while (0)
#define PG8_MMAZ(ai, bj, At, Bt) do { __builtin_amdgcn_s_setprio(1); _Pragma("unroll") for (int m = 0; m < 4; ++m) _Pragma("unroll") for (int n = 0; n < 2; ++n) \
        asm volatile("v_mfma_scale_f32_16x16x128_f8f6f4 %0, %1, %2, 0, %3, %4 op_sel_hi:[0,0,0]" : "=v"(acc[ai][bj][m][n]) : "v"(Bt[n]), "v"(At[m]), "v"(sc2_), "v"(sc1_)); __builtin_amdgcn_s_setprio(0); } while (0)
#define PG8_WAIT_V(n) asm volatile("s_waitcnt vmcnt(" #n ")" ::: "memory")
#define PG8_WAIT_L(n) asm volatile("s_waitcnt lgkmcnt(" #n ")" ::: "memory")
#define PG8_BAR __builtin_amdgcn_s_barrier()
#define PG8_SCHED __builtin_amdgcn_sched_barrier(0)
#define PG8_GOFF(dst, U, PM) do { int t2_ = tid; asm volatile("" : "+v"(t2_)); _Pragma("unroll") for (int i_ = 0; i_ < 2; ++i_) { int R_, C_; stage_rc(t2_ * 16 + i_ * 8192, R_, C_); _Pragma("unroll") for (int h_ = 0; h_ < 2; ++h_) \
        dst[h_][i_] = (GATHER ? (unsigned)rows16[(U) * 256 + h_ * HALF + R_] : (unsigned)((PM) * 256 + h_ * HALF + R_)) * rowb + (unsigned)C_ * 2u; } } while (0)
    Unit cur, nxt; int ui = 0;
    if (!S.next(0, cur)) return;
    int sc1_ = 0x7f7f7f7f, sc2_ = 0x79797979; asm volatile("" : "+v"(sc1_), "+v"(sc2_));
    f32x4 acc[2][2][4][2];
    v8i At[4], B0[2], B1[2];
    const char* const Ab = (const char*)g.A;
    const char* cB = (const char*)g.Bt + (size_t)cur.pn * tstep;
    unsigned gc[2][2], gn[2][2];
    PG8_GOFF(gc, 0, cur.pm);
    S.a_ready(cur);
#define PG8_BIAS(U, SLOT) do { if constexpr (Epi::HAS_BIAS) if (wid == 0) __builtin_amdgcn_global_load_lds((const unsigned*)E.bias_src((U), lane), (PG8_LAS unsigned*)(E.bl + (SLOT) * 256), 16, 0, 0); } while (0)
    PG8_BIAS(cur, 0);
    PG8_STAGE(PG8_SB(0, 0), cB, voffB); PG8_STAGE(PG8_SB(0, 1), cB + hstep, voffB); PG8_STAGE(PG8_SA(0, 0), Ab, gc[0]); PG8_STAGE(PG8_SA(0, 1), Ab, gc[1]);
    if (wr == 1) PG8_BAR;
    PG8_WAIT_V(2); PG8_BAR;
    PG8_STAGE(PG8_SB(1, 0), cB + kstep, voffB); PG8_STAGE(PG8_SA(1, 0), Ab + kstep, gc[0]); PG8_STAGE(PG8_SB(1, 1), cB + hstep + kstep, voffB);
    PG8_WAIT_V(6); PG8_BAR;
    for (;;) {
        const bool has_next = S.next(ui + 1, nxt);
        const char* nB = has_next ? (const char*)g.Bt + (size_t)nxt.pn * tstep : cB;
        if (has_next) { PG8_GOFF(gn, ui + 1, nxt.pm); } else {
#pragma unroll
            for (int h_ = 0; h_ < 2; ++h_)
#pragma unroll
                for (int i_ = 0; i_ < 2; ++i_) gn[h_][i_] = gc[h_][i_]; }
#pragma unroll 1
        for (int t = 0; t < nt; t += 2) {
            const bool last = (t == nt - 2);
            const char* a1 = Ab + (size_t)(t + 1) * kstep;
            const char* a2 = last ? Ab : Ab + (size_t)(t + 2) * kstep; const char* b2 = last ? nB : cB + (size_t)(t + 2) * kstep;
            const char* a3 = a2 + kstep; const char* b3 = b2 + kstep;
            unsigned g2[2][2];
#pragma unroll
            for (int h_ = 0; h_ < 2; ++h_)
#pragma unroll
                for (int i_ = 0; i_ < 2; ++i_) g2[h_][i_] = last ? gn[h_][i_] : gc[h_][i_];
            if (last && has_next) S.a_ready(nxt);
            PG8_LDB(B0, 0, 0); PG8_LDB(B1, 0, 1); PG8_SCHED; PG8_LDA(At, 0, 0); PG8_STAGE(PG8_SA(1, 1), a1, gc[1]);
            PG8_WAIT_V(8); PG8_WAIT_L(0); PG8_BAR; if (t == 0) { PG8_MMAZ(0, 0, At, B0); PG8_MMAZ(0, 1, At, B1); } else { PG8_MMA(0, 0, At, B0); PG8_MMA(0, 1, At, B1); } PG8_BAR; PG8_SCHED;
            PG8_LDA(At, 0, 1); PG8_STAGE(PG8_SB(0, 0), b2, voffB); PG8_STAGE(PG8_SB(0, 1), b2 + hstep, voffB); PG8_STAGE(PG8_SA(0, 0), a2, g2[0]);
            PG8_WAIT_V(8); PG8_WAIT_L(0); PG8_BAR; if (t == 0) { PG8_MMAZ(1, 0, At, B0); PG8_MMAZ(1, 1, At, B1); } else { PG8_MMA(1, 0, At, B0); PG8_MMA(1, 1, At, B1); } PG8_BAR; PG8_SCHED;
            PG8_LDB(B0, 1, 0); PG8_LDB(B1, 1, 1); PG8_SCHED; PG8_LDA(At, 1, 0); PG8_STAGE(PG8_SA(0, 1), a2, g2[1]);
            PG8_WAIT_V(8); PG8_WAIT_L(0); PG8_BAR; PG8_MMA(0, 0, At, B0); PG8_MMA(0, 1, At, B1); PG8_BAR; PG8_SCHED;
            PG8_LDA(At, 1, 1); PG8_STAGE(PG8_SB(1, 0), b3, voffB); PG8_STAGE(PG8_SB(1, 1), b3 + hstep, voffB); PG8_STAGE(PG8_SA(1, 0), a3, g2[0]);
            PG8_WAIT_V(8); PG8_WAIT_L(0); PG8_BAR; PG8_MMA(1, 0, At, B0); PG8_MMA(1, 1, At, B1); PG8_BAR; PG8_SCHED;
        }
        if constexpr (ALIGN_EPI) { if (wr == 0) PG8_BAR; }
        asm volatile("s_nop 15\n\ts_nop 15" ::: "memory");
        E(acc, cur, wr, wc, fr, fq, ui & 1); S.done(cur);
        if (!has_next) break;
        PG8_BIAS(nxt, (ui + 1) & 1);
        cur = nxt; cB = nB; ++ui;
#pragma unroll
        for (int h_ = 0; h_ < 2; ++h_)
#pragma unroll
            for (int i_ = 0; i_ < 2; ++i_) gc[h_][i_] = gn[h_][i_];
        if constexpr (ALIGN_EPI) { if (wr == 1) PG8_BAR; }
    }
    PG8_WAIT_V(0);
    if constexpr (!ALIGN_EPI) { if (wr == 0) PG8_BAR; }
    PG8_BAR;
#undef PG8_SA
#undef PG8_SB
#undef PG8_STAGE
#undef PG8_LDA
#undef PG8_LDB
#undef PG8_MMA
#undef PG8_MMAZ
#undef PG8_WAIT_V
#undef PG8_WAIT_L
#undef PG8_BAR
#undef PG8_SCHED
#undef PG8_GOFF
#undef PG8_F8
#undef PG8_BIAS
}
}
#define GAS __attribute__((address_space(1)))
#define LAS __attribute__((address_space(3)))
typedef unsigned short bf16;
typedef unsigned v4u __attribute__((ext_vector_type(4)));
typedef float f32x4 __attribute__((ext_vector_type(4)));
typedef short bf16x8 __attribute__((ext_vector_type(8)));
typedef GAS unsigned gu32;
typedef GAS unsigned long long gu64;
#define RLX_AGENT __ATOMIC_RELAXED, __HIP_MEMORY_SCOPE_AGENT
#define LDS_WAIT() asm volatile("s_waitcnt lgkmcnt(0)" ::: "memory")
#define VM_WAIT() asm volatile("s_waitcnt vmcnt(0)" ::: "memory")
__device__ __forceinline__ unsigned long long rt() { return __builtin_amdgcn_s_memrealtime(); }
__device__ __forceinline__ unsigned f2bf(float f) { unsigned u = __builtin_bit_cast(unsigned, f); return (u + 0x7fffu + ((u >> 16) & 1u)) >> 16; }
__device__ __forceinline__ unsigned pk2(float lo, float hi) { return f2bf(lo) | (f2bf(hi) << 16); }
#define XB_TMO      128
#define XB_XCNT(j)  (256  + 64 * (j))
#define XB_XSUB(j)  (1280 + 64 * (j))
#define XB_XGEN(j)  (2304 + 64 * (j))
#define XB_TOP      3328
#define XB_TOPGEN   3392
#define XCD_BAR_WORDS 3456
#define XB_SPIN_CAP (1u << 18)

__device__ __forceinline__ unsigned xb_ld(unsigned* p)              { return __hip_atomic_load(p, __ATOMIC_RELAXED, __HIP_MEMORY_SCOPE_AGENT); }
__device__ __forceinline__ unsigned xb_add(unsigned* p, unsigned v) { return __hip_atomic_fetch_add(p, v, __ATOMIC_RELAXED, __HIP_MEMORY_SCOPE_AGENT); }
__device__ __forceinline__ unsigned xb_xcc_id() { return (unsigned)__builtin_amdgcn_s_getreg((3 << 11) | 20) & 0xFu; }
#define XB_SPIN(cond, bar) do { unsigned _sp = 0; while (cond) { __builtin_amdgcn_s_sleep(1); \
    if ((++_sp & 255u) == 0u) { if (xb_ld(&(bar)[XB_TMO])) break; if (_sp > XB_SPIN_CAP) { atomicAdd(&(bar)[XB_TMO], 1u); break; } } } } while (0)

struct XcdBarrier {
    unsigned* bar; unsigned x;
    volatile LAS unsigned* st;
};

__device__ __forceinline__ XcdBarrier xcd_barrier_post(unsigned* bar, volatile LAS unsigned* st) {
    XcdBarrier b; b.bar = bar; b.x = xb_xcc_id(); b.st = st;
    if (threadIdx.x == 0) (void)xb_add(&bar[XB_XCNT(b.x)], 1u);
    return b;
}
__device__ __forceinline__ void xcd_barrier_complete(unsigned* bar, unsigned x, unsigned& nloc, unsigned& nx) {
    const unsigned G = gridDim.x * gridDim.y * gridDim.z;
    unsigned sum, cnt, mine, sp = 0u;
    for (;;) {
        sum = 0u; cnt = 0u; mine = 0u;
#pragma unroll
        for (unsigned j = 0; j < 16; ++j) { const unsigned c = xb_ld(&bar[XB_XCNT(j)]); sum += c; cnt += (c > 0u) ? 1u : 0u; mine = (j == x) ? c : mine; }
        if (sum == G) break;
        __builtin_amdgcn_s_sleep(1);
        if ((++sp & 255u) == 0u) { if (xb_ld(&bar[XB_TMO])) break; if (sp > XB_SPIN_CAP) { atomicAdd(&bar[XB_TMO], 1u); break; } }
    }
    nloc = mine > 0u ? mine : 1u; nx = cnt > 0u ? cnt : 1u;
}

__device__ __forceinline__ void xcd_barrier(const XcdBarrier& b) {
    asm volatile("s_waitcnt vmcnt(0)" ::: "memory");
    __syncthreads();
    if (threadIdx.x == 0) {
        unsigned* bar = b.bar;
        __builtin_amdgcn_s_waitcnt(0);
        unsigned nloc = b.st[0], nx = b.st[1];
        if (nloc == 0u) { xcd_barrier_complete(bar, b.x, nloc, nx); b.st[0] = nloc; b.st[1] = nx; }
        const unsigned old = xb_add(&bar[XB_XSUB(b.x)], 1u);
        const unsigned gen = old / nloc;
        if (old + 1u == (gen + 1u) * nloc) {
            __builtin_amdgcn_fence(__ATOMIC_RELEASE, "agent");
            asm volatile("s_waitcnt vmcnt(0)" ::: "memory");
            const unsigned og = xb_add(&bar[XB_TOP], 1u);
            const unsigned tg = og / nx;
            if (og + 1u == (tg + 1u) * nx) xb_add(&bar[XB_TOPGEN], 1u);
            else XB_SPIN(xb_ld(&bar[XB_TOPGEN]) == tg, bar);
            __builtin_amdgcn_fence(__ATOMIC_ACQUIRE, "agent");
            xb_add(&bar[XB_XGEN(b.x)], 1u);
            asm volatile("s_waitcnt vmcnt(0)" ::: "memory");
        } else {
            XB_SPIN(xb_ld(&bar[XB_XGEN(b.x)]) == gen, bar);
            __builtin_amdgcn_fence(__ATOMIC_ACQUIRE, "agent");
            asm volatile("s_waitcnt vmcnt(0)" ::: "memory");
        }
    }
    __syncthreads();
}
namespace attn_body {
using bf16=__hip_bfloat16;
using bf16x8=__attribute__((ext_vector_type(8)))short;
using s16x4=__attribute__((ext_vector_type(4)))short;
using f32x16=__attribute__((ext_vector_type(16)))float;
using u32x4=__attribute__((ext_vector_type(4)))unsigned;
typedef int v8i_t __attribute__((ext_vector_type(8))); typedef int v4i_t __attribute__((ext_vector_type(4)));
constexpr int BATCH=8,NHEAD=8,NKVH=2,SEQ=4096,D=64;
constexpr int DMQ=512,DMK=128,DMV=2048,DMO=1024;
constexpr int NW=8,QBLK=32,QB=QBLK*NW,KVBLK=64,NQB=SEQ/QB;
constexpr int ATTN_UNIT_ROWS=QB;
__device__ __forceinline__ int crow(int r,int hi){return (r&3)+8*(r>>2)+4*hi;}
#define SBAR() __builtin_amdgcn_sched_barrier(0)
__device__ __forceinline__ void cmask(f32x16&p0,f32x16&p1,int jb,int qrel,int hi){
  const float NEG=-INFINITY; int kb=64*jb+4*hi;
  #pragma unroll
  for(int r=0;r<16;++r){int kv=kb+(r&3)+8*(r>>2); if(kv>qrel)p0[r]=NEG; if(kv+32>qrel)p1[r]=NEG;}
}

constexpr int NSLOT=3, SLOTB=8192;
constexpr int LDS_K=0, LDS_V=NSLOT*SLOTB, LDS_WS=2*NSLOT*SLOTB, LDS_OST=LDS_WS+NW*64*4, LDS_BYTES=LDS_OST+NW*4096;
constexpr float C2=0.125f*1.4426950408889634f;
__device__ __forceinline__ void glds16(const void*gsrc,unsigned lds_dst){unsigned keep;
  asm volatile("s_mov_b32 %0, m0\n\ts_mov_b32 m0, %2\n\ts_nop 0\n\tglobal_load_lds_dwordx4 %1, off\n\ts_mov_b32 m0, %0":"=&s"(keep):"v"(gsrc),"s"(lds_dst):"memory");}
__device__ __forceinline__ float max3f(float a,float b,float c){float r;asm("v_max3_f32 %0, %1, %2, %3":"=v"(r):"v"(a),"v"(b),"v"(c));return r;}
__device__ __forceinline__ float max2f(float a,float b){float r;asm("v_max_f32_e32 %0, %1, %2":"=v"(r):"v"(a),"v"(b));return r;}
__device__ __forceinline__ float fadd_s(float a,float b){float r;asm("v_add_f32_e32 %0, %1, %2":"=v"(r):"v"(a),"v"(b));return r;}
__device__ __forceinline__ float fsub_s(float a,float b){float r;asm("v_sub_f32_e32 %0, %1, %2":"=v"(r):"v"(a),"v"(b));return r;}
typedef float f32x2_t __attribute__((ext_vector_type(2))); typedef __bf16 bf16x2_t __attribute__((ext_vector_type(2)));
__device__ __forceinline__ unsigned cvtpk_s(float lo,float hi){f32x2_t v={lo,hi};bf16x2_t b=__builtin_convertvector(v,bf16x2_t);return __builtin_bit_cast(unsigned,b);}
#define WAIT_BAR(N) asm volatile("s_waitcnt vmcnt(" #N ") lgkmcnt(0)\n\ts_barrier":::"memory")
#define WAIT_BAR2() WAIT_BAR(1)

#define QK8(DST,KF,QF,CSRC) asm volatile("v_mfma_scale_f32_32x32x64_f8f6f4 %0, %1, %2, %3, %4, %5 op_sel_hi:[0,0,0]":"=&v"(DST):"v"(KF),"v"(QF),"v"(CSRC),"v"(scK_),"v"(scQ_))
#define QK8Z(DST,KF,QF) asm volatile("v_mfma_scale_f32_32x32x64_f8f6f4 %0, %1, %2, 0, %3, %4 op_sel_hi:[0,0,0]":"=v"(DST):"v"(KF),"v"(QF),"v"(scK_),"v"(scQ_))
typedef __attribute__((address_space(3))) const char* lds_cptr;
typedef short v4i16_t __attribute__((ext_vector_type(4)));
__device__ __forceinline__ v8i_t kloadh(lds_cptr kp,int ko0,int ko1,int kk){ const v4i_t lo=*(const __attribute__((address_space(3))) v4i_t*)(kp+kk*2048+ko0), hi_=*(const __attribute__((address_space(3))) v4i_t*)(kp+kk*2048+ko1); return __builtin_shufflevector(lo,hi_,0,1,2,3,4,5,6,7); }
__device__ __forceinline__ s16x4 vtr(lds_cptr p){ return __builtin_bit_cast(s16x4,__builtin_amdgcn_ds_read_tr16_b64_v4i16((__attribute__((address_space(3))) v4i16_t*)p)); }
__device__ __forceinline__ float rowmax(const f32x16&p0,const f32x16&p1){
  float a=max3f(p0[0],p0[1],p1[0]),b=max3f(p0[2],p0[3],p1[1]);a=max3f(a,p1[2],p1[3]);
  #pragma unroll
  for(int r=4;r<16;r+=4){a=max3f(a,p0[r],p0[r+1]);b=max3f(b,p0[r+2],p0[r+3]);a=max3f(a,p1[r],p1[r+1]);b=max3f(b,p1[r+2],p1[r+3]);}
  const float m=max2f(a,b);
  auto rr=__builtin_amdgcn_permlane32_swap(__float_as_uint(m),__float_as_uint(m),false,false);
  return max2f(__uint_as_float(rr[0]),__uint_as_float(rr[1]));
}
__device__ __forceinline__ void pv(f32x16*o,int vb,bf16x8 pa0,bf16x8 pa1,bf16x8 pa2,bf16x8 pa3){
  #pragma unroll
  for(int d0=0;d0<2;++d0){s16x4 lo[4],hi[4];
    #pragma unroll
    for(int ks=0;ks<4;++ks){
      asm volatile("ds_read_b64_tr_b16 %0,%1 offset:%c2":"=&v"(lo[ks]):"v"(vb),"i"(d0*4096+ks*1024):"memory");
      asm volatile("ds_read_b64_tr_b16 %0,%1 offset:%c2":"=&v"(hi[ks]):"v"(vb),"i"(d0*4096+ks*1024+512):"memory");}
    asm volatile("s_waitcnt lgkmcnt(0)":::"memory");SBAR();
    #define PK(k) (bf16x8){lo[k][0],lo[k][1],lo[k][2],lo[k][3],hi[k][0],hi[k][1],hi[k][2],hi[k][3]}
    o[d0]=__builtin_amdgcn_mfma_f32_32x32x16_bf16(pa0,PK(0),o[d0],0,0,0);
    o[d0]=__builtin_amdgcn_mfma_f32_32x32x16_bf16(pa1,PK(1),o[d0],0,0,0);
    o[d0]=__builtin_amdgcn_mfma_f32_32x32x16_bf16(pa2,PK(2),o[d0],0,0,0);
    o[d0]=__builtin_amdgcn_mfma_f32_32x32x16_bf16(pa3,PK(3),o[d0],0,0,0);
    #undef PK
  }
}

#ifndef ATTN_STORE16
#define ATTN_STORE16(p,v) (*(u32x4*)(p)=(v))
#endif
template<int THRL,bool FIXED> __device__ __forceinline__ void attn_unit(int b,int h,int qb,const bf16*Q,const bf16*__restrict__ K,const bf16*__restrict__ V,bf16*O,char*shm,float bref){
  int tid_=threadIdx.x; asm volatile("":"+v"(tid_)); const int tid=tid_,lane=tid&63,r32=lane&31,hi=lane>>5; const int wid=__builtin_amdgcn_readfirstlane(tid>>6);
  const long rowbase=(long)b*SEQ; const int q0=qb*QB;
  const unsigned char*Qw8=(const unsigned char*)Q+((rowbase+q0+wid*QBLK)*512+h*64); const int kvh=h>>2;
  const unsigned char*Kh8=(const unsigned char*)K+(long)((b*NKVH+kvh)*(SEQ/KVBLK))*4096;
  const unsigned lds0=(unsigned)(uintptr_t)shm;
  float*wsf=(float*)(shm+LDS_WS)+wid*64;
  const unsigned char*ksrc8=Kh8+(wid&3)*1024+lane*16;
  const unsigned char*vsrc8=(const unsigned char*)V+(long)((b*NKVH+kvh)*(SEQ/KVBLK))*4096+(wid&3)*1024+lane*16;
  const unsigned kdst=lds0+LDS_K+(wid&3)*1024, vdst=lds0+LDS_V+(wid&3)*1024;
  #define DMA_K(t,slot) do{ if(wid<4) glds16(ksrc8+(long)(t)*4096,(unsigned)__builtin_amdgcn_readfirstlane(kdst+(slot))); }while(0)
  #define DMA_V(t,slot) do{ if(wid>=4) glds16(vsrc8+(long)(t)*4096,(unsigned)__builtin_amdgcn_readfirstlane(vdst+(slot))); }while(0)
  const int vb0=(int)(lds0+LDS_V)+((lane>>4)&1)*32+(lane&3)*8+(4*hi+((lane&15)>>2))*64;
  v8i_t kf[2];
  int scK_=0x7f7f7f7f,scQ_=0x7c7c7c7c; asm volatile("":"+v"(scK_),"+v"(scQ_));
  const lds_cptr shm3=(lds_cptr)shm; const lds_cptr kp0=shm3+LDS_K+r32*64; const int ksw_=(r32>>2)&3, ko0=((2*hi)^ksw_)*16, ko1=((2*hi+1)^ksw_)*16; const lds_cptr vp0=shm3+LDS_V+r32*64;
  constexpr int NT=SEQ/KVBLK;
  DMA_K(0,0);DMA_V(0,0);DMA_K(1,SLOTB);
  v8i_t q8; { const v4i_t lo=*reinterpret_cast<const v4i_t*>(Qw8+(long)r32*512+hi*32), hi_=*reinterpret_cast<const v4i_t*>(Qw8+(long)r32*512+hi*32+16); q8=__builtin_shufflevector(lo,hi_,0,1,2,3,4,5,6,7); }
  float mhat=0.f,l_reg=0.f;f32x16 o[2];o[0]=f32x16{};o[1]=f32x16{};f32x16 negm=f32x16{}; if constexpr(FIXED){ _Pragma("unroll") for(int r=0;r<16;++r)negm[r]=8.75f-bref; }     asm volatile("":"+v"(negm));
  #define CMASK(P0,P1,t) do{}while(0)
  bool resc=false;
  #define START(P0,P1) do{ if constexpr(!FIXED){ const float rm=rowmax(P0,P1); resc=false; \
    { const float dl=rm; mhat=fadd_s(mhat,dl); \
      _Pragma("unroll") for(int r=0;r<16;++r){P0[r]=fsub_s(P0[r],dl);P1[r]=fsub_s(P1[r],dl);} \
      _Pragma("unroll") for(int r=0;r<16;++r)negm[r]=-mhat; asm volatile("":"+v"(negm)); } } \
    _Pragma("unroll") for(int r=0;r<16;++r)P0[r]=__builtin_amdgcn_exp2f(P0[r]); }while(0)
  #define RESC() do{ if constexpr(!FIXED) if(resc){ asm volatile("s_waitcnt lgkmcnt(0)":::"memory"); \
      _Pragma("unroll") for(int d_=0;d_<2;++d_) _Pragma("unroll") for(int r=0;r<16;++r)o[d_][r]*=wsf[crow(r,hi)]; } }while(0)
  f32x16 pA0,pA1,pB0,pB1;
  int sl_prev=0,sl_cur=0,sl_next=SLOTB;
  #define ROT() do{sl_prev=sl_cur;sl_cur=sl_next;sl_next=(sl_next==(NSLOT-1)*SLOTB)?0:sl_next+SLOTB;}while(0)
  DMA_K(2,2*SLOTB);
  WAIT_BAR(3);
  { const v8i_t k0_=kloadh(kp0,ko0,ko1,0),k1_=kloadh(kp0,ko0,ko1,1); if constexpr(FIXED){ QK8(pA0,k0_,q8,negm); QK8(pA1,k1_,q8,negm); } else { QK8(pA0,k0_,q8,negm); QK8(pA1,k1_,q8,negm); } }
  asm volatile("s_nop 15\n\ts_nop 15\n\ts_nop 15":"+v"(pA0),"+v"(pA1));CMASK(pA0,pA1,0);
  START(pA0,pA1);
  _Pragma("unroll") for(int r=0;r<16;++r)pA1[r]=__builtin_amdgcn_exp2f(pA1[r]);
  WAIT_BAR(0);
  DMA_K(3,0);DMA_V(1,SLOTB);
  ROT();
  kf[0]=kloadh(kp0+sl_cur,ko0,ko1,0); kf[1]=kloadh(kp0+sl_cur,ko0,ko1,1);
  WAIT_BAR(2);
  v8i_t vf[2]; v8i_t pwv; int scP_=0x7f7f7f7f; asm volatile("":"+v"(scP_));
  #define PK8A(i,P,B) pwv[i]=__builtin_amdgcn_cvt_pk_fp8_f32(P[B],P[(B)+1],0,false)
  #define PK8B(i,P,B) pwv[i]=__builtin_amdgcn_cvt_pk_fp8_f32(P[(B)+2],P[(B)+3],pwv[i],true)
  #define PV8(ACC,VF) asm volatile("v_mfma_scale_f32_32x32x64_f8f6f4 %0, %1, %2, %0, %3, %3 op_sel_hi:[0,0,0]":"+v"(ACC):"v"(pwv),"v"(VF),"v"(scP_))
  #define PIN(x) asm volatile("":"+v"(x))
  #define MX3(a,b,c) __builtin_fmaxf(__builtin_fmaxf((a),(b)),(c))
  #define GAPA(MF,A0,A1,A2,A3,W0,W1,PW) do{ MF; sacc+=A0; sacc+=A1; sacc+=A2; sacc+=A3; PIN(sacc); W0; W1; PIN(PW); SBAR(); }while(0)
  #define EX(v) __builtin_amdgcn_exp2f(v)
  #define GAPB(MF,X,B) do{ MF; X[B]=EX(X[B]); X[B+1]=EX(X[B+1]); X[B+2]=EX(X[B+2]); X[B+3]=EX(X[B+3]); PIN(X); SBAR(); }while(0)
  #define VRD(i) do{ vf[i]=kloadh(vp_,ko0,ko1,(i)); }while(0)
  #define KRD(G,j) do{ if(G){ if((j)==0)kf[0]=kloadh(kp0+sl_next,ko0,ko1,0); if((j)==2)kf[1]=kloadh(kp0+sl_next,ko0,ko1,1); SBAR(); } }while(0)
  #define STEP(C0,C1,P0,P1,t,GK,GV,GL) do{ SBAR(); \
    const lds_cptr vp_=vp0+sl_prev; \
    VRD(0); SBAR(); float sacc=(P0[0]+P0[1]); \
    GAPA(QK8(C0,kf[0],q8,negm), P0[2],P0[3],P0[4],P0[5],     PK8A(0,P0,0), PK8B(0,P0,0), pwv); \
    VRD(1); SBAR(); GAPA(QK8(C1,kf[1],q8,negm), P0[6],P0[7],P0[8],P0[9],     PK8A(1,P0,4), PK8B(1,P0,4), pwv); \
    GAPA((void)0,   P0[10],P0[11],P0[12],P0[13], PK8A(2,P0,8), PK8B(2,P0,8), pwv); \
    GAPA((void)0,   P0[14],P0[15],P1[0],P1[1],   PK8A(3,P0,12),PK8B(3,P0,12), pwv); \
    GAPA((void)0,   P1[2],P1[3],P1[4],P1[5],     PK8A(4,P1,0), PK8B(4,P1,0), pwv); \
    GAPA((void)0,   P1[6],P1[7],P1[8],P1[9],     PK8A(5,P1,4), PK8B(5,P1,4), pwv); \
    GAPA((void)0,   P1[10],P1[11],P1[12],P1[13], PK8A(6,P1,8), PK8B(6,P1,8), pwv); \
    GAPA((void)0,   P1[14],P1[15],0.f,0.f,       PK8A(7,P1,12),PK8B(7,P1,12), pwv); \
    l_reg+=sacc; \
    if(GK){DMA_K((t)+3,sl_cur);} if(GV){DMA_V((t)+1,sl_next);} \
    CMASK(C0,C1,t); \
    if constexpr(!FIXED){ float a=MX3(C0[0],C0[1],C1[0]),b=MX3(C0[2],C0[3],C1[1]); a=MX3(a,C1[2],C1[3]); \
      _Pragma("unroll") for(int r=4;r<16;r+=4){a=MX3(a,C0[r],C0[r+1]);b=MX3(b,C0[r+2],C0[r+3]);a=MX3(a,C1[r],C1[r+1]);b=MX3(b,C1[r+2],C1[r+3]);} \
      float rm=__builtin_fmaxf(a,b); { auto rr=__builtin_amdgcn_permlane32_swap(__float_as_uint(rm),__float_as_uint(rm),false,false); rm=__builtin_fmaxf(__uint_as_float(rr[0]),__uint_as_float(rr[1])); } \
      resc=false; \
      if(__builtin_expect(__any(rm>(float)THRL),0)){ const float dl=__builtin_fmaxf(rm,0.f); mhat+=dl; \
        _Pragma("unroll") for(int r=0;r<16;++r){C0[r]-=dl;C1[r]-=dl;} \
        _Pragma("unroll") for(int r=0;r<16;++r)negm[r]=-mhat; asm volatile("":"+v"(negm)); \
        const float f=__builtin_amdgcn_exp2f(-dl); l_reg*=f; if(hi==0)wsf[r32]=f; resc=true; } } \
    SBAR(); \
    GAPB(PV8(o[0],vf[0]), C0,0); \
    GAPB(PV8(o[1],vf[1]), C0,4); \
    KRD(GL,0); GAPB((void)0, C0,8); \
    KRD(GL,1); GAPB((void)0, C0,12); \
    KRD(GL,2); GAPB((void)0, C1,0); \
    KRD(GL,3); GAPB((void)0, C1,4); \
    GAPB((void)0, C1,8); \
    GAPB((void)0, C1,12); \
    }while(0)
  int t=1;
  #undef CMASK
  #define CMASK(P0,P1,t) do{}while(0)
  for(;t+5<NT;t+=2){
    STEP(pB0,pB1,pA0,pA1,t,true,true,true);     WAIT_BAR2(); RESC(); ROT();
    STEP(pA0,pA1,pB0,pB1,t+1,true,true,true);   WAIT_BAR2(); RESC(); ROT();
  }
  #undef CMASK
  #define CMASK(P0,P1,t) do{}while(0)
  #define ENDW(tt) WAIT_BAR(0)
  for(;t+1<NT;t+=2){
    STEP(pB0,pB1,pA0,pA1,t,(t+3<NT),(t+1<NT),(t+1<NT));       ENDW(t);   RESC(); ROT();
    STEP(pA0,pA1,pB0,pB1,t+1,(t+4<NT),(t+2<NT),(t+2<NT));     ENDW(t+1); RESC(); ROT();
  }
  STEP(pB0,pB1,pA0,pA1,NT-1,false,false,false); RESC();
  { float sacc=pB0[0]+pB0[1]; _Pragma("unroll") for(int r=2;r<16;++r)sacc+=pB0[r]; _Pragma("unroll") for(int r=0;r<16;++r)sacc+=pB1[r]; l_reg+=sacc;
    PK8A(0,pB0,0);PK8B(0,pB0,0);PK8A(1,pB0,4);PK8B(1,pB0,4);PK8A(2,pB0,8);PK8B(2,pB0,8);PK8A(3,pB0,12);PK8B(3,pB0,12);PK8A(4,pB1,0);PK8B(4,pB1,0);PK8A(5,pB1,4);PK8B(5,pB1,4);PK8A(6,pB1,8);PK8B(6,pB1,8);PK8A(7,pB1,12);PK8B(7,pB1,12);
    SBAR(); vf[0]=kloadh(vp0+sl_cur,ko0,ko1,0); vf[1]=kloadh(vp0+sl_cur,ko0,ko1,1); PV8(o[0],vf[0]); PV8(o[1],vf[1]); asm volatile("s_nop 15\n\ts_nop 15\n\ts_nop 15\n\ts_nop 15\n\ts_nop 7":"+v"(o[0]),"+v"(o[1])); }
  #undef PK8A
  #undef PK8B
  #undef PV8
  #undef PIN
  #undef MX3
  #undef GAPA
  #undef GAPB
  #undef EX
  #undef VRD
  #undef KRD
  #undef STEP
  #undef ENDW
  {auto rr=__builtin_amdgcn_permlane32_swap(__float_as_uint(l_reg),__float_as_uint(l_reg),false,false);l_reg=__uint_as_float(rr[0])+__uint_as_float(rr[1]);}
  if(hi==0)wsf[32+r32]=l_reg;asm volatile("s_waitcnt lgkmcnt(0)":::"memory");
  float rli[16];
  #pragma unroll
  for(int r=0;r<16;++r)rli[r]=__builtin_amdgcn_rcpf(wsf[32+crow(r,hi)]);
  bf16*Ow=O+(rowbase+q0+wid*QBLK)*DMO+h*D;
  { bf16*stg=(bf16*)(shm+LDS_OST)+wid*2048;
    #pragma unroll
    for(int r=0;r<16;++r){const int orow=crow(r,hi);
      #pragma unroll
      for(int d0=0;d0<2;++d0)stg[orow*64+d0*32+r32]=__float2bfloat16(o[d0][r]*rli[r]);}
    asm volatile("s_waitcnt lgkmcnt(0)":::"memory");
    #pragma unroll
    for(int i=0;i<4;++i){const int row=i*8+(lane>>3),ch=lane&7; const u32x4 v=*(const u32x4*)(stg+row*64+ch*8); ATTN_STORE16(Ow+(long)row*DMO+ch*8,v);} }
  asm volatile("s_waitcnt lgkmcnt(0)\n\ts_barrier":::"memory");
  #undef DMA_K
  #undef DMA_V
  #undef CMASK
  #undef START
  #undef RESC
  #undef ROT
}
constexpr int ATTN_LDS_BYTES=LDS_BYTES;
struct AttnTensors { const bf16* Q; const bf16* K; const bf16* V; bf16* O; };
struct AttnUnit { int bh; int qb; };
struct StaticOrder {
  int vcu, G;
  __device__ __forceinline__ explicit StaticOrder(int grid,int block):vcu((grid%8==0)?(block%8)*(grid/8)+block/8:block),G(grid){}
  __device__ __forceinline__ bool next(int i,AttnUnit&u)const{ const int per=(BATCH*NHEAD*NQB+G-1)/G; if(i>=per)return false; const int idx=vcu*per+i; if(idx>=BATCH*NHEAD*NQB)return false;
    const int qb=idx%NQB, hq=(idx/NQB)&3, bk=idx/(NQB*4), kvh=bk&1, b=bk>>1; u.bh=b*NHEAD+kvh*4+hq; u.qb=qb; return true; }
  __device__ __forceinline__ void a_ready(const AttnUnit&)const{}
  __device__ __forceinline__ void done(const AttnUnit&)const{}
};
template<class Sched,int THRL=8> __device__ __forceinline__ void attn_phase(char*lds,const AttnTensors&T,const Sched&S,float bref){
  AttnUnit u;
  if(bref>=0.f&&bref<=56.f){ for(int i=0;S.next(i,u);++i){ S.a_ready(u); attn_unit<THRL,true>(u.bh/NHEAD,u.bh%NHEAD,u.qb,T.Q,T.K,T.V,T.O,lds,bref); S.done(u); } }
  else { for(int i=0;S.next(i,u);++i){ S.a_ready(u); attn_unit<THRL,false>(u.bh/NHEAD,u.bh%NHEAD,u.qb,T.Q,T.K,T.V,T.O,lds,0.f); S.done(u); } }
}
#undef SBAR
#undef WAIT_BAR
#undef WAIT_BAR2
#undef QK8
#undef QK8Z
}
constexpr int NB = 8, SEQ = 4096, DM = 1024, NL = 4, NTOK = NB * SEQ;
constexpr int INW = 1824, INP = 2048;
constexpr int C_AQ = 0, C_AK = 512, C_AV = 640, C_GQ = 768, C_GK = 896, C_GV = 1024, C_GR = 1280, C_FX = 1536, C_GLR = 1792;
constexpr int NE = 32, TOPK = 4, DE = 1024;
constexpr int MPAD = NTOK * TOPK + NE * 256;
constexpr float LN_EPS = 1e-5f, RMS_EPS = 1e-6f;
constexpr float DN_ALPHA = 1.681792830507429f;
constexpr float QSCALE = 0.125f * 1.4426950408889634f;
constexpr float GLA_QSCALE = 0.17677669529663687f;

constexpr size_t MiB = 1u << 20;
constexpr size_t WS_CTL = 0, CTL_ZERO_BYTES = 256 * 1024;
constexpr size_t WS_ROPE = 1 * MiB;
constexpr size_t WS_WIN_T = 2 * MiB;
constexpr size_t WS_WOUT_T = 18 * MiB;
constexpr size_t WS_FTAB = 26 * MiB;
constexpr size_t WS_TW = WS_FTAB + 65536;
constexpr size_t WS_RWT = WS_FTAB + 131072;
constexpr size_t WS_FTMP = 27 * MiB;
constexpr size_t WS_WGU_T = 90 * MiB;
constexpr size_t WS_WDN_T = 602 * MiB;
constexpr size_t WS_HF = 858 * MiB;
constexpr size_t WS_HB = 986 * MiB;
constexpr size_t WS_PROJ = 1050 * MiB;
constexpr size_t WS_QB = 1178 * MiB;
constexpr size_t WS_KB = 1210 * MiB;
constexpr size_t WS_MIX = 1218 * MiB;
constexpr size_t WS_T1 = 1282 * MiB;
constexpr size_t WS_UVT = 1410 * MiB;
constexpr size_t WS_LA = 1442 * MiB;
constexpr size_t WS_OF = 1474 * MiB;
constexpr size_t WS_OB = 1506 * MiB;
constexpr size_t WS_TOK = 1538 * MiB;
constexpr size_t WS_XS = 1542 * MiB;
constexpr size_t WS_HID = 1814 * MiB;
constexpr size_t WS_YS = 2086 * MiB;
constexpr size_t WS_HB8L = 2358 * MiB;
constexpr size_t WS_END = 2390 * MiB;
static_assert((size_t)MPAD * 2048 == 272 * MiB, "sorted buffers");
constexpr int CW_TMO = 0, CW_CODE = 1, CW_BAR = 4096, CW_CNT = 8192;

constexpr int RING_OFF = 0, RING_BYTES = 131072;
constexpr int LDSCTL_OFF = RING_BYTES;
constexpr int LDS_BYTES = 163840;
constexpr int LC_MISC = 0;
constexpr int LC_PSTART = 128;
constexpr int LC_ULIST = 384;
constexpr int LC_CNT = 640;
constexpr int LC_BASE = 768;
constexpr int LC_SELE = 1024;
constexpr int LC_SELS = 1024 + 2048;
constexpr int LC_COS64 = 5120;
constexpr int LC_ROWS = 6144;
constexpr int LC_LG = 16384;

constexpr int NWAVES = 8;
constexpr int N_PHASES = 1 + 10 * NL;

typedef float f32x2_t __attribute__((ext_vector_type(2))); typedef __bf16 bf16x2_t __attribute__((ext_vector_type(2)));
__device__ __forceinline__ unsigned cvtpk2(float lo, float hi) { f32x2_t v = {lo, hi}; bf16x2_t b = __builtin_convertvector(v, bf16x2_t); return __builtin_bit_cast(unsigned, b); }
#define pk2(lo, hi) cvtpk2((lo), (hi))
__device__ __forceinline__ unsigned pk4_fp8(float a, float b, float c, float d) { int w = 0; w = __builtin_amdgcn_cvt_pk_fp8_f32(a, b, w, false); w = __builtin_amdgcn_cvt_pk_fp8_f32(c, d, w, true); return (unsigned)w; }
constexpr float W8_SCALE = 64.f, W8_INV = 1.f / 64.f;
#define f2bf(x) (cvtpk2((x), 0.f) & 0xffffu)
__device__ __forceinline__ float bf2f(unsigned short b) { return __uint_as_float((unsigned)b << 16); }
__device__ __forceinline__ float wave_sum(float v) {
#pragma unroll
    for (int o = 1; o < 64; o <<= 1) v += __shfl_xor(v, o);
    return v;
}
typedef unsigned short u16x8 __attribute__((ext_vector_type(8)));
typedef unsigned short u16x4 __attribute__((ext_vector_type(4)));

typedef float f32x2v __attribute__((ext_vector_type(2)));
__device__ __forceinline__ void tr_task(const float* W, int K, int Nsrc, int srcn, bf16* WT, int dst_n, int k0) {
#pragma unroll 1
    for (int hf = 0; hf < 2; ++hf) { const int kk = k0 + hf * 64; f32x2v v[64];
        if (srcn >= 0) { const float* p = W + (size_t)kk * Nsrc + srcn;
#pragma unroll
            for (int i = 0; i < 64; ++i) v[i] = __builtin_nontemporal_load((const f32x2v*)(p + (size_t)i * Nsrc)); }
        else {
#pragma unroll
            for (int i = 0; i < 64; ++i) v[i] = (f32x2v){0.f, 0.f}; }
        bf16* o0 = WT + (size_t)dst_n * K + kk; bf16* o1 = o0 + K;
#pragma unroll
        for (int j = 0; j < 8; ++j) { v4u w0, w1;
            w0.x = pk2(v[8 * j].x, v[8 * j + 1].x); w0.y = pk2(v[8 * j + 2].x, v[8 * j + 3].x); w0.z = pk2(v[8 * j + 4].x, v[8 * j + 5].x); w0.w = pk2(v[8 * j + 6].x, v[8 * j + 7].x);
            w1.x = pk2(v[8 * j].y, v[8 * j + 1].y); w1.y = pk2(v[8 * j + 2].y, v[8 * j + 3].y); w1.z = pk2(v[8 * j + 4].y, v[8 * j + 5].y); w1.w = pk2(v[8 * j + 6].y, v[8 * j + 7].y);
            *(v4u*)(o0 + 8 * j) = w0; *(v4u*)(o1 + 8 * j) = w1; } }
}

#define RC(l, j) (((j) >> 1) * 512 + 8 * (l) + ((j) & 1) * 4)
__device__ __forceinline__ void row_load_bf16(f32x4 (&v)[4], const bf16* row, int lane) {
#pragma unroll
    for (int h = 0; h < 2; ++h) { const v4u t = *(const v4u*)(row + h * 512 + 8 * lane);
        v[2 * h] = (f32x4){__uint_as_float(t.x << 16), __uint_as_float(t.x & 0xffff0000u), __uint_as_float(t.y << 16), __uint_as_float(t.y & 0xffff0000u)};
        v[2 * h + 1] = (f32x4){__uint_as_float(t.z << 16), __uint_as_float(t.z & 0xffff0000u), __uint_as_float(t.w << 16), __uint_as_float(t.w & 0xffff0000u)}; }
}
__device__ __forceinline__ void row_store_bf16(const f32x4 (&v)[4], bf16* row, int lane) {
#pragma unroll
    for (int h = 0; h < 2; ++h) { v4u w; w.x = pk2(v[2 * h].x, v[2 * h].y); w.y = pk2(v[2 * h].z, v[2 * h].w); w.z = pk2(v[2 * h + 1].x, v[2 * h + 1].y); w.w = pk2(v[2 * h + 1].z, v[2 * h + 1].w); *(v4u*)(row + h * 512 + 8 * lane) = w; }
}
__device__ __forceinline__ void ln_row8(f32x4 (&v)[4], const f32x4 (&gam)[4], const f32x4 (&bet)[4]) {
    float s = 0.f;
#pragma unroll
    for (int j = 0; j < 4; ++j) s += (v[j].x + v[j].y) + (v[j].z + v[j].w);
    const float mean = wave_sum(s) * (1.f / DM); float s2 = 0.f;
#pragma unroll
    for (int j = 0; j < 4; ++j) { v[j] = v[j] - mean; s2 += (v[j].x * v[j].x + v[j].y * v[j].y) + (v[j].z * v[j].z + v[j].w * v[j].w); }
    const float rstd = __builtin_amdgcn_rsqf(wave_sum(s2) * (1.f / DM) + LN_EPS);
#pragma unroll
    for (int j = 0; j < 4; ++j) v[j] = v[j] * rstd * gam[j] + bet[j];
}

constexpr int GM_QF = 0, GM_KF = 5120, GM_QB = 10240, GM_KB = 15360, GM_VT = 20480, GM_P = 29696, GM_HTF = 38912, GM_HTB = 44032, GM_DL = 38912, GM_RG = 49152, GM_SLOT = 65536;
#define LBAR() asm volatile("s_waitcnt lgkmcnt(0)\n\ts_barrier" ::: "memory")
static_assert(2 * GM_SLOT <= RING_BYTES, "two GLA chunk images fit the phase scratch");
#define MFMA16(a, b, c) __builtin_amdgcn_mfma_f32_16x16x32_bf16((a), (b), (c), 0, 0, 0)
template <bool OUT>
__device__ __forceinline__ void gla_stage_mfma(LAS unsigned char* Ls, const bf16* PROJ, const float* LA, const float* HIN, size_t tok0, int hd, int w4, int lane) {
    if (w4 < 2) { const int dir = w4, g = lane >> 3, c4 = (lane & 7) * 4; f32x4 bc[8]; u16x4 kx[8], qx[8];
        const float* lap = LA + (tok0 + 8 * g) * 256 + dir * 128 + hd * 32 + c4; const bf16* xp = PROJ + (tok0 + 8 * g) * INP + hd * 32 + c4;
#pragma unroll
        for (int i = 0; i < 8; ++i) { bc[i] = *(const f32x4*)(lap + (size_t)i * 256); kx[i] = *(const u16x4*)(xp + (size_t)i * INP + C_GK); if (OUT) qx[i] = *(const u16x4*)(xp + (size_t)i * INP + C_GQ); }
        f32x4 inc;
        if (dir == 0) {
#pragma unroll
            for (int i = 1; i < 8; ++i) bc[i] = bc[i] + bc[i - 1];
            inc = bc[7];
#pragma unroll
            for (int o = 1; o < 8; o <<= 1) { f32x4 y; y.x = __shfl_up(inc.x, 8 * o); y.y = __shfl_up(inc.y, 8 * o); y.z = __shfl_up(inc.z, 8 * o); y.w = __shfl_up(inc.w, 8 * o); if (g >= o) inc = inc + y; }
            const f32x4 off = inc - bc[7];
#pragma unroll
            for (int i = 0; i < 8; ++i) bc[i] = bc[i] + off; }
        else {
#pragma unroll
            for (int i = 6; i >= 0; --i) bc[i] = bc[i] + bc[i + 1];
            inc = bc[0];
#pragma unroll
            for (int o = 1; o < 8; o <<= 1) { f32x4 y; y.x = __shfl_down(inc.x, 8 * o); y.y = __shfl_down(inc.y, 8 * o); y.z = __shfl_down(inc.z, 8 * o); y.w = __shfl_down(inc.w, 8 * o); if (g + o < 8) inc = inc + y; }
            const f32x4 off = inc - bc[0];
#pragma unroll
            for (int i = 0; i < 8; ++i) bc[i] = bc[i] + off; }
        if (OUT) { LAS bf16* qd = (LAS bf16*)(Ls + (dir ? GM_QB : GM_QF)) + (8 * g) * 40 + c4; LAS bf16* kd = (LAS bf16*)(Ls + (dir ? GM_KB : GM_KF)) + (8 * g) * 40 + c4;
#pragma unroll
            for (int i = 0; i < 8; ++i) { float qv[4], kv[4];
#pragma unroll
                for (int c = 0; c < 4; ++c) { const float e_ = __expf(fmaxf(bc[i][c], -60.f)); qv[c] = bf2f(qx[i][c]) * GLA_QSCALE * e_; kv[c] = bf2f(kx[i][c]) * __builtin_amdgcn_rcpf(e_); }
                *(LAS unsigned long long*)(qd + i * 40) = (unsigned long long)pk2(qv[0], qv[1]) | ((unsigned long long)pk2(qv[2], qv[3]) << 32);
                *(LAS unsigned long long*)(kd + i * 40) = (unsigned long long)pk2(kv[0], kv[1]) | ((unsigned long long)pk2(kv[2], kv[3]) << 32); } }
        else { LAS bf16* kt = (LAS bf16*)(Ls + GM_P + dir * 4608) + c4 * 72 + 8 * g;
#pragma unroll
            for (int c = 0; c < 4; ++c) { float t[8];
#pragma unroll
                for (int i = 0; i < 8; ++i) t[i] = bf2f(kx[i][c]) * __expf(fminf(-bc[i][c], 60.f));
                v4u w; w.x = pk2(t[0], t[1]); w.y = pk2(t[2], t[3]); w.z = pk2(t[4], t[5]); w.w = pk2(t[6], t[7]); *(LAS v4u*)(kt + c * 72) = w; }
            if (g == (dir ? 0 : 7)) { const f32x4 tot = dir ? bc[0] : bc[7]; LAS float* dl = (LAS float*)(Ls + GM_DL) + dir * 32 + c4; dl[0] = __expf(tot.x); dl[1] = __expf(tot.y); dl[2] = __expf(tot.z); dl[3] = __expf(tot.w); } } }
    else if (w4 == 2) { const int g = lane >> 3, v0 = (lane & 7) * 8; u16x8 x[8]; const bf16* xp = PROJ + (tok0 + 8 * g) * INP + C_GV + hd * 64 + v0;
#pragma unroll
        for (int i = 0; i < 8; ++i) x[i] = *(const u16x8*)(xp + (size_t)i * INP);
        u16x8 rgx[8];
        if (OUT) { const bf16* rp = PROJ + (tok0 + 8 * g) * INP + C_GR + hd * 64 + v0;
#pragma unroll
            for (int i = 0; i < 8; ++i) rgx[i] = *(const u16x8*)(rp + (size_t)i * INP); }
        LAS bf16* dst = (LAS bf16*)(Ls + GM_VT) + v0 * 72 + 8 * g;
#pragma unroll
        for (int c = 0; c < 8; ++c) { v4u w; w.x = (unsigned)x[0][c] | ((unsigned)x[1][c] << 16); w.y = (unsigned)x[2][c] | ((unsigned)x[3][c] << 16); w.z = (unsigned)x[4][c] | ((unsigned)x[5][c] << 16); w.w = (unsigned)x[6][c] | ((unsigned)x[7][c] << 16);
            *(LAS v4u*)(dst + c * 72) = w; }
        if (OUT) { LAS bf16* rd = (LAS bf16*)(Ls + GM_RG) + (8 * g) * 72 + v0;
#pragma unroll
            for (int i = 0; i < 8; ++i) *(LAS u16x8*)(rd + i * 72) = rgx[i]; } }
    else if (OUT) {
#pragma unroll
        for (int dir = 0; dir < 2; ++dir) { const f32x4* src = (const f32x4*)(HIN + ((size_t)dir * 64 + lane) * 32); LAS bf16* dst = (LAS bf16*)(Ls + (dir ? GM_HTB : GM_HTF)) + lane * 40;
#pragma unroll
            for (int c8 = 0; c8 < 4; ++c8) { const f32x4 a_ = src[2 * c8], b_ = src[2 * c8 + 1]; v4u w; w.x = pk2(a_.x, a_.y); w.y = pk2(a_.z, a_.w); w.z = pk2(b_.x, b_.y); w.w = pk2(b_.z, b_.w); *(LAS v4u*)(dst + c8 * 8) = w; } } }
}

typedef float f32x16 __attribute__((ext_vector_type(16)));
typedef short s16x4 __attribute__((ext_vector_type(4)));
__device__ __forceinline__ bf16x8 pack_step(const f32x16& x, int s) { v4u p; p.x = cvtpk2(x[8 * s], x[8 * s + 1]); p.y = cvtpk2(x[8 * s + 2], x[8 * s + 3]); p.z = cvtpk2(x[8 * s + 4], x[8 * s + 5]); p.w = cvtpk2(x[8 * s + 6], x[8 * s + 7]); return __builtin_bit_cast(bf16x8, p); }
__device__ __forceinline__ int crow16(int i, int h) { return (i & 3) + 8 * (i >> 2) + 4 * h; }
#define MFMA32(a, b, c) __builtin_amdgcn_mfma_f32_32x32x16_bf16((a), (b), (c), 0, 0, 0)
constexpr int FT_PITCH = 72, FT_TAB = 64 * FT_PITCH;
constexpr int FFT_LDS_TAB = 0, FFT_LDS_TW = 28672, FFT_LDS_HT = 28672, FFT_HT_PAIR = 2 * 64 * FT_PITCH * 2;

struct Args { const float* in[20]; float* out; unsigned char* ws; int ph_lo, ph_hi; };
static_assert(sizeof(Args) == 20 * 8 + 8 + 8 + 8, "no padding bytes in Args");


typedef __attribute__((address_space(4))) const unsigned char* kptr_t;
__device__ __forceinline__ kptr_t karg() { kptr_t p = (kptr_t)__builtin_amdgcn_kernarg_segment_ptr(); asm volatile("" : "+s"(p)); return p; }
#define KIN(i) (*(const float* const __attribute__((address_space(4)))*)(karg() + 8 * (i)))
#define KOUT() (*(float* const __attribute__((address_space(4)))*)(karg() + 160))
#define KWS() (*(unsigned char* const __attribute__((address_space(4)))*)(karg() + 168))
#define WSP(T, off) ((T*)(ws + (off)))

#ifndef NAIVE_ATTN
#define NAIVE_ATTN 0
#ifndef P2_TOKB
#define P2_TOKB 8
#endif
#ifndef P6_ROWS
#define P6_ROWS 16
#endif
#ifndef P3_BATCH
#define P3_BATCH 32
#endif
#endif

__global__ void __launch_bounds__(NWAVES * 64, 2) fwd(Args args) {
    extern __shared__ __attribute__((aligned(16))) unsigned char lds_raw[];
    LAS unsigned char* lds = (LAS unsigned char*)lds_raw;
    LAS unsigned char* lctl = lds + LDSCTL_OFF;
    const int G = gridDim.x, bx = blockIdx.x;
    const int NGW = G * NWAVES, NGT = G * NWAVES * 64;
#define TID_SETUP() int tid_ = threadIdx.x; asm volatile("" : "+v"(tid_)); const int tid = tid_, lane = tid & 63, wave = __builtin_amdgcn_readfirstlane(tid >> 6); \
    const int gw = bx * NWAVES + wave, gt = bx * (NWAVES * 64) + tid; (void)lane; (void)gw; (void)gt
    for (int u = threadIdx.x; u < (LDS_BYTES - LDSCTL_OFF) / 4; u += NWAVES * 64) ((LAS unsigned*)lctl)[u] = 0u;
    __syncthreads();
    volatile LAS unsigned* MISC = (volatile LAS unsigned*)(lctl + LC_MISC);
    XcdBarrier bar = xcd_barrier_post((unsigned*)(KWS() + WS_CTL) + CW_BAR, MISC + 8);
    const int lo = args.ph_lo, hi = args.ph_hi;
#ifndef PH_OFF
#define PH_OFF 0
#endif
#define PON(j) (!((PH_OFF >> (j)) & 1))
#define IN(k) (lo <= (k) && (k) < hi)
#ifndef PROBE_A
#define PROBE_A -1
#endif
#ifndef PROBE_B
#define PROBE_B -1
#endif
#if PROBE_A >= 0
#define STAMP(k) do { if (blockIdx.x == 0 && threadIdx.x == 0) { ((unsigned long long*)(KWS() + WS_CTL + 65536))[(k)] = __builtin_amdgcn_s_memrealtime(); } } while (0)
#define STAMP2(i) do { __syncthreads(); if (blockIdx.x == 0 && threadIdx.x == 0) { ((unsigned long long*)(KWS() + WS_CTL + 65536))[128 + l * 16 + (i)] = __builtin_amdgcn_s_memrealtime(); } } while (0)
#else
#define STAMP(k) do {} while (0)
#define STAMP2(i) do {} while (0)
#endif
#ifndef PROBE_SUB_A
#define PROBE_SUB_A -1
#define PROBE_SUB_B -1
#endif
#define SEAM(k) do { if (IN(k) && IN((k) + 1)) xcd_barrier(bar); STAMP((k) + 1); } while (0)
    STAMP(0);

    if (IN(0) && PON(0)) {
        TID_SETUP(); unsigned char* ws = KWS(); const float* x_in = KIN(0); const float* ln_in_g = KIN(1); const float* ln_in_b = KIN(2); const float* w_in = KIN(3); const float* w_out = KIN(9);
        const float* exp_w_gu = KIN(14); const float* exp_w_down = KIN(16);
        float* ROPE = WSP(float, WS_ROPE); bf16* WIN_T = WSP(bf16, WS_WIN_T); bf16* WOUT_T = WSP(bf16, WS_WOUT_T); bf16* WGU_T = WSP(bf16, WS_WGU_T); bf16* WDN_T = WSP(bf16, WS_WDN_T);
        bf16* HB = WSP(bf16, WS_HB); unsigned char* HB8L = WSP(unsigned char, WS_HB8L);
        { LAS unsigned* Lt = (LAS unsigned*)(lds + RING_OFF);
          constexpr int T_WIN = NL * 16 * 2, T_WOUT = NL * 8 * 4, T_WGU = NL * NE * 16 * 2, T_WDN = NL * NE * 8 * 2, NTILE = T_WIN + T_WOUT + T_WGU + T_WDN;
#define P0_DECODE_AND_LOAD(IT) do { int r = (IT); const float* W; int Nsrc, mode; \
            if (r < T_WIN) { const int l_ = r / 32, q = r % 32; nb = q / 2; kq = q % 2; W = w_in + (size_t)l_ * DM * INW; WT = (unsigned char*)WIN_T + (size_t)l_ * INP * DM; Nsrc = INW; mode = 0; f8 = 1; } \
            else if ((r -= T_WIN) < T_WOUT) { const int l_ = r / 32, q = r % 32; nb = q / 4; kq = q % 4; W = w_out + (size_t)l_ * DM * DM; WT = (unsigned char*)(WOUT_T + (size_t)l_ * DM * DM); Nsrc = DM; mode = 1; f8 = 0; } \
            else if ((r -= T_WOUT) < T_WGU) { const int le = r / 32, q = r % 32; nb = q / 2; kq = q % 2; W = exp_w_gu + (size_t)le * DM * 2048; WT = (unsigned char*)WGU_T + (size_t)le * 2048 * DM; Nsrc = 2048; mode = 2; f8 = 1; } \
            else { r -= T_WGU; const int le = r / 16, q = r % 16; nb = q / 2; kq = q % 2; W = exp_w_down + (size_t)le * DE * DM; WT = (unsigned char*)WDN_T + (size_t)le * DM * DE; Nsrc = DM; mode = 1; f8 = 1; } \
            const int n = nb * 128 + 2 * lane; int src = n; \
            if (mode == 0) src = n < 1536 ? n : (n < 1792 ? n + 32 : (n < 1824 ? n - 256 : -1)); \
            else if (mode == 2) { const int pn = n >> 8, bj = (n >> 7) & 1, j = n & 127; src = bj * 1024 + pn * 128 + j; } \
            if (f8 && src >= 0) { const float* p = W + (size_t)(kq * 512 + 64 * wave) * Nsrc + src; \
                _Pragma("unroll") for (int i = 0; i < 64; ++i) v[i] = __builtin_nontemporal_load((const f32x2v*)(p + (size_t)i * Nsrc)); } \
            else if (f8) { _Pragma("unroll") for (int i = 0; i < 64; ++i) v[i] = (f32x2v){0.f, 0.f}; } \
            else if (src >= 0) { const float* p = W + (size_t)(kq * 256 + 32 * wave) * Nsrc + src; \
                _Pragma("unroll") for (int i = 0; i < 32; ++i) v[i] = __builtin_nontemporal_load((const f32x2v*)(p + (size_t)i * Nsrc)); } \
            else { _Pragma("unroll") for (int i = 0; i < 32; ++i) v[i] = (f32x2v){0.f, 0.f}; } } while (0)
          f32x2v v[64]; unsigned char* WT; int nb, kq, f8;
          if (bx < NTILE) P0_DECODE_AND_LOAD(bx);
          for (int it = bx; it < NTILE; it += G) {
            __syncthreads();
            if (f8) {
#pragma unroll
                for (int i4 = 0; i4 < 16; ++i4) { Lt[(2 * lane) * 129 + 16 * wave + i4] = pk4_fp8(v[4 * i4].x * W8_SCALE, v[4 * i4 + 1].x * W8_SCALE, v[4 * i4 + 2].x * W8_SCALE, v[4 * i4 + 3].x * W8_SCALE);
                    Lt[(2 * lane + 1) * 129 + 16 * wave + i4] = pk4_fp8(v[4 * i4].y * W8_SCALE, v[4 * i4 + 1].y * W8_SCALE, v[4 * i4 + 2].y * W8_SCALE, v[4 * i4 + 3].y * W8_SCALE); } }
            else {
#pragma unroll
                for (int i2 = 0; i2 < 16; ++i2) { Lt[(2 * lane) * 129 + 16 * wave + i2] = pk2(v[2 * i2].x, v[2 * i2 + 1].x); Lt[(2 * lane + 1) * 129 + 16 * wave + i2] = pk2(v[2 * i2].y, v[2 * i2 + 1].y); } }
            __syncthreads();
            unsigned char* const WTc = WT; const int nbc = nb, kqc = kq; const int pitchc = f8 ? 1024 : 2048;
            if (it + G < NTILE) P0_DECODE_AND_LOAD(it + G);
            const int p4 = (lane & 31) * 4;
#pragma unroll
            for (int j = 0; j < 8; ++j) { const int row = 16 * wave + 2 * j + (lane >> 5); const LAS unsigned* lp = Lt + row * 129 + p4; v4u o; o.x = lp[0]; o.y = lp[1]; o.z = lp[2]; o.w = lp[3];
                *(v4u*)(WTc + (size_t)(nbc * 128 + row) * pitchc + kqc * 512 + 4 * p4) = o; }
          }
#undef P0_DECODE_AND_LOAD
          __syncthreads(); }
        { bf16* FTAB = WSP(bf16, WS_FTAB); float* TW = WSP(float, WS_TW);
          for (int it = gt; it < 3 * FT_TAB; it += NGT) { const int t = it / FT_TAB, q = it % FT_TAB, row = q / FT_PITCH, col = q % FT_PITCH; float sn, cs; sincospif((float)((row * col) & 63) * (1.0f / 32.0f), &sn, &cs);
              const float v = col >= 64 ? 0.f : (t == 0 ? cs : (t == 1 ? sn : -sn)); FTAB[it] = (bf16)f2bf(v); }
          for (int it = gt; it < 4096; it += NGT) { float sn, cs; sincospif((float)it * (1.0f / 2048.0f), &sn, &cs); TW[2 * it] = cs; TW[2 * it + 1] = -sn; } }
        { const float* router_w = KIN(12); bf16* RWT = WSP(bf16, WS_RWT);
          for (int it = gt; it < NL * NE * DM; it += NGT) { const int k = it & (DM - 1), e = (it >> 10) & 31, l = it >> 15; const float w = router_w[((size_t)l * DM + k) * NE + e];
              const unsigned hi = f2bf(w); const float lo = w - __uint_as_float(hi << 16); RWT[((size_t)(l * 2 + 0) * NE + e) * DM + k] = (bf16)hi; RWT[((size_t)(l * 2 + 1) * NE + e) * DM + k] = (bf16)f2bf(lo); } }
        for (int it = gt; it < SEQ * 32; it += NGT) { const int t = it >> 5, i = it & 31, a = i >> 4, f = i & 15; const int pos = a ? (t & 63) : (t >> 6);
            const double inv = exp(-9.210340371976184 * (double)f / 16.0); const double ang = (double)pos * inv;
            ROPE[it] = (float)cos(ang); ROPE[SEQ * 32 + it] = (float)sin(ang); }
        { f32x4 gam[4], bet[4];
#pragma unroll
          for (int j = 0; j < 4; ++j) { gam[j] = *(const f32x4*)(ln_in_g + RC(lane, j)); bet[j] = *(const f32x4*)(ln_in_b + RC(lane, j)); }
          for (int m0 = gw; m0 < NTOK; m0 += 2 * NGW) { f32x4 v[2][4];
#pragma unroll
            for (int q = 0; q < 2; ++q)
#pragma unroll
                for (int j = 0; j < 4; ++j) v[q][j] = *(const f32x4*)(x_in + (size_t)(m0 + q * NGW) * DM + RC(lane, j));
#pragma unroll
            for (int q = 0; q < 2; ++q) { ln_row8(v[q], gam, bet); row_store_bf16(v[q], HB + (size_t)(m0 + q * NGW) * DM, lane);
#pragma unroll
                for (int h = 0; h < 2; ++h) *(unsigned long long*)(HB8L + (size_t)(m0 + q * NGW) * DM + h * 512 + 8 * lane) = (unsigned long long)pk4_fp8(v[q][2 * h].x, v[q][2 * h].y, v[q][2 * h].z, v[q][2 * h].w) | ((unsigned long long)pk4_fp8(v[q][2 * h + 1].x, v[q][2 * h + 1].y, v[q][2 * h + 1].z, v[q][2 * h + 1].w) << 32); } } }
    }
    SEAM(0);

    for (int l = 0; l < NL; ++l) {
        const int pb = 1 + 10 * l;
        if (IN(pb + 0) && PON(1)) {
            TID_SETUP(); unsigned char* ws = KWS(); const unsigned char* HB8L = WSP(unsigned char, WS_HB8L); const unsigned char* WIN8 = WSP(unsigned char, WS_WIN_T); bf16* PROJ = WSP(bf16, WS_PROJ);
            pg8::Gemm g{(const pg8::bf16_t*)HB8L, (const pg8::bf16_t*)(WIN8 + (size_t)l * INP * DM), NTOK, INP, DM}; pg8::StaticOrder S; S.init(NTOK, INP, G, bx);
            pg8::EpiPlain8 E{PROJ, INP};
            STAMP2(2);
            pg8::gemm_phase_fp8<pg8::EpiPlain8, pg8::StaticOrder, true, false>(lds + RING_OFF, g, S, E, nullptr);
            STAMP2(3);
        }
        SEAM(pb + 0);
        if (IN(pb + 1) && PON(2)) {
            TID_SETUP(); unsigned char* ws = KWS(); const float* att_q_gain = KIN(4); const float* att_k_gain = KIN(5); const float* gla_gate_w = KIN(6); const float* gla_gate_b = KIN(7);
            const float* ROPE = WSP(float, WS_ROPE); const bf16* PROJ = WSP(bf16, WS_PROJ); bf16* QB = WSP(bf16, WS_QB); bf16* KB = WSP(bf16, WS_KB); float* LA = WSP(float, WS_LA);
            STAMP2(8);
            { LAS float* RTC = (LAS float*)(lds + RING_OFF + 65536);
              for (int i = tid; i < 1024; i += NWAVES * 64) { const int pos = i >> 4, f = i & 15; RTC[i] = ROPE[(pos * 64) * 32 + f]; RTC[1024 + i] = ROPE[SEQ * 32 + (pos * 64) * 32 + f]; RTC[2048 + i] = ROPE[pos * 32 + 16 + f]; RTC[3072 + i] = ROPE[SEQ * 32 + pos * 32 + 16 + f]; }
              __syncthreads();
              const int li = lane & 7, ax = li >> 2, f0 = 8 * (li & 1); const float sg = ((li >> 1) & 1) ? 1.f : -1.f;
              f32x4 qg8[2], kg8[2];
#pragma unroll
              for (int c = 0; c < 2; ++c) { qg8[c] = *(const f32x4*)(att_q_gain + l * 64 + 8 * li + 4 * c); kg8[c] = *(const f32x4*)(att_k_gain + l * 64 + 8 * li + 4 * c); }
              for (int m0 = gw; m0 < NTOK; m0 += 4 * NGW) { v4u xp[5];
#pragma unroll
                for (int i = 0; i < 5; ++i) { const int P = lane + 64 * i, q = P / 80, p = P % 80; xp[i] = *(const v4u*)(PROJ + (size_t)(m0 + q * NGW) * INP + p * 8); }
#pragma unroll
                for (int i = 0; i < 5; ++i) { const int P = lane + 64 * i, q = P / 80, p = P % 80, head = p >> 3; const size_t m = (size_t)(m0 + q * NGW); const int t = (int)(m & (SEQ - 1));
                    float xv[8] = {__uint_as_float(xp[i].x << 16), __uint_as_float(xp[i].x & 0xffff0000u), __uint_as_float(xp[i].y << 16), __uint_as_float(xp[i].y & 0xffff0000u),
                                   __uint_as_float(xp[i].z << 16), __uint_as_float(xp[i].z & 0xffff0000u), __uint_as_float(xp[i].w << 16), __uint_as_float(xp[i].w & 0xffff0000u)};
                    float ss = 0.f;
#pragma unroll
                    for (int c = 0; c < 8; ++c) ss += xv[c] * xv[c];
                    ss += __shfl_xor(ss, 1); ss += __shfl_xor(ss, 2); ss += __shfl_xor(ss, 4);
                    const float rs = __builtin_amdgcn_rsqf(ss * (1.f / 64.f) + RMS_EPS); const bool isq = head < 8;
                    const LAS float* tb = RTC + (ax ? 2048 : 0) + (ax ? (t & 63) : (t >> 6)) * 16 + f0;
                    const f32x4 c0 = *(const LAS f32x4*)tb, c1 = *(const LAS f32x4*)(tb + 4), s0 = *(const LAS f32x4*)(tb + 1024), s1 = *(const LAS f32x4*)(tb + 1028);
                    const float csv[8] = {c0.x, c0.y, c0.z, c0.w, c1.x, c1.y, c1.z, c1.w}, snv[8] = {s0.x, s0.y, s0.z, s0.w, s1.x, s1.y, s1.z, s1.w};
                    const f32x4 g0 = isq ? qg8[0] : kg8[0], g1 = isq ? qg8[1] : kg8[1]; const float gv[8] = {g0.x, g0.y, g0.z, g0.w, g1.x, g1.y, g1.z, g1.w};
                    const float osc = isq ? QSCALE * 8.f : 1.f; float o[8];
#pragma unroll
                    for (int c = 0; c < 8; ++c) { const float xn = xv[c] * rs * gv[c]; const float pr = __shfl_xor(xn, 2); o[c] = (xn * csv[c] + sg * pr * snv[c]) * osc; }
                    const unsigned long long w8 = (unsigned long long)pk4_fp8(o[0], o[1], o[2], o[3]) | ((unsigned long long)pk4_fp8(o[4], o[5], o[6], o[7]) << 32);
                    const int r_ = (int)(m & 63), c_ = li >> 1;
                    unsigned char* dst = isq ? ((unsigned char*)QB + m * 512 + head * 64 + 8 * li)
                                             : ((unsigned char*)KB + (size_t)((((m >> 12) * 2 + (head - 8)) * 64 + ((m & 4095) >> 6))) * 4096 + r_ * 64 + ((c_ ^ ((r_ >> 2) & 3)) * 16) + (li & 1) * 8);
                    *(unsigned long long*)dst = w8; } }
              int lane_v = lane; asm volatile("" : "+v"(lane_v));
              if (gw < NB * 2 * 64) { const int tile_ = gw & 63, kvh_ = (gw >> 6) & 1, b_ = gw >> 7; const size_t tok0 = (size_t)b_ * SEQ + tile_ * 64; const int g = lane_v >> 3, v0 = (lane_v & 7) * 8;
                u16x8 x[8]; const bf16* xp = PROJ + (tok0 + 8 * g) * INP + C_AV + kvh_ * 64 + v0;
#pragma unroll
                for (int i = 0; i < 8; ++i) x[i] = *(const u16x8*)(xp + (size_t)i * INP);
                unsigned char* tb = (unsigned char*)KB + 4 * MiB + (size_t)gw * 4096;
#pragma unroll
                for (int c = 0; c < 8; ++c) { const int d = v0 + c, sw = (d >> 2) & 3;
                    const unsigned lo = pk4_fp8(bf2f(x[0][c]), bf2f(x[1][c]), bf2f(x[2][c]), bf2f(x[3][c])), hi_ = pk4_fp8(bf2f(x[4][c]), bf2f(x[5][c]), bf2f(x[6][c]), bf2f(x[7][c]));
                    *(unsigned*)(tb + d * 64 + (((g >> 2) ^ sw) * 16) + 4 * (g & 3)) = lo;
                    *(unsigned*)(tb + d * 64 + (((2 + (g >> 2)) ^ sw) * 16) + 4 * (g & 3)) = hi_; } }
              const float* gw_l = gla_gate_w + (size_t)l * 2 * 16 * 128; const float* gb_l = gla_gate_b + (size_t)l * 2 * 128; const int dir = lane >> 5, kc = (lane & 31) * 4;
              f32x4 gwr[16]; const f32x4 gbv = *(const f32x4*)(gb_l + dir * 128 + kc);
#pragma unroll
              for (int r = 0; r < 16; ++r) gwr[r] = *(const f32x4*)(gw_l + (size_t)(dir * 16 + r) * 128 + kc);
              for (int m0 = gw; m0 < NTOK; m0 += P2_TOKB * NGW) { v4u gl[P2_TOKB][2];
#pragma unroll
                for (int q = 0; q < P2_TOKB; ++q) { const bf16* gp = PROJ + (size_t)(m0 + q * NGW) * INP + C_GLR + dir * 16; gl[q][0] = *(const v4u*)gp; gl[q][1] = *(const v4u*)(gp + 8); }
#pragma unroll
                for (int q = 0; q < P2_TOKB; ++q) { const size_t m = (size_t)(m0 + q * NGW); f32x4 z = gbv;
                    const unsigned gu[8] = {gl[q][0].x, gl[q][0].y, gl[q][0].z, gl[q][0].w, gl[q][1].x, gl[q][1].y, gl[q][1].z, gl[q][1].w};
#pragma unroll
                    for (int r2 = 0; r2 < 8; ++r2) { z = z + gwr[2 * r2] * __uint_as_float(gu[r2] << 16); z = z + gwr[2 * r2 + 1] * __uint_as_float(gu[r2] & 0xffff0000u); }
                    f32x4 o4;
#pragma unroll
                    for (int i = 0; i < 4; ++i) o4[i] = (fminf(z[i], 0.f) - __logf(1.f + __expf(-fabsf(z[i])))) * (1.f / 16.f);
                    *(f32x4*)(LA + m * 256 + dir * 128 + kc) = o4; } }
              __syncthreads(); }
            STAMP2(4);
            { __syncthreads();
              { const v4u* src = (const v4u*)WSP(bf16, WS_FTAB); LAS v4u* dst = (LAS v4u*)(lds + RING_OFF + FFT_LDS_TAB); for (int i = tid; i < 3 * FT_TAB * 2 / 16; i += NWAVES * 64) dst[i] = src[i];
                const v4u* s2_ = (const v4u*)WSP(float, WS_TW); LAS v4u* d2_ = (LAS v4u*)(lds + RING_OFF + FFT_LDS_TW); for (int i = tid; i < 4096 * 8 / 16; i += NWAVES * 64) d2_[i] = s2_[i]; }
              __syncthreads();
              const LAS bf16* FT = (const LAS bf16*)(lds + RING_OFF + FFT_LDS_TAB); const LAS float* TWL = (const LAS float*)(lds + RING_OFF + FFT_LDS_TW); bf16* FTMP = WSP(bf16, WS_FTMP);
              const int pair = wave >> 1, cb = wave & 1, r = lane & 31, h = lane >> 5;
              for (int ub = bx; ub < NB * 4 * 64 / 4; ub += G) { const int u = ub * 4 + pair, s2 = u & 63, g4 = (u >> 6) & 3, b = u >> 8;
                bf16x8 xa[2][4];
#pragma unroll
                for (int R = 0; R < 2; ++R)
#pragma unroll
                    for (int ks = 0; ks < 4; ++ks) xa[R][ks] = *(const bf16x8*)(PROJ + ((size_t)b * SEQ + 64 * (32 * R + r) + s2) * INP + C_FX + g4 * 64 + 16 * ks + 8 * h);
                f32x16 Tr[2], Ti[2];
#pragma unroll
                for (int R = 0; R < 2; ++R)
#pragma unroll
                    for (int i = 0; i < 16; ++i) { Tr[R][i] = 0.f; Ti[R][i] = 0.f; }
#pragma unroll
                for (int ks = 0; ks < 4; ++ks) { const bf16x8 bc = *(const LAS bf16x8*)(FT + (32 * cb + r) * FT_PITCH + 16 * ks + 8 * h), bs = *(const LAS bf16x8*)(FT + 2 * FT_TAB + (32 * cb + r) * FT_PITCH + 16 * ks + 8 * h);
#pragma unroll
                    for (int R = 0; R < 2; ++R) { Tr[R] = MFMA32(xa[R][ks], bc, Tr[R]); Ti[R] = MFMA32(xa[R][ks], bs, Ti[R]); } }
#pragma unroll
                for (int Rp = 0; Rp < 2; ++Rp) { f32x16 Gr, Gi;
#pragma unroll
                    for (int i = 0; i < 16; ++i) { Gr[i] = 0.f; Gi[i] = 0.f; }
#pragma unroll
                    for (int R = 0; R < 2; ++R)
#pragma unroll
                        for (int s_ = 0; s_ < 2; ++s_) { const bf16x8 xr = pack_step(Tr[R], s_), xi = pack_step(Ti[R], s_);
                            const int kb = 32 * R + 16 * s_ + 4 * h, ro = (32 * Rp + r) * FT_PITCH + kb;
                            const s16x4 c0 = *(const LAS s16x4*)(FT + ro), c1 = *(const LAS s16x4*)(FT + ro + 8), s0 = *(const LAS s16x4*)(FT + FT_TAB + ro), s1 = *(const LAS s16x4*)(FT + FT_TAB + ro + 8),
                                        n0 = *(const LAS s16x4*)(FT + 2 * FT_TAB + ro), n1 = *(const LAS s16x4*)(FT + 2 * FT_TAB + ro + 8);
                            const bf16x8 ca = __builtin_shufflevector(c0, c1, 0, 1, 2, 3, 4, 5, 6, 7), sa = __builtin_shufflevector(s0, s1, 0, 1, 2, 3, 4, 5, 6, 7), na = __builtin_shufflevector(n0, n1, 0, 1, 2, 3, 4, 5, 6, 7);
                            Gr = MFMA32(ca, xr, Gr); Gr = MFMA32(sa, xi, Gr); Gi = MFMA32(ca, xi, Gi); Gi = MFMA32(na, xr, Gi); }
#pragma unroll
                    for (int i = 0; i < 16; ++i) { const int s1p = 32 * Rp + crow16(i, h); const int m = (s2 * s1p) & 4095; const float wr = TWL[2 * m], wi = TWL[2 * m + 1];
                        const size_t o = ((((size_t)(b * 4 + g4) * 64 + s1p) * 2) * 64 + s2) * 64 + 32 * cb + r;
                        FTMP[o] = (bf16)f2bf(Gr[i] * wr - Gi[i] * wi); FTMP[o + 4096] = (bf16)f2bf(Gr[i] * wi + Gi[i] * wr); } }
              }
              __syncthreads(); }
            STAMP2(5);
            { float* GS = WSP(float, WS_OF); float* GD = WSP(float, WS_OB);
              const int slot = wave >> 2, w4 = wave & 3, fr = lane & 15, fq = lane >> 4; LAS unsigned char* Ls = lds + RING_OFF + slot * GM_SLOT;
              for (int ub = bx; ub < NB * 4 * 64 / 2; ub += G) { const int u = ub * 2 + slot, c = u & 63, bh = u >> 6, hd = bh & 3, b = bh >> 2; const size_t tok0 = (size_t)b * SEQ + c * 64;
                LBAR();
                gla_stage_mfma<false>(Ls, PROJ, LA, nullptr, tok0, hd, w4, lane);
                LBAR();
                const LAS bf16* VT = (const LAS bf16*)(Ls + GM_VT); const LAS float* DL = (const LAS float*)(Ls + GM_DL);
#pragma unroll
                for (int dir = 0; dir < 2; ++dir) { const LAS bf16* KT = (const LAS bf16*)(Ls + GM_P + dir * 4608);
#pragma unroll
                    for (int Cd = 0; Cd < 2; ++Cd) { f32x4 acc = {0.f, 0.f, 0.f, 0.f};
#pragma unroll
                        for (int ks = 0; ks < 2; ++ks) { const bf16x8 a_ = *(const LAS bf16x8*)(VT + (16 * w4 + fr) * 72 + 32 * ks + 8 * fq), b_ = *(const LAS bf16x8*)(KT + (16 * Cd + fr) * 72 + 32 * ks + 8 * fq); acc = MFMA16(a_, b_, acc); }
                        const float Dd = DL[dir * 32 + 16 * Cd + fr]; float* o = GS + (((size_t)u * 2 + dir) * 64 + 16 * w4 + 4 * fq) * 32 + 16 * Cd + fr;
#pragma unroll
                        for (int r = 0; r < 4; ++r) o[r * 32] = acc[r] * Dd; } }
                if (w4 == 3) GD[((size_t)u * 2 + (lane >> 5)) * 32 + (lane & 31)] = DL[lane]; }
              __syncthreads(); }
            STAMP2(9);
        }
        SEAM(pb + 1);
        if (IN(pb + 2) && PON(3)) {
            TID_SETUP(); unsigned char* ws = KWS(); float* GS = WSP(float, WS_OF); const float* GD = WSP(float, WS_OB);
            for (int e = gt; e < NB * 4 * 2 * 2048; e += NGT) { const int dv = e & 2047, dir = (e >> 11) & 1, bh = e >> 12, d = dv & 31; float H = 0.f;
                for (int c8 = 0; c8 < 64; c8 += P3_BATCH) { float sv[P3_BATCH], dd[P3_BATCH];
#pragma unroll
                    for (int i = 0; i < P3_BATCH; ++i) { const int c = dir ? 63 - (c8 + i) : (c8 + i); const size_t sidx = ((size_t)(bh * 64 + c) * 2 + dir); sv[i] = GS[sidx * 2048 + dv]; dd[i] = GD[sidx * 32 + d]; }
#pragma unroll
                    for (int i = 0; i < P3_BATCH; ++i) { const int c = dir ? 63 - (c8 + i) : (c8 + i); const size_t sidx = ((size_t)(bh * 64 + c) * 2 + dir); GS[sidx * 2048 + dv] = H; H = H * dd[i] + sv[i]; } } }
        }
        SEAM(pb + 2);
        if (IN(pb + 3) && PON(4)) {
            TID_SETUP(); unsigned char* ws = KWS(); const float* gla_norm_g = KIN(8); const bf16* PROJ = WSP(bf16, WS_PROJ);
            bf16* MIX = WSP(bf16, WS_MIX); const bf16* QB = WSP(bf16, WS_QB); const bf16* KB = WSP(bf16, WS_KB);
            STAMP2(10);
            { __syncthreads();
              { const v4u* src = (const v4u*)WSP(bf16, WS_FTAB); LAS v4u* dst = (LAS v4u*)(lds + RING_OFF + FFT_LDS_TAB); for (int i = tid; i < 3 * FT_TAB * 2 / 16; i += NWAVES * 64) dst[i] = src[i]; }
              const LAS bf16* FT = (const LAS bf16*)(lds + RING_OFF + FFT_LDS_TAB); const bf16* FTMP = WSP(bf16, WS_FTMP);
              const int pair = wave >> 1, cb = wave & 1, r = lane & 31, h = lane >> 5;
              LAS bf16* HT = (LAS bf16*)(lds + RING_OFF + FFT_LDS_HT + pair * FFT_HT_PAIR);
              for (int ub = bx; ub < NB * 4 * 64 / 4; ub += G) { const int u = ub * 4 + pair, s1p = u & 63, g4 = (u >> 6) & 3, b = u >> 8;
                const bf16* src = FTMP + (size_t)u * 2 * 4096;
                LBAR();
#pragma unroll
                for (int q = 0; q < 8; ++q) { const int p = cb * 64 + lane + 128 * q, ri = p >> 9, s2 = (p >> 3) & 63, c0 = (p & 7) * 8; const u16x8 v = *(const u16x8*)(src + p * 8);
#pragma unroll
                    for (int i = 0; i < 8; ++i) HT[(ri * 64 + c0 + i) * FT_PITCH + s2] = v[i]; }
                LBAR();
#pragma unroll
                for (int Rp = 0; Rp < 2; ++Rp) { f32x16 acc;
#pragma unroll
                    for (int i = 0; i < 16; ++i) acc[i] = 0.f;
#pragma unroll
                    for (int ks = 0; ks < 4; ++ks) { const int ko = 16 * ks + 8 * h;
                        const bf16x8 ca = *(const LAS bf16x8*)(FT + (32 * Rp + r) * FT_PITCH + ko), sa = *(const LAS bf16x8*)(FT + FT_TAB + (32 * Rp + r) * FT_PITCH + ko);
                        const bf16x8 hr = *(const LAS bf16x8*)(HT + (32 * cb + r) * FT_PITCH + ko), hi_ = *(const LAS bf16x8*)(HT + (64 + 32 * cb + r) * FT_PITCH + ko);
                        acc = MFMA32(ca, hr, acc); acc = MFMA32(sa, hi_, acc); }
#pragma unroll
                    for (int i = 0; i < 16; ++i) { const int s2p = 32 * Rp + crow16(i, h); MIX[((size_t)b * SEQ + s1p + 64 * s2p) * DM + 768 + g4 * 64 + 32 * cb + r] = (bf16)f2bf(acc[i] * (1.0f / 512.0f)); } }
              }
              __syncthreads(); }
            STAMP2(6);
            { const float* GS = WSP(float, WS_OF); const float* LA = WSP(float, WS_LA);
              const int slot = wave >> 2, w4 = wave & 3, fr = lane & 15, fq = lane >> 4, I0 = 16 * w4; LAS unsigned char* Ls = lds + RING_OFF + slot * GM_SLOT;
              for (int ub = bx; ub < NB * 4 * 64 / 2; ub += G) { const int u = ub * 2 + slot, c = u & 63, bh = u >> 6, hd = bh & 3, b = bh >> 2; const size_t tok0 = (size_t)b * SEQ + c * 64;
                float gnv[4];
#pragma unroll
                for (int Cv = 0; Cv < 4; ++Cv) gnv[Cv] = gla_norm_g[l * 64 + 16 * Cv + fr];
                LBAR();
                gla_stage_mfma<true>(Ls, PROJ, LA, GS + (size_t)u * 2 * 2048, tok0, hd, w4, lane);
                LBAR();
                const LAS bf16* QF = (const LAS bf16*)(Ls + GM_QF); const LAS bf16* KF = (const LAS bf16*)(Ls + GM_KF); const LAS bf16* QBm = (const LAS bf16*)(Ls + GM_QB); const LAS bf16* KBm = (const LAS bf16*)(Ls + GM_KB);
                const LAS bf16* VT = (const LAS bf16*)(Ls + GM_VT); LAS bf16* P = (LAS bf16*)(Ls + GM_P); const LAS bf16* HTF = (const LAS bf16*)(Ls + GM_HTF); const LAS bf16* HTB = (const LAS bf16*)(Ls + GM_HTB);
                const bf16x8 qfa = *(const LAS bf16x8*)(QF + (I0 + fr) * 40 + 8 * fq), qba = *(const LAS bf16x8*)(QBm + (I0 + fr) * 40 + 8 * fq);
#pragma unroll
                for (int Cj = 0; Cj < 4; ++Cj) { const f32x4 z = {0.f, 0.f, 0.f, 0.f};
                    const f32x4 pf = MFMA16(qfa, *(const LAS bf16x8*)(KF + (16 * Cj + fr) * 40 + 8 * fq), z), pb = MFMA16(qba, *(const LAS bf16x8*)(KBm + (16 * Cj + fr) * 40 + 8 * fq), z);
#pragma unroll
                    for (int r = 0; r < 4; ++r) { const int i = I0 + 4 * fq + r, j = 16 * Cj + fr; P[i * 72 + j] = (bf16)f2bf(j <= i ? pf[r] : pb[r]); } }
                asm volatile("s_waitcnt lgkmcnt(0)" ::: "memory");
                f32x4 o[4];
#pragma unroll
                for (int Cv = 0; Cv < 4; ++Cv) { f32x4 acc = {0.f, 0.f, 0.f, 0.f};
#pragma unroll
                    for (int ks = 0; ks < 2; ++ks) acc = MFMA16(*(const LAS bf16x8*)(P + (I0 + fr) * 72 + 32 * ks + 8 * fq), *(const LAS bf16x8*)(VT + (16 * Cv + fr) * 72 + 32 * ks + 8 * fq), acc);
                    acc = MFMA16(qfa, *(const LAS bf16x8*)(HTF + (16 * Cv + fr) * 40 + 8 * fq), acc); acc = MFMA16(qba, *(const LAS bf16x8*)(HTB + (16 * Cv + fr) * 40 + 8 * fq), acc);
                    o[Cv] = acc; }
                float rs[4];
#pragma unroll
                for (int r = 0; r < 4; ++r) { float ss = (o[0][r] * o[0][r] + o[1][r] * o[1][r]) + (o[2][r] * o[2][r] + o[3][r] * o[3][r]);
#pragma unroll
                    for (int m_ = 1; m_ < 16; m_ <<= 1) ss += __shfl_xor(ss, m_);
                    rs[r] = 1.f / sqrtf(ss * (1.f / 64.f) + RMS_EPS); }
                { const LAS unsigned short* RG = (const LAS unsigned short*)(Ls + GM_RG); LAS unsigned short* PO = (LAS unsigned short*)(Ls + GM_P);
#pragma unroll
                  for (int Cv = 0; Cv < 4; ++Cv) { const int v = 16 * Cv + fr; const float gn = gnv[Cv];
#pragma unroll
                    for (int r = 0; r < 4; ++r) { const int i = I0 + 4 * fq + r; const float rg = bf2f(RG[i * 72 + v]);
                        PO[i * 72 + v] = (unsigned short)f2bf(o[Cv][r] * rs[r] * gn * rg * __builtin_amdgcn_rcpf(1.f + __expf(-rg))); } }
                  asm volatile("s_waitcnt lgkmcnt(0)" ::: "memory");
#pragma unroll
                  for (int k = 0; k < 2; ++k) { const int p_ = lane + 64 * k, row = p_ >> 3, ch = p_ & 7; const v4u w = *(const LAS v4u*)(PO + (I0 + row) * 72 + ch * 8);
                      *(v4u*)(MIX + (tok0 + I0 + row) * DM + 512 + hd * 64 + ch * 8) = w; } } }
              __syncthreads(); }
            STAMP2(7);
#if NAIVE_ATTN
            { LAS float* Kt = (LAS float*)(lds + RING_OFF); LAS float* Vt = Kt + 64 * 64;
              for (int unit = bx; unit < NB * 8 * 8; unit += G) { const int rb = unit & 7, h = (unit >> 3) & 7, b = unit >> 6, kvh = h >> 2;
                const size_t qrow = (size_t)b * SEQ + rb * 512 + tid;
                float q[64], o[64]; float mrun = -INFINITY, lrun = 0.f;
#pragma unroll
                for (int c8 = 0; c8 < 8; ++c8) { const u16x8 f = *(const u16x8*)(QB + qrow * 512 + h * 64 + c8 * 8);
#pragma unroll
                    for (int i = 0; i < 8; ++i) { q[c8 * 8 + i] = bf2f(f[i]); o[c8 * 8 + i] = 0.f; } }
                for (int kt = 0; kt < SEQ; kt += 64) {
                    __syncthreads();
                    { const int kr = tid >> 3, c8 = (tid & 7) * 8; const size_t krow = (size_t)b * SEQ + kt + kr;
                      const u16x8 kf = *(const u16x8*)(KB + krow * 128 + kvh * 64 + c8); const u16x8 vf = *(const u16x8*)(PROJ + krow * INP + C_AV + kvh * 64 + c8);
#pragma unroll
                      for (int i = 0; i < 8; ++i) { Kt[kr * 64 + c8 + i] = bf2f(kf[i]); Vt[kr * 64 + c8 + i] = bf2f(vf[i]); } }
                    __syncthreads();
#pragma unroll 1
                    for (int j = 0; j < 64; ++j) { float a = 0.f;
#pragma unroll
                        for (int d4 = 0; d4 < 16; ++d4) { const f32x4 kv = *(const LAS f32x4*)(Kt + j * 64 + d4 * 4); a += (q[d4 * 4] * kv.x + q[d4 * 4 + 1] * kv.y) + (q[d4 * 4 + 2] * kv.z + q[d4 * 4 + 3] * kv.w); }
                        if (a > mrun) { const float al = exp2f(mrun - a); mrun = a; lrun *= al;
#pragma unroll
                            for (int d = 0; d < 64; ++d) o[d] *= al; }
                        const float p = exp2f(a - mrun); lrun += p;
#pragma unroll
                        for (int d4 = 0; d4 < 16; ++d4) { const f32x4 vv = *(const LAS f32x4*)(Vt + j * 64 + d4 * 4); o[d4 * 4] += p * vv.x; o[d4 * 4 + 1] += p * vv.y; o[d4 * 4 + 2] += p * vv.z; o[d4 * 4 + 3] += p * vv.w; } }
                }
                const float rl = 1.f / lrun;
#pragma unroll
                for (int c8 = 0; c8 < 8; ++c8) { v4u w; w.x = pk2(o[c8 * 8] * rl, o[c8 * 8 + 1] * rl); w.y = pk2(o[c8 * 8 + 2] * rl, o[c8 * 8 + 3] * rl); w.z = pk2(o[c8 * 8 + 4] * rl, o[c8 * 8 + 5] * rl); w.w = pk2(o[c8 * 8 + 6] * rl, o[c8 * 8 + 7] * rl);
                    *(v4u*)(MIX + qrow * DM + h * 64 + c8 * 8) = w; }
              }
              __syncthreads(); }
#else
            { const attn_body::AttnTensors AT{(const attn_body::bf16*)QB, (const attn_body::bf16*)KB, (const attn_body::bf16*)((const unsigned char*)KB + 4 * MiB), (attn_body::bf16*)MIX};
              const attn_body::StaticOrder S(G, bx);
              float bq_ = fabsf(KIN(4)[l * 64 + lane]), bk_ = fabsf(KIN(5)[l * 64 + lane]);
#pragma unroll
              for (int m_ = 1; m_ < 64; m_ <<= 1) { bq_ = fmaxf(bq_, __shfl_xor(bq_, m_)); bk_ = fmaxf(bk_, __shfl_xor(bk_, m_)); }
              const float bref = __uint_as_float(__builtin_amdgcn_readfirstlane(__float_as_uint(64.f * QSCALE * 1.02f * bq_ * bk_)));
              attn_body::attn_phase<attn_body::StaticOrder>((char*)lds_raw + RING_OFF, AT, S, bref); }
#endif
            STAMP2(11);
        }
        SEAM(pb + 3);
        if (IN(pb + 4) && PON(5)) {
            TID_SETUP(); unsigned char* ws = KWS(); const bf16* MIX = WSP(bf16, WS_MIX); const bf16* WOUT_T = WSP(bf16, WS_WOUT_T); const bf16* HB = WSP(bf16, WS_HB); bf16* T1 = WSP(bf16, WS_T1);
            pg8::Gemm g{MIX, WOUT_T + (size_t)l * DM * DM, NTOK, DM, DM}; pg8::StaticOrder S; S.init(NTOK, DM, G, bx);
            pg8::EpiResBf16 E{HB, T1, DM, DN_ALPHA};
            pg8::gemm_phase<pg8::EpiResBf16, pg8::StaticOrder, true, true>(lds + RING_OFF, g, S, E);
        }
        SEAM(pb + 4);
        if (IN(pb + 5) && PON(6)) {
            TID_SETUP(); unsigned char* ws = KWS(); gu32* ctl = (gu32*)(ws + WS_CTL); const float* ln1_g = KIN(10); const float* ln1_b = KIN(11); const float* router_w = KIN(12); const float* router_b = KIN(13);
            const bf16* T1 = WSP(bf16, WS_T1); bf16* HB = WSP(bf16, WS_HB); unsigned char* HB8 = WSP(unsigned char, WS_UVT); int* TOKE = WSP(int, WS_TOK); int* TOKS = TOKE + NTOK * 4; float* TOKW = (float*)(TOKS + NTOK * 4); int* LIST = WSP(int, WS_XS);
            { const v4u* src = (const v4u*)(WSP(bf16, WS_RWT) + (size_t)l * 2 * NE * DM); LAS v4u* dst = (LAS v4u*)(lds + RING_OFF);
              for (int i = tid; i < 2 * NE * DM * 2 / 16; i += NWAVES * 64) { const int row = i >> 7, c = i & 127; dst[row * 128 + (c ^ (row & 7))] = src[i]; }
              LAS float* GBw = (LAS float*)(lctl + LC_ROWS); for (int i = tid; i < DM; i += NWAVES * 64) { GBw[i] = ln1_g[l * DM + i]; GBw[DM + i] = ln1_b[l * DM + i]; } }
            const LAS bf16* RWH = (const LAS bf16*)(lds + RING_OFF); const LAS float* GB = (const LAS float*)(lctl + LC_ROWS); LAS float* ST = (LAS float*)(lctl + LC_ROWS + 8192);
            LAS int* lcnt = (LAS int*)(lctl + LC_CNT); LAS int* lbase = (LAS int*)(lctl + LC_BASE); LAS int* sele = (LAS int*)(lctl + LC_SELE); LAS int* sels = (LAS int*)(lctl + LC_SELS);
            const float* rb = router_b + l * NE;
            for (int r0 = bx * 128; r0 < NTOK; r0 += G * 128) {
                if (tid < 32) lcnt[tid] = 0;
                __syncthreads();
                LAS float* LG = (LAS float*)(lctl + LC_LG) + wave * 512;
                for (int rr = 0; rr < 16; rr += P6_ROWS) { v4u raw[P6_ROWS][2];
#pragma unroll
                    for (int q = 0; q < P6_ROWS; ++q)
#pragma unroll
                        for (int h = 0; h < 2; ++h) raw[q][h] = *(const v4u*)(T1 + ((size_t)r0 + wave * 16 + rr + q) * DM + h * 512 + 8 * lane);
#pragma unroll
                    for (int q = 0; q < P6_ROWS; ++q) { f32x4 v[4];
#pragma unroll
                        for (int h = 0; h < 2; ++h) { const v4u t = raw[q][h];
                            v[2 * h] = (f32x4){__uint_as_float(t.x << 16), __uint_as_float(t.x & 0xffff0000u), __uint_as_float(t.y << 16), __uint_as_float(t.y & 0xffff0000u)};
                            v[2 * h + 1] = (f32x4){__uint_as_float(t.z << 16), __uint_as_float(t.z & 0xffff0000u), __uint_as_float(t.w << 16), __uint_as_float(t.w & 0xffff0000u)}; }
                        float s_ = 0.f;
#pragma unroll
                        for (int j = 0; j < 4; ++j) s_ += (v[j].x + v[j].y) + (v[j].z + v[j].w);
                        const float mean = wave_sum(s_) * (1.f / DM); float s2_ = 0.f;
#pragma unroll
                        for (int j = 0; j < 4; ++j) { const f32x4 d_ = v[j] - mean; s2_ += (d_.x * d_.x + d_.y * d_.y) + (d_.z * d_.z + d_.w * d_.w); }
                        const float rstd = __builtin_amdgcn_rsqf(wave_sum(s2_) * (1.f / DM) + LN_EPS);
                        if (lane == 0) { ST[(wave * 16 + rr + q) * 2] = mean; ST[(wave * 16 + rr + q) * 2 + 1] = rstd; } } }
                asm volatile("s_waitcnt lgkmcnt(0)" ::: "memory");
                { const int fr = lane & 15, fq = lane >> 4; const size_t row = (size_t)r0 + wave * 16 + fr; const float mean = ST[(wave * 16 + fr) * 2], rstd = ST[(wave * 16 + fr) * 2 + 1];
                  const bf16* xrow = T1 + row * DM + 8 * fq; bf16* hrow = HB + row * DM + 8 * fq;
                  f32x4 acc0 = {0.f, 0.f, 0.f, 0.f}, acc1 = {0.f, 0.f, 0.f, 0.f};
#pragma unroll 1
                  for (int s8 = 0; s8 < 32; s8 += 8) { v4u xr[8];
#pragma unroll
                    for (int i = 0; i < 8; ++i) xr[i] = *(const v4u*)(xrow + 32 * (s8 + i));
#pragma unroll
                    for (int i = 0; i < 8; ++i) { const int k0 = 32 * (s8 + i) + 8 * fq;
                        const f32x4 g0 = *(const LAS f32x4*)(GB + k0), g1 = *(const LAS f32x4*)(GB + k0 + 4), b0 = *(const LAS f32x4*)(GB + DM + k0), b1 = *(const LAS f32x4*)(GB + DM + k0 + 4);
                        f32x4 x0 = {__uint_as_float(xr[i].x << 16), __uint_as_float(xr[i].x & 0xffff0000u), __uint_as_float(xr[i].y << 16), __uint_as_float(xr[i].y & 0xffff0000u)};
                        f32x4 x1 = {__uint_as_float(xr[i].z << 16), __uint_as_float(xr[i].z & 0xffff0000u), __uint_as_float(xr[i].w << 16), __uint_as_float(xr[i].w & 0xffff0000u)};
                        x0 = (x0 - mean) * rstd * g0 + b0; x1 = (x1 - mean) * rstd * g1 + b1;
                        v4u hi; hi.x = pk2(x0.x, x0.y); hi.y = pk2(x0.z, x0.w); hi.z = pk2(x1.x, x1.y); hi.w = pk2(x1.z, x1.w);
                        *(v4u*)(hrow + 32 * (s8 + i)) = hi;
                        *(unsigned long long*)(HB8 + row * DM + 32 * (s8 + i) + 8 * fq) = (unsigned long long)pk4_fp8(x0.x, x0.y, x0.z, x0.w) | ((unsigned long long)pk4_fp8(x1.x, x1.y, x1.z, x1.w) << 32);
                        const f32x4 l0 = {x0.x - __uint_as_float(hi.x << 16), x0.y - __uint_as_float(hi.x & 0xffff0000u), x0.z - __uint_as_float(hi.y << 16), x0.w - __uint_as_float(hi.y & 0xffff0000u)};
                        const f32x4 l1 = {x1.x - __uint_as_float(hi.z << 16), x1.y - __uint_as_float(hi.z & 0xffff0000u), x1.z - __uint_as_float(hi.w << 16), x1.w - __uint_as_float(hi.w & 0xffff0000u)};
                        v4u lo; lo.x = pk2(l0.x, l0.y); lo.y = pk2(l0.z, l0.w); lo.z = pk2(l1.x, l1.y); lo.w = pk2(l1.z, l1.w);
                        const bf16x8 ah = __builtin_bit_cast(bf16x8, hi), al = __builtin_bit_cast(bf16x8, lo);
                        const int c = 4 * (s8 + i) + fq;
                        const LAS bf16* w0 = RWH + fr * DM + ((c ^ (fr & 7)) << 3); const LAS bf16* w1 = RWH + (16 + fr) * DM + ((c ^ (fr & 7)) << 3);
                        const bf16x8 bh0 = *(const LAS bf16x8*)w0, bl0 = *(const LAS bf16x8*)(w0 + NE * DM), bh1 = *(const LAS bf16x8*)w1, bl1 = *(const LAS bf16x8*)(w1 + NE * DM);
                        acc0 = MFMA16(ah, bh0, acc0); acc0 = MFMA16(ah, bl0, acc0); acc0 = MFMA16(al, bh0, acc0);
                        acc1 = MFMA16(ah, bh1, acc1); acc1 = MFMA16(ah, bl1, acc1); acc1 = MFMA16(al, bh1, acc1); } }
                  const float bias0 = rb[fr], bias1 = rb[16 + fr];
#pragma unroll
                  for (int r = 0; r < 4; ++r) { LG[(4 * fq + r) * 32 + fr] = acc0[r] + bias0; LG[(4 * fq + r) * 32 + 16 + fr] = acc1[r] + bias1; } }
                asm volatile("s_waitcnt lgkmcnt(0)" ::: "memory");
                if (lane < 16) { const int lr = wave * 16 + lane; const size_t m = (size_t)r0 + lr; float lg[32];
#pragma unroll
                    for (int e4 = 0; e4 < 8; ++e4) { const f32x4 x = *(const LAS f32x4*)(LG + lane * 32 + e4 * 4); lg[e4 * 4] = x.x; lg[e4 * 4 + 1] = x.y; lg[e4 * 4 + 2] = x.z; lg[e4 * 4 + 3] = x.w; }
                    int se[4]; float sv[4];
#pragma unroll
                    for (int k = 0; k < 4; ++k) { float best = -INFINITY; int bi = 0;
#pragma unroll
                        for (int e = 0; e < 32; ++e) { if (lg[e] > best) { best = lg[e]; bi = e; } }
                        se[k] = bi; sv[k] = best;
#pragma unroll
                        for (int e = 0; e < 32; ++e) if (e == bi) lg[e] = -INFINITY; }
                    const float e1 = expf(sv[1] - sv[0]), e2 = expf(sv[2] - sv[0]), e3 = expf(sv[3] - sv[0]); const float inv = 1.f / (1.f + e1 + e2 + e3);
                    const float wts[4] = {inv, e1 * inv, e2 * inv, e3 * inv};
#pragma unroll
                    for (int k = 0; k < 4; ++k) { const int ls = __hip_atomic_fetch_add(lcnt + se[k], 1, __ATOMIC_RELAXED, __HIP_MEMORY_SCOPE_WORKGROUP); sele[lr * 4 + k] = se[k]; sels[lr * 4 + k] = ls; TOKW[m * 4 + k] = wts[k]; } }
                __syncthreads();
                if (tid < 32) lbase[tid] = (int)__hip_atomic_fetch_add(ctl + CW_CNT + l * 32 + tid, (unsigned)lcnt[tid], RLX_AGENT);
                __syncthreads();
                { const int e = sele[tid], sl = lbase[e] + sels[tid]; TOKE[(size_t)r0 * 4 + tid] = e; TOKS[(size_t)r0 * 4 + tid] = sl; LIST[(size_t)e * NTOK + sl] = r0 + (tid >> 2); }
                __syncthreads();
            }
        }
        SEAM(pb + 5);
#if defined(EXP_P1_NOEPI)
        if (IN(pb + 6)) {
            TID_SETUP(); unsigned char* ws = KWS(); bf16* HB = WSP(bf16, WS_HB); bf16* WIN_T = WSP(bf16, WS_WIN_T); bf16* PROJ = WSP(bf16, WS_PROJ);
            pg8::Gemm g{HB, WIN_T + (size_t)l * INP * DM, NTOK, INP, DM}; pg8::StaticOrder S; S.init(NTOK, INP, G, bx);
            pg8::EpiNull EN{PROJ}; pg8::gemm_phase<pg8::EpiNull, pg8::StaticOrder, true, true>(lds + RING_OFF, g, S, EN);
            __syncthreads(); }
#endif
        STAMP(pb + 7);
        if (IN(pb + 7) || IN(pb + 8) || IN(pb + 9)) {
            LAS int* pst = (LAS int*)(lctl + LC_PSTART); LAS int* ecnt = (LAS int*)(lctl + LC_BASE); gu32* ctl = (gu32*)(KWS() + WS_CTL);
            __syncthreads();
            int ln_ = threadIdx.x; asm volatile("" : "+v"(ln_));
            if (ln_ < 64) { const int e = ln_ & 31;
                const int c = (int)__hip_atomic_load(ctl + CW_CNT + l * 32 + e, RLX_AGENT); const int p_ = (c + 255) >> 8; int incl = p_;
#pragma unroll
                for (int o = 1; o < 32; o <<= 1) { const int y = __shfl_up(incl, o); if (e >= o) incl += y; }
                if (ln_ < 32) { pst[e] = incl - p_; ecnt[e] = c; if (e == NE - 1) pst[NE] = incl; } }
            __syncthreads();
        }
        if (IN(pb + 7) && PON(8)) {
            TID_SETUP(); unsigned char* ws = KWS(); const float* exp_b_gu = KIN(15); const unsigned char* HB8 = WSP(unsigned char, WS_UVT); const int* LIST = WSP(int, WS_XS); const unsigned char* WGU8 = WSP(unsigned char, WS_WGU_T); unsigned char* HID8 = WSP(unsigned char, WS_HID);
            const LAS int* pst = (const LAS int*)(lctl + LC_PSTART); LAS int* ul = (LAS int*)(lctl + LC_ULIST);
            const int nM = pst[NE], nN = 8, nwg = nM * nN;
            if (tid < 64) { const long L = (long)tid * G + bx; int v = -1;
                if (L < nwg) { int wgid = (int)L; { const int q = nwg / 8, r = nwg % 8, xcd = wgid % 8, off = wgid / 8; wgid = (xcd < r ? xcd * (q + 1) : r * (q + 1) + (xcd - r) * q) + off; }
                    const int nig = 8 * nN, gid = wgid / nig, fm = gid * 8, gsz = (nM - fm) < 8 ? (nM - fm) : 8; const int pm = fm + ((wgid % nig) % gsz), pn = (wgid % nig) / gsz;
                    int e = 0; for (int k = 1; k < NE; ++k) if (pst[k] <= pm) e = k;
                    v = (pm << 16) | (e * nN + pn); }
                ul[tid] = v; }
            __syncthreads();
            const int nunits = bx < nwg ? (nwg - bx + G - 1) / G : 0;
            LAS unsigned short* rows16 = (LAS unsigned short*)(lctl + LC_ROWS); const LAS int* ecnt = (const LAS int*)(lctl + LC_BASE);
            if (nunits > 0) { int tok_[10]; int tid3 = tid; asm volatile("" : "+v"(tid3));
#pragma unroll
                for (int j = 0; j < 10; ++j) { const int i = tid3 + 512 * j; int sl = i >> 8; sl = sl < nunits ? sl : nunits - 1; const int v = ul[sl]; const int pm = v >> 16, e = (v & 0xffff) >> 3, pl = pm - pst[e]; const int idx = pl * 256 + (i & 255);
                    const bool ok = idx < ecnt[e]; const int t_ = LIST[(size_t)e * NTOK + (ok ? idx : 0)]; tok_[j] = ok ? t_ : 0; }
#pragma unroll
                for (int j = 0; j < 10; ++j) { const int i = tid3 + 512 * j; if (i < nunits * 256) rows16[i] = (unsigned short)tok_[j]; } }
            __syncthreads();
            pg8::Gemm g{(const pg8::bf16_t*)HB8, (const pg8::bf16_t*)(WGU8 + (size_t)l * NE * 2048 * DM), NTOK, NE * 2048, DM}; pg8::ListOrder S{ul, nunits};
            pg8::EpiSwiglu8 E{HID8, exp_b_gu + (size_t)l * NE * 2048, (LAS float*)(lctl + LC_LG)};
            pg8::gemm_phase_fp8<pg8::EpiSwiglu8, pg8::ListOrder, true, true>(lds + RING_OFF, g, S, E, rows16);
        }
        SEAM(pb + 7);
        if (IN(pb + 8) && PON(9)) {
            TID_SETUP(); unsigned char* ws = KWS(); const float* exp_b_down = KIN(17); const unsigned char* HID8 = WSP(unsigned char, WS_HID); const unsigned char* WDN8 = WSP(unsigned char, WS_WDN_T); unsigned char* YS = WSP(unsigned char, WS_YS);
            const LAS int* pst = (const LAS int*)(lctl + LC_PSTART); LAS int* ul = (LAS int*)(lctl + LC_ULIST);
            const int nM = pst[NE], nN = 4, nwg = nM * nN;
            __syncthreads();
            if (tid < 64) { const long L = (long)tid * G + bx; int v = -1;
                if (L < nwg) { int wgid = (int)L; { const int q = nwg / 8, r = nwg % 8, xcd = wgid % 8, off = wgid / 8; wgid = (xcd < r ? xcd * (q + 1) : r * (q + 1) + (xcd - r) * q) + off; }
                    const int nig = 8 * nN, gid = wgid / nig, fm = gid * 8, gsz = (nM - fm) < 8 ? (nM - fm) : 8; const int pm = fm + ((wgid % nig) % gsz), pn = (wgid % nig) / gsz;
                    int e = 0; for (int k = 1; k < NE; ++k) if (pst[k] <= pm) e = k;
                    v = (pm << 16) | (e * nN + pn); }
                ul[tid] = v; }
            __syncthreads();
            const int nunits = bx < nwg ? (nwg - bx + G - 1) / G : 0;
            pg8::Gemm g{(const pg8::bf16_t*)HID8, (const pg8::bf16_t*)(WDN8 + (size_t)l * NE * DM * DE), MPAD, NE * DM, DE}; pg8::ListOrder S{ul, nunits};
            pg8::EpiDown8 E{YS, exp_b_down + (size_t)l * NE * DM, (LAS float*)(lctl + LC_LG)};
            pg8::gemm_phase_fp8<pg8::EpiDown8, pg8::ListOrder, true, false>(lds + RING_OFF, g, S, E, nullptr);
        }
        SEAM(pb + 8);
        if (IN(pb + 9) && PON(10)) {
            TID_SETUP(); unsigned char* ws = KWS(); const float* ln2_g = KIN(18); const float* ln2_b = KIN(19); float* out = KOUT(); bf16* HB = WSP(bf16, WS_HB); unsigned char* HB8L = WSP(unsigned char, WS_HB8L);
            const unsigned char* YS = WSP(unsigned char, WS_YS); const int* TOKE = WSP(int, WS_TOK); const int* TOKS = TOKE + NTOK * 4; const float* TOKW = (const float*)(TOKS + NTOK * 4); const LAS int* pst = (const LAS int*)(lctl + LC_PSTART);
            const bool lastl = (l == NL - 1);
            f32x4 gam[4], bet[4];
#pragma unroll
            for (int j = 0; j < 4; ++j) { gam[j] = *(const f32x4*)(ln2_g + l * DM + 16 * lane + 4 * j); bet[j] = *(const f32x4*)(ln2_b + l * DM + 16 * lane + 4 * j); }
            int yo[4]; f32x4 wl = {0.f, 0.f, 0.f, 0.f};
            { const int m = gw + (lane & 15) * NGW; const v4u te = *(const v4u*)(TOKE + m * 4), ts = *(const v4u*)(TOKS + m * 4); wl = *(const f32x4*)(TOKW + m * 4);
              yo[0] = pst[te.x] * 256 + (int)ts.x; yo[1] = pst[te.y] * 256 + (int)ts.y; yo[2] = pst[te.z] * 256 + (int)ts.z; yo[3] = pst[te.w] * 256 + (int)ts.w; }
            for (int p2 = 0; p2 < NTOK / (2 * NGW); ++p2) { f32x4 v[2][4]; v4u yraw[2][4]; float wk[2][4];
#pragma unroll
                for (int q = 0; q < 2; ++q) { const int t = 2 * p2 + q, m = gw + t * NGW;
#pragma unroll
                    for (int k = 0; k < 4; ++k) { yraw[q][k] = *(const v4u*)(YS + (size_t)__builtin_amdgcn_readfirstlane(__shfl(yo[k], t)) * DM + 16 * lane); wk[q][k] = __shfl(wl[k], t); }
                    const v4u h0 = *(const v4u*)(HB + (size_t)m * DM + 16 * lane), h1 = *(const v4u*)(HB + (size_t)m * DM + 16 * lane + 8);
                    v[q][0] = (f32x4){__uint_as_float(h0.x << 16), __uint_as_float(h0.x & 0xffff0000u), __uint_as_float(h0.y << 16), __uint_as_float(h0.y & 0xffff0000u)} * DN_ALPHA;
                    v[q][1] = (f32x4){__uint_as_float(h0.z << 16), __uint_as_float(h0.z & 0xffff0000u), __uint_as_float(h0.w << 16), __uint_as_float(h0.w & 0xffff0000u)} * DN_ALPHA;
                    v[q][2] = (f32x4){__uint_as_float(h1.x << 16), __uint_as_float(h1.x & 0xffff0000u), __uint_as_float(h1.y << 16), __uint_as_float(h1.y & 0xffff0000u)} * DN_ALPHA;
                    v[q][3] = (f32x4){__uint_as_float(h1.z << 16), __uint_as_float(h1.z & 0xffff0000u), __uint_as_float(h1.w << 16), __uint_as_float(h1.w & 0xffff0000u)} * DN_ALPHA; }
#pragma unroll
                for (int q = 0; q < 2; ++q)
#pragma unroll
                    for (int k = 0; k < 4; ++k) { const float w = wk[q][k]; const unsigned yw[4] = {yraw[q][k].x, yraw[q][k].y, yraw[q][k].z, yraw[q][k].w};
#pragma unroll
                        for (int j = 0; j < 4; ++j) { const f32x2_t lo = __builtin_amdgcn_cvt_pk_f32_fp8((int)yw[j], false), hi = __builtin_amdgcn_cvt_pk_f32_fp8((int)yw[j], true);
                            v[q][j] = v[q][j] + (f32x4){lo.x, lo.y, hi.x, hi.y} * w; } }
#pragma unroll
                for (int q = 0; q < 2; ++q) { const int m = gw + (2 * p2 + q) * NGW; ln_row8(v[q], gam, bet);
                    if (lastl) {
#pragma unroll
                        for (int j = 0; j < 4; ++j) *(f32x4*)(out + (size_t)m * DM + 16 * lane + 4 * j) = v[q][j]; }
                    else { v4u w0, w1; w0.x = pk2(v[q][0].x, v[q][0].y); w0.y = pk2(v[q][0].z, v[q][0].w); w0.z = pk2(v[q][1].x, v[q][1].y); w0.w = pk2(v[q][1].z, v[q][1].w);
                        w1.x = pk2(v[q][2].x, v[q][2].y); w1.y = pk2(v[q][2].z, v[q][2].w); w1.z = pk2(v[q][3].x, v[q][3].y); w1.w = pk2(v[q][3].z, v[q][3].w);
                        *(v4u*)(HB + (size_t)m * DM + 16 * lane) = w0; *(v4u*)(HB + (size_t)m * DM + 16 * lane + 8) = w1;
                        v4u w8; w8.x = pk4_fp8(v[q][0].x, v[q][0].y, v[q][0].z, v[q][0].w); w8.y = pk4_fp8(v[q][1].x, v[q][1].y, v[q][1].z, v[q][1].w); w8.z = pk4_fp8(v[q][2].x, v[q][2].y, v[q][2].z, v[q][2].w); w8.w = pk4_fp8(v[q][3].x, v[q][3].y, v[q][3].z, v[q][3].w);
                        *(v4u*)(HB8L + (size_t)m * DM + 16 * lane) = w8; } } }
        }
        SEAM(pb + 9);
    }
#if PROBE_A >= 0
    { xcd_barrier(bar);
      const unsigned long long* st = (const unsigned long long*)(KWS() + WS_CTL + 65536); unsigned long long T = 0;
      if (PROBE_A & 1) T += st[1] - st[0];
      for (int l = 0; l < NL; ++l) for (int j = 1; j <= 10; ++j) if ((PROBE_A >> j) & 1) T += st[1 + 10 * l + j] - st[10 * l + j];
      if (PROBE_SUB_A >= 0) for (int l = 0; l < NL; ++l) T += st[128 + l * 16 + PROBE_SUB_B] - st[128 + l * 16 + PROBE_SUB_A];
      T *= 4ull; if (T > 5000000ull) T = 5000000ull;
      const unsigned long long t0 = __builtin_amdgcn_s_memrealtime();
      while (__builtin_amdgcn_s_memrealtime() - t0 < T) __builtin_amdgcn_s_sleep(16); }
#endif
#undef IN
#undef SEAM
}

#ifndef MK_PER_PHASE
#define MK_PER_PHASE 0
#endif
extern "C" void kernel_launch(void* const* d_in, const int* in_sizes, int n_in, void* d_out, int out_size, void* d_ws, size_t ws_size, hipStream_t stream) {
    static int grid = 0;
    if (grid == 0) {
        if (n_in != 20 || in_sizes[0] != NTOK * DM || out_size != NTOK * DM || ws_size < WS_END) { fprintf(stderr, "kernel_launch: unexpected shapes (n_in %d, in0 %d, out %d, ws %zu); nothing launched\n", n_in, n_in > 0 ? in_sizes[0] : -1, out_size, ws_size); grid = -1; return; }
        int dev = 0, cus = 0, per_cu = 0;
        if (hipGetDevice(&dev) != hipSuccess || hipDeviceGetAttribute(&cus, hipDeviceAttributeMultiprocessorCount, dev) != hipSuccess) { grid = -1; return; }
        if (hipFuncSetAttribute((const void*)fwd, hipFuncAttributeMaxDynamicSharedMemorySize, LDS_BYTES) != hipSuccess) { fprintf(stderr, "kernel_launch: hipFuncSetAttribute failed\n"); grid = -1; return; }
        if (hipOccupancyMaxActiveBlocksPerMultiprocessor(&per_cu, (const void*)fwd, NWAVES * 64, LDS_BYTES) != hipSuccess || per_cu < 1) fprintf(stderr, "kernel_launch: occupancy query reports %d\n", per_cu);
        (void)hipGetLastError();
        if (cus < 256) { fprintf(stderr, "kernel_launch: built for a 256-CU device (got %d CUs); nothing launched\n", cus); grid = -1; return; }
        grid = 256;
    }
    if (grid < 0) return;
    if (hipMemsetAsync((char*)d_ws + WS_CTL, 0, CTL_ZERO_BYTES, stream) != hipSuccess) return;
    Args a{};
    for (int i = 0; i < 20; ++i) a.in[i] = (const float*)d_in[i];
    a.out = (float*)d_out; a.ws = (unsigned char*)d_ws;
#if MK_PER_PHASE
    for (int p = 0; p < N_PHASES; ++p) { a.ph_lo = p; a.ph_hi = p + 1; hipLaunchKernelGGL(fwd, dim3(grid), dim3(NWAVES * 64), LDS_BYTES, stream, a); }
#else
    a.ph_lo = 0; a.ph_hi = N_PHASES;
    hipLaunchKernelGGL(fwd, dim3(grid), dim3(NWAVES * 64), LDS_BYTES, stream, a);
#endif
    const hipError_t le = hipPeekAtLastError();
    if (le != hipSuccess) fprintf(stderr, "kernel_launch: launch failed: %s\n", hipGetErrorName(le));
}
```

```cpp
#include <hip/hip_runtime.h>
#include <hip/hip_bf16.h>
#include <cstdio>
#include <cstdint>
#include <cmath>
namespace pg8 {
#define PG8_LAS __attribute__((address_space(3)))
typedef unsigned short bf16_t;
typedef short bf16x8 __attribute__((ext_vector_type(8)));
typedef float f32x4 __attribute__((ext_vector_type(4)));
typedef unsigned u32x4 __attribute__((ext_vector_type(4)));
constexpr int BM = 256, BK = 64, HALF = 128, HTB = HALF * BK * 2  , STAGE_BYTES = 8 * HTB, NXCD = 8, WGM = 8;

__host__ __device__ __forceinline__ int lds_byte(int r, int c) { const int st = (r >> 4) * 2 + (c >> 5), rr = r & 15, cc = c & 31, ob = rr * 64 + cc * 2; return st * 1024 + (ob ^ (((ob >> 9) & 1) << 5)); }
__host__ __device__ __forceinline__ void stage_rc(int b, int& R, int& C) { const int st = b / 1024, sb = b % 1024, swz = sb ^ (((sb >> 9) & 1) << 5); R = (st >> 1) * 16 + swz / 64; C = (st & 1) * 32 + (swz % 64) / 2; }
__host__ __device__ __forceinline__ int perm32(int rho) { const int n = rho >> 4, i = rho & 15; return 8 * (i >> 2) + 4 * n + (i & 3); }

struct Unit { int pm, pn; };
struct Gemm { const bf16_t* A; const bf16_t* Bt; int M, N, K; };

struct StaticOrder {
    int nM, nN, nwg, G, c;
    __host__ __device__ void init(int M, int N, int G_, int c_) { nM = M / BM; nN = N / BM; nwg = nM * nN; G = G_; c = c_; }
    __host__ __device__ bool next(int i, Unit& u) const {
        const long L = (long)i * G + c; if (L >= nwg) return false;
        int wgid = (int)L; { const int q = nwg / NXCD, r = nwg % NXCD, xcd = wgid % NXCD, off = wgid / NXCD; wgid = (xcd < r ? xcd * (q + 1) : r * (q + 1) + (xcd - r) * q) + off; }
        const int nig = WGM * nN, gid = wgid / nig, fm = gid * WGM, gsz = (nM - fm) < WGM ? (nM - fm) : WGM;
        u.pm = fm + ((wgid % nig) % gsz); u.pn = (wgid % nig) / gsz; return true;
    }
    __device__ __forceinline__ void a_ready(const Unit&) const {}
    __device__ __forceinline__ void done(const Unit&) const {}
};

__device__ __forceinline__ unsigned cvt_pk_bf16(float lo, float hi) { unsigned r; asm volatile("v_cvt_pk_bf16_f32 %0, %1, %2" : "=v"(r) : "v"(lo), "v"(hi)); return r; }
typedef float f32x2 __attribute__((ext_vector_type(2)));
__device__ __forceinline__ u32x4 pack8(const f32x4 v0, const f32x4 v1) { u32x4 w; w.x = cvt_pk_bf16(v0[0], v0[1]); w.y = cvt_pk_bf16(v0[2], v0[3]); w.z = cvt_pk_bf16(v1[0], v1[1]); w.w = cvt_pk_bf16(v1[2], v1[3]); return w; }

struct EpiPlainBf16 {
    static constexpr bool PERM = true, AFTER_DRAIN = false;
    bf16_t* O; int ldc;
    __device__ __forceinline__ void operator()(const f32x4 (&acc)[2][2][4][2], const Unit& u, int wr, int wc, int fr, int fq) const {
        const int row0 = u.pm * BM + wr * 64 + fr, col0 = u.pn * BM + wc * 32 + 8 * fq;
#pragma unroll
        for (int ai = 0; ai < 2; ++ai)
#pragma unroll
            for (int m = 0; m < 4; ++m) { bf16_t* rowp = O + (size_t)(row0 + ai * HALF + m * 16) * ldc + col0;
#pragma unroll
                for (int bj = 0; bj < 2; ++bj) *(u32x4*)(rowp + bj * HALF) = pack8(acc[ai][bj][m][0], acc[ai][bj][m][1]); }
    }
};
struct EpiFnet {
    static constexpr bool PERM = true, AFTER_DRAIN = false;
    bf16_t* MIX;
    __device__ __forceinline__ void operator()(const f32x4 (&acc)[2][2][4][2], const Unit& u, int wr, int wc, int fr, int fq) const {
        const int row0 = u.pn * 4096 + u.pm * BM + wr * 64 + fr, col0 = 768 + wc * 32 + 8 * fq;
#pragma unroll
        for (int ai = 0; ai < 2; ++ai)
#pragma unroll
            for (int m = 0; m < 4; ++m) { bf16_t* rowp = MIX + (size_t)(row0 + ai * HALF + m * 16) * 1024 + col0;
#pragma unroll
                for (int bj = 0; bj < 2; ++bj) *(u32x4*)(rowp + bj * HALF) = pack8(acc[ai][bj][m][0], acc[ai][bj][m][1]); }
    }
};
struct EpiResF32 {
    static constexpr bool PERM = false, AFTER_DRAIN = false;
    const float* base; float* out; int ldc; float alpha;
    __device__ __forceinline__ void operator()(const f32x4 (&acc)[2][2][4][2], const Unit& u, int wr, int wc, int fr, int fq) const {
        const int row0 = u.pm * BM + wr * 64 + fr, col0 = u.pn * BM + wc * 32 + 4 * fq;
#pragma unroll
        for (int ai = 0; ai < 2; ++ai)
#pragma unroll
            for (int m = 0; m < 4; ++m) { const size_t off = (size_t)(row0 + ai * HALF + m * 16) * ldc + col0;
#pragma unroll
                for (int bj = 0; bj < 2; ++bj)
#pragma unroll
                    for (int n = 0; n < 2; ++n) { const f32x4 b = *(const f32x4*)(base + off + bj * HALF + n * 16); *(f32x4*)(out + off + bj * HALF + n * 16) = b * alpha + acc[ai][bj][m][n]; } }
    }
};
struct EpiResBf16 {
    static constexpr bool PERM = true, AFTER_DRAIN = false;
    const bf16_t* base; bf16_t* out; int ldc; float alpha;
    __device__ __forceinline__ void operator()(const f32x4 (&acc)[2][2][4][2], const Unit& u, int wr, int wc, int fr, int fq) const {
        const int row0 = u.pm * BM + wr * 64 + fr, col0 = u.pn * BM + wc * 32 + 8 * fq;
#pragma unroll
        for (int ai = 0; ai < 2; ++ai)
#pragma unroll
            for (int m = 0; m < 4; ++m) { const size_t off = (size_t)(row0 + ai * HALF + m * 16) * ldc + col0;
#pragma unroll
                for (int bj = 0; bj < 2; ++bj) { const u32x4 b = *(const u32x4*)(base + off + bj * HALF);
                    const f32x4 b0 = {__uint_as_float(b.x << 16), __uint_as_float(b.x & 0xffff0000u), __uint_as_float(b.y << 16), __uint_as_float(b.y & 0xffff0000u)};
                    const f32x4 b1 = {__uint_as_float(b.z << 16), __uint_as_float(b.z & 0xffff0000u), __uint_as_float(b.w << 16), __uint_as_float(b.w & 0xffff0000u)};
                    *(u32x4*)(out + off + bj * HALF) = pack8(b0 * alpha + acc[ai][bj][m][0], b1 * alpha + acc[ai][bj][m][1]); } }
    }
};
__device__ __forceinline__ f32x4 swiglu4(f32x4 g, f32x4 u) {
    typedef float f32x2_ __attribute__((ext_vector_type(2)));
    f32x4 h;
#pragma unroll
    for (int p = 0; p < 2; ++p) { f32x2_ gg = {fminf(g[2 * p], 7.0f), fminf(g[2 * p + 1], 7.0f)}; f32x2_ uu = {__builtin_amdgcn_fmed3f(u[2 * p], -7.0f, 7.0f), __builtin_amdgcn_fmed3f(u[2 * p + 1], -7.0f, 7.0f)};
        const f32x2_ t = gg * (-1.702f * 1.4426950408889634f); f32x2_ e = {__builtin_amdgcn_exp2f(t.x), __builtin_amdgcn_exp2f(t.y)}; e = e + 1.0f;
        const f32x2_ r = {__builtin_amdgcn_rcpf(e.x), __builtin_amdgcn_rcpf(e.y)}; const f32x2_ w = (uu * gg + gg) * r; h[2 * p] = w.x; h[2 * p + 1] = w.y; }
    return h;
}
__device__ __forceinline__ float swiglu1(float g, float u) { g = fminf(g, 7.0f); u = fminf(fmaxf(u, -7.0f), 7.0f); return (u + 1.0f) * g * __builtin_amdgcn_rcpf(1.0f + __expf(-1.702f * g)); }
struct EpiSwiglu {
    static constexpr bool PERM = true, AFTER_DRAIN = false;
    bf16_t* HID; const float* bgu;
    __device__ __forceinline__ void operator()(const f32x4 (&acc)[2][2][4][2], const Unit& u, int wr, int wc, int fr, int fq) const {
        const int e = u.pn >> 3, pnl = u.pn & 7; const int row0 = u.pm * BM + wr * 64 + fr, jj0 = pnl * 128 + wc * 32 + 8 * fq;
        const float* bg = bgu + (size_t)e * 2048 + jj0;
        const f32x4 bg0 = *(const f32x4*)bg, bg1 = *(const f32x4*)(bg + 4), bu0 = *(const f32x4*)(bg + 1024), bu1 = *(const f32x4*)(bg + 1028);
#pragma unroll
        for (int ai = 0; ai < 2; ++ai)
#pragma unroll
            for (int m = 0; m < 4; ++m) { bf16_t* rowp = HID + (size_t)(row0 + ai * HALF + m * 16) * 1024 + jj0;
                const f32x4 g0 = acc[ai][0][m][0] + bg0, g1 = acc[ai][0][m][1] + bg1, u0 = acc[ai][1][m][0] + bu0, u1 = acc[ai][1][m][1] + bu1;
                f32x4 h0, h1;
#pragma unroll
                for (int i = 0; i < 4; ++i) { h0[i] = swiglu1(g0[i], u0[i]); h1[i] = swiglu1(g1[i], u1[i]); }
                *(u32x4*)rowp = pack8(h0, h1); }
    }
};
struct EpiDown {
    static constexpr bool PERM = true, AFTER_DRAIN = false;
    bf16_t* Y; const float* bd;
    __device__ __forceinline__ void operator()(const f32x4 (&acc)[2][2][4][2], const Unit& u, int wr, int wc, int fr, int fq) const {
        const int e = u.pn >> 2, pnl = u.pn & 3; const int row0 = u.pm * BM + wr * 64 + fr, col0 = pnl * BM + wc * 32 + 8 * fq;
        const float* bp = bd + (size_t)e * 1024 + col0;
        f32x4 bv[2][2];
#pragma unroll
        for (int bj = 0; bj < 2; ++bj)
#pragma unroll
            for (int n = 0; n < 2; ++n) bv[bj][n] = *(const f32x4*)(bp + bj * HALF + 4 * n);
#pragma unroll
        for (int ai = 0; ai < 2; ++ai)
#pragma unroll
            for (int m = 0; m < 4; ++m) { bf16_t* rowp = Y + (size_t)(row0 + ai * HALF + m * 16) * 1024 + col0;
#pragma unroll
                for (int bj = 0; bj < 2; ++bj) *(u32x4*)(rowp + bj * HALF) = pack8(acc[ai][bj][m][0] + bv[bj][0], acc[ai][bj][m][1] + bv[bj][1]); }
    }
};
struct EpiNull {
    static constexpr bool PERM = true, AFTER_DRAIN = false;
    bf16_t* O;
    __device__ __forceinline__ void operator()(const f32x4 (&acc)[2][2][4][2], const Unit& u, int wr, int wc, int fr, int fq) const {
#pragma unroll
        for (int ai = 0; ai < 2; ++ai)
#pragma unroll
            for (int bj = 0; bj < 2; ++bj)
#pragma unroll
                for (int m = 0; m < 4; ++m)
#pragma unroll
                    for (int n = 0; n < 2; ++n) asm volatile("" :: "v"(acc[ai][bj][m][n]));
    }
};
__device__ __forceinline__ unsigned pk4_fp8e(float a, float b, float c, float d) { int w = 0; w = __builtin_amdgcn_cvt_pk_fp8_f32(a, b, w, false); w = __builtin_amdgcn_cvt_pk_fp8_f32(c, d, w, true); return (unsigned)w; }
struct EpiPlain8 {
    static constexpr bool PERM = true, AFTER_DRAIN = false, HAS_BIAS = false;
    bf16_t* O; int ldc;
    __device__ __forceinline__ void operator()(const f32x4 (&acc)[2][2][4][2], const Unit& u, int wr, int wc, int fr, int fq, int) const {
        const int row0 = u.pm * BM + wr * 64 + fr, col0 = u.pn * BM + wc * 32 + 8 * fq;
#pragma unroll
        for (int ai = 0; ai < 2; ++ai)
#pragma unroll
            for (int m = 0; m < 4; ++m) { bf16_t* rowp = O + (size_t)(row0 + ai * HALF + m * 16) * ldc + col0;
#pragma unroll
                for (int bj = 0; bj < 2; ++bj) *(u32x4*)(rowp + bj * HALF) = pack8(acc[ai][bj][m][0], acc[ai][bj][m][1]); }
    }
};
struct EpiSwiglu8 {
    static constexpr bool PERM = true, AFTER_DRAIN = false, HAS_BIAS = true;
    unsigned char* HID; const float* bgu; PG8_LAS float* bl;
    __device__ __forceinline__ const float* bias_src(const Unit& u, int lane) const { const int e = u.pn >> 3, pnl = u.pn & 7; return bgu + (size_t)e * 2048 + pnl * 128 + (lane >> 5) * 1024 + (lane & 31) * 4; }
    __device__ __forceinline__ void operator()(const f32x4 (&acc)[2][2][4][2], const Unit& u, int wr, int wc, int fr, int fq, int slot) const {
        const int pnl = u.pn & 7; const int row0 = u.pm * BM + wr * 64 + fr, jj0 = pnl * 128 + wc * 32 + 8 * fq;
        const PG8_LAS float* bg = bl + slot * 256 + wc * 32 + 8 * fq;
        const f32x4 bg0 = *(const PG8_LAS f32x4*)bg, bg1 = *(const PG8_LAS f32x4*)(bg + 4), bu0 = *(const PG8_LAS f32x4*)(bg + 128), bu1 = *(const PG8_LAS f32x4*)(bg + 132);
#pragma unroll
        for (int ai = 0; ai < 2; ++ai)
#pragma unroll
            for (int m = 0; m < 4; ++m) { unsigned char* rowp = HID + (size_t)(row0 + ai * HALF + m * 16) * 1024 + jj0;
                const f32x4 g0 = acc[ai][0][m][0] + bg0, g1 = acc[ai][0][m][1] + bg1, u0 = acc[ai][1][m][0] + bu0, u1 = acc[ai][1][m][1] + bu1;
                const f32x4 h0 = swiglu4(g0, u0), h1 = swiglu4(g1, u1);
                *(unsigned long long*)rowp = (unsigned long long)pk4_fp8e(h0[0], h0[1], h0[2], h0[3]) | ((unsigned long long)pk4_fp8e(h1[0], h1[1], h1[2], h1[3]) << 32); }
    }
};
struct EpiDown8 {
    static constexpr bool PERM = true, AFTER_DRAIN = false, HAS_BIAS = true;
    unsigned char* Y; const float* bd; PG8_LAS float* bl;
    __device__ __forceinline__ const float* bias_src(const Unit& u, int lane) const { const int e = u.pn >> 2, pnl = u.pn & 3; return bd + (size_t)e * 1024 + pnl * BM + lane * 4; }
    __device__ __forceinline__ void operator()(const f32x4 (&acc)[2][2][4][2], const Unit& u, int wr, int wc, int fr, int fq, int slot) const {
        const int pnl = u.pn & 3; const int row0 = u.pm * BM + wr * 64 + fr, col0 = pnl * BM + wc * 32 + 8 * fq;
        const PG8_LAS float* bp = bl + slot * 256 + wc * 32 + 8 * fq;
        f32x4 bv[2][2];
#pragma unroll
        for (int bj = 0; bj < 2; ++bj)
#pragma unroll
            for (int n = 0; n < 2; ++n) bv[bj][n] = *(const PG8_LAS f32x4*)(bp + bj * HALF + 4 * n);
#pragma unroll
        for (int ai = 0; ai < 2; ++ai)
#pragma unroll
            for (int m = 0; m < 4; ++m) { unsigned char* rowp = Y + (size_t)(row0 + ai * HALF + m * 16) * 1024 + col0;
#pragma unroll
                for (int bj = 0; bj < 2; ++bj) { const f32x4 y0 = acc[ai][bj][m][0] + bv[bj][0], y1 = acc[ai][bj][m][1] + bv[bj][1];
                    *(unsigned long long*)(rowp + bj * HALF) = (unsigned long long)pk4_fp8e(y0[0], y0[1], y0[2], y0[3]) | ((unsigned long long)pk4_fp8e(y1[0], y1[1], y1[2], y1[3]) << 32); } }
    }
};
struct ListOrder {
    const PG8_LAS int* list; int n;
    __device__ __forceinline__ bool next(int i, Unit& u) const { if (i >= n) return false; const int v = __builtin_amdgcn_readfirstlane(list[i]); u.pm = v >> 16; u.pn = v & 0xffff; return true; }
    __device__ __forceinline__ void a_ready(const Unit&) const {}
    __device__ __forceinline__ void done(const Unit&) const {}
};
template <class Epi, class Sched, bool ALIGN_EPI = false, bool SP2 = false>
__device__ __forceinline__ void gemm_phase(PG8_LAS unsigned char* lds, const Gemm g, const Sched& S, const Epi& E) {
    int tid_ = threadIdx.x; asm volatile("" : "+v"(tid_));
    const int tid = tid_, wid = __builtin_amdgcn_readfirstlane(tid >> 6), lane = tid & 63, wr = wid >> 2, wc = wid & 3, fr = lane & 15, fq = lane >> 4;
    const int K = g.K, nt = K / BK;
    unsigned voffA[2], voffB[2];
#pragma unroll
    for (int i = 0; i < 2; ++i) { int R, C; stage_rc(tid * 16 + i * 8192, R, C); const int Rb = Epi::PERM ? ((R & ~31) + perm32(R & 31)) : R;
        voffA[i] = (unsigned)(R * K + C) * 2u; voffB[i] = (unsigned)(Rb * K + C) * 2u; }
    const size_t kstep = (size_t)(BK * 2);
    const size_t hstep = (size_t)HALF * K * 2;
    const size_t tstep = 2 * hstep;
    const unsigned ldsw = (unsigned)wid * 1024u;
    const int aoff = lds_byte(wr * 64 + fr, fq * 8), boff = lds_byte(wc * 32 + fr, fq * 8);
#define PG8_SA(b, h) (((b) * 2 + (h)) * HTB)
#define PG8_SB(b, h) ((4 + (b) * 2 + (h)) * HTB)
#define PG8_STAGE(bufoff, gbase, voff) do { _Pragma("unroll") for (int _i = 0; _i < 2; ++_i) \
        __builtin_amdgcn_global_load_lds((const unsigned*)((const char*)(gbase) + (voff)[_i]), (PG8_LAS unsigned*)(lds + (bufoff) + ldsw + _i * 8192), 16, 0, 0); } while (0)
#define PG8_LDA(dst, b, h) do { _Pragma("unroll") for (int m = 0; m < 4; ++m) _Pragma("unroll") for (int k = 0; k < 2; ++k) dst[m][k] = *(const PG8_LAS bf16x8*)(lds + PG8_SA(b, h) + aoff + m * 2048 + k * 1024); } while (0)
#define PG8_LDB(dst, b, h) do { _Pragma("unroll") for (int n = 0; n < 2; ++n) _Pragma("unroll") for (int k = 0; k < 2; ++k) dst[n][k] = *(const PG8_LAS bf16x8*)(lds + PG8_SB(b, h) + boff + n * 2048 + k * 1024); } while (0)
#define PG8_MMA(ai, bj, At, Bt) do { __builtin_amdgcn_s_setprio(1); _Pragma("unroll") for (int m = 0; m < 4; ++m) _Pragma("unroll") for (int n = 0; n < 2; ++n) _Pragma("unroll") for (int k = 0; k < 2; ++k) \
        acc[ai][bj][m][n] = __builtin_amdgcn_mfma_f32_16x16x32_bf16(Bt[n][k], At[m][k], acc[ai][bj][m][n], 0, 0, 0); __builtin_amdgcn_s_setprio(0); } while (0)
#define PG8_WAIT_V(n) asm volatile("s_waitcnt vmcnt(" #n ")" ::: "memory")
#define PG8_WAIT_L(n) asm volatile("s_waitcnt lgkmcnt(" #n ")" ::: "memory")
#define PG8_BAR __builtin_amdgcn_s_barrier()
#define PG8_SCHED __builtin_amdgcn_sched_barrier(0)
    Unit cur, nxt; int ui = 0;
    if (!S.next(0, cur)) return;
    f32x4 acc[2][2][4][2];
#pragma unroll
    for (int a = 0; a < 2; ++a)
#pragma unroll
        for (int b = 0; b < 2; ++b)
#pragma unroll
            for (int m = 0; m < 4; ++m)
#pragma unroll
                for (int n = 0; n < 2; ++n) acc[a][b][m][n] = (f32x4){0.f, 0.f, 0.f, 0.f};
    bf16x8 At[4][2], B0[2][2], B1[2][2];
    const char* cA = (const char*)g.A + (size_t)cur.pm * tstep; const char* cB = (const char*)g.Bt + (size_t)cur.pn * tstep;
    S.a_ready(cur);
    if constexpr (SP2) {
        PG8_STAGE(PG8_SB(0, 0), cB, voffB); PG8_STAGE(PG8_SB(0, 1), cB + hstep, voffB); PG8_STAGE(PG8_SA(0, 0), cA, voffA); PG8_STAGE(PG8_SA(0, 1), cA + hstep, voffA);
        if (wr == 1) PG8_BAR;
        PG8_WAIT_V(2); PG8_BAR;
        PG8_STAGE(PG8_SB(1, 0), cB + kstep, voffB); PG8_STAGE(PG8_SA(1, 0), cA + kstep, voffA); PG8_STAGE(PG8_SB(1, 1), cB + hstep + kstep, voffB);
        PG8_WAIT_V(6); PG8_BAR;
    } else {
        PG8_STAGE(PG8_SB(0, 0), cB, voffB); PG8_STAGE(PG8_SA(0, 0), cA, voffA); PG8_STAGE(PG8_SB(0, 1), cB + hstep, voffB); PG8_STAGE(PG8_SA(0, 1), cA + hstep, voffA);
        if (wr == 1) PG8_BAR;
        PG8_WAIT_V(4); PG8_BAR;
        PG8_STAGE(PG8_SB(1, 0), cB + kstep, voffB); PG8_STAGE(PG8_SA(1, 0), cA + kstep, voffA); PG8_STAGE(PG8_SB(1, 1), cB + hstep + kstep, voffB);
        PG8_WAIT_V(6); PG8_BAR;
    }
    for (;;) {
        const bool has_next = S.next(ui + 1, nxt);
        const char* nA = has_next ? (const char*)g.A + (size_t)nxt.pm * tstep : cA; const char* nB = has_next ? (const char*)g.Bt + (size_t)nxt.pn * tstep : cB;
        for (int t = 0; t < nt; t += 2) {
            const bool last = (t == nt - 2);
            const char* a1 = cA + (size_t)(t + 1) * kstep;
            const char* a2 = last ? nA : cA + (size_t)(t + 2) * kstep; const char* b2 = last ? nB : cB + (size_t)(t + 2) * kstep;
            const char* a3 = a2 + kstep; const char* b3 = b2 + kstep;
            if (last && has_next) S.a_ready(nxt);
            if constexpr (SP2) {
            PG8_LDB(B0, 0, 0); PG8_LDB(B1, 0, 1); PG8_SCHED; PG8_LDA(At, 0, 0); PG8_STAGE(PG8_SA(1, 1), a1 + hstep, voffA);
            PG8_WAIT_V(8); PG8_WAIT_L(0); PG8_BAR; PG8_MMA(0, 0, At, B0); PG8_MMA(0, 1, At, B1); PG8_BAR; PG8_SCHED;
            PG8_LDA(At, 0, 1); PG8_STAGE(PG8_SB(0, 0), b2, voffB); PG8_STAGE(PG8_SB(0, 1), b2 + hstep, voffB); PG8_STAGE(PG8_SA(0, 0), a2, voffA);
            PG8_WAIT_V(8); PG8_WAIT_L(0); PG8_BAR; PG8_MMA(1, 0, At, B0); PG8_MMA(1, 1, At, B1); PG8_BAR; PG8_SCHED;
            PG8_LDB(B0, 1, 0); PG8_LDB(B1, 1, 1); PG8_SCHED; PG8_LDA(At, 1, 0); PG8_STAGE(PG8_SA(0, 1), a2 + hstep, voffA);
            PG8_WAIT_V(8); PG8_WAIT_L(0); PG8_BAR; PG8_MMA(0, 0, At, B0); PG8_MMA(0, 1, At, B1); PG8_BAR; PG8_SCHED;
            PG8_LDA(At, 1, 1); PG8_STAGE(PG8_SB(1, 0), b3, voffB); PG8_STAGE(PG8_SB(1, 1), b3 + hstep, voffB); PG8_STAGE(PG8_SA(1, 0), a3, voffA);
            PG8_WAIT_V(8); PG8_WAIT_L(0); PG8_BAR; PG8_MMA(1, 0, At, B0); PG8_MMA(1, 1, At, B1); PG8_BAR; PG8_SCHED;
            } else {
            PG8_LDB(B0, 0, 0); PG8_SCHED; PG8_LDA(At, 0, 0); PG8_STAGE(PG8_SA(1, 1), a1 + hstep, voffA);
            PG8_WAIT_L(8); PG8_BAR; PG8_WAIT_L(0); PG8_MMA(0, 0, At, B0); PG8_BAR; PG8_SCHED;
            PG8_LDB(B1, 0, 1); PG8_STAGE(PG8_SB(0, 0), b2, voffB);
            PG8_BAR; PG8_WAIT_L(0); PG8_MMA(0, 1, At, B1); PG8_BAR;
            PG8_LDA(At, 0, 1); PG8_STAGE(PG8_SA(0, 0), a2, voffA);
            PG8_BAR; PG8_WAIT_L(0); PG8_MMA(1, 0, At, B0); PG8_BAR; PG8_SCHED;
            PG8_STAGE(PG8_SB(0, 1), b2 + hstep, voffB);
            PG8_WAIT_V(6); PG8_BAR; PG8_MMA(1, 1, At, B1); PG8_BAR;
            PG8_LDB(B0, 1, 0); PG8_SCHED; PG8_LDA(At, 1, 0); PG8_STAGE(PG8_SA(0, 1), a2 + hstep, voffA);
            PG8_WAIT_L(8); PG8_BAR; PG8_WAIT_L(0); PG8_MMA(0, 0, At, B0); PG8_BAR; PG8_SCHED;
            PG8_LDB(B1, 1, 1); PG8_STAGE(PG8_SB(1, 0), b3, voffB);
            PG8_BAR; PG8_WAIT_L(0); PG8_MMA(0, 1, At, B1); PG8_BAR;
            PG8_LDA(At, 1, 1); PG8_STAGE(PG8_SA(1, 0), a3, voffA);
            PG8_BAR; PG8_WAIT_L(0); PG8_MMA(1, 0, At, B0); PG8_BAR; PG8_SCHED;
            PG8_STAGE(PG8_SB(1, 1), b3 + hstep, voffB);
            PG8_WAIT_V(6); PG8_BAR; PG8_MMA(1, 1, At, B1); PG8_BAR;
            }
        }
        if constexpr (ALIGN_EPI) { if (wr == 0) PG8_BAR; }
        if constexpr (!Epi::AFTER_DRAIN) { E(acc, cur, wr, wc, fr, fq); S.done(cur); }
        if (!has_next) break;
#pragma unroll
        for (int a = 0; a < 2; ++a)
#pragma unroll
            for (int b = 0; b < 2; ++b)
#pragma unroll
                for (int m = 0; m < 4; ++m)
#pragma unroll
                    for (int n = 0; n < 2; ++n) acc[a][b][m][n] = (f32x4){0.f, 0.f, 0.f, 0.f};
        cur = nxt; cA = nA; cB = nB; ++ui;
        if constexpr (ALIGN_EPI) { if (wr == 1) PG8_BAR; }
    }
    PG8_WAIT_V(0);
    if constexpr (!ALIGN_EPI) { if (wr == 0) PG8_BAR; }
    PG8_BAR;
    if constexpr (Epi::AFTER_DRAIN) { E.fused(acc, cur, wr, wc, fr, fq, lds, wid, lane); S.done(cur); }
#undef PG8_SA
#undef PG8_SB
#undef PG8_STAGE
#undef PG8_LDA
#undef PG8_LDB
#undef PG8_MMA
#undef PG8_WAIT_V
#undef PG8_WAIT_L
#undef PG8_BAR
#undef PG8_SCHED
}
}
namespace pg8 {
template <class Epi, class Sched, bool ALIGN_EPI>
__device__ __forceinline__ void gemm_phase_gather(PG8_LAS unsigned char* lds, const Gemm g, const Sched& S, const Epi& E, const PG8_LAS unsigned short* rows16) {
    int tid_ = threadIdx.x; asm volatile("" : "+v"(tid_));
    const int tid = tid_, wid = __builtin_amdgcn_readfirstlane(tid >> 6), lane = tid & 63, wr = wid >> 2, wc = wid & 3, fr = lane & 15, fq = lane >> 4;
    const int K = g.K, nt = K / BK;
    unsigned voffB[2]; int RA[2]; unsigned CA2[2];
#pragma unroll
    for (int i = 0; i < 2; ++i) { int R, C; stage_rc(tid * 16 + i * 8192, R, C); const int Rb = Epi::PERM ? ((R & ~31) + perm32(R & 31)) : R;
        RA[i] = R; CA2[i] = (unsigned)C * 2u; voffB[i] = (unsigned)(Rb * K + C) * 2u; }
    const size_t kstep = (size_t)(BK * 2);
    const size_t hstep = (size_t)HALF * K * 2;
    const size_t tstep = 2 * hstep;
    const unsigned ldsw = (unsigned)wid * 1024u;
    const unsigned rowb = (unsigned)K * 2u;
    const int aoff = lds_byte(wr * 64 + fr, fq * 8), boff = lds_byte(wc * 32 + fr, fq * 8);
#define PG8_SA(b, h) (((b) * 2 + (h)) * HTB)
#define PG8_SB(b, h) ((4 + (b) * 2 + (h)) * HTB)
#define PG8_STAGE(bufoff, gbase, voff) do { _Pragma("unroll") for (int _i = 0; _i < 2; ++_i) \
        __builtin_amdgcn_global_load_lds((const unsigned*)((const char*)(gbase) + (voff)[_i]), (PG8_LAS unsigned*)(lds + (bufoff) + ldsw + _i * 8192), 16, 0, 0); } while (0)
#define PG8_LDA(dst, b, h) do { _Pragma("unroll") for (int m = 0; m < 4; ++m) _Pragma("unroll") for (int k = 0; k < 2; ++k) dst[m][k] = *(const PG8_LAS bf16x8*)(lds + PG8_SA(b, h) + aoff + m * 2048 + k * 1024); } while (0)
#define PG8_LDB(dst, b, h) do { _Pragma("unroll") for (int n = 0; n < 2; ++n) _Pragma("unroll") for (int k = 0; k < 2; ++k) dst[n][k] = *(const PG8_LAS bf16x8*)(lds + PG8_SB(b, h) + boff + n * 2048 + k * 1024); } while (0)
#define PG8_MMA(ai, bj, At, Bt) do { __builtin_amdgcn_s_setprio(1); _Pragma("unroll") for (int m = 0; m < 4; ++m) _Pragma("unroll") for (int n = 0; n < 2; ++n) _Pragma("unroll") for (int k = 0; k < 2; ++k) \
        acc[ai][bj][m][n] = __builtin_amdgcn_mfma_f32_16x16x32_bf16(Bt[n][k], At[m][k], acc[ai][bj][m][n], 0, 0, 0); __builtin_amdgcn_s_setprio(0); } while (0)
#define PG8_WAIT_V(n) asm volatile("s_waitcnt vmcnt(" #n ")" ::: "memory")
#define PG8_WAIT_L(n) asm volatile("s_waitcnt lgkmcnt(" #n ")" ::: "memory")
#define PG8_BAR __builtin_amdgcn_s_barrier()
#define PG8_SCHED __builtin_amdgcn_sched_barrier(0)
#define PG8_GOFF(dst, U) do { _Pragma("unroll") for (int h_ = 0; h_ < 2; ++h_) _Pragma("unroll") for (int i_ = 0; i_ < 2; ++i_) dst[h_][i_] = (unsigned)rows16[(U) * 256 + h_ * HALF + RA[i_]] * rowb + CA2[i_]; } while (0)
    Unit cur, nxt; int ui = 0;
    if (!S.next(0, cur)) return;
    f32x4 acc[2][2][4][2];
#pragma unroll
    for (int a = 0; a < 2; ++a)
#pragma unroll
        for (int b = 0; b < 2; ++b)
#pragma unroll
            for (int m = 0; m < 4; ++m)
#pragma unroll
                for (int n = 0; n < 2; ++n) acc[a][b][m][n] = (f32x4){0.f, 0.f, 0.f, 0.f};
    bf16x8 At[4][2], B0[2][2], B1[2][2];
    const char* const Ab = (const char*)g.A;
    const char* cB = (const char*)g.Bt + (size_t)cur.pn * tstep;
    unsigned gc[2][2], gn[2][2];
    PG8_GOFF(gc, 0);
    S.a_ready(cur);
    PG8_STAGE(PG8_SB(0, 0), cB, voffB); PG8_STAGE(PG8_SB(0, 1), cB + hstep, voffB); PG8_STAGE(PG8_SA(0, 0), Ab, gc[0]); PG8_STAGE(PG8_SA(0, 1), Ab, gc[1]);
    if (wr == 1) PG8_BAR;
    PG8_WAIT_V(2); PG8_BAR;
    PG8_STAGE(PG8_SB(1, 0), cB + kstep, voffB); PG8_STAGE(PG8_SA(1, 0), Ab + kstep, gc[0]); PG8_STAGE(PG8_SB(1, 1), cB + hstep + kstep, voffB);
    PG8_WAIT_V(6); PG8_BAR;
    for (;;) {
        const bool has_next = S.next(ui + 1, nxt);
        const char* nB = has_next ? (const char*)g.Bt + (size_t)nxt.pn * tstep : cB;
        if (has_next) { PG8_GOFF(gn, ui + 1); } else {
#pragma unroll
            for (int h_ = 0; h_ < 2; ++h_)
#pragma unroll
                for (int i_ = 0; i_ < 2; ++i_) gn[h_][i_] = gc[h_][i_]; }
        for (int t = 0; t < nt; t += 2) {
            const bool last = (t == nt - 2);
            const char* a1 = Ab + (size_t)(t + 1) * kstep;
            const char* a2 = last ? Ab : Ab + (size_t)(t + 2) * kstep; const char* b2 = last ? nB : cB + (size_t)(t + 2) * kstep;
            const char* a3 = a2 + kstep; const char* b3 = b2 + kstep;
            unsigned g2[2][2];
#pragma unroll
            for (int h_ = 0; h_ < 2; ++h_)
#pragma unroll
                for (int i_ = 0; i_ < 2; ++i_) g2[h_][i_] = last ? gn[h_][i_] : gc[h_][i_];
            if (last && has_next) S.a_ready(nxt);
            PG8_LDB(B0, 0, 0); PG8_LDB(B1, 0, 1); PG8_SCHED; PG8_LDA(At, 0, 0); PG8_STAGE(PG8_SA(1, 1), a1, gc[1]);
            PG8_WAIT_V(8); PG8_WAIT_L(0); PG8_BAR; PG8_MMA(0, 0, At, B0); PG8_MMA(0, 1, At, B1); PG8_BAR; PG8_SCHED;
            PG8_LDA(At, 0, 1); PG8_STAGE(PG8_SB(0, 0), b2, voffB); PG8_STAGE(PG8_SB(0, 1), b2 + hstep, voffB); PG8_STAGE(PG8_SA(0, 0), a2, g2[0]);
            PG8_WAIT_V(8); PG8_WAIT_L(0); PG8_BAR; PG8_MMA(1, 0, At, B0); PG8_MMA(1, 1, At, B1); PG8_BAR; PG8_SCHED;
            PG8_LDB(B0, 1, 0); PG8_LDB(B1, 1, 1); PG8_SCHED; PG8_LDA(At, 1, 0); PG8_STAGE(PG8_SA(0, 1), a2, g2[1]);
            PG8_WAIT_V(8); PG8_WAIT_L(0); PG8_BAR; PG8_MMA(0, 0, At, B0); PG8_MMA(0, 1, At, B1); PG8_BAR; PG8_SCHED;
            PG8_LDA(At, 1, 1); PG8_STAGE(PG8_SB(1, 0), b3, voffB); PG8_STAGE(PG8_SB(1, 1), b3 + hstep, voffB); PG8_STAGE(PG8_SA(1, 0), a3, g2[0]);
            PG8_WAIT_V(8); PG8_WAIT_L(0); PG8_BAR; PG8_MMA(1, 0, At, B0); PG8_MMA(1, 1, At, B1); PG8_BAR; PG8_SCHED;
        }
        if constexpr (ALIGN_EPI) { if (wr == 0) PG8_BAR; }
        E(acc, cur, wr, wc, fr, fq); S.done(cur);
        if (!has_next) break;
#pragma unroll
        for (int a = 0; a < 2; ++a)
#pragma unroll
            for (int b = 0; b < 2; ++b)
#pragma unroll
                for (int m = 0; m < 4; ++m)
#pragma unroll
                    for (int n = 0; n < 2; ++n) acc[a][b][m][n] = (f32x4){0.f, 0.f, 0.f, 0.f};
        cur = nxt; cB = nB; ++ui;
#pragma unroll
        for (int h_ = 0; h_ < 2; ++h_)
#pragma unroll
            for (int i_ = 0; i_ < 2; ++i_) gc[h_][i_] = gn[h_][i_];
        if constexpr (ALIGN_EPI) { if (wr == 1) PG8_BAR; }
    }
    PG8_WAIT_V(0);
    if constexpr (!ALIGN_EPI) { if (wr == 0) PG8_BAR; }
    PG8_BAR;
#undef PG8_SA
#undef PG8_SB
#undef PG8_STAGE
#undef PG8_LDA
#undef PG8_LDB
#undef PG8_MMA
#undef PG8_WAIT_V
#undef PG8_WAIT_L
#undef PG8_BAR
#undef PG8_SCHED
#undef PG8_GOFF
}
}
namespace pg8 {
typedef int v8i __attribute__((ext_vector_type(8)));
typedef int v4i __attribute__((ext_vector_type(4)));
template <class Epi, class Sched, bool ALIGN_EPI, bool GATHER>
__device__ __forceinline__ void gemm_phase_fp8(PG8_LAS unsigned char* lds, const Gemm g, const Sched& S, const Epi& E, const PG8_LAS unsigned short* rows16) {
    int tid_ = threadIdx.x; asm volatile("" : "+v"(tid_));
    const int tid = tid_, wid = __builtin_amdgcn_readfirstlane(tid >> 6), lane = tid & 63, wr = wid >> 2, wc = wid & 3, fr = lane & 15, fq = lane >> 4;
    const int K = g.K, nt = K / 128;
    unsigned voffB[2];
#pragma unroll
    for (int i = 0; i < 2; ++i) { int R, C; stage_rc(tid * 16 + i * 8192, R, C); const int Rb = Epi::PERM ? ((R & ~31) + perm32(R & 31)) : R;
        voffB[i] = (unsigned)(Rb * K) + (unsigned)C * 2u; }
    const size_t kstep = (size_t)(BK * 2);
    const size_t hstep = (size_t)HALF * K;
    const size_t tstep = 2 * hstep;
    const unsigned ldsw = (unsigned)wid * 1024u;
    const unsigned rowb = (unsigned)K;
    const int aoff = lds_byte(wr * 64 + fr, fq * 8), boff = lds_byte(wc * 32 + fr, fq * 8);
#define PG8_SA(b, h) (((b) * 2 + (h)) * HTB)
#define PG8_SB(b, h) ((4 + (b) * 2 + (h)) * HTB)
#define PG8_STAGE(bufoff, gbase, voff) do { _Pragma("unroll") for (int _i = 0; _i < 2; ++_i) \
        __builtin_amdgcn_global_load_lds((const unsigned*)((const char*)(gbase) + (voff)[_i]), (PG8_LAS unsigned*)(lds + (bufoff) + ldsw + _i * 8192), 16, 0, 0); } while (0)
#define PG8_LDA(dst, b, h) do { _Pragma("unroll") for (int m = 0; m < 4; ++m) { const v4i lo_ = *(const PG8_LAS v4i*)(lds + PG8_SA(b, h) + aoff + m * 2048), hi_ = *(const PG8_LAS v4i*)(lds + PG8_SA(b, h) + aoff + m * 2048 + 1024); dst[m] = __builtin_shufflevector(lo_, hi_, 0, 1, 2, 3, 4, 5, 6, 7); } } while (0)
#define PG8_LDB(dst, b, h) do { _Pragma("unroll") for (int n = 0; n < 2; ++n) { const v4i lo_ = *(const PG8_LAS v4i*)(lds + PG8_SB(b, h) + boff + n * 2048), hi_ = *(const PG8_LAS v4i*)(lds + PG8_SB(b, h) + boff + n * 2048 + 1024); dst[n] = __builtin_shufflevector(lo_, hi_, 0, 1, 2, 3, 4, 5, 6, 7); } } while (0)
#define PG8_F8(x) (x)
#define PG8_MMA(ai, bj, At, Bt) do { __builtin_amdgcn_s_setprio(1); _Pragma("unroll") for (int m = 0; m < 4; ++m) _Pragma("unroll") for (int n = 0; n < 2; ++n) \
        asm volatile("v_mfma_scale_f32_16x16x128_f8f6f4 %0, %1, %2, %0, %3, %4 op_sel_hi:[0,0,0]" : "+v"(acc[ai][bj][m][n]) : "v"(Bt[n]), "v"(At[m]), "v"(sc2_), "v"(sc1_)); __builtin_amdgcn_s_setprio(0); } while (0)
#define PG8_MMAZ(ai, bj, At, Bt) do { __builtin_amdgcn_s_setprio(1); _Pragma("unroll") for (int m = 0; m < 4; ++m) _Pragma("unroll") for (int n = 0; n < 2; ++n) \
        asm volatile("v_mfma_scale_f32_16x16x128_f8f6f4 %0, %1, %2, 0, %3, %4 op_sel_hi:[0,0,0]" : "=v"(acc[ai][bj][m][n]) : "v"(Bt[n]), "v"(At[m]), "v"(sc2_), "v"(sc1_)); __builtin_amdgcn_s_setprio(0); } while (0)
#define PG8_WAIT_V(n) asm volatile("s_waitcnt vmcnt(" #n ")" ::: "memory")
#define PG8_WAIT_L(n) asm volatile("s_waitcnt lgkmcnt(" #n ")" ::: "memory")
#define PG8_BAR __builtin_amdgcn_s_barrier()
#define PG8_SCHED __builtin_amdgcn_sched_barrier(0)
#define PG8_GOFF(dst, U, PM) do { int t2_ = tid; asm volatile("" : "+v"(t2_)); _Pragma("unroll") for (int i_ = 0; i_ < 2; ++i_) { int R_, C_; stage_rc(t2_ * 16 + i_ * 8192, R_, C_); _Pragma("unroll") for (int h_ = 0; h_ < 2; ++h_) \
        dst[h_][i_] = (GATHER ? (unsigned)rows16[(U) * 256 + h_ * HALF + R_] : (unsigned)((PM) * 256 + h_ * HALF + R_)) * rowb + (unsigned)C_ * 2u; } } while (0)
    Unit cur, nxt; int ui = 0;
    if (!S.next(0, cur)) return;
    int sc1_ = 0x7f7f7f7f, sc2_ = 0x79797979; asm volatile("" : "+v"(sc1_), "+v"(sc2_));
    f32x4 acc[2][2][4][2];
    v8i At[4], B0[2], B1[2];
    const char* const Ab = (const char*)g.A;
    const char* cB = (const char*)g.Bt + (size_t)cur.pn * tstep;
    unsigned gc[2][2], gn[2][2];
    PG8_GOFF(gc, 0, cur.pm);
    S.a_ready(cur);
#define PG8_BIAS(U, SLOT) do { if constexpr (Epi::HAS_BIAS) if (wid == 0) __builtin_amdgcn_global_load_lds((const unsigned*)E.bias_src((U), lane), (PG8_LAS unsigned*)(E.bl + (SLOT) * 256), 16, 0, 0); } while (0)
    PG8_BIAS(cur, 0);
    PG8_STAGE(PG8_SB(0, 0), cB, voffB); PG8_STAGE(PG8_SB(0, 1), cB + hstep, voffB); PG8_STAGE(PG8_SA(0, 0), Ab, gc[0]); PG8_STAGE(PG8_SA(0, 1), Ab, gc[1]);
    if (wr == 1) PG8_BAR;
    PG8_WAIT_V(2); PG8_BAR;
    PG8_STAGE(PG8_SB(1, 0), cB + kstep, voffB); PG8_STAGE(PG8_SA(1, 0), Ab + kstep, gc[0]); PG8_STAGE(PG8_SB(1, 1), cB + hstep + kstep, voffB);
    PG8_WAIT_V(6); PG8_BAR;
    for (;;) {
        const bool has_next = S.next(ui + 1, nxt);
        const char* nB = has_next ? (const char*)g.Bt + (size_t)nxt.pn * tstep : cB;
        if (has_next) { PG8_GOFF(gn, ui + 1, nxt.pm); } else {
#pragma unroll
            for (int h_ = 0; h_ < 2; ++h_)
#pragma unroll
                for (int i_ = 0; i_ < 2; ++i_) gn[h_][i_] = gc[h_][i_]; }
#pragma unroll 1
        for (int t = 0; t < nt; t += 2) {
            const bool last = (t == nt - 2);
            const char* a1 = Ab + (size_t)(t + 1) * kstep;
            const char* a2 = last ? Ab : Ab + (size_t)(t + 2) * kstep; const char* b2 = last ? nB : cB + (size_t)(t + 2) * kstep;
            const char* a3 = a2 + kstep; const char* b3 = b2 + kstep;
            unsigned g2[2][2];
#pragma unroll
            for (int h_ = 0; h_ < 2; ++h_)
#pragma unroll
                for (int i_ = 0; i_ < 2; ++i_) g2[h_][i_] = last ? gn[h_][i_] : gc[h_][i_];
            if (last && has_next) S.a_ready(nxt);
            PG8_LDB(B0, 0, 0); PG8_LDB(B1, 0, 1); PG8_SCHED; PG8_LDA(At, 0, 0); PG8_STAGE(PG8_SA(1, 1), a1, gc[1]);
            PG8_WAIT_V(8); PG8_WAIT_L(0); PG8_BAR; if (t == 0) { PG8_MMAZ(0, 0, At, B0); PG8_MMAZ(0, 1, At, B1); } else { PG8_MMA(0, 0, At, B0); PG8_MMA(0, 1, At, B1); } PG8_BAR; PG8_SCHED;
            PG8_LDA(At, 0, 1); PG8_STAGE(PG8_SB(0, 0), b2, voffB); PG8_STAGE(PG8_SB(0, 1), b2 + hstep, voffB); PG8_STAGE(PG8_SA(0, 0), a2, g2[0]);
            PG8_WAIT_V(8); PG8_WAIT_L(0); PG8_BAR; if (t == 0) { PG8_MMAZ(1, 0, At, B0); PG8_MMAZ(1, 1, At, B1); } else { PG8_MMA(1, 0, At, B0); PG8_MMA(1, 1, At, B1); } PG8_BAR; PG8_SCHED;
            PG8_LDB(B0, 1, 0); PG8_LDB(B1, 1, 1); PG8_SCHED; PG8_LDA(At, 1, 0); PG8_STAGE(PG8_SA(0, 1), a2, g2[1]);
            PG8_WAIT_V(8); PG8_WAIT_L(0); PG8_BAR; PG8_MMA(0, 0, At, B0); PG8_MMA(0, 1, At, B1); PG8_BAR; PG8_SCHED;
            PG8_LDA(At, 1, 1); PG8_STAGE(PG8_SB(1, 0), b3, voffB); PG8_STAGE(PG8_SB(1, 1), b3 + hstep, voffB); PG8_STAGE(PG8_SA(1, 0), a3, g2[0]);
            PG8_WAIT_V(8); PG8_WAIT_L(0); PG8_BAR; PG8_MMA(1, 0, At, B0); PG8_MMA(1, 1, At, B1); PG8_BAR; PG8_SCHED;
        }
        if constexpr (ALIGN_EPI) { if (wr == 0) PG8_BAR; }
        asm volatile("s_nop 15\n\ts_nop 15" ::: "memory");
        E(acc, cur, wr, wc, fr, fq, ui & 1); S.done(cur);
        if (!has_next) break;
        PG8_BIAS(nxt, (ui + 1) & 1);
        cur = nxt; cB = nB; ++ui;
#pragma unroll
        for (int h_ = 0; h_ < 2; ++h_)
#pragma unroll
            for (int i_ = 0; i_ < 2; ++i_) gc[h_][i_] = gn[h_][i_];
        if constexpr (ALIGN_EPI) { if (wr == 1) PG8_BAR; }
    }
    PG8_WAIT_V(0);
    if constexpr (!ALIGN_EPI) { if (wr == 0) PG8_BAR; }
    PG8_BAR;
#undef PG8_SA
#undef PG8_SB
#undef PG8_STAGE
#undef PG8_LDA
#undef PG8_LDB
#undef PG8_MMA
#undef PG8_MMAZ
#undef PG8_WAIT_V
#undef PG8_WAIT_L
#undef PG8_BAR
#undef PG8_SCHED
#undef PG8_GOFF
#undef PG8_F8
#undef PG8_BIAS
}
}
#define GAS __attribute__((address_space(1)))
#define LAS __attribute__((address_space(3)))
typedef unsigned short bf16;
typedef unsigned v4u __attribute__((ext_vector_type(4)));
typedef float f32x4 __attribute__((ext_vector_type(4)));
typedef short bf16x8 __attribute__((ext_vector_type(8)));
typedef GAS unsigned gu32;
typedef GAS unsigned long long gu64;
#define RLX_AGENT __ATOMIC_RELAXED, __HIP_MEMORY_SCOPE_AGENT
#define LDS_WAIT() asm volatile("s_waitcnt lgkmcnt(0)" ::: "memory")
#define VM_WAIT() asm volatile("s_waitcnt vmcnt(0)" ::: "memory")
__device__ __forceinline__ unsigned long long rt() { return __builtin_amdgcn_s_memrealtime(); }
__device__ __forceinline__ unsigned f2bf(float f) { unsigned u = __builtin_bit_cast(unsigned, f); return (u + 0x7fffu + ((u >> 16) & 1u)) >> 16; }
__device__ __forceinline__ unsigned pk2(float lo, float hi) { return f2bf(lo) | (f2bf(hi) << 16); }
#define XB_TMO      128
#define XB_XCNT(j)  (256  + 64 * (j))
#define XB_XSUB(j)  (1280 + 64 * (j))
#define XB_XGEN(j)  (2304 + 64 * (j))
#define XB_TOP      3328
#define XB_TOPGEN   3392
#define XCD_BAR_WORDS 3456
#define XB_SPIN_CAP (1u << 18)

__device__ __forceinline__ unsigned xb_ld(unsigned* p)              { return __hip_atomic_load(p, __ATOMIC_RELAXED, __HIP_MEMORY_SCOPE_AGENT); }
__device__ __forceinline__ unsigned xb_add(unsigned* p, unsigned v) { return __hip_atomic_fetch_add(p, v, __ATOMIC_RELAXED, __HIP_MEMORY_SCOPE_AGENT); }
__device__ __forceinline__ unsigned xb_xcc_id() { return (unsigned)__builtin_amdgcn_s_getreg((3 << 11) | 20) & 0xFu; }
#define XB_SPIN(cond, bar) do { unsigned _sp = 0; while (cond) { __builtin_amdgcn_s_sleep(1); \
    if ((++_sp & 255u) == 0u) { if (xb_ld(&(bar)[XB_TMO])) break; if (_sp > XB_SPIN_CAP) { atomicAdd(&(bar)[XB_TMO], 1u); break; } } } } while (0)

struct XcdBarrier {
    unsigned* bar; unsigned x;
    volatile LAS unsigned* st;
};

__device__ __forceinline__ XcdBarrier xcd_barrier_post(unsigned* bar, volatile LAS unsigned* st) {
    XcdBarrier b; b.bar = bar; b.x = xb_xcc_id(); b.st = st;
    if (threadIdx.x == 0) (void)xb_add(&bar[XB_XCNT(b.x)], 1u);
    return b;
}
__device__ __forceinline__ void xcd_barrier_complete(unsigned* bar, unsigned x, unsigned& nloc, unsigned& nx) {
    const unsigned G = gridDim.x * gridDim.y * gridDim.z;
    unsigned sum, cnt, mine, sp = 0u;
    for (;;) {
        sum = 0u; cnt = 0u; mine = 0u;
#pragma unroll
        for (unsigned j = 0; j < 16; ++j) { const unsigned c = xb_ld(&bar[XB_XCNT(j)]); sum += c; cnt += (c > 0u) ? 1u : 0u; mine = (j == x) ? c : mine; }
        if (sum == G) break;
        __builtin_amdgcn_s_sleep(1);
        if ((++sp & 255u) == 0u) { if (xb_ld(&bar[XB_TMO])) break; if (sp > XB_SPIN_CAP) { atomicAdd(&bar[XB_TMO], 1u); break; } }
    }
    nloc = mine > 0u ? mine : 1u; nx = cnt > 0u ? cnt : 1u;
}

__device__ __forceinline__ void xcd_barrier(const XcdBarrier& b) {
    asm volatile("s_waitcnt vmcnt(0)" ::: "memory");
    __syncthreads();
    if (threadIdx.x == 0) {
        unsigned* bar = b.bar;
        __builtin_amdgcn_s_waitcnt(0);
        unsigned nloc = b.st[0], nx = b.st[1];
        if (nloc == 0u) { xcd_barrier_complete(bar, b.x, nloc, nx); b.st[0] = nloc; b.st[1] = nx; }
        const unsigned old = xb_add(&bar[XB_XSUB(b.x)], 1u);
        const unsigned gen = old / nloc;
        if (old + 1u == (gen + 1u) * nloc) {
            __builtin_amdgcn_fence(__ATOMIC_RELEASE, "agent");
            asm volatile("s_waitcnt vmcnt(0)" ::: "memory");
            const unsigned og = xb_add(&bar[XB_TOP], 1u);
            const unsigned tg = og / nx;
            if (og + 1u == (tg + 1u) * nx) xb_add(&bar[XB_TOPGEN], 1u);
            else XB_SPIN(xb_ld(&bar[XB_TOPGEN]) == tg, bar);
            __builtin_amdgcn_fence(__ATOMIC_ACQUIRE, "agent");
            xb_add(&bar[XB_XGEN(b.x)], 1u);
            asm volatile("s_waitcnt vmcnt(0)" ::: "memory");
        } else {
            XB_SPIN(xb_ld(&bar[XB_XGEN(b.x)]) == gen, bar);
            __builtin_amdgcn_fence(__ATOMIC_ACQUIRE, "agent");
            asm volatile("s_waitcnt vmcnt(0)" ::: "memory");
        }
    }
    __syncthreads();
}
namespace attn_body {
using bf16=__hip_bfloat16;
using bf16x8=__attribute__((ext_vector_type(8)))short;
using s16x4=__attribute__((ext_vector_type(4)))short;
using f32x16=__attribute__((ext_vector_type(16)))float;
using u32x4=__attribute__((ext_vector_type(4)))unsigned;
typedef int v8i_t __attribute__((ext_vector_type(8))); typedef int v4i_t __attribute__((ext_vector_type(4)));
constexpr int BATCH=8,NHEAD=8,NKVH=2,SEQ=4096,D=64;
constexpr int DMQ=512,DMK=128,DMV=2048,DMO=1024;
constexpr int NW=8,QBLK=32,QB=QBLK*NW,KVBLK=64,NQB=SEQ/QB;
constexpr int ATTN_UNIT_ROWS=QB;
__device__ __forceinline__ int crow(int r,int hi){return (r&3)+8*(r>>2)+4*hi;}
#define SBAR() __builtin_amdgcn_sched_barrier(0)
__device__ __forceinline__ void cmask(f32x16&p0,f32x16&p1,int jb,int qrel,int hi){
  const float NEG=-INFINITY; int kb=64*jb+4*hi;
  #pragma unroll
  for(int r=0;r<16;++r){int kv=kb+(r&3)+8*(r>>2); if(kv>qrel)p0[r]=NEG; if(kv+32>qrel)p1[r]=NEG;}
}

constexpr int NSLOT=3, SLOTB=8192;
constexpr int LDS_K=0, LDS_V=NSLOT*SLOTB, LDS_WS=2*NSLOT*SLOTB, LDS_OST=LDS_WS+NW*64*4, LDS_BYTES=LDS_OST+NW*4096;
constexpr float C2=0.125f*1.4426950408889634f;
__device__ __forceinline__ void glds16(const void*gsrc,unsigned lds_dst){unsigned keep;
  asm volatile("s_mov_b32 %0, m0\n\ts_mov_b32 m0, %2\n\ts_nop 0\n\tglobal_load_lds_dwordx4 %1, off\n\ts_mov_b32 m0, %0":"=&s"(keep):"v"(gsrc),"s"(lds_dst):"memory");}
__device__ __forceinline__ float max3f(float a,float b,float c){float r;asm("v_max3_f32 %0, %1, %2, %3":"=v"(r):"v"(a),"v"(b),"v"(c));return r;}
__device__ __forceinline__ float max2f(float a,float b){float r;asm("v_max_f32_e32 %0, %1, %2":"=v"(r):"v"(a),"v"(b));return r;}
__device__ __forceinline__ float fadd_s(float a,float b){float r;asm("v_add_f32_e32 %0, %1, %2":"=v"(r):"v"(a),"v"(b));return r;}
__device__ __forceinline__ float fsub_s(float a,float b){float r;asm("v_sub_f32_e32 %0, %1, %2":"=v"(r):"v"(a),"v"(b));return r;}
typedef float f32x2_t __attribute__((ext_vector_type(2))); typedef __bf16 bf16x2_t __attribute__((ext_vector_type(2)));
__device__ __forceinline__ unsigned cvtpk_s(float lo,float hi){f32x2_t v={lo,hi};bf16x2_t b=__builtin_convertvector(v,bf16x2_t);return __builtin_bit_cast(unsigned,b);}
#define WAIT_BAR(N) asm volatile("s_waitcnt vmcnt(" #N ") lgkmcnt(0)\n\ts_barrier":::"memory")
#define WAIT_BAR2() WAIT_BAR(1)

#define QK8(DST,KF,QF,CSRC) asm volatile("v_mfma_scale_f32_32x32x64_f8f6f4 %0, %1, %2, %3, %4, %5 op_sel_hi:[0,0,0]":"=&v"(DST):"v"(KF),"v"(QF),"v"(CSRC),"v"(scK_),"v"(scQ_))
#define QK8Z(DST,KF,QF) asm volatile("v_mfma_scale_f32_32x32x64_f8f6f4 %0, %1, %2, 0, %3, %4 op_sel_hi:[0,0,0]":"=v"(DST):"v"(KF),"v"(QF),"v"(scK_),"v"(scQ_))
typedef __attribute__((address_space(3))) const char* lds_cptr;
typedef short v4i16_t __attribute__((ext_vector_type(4)));
__device__ __forceinline__ v8i_t kloadh(lds_cptr kp,int ko0,int ko1,int kk){ const v4i_t lo=*(const __attribute__((address_space(3))) v4i_t*)(kp+kk*2048+ko0), hi_=*(const __attribute__((address_space(3))) v4i_t*)(kp+kk*2048+ko1); return __builtin_shufflevector(lo,hi_,0,1,2,3,4,5,6,7); }
__device__ __forceinline__ s16x4 vtr(lds_cptr p){ return __builtin_bit_cast(s16x4,__builtin_amdgcn_ds_read_tr16_b64_v4i16((__attribute__((address_space(3))) v4i16_t*)p)); }
__device__ __forceinline__ float rowmax(const f32x16&p0,const f32x16&p1){
  float a=max3f(p0[0],p0[1],p1[0]),b=max3f(p0[2],p0[3],p1[1]);a=max3f(a,p1[2],p1[3]);
  #pragma unroll
  for(int r=4;r<16;r+=4){a=max3f(a,p0[r],p0[r+1]);b=max3f(b,p0[r+2],p0[r+3]);a=max3f(a,p1[r],p1[r+1]);b=max3f(b,p1[r+2],p1[r+3]);}
  const float m=max2f(a,b);
  auto rr=__builtin_amdgcn_permlane32_swap(__float_as_uint(m),__float_as_uint(m),false,false);
  return max2f(__uint_as_float(rr[0]),__uint_as_float(rr[1]));
}
__device__ __forceinline__ void pv(f32x16*o,int vb,bf16x8 pa0,bf16x8 pa1,bf16x8 pa2,bf16x8 pa3){
  #pragma unroll
  for(int d0=0;d0<2;++d0){s16x4 lo[4],hi[4];
    #pragma unroll
    for(int ks=0;ks<4;++ks){
      asm volatile("ds_read_b64_tr_b16 %0,%1 offset:%c2":"=&v"(lo[ks]):"v"(vb),"i"(d0*4096+ks*1024):"memory");
      asm volatile("ds_read_b64_tr_b16 %0,%1 offset:%c2":"=&v"(hi[ks]):"v"(vb),"i"(d0*4096+ks*1024+512):"memory");}
    asm volatile("s_waitcnt lgkmcnt(0)":::"memory");SBAR();
    #define PK(k) (bf16x8){lo[k][0],lo[k][1],lo[k][2],lo[k][3],hi[k][0],hi[k][1],hi[k][2],hi[k][3]}
    o[d0]=__builtin_amdgcn_mfma_f32_32x32x16_bf16(pa0,PK(0),o[d0],0,0,0);
    o[d0]=__builtin_amdgcn_mfma_f32_32x32x16_bf16(pa1,PK(1),o[d0],0,0,0);
    o[d0]=__builtin_amdgcn_mfma_f32_32x32x16_bf16(pa2,PK(2),o[d0],0,0,0);
    o[d0]=__builtin_amdgcn_mfma_f32_32x32x16_bf16(pa3,PK(3),o[d0],0,0,0);
    #undef PK
  }
}

#ifndef ATTN_STORE16
#define ATTN_STORE16(p,v) (*(u32x4*)(p)=(v))
#endif
template<int THRL,bool FIXED> __device__ __forceinline__ void attn_unit(int b,int h,int qb,const bf16*Q,const bf16*__restrict__ K,const bf16*__restrict__ V,bf16*O,char*shm,float bref){
  int tid_=threadIdx.x; asm volatile("":"+v"(tid_)); const int tid=tid_,lane=tid&63,r32=lane&31,hi=lane>>5; const int wid=__builtin_amdgcn_readfirstlane(tid>>6);
  const long rowbase=(long)b*SEQ; const int q0=qb*QB;
  const unsigned char*Qw8=(const unsigned char*)Q+((rowbase+q0+wid*QBLK)*512+h*64); const int kvh=h>>2;
  const unsigned char*Kh8=(const unsigned char*)K+(long)((b*NKVH+kvh)*(SEQ/KVBLK))*4096;
  const unsigned lds0=(unsigned)(uintptr_t)shm;
  float*wsf=(float*)(shm+LDS_WS)+wid*64;
  const unsigned char*ksrc8=Kh8+(wid&3)*1024+lane*16;
  const unsigned char*vsrc8=(const unsigned char*)V+(long)((b*NKVH+kvh)*(SEQ/KVBLK))*4096+(wid&3)*1024+lane*16;
  const unsigned kdst=lds0+LDS_K+(wid&3)*1024, vdst=lds0+LDS_V+(wid&3)*1024;
  #define DMA_K(t,slot) do{ if(wid<4) glds16(ksrc8+(long)(t)*4096,(unsigned)__builtin_amdgcn_readfirstlane(kdst+(slot))); }while(0)
  #define DMA_V(t,slot) do{ if(wid>=4) glds16(vsrc8+(long)(t)*4096,(unsigned)__builtin_amdgcn_readfirstlane(vdst+(slot))); }while(0)
  const int vb0=(int)(lds0+LDS_V)+((lane>>4)&1)*32+(lane&3)*8+(4*hi+((lane&15)>>2))*64;
  v8i_t kf[2];
  int scK_=0x7f7f7f7f,scQ_=0x7c7c7c7c; asm volatile("":"+v"(scK_),"+v"(scQ_));
  const lds_cptr shm3=(lds_cptr)shm; const lds_cptr kp0=shm3+LDS_K+r32*64; const int ksw_=(r32>>2)&3, ko0=((2*hi)^ksw_)*16, ko1=((2*hi+1)^ksw_)*16; const lds_cptr vp0=shm3+LDS_V+r32*64;
  constexpr int NT=SEQ/KVBLK;
  DMA_K(0,0);DMA_V(0,0);DMA_K(1,SLOTB);
  v8i_t q8; { const v4i_t lo=*reinterpret_cast<const v4i_t*>(Qw8+(long)r32*512+hi*32), hi_=*reinterpret_cast<const v4i_t*>(Qw8+(long)r32*512+hi*32+16); q8=__builtin_shufflevector(lo,hi_,0,1,2,3,4,5,6,7); }
  float mhat=0.f;f32x16 o[2];o[0]=f32x16{};o[1]=f32x16{};f32x16 ol=f32x16{};
  v8i_t ones8; { _Pragma("unroll") for(int i_=0;i_<8;++i_)ones8[i_]=0x38383838; } asm volatile("":"+v"(ones8));
  f32x16 negm=f32x16{}; if constexpr(FIXED){ _Pragma("unroll") for(int r=0;r<16;++r)negm[r]=8.75f-bref; }     asm volatile("":"+v"(negm));
  #define CMASK(P0,P1,t) do{}while(0)
  bool resc=false;
  #define START(P0,P1) do{ if constexpr(!FIXED){ const float rm=rowmax(P0,P1); resc=false; \
    { const float dl=rm; mhat=fadd_s(mhat,dl); \
      _Pragma("unroll") for(int r=0;r<16;++r){P0[r]=fsub_s(P0[r],dl);P1[r]=fsub_s(P1[r],dl);} \
      _Pragma("unroll") for(int r=0;r<16;++r)negm[r]=-mhat; asm volatile("":"+v"(negm)); } } \
    _Pragma("unroll") for(int r=0;r<16;++r)P0[r]=__builtin_amdgcn_exp2f(P0[r]); }while(0)
  #define RESC() do{ if constexpr(!FIXED) if(resc){ asm volatile("s_waitcnt lgkmcnt(0)":::"memory"); \
      _Pragma("unroll") for(int r=0;r<16;++r){const float f_=wsf[crow(r,hi)];o[0][r]*=f_;o[1][r]*=f_;ol[r]*=f_;} } }while(0)
  f32x16 pA0,pA1,pB0,pB1;
  int sl_prev=0,sl_cur=0,sl_next=SLOTB;
  #define ROT() do{sl_prev=sl_cur;sl_cur=sl_next;sl_next=(sl_next==(NSLOT-1)*SLOTB)?0:sl_next+SLOTB;}while(0)
  DMA_K(2,2*SLOTB);
  WAIT_BAR(3);
  { const v8i_t k0_=kloadh(kp0,ko0,ko1,0),k1_=kloadh(kp0,ko0,ko1,1); if constexpr(FIXED){ QK8(pA0,k0_,q8,negm); QK8(pA1,k1_,q8,negm); } else { QK8(pA0,k0_,q8,negm); QK8(pA1,k1_,q8,negm); } }
  asm volatile("s_nop 15\n\ts_nop 15\n\ts_nop 15":"+v"(pA0),"+v"(pA1));CMASK(pA0,pA1,0);
  START(pA0,pA1);
  _Pragma("unroll") for(int r=0;r<16;++r)pA1[r]=__builtin_amdgcn_exp2f(pA1[r]);
  WAIT_BAR(0);
  DMA_K(3,0);DMA_V(1,SLOTB);
  ROT();
  kf[0]=kloadh(kp0+sl_cur,ko0,ko1,0); kf[1]=kloadh(kp0+sl_cur,ko0,ko1,1);
  WAIT_BAR(2);
  v8i_t vf[2]; v8i_t pwv={0,0,0,0,0,0,0,0}; int scP_=0x7f7f7f7f; asm volatile("":"+v"(scP_));
  #define PK8A(i,P,B) pwv[i]=__builtin_amdgcn_cvt_pk_fp8_f32(P[B],P[(B)+1],pwv[i],false)
  #define PK8B(i,P,B) pwv[i]=__builtin_amdgcn_cvt_pk_fp8_f32(P[(B)+2],P[(B)+3],pwv[i],true)
  #define PV8(ACC,VF) asm volatile("v_mfma_scale_f32_32x32x64_f8f6f4 %0, %1, %2, %0, %3, %3 op_sel_hi:[0,0,0]":"+v"(ACC):"v"(pwv),"v"(VF),"v"(scP_))
  #define PIN(x) asm volatile("":"+v"(x))
  #define MX3(a,b,c) __builtin_fmaxf(__builtin_fmaxf((a),(b)),(c))
  #define GAPA(MF,A0,A1,A2,A3,W0,W1,PW) do{ MF; W0; W1; SBAR(); }while(0)
  #define EX(v) __builtin_amdgcn_exp2f(v)
  #define GAPB(MF,X,B) do{ MF; X[B]=EX(X[B]); X[B+1]=EX(X[B+1]); X[B+2]=EX(X[B+2]); X[B+3]=EX(X[B+3]); PIN(X); SBAR(); }while(0)
  #define VRD(i) do{ vf[i]=kloadh(vp_,ko0,ko1,(i)); }while(0)
  #define KRD(G,j) do{ if(G){ if((j)==0)kf[0]=kloadh(kp0+sl_next,ko0,ko1,0); if((j)==2)kf[1]=kloadh(kp0+sl_next,ko0,ko1,1); SBAR(); } }while(0)
  #define STEP(C0,C1,P0,P1,t,GK,GV,GL) do{ SBAR(); \
    const lds_cptr vp_=vp0+sl_prev; \
    VRD(0); SBAR(); \
    GAPA(QK8(C0,kf[0],q8,negm), P0[2],P0[3],P0[4],P0[5],     PK8A(0,P0,0), PK8B(0,P0,0), pwv); \
    VRD(1); SBAR(); GAPA((void)0, P0[6],P0[7],P0[8],P0[9],     PK8A(1,P0,4), PK8B(1,P0,4), pwv); \
    GAPA((void)0,   P0[10],P0[11],P0[12],P0[13], PK8A(2,P0,8), PK8B(2,P0,8), pwv); \
    GAPA((void)0,   P0[14],P0[15],P1[0],P1[1],   PK8A(3,P0,12),PK8B(3,P0,12), pwv); \
    GAPA(QK8(C1,kf[1],q8,negm),   P1[2],P1[3],P1[4],P1[5],     PK8A(4,P1,0), PK8B(4,P1,0), pwv); \
    GAPA((void)0,   P1[6],P1[7],P1[8],P1[9],     PK8A(5,P1,4), PK8B(5,P1,4), pwv); \
    GAPA((void)0,   P1[10],P1[11],P1[12],P1[13], PK8A(6,P1,8), PK8B(6,P1,8), pwv); \
    GAPA((void)0,   P1[14],P1[15],0.f,0.f,       PK8A(7,P1,12),PK8B(7,P1,12), pwv); PIN(pwv); \
    if(GK){DMA_K((t)+3,sl_cur);} if(GV){DMA_V((t)+1,sl_next);} \
    CMASK(C0,C1,t); \
    if constexpr(!FIXED){ float a=MX3(C0[0],C0[1],C1[0]),b=MX3(C0[2],C0[3],C1[1]); a=MX3(a,C1[2],C1[3]); \
      _Pragma("unroll") for(int r=4;r<16;r+=4){a=MX3(a,C0[r],C0[r+1]);b=MX3(b,C0[r+2],C0[r+3]);a=MX3(a,C1[r],C1[r+1]);b=MX3(b,C1[r+2],C1[r+3]);} \
      float rm=__builtin_fmaxf(a,b); { auto rr=__builtin_amdgcn_permlane32_swap(__float_as_uint(rm),__float_as_uint(rm),false,false); rm=__builtin_fmaxf(__uint_as_float(rr[0]),__uint_as_float(rr[1])); } \
      resc=false; \
      if(__builtin_expect(__any(rm>(float)THRL),0)){ const float dl=__builtin_fmaxf(rm,0.f); mhat+=dl; \
        _Pragma("unroll") for(int r=0;r<16;++r){C0[r]-=dl;C1[r]-=dl;} \
        _Pragma("unroll") for(int r=0;r<16;++r)negm[r]=-mhat; asm volatile("":"+v"(negm)); \
        const float f=__builtin_amdgcn_exp2f(-dl); if(hi==0)wsf[r32]=f; resc=true; } } \
    SBAR(); \
    GAPB(PV8(o[0],vf[0]), C0,0); \
    GAPB((void)0, C0,4); \
    KRD(GL,0); GAPB((void)0, C0,8); \
    KRD(GL,1); GAPB(PV8(o[1],vf[1]), C0,12); \
    KRD(GL,2); GAPB((void)0, C1,0); \
    KRD(GL,3); GAPB((void)0, C1,4); \
    GAPB(PV8(ol,ones8), C1,8); \
    GAPB((void)0, C1,12); \
    }while(0)
  int t=1;
  #undef CMASK
  #define CMASK(P0,P1,t) do{}while(0)
  for(;t+5<NT;t+=2){
    STEP(pB0,pB1,pA0,pA1,t,true,true,true);     WAIT_BAR2(); RESC(); ROT();
    STEP(pA0,pA1,pB0,pB1,t+1,true,true,true);   WAIT_BAR2(); RESC(); ROT();
  }
  #undef CMASK
  #define CMASK(P0,P1,t) do{}while(0)
  #define ENDW(tt) WAIT_BAR(0)
  for(;t+1<NT;t+=2){
    STEP(pB0,pB1,pA0,pA1,t,(t+3<NT),(t+1<NT),(t+1<NT));       ENDW(t);   RESC(); ROT();
    STEP(pA0,pA1,pB0,pB1,t+1,(t+4<NT),(t+2<NT),(t+2<NT));     ENDW(t+1); RESC(); ROT();
  }
  STEP(pB0,pB1,pA0,pA1,NT-1,false,false,false); RESC();
  {
    PK8A(0,pB0,0);PK8B(0,pB0,0);PK8A(1,pB0,4);PK8B(1,pB0,4);PK8A(2,pB0,8);PK8B(2,pB0,8);PK8A(3,pB0,12);PK8B(3,pB0,12);PK8A(4,pB1,0);PK8B(4,pB1,0);PK8A(5,pB1,4);PK8B(5,pB1,4);PK8A(6,pB1,8);PK8B(6,pB1,8);PK8A(7,pB1,12);PK8B(7,pB1,12);
    SBAR(); vf[0]=kloadh(vp0+sl_cur,ko0,ko1,0); vf[1]=kloadh(vp0+sl_cur,ko0,ko1,1); PV8(o[0],vf[0]); PV8(o[1],vf[1]); PV8(ol,ones8); asm volatile("s_nop 15\n\ts_nop 15\n\ts_nop 15\n\ts_nop 15\n\ts_nop 7":"+v"(o[0]),"+v"(o[1]),"+v"(ol)); }
  #undef PK8A
  #undef PK8B
  #undef PV8
  #undef PIN
  #undef MX3
  #undef GAPA
  #undef GAPB
  #undef EX
  #undef VRD
  #undef KRD
  #undef STEP
  #undef ENDW
  float rli[16];
  #pragma unroll
  for(int r=0;r<16;++r)rli[r]=__builtin_amdgcn_rcpf(ol[r]);
  bf16*Ow=O+(rowbase+q0+wid*QBLK)*DMO+h*D;
  { bf16*stg=(bf16*)(shm+LDS_OST)+wid*2048;
    #pragma unroll
    for(int r=0;r<16;++r){const int orow=crow(r,hi);
      #pragma unroll
      for(int d0=0;d0<2;++d0)stg[orow*64+d0*32+r32]=__float2bfloat16(o[d0][r]*rli[r]);}
    asm volatile("s_waitcnt lgkmcnt(0)":::"memory");
    #pragma unroll
    for(int i=0;i<4;++i){const int row=i*8+(lane>>3),ch=lane&7; const u32x4 v=*(const u32x4*)(stg+row*64+ch*8); ATTN_STORE16(Ow+(long)row*DMO+ch*8,v);} }
  asm volatile("s_waitcnt lgkmcnt(0)\n\ts_barrier":::"memory");
  #undef DMA_K
  #undef DMA_V
  #undef CMASK
  #undef START
  #undef RESC
  #undef ROT
}
constexpr int ATTN_LDS_BYTES=LDS_BYTES;
struct AttnTensors { const bf16* Q; const bf16* K; const bf16* V; bf16* O; };
struct AttnUnit { int bh; int qb; };
struct StaticOrder {
  int vcu, G;
  __device__ __forceinline__ explicit StaticOrder(int grid,int block):vcu((grid%8==0)?(block%8)*(grid/8)+block/8:block),G(grid){}
  __device__ __forceinline__ bool next(int i,AttnUnit&u)const{ const int per=(BATCH*NHEAD*NQB+G-1)/G; if(i>=per)return false; const int idx=vcu*per+i; if(idx>=BATCH*NHEAD*NQB)return false;
    const int qb=idx%NQB, hq=(idx/NQB)&3, bk=idx/(NQB*4), kvh=bk&1, b=bk>>1; u.bh=b*NHEAD+kvh*4+hq; u.qb=qb; return true; }
  __device__ __forceinline__ void a_ready(const AttnUnit&)const{}
  __device__ __forceinline__ void done(const AttnUnit&)const{}
};
template<class Sched,int THRL=8> __device__ __forceinline__ void attn_phase(char*lds,const AttnTensors&T,const Sched&S,float bref){
  AttnUnit u;
  if(bref>=0.f&&bref<=56.f){ for(int i=0;S.next(i,u);++i){ S.a_ready(u); attn_unit<THRL,true>(u.bh/NHEAD,u.bh%NHEAD,u.qb,T.Q,T.K,T.V,T.O,lds,bref); S.done(u); } }
  else { for(int i=0;S.next(i,u);++i){ S.a_ready(u); attn_unit<THRL,false>(u.bh/NHEAD,u.bh%NHEAD,u.qb,T.Q,T.K,T.V,T.O,lds,0.f); S.done(u); } }
}
#undef SBAR
#undef WAIT_BAR
#undef WAIT_BAR2
#undef QK8
#undef QK8Z
}
constexpr int NB = 8, SEQ = 4096, DM = 1024, NL = 4, NTOK = NB * SEQ;
constexpr int INW = 1824, INP = 2048;
constexpr int C_AQ = 0, C_AK = 512, C_AV = 640, C_GQ = 768, C_GK = 896, C_GV = 1024, C_GR = 1280, C_FX = 1536, C_GLR = 1792;
constexpr int NE = 32, TOPK = 4, DE = 1024;
constexpr int MPAD = NTOK * TOPK + NE * 256;
constexpr float LN_EPS = 1e-5f, RMS_EPS = 1e-6f;
constexpr float DN_ALPHA = 1.681792830507429f;
constexpr float QSCALE = 0.125f * 1.4426950408889634f;
constexpr float GLA_QSCALE = 0.17677669529663687f;

constexpr size_t MiB = 1u << 20;
constexpr size_t WS_CTL = 0, CTL_ZERO_BYTES = 256 * 1024;
constexpr size_t WS_ROPE = 1 * MiB;
constexpr size_t WS_WIN_T = 2 * MiB;
constexpr size_t WS_WOUT_T = 18 * MiB;
constexpr size_t WS_FTAB = 26 * MiB;
constexpr size_t WS_TW = WS_FTAB + 65536;
constexpr size_t WS_RWT = WS_FTAB + 131072;
constexpr size_t WS_FTMP = 27 * MiB;
constexpr size_t WS_WGU_T = 90 * MiB;
constexpr size_t WS_WDN_T = 602 * MiB;
constexpr size_t WS_HF = 858 * MiB;
constexpr size_t WS_HB = 986 * MiB;
constexpr size_t WS_PROJ = 1050 * MiB;
constexpr size_t WS_QB = 1178 * MiB;
constexpr size_t WS_KB = 1210 * MiB;
constexpr size_t WS_MIX = 1218 * MiB;
constexpr size_t WS_T1 = 1282 * MiB;
constexpr size_t WS_UVT = 1410 * MiB;
constexpr size_t WS_LA = 1442 * MiB;
constexpr size_t WS_OF = 1474 * MiB;
constexpr size_t WS_OB = 1506 * MiB;
constexpr size_t WS_TOK = 1538 * MiB;
constexpr size_t WS_XS = 1542 * MiB;
constexpr size_t WS_HID = 1814 * MiB;
constexpr size_t WS_YS = 2086 * MiB;
constexpr size_t WS_HB8L = 2358 * MiB;
constexpr size_t WS_END = 2390 * MiB;
static_assert((size_t)MPAD * 2048 == 272 * MiB, "sorted buffers");
constexpr int CW_TMO = 0, CW_CODE = 1, CW_BAR = 4096, CW_CNT = 8192;

constexpr int RING_OFF = 0, RING_BYTES = 131072;
constexpr int LDSCTL_OFF = RING_BYTES;
constexpr int LDS_BYTES = 163840;
constexpr int LC_MISC = 0;
constexpr int LC_PSTART = 128;
constexpr int LC_ULIST = 384;
constexpr int LC_CNT = 640;
constexpr int LC_BASE = 768;
constexpr int LC_SELE = 1024;
constexpr int LC_SELS = 1024 + 2048;
constexpr int LC_COS64 = 5120;
constexpr int LC_ROWS = 6144;
constexpr int LC_LG = 16384;

constexpr int NWAVES = 8;
constexpr int N_PHASES = 1 + 10 * NL;

typedef float f32x2_t __attribute__((ext_vector_type(2))); typedef __bf16 bf16x2_t __attribute__((ext_vector_type(2)));
__device__ __forceinline__ unsigned cvtpk2(float lo, float hi) { f32x2_t v = {lo, hi}; bf16x2_t b = __builtin_convertvector(v, bf16x2_t); return __builtin_bit_cast(unsigned, b); }
#define pk2(lo, hi) cvtpk2((lo), (hi))
__device__ __forceinline__ unsigned pk4_fp8(float a, float b, float c, float d) { int w = 0; w = __builtin_amdgcn_cvt_pk_fp8_f32(a, b, w, false); w = __builtin_amdgcn_cvt_pk_fp8_f32(c, d, w, true); return (unsigned)w; }
constexpr float W8_SCALE = 64.f, W8_INV = 1.f / 64.f;
#define f2bf(x) (cvtpk2((x), 0.f) & 0xffffu)
__device__ __forceinline__ float bf2f(unsigned short b) { return __uint_as_float((unsigned)b << 16); }
__device__ __forceinline__ float wave_sum(float v) {
#pragma unroll
    for (int o = 1; o < 64; o <<= 1) v += __shfl_xor(v, o);
    return v;
}
typedef unsigned short u16x8 __attribute__((ext_vector_type(8)));
typedef unsigned short u16x4 __attribute__((ext_vector_type(4)));

typedef float f32x2v __attribute__((ext_vector_type(2)));
__device__ __forceinline__ void tr_task(const float* W, int K, int Nsrc, int srcn, bf16* WT, int dst_n, int k0) {
#pragma unroll 1
    for (int hf = 0; hf < 2; ++hf) { const int kk = k0 + hf * 64; f32x2v v[64];
        if (srcn >= 0) { const float* p = W + (size_t)kk * Nsrc + srcn;
#pragma unroll
            for (int i = 0; i < 64; ++i) v[i] = __builtin_nontemporal_load((const f32x2v*)(p + (size_t)i * Nsrc)); }
        else {
#pragma unroll
            for (int i = 0; i < 64; ++i) v[i] = (f32x2v){0.f, 0.f}; }
        bf16* o0 = WT + (size_t)dst_n * K + kk; bf16* o1 = o0 + K;
#pragma unroll
        for (int j = 0; j < 8; ++j) { v4u w0, w1;
            w0.x = pk2(v[8 * j].x, v[8 * j + 1].x); w0.y = pk2(v[8 * j + 2].x, v[8 * j + 3].x); w0.z = pk2(v[8 * j + 4].x, v[8 * j + 5].x); w0.w = pk2(v[8 * j + 6].x, v[8 * j + 7].x);
            w1.x = pk2(v[8 * j].y, v[8 * j + 1].y); w1.y = pk2(v[8 * j + 2].y, v[8 * j + 3].y); w1.z = pk2(v[8 * j + 4].y, v[8 * j + 5].y); w1.w = pk2(v[8 * j + 6].y, v[8 * j + 7].y);
            *(v4u*)(o0 + 8 * j) = w0; *(v4u*)(o1 + 8 * j) = w1; } }
}

#define RC(l, j) (((j) >> 1) * 512 + 8 * (l) + ((j) & 1) * 4)
__device__ __forceinline__ void row_load_bf16(f32x4 (&v)[4], const bf16* row, int lane) {
#pragma unroll
    for (int h = 0; h < 2; ++h) { const v4u t = *(const v4u*)(row + h * 512 + 8 * lane);
        v[2 * h] = (f32x4){__uint_as_float(t.x << 16), __uint_as_float(t.x & 0xffff0000u), __uint_as_float(t.y << 16), __uint_as_float(t.y & 0xffff0000u)};
        v[2 * h + 1] = (f32x4){__uint_as_float(t.z << 16), __uint_as_float(t.z & 0xffff0000u), __uint_as_float(t.w << 16), __uint_as_float(t.w & 0xffff0000u)}; }
}
__device__ __forceinline__ void row_store_bf16(const f32x4 (&v)[4], bf16* row, int lane) {
#pragma unroll
    for (int h = 0; h < 2; ++h) { v4u w; w.x = pk2(v[2 * h].x, v[2 * h].y); w.y = pk2(v[2 * h].z, v[2 * h].w); w.z = pk2(v[2 * h + 1].x, v[2 * h + 1].y); w.w = pk2(v[2 * h + 1].z, v[2 * h + 1].w); *(v4u*)(row + h * 512 + 8 * lane) = w; }
}
__device__ __forceinline__ void ln_row8(f32x4 (&v)[4], const f32x4 (&gam)[4], const f32x4 (&bet)[4]) {
    float s = 0.f;
#pragma unroll
    for (int j = 0; j < 4; ++j) s += (v[j].x + v[j].y) + (v[j].z + v[j].w);
    const float mean = wave_sum(s) * (1.f / DM); float s2 = 0.f;
#pragma unroll
    for (int j = 0; j < 4; ++j) { v[j] = v[j] - mean; s2 += (v[j].x * v[j].x + v[j].y * v[j].y) + (v[j].z * v[j].z + v[j].w * v[j].w); }
    const float rstd = __builtin_amdgcn_rsqf(wave_sum(s2) * (1.f / DM) + LN_EPS);
#pragma unroll
    for (int j = 0; j < 4; ++j) v[j] = v[j] * rstd * gam[j] + bet[j];
}

constexpr int GM_QF = 0, GM_KF = 5120, GM_QB = 10240, GM_KB = 15360, GM_VT = 20480, GM_P = 29696, GM_HTF = 38912, GM_HTB = 44032, GM_DL = 38912, GM_RG = 49152, GM_SLOT = 65536;
#define LBAR() asm volatile("s_waitcnt lgkmcnt(0)\n\ts_barrier" ::: "memory")
static_assert(2 * GM_SLOT <= RING_BYTES, "two GLA chunk images fit the phase scratch");
#define MFMA16(a, b, c) __builtin_amdgcn_mfma_f32_16x16x32_bf16((a), (b), (c), 0, 0, 0)
template <bool OUT>
__device__ __forceinline__ void gla_stage_mfma(LAS unsigned char* Ls, const bf16* PROJ, const float* LA, const float* HIN, size_t tok0, int hd, int w4, int lane) {
    if (w4 < 2) { const int dir = w4, g = lane >> 3, c4 = (lane & 7) * 4; f32x4 bc[8]; u16x4 kx[8], qx[8];
        const float* lap = LA + (tok0 + 8 * g) * 256 + dir * 128 + hd * 32 + c4; const bf16* xp = PROJ + (tok0 + 8 * g) * INP + hd * 32 + c4;
#pragma unroll
        for (int i = 0; i < 8; ++i) { bc[i] = *(const f32x4*)(lap + (size_t)i * 256); kx[i] = *(const u16x4*)(xp + (size_t)i * INP + C_GK); if (OUT) qx[i] = *(const u16x4*)(xp + (size_t)i * INP + C_GQ); }
        f32x4 inc;
        if (dir == 0) {
#pragma unroll
            for (int i = 1; i < 8; ++i) bc[i] = bc[i] + bc[i - 1];
            inc = bc[7];
#pragma unroll
            for (int o = 1; o < 8; o <<= 1) { f32x4 y; y.x = __shfl_up(inc.x, 8 * o); y.y = __shfl_up(inc.y, 8 * o); y.z = __shfl_up(inc.z, 8 * o); y.w = __shfl_up(inc.w, 8 * o); if (g >= o) inc = inc + y; }
            const f32x4 off = inc - bc[7];
#pragma unroll
            for (int i = 0; i < 8; ++i) bc[i] = bc[i] + off; }
        else {
#pragma unroll
            for (int i = 6; i >= 0; --i) bc[i] = bc[i] + bc[i + 1];
            inc = bc[0];
#pragma unroll
            for (int o = 1; o < 8; o <<= 1) { f32x4 y; y.x = __shfl_down(inc.x, 8 * o); y.y = __shfl_down(inc.y, 8 * o); y.z = __shfl_down(inc.z, 8 * o); y.w = __shfl_down(inc.w, 8 * o); if (g + o < 8) inc = inc + y; }
            const f32x4 off = inc - bc[0];
#pragma unroll
            for (int i = 0; i < 8; ++i) bc[i] = bc[i] + off; }
        if (OUT) { LAS bf16* qd = (LAS bf16*)(Ls + (dir ? GM_QB : GM_QF)) + (8 * g) * 40 + c4; LAS bf16* kd = (LAS bf16*)(Ls + (dir ? GM_KB : GM_KF)) + (8 * g) * 40 + c4;
#pragma unroll
            for (int i = 0; i < 8; ++i) { float qv[4], kv[4];
#pragma unroll
                for (int c = 0; c < 4; ++c) { const float e_ = __expf(fmaxf(bc[i][c], -60.f)); qv[c] = bf2f(qx[i][c]) * GLA_QSCALE * e_; kv[c] = bf2f(kx[i][c]) * __builtin_amdgcn_rcpf(e_); }
                *(LAS unsigned long long*)(qd + i * 40) = (unsigned long long)pk2(qv[0], qv[1]) | ((unsigned long long)pk2(qv[2], qv[3]) << 32);
                *(LAS unsigned long long*)(kd + i * 40) = (unsigned long long)pk2(kv[0], kv[1]) | ((unsigned long long)pk2(kv[2], kv[3]) << 32); } }
        else { LAS bf16* kt = (LAS bf16*)(Ls + GM_P + dir * 4608) + c4 * 72 + 8 * g;
#pragma unroll
            for (int c = 0; c < 4; ++c) { float t[8];
#pragma unroll
                for (int i = 0; i < 8; ++i) t[i] = bf2f(kx[i][c]) * __expf(fminf(-bc[i][c], 60.f));
                v4u w; w.x = pk2(t[0], t[1]); w.y = pk2(t[2], t[3]); w.z = pk2(t[4], t[5]); w.w = pk2(t[6], t[7]); *(LAS v4u*)(kt + c * 72) = w; }
            if (g == (dir ? 0 : 7)) { const f32x4 tot = dir ? bc[0] : bc[7]; LAS float* dl = (LAS float*)(Ls + GM_DL) + dir * 32 + c4; dl[0] = __expf(tot.x); dl[1] = __expf(tot.y); dl[2] = __expf(tot.z); dl[3] = __expf(tot.w); } } }
    else if (w4 == 2) { const int g = lane >> 3, v0 = (lane & 7) * 8; u16x8 x[8]; const bf16* xp = PROJ + (tok0 + 8 * g) * INP + C_GV + hd * 64 + v0;
#pragma unroll
        for (int i = 0; i < 8; ++i) x[i] = *(const u16x8*)(xp + (size_t)i * INP);
        u16x8 rgx[8];
        if (OUT) { const bf16* rp = PROJ + (tok0 + 8 * g) * INP + C_GR + hd * 64 + v0;
#pragma unroll
            for (int i = 0; i < 8; ++i) rgx[i] = *(const u16x8*)(rp + (size_t)i * INP); }
        LAS bf16* dst = (LAS bf16*)(Ls + GM_VT) + v0 * 72 + 8 * g;
#pragma unroll
        for (int c = 0; c < 8; ++c) { v4u w; w.x = (unsigned)x[0][c] | ((unsigned)x[1][c] << 16); w.y = (unsigned)x[2][c] | ((unsigned)x[3][c] << 16); w.z = (unsigned)x[4][c] | ((unsigned)x[5][c] << 16); w.w = (unsigned)x[6][c] | ((unsigned)x[7][c] << 16);
            *(LAS v4u*)(dst + c * 72) = w; }
        if (OUT) { LAS bf16* rd = (LAS bf16*)(Ls + GM_RG) + (8 * g) * 72 + v0;
#pragma unroll
            for (int i = 0; i < 8; ++i) *(LAS u16x8*)(rd + i * 72) = rgx[i]; } }
    else if (OUT) {
#pragma unroll
        for (int dir = 0; dir < 2; ++dir) { const f32x4* src = (const f32x4*)(HIN + ((size_t)dir * 64 + lane) * 32); LAS bf16* dst = (LAS bf16*)(Ls + (dir ? GM_HTB : GM_HTF)) + lane * 40;
#pragma unroll
            for (int c8 = 0; c8 < 4; ++c8) { const f32x4 a_ = src[2 * c8], b_ = src[2 * c8 + 1]; v4u w; w.x = pk2(a_.x, a_.y); w.y = pk2(a_.z, a_.w); w.z = pk2(b_.x, b_.y); w.w = pk2(b_.z, b_.w); *(LAS v4u*)(dst + c8 * 8) = w; } } }
}

typedef float f32x16 __attribute__((ext_vector_type(16)));
typedef short s16x4 __attribute__((ext_vector_type(4)));
__device__ __forceinline__ bf16x8 pack_step(const f32x16& x, int s) { v4u p; p.x = cvtpk2(x[8 * s], x[8 * s + 1]); p.y = cvtpk2(x[8 * s + 2], x[8 * s + 3]); p.z = cvtpk2(x[8 * s + 4], x[8 * s + 5]); p.w = cvtpk2(x[8 * s + 6], x[8 * s + 7]); return __builtin_bit_cast(bf16x8, p); }
__device__ __forceinline__ int crow16(int i, int h) { return (i & 3) + 8 * (i >> 2) + 4 * h; }
#define MFMA32(a, b, c) __builtin_amdgcn_mfma_f32_32x32x16_bf16((a), (b), (c), 0, 0, 0)
constexpr int FT_PITCH = 72, FT_TAB = 64 * FT_PITCH;
constexpr int FFT_LDS_TAB = 0, FFT_LDS_TW = 28672, FFT_LDS_HT = 28672, FFT_HT_PAIR = 2 * 64 * FT_PITCH * 2;

struct Args { const float* in[20]; float* out; unsigned char* ws; int ph_lo, ph_hi; };
static_assert(sizeof(Args) == 20 * 8 + 8 + 8 + 8, "no padding bytes in Args");


typedef __attribute__((address_space(4))) const unsigned char* kptr_t;
__device__ __forceinline__ kptr_t karg() { kptr_t p = (kptr_t)__builtin_amdgcn_kernarg_segment_ptr(); asm volatile("" : "+s"(p)); return p; }
#define KIN(i) (*(const float* const __attribute__((address_space(4)))*)(karg() + 8 * (i)))
#define KOUT() (*(float* const __attribute__((address_space(4)))*)(karg() + 160))
#define KWS() (*(unsigned char* const __attribute__((address_space(4)))*)(karg() + 168))
#define WSP(T, off) ((T*)(ws + (off)))

#ifndef NAIVE_ATTN
#define NAIVE_ATTN 0
#ifndef P2_TOKB
#define P2_TOKB 8
#endif
#ifndef P6_ROWS
#define P6_ROWS 16
#endif
#ifndef P3_BATCH
#define P3_BATCH 32
#endif
#endif

__global__ void __launch_bounds__(NWAVES * 64, 2) fwd(Args args) {
    extern __shared__ __attribute__((aligned(16))) unsigned char lds_raw[];
    LAS unsigned char* lds = (LAS unsigned char*)lds_raw;
    LAS unsigned char* lctl = lds + LDSCTL_OFF;
    const int G = gridDim.x, bx = blockIdx.x;
    const int NGW = G * NWAVES, NGT = G * NWAVES * 64;
#define TID_SETUP() int tid_ = threadIdx.x; asm volatile("" : "+v"(tid_)); const int tid = tid_, lane = tid & 63, wave = __builtin_amdgcn_readfirstlane(tid >> 6); \
    const int gw = bx * NWAVES + wave, gt = bx * (NWAVES * 64) + tid; (void)lane; (void)gw; (void)gt
    for (int u = threadIdx.x; u < (LDS_BYTES - LDSCTL_OFF) / 4; u += NWAVES * 64) ((LAS unsigned*)lctl)[u] = 0u;
    __syncthreads();
    volatile LAS unsigned* MISC = (volatile LAS unsigned*)(lctl + LC_MISC);
    XcdBarrier bar = xcd_barrier_post((unsigned*)(KWS() + WS_CTL) + CW_BAR, MISC + 8);
    const int lo = args.ph_lo, hi = args.ph_hi;
#ifndef PH_OFF
#define PH_OFF 0
#endif
#define PON(j) (!((PH_OFF >> (j)) & 1))
#define IN(k) (lo <= (k) && (k) < hi)
#ifndef PROBE_A
#define PROBE_A -1
#endif
#ifndef PROBE_B
#define PROBE_B -1
#endif
#if PROBE_A >= 0
#define STAMP(k) do { if (blockIdx.x == 0 && threadIdx.x == 0) { ((unsigned long long*)(KWS() + WS_CTL + 65536))[(k)] = __builtin_amdgcn_s_memrealtime(); } } while (0)
#define STAMP2(i) do { __syncthreads(); if (blockIdx.x == 0 && threadIdx.x == 0) { ((unsigned long long*)(KWS() + WS_CTL + 65536))[128 + l * 16 + (i)] = __builtin_amdgcn_s_memrealtime(); } } while (0)
#else
#define STAMP(k) do {} while (0)
#define STAMP2(i) do {} while (0)
#endif
#ifndef PROBE_SUB_A
#define PROBE_SUB_A -1
#define PROBE_SUB_B -1
#endif
#define SEAM(k) do { if (IN(k) && IN((k) + 1)) xcd_barrier(bar); STAMP((k) + 1); } while (0)
    STAMP(0);

    if (IN(0) && PON(0)) {
        TID_SETUP(); unsigned char* ws = KWS(); const float* x_in = KIN(0); const float* ln_in_g = KIN(1); const float* ln_in_b = KIN(2); const float* w_in = KIN(3); const float* w_out = KIN(9);
        const float* exp_w_gu = KIN(14); const float* exp_w_down = KIN(16);
        float* ROPE = WSP(float, WS_ROPE); bf16* WIN_T = WSP(bf16, WS_WIN_T); bf16* WOUT_T = WSP(bf16, WS_WOUT_T); bf16* WGU_T = WSP(bf16, WS_WGU_T); bf16* WDN_T = WSP(bf16, WS_WDN_T);
        bf16* HB = WSP(bf16, WS_HB); unsigned char* HB8L = WSP(unsigned char, WS_HB8L);
        { LAS unsigned* Lt = (LAS unsigned*)(lds + RING_OFF);
          constexpr int T_WIN = NL * 16 * 2, T_WOUT = NL * 8 * 4, T_WGU = NL * NE * 16 * 2, T_WDN = NL * NE * 8 * 2, NTILE = T_WIN + T_WOUT + T_WGU + T_WDN;
#define P0_DECODE_AND_LOAD(IT) do { int r = (IT); const float* W; int Nsrc, mode; \
            if (r < T_WIN) { const int l_ = r / 32, q = r % 32; nb = q / 2; kq = q % 2; W = w_in + (size_t)l_ * DM * INW; WT = (unsigned char*)WIN_T + (size_t)l_ * INP * DM; Nsrc = INW; mode = 0; f8 = 1; } \
            else if ((r -= T_WIN) < T_WOUT) { const int l_ = r / 32, q = r % 32; nb = q / 4; kq = q % 4; W = w_out + (size_t)l_ * DM * DM; WT = (unsigned char*)(WOUT_T + (size_t)l_ * DM * DM); Nsrc = DM; mode = 1; f8 = 0; } \
            else if ((r -= T_WOUT) < T_WGU) { const int le = r / 32, q = r % 32; nb = q / 2; kq = q % 2; W = exp_w_gu + (size_t)le * DM * 2048; WT = (unsigned char*)WGU_T + (size_t)le * 2048 * DM; Nsrc = 2048; mode = 2; f8 = 1; } \
            else { r -= T_WGU; const int le = r / 16, q = r % 16; nb = q / 2; kq = q % 2; W = exp_w_down + (size_t)le * DE * DM; WT = (unsigned char*)WDN_T + (size_t)le * DM * DE; Nsrc = DM; mode = 1; f8 = 1; } \
            const int n = nb * 128 + 2 * lane; int src = n; \
            if (mode == 0) src = n < 1536 ? n : (n < 1792 ? n + 32 : (n < 1824 ? n - 256 : -1)); \
            else if (mode == 2) { const int pn = n >> 8, bj = (n >> 7) & 1, j = n & 127; src = bj * 1024 + pn * 128 + j; } \
            if (f8 && src >= 0) { const float* p = W + (size_t)(kq * 512 + 64 * wave) * Nsrc + src; \
                _Pragma("unroll") for (int i = 0; i < 64; ++i) v[i] = __builtin_nontemporal_load((const f32x2v*)(p + (size_t)i * Nsrc)); } \
            else if (f8) { _Pragma("unroll") for (int i = 0; i < 64; ++i) v[i] = (f32x2v){0.f, 0.f}; } \
            else if (src >= 0) { const float* p = W + (size_t)(kq * 256 + 32 * wave) * Nsrc + src; \
                _Pragma("unroll") for (int i = 0; i < 32; ++i) v[i] = __builtin_nontemporal_load((const f32x2v*)(p + (size_t)i * Nsrc)); } \
            else { _Pragma("unroll") for (int i = 0; i < 32; ++i) v[i] = (f32x2v){0.f, 0.f}; } } while (0)
          f32x2v v[64]; unsigned char* WT; int nb, kq, f8;
          if (bx < NTILE) P0_DECODE_AND_LOAD(bx);
          for (int it = bx; it < NTILE; it += G) {
            __syncthreads();
            if (f8) {
#pragma unroll
                for (int i4 = 0; i4 < 16; ++i4) { Lt[(2 * lane) * 129 + 16 * wave + i4] = pk4_fp8(v[4 * i4].x * W8_SCALE, v[4 * i4 + 1].x * W8_SCALE, v[4 * i4 + 2].x * W8_SCALE, v[4 * i4 + 3].x * W8_SCALE);
                    Lt[(2 * lane + 1) * 129 + 16 * wave + i4] = pk4_fp8(v[4 * i4].y * W8_SCALE, v[4 * i4 + 1].y * W8_SCALE, v[4 * i4 + 2].y * W8_SCALE, v[4 * i4 + 3].y * W8_SCALE); } }
            else {
#pragma unroll
                for (int i2 = 0; i2 < 16; ++i2) { Lt[(2 * lane) * 129 + 16 * wave + i2] = pk2(v[2 * i2].x, v[2 * i2 + 1].x); Lt[(2 * lane + 1) * 129 + 16 * wave + i2] = pk2(v[2 * i2].y, v[2 * i2 + 1].y); } }
            __syncthreads();
            unsigned char* const WTc = WT; const int nbc = nb, kqc = kq; const int pitchc = f8 ? 1024 : 2048;
            if (it + G < NTILE) P0_DECODE_AND_LOAD(it + G);
            const int p4 = (lane & 31) * 4;
#pragma unroll
            for (int j = 0; j < 8; ++j) { const int row = 16 * wave + 2 * j + (lane >> 5); const LAS unsigned* lp = Lt + row * 129 + p4; v4u o; o.x = lp[0]; o.y = lp[1]; o.z = lp[2]; o.w = lp[3];
                *(v4u*)(WTc + (size_t)(nbc * 128 + row) * pitchc + kqc * 512 + 4 * p4) = o; }
          }
#undef P0_DECODE_AND_LOAD
          __syncthreads(); }
        { bf16* FTAB = WSP(bf16, WS_FTAB); float* TW = WSP(float, WS_TW);
          for (int it = gt; it < 3 * FT_TAB; it += NGT) { const int t = it / FT_TAB, q = it % FT_TAB, row = q / FT_PITCH, col = q % FT_PITCH; float sn, cs; sincospif((float)((row * col) & 63) * (1.0f / 32.0f), &sn, &cs);
              const float v = col >= 64 ? 0.f : (t == 0 ? cs : (t == 1 ? sn : -sn)); FTAB[it] = (bf16)f2bf(v); }
          for (int it = gt; it < 4096; it += NGT) { float sn, cs; sincospif((float)it * (1.0f / 2048.0f), &sn, &cs); TW[2 * it] = cs; TW[2 * it + 1] = -sn; } }
        { const float* router_w = KIN(12); bf16* RWT = WSP(bf16, WS_RWT);
          for (int it = gt; it < NL * NE * DM; it += NGT) { const int k = it & (DM - 1), e = (it >> 10) & 31, l = it >> 15; const float w = router_w[((size_t)l * DM + k) * NE + e];
              const unsigned hi = f2bf(w); const float lo = w - __uint_as_float(hi << 16); RWT[((size_t)(l * 2 + 0) * NE + e) * DM + k] = (bf16)hi; RWT[((size_t)(l * 2 + 1) * NE + e) * DM + k] = (bf16)f2bf(lo); } }
        for (int it = gt; it < SEQ * 32; it += NGT) { const int t = it >> 5, i = it & 31, a = i >> 4, f = i & 15; const int pos = a ? (t & 63) : (t >> 6);
            const double inv = exp(-9.210340371976184 * (double)f / 16.0); const double ang = (double)pos * inv;
            ROPE[it] = (float)cos(ang); ROPE[SEQ * 32 + it] = (float)sin(ang); }
        { f32x4 gam[4], bet[4];
#pragma unroll
          for (int j = 0; j < 4; ++j) { gam[j] = *(const f32x4*)(ln_in_g + RC(lane, j)); bet[j] = *(const f32x4*)(ln_in_b + RC(lane, j)); }
          for (int m0 = gw; m0 < NTOK; m0 += 2 * NGW) { f32x4 v[2][4];
#pragma unroll
            for (int q = 0; q < 2; ++q)
#pragma unroll
                for (int j = 0; j < 4; ++j) v[q][j] = *(const f32x4*)(x_in + (size_t)(m0 + q * NGW) * DM + RC(lane, j));
#pragma unroll
            for (int q = 0; q < 2; ++q) { ln_row8(v[q], gam, bet); row_store_bf16(v[q], HB + (size_t)(m0 + q * NGW) * DM, lane);
#pragma unroll
                for (int h = 0; h < 2; ++h) *(unsigned long long*)(HB8L + (size_t)(m0 + q * NGW) * DM + h * 512 + 8 * lane) = (unsigned long long)pk4_fp8(v[q][2 * h].x, v[q][2 * h].y, v[q][2 * h].z, v[q][2 * h].w) | ((unsigned long long)pk4_fp8(v[q][2 * h + 1].x, v[q][2 * h + 1].y, v[q][2 * h + 1].z, v[q][2 * h + 1].w) << 32); } } }
    }
    SEAM(0);

    for (int l = 0; l < NL; ++l) {
        const int pb = 1 + 10 * l;
        if (IN(pb + 0) && PON(1)) {
            TID_SETUP(); unsigned char* ws = KWS(); const unsigned char* HB8L = WSP(unsigned char, WS_HB8L); const unsigned char* WIN8 = WSP(unsigned char, WS_WIN_T); bf16* PROJ = WSP(bf16, WS_PROJ);
            pg8::Gemm g{(const pg8::bf16_t*)HB8L, (const pg8::bf16_t*)(WIN8 + (size_t)l * INP * DM), NTOK, INP, DM}; pg8::StaticOrder S; S.init(NTOK, INP, G, bx);
            pg8::EpiPlain8 E{PROJ, INP};
            STAMP2(2);
            pg8::gemm_phase_fp8<pg8::EpiPlain8, pg8::StaticOrder, true, false>(lds + RING_OFF, g, S, E, nullptr);
            STAMP2(3);
        }
        SEAM(pb + 0);
        if (IN(pb + 1) && PON(2)) {
            TID_SETUP(); unsigned char* ws = KWS(); const float* att_q_gain = KIN(4); const float* att_k_gain = KIN(5); const float* gla_gate_w = KIN(6); const float* gla_gate_b = KIN(7);
            const float* ROPE = WSP(float, WS_ROPE); const bf16* PROJ = WSP(bf16, WS_PROJ); bf16* QB = WSP(bf16, WS_QB); bf16* KB = WSP(bf16, WS_KB); float* LA = WSP(float, WS_LA);
            STAMP2(8);
            { LAS float* RTC = (LAS float*)(lds + RING_OFF + 65536);
              for (int i = tid; i < 1024; i += NWAVES * 64) { const int pos = i >> 4, f = i & 15; RTC[i] = ROPE[(pos * 64) * 32 + f]; RTC[1024 + i] = ROPE[SEQ * 32 + (pos * 64) * 32 + f]; RTC[2048 + i] = ROPE[pos * 32 + 16 + f]; RTC[3072 + i] = ROPE[SEQ * 32 + pos * 32 + 16 + f]; }
              __syncthreads();
              const int li = lane & 7, ax = li >> 2, f0 = 8 * (li & 1); const float sg = ((li >> 1) & 1) ? 1.f : -1.f;
              f32x4 qg8[2], kg8[2];
#pragma unroll
              for (int c = 0; c < 2; ++c) { qg8[c] = *(const f32x4*)(att_q_gain + l * 64 + 8 * li + 4 * c); kg8[c] = *(const f32x4*)(att_k_gain + l * 64 + 8 * li + 4 * c); }
              for (int m0 = gw; m0 < NTOK; m0 += 4 * NGW) { v4u xp[5];
#pragma unroll
                for (int i = 0; i < 5; ++i) { const int P = lane + 64 * i, q = P / 80, p = P % 80; xp[i] = *(const v4u*)(PROJ + (size_t)(m0 + q * NGW) * INP + p * 8); }
#pragma unroll
                for (int i = 0; i < 5; ++i) { const int P = lane + 64 * i, q = P / 80, p = P % 80, head = p >> 3; const size_t m = (size_t)(m0 + q * NGW); const int t = (int)(m & (SEQ - 1));
                    float xv[8] = {__uint_as_float(xp[i].x << 16), __uint_as_float(xp[i].x & 0xffff0000u), __uint_as_float(xp[i].y << 16), __uint_as_float(xp[i].y & 0xffff0000u),
                                   __uint_as_float(xp[i].z << 16), __uint_as_float(xp[i].z & 0xffff0000u), __uint_as_float(xp[i].w << 16), __uint_as_float(xp[i].w & 0xffff0000u)};
                    float ss = 0.f;
#pragma unroll
                    for (int c = 0; c < 8; ++c) ss += xv[c] * xv[c];
                    ss += __shfl_xor(ss, 1); ss += __shfl_xor(ss, 2); ss += __shfl_xor(ss, 4);
                    const float rs = __builtin_amdgcn_rsqf(ss * (1.f / 64.f) + RMS_EPS); const bool isq = head < 8;
                    const LAS float* tb = RTC + (ax ? 2048 : 0) + (ax ? (t & 63) : (t >> 6)) * 16 + f0;
                    const f32x4 c0 = *(const LAS f32x4*)tb, c1 = *(const LAS f32x4*)(tb + 4), s0 = *(const LAS f32x4*)(tb + 1024), s1 = *(const LAS f32x4*)(tb + 1028);
                    const float csv[8] = {c0.x, c0.y, c0.z, c0.w, c1.x, c1.y, c1.z, c1.w}, snv[8] = {s0.x, s0.y, s0.z, s0.w, s1.x, s1.y, s1.z, s1.w};
                    const f32x4 g0 = isq ? qg8[0] : kg8[0], g1 = isq ? qg8[1] : kg8[1]; const float gv[8] = {g0.x, g0.y, g0.z, g0.w, g1.x, g1.y, g1.z, g1.w};
                    const float osc = isq ? QSCALE * 8.f : 1.f; float o[8];
#pragma unroll
                    for (int c = 0; c < 8; ++c) { const float xn = xv[c] * rs * gv[c]; const float pr = __shfl_xor(xn, 2); o[c] = (xn * csv[c] + sg * pr * snv[c]) * osc; }
                    const unsigned long long w8 = (unsigned long long)pk4_fp8(o[0], o[1], o[2], o[3]) | ((unsigned long long)pk4_fp8(o[4], o[5], o[6], o[7]) << 32);
                    const int r_ = (int)(m & 63), c_ = li >> 1;
                    unsigned char* dst = isq ? ((unsigned char*)QB + m * 512 + head * 64 + 8 * li)
                                             : ((unsigned char*)KB + (size_t)((((m >> 12) * 2 + (head - 8)) * 64 + ((m & 4095) >> 6))) * 4096 + r_ * 64 + ((c_ ^ ((r_ >> 2) & 3)) * 16) + (li & 1) * 8);
                    *(unsigned long long*)dst = w8; } }
              int lane_v = lane; asm volatile("" : "+v"(lane_v));
              if (gw < NB * 2 * 64) { const int tile_ = gw & 63, kvh_ = (gw >> 6) & 1, b_ = gw >> 7; const size_t tok0 = (size_t)b_ * SEQ + tile_ * 64; const int g = lane_v >> 3, v0 = (lane_v & 7) * 8;
                u16x8 x[8]; const bf16* xp = PROJ + (tok0 + 8 * g) * INP + C_AV + kvh_ * 64 + v0;
#pragma unroll
                for (int i = 0; i < 8; ++i) x[i] = *(const u16x8*)(xp + (size_t)i * INP);
                unsigned char* tb = (unsigned char*)KB + 4 * MiB + (size_t)gw * 4096;
#pragma unroll
                for (int c = 0; c < 8; ++c) { const int d = v0 + c, sw = (d >> 2) & 3;
                    const unsigned lo = pk4_fp8(bf2f(x[0][c]), bf2f(x[1][c]), bf2f(x[2][c]), bf2f(x[3][c])), hi_ = pk4_fp8(bf2f(x[4][c]), bf2f(x[5][c]), bf2f(x[6][c]), bf2f(x[7][c]));
                    *(unsigned*)(tb + d * 64 + (((g >> 2) ^ sw) * 16) + 4 * (g & 3)) = lo;
                    *(unsigned*)(tb + d * 64 + (((2 + (g >> 2)) ^ sw) * 16) + 4 * (g & 3)) = hi_; } }
              const float* gw_l = gla_gate_w + (size_t)l * 2 * 16 * 128; const float* gb_l = gla_gate_b + (size_t)l * 2 * 128; const int dir = lane >> 5, kc = (lane & 31) * 4;
              f32x4 gwr[16]; const f32x4 gbv = *(const f32x4*)(gb_l + dir * 128 + kc);
#pragma unroll
              for (int r = 0; r < 16; ++r) gwr[r] = *(const f32x4*)(gw_l + (size_t)(dir * 16 + r) * 128 + kc);
              for (int m0 = gw; m0 < NTOK; m0 += P2_TOKB * NGW) { v4u gl[P2_TOKB][2];
#pragma unroll
                for (int q = 0; q < P2_TOKB; ++q) { const bf16* gp = PROJ + (size_t)(m0 + q * NGW) * INP + C_GLR + dir * 16; gl[q][0] = *(const v4u*)gp; gl[q][1] = *(const v4u*)(gp + 8); }
#pragma unroll
                for (int q = 0; q < P2_TOKB; ++q) { const size_t m = (size_t)(m0 + q * NGW); f32x4 z = gbv;
                    const unsigned gu[8] = {gl[q][0].x, gl[q][0].y, gl[q][0].z, gl[q][0].w, gl[q][1].x, gl[q][1].y, gl[q][1].z, gl[q][1].w};
#pragma unroll
                    for (int r2 = 0; r2 < 8; ++r2) { z = z + gwr[2 * r2] * __uint_as_float(gu[r2] << 16); z = z + gwr[2 * r2 + 1] * __uint_as_float(gu[r2] & 0xffff0000u); }
                    f32x4 o4;
#pragma unroll
                    for (int i = 0; i < 4; ++i) o4[i] = (fminf(z[i], 0.f) - __logf(1.f + __expf(-fabsf(z[i])))) * (1.f / 16.f);
                    *(f32x4*)(LA + m * 256 + dir * 128 + kc) = o4; } }
              __syncthreads(); }
            STAMP2(4);
            { __syncthreads();
              { const v4u* src = (const v4u*)WSP(bf16, WS_FTAB); LAS v4u* dst = (LAS v4u*)(lds + RING_OFF + FFT_LDS_TAB); for (int i = tid; i < 3 * FT_TAB * 2 / 16; i += NWAVES * 64) dst[i] = src[i];
                const v4u* s2_ = (const v4u*)WSP(float, WS_TW); LAS v4u* d2_ = (LAS v4u*)(lds + RING_OFF + FFT_LDS_TW); for (int i = tid; i < 4096 * 8 / 16; i += NWAVES * 64) d2_[i] = s2_[i]; }
              __syncthreads();
              const LAS bf16* FT = (const LAS bf16*)(lds + RING_OFF + FFT_LDS_TAB); const LAS float* TWL = (const LAS float*)(lds + RING_OFF + FFT_LDS_TW); bf16* FTMP = WSP(bf16, WS_FTMP);
              const int pair = wave >> 1, cb = wave & 1, r = lane & 31, h = lane >> 5;
              for (int ub = bx; ub < NB * 4 * 64 / 4; ub += G) { const int u = ub * 4 + pair, s2 = u & 63, g4 = (u >> 6) & 3, b = u >> 8;
                bf16x8 xa[2][4];
#pragma unroll
                for (int R = 0; R < 2; ++R)
#pragma unroll
                    for (int ks = 0; ks < 4; ++ks) xa[R][ks] = *(const bf16x8*)(PROJ + ((size_t)b * SEQ + 64 * (32 * R + r) + s2) * INP + C_FX + g4 * 64 + 16 * ks + 8 * h);
                f32x16 Tr[2], Ti[2];
#pragma unroll
                for (int R = 0; R < 2; ++R)
#pragma unroll
                    for (int i = 0; i < 16; ++i) { Tr[R][i] = 0.f; Ti[R][i] = 0.f; }
#pragma unroll
                for (int ks = 0; ks < 4; ++ks) { const bf16x8 bc = *(const LAS bf16x8*)(FT + (32 * cb + r) * FT_PITCH + 16 * ks + 8 * h), bs = *(const LAS bf16x8*)(FT + 2 * FT_TAB + (32 * cb + r) * FT_PITCH + 16 * ks + 8 * h);
#pragma unroll
                    for (int R = 0; R < 2; ++R) { Tr[R] = MFMA32(xa[R][ks], bc, Tr[R]); Ti[R] = MFMA32(xa[R][ks], bs, Ti[R]); } }
#pragma unroll
                for (int Rp = 0; Rp < 2; ++Rp) { f32x16 Gr, Gi;
#pragma unroll
                    for (int i = 0; i < 16; ++i) { Gr[i] = 0.f; Gi[i] = 0.f; }
#pragma unroll
                    for (int R = 0; R < 2; ++R)
#pragma unroll
                        for (int s_ = 0; s_ < 2; ++s_) { const bf16x8 xr = pack_step(Tr[R], s_), xi = pack_step(Ti[R], s_);
                            const int kb = 32 * R + 16 * s_ + 4 * h, ro = (32 * Rp + r) * FT_PITCH + kb;
                            const s16x4 c0 = *(const LAS s16x4*)(FT + ro), c1 = *(const LAS s16x4*)(FT + ro + 8), s0 = *(const LAS s16x4*)(FT + FT_TAB + ro), s1 = *(const LAS s16x4*)(FT + FT_TAB + ro + 8),
                                        n0 = *(const LAS s16x4*)(FT + 2 * FT_TAB + ro), n1 = *(const LAS s16x4*)(FT + 2 * FT_TAB + ro + 8);
                            const bf16x8 ca = __builtin_shufflevector(c0, c1, 0, 1, 2, 3, 4, 5, 6, 7), sa = __builtin_shufflevector(s0, s1, 0, 1, 2, 3, 4, 5, 6, 7), na = __builtin_shufflevector(n0, n1, 0, 1, 2, 3, 4, 5, 6, 7);
                            Gr = MFMA32(ca, xr, Gr); Gr = MFMA32(sa, xi, Gr); Gi = MFMA32(ca, xi, Gi); Gi = MFMA32(na, xr, Gi); }
#pragma unroll
                    for (int i = 0; i < 16; ++i) { const int s1p = 32 * Rp + crow16(i, h); const int m = (s2 * s1p) & 4095; const float wr = TWL[2 * m], wi = TWL[2 * m + 1];
                        const size_t o = ((((size_t)(b * 4 + g4) * 64 + s1p) * 2) * 64 + s2) * 64 + 32 * cb + r;
                        FTMP[o] = (bf16)f2bf(Gr[i] * wr - Gi[i] * wi); FTMP[o + 4096] = (bf16)f2bf(Gr[i] * wi + Gi[i] * wr); } }
              }
              __syncthreads(); }
            STAMP2(5);
            { float* GS = WSP(float, WS_OF); float* GD = WSP(float, WS_OB);
              const int slot = wave >> 2, w4 = wave & 3, fr = lane & 15, fq = lane >> 4; LAS unsigned char* Ls = lds + RING_OFF + slot * GM_SLOT;
              for (int ub = bx; ub < NB * 4 * 64 / 2; ub += G) { const int u = ub * 2 + slot, c = u & 63, bh = u >> 6, hd = bh & 3, b = bh >> 2; const size_t tok0 = (size_t)b * SEQ + c * 64;
                LBAR();
                gla_stage_mfma<false>(Ls, PROJ, LA, nullptr, tok0, hd, w4, lane);
                LBAR();
                const LAS bf16* VT = (const LAS bf16*)(Ls + GM_VT); const LAS float* DL = (const LAS float*)(Ls + GM_DL);
#pragma unroll
                for (int dir = 0; dir < 2; ++dir) { const LAS bf16* KT = (const LAS bf16*)(Ls + GM_P + dir * 4608);
#pragma unroll
                    for (int Cd = 0; Cd < 2; ++Cd) { f32x4 acc = {0.f, 0.f, 0.f, 0.f};
#pragma unroll
                        for (int ks = 0; ks < 2; ++ks) { const bf16x8 a_ = *(const LAS bf16x8*)(VT + (16 * w4 + fr) * 72 + 32 * ks + 8 * fq), b_ = *(const LAS bf16x8*)(KT + (16 * Cd + fr) * 72 + 32 * ks + 8 * fq); acc = MFMA16(a_, b_, acc); }
                        const float Dd = DL[dir * 32 + 16 * Cd + fr]; float* o = GS + (((size_t)u * 2 + dir) * 64 + 16 * w4 + 4 * fq) * 32 + 16 * Cd + fr;
#pragma unroll
                        for (int r = 0; r < 4; ++r) o[r * 32] = acc[r] * Dd; } }
                if (w4 == 3) GD[((size_t)u * 2 + (lane >> 5)) * 32 + (lane & 31)] = DL[lane]; }
              __syncthreads(); }
            STAMP2(9);
        }
        SEAM(pb + 1);
        if (IN(pb + 2) && PON(3)) {
            TID_SETUP(); unsigned char* ws = KWS(); float* GS = WSP(float, WS_OF); const float* GD = WSP(float, WS_OB);
            for (int e = gt; e < NB * 4 * 2 * 2048; e += NGT) { const int dv = e & 2047, dir = (e >> 11) & 1, bh = e >> 12, d = dv & 31; float H = 0.f;
                for (int c8 = 0; c8 < 64; c8 += P3_BATCH) { float sv[P3_BATCH], dd[P3_BATCH];
#pragma unroll
                    for (int i = 0; i < P3_BATCH; ++i) { const int c = dir ? 63 - (c8 + i) : (c8 + i); const size_t sidx = ((size_t)(bh * 64 + c) * 2 + dir); sv[i] = GS[sidx * 2048 + dv]; dd[i] = GD[sidx * 32 + d]; }
#pragma unroll
                    for (int i = 0; i < P3_BATCH; ++i) { const int c = dir ? 63 - (c8 + i) : (c8 + i); const size_t sidx = ((size_t)(bh * 64 + c) * 2 + dir); GS[sidx * 2048 + dv] = H; H = H * dd[i] + sv[i]; } } }
        }
        SEAM(pb + 2);
        if (IN(pb + 3) && PON(4)) {
            TID_SETUP(); unsigned char* ws = KWS(); const float* gla_norm_g = KIN(8); const bf16* PROJ = WSP(bf16, WS_PROJ);
            bf16* MIX = WSP(bf16, WS_MIX); const bf16* QB = WSP(bf16, WS_QB); const bf16* KB = WSP(bf16, WS_KB);
            STAMP2(10);
            { __syncthreads();
              { const v4u* src = (const v4u*)WSP(bf16, WS_FTAB); LAS v4u* dst = (LAS v4u*)(lds + RING_OFF + FFT_LDS_TAB); for (int i = tid; i < 3 * FT_TAB * 2 / 16; i += NWAVES * 64) dst[i] = src[i]; }
              const LAS bf16* FT = (const LAS bf16*)(lds + RING_OFF + FFT_LDS_TAB); const bf16* FTMP = WSP(bf16, WS_FTMP);
              const int pair = wave >> 1, cb = wave & 1, r = lane & 31, h = lane >> 5;
              LAS bf16* HT = (LAS bf16*)(lds + RING_OFF + FFT_LDS_HT + pair * FFT_HT_PAIR);
              for (int ub = bx; ub < NB * 4 * 64 / 4; ub += G) { const int u = ub * 4 + pair, s1p = u & 63, g4 = (u >> 6) & 3, b = u >> 8;
                const bf16* src = FTMP + (size_t)u * 2 * 4096;
                LBAR();
#pragma unroll
                for (int q = 0; q < 8; ++q) { const int p = cb * 64 + lane + 128 * q, ri = p >> 9, s2 = (p >> 3) & 63, c0 = (p & 7) * 8; const u16x8 v = *(const u16x8*)(src + p * 8);
#pragma unroll
                    for (int i = 0; i < 8; ++i) HT[(ri * 64 + c0 + i) * FT_PITCH + s2] = v[i]; }
                LBAR();
#pragma unroll
                for (int Rp = 0; Rp < 2; ++Rp) { f32x16 acc;
#pragma unroll
                    for (int i = 0; i < 16; ++i) acc[i] = 0.f;
#pragma unroll
                    for (int ks = 0; ks < 4; ++ks) { const int ko = 16 * ks + 8 * h;
                        const bf16x8 ca = *(const LAS bf16x8*)(FT + (32 * Rp + r) * FT_PITCH + ko), sa = *(const LAS bf16x8*)(FT + FT_TAB + (32 * Rp + r) * FT_PITCH + ko);
                        const bf16x8 hr = *(const LAS bf16x8*)(HT + (32 * cb + r) * FT_PITCH + ko), hi_ = *(const LAS bf16x8*)(HT + (64 + 32 * cb + r) * FT_PITCH + ko);
                        acc = MFMA32(ca, hr, acc); acc = MFMA32(sa, hi_, acc); }
#pragma unroll
                    for (int i = 0; i < 16; ++i) { const int s2p = 32 * Rp + crow16(i, h); MIX[((size_t)b * SEQ + s1p + 64 * s2p) * DM + 768 + g4 * 64 + 32 * cb + r] = (bf16)f2bf(acc[i] * (1.0f / 512.0f)); } }
              }
              __syncthreads(); }
            STAMP2(6);
            { const float* GS = WSP(float, WS_OF); const float* LA = WSP(float, WS_LA);
              const int slot = wave >> 2, w4 = wave & 3, fr = lane & 15, fq = lane >> 4, I0 = 16 * w4; LAS unsigned char* Ls = lds + RING_OFF + slot * GM_SLOT;
              for (int ub = bx; ub < NB * 4 * 64 / 2; ub += G) { const int u = ub * 2 + slot, c = u & 63, bh = u >> 6, hd = bh & 3, b = bh >> 2; const size_t tok0 = (size_t)b * SEQ + c * 64;
                float gnv[4];
#pragma unroll
                for (int Cv = 0; Cv < 4; ++Cv) gnv[Cv] = gla_norm_g[l * 64 + 16 * Cv + fr];
                LBAR();
                gla_stage_mfma<true>(Ls, PROJ, LA, GS + (size_t)u * 2 * 2048, tok0, hd, w4, lane);
                LBAR();
                const LAS bf16* QF = (const LAS bf16*)(Ls + GM_QF); const LAS bf16* KF = (const LAS bf16*)(Ls + GM_KF); const LAS bf16* QBm = (const LAS bf16*)(Ls + GM_QB); const LAS bf16* KBm = (const LAS bf16*)(Ls + GM_KB);
                const LAS bf16* VT = (const LAS bf16*)(Ls + GM_VT); LAS bf16* P = (LAS bf16*)(Ls + GM_P); const LAS bf16* HTF = (const LAS bf16*)(Ls + GM_HTF); const LAS bf16* HTB = (const LAS bf16*)(Ls + GM_HTB);
                const bf16x8 qfa = *(const LAS bf16x8*)(QF + (I0 + fr) * 40 + 8 * fq), qba = *(const LAS bf16x8*)(QBm + (I0 + fr) * 40 + 8 * fq);
#pragma unroll
                for (int Cj = 0; Cj < 4; ++Cj) { const f32x4 z = {0.f, 0.f, 0.f, 0.f};
                    const f32x4 pf = MFMA16(qfa, *(const LAS bf16x8*)(KF + (16 * Cj + fr) * 40 + 8 * fq), z), pb = MFMA16(qba, *(const LAS bf16x8*)(KBm + (16 * Cj + fr) * 40 + 8 * fq), z);
#pragma unroll
                    for (int r = 0; r < 4; ++r) { const int i = I0 + 4 * fq + r, j = 16 * Cj + fr; P[i * 72 + j] = (bf16)f2bf(j <= i ? pf[r] : pb[r]); } }
                asm volatile("s_waitcnt lgkmcnt(0)" ::: "memory");
                f32x4 o[4];
#pragma unroll
                for (int Cv = 0; Cv < 4; ++Cv) { f32x4 acc = {0.f, 0.f, 0.f, 0.f};
#pragma unroll
                    for (int ks = 0; ks < 2; ++ks) acc = MFMA16(*(const LAS bf16x8*)(P + (I0 + fr) * 72 + 32 * ks + 8 * fq), *(const LAS bf16x8*)(VT + (16 * Cv + fr) * 72 + 32 * ks + 8 * fq), acc);
                    acc = MFMA16(qfa, *(const LAS bf16x8*)(HTF + (16 * Cv + fr) * 40 + 8 * fq), acc); acc = MFMA16(qba, *(const LAS bf16x8*)(HTB + (16 * Cv + fr) * 40 + 8 * fq), acc);
                    o[Cv] = acc; }
                float rs[4];
#pragma unroll
                for (int r = 0; r < 4; ++r) { float ss = (o[0][r] * o[0][r] + o[1][r] * o[1][r]) + (o[2][r] * o[2][r] + o[3][r] * o[3][r]);
#pragma unroll
                    for (int m_ = 1; m_ < 16; m_ <<= 1) ss += __shfl_xor(ss, m_);
                    rs[r] = 1.f / sqrtf(ss * (1.f / 64.f) + RMS_EPS); }
                { const LAS unsigned short* RG = (const LAS unsigned short*)(Ls + GM_RG); LAS unsigned short* PO = (LAS unsigned short*)(Ls + GM_P);
#pragma unroll
                  for (int Cv = 0; Cv < 4; ++Cv) { const int v = 16 * Cv + fr; const float gn = gnv[Cv];
#pragma unroll
                    for (int r = 0; r < 4; ++r) { const int i = I0 + 4 * fq + r; const float rg = bf2f(RG[i * 72 + v]);
                        PO[i * 72 + v] = (unsigned short)f2bf(o[Cv][r] * rs[r] * gn * rg * __builtin_amdgcn_rcpf(1.f + __expf(-rg))); } }
                  asm volatile("s_waitcnt lgkmcnt(0)" ::: "memory");
#pragma unroll
                  for (int k = 0; k < 2; ++k) { const int p_ = lane + 64 * k, row = p_ >> 3, ch = p_ & 7; const v4u w = *(const LAS v4u*)(PO + (I0 + row) * 72 + ch * 8);
                      *(v4u*)(MIX + (tok0 + I0 + row) * DM + 512 + hd * 64 + ch * 8) = w; } } }
              __syncthreads(); }
            STAMP2(7);
#if NAIVE_ATTN
            { LAS float* Kt = (LAS float*)(lds + RING_OFF); LAS float* Vt = Kt + 64 * 64;
              for (int unit = bx; unit < NB * 8 * 8; unit += G) { const int rb = unit & 7, h = (unit >> 3) & 7, b = unit >> 6, kvh = h >> 2;
                const size_t qrow = (size_t)b * SEQ + rb * 512 + tid;
                float q[64], o[64]; float mrun = -INFINITY, lrun = 0.f;
#pragma unroll
                for (int c8 = 0; c8 < 8; ++c8) { const u16x8 f = *(const u16x8*)(QB + qrow * 512 + h * 64 + c8 * 8);
#pragma unroll
                    for (int i = 0; i < 8; ++i) { q[c8 * 8 + i] = bf2f(f[i]); o[c8 * 8 + i] = 0.f; } }
                for (int kt = 0; kt < SEQ; kt += 64) {
                    __syncthreads();
                    { const int kr = tid >> 3, c8 = (tid & 7) * 8; const size_t krow = (size_t)b * SEQ + kt + kr;
                      const u16x8 kf = *(const u16x8*)(KB + krow * 128 + kvh * 64 + c8); const u16x8 vf = *(const u16x8*)(PROJ + krow * INP + C_AV + kvh * 64 + c8);
#pragma unroll
                      for (int i = 0; i < 8; ++i) { Kt[kr * 64 + c8 + i] = bf2f(kf[i]); Vt[kr * 64 + c8 + i] = bf2f(vf[i]); } }
                    __syncthreads();
#pragma unroll 1
                    for (int j = 0; j < 64; ++j) { float a = 0.f;
#pragma unroll
                        for (int d4 = 0; d4 < 16; ++d4) { const f32x4 kv = *(const LAS f32x4*)(Kt + j * 64 + d4 * 4); a += (q[d4 * 4] * kv.x + q[d4 * 4 + 1] * kv.y) + (q[d4 * 4 + 2] * kv.z + q[d4 * 4 + 3] * kv.w); }
                        if (a > mrun) { const float al = exp2f(mrun - a); mrun = a; lrun *= al;
#pragma unroll
                            for (int d = 0; d < 64; ++d) o[d] *= al; }
                        const float p = exp2f(a - mrun); lrun += p;
#pragma unroll
                        for (int d4 = 0; d4 < 16; ++d4) { const f32x4 vv = *(const LAS f32x4*)(Vt + j * 64 + d4 * 4); o[d4 * 4] += p * vv.x; o[d4 * 4 + 1] += p * vv.y; o[d4 * 4 + 2] += p * vv.z; o[d4 * 4 + 3] += p * vv.w; } }
                }
                const float rl = 1.f / lrun;
#pragma unroll
                for (int c8 = 0; c8 < 8; ++c8) { v4u w; w.x = pk2(o[c8 * 8] * rl, o[c8 * 8 + 1] * rl); w.y = pk2(o[c8 * 8 + 2] * rl, o[c8 * 8 + 3] * rl); w.z = pk2(o[c8 * 8 + 4] * rl, o[c8 * 8 + 5] * rl); w.w = pk2(o[c8 * 8 + 6] * rl, o[c8 * 8 + 7] * rl);
                    *(v4u*)(MIX + qrow * DM + h * 64 + c8 * 8) = w; }
              }
              __syncthreads(); }
#else
            { const attn_body::AttnTensors AT{(const attn_body::bf16*)QB, (const attn_body::bf16*)KB, (const attn_body::bf16*)((const unsigned char*)KB + 4 * MiB), (attn_body::bf16*)MIX};
              const attn_body::StaticOrder S(G, bx);
              float bq_ = fabsf(KIN(4)[l * 64 + lane]), bk_ = fabsf(KIN(5)[l * 64 + lane]);
#pragma unroll
              for (int m_ = 1; m_ < 64; m_ <<= 1) { bq_ = fmaxf(bq_, __shfl_xor(bq_, m_)); bk_ = fmaxf(bk_, __shfl_xor(bk_, m_)); }
              const float bref = __uint_as_float(__builtin_amdgcn_readfirstlane(__float_as_uint(64.f * QSCALE * 1.02f * bq_ * bk_)));
              attn_body::attn_phase<attn_body::StaticOrder>((char*)lds_raw + RING_OFF, AT, S, bref); }
#endif
            STAMP2(11);
        }
        SEAM(pb + 3);
        if (IN(pb + 4) && PON(5)) {
            TID_SETUP(); unsigned char* ws = KWS(); const bf16* MIX = WSP(bf16, WS_MIX); const bf16* WOUT_T = WSP(bf16, WS_WOUT_T); const bf16* HB = WSP(bf16, WS_HB); bf16* T1 = WSP(bf16, WS_T1);
            pg8::Gemm g{MIX, WOUT_T + (size_t)l * DM * DM, NTOK, DM, DM}; pg8::StaticOrder S; S.init(NTOK, DM, G, bx);
            pg8::EpiResBf16 E{HB, T1, DM, DN_ALPHA};
            pg8::gemm_phase<pg8::EpiResBf16, pg8::StaticOrder, true, true>(lds + RING_OFF, g, S, E);
        }
        SEAM(pb + 4);
        if (IN(pb + 5) && PON(6)) {
            TID_SETUP(); unsigned char* ws = KWS(); gu32* ctl = (gu32*)(ws + WS_CTL); const float* ln1_g = KIN(10); const float* ln1_b = KIN(11); const float* router_w = KIN(12); const float* router_b = KIN(13);
            const bf16* T1 = WSP(bf16, WS_T1); bf16* HB = WSP(bf16, WS_HB); unsigned char* HB8 = WSP(unsigned char, WS_UVT); int* TOKE = WSP(int, WS_TOK); int* TOKS = TOKE + NTOK * 4; float* TOKW = (float*)(TOKS + NTOK * 4); int* LIST = WSP(int, WS_XS);
            { const v4u* src = (const v4u*)(WSP(bf16, WS_RWT) + (size_t)l * 2 * NE * DM); LAS v4u* dst = (LAS v4u*)(lds + RING_OFF);
              for (int i = tid; i < 2 * NE * DM * 2 / 16; i += NWAVES * 64) { const int row = i >> 7, c = i & 127; dst[row * 128 + (c ^ (row & 7))] = src[i]; }
              LAS float* GBw = (LAS float*)(lctl + LC_ROWS); for (int i = tid; i < DM; i += NWAVES * 64) { GBw[i] = ln1_g[l * DM + i]; GBw[DM + i] = ln1_b[l * DM + i]; } }
            const LAS bf16* RWH = (const LAS bf16*)(lds + RING_OFF); const LAS float* GB = (const LAS float*)(lctl + LC_ROWS); LAS float* ST = (LAS float*)(lctl + LC_ROWS + 8192);
            LAS int* lcnt = (LAS int*)(lctl + LC_CNT); LAS int* lbase = (LAS int*)(lctl + LC_BASE); LAS int* sele = (LAS int*)(lctl + LC_SELE); LAS int* sels = (LAS int*)(lctl + LC_SELS);
            const float* rb = router_b + l * NE;
            for (int r0 = bx * 128; r0 < NTOK; r0 += G * 128) {
                if (tid < 32) lcnt[tid] = 0;
                __syncthreads();
                LAS float* LG = (LAS float*)(lctl + LC_LG) + wave * 512;
                for (int rr = 0; rr < 16; rr += P6_ROWS) { v4u raw[P6_ROWS][2];
#pragma unroll
                    for (int q = 0; q < P6_ROWS; ++q)
#pragma unroll
                        for (int h = 0; h < 2; ++h) raw[q][h] = *(const v4u*)(T1 + ((size_t)r0 + wave * 16 + rr + q) * DM + h * 512 + 8 * lane);
#pragma unroll
                    for (int q = 0; q < P6_ROWS; ++q) { f32x4 v[4];
#pragma unroll
                        for (int h = 0; h < 2; ++h) { const v4u t = raw[q][h];
                            v[2 * h] = (f32x4){__uint_as_float(t.x << 16), __uint_as_float(t.x & 0xffff0000u), __uint_as_float(t.y << 16), __uint_as_float(t.y & 0xffff0000u)};
                            v[2 * h + 1] = (f32x4){__uint_as_float(t.z << 16), __uint_as_float(t.z & 0xffff0000u), __uint_as_float(t.w << 16), __uint_as_float(t.w & 0xffff0000u)}; }
                        float s_ = 0.f;
#pragma unroll
                        for (int j = 0; j < 4; ++j) s_ += (v[j].x + v[j].y) + (v[j].z + v[j].w);
                        const float mean = wave_sum(s_) * (1.f / DM); float s2_ = 0.f;
#pragma unroll
                        for (int j = 0; j < 4; ++j) { const f32x4 d_ = v[j] - mean; s2_ += (d_.x * d_.x + d_.y * d_.y) + (d_.z * d_.z + d_.w * d_.w); }
                        const float rstd = __builtin_amdgcn_rsqf(wave_sum(s2_) * (1.f / DM) + LN_EPS);
                        if (lane == 0) { ST[(wave * 16 + rr + q) * 2] = mean; ST[(wave * 16 + rr + q) * 2 + 1] = rstd; } } }
                asm volatile("s_waitcnt lgkmcnt(0)" ::: "memory");
                { const int fr = lane & 15, fq = lane >> 4; const size_t row = (size_t)r0 + wave * 16 + fr; const float mean = ST[(wave * 16 + fr) * 2], rstd = ST[(wave * 16 + fr) * 2 + 1];
                  const bf16* xrow = T1 + row * DM + 8 * fq; bf16* hrow = HB + row * DM + 8 * fq;
                  f32x4 acc0 = {0.f, 0.f, 0.f, 0.f}, acc1 = {0.f, 0.f, 0.f, 0.f};
#pragma unroll 1
                  for (int s8 = 0; s8 < 32; s8 += 8) { v4u xr[8];
#pragma unroll
                    for (int i = 0; i < 8; ++i) xr[i] = *(const v4u*)(xrow + 32 * (s8 + i));
#pragma unroll
                    for (int i = 0; i < 8; ++i) { const int k0 = 32 * (s8 + i) + 8 * fq;
                        const f32x4 g0 = *(const LAS f32x4*)(GB + k0), g1 = *(const LAS f32x4*)(GB + k0 + 4), b0 = *(const LAS f32x4*)(GB + DM + k0), b1 = *(const LAS f32x4*)(GB + DM + k0 + 4);
                        f32x4 x0 = {__uint_as_float(xr[i].x << 16), __uint_as_float(xr[i].x & 0xffff0000u), __uint_as_float(xr[i].y << 16), __uint_as_float(xr[i].y & 0xffff0000u)};
                        f32x4 x1 = {__uint_as_float(xr[i].z << 16), __uint_as_float(xr[i].z & 0xffff0000u), __uint_as_float(xr[i].w << 16), __uint_as_float(xr[i].w & 0xffff0000u)};
                        x0 = (x0 - mean) * rstd * g0 + b0; x1 = (x1 - mean) * rstd * g1 + b1;
                        v4u hi; hi.x = pk2(x0.x, x0.y); hi.y = pk2(x0.z, x0.w); hi.z = pk2(x1.x, x1.y); hi.w = pk2(x1.z, x1.w);
                        *(v4u*)(hrow + 32 * (s8 + i)) = hi;
                        *(unsigned long long*)(HB8 + row * DM + 32 * (s8 + i) + 8 * fq) = (unsigned long long)pk4_fp8(x0.x, x0.y, x0.z, x0.w) | ((unsigned long long)pk4_fp8(x1.x, x1.y, x1.z, x1.w) << 32);
                        const f32x4 l0 = {x0.x - __uint_as_float(hi.x << 16), x0.y - __uint_as_float(hi.x & 0xffff0000u), x0.z - __uint_as_float(hi.y << 16), x0.w - __uint_as_float(hi.y & 0xffff0000u)};
                        const f32x4 l1 = {x1.x - __uint_as_float(hi.z << 16), x1.y - __uint_as_float(hi.z & 0xffff0000u), x1.z - __uint_as_float(hi.w << 16), x1.w - __uint_as_float(hi.w & 0xffff0000u)};
                        v4u lo; lo.x = pk2(l0.x, l0.y); lo.y = pk2(l0.z, l0.w); lo.z = pk2(l1.x, l1.y); lo.w = pk2(l1.z, l1.w);
                        const bf16x8 ah = __builtin_bit_cast(bf16x8, hi), al = __builtin_bit_cast(bf16x8, lo);
                        const int c = 4 * (s8 + i) + fq;
                        const LAS bf16* w0 = RWH + fr * DM + ((c ^ (fr & 7)) << 3); const LAS bf16* w1 = RWH + (16 + fr) * DM + ((c ^ (fr & 7)) << 3);
                        const bf16x8 bh0 = *(const LAS bf16x8*)w0, bl0 = *(const LAS bf16x8*)(w0 + NE * DM), bh1 = *(const LAS bf16x8*)w1, bl1 = *(const LAS bf16x8*)(w1 + NE * DM);
                        acc0 = MFMA16(ah, bh0, acc0); acc0 = MFMA16(ah, bl0, acc0); acc0 = MFMA16(al, bh0, acc0);
                        acc1 = MFMA16(ah, bh1, acc1); acc1 = MFMA16(ah, bl1, acc1); acc1 = MFMA16(al, bh1, acc1); } }
                  const float bias0 = rb[fr], bias1 = rb[16 + fr];
#pragma unroll
                  for (int r = 0; r < 4; ++r) { LG[(4 * fq + r) * 32 + fr] = acc0[r] + bias0; LG[(4 * fq + r) * 32 + 16 + fr] = acc1[r] + bias1; } }
                asm volatile("s_waitcnt lgkmcnt(0)" ::: "memory");
                if (lane < 16) { const int lr = wave * 16 + lane; const size_t m = (size_t)r0 + lr; float lg[32];
#pragma unroll
                    for (int e4 = 0; e4 < 8; ++e4) { const f32x4 x = *(const LAS f32x4*)(LG + lane * 32 + e4 * 4); lg[e4 * 4] = x.x; lg[e4 * 4 + 1] = x.y; lg[e4 * 4 + 2] = x.z; lg[e4 * 4 + 3] = x.w; }
                    int se[4]; float sv[4];
#pragma unroll
                    for (int k = 0; k < 4; ++k) { float best = -INFINITY; int bi = 0;
#pragma unroll
                        for (int e = 0; e < 32; ++e) { if (lg[e] > best) { best = lg[e]; bi = e; } }
                        se[k] = bi; sv[k] = best;
#pragma unroll
                        for (int e = 0; e < 32; ++e) if (e == bi) lg[e] = -INFINITY; }
                    const float e1 = expf(sv[1] - sv[0]), e2 = expf(sv[2] - sv[0]), e3 = expf(sv[3] - sv[0]); const float inv = 1.f / (1.f + e1 + e2 + e3);
                    const float wts[4] = {inv, e1 * inv, e2 * inv, e3 * inv};
#pragma unroll
                    for (int k = 0; k < 4; ++k) { const int ls = __hip_atomic_fetch_add(lcnt + se[k], 1, __ATOMIC_RELAXED, __HIP_MEMORY_SCOPE_WORKGROUP); sele[lr * 4 + k] = se[k]; sels[lr * 4 + k] = ls; TOKW[m * 4 + k] = wts[k]; } }
                __syncthreads();
                if (tid < 32) lbase[tid] = (int)__hip_atomic_fetch_add(ctl + CW_CNT + l * 32 + tid, (unsigned)lcnt[tid], RLX_AGENT);
                __syncthreads();
                { const int e = sele[tid], sl = lbase[e] + sels[tid]; TOKE[(size_t)r0 * 4 + tid] = e; TOKS[(size_t)r0 * 4 + tid] = sl; LIST[(size_t)e * NTOK + sl] = r0 + (tid >> 2); }
                __syncthreads();
            }
        }
        SEAM(pb + 5);
#if defined(EXP_P1_NOEPI)
        if (IN(pb + 6)) {
            TID_SETUP(); unsigned char* ws = KWS(); bf16* HB = WSP(bf16, WS_HB); bf16* WIN_T = WSP(bf16, WS_WIN_T); bf16* PROJ = WSP(bf16, WS_PROJ);
            pg8::Gemm g{HB, WIN_T + (size_t)l * INP * DM, NTOK, INP, DM}; pg8::StaticOrder S; S.init(NTOK, INP, G, bx);
            pg8::EpiNull EN{PROJ}; pg8::gemm_phase<pg8::EpiNull, pg8::StaticOrder, true, true>(lds + RING_OFF, g, S, EN);
            __syncthreads(); }
#endif
        STAMP(pb + 7);
        if (IN(pb + 7) || IN(pb + 8) || IN(pb + 9)) {
            LAS int* pst = (LAS int*)(lctl + LC_PSTART); LAS int* ecnt = (LAS int*)(lctl + LC_BASE); gu32* ctl = (gu32*)(KWS() + WS_CTL);
            __syncthreads();
            int ln_ = threadIdx.x; asm volatile("" : "+v"(ln_));
            if (ln_ < 64) { const int e = ln_ & 31;
                const int c = (int)__hip_atomic_load(ctl + CW_CNT + l * 32 + e, RLX_AGENT); const int p_ = (c + 255) >> 8; int incl = p_;
#pragma unroll
                for (int o = 1; o < 32; o <<= 1) { const int y = __shfl_up(incl, o); if (e >= o) incl += y; }
                if (ln_ < 32) { pst[e] = incl - p_; ecnt[e] = c; if (e == NE - 1) pst[NE] = incl; } }
            __syncthreads();
        }
        if (IN(pb + 7) && PON(8)) {
            TID_SETUP(); unsigned char* ws = KWS(); const float* exp_b_gu = KIN(15); const unsigned char* HB8 = WSP(unsigned char, WS_UVT); const int* LIST = WSP(int, WS_XS); const unsigned char* WGU8 = WSP(unsigned char, WS_WGU_T); unsigned char* HID8 = WSP(unsigned char, WS_HID);
            const LAS int* pst = (const LAS int*)(lctl + LC_PSTART); LAS int* ul = (LAS int*)(lctl + LC_ULIST);
            const int nM = pst[NE], nN = 8, nwg = nM * nN;
            if (tid < 64) { const long L = (long)tid * G + bx; int v = -1;
                if (L < nwg) { int wgid = (int)L; { const int q = nwg / 8, r = nwg % 8, xcd = wgid % 8, off = wgid / 8; wgid = (xcd < r ? xcd * (q + 1) : r * (q + 1) + (xcd - r) * q) + off; }
                    const int nig = 8 * nN, gid = wgid / nig, fm = gid * 8, gsz = (nM - fm) < 8 ? (nM - fm) : 8; const int pm = fm + ((wgid % nig) % gsz), pn = (wgid % nig) / gsz;
                    int e = 0; for (int k = 1; k < NE; ++k) if (pst[k] <= pm) e = k;
                    v = (pm << 16) | (e * nN + pn); }
                ul[tid] = v; }
            __syncthreads();
            const int nunits = bx < nwg ? (nwg - bx + G - 1) / G : 0;
            LAS unsigned short* rows16 = (LAS unsigned short*)(lctl + LC_ROWS); const LAS int* ecnt = (const LAS int*)(lctl + LC_BASE);
            if (nunits > 0) { int tok_[10]; int tid3 = tid; asm volatile("" : "+v"(tid3));
#pragma unroll
                for (int j = 0; j < 10; ++j) { const int i = tid3 + 512 * j; int sl = i >> 8; sl = sl < nunits ? sl : nunits - 1; const int v = ul[sl]; const int pm = v >> 16, e = (v & 0xffff) >> 3, pl = pm - pst[e]; const int idx = pl * 256 + (i & 255);
                    const bool ok = idx < ecnt[e]; const int t_ = LIST[(size_t)e * NTOK + (ok ? idx : 0)]; tok_[j] = ok ? t_ : 0; }
#pragma unroll
                for (int j = 0; j < 10; ++j) { const int i = tid3 + 512 * j; if (i < nunits * 256) rows16[i] = (unsigned short)tok_[j]; } }
            __syncthreads();
            pg8::Gemm g{(const pg8::bf16_t*)HB8, (const pg8::bf16_t*)(WGU8 + (size_t)l * NE * 2048 * DM), NTOK, NE * 2048, DM}; pg8::ListOrder S{ul, nunits};
            pg8::EpiSwiglu8 E{HID8, exp_b_gu + (size_t)l * NE * 2048, (LAS float*)(lctl + LC_LG)};
            pg8::gemm_phase_fp8<pg8::EpiSwiglu8, pg8::ListOrder, true, true>(lds + RING_OFF, g, S, E, rows16);
        }
        SEAM(pb + 7);
        if (IN(pb + 8) && PON(9)) {
            TID_SETUP(); unsigned char* ws = KWS(); const float* exp_b_down = KIN(17); const unsigned char* HID8 = WSP(unsigned char, WS_HID); const unsigned char* WDN8 = WSP(unsigned char, WS_WDN_T); unsigned char* YS = WSP(unsigned char, WS_YS);
            const LAS int* pst = (const LAS int*)(lctl + LC_PSTART); LAS int* ul = (LAS int*)(lctl + LC_ULIST);
            const int nM = pst[NE], nN = 4, nwg = nM * nN;
            __syncthreads();
            if (tid < 64) { const long L = (long)tid * G + bx; int v = -1;
                if (L < nwg) { int wgid = (int)L; { const int q = nwg / 8, r = nwg % 8, xcd = wgid % 8, off = wgid / 8; wgid = (xcd < r ? xcd * (q + 1) : r * (q + 1) + (xcd - r) * q) + off; }
                    const int nig = 8 * nN, gid = wgid / nig, fm = gid * 8, gsz = (nM - fm) < 8 ? (nM - fm) : 8; const int pm = fm + ((wgid % nig) % gsz), pn = (wgid % nig) / gsz;
                    int e = 0; for (int k = 1; k < NE; ++k) if (pst[k] <= pm) e = k;
                    v = (pm << 16) | (e * nN + pn); }
                ul[tid] = v; }
            __syncthreads();
            const int nunits = bx < nwg ? (nwg - bx + G - 1) / G : 0;
            pg8::Gemm g{(const pg8::bf16_t*)HID8, (const pg8::bf16_t*)(WDN8 + (size_t)l * NE * DM * DE), MPAD, NE * DM, DE}; pg8::ListOrder S{ul, nunits};
            pg8::EpiDown8 E{YS, exp_b_down + (size_t)l * NE * DM, (LAS float*)(lctl + LC_LG)};
            pg8::gemm_phase_fp8<pg8::EpiDown8, pg8::ListOrder, true, false>(lds + RING_OFF, g, S, E, nullptr);
        }
        SEAM(pb + 8);
        if (IN(pb + 9) && PON(10)) {
            TID_SETUP(); unsigned char* ws = KWS(); const float* ln2_g = KIN(18); const float* ln2_b = KIN(19); float* out = KOUT(); bf16* HB = WSP(bf16, WS_HB); unsigned char* HB8L = WSP(unsigned char, WS_HB8L);
            const unsigned char* YS = WSP(unsigned char, WS_YS); const int* TOKE = WSP(int, WS_TOK); const int* TOKS = TOKE + NTOK * 4; const float* TOKW = (const float*)(TOKS + NTOK * 4); const LAS int* pst = (const LAS int*)(lctl + LC_PSTART);
            const bool lastl = (l == NL - 1);
            f32x4 gam[4], bet[4];
#pragma unroll
            for (int j = 0; j < 4; ++j) { gam[j] = *(const f32x4*)(ln2_g + l * DM + 16 * lane + 4 * j); bet[j] = *(const f32x4*)(ln2_b + l * DM + 16 * lane + 4 * j); }
            int yo[4]; f32x4 wl = {0.f, 0.f, 0.f, 0.f};
            { const int m = gw + (lane & 15) * NGW; const v4u te = *(const v4u*)(TOKE + m * 4), ts = *(const v4u*)(TOKS + m * 4); wl = *(const f32x4*)(TOKW + m * 4);
              yo[0] = pst[te.x] * 256 + (int)ts.x; yo[1] = pst[te.y] * 256 + (int)ts.y; yo[2] = pst[te.z] * 256 + (int)ts.z; yo[3] = pst[te.w] * 256 + (int)ts.w; }
            for (int p2 = 0; p2 < NTOK / (2 * NGW); ++p2) { f32x4 v[2][4]; v4u yraw[2][4]; float wk[2][4];
#pragma unroll
                for (int q = 0; q < 2; ++q) { const int t = 2 * p2 + q, m = gw + t * NGW;
#pragma unroll
                    for (int k = 0; k < 4; ++k) { yraw[q][k] = *(const v4u*)(YS + (size_t)__builtin_amdgcn_readfirstlane(__shfl(yo[k], t)) * DM + 16 * lane); wk[q][k] = __shfl(wl[k], t); }
                    const v4u h0 = *(const v4u*)(HB + (size_t)m * DM + 16 * lane), h1 = *(const v4u*)(HB + (size_t)m * DM + 16 * lane + 8);
                    v[q][0] = (f32x4){__uint_as_float(h0.x << 16), __uint_as_float(h0.x & 0xffff0000u), __uint_as_float(h0.y << 16), __uint_as_float(h0.y & 0xffff0000u)} * DN_ALPHA;
                    v[q][1] = (f32x4){__uint_as_float(h0.z << 16), __uint_as_float(h0.z & 0xffff0000u), __uint_as_float(h0.w << 16), __uint_as_float(h0.w & 0xffff0000u)} * DN_ALPHA;
                    v[q][2] = (f32x4){__uint_as_float(h1.x << 16), __uint_as_float(h1.x & 0xffff0000u), __uint_as_float(h1.y << 16), __uint_as_float(h1.y & 0xffff0000u)} * DN_ALPHA;
                    v[q][3] = (f32x4){__uint_as_float(h1.z << 16), __uint_as_float(h1.z & 0xffff0000u), __uint_as_float(h1.w << 16), __uint_as_float(h1.w & 0xffff0000u)} * DN_ALPHA; }
#pragma unroll
                for (int q = 0; q < 2; ++q)
#pragma unroll
                    for (int k = 0; k < 4; ++k) { const float w = wk[q][k]; const unsigned yw[4] = {yraw[q][k].x, yraw[q][k].y, yraw[q][k].z, yraw[q][k].w};
#pragma unroll
                        for (int j = 0; j < 4; ++j) { const f32x2_t lo = __builtin_amdgcn_cvt_pk_f32_fp8((int)yw[j], false), hi = __builtin_amdgcn_cvt_pk_f32_fp8((int)yw[j], true);
                            v[q][j] = v[q][j] + (f32x4){lo.x, lo.y, hi.x, hi.y} * w; } }
#pragma unroll
                for (int q = 0; q < 2; ++q) { const int m = gw + (2 * p2 + q) * NGW; ln_row8(v[q], gam, bet);
                    if (lastl) {
#pragma unroll
                        for (int j = 0; j < 4; ++j) *(f32x4*)(out + (size_t)m * DM + 16 * lane + 4 * j) = v[q][j]; }
                    else { v4u w0, w1; w0.x = pk2(v[q][0].x, v[q][0].y); w0.y = pk2(v[q][0].z, v[q][0].w); w0.z = pk2(v[q][1].x, v[q][1].y); w0.w = pk2(v[q][1].z, v[q][1].w);
                        w1.x = pk2(v[q][2].x, v[q][2].y); w1.y = pk2(v[q][2].z, v[q][2].w); w1.z = pk2(v[q][3].x, v[q][3].y); w1.w = pk2(v[q][3].z, v[q][3].w);
                        *(v4u*)(HB + (size_t)m * DM + 16 * lane) = w0; *(v4u*)(HB + (size_t)m * DM + 16 * lane + 8) = w1;
                        v4u w8; w8.x = pk4_fp8(v[q][0].x, v[q][0].y, v[q][0].z, v[q][0].w); w8.y = pk4_fp8(v[q][1].x, v[q][1].y, v[q][1].z, v[q][1].w); w8.z = pk4_fp8(v[q][2].x, v[q][2].y, v[q][2].z, v[q][2].w); w8.w = pk4_fp8(v[q][3].x, v[q][3].y, v[q][3].z, v[q][3].w);
                        *(v4u*)(HB8L + (size_t)m * DM + 16 * lane) = w8; } } }
        }
        SEAM(pb + 9);
    }
#if PROBE_A >= 0
    { xcd_barrier(bar);
      const unsigned long long* st = (const unsigned long long*)(KWS() + WS_CTL + 65536); unsigned long long T = 0;
      if (PROBE_A & 1) T += st[1] - st[0];
      for (int l = 0; l < NL; ++l) for (int j = 1; j <= 10; ++j) if ((PROBE_A >> j) & 1) T += st[1 + 10 * l + j] - st[10 * l + j];
      if (PROBE_SUB_A >= 0) for (int l = 0; l < NL; ++l) T += st[128 + l * 16 + PROBE_SUB_B] - st[128 + l * 16 + PROBE_SUB_A];
      T *= 4ull; if (T > 5000000ull) T = 5000000ull;
      const unsigned long long t0 = __builtin_amdgcn_s_memrealtime();
      while (__builtin_amdgcn_s_memrealtime() - t0 < T) __builtin_amdgcn_s_sleep(16); }
#endif
#undef IN
#undef SEAM
}

#ifndef MK_PER_PHASE
#define MK_PER_PHASE 0
#endif
extern "C" void kernel_launch(void* const* d_in, const int* in_sizes, int n_in, void* d_out, int out_size, void* d_ws, size_t ws_size, hipStream_t stream) {
    static int grid = 0;
    if (grid == 0) {
        if (n_in != 20 || in_sizes[0] != NTOK * DM || out_size != NTOK * DM || ws_size < WS_END) { fprintf(stderr, "kernel_launch: unexpected shapes (n_in %d, in0 %d, out %d, ws %zu); nothing launched\n", n_in, n_in > 0 ? in_sizes[0] : -1, out_size, ws_size); grid = -1; return; }
        int dev = 0, cus = 0, per_cu = 0;
        if (hipGetDevice(&dev) != hipSuccess || hipDeviceGetAttribute(&cus, hipDeviceAttributeMultiprocessorCount, dev) != hipSuccess) { grid = -1; return; }
        if (hipFuncSetAttribute((const void*)fwd, hipFuncAttributeMaxDynamicSharedMemorySize, LDS_BYTES) != hipSuccess) { fprintf(stderr, "kernel_launch: hipFuncSetAttribute failed\n"); grid = -1; return; }
        if (hipOccupancyMaxActiveBlocksPerMultiprocessor(&per_cu, (const void*)fwd, NWAVES * 64, LDS_BYTES) != hipSuccess || per_cu < 1) fprintf(stderr, "kernel_launch: occupancy query reports %d\n", per_cu);
        (void)hipGetLastError();
        if (cus < 256) { fprintf(stderr, "kernel_launch: built for a 256-CU device (got %d CUs); nothing launched\n", cus); grid = -1; return; }
        grid = 256;
    }
    if (grid < 0) return;
    if (hipMemsetAsync((char*)d_ws + WS_CTL, 0, CTL_ZERO_BYTES, stream) != hipSuccess) return;
    Args a{};
    for (int i = 0; i < 20; ++i) a.in[i] = (const float*)d_in[i];
    a.out = (float*)d_out; a.ws = (unsigned char*)d_ws;
#if MK_PER_PHASE
    for (int p = 0; p < N_PHASES; ++p) { a.ph_lo = p; a.ph_hi = p + 1; hipLaunchKernelGGL(fwd, dim3(grid), dim3(NWAVES * 64), LDS_BYTES, stream, a); }
#else
    a.ph_lo = 0; a.ph_hi = N_PHASES;
    hipLaunchKernelGGL(fwd, dim3(grid), dim3(NWAVES * 64), LDS_BYTES, stream, a);
#endif
    const hipError_t le = hipPeekAtLastError();
    if (le != hipSuccess) fprintf(stderr, "kernel_launch: launch failed: %s\n", hipGetErrorName(le));
}
```
